# Optimizing an MI355X kernel written in HIP

```python
import math
import jax, jax.numpy as jnp
from jax import lax
import numpy as np

D_MODEL = 1024
BATCH = 2
SEQ = 8192
DEPTH = 2

HG_HEADS = 4
HG_W = D_MODEL // 4
HG_DK = HG_W // HG_HEADS
ML_HEADS = 4
ML_W = D_MODEL // 4
ML_DH = ML_W // ML_HEADS
FX_HEADS = 8
FX_W = D_MODEL // 2
FX_DH = FX_W // FX_HEADS
D_MIX = HG_W + ML_W + FX_W
SPLIT_SIZES = (HG_W, HG_W, HG_W, HG_W, ML_W, ML_W, ML_W, ML_HEADS, ML_HEADS, ML_W, FX_W, FX_W, FX_W, FX_HEADS)
D_IN = 4 * HG_W + 4 * ML_W + 2 * ML_HEADS + 3 * FX_W + FX_HEADS
CONV_K = 4
CHUNK = 64
Q_BLOCK = 128
D_FF = ((8 * D_MODEL // 3 + 127) // 128) * 128
N_EXPERTS = 8
TOP_K = 2
D_FF_EXPERT = 7 * D_MODEL // 2
EXPERT_BLOCK = 256
N_DENSE = (DEPTH + 1) // 2
N_MOE = DEPTH // 2
EPS = 1e-6

kernel_name = "hymba_style_hgrn2_mlstm_fox_moe"


def rmsnorm(x, g):
    xf = x.astype(jnp.float32)
    y = xf * lax.rsqrt(jnp.mean(xf * xf, axis=-1, keepdims=True) + EPS)
    return (y * g.astype(jnp.float32)).astype(x.dtype)


def head_rmsnorm(o, gain, heads):
    B, S, W = o.shape
    of = o.reshape(B, S, heads, W // heads)
    of = of * lax.rsqrt(jnp.mean(of * of, axis=-1, keepdims=True) + EPS)
    return of.reshape(B, S, W) * gain.astype(jnp.float32)


def to_chunks(t, heads):
    B, S, W = t.shape
    return t.reshape(B, S // CHUNK, CHUNK, heads, W // heads).transpose(1, 0, 3, 2, 4)


def gate_chunks(t):
    B, S, H = t.shape
    return t.reshape(B, S // CHUNK, CHUNK, H).transpose(1, 0, 3, 2)


def from_chunks(t):
    NC, B, H, C, d = t.shape
    return t.transpose(1, 0, 3, 2, 4).reshape(B, NC * C, H * d)


def causal_conv(x, w):
    C = x.shape[-1]
    return lax.conv_general_dilated(x, w[:, None, :].astype(x.dtype), window_strides=(1,),
                                    padding=[(CONV_K - 1, 0)],
                                    dimension_numbers=('NWC', 'WIO', 'NWC'),
                                    feature_group_count=C)


def hgrn2_mixer(q, fz, i, g, lb, gain):
    f32 = jnp.float32
    B = q.shape[0]
    lb = lb.astype(f32)
    fz = fz.astype(f32)
    log_f = jnp.logaddexp(jnp.log(lb), jnp.log1p(-lb) + jax.nn.log_sigmoid(fz))
    k = (1.0 - lb) * jax.nn.sigmoid(-fz)
    qc = to_chunks(q.astype(f32), HG_HEADS)
    kc = to_chunks(k, HG_HEADS)
    vc = to_chunks(i.astype(f32), HG_HEADS)
    gc = to_chunks(log_f, HG_HEADS)
    mask = jnp.tril(jnp.ones((CHUNK, CHUNK), bool))[:, :, None]

    def step(S, xs):
        qb, kb, vb, gb = xs
        b = jnp.cumsum(gb, axis=2)
        diff = b[:, :, :, None, :] - b[:, :, None, :, :]
        decay = jnp.exp(jnp.where(mask, diff, -jnp.inf))
        scores = jnp.einsum('bhtd,bhsd,bhtsd->bhts', qb, kb, decay)
        o = (jnp.einsum('bhts,bhsv->bhtv', scores, vb)
             + jnp.einsum('bhtd,bhdv->bhtv', qb * jnp.exp(b), S))
        b_end = b[:, :, -1:, :]
        S = (jnp.exp(b_end[:, :, 0, :])[..., None] * S
             + jnp.einsum('bhsd,bhsv->bhdv', kb * jnp.exp(b_end - b), vb))
        return S, o

    S0 = jnp.zeros((B, HG_HEADS, HG_DK, HG_DK), f32)
    _, o = lax.scan(step, S0, (qc, kc, vc, gc))
    o = from_chunks(o)
    return head_rmsnorm(o, gain, HG_HEADS) * jax.nn.silu(g.astype(f32))


def mlstm_mixer(q, k, v, ig, fg, og, conv_w, b_i, b_f, gain):
    f32 = jnp.float32
    B = q.shape[0]
    qk = jax.nn.silu(causal_conv(jnp.concatenate([q, k], axis=-1), conv_w))
    q, k = jnp.split(qk.astype(f32), 2, axis=-1)
    k = k * (ML_DH ** -0.5)
    log_i = ig.astype(f32) + b_i.astype(f32)
    log_f = jax.nn.log_sigmoid(fg.astype(f32) + b_f.astype(f32))
    qc = to_chunks(q, ML_HEADS)
    kc = to_chunks(k, ML_HEADS)
    vc = to_chunks(v.astype(f32), ML_HEADS)
    ic = gate_chunks(log_i)
    fc = gate_chunks(log_f)
    mask = jnp.tril(jnp.ones((CHUNK, CHUNK), bool))

    def step(carry, xs):
        Cm, n, m = carry
        qb, kb, vb, lib, lfb = xs
        b = jnp.cumsum(lfb, axis=-1)
        d_log = jnp.where(mask, b[..., :, None] - b[..., None, :] + lib[..., None, :], -jnp.inf)
        inter = b + m[..., None]
        m_t = jnp.maximum(jnp.max(d_log, axis=-1), inter)
        w = jnp.einsum('bhtd,bhsd->bhts', qb, kb) * jnp.exp(d_log - m_t[..., None])
        s_inter = jnp.exp(inter - m_t)
        num = (jnp.einsum('bhts,bhsv->bhtv', w, vb)
               + s_inter[..., None] * jnp.einsum('bhtd,bhdv->bhtv', qb, Cm))
        den = w.sum(-1) + s_inter * jnp.einsum('bhtd,bhd->bht', qb, n)
        h = num / jnp.maximum(jnp.abs(den), jnp.exp(-m_t))[..., None]
        b_end = b[..., -1]
        log_w = b_end[..., None] - b + lib
        m_new = jnp.maximum(b_end + m, jnp.max(log_w, axis=-1))
        wk = jnp.exp(log_w - m_new[..., None])
        decay = jnp.exp(b_end + m - m_new)
        Cm = decay[..., None, None] * Cm + jnp.einsum('bhs,bhsd,bhsv->bhdv', wk, kb, vb)
        n = decay[..., None] * n + jnp.einsum('bhs,bhsd->bhd', wk, kb)
        return (Cm, n, m_new), h

    init = (jnp.zeros((B, ML_HEADS, ML_DH, ML_DH), f32),
            jnp.zeros((B, ML_HEADS, ML_DH), f32),
            jnp.zeros((B, ML_HEADS), f32))
    _, h = lax.scan(step, init, (qc, kc, vc, ic, fc))
    h = from_chunks(h)
    return head_rmsnorm(h, gain, ML_HEADS) * jax.nn.sigmoid(og.astype(f32))


def fox_mixer(q, k, v, fz, b_f):
    f32 = jnp.float32
    B, S, _ = q.shape

    def heads(t):
        return t.reshape(B, S, FX_HEADS, FX_DH).transpose(0, 2, 1, 3)

    q, k, v = heads(q), heads(k), heads(v)
    log_f = jax.nn.log_sigmoid(fz.astype(f32) + b_f.astype(f32)).transpose(0, 2, 1)
    c = jnp.cumsum(log_f, axis=-1)
    nb = S // Q_BLOCK
    q_blocks = q.reshape(B, FX_HEADS, nb, Q_BLOCK, FX_DH).transpose(2, 0, 1, 3, 4)
    c_blocks = c.reshape(B, FX_HEADS, nb, Q_BLOCK).transpose(2, 0, 1, 3)
    kpos = jnp.arange(S)
    scale = FX_DH ** -0.5

    def block(args):
        qb, cb, bi = args
        qpos = bi * Q_BLOCK + jnp.arange(Q_BLOCK)
        s = (jnp.einsum('bhqd,bhkd->bhqk', qb, k).astype(f32) * scale
             + cb[..., None] - c[:, :, None, :])
        s = jnp.where(kpos[None, :] <= qpos[:, None], s, -jnp.inf)
        p = jax.nn.softmax(s, axis=-1)
        return jnp.einsum('bhqk,bhkd->bhqd', p.astype(v.dtype), v)

    o = lax.map(block, (q_blocks, c_blocks, jnp.arange(nb)))
    o = o.transpose(1, 2, 0, 3, 4).reshape(B, FX_HEADS, S, FX_DH)
    return o.transpose(0, 2, 1, 3).reshape(B, S, FX_W)


def swiglu(h, w_gate, w_up, w_down):
    return (jax.nn.silu(h @ w_gate) * (h @ w_up)) @ w_down


def moe_swiglu(h, router, w_gate, w_up, w_down):
    B, S, D = h.shape
    N = B * S
    xt = h.reshape(N, D)
    logits = (xt @ router).astype(jnp.float32)
    top_val, top_idx = lax.top_k(logits, TOP_K)
    gates = jax.nn.softmax(top_val, axis=-1)
    A = N * TOP_K
    e_flat = top_idx.reshape(A)
    t_flat = jnp.repeat(jnp.arange(N, dtype=jnp.int32), TOP_K)
    g_flat = gates.reshape(A).astype(h.dtype)
    order = jnp.argsort(e_flat)
    e_s, t_s, g_s = e_flat[order], t_flat[order], g_flat[order]
    counts = jax.ops.segment_sum(jnp.ones((A,), jnp.int32), e_flat, num_segments=N_EXPERTS)
    starts = jnp.cumsum(counts) - counts
    padded = (counts + EXPERT_BLOCK - 1) // EXPERT_BLOCK * EXPERT_BLOCK
    pad_end = jnp.cumsum(padded)
    pad_start = pad_end - padded
    dest = pad_start[e_s] + (jnp.arange(A, dtype=jnp.int32) - starts[e_s])
    P = A + N_EXPERTS * EXPERT_BLOCK
    n_blocks = P // EXPERT_BLOCK
    tok_pad = jnp.full((P,), N, jnp.int32).at[dest].set(t_s)
    gate_pad = jnp.zeros((P,), h.dtype).at[dest].set(g_s)
    blk_expert = jnp.minimum(
        jnp.searchsorted(pad_end, jnp.arange(n_blocks) * EXPERT_BLOCK, side='right'),
        N_EXPERTS - 1)
    x_pad = jnp.concatenate([xt, jnp.zeros((1, D), h.dtype)], axis=0)

    def expert_block(args):
        tok, gt, e = args
        xb = x_pad[tok]
        hid = jax.nn.silu(xb @ w_gate[e]) * (xb @ w_up[e])
        return (hid @ w_down[e]) * gt[:, None]

    ys = lax.map(expert_block, (tok_pad.reshape(n_blocks, EXPERT_BLOCK),
                                gate_pad.reshape(n_blocks, EXPERT_BLOCK), blk_expert))
    y = jnp.zeros((N + 1, D), h.dtype).at[tok_pad].add(ys.reshape(P, D))
    return y[:N].reshape(B, S, D)


def setup_inputs(seed: int = 0) -> dict:
    key = jax.random.key(seed)
    ks = jax.random.split(key, 24)
    f32 = jnp.float32

    def nrm(k, shape, scale):
        return jax.random.normal(k, shape, f32) * scale

    return {
        "x": nrm(ks[0], (BATCH, SEQ, D_MODEL), 1.0),
        "attn_norm": 1.0 + nrm(ks[1], (DEPTH, D_MODEL), 0.02),
        "w_in": nrm(ks[2], (DEPTH, D_MODEL, D_IN), D_MODEL ** -0.5),
        "hgrn_lb": nrm(ks[3], (DEPTH, HG_W), 0.5),
        "hgrn_norm": 1.0 + nrm(ks[4], (DEPTH, HG_W), 0.02),
        "mlstm_conv": nrm(ks[5], (DEPTH, CONV_K, 2 * ML_W), CONV_K ** -0.5),
        "mlstm_b_i": nrm(ks[6], (DEPTH, ML_HEADS), 0.1),
        "mlstm_b_f": jnp.linspace(3.0, 6.0, ML_HEADS, dtype=f32)[None, :] + nrm(ks[7], (DEPTH, ML_HEADS), 0.1),
        "mlstm_norm": 1.0 + nrm(ks[8], (DEPTH, ML_W), 0.02),
        "fox_b_f": jnp.linspace(1.0, 6.0, FX_HEADS, dtype=f32)[None, :] + nrm(ks[9], (DEPTH, FX_HEADS), 0.1),
        "w_out": nrm(ks[10], (DEPTH, D_MIX, D_MODEL), D_MIX ** -0.5),
        "ffn_norm": 1.0 + nrm(ks[11], (DEPTH, D_MODEL), 0.02),
        "dense_w_gate": nrm(ks[12], (N_DENSE, D_MODEL, D_FF), D_MODEL ** -0.5),
        "dense_w_up": nrm(ks[13], (N_DENSE, D_MODEL, D_FF), D_MODEL ** -0.5),
        "dense_w_down": nrm(ks[14], (N_DENSE, D_FF, D_MODEL), D_FF ** -0.5),
        "router": nrm(ks[15], (N_MOE, D_MODEL, N_EXPERTS), D_MODEL ** -0.5),
        "moe_w_gate": nrm(ks[16], (N_MOE, N_EXPERTS, D_MODEL, D_FF_EXPERT), D_MODEL ** -0.5),
        "moe_w_up": nrm(ks[17], (N_MOE, N_EXPERTS, D_MODEL, D_FF_EXPERT), D_MODEL ** -0.5),
        "moe_w_down": nrm(ks[18], (N_MOE, N_EXPERTS, D_FF_EXPERT, D_MODEL), D_FF_EXPERT ** -0.5),
        "final_norm": 1.0 + nrm(ks[19], (D_MODEL,), 0.02),
    }


def reference(x, attn_norm, w_in, hgrn_lb, hgrn_norm, mlstm_conv, mlstm_b_i, mlstm_b_f,
              mlstm_norm, fox_b_f, w_out, ffn_norm, dense_w_gate, dense_w_up, dense_w_down,
              router, moe_w_gate, moe_w_up, moe_w_down, final_norm):
    lb_all = jnp.cumsum(jax.nn.softmax(hgrn_lb.astype(jnp.float32), axis=0), axis=0)
    lb_all = lb_all - lb_all[0:1]
    split_idx = np.cumsum(SPLIT_SIZES)[:-1].tolist()
    for l in range(DEPTH):
        h = rmsnorm(x, attn_norm[l])
        (hq, hf, hi, hg, mq, mk, mv, mi, mf, mo, fq, fk, fv, ff) = jnp.split(h @ w_in[l], split_idx, axis=-1)
        o_hg = hgrn2_mixer(hq, hf, hi, hg, lb_all[l], hgrn_norm[l])
        o_ml = mlstm_mixer(mq, mk, mv, mi, mf, mo, mlstm_conv[l], mlstm_b_i[l], mlstm_b_f[l], mlstm_norm[l])
        o_fx = fox_mixer(fq, fk, fv, ff, fox_b_f[l])
        mix = jnp.concatenate([o_hg.astype(x.dtype), o_ml.astype(x.dtype), o_fx.astype(x.dtype)], axis=-1)
        x = x + mix @ w_out[l]
        h = rmsnorm(x, ffn_norm[l])
        if l % 2 == 0:
            j = l // 2
            x = x + swiglu(h, dense_w_gate[j], dense_w_up[j], dense_w_down[j])
        else:
            j = l // 2
            x = x + moe_swiglu(h, router[j], moe_w_gate[j], moe_w_up[j], moe_w_down[j])
    return rmsnorm(x, final_norm)
```

```cpp
#include <hip/hip_runtime.h>
#include <hip/hip_bf16.h>
#include <cstdint>
#include <cstdio>
#include <cstring>

namespace cfg {
constexpr int NTOK = 16384, D = 1024, SEQ = 8192, NB = 2, DIN = 3600, PW = 3584, GW = 16;
constexpr int FF = 2816, FE = 3584, NE = 8, MAXROWS = 34816;
constexpr float EPS = 1e-6f;
constexpr float LOG2E = 1.4426950408889634f;
constexpr float QSCALE = 0.125f * LOG2E;
constexpr int P_HQ = 0, P_HF = 256, P_HI = 512, P_HG = 768, P_MQ = 1024, P_MK = 1280, P_MV = 1536, P_MO = 1792, P_FQ = 2048, P_FK = 2560, P_FV = 3072;
constexpr size_t MiB = 1u << 20;
constexpr size_t WS_CTL = 0, CTL_BYTES = 1 * MiB;
constexpr size_t WS_G = 2 * MiB;
constexpr size_t WS_CF = 3 * MiB;
constexpr size_t WS_TOKINFO = 3 * MiB + 512 * 1024;
constexpr size_t WS_TGATE = 3 * MiB + 768 * 1024;
constexpr size_t WS_TOKLIST = 4 * MiB;
constexpr size_t WS_P = 8 * MiB;
constexpr size_t WS_SCAN = 120 * MiB;
constexpr size_t WS_HID = 8 * MiB;
constexpr size_t WS_H = 246 * MiB;
constexpr size_t WS_MIX = 278 * MiB;
constexpr size_t WS_XG = 278 * MiB;
constexpr size_t WS_W = 346 * MiB;
constexpr size_t WS_Y = 346 * MiB;
constexpr size_t WS_END = 458 * MiB;
constexpr int CW_CNT = 64;
}
using namespace cfg;
typedef unsigned short bf16_t;

__device__ __forceinline__ bf16_t f2bf(float f) { unsigned u = __builtin_bit_cast(unsigned, f); return (bf16_t)((u + 0x7fffu + ((u >> 16) & 1u)) >> 16); }
__device__ __forceinline__ float bf2f(bf16_t h) { return __builtin_bit_cast(float, (unsigned)h << 16); }
__device__ __forceinline__ float wave_sum(float v) {
#pragma unroll
    for (int o = 1; o < 64; o <<= 1) v += __shfl_xor(v, o);
    return v;
}
__device__ __forceinline__ float sigmoidf_(float z) { return 1.f / (1.f + __expf(-z)); }
__device__ __forceinline__ float siluf_(float z) { return z / (1.f + __expf(-z)); }
__device__ __forceinline__ float log_sigmoidf_(float z) { return fminf(z, 0.f) - log1pf(__expf(-fabsf(z))); }

__device__ __forceinline__ int moe_bases(const int* cnt, int* base) {
    int acc = 0;
#pragma unroll
    for (int e = 0; e < NE; ++e) { base[e] = acc; acc += (cnt[e] + 255) & ~255; }
    return acc;
}

namespace pg8 {
#define PG8_LAS __attribute__((address_space(3)))
typedef unsigned short bf16_t;
typedef short bf16x8 __attribute__((ext_vector_type(8)));
typedef float f32x4 __attribute__((ext_vector_type(4)));
typedef unsigned u32x4 __attribute__((ext_vector_type(4)));
constexpr int BM = 256, BK = 64, HALF = 128, HTB = HALF * BK * 2  , STAGE_BYTES = 8 * HTB, NXCD = 8, WGM = 8;

__host__ __device__ __forceinline__ int lds_byte(int r, int c) { const int st = (r >> 4) * 2 + (c >> 5), rr = r & 15, cc = c & 31, ob = rr * 64 + cc * 2; return st * 1024 + (ob ^ (((ob >> 9) & 1) << 5)); }
__host__ __device__ __forceinline__ void stage_rc(int b, int& R, int& C) { const int st = b / 1024, sb = b % 1024, swz = sb ^ (((sb >> 9) & 1) << 5); R = (st >> 1) * 16 + swz / 64; C = (st & 1) * 32 + (swz % 64) / 2; }
__host__ __device__ __forceinline__ int perm32(int rho) { const int n = rho >> 4, i = rho & 15; return 8 * (i >> 2) + 4 * n + (i & 3); }

struct Unit { int pm, pn; };
struct Gemm { int K; };

struct StaticOrder {
    int nM, nN, nwg, G, c;
    __host__ __device__ void init(int M, int N, int G_, int c_) { nM = M / BM; nN = N / BM; nwg = nM * nN; G = G_; c = c_; }
    __host__ __device__ bool next(int i, Unit& u) const {
        const long L = (long)i * G + c; if (L >= nwg) return false;
        int wgid = (int)L; { const int q = nwg / NXCD, r = nwg % NXCD, xcd = wgid % NXCD, off = wgid / NXCD; wgid = (xcd < r ? xcd * (q + 1) : r * (q + 1) + (xcd - r) * q) + off; }
        const int nig = WGM * nN, gid = wgid / nig, fm = gid * WGM, gsz = (nM - fm) < WGM ? (nM - fm) : WGM;
        u.pm = fm + ((wgid % nig) % gsz); u.pn = (wgid % nig) / gsz; return true;
    }
    __device__ __forceinline__ void a_ready(const Unit&) const {}
    __device__ __forceinline__ void done(const Unit&) const {}
};

__device__ __forceinline__ unsigned cvt_pk_bf16(float lo, float hi) { unsigned r; asm volatile("v_cvt_pk_bf16_f32 %0, %1, %2" : "=v"(r) : "v"(lo), "v"(hi)); return r; }
struct EpiBf {
    static constexpr bool PERM = true, AFTER_DRAIN = false;
    bf16_t* O; int ldc; int s_lo, s_hi; float scale;
    __device__ __forceinline__ void operator()(const f32x4 (&acc)[2][2][4][2], const Unit& u, int wr, int wc, int fr, int fq) const {
        const int row0 = u.pm * BM + wr * 64 + fr, col0 = u.pn * BM + wc * 32 + 8 * fq;
        const float sc = (u.pn >= s_lo && u.pn < s_hi) ? scale : 1.f;
#pragma unroll
        for (int ai = 0; ai < 2; ++ai)
#pragma unroll
            for (int m = 0; m < 4; ++m) { bf16_t* rowp = O + (size_t)(row0 + ai * HALF + m * 16) * ldc + col0;
#pragma unroll
                for (int bj = 0; bj < 2; ++bj) { const f32x4 v0 = acc[ai][bj][m][0] * sc, v1 = acc[ai][bj][m][1] * sc;
                    u32x4 w; w.x = cvt_pk_bf16(v0[0], v0[1]); w.y = cvt_pk_bf16(v0[2], v0[3]); w.z = cvt_pk_bf16(v1[0], v1[1]); w.w = cvt_pk_bf16(v1[2], v1[3]);
                    *(u32x4*)(rowp + bj * HALF) = w; } }
    }
};
__device__ __forceinline__ float silu_mul(float g, float u) { return g * __builtin_amdgcn_rcpf(1.f + __expf(-g)) * u; }
struct EpiSwiglu {
    static constexpr bool PERM = true, AFTER_DRAIN = false;
    bf16_t* O; int ldc;
    __device__ __forceinline__ void operator()(const f32x4 (&acc)[2][2][4][2], const Unit& u, int wr, int wc, int fr, int fq) const {
        const int row0 = u.pm * BM + wr * 64 + fr, col0 = u.pn * HALF + wc * 32 + 8 * fq;
#pragma unroll
        for (int ai = 0; ai < 2; ++ai)
#pragma unroll
            for (int m = 0; m < 4; ++m) { bf16_t* rowp = O + (size_t)(row0 + ai * HALF + m * 16) * ldc + col0;
                const f32x4 g0 = acc[ai][0][m][0], g1 = acc[ai][0][m][1], u0 = acc[ai][1][m][0], u1 = acc[ai][1][m][1];
                u32x4 w; w.x = cvt_pk_bf16(silu_mul(g0[0], u0[0]), silu_mul(g0[1], u0[1])); w.y = cvt_pk_bf16(silu_mul(g0[2], u0[2]), silu_mul(g0[3], u0[3]));
                w.z = cvt_pk_bf16(silu_mul(g1[0], u1[0]), silu_mul(g1[1], u1[1])); w.w = cvt_pk_bf16(silu_mul(g1[2], u1[2]), silu_mul(g1[3], u1[3]));
                *(u32x4*)rowp = w; }
    }
};
struct EpiResid {
    static constexpr bool PERM = false, AFTER_DRAIN = false;
    float* X; int ldc;
    __device__ __forceinline__ void operator()(const f32x4 (&acc)[2][2][4][2], const Unit& u, int wr, int wc, int fr, int fq) const {
        const int row0 = u.pm * BM + wr * 64 + fr, col0 = u.pn * BM + wc * 32 + 4 * fq;
#pragma unroll
        for (int ai = 0; ai < 2; ++ai)
#pragma unroll
            for (int m = 0; m < 4; ++m) { float* rowp = X + (size_t)(row0 + ai * HALF + m * 16) * ldc + col0;
#pragma unroll
                for (int bj = 0; bj < 2; ++bj)
#pragma unroll
                    for (int n = 0; n < 2; ++n) { f32x4* p = (f32x4*)(rowp + bj * HALF + n * 16); *p = *p + acc[ai][bj][m][n]; }
                asm volatile("" ::: "memory"); }
    }
};
struct GOrder {
    StaticOrder so; const char* A; const char* B; size_t a_tile, b_tile, b_exp; int tb1, tb2, tb3, tb4, tb5, tb6, tb7;
    __device__ __forceinline__ bool next(int i, Unit& u) const { return so.next(i, u); }
    __device__ __forceinline__ const char* a_base(const Unit& u) const { return A + (size_t)u.pm * a_tile; }
    __device__ __forceinline__ const char* b_base(const Unit& u) const {
        const int e = (u.pm >= tb1) + (u.pm >= tb2) + (u.pm >= tb3) + (u.pm >= tb4) + (u.pm >= tb5) + (u.pm >= tb6) + (u.pm >= tb7);
        return B + (size_t)e * b_exp + (size_t)u.pn * b_tile; }
    __device__ __forceinline__ void a_ready(const Unit&) const {}
    __device__ __forceinline__ void done(const Unit&) const {}
};
template <class Epi, class Sched, bool ALIGN_EPI = false, bool SP2 = false>
__device__ __forceinline__ void gemm_phase(PG8_LAS unsigned char* lds, const Gemm g, const Sched& S, const Epi& E) {
    const int tid = threadIdx.x, wid = __builtin_amdgcn_readfirstlane(tid >> 6), lane = tid & 63, wr = wid >> 2, wc = wid & 3, fr = lane & 15, fq = lane >> 4;
    const int K = g.K, nt = K / BK;
    unsigned voffA[2], voffB[2];
#pragma unroll
    for (int i = 0; i < 2; ++i) { int R, C; stage_rc(tid * 16 + i * 8192, R, C); const int Rb = Epi::PERM ? ((R & ~31) + perm32(R & 31)) : R;
        voffA[i] = (unsigned)(R * K + C) * 2u; voffB[i] = (unsigned)(Rb * K + C) * 2u; }
    const size_t kstep = (size_t)(BK * 2);
    const size_t hstep = (size_t)HALF * K * 2;
        const unsigned ldsw = (unsigned)wid * 1024u;
    const int aoff = lds_byte(wr * 64 + fr, fq * 8), boff = lds_byte(wc * 32 + fr, fq * 8);
#define PG8_SA(b, h) (((b) * 2 + (h)) * HTB)
#define PG8_SB(b, h) ((4 + (b) * 2 + (h)) * HTB)
#define PG8_STAGE(bufoff, gbase, voff) do { _Pragma("unroll") for (int _i = 0; _i < 2; ++_i) \
        __builtin_amdgcn_global_load_lds((const unsigned*)((const char*)(gbase) + (voff)[_i]), (PG8_LAS unsigned*)(lds + (bufoff) + ldsw + _i * 8192), 16, 0, 0); } while (0)
#define PG8_LDA(dst, b, h) do { _Pragma("unroll") for (int m = 0; m < 4; ++m) _Pragma("unroll") for (int k = 0; k < 2; ++k) dst[m][k] = *(const PG8_LAS bf16x8*)(lds + PG8_SA(b, h) + aoff + m * 2048 + k * 1024); } while (0)
#define PG8_LDB(dst, b, h) do { _Pragma("unroll") for (int n = 0; n < 2; ++n) _Pragma("unroll") for (int k = 0; k < 2; ++k) dst[n][k] = *(const PG8_LAS bf16x8*)(lds + PG8_SB(b, h) + boff + n * 2048 + k * 1024); } while (0)
#define PG8_MMA(ai, bj, At, Bt) do { __builtin_amdgcn_s_setprio(1); _Pragma("unroll") for (int m = 0; m < 4; ++m) _Pragma("unroll") for (int n = 0; n < 2; ++n) _Pragma("unroll") for (int k = 0; k < 2; ++k) \
        acc[ai][bj][m][n] = __builtin_amdgcn_mfma_f32_16x16x32_bf16(Bt[n][k], At[m][k], acc[ai][bj][m][n], 0, 0, 0); __builtin_amdgcn_s_setprio(0); } while (0)
#define PG8_WAIT_V(n) asm volatile("s_waitcnt vmcnt(" #n ")" ::: "memory")
#define PG8_WAIT_L(n) asm volatile("s_waitcnt lgkmcnt(" #n ")" ::: "memory")
#define PG8_BAR __builtin_amdgcn_s_barrier()
#define PG8_SCHED __builtin_amdgcn_sched_barrier(0)
    Unit cur, nxt; int ui = 0;
    if (!S.next(0, cur)) return;
    f32x4 acc[2][2][4][2];
#pragma unroll
    for (int a = 0; a < 2; ++a)
#pragma unroll
        for (int b = 0; b < 2; ++b)
#pragma unroll
            for (int m = 0; m < 4; ++m)
#pragma unroll
                for (int n = 0; n < 2; ++n) acc[a][b][m][n] = (f32x4){0.f, 0.f, 0.f, 0.f};
    bf16x8 At[4][2], B0[2][2], B1[2][2];
    const char* cA = S.a_base(cur); const char* cB = S.b_base(cur);
    S.a_ready(cur);
    if constexpr (SP2) {
        PG8_STAGE(PG8_SB(0, 0), cB, voffB); PG8_STAGE(PG8_SB(0, 1), cB + hstep, voffB); PG8_STAGE(PG8_SA(0, 0), cA, voffA); PG8_STAGE(PG8_SA(0, 1), cA + hstep, voffA);
        if (wr == 1) PG8_BAR;
        PG8_WAIT_V(2); PG8_BAR;
        PG8_STAGE(PG8_SB(1, 0), cB + kstep, voffB); PG8_STAGE(PG8_SA(1, 0), cA + kstep, voffA); PG8_STAGE(PG8_SB(1, 1), cB + hstep + kstep, voffB);
        PG8_WAIT_V(6); PG8_BAR;
    } else {
        PG8_STAGE(PG8_SB(0, 0), cB, voffB); PG8_STAGE(PG8_SA(0, 0), cA, voffA); PG8_STAGE(PG8_SB(0, 1), cB + hstep, voffB); PG8_STAGE(PG8_SA(0, 1), cA + hstep, voffA);
        if (wr == 1) PG8_BAR;
        PG8_WAIT_V(4); PG8_BAR;
        PG8_STAGE(PG8_SB(1, 0), cB + kstep, voffB); PG8_STAGE(PG8_SA(1, 0), cA + kstep, voffA); PG8_STAGE(PG8_SB(1, 1), cB + hstep + kstep, voffB);
        PG8_WAIT_V(6); PG8_BAR;
    }
    for (;;) {
        const bool has_next = S.next(ui + 1, nxt);
        const char* nA = has_next ? S.a_base(nxt) : cA; const char* nB = has_next ? S.b_base(nxt) : cB;
        for (int t = 0; t < nt; t += 2) {
            const bool last = (t == nt - 2);
            const char* a1 = cA + (size_t)(t + 1) * kstep;
            const char* a2 = last ? nA : cA + (size_t)(t + 2) * kstep; const char* b2 = last ? nB : cB + (size_t)(t + 2) * kstep;
            const char* a3 = a2 + kstep; const char* b3 = b2 + kstep;
            if (last && has_next) S.a_ready(nxt);
            if constexpr (SP2) {
            PG8_LDB(B0, 0, 0); PG8_LDB(B1, 0, 1); PG8_SCHED; PG8_LDA(At, 0, 0); PG8_STAGE(PG8_SA(1, 1), a1 + hstep, voffA);
            PG8_WAIT_V(8); PG8_WAIT_L(0); PG8_BAR; PG8_MMA(0, 0, At, B0); PG8_MMA(0, 1, At, B1); PG8_BAR; PG8_SCHED;
            PG8_LDA(At, 0, 1); PG8_STAGE(PG8_SB(0, 0), b2, voffB); PG8_STAGE(PG8_SB(0, 1), b2 + hstep, voffB); PG8_STAGE(PG8_SA(0, 0), a2, voffA);
            PG8_WAIT_V(8); PG8_WAIT_L(0); PG8_BAR; PG8_MMA(1, 0, At, B0); PG8_MMA(1, 1, At, B1); PG8_BAR; PG8_SCHED;
            PG8_LDB(B0, 1, 0); PG8_LDB(B1, 1, 1); PG8_SCHED; PG8_LDA(At, 1, 0); PG8_STAGE(PG8_SA(0, 1), a2 + hstep, voffA);
            PG8_WAIT_V(8); PG8_WAIT_L(0); PG8_BAR; PG8_MMA(0, 0, At, B0); PG8_MMA(0, 1, At, B1); PG8_BAR; PG8_SCHED;
            PG8_LDA(At, 1, 1); PG8_STAGE(PG8_SB(1, 0), b3, voffB); PG8_STAGE(PG8_SB(1, 1), b3 + hstep, voffB); PG8_STAGE(PG8_SA(1, 0), a3, voffA);
            PG8_WAIT_V(8); PG8_WAIT_L(0); PG8_BAR; PG8_MMA(1, 0, At, B0); PG8_MMA(1, 1, At, B1); PG8_BAR; PG8_SCHED;
            } else {
            PG8_LDB(B0, 0, 0); PG8_SCHED; PG8_LDA(At, 0, 0); PG8_STAGE(PG8_SA(1, 1), a1 + hstep, voffA);
            PG8_WAIT_L(8); PG8_BAR; PG8_WAIT_L(0); PG8_MMA(0, 0, At, B0); PG8_BAR; PG8_SCHED;
            PG8_LDB(B1, 0, 1); PG8_STAGE(PG8_SB(0, 0), b2, voffB);
            PG8_BAR; PG8_WAIT_L(0); PG8_MMA(0, 1, At, B1); PG8_BAR;
            PG8_LDA(At, 0, 1); PG8_STAGE(PG8_SA(0, 0), a2, voffA);
            PG8_BAR; PG8_WAIT_L(0); PG8_MMA(1, 0, At, B0); PG8_BAR; PG8_SCHED;
            PG8_STAGE(PG8_SB(0, 1), b2 + hstep, voffB);
            PG8_WAIT_V(6); PG8_BAR; PG8_MMA(1, 1, At, B1); PG8_BAR;
            PG8_LDB(B0, 1, 0); PG8_SCHED; PG8_LDA(At, 1, 0); PG8_STAGE(PG8_SA(0, 1), a2 + hstep, voffA);
            PG8_WAIT_L(8); PG8_BAR; PG8_WAIT_L(0); PG8_MMA(0, 0, At, B0); PG8_BAR; PG8_SCHED;
            PG8_LDB(B1, 1, 1); PG8_STAGE(PG8_SB(1, 0), b3, voffB);
            PG8_BAR; PG8_WAIT_L(0); PG8_MMA(0, 1, At, B1); PG8_BAR;
            PG8_LDA(At, 1, 1); PG8_STAGE(PG8_SA(1, 0), a3, voffA);
            PG8_BAR; PG8_WAIT_L(0); PG8_MMA(1, 0, At, B0); PG8_BAR; PG8_SCHED;
            PG8_STAGE(PG8_SB(1, 1), b3 + hstep, voffB);
            PG8_WAIT_V(6); PG8_BAR; PG8_MMA(1, 1, At, B1); PG8_BAR;
            }
        }
        if constexpr (ALIGN_EPI) { if (wr == 0) PG8_BAR; }
        if constexpr (!Epi::AFTER_DRAIN) { E(acc, cur, wr, wc, fr, fq); S.done(cur); }
        if (!has_next) break;
#pragma unroll
        for (int a = 0; a < 2; ++a)
#pragma unroll
            for (int b = 0; b < 2; ++b)
#pragma unroll
                for (int m = 0; m < 4; ++m)
#pragma unroll
                    for (int n = 0; n < 2; ++n) acc[a][b][m][n] = (f32x4){0.f, 0.f, 0.f, 0.f};
        cur = nxt; cA = nA; cB = nB; ++ui;
        if constexpr (ALIGN_EPI) { if (wr == 1) PG8_BAR; }
    }
    PG8_WAIT_V(0);
    if constexpr (!ALIGN_EPI) { if (wr == 0) PG8_BAR; }
    PG8_BAR;
    if constexpr (Epi::AFTER_DRAIN) { E.fused(acc, cur, wr, wc, fr, fq, lds, wid, lane); S.done(cur); }
#undef PG8_SA
#undef PG8_SB
#undef PG8_STAGE
#undef PG8_LDA
#undef PG8_LDB
#undef PG8_MMA
#undef PG8_WAIT_V
#undef PG8_WAIT_L
#undef PG8_BAR
#undef PG8_SCHED
}
}
#include <hip/hip_bf16.h>
#include <cmath>
namespace attn_body {
using bf16=__hip_bfloat16;
using bf16x8=__attribute__((ext_vector_type(8)))short;
using s16x4=__attribute__((ext_vector_type(4)))short;
using f32x16=__attribute__((ext_vector_type(16)))float;
using u32x4=__attribute__((ext_vector_type(4)))unsigned;
constexpr int BATCH=2,NHEAD=8,SEQ=8192,D=64,DM=3584,OPITCH=1024;
constexpr int NW=8,QBLK=32,QB=QBLK*NW,KVBLK=64,NQB=SEQ/QB;
constexpr int ATTN_PITCH=DM, ATTN_UNIT_ROWS=QB;
__device__ __forceinline__ int crow(int r,int hi){return (r&3)+8*(r>>2)+4*hi;}
#define SBAR() __builtin_amdgcn_sched_barrier(0)
__device__ __forceinline__ void cmask(f32x16&p0,f32x16&p1,int jb,int qrel,int hi){
  const float NEG=-INFINITY; int kb=64*jb+4*hi;
  #pragma unroll
  for(int r=0;r<16;++r){int kv=kb+(r&3)+8*(r>>2); if(kv>qrel)p0[r]=NEG; if(kv+32>qrel)p1[r]=NEG;}
}

constexpr int NSLOT=3, SLOTB=8192;
constexpr int LDS_K=0, LDS_V=NSLOT*SLOTB, LDS_WS=2*NSLOT*SLOTB, LDS_OST=LDS_WS+NW*64*4, LDS_CK=LDS_OST+NW*4096, LDS_BYTES=LDS_CK+SEQ*4;
constexpr float C2=0.125f*1.4426950408889634f;
__device__ __forceinline__ void glds16(const void*gsrc,unsigned lds_dst){unsigned keep;
  asm volatile("s_mov_b32 %0, m0\n\ts_mov_b32 m0, %2\n\ts_nop 0\n\tglobal_load_lds_dwordx4 %1, off\n\ts_mov_b32 m0, %0":"=&s"(keep):"v"(gsrc),"s"(lds_dst):"memory");}
__device__ __forceinline__ float max3f(float a,float b,float c){float r;asm("v_max3_f32 %0, %1, %2, %3":"=v"(r):"v"(a),"v"(b),"v"(c));return r;}
__device__ __forceinline__ float max2f(float a,float b){float r;asm("v_max_f32_e32 %0, %1, %2":"=v"(r):"v"(a),"v"(b));return r;}
__device__ __forceinline__ float fadd_s(float a,float b){float r;asm("v_add_f32_e32 %0, %1, %2":"=v"(r):"v"(a),"v"(b));return r;}
__device__ __forceinline__ float fsub_s(float a,float b){float r;asm("v_sub_f32_e32 %0, %1, %2":"=v"(r):"v"(a),"v"(b));return r;}
typedef float f32x2_t __attribute__((ext_vector_type(2))); typedef float f32x4_t __attribute__((ext_vector_type(4))); typedef __bf16 bf16x2_t __attribute__((ext_vector_type(2)));
__device__ __forceinline__ unsigned cvtpk_s(float lo,float hi){f32x2_t v={lo,hi};bf16x2_t b=__builtin_convertvector(v,bf16x2_t);return __builtin_bit_cast(unsigned,b);}
#define WAIT_BAR(N) asm volatile("s_waitcnt vmcnt(" #N ") lgkmcnt(0)\n\ts_barrier":::"memory")

__device__ __forceinline__ void qkt(f32x16&p0,f32x16&p1,const char*Kslot,const bf16x8*qr,const f32x16&negm,int r32,int hi){
  const char*kb=Kslot+hi*1024+r32*16;
  #pragma unroll
  for(int d0=0;d0<4;++d0){
    const bf16x8 b0=*reinterpret_cast<const bf16x8*>(kb+d0*2048);
    const bf16x8 b1=*reinterpret_cast<const bf16x8*>(kb+d0*2048+512);
    if(d0==0){p0=__builtin_amdgcn_mfma_f32_32x32x16_bf16(b0,qr[0],negm,0,0,0);p1=__builtin_amdgcn_mfma_f32_32x32x16_bf16(b1,qr[0],negm,0,0,0);}
    else{p0=__builtin_amdgcn_mfma_f32_32x32x16_bf16(b0,qr[d0],p0,0,0,0);p1=__builtin_amdgcn_mfma_f32_32x32x16_bf16(b1,qr[d0],p1,0,0,0);}}
}
typedef __attribute__((address_space(3))) const char* lds_cptr;
typedef short v4i16_t __attribute__((ext_vector_type(4)));
__device__ __forceinline__ void kload8(bf16x8*kf,lds_cptr kp){
  kf[0]=*(const __attribute__((address_space(3))) bf16x8*)(kp);      kf[1]=*(const __attribute__((address_space(3))) bf16x8*)(kp+512);
  kf[2]=*(const __attribute__((address_space(3))) bf16x8*)(kp+2048); kf[3]=*(const __attribute__((address_space(3))) bf16x8*)(kp+2560);
  kf[4]=*(const __attribute__((address_space(3))) bf16x8*)(kp+4096); kf[5]=*(const __attribute__((address_space(3))) bf16x8*)(kp+4608);
  kf[6]=*(const __attribute__((address_space(3))) bf16x8*)(kp+6144); kf[7]=*(const __attribute__((address_space(3))) bf16x8*)(kp+6656);
}
__device__ __forceinline__ void kload2(bf16x8*kf,lds_cptr kp,int j){ kf[2*j]=*(const __attribute__((address_space(3))) bf16x8*)(kp+j*2048); kf[2*j+1]=*(const __attribute__((address_space(3))) bf16x8*)(kp+j*2048+512); }
__device__ __forceinline__ s16x4 vtr(lds_cptr p){ return __builtin_bit_cast(s16x4,__builtin_amdgcn_ds_read_tr16_b64_v4i16((__attribute__((address_space(3))) v4i16_t*)p)); }
__device__ __forceinline__ float rowmax(const f32x16&p0,const f32x16&p1){
  float a=max3f(p0[0],p0[1],p1[0]),b=max3f(p0[2],p0[3],p1[1]);a=max3f(a,p1[2],p1[3]);
  #pragma unroll
  for(int r=4;r<16;r+=4){a=max3f(a,p0[r],p0[r+1]);b=max3f(b,p0[r+2],p0[r+3]);a=max3f(a,p1[r],p1[r+1]);b=max3f(b,p1[r+2],p1[r+3]);}
  const float m=max2f(a,b);
  auto rr=__builtin_amdgcn_permlane32_swap(__float_as_uint(m),__float_as_uint(m),false,false);
  return max2f(__uint_as_float(rr[0]),__uint_as_float(rr[1]));
}
__device__ __forceinline__ void pv(f32x16*o,int vb,bf16x8 pa0,bf16x8 pa1,bf16x8 pa2,bf16x8 pa3){
  #pragma unroll
  for(int d0=0;d0<2;++d0){s16x4 lo[4],hi[4];
    #pragma unroll
    for(int ks=0;ks<4;++ks){
      asm volatile("ds_read_b64_tr_b16 %0,%1 offset:%c2":"=&v"(lo[ks]):"v"(vb),"i"(d0*4096+ks*1024):"memory");
      asm volatile("ds_read_b64_tr_b16 %0,%1 offset:%c2":"=&v"(hi[ks]):"v"(vb),"i"(d0*4096+ks*1024+512):"memory");}
    asm volatile("s_waitcnt lgkmcnt(0)":::"memory");SBAR();
    #define PK(k) (bf16x8){lo[k][0],lo[k][1],lo[k][2],lo[k][3],hi[k][0],hi[k][1],hi[k][2],hi[k][3]}
    o[d0]=__builtin_amdgcn_mfma_f32_32x32x16_bf16(pa0,PK(0),o[d0],0,0,0);
    o[d0]=__builtin_amdgcn_mfma_f32_32x32x16_bf16(pa1,PK(1),o[d0],0,0,0);
    o[d0]=__builtin_amdgcn_mfma_f32_32x32x16_bf16(pa2,PK(2),o[d0],0,0,0);
    o[d0]=__builtin_amdgcn_mfma_f32_32x32x16_bf16(pa3,PK(3),o[d0],0,0,0);
    #undef PK
  }
}

#ifndef ATTN_STORE16
#define ATTN_STORE16(p,v) (*(u32x4*)(p)=(v))
#endif
template<int THRL> __device__ __forceinline__ void attn_unit(int b,int h,int qb,const bf16*Q,const bf16*__restrict__ K,const bf16*__restrict__ V,bf16*O,const float*__restrict__ cf,char*shm){
  const int tid=threadIdx.x,lane=tid&63,r32=lane&31,hi=lane>>5; const int wid=__builtin_amdgcn_readfirstlane(tid>>6);
  const long rowbase=(long)b*SEQ; const int q0=qb*QB;
  const bf16*Qw=Q+(rowbase+q0+wid*QBLK)*DM+h*D;
  const bf16*Kh=K+rowbase*DM+h*D,*Vh=V+rowbase*DM+h*D;
  const unsigned lds0=(unsigned)(uintptr_t)shm;
  float*wsf=(float*)(shm+LDS_WS)+wid*64;
  const bf16*ksrc=Kh+(long)lane*DM+wid*8;
  const bf16*vsrc=Vh+(long)(16*(wid&3)+(lane>>2))*DM+(wid>>2)*32+(lane&3)*8;
  const unsigned kdst=lds0+LDS_K+wid*1024, vdst=lds0+LDS_V+wid*1024;
  #define DMA_K(t,slot) glds16(ksrc+(long)(t)*KVBLK*DM,(unsigned)__builtin_amdgcn_readfirstlane(kdst+(slot)))
  #define DMA_V(t,slot) glds16(vsrc+(long)(t)*KVBLK*DM,(unsigned)__builtin_amdgcn_readfirstlane(vdst+(slot)))
  const int vb0=(int)(lds0+LDS_V)+((lane>>4)&1)*32+(lane&3)*8+(4*hi+((lane&15)>>2))*64;
  const char*Kbase=shm+LDS_K; bf16x8 kf[8];
  const lds_cptr shm3=(lds_cptr)shm; const lds_cptr kp0=shm3+LDS_K+hi*1024+r32*16; const lds_cptr vp0=shm3+LDS_V+((lane>>4)&1)*32+(lane&3)*8+(4*hi+((lane&15)>>2))*64;
  const int NT=(q0+QB)/KVBLK;
  typedef __attribute__((address_space(3))) float lds_f32; typedef __attribute__((address_space(3))) const f32x4_t* lds_cf4;
  { lds_f32* ckw=(lds_f32*)((lds_cptr)shm+LDS_CK); int i0_=tid; asm volatile("":"+v"(i0_)); _Pragma("nounroll") for(int i=i0_;i<q0+QB;i+=NW*64)ckw[i]=cf[i]; }
  const float cq=cf[q0+wid*QBLK+(lane&31)];
  const lds_cptr ckl=(lds_cptr)shm+LDS_CK+16*(lane>>5);
  #define CBIAS(P0,P1,t) do{ const lds_cptr cb_=ckl+256*(t); _Pragma("unroll") for(int g_=0;g_<4;++g_){ const f32x4_t a_=*(lds_cf4)(cb_+32*g_), b_=*(lds_cf4)(cb_+128+32*g_); \
      _Pragma("unroll") for(int i_=0;i_<4;++i_){ P0[4*g_+i_]-=(a_[i_]+mm); P1[4*g_+i_]-=(b_[i_]+mm); } } }while(0)
  DMA_K(0,0);DMA_V(0,0);DMA_K(1,SLOTB);
  bf16x8 qr[4];
  #pragma unroll
  for(int d0=0;d0<4;++d0)qr[d0]=*reinterpret_cast<const bf16x8*>(&Qw[(long)r32*DM+d0*16+hi*8]);
  float mhat=0.f,l_reg=0.f;f32x16 o[2];o[0]=f32x16{};o[1]=f32x16{};float mm=-cq; const f32x16 negm=f32x16{};
  const int qrel=wid*QBLK+r32;
  #define CMASK(P0,P1,t) do{int jb_=(t)-(NT-4); if(jb_>=0)cmask(P0,P1,jb_,qrel,hi);}while(0)
  bool resc=false;
  #define START(P0,P1) do{ const float rm=rowmax(P0,P1); resc=false; \
    { const float dl=rm; mhat=fadd_s(mhat,dl); \
      _Pragma("unroll") for(int r=0;r<16;++r){P0[r]=fsub_s(P0[r],dl);P1[r]=fsub_s(P1[r],dl);} \
      mm+=dl; } \
    _Pragma("unroll") for(int r=0;r<16;++r)P0[r]=__builtin_amdgcn_exp2f(P0[r]); }while(0)
  #define RESC() do{ if(resc){ asm volatile("s_waitcnt lgkmcnt(0)":::"memory"); \
      _Pragma("unroll") for(int d_=0;d_<2;++d_) _Pragma("unroll") for(int r=0;r<16;++r)o[d_][r]*=wsf[crow(r,hi)]; } }while(0)
  f32x16 pA0,pA1,pB0,pB1;
  int sl_prev=0,sl_cur=0,sl_next=SLOTB;
  #define ROT() do{sl_prev=sl_cur;sl_cur=sl_next;sl_next=(sl_next==(NSLOT-1)*SLOTB)?0:sl_next+SLOTB;}while(0)
  DMA_K(2,2*SLOTB);
  WAIT_BAR(3);
  qkt(pA0,pA1,Kbase,qr,negm,r32,hi);asm volatile("s_nop 15\n\ts_nop 7":"+v"(pA0),"+v"(pA1));CBIAS(pA0,pA1,0);CMASK(pA0,pA1,0);
  START(pA0,pA1);
  _Pragma("unroll") for(int r=0;r<16;++r)pA1[r]=__builtin_amdgcn_exp2f(pA1[r]);
  WAIT_BAR(0);
  DMA_K(3,0);DMA_V(1,SLOTB);
  ROT();
  kload8(kf,kp0+sl_cur);
  WAIT_BAR(2);
  s16x4 vlo[8],vhi[8]; u32x4 pw0,pw1,pw2,pw3;
  #define PKW(P,B) cvtpk_s(P[B],P[B+1])
  #define PAF(k) __builtin_bit_cast(bf16x8,pw##k)
  #define VFR(i) (bf16x8){vlo[i][0],vlo[i][1],vlo[i][2],vlo[i][3],vhi[i][0],vhi[i][1],vhi[i][2],vhi[i][3]}
  #define PIN(x) asm volatile("":"+v"(x))
  #define MX3(a,b,c) __builtin_fmaxf(__builtin_fmaxf((a),(b)),(c))
  #define GAPA(MF,A0,A1,A2,A3,W0,W1,PW) do{ MF; sacc+=A0; sacc+=A1; sacc+=A2; sacc+=A3; PIN(sacc); W0; W1; PIN(PW); SBAR(); }while(0)
  #define EX(v) __builtin_amdgcn_exp2f(v)
  #define GAPB(MF,X,B) do{ MF; X[B]=EX(X[B]); X[B+1]=EX(X[B+1]); X[B+2]=EX(X[B+2]); X[B+3]=EX(X[B+3]); PIN(X); SBAR(); }while(0)
  #define VRD(i) do{ vlo[i]=vtr(vp_+(((i)>>2)*4096+((i)&3)*1024)); vhi[i]=vtr(vp_+(((i)>>2)*4096+((i)&3)*1024+512)); }while(0)
  #define KRD(G,j) do{ if(G){ kload2(kf,kp0+sl_next,j); SBAR(); } }while(0)
  #define STEP(C0,C1,P0,P1,t,GK,GV,GL) do{ SBAR(); \
    const lds_cptr vp_=vp0+sl_prev; \
    VRD(0); SBAR(); float sacc=(P0[0]+P0[1]); \
    GAPA(C0=__builtin_amdgcn_mfma_f32_32x32x16_bf16(kf[0],qr[0],negm,0,0,0), P0[2],P0[3],P0[4],P0[5],     pw0[0]=PKW(P0,0), pw0[1]=PKW(P0,2), pw0); \
    VRD(4); SBAR(); GAPA(C1=__builtin_amdgcn_mfma_f32_32x32x16_bf16(kf[1],qr[0],negm,0,0,0), P0[6],P0[7],P0[8],P0[9],     pw0[2]=PKW(P0,4), pw0[3]=PKW(P0,6), pw0); \
    VRD(1); SBAR(); GAPA(C0=__builtin_amdgcn_mfma_f32_32x32x16_bf16(kf[2],qr[1],C0,0,0,0),   P0[10],P0[11],P0[12],P0[13], pw1[0]=PKW(P0,8), pw1[1]=PKW(P0,10), pw1); \
    VRD(5); SBAR(); GAPA(C1=__builtin_amdgcn_mfma_f32_32x32x16_bf16(kf[3],qr[1],C1,0,0,0),   P0[14],P0[15],P1[0],P1[1],   pw1[2]=PKW(P0,12),pw1[3]=PKW(P0,14), pw1); \
    VRD(2); SBAR(); GAPA(C0=__builtin_amdgcn_mfma_f32_32x32x16_bf16(kf[4],qr[2],C0,0,0,0),   P1[2],P1[3],P1[4],P1[5],     pw2[0]=PKW(P1,0), pw2[1]=PKW(P1,2), pw2); \
    VRD(6); SBAR(); GAPA(C1=__builtin_amdgcn_mfma_f32_32x32x16_bf16(kf[5],qr[2],C1,0,0,0),   P1[6],P1[7],P1[8],P1[9],     pw2[2]=PKW(P1,4), pw2[3]=PKW(P1,6), pw2); \
    VRD(3); SBAR(); GAPA(C0=__builtin_amdgcn_mfma_f32_32x32x16_bf16(kf[6],qr[3],C0,0,0,0),   P1[10],P1[11],P1[12],P1[13], pw3[0]=PKW(P1,8), pw3[1]=PKW(P1,10), pw3); \
    VRD(7); SBAR(); GAPA(C1=__builtin_amdgcn_mfma_f32_32x32x16_bf16(kf[7],qr[3],C1,0,0,0),   P1[14],P1[15],0.f,0.f,       pw3[2]=PKW(P1,12),pw3[3]=PKW(P1,14), pw3); \
    l_reg+=sacc; \
    if(GK){DMA_K((t)+3,sl_cur);} if(GV){DMA_V((t)+1,sl_next);} \
    CBIAS(C0,C1,t); CMASK(C0,C1,t); \
    { float a=MX3(C0[0],C0[1],C1[0]),b=MX3(C0[2],C0[3],C1[1]); a=MX3(a,C1[2],C1[3]); \
      _Pragma("unroll") for(int r=4;r<16;r+=4){a=MX3(a,C0[r],C0[r+1]);b=MX3(b,C0[r+2],C0[r+3]);a=MX3(a,C1[r],C1[r+1]);b=MX3(b,C1[r+2],C1[r+3]);} \
      float rm=__builtin_fmaxf(a,b); { auto rr=__builtin_amdgcn_permlane32_swap(__float_as_uint(rm),__float_as_uint(rm),false,false); rm=__builtin_fmaxf(__uint_as_float(rr[0]),__uint_as_float(rr[1])); } \
      resc=false; \
      if(__builtin_expect(__any(rm>(float)THRL),0)){ const float dl=__builtin_fmaxf(rm,0.f); mhat+=dl; \
        _Pragma("unroll") for(int r=0;r<16;++r){C0[r]-=dl;C1[r]-=dl;} \
        mm+=dl; \
        const float f=__builtin_amdgcn_exp2f(-dl); l_reg*=f; if(hi==0)wsf[r32]=f; resc=true; } } \
    SBAR(); \
    GAPB(o[0]=__builtin_amdgcn_mfma_f32_32x32x16_bf16(PAF(0),VFR(0),o[0],0,0,0), C0,0); \
    GAPB(o[1]=__builtin_amdgcn_mfma_f32_32x32x16_bf16(PAF(0),VFR(4),o[1],0,0,0), C0,4); \
    KRD(GL,0); GAPB(o[0]=__builtin_amdgcn_mfma_f32_32x32x16_bf16(PAF(1),VFR(1),o[0],0,0,0), C0,8); \
    KRD(GL,1); GAPB(o[1]=__builtin_amdgcn_mfma_f32_32x32x16_bf16(PAF(1),VFR(5),o[1],0,0,0), C0,12); \
    KRD(GL,2); GAPB(o[0]=__builtin_amdgcn_mfma_f32_32x32x16_bf16(PAF(2),VFR(2),o[0],0,0,0), C1,0); \
    KRD(GL,3); GAPB(o[1]=__builtin_amdgcn_mfma_f32_32x32x16_bf16(PAF(2),VFR(6),o[1],0,0,0), C1,4); \
    GAPB(o[0]=__builtin_amdgcn_mfma_f32_32x32x16_bf16(PAF(3),VFR(3),o[0],0,0,0), C1,8); \
    GAPB(o[1]=__builtin_amdgcn_mfma_f32_32x32x16_bf16(PAF(3),VFR(7),o[1],0,0,0), C1,12); \
    }while(0)
  int t=1;
  #undef CMASK
  #define CMASK(P0,P1,t) do{}while(0)
  for(;t+5<NT;t+=2){
    STEP(pB0,pB1,pA0,pA1,t,true,true,true);     WAIT_BAR(2); RESC(); ROT();
    STEP(pA0,pA1,pB0,pB1,t+1,true,true,true);   WAIT_BAR(2); RESC(); ROT();
  }
  #undef CMASK
  #define CMASK(P0,P1,t) do{int jb_=(t)-(NT-4); if(jb_>=0)cmask(P0,P1,jb_,qrel,hi);}while(0)
  #define ENDW(tt) do{ if((tt)+3<NT){WAIT_BAR(2);} else if((tt)+2<NT){WAIT_BAR(1);} else {WAIT_BAR(0);} }while(0)
  for(;t+1<NT;t+=2){
    STEP(pB0,pB1,pA0,pA1,t,(t+3<NT),(t+1<NT),(t+1<NT));       ENDW(t);   RESC(); ROT();
    STEP(pA0,pA1,pB0,pB1,t+1,(t+4<NT),(t+2<NT),(t+2<NT));     ENDW(t+1); RESC(); ROT();
  }
  STEP(pB0,pB1,pA0,pA1,NT-1,false,false,false); RESC();
  { float sacc=pB0[0]+pB0[1]; _Pragma("unroll") for(int r=2;r<16;++r)sacc+=pB0[r]; _Pragma("unroll") for(int r=0;r<16;++r)sacc+=pB1[r]; l_reg+=sacc;
    pw0=(u32x4){PKW(pB0,0),PKW(pB0,2),PKW(pB0,4),PKW(pB0,6)};pw1=(u32x4){PKW(pB0,8),PKW(pB0,10),PKW(pB0,12),PKW(pB0,14)};pw2=(u32x4){PKW(pB1,0),PKW(pB1,2),PKW(pB1,4),PKW(pB1,6)};pw3=(u32x4){PKW(pB1,8),PKW(pB1,10),PKW(pB1,12),PKW(pB1,14)};
    SBAR(); pv(o,vb0+sl_cur,PAF(0),PAF(1),PAF(2),PAF(3)); }
  #undef PKW
  #undef PAF
  #undef VFR
  #undef PIN
  #undef MX3
  #undef GAPA
  #undef GAPB
  #undef EX
  #undef VRD
  #undef KRD
  #undef STEP
  #undef ENDW
  {auto rr=__builtin_amdgcn_permlane32_swap(__float_as_uint(l_reg),__float_as_uint(l_reg),false,false);l_reg=__uint_as_float(rr[0])+__uint_as_float(rr[1]);}
  if(hi==0)wsf[32+r32]=l_reg;asm volatile("s_waitcnt lgkmcnt(0)":::"memory");
  float rli[16];
  #pragma unroll
  for(int r=0;r<16;++r)rli[r]=__builtin_amdgcn_rcpf(wsf[32+crow(r,hi)]);
  bf16*Ow=O+(rowbase+q0+wid*QBLK)*OPITCH+h*D;
  { bf16*stg=(bf16*)(shm+LDS_OST)+wid*2048;
    #pragma unroll
    for(int r=0;r<16;++r){const int orow=crow(r,hi);
      #pragma unroll
      for(int d0=0;d0<2;++d0)stg[orow*64+d0*32+r32]=__float2bfloat16(o[d0][r]*rli[r]);}
    asm volatile("s_waitcnt lgkmcnt(0)":::"memory");
    #pragma unroll
    for(int i=0;i<4;++i){const int row=i*8+(lane>>3),ch=lane&7; const u32x4 v=*(const u32x4*)(stg+row*64+ch*8); ATTN_STORE16(Ow+(long)row*OPITCH+ch*8,v);} }
  asm volatile("s_waitcnt lgkmcnt(0)\n\ts_barrier":::"memory");
  #undef CBIAS
  #undef DMA_K
  #undef DMA_V
  #undef CMASK
  #undef START
  #undef RESC
  #undef ROT
}
constexpr int ATTN_LDS_BYTES=LDS_BYTES;
struct AttnTensors { const bf16* Q; const bf16* K; const bf16* V; bf16* O; const float* CF; };
struct AttnUnit { int bh; int qb; };
struct StaticOrder {
  int vcu;
  __device__ __forceinline__ explicit StaticOrder(int grid,int block):vcu((grid%8==0)?(block%8)*(grid/8)+block/8:block),G_(grid){}
  int G_;
  __device__ __forceinline__ bool next(int i,AttnUnit&u)const{ const int v=vcu+(i>>1)*G_; if(v>=256)return false; const int s=v&15; u.bh=v>>4; u.qb=(i&1)?31-s:s; return true; }
  __device__ __forceinline__ void a_ready(const AttnUnit&)const{}
  __device__ __forceinline__ void done(const AttnUnit&)const{}
};
template<class Sched,int THRL=8> __device__ __forceinline__ void attn_phase(char*lds,const AttnTensors&T,const Sched&S){
  AttnUnit u;
  for(int i=0;S.next(i,u);++i){ S.a_ready(u); attn_unit<THRL>(u.bh/NHEAD,u.bh%NHEAD,u.qb,T.Q,T.K,T.V,T.O,T.CF+(long)u.bh*SEQ,lds); S.done(u); }
}
#undef SBAR
#undef WAIT_BAR
}
#define GAS __attribute__((address_space(1)))
#define LAS __attribute__((address_space(3)))
typedef unsigned v4u __attribute__((ext_vector_type(4)));
typedef float f32x4 __attribute__((ext_vector_type(4)));
typedef short bf16x8 __attribute__((ext_vector_type(8)));
typedef GAS unsigned gu32;
typedef GAS unsigned long long gu64;
#define RLX_AGENT __ATOMIC_RELAXED, __HIP_MEMORY_SCOPE_AGENT
#define LDS_WAIT() asm volatile("s_waitcnt lgkmcnt(0)" ::: "memory")
#define VM_WAIT() asm volatile("s_waitcnt vmcnt(0)" ::: "memory")
__device__ __forceinline__ unsigned long long rt() { return __builtin_amdgcn_s_memrealtime(); }
__device__ __forceinline__ unsigned pk2(float lo, float hi) { return (unsigned)f2bf(lo) | ((unsigned)f2bf(hi) << 16); }

#define XB_TMO      128
#define XB_XCNT(j)  (256  + 64 * (j))
#define XB_XSUB(j)  (1280 + 64 * (j))
#define XB_XGEN(j)  (2304 + 64 * (j))
#define XB_TOP      3328
#define XB_TOPGEN   3392
#define XCD_BAR_WORDS 3456
#define XB_SPIN_CAP (1u << 18)

__device__ __forceinline__ unsigned xb_ld(unsigned* p)              { return __hip_atomic_load(p, __ATOMIC_RELAXED, __HIP_MEMORY_SCOPE_AGENT); }
__device__ __forceinline__ unsigned xb_add(unsigned* p, unsigned v) { return __hip_atomic_fetch_add(p, v, __ATOMIC_RELAXED, __HIP_MEMORY_SCOPE_AGENT); }
__device__ __forceinline__ unsigned xb_xcc_id() { return (unsigned)__builtin_amdgcn_s_getreg((3 << 11) | 20) & 0xFu; }
#define XB_SPIN(cond, bar) do { unsigned _sp = 0; while (cond) { __builtin_amdgcn_s_sleep(1); \
    if ((++_sp & 255u) == 0u) { if (xb_ld(&(bar)[XB_TMO])) break; if (_sp > XB_SPIN_CAP) { atomicAdd(&(bar)[XB_TMO], 1u); break; } } } } while (0)

struct XcdBarrier {
    unsigned* bar; unsigned x;
    volatile LAS unsigned* st;
};

__device__ __forceinline__ XcdBarrier xcd_barrier_post(unsigned* bar, volatile LAS unsigned* st) {
    XcdBarrier b; b.bar = bar; b.x = xb_xcc_id(); b.st = st;
    if (threadIdx.x == 0) (void)xb_add(&bar[XB_XCNT(b.x)], 1u);
    return b;
}
__device__ __forceinline__ void xcd_barrier_complete(unsigned* bar, unsigned x, unsigned& nloc, unsigned& nx) {
    const unsigned G = gridDim.x * gridDim.y * gridDim.z;
    unsigned sum, cnt, mine, sp = 0u;
    for (;;) {
        sum = 0u; cnt = 0u; mine = 0u;
#pragma unroll
        for (unsigned j = 0; j < 16; ++j) { const unsigned c = xb_ld(&bar[XB_XCNT(j)]); sum += c; cnt += (c > 0u) ? 1u : 0u; mine = (j == x) ? c : mine; }
        if (sum == G) break;
        __builtin_amdgcn_s_sleep(1);
        if ((++sp & 255u) == 0u) { if (xb_ld(&bar[XB_TMO])) break; if (sp > XB_SPIN_CAP) { atomicAdd(&bar[XB_TMO], 1u); break; } }
    }
    nloc = mine > 0u ? mine : 1u; nx = cnt > 0u ? cnt : 1u;
}

__device__ __forceinline__ void xcd_barrier(const XcdBarrier& b) {
    asm volatile("s_waitcnt vmcnt(0)" ::: "memory");
    __syncthreads();
    if (threadIdx.x == 0) {
        unsigned* bar = b.bar;
        __builtin_amdgcn_s_waitcnt(0);
        unsigned nloc = b.st[0], nx = b.st[1];
        if (nloc == 0u) { xcd_barrier_complete(bar, b.x, nloc, nx); b.st[0] = nloc; b.st[1] = nx; }
        const unsigned old = xb_add(&bar[XB_XSUB(b.x)], 1u);
        const unsigned gen = old / nloc;
        if (old + 1u == (gen + 1u) * nloc) {
            __builtin_amdgcn_fence(__ATOMIC_RELEASE, "agent");
            asm volatile("s_waitcnt vmcnt(0)" ::: "memory");
            const unsigned og = xb_add(&bar[XB_TOP], 1u);
            const unsigned tg = og / nx;
            if (og + 1u == (tg + 1u) * nx) xb_add(&bar[XB_TOPGEN], 1u);
            else XB_SPIN(xb_ld(&bar[XB_TOPGEN]) == tg, bar);
            __builtin_amdgcn_fence(__ATOMIC_ACQUIRE, "agent");
            xb_add(&bar[XB_XGEN(b.x)], 1u);
            asm volatile("s_waitcnt vmcnt(0)" ::: "memory");
        } else {
            XB_SPIN(xb_ld(&bar[XB_XGEN(b.x)]) == gen, bar);
            __builtin_amdgcn_fence(__ATOMIC_ACQUIRE, "agent");
            asm volatile("s_waitcnt vmcnt(0)" ::: "memory");
        }
    }
    __syncthreads();
}
constexpr int NWAVES = 8, NTHR = 512;
constexpr int RING_OFF = 0, RING_BYTES = 131072, LDSCTL_OFF = RING_BYTES, MISC_OFF = LDSCTL_OFF + 320, LDS_BYTES = 147456;
constexpr int CW_BAR = 4096;
constexpr size_t WS_WIN = WS_W, WS_WOUT = WS_W + 14 * MiB, WS_WDGU = WS_W + 18 * MiB, WS_WDDN = WS_W + 29 * MiB;
constexpr size_t WS_WMGU = WS_W, WS_WMDN = WS_XG;
struct MArgs { const float* in[20]; float* out; unsigned char* ws; int ph_lo, ph_hi; };
enum { I_X = 0, I_ATTN_NORM, I_W_IN, I_HGRN_LB, I_HGRN_NORM, I_MLSTM_CONV, I_MLSTM_BI, I_MLSTM_BF, I_MLSTM_NORM, I_FOX_BF, I_W_OUT, I_FFN_NORM, I_DGATE, I_DUP, I_DDOWN, I_ROUTER, I_MGATE, I_MUP, I_MDOWN, I_FINAL_NORM };

__device__ __forceinline__ void tr_item(const float* W, int ldw, int K, bf16_t* WT, LAS float* scr, int k0, int lane) {
#pragma unroll 8
    for (int i = 0; i < 32; ++i) { const int kk = 2 * i + (lane >> 5); scr[kk * 33 + (lane & 31)] = W[(size_t)(k0 + kk) * ldw + (lane & 31)]; }
    LDS_WAIT(); asm volatile("" ::: "memory");
    const int c = lane & 7;
#pragma unroll
    for (int j = 0; j < 4; ++j) { const int n = (lane >> 3) + 8 * j; const LAS float* s = scr + (8 * c) * 33 + n;
        v4u o; o.x = pk2(s[0 * 33], s[1 * 33]); o.y = pk2(s[2 * 33], s[3 * 33]); o.z = pk2(s[4 * 33], s[5 * 33]); o.w = pk2(s[6 * 33], s[7 * 33]);
        *(GAS v4u*)(WT + (size_t)n * K + k0 + 8 * c) = o; }
    LDS_WAIT(); asm volatile("" ::: "memory");
}
__device__ __forceinline__ int glu_row(int c, int up) { return (c >> 7) * 256 + (c & 127) + up * 128; }

template <int MODE> __device__ __forceinline__ void mrow(const float* src, float* X, bf16_t* H, const float* gain, const float* w_in, float* G, const float* router, int row, int lane, float (&lg)[8]) {
    const float4* xr = (const float4*)(src + (size_t)row * D) + lane;
    float4 v[4]; float ss = 0.f;
#pragma unroll
    for (int j = 0; j < 4; ++j) { v[j] = xr[64 * j]; ss += v[j].x * v[j].x + v[j].y * v[j].y + v[j].z * v[j].z + v[j].w * v[j].w; }
    ss = wave_sum(ss);
    const float r = rsqrtf(ss * (1.f / D) + EPS);
    if (X != src) { float4* xo = (float4*)(X + (size_t)row * D) + lane;
#pragma unroll
        for (int j = 0; j < 4; ++j) xo[64 * j] = v[j]; }
    float h[16];
#pragma unroll
    for (int j = 0; j < 4; ++j) { const float4 g = *((const float4*)gain + 64 * j + lane);
        h[4 * j + 0] = v[j].x * r * g.x; h[4 * j + 1] = v[j].y * r * g.y; h[4 * j + 2] = v[j].z * r * g.z; h[4 * j + 3] = v[j].w * r * g.w; }
#pragma unroll
    for (int j = 0; j < 4; ++j) { uint2 w; w.x = pk2(h[4 * j], h[4 * j + 1]); w.y = pk2(h[4 * j + 2], h[4 * j + 3]); *((uint2*)(H + (size_t)row * D) + 64 * j + lane) = w; }
    if (MODE == 0) {
        float acc[16];
#pragma unroll
        for (int c = 0; c < 16; ++c) acc[c] = 0.f;
#pragma unroll
        for (int j = 0; j < 4; ++j)
#pragma unroll
            for (int i = 0; i < 4; ++i) { const int k = 256 * j + 4 * lane + i; const float hv = h[4 * j + i];
                const float4* w0 = (const float4*)(w_in + (size_t)k * DIN + 1792); const float4* w1 = (const float4*)(w_in + (size_t)k * DIN + 3592);
                const float4 a0 = w0[0], a1 = w0[1], b0 = w1[0], b1 = w1[1];
                acc[0] += hv * a0.x; acc[1] += hv * a0.y; acc[2] += hv * a0.z; acc[3] += hv * a0.w; acc[4] += hv * a1.x; acc[5] += hv * a1.y; acc[6] += hv * a1.z; acc[7] += hv * a1.w;
                acc[8] += hv * b0.x; acc[9] += hv * b0.y; acc[10] += hv * b0.z; acc[11] += hv * b0.w; acc[12] += hv * b1.x; acc[13] += hv * b1.y; acc[14] += hv * b1.z; acc[15] += hv * b1.w; }
        float mine = 0.f;
#pragma unroll
        for (int c = 0; c < 16; ++c) { const float s = wave_sum(acc[c]); if (lane == c) mine = s; }
        if (lane < 16) G[(size_t)row * GW + lane] = mine;
    }
    if (MODE == 2) {
        float acc[8];
#pragma unroll
        for (int c = 0; c < 8; ++c) acc[c] = 0.f;
#pragma unroll
        for (int j = 0; j < 4; ++j)
#pragma unroll
            for (int i = 0; i < 4; ++i) { const int k = 256 * j + 4 * lane + i; const float hv = h[4 * j + i];
                const float4* w0 = (const float4*)(router + (size_t)k * NE); const float4 a0 = w0[0], a1 = w0[1];
                acc[0] += hv * a0.x; acc[1] += hv * a0.y; acc[2] += hv * a0.z; acc[3] += hv * a0.w; acc[4] += hv * a1.x; acc[5] += hv * a1.y; acc[6] += hv * a1.z; acc[7] += hv * a1.w; }
#pragma unroll
        for (int c = 0; c < 8; ++c) lg[c] = wave_sum(acc[c]);
    }
}
namespace scan {
typedef short bf16x8 __attribute__((ext_vector_type(8)));
typedef float f32x4 __attribute__((ext_vector_type(4)));
typedef unsigned v2u __attribute__((ext_vector_type(2)));
constexpr int TS = 144, TB = 64 * TS;
constexpr int L_T0 = 0, L_T1 = TB, L_T2 = 2 * TB, L_T3 = 3 * TB, L_T4 = 4 * TB, L_T5 = 5 * TB, L_O = 6 * TB, OS = 68  , L_PART = L_O + 64 * OS * 4, L_VEC = L_PART + 8 * 64 * 4, L_END = L_VEC + 8 * 64 * 4;
static_assert(L_END <= RING_BYTES, "scan LDS");
constexpr size_t SC_LHG = 0, SC_LML = 16 * MiB, SC_DEC = 32 * MiB  , SC_NL = 32 * MiB + 256 * 1024  , SC_AMAX = 32 * MiB + 512 * 1024, SC_BEND = SC_AMAX + 4096, SC_MPREV = SC_BEND + 4096;

__device__ __forceinline__ float wave_incl_add(float v, int lane) {
#pragma unroll
    for (int o = 1; o < 64; o <<= 1) { const float u = __shfl_up(v, o); if (lane >= o) v += u; }
    return v;
}
__device__ __forceinline__ float wave_incl_max(float v, int lane) {
#pragma unroll
    for (int o = 1; o < 64; o <<= 1) { const float u = __shfl_up(v, o); if (lane >= o) v = fmaxf(v, u); }
    return v;
}
__device__ __forceinline__ float wave_max(float v) {
#pragma unroll
    for (int o = 1; o < 64; o <<= 1) v = fmaxf(v, __shfl_xor(v, o));
    return v;
}
__device__ __forceinline__ f32x4 mma64(LAS const unsigned char* A, LAS const unsigned char* B, int m0, int n0, int lane, f32x4 acc) {
    const int r = lane & 15, kq = lane >> 4;
#pragma unroll
    for (int ks = 0; ks < 2; ++ks) {
        const bf16x8 a = *(LAS const bf16x8*)(A + (m0 + r) * TS + kq * 16 + ks * 64);
        const bf16x8 b = *(LAS const bf16x8*)(B + (n0 + r) * TS + kq * 16 + ks * 64);
        acc = __builtin_amdgcn_mfma_f32_16x16x32_bf16(a, b, acc, 0, 0, 0);
    }
    return acc;
}
__device__ __forceinline__ v4u pack8(const float (&v)[8]) { v4u w; w.x = pk2(v[0], v[1]); w.y = pk2(v[2], v[3]); w.z = pk2(v[4], v[5]); w.w = pk2(v[6], v[7]); return w; }
__device__ __forceinline__ v4u pack8h(const bf16_t (&v)[8]) { v4u w; w.x = v[0] | ((unsigned)v[1] << 16); w.y = v[2] | ((unsigned)v[3] << 16); w.z = v[4] | ((unsigned)v[5] << 16); w.w = v[6] | ((unsigned)v[7] << 16); return w; }
__device__ __forceinline__ void st16(LAS unsigned char* p, float v) { *(LAS bf16_t*)p = f2bf(v); }
__device__ __forceinline__ void load_state_tile(LAS unsigned char* T, const float* S, int tid) {
    const int v = tid >> 3, d0 = (tid & 7) * 8; const float4 x0 = *(const float4*)(S + v * 64 + d0), x1 = *(const float4*)(S + v * 64 + d0 + 4);
    v4u w; w.x = pk2(x0.x, x0.y); w.y = pk2(x0.z, x0.w); w.z = pk2(x1.x, x1.y); w.w = pk2(x1.z, x1.w);
    *(LAS v4u*)(T + v * TS + d0 * 2) = w;
}
__device__ __forceinline__ void local_state_mma_store(LAS unsigned char* L, float* LT, int wave, int lane) {
    const int mt = wave >> 1;
#pragma unroll
    for (int nn = 0; nn < 2; ++nn) { const int nt = 2 * (wave & 1) + nn; f32x4 acc = {0.f, 0.f, 0.f, 0.f};
        acc = mma64(L + L_T1, L + L_T0, mt * 16, nt * 16, lane, acc);
#pragma unroll
        for (int r = 0; r < 4; ++r) LT[(mt * 16 + 4 * (lane >> 4) + r) * 64 + nt * 16 + (lane & 15)] = acc[r]; }
}

__device__ __forceinline__ void hgrn_b_item(LAS unsigned char* L, const bf16_t* P, float lb, int b, int c, int h, float* LT, float* DEC, int tid, int wave) {
    const int d = tid & 63, tq = wave;
    const bf16_t* pr = P + (size_t)(b * SEQ + c * 64 + 8 * tq) * PW + h * 64 + d;
    float bl[8], kh[8]; bf16_t iv[8]; float run = 0.f;
#pragma unroll
    for (int i = 0; i < 8; ++i) { const float fz = bf2f(pr[(size_t)i * PW + P_HF]); iv[i] = pr[(size_t)i * PW + P_HI];
        const float sg = sigmoidf_(fz), f = lb + (1.f - lb) * sg; kh[i] = (1.f - lb) * (1.f - sg); run += __logf(f); bl[i] = run; }
    LAS float* part = (LAS float*)(L + L_PART);
    part[tq * 64 + d] = run; __syncthreads();
    float off = 0.f, btot = 0.f;
#pragma unroll
    for (int w = 0; w < 8; ++w) { const float pv = part[w * 64 + d]; btot += pv; if (w < tq) off += pv; }
#pragma unroll
    for (int i = 0; i < 8; ++i) kh[i] *= __expf(btot - (off + bl[i]));
    *(LAS v4u*)(L + L_T0 + d * TS + tq * 16) = pack8(kh);
    *(LAS v4u*)(L + L_T1 + d * TS + tq * 16) = pack8h(iv);
    if (tq == 0) DEC[d] = __expf(btot);
    __syncthreads();
    local_state_mma_store(L, LT, wave, tid & 63);
    __syncthreads();
}
__device__ __forceinline__ void mlstm_gates(const float* G, const float* b_i, const float* b_f, int row0, int h, int lane, float& bcum, float& a) {
    const float ig = G[(size_t)(row0 + lane) * GW + h], fg = G[(size_t)(row0 + lane) * GW + 4 + h];
    bcum = wave_incl_add(log_sigmoidf_(fg + b_f[h]), lane); a = ig + b_i[h] - bcum;
}
__device__ __forceinline__ void conv_silu8(const bf16_t* col  , bool first3_zero, const float* w4  , float scale, float (&out)[8]) {
    float raw[11];
#pragma unroll
    for (int j = 0; j < 11; ++j) raw[j] = (j < 3 && first3_zero) ? 0.f : bf2f(col[((long)j - 3) * PW]);
    const float w0 = w4[0], w1 = w4[512], w2 = w4[1024], w3 = w4[1536];
#pragma unroll
    for (int i = 0; i < 8; ++i) out[i] = siluf_(w0 * raw[i] + w1 * raw[i + 1] + w2 * raw[i + 2] + w3 * raw[i + 3]) * scale;
}
__device__ __forceinline__ void mlstm_b_item(LAS unsigned char* L, const bf16_t* P, const float* G, const float* conv, const float* b_i, const float* b_f, int b, int c, int h, float* LT, float* NL, float* AMAX, float* BEND, int tid, int wave) {
    const int d = tid & 63, tq = wave, lane = tid & 63, row0 = b * SEQ + c * 64;
    float bcum, a; mlstm_gates(G, b_i, b_f, row0, h, lane, bcum, a);
    const float A = wave_max(a), bend = __shfl(bcum, 63);
    float kh[8]; conv_silu8(P + (size_t)(row0 + 8 * tq) * PW + P_MK + h * 64 + d, c == 0 && tq == 0, conv + 256 + h * 64 + d, 0.125f, kh);
    bf16_t vv[8]; float nsum = 0.f;
#pragma unroll
    for (int i = 0; i < 8; ++i) { vv[i] = P[(size_t)(row0 + 8 * tq + i) * PW + P_MV + h * 64 + d]; kh[i] *= __expf(__shfl(a, 8 * tq + i) - A); nsum += bf2f(f2bf(kh[i])); }
    *(LAS v4u*)(L + L_T0 + d * TS + tq * 16) = pack8(kh);
    *(LAS v4u*)(L + L_T1 + d * TS + tq * 16) = pack8h(vv);
    LAS float* part = (LAS float*)(L + L_PART); part[tq * 64 + d] = nsum;
    __syncthreads();
    if (tq == 0) { float s = 0.f;
#pragma unroll
        for (int w = 0; w < 8; ++w) s += part[w * 64 + d];
        NL[d] = s; if (lane == 0) { AMAX[0] = A; BEND[0] = bend; } }
    local_state_mma_store(L, LT, wave, lane);
    __syncthreads();
}
__device__ __forceinline__ void fox_cumsum_item(LAS unsigned char* L, const float* G, const float* fox_bf, float* CF, int bh, int tid, int wave) {
    const int b = bh >> 3, h = bh & 7, lane = tid & 63; const float bf = fox_bf[h];
    float loc[16]; float s = 0.f;
#pragma unroll
    for (int i = 0; i < 16; ++i) { s += log_sigmoidf_(G[((size_t)b * SEQ + tid * 16 + i) * GW + 8 + h] + bf); loc[i] = s; }
    const float incl = wave_incl_add(s, lane);
    LAS float* wt = (LAS float*)(L + L_PART);
    if (lane == 63) wt[wave] = incl;
    __syncthreads();
    float off = incl - s;
#pragma unroll
    for (int w = 0; w < 8; ++w) if (w < wave) off += wt[w];
#pragma unroll
    for (int i = 0; i < 16; ++i) CF[(size_t)bh * SEQ + tid * 16 + i] = (off + loc[i]) * LOG2E;
    __syncthreads();
}

__device__ __forceinline__ void scan_c_block(unsigned char* sc, int j, int tid) {
    if (j < 128) {
        if (tid < 256) { const int chain = j >> 4, e = (j & 15) * 256 + tid, b = chain >> 2, h = chain & 3;
            float* p = (float*)(sc + SC_LHG) + ((size_t)(b * 128) * 4 + h) * 4096 + e; const float* dp = (const float*)(sc + SC_DEC) + ((size_t)(b * 128) * 4 + h) * 64 + (e & 63);
            float S = 0.f;
#pragma unroll 8
            for (int c = 0; c < 128; ++c) { const float Lc = p[(size_t)c * 4 * 4096], dec = dp[(size_t)c * 4 * 64]; p[(size_t)c * 4 * 4096] = S; S = dec * S + Lc; } }
    } else {
        const int jj = j - 128, chain = jj >> 4, part = jj & 15, b = chain >> 2, h = chain & 3;
        if (tid < 260) { const bool isn = tid >= 256; const size_t it0 = (size_t)(b * 128) * 4 + h;
            float* p = isn ? (float*)(sc + SC_NL) + it0 * 64 + part * 4 + (tid - 256) : (float*)(sc + SC_LML) + it0 * 4096 + part * 256 + tid;
            const size_t stride = isn ? 4 * 64 : 4 * 4096;
            const float* am = (const float*)(sc + SC_AMAX) + it0; const float* be = (const float*)(sc + SC_BEND) + it0; float* mp = (float*)(sc + SC_MPREV) + it0;
            const bool writer = (part == 0 && tid == 0);
            float S = 0.f, m = 0.f;
#pragma unroll 8
            for (int c = 0; c < 128; ++c) { const float A = am[c * 4], bb = be[c * 4], Lc = p[c * stride]; const float Mx = fmaxf(m, A);
                p[c * stride] = S; S = __expf(m - Mx) * S + __expf(A - Mx) * Lc; if (writer) mp[c * 4] = m; m = bb + Mx; } }
    }
}

template <bool SIG> __device__ __forceinline__ void head_epilogue(LAS unsigned char* L, float inv, const bf16_t* gate  , const float* gain  , bf16_t* out  , int tid) {
    const int t = tid >> 3, v0 = (tid & 7) * 8; const LAS float* o = (const LAS float*)(L + L_O) + t * OS + v0;
    float x[8]; float ss = 0.f;
#pragma unroll
    for (int i = 0; i < 8; ++i) { x[i] = o[i] * inv; ss += x[i] * x[i]; }
    ss += __shfl_xor(ss, 1); ss += __shfl_xor(ss, 2); ss += __shfl_xor(ss, 4);
    const float r = rsqrtf(ss * (1.f / 64.f) + EPS);
    const uint4 gw = *(const uint4*)gate; const unsigned gu[4] = {gw.x, gw.y, gw.z, gw.w};
    float y[8];
#pragma unroll
    for (int i = 0; i < 8; ++i) { const float gz = bf2f((bf16_t)((gu[i >> 1] >> (16 * (i & 1))) & 0xffff)); y[i] = x[i] * r * gain[i] * (SIG ? sigmoidf_(gz) : siluf_(gz)); }
    *(v4u*)out = pack8(y);
}
__device__ __forceinline__ void store_o_tiles(LAS unsigned char* L, LAS const unsigned char* A1, LAS const unsigned char* B1, LAS const unsigned char* A2, LAS const unsigned char* B2, int wave, int lane) {
    const int mt = wave >> 1;
#pragma unroll
    for (int nn = 0; nn < 2; ++nn) { const int nt = 2 * (wave & 1) + nn; f32x4 acc = {0.f, 0.f, 0.f, 0.f};
        acc = mma64(A1, B1, mt * 16, nt * 16, lane, acc); acc = mma64(A2, B2, mt * 16, nt * 16, lane, acc);
        LAS float* o = (LAS float*)(L + L_O);
#pragma unroll
        for (int r = 0; r < 4; ++r) o[(mt * 16 + 4 * (lane >> 4) + r) * OS + nt * 16 + (lane & 15)] = acc[r]; }
}
__device__ __forceinline__ void hgrn_d_item(LAS unsigned char* L, const bf16_t* P, float lb, const float* gain, int b, int c, int h, const float* ST, bf16_t* MIX, int tid, int wave) {
    const int d = tid & 63, tq = wave, lane = tid & 63, row0 = b * SEQ + c * 64;
    const bf16_t* pr = P + (size_t)(row0 + 8 * tq) * PW + h * 64 + d;
    float bl[8], kk[8], q[8]; bf16_t iv[8]; float run = 0.f;
#pragma unroll
    for (int i = 0; i < 8; ++i) { const float fz = bf2f(pr[(size_t)i * PW + P_HF]); q[i] = bf2f(pr[(size_t)i * PW + P_HQ]); iv[i] = pr[(size_t)i * PW + P_HI];
        const float sg = sigmoidf_(fz), f = lb + (1.f - lb) * sg; kk[i] = (1.f - lb) * (1.f - sg); run += __logf(f); bl[i] = run; }
    LAS float* part = (LAS float*)(L + L_PART);
    part[tq * 64 + d] = run;
    load_state_tile(L + L_T4, ST, tid);
    *(LAS v4u*)(L + L_T3 + d * TS + tq * 16) = pack8h(iv);
    __syncthreads();
    float off = 0.f, bref = 0.f;
#pragma unroll
    for (int w = 0; w < 8; ++w) { const float pv = part[w * 64 + d]; if (w < 4) bref += pv; if (w < tq) off += pv; }
#pragma unroll
    for (int i = 0; i < 8; ++i) { const float bb = off + bl[i]; const int t = 8 * tq + i;
        st16(L + L_T0 + t * TS + d * 2, q[i] * __expf(bb - bref));
        st16(L + L_T1 + t * TS + d * 2, kk[i] * __expf(bref - bb));
        st16(L + L_T2 + t * TS + d * 2, q[i] * __expf(bb)); }
    __syncthreads();
    { const int mt = wave >> 1;
#pragma unroll
      for (int nn = 0; nn < 2; ++nn) { const int nt = 2 * (wave & 1) + nn; f32x4 acc = {0.f, 0.f, 0.f, 0.f};
          acc = mma64(L + L_T1, L + L_T0, mt * 16, nt * 16, lane, acc);
          const int s0 = mt * 16 + 4 * (lane >> 4), t = nt * 16 + (lane & 15);
          v2u w; w.x = pk2(s0 <= t ? acc[0] : 0.f, s0 + 1 <= t ? acc[1] : 0.f); w.y = pk2(s0 + 2 <= t ? acc[2] : 0.f, s0 + 3 <= t ? acc[3] : 0.f);
          *(LAS v2u*)(L + L_T5 + t * TS + s0 * 2) = w; } }
    __syncthreads();
    store_o_tiles(L, L + L_T5, L + L_T3, L + L_T2, L + L_T4, wave, lane);
    __syncthreads();
    { const int t = tid >> 3, v0 = (tid & 7) * 8;
      head_epilogue<false>(L, 1.f, P + (size_t)(row0 + t) * PW + P_HG + h * 64 + v0, gain + h * 64 + v0, MIX + (size_t)(row0 + t) * D + h * 64 + v0, tid); }
    __syncthreads();
}
__device__ __forceinline__ void mlstm_d_item(LAS unsigned char* L, const bf16_t* P, const float* G, const float* conv, const float* b_i, const float* b_f, const float* gain, int b, int c, int h,
                                             const float* CT, const float* NP, float mprev, bf16_t* MIX, int tid, int wave) {
    const int d = tid & 63, tq = wave, lane = tid & 63, row0 = b * SEQ + c * 64;
    float bcum, a; mlstm_gates(G, b_i, b_f, row0, h, lane, bcum, a);
    const float M = fmaxf(wave_incl_max(a, lane), mprev), sint = __expf(mprev - M);
    LAS float* vec = (LAS float*)(L + L_VEC);
    if (wave == 0) { vec[lane] = a; vec[64 + lane] = M; vec[128 + lane] = __expf(-bcum - M); vec[192 + lane] = NP[lane]; }
    float qc[8], kc[8]; const bool fz3 = (c == 0 && tq == 0);
    conv_silu8(P + (size_t)(row0 + 8 * tq) * PW + P_MQ + h * 64 + d, fz3, conv + h * 64 + d, 1.f, qc);
    conv_silu8(P + (size_t)(row0 + 8 * tq) * PW + P_MK + h * 64 + d, fz3, conv + 256 + h * 64 + d, 0.125f, kc);
    bf16_t vv[8];
#pragma unroll
    for (int i = 0; i < 8; ++i) { vv[i] = P[(size_t)(row0 + 8 * tq + i) * PW + P_MV + h * 64 + d]; const int t = 8 * tq + i;
        st16(L + L_T0 + t * TS + d * 2, qc[i]);
        st16(L + L_T1 + t * TS + d * 2, kc[i]);
        st16(L + L_T2 + t * TS + d * 2, qc[i] * __shfl(sint, t)); }
    *(LAS v4u*)(L + L_T3 + d * TS + tq * 16) = pack8h(vv);
    load_state_tile(L + L_T4, CT, tid);
    __syncthreads();
    { const int mt = wave >> 1;
#pragma unroll
      for (int nn = 0; nn < 2; ++nn) { const int nt = 2 * (wave & 1) + nn; f32x4 acc = {0.f, 0.f, 0.f, 0.f};
          acc = mma64(L + L_T1, L + L_T0, mt * 16, nt * 16, lane, acc);
          const int s0 = mt * 16 + 4 * (lane >> 4), t = nt * 16 + (lane & 15); const float Mt = vec[64 + t];
          float wv[4];
#pragma unroll
          for (int r = 0; r < 4; ++r) wv[r] = (s0 + r <= t) ? acc[r] * __expf(vec[s0 + r] - Mt) : 0.f;
          v2u w; w.x = pk2(wv[0], wv[1]); w.y = pk2(wv[2], wv[3]); *(LAS v2u*)(L + L_T5 + t * TS + s0 * 2) = w; } }
    __syncthreads();
    store_o_tiles(L, L + L_T5, L + L_T3, L + L_T2, L + L_T4, wave, lane);
    __syncthreads();
    { const int t = tid >> 3, c8 = (tid & 7) * 8;
      const v4u pw = *(LAS const v4u*)(L + L_T5 + t * TS + c8 * 2), qw = *(LAS const v4u*)(L + L_T2 + t * TS + c8 * 2);
      const unsigned pu[4] = {pw.x, pw.y, pw.z, pw.w}, qu[4] = {qw.x, qw.y, qw.z, qw.w}; float den = 0.f;
#pragma unroll
      for (int i = 0; i < 8; ++i) { den += bf2f((bf16_t)((pu[i >> 1] >> (16 * (i & 1))) & 0xffff)) + bf2f((bf16_t)((qu[i >> 1] >> (16 * (i & 1))) & 0xffff)) * vec[192 + c8 + i]; }
      den += __shfl_xor(den, 1); den += __shfl_xor(den, 2); den += __shfl_xor(den, 4);
      const float inv = 1.f / fmaxf(fabsf(den), vec[128 + t]);
      head_epilogue<true>(L, inv, P + (size_t)(row0 + t) * PW + P_MO + h * 64 + c8, gain + h * 64 + c8, MIX + (size_t)(row0 + t) * D + 256 + h * 64 + c8, tid); }
    __syncthreads();
}
}
constexpr int N_PHASES = 21;
template <int PH> __device__ __forceinline__ void run_phase(const MArgs& a, LAS unsigned char* L, const int tid, const int wave, const int G, const int bx, const int vcu) {
    const int lane = tid & 63, gw = vcu * NWAVES + wave, NGW = G * NWAVES;
    unsigned char* ws = a.ws; float* X = a.out;
    int* ctl = (int*)(ws + WS_CTL); int* cnt = ctl + CW_CNT;
    float* Gt = (float*)(ws + WS_G); float* CF = (float*)(ws + WS_CF); int4* tokinfo = (int4*)(ws + WS_TOKINFO); float2* tgate = (float2*)(ws + WS_TGATE); int* toklist = (int*)(ws + WS_TOKLIST);
    bf16_t* P = (bf16_t*)(ws + WS_P); bf16_t* HID = (bf16_t*)(ws + WS_HID); bf16_t* H = (bf16_t*)(ws + WS_H); bf16_t* MIX = (bf16_t*)(ws + WS_MIX);
    bf16_t* XG = (bf16_t*)(ws + WS_XG); bf16_t* Y = (bf16_t*)(ws + WS_Y);
    LAS float* scr = (LAS float*)(L + RING_OFF + wave * 16384);
    (void)Gt; (void)CF; (void)tokinfo; (void)tgate; (void)toklist; (void)P; (void)HID; (void)H; (void)MIX; (void)XG; (void)Y; (void)scr; (void)cnt; (void)lane; (void)gw; (void)NGW;
    constexpr int p = PH, l = p >= 10 ? 1 : 0, k = p == 0 ? -1 : (l ? p - 10 : p - 1);
    if constexpr (p == 0) {
            for (int it = gw; it < 8832; it += NGW) {
                int r = it;
                if (r < 3584) { const int ll = r / 1792; r %= 1792; const int kb = r / 112, nb = r % 112, sc = 32 * nb + (nb >= 56 ? 8 : 0);
                    tr_item(a.in[I_W_IN] + (size_t)ll * D * DIN + sc, DIN, D, (bf16_t*)(ws + WS_WIN) + (size_t)ll * PW * D + (size_t)32 * nb * D, scr, 64 * kb, lane); continue; }
                r -= 3584;
                if (r < 1024) { const int ll = r / 512; r %= 512; const int kb = r / 32, nb = r % 32;
                    tr_item(a.in[I_W_OUT] + (size_t)ll * D * D + 32 * nb, D, D, (bf16_t*)(ws + WS_WOUT) + (size_t)ll * D * D + (size_t)32 * nb * D, scr, 64 * kb, lane); continue; }
                r -= 1024;
                if (r < 2816) { const int up = r / 1408; r %= 1408; const int kb = r / 88, nb = r % 88, c = 32 * nb;
                    tr_item((up ? a.in[I_DUP] : a.in[I_DGATE]) + c, FF, D, (bf16_t*)(ws + WS_WDGU) + (size_t)glu_row(c, up) * D, scr, 64 * kb, lane); continue; }
                r -= 2816;
                { const int kb = r / 32, nb = r % 32; tr_item(a.in[I_DDOWN] + 32 * nb, D, FF, (bf16_t*)(ws + WS_WDDN) + (size_t)32 * nb * FF, scr, 64 * kb, lane); }
            }
            float lg[8];
            for (int row = gw; row < NTOK; row += NGW) mrow<0>(a.in[I_X], X, H, a.in[I_ATTN_NORM], a.in[I_W_IN], Gt, nullptr, row, lane, lg);
        } else if constexpr (k == 0 || (l == 1 && k == 9)) {
            pg8::GOrder S; pg8::EpiBf E; int K;
            if constexpr (k == 0) { S.so.init(NTOK, PW, G, bx); S.A = (const char*)H; S.B = (const char*)(ws + WS_WIN) + (size_t)l * PW * D * 2; S.a_tile = (size_t)256 * D * 2; S.b_tile = (size_t)256 * D * 2; S.b_exp = 0;
                S.tb1 = S.tb2 = S.tb3 = S.tb4 = S.tb5 = S.tb6 = S.tb7 = 0x7fffffff; K = D; E.O = P; E.ldc = PW; E.s_lo = P_FQ / 256; E.s_hi = P_FK / 256; E.scale = QSCALE; }
            else { int t[8]; int acc = 0;
#pragma unroll
                for (int e = 0; e < NE; ++e) { t[e] = acc; acc += (cnt[e] + 255) >> 8; }
                S.so.init(acc * 256, D, G, bx); S.A = (const char*)HID; S.B = (const char*)(ws + WS_WMDN); S.a_tile = (size_t)256 * FE * 2; S.b_tile = (size_t)256 * FE * 2; S.b_exp = (size_t)D * FE * 2;
                S.tb1 = t[1]; S.tb2 = t[2]; S.tb3 = t[3]; S.tb4 = t[4]; S.tb5 = t[5]; S.tb6 = t[6]; S.tb7 = t[7]; K = FE; E.O = Y; E.ldc = D; E.s_lo = 0; E.s_hi = 0; E.scale = 1.f; }
            pg8::Gemm g{K};
            pg8::gemm_phase<pg8::EpiBf, pg8::GOrder, true, true>(L + RING_OFF, g, S, E);
        } else if constexpr (k == 4 || (l == 0 && k == 7)) {
            pg8::GOrder S; S.so.init(NTOK, D, G, bx); S.b_exp = 0; S.tb1 = S.tb2 = S.tb3 = S.tb4 = S.tb5 = S.tb6 = S.tb7 = 0x7fffffff; int K;
            if constexpr (k == 4) { K = D; S.A = (const char*)MIX; S.B = (const char*)(ws + WS_WOUT) + (size_t)l * D * D * 2; }
            else { K = FF; S.A = (const char*)HID; S.B = (const char*)(ws + WS_WDDN); }
            S.a_tile = (size_t)256 * K * 2; S.b_tile = (size_t)256 * K * 2;
            pg8::EpiResid E{X, D}; pg8::Gemm g{K};
            pg8::gemm_phase<pg8::EpiResid, pg8::GOrder, true, true>(L + RING_OFF, g, S, E);
        } else if constexpr ((l == 0 && k == 6) || (l == 1 && k == 7)) {
            pg8::GOrder S; pg8::EpiSwiglu E; S.a_tile = (size_t)256 * D * 2; S.b_tile = (size_t)256 * D * 2;
            if constexpr (l == 0) { S.so.init(NTOK, 2 * FF, G, bx); S.A = (const char*)H; S.B = (const char*)(ws + WS_WDGU); S.b_exp = 0; S.tb1 = S.tb2 = S.tb3 = S.tb4 = S.tb5 = S.tb6 = S.tb7 = 0x7fffffff; E.O = HID; E.ldc = FF; }
            else { int t[8]; int acc = 0;
#pragma unroll
                for (int e = 0; e < NE; ++e) { t[e] = acc; acc += (cnt[e] + 255) >> 8; }
                S.so.init(acc * 256, 2 * FE, G, bx); S.A = (const char*)XG; S.B = (const char*)(ws + WS_WMGU); S.b_exp = (size_t)2 * FE * D * 2;
                S.tb1 = t[1]; S.tb2 = t[2]; S.tb3 = t[3]; S.tb4 = t[4]; S.tb5 = t[5]; S.tb6 = t[6]; S.tb7 = t[7]; E.O = HID; E.ldc = FE; }
            pg8::Gemm g{D};
            pg8::gemm_phase<pg8::EpiSwiglu, pg8::GOrder, true, true>(L + RING_OFF, g, S, E);
        } else if constexpr (k == 5 && l == 0) {
            float lg[8];
            for (int row = gw; row < NTOK; row += NGW) mrow<1>(X, X, H, a.in[I_FFN_NORM], nullptr, nullptr, nullptr, row, lane, lg);
        } else if constexpr (k == 8 && l == 0) {
            float lg[8];
            for (int row = gw; row < NTOK; row += NGW) mrow<0>(X, X, H, a.in[I_ATTN_NORM] + D, a.in[I_W_IN] + (size_t)D * DIN, Gt, nullptr, row, lane, lg);
        } else if constexpr (k == 5 && l == 1) {
            LAS int* sel_e = (LAS int*)(L + RING_OFF);
            LAS float* sel_g = (LAS float*)(L + RING_OFF + 512);
            LAS int* lcnt = (LAS int*)(L + RING_OFF + 1024);
            for (int rb = bx; rb < NTOK / 64; rb += G) {
                if (tid < 16) lcnt[tid] = 0;
                for (int i = 0; i < 8; ++i) { const int rl = wave * 8 + i, row = rb * 64 + rl; float lg[8];
                    mrow<2>(X, X, H, a.in[I_FFN_NORM] + D, nullptr, nullptr, a.in[I_ROUTER], row, lane, lg);
                    if (lane == 0) { int e0 = 0; float v0 = lg[0];
#pragma unroll
                        for (int c = 1; c < 8; ++c) if (lg[c] > v0) { v0 = lg[c]; e0 = c; }
                        int e1 = -1; float v1 = -INFINITY;
#pragma unroll
                        for (int c = 0; c < 8; ++c) if (c != e0 && lg[c] > v1) { v1 = lg[c]; e1 = c; }
                        const float g1 = 1.f / (1.f + __expf(v0 - v1));
                        sel_e[2 * rl] = e0; sel_e[2 * rl + 1] = e1; sel_g[2 * rl] = 1.f - g1; sel_g[2 * rl + 1] = g1; } }
                __syncthreads();
                int e0 = 0, e1 = 0, r0 = 0, r1 = 0;
                if (tid < 64) { e0 = sel_e[2 * tid]; e1 = sel_e[2 * tid + 1]; r0 = __hip_atomic_fetch_add(lcnt + e0, 1, __ATOMIC_RELAXED, __HIP_MEMORY_SCOPE_WORKGROUP); r1 = __hip_atomic_fetch_add(lcnt + e1, 1, __ATOMIC_RELAXED, __HIP_MEMORY_SCOPE_WORKGROUP); }
                __syncthreads();
                if (tid < 8) lcnt[8 + tid] = atomicAdd(cnt + tid, (int)lcnt[tid]);
                __syncthreads();
                if (tid < 64) { const int row = rb * 64 + tid, s0 = lcnt[8 + e0] + r0, s1 = lcnt[8 + e1] + r1;
                    toklist[e0 * NTOK + s0] = row; toklist[e1 * NTOK + s1] = row; tokinfo[row] = make_int4(e0, s0, e1, s1); tgate[row] = make_float2(sel_g[2 * tid], sel_g[2 * tid + 1]); }
                __syncthreads();
            }
        } else if constexpr (k == 6 && l == 1) {
            { int base[NE]; int acc = 0;
#pragma unroll
              for (int e = 0; e < NE; ++e) { base[e] = acc; acc += (cnt[e] + 255) & ~255; }
              for (int r = gw; r < acc; r += NGW) { int e = 0, be = 0;
#pragma unroll
                  for (int c = 1; c < NE; ++c) if (r >= base[c]) { e = c; be = base[c]; }
                  const int s = r - be; uint4 v0 = make_uint4(0, 0, 0, 0), v1 = v0;
                  if (s < cnt[e]) { const int tok = toklist[e * NTOK + s]; const uint4* src = (const uint4*)(H + (size_t)tok * D); v0 = src[lane]; v1 = src[64 + lane]; }
                  uint4* dst = (uint4*)(XG + (size_t)r * D); dst[lane] = v0; dst[64 + lane] = v1; } }
            for (int it = gw; it < 28672; it += NGW) { const int e = it / 3584; int r = it % 3584; const int up = r / 1792; r %= 1792; const int kb = r / 112, nb = r % 112, c = 32 * nb;
                tr_item((up ? a.in[I_MUP] : a.in[I_MGATE]) + (size_t)e * D * FE + c, FE, D, (bf16_t*)(ws + WS_WMGU) + (size_t)e * 2 * FE * D + (size_t)glu_row(c, up) * D, scr, 64 * kb, lane); }
        } else if constexpr (k == 8 && l == 1) {
            for (int it = gw; it < 14336; it += NGW) { const int e = it / 1792, r = it % 1792, kb = r / 32, nb = r % 32;
                tr_item(a.in[I_MDOWN] + (size_t)e * FE * D + 32 * nb, D, FE, (bf16_t*)(ws + WS_WMDN) + (size_t)e * D * FE + (size_t)32 * nb * FE, scr, 64 * kb, lane); }
        } else if constexpr (k == 10 && l == 1) {
            int base[NE]; { int acc = 0;
#pragma unroll
              for (int e = 0; e < NE; ++e) { base[e] = acc; acc += (cnt[e] + 255) & ~255; } }
            for (int row = gw; row < NTOK; row += NGW) {
                float4* xr = (float4*)(X + (size_t)row * D) + lane; float4 v[4];
#pragma unroll
                for (int j = 0; j < 4; ++j) v[j] = xr[64 * j];
                const int4 ti = tokinfo[row]; const float2 tg = tgate[row]; int b0 = 0, b1 = 0;
#pragma unroll
                for (int c = 0; c < NE; ++c) { if (c == ti.x) b0 = base[c]; if (c == ti.z) b1 = base[c]; }
                const bf16_t* y0 = Y + (size_t)(b0 + ti.y) * D; const bf16_t* y1 = Y + (size_t)(b1 + ti.w) * D;
#pragma unroll
                for (int j = 0; j < 4; ++j) { const uint2 q = *((const uint2*)y0 + 64 * j + lane), c = *((const uint2*)y1 + 64 * j + lane);
                    v[j].x += tg.x * bf2f((bf16_t)(q.x & 0xffff)) + tg.y * bf2f((bf16_t)(c.x & 0xffff)); v[j].y += tg.x * bf2f((bf16_t)(q.x >> 16)) + tg.y * bf2f((bf16_t)(c.x >> 16));
                    v[j].z += tg.x * bf2f((bf16_t)(q.y & 0xffff)) + tg.y * bf2f((bf16_t)(c.y & 0xffff)); v[j].w += tg.x * bf2f((bf16_t)(q.y >> 16)) + tg.y * bf2f((bf16_t)(c.y >> 16)); }
                float ss = 0.f;
#pragma unroll
                for (int j = 0; j < 4; ++j) ss += v[j].x * v[j].x + v[j].y * v[j].y + v[j].z * v[j].z + v[j].w * v[j].w;
                ss = wave_sum(ss); const float r = rsqrtf(ss * (1.f / D) + EPS);
#pragma unroll
                for (int j = 0; j < 4; ++j) { const float4 g = *((const float4*)a.in[I_FINAL_NORM] + 64 * j + lane); xr[64 * j] = make_float4(v[j].x * r * g.x, v[j].y * r * g.y, v[j].z * r * g.z, v[j].w * r * g.w); }
            }
        } else {
            if constexpr (k == 1) {
                unsigned char* sc = ws + WS_SCAN; const int wv = wave;
                for (int it = bx; it < 2048; it += G) { const int item = it & 1023, h = item & 3, c = (item >> 2) & 127, b = item >> 9;
                    if (it < 1024) { const int ch = h * 64 + (tid & 63); const float lb = l == 0 ? 0.f : 1.f / (1.f + __expf(a.in[I_HGRN_LB][ch] - a.in[I_HGRN_LB][256 + ch]));
                        scan::hgrn_b_item(L, P, lb, b, c, h, (float*)(sc + scan::SC_LHG) + (size_t)item * 4096, (float*)(sc + scan::SC_DEC) + item * 64, tid, wv); }
                    else scan::mlstm_b_item(L, P, Gt, a.in[I_MLSTM_CONV] + l * 2048, a.in[I_MLSTM_BI] + l * 4, a.in[I_MLSTM_BF] + l * 4, b, c, h, (float*)(sc + scan::SC_LML) + (size_t)item * 4096,
                                            (float*)(sc + scan::SC_NL) + item * 64, (float*)(sc + scan::SC_AMAX) + item, (float*)(sc + scan::SC_BEND) + item, tid, wv); }
                for (int bh = bx; bh < 16; bh += G) scan::fox_cumsum_item(L, Gt, a.in[I_FOX_BF] + l * 8, CF, bh, tid, wv);
            } else if constexpr (k == 2) {
                for (int j = bx; j < 256; j += G) scan::scan_c_block(ws + WS_SCAN, j, tid);
                static_assert(attn_body::ATTN_LDS_BYTES <= RING_BYTES, "attention LDS");
                const attn_body::AttnTensors AT{(const attn_body::bf16*)(P + P_FQ), (const attn_body::bf16*)(P + P_FK), (const attn_body::bf16*)(P + P_FV), (attn_body::bf16*)(MIX + 512), CF};
                const attn_body::StaticOrder S(G, bx);
                attn_body::attn_phase<attn_body::StaticOrder>((char*)L + RING_OFF, AT, S);
            } else if constexpr (k == 3) {
                unsigned char* sc = ws + WS_SCAN; const int wv = wave;
                for (int it = bx; it < 2048; it += G) { const int item = it & 1023, h = item & 3, c = (item >> 2) & 127, b = item >> 9;
                    if (it < 1024) { const int ch = h * 64 + (tid & 63); const float lb = l == 0 ? 0.f : 1.f / (1.f + __expf(a.in[I_HGRN_LB][ch] - a.in[I_HGRN_LB][256 + ch]));
                        scan::hgrn_d_item(L, P, lb, a.in[I_HGRN_NORM] + l * 256, b, c, h, (const float*)(sc + scan::SC_LHG) + (size_t)item * 4096, MIX, tid, wv); }
                    else scan::mlstm_d_item(L, P, Gt, a.in[I_MLSTM_CONV] + l * 2048, a.in[I_MLSTM_BI] + l * 4, a.in[I_MLSTM_BF] + l * 4, a.in[I_MLSTM_NORM] + l * 256, b, c, h,
                                            (const float*)(sc + scan::SC_LML) + (size_t)item * 4096, (const float*)(sc + scan::SC_NL) + item * 64, ((const float*)(sc + scan::SC_MPREV))[item], MIX, tid, wv); }
            }

        }
}
__global__ void __launch_bounds__(NTHR, 2) mega(MArgs a) {
    extern __shared__ __attribute__((aligned(16))) unsigned char lds[];
    LAS unsigned char* L = (LAS unsigned char*)lds;
    volatile LAS unsigned* MISC = (volatile LAS unsigned*)(L + MISC_OFF);
    const int tid = threadIdx.x, wave = __builtin_amdgcn_readfirstlane(tid >> 6);
    const int G = gridDim.x, bx = blockIdx.x, vcu = (G % 8 == 0) ? (bx % 8) * (G / 8) + bx / 8 : bx;
    for (int u = tid; u < (LDS_BYTES - LDSCTL_OFF) / 4; u += NTHR) ((LAS unsigned*)(L + LDSCTL_OFF))[u] = 0u;
    __syncthreads();
    const int lo = a.ph_lo, hi = a.ph_hi;
    XcdBarrier bar; bar.bar = (unsigned*)(a.ws + WS_CTL) + CW_BAR; bar.x = 0; bar.st = nullptr;
    if (hi - lo > 1) bar = xcd_barrier_post((unsigned*)(a.ws + WS_CTL) + CW_BAR, MISC + 8);
#define PHASE(k) if (lo <= (k) && (k) < hi) { run_phase<k>(a, L, tid, wave, G, bx, vcu); if ((k) + 1 < hi) xcd_barrier(bar); }
    PHASE(0) PHASE(1) PHASE(2) PHASE(3) PHASE(4) PHASE(5) PHASE(6) PHASE(7) PHASE(8) PHASE(9) PHASE(10)
    PHASE(11) PHASE(12) PHASE(13) PHASE(14) PHASE(15) PHASE(16) PHASE(17) PHASE(18) PHASE(19) PHASE(20)
#undef PHASE
}
struct RowArgs { const float* src; float* X; bf16_t* H; const float* gain; const float* w_in; float* G; const float* router; int* cnt; int* toklist; int4* tokinfo; float2* tgate; };
template <int MODE> __global__ void __launch_bounds__(256) k_rowpass(RowArgs a) {
    const int wave = threadIdx.x >> 6, lane = threadIdx.x & 63, row = blockIdx.x * 4 + wave;
    const float4* xr = (const float4*)(a.src + (size_t)row * D) + lane;
    float4 v[4]; float ss = 0.f;
#pragma unroll
    for (int j = 0; j < 4; ++j) { v[j] = xr[64 * j]; ss += v[j].x * v[j].x + v[j].y * v[j].y + v[j].z * v[j].z + v[j].w * v[j].w; }
    ss = wave_sum(ss);
    const float r = rsqrtf(ss * (1.f / D) + EPS);
    if (a.X != a.src) { float4* xo = (float4*)(a.X + (size_t)row * D) + lane;
#pragma unroll
        for (int j = 0; j < 4; ++j) xo[64 * j] = v[j]; }
    float h[16];
#pragma unroll
    for (int j = 0; j < 4; ++j) { const float4 g = *((const float4*)a.gain + 64 * j + lane);
        h[4 * j + 0] = v[j].x * r * g.x; h[4 * j + 1] = v[j].y * r * g.y; h[4 * j + 2] = v[j].z * r * g.z; h[4 * j + 3] = v[j].w * r * g.w; }
#pragma unroll
    for (int j = 0; j < 4; ++j) { uint2 w; w.x = (unsigned)f2bf(h[4 * j]) | ((unsigned)f2bf(h[4 * j + 1]) << 16); w.y = (unsigned)f2bf(h[4 * j + 2]) | ((unsigned)f2bf(h[4 * j + 3]) << 16);
        *((uint2*)(a.H + (size_t)row * D) + 64 * j + lane) = w; }
    if (MODE == 0) {
        float acc[16];
#pragma unroll
        for (int c = 0; c < 16; ++c) acc[c] = 0.f;
#pragma unroll
        for (int j = 0; j < 4; ++j)
#pragma unroll
            for (int i = 0; i < 4; ++i) { const int k = 256 * j + 4 * lane + i; const float hv = h[4 * j + i];
                const float4* w0 = (const float4*)(a.w_in + (size_t)k * DIN + 1792); const float4* w1 = (const float4*)(a.w_in + (size_t)k * DIN + 3592);
                const float4 a0 = w0[0], a1 = w0[1], b0 = w1[0], b1 = w1[1];
                acc[0] += hv * a0.x; acc[1] += hv * a0.y; acc[2] += hv * a0.z; acc[3] += hv * a0.w; acc[4] += hv * a1.x; acc[5] += hv * a1.y; acc[6] += hv * a1.z; acc[7] += hv * a1.w;
                acc[8] += hv * b0.x; acc[9] += hv * b0.y; acc[10] += hv * b0.z; acc[11] += hv * b0.w; acc[12] += hv * b1.x; acc[13] += hv * b1.y; acc[14] += hv * b1.z; acc[15] += hv * b1.w; }
        float mine = 0.f;
#pragma unroll
        for (int c = 0; c < 16; ++c) { const float s = wave_sum(acc[c]); if (lane == c) mine = s; }
        if (lane < 16) a.G[(size_t)row * GW + lane] = mine;
    }
    if (MODE == 2) {
        float acc[8];
#pragma unroll
        for (int c = 0; c < 8; ++c) acc[c] = 0.f;
#pragma unroll
        for (int j = 0; j < 4; ++j)
#pragma unroll
            for (int i = 0; i < 4; ++i) { const int k = 256 * j + 4 * lane + i; const float hv = h[4 * j + i];
                const float4* w0 = (const float4*)(a.router + (size_t)k * NE); const float4 a0 = w0[0], a1 = w0[1];
                acc[0] += hv * a0.x; acc[1] += hv * a0.y; acc[2] += hv * a0.z; acc[3] += hv * a0.w; acc[4] += hv * a1.x; acc[5] += hv * a1.y; acc[6] += hv * a1.z; acc[7] += hv * a1.w; }
        float lg[8];
#pragma unroll
        for (int c = 0; c < 8; ++c) lg[c] = wave_sum(acc[c]);
        if (lane == 0) {
            int e0 = 0; float v0 = lg[0];
#pragma unroll
            for (int c = 1; c < 8; ++c) if (lg[c] > v0) { v0 = lg[c]; e0 = c; }
            int e1 = -1; float v1 = -INFINITY;
#pragma unroll
            for (int c = 0; c < 8; ++c) if (c != e0 && lg[c] > v1) { v1 = lg[c]; e1 = c; }
            const float g1 = 1.f / (1.f + __expf(v0 - v1)), g0 = 1.f - g1;
            const int s0 = atomicAdd(a.cnt + e0, 1), s1 = atomicAdd(a.cnt + e1, 1);
            a.toklist[e0 * NTOK + s0] = row; a.toklist[e1 * NTOK + s1] = row;
            a.tokinfo[row] = make_int4(e0, s0, e1, s1); a.tgate[row] = make_float2(g0, g1);
        }
    }
}

struct GemmArgs { const bf16_t* A; const float* W; const float* W2; float* X; bf16_t* O; const int* cnt; int lda, ldw, K, ldo; };
template <int MODE> __global__ void __launch_bounds__(256) k_gemm_naive(GemmArgs g) {
    __shared__ float As[16][68], Bs[16][68], Bs2[16][68];
    const int tid = threadIdx.x, tx = tid & 15, ty = tid >> 4;
    const int row0 = blockIdx.y * 64, col0 = blockIdx.x * 64;
    const float* W = g.W; const float* W2 = g.W2;
    if (MODE == 3 || MODE == 4) { int base[NE]; const int total = moe_bases(g.cnt, base); if (row0 >= total) return; int e = 0;
#pragma unroll
        for (int c = 1; c < NE; ++c) if (row0 >= base[c]) e = c;
        W += (size_t)e * g.K * g.ldw; if (MODE == 3) W2 += (size_t)e * g.K * g.ldw; }
    int wcol0 = col0; if (MODE == 0) wcol0 = col0 + (col0 >= 1792 ? 8 : 0);
    float acc[4][4], acc2[4][4];
#pragma unroll
    for (int i = 0; i < 4; ++i)
#pragma unroll
        for (int j = 0; j < 4; ++j) { acc[i][j] = 0.f; acc2[i][j] = 0.f; }
    const int ar = tid >> 2, akq = (tid & 3) * 4, bk = tid >> 4, bc = (tid & 15) * 4;
    for (int k0 = 0; k0 < g.K; k0 += 16) {
        { const uint2 w = *(const uint2*)(g.A + (size_t)(row0 + ar) * g.lda + k0 + akq);
          As[akq + 0][ar] = bf2f((bf16_t)(w.x & 0xffff)); As[akq + 1][ar] = bf2f((bf16_t)(w.x >> 16)); As[akq + 2][ar] = bf2f((bf16_t)(w.y & 0xffff)); As[akq + 3][ar] = bf2f((bf16_t)(w.y >> 16)); }
        { const float4 b = *(const float4*)(W + (size_t)(k0 + bk) * g.ldw + wcol0 + bc); *(float4*)&Bs[bk][bc] = b; }
        if (MODE == 2 || MODE == 3) { const float4 b = *(const float4*)(W2 + (size_t)(k0 + bk) * g.ldw + wcol0 + bc); *(float4*)&Bs2[bk][bc] = b; }
        __syncthreads();
#pragma unroll
        for (int kk = 0; kk < 16; ++kk) {
            const float4 a4 = *(const float4*)&As[kk][ty * 4]; const float4 b4 = *(const float4*)&Bs[kk][tx * 4];
            const float av[4] = {a4.x, a4.y, a4.z, a4.w}, bv[4] = {b4.x, b4.y, b4.z, b4.w};
#pragma unroll
            for (int i = 0; i < 4; ++i)
#pragma unroll
                for (int j = 0; j < 4; ++j) acc[i][j] += av[i] * bv[j];
            if (MODE == 2 || MODE == 3) { const float4 c4 = *(const float4*)&Bs2[kk][tx * 4]; const float cv[4] = {c4.x, c4.y, c4.z, c4.w};
#pragma unroll
                for (int i = 0; i < 4; ++i)
#pragma unroll
                    for (int j = 0; j < 4; ++j) acc2[i][j] += av[i] * cv[j]; }
        }
        __syncthreads();
    }
#pragma unroll
    for (int i = 0; i < 4; ++i) { const int row = row0 + ty * 4 + i, col = col0 + tx * 4;
        if (MODE == 1) { float4* xp = (float4*)(g.X + (size_t)row * D + col); float4 x = *xp; x.x += acc[i][0]; x.y += acc[i][1]; x.z += acc[i][2]; x.w += acc[i][3]; *xp = x; }
        else { float o[4];
#pragma unroll
            for (int j = 0; j < 4; ++j) { float v = acc[i][j];
                if (MODE == 0 && col >= P_FQ && col < P_FK) v *= QSCALE;
                if (MODE == 2 || MODE == 3) v = siluf_(v) * acc2[i][j];
                o[j] = v; }
            uint2 w; w.x = (unsigned)f2bf(o[0]) | ((unsigned)f2bf(o[1]) << 16); w.y = (unsigned)f2bf(o[2]) | ((unsigned)f2bf(o[3]) << 16);
            *(uint2*)(g.O + (size_t)row * g.ldo + col) = w; }
    }
}

__global__ void __launch_bounds__(256) k_hgrn_naive(const bf16_t* P, const float* lb_raw, int layer, float* OT) {
    const int b = blockIdx.x >> 4, h = (blockIdx.x >> 2) & 3, vg = blockIdx.x & 3, w = threadIdx.x >> 6, lane = threadIdx.x & 63;
    const int ch = h * 64 + lane, v0 = vg * 16 + w * 4;
    const float lb = layer == 0 ? 0.f : 1.f / (1.f + __expf(lb_raw[ch] - lb_raw[256 + ch]));
    float S[4] = {0.f, 0.f, 0.f, 0.f};
    const bf16_t* Pr = P + (size_t)b * SEQ * PW;
    float qn = bf2f(Pr[P_HQ + ch]), fn = bf2f(Pr[P_HF + ch]); uint2 in = *(const uint2*)(Pr + P_HI + h * 64 + v0);
    for (int t = 0; t < SEQ; ++t) {
        const float q = qn, fz = fn; const uint2 iw = in;
        if (t + 1 < SEQ) { const bf16_t* Pn = Pr + (size_t)(t + 1) * PW; qn = bf2f(Pn[P_HQ + ch]); fn = bf2f(Pn[P_HF + ch]); in = *(const uint2*)(Pn + P_HI + h * 64 + v0); }
        const float sg = sigmoidf_(fz), f = lb + (1.f - lb) * sg, k = (1.f - lb) * (1.f - sg);
        const float iv[4] = {bf2f((bf16_t)(iw.x & 0xffff)), bf2f((bf16_t)(iw.x >> 16)), bf2f((bf16_t)(iw.y & 0xffff)), bf2f((bf16_t)(iw.y >> 16))};
        float o[4];
#pragma unroll
        for (int j = 0; j < 4; ++j) { S[j] = f * S[j] + k * iv[j]; o[j] = wave_sum(S[j] * q); }
        if (lane == 0) *(float4*)(OT + ((size_t)b * SEQ + t) * 512 + h * 64 + v0) = make_float4(o[0], o[1], o[2], o[3]);
    }
}
__global__ void __launch_bounds__(256) k_mlstm_naive(const bf16_t* P, const float* G, const float* conv, const float* b_i, const float* b_f, float* OT) {
    const int b = blockIdx.x >> 4, h = (blockIdx.x >> 2) & 3, vg = blockIdx.x & 3, w = threadIdx.x >> 6, lane = threadIdx.x & 63;
    const int ch = h * 64 + lane, v0 = vg * 16 + w * 4;
    float wq[4], wk[4];
#pragma unroll
    for (int j = 0; j < 4; ++j) { wq[j] = conv[j * 512 + ch]; wk[j] = conv[j * 512 + 256 + ch]; }
    const float bi = b_i[h], bf = b_f[h];
    float C[4] = {0.f, 0.f, 0.f, 0.f}, n = 0.f;
    float q0 = 0.f, q1 = 0.f, q2 = 0.f, k0 = 0.f, k1 = 0.f, k2 = 0.f;
    const bf16_t* Pr = P + (size_t)b * SEQ * PW; const float* Gr = G + (size_t)b * SEQ * GW;
    for (int t = 0; t < SEQ; ++t) {
        const bf16_t* Pt = Pr + (size_t)t * PW;
        const float q3 = bf2f(Pt[P_MQ + ch]), k3 = bf2f(Pt[P_MK + ch]); const uint2 vw = *(const uint2*)(Pt + P_MV + h * 64 + v0);
        const float ig = Gr[(size_t)t * GW + h], fg = Gr[(size_t)t * GW + 4 + h];
        const float qc = siluf_(wq[0] * q0 + wq[1] * q1 + wq[2] * q2 + wq[3] * q3);
        const float kc = siluf_(wk[0] * k0 + wk[1] * k1 + wk[2] * k2 + wk[3] * k3) * 0.125f;
        q0 = q1; q1 = q2; q2 = q3; k0 = k1; k1 = k2; k2 = k3;
        const float iv = __expf(ig + bi), f = sigmoidf_(fg + bf);
        const float vv[4] = {bf2f((bf16_t)(vw.x & 0xffff)), bf2f((bf16_t)(vw.x >> 16)), bf2f((bf16_t)(vw.y & 0xffff)), bf2f((bf16_t)(vw.y >> 16))};
        n = f * n + iv * kc; const float den = wave_sum(n * qc); const float dd = fmaxf(fabsf(den), 1.f);
        float o[4];
#pragma unroll
        for (int j = 0; j < 4; ++j) { C[j] = f * C[j] + iv * kc * vv[j]; o[j] = wave_sum(C[j] * qc) / dd; }
        if (lane == 0) *(float4*)(OT + ((size_t)b * SEQ + t) * 512 + 256 + h * 64 + v0) = make_float4(o[0], o[1], o[2], o[3]);
    }
}
__global__ void __launch_bounds__(256) k_headnorm_naive(const float* OT, const bf16_t* P, const float* hg_gain, const float* ml_gain, bf16_t* MIX) {
    const int gw = blockIdx.x * 4 + (threadIdx.x >> 6), lane = threadIdx.x & 63, row = gw >> 3, hs = gw & 7;
    const float v = OT[(size_t)row * 512 + hs * 64 + lane];
    const float ms = wave_sum(v * v) * (1.f / 64.f);
    float y = v * rsqrtf(ms + EPS);
    if (hs < 4) { y *= hg_gain[hs * 64 + lane] * siluf_(bf2f(P[(size_t)row * PW + P_HG + hs * 64 + lane])); }
    else { y *= ml_gain[(hs - 4) * 64 + lane] * sigmoidf_(bf2f(P[(size_t)row * PW + P_MO + (hs - 4) * 64 + lane])); }
    MIX[(size_t)row * D + hs * 64 + lane] = f2bf(y);
}
__global__ void __launch_bounds__(256) k_fox_cumsum(const float* G, const float* b_f, float* CF) {
    __shared__ float part[256];
    const int b = blockIdx.x >> 3, h = blockIdx.x & 7, tid = threadIdx.x; const float bf = b_f[h];
    float loc[32]; float s = 0.f;
#pragma unroll
    for (int i = 0; i < 32; ++i) { const int t = tid * 32 + i; s += log_sigmoidf_(G[((size_t)b * SEQ + t) * GW + 8 + h] + bf); loc[i] = s; }
    part[tid] = s; __syncthreads();
    float off = 0.f; for (int j = 0; j < tid; ++j) off += part[j];
#pragma unroll
    for (int i = 0; i < 32; ++i) CF[(size_t)blockIdx.x * SEQ + tid * 32 + i] = (off + loc[i]) * LOG2E;
}
__global__ void __launch_bounds__(256) k_attn_naive(const bf16_t* P, const float* CF, bf16_t* MIX) {
    __shared__ bf16_t Ks[64][64], Vs[64][64]; __shared__ float cs[64];
    const int bh = blockIdx.x >> 5, qb = blockIdx.x & 31, b = bh >> 3, h = bh & 7, tid = threadIdx.x, t = qb * 256 + tid;
    const bf16_t* Pr = P + (size_t)b * SEQ * PW; const float* cf = CF + (size_t)bh * SEQ;
    float q[64], o[64];
#pragma unroll
    for (int d = 0; d < 64; ++d) { q[d] = bf2f(Pr[(size_t)t * PW + P_FQ + h * 64 + d]); o[d] = 0.f; }
    const float cq = cf[t]; float m = -INFINITY, l = 0.f;
    const int NT = qb * 4 + 4;
    for (int kt = 0; kt < NT; ++kt) {
        __syncthreads();
        { const int r = tid >> 2, c = (tid & 3) * 16; const bf16_t* kr = Pr + (size_t)(kt * 64 + r) * PW + h * 64 + c;
          *(uint4*)&Ks[r][c] = *(const uint4*)(kr + P_FK); *(uint4*)&Ks[r][c + 8] = *(const uint4*)(kr + P_FK + 8);
          *(uint4*)&Vs[r][c] = *(const uint4*)(kr + P_FV); *(uint4*)&Vs[r][c + 8] = *(const uint4*)(kr + P_FV + 8);
          if (tid < 64) cs[tid] = cf[kt * 64 + tid]; }
        __syncthreads();
        for (int j = 0; j < 64; ++j) {
            if (kt * 64 + j > t) break;
            float s = 0.f;
#pragma unroll
            for (int d = 0; d < 64; ++d) s += q[d] * bf2f(Ks[j][d]);
            s += cq - cs[j];
            const float mn = fmaxf(m, s), al = exp2f(m - mn), p = exp2f(s - mn);
            l = l * al + p; m = mn;
#pragma unroll
            for (int d = 0; d < 64; ++d) o[d] = o[d] * al + p * bf2f(Vs[j][d]);
        }
    }
    const float il = 1.f / l;
#pragma unroll
    for (int d = 0; d < 64; d += 2) *(unsigned*)(MIX + ((size_t)b * SEQ + t) * D + 512 + h * 64 + d) = (unsigned)f2bf(o[d] * il) | ((unsigned)f2bf(o[d + 1] * il) << 16);
}
__global__ void __launch_bounds__(256) k_gather(const bf16_t* H, const int* cnt, const int* toklist, bf16_t* XG) {
    const int r = blockIdx.x * 4 + (threadIdx.x >> 6), lane = threadIdx.x & 63;
    int base[NE]; const int total = moe_bases(cnt, base); if (r >= total) return;
    int e = 0, be = 0;
#pragma unroll
    for (int c = 1; c < NE; ++c) if (r >= base[c]) { e = c; be = base[c]; }
    const int s = r - be;
    uint4 v0 = make_uint4(0, 0, 0, 0), v1 = v0;
    if (s < cnt[e]) { const int tok = toklist[e * NTOK + s]; const uint4* src = (const uint4*)(H + (size_t)tok * D); v0 = src[lane]; v1 = src[64 + lane]; }
    uint4* dst = (uint4*)(XG + (size_t)r * D); dst[lane] = v0; dst[64 + lane] = v1;
}
__global__ void __launch_bounds__(256) k_final(float* X, const bf16_t* Y, const int* cnt, const int4* tokinfo, const float2* tgate, const float* gain, int moe) {
    const int row = blockIdx.x * 4 + (threadIdx.x >> 6), lane = threadIdx.x & 63;
    float4* xr = (float4*)(X + (size_t)row * D) + lane;
    float4 v[4];
#pragma unroll
    for (int j = 0; j < 4; ++j) v[j] = xr[64 * j];
    if (moe) { int base[NE]; moe_bases(cnt, base); const int4 ti = tokinfo[row]; const float2 tg = tgate[row];
        int b0 = 0, b1 = 0;
#pragma unroll
        for (int c = 0; c < NE; ++c) { if (c == ti.x) b0 = base[c]; if (c == ti.z) b1 = base[c]; }
        const bf16_t* y0 = Y + (size_t)(b0 + ti.y) * D; const bf16_t* y1 = Y + (size_t)(b1 + ti.w) * D;
#pragma unroll
        for (int j = 0; j < 4; ++j) { const uint2 a = *((const uint2*)y0 + 64 * j + lane), c = *((const uint2*)y1 + 64 * j + lane);
            v[j].x += tg.x * bf2f((bf16_t)(a.x & 0xffff)) + tg.y * bf2f((bf16_t)(c.x & 0xffff)); v[j].y += tg.x * bf2f((bf16_t)(a.x >> 16)) + tg.y * bf2f((bf16_t)(c.x >> 16));
            v[j].z += tg.x * bf2f((bf16_t)(a.y & 0xffff)) + tg.y * bf2f((bf16_t)(c.y & 0xffff)); v[j].w += tg.x * bf2f((bf16_t)(a.y >> 16)) + tg.y * bf2f((bf16_t)(c.y >> 16)); } }
    float ss = 0.f;
#pragma unroll
    for (int j = 0; j < 4; ++j) ss += v[j].x * v[j].x + v[j].y * v[j].y + v[j].z * v[j].z + v[j].w * v[j].w;
    ss = wave_sum(ss); const float r = rsqrtf(ss * (1.f / D) + EPS);
#pragma unroll
    for (int j = 0; j < 4; ++j) { const float4 g = *((const float4*)gain + 64 * j + lane); xr[64 * j] = make_float4(v[j].x * r * g.x, v[j].y * r * g.y, v[j].z * r * g.z, v[j].w * r * g.w); }
}

#ifndef MEGA_MASK
#define MEGA_MASK 0x1FFFFFu
#endif
#ifndef FUSE_RUNS
#define FUSE_RUNS 1
#endif
extern "C" void kernel_launch(void* const* d_in, const int* in_sizes, int n_in, void* d_out, int out_size, void* d_ws, size_t ws_size, hipStream_t stream) {
    static int grid = 0;
    if (grid == 0) {
        if (n_in != 20 || ws_size < WS_END || out_size != NTOK * D) { fprintf(stderr, "kernel_launch: unexpected n_in %d / ws %zu / out %d\n", n_in, ws_size, out_size); grid = -1; return; }
        int dev = 0, cus = 0, per_cu = 0;
        if (hipGetDevice(&dev) != hipSuccess || hipDeviceGetAttribute(&cus, hipDeviceAttributeMultiprocessorCount, dev) != hipSuccess) { grid = -1; return; }
        if (hipFuncSetAttribute((const void*)mega, hipFuncAttributeMaxDynamicSharedMemorySize, LDS_BYTES) != hipSuccess) { fprintf(stderr, "kernel_launch: hipFuncSetAttribute failed\n"); grid = -1; return; }
        if (hipOccupancyMaxActiveBlocksPerMultiprocessor(&per_cu, (const void*)mega, NTHR, LDS_BYTES) != hipSuccess || per_cu < 1) { fprintf(stderr, "kernel_launch: occupancy query says %d\n", per_cu); per_cu = 1; }
        (void)hipGetLastError();
        grid = cus;
        if (grid > 256) grid = 256;
    }
    if (grid < 0) return;
    const float* const* in = (const float* const*)d_in;
    unsigned char* ws = (unsigned char*)d_ws; float* X = (float*)d_out;
    int* ctl = (int*)(ws + WS_CTL); int* cnt = ctl + CW_CNT;
    float* G = (float*)(ws + WS_G); float* CF = (float*)(ws + WS_CF); int4* tokinfo = (int4*)(ws + WS_TOKINFO); float2* tgate = (float2*)(ws + WS_TGATE); int* toklist = (int*)(ws + WS_TOKLIST);
    bf16_t* P = (bf16_t*)(ws + WS_P); float* OT = (float*)(ws + WS_SCAN); bf16_t* HID = (bf16_t*)(ws + WS_HID); bf16_t* H = (bf16_t*)(ws + WS_H); bf16_t* MIX = (bf16_t*)(ws + WS_MIX);
    bf16_t* XG = (bf16_t*)(ws + WS_XG); bf16_t* Y = (bf16_t*)(ws + WS_Y);
    (void)hipMemsetAsync(ws + WS_CTL, 0, CTL_BYTES, stream);
    MArgs ma; memset(&ma, 0, sizeof ma);
    for (int i = 0; i < 20; ++i) ma.in[i] = in[i];
    ma.out = X; ma.ws = ws;
    int p = 0;
    while (p < N_PHASES) {
        if ((MEGA_MASK >> p) & 1u) {
            int q = p + 1;
            if (FUSE_RUNS) while (q < N_PHASES && ((MEGA_MASK >> q) & 1u)) ++q;
            ma.ph_lo = p; ma.ph_hi = q;
            hipLaunchKernelGGL(mega, dim3(grid), dim3(NTHR), LDS_BYTES, stream, ma);
            p = q; continue;
        }
        const int l = p >= 10 ? 1 : 0, k = p == 0 ? -1 : (l ? p - 10 : p - 1);
        if (p == 0 || (l == 0 && k == 8)) { const int ll = p == 0 ? 0 : 1; RowArgs ra; memset(&ra, 0, sizeof ra); ra.src = ll == 0 ? in[I_X] : X; ra.X = X; ra.H = H; ra.gain = in[I_ATTN_NORM] + ll * D; ra.w_in = in[I_W_IN] + (size_t)ll * D * DIN; ra.G = G;
            k_rowpass<0><<<NTOK / 4, 256, 0, stream>>>(ra); }
        else if (k == 0) { GemmArgs g0; memset(&g0, 0, sizeof g0); g0.A = H; g0.lda = D; g0.W = in[I_W_IN] + (size_t)l * D * DIN; g0.ldw = DIN; g0.K = D; g0.O = P; g0.ldo = PW;
            k_gemm_naive<0><<<dim3(PW / 64, NTOK / 64), 256, 0, stream>>>(g0); }
        else if (k == 1) { k_fox_cumsum<<<16, 256, 0, stream>>>(G, in[I_FOX_BF] + l * 8, CF); }
        else if (k == 2) { k_attn_naive<<<512, 256, 0, stream>>>(P, CF, MIX); }
        else if (k == 3) { k_hgrn_naive<<<32, 256, 0, stream>>>(P, in[I_HGRN_LB], l, OT);
            k_mlstm_naive<<<32, 256, 0, stream>>>(P, G, in[I_MLSTM_CONV] + l * 4 * 512, in[I_MLSTM_BI] + l * 4, in[I_MLSTM_BF] + l * 4, OT);
            k_headnorm_naive<<<NTOK * 8 / 4, 256, 0, stream>>>(OT, P, in[I_HGRN_NORM] + l * 256, in[I_MLSTM_NORM] + l * 256, MIX); }
        else if (k == 4) { GemmArgs g1; memset(&g1, 0, sizeof g1); g1.A = MIX; g1.lda = D; g1.W = in[I_W_OUT] + (size_t)l * D * D; g1.ldw = D; g1.K = D; g1.X = X;
            k_gemm_naive<1><<<dim3(D / 64, NTOK / 64), 256, 0, stream>>>(g1); }
        else if (k == 5) { RowArgs rb; memset(&rb, 0, sizeof rb); rb.src = X; rb.X = X; rb.H = H; rb.gain = in[I_FFN_NORM] + l * D; rb.router = in[I_ROUTER]; rb.cnt = cnt; rb.toklist = toklist; rb.tokinfo = tokinfo; rb.tgate = tgate;
            if (l == 0) k_rowpass<1><<<NTOK / 4, 256, 0, stream>>>(rb); else k_rowpass<2><<<NTOK / 4, 256, 0, stream>>>(rb); }
        else if (l == 0 && k == 6) { GemmArgs g2; memset(&g2, 0, sizeof g2); g2.A = H; g2.lda = D; g2.W = in[I_DGATE]; g2.W2 = in[I_DUP]; g2.ldw = FF; g2.K = D; g2.O = HID; g2.ldo = FF;
            k_gemm_naive<2><<<dim3(FF / 64, NTOK / 64), 256, 0, stream>>>(g2); }
        else if (l == 0 && k == 7) { GemmArgs g3; memset(&g3, 0, sizeof g3); g3.A = HID; g3.lda = FF; g3.W = in[I_DDOWN]; g3.ldw = D; g3.K = FF; g3.X = X;
            k_gemm_naive<1><<<dim3(D / 64, NTOK / 64), 256, 0, stream>>>(g3); }
        else if (l == 1 && k == 6) { k_gather<<<MAXROWS / 4, 256, 0, stream>>>(H, cnt, toklist, XG); }
        else if (l == 1 && k == 7) { GemmArgs g2; memset(&g2, 0, sizeof g2); g2.A = XG; g2.lda = D; g2.W = in[I_MGATE]; g2.W2 = in[I_MUP]; g2.ldw = FE; g2.K = D; g2.O = HID; g2.ldo = FE; g2.cnt = cnt;
            k_gemm_naive<3><<<dim3(FE / 64, MAXROWS / 64), 256, 0, stream>>>(g2); }
        else if (l == 1 && k == 8) { }
        else if (l == 1 && k == 9) { GemmArgs g3; memset(&g3, 0, sizeof g3); g3.A = HID; g3.lda = FE; g3.W = in[I_MDOWN]; g3.ldw = D; g3.K = FE; g3.O = Y; g3.ldo = D; g3.cnt = cnt;
            k_gemm_naive<4><<<dim3(D / 64, MAXROWS / 64), 256, 0, stream>>>(g3); }
        else if (l == 1 && k == 10) { k_final<<<NTOK / 4, 256, 0, stream>>>(X, Y, cnt, tokinfo, tgate, in[I_FINAL_NORM], 1); }
        ++p;
    }
}
```

```cpp
#include <hip/hip_runtime.h>
#include <hip/hip_bf16.h>
#include <cstdint>
#include <cstdio>
#include <cstring>

namespace cfg {
constexpr int NTOK = 16384, D = 1024, SEQ = 8192, NB = 2, DIN = 3600, PW = 3584, GW = 16;
constexpr int FF = 2816, FE = 3584, NE = 8, MAXROWS = 34816;
constexpr float EPS = 1e-6f;
constexpr float LOG2E = 1.4426950408889634f;
constexpr float QSCALE = 0.125f * LOG2E;
constexpr int P_HQ = 0, P_HF = 256, P_HI = 512, P_HG = 768, P_MQ = 1024, P_MK = 1280, P_MV = 1536, P_MO = 1792, P_FQ = 2048, P_FK = 2560, P_FV = 3072;
constexpr size_t MiB = 1u << 20;
constexpr size_t WS_CTL = 0, CTL_BYTES = 1 * MiB;
constexpr size_t WS_G = 2 * MiB;
constexpr size_t WS_CF = 3 * MiB;
constexpr size_t WS_TOKINFO = 3 * MiB + 512 * 1024;
constexpr size_t WS_TGATE = 3 * MiB + 768 * 1024;
constexpr size_t WS_TOKLIST = 4 * MiB;
constexpr size_t WS_P = 8 * MiB;
constexpr size_t WS_SCAN = 120 * MiB;
constexpr size_t WS_HID = 8 * MiB;
constexpr size_t WS_H = 246 * MiB;
constexpr size_t WS_MIX = 278 * MiB;
constexpr size_t WS_XG = 278 * MiB;
constexpr size_t WS_W = 346 * MiB;
constexpr size_t WS_Y = 346 * MiB;
constexpr size_t WS_END = 466 * MiB;
constexpr int CW_CNT = 64;
}
using namespace cfg;
typedef unsigned short bf16_t;

__device__ __forceinline__ bf16_t f2bf(float f) { unsigned u = __builtin_bit_cast(unsigned, f); return (bf16_t)((u + 0x7fffu + ((u >> 16) & 1u)) >> 16); }
__device__ __forceinline__ float bf2f(bf16_t h) { return __builtin_bit_cast(float, (unsigned)h << 16); }
__device__ __forceinline__ float wave_sum(float v) {
#pragma unroll
    for (int o = 1; o < 64; o <<= 1) v += __shfl_xor(v, o);
    return v;
}
__device__ __forceinline__ float sigmoidf_(float z) { return 1.f / (1.f + __expf(-z)); }
__device__ __forceinline__ float siluf_(float z) { return z / (1.f + __expf(-z)); }
__device__ __forceinline__ float log_sigmoidf_(float z) { return fminf(z, 0.f) - log1pf(__expf(-fabsf(z))); }

__device__ __forceinline__ int moe_bases(const int* cnt, int* base) {
    int acc = 0;
#pragma unroll
    for (int e = 0; e < NE; ++e) { base[e] = acc; acc += (cnt[e] + 255) & ~255; }
    return acc;
}

namespace pg8 {
#define PG8_LAS __attribute__((address_space(3)))
typedef unsigned short bf16_t;
typedef short bf16x8 __attribute__((ext_vector_type(8)));
typedef float f32x4 __attribute__((ext_vector_type(4)));
typedef unsigned u32x4 __attribute__((ext_vector_type(4)));
constexpr int BM = 256, BK = 64, HALF = 128, HTB = HALF * BK * 2  , STAGE_BYTES = 8 * HTB, NXCD = 8, WGM = 8;

__host__ __device__ __forceinline__ int lds_byte(int r, int c) { const int st = (r >> 4) * 2 + (c >> 5), rr = r & 15, cc = c & 31, ob = rr * 64 + cc * 2; return st * 1024 + (ob ^ (((ob >> 9) & 1) << 5)); }
__host__ __device__ __forceinline__ void stage_rc(int b, int& R, int& C) { const int st = b / 1024, sb = b % 1024, swz = sb ^ (((sb >> 9) & 1) << 5); R = (st >> 1) * 16 + swz / 64; C = (st & 1) * 32 + (swz % 64) / 2; }
__host__ __device__ __forceinline__ int perm32(int rho) { const int n = rho >> 4, i = rho & 15; return 8 * (i >> 2) + 4 * n + (i & 3); }

struct Unit { int pm, pn; };
struct Gemm { int K; };

struct StaticOrder {
    int nM, nN, nwg, G, c;
    __host__ __device__ void init(int M, int N, int G_, int c_) { nM = M / BM; nN = N / BM; nwg = nM * nN; G = G_; c = c_; }
    __host__ __device__ bool next(int i, Unit& u) const {
        const long L = (long)i * G + c; if (L >= nwg) return false;
        int wgid = (int)L; { const int q = nwg / NXCD, r = nwg % NXCD, xcd = wgid % NXCD, off = wgid / NXCD; wgid = (xcd < r ? xcd * (q + 1) : r * (q + 1) + (xcd - r) * q) + off; }
        const int nig = WGM * nN, gid = wgid / nig, fm = gid * WGM, gsz = (nM - fm) < WGM ? (nM - fm) : WGM;
        u.pm = fm + ((wgid % nig) % gsz); u.pn = (wgid % nig) / gsz; return true;
    }
    __device__ __forceinline__ void a_ready(const Unit&) const {}
    __device__ __forceinline__ void done(const Unit&) const {}
};

__device__ __forceinline__ unsigned cvt_pk_bf16(float lo, float hi) { unsigned r; asm volatile("v_cvt_pk_bf16_f32 %0, %1, %2" : "=v"(r) : "v"(lo), "v"(hi)); return r; }
typedef int i32x4 __attribute__((ext_vector_type(4)));
template <bool I8> struct AccT { typedef f32x4 type; };
template <> struct AccT<true> { typedef i32x4 type; };
__device__ __forceinline__ f32x4 mma_sel(bf16x8 b, bf16x8 a, f32x4 c) { return __builtin_amdgcn_mfma_f32_16x16x32_bf16(b, a, c, 0, 0, 0); }
__device__ __forceinline__ i32x4 mma_sel(bf16x8 b, bf16x8 a, i32x4 c) { return __builtin_amdgcn_mfma_i32_16x16x64_i8(__builtin_bit_cast(i32x4, b), __builtin_bit_cast(i32x4, a), c, 0, 0, 0); }
struct EpiBf {
    static constexpr bool PERM = true, AFTER_DRAIN = false;
    bf16_t* O; int ldc; int s_lo, s_hi; float scale;
    __device__ __forceinline__ void operator()(const f32x4 (&acc)[2][2][4][2], const Unit& u, int wr, int wc, int fr, int fq) const {
        const int row0 = u.pm * BM + wr * 64 + fr, col0 = u.pn * BM + wc * 32 + 8 * fq;
        const float sc = (u.pn >= s_lo && u.pn < s_hi) ? scale : 1.f;
#pragma unroll
        for (int ai = 0; ai < 2; ++ai)
#pragma unroll
            for (int m = 0; m < 4; ++m) { bf16_t* rowp = O + (size_t)(row0 + ai * HALF + m * 16) * ldc + col0;
#pragma unroll
                for (int bj = 0; bj < 2; ++bj) { const f32x4 v0 = acc[ai][bj][m][0] * sc, v1 = acc[ai][bj][m][1] * sc;
                    u32x4 w; w.x = cvt_pk_bf16(v0[0], v0[1]); w.y = cvt_pk_bf16(v0[2], v0[3]); w.z = cvt_pk_bf16(v1[0], v1[1]); w.w = cvt_pk_bf16(v1[2], v1[3]);
                    *(u32x4*)(rowp + bj * HALF) = w; } }
    }
};
__device__ __forceinline__ float silu_mul(float g, float u) { return g * __builtin_amdgcn_rcpf(1.f + __expf(-g)) * u; }
struct EpiSwiglu {
    static constexpr bool PERM = true, AFTER_DRAIN = false;
    bf16_t* O; int ldc;
    __device__ __forceinline__ void operator()(const f32x4 (&acc)[2][2][4][2], const Unit& u, int wr, int wc, int fr, int fq) const {
        const int row0 = u.pm * BM + wr * 64 + fr, col0 = u.pn * HALF + wc * 32 + 8 * fq;
#pragma unroll
        for (int ai = 0; ai < 2; ++ai)
#pragma unroll
            for (int m = 0; m < 4; ++m) { bf16_t* rowp = O + (size_t)(row0 + ai * HALF + m * 16) * ldc + col0;
                const f32x4 g0 = acc[ai][0][m][0], g1 = acc[ai][0][m][1], u0 = acc[ai][1][m][0], u1 = acc[ai][1][m][1];
                u32x4 w; w.x = cvt_pk_bf16(silu_mul(g0[0], u0[0]), silu_mul(g0[1], u0[1])); w.y = cvt_pk_bf16(silu_mul(g0[2], u0[2]), silu_mul(g0[3], u0[3]));
                w.z = cvt_pk_bf16(silu_mul(g1[0], u1[0]), silu_mul(g1[1], u1[1])); w.w = cvt_pk_bf16(silu_mul(g1[2], u1[2]), silu_mul(g1[3], u1[3]));
                *(u32x4*)rowp = w; }
    }
};
struct EpiResid {
    static constexpr bool PERM = false, AFTER_DRAIN = false;
    float* X; int ldc;
    __device__ __forceinline__ void operator()(const f32x4 (&acc)[2][2][4][2], const Unit& u, int wr, int wc, int fr, int fq) const {
        const int row0 = u.pm * BM + wr * 64 + fr, col0 = u.pn * BM + wc * 32 + 4 * fq;
#pragma unroll
        for (int ai = 0; ai < 2; ++ai)
#pragma unroll
            for (int m = 0; m < 4; ++m) { float* rowp = X + (size_t)(row0 + ai * HALF + m * 16) * ldc + col0;
#pragma unroll
                for (int bj = 0; bj < 2; ++bj)
#pragma unroll
                    for (int n = 0; n < 2; ++n) { f32x4* p = (f32x4*)(rowp + bj * HALF + n * 16); *p = *p + acc[ai][bj][m][n]; }
                asm volatile("" ::: "memory"); }
    }
};
struct EpiBf8 {
    static constexpr bool PERM = true, AFTER_DRAIN = false;
    bf16_t* O; int ldc; int s_lo, s_hi; float scale; const float* sA; const float* sB;
    __device__ __forceinline__ void operator()(const i32x4 (&acc)[2][2][4][2], const Unit& u, int wr, int wc, int fr, int fq) const {
        const int row0 = u.pm * BM + wr * 64 + fr, col0 = u.pn * BM + wc * 32 + 8 * fq;
        const float sc = (u.pn >= s_lo && u.pn < s_hi) ? scale : 1.f;
        f32x4 cb[2][2];
#pragma unroll
        for (int bj = 0; bj < 2; ++bj)
#pragma unroll
            for (int n = 0; n < 2; ++n) cb[bj][n] = *(const f32x4*)(sB + col0 + bj * HALF + 4 * n) * sc;
#pragma unroll
        for (int ai = 0; ai < 2; ++ai)
#pragma unroll
            for (int m = 0; m < 4; ++m) { const int row = row0 + ai * HALF + m * 16; const float ra = sA[row]; bf16_t* rowp = O + (size_t)row * ldc + col0;
#pragma unroll
                for (int bj = 0; bj < 2; ++bj) { const f32x4 v0 = __builtin_convertvector(acc[ai][bj][m][0], f32x4) * cb[bj][0] * ra, v1 = __builtin_convertvector(acc[ai][bj][m][1], f32x4) * cb[bj][1] * ra;
                    u32x4 w; w.x = cvt_pk_bf16(v0[0], v0[1]); w.y = cvt_pk_bf16(v0[2], v0[3]); w.z = cvt_pk_bf16(v1[0], v1[1]); w.w = cvt_pk_bf16(v1[2], v1[3]);
                    *(u32x4*)(rowp + bj * HALF) = w; } }
    }
};
struct EpiSwiglu8 {
    static constexpr bool PERM = true, AFTER_DRAIN = false;
    bf16_t* O; int ldc; const float* sA; const float* sB; int sb_exp; int tb1, tb2, tb3, tb4, tb5, tb6, tb7;
    __device__ __forceinline__ void operator()(const i32x4 (&acc)[2][2][4][2], const Unit& u, int wr, int wc, int fr, int fq) const {
        const int row0 = u.pm * BM + wr * 64 + fr, col0 = u.pn * HALF + wc * 32 + 8 * fq;
        const int e = (u.pm >= tb1) + (u.pm >= tb2) + (u.pm >= tb3) + (u.pm >= tb4) + (u.pm >= tb5) + (u.pm >= tb6) + (u.pm >= tb7);
        const float* sb = sB + (size_t)e * sb_exp + u.pn * BM + wc * 32 + 8 * fq;
        const f32x4 sg0 = *(const f32x4*)sb, sg1 = *(const f32x4*)(sb + 4), su0 = *(const f32x4*)(sb + HALF), su1 = *(const f32x4*)(sb + HALF + 4);
#pragma unroll
        for (int ai = 0; ai < 2; ++ai)
#pragma unroll
            for (int m = 0; m < 4; ++m) { const int row = row0 + ai * HALF + m * 16; const float ra = sA[row]; bf16_t* rowp = O + (size_t)row * ldc + col0;
                const f32x4 g0 = __builtin_convertvector(acc[ai][0][m][0], f32x4) * sg0 * ra, g1 = __builtin_convertvector(acc[ai][0][m][1], f32x4) * sg1 * ra;
                const f32x4 u0 = __builtin_convertvector(acc[ai][1][m][0], f32x4) * su0 * ra, u1 = __builtin_convertvector(acc[ai][1][m][1], f32x4) * su1 * ra;
                u32x4 w; w.x = cvt_pk_bf16(silu_mul(g0[0], u0[0]), silu_mul(g0[1], u0[1])); w.y = cvt_pk_bf16(silu_mul(g0[2], u0[2]), silu_mul(g0[3], u0[3]));
                w.z = cvt_pk_bf16(silu_mul(g1[0], u1[0]), silu_mul(g1[1], u1[1])); w.w = cvt_pk_bf16(silu_mul(g1[2], u1[2]), silu_mul(g1[3], u1[3]));
                *(u32x4*)rowp = w; }
    }
};
struct GOrder {
    StaticOrder so; const char* A; const char* B; size_t a_tile, b_tile, b_exp; int tb1, tb2, tb3, tb4, tb5, tb6, tb7;
    __device__ __forceinline__ bool next(int i, Unit& u) const { return so.next(i, u); }
    __device__ __forceinline__ const char* a_base(const Unit& u) const { return A + (size_t)u.pm * a_tile; }
    __device__ __forceinline__ const char* b_base(const Unit& u) const {
        const int e = (u.pm >= tb1) + (u.pm >= tb2) + (u.pm >= tb3) + (u.pm >= tb4) + (u.pm >= tb5) + (u.pm >= tb6) + (u.pm >= tb7);
        return B + (size_t)e * b_exp + (size_t)u.pn * b_tile; }
    __device__ __forceinline__ void a_ready(const Unit&) const {}
    __device__ __forceinline__ void done(const Unit&) const {}
};
template <class Epi, class Sched, bool ALIGN_EPI = false, bool SP2 = false, bool I8 = false>
__device__ __forceinline__ void gemm_phase(PG8_LAS unsigned char* lds, const Gemm g, const Sched& S, const Epi& E) {
    const int tid = threadIdx.x, wid = __builtin_amdgcn_readfirstlane(tid >> 6), lane = tid & 63, wr = wid >> 2, wc = wid & 3, fr = lane & 15, fq = lane >> 4;
    const int K = g.K, nt = K / BK;
    unsigned voffA[2], voffB[2];
#pragma unroll
    for (int i = 0; i < 2; ++i) { int R, C; stage_rc(tid * 16 + i * 8192, R, C); const int Rb = Epi::PERM ? ((R & ~31) + perm32(R & 31)) : R;
        voffA[i] = (unsigned)(R * K + C) * 2u; voffB[i] = (unsigned)(Rb * K + C) * 2u; }
    const size_t kstep = (size_t)(BK * 2);
    const size_t hstep = (size_t)HALF * K * 2;
        const unsigned ldsw = (unsigned)wid * 1024u;
    const int aoff = lds_byte(wr * 64 + fr, fq * 8), boff = lds_byte(wc * 32 + fr, fq * 8);
#define PG8_SA(b, h) (((b) * 2 + (h)) * HTB)
#define PG8_SB(b, h) ((4 + (b) * 2 + (h)) * HTB)
#define PG8_STAGE(bufoff, gbase, voff) do { _Pragma("unroll") for (int _i = 0; _i < 2; ++_i) \
        __builtin_amdgcn_global_load_lds((const unsigned*)((const char*)(gbase) + (voff)[_i]), (PG8_LAS unsigned*)(lds + (bufoff) + ldsw + _i * 8192), 16, 0, 0); } while (0)
#define PG8_LDA(dst, b, h) do { _Pragma("unroll") for (int m = 0; m < 4; ++m) _Pragma("unroll") for (int k = 0; k < 2; ++k) dst[m][k] = *(const PG8_LAS bf16x8*)(lds + PG8_SA(b, h) + aoff + m * 2048 + k * 1024); } while (0)
#define PG8_LDB(dst, b, h) do { _Pragma("unroll") for (int n = 0; n < 2; ++n) _Pragma("unroll") for (int k = 0; k < 2; ++k) dst[n][k] = *(const PG8_LAS bf16x8*)(lds + PG8_SB(b, h) + boff + n * 2048 + k * 1024); } while (0)
#define PG8_MMA(ai, bj, At, Bt) do { __builtin_amdgcn_s_setprio(1); _Pragma("unroll") for (int m = 0; m < 4; ++m) _Pragma("unroll") for (int n = 0; n < 2; ++n) _Pragma("unroll") for (int k = 0; k < 2; ++k) \
        acc[ai][bj][m][n] = mma_sel(Bt[n][k], At[m][k], acc[ai][bj][m][n]); __builtin_amdgcn_s_setprio(0); } while (0)
#define PG8_WAIT_V(n) asm volatile("s_waitcnt vmcnt(" #n ")" ::: "memory")
#define PG8_WAIT_L(n) asm volatile("s_waitcnt lgkmcnt(" #n ")" ::: "memory")
#define PG8_BAR __builtin_amdgcn_s_barrier()
#define PG8_SCHED __builtin_amdgcn_sched_barrier(0)
    Unit cur, nxt; int ui = 0;
    if (!S.next(0, cur)) return;
    typename AccT<I8>::type acc[2][2][4][2];
#pragma unroll
    for (int a = 0; a < 2; ++a)
#pragma unroll
        for (int b = 0; b < 2; ++b)
#pragma unroll
            for (int m = 0; m < 4; ++m)
#pragma unroll
                for (int n = 0; n < 2; ++n) acc[a][b][m][n] = typename AccT<I8>::type{};
    bf16x8 At[4][2], B0[2][2], B1[2][2];
    const char* cA = S.a_base(cur); const char* cB = S.b_base(cur);
    S.a_ready(cur);
    if constexpr (SP2) {
        PG8_STAGE(PG8_SB(0, 0), cB, voffB); PG8_STAGE(PG8_SB(0, 1), cB + hstep, voffB); PG8_STAGE(PG8_SA(0, 0), cA, voffA); PG8_STAGE(PG8_SA(0, 1), cA + hstep, voffA);
        if (wr == 1) PG8_BAR;
        PG8_WAIT_V(2); PG8_BAR;
        PG8_STAGE(PG8_SB(1, 0), cB + kstep, voffB); PG8_STAGE(PG8_SA(1, 0), cA + kstep, voffA); PG8_STAGE(PG8_SB(1, 1), cB + hstep + kstep, voffB);
        PG8_WAIT_V(6); PG8_BAR;
    } else {
        PG8_STAGE(PG8_SB(0, 0), cB, voffB); PG8_STAGE(PG8_SA(0, 0), cA, voffA); PG8_STAGE(PG8_SB(0, 1), cB + hstep, voffB); PG8_STAGE(PG8_SA(0, 1), cA + hstep, voffA);
        if (wr == 1) PG8_BAR;
        PG8_WAIT_V(4); PG8_BAR;
        PG8_STAGE(PG8_SB(1, 0), cB + kstep, voffB); PG8_STAGE(PG8_SA(1, 0), cA + kstep, voffA); PG8_STAGE(PG8_SB(1, 1), cB + hstep + kstep, voffB);
        PG8_WAIT_V(6); PG8_BAR;
    }
    for (;;) {
        const bool has_next = S.next(ui + 1, nxt);
        const char* nA = has_next ? S.a_base(nxt) : cA; const char* nB = has_next ? S.b_base(nxt) : cB;
        for (int t = 0; t < nt; t += 2) {
            const bool last = (t == nt - 2);
            const char* a1 = cA + (size_t)(t + 1) * kstep;
            const char* a2 = last ? nA : cA + (size_t)(t + 2) * kstep; const char* b2 = last ? nB : cB + (size_t)(t + 2) * kstep;
            const char* a3 = a2 + kstep; const char* b3 = b2 + kstep;
            if (last && has_next) S.a_ready(nxt);
            if constexpr (SP2) {
            PG8_LDB(B0, 0, 0); PG8_LDB(B1, 0, 1); PG8_SCHED; PG8_LDA(At, 0, 0); PG8_STAGE(PG8_SA(1, 1), a1 + hstep, voffA);
            PG8_WAIT_V(8); PG8_WAIT_L(0); PG8_BAR; PG8_MMA(0, 0, At, B0); PG8_MMA(0, 1, At, B1); PG8_BAR; PG8_SCHED;
            PG8_LDA(At, 0, 1); PG8_STAGE(PG8_SB(0, 0), b2, voffB); PG8_STAGE(PG8_SB(0, 1), b2 + hstep, voffB); PG8_STAGE(PG8_SA(0, 0), a2, voffA);
            PG8_WAIT_V(8); PG8_WAIT_L(0); PG8_BAR; PG8_MMA(1, 0, At, B0); PG8_MMA(1, 1, At, B1); PG8_BAR; PG8_SCHED;
            PG8_LDB(B0, 1, 0); PG8_LDB(B1, 1, 1); PG8_SCHED; PG8_LDA(At, 1, 0); PG8_STAGE(PG8_SA(0, 1), a2 + hstep, voffA);
            PG8_WAIT_V(8); PG8_WAIT_L(0); PG8_BAR; PG8_MMA(0, 0, At, B0); PG8_MMA(0, 1, At, B1); PG8_BAR; PG8_SCHED;
            PG8_LDA(At, 1, 1); PG8_STAGE(PG8_SB(1, 0), b3, voffB); PG8_STAGE(PG8_SB(1, 1), b3 + hstep, voffB); PG8_STAGE(PG8_SA(1, 0), a3, voffA);
            PG8_WAIT_V(8); PG8_WAIT_L(0); PG8_BAR; PG8_MMA(1, 0, At, B0); PG8_MMA(1, 1, At, B1); PG8_BAR; PG8_SCHED;
            } else {
            PG8_LDB(B0, 0, 0); PG8_SCHED; PG8_LDA(At, 0, 0); PG8_STAGE(PG8_SA(1, 1), a1 + hstep, voffA);
            PG8_WAIT_L(8); PG8_BAR; PG8_WAIT_L(0); PG8_MMA(0, 0, At, B0); PG8_BAR; PG8_SCHED;
            PG8_LDB(B1, 0, 1); PG8_STAGE(PG8_SB(0, 0), b2, voffB);
            PG8_BAR; PG8_WAIT_L(0); PG8_MMA(0, 1, At, B1); PG8_BAR;
            PG8_LDA(At, 0, 1); PG8_STAGE(PG8_SA(0, 0), a2, voffA);
            PG8_BAR; PG8_WAIT_L(0); PG8_MMA(1, 0, At, B0); PG8_BAR; PG8_SCHED;
            PG8_STAGE(PG8_SB(0, 1), b2 + hstep, voffB);
            PG8_WAIT_V(6); PG8_BAR; PG8_MMA(1, 1, At, B1); PG8_BAR;
            PG8_LDB(B0, 1, 0); PG8_SCHED; PG8_LDA(At, 1, 0); PG8_STAGE(PG8_SA(0, 1), a2 + hstep, voffA);
            PG8_WAIT_L(8); PG8_BAR; PG8_WAIT_L(0); PG8_MMA(0, 0, At, B0); PG8_BAR; PG8_SCHED;
            PG8_LDB(B1, 1, 1); PG8_STAGE(PG8_SB(1, 0), b3, voffB);
            PG8_BAR; PG8_WAIT_L(0); PG8_MMA(0, 1, At, B1); PG8_BAR;
            PG8_LDA(At, 1, 1); PG8_STAGE(PG8_SA(1, 0), a3, voffA);
            PG8_BAR; PG8_WAIT_L(0); PG8_MMA(1, 0, At, B0); PG8_BAR; PG8_SCHED;
            PG8_STAGE(PG8_SB(1, 1), b3 + hstep, voffB);
            PG8_WAIT_V(6); PG8_BAR; PG8_MMA(1, 1, At, B1); PG8_BAR;
            }
        }
        if constexpr (ALIGN_EPI) { if (wr == 0) PG8_BAR; }
        if constexpr (!Epi::AFTER_DRAIN) { E(acc, cur, wr, wc, fr, fq); S.done(cur); }
        if (!has_next) break;
#pragma unroll
        for (int a = 0; a < 2; ++a)
#pragma unroll
            for (int b = 0; b < 2; ++b)
#pragma unroll
                for (int m = 0; m < 4; ++m)
#pragma unroll
                    for (int n = 0; n < 2; ++n) acc[a][b][m][n] = typename AccT<I8>::type{};
        cur = nxt; cA = nA; cB = nB; ++ui;
        if constexpr (ALIGN_EPI) { if (wr == 1) PG8_BAR; }
    }
    PG8_WAIT_V(0);
    if constexpr (!ALIGN_EPI) { if (wr == 0) PG8_BAR; }
    PG8_BAR;
    if constexpr (Epi::AFTER_DRAIN) { E.fused(acc, cur, wr, wc, fr, fq, lds, wid, lane); S.done(cur); }
#undef PG8_SA
#undef PG8_SB
#undef PG8_STAGE
#undef PG8_LDA
#undef PG8_LDB
#undef PG8_MMA
#undef PG8_WAIT_V
#undef PG8_WAIT_L
#undef PG8_BAR
#undef PG8_SCHED
}
}
#include <hip/hip_bf16.h>
#include <cmath>
namespace attn_body {
using bf16=__hip_bfloat16;
using bf16x8=__attribute__((ext_vector_type(8)))short;
using s16x4=__attribute__((ext_vector_type(4)))short;
using f32x16=__attribute__((ext_vector_type(16)))float;
using u32x4=__attribute__((ext_vector_type(4)))unsigned;
constexpr int BATCH=2,NHEAD=8,SEQ=8192,D=64,DM=3584,OPITCH=1024;
constexpr int NW=8,QBLK=32,QB=QBLK*NW,KVBLK=64,NQB=SEQ/QB;
constexpr int ATTN_PITCH=DM, ATTN_UNIT_ROWS=QB;
__device__ __forceinline__ int crow(int r,int hi){return (r&3)+8*(r>>2)+4*hi;}
#define SBAR() __builtin_amdgcn_sched_barrier(0)
__device__ __forceinline__ void cmask(f32x16&p0,f32x16&p1,int jb,int qrel,int hi){
  const float NEG=-INFINITY; int kb=64*jb+4*hi;
  #pragma unroll
  for(int r=0;r<16;++r){int kv=kb+(r&3)+8*(r>>2); if(kv>qrel)p0[r]=NEG; if(kv+32>qrel)p1[r]=NEG;}
}

constexpr int NSLOT=3, SLOTB=8192;
constexpr int LDS_K=0, LDS_V=NSLOT*SLOTB, LDS_WS=2*NSLOT*SLOTB, LDS_OST=LDS_WS+NW*64*4, LDS_CK=LDS_OST+NW*4096, LDS_BYTES=LDS_CK+SEQ*4;
constexpr float C2=0.125f*1.4426950408889634f;
__device__ __forceinline__ void glds16(const void*gsrc,unsigned lds_dst){unsigned keep;
  asm volatile("s_mov_b32 %0, m0\n\ts_mov_b32 m0, %2\n\ts_nop 0\n\tglobal_load_lds_dwordx4 %1, off\n\ts_mov_b32 m0, %0":"=&s"(keep):"v"(gsrc),"s"(lds_dst):"memory");}
__device__ __forceinline__ float max3f(float a,float b,float c){float r;asm("v_max3_f32 %0, %1, %2, %3":"=v"(r):"v"(a),"v"(b),"v"(c));return r;}
__device__ __forceinline__ float max2f(float a,float b){float r;asm("v_max_f32_e32 %0, %1, %2":"=v"(r):"v"(a),"v"(b));return r;}
__device__ __forceinline__ float fadd_s(float a,float b){float r;asm("v_add_f32_e32 %0, %1, %2":"=v"(r):"v"(a),"v"(b));return r;}
__device__ __forceinline__ float fsub_s(float a,float b){float r;asm("v_sub_f32_e32 %0, %1, %2":"=v"(r):"v"(a),"v"(b));return r;}
typedef float f32x2_t __attribute__((ext_vector_type(2))); typedef float f32x4_t __attribute__((ext_vector_type(4))); typedef __bf16 bf16x2_t __attribute__((ext_vector_type(2)));
__device__ __forceinline__ unsigned cvtpk_s(float lo,float hi){f32x2_t v={lo,hi};bf16x2_t b=__builtin_convertvector(v,bf16x2_t);return __builtin_bit_cast(unsigned,b);}
#define WAIT_BAR(N) asm volatile("s_waitcnt vmcnt(" #N ") lgkmcnt(0)\n\ts_barrier":::"memory")

__device__ __forceinline__ void qkt(f32x16&p0,f32x16&p1,const char*Kslot,const bf16x8*qr,const f32x16&negm,int r32,int hi){
  const char*kb=Kslot+hi*1024+r32*16;
  #pragma unroll
  for(int d0=0;d0<4;++d0){
    const bf16x8 b0=*reinterpret_cast<const bf16x8*>(kb+d0*2048);
    const bf16x8 b1=*reinterpret_cast<const bf16x8*>(kb+d0*2048+512);
    if(d0==0){p0=__builtin_amdgcn_mfma_f32_32x32x16_bf16(b0,qr[0],negm,0,0,0);p1=__builtin_amdgcn_mfma_f32_32x32x16_bf16(b1,qr[0],negm,0,0,0);}
    else{p0=__builtin_amdgcn_mfma_f32_32x32x16_bf16(b0,qr[d0],p0,0,0,0);p1=__builtin_amdgcn_mfma_f32_32x32x16_bf16(b1,qr[d0],p1,0,0,0);}}
}
typedef __attribute__((address_space(3))) const char* lds_cptr;
typedef short v4i16_t __attribute__((ext_vector_type(4)));
__device__ __forceinline__ void kload8(bf16x8*kf,lds_cptr kp){
  kf[0]=*(const __attribute__((address_space(3))) bf16x8*)(kp);      kf[1]=*(const __attribute__((address_space(3))) bf16x8*)(kp+512);
  kf[2]=*(const __attribute__((address_space(3))) bf16x8*)(kp+2048); kf[3]=*(const __attribute__((address_space(3))) bf16x8*)(kp+2560);
  kf[4]=*(const __attribute__((address_space(3))) bf16x8*)(kp+4096); kf[5]=*(const __attribute__((address_space(3))) bf16x8*)(kp+4608);
  kf[6]=*(const __attribute__((address_space(3))) bf16x8*)(kp+6144); kf[7]=*(const __attribute__((address_space(3))) bf16x8*)(kp+6656);
}
__device__ __forceinline__ void kload2(bf16x8*kf,lds_cptr kp,int j){ kf[2*j]=*(const __attribute__((address_space(3))) bf16x8*)(kp+j*2048); kf[2*j+1]=*(const __attribute__((address_space(3))) bf16x8*)(kp+j*2048+512); }
__device__ __forceinline__ s16x4 vtr(lds_cptr p){ return __builtin_bit_cast(s16x4,__builtin_amdgcn_ds_read_tr16_b64_v4i16((__attribute__((address_space(3))) v4i16_t*)p)); }
__device__ __forceinline__ float rowmax(const f32x16&p0,const f32x16&p1){
  float a=max3f(p0[0],p0[1],p1[0]),b=max3f(p0[2],p0[3],p1[1]);a=max3f(a,p1[2],p1[3]);
  #pragma unroll
  for(int r=4;r<16;r+=4){a=max3f(a,p0[r],p0[r+1]);b=max3f(b,p0[r+2],p0[r+3]);a=max3f(a,p1[r],p1[r+1]);b=max3f(b,p1[r+2],p1[r+3]);}
  const float m=max2f(a,b);
  auto rr=__builtin_amdgcn_permlane32_swap(__float_as_uint(m),__float_as_uint(m),false,false);
  return max2f(__uint_as_float(rr[0]),__uint_as_float(rr[1]));
}
__device__ __forceinline__ void pv(f32x16*o,int vb,bf16x8 pa0,bf16x8 pa1,bf16x8 pa2,bf16x8 pa3){
  #pragma unroll
  for(int d0=0;d0<2;++d0){s16x4 lo[4],hi[4];
    #pragma unroll
    for(int ks=0;ks<4;++ks){
      asm volatile("ds_read_b64_tr_b16 %0,%1 offset:%c2":"=&v"(lo[ks]):"v"(vb),"i"(d0*4096+ks*1024):"memory");
      asm volatile("ds_read_b64_tr_b16 %0,%1 offset:%c2":"=&v"(hi[ks]):"v"(vb),"i"(d0*4096+ks*1024+512):"memory");}
    asm volatile("s_waitcnt lgkmcnt(0)":::"memory");SBAR();
    #define PK(k) (bf16x8){lo[k][0],lo[k][1],lo[k][2],lo[k][3],hi[k][0],hi[k][1],hi[k][2],hi[k][3]}
    o[d0]=__builtin_amdgcn_mfma_f32_32x32x16_bf16(pa0,PK(0),o[d0],0,0,0);
    o[d0]=__builtin_amdgcn_mfma_f32_32x32x16_bf16(pa1,PK(1),o[d0],0,0,0);
    o[d0]=__builtin_amdgcn_mfma_f32_32x32x16_bf16(pa2,PK(2),o[d0],0,0,0);
    o[d0]=__builtin_amdgcn_mfma_f32_32x32x16_bf16(pa3,PK(3),o[d0],0,0,0);
    #undef PK
  }
}

#ifndef ATTN_STORE16
#define ATTN_STORE16(p,v) (*(u32x4*)(p)=(v))
#endif
template<int THRL> __device__ __forceinline__ void attn_unit(int b,int h,int qb,const bf16*Q,const bf16*__restrict__ K,const bf16*__restrict__ V,bf16*O,const float*__restrict__ cf,char*shm){
  const int tid=threadIdx.x,lane=tid&63,r32=lane&31,hi=lane>>5; const int wid=__builtin_amdgcn_readfirstlane(tid>>6);
  const long rowbase=(long)b*SEQ; const int q0=qb*QB;
  const bf16*Qw=Q+(rowbase+q0+wid*QBLK)*DM+h*D;
  const bf16*Kh=K+rowbase*DM+h*D,*Vh=V+rowbase*DM+h*D;
  const unsigned lds0=(unsigned)(uintptr_t)shm;
  float*wsf=(float*)(shm+LDS_WS)+wid*64;
  const bf16*ksrc=Kh+(long)lane*DM+wid*8;
  const bf16*vsrc=Vh+(long)(16*(wid&3)+(lane>>2))*DM+(wid>>2)*32+(lane&3)*8;
  const unsigned kdst=lds0+LDS_K+wid*1024, vdst=lds0+LDS_V+wid*1024;
  #define DMA_K(t,slot) glds16(ksrc+(long)(t)*KVBLK*DM,(unsigned)__builtin_amdgcn_readfirstlane(kdst+(slot)))
  #define DMA_V(t,slot) glds16(vsrc+(long)(t)*KVBLK*DM,(unsigned)__builtin_amdgcn_readfirstlane(vdst+(slot)))
  const int vb0=(int)(lds0+LDS_V)+((lane>>4)&1)*32+(lane&3)*8+(4*hi+((lane&15)>>2))*64;
  const char*Kbase=shm+LDS_K; bf16x8 kf[8];
  const lds_cptr shm3=(lds_cptr)shm; const lds_cptr kp0=shm3+LDS_K+hi*1024+r32*16; const lds_cptr vp0=shm3+LDS_V+((lane>>4)&1)*32+(lane&3)*8+(4*hi+((lane&15)>>2))*64;
  const int NT=(q0+QB)/KVBLK;
  typedef __attribute__((address_space(3))) float lds_f32; typedef __attribute__((address_space(3))) const f32x4_t* lds_cf4;
  { lds_f32* ckw=(lds_f32*)((lds_cptr)shm+LDS_CK); int i0_=tid; asm volatile("":"+v"(i0_)); _Pragma("nounroll") for(int i=i0_;i<q0+QB;i+=NW*64)ckw[i]=cf[i]; }
  const float cq=cf[q0+wid*QBLK+(lane&31)];
  const lds_cptr ckl=(lds_cptr)shm+LDS_CK+16*(lane>>5);
  #define CBIAS(P0,P1,t) do{ const lds_cptr cb_=ckl+256*(t); _Pragma("unroll") for(int g_=0;g_<4;++g_){ const f32x4_t a_=*(lds_cf4)(cb_+32*g_), b_=*(lds_cf4)(cb_+128+32*g_); \
      _Pragma("unroll") for(int i_=0;i_<4;++i_){ P0[4*g_+i_]-=(a_[i_]+mm); P1[4*g_+i_]-=(b_[i_]+mm); } } }while(0)
  DMA_K(0,0);DMA_V(0,0);DMA_K(1,SLOTB);
  bf16x8 qr[4];
  #pragma unroll
  for(int d0=0;d0<4;++d0)qr[d0]=*reinterpret_cast<const bf16x8*>(&Qw[(long)r32*DM+d0*16+hi*8]);
  float mhat=0.f,l_reg=0.f;f32x16 o[2];o[0]=f32x16{};o[1]=f32x16{};float mm=-cq; const f32x16 negm=f32x16{};
  const int qrel=wid*QBLK+r32;
  #define CMASK(P0,P1,t) do{int jb_=(t)-(NT-4); if(jb_>=0)cmask(P0,P1,jb_,qrel,hi);}while(0)
  bool resc=false;
  #define START(P0,P1) do{ const float rm=rowmax(P0,P1); resc=false; \
    { const float dl=rm; mhat=fadd_s(mhat,dl); \
      _Pragma("unroll") for(int r=0;r<16;++r){P0[r]=fsub_s(P0[r],dl);P1[r]=fsub_s(P1[r],dl);} \
      mm+=dl; } \
    _Pragma("unroll") for(int r=0;r<16;++r)P0[r]=__builtin_amdgcn_exp2f(P0[r]); }while(0)
  #define RESC() do{ if(resc){ asm volatile("s_waitcnt lgkmcnt(0)":::"memory"); \
      _Pragma("unroll") for(int d_=0;d_<2;++d_) _Pragma("unroll") for(int r=0;r<16;++r)o[d_][r]*=wsf[crow(r,hi)]; } }while(0)
  f32x16 pA0,pA1,pB0,pB1;
  int sl_prev=0,sl_cur=0,sl_next=SLOTB;
  #define ROT() do{sl_prev=sl_cur;sl_cur=sl_next;sl_next=(sl_next==(NSLOT-1)*SLOTB)?0:sl_next+SLOTB;}while(0)
  DMA_K(2,2*SLOTB);
  WAIT_BAR(3);
  qkt(pA0,pA1,Kbase,qr,negm,r32,hi);asm volatile("s_nop 15\n\ts_nop 7":"+v"(pA0),"+v"(pA1));CBIAS(pA0,pA1,0);CMASK(pA0,pA1,0);
  START(pA0,pA1);
  _Pragma("unroll") for(int r=0;r<16;++r)pA1[r]=__builtin_amdgcn_exp2f(pA1[r]);
  WAIT_BAR(0);
  DMA_K(3,0);DMA_V(1,SLOTB);
  ROT();
  kload8(kf,kp0+sl_cur);
  WAIT_BAR(2);
  s16x4 vlo[8],vhi[8]; u32x4 pw0,pw1,pw2,pw3;
  #define PKW(P,B) cvtpk_s(P[B],P[B+1])
  #define PAF(k) __builtin_bit_cast(bf16x8,pw##k)
  #define VFR(i) (bf16x8){vlo[i][0],vlo[i][1],vlo[i][2],vlo[i][3],vhi[i][0],vhi[i][1],vhi[i][2],vhi[i][3]}
  #define PIN(x) asm volatile("":"+v"(x))
  #define MX3(a,b,c) __builtin_fmaxf(__builtin_fmaxf((a),(b)),(c))
  #define GAPA(MF,A0,A1,A2,A3,W0,W1,PW) do{ MF; sacc+=A0; sacc+=A1; sacc+=A2; sacc+=A3; PIN(sacc); W0; W1; PIN(PW); SBAR(); }while(0)
  #define EX(v) __builtin_amdgcn_exp2f(v)
  #define GAPB(MF,X,B) do{ MF; X[B]=EX(X[B]); X[B+1]=EX(X[B+1]); X[B+2]=EX(X[B+2]); X[B+3]=EX(X[B+3]); PIN(X); SBAR(); }while(0)
  #define VRD(i) do{ vlo[i]=vtr(vp_+(((i)>>2)*4096+((i)&3)*1024)); vhi[i]=vtr(vp_+(((i)>>2)*4096+((i)&3)*1024+512)); }while(0)
  #define KRD(G,j) do{ if(G){ kload2(kf,kp0+sl_next,j); SBAR(); } }while(0)
  #define STEP(C0,C1,P0,P1,t,GK,GV,GL) do{ SBAR(); \
    const lds_cptr vp_=vp0+sl_prev; \
    VRD(0); SBAR(); float sacc=(P0[0]+P0[1]); \
    GAPA(C0=__builtin_amdgcn_mfma_f32_32x32x16_bf16(kf[0],qr[0],negm,0,0,0), P0[2],P0[3],P0[4],P0[5],     pw0[0]=PKW(P0,0), pw0[1]=PKW(P0,2), pw0); \
    VRD(4); SBAR(); GAPA(C1=__builtin_amdgcn_mfma_f32_32x32x16_bf16(kf[1],qr[0],negm,0,0,0), P0[6],P0[7],P0[8],P0[9],     pw0[2]=PKW(P0,4), pw0[3]=PKW(P0,6), pw0); \
    VRD(1); SBAR(); GAPA(C0=__builtin_amdgcn_mfma_f32_32x32x16_bf16(kf[2],qr[1],C0,0,0,0),   P0[10],P0[11],P0[12],P0[13], pw1[0]=PKW(P0,8), pw1[1]=PKW(P0,10), pw1); \
    VRD(5); SBAR(); GAPA(C1=__builtin_amdgcn_mfma_f32_32x32x16_bf16(kf[3],qr[1],C1,0,0,0),   P0[14],P0[15],P1[0],P1[1],   pw1[2]=PKW(P0,12),pw1[3]=PKW(P0,14), pw1); \
    VRD(2); SBAR(); GAPA(C0=__builtin_amdgcn_mfma_f32_32x32x16_bf16(kf[4],qr[2],C0,0,0,0),   P1[2],P1[3],P1[4],P1[5],     pw2[0]=PKW(P1,0), pw2[1]=PKW(P1,2), pw2); \
    VRD(6); SBAR(); GAPA(C1=__builtin_amdgcn_mfma_f32_32x32x16_bf16(kf[5],qr[2],C1,0,0,0),   P1[6],P1[7],P1[8],P1[9],     pw2[2]=PKW(P1,4), pw2[3]=PKW(P1,6), pw2); \
    VRD(3); SBAR(); GAPA(C0=__builtin_amdgcn_mfma_f32_32x32x16_bf16(kf[6],qr[3],C0,0,0,0),   P1[10],P1[11],P1[12],P1[13], pw3[0]=PKW(P1,8), pw3[1]=PKW(P1,10), pw3); \
    VRD(7); SBAR(); GAPA(C1=__builtin_amdgcn_mfma_f32_32x32x16_bf16(kf[7],qr[3],C1,0,0,0),   P1[14],P1[15],0.f,0.f,       pw3[2]=PKW(P1,12),pw3[3]=PKW(P1,14), pw3); \
    l_reg+=sacc; \
    if(GK){DMA_K((t)+3,sl_cur);} if(GV){DMA_V((t)+1,sl_next);} \
    CBIAS(C0,C1,t); CMASK(C0,C1,t); \
    { float a=MX3(C0[0],C0[1],C1[0]),b=MX3(C0[2],C0[3],C1[1]); a=MX3(a,C1[2],C1[3]); \
      _Pragma("unroll") for(int r=4;r<16;r+=4){a=MX3(a,C0[r],C0[r+1]);b=MX3(b,C0[r+2],C0[r+3]);a=MX3(a,C1[r],C1[r+1]);b=MX3(b,C1[r+2],C1[r+3]);} \
      float rm=__builtin_fmaxf(a,b); { auto rr=__builtin_amdgcn_permlane32_swap(__float_as_uint(rm),__float_as_uint(rm),false,false); rm=__builtin_fmaxf(__uint_as_float(rr[0]),__uint_as_float(rr[1])); } \
      resc=false; \
      if(__builtin_expect(__any(rm>(float)THRL),0)){ const float dl=__builtin_fmaxf(rm,0.f); mhat+=dl; \
        _Pragma("unroll") for(int r=0;r<16;++r){C0[r]-=dl;C1[r]-=dl;} \
        mm+=dl; \
        const float f=__builtin_amdgcn_exp2f(-dl); l_reg*=f; if(hi==0)wsf[r32]=f; resc=true; } } \
    SBAR(); \
    GAPB(o[0]=__builtin_amdgcn_mfma_f32_32x32x16_bf16(PAF(0),VFR(0),o[0],0,0,0), C0,0); \
    GAPB(o[1]=__builtin_amdgcn_mfma_f32_32x32x16_bf16(PAF(0),VFR(4),o[1],0,0,0), C0,4); \
    KRD(GL,0); GAPB(o[0]=__builtin_amdgcn_mfma_f32_32x32x16_bf16(PAF(1),VFR(1),o[0],0,0,0), C0,8); \
    KRD(GL,1); GAPB(o[1]=__builtin_amdgcn_mfma_f32_32x32x16_bf16(PAF(1),VFR(5),o[1],0,0,0), C0,12); \
    KRD(GL,2); GAPB(o[0]=__builtin_amdgcn_mfma_f32_32x32x16_bf16(PAF(2),VFR(2),o[0],0,0,0), C1,0); \
    KRD(GL,3); GAPB(o[1]=__builtin_amdgcn_mfma_f32_32x32x16_bf16(PAF(2),VFR(6),o[1],0,0,0), C1,4); \
    GAPB(o[0]=__builtin_amdgcn_mfma_f32_32x32x16_bf16(PAF(3),VFR(3),o[0],0,0,0), C1,8); \
    GAPB(o[1]=__builtin_amdgcn_mfma_f32_32x32x16_bf16(PAF(3),VFR(7),o[1],0,0,0), C1,12); \
    }while(0)
  int t=1;
  #undef CMASK
  #define CMASK(P0,P1,t) do{}while(0)
  for(;t+5<NT;t+=2){
    STEP(pB0,pB1,pA0,pA1,t,true,true,true);     WAIT_BAR(2); RESC(); ROT();
    STEP(pA0,pA1,pB0,pB1,t+1,true,true,true);   WAIT_BAR(2); RESC(); ROT();
  }
  #undef CMASK
  #define CMASK(P0,P1,t) do{int jb_=(t)-(NT-4); if(jb_>=0)cmask(P0,P1,jb_,qrel,hi);}while(0)
  #define ENDW(tt) do{ if((tt)+3<NT){WAIT_BAR(2);} else if((tt)+2<NT){WAIT_BAR(1);} else {WAIT_BAR(0);} }while(0)
  for(;t+1<NT;t+=2){
    STEP(pB0,pB1,pA0,pA1,t,(t+3<NT),(t+1<NT),(t+1<NT));       ENDW(t);   RESC(); ROT();
    STEP(pA0,pA1,pB0,pB1,t+1,(t+4<NT),(t+2<NT),(t+2<NT));     ENDW(t+1); RESC(); ROT();
  }
  STEP(pB0,pB1,pA0,pA1,NT-1,false,false,false); RESC();
  { float sacc=pB0[0]+pB0[1]; _Pragma("unroll") for(int r=2;r<16;++r)sacc+=pB0[r]; _Pragma("unroll") for(int r=0;r<16;++r)sacc+=pB1[r]; l_reg+=sacc;
    pw0=(u32x4){PKW(pB0,0),PKW(pB0,2),PKW(pB0,4),PKW(pB0,6)};pw1=(u32x4){PKW(pB0,8),PKW(pB0,10),PKW(pB0,12),PKW(pB0,14)};pw2=(u32x4){PKW(pB1,0),PKW(pB1,2),PKW(pB1,4),PKW(pB1,6)};pw3=(u32x4){PKW(pB1,8),PKW(pB1,10),PKW(pB1,12),PKW(pB1,14)};
    SBAR(); pv(o,vb0+sl_cur,PAF(0),PAF(1),PAF(2),PAF(3)); }
  #undef PKW
  #undef PAF
  #undef VFR
  #undef PIN
  #undef MX3
  #undef GAPA
  #undef GAPB
  #undef EX
  #undef VRD
  #undef KRD
  #undef STEP
  #undef ENDW
  {auto rr=__builtin_amdgcn_permlane32_swap(__float_as_uint(l_reg),__float_as_uint(l_reg),false,false);l_reg=__uint_as_float(rr[0])+__uint_as_float(rr[1]);}
  if(hi==0)wsf[32+r32]=l_reg;asm volatile("s_waitcnt lgkmcnt(0)":::"memory");
  float rli[16];
  #pragma unroll
  for(int r=0;r<16;++r)rli[r]=__builtin_amdgcn_rcpf(wsf[32+crow(r,hi)]);
  bf16*Ow=O+(rowbase+q0+wid*QBLK)*OPITCH+h*D;
  { bf16*stg=(bf16*)(shm+LDS_OST)+wid*2048;
    #pragma unroll
    for(int r=0;r<16;++r){const int orow=crow(r,hi);
      #pragma unroll
      for(int d0=0;d0<2;++d0)stg[orow*64+d0*32+r32]=__float2bfloat16(o[d0][r]*rli[r]);}
    asm volatile("s_waitcnt lgkmcnt(0)":::"memory");
    #pragma unroll
    for(int i=0;i<4;++i){const int row=i*8+(lane>>3),ch=lane&7; const u32x4 v=*(const u32x4*)(stg+row*64+ch*8); ATTN_STORE16(Ow+(long)row*OPITCH+ch*8,v);} }
  asm volatile("s_waitcnt lgkmcnt(0)\n\ts_barrier":::"memory");
  #undef CBIAS
  #undef DMA_K
  #undef DMA_V
  #undef CMASK
  #undef START
  #undef RESC
  #undef ROT
}
constexpr int ATTN_LDS_BYTES=LDS_BYTES;
struct AttnTensors { const bf16* Q; const bf16* K; const bf16* V; bf16* O; const float* CF; };
struct AttnUnit { int bh; int qb; };
struct StaticOrder {
  int vcu;
  __device__ __forceinline__ explicit StaticOrder(int grid,int block):vcu((grid%8==0)?(block%8)*(grid/8)+block/8:block),G_(grid){}
  int G_;
  __device__ __forceinline__ bool next(int i,AttnUnit&u)const{ const int v=vcu+(i>>1)*G_; if(v>=256)return false; const int s=v&15; u.bh=v>>4; u.qb=(i&1)?31-s:s; return true; }
  __device__ __forceinline__ void a_ready(const AttnUnit&)const{}
  __device__ __forceinline__ void done(const AttnUnit&)const{}
};
template<class Sched,int THRL=8> __device__ __forceinline__ void attn_phase(char*lds,const AttnTensors&T,const Sched&S){
  AttnUnit u;
  for(int i=0;S.next(i,u);++i){ S.a_ready(u); attn_unit<THRL>(u.bh/NHEAD,u.bh%NHEAD,u.qb,T.Q,T.K,T.V,T.O,T.CF+(long)u.bh*SEQ,lds); S.done(u); }
}
#undef SBAR
#undef WAIT_BAR
}
#define GAS __attribute__((address_space(1)))
#define LAS __attribute__((address_space(3)))
typedef unsigned v4u __attribute__((ext_vector_type(4)));
typedef float f32x4 __attribute__((ext_vector_type(4)));
typedef short bf16x8 __attribute__((ext_vector_type(8)));
typedef GAS unsigned gu32;
typedef GAS unsigned long long gu64;
#define RLX_AGENT __ATOMIC_RELAXED, __HIP_MEMORY_SCOPE_AGENT
#define LDS_WAIT() asm volatile("s_waitcnt lgkmcnt(0)" ::: "memory")
#define VM_WAIT() asm volatile("s_waitcnt vmcnt(0)" ::: "memory")
__device__ __forceinline__ unsigned long long rt() { return __builtin_amdgcn_s_memrealtime(); }
__device__ __forceinline__ unsigned pk2(float lo, float hi) { return (unsigned)f2bf(lo) | ((unsigned)f2bf(hi) << 16); }

#define XB_TMO      128
#define XB_XCNT(j)  (256  + 64 * (j))
#define XB_XSUB(j)  (1280 + 64 * (j))
#define XB_XGEN(j)  (2304 + 64 * (j))
#define XB_TOP      3328
#define XB_TOPGEN   3392
#define XCD_BAR_WORDS 3456
#define XB_SPIN_CAP (1u << 18)

__device__ __forceinline__ unsigned xb_ld(unsigned* p)              { return __hip_atomic_load(p, __ATOMIC_RELAXED, __HIP_MEMORY_SCOPE_AGENT); }
__device__ __forceinline__ unsigned xb_add(unsigned* p, unsigned v) { return __hip_atomic_fetch_add(p, v, __ATOMIC_RELAXED, __HIP_MEMORY_SCOPE_AGENT); }
__device__ __forceinline__ unsigned xb_xcc_id() { return (unsigned)__builtin_amdgcn_s_getreg((3 << 11) | 20) & 0xFu; }
#define XB_SPIN(cond, bar) do { unsigned _sp = 0; while (cond) { __builtin_amdgcn_s_sleep(1); \
    if ((++_sp & 255u) == 0u) { if (xb_ld(&(bar)[XB_TMO])) break; if (_sp > XB_SPIN_CAP) { atomicAdd(&(bar)[XB_TMO], 1u); break; } } } } while (0)

struct XcdBarrier {
    unsigned* bar; unsigned x;
    volatile LAS unsigned* st;
};

__device__ __forceinline__ XcdBarrier xcd_barrier_post(unsigned* bar, volatile LAS unsigned* st) {
    XcdBarrier b; b.bar = bar; b.x = xb_xcc_id(); b.st = st;
    if (threadIdx.x == 0) (void)xb_add(&bar[XB_XCNT(b.x)], 1u);
    return b;
}
__device__ __forceinline__ void xcd_barrier_complete(unsigned* bar, unsigned x, unsigned& nloc, unsigned& nx) {
    const unsigned G = gridDim.x * gridDim.y * gridDim.z;
    unsigned sum, cnt, mine, sp = 0u;
    for (;;) {
        sum = 0u; cnt = 0u; mine = 0u;
#pragma unroll
        for (unsigned j = 0; j < 16; ++j) { const unsigned c = xb_ld(&bar[XB_XCNT(j)]); sum += c; cnt += (c > 0u) ? 1u : 0u; mine = (j == x) ? c : mine; }
        if (sum == G) break;
        __builtin_amdgcn_s_sleep(1);
        if ((++sp & 255u) == 0u) { if (xb_ld(&bar[XB_TMO])) break; if (sp > XB_SPIN_CAP) { atomicAdd(&bar[XB_TMO], 1u); break; } }
    }
    nloc = mine > 0u ? mine : 1u; nx = cnt > 0u ? cnt : 1u;
}

__device__ __forceinline__ void xcd_barrier(const XcdBarrier& b) {
    asm volatile("s_waitcnt vmcnt(0)" ::: "memory");
    __syncthreads();
    if (threadIdx.x == 0) {
        unsigned* bar = b.bar;
        __builtin_amdgcn_s_waitcnt(0);
        unsigned nloc = b.st[0], nx = b.st[1];
        if (nloc == 0u) { xcd_barrier_complete(bar, b.x, nloc, nx); b.st[0] = nloc; b.st[1] = nx; }
        const unsigned old = xb_add(&bar[XB_XSUB(b.x)], 1u);
        const unsigned gen = old / nloc;
        if (old + 1u == (gen + 1u) * nloc) {
            __builtin_amdgcn_fence(__ATOMIC_RELEASE, "agent");
            asm volatile("s_waitcnt vmcnt(0)" ::: "memory");
            const unsigned og = xb_add(&bar[XB_TOP], 1u);
            const unsigned tg = og / nx;
            if (og + 1u == (tg + 1u) * nx) xb_add(&bar[XB_TOPGEN], 1u);
            else XB_SPIN(xb_ld(&bar[XB_TOPGEN]) == tg, bar);
            __builtin_amdgcn_fence(__ATOMIC_ACQUIRE, "agent");
            xb_add(&bar[XB_XGEN(b.x)], 1u);
            asm volatile("s_waitcnt vmcnt(0)" ::: "memory");
        } else {
            XB_SPIN(xb_ld(&bar[XB_XGEN(b.x)]) == gen, bar);
            __builtin_amdgcn_fence(__ATOMIC_ACQUIRE, "agent");
            asm volatile("s_waitcnt vmcnt(0)" ::: "memory");
        }
    }
    __syncthreads();
}
constexpr int NWAVES = 8, NTHR = 512;
constexpr int RING_OFF = 0, RING_BYTES = 131072, LDSCTL_OFF = RING_BYTES, MISC_OFF = LDSCTL_OFF + 320, LDS_BYTES = 147456;
constexpr int CW_BAR = 4096;
constexpr size_t WS_WIN = WS_W  , WS_SWIN = WS_W + 8 * MiB  , WS_WOUT = WS_W + 14 * MiB  , WS_WDGU = WS_W + 18 * MiB  , WS_SWDGU = WS_W + 24 * MiB  , WS_WDDN = WS_W + 29 * MiB  ;
constexpr size_t WS_SH = WS_H + 16 * MiB  , WS_SXG = WS_XG + 34 * MiB  ;
constexpr size_t WS_WMGU = WS_W  , WS_SWMGU = WS_W + 60 * MiB  , WS_WMDN = WS_W + 64 * MiB  ;
static_assert(WS_WMDN + 56 * MiB <= 469 * MiB, "ws");
struct MArgs { const float* in[20]; float* out; unsigned char* ws; int ph_lo, ph_hi; };
enum { I_X = 0, I_ATTN_NORM, I_W_IN, I_HGRN_LB, I_HGRN_NORM, I_MLSTM_CONV, I_MLSTM_BI, I_MLSTM_BF, I_MLSTM_NORM, I_FOX_BF, I_W_OUT, I_FFN_NORM, I_DGATE, I_DUP, I_DDOWN, I_ROUTER, I_MGATE, I_MUP, I_MDOWN, I_FINAL_NORM };

__device__ __forceinline__ void tr_item(const float* W, int ldw, int K, bf16_t* WT, LAS float* scr, int k0, int lane) {
#pragma unroll 8
    for (int i = 0; i < 32; ++i) { const int kk = 2 * i + (lane >> 5); scr[kk * 33 + (lane & 31)] = W[(size_t)(k0 + kk) * ldw + (lane & 31)]; }
    LDS_WAIT(); asm volatile("" ::: "memory");
    const int c = lane & 7;
#pragma unroll
    for (int j = 0; j < 4; ++j) { const int n = (lane >> 3) + 8 * j; const LAS float* s = scr + (8 * c) * 33 + n;
        v4u o; o.x = pk2(s[0 * 33], s[1 * 33]); o.y = pk2(s[2 * 33], s[3 * 33]); o.z = pk2(s[4 * 33], s[5 * 33]); o.w = pk2(s[6 * 33], s[7 * 33]);
        *(GAS v4u*)(WT + (size_t)n * K + k0 + 8 * c) = o; }
    LDS_WAIT(); asm volatile("" ::: "memory");
}
__device__ __forceinline__ int glu_row(int c, int up) { return (c >> 7) * 256 + (c & 127) + up * 128; }

template <int MODE> __device__ __forceinline__ void mrow(const float* src, float* X, signed char* H8, float* SH, const float* gain, const LAS float* tab, float* G, int row, int lane, float (&lg)[8]) {
    const float4* xr = (const float4*)(src + (size_t)row * D) + lane;
    float4 v[4]; float ss = 0.f;
#pragma unroll
    for (int j = 0; j < 4; ++j) { v[j] = xr[64 * j]; ss += v[j].x * v[j].x + v[j].y * v[j].y + v[j].z * v[j].z + v[j].w * v[j].w; }
    ss = wave_sum(ss);
    const float r = rsqrtf(ss * (1.f / D) + EPS);
    if (X != src) { float4* xo = (float4*)(X + (size_t)row * D) + lane;
#pragma unroll
        for (int j = 0; j < 4; ++j) xo[64 * j] = v[j]; }
    float h[16];
#pragma unroll
    for (int j = 0; j < 4; ++j) { const float4 g = *((const float4*)gain + 64 * j + lane);
        h[4 * j + 0] = v[j].x * r * g.x; h[4 * j + 1] = v[j].y * r * g.y; h[4 * j + 2] = v[j].z * r * g.z; h[4 * j + 3] = v[j].w * r * g.w; }
    { float am = 0.f;
#pragma unroll
      for (int i = 0; i < 16; ++i) am = fmaxf(am, fabsf(h[i]));
#pragma unroll
      for (int o = 1; o < 64; o <<= 1) am = fmaxf(am, __shfl_xor(am, o));
      const float inv = am > 0.f ? 127.f / am : 0.f;
#pragma unroll
      for (int j = 0; j < 4; ++j) { const int q0 = (int)rintf(h[4 * j] * inv), q1 = (int)rintf(h[4 * j + 1] * inv), q2 = (int)rintf(h[4 * j + 2] * inv), q3 = (int)rintf(h[4 * j + 3] * inv);
          *((unsigned*)(H8 + (size_t)row * D) + 64 * j + lane) = (unsigned)(q0 & 255) | ((unsigned)(q1 & 255) << 8) | ((unsigned)(q2 & 255) << 16) | ((unsigned)(q3 & 255) << 24); }
      if (lane == 0) SH[row] = am > 0.f ? am * (1.f / 127.f) : 1.f; }
    if (MODE == 0) {
        float mine = 0.f;
#pragma unroll 2
        for (int c = 0; c < 16; ++c) { float s = 0.f;
#pragma unroll
            for (int j = 0; j < 4; ++j) { const f32x4 w = *(const LAS f32x4*)(tab + c * 1024 + 256 * j + 4 * lane); s += h[4 * j] * w[0] + h[4 * j + 1] * w[1] + h[4 * j + 2] * w[2] + h[4 * j + 3] * w[3]; }
            s = wave_sum(s); if (lane == c) mine = s; }
        if (lane < 16) G[(size_t)row * GW + lane] = mine;
    }
    if (MODE == 2) {
        float v0 = -INFINITY, v1 = -INFINITY; int e0 = 0, e1 = 0;
#pragma unroll 2
        for (int c = 0; c < 8; ++c) { float s = 0.f;
#pragma unroll
            for (int j = 0; j < 4; ++j) { const f32x4 w = *(const LAS f32x4*)(tab + c * 1024 + 256 * j + 4 * lane); s += h[4 * j] * w[0] + h[4 * j + 1] * w[1] + h[4 * j + 2] * w[2] + h[4 * j + 3] * w[3]; }
            s = wave_sum(s);
            if (s > v0) { v1 = v0; e1 = e0; v0 = s; e0 = c; } else if (s > v1) { v1 = s; e1 = c; } }
        lg[0] = v0; lg[1] = v1; lg[2] = __int_as_float(e0); lg[3] = __int_as_float(e1);
    }
}
__device__ __forceinline__ void load_gate_tab(LAS float* tab, const float* w_in, int tid) {
    for (int k = tid; k < D; k += NTHR) { const float4* w0 = (const float4*)(w_in + (size_t)k * DIN + 1792); const float4* w1 = (const float4*)(w_in + (size_t)k * DIN + 3592);
        const float4 a0 = w0[0], a1 = w0[1], b0 = w1[0], b1 = w1[1];
        tab[0 * 1024 + k] = a0.x; tab[1 * 1024 + k] = a0.y; tab[2 * 1024 + k] = a0.z; tab[3 * 1024 + k] = a0.w; tab[4 * 1024 + k] = a1.x; tab[5 * 1024 + k] = a1.y; tab[6 * 1024 + k] = a1.z; tab[7 * 1024 + k] = a1.w;
        tab[8 * 1024 + k] = b0.x; tab[9 * 1024 + k] = b0.y; tab[10 * 1024 + k] = b0.z; tab[11 * 1024 + k] = b0.w; tab[12 * 1024 + k] = b1.x; tab[13 * 1024 + k] = b1.y; tab[14 * 1024 + k] = b1.z; tab[15 * 1024 + k] = b1.w; }
}
__device__ __forceinline__ void load_router_tab(LAS float* tab, const float* router, int tid) {
    for (int k = tid; k < D; k += NTHR) { const float4* w0 = (const float4*)(router + (size_t)k * NE); const float4 a0 = w0[0], a1 = w0[1];
        tab[0 * 1024 + k] = a0.x; tab[1 * 1024 + k] = a0.y; tab[2 * 1024 + k] = a0.z; tab[3 * 1024 + k] = a0.w; tab[4 * 1024 + k] = a1.x; tab[5 * 1024 + k] = a1.y; tab[6 * 1024 + k] = a1.z; tab[7 * 1024 + k] = a1.w; }
}
__device__ __forceinline__ void conv8_block(const float* W, int ldw, signed char* WT8, float* S, LAS float* img, LAS float* pm, int tid, int wave) {
    const int lane = tid & 63, n = lane & 31, kp = lane >> 5;
    float m = 0.f;
#pragma unroll 8
    for (int i = 0; i < 64; ++i) { const int k = 128 * wave + 2 * i + kp; const float v = W[(size_t)k * ldw + n]; img[k * 32 + n] = v; m = fmaxf(m, fabsf(v)); }
    m = fmaxf(m, __shfl_xor(m, 32));
    if (lane < 32) pm[wave * 32 + lane] = m;
    __syncthreads();
    const int no = lane >> 1, kh = 128 * wave + 64 * (lane & 1);
    float cm = 0.f;
#pragma unroll
    for (int w = 0; w < 8; ++w) cm = fmaxf(cm, pm[w * 32 + no]);
    const float inv = cm > 0.f ? 127.f / cm : 0.f;
    if (wave == 0 && (lane & 1) == 0) S[no] = cm > 0.f ? cm * (1.f / 127.f) : 1.f;
    const LAS float* sp = img + kh * 32 + no;
#pragma unroll
    for (int q = 0; q < 4; ++q) { unsigned wq[4];
#pragma unroll
        for (int j = 0; j < 4; ++j) { const int kk = 16 * q + 4 * j; const int q0 = (int)rintf(sp[kk * 32] * inv), q1 = (int)rintf(sp[(kk + 1) * 32] * inv), q2 = (int)rintf(sp[(kk + 2) * 32] * inv), q3 = (int)rintf(sp[(kk + 3) * 32] * inv);
            wq[j] = (unsigned)(q0 & 255) | ((unsigned)(q1 & 255) << 8) | ((unsigned)(q2 & 255) << 16) | ((unsigned)(q3 & 255) << 24); }
        v4u o; o.x = wq[0]; o.y = wq[1]; o.z = wq[2]; o.w = wq[3];
        *(GAS v4u*)(WT8 + (size_t)no * 1024 + kh + 16 * q) = o; }
    __syncthreads();
}
namespace scan {
typedef short bf16x8 __attribute__((ext_vector_type(8)));
typedef float f32x4 __attribute__((ext_vector_type(4)));
typedef unsigned v2u __attribute__((ext_vector_type(2)));
constexpr int TS = 144, TB = 64 * TS;
constexpr int L_T0 = 0, L_T1 = TB, L_T2 = 2 * TB, L_T3 = 3 * TB, L_T4 = 4 * TB, L_T5 = 5 * TB, L_O = 6 * TB, OS = 68  , L_PART = L_O + 64 * OS * 4, L_VEC = L_PART + 8 * 64 * 4, L_END = L_VEC + 8 * 64 * 4;
static_assert(L_END <= RING_BYTES, "scan LDS");
constexpr size_t SC_LHG = 0, SC_LML = 16 * MiB, SC_DEC = 32 * MiB  , SC_NL = 32 * MiB + 256 * 1024  , SC_AMAX = 32 * MiB + 512 * 1024, SC_BEND = SC_AMAX + 4096, SC_MPREV = SC_BEND + 4096;

__device__ __forceinline__ float wave_incl_add(float v, int lane) {
#pragma unroll
    for (int o = 1; o < 64; o <<= 1) { const float u = __shfl_up(v, o); if (lane >= o) v += u; }
    return v;
}
__device__ __forceinline__ float wave_incl_max(float v, int lane) {
#pragma unroll
    for (int o = 1; o < 64; o <<= 1) { const float u = __shfl_up(v, o); if (lane >= o) v = fmaxf(v, u); }
    return v;
}
__device__ __forceinline__ float wave_max(float v) {
#pragma unroll
    for (int o = 1; o < 64; o <<= 1) v = fmaxf(v, __shfl_xor(v, o));
    return v;
}
__device__ __forceinline__ f32x4 mma64(LAS const unsigned char* A, LAS const unsigned char* B, int m0, int n0, int lane, f32x4 acc) {
    const int r = lane & 15, kq = lane >> 4;
#pragma unroll
    for (int ks = 0; ks < 2; ++ks) {
        const bf16x8 a = *(LAS const bf16x8*)(A + (m0 + r) * TS + kq * 16 + ks * 64);
        const bf16x8 b = *(LAS const bf16x8*)(B + (n0 + r) * TS + kq * 16 + ks * 64);
        acc = __builtin_amdgcn_mfma_f32_16x16x32_bf16(a, b, acc, 0, 0, 0);
    }
    return acc;
}
__device__ __forceinline__ v4u pack8(const float (&v)[8]) { v4u w; w.x = pk2(v[0], v[1]); w.y = pk2(v[2], v[3]); w.z = pk2(v[4], v[5]); w.w = pk2(v[6], v[7]); return w; }
__device__ __forceinline__ v4u pack8h(const bf16_t (&v)[8]) { v4u w; w.x = v[0] | ((unsigned)v[1] << 16); w.y = v[2] | ((unsigned)v[3] << 16); w.z = v[4] | ((unsigned)v[5] << 16); w.w = v[6] | ((unsigned)v[7] << 16); return w; }
__device__ __forceinline__ void st16(LAS unsigned char* p, float v) { *(LAS bf16_t*)p = f2bf(v); }
__device__ __forceinline__ void load_state_tile(LAS unsigned char* T, const float* S, int tid) {
    const int v = tid >> 3, d0 = (tid & 7) * 8; const float4 x0 = *(const float4*)(S + v * 64 + d0), x1 = *(const float4*)(S + v * 64 + d0 + 4);
    v4u w; w.x = pk2(x0.x, x0.y); w.y = pk2(x0.z, x0.w); w.z = pk2(x1.x, x1.y); w.w = pk2(x1.z, x1.w);
    *(LAS v4u*)(T + v * TS + d0 * 2) = w;
}
__device__ __forceinline__ void local_state_mma_store(LAS unsigned char* L, float* LT, int wave, int lane) {
    const int mt = wave >> 1;
#pragma unroll
    for (int nn = 0; nn < 2; ++nn) { const int nt = 2 * (wave & 1) + nn; f32x4 acc = {0.f, 0.f, 0.f, 0.f};
        acc = mma64(L + L_T1, L + L_T0, mt * 16, nt * 16, lane, acc);
#pragma unroll
        for (int r = 0; r < 4; ++r) LT[(mt * 16 + 4 * (lane >> 4) + r) * 64 + nt * 16 + (lane & 15)] = acc[r]; }
}

__device__ __forceinline__ void hgrn_b_item(LAS unsigned char* L, const bf16_t* P, float lb, int b, int c, int h, float* LT, float* DEC, int tid, int wave) {
    const int d = tid & 63, tq = wave;
    const bf16_t* pr = P + (size_t)(b * SEQ + c * 64 + 8 * tq) * PW + h * 64 + d;
    float bl[8], kh[8]; bf16_t iv[8]; float run = 0.f;
#pragma unroll
    for (int i = 0; i < 8; ++i) { const float fz = bf2f(pr[(size_t)i * PW + P_HF]); iv[i] = pr[(size_t)i * PW + P_HI];
        const float sg = sigmoidf_(fz), f = lb + (1.f - lb) * sg; kh[i] = (1.f - lb) * (1.f - sg); run += __logf(f); bl[i] = run; }
    LAS float* part = (LAS float*)(L + L_PART);
    part[tq * 64 + d] = run; __syncthreads();
    float off = 0.f, btot = 0.f;
#pragma unroll
    for (int w = 0; w < 8; ++w) { const float pv = part[w * 64 + d]; btot += pv; if (w < tq) off += pv; }
#pragma unroll
    for (int i = 0; i < 8; ++i) kh[i] *= __expf(btot - (off + bl[i]));
    *(LAS v4u*)(L + L_T0 + d * TS + tq * 16) = pack8(kh);
    *(LAS v4u*)(L + L_T1 + d * TS + tq * 16) = pack8h(iv);
    if (tq == 0) DEC[d] = __expf(btot);
    __syncthreads();
    local_state_mma_store(L, LT, wave, tid & 63);
    __syncthreads();
}
__device__ __forceinline__ void mlstm_gates(const float* G, const float* b_i, const float* b_f, int row0, int h, int lane, float& bcum, float& a) {
    const float ig = G[(size_t)(row0 + lane) * GW + h], fg = G[(size_t)(row0 + lane) * GW + 4 + h];
    bcum = wave_incl_add(log_sigmoidf_(fg + b_f[h]), lane); a = ig + b_i[h] - bcum;
}
__device__ __forceinline__ void conv_silu8(const bf16_t* col  , bool first3_zero, const float* w4  , float scale, float (&out)[8]) {
    float raw[11];
#pragma unroll
    for (int j = 0; j < 11; ++j) raw[j] = (j < 3 && first3_zero) ? 0.f : bf2f(col[((long)j - 3) * PW]);
    const float w0 = w4[0], w1 = w4[512], w2 = w4[1024], w3 = w4[1536];
#pragma unroll
    for (int i = 0; i < 8; ++i) out[i] = siluf_(w0 * raw[i] + w1 * raw[i + 1] + w2 * raw[i + 2] + w3 * raw[i + 3]) * scale;
}
__device__ __forceinline__ void mlstm_b_item(LAS unsigned char* L, const bf16_t* P, const float* G, const float* conv, const float* b_i, const float* b_f, int b, int c, int h, float* LT, float* NL, float* AMAX, float* BEND, int tid, int wave) {
    const int d = tid & 63, tq = wave, lane = tid & 63, row0 = b * SEQ + c * 64;
    float bcum, a; mlstm_gates(G, b_i, b_f, row0, h, lane, bcum, a);
    const float A = wave_max(a), bend = __shfl(bcum, 63);
    float kh[8]; conv_silu8(P + (size_t)(row0 + 8 * tq) * PW + P_MK + h * 64 + d, c == 0 && tq == 0, conv + 256 + h * 64 + d, 0.125f, kh);
    bf16_t vv[8]; float nsum = 0.f;
#pragma unroll
    for (int i = 0; i < 8; ++i) { vv[i] = P[(size_t)(row0 + 8 * tq + i) * PW + P_MV + h * 64 + d]; kh[i] *= __expf(__shfl(a, 8 * tq + i) - A); nsum += bf2f(f2bf(kh[i])); }
    *(LAS v4u*)(L + L_T0 + d * TS + tq * 16) = pack8(kh);
    *(LAS v4u*)(L + L_T1 + d * TS + tq * 16) = pack8h(vv);
    LAS float* part = (LAS float*)(L + L_PART); part[tq * 64 + d] = nsum;
    __syncthreads();
    if (tq == 0) { float s = 0.f;
#pragma unroll
        for (int w = 0; w < 8; ++w) s += part[w * 64 + d];
        NL[d] = s; if (lane == 0) { AMAX[0] = A; BEND[0] = bend; } }
    local_state_mma_store(L, LT, wave, lane);
    __syncthreads();
}
__device__ __forceinline__ void fox_cumsum_item(LAS unsigned char* L, const float* G, const float* fox_bf, float* CF, int bh, int tid, int wave) {
    const int b = bh >> 3, h = bh & 7, lane = tid & 63; const float bf = fox_bf[h];
    float loc[16]; float s = 0.f;
#pragma unroll
    for (int i = 0; i < 16; ++i) { s += log_sigmoidf_(G[((size_t)b * SEQ + tid * 16 + i) * GW + 8 + h] + bf); loc[i] = s; }
    const float incl = wave_incl_add(s, lane);
    LAS float* wt = (LAS float*)(L + L_PART);
    if (lane == 63) wt[wave] = incl;
    __syncthreads();
    float off = incl - s;
#pragma unroll
    for (int w = 0; w < 8; ++w) if (w < wave) off += wt[w];
#pragma unroll
    for (int i = 0; i < 16; ++i) CF[(size_t)bh * SEQ + tid * 16 + i] = (off + loc[i]) * LOG2E;
    __syncthreads();
}

__device__ __forceinline__ void scan_c_block(unsigned char* sc, int j, int tid) {
    if (j < 128) {
        if (tid < 256) { const int chain = j >> 4, e = (j & 15) * 256 + tid, b = chain >> 2, h = chain & 3;
            float* p = (float*)(sc + SC_LHG) + ((size_t)(b * 128) * 4 + h) * 4096 + e; const float* dp = (const float*)(sc + SC_DEC) + ((size_t)(b * 128) * 4 + h) * 64 + (e & 63);
            float S = 0.f;
#pragma unroll 8
            for (int c = 0; c < 128; ++c) { const float Lc = p[(size_t)c * 4 * 4096], dec = dp[(size_t)c * 4 * 64]; p[(size_t)c * 4 * 4096] = S; S = dec * S + Lc; } }
    } else {
        const int jj = j - 128, chain = jj >> 4, part = jj & 15, b = chain >> 2, h = chain & 3;
        if (tid < 260) { const bool isn = tid >= 256; const size_t it0 = (size_t)(b * 128) * 4 + h;
            float* p = isn ? (float*)(sc + SC_NL) + it0 * 64 + part * 4 + (tid - 256) : (float*)(sc + SC_LML) + it0 * 4096 + part * 256 + tid;
            const size_t stride = isn ? 4 * 64 : 4 * 4096;
            const float* am = (const float*)(sc + SC_AMAX) + it0; const float* be = (const float*)(sc + SC_BEND) + it0; float* mp = (float*)(sc + SC_MPREV) + it0;
            const bool writer = (part == 0 && tid == 0);
            float S = 0.f, m = 0.f;
#pragma unroll 8
            for (int c = 0; c < 128; ++c) { const float A = am[c * 4], bb = be[c * 4], Lc = p[c * stride]; const float Mx = fmaxf(m, A);
                p[c * stride] = S; S = __expf(m - Mx) * S + __expf(A - Mx) * Lc; if (writer) mp[c * 4] = m; m = bb + Mx; } }
    }
}

template <bool SIG> __device__ __forceinline__ void head_epilogue(LAS unsigned char* L, float inv, const bf16_t* gate  , const float* gain  , bf16_t* out  , int tid) {
    const int t = tid >> 3, v0 = (tid & 7) * 8; const LAS float* o = (const LAS float*)(L + L_O) + t * OS + v0;
    float x[8]; float ss = 0.f;
#pragma unroll
    for (int i = 0; i < 8; ++i) { x[i] = o[i] * inv; ss += x[i] * x[i]; }
    ss += __shfl_xor(ss, 1); ss += __shfl_xor(ss, 2); ss += __shfl_xor(ss, 4);
    const float r = rsqrtf(ss * (1.f / 64.f) + EPS);
    const uint4 gw = *(const uint4*)gate; const unsigned gu[4] = {gw.x, gw.y, gw.z, gw.w};
    float y[8];
#pragma unroll
    for (int i = 0; i < 8; ++i) { const float gz = bf2f((bf16_t)((gu[i >> 1] >> (16 * (i & 1))) & 0xffff)); y[i] = x[i] * r * gain[i] * (SIG ? sigmoidf_(gz) : siluf_(gz)); }
    *(v4u*)out = pack8(y);
}
__device__ __forceinline__ void store_o_tiles(LAS unsigned char* L, LAS const unsigned char* A1, LAS const unsigned char* B1, LAS const unsigned char* A2, LAS const unsigned char* B2, int wave, int lane) {
    const int mt = wave >> 1;
#pragma unroll
    for (int nn = 0; nn < 2; ++nn) { const int nt = 2 * (wave & 1) + nn; f32x4 acc = {0.f, 0.f, 0.f, 0.f};
        acc = mma64(A1, B1, mt * 16, nt * 16, lane, acc); acc = mma64(A2, B2, mt * 16, nt * 16, lane, acc);
        LAS float* o = (LAS float*)(L + L_O);
#pragma unroll
        for (int r = 0; r < 4; ++r) o[(mt * 16 + 4 * (lane >> 4) + r) * OS + nt * 16 + (lane & 15)] = acc[r]; }
}
__device__ __forceinline__ void hgrn_d_item(LAS unsigned char* L, const bf16_t* P, float lb, const float* gain, int b, int c, int h, const float* ST, bf16_t* MIX, int tid, int wave) {
    const int d = tid & 63, tq = wave, lane = tid & 63, row0 = b * SEQ + c * 64;
    const bf16_t* pr = P + (size_t)(row0 + 8 * tq) * PW + h * 64 + d;
    float bl[8], kk[8], q[8]; bf16_t iv[8]; float run = 0.f;
#pragma unroll
    for (int i = 0; i < 8; ++i) { const float fz = bf2f(pr[(size_t)i * PW + P_HF]); q[i] = bf2f(pr[(size_t)i * PW + P_HQ]); iv[i] = pr[(size_t)i * PW + P_HI];
        const float sg = sigmoidf_(fz), f = lb + (1.f - lb) * sg; kk[i] = (1.f - lb) * (1.f - sg); run += __logf(f); bl[i] = run; }
    LAS float* part = (LAS float*)(L + L_PART);
    part[tq * 64 + d] = run;
    load_state_tile(L + L_T4, ST, tid);
    *(LAS v4u*)(L + L_T3 + d * TS + tq * 16) = pack8h(iv);
    __syncthreads();
    float off = 0.f, bref = 0.f;
#pragma unroll
    for (int w = 0; w < 8; ++w) { const float pv = part[w * 64 + d]; if (w < 4) bref += pv; if (w < tq) off += pv; }
#pragma unroll
    for (int i = 0; i < 8; ++i) { const float bb = off + bl[i]; const int t = 8 * tq + i;
        st16(L + L_T0 + t * TS + d * 2, q[i] * __expf(bb - bref));
        st16(L + L_T1 + t * TS + d * 2, kk[i] * __expf(bref - bb));
        st16(L + L_T2 + t * TS + d * 2, q[i] * __expf(bb)); }
    __syncthreads();
    { const int mt = wave >> 1;
#pragma unroll
      for (int nn = 0; nn < 2; ++nn) { const int nt = 2 * (wave & 1) + nn; f32x4 acc = {0.f, 0.f, 0.f, 0.f};
          acc = mma64(L + L_T1, L + L_T0, mt * 16, nt * 16, lane, acc);
          const int s0 = mt * 16 + 4 * (lane >> 4), t = nt * 16 + (lane & 15);
          v2u w; w.x = pk2(s0 <= t ? acc[0] : 0.f, s0 + 1 <= t ? acc[1] : 0.f); w.y = pk2(s0 + 2 <= t ? acc[2] : 0.f, s0 + 3 <= t ? acc[3] : 0.f);
          *(LAS v2u*)(L + L_T5 + t * TS + s0 * 2) = w; } }
    __syncthreads();
    store_o_tiles(L, L + L_T5, L + L_T3, L + L_T2, L + L_T4, wave, lane);
    __syncthreads();
    { const int t = tid >> 3, v0 = (tid & 7) * 8;
      head_epilogue<false>(L, 1.f, P + (size_t)(row0 + t) * PW + P_HG + h * 64 + v0, gain + h * 64 + v0, MIX + (size_t)(row0 + t) * D + h * 64 + v0, tid); }
    __syncthreads();
}
__device__ __forceinline__ void mlstm_d_item(LAS unsigned char* L, const bf16_t* P, const float* G, const float* conv, const float* b_i, const float* b_f, const float* gain, int b, int c, int h,
                                             const float* CT, const float* NP, float mprev, bf16_t* MIX, int tid, int wave) {
    const int d = tid & 63, tq = wave, lane = tid & 63, row0 = b * SEQ + c * 64;
    float bcum, a; mlstm_gates(G, b_i, b_f, row0, h, lane, bcum, a);
    const float M = fmaxf(wave_incl_max(a, lane), mprev), sint = __expf(mprev - M);
    LAS float* vec = (LAS float*)(L + L_VEC);
    if (wave == 0) { vec[lane] = a; vec[64 + lane] = M; vec[128 + lane] = __expf(-bcum - M); vec[192 + lane] = NP[lane]; }
    float qc[8], kc[8]; const bool fz3 = (c == 0 && tq == 0);
    conv_silu8(P + (size_t)(row0 + 8 * tq) * PW + P_MQ + h * 64 + d, fz3, conv + h * 64 + d, 1.f, qc);
    conv_silu8(P + (size_t)(row0 + 8 * tq) * PW + P_MK + h * 64 + d, fz3, conv + 256 + h * 64 + d, 0.125f, kc);
    bf16_t vv[8];
#pragma unroll
    for (int i = 0; i < 8; ++i) { vv[i] = P[(size_t)(row0 + 8 * tq + i) * PW + P_MV + h * 64 + d]; const int t = 8 * tq + i;
        st16(L + L_T0 + t * TS + d * 2, qc[i]);
        st16(L + L_T1 + t * TS + d * 2, kc[i]);
        st16(L + L_T2 + t * TS + d * 2, qc[i] * __shfl(sint, t)); }
    *(LAS v4u*)(L + L_T3 + d * TS + tq * 16) = pack8h(vv);
    load_state_tile(L + L_T4, CT, tid);
    __syncthreads();
    { const int mt = wave >> 1;
#pragma unroll
      for (int nn = 0; nn < 2; ++nn) { const int nt = 2 * (wave & 1) + nn; f32x4 acc = {0.f, 0.f, 0.f, 0.f};
          acc = mma64(L + L_T1, L + L_T0, mt * 16, nt * 16, lane, acc);
          const int s0 = mt * 16 + 4 * (lane >> 4), t = nt * 16 + (lane & 15); const float Mt = vec[64 + t];
          float wv[4];
#pragma unroll
          for (int r = 0; r < 4; ++r) wv[r] = (s0 + r <= t) ? acc[r] * __expf(vec[s0 + r] - Mt) : 0.f;
          v2u w; w.x = pk2(wv[0], wv[1]); w.y = pk2(wv[2], wv[3]); *(LAS v2u*)(L + L_T5 + t * TS + s0 * 2) = w; } }
    __syncthreads();
    store_o_tiles(L, L + L_T5, L + L_T3, L + L_T2, L + L_T4, wave, lane);
    __syncthreads();
    { const int t = tid >> 3, c8 = (tid & 7) * 8;
      const v4u pw = *(LAS const v4u*)(L + L_T5 + t * TS + c8 * 2), qw = *(LAS const v4u*)(L + L_T2 + t * TS + c8 * 2);
      const unsigned pu[4] = {pw.x, pw.y, pw.z, pw.w}, qu[4] = {qw.x, qw.y, qw.z, qw.w}; float den = 0.f;
#pragma unroll
      for (int i = 0; i < 8; ++i) { den += bf2f((bf16_t)((pu[i >> 1] >> (16 * (i & 1))) & 0xffff)) + bf2f((bf16_t)((qu[i >> 1] >> (16 * (i & 1))) & 0xffff)) * vec[192 + c8 + i]; }
      den += __shfl_xor(den, 1); den += __shfl_xor(den, 2); den += __shfl_xor(den, 4);
      const float inv = 1.f / fmaxf(fabsf(den), vec[128 + t]);
      head_epilogue<true>(L, inv, P + (size_t)(row0 + t) * PW + P_MO + h * 64 + c8, gain + h * 64 + c8, MIX + (size_t)(row0 + t) * D + 256 + h * 64 + c8, tid); }
    __syncthreads();
}
}
constexpr int N_PHASES = 21;
template <int PH, bool REP = false> __device__ __forceinline__ void run_phase(const MArgs& a, LAS unsigned char* L, const int tid, const int wave, const int G, const int bx, const int vcu) {
    const int lane = tid & 63, gw = vcu * NWAVES + wave, NGW = G * NWAVES;
    unsigned char* ws = a.ws; float* X = a.out;
    int* ctl = (int*)(ws + WS_CTL); int* cnt = ctl + CW_CNT;
    float* Gt = (float*)(ws + WS_G); float* CF = (float*)(ws + WS_CF); int4* tokinfo = (int4*)(ws + WS_TOKINFO); float2* tgate = (float2*)(ws + WS_TGATE); int* toklist = (int*)(ws + WS_TOKLIST);
    bf16_t* P = (bf16_t*)(ws + WS_P); bf16_t* HID = (bf16_t*)(ws + WS_HID); signed char* H = (signed char*)(ws + WS_H); float* SH = (float*)(ws + WS_SH); bf16_t* MIX = (bf16_t*)(ws + WS_MIX);
    signed char* XG = (signed char*)(ws + WS_XG); float* SXG = (float*)(ws + WS_SXG); bf16_t* Y = (bf16_t*)(ws + WS_XG);
    LAS float* scr = (LAS float*)(L + RING_OFF + wave * 16384);
    (void)Gt; (void)CF; (void)tokinfo; (void)tgate; (void)toklist; (void)P; (void)HID; (void)H; (void)SH; (void)SXG; (void)MIX; (void)XG; (void)Y; (void)scr; (void)cnt; (void)lane; (void)gw; (void)NGW;
    constexpr int p = PH, l = p >= 10 ? 1 : 0, k = p == 0 ? -1 : (l ? p - 10 : p - 1);
    if constexpr (p == 0) {
            LAS float* img = (LAS float*)(L + RING_OFF); LAS float* pm = (LAS float*)(L + LDSCTL_OFF + 1024);
            for (int it = vcu; it < 400; it += G) {
                int r = it;
                if (r < 224) { const int ll = r / 112, nb = r % 112, sc = 32 * nb + (nb >= 56 ? 8 : 0);
                    conv8_block(a.in[I_W_IN] + (size_t)ll * D * DIN + sc, DIN, (signed char*)(ws + WS_WIN) + (size_t)ll * PW * D + (size_t)32 * nb * D, (float*)(ws + WS_SWIN) + ll * PW + 32 * nb, img, pm, tid, wave); }
                else { r -= 224; const int up = r / 88, nb = r % 88, c = 32 * nb;
                    conv8_block((up ? a.in[I_DUP] : a.in[I_DGATE]) + c, FF, (signed char*)(ws + WS_WDGU) + (size_t)glu_row(c, up) * D, (float*)(ws + WS_SWDGU) + glu_row(c, up), img, pm, tid, wave); }
            }
            for (int it = gw; it < 2432; it += NGW) {
                int r = it;
                if (r < 1024) { const int ll = r / 512; r %= 512; const int kb = r / 32, nb = r % 32;
                    tr_item(a.in[I_W_OUT] + (size_t)ll * D * D + 32 * nb, D, D, (bf16_t*)(ws + WS_WOUT) + (size_t)ll * D * D + (size_t)32 * nb * D, scr, 64 * kb, lane); continue; }
                r -= 1024;
                { const int kb = r / 32, nb = r % 32; tr_item(a.in[I_DDOWN] + 32 * nb, D, FF, (bf16_t*)(ws + WS_WDDN) + (size_t)32 * nb * FF, scr, 64 * kb, lane); }
            }
            __syncthreads();
            LAS float* tab = (LAS float*)(L + RING_OFF); load_gate_tab(tab, a.in[I_W_IN], tid); __syncthreads();
            float lg[8];
            for (int row = gw; row < NTOK; row += NGW) mrow<0>(a.in[I_X], X, H, SH, a.in[I_ATTN_NORM], tab, Gt, row, lane, lg);
        } else if constexpr (k == 0) {
            pg8::GOrder S; S.so.init(NTOK, PW, G, bx); S.A = (const char*)H; S.B = (const char*)(ws + WS_WIN) + (size_t)l * PW * D; S.a_tile = (size_t)256 * D; S.b_tile = (size_t)256 * D; S.b_exp = 0;
            S.tb1 = S.tb2 = S.tb3 = S.tb4 = S.tb5 = S.tb6 = S.tb7 = 0x7fffffff;
            pg8::EpiBf8 E; E.O = P; E.ldc = PW; E.s_lo = P_FQ / 256; E.s_hi = P_FK / 256; E.scale = QSCALE; E.sA = SH; E.sB = (const float*)(ws + WS_SWIN) + l * PW;
            pg8::Gemm g{D / 2};
            pg8::gemm_phase<pg8::EpiBf8, pg8::GOrder, true, true, true>(L + RING_OFF, g, S, E);
        } else if constexpr (l == 1 && k == 9) {
            pg8::GOrder S; pg8::EpiBf E; int t[8]; int acc = 0;
#pragma unroll
            for (int e = 0; e < NE; ++e) { t[e] = acc; acc += (cnt[e] + 255) >> 8; }
            S.so.init(acc * 256, D, G, bx); S.A = (const char*)HID; S.B = (const char*)(ws + WS_WMDN); S.a_tile = (size_t)256 * FE * 2; S.b_tile = (size_t)256 * FE * 2; S.b_exp = (size_t)D * FE * 2;
            S.tb1 = t[1]; S.tb2 = t[2]; S.tb3 = t[3]; S.tb4 = t[4]; S.tb5 = t[5]; S.tb6 = t[6]; S.tb7 = t[7]; E.O = Y; E.ldc = D; E.s_lo = 0; E.s_hi = 0; E.scale = 1.f;
            pg8::Gemm g{FE};
            pg8::gemm_phase<pg8::EpiBf, pg8::GOrder, true, true>(L + RING_OFF, g, S, E);
        } else if constexpr (k == 4 || (l == 0 && k == 7)) {
            pg8::GOrder S; S.so.init(NTOK, D, G, bx); S.b_exp = 0; S.tb1 = S.tb2 = S.tb3 = S.tb4 = S.tb5 = S.tb6 = S.tb7 = 0x7fffffff; int K;
            if constexpr (k == 4) { K = D; S.A = (const char*)MIX; S.B = (const char*)(ws + WS_WOUT) + (size_t)l * D * D * 2; }
            else { K = FF; S.A = (const char*)HID; S.B = (const char*)(ws + WS_WDDN); }
            S.a_tile = (size_t)256 * K * 2; S.b_tile = (size_t)256 * K * 2;
            pg8::EpiResid E{X, D}; pg8::Gemm g{K};
            pg8::gemm_phase<pg8::EpiResid, pg8::GOrder, true, true>(L + RING_OFF, g, S, E);
        } else if constexpr ((l == 0 && k == 6) || (l == 1 && k == 7)) {
            pg8::GOrder S; pg8::EpiSwiglu8 E; S.a_tile = (size_t)256 * D; S.b_tile = (size_t)256 * D; E.O = HID;
            if constexpr (l == 0) { S.so.init(NTOK, 2 * FF, G, bx); S.A = (const char*)H; S.B = (const char*)(ws + WS_WDGU); S.b_exp = 0; S.tb1 = S.tb2 = S.tb3 = S.tb4 = S.tb5 = S.tb6 = S.tb7 = 0x7fffffff;
                E.ldc = FF; E.sA = SH; E.sB = (const float*)(ws + WS_SWDGU); E.sb_exp = 0; }
            else { int t[8]; int acc = 0;
#pragma unroll
                for (int e = 0; e < NE; ++e) { t[e] = acc; acc += (cnt[e] + 255) >> 8; }
                S.so.init(acc * 256, 2 * FE, G, bx); S.A = (const char*)XG; S.B = (const char*)(ws + WS_WMGU); S.b_exp = (size_t)2 * FE * D;
                S.tb1 = t[1]; S.tb2 = t[2]; S.tb3 = t[3]; S.tb4 = t[4]; S.tb5 = t[5]; S.tb6 = t[6]; S.tb7 = t[7]; E.ldc = FE; E.sA = SXG; E.sB = (const float*)(ws + WS_SWMGU); E.sb_exp = 2 * FE; }
            E.tb1 = S.tb1; E.tb2 = S.tb2; E.tb3 = S.tb3; E.tb4 = S.tb4; E.tb5 = S.tb5; E.tb6 = S.tb6; E.tb7 = S.tb7;
            pg8::Gemm g{D / 2};
            pg8::gemm_phase<pg8::EpiSwiglu8, pg8::GOrder, true, true, true>(L + RING_OFF, g, S, E);
        } else if constexpr (k == 5 && l == 0) {
            float lg[8];
            for (int row = gw; row < NTOK; row += NGW) mrow<1>(X, X, H, SH, a.in[I_FFN_NORM], nullptr, nullptr, row, lane, lg);
        } else if constexpr (k == 8 && l == 0) {
            LAS float* tab = (LAS float*)(L + RING_OFF); load_gate_tab(tab, a.in[I_W_IN] + (size_t)D * DIN, tid); __syncthreads();
            float lg[8];
            for (int row = gw; row < NTOK; row += NGW) mrow<0>(X, X, H, SH, a.in[I_ATTN_NORM] + D, tab, Gt, row, lane, lg);
        } else if constexpr (k == 5 && l == 1) {
            LAS int* sel_e = (LAS int*)(L + RING_OFF);
            LAS float* sel_g = (LAS float*)(L + RING_OFF + 512);
            LAS int* lcnt = (LAS int*)(L + RING_OFF + 1024);
            LAS float* tab = (LAS float*)(L + RING_OFF + 4096); load_router_tab(tab, a.in[I_ROUTER], tid); __syncthreads();
            for (int rb = bx; rb < NTOK / 64; rb += G) {
                if (tid < 16) lcnt[tid] = 0;
                for (int i = 0; i < 8; ++i) { const int rl = wave * 8 + i, row = rb * 64 + rl; float lg[8];
                    mrow<2>(X, X, H, SH, a.in[I_FFN_NORM] + D, tab, nullptr, row, lane, lg);
                    if (lane == 0) { const float v0 = lg[0], v1 = lg[1]; const int e0 = __float_as_int(lg[2]), e1 = __float_as_int(lg[3]);
                        const float g1 = 1.f / (1.f + __expf(v0 - v1));
                        sel_e[2 * rl] = e0; sel_e[2 * rl + 1] = e1; sel_g[2 * rl] = 1.f - g1; sel_g[2 * rl + 1] = g1; } }
                __syncthreads();
                int e0 = 0, e1 = 0, r0 = 0, r1 = 0;
                if (tid < 64) { e0 = sel_e[2 * tid]; e1 = sel_e[2 * tid + 1]; r0 = __hip_atomic_fetch_add(lcnt + e0, 1, __ATOMIC_RELAXED, __HIP_MEMORY_SCOPE_WORKGROUP); r1 = __hip_atomic_fetch_add(lcnt + e1, 1, __ATOMIC_RELAXED, __HIP_MEMORY_SCOPE_WORKGROUP); }
                __syncthreads();
                if (tid < 8) lcnt[8 + tid] = atomicAdd(cnt + tid, (int)lcnt[tid]);
                __syncthreads();
                if (tid < 64) { const int row = rb * 64 + tid, s0 = lcnt[8 + e0] + r0, s1 = lcnt[8 + e1] + r1;
                    toklist[e0 * NTOK + s0] = row; toklist[e1 * NTOK + s1] = row; tokinfo[row] = make_int4(e0, s0, e1, s1); tgate[row] = make_float2(sel_g[2 * tid], sel_g[2 * tid + 1]); }
                __syncthreads();
            }
        } else if constexpr (k == 6 && l == 1) {
            { int base[NE]; int acc = 0;
#pragma unroll
              for (int e = 0; e < NE; ++e) { base[e] = acc; acc += (cnt[e] + 255) & ~255; }
              for (int r = gw; r < acc; r += NGW) { int e = 0, be = 0;
#pragma unroll
                  for (int c = 1; c < NE; ++c) if (r >= base[c]) { e = c; be = base[c]; }
                  const int s = r - be; v4u v0 = {0u, 0u, 0u, 0u}; float sv = 0.f;
                  if (s < cnt[e]) { const int tok = toklist[e * NTOK + s]; v0 = *((const v4u*)(H + (size_t)tok * D) + lane); sv = SH[tok]; }
                  *((v4u*)(XG + (size_t)r * D) + lane) = v0; if (lane == 0) SXG[r] = sv; } }
            __syncthreads();
            { LAS float* img = (LAS float*)(L + RING_OFF); LAS float* pm = (LAS float*)(L + LDSCTL_OFF + 1024);
              for (int it = vcu; it < 1792; it += G) { const int e = it / 224; int r = it % 224; const int up = r / 112, nb = r % 112, c = 32 * nb;
                  conv8_block((up ? a.in[I_MUP] : a.in[I_MGATE]) + (size_t)e * D * FE + c, FE, (signed char*)(ws + WS_WMGU) + (size_t)e * 2 * FE * D + (size_t)glu_row(c, up) * D, (float*)(ws + WS_SWMGU) + e * 2 * FE + glu_row(c, up), img, pm, tid, wave); } }
            for (int it = gw; it < 14336; it += NGW) { const int e = it / 1792, r = it % 1792, kb = r / 32, nb = r % 32;
                tr_item(a.in[I_MDOWN] + (size_t)e * FE * D + 32 * nb, D, FE, (bf16_t*)(ws + WS_WMDN) + (size_t)e * D * FE + (size_t)32 * nb * FE, scr, 64 * kb, lane); }
        } else if constexpr (k == 8 && l == 1) {
        } else if constexpr (k == 10 && l == 1) {
            int base[NE]; { int acc = 0;
#pragma unroll
              for (int e = 0; e < NE; ++e) { base[e] = acc; acc += (cnt[e] + 255) & ~255; } }
            for (int row = gw; row < NTOK; row += NGW) {
                float4* xr = (float4*)(X + (size_t)row * D) + lane; float4 v[4];
#pragma unroll
                for (int j = 0; j < 4; ++j) v[j] = xr[64 * j];
                const int4 ti = tokinfo[row]; const float2 tg = tgate[row]; int b0 = 0, b1 = 0;
#pragma unroll
                for (int c = 0; c < NE; ++c) { if (c == ti.x) b0 = base[c]; if (c == ti.z) b1 = base[c]; }
                const bf16_t* y0 = Y + (size_t)(b0 + ti.y) * D; const bf16_t* y1 = Y + (size_t)(b1 + ti.w) * D;
#pragma unroll
                for (int j = 0; j < 4; ++j) { const uint2 q = *((const uint2*)y0 + 64 * j + lane), c = *((const uint2*)y1 + 64 * j + lane);
                    v[j].x += tg.x * bf2f((bf16_t)(q.x & 0xffff)) + tg.y * bf2f((bf16_t)(c.x & 0xffff)); v[j].y += tg.x * bf2f((bf16_t)(q.x >> 16)) + tg.y * bf2f((bf16_t)(c.x >> 16));
                    v[j].z += tg.x * bf2f((bf16_t)(q.y & 0xffff)) + tg.y * bf2f((bf16_t)(c.y & 0xffff)); v[j].w += tg.x * bf2f((bf16_t)(q.y >> 16)) + tg.y * bf2f((bf16_t)(c.y >> 16)); }
                float ss = 0.f;
#pragma unroll
                for (int j = 0; j < 4; ++j) ss += v[j].x * v[j].x + v[j].y * v[j].y + v[j].z * v[j].z + v[j].w * v[j].w;
                ss = wave_sum(ss); const float r = rsqrtf(ss * (1.f / D) + EPS);
#pragma unroll
                for (int j = 0; j < 4; ++j) { const float4 g = *((const float4*)a.in[I_FINAL_NORM] + 64 * j + lane); xr[64 * j] = make_float4(v[j].x * r * g.x, v[j].y * r * g.y, v[j].z * r * g.z, v[j].w * r * g.w); }
            }
        } else {
            if constexpr (k == 1) {
                unsigned char* sc = ws + WS_SCAN; const int wv = wave;
                for (int it = bx; it < 2048; it += G) { const int item = it & 1023, h = item & 3, c = (item >> 2) & 127, b = item >> 9;
                    if (it < 1024) { const int ch = h * 64 + (tid & 63); const float lb = l == 0 ? 0.f : 1.f / (1.f + __expf(a.in[I_HGRN_LB][ch] - a.in[I_HGRN_LB][256 + ch]));
                        scan::hgrn_b_item(L, P, lb, b, c, h, (float*)(sc + scan::SC_LHG) + (size_t)item * 4096, (float*)(sc + scan::SC_DEC) + item * 64, tid, wv); }
                    else scan::mlstm_b_item(L, P, Gt, a.in[I_MLSTM_CONV] + l * 2048, a.in[I_MLSTM_BI] + l * 4, a.in[I_MLSTM_BF] + l * 4, b, c, h, (float*)(sc + scan::SC_LML) + (size_t)item * 4096,
                                            (float*)(sc + scan::SC_NL) + item * 64, (float*)(sc + scan::SC_AMAX) + item, (float*)(sc + scan::SC_BEND) + item, tid, wv); }
                for (int bh = bx; bh < 16; bh += G) scan::fox_cumsum_item(L, Gt, a.in[I_FOX_BF] + l * 8, CF, bh, tid, wv);
            } else if constexpr (k == 2) {
                if constexpr (!REP) { for (int j = bx; j < 256; j += G) scan::scan_c_block(ws + WS_SCAN, j, tid); }
                static_assert(attn_body::ATTN_LDS_BYTES <= RING_BYTES, "attention LDS");
                const attn_body::AttnTensors AT{(const attn_body::bf16*)(P + P_FQ), (const attn_body::bf16*)(P + P_FK), (const attn_body::bf16*)(P + P_FV), (attn_body::bf16*)(MIX + 512), CF};
                const attn_body::StaticOrder S(G, bx);
                attn_body::attn_phase<attn_body::StaticOrder>((char*)L + RING_OFF, AT, S);
            } else if constexpr (k == 3) {
                unsigned char* sc = ws + WS_SCAN; const int wv = wave;
                for (int it = bx; it < 2048; it += G) { const int item = it & 1023, h = item & 3, c = (item >> 2) & 127, b = item >> 9;
                    if (it < 1024) { const int ch = h * 64 + (tid & 63); const float lb = l == 0 ? 0.f : 1.f / (1.f + __expf(a.in[I_HGRN_LB][ch] - a.in[I_HGRN_LB][256 + ch]));
                        scan::hgrn_d_item(L, P, lb, a.in[I_HGRN_NORM] + l * 256, b, c, h, (const float*)(sc + scan::SC_LHG) + (size_t)item * 4096, MIX, tid, wv); }
                    else scan::mlstm_d_item(L, P, Gt, a.in[I_MLSTM_CONV] + l * 2048, a.in[I_MLSTM_BI] + l * 4, a.in[I_MLSTM_BF] + l * 4, a.in[I_MLSTM_NORM] + l * 256, b, c, h,
                                            (const float*)(sc + scan::SC_LML) + (size_t)item * 4096, (const float*)(sc + scan::SC_NL) + item * 64, ((const float*)(sc + scan::SC_MPREV))[item], MIX, tid, wv); }
            }

        }
}
__global__ void __launch_bounds__(NTHR, 2) mega(MArgs a) {
    extern __shared__ __attribute__((aligned(16))) unsigned char lds[];
    LAS unsigned char* L = (LAS unsigned char*)lds;
    volatile LAS unsigned* MISC = (volatile LAS unsigned*)(L + MISC_OFF);
    const int tid = threadIdx.x, wave = __builtin_amdgcn_readfirstlane(tid >> 6);
    const int G = gridDim.x, bx = blockIdx.x, vcu = (G % 8 == 0) ? (bx % 8) * (G / 8) + bx / 8 : bx;
    for (int u = tid; u < (LDS_BYTES - LDSCTL_OFF) / 4; u += NTHR) ((LAS unsigned*)(L + LDSCTL_OFF))[u] = 0u;
    __syncthreads();
    const int lo = a.ph_lo, hi = a.ph_hi;
    XcdBarrier bar; bar.bar = (unsigned*)(a.ws + WS_CTL) + CW_BAR; bar.x = 0; bar.st = nullptr;
    if (hi - lo > 1) bar = xcd_barrier_post((unsigned*)(a.ws + WS_CTL) + CW_BAR, MISC + 8);
#ifndef REPEAT_MASK
#define REPEAT_MASK 0u
#endif
#define PHASE(k) if (lo <= (k) && (k) < hi) { run_phase<k>(a, L, tid, wave, G, bx, vcu); if constexpr ((REPEAT_MASK >> (k)) & 1u) { xcd_barrier(bar); run_phase<k, true>(a, L, tid, wave, G, bx, vcu); } if ((k) + 1 < hi) xcd_barrier(bar); }
    PHASE(0) PHASE(1) PHASE(2) PHASE(3) PHASE(4) PHASE(5) PHASE(6) PHASE(7) PHASE(8) PHASE(9) PHASE(10)
    PHASE(11) PHASE(12) PHASE(13) PHASE(14) PHASE(15) PHASE(16) PHASE(17) PHASE(19) PHASE(20)
#undef PHASE
}
#ifndef MEGA_MASK
#define MEGA_MASK 0x1FFFFFu
#endif
#ifndef FUSE_RUNS
#define FUSE_RUNS 1
#endif
extern "C" void kernel_launch(void* const* d_in, const int* in_sizes, int n_in, void* d_out, int out_size, void* d_ws, size_t ws_size, hipStream_t stream) {
    static int grid = 0;
    if (grid == 0) {
        if (n_in != 20 || ws_size < WS_END || out_size != NTOK * D) { fprintf(stderr, "kernel_launch: unexpected n_in %d / ws %zu / out %d\n", n_in, ws_size, out_size); grid = -1; return; }
        int dev = 0, cus = 0, per_cu = 0;
        if (hipGetDevice(&dev) != hipSuccess || hipDeviceGetAttribute(&cus, hipDeviceAttributeMultiprocessorCount, dev) != hipSuccess) { grid = -1; return; }
        if (hipFuncSetAttribute((const void*)mega, hipFuncAttributeMaxDynamicSharedMemorySize, LDS_BYTES) != hipSuccess) { fprintf(stderr, "kernel_launch: hipFuncSetAttribute failed\n"); grid = -1; return; }
        if (hipOccupancyMaxActiveBlocksPerMultiprocessor(&per_cu, (const void*)mega, NTHR, LDS_BYTES) != hipSuccess || per_cu < 1) { fprintf(stderr, "kernel_launch: occupancy query says %d\n", per_cu); per_cu = 1; }
        (void)hipGetLastError();
        grid = cus;
        if (grid > 256) grid = 256;
    }
    if (grid < 0) return;
    const float* const* in = (const float* const*)d_in;
    unsigned char* ws = (unsigned char*)d_ws; float* X = (float*)d_out;
    (void)hipMemsetAsync(ws + WS_CTL, 0, CTL_BYTES, stream);
    MArgs ma; memset(&ma, 0, sizeof ma);
    for (int i = 0; i < 20; ++i) ma.in[i] = in[i];
    ma.out = X; ma.ws = ws;
    ma.ph_lo = 0; ma.ph_hi = N_PHASES;
    hipLaunchKernelGGL(mega, dim3(grid), dim3(NTHR), LDS_BYTES, stream, ma);
}
```

```cpp
#include <hip/hip_runtime.h>
#include <hip/hip_bf16.h>
#include <cstdint>
#include <cstdio>
#include <cstring>

namespace cfg {
constexpr int NTOK = 16384, D = 1024, SEQ = 8192, NB = 2, DIN = 3600, PW = 3584, GW = 16;
constexpr int FF = 2816, FE = 3584, NE = 8, MAXROWS = 34816;
constexpr float EPS = 1e-6f;
constexpr float LOG2E = 1.4426950408889634f;
constexpr float QSCALE = 0.125f * LOG2E;
constexpr int P_HQ = 0, P_HF = 256, P_HI = 512, P_HG = 768, P_MQ = 1024, P_MK = 1280, P_MV = 1536, P_MO = 1792, P_FQ = 2048, P_FK = 2560, P_FV = 3072;
constexpr size_t MiB = 1u << 20;
constexpr size_t WS_CTL = 0, CTL_BYTES = 1 * MiB;
constexpr size_t WS_G = 2 * MiB;
constexpr size_t WS_CF = 3 * MiB;
constexpr size_t WS_TOKINFO = 3 * MiB + 512 * 1024;
constexpr size_t WS_TGATE = 3 * MiB + 768 * 1024;
constexpr size_t WS_TOKLIST = 4 * MiB;
constexpr size_t WS_P = 8 * MiB;
constexpr size_t WS_SCAN = 120 * MiB;
constexpr size_t WS_HID = 8 * MiB;
constexpr size_t WS_H = 246 * MiB;
constexpr size_t WS_MIX = 278 * MiB;
constexpr size_t WS_XG = 278 * MiB;
constexpr size_t WS_W = 346 * MiB;
constexpr size_t WS_Y = 346 * MiB;
constexpr size_t WS_END = 466 * MiB;
constexpr int CW_CNT = 64;
constexpr int CW_STAT = 128;
constexpr int CW_QCTR = 256;
}
using namespace cfg;
typedef unsigned short bf16_t;

__device__ __forceinline__ bf16_t f2bf(float f) { unsigned u = __builtin_bit_cast(unsigned, f); return (bf16_t)((u + 0x7fffu + ((u >> 16) & 1u)) >> 16); }
__device__ __forceinline__ float bf2f(bf16_t h) { return __builtin_bit_cast(float, (unsigned)h << 16); }
__device__ __forceinline__ float wave_sum(float v) {
#pragma unroll
    for (int o = 1; o < 64; o <<= 1) v += __shfl_xor(v, o);
    return v;
}
__device__ __forceinline__ float sigmoidf_(float z) { return 1.f / (1.f + __expf(-z)); }
__device__ __forceinline__ float siluf_(float z) { return z / (1.f + __expf(-z)); }
__device__ __forceinline__ float log_sigmoidf_(float z) { return fminf(z, 0.f) - log1pf(__expf(-fabsf(z))); }

__device__ __forceinline__ int moe_bases(const int* cnt, int* base) {
    int acc = 0;
#pragma unroll
    for (int e = 0; e < NE; ++e) { base[e] = acc; acc += (cnt[e] + 255) & ~255; }
    return acc;
}

namespace pg8 {
#define PG8_LAS __attribute__((address_space(3)))
typedef unsigned short bf16_t;
typedef short bf16x8 __attribute__((ext_vector_type(8)));
typedef float f32x4 __attribute__((ext_vector_type(4)));
typedef unsigned u32x4 __attribute__((ext_vector_type(4)));
constexpr int BM = 256, BK = 64, HALF = 128, HTB = HALF * BK * 2  , STAGE_BYTES = 8 * HTB, NXCD = 8, WGM = 8;

__host__ __device__ __forceinline__ int lds_byte(int r, int c) { const int st = (r >> 4) * 2 + (c >> 5), rr = r & 15, cc = c & 31, ob = rr * 64 + cc * 2; return st * 1024 + (ob ^ (((ob >> 9) & 1) << 5)); }
__host__ __device__ __forceinline__ void stage_rc(int b, int& R, int& C) { const int st = b / 1024, sb = b % 1024, swz = sb ^ (((sb >> 9) & 1) << 5); R = (st >> 1) * 16 + swz / 64; C = (st & 1) * 32 + (swz % 64) / 2; }
__host__ __device__ __forceinline__ int perm32(int rho) { const int n = rho >> 4, i = rho & 15; return 8 * (i >> 2) + 4 * n + (i & 3); }

struct Unit { int pm, pn; };
struct Gemm { int K; };

struct StaticOrder {
    int nM, nN, nwg, G, c;
    __host__ __device__ void init(int M, int N, int G_, int c_) { nM = M / BM; nN = N / BM; nwg = nM * nN; G = G_; c = c_; }
    __host__ __device__ bool next(int i, Unit& u) const {
        const long L = (long)i * G + c; if (L >= nwg) return false;
        int wgid = (int)L; { const int q = nwg / NXCD, r = nwg % NXCD, xcd = wgid % NXCD, off = wgid / NXCD; wgid = (xcd < r ? xcd * (q + 1) : r * (q + 1) + (xcd - r) * q) + off; }
        const int nig = WGM * nN, gid = wgid / nig, fm = gid * WGM, gsz = (nM - fm) < WGM ? (nM - fm) : WGM;
        u.pm = fm + ((wgid % nig) % gsz); u.pn = (wgid % nig) / gsz; return true;
    }
    __device__ __forceinline__ void a_ready(const Unit&) const {}
    __device__ __forceinline__ void done(const Unit&) const {}
};

__device__ __forceinline__ unsigned cvt_pk_bf16(float lo, float hi) { unsigned r; asm volatile("v_cvt_pk_bf16_f32 %0, %1, %2" : "=v"(r) : "v"(lo), "v"(hi)); return r; }
typedef int i32x4 __attribute__((ext_vector_type(4)));
template <bool I8> struct AccT { typedef f32x4 type; };
template <> struct AccT<true> { typedef i32x4 type; };
__device__ __forceinline__ f32x4 mma_sel(bf16x8 b, bf16x8 a, f32x4 c) { return __builtin_amdgcn_mfma_f32_16x16x32_bf16(b, a, c, 0, 0, 0); }
__device__ __forceinline__ i32x4 mma_sel(bf16x8 b, bf16x8 a, i32x4 c) { return __builtin_amdgcn_mfma_i32_16x16x64_i8(__builtin_bit_cast(i32x4, b), __builtin_bit_cast(i32x4, a), c, 0, 0, 0); }
struct EpiBf {
    static constexpr bool PERM = true, AFTER_DRAIN = false;
    bf16_t* O; int ldc; int s_lo, s_hi; float scale;
    __device__ __forceinline__ void operator()(const f32x4 (&acc)[2][2][4][2], const Unit& u, int wr, int wc, int fr, int fq) const {
        const int row0 = u.pm * BM + wr * 64 + fr, col0 = u.pn * BM + wc * 32 + 8 * fq;
        const float sc = (u.pn >= s_lo && u.pn < s_hi) ? scale : 1.f;
#pragma unroll
        for (int ai = 0; ai < 2; ++ai)
#pragma unroll
            for (int m = 0; m < 4; ++m) { bf16_t* rowp = O + (size_t)(row0 + ai * HALF + m * 16) * ldc + col0;
#pragma unroll
                for (int bj = 0; bj < 2; ++bj) { const f32x4 v0 = acc[ai][bj][m][0] * sc, v1 = acc[ai][bj][m][1] * sc;
                    u32x4 w; w.x = cvt_pk_bf16(v0[0], v0[1]); w.y = cvt_pk_bf16(v0[2], v0[3]); w.z = cvt_pk_bf16(v1[0], v1[1]); w.w = cvt_pk_bf16(v1[2], v1[3]);
                    *(u32x4*)(rowp + bj * HALF) = w; } }
    }
};
__device__ __forceinline__ float silu_mul(float g, float u) { return g * __builtin_amdgcn_rcpf(1.f + __expf(-g)) * u; }
struct EpiSwiglu {
    static constexpr bool PERM = true, AFTER_DRAIN = false;
    bf16_t* O; int ldc;
    __device__ __forceinline__ void operator()(const f32x4 (&acc)[2][2][4][2], const Unit& u, int wr, int wc, int fr, int fq) const {
        const int row0 = u.pm * BM + wr * 64 + fr, col0 = u.pn * HALF + wc * 32 + 8 * fq;
#pragma unroll
        for (int ai = 0; ai < 2; ++ai)
#pragma unroll
            for (int m = 0; m < 4; ++m) { bf16_t* rowp = O + (size_t)(row0 + ai * HALF + m * 16) * ldc + col0;
                const f32x4 g0 = acc[ai][0][m][0], g1 = acc[ai][0][m][1], u0 = acc[ai][1][m][0], u1 = acc[ai][1][m][1];
                u32x4 w; w.x = cvt_pk_bf16(silu_mul(g0[0], u0[0]), silu_mul(g0[1], u0[1])); w.y = cvt_pk_bf16(silu_mul(g0[2], u0[2]), silu_mul(g0[3], u0[3]));
                w.z = cvt_pk_bf16(silu_mul(g1[0], u1[0]), silu_mul(g1[1], u1[1])); w.w = cvt_pk_bf16(silu_mul(g1[2], u1[2]), silu_mul(g1[3], u1[3]));
                *(u32x4*)rowp = w; }
    }
};
struct EpiResid {
    static constexpr bool PERM = false, AFTER_DRAIN = false;
    float* X; int ldc;
    __device__ __forceinline__ void operator()(const f32x4 (&acc)[2][2][4][2], const Unit& u, int wr, int wc, int fr, int fq) const {
        const int row0 = u.pm * BM + wr * 64 + fr, col0 = u.pn * BM + wc * 32 + 4 * fq;
#pragma unroll
        for (int ai = 0; ai < 2; ++ai)
#pragma unroll
            for (int m = 0; m < 4; ++m) { float* rowp = X + (size_t)(row0 + ai * HALF + m * 16) * ldc + col0;
#pragma unroll
                for (int bj = 0; bj < 2; ++bj)
#pragma unroll
                    for (int n = 0; n < 2; ++n) { f32x4* p = (f32x4*)(rowp + bj * HALF + n * 16); *p = *p + acc[ai][bj][m][n]; }
                asm volatile("" ::: "memory"); }
    }
};
struct EpiBf8 {
    static constexpr bool PERM = true, AFTER_DRAIN = false;
    bf16_t* O; int ldc; int s_lo, s_hi; float scale; const float* sA; const float* sB;
    __device__ __forceinline__ void operator()(const i32x4 (&acc)[2][2][4][2], const Unit& u, int wr, int wc, int fr, int fq) const {
        const int row0 = u.pm * BM + wr * 64 + fr, col0 = u.pn * BM + wc * 32 + 8 * fq;
        const float sc = (u.pn >= s_lo && u.pn < s_hi) ? scale : 1.f;
        f32x4 cb[2][2];
#pragma unroll
        for (int bj = 0; bj < 2; ++bj)
#pragma unroll
            for (int n = 0; n < 2; ++n) cb[bj][n] = *(const f32x4*)(sB + col0 + bj * HALF + 4 * n) * sc;
#pragma unroll
        for (int ai = 0; ai < 2; ++ai)
#pragma unroll
            for (int m = 0; m < 4; ++m) { const int row = row0 + ai * HALF + m * 16; const float ra = sA[row]; bf16_t* rowp = O + (size_t)row * ldc + col0;
#pragma unroll
                for (int bj = 0; bj < 2; ++bj) { const f32x4 v0 = __builtin_convertvector(acc[ai][bj][m][0], f32x4) * cb[bj][0] * ra, v1 = __builtin_convertvector(acc[ai][bj][m][1], f32x4) * cb[bj][1] * ra;
                    u32x4 w; w.x = cvt_pk_bf16(v0[0], v0[1]); w.y = cvt_pk_bf16(v0[2], v0[3]); w.z = cvt_pk_bf16(v1[0], v1[1]); w.w = cvt_pk_bf16(v1[2], v1[3]);
                    *(u32x4*)(rowp + bj * HALF) = w; } }
    }
};
struct EpiSwiglu8 {
    static constexpr bool PERM = true, AFTER_DRAIN = false;
    bf16_t* O; int ldc; const float* sA; const float* sB; int sb_exp; int tb1, tb2, tb3, tb4, tb5, tb6, tb7;
    __device__ __forceinline__ void operator()(const i32x4 (&acc)[2][2][4][2], const Unit& u, int wr, int wc, int fr, int fq) const {
        const int row0 = u.pm * BM + wr * 64 + fr, col0 = u.pn * HALF + wc * 32 + 8 * fq;
        const int e = (u.pm >= tb1) + (u.pm >= tb2) + (u.pm >= tb3) + (u.pm >= tb4) + (u.pm >= tb5) + (u.pm >= tb6) + (u.pm >= tb7);
        const float* sb = sB + (size_t)e * sb_exp + u.pn * BM + wc * 32 + 8 * fq;
        const f32x4 sg0 = *(const f32x4*)sb, sg1 = *(const f32x4*)(sb + 4), su0 = *(const f32x4*)(sb + HALF), su1 = *(const f32x4*)(sb + HALF + 4);
#pragma unroll
        for (int ai = 0; ai < 2; ++ai)
#pragma unroll
            for (int m = 0; m < 4; ++m) { const int row = row0 + ai * HALF + m * 16; const float ra = sA[row]; bf16_t* rowp = O + (size_t)row * ldc + col0;
                const f32x4 g0 = __builtin_convertvector(acc[ai][0][m][0], f32x4) * sg0 * ra, g1 = __builtin_convertvector(acc[ai][0][m][1], f32x4) * sg1 * ra;
                const f32x4 u0 = __builtin_convertvector(acc[ai][1][m][0], f32x4) * su0 * ra, u1 = __builtin_convertvector(acc[ai][1][m][1], f32x4) * su1 * ra;
                u32x4 w; w.x = cvt_pk_bf16(silu_mul(g0[0], u0[0]), silu_mul(g0[1], u0[1])); w.y = cvt_pk_bf16(silu_mul(g0[2], u0[2]), silu_mul(g0[3], u0[3]));
                w.z = cvt_pk_bf16(silu_mul(g1[0], u1[0]), silu_mul(g1[1], u1[1])); w.w = cvt_pk_bf16(silu_mul(g1[2], u1[2]), silu_mul(g1[3], u1[3]));
                *(u32x4*)rowp = w; }
    }
};
struct GOrder {
    StaticOrder so; const char* A; const char* B; size_t a_tile, b_tile, b_exp; int tb1, tb2, tb3, tb4, tb5, tb6, tb7;
    __device__ __forceinline__ bool next(int i, Unit& u) const { return so.next(i, u); }
    __device__ __forceinline__ const char* a_base(const Unit& u) const { return A + (size_t)u.pm * a_tile; }
    __device__ __forceinline__ const char* b_base(const Unit& u) const {
        const int e = (u.pm >= tb1) + (u.pm >= tb2) + (u.pm >= tb3) + (u.pm >= tb4) + (u.pm >= tb5) + (u.pm >= tb6) + (u.pm >= tb7);
        return B + (size_t)e * b_exp + (size_t)u.pn * b_tile; }
    __device__ __forceinline__ void a_ready(const Unit&) const {}
    __device__ __forceinline__ void done(const Unit&) const {}
};
template <class Epi, class Sched, bool ALIGN_EPI = false, bool SP2 = false, bool I8 = false>
__device__ __forceinline__ void gemm_phase(PG8_LAS unsigned char* lds, const Gemm g, const Sched& S, const Epi& E) {
    const int tid = threadIdx.x, wid = __builtin_amdgcn_readfirstlane(tid >> 6), lane = tid & 63, wr = wid >> 2, wc = wid & 3, fr = lane & 15, fq = lane >> 4;
    const int K = g.K, nt = K / BK;
    unsigned voffA[2], voffB[2];
#pragma unroll
    for (int i = 0; i < 2; ++i) { int R, C; stage_rc(tid * 16 + i * 8192, R, C); const int Rb = Epi::PERM ? ((R & ~31) + perm32(R & 31)) : R;
        voffA[i] = (unsigned)(R * K + C) * 2u; voffB[i] = (unsigned)(Rb * K + C) * 2u; }
    const size_t kstep = (size_t)(BK * 2);
    const size_t hstep = (size_t)HALF * K * 2;
        const unsigned ldsw = (unsigned)wid * 1024u;
    const int aoff = lds_byte(wr * 64 + fr, fq * 8), boff = lds_byte(wc * 32 + fr, fq * 8);
#define PG8_SA(b, h) (((b) * 2 + (h)) * HTB)
#define PG8_SB(b, h) ((4 + (b) * 2 + (h)) * HTB)
#define PG8_STAGE(bufoff, gbase, voff) do { _Pragma("unroll") for (int _i = 0; _i < 2; ++_i) \
        __builtin_amdgcn_global_load_lds((const unsigned*)((const char*)(gbase) + (voff)[_i]), (PG8_LAS unsigned*)(lds + (bufoff) + ldsw + _i * 8192), 16, 0, 0); } while (0)
#define PG8_LDA(dst, b, h) do { _Pragma("unroll") for (int m = 0; m < 4; ++m) _Pragma("unroll") for (int k = 0; k < 2; ++k) dst[m][k] = *(const PG8_LAS bf16x8*)(lds + PG8_SA(b, h) + aoff + m * 2048 + k * 1024); } while (0)
#define PG8_LDB(dst, b, h) do { _Pragma("unroll") for (int n = 0; n < 2; ++n) _Pragma("unroll") for (int k = 0; k < 2; ++k) dst[n][k] = *(const PG8_LAS bf16x8*)(lds + PG8_SB(b, h) + boff + n * 2048 + k * 1024); } while (0)
#define PG8_MMA(ai, bj, At, Bt) do { __builtin_amdgcn_s_setprio(1); _Pragma("unroll") for (int m = 0; m < 4; ++m) _Pragma("unroll") for (int n = 0; n < 2; ++n) _Pragma("unroll") for (int k = 0; k < 2; ++k) \
        acc[ai][bj][m][n] = mma_sel(Bt[n][k], At[m][k], acc[ai][bj][m][n]); __builtin_amdgcn_s_setprio(0); } while (0)
#define PG8_WAIT_V(n) asm volatile("s_waitcnt vmcnt(" #n ")" ::: "memory")
#define PG8_WAIT_L(n) asm volatile("s_waitcnt lgkmcnt(" #n ")" ::: "memory")
#define PG8_BAR __builtin_amdgcn_s_barrier()
#define PG8_SCHED __builtin_amdgcn_sched_barrier(0)
    Unit cur, nxt; int ui = 0;
    if (!S.next(0, cur)) return;
    typename AccT<I8>::type acc[2][2][4][2];
#pragma unroll
    for (int a = 0; a < 2; ++a)
#pragma unroll
        for (int b = 0; b < 2; ++b)
#pragma unroll
            for (int m = 0; m < 4; ++m)
#pragma unroll
                for (int n = 0; n < 2; ++n) acc[a][b][m][n] = typename AccT<I8>::type{};
    bf16x8 At[4][2], B0[2][2], B1[2][2];
    const char* cA = S.a_base(cur); const char* cB = S.b_base(cur);
    S.a_ready(cur);
    if constexpr (SP2) {
        PG8_STAGE(PG8_SB(0, 0), cB, voffB); PG8_STAGE(PG8_SB(0, 1), cB + hstep, voffB); PG8_STAGE(PG8_SA(0, 0), cA, voffA); PG8_STAGE(PG8_SA(0, 1), cA + hstep, voffA);
        if (wr == 1) PG8_BAR;
        PG8_WAIT_V(2); PG8_BAR;
        PG8_STAGE(PG8_SB(1, 0), cB + kstep, voffB); PG8_STAGE(PG8_SA(1, 0), cA + kstep, voffA); PG8_STAGE(PG8_SB(1, 1), cB + hstep + kstep, voffB);
        PG8_WAIT_V(6); PG8_BAR;
    } else {
        PG8_STAGE(PG8_SB(0, 0), cB, voffB); PG8_STAGE(PG8_SA(0, 0), cA, voffA); PG8_STAGE(PG8_SB(0, 1), cB + hstep, voffB); PG8_STAGE(PG8_SA(0, 1), cA + hstep, voffA);
        if (wr == 1) PG8_BAR;
        PG8_WAIT_V(4); PG8_BAR;
        PG8_STAGE(PG8_SB(1, 0), cB + kstep, voffB); PG8_STAGE(PG8_SA(1, 0), cA + kstep, voffA); PG8_STAGE(PG8_SB(1, 1), cB + hstep + kstep, voffB);
        PG8_WAIT_V(6); PG8_BAR;
    }
    for (;;) {
        const bool has_next = S.next(ui + 1, nxt);
        const char* nA = has_next ? S.a_base(nxt) : cA; const char* nB = has_next ? S.b_base(nxt) : cB;
        for (int t = 0; t < nt; t += 2) {
            const bool last = (t == nt - 2);
            const char* a1 = cA + (size_t)(t + 1) * kstep;
            const char* a2 = last ? nA : cA + (size_t)(t + 2) * kstep; const char* b2 = last ? nB : cB + (size_t)(t + 2) * kstep;
            const char* a3 = a2 + kstep; const char* b3 = b2 + kstep;
            if (last && has_next) S.a_ready(nxt);
            if constexpr (SP2) {
            PG8_LDB(B0, 0, 0); PG8_LDB(B1, 0, 1); PG8_SCHED; PG8_LDA(At, 0, 0); PG8_STAGE(PG8_SA(1, 1), a1 + hstep, voffA);
            PG8_WAIT_V(8); PG8_WAIT_L(0); PG8_BAR; PG8_MMA(0, 0, At, B0); PG8_MMA(0, 1, At, B1); PG8_BAR; PG8_SCHED;
            PG8_LDA(At, 0, 1); PG8_STAGE(PG8_SB(0, 0), b2, voffB); PG8_STAGE(PG8_SB(0, 1), b2 + hstep, voffB); PG8_STAGE(PG8_SA(0, 0), a2, voffA);
            PG8_WAIT_V(8); PG8_WAIT_L(0); PG8_BAR; PG8_MMA(1, 0, At, B0); PG8_MMA(1, 1, At, B1); PG8_BAR; PG8_SCHED;
            PG8_LDB(B0, 1, 0); PG8_LDB(B1, 1, 1); PG8_SCHED; PG8_LDA(At, 1, 0); PG8_STAGE(PG8_SA(0, 1), a2 + hstep, voffA);
            PG8_WAIT_V(8); PG8_WAIT_L(0); PG8_BAR; PG8_MMA(0, 0, At, B0); PG8_MMA(0, 1, At, B1); PG8_BAR; PG8_SCHED;
            PG8_LDA(At, 1, 1); PG8_STAGE(PG8_SB(1, 0), b3, voffB); PG8_STAGE(PG8_SB(1, 1), b3 + hstep, voffB); PG8_STAGE(PG8_SA(1, 0), a3, voffA);
            PG8_WAIT_V(8); PG8_WAIT_L(0); PG8_BAR; PG8_MMA(1, 0, At, B0); PG8_MMA(1, 1, At, B1); PG8_BAR; PG8_SCHED;
            } else {
            PG8_LDB(B0, 0, 0); PG8_SCHED; PG8_LDA(At, 0, 0); PG8_STAGE(PG8_SA(1, 1), a1 + hstep, voffA);
            PG8_WAIT_L(8); PG8_BAR; PG8_WAIT_L(0); PG8_MMA(0, 0, At, B0); PG8_BAR; PG8_SCHED;
            PG8_LDB(B1, 0, 1); PG8_STAGE(PG8_SB(0, 0), b2, voffB);
            PG8_BAR; PG8_WAIT_L(0); PG8_MMA(0, 1, At, B1); PG8_BAR;
            PG8_LDA(At, 0, 1); PG8_STAGE(PG8_SA(0, 0), a2, voffA);
            PG8_BAR; PG8_WAIT_L(0); PG8_MMA(1, 0, At, B0); PG8_BAR; PG8_SCHED;
            PG8_STAGE(PG8_SB(0, 1), b2 + hstep, voffB);
            PG8_WAIT_V(6); PG8_BAR; PG8_MMA(1, 1, At, B1); PG8_BAR;
            PG8_LDB(B0, 1, 0); PG8_SCHED; PG8_LDA(At, 1, 0); PG8_STAGE(PG8_SA(0, 1), a2 + hstep, voffA);
            PG8_WAIT_L(8); PG8_BAR; PG8_WAIT_L(0); PG8_MMA(0, 0, At, B0); PG8_BAR; PG8_SCHED;
            PG8_LDB(B1, 1, 1); PG8_STAGE(PG8_SB(1, 0), b3, voffB);
            PG8_BAR; PG8_WAIT_L(0); PG8_MMA(0, 1, At, B1); PG8_BAR;
            PG8_LDA(At, 1, 1); PG8_STAGE(PG8_SA(1, 0), a3, voffA);
            PG8_BAR; PG8_WAIT_L(0); PG8_MMA(1, 0, At, B0); PG8_BAR; PG8_SCHED;
            PG8_STAGE(PG8_SB(1, 1), b3 + hstep, voffB);
            PG8_WAIT_V(6); PG8_BAR; PG8_MMA(1, 1, At, B1); PG8_BAR;
            }
        }
        if constexpr (ALIGN_EPI) { if (wr == 0) PG8_BAR; }
        if constexpr (!Epi::AFTER_DRAIN) { E(acc, cur, wr, wc, fr, fq); S.done(cur); }
        if (!has_next) break;
#pragma unroll
        for (int a = 0; a < 2; ++a)
#pragma unroll
            for (int b = 0; b < 2; ++b)
#pragma unroll
                for (int m = 0; m < 4; ++m)
#pragma unroll
                    for (int n = 0; n < 2; ++n) acc[a][b][m][n] = typename AccT<I8>::type{};
        cur = nxt; cA = nA; cB = nB; ++ui;
        if constexpr (ALIGN_EPI) { if (wr == 1) PG8_BAR; }
    }
    PG8_WAIT_V(0);
    if constexpr (!ALIGN_EPI) { if (wr == 0) PG8_BAR; }
    PG8_BAR;
    if constexpr (Epi::AFTER_DRAIN) { E.fused(acc, cur, wr, wc, fr, fq, lds, wid, lane); S.done(cur); }
#undef PG8_SA
#undef PG8_SB
#undef PG8_STAGE
#undef PG8_LDA
#undef PG8_LDB
#undef PG8_MMA
#undef PG8_WAIT_V
#undef PG8_WAIT_L
#undef PG8_BAR
#undef PG8_SCHED
}
}
#include <hip/hip_bf16.h>
#include <cmath>
namespace attn_body {
using bf16=__hip_bfloat16;
using bf16x8=__attribute__((ext_vector_type(8)))short;
using s16x4=__attribute__((ext_vector_type(4)))short;
using f32x16=__attribute__((ext_vector_type(16)))float;
using u32x4=__attribute__((ext_vector_type(4)))unsigned;
constexpr int BATCH=2,NHEAD=8,SEQ=8192,D=64,DM=3584,OPITCH=1024;
constexpr int NW=8,QBLK=32,QB=QBLK*NW,KVBLK=64,NQB=SEQ/QB;
constexpr int ATTN_PITCH=DM, ATTN_UNIT_ROWS=QB;
__device__ __forceinline__ int crow(int r,int hi){return (r&3)+8*(r>>2)+4*hi;}
#define SBAR() __builtin_amdgcn_sched_barrier(0)
__device__ __forceinline__ void cmask(f32x16&p0,f32x16&p1,int jb,int qrel,int hi){
  const float NEG=-INFINITY; int kb=64*jb+4*hi;
  #pragma unroll
  for(int r=0;r<16;++r){int kv=kb+(r&3)+8*(r>>2); if(kv>qrel)p0[r]=NEG; if(kv+32>qrel)p1[r]=NEG;}
}

constexpr int NSLOT=3, SLOTB=8192;
constexpr int LDS_K=0, LDS_V=NSLOT*SLOTB, LDS_WS=2*NSLOT*SLOTB, LDS_OST=LDS_WS+NW*64*4, LDS_CK=LDS_OST+NW*4096, LDS_BYTES=LDS_CK+SEQ*4;
constexpr float C2=0.125f*1.4426950408889634f;
__device__ __forceinline__ void glds16(const void*gsrc,unsigned lds_dst){unsigned keep;
  asm volatile("s_mov_b32 %0, m0\n\ts_mov_b32 m0, %2\n\ts_nop 0\n\tglobal_load_lds_dwordx4 %1, off\n\ts_mov_b32 m0, %0":"=&s"(keep):"v"(gsrc),"s"(lds_dst):"memory");}
__device__ __forceinline__ float max3f(float a,float b,float c){float r;asm("v_max3_f32 %0, %1, %2, %3":"=v"(r):"v"(a),"v"(b),"v"(c));return r;}
__device__ __forceinline__ float max2f(float a,float b){float r;asm("v_max_f32_e32 %0, %1, %2":"=v"(r):"v"(a),"v"(b));return r;}
__device__ __forceinline__ float fadd_s(float a,float b){float r;asm("v_add_f32_e32 %0, %1, %2":"=v"(r):"v"(a),"v"(b));return r;}
__device__ __forceinline__ float fsub_s(float a,float b){float r;asm("v_sub_f32_e32 %0, %1, %2":"=v"(r):"v"(a),"v"(b));return r;}
typedef float f32x2_t __attribute__((ext_vector_type(2))); typedef float f32x4_t __attribute__((ext_vector_type(4))); typedef __bf16 bf16x2_t __attribute__((ext_vector_type(2)));
__device__ __forceinline__ unsigned cvtpk_s(float lo,float hi){f32x2_t v={lo,hi};bf16x2_t b=__builtin_convertvector(v,bf16x2_t);return __builtin_bit_cast(unsigned,b);}
#define WAIT_BAR(N) asm volatile("s_waitcnt vmcnt(" #N ") lgkmcnt(0)\n\ts_barrier":::"memory")

__device__ __forceinline__ void qkt(f32x16&p0,f32x16&p1,const char*Kslot,const bf16x8*qr,const f32x16&negm,int r32,int hi){
  const char*kb=Kslot+hi*1024+r32*16;
  #pragma unroll
  for(int d0=0;d0<4;++d0){
    const bf16x8 b0=*reinterpret_cast<const bf16x8*>(kb+d0*2048);
    const bf16x8 b1=*reinterpret_cast<const bf16x8*>(kb+d0*2048+512);
    if(d0==0){p0=__builtin_amdgcn_mfma_f32_32x32x16_bf16(b0,qr[0],negm,0,0,0);p1=__builtin_amdgcn_mfma_f32_32x32x16_bf16(b1,qr[0],negm,0,0,0);}
    else{p0=__builtin_amdgcn_mfma_f32_32x32x16_bf16(b0,qr[d0],p0,0,0,0);p1=__builtin_amdgcn_mfma_f32_32x32x16_bf16(b1,qr[d0],p1,0,0,0);}}
}
typedef __attribute__((address_space(3))) const char* lds_cptr;
typedef short v4i16_t __attribute__((ext_vector_type(4)));
__device__ __forceinline__ void kload8(bf16x8*kf,lds_cptr kp){
  kf[0]=*(const __attribute__((address_space(3))) bf16x8*)(kp);      kf[1]=*(const __attribute__((address_space(3))) bf16x8*)(kp+512);
  kf[2]=*(const __attribute__((address_space(3))) bf16x8*)(kp+2048); kf[3]=*(const __attribute__((address_space(3))) bf16x8*)(kp+2560);
  kf[4]=*(const __attribute__((address_space(3))) bf16x8*)(kp+4096); kf[5]=*(const __attribute__((address_space(3))) bf16x8*)(kp+4608);
  kf[6]=*(const __attribute__((address_space(3))) bf16x8*)(kp+6144); kf[7]=*(const __attribute__((address_space(3))) bf16x8*)(kp+6656);
}
__device__ __forceinline__ void kload2(bf16x8*kf,lds_cptr kp,int j){ kf[2*j]=*(const __attribute__((address_space(3))) bf16x8*)(kp+j*2048); kf[2*j+1]=*(const __attribute__((address_space(3))) bf16x8*)(kp+j*2048+512); }
__device__ __forceinline__ s16x4 vtr(lds_cptr p){ return __builtin_bit_cast(s16x4,__builtin_amdgcn_ds_read_tr16_b64_v4i16((__attribute__((address_space(3))) v4i16_t*)p)); }
__device__ __forceinline__ float rowmax(const f32x16&p0,const f32x16&p1){
  float a=max3f(p0[0],p0[1],p1[0]),b=max3f(p0[2],p0[3],p1[1]);a=max3f(a,p1[2],p1[3]);
  #pragma unroll
  for(int r=4;r<16;r+=4){a=max3f(a,p0[r],p0[r+1]);b=max3f(b,p0[r+2],p0[r+3]);a=max3f(a,p1[r],p1[r+1]);b=max3f(b,p1[r+2],p1[r+3]);}
  const float m=max2f(a,b);
  auto rr=__builtin_amdgcn_permlane32_swap(__float_as_uint(m),__float_as_uint(m),false,false);
  return max2f(__uint_as_float(rr[0]),__uint_as_float(rr[1]));
}
__device__ __forceinline__ void pv(f32x16*o,int vb,bf16x8 pa0,bf16x8 pa1,bf16x8 pa2,bf16x8 pa3){
  #pragma unroll
  for(int d0=0;d0<2;++d0){s16x4 lo[4],hi[4];
    #pragma unroll
    for(int ks=0;ks<4;++ks){
      asm volatile("ds_read_b64_tr_b16 %0,%1 offset:%c2":"=&v"(lo[ks]):"v"(vb),"i"(d0*4096+ks*1024):"memory");
      asm volatile("ds_read_b64_tr_b16 %0,%1 offset:%c2":"=&v"(hi[ks]):"v"(vb),"i"(d0*4096+ks*1024+512):"memory");}
    asm volatile("s_waitcnt lgkmcnt(0)":::"memory");SBAR();
    #define PK(k) (bf16x8){lo[k][0],lo[k][1],lo[k][2],lo[k][3],hi[k][0],hi[k][1],hi[k][2],hi[k][3]}
    o[d0]=__builtin_amdgcn_mfma_f32_32x32x16_bf16(pa0,PK(0),o[d0],0,0,0);
    o[d0]=__builtin_amdgcn_mfma_f32_32x32x16_bf16(pa1,PK(1),o[d0],0,0,0);
    o[d0]=__builtin_amdgcn_mfma_f32_32x32x16_bf16(pa2,PK(2),o[d0],0,0,0);
    o[d0]=__builtin_amdgcn_mfma_f32_32x32x16_bf16(pa3,PK(3),o[d0],0,0,0);
    #undef PK
  }
}

#ifndef ATTN_STORE16
#define ATTN_STORE16(p,v) (*(u32x4*)(p)=(v))
#endif
template<int THRL> __device__ __forceinline__ void attn_unit(int b,int h,int qb,const bf16*Q,const bf16*__restrict__ K,const bf16*__restrict__ V,bf16*O,const float*__restrict__ cf,const float Tskip,char*shm){
  int tid_=threadIdx.x; asm volatile("":"+v"(tid_));
  const int tid=tid_,lane=tid&63,r32=lane&31,hi=lane>>5; const int wid=__builtin_amdgcn_readfirstlane(tid>>6);
  const long rowbase=(long)b*SEQ; const int q0=qb*QB;
  const bf16*Qw=Q+(rowbase+q0+wid*QBLK)*DM+h*D;
  const unsigned lds0=(unsigned)(uintptr_t)shm;
  float*wsf=(float*)(shm+LDS_WS)+wid*64;
  const unsigned kdst=lds0+LDS_K+wid*1024, vdst=lds0+LDS_V+wid*1024;
  #define DMA_K(t,slot) glds16(ksrc+(long)(t)*KVBLK*DM,(unsigned)__builtin_amdgcn_readfirstlane(kdst+(slot)))
  #define DMA_V(t,slot) glds16(vsrc+(long)(t)*KVBLK*DM,(unsigned)__builtin_amdgcn_readfirstlane(vdst+(slot)))
  const int vb0=(int)(lds0+LDS_V)+((lane>>4)&1)*32+(lane&3)*8+(4*hi+((lane&15)>>2))*64;
  const char*Kbase=shm+LDS_K; bf16x8 kf[8];
  const lds_cptr shm3=(lds_cptr)shm; const lds_cptr kp0=shm3+LDS_K+hi*1024+r32*16; const lds_cptr vp0=shm3+LDS_V+((lane>>4)&1)*32+(lane&3)*8+(4*hi+((lane&15)>>2))*64;
  typedef __attribute__((address_space(3))) float lds_f32; typedef __attribute__((address_space(3))) const f32x4_t* lds_cf4;
  const int NT0=(q0+QB)/KVBLK;
  { lds_f32* ckw=(lds_f32*)((lds_cptr)shm+LDS_CK); int i0_=tid; asm volatile("":"+v"(i0_)); _Pragma("nounroll") for(int i=i0_;i<q0+QB;i+=NW*64)ckw[i]=cf[i]; }
  const float cq=cf[q0+wid*QBLK+(lane&31)];
  asm volatile("s_waitcnt vmcnt(0) lgkmcnt(0)\n\ts_barrier":::"memory");
  int tb;
  { const __attribute__((address_space(3))) float* ckt=(const __attribute__((address_space(3))) float*)((lds_cptr)shm+LDS_CK);
    const float thr=ckt[q0]+Tskip; const int t1=lane,t2=lane+64;
    const bool n1=(t1<NT0)&&(ckt[64*t1+63]>thr), n2=(t2<NT0)&&(ckt[64*t2+63]>thr);
    const int t0=(int)__popcll(__ballot(n1))+(int)__popcll(__ballot(n2));
    tb=t0&~1; if(tb>NT0-4)tb=NT0-4; tb=__builtin_amdgcn_readfirstlane(tb); }
  const int NT=NT0-tb;
  const bf16*Kh=K+(rowbase+(long)tb*KVBLK)*DM+h*D,*Vh=V+(rowbase+(long)tb*KVBLK)*DM+h*D;
  const bf16*ksrc=Kh+(long)lane*DM+wid*8;
  const bf16*vsrc=Vh+(long)(16*(wid&3)+(lane>>2))*DM+(wid>>2)*32+(lane&3)*8;
  const lds_cptr ckl=(lds_cptr)shm+LDS_CK+256*tb+16*(lane>>5);
  #define CBIAS(P0,P1,t) do{ const lds_cptr cb_=ckl+256*(t); _Pragma("unroll") for(int g_=0;g_<4;++g_){ const f32x4_t a_=*(lds_cf4)(cb_+32*g_), b_=*(lds_cf4)(cb_+128+32*g_); \
      _Pragma("unroll") for(int i_=0;i_<4;++i_){ P0[4*g_+i_]-=(a_[i_]+mm); P1[4*g_+i_]-=(b_[i_]+mm); } } }while(0)
  f32x4_t cbA[4],cbB[4]; float clast;
  #define CBLD(t) do{ const lds_cptr cb_=ckl+256*(t); _Pragma("unroll") for(int g_=0;g_<4;++g_){ cbA[g_]=*(lds_cf4)(cb_+32*g_); cbB[g_]=*(lds_cf4)(cb_+128+32*g_); } \
      clast=*(const __attribute__((address_space(3))) float*)((lds_cptr)shm+LDS_CK+256*tb+256*(t)+252); }while(0)
  DMA_K(0,0);DMA_V(0,0);DMA_K(1,SLOTB);
  bf16x8 qr[4];
  #pragma unroll
  for(int d0=0;d0<4;++d0)qr[d0]=*reinterpret_cast<const bf16x8*>(&Qw[(long)r32*DM+d0*16+hi*8]);
  float mhat=0.f,l_reg=0.f;f32x16 o[2];o[0]=f32x16{};o[1]=f32x16{};float mm=-cq; const f32x16 negm=f32x16{};
  const int qrel=wid*QBLK+r32;
  #define CMASK(P0,P1,t) do{int jb_=(t)-(NT-4); if(jb_>=0)cmask(P0,P1,jb_,qrel,hi);}while(0)
  bool resc=false;
  #define START(P0,P1) do{ const float rm=rowmax(P0,P1); resc=false; \
    { const float dl=rm; mhat=fadd_s(mhat,dl); \
      _Pragma("unroll") for(int r=0;r<16;++r){P0[r]=fsub_s(P0[r],dl);P1[r]=fsub_s(P1[r],dl);} \
      mm+=dl; } \
    _Pragma("unroll") for(int r=0;r<16;++r)P0[r]=__builtin_amdgcn_exp2f(P0[r]); }while(0)
  #define RESC() do{ if(resc){ asm volatile("s_waitcnt lgkmcnt(0)":::"memory"); \
      _Pragma("unroll") for(int d_=0;d_<2;++d_) _Pragma("unroll") for(int r=0;r<16;++r)o[d_][r]*=wsf[crow(r,hi)]; } }while(0)
  f32x16 pA0,pA1,pB0,pB1;
  int sl_prev=0,sl_cur=0,sl_next=SLOTB;
  #define ROT() do{sl_prev=sl_cur;sl_cur=sl_next;sl_next=(sl_next==(NSLOT-1)*SLOTB)?0:sl_next+SLOTB;}while(0)
  DMA_K(2,2*SLOTB);
  WAIT_BAR(3);
  qkt(pA0,pA1,Kbase,qr,negm,r32,hi);asm volatile("s_nop 15\n\ts_nop 7":"+v"(pA0),"+v"(pA1));CBIAS(pA0,pA1,0);CMASK(pA0,pA1,0);
  START(pA0,pA1);
  _Pragma("unroll") for(int r=0;r<16;++r)pA1[r]=__builtin_amdgcn_exp2f(pA1[r]);
  WAIT_BAR(0);
  DMA_K(3,0);DMA_V(1,SLOTB);
  ROT();
  kload8(kf,kp0+sl_cur);
  WAIT_BAR(2);
  s16x4 vlo[8],vhi[8]; u32x4 pw0,pw1,pw2,pw3;
  #define PKW(P,B) cvtpk_s(P[B],P[B+1])
  #define PAF(k) __builtin_bit_cast(bf16x8,pw##k)
  #define VFR(i) (bf16x8){vlo[i][0],vlo[i][1],vlo[i][2],vlo[i][3],vhi[i][0],vhi[i][1],vhi[i][2],vhi[i][3]}
  #define PIN(x) asm volatile("":"+v"(x))
  #define MX3(a,b,c) __builtin_fmaxf(__builtin_fmaxf((a),(b)),(c))
  #define GAPA(MF,A0,A1,A2,A3,W0,W1,PW) do{ MF; sacc+=A0; sacc+=A1; sacc+=A2; sacc+=A3; PIN(sacc); W0; W1; PIN(PW); SBAR(); }while(0)
  #define EX(v) __builtin_amdgcn_exp2f(v)
  #define GAPB(MF,X,B,CB) do{ MF; { const f32x4_t t_=(CB)+mm; X[B]=EX(X[B]-t_[0]); X[B+1]=EX(X[B+1]-t_[1]); X[B+2]=EX(X[B+2]-t_[2]); X[B+3]=EX(X[B+3]-t_[3]); } PIN(X); SBAR(); }while(0)
  #define VRD(i) do{ vlo[i]=vtr(vp_+(((i)>>2)*4096+((i)&3)*1024)); vhi[i]=vtr(vp_+(((i)>>2)*4096+((i)&3)*1024+512)); }while(0)
  #define KRD(G,j) do{ if(G){ kload2(kf,kp0+sl_next,j); SBAR(); } }while(0)
  #define STEP(C0,C1,P0,P1,t,GK,GV,GL) do{ SBAR(); \
    const lds_cptr vp_=vp0+sl_prev; \
    VRD(0); SBAR(); float sacc=(P0[0]+P0[1]); \
    GAPA(C0=__builtin_amdgcn_mfma_f32_32x32x16_bf16(kf[0],qr[0],negm,0,0,0), P0[2],P0[3],P0[4],P0[5],     pw0[0]=PKW(P0,0), pw0[1]=PKW(P0,2), pw0); \
    VRD(4); SBAR(); GAPA(C1=__builtin_amdgcn_mfma_f32_32x32x16_bf16(kf[1],qr[0],negm,0,0,0), P0[6],P0[7],P0[8],P0[9],     pw0[2]=PKW(P0,4), pw0[3]=PKW(P0,6), pw0); \
    VRD(1); SBAR(); GAPA(C0=__builtin_amdgcn_mfma_f32_32x32x16_bf16(kf[2],qr[1],C0,0,0,0),   P0[10],P0[11],P0[12],P0[13], pw1[0]=PKW(P0,8), pw1[1]=PKW(P0,10), pw1); \
    VRD(5); SBAR(); GAPA(C1=__builtin_amdgcn_mfma_f32_32x32x16_bf16(kf[3],qr[1],C1,0,0,0),   P0[14],P0[15],P1[0],P1[1],   pw1[2]=PKW(P0,12),pw1[3]=PKW(P0,14), pw1); \
    VRD(2); SBAR(); GAPA(C0=__builtin_amdgcn_mfma_f32_32x32x16_bf16(kf[4],qr[2],C0,0,0,0),   P1[2],P1[3],P1[4],P1[5],     pw2[0]=PKW(P1,0), pw2[1]=PKW(P1,2), pw2); \
    VRD(6); SBAR(); GAPA(C1=__builtin_amdgcn_mfma_f32_32x32x16_bf16(kf[5],qr[2],C1,0,0,0),   P1[6],P1[7],P1[8],P1[9],     pw2[2]=PKW(P1,4), pw2[3]=PKW(P1,6), pw2); \
    VRD(3); SBAR(); GAPA(C0=__builtin_amdgcn_mfma_f32_32x32x16_bf16(kf[6],qr[3],C0,0,0,0),   P1[10],P1[11],P1[12],P1[13], pw3[0]=PKW(P1,8), pw3[1]=PKW(P1,10), pw3); \
    VRD(7); SBAR(); GAPA(C1=__builtin_amdgcn_mfma_f32_32x32x16_bf16(kf[7],qr[3],C1,0,0,0),   P1[14],P1[15],0.f,0.f,       pw3[2]=PKW(P1,12),pw3[3]=PKW(P1,14), pw3); \
    l_reg+=sacc; \
    if(GK){DMA_K((t)+3,sl_cur);} if(GV){DMA_V((t)+1,sl_next);} \
    CBLD(t); CMASK(C0,C1,t); \
    { float a=MX3(C0[0],C0[1],C1[0]),b=MX3(C0[2],C0[3],C1[1]); a=MX3(a,C1[2],C1[3]); \
      _Pragma("unroll") for(int r=4;r<16;r+=4){a=MX3(a,C0[r],C0[r+1]);b=MX3(b,C0[r+2],C0[r+3]);a=MX3(a,C1[r],C1[r+1]);b=MX3(b,C1[r+2],C1[r+3]);} \
      float rm=__builtin_fmaxf(a,b); { auto rr=__builtin_amdgcn_permlane32_swap(__float_as_uint(rm),__float_as_uint(rm),false,false); rm=__builtin_fmaxf(__uint_as_float(rr[0]),__uint_as_float(rr[1])); } rm=rm-clast-mm; \
      resc=false; \
      if(__builtin_expect(__any(rm>(float)THRL),0)){ const float dl=__builtin_fmaxf(rm,0.f); mhat+=dl; \
        mm+=dl; \
        const float f=__builtin_amdgcn_exp2f(-dl); l_reg*=f; if(hi==0)wsf[r32]=f; resc=true; } } \
    SBAR(); \
    GAPB(o[0]=__builtin_amdgcn_mfma_f32_32x32x16_bf16(PAF(0),VFR(0),o[0],0,0,0), C0,0,cbA[0]); \
    GAPB(o[1]=__builtin_amdgcn_mfma_f32_32x32x16_bf16(PAF(0),VFR(4),o[1],0,0,0), C0,4,cbA[1]); \
    KRD(GL,0); GAPB(o[0]=__builtin_amdgcn_mfma_f32_32x32x16_bf16(PAF(1),VFR(1),o[0],0,0,0), C0,8,cbA[2]); \
    KRD(GL,1); GAPB(o[1]=__builtin_amdgcn_mfma_f32_32x32x16_bf16(PAF(1),VFR(5),o[1],0,0,0), C0,12,cbA[3]); \
    KRD(GL,2); GAPB(o[0]=__builtin_amdgcn_mfma_f32_32x32x16_bf16(PAF(2),VFR(2),o[0],0,0,0), C1,0,cbB[0]); \
    KRD(GL,3); GAPB(o[1]=__builtin_amdgcn_mfma_f32_32x32x16_bf16(PAF(2),VFR(6),o[1],0,0,0), C1,4,cbB[1]); \
    GAPB(o[0]=__builtin_amdgcn_mfma_f32_32x32x16_bf16(PAF(3),VFR(3),o[0],0,0,0), C1,8,cbB[2]); \
    GAPB(o[1]=__builtin_amdgcn_mfma_f32_32x32x16_bf16(PAF(3),VFR(7),o[1],0,0,0), C1,12,cbB[3]); \
    }while(0)
  int t=1;
  #undef CMASK
  #define CMASK(P0,P1,t) do{}while(0)
  for(;t+5<NT;t+=2){
    STEP(pB0,pB1,pA0,pA1,t,true,true,true);     WAIT_BAR(2); RESC(); ROT();
    STEP(pA0,pA1,pB0,pB1,t+1,true,true,true);   WAIT_BAR(2); RESC(); ROT();
  }
  #undef CMASK
  #define CMASK(P0,P1,t) do{int jb_=(t)-(NT-4); if(jb_>=0)cmask(P0,P1,jb_,qrel,hi);}while(0)
  #define ENDW(tt) do{ if((tt)+3<NT){WAIT_BAR(2);} else if((tt)+2<NT){WAIT_BAR(1);} else {WAIT_BAR(0);} }while(0)
  for(;t+1<NT;t+=2){
    STEP(pB0,pB1,pA0,pA1,t,(t+3<NT),(t+1<NT),(t+1<NT));       ENDW(t);   RESC(); ROT();
    STEP(pA0,pA1,pB0,pB1,t+1,(t+4<NT),(t+2<NT),(t+2<NT));     ENDW(t+1); RESC(); ROT();
  }
  STEP(pB0,pB1,pA0,pA1,NT-1,false,false,false); RESC();
  { float sacc=pB0[0]+pB0[1]; _Pragma("unroll") for(int r=2;r<16;++r)sacc+=pB0[r]; _Pragma("unroll") for(int r=0;r<16;++r)sacc+=pB1[r]; l_reg+=sacc;
    pw0=(u32x4){PKW(pB0,0),PKW(pB0,2),PKW(pB0,4),PKW(pB0,6)};pw1=(u32x4){PKW(pB0,8),PKW(pB0,10),PKW(pB0,12),PKW(pB0,14)};pw2=(u32x4){PKW(pB1,0),PKW(pB1,2),PKW(pB1,4),PKW(pB1,6)};pw3=(u32x4){PKW(pB1,8),PKW(pB1,10),PKW(pB1,12),PKW(pB1,14)};
    SBAR(); pv(o,vb0+sl_cur,PAF(0),PAF(1),PAF(2),PAF(3)); }
  #undef PKW
  #undef PAF
  #undef VFR
  #undef PIN
  #undef MX3
  #undef GAPA
  #undef GAPB
  #undef EX
  #undef VRD
  #undef KRD
  #undef STEP
  #undef ENDW
  {auto rr=__builtin_amdgcn_permlane32_swap(__float_as_uint(l_reg),__float_as_uint(l_reg),false,false);l_reg=__uint_as_float(rr[0])+__uint_as_float(rr[1]);}
  if(hi==0)wsf[32+r32]=l_reg;asm volatile("s_waitcnt lgkmcnt(0)":::"memory");
  float rli[16];
  #pragma unroll
  for(int r=0;r<16;++r)rli[r]=__builtin_amdgcn_rcpf(wsf[32+crow(r,hi)]);
  bf16*Ow=O+(rowbase+q0+wid*QBLK)*OPITCH+h*D;
  { bf16*stg=(bf16*)(shm+LDS_OST)+wid*2048;
    #pragma unroll
    for(int r=0;r<16;++r){const int orow=crow(r,hi);
      #pragma unroll
      for(int d0=0;d0<2;++d0)stg[orow*64+d0*32+r32]=__float2bfloat16(o[d0][r]*rli[r]);}
    asm volatile("s_waitcnt lgkmcnt(0)":::"memory");
    #pragma unroll
    for(int i=0;i<4;++i){const int row=i*8+(lane>>3),ch=lane&7; const u32x4 v=*(const u32x4*)(stg+row*64+ch*8); ATTN_STORE16(Ow+(long)row*OPITCH+ch*8,v);} }
  asm volatile("s_waitcnt lgkmcnt(0)\n\ts_barrier":::"memory");
  #undef CBIAS
  #undef CBLD
  #undef DMA_K
  #undef DMA_V
  #undef CMASK
  #undef START
  #undef RESC
  #undef ROT
}
constexpr int ATTN_LDS_BYTES=LDS_BYTES;
struct AttnTensors { const bf16* Q; const bf16* K; const bf16* V; bf16* O; const float* CF; const float* stat; };
struct AttnUnit { int bh; int qb; };
struct StaticOrder {
  int vcu;
  __device__ __forceinline__ explicit StaticOrder(int grid,int block):vcu((grid%8==0)?(block%8)*(grid/8)+block/8:block),G_(grid){}
  int G_;
  __device__ __forceinline__ bool next(int i,AttnUnit&u)const{ const int v=vcu+(i>>1)*G_; if(v>=256)return false; const int s=v&15; u.bh=v>>4; u.qb=(i&1)?31-s:s; return true; }
  __device__ __forceinline__ void a_ready(const AttnUnit&)const{}
  __device__ __forceinline__ void done(const AttnUnit&)const{}
};
struct QueueOrder {
  unsigned* ctr; __attribute__((address_space(3))) unsigned* slot;
  __device__ __forceinline__ bool next(int,AttnUnit&u)const{
    if(threadIdx.x==0)*slot=__hip_atomic_fetch_add(ctr,1u,__ATOMIC_RELAXED,__HIP_MEMORY_SCOPE_AGENT);
    asm volatile("s_waitcnt vmcnt(0) lgkmcnt(0)\n\ts_barrier":::"memory");
    const unsigned v=*(volatile __attribute__((address_space(3))) unsigned*)slot; const int vv=__builtin_amdgcn_readfirstlane((int)v);
    if(vv>=512)return false; u.qb=31-(vv>>4); u.bh=vv&15; return true; }
  __device__ __forceinline__ void a_ready(const AttnUnit&)const{}
  __device__ __forceinline__ void done(const AttnUnit&)const{}
};
template<class Sched,int THRL=8> __device__ __forceinline__ void attn_phase(char*lds,const AttnTensors&T,const Sched&S){
  AttnUnit u;
  for(int i=0;S.next(i,u);++i){ S.a_ready(u); const float Tsk=40.f+2.f*__builtin_sqrtf(T.stat[u.bh*2]*T.stat[u.bh*2+1])*1.01f+1.f;
    attn_unit<THRL>(u.bh/NHEAD,u.bh%NHEAD,u.qb,T.Q,T.K,T.V,T.O,T.CF+(long)u.bh*SEQ,Tsk,lds); S.done(u); }
}
#undef SBAR
#undef WAIT_BAR
}
#define GAS __attribute__((address_space(1)))
#define LAS __attribute__((address_space(3)))
typedef unsigned v4u __attribute__((ext_vector_type(4)));
typedef float f32x4 __attribute__((ext_vector_type(4)));
typedef short bf16x8 __attribute__((ext_vector_type(8)));
typedef GAS unsigned gu32;
typedef GAS unsigned long long gu64;
#define RLX_AGENT __ATOMIC_RELAXED, __HIP_MEMORY_SCOPE_AGENT
#define LDS_WAIT() asm volatile("s_waitcnt lgkmcnt(0)" ::: "memory")
#define VM_WAIT() asm volatile("s_waitcnt vmcnt(0)" ::: "memory")
__device__ __forceinline__ unsigned long long rt() { return __builtin_amdgcn_s_memrealtime(); }
__device__ __forceinline__ unsigned pk2(float lo, float hi) { return (unsigned)f2bf(lo) | ((unsigned)f2bf(hi) << 16); }

#define XB_TMO      128
#define XB_XCNT(j)  (256  + 64 * (j))
#define XB_XSUB(j)  (1280 + 64 * (j))
#define XB_XGEN(j)  (2304 + 64 * (j))
#define XB_TOP      3328
#define XB_TOPGEN   3392
#define XCD_BAR_WORDS 3456
#define XB_SPIN_CAP (1u << 18)

__device__ __forceinline__ unsigned xb_ld(unsigned* p)              { return __hip_atomic_load(p, __ATOMIC_RELAXED, __HIP_MEMORY_SCOPE_AGENT); }
__device__ __forceinline__ unsigned xb_add(unsigned* p, unsigned v) { return __hip_atomic_fetch_add(p, v, __ATOMIC_RELAXED, __HIP_MEMORY_SCOPE_AGENT); }
__device__ __forceinline__ unsigned xb_xcc_id() { return (unsigned)__builtin_amdgcn_s_getreg((3 << 11) | 20) & 0xFu; }
#define XB_SPIN(cond, bar) do { unsigned _sp = 0; while (cond) { __builtin_amdgcn_s_sleep(1); \
    if ((++_sp & 255u) == 0u) { if (xb_ld(&(bar)[XB_TMO])) break; if (_sp > XB_SPIN_CAP) { atomicAdd(&(bar)[XB_TMO], 1u); break; } } } } while (0)

struct XcdBarrier {
    unsigned* bar; unsigned x;
    volatile LAS unsigned* st;
};

__device__ __forceinline__ XcdBarrier xcd_barrier_post(unsigned* bar, volatile LAS unsigned* st) {
    XcdBarrier b; b.bar = bar; b.x = xb_xcc_id(); b.st = st;
    if (threadIdx.x == 0) (void)xb_add(&bar[XB_XCNT(b.x)], 1u);
    return b;
}
__device__ __forceinline__ void xcd_barrier_complete(unsigned* bar, unsigned x, unsigned& nloc, unsigned& nx) {
    const unsigned G = gridDim.x * gridDim.y * gridDim.z;
    unsigned sum, cnt, mine, sp = 0u;
    for (;;) {
        sum = 0u; cnt = 0u; mine = 0u;
#pragma unroll
        for (unsigned j = 0; j < 16; ++j) { const unsigned c = xb_ld(&bar[XB_XCNT(j)]); sum += c; cnt += (c > 0u) ? 1u : 0u; mine = (j == x) ? c : mine; }
        if (sum == G) break;
        __builtin_amdgcn_s_sleep(1);
        if ((++sp & 255u) == 0u) { if (xb_ld(&bar[XB_TMO])) break; if (sp > XB_SPIN_CAP) { atomicAdd(&bar[XB_TMO], 1u); break; } }
    }
    nloc = mine > 0u ? mine : 1u; nx = cnt > 0u ? cnt : 1u;
}

__device__ __forceinline__ void xcd_barrier(const XcdBarrier& b) {
    asm volatile("s_waitcnt vmcnt(0)" ::: "memory");
    __syncthreads();
    if (threadIdx.x == 0) {
        unsigned* bar = b.bar;
        __builtin_amdgcn_s_waitcnt(0);
        unsigned nloc = b.st[0], nx = b.st[1];
        if (nloc == 0u) { xcd_barrier_complete(bar, b.x, nloc, nx); b.st[0] = nloc; b.st[1] = nx; }
        const unsigned old = xb_add(&bar[XB_XSUB(b.x)], 1u);
        const unsigned gen = old / nloc;
        if (old + 1u == (gen + 1u) * nloc) {
            __builtin_amdgcn_fence(__ATOMIC_RELEASE, "agent");
            asm volatile("s_waitcnt vmcnt(0)" ::: "memory");
            const unsigned og = xb_add(&bar[XB_TOP], 1u);
            const unsigned tg = og / nx;
            if (og + 1u == (tg + 1u) * nx) xb_add(&bar[XB_TOPGEN], 1u);
            else XB_SPIN(xb_ld(&bar[XB_TOPGEN]) == tg, bar);
            __builtin_amdgcn_fence(__ATOMIC_ACQUIRE, "agent");
            xb_add(&bar[XB_XGEN(b.x)], 1u);
            asm volatile("s_waitcnt vmcnt(0)" ::: "memory");
        } else {
            XB_SPIN(xb_ld(&bar[XB_XGEN(b.x)]) == gen, bar);
            __builtin_amdgcn_fence(__ATOMIC_ACQUIRE, "agent");
            asm volatile("s_waitcnt vmcnt(0)" ::: "memory");
        }
    }
    __syncthreads();
}
constexpr int NWAVES = 8, NTHR = 512;
constexpr int RING_OFF = 0, RING_BYTES = 131072, LDSCTL_OFF = RING_BYTES, MISC_OFF = LDSCTL_OFF + 320, LDS_BYTES = 147456;
constexpr int CW_BAR = 4096;
constexpr size_t WS_WIN = WS_W  , WS_SWIN = WS_W + 8 * MiB  , WS_WOUT = WS_W + 14 * MiB  , WS_WDGU = WS_W + 18 * MiB  , WS_SWDGU = WS_W + 24 * MiB  , WS_WDDN = WS_W + 29 * MiB  ;
constexpr size_t WS_SH = WS_H + 16 * MiB  , WS_SXG = WS_XG + 34 * MiB  ;
constexpr size_t WS_WMGU = WS_W  , WS_SWMGU = WS_W + 60 * MiB  , WS_WMDN = WS_W + 64 * MiB  ;
static_assert(WS_WMDN + 56 * MiB <= 469 * MiB, "ws");
struct MArgs { const float* in[20]; float* out; unsigned char* ws; int ph_lo, ph_hi; };
enum { I_X = 0, I_ATTN_NORM, I_W_IN, I_HGRN_LB, I_HGRN_NORM, I_MLSTM_CONV, I_MLSTM_BI, I_MLSTM_BF, I_MLSTM_NORM, I_FOX_BF, I_W_OUT, I_FFN_NORM, I_DGATE, I_DUP, I_DDOWN, I_ROUTER, I_MGATE, I_MUP, I_MDOWN, I_FINAL_NORM };

__device__ __forceinline__ void tr_item(const float* W, int ldw, int K, bf16_t* WT, LAS float* scr, int k0, int lane) {
#pragma unroll 8
    for (int i = 0; i < 32; ++i) { const int kk = 2 * i + (lane >> 5); scr[kk * 33 + (lane & 31)] = W[(size_t)(k0 + kk) * ldw + (lane & 31)]; }
    LDS_WAIT(); asm volatile("" ::: "memory");
    const int c = lane & 7;
#pragma unroll
    for (int j = 0; j < 4; ++j) { const int n = (lane >> 3) + 8 * j; const LAS float* s = scr + (8 * c) * 33 + n;
        v4u o; o.x = pk2(s[0 * 33], s[1 * 33]); o.y = pk2(s[2 * 33], s[3 * 33]); o.z = pk2(s[4 * 33], s[5 * 33]); o.w = pk2(s[6 * 33], s[7 * 33]);
        *(GAS v4u*)(WT + (size_t)n * K + k0 + 8 * c) = o; }
    LDS_WAIT(); asm volatile("" ::: "memory");
}
__device__ __forceinline__ int glu_row(int c, int up) { return (c >> 7) * 256 + (c & 127) + up * 128; }

template <int MODE> __device__ __forceinline__ void mrow(const float* src, float* X, signed char* H8, float* SH, const float* gain, const LAS float* tab, float* G, int row, int lane, float (&lg)[8]) {
    const float4* xr = (const float4*)(src + (size_t)row * D) + lane;
    float4 v[4]; float ss = 0.f;
#pragma unroll
    for (int j = 0; j < 4; ++j) { v[j] = xr[64 * j]; ss += v[j].x * v[j].x + v[j].y * v[j].y + v[j].z * v[j].z + v[j].w * v[j].w; }
    ss = wave_sum(ss);
    const float r = rsqrtf(ss * (1.f / D) + EPS);
    if (X != src) { float4* xo = (float4*)(X + (size_t)row * D) + lane;
#pragma unroll
        for (int j = 0; j < 4; ++j) xo[64 * j] = v[j]; }
    float h[16];
#pragma unroll
    for (int j = 0; j < 4; ++j) { const float4 g = *((const float4*)gain + 64 * j + lane);
        h[4 * j + 0] = v[j].x * r * g.x; h[4 * j + 1] = v[j].y * r * g.y; h[4 * j + 2] = v[j].z * r * g.z; h[4 * j + 3] = v[j].w * r * g.w; }
    { float am = 0.f;
#pragma unroll
      for (int i = 0; i < 16; ++i) am = fmaxf(am, fabsf(h[i]));
#pragma unroll
      for (int o = 1; o < 64; o <<= 1) am = fmaxf(am, __shfl_xor(am, o));
      const float inv = am > 0.f ? 127.f / am : 0.f;
#pragma unroll
      for (int j = 0; j < 4; ++j) { const int q0 = (int)rintf(h[4 * j] * inv), q1 = (int)rintf(h[4 * j + 1] * inv), q2 = (int)rintf(h[4 * j + 2] * inv), q3 = (int)rintf(h[4 * j + 3] * inv);
          *((unsigned*)(H8 + (size_t)row * D) + 64 * j + lane) = (unsigned)(q0 & 255) | ((unsigned)(q1 & 255) << 8) | ((unsigned)(q2 & 255) << 16) | ((unsigned)(q3 & 255) << 24); }
      if (lane == 0) SH[row] = am > 0.f ? am * (1.f / 127.f) : 1.f; }
    if (MODE == 0) {
        float mine = 0.f;
#pragma unroll 2
        for (int c = 0; c < 16; ++c) { float s = 0.f;
#pragma unroll
            for (int j = 0; j < 4; ++j) { const f32x4 w = *(const LAS f32x4*)(tab + c * 1024 + 256 * j + 4 * lane); s += h[4 * j] * w[0] + h[4 * j + 1] * w[1] + h[4 * j + 2] * w[2] + h[4 * j + 3] * w[3]; }
            s = wave_sum(s); if (lane == c) mine = s; }
        if (lane < 16) G[(size_t)row * GW + lane] = mine;
    }
    if (MODE == 2) {
        float v0 = -INFINITY, v1 = -INFINITY; int e0 = 0, e1 = 0;
#pragma unroll 2
        for (int c = 0; c < 8; ++c) { float s = 0.f;
#pragma unroll
            for (int j = 0; j < 4; ++j) { const f32x4 w = *(const LAS f32x4*)(tab + c * 1024 + 256 * j + 4 * lane); s += h[4 * j] * w[0] + h[4 * j + 1] * w[1] + h[4 * j + 2] * w[2] + h[4 * j + 3] * w[3]; }
            s = wave_sum(s);
            if (s > v0) { v1 = v0; e1 = e0; v0 = s; e0 = c; } else if (s > v1) { v1 = s; e1 = c; } }
        lg[0] = v0; lg[1] = v1; lg[2] = __int_as_float(e0); lg[3] = __int_as_float(e1);
    }
}
__device__ __forceinline__ void load_gate_tab(LAS float* tab, const float* w_in, int tid) {
    for (int k = tid; k < D; k += NTHR) { const float4* w0 = (const float4*)(w_in + (size_t)k * DIN + 1792); const float4* w1 = (const float4*)(w_in + (size_t)k * DIN + 3592);
        const float4 a0 = w0[0], a1 = w0[1], b0 = w1[0], b1 = w1[1];
        tab[0 * 1024 + k] = a0.x; tab[1 * 1024 + k] = a0.y; tab[2 * 1024 + k] = a0.z; tab[3 * 1024 + k] = a0.w; tab[4 * 1024 + k] = a1.x; tab[5 * 1024 + k] = a1.y; tab[6 * 1024 + k] = a1.z; tab[7 * 1024 + k] = a1.w;
        tab[8 * 1024 + k] = b0.x; tab[9 * 1024 + k] = b0.y; tab[10 * 1024 + k] = b0.z; tab[11 * 1024 + k] = b0.w; tab[12 * 1024 + k] = b1.x; tab[13 * 1024 + k] = b1.y; tab[14 * 1024 + k] = b1.z; tab[15 * 1024 + k] = b1.w; }
}
__device__ __forceinline__ void load_router_tab(LAS float* tab, const float* router, int tid) {
    for (int k = tid; k < D; k += NTHR) { const float4* w0 = (const float4*)(router + (size_t)k * NE); const float4 a0 = w0[0], a1 = w0[1];
        tab[0 * 1024 + k] = a0.x; tab[1 * 1024 + k] = a0.y; tab[2 * 1024 + k] = a0.z; tab[3 * 1024 + k] = a0.w; tab[4 * 1024 + k] = a1.x; tab[5 * 1024 + k] = a1.y; tab[6 * 1024 + k] = a1.z; tab[7 * 1024 + k] = a1.w; }
}
__device__ __forceinline__ void conv8_block(const float* W, int ldw, signed char* WT8, float* S, LAS float* img, LAS float* pm, int tid, int wave) {
    const int lane = tid & 63, n = lane & 31, kp = lane >> 5;
    float m = 0.f;
#pragma unroll 8
    for (int i = 0; i < 64; ++i) { const int k = 128 * wave + 2 * i + kp; const float v = W[(size_t)k * ldw + n]; img[k * 32 + n] = v; m = fmaxf(m, fabsf(v)); }
    m = fmaxf(m, __shfl_xor(m, 32));
    if (lane < 32) pm[wave * 32 + lane] = m;
    __syncthreads();
    const int no = lane >> 1, kh = 128 * wave + 64 * (lane & 1);
    float cm = 0.f;
#pragma unroll
    for (int w = 0; w < 8; ++w) cm = fmaxf(cm, pm[w * 32 + no]);
    const float inv = cm > 0.f ? 127.f / cm : 0.f;
    if (wave == 0 && (lane & 1) == 0) S[no] = cm > 0.f ? cm * (1.f / 127.f) : 1.f;
    const LAS float* sp = img + kh * 32 + no;
#pragma unroll
    for (int q = 0; q < 4; ++q) { unsigned wq[4];
#pragma unroll
        for (int j = 0; j < 4; ++j) { const int kk = 16 * q + 4 * j; const int q0 = (int)rintf(sp[kk * 32] * inv), q1 = (int)rintf(sp[(kk + 1) * 32] * inv), q2 = (int)rintf(sp[(kk + 2) * 32] * inv), q3 = (int)rintf(sp[(kk + 3) * 32] * inv);
            wq[j] = (unsigned)(q0 & 255) | ((unsigned)(q1 & 255) << 8) | ((unsigned)(q2 & 255) << 16) | ((unsigned)(q3 & 255) << 24); }
        v4u o; o.x = wq[0]; o.y = wq[1]; o.z = wq[2]; o.w = wq[3];
        *(GAS v4u*)(WT8 + (size_t)no * 1024 + kh + 16 * q) = o; }
    __syncthreads();
}
namespace scan {
typedef short bf16x8 __attribute__((ext_vector_type(8)));
typedef float f32x4 __attribute__((ext_vector_type(4)));
typedef unsigned v2u __attribute__((ext_vector_type(2)));
constexpr int TS = 144, TB = 64 * TS;
constexpr int L_T0 = 0, L_T1 = TB, L_T2 = 2 * TB, L_T3 = 3 * TB, L_T4 = 4 * TB, L_T5 = 5 * TB, L_O = 6 * TB, OS = 68  , L_PART = L_O + 64 * OS * 4, L_VEC = L_PART + 8 * 64 * 4, L_END = L_VEC + 8 * 64 * 4;
static_assert(L_END <= RING_BYTES, "scan LDS");
constexpr size_t SC_LHG = 0, SC_LML = 16 * MiB, SC_DEC = 32 * MiB  , SC_NL = 32 * MiB + 256 * 1024  , SC_AMAX = 32 * MiB + 512 * 1024, SC_BEND = SC_AMAX + 4096, SC_MPREV = SC_BEND + 4096;

__device__ __forceinline__ float wave_incl_add(float v, int lane) {
#pragma unroll
    for (int o = 1; o < 64; o <<= 1) { const float u = __shfl_up(v, o); if (lane >= o) v += u; }
    return v;
}
__device__ __forceinline__ float wave_incl_max(float v, int lane) {
#pragma unroll
    for (int o = 1; o < 64; o <<= 1) { const float u = __shfl_up(v, o); if (lane >= o) v = fmaxf(v, u); }
    return v;
}
__device__ __forceinline__ float wave_max(float v) {
#pragma unroll
    for (int o = 1; o < 64; o <<= 1) v = fmaxf(v, __shfl_xor(v, o));
    return v;
}
__device__ __forceinline__ f32x4 mma64(LAS const unsigned char* A, LAS const unsigned char* B, int m0, int n0, int lane, f32x4 acc) {
    const int r = lane & 15, kq = lane >> 4;
#pragma unroll
    for (int ks = 0; ks < 2; ++ks) {
        const bf16x8 a = *(LAS const bf16x8*)(A + (m0 + r) * TS + kq * 16 + ks * 64);
        const bf16x8 b = *(LAS const bf16x8*)(B + (n0 + r) * TS + kq * 16 + ks * 64);
        acc = __builtin_amdgcn_mfma_f32_16x16x32_bf16(a, b, acc, 0, 0, 0);
    }
    return acc;
}
__device__ __forceinline__ v4u pack8(const float (&v)[8]) { v4u w; w.x = pk2(v[0], v[1]); w.y = pk2(v[2], v[3]); w.z = pk2(v[4], v[5]); w.w = pk2(v[6], v[7]); return w; }
__device__ __forceinline__ v4u pack8h(const bf16_t (&v)[8]) { v4u w; w.x = v[0] | ((unsigned)v[1] << 16); w.y = v[2] | ((unsigned)v[3] << 16); w.z = v[4] | ((unsigned)v[5] << 16); w.w = v[6] | ((unsigned)v[7] << 16); return w; }
__device__ __forceinline__ void st16(LAS unsigned char* p, float v) { *(LAS bf16_t*)p = f2bf(v); }
__device__ __forceinline__ void load_state_tile(LAS unsigned char* T, const float* S, int tid) {
    const int v = tid >> 3, d0 = (tid & 7) * 8; const float4 x0 = *(const float4*)(S + v * 64 + d0), x1 = *(const float4*)(S + v * 64 + d0 + 4);
    v4u w; w.x = pk2(x0.x, x0.y); w.y = pk2(x0.z, x0.w); w.z = pk2(x1.x, x1.y); w.w = pk2(x1.z, x1.w);
    *(LAS v4u*)(T + v * TS + d0 * 2) = w;
}
__device__ __forceinline__ void local_state_mma_store(LAS unsigned char* L, float* LT, int wave, int lane) {
    const int mt = wave >> 1;
#pragma unroll
    for (int nn = 0; nn < 2; ++nn) { const int nt = 2 * (wave & 1) + nn; f32x4 acc = {0.f, 0.f, 0.f, 0.f};
        acc = mma64(L + L_T1, L + L_T0, mt * 16, nt * 16, lane, acc);
#pragma unroll
        for (int r = 0; r < 4; ++r) LT[(mt * 16 + 4 * (lane >> 4) + r) * 64 + nt * 16 + (lane & 15)] = acc[r]; }
}

__device__ __forceinline__ void hgrn_b_item(LAS unsigned char* L, const bf16_t* P, float lb, int b, int c, int h, float* LT, float* DEC, int tid, int wave) {
    const int d = tid & 63, tq = wave;
    const bf16_t* pr = P + (size_t)(b * SEQ + c * 64 + 8 * tq) * PW + h * 64 + d;
    float bl[8], kh[8]; bf16_t iv[8]; float run = 0.f;
#pragma unroll
    for (int i = 0; i < 8; ++i) { const float fz = bf2f(pr[(size_t)i * PW + P_HF]); iv[i] = pr[(size_t)i * PW + P_HI];
        const float sg = sigmoidf_(fz), f = lb + (1.f - lb) * sg; kh[i] = (1.f - lb) * (1.f - sg); run += __logf(f); bl[i] = run; }
    LAS float* part = (LAS float*)(L + L_PART);
    part[tq * 64 + d] = run; __syncthreads();
    float off = 0.f, btot = 0.f;
#pragma unroll
    for (int w = 0; w < 8; ++w) { const float pv = part[w * 64 + d]; btot += pv; if (w < tq) off += pv; }
#pragma unroll
    for (int i = 0; i < 8; ++i) kh[i] *= __expf(btot - (off + bl[i]));
    *(LAS v4u*)(L + L_T0 + d * TS + tq * 16) = pack8(kh);
    *(LAS v4u*)(L + L_T1 + d * TS + tq * 16) = pack8h(iv);
    if (tq == 0) DEC[d] = __expf(btot);
    __syncthreads();
    local_state_mma_store(L, LT, wave, tid & 63);
    __syncthreads();
}
__device__ __forceinline__ void mlstm_gates(const float* G, const float* b_i, const float* b_f, int row0, int h, int lane, float& bcum, float& a) {
    const float ig = G[(size_t)(row0 + lane) * GW + h], fg = G[(size_t)(row0 + lane) * GW + 4 + h];
    bcum = wave_incl_add(log_sigmoidf_(fg + b_f[h]), lane); a = ig + b_i[h] - bcum;
}
__device__ __forceinline__ void conv_silu8(const bf16_t* col  , bool first3_zero, const float* w4  , float scale, float (&out)[8]) {
    float raw[11];
#pragma unroll
    for (int j = 0; j < 11; ++j) raw[j] = (j < 3 && first3_zero) ? 0.f : bf2f(col[((long)j - 3) * PW]);
    const float w0 = w4[0], w1 = w4[512], w2 = w4[1024], w3 = w4[1536];
#pragma unroll
    for (int i = 0; i < 8; ++i) out[i] = siluf_(w0 * raw[i] + w1 * raw[i + 1] + w2 * raw[i + 2] + w3 * raw[i + 3]) * scale;
}
__device__ __forceinline__ void mlstm_b_item(LAS unsigned char* L, const bf16_t* P, const float* G, const float* conv, const float* b_i, const float* b_f, int b, int c, int h, float* LT, float* NL, float* AMAX, float* BEND, int tid, int wave) {
    const int d = tid & 63, tq = wave, lane = tid & 63, row0 = b * SEQ + c * 64;
    float bcum, a; mlstm_gates(G, b_i, b_f, row0, h, lane, bcum, a);
    const float A = wave_max(a), bend = __shfl(bcum, 63);
    float kh[8]; conv_silu8(P + (size_t)(row0 + 8 * tq) * PW + P_MK + h * 64 + d, c == 0 && tq == 0, conv + 256 + h * 64 + d, 0.125f, kh);
    bf16_t vv[8]; float nsum = 0.f;
#pragma unroll
    for (int i = 0; i < 8; ++i) { vv[i] = P[(size_t)(row0 + 8 * tq + i) * PW + P_MV + h * 64 + d]; kh[i] *= __expf(__shfl(a, 8 * tq + i) - A); nsum += bf2f(f2bf(kh[i])); }
    *(LAS v4u*)(L + L_T0 + d * TS + tq * 16) = pack8(kh);
    *(LAS v4u*)(L + L_T1 + d * TS + tq * 16) = pack8h(vv);
    LAS float* part = (LAS float*)(L + L_PART); part[tq * 64 + d] = nsum;
    __syncthreads();
    if (tq == 0) { float s = 0.f;
#pragma unroll
        for (int w = 0; w < 8; ++w) s += part[w * 64 + d];
        NL[d] = s; if (lane == 0) { AMAX[0] = A; BEND[0] = bend; } }
    local_state_mma_store(L, LT, wave, lane);
    __syncthreads();
}
__device__ __forceinline__ void fox_cumsum_item(LAS unsigned char* L, const float* G, const float* fox_bf, float* CF, int bh, int tid, int wave) {
    const int b = bh >> 3, h = bh & 7, lane = tid & 63; const float bf = fox_bf[h];
    float loc[16]; float s = 0.f;
#pragma unroll
    for (int i = 0; i < 16; ++i) { s += log_sigmoidf_(G[((size_t)b * SEQ + tid * 16 + i) * GW + 8 + h] + bf); loc[i] = s; }
    const float incl = wave_incl_add(s, lane);
    LAS float* wt = (LAS float*)(L + L_PART);
    if (lane == 63) wt[wave] = incl;
    __syncthreads();
    float off = incl - s;
#pragma unroll
    for (int w = 0; w < 8; ++w) if (w < wave) off += wt[w];
#pragma unroll
    for (int i = 0; i < 16; ++i) CF[(size_t)bh * SEQ + tid * 16 + i] = (off + loc[i]) * LOG2E;
    __syncthreads();
}

__device__ __forceinline__ void scan_c_block(unsigned char* sc, int j, int tid) {
    if (j < 128) {
        if (tid < 256) { const int chain = j >> 4, e = (j & 15) * 256 + tid, b = chain >> 2, h = chain & 3;
            float* p = (float*)(sc + SC_LHG) + ((size_t)(b * 128) * 4 + h) * 4096 + e; const float* dp = (const float*)(sc + SC_DEC) + ((size_t)(b * 128) * 4 + h) * 64 + (e & 63);
            float S = 0.f;
#pragma unroll 8
            for (int c = 0; c < 128; ++c) { const float Lc = p[(size_t)c * 4 * 4096], dec = dp[(size_t)c * 4 * 64]; p[(size_t)c * 4 * 4096] = S; S = dec * S + Lc; } }
    } else {
        const int jj = j - 128, chain = jj >> 4, part = jj & 15, b = chain >> 2, h = chain & 3;
        if (tid < 260) { const bool isn = tid >= 256; const size_t it0 = (size_t)(b * 128) * 4 + h;
            float* p = isn ? (float*)(sc + SC_NL) + it0 * 64 + part * 4 + (tid - 256) : (float*)(sc + SC_LML) + it0 * 4096 + part * 256 + tid;
            const size_t stride = isn ? 4 * 64 : 4 * 4096;
            const float* am = (const float*)(sc + SC_AMAX) + it0; const float* be = (const float*)(sc + SC_BEND) + it0; float* mp = (float*)(sc + SC_MPREV) + it0;
            const bool writer = (part == 0 && tid == 0);
            float S = 0.f, m = 0.f;
#pragma unroll 8
            for (int c = 0; c < 128; ++c) { const float A = am[c * 4], bb = be[c * 4], Lc = p[c * stride]; const float Mx = fmaxf(m, A);
                p[c * stride] = S; S = __expf(m - Mx) * S + __expf(A - Mx) * Lc; if (writer) mp[c * 4] = m; m = bb + Mx; } }
    }
}

template <bool SIG> __device__ __forceinline__ void head_epilogue(LAS unsigned char* L, float inv, const bf16_t* gate  , const float* gain  , bf16_t* out  , int tid) {
    const int t = tid >> 3, v0 = (tid & 7) * 8; const LAS float* o = (const LAS float*)(L + L_O) + t * OS + v0;
    float x[8]; float ss = 0.f;
#pragma unroll
    for (int i = 0; i < 8; ++i) { x[i] = o[i] * inv; ss += x[i] * x[i]; }
    ss += __shfl_xor(ss, 1); ss += __shfl_xor(ss, 2); ss += __shfl_xor(ss, 4);
    const float r = rsqrtf(ss * (1.f / 64.f) + EPS);
    const uint4 gw = *(const uint4*)gate; const unsigned gu[4] = {gw.x, gw.y, gw.z, gw.w};
    float y[8];
#pragma unroll
    for (int i = 0; i < 8; ++i) { const float gz = bf2f((bf16_t)((gu[i >> 1] >> (16 * (i & 1))) & 0xffff)); y[i] = x[i] * r * gain[i] * (SIG ? sigmoidf_(gz) : siluf_(gz)); }
    *(v4u*)out = pack8(y);
}
__device__ __forceinline__ void store_o_tiles(LAS unsigned char* L, LAS const unsigned char* A1, LAS const unsigned char* B1, LAS const unsigned char* A2, LAS const unsigned char* B2, int wave, int lane) {
    const int mt = wave >> 1;
#pragma unroll
    for (int nn = 0; nn < 2; ++nn) { const int nt = 2 * (wave & 1) + nn; f32x4 acc = {0.f, 0.f, 0.f, 0.f};
        acc = mma64(A1, B1, mt * 16, nt * 16, lane, acc); acc = mma64(A2, B2, mt * 16, nt * 16, lane, acc);
        LAS float* o = (LAS float*)(L + L_O);
#pragma unroll
        for (int r = 0; r < 4; ++r) o[(mt * 16 + 4 * (lane >> 4) + r) * OS + nt * 16 + (lane & 15)] = acc[r]; }
}
__device__ __forceinline__ void hgrn_d_item(LAS unsigned char* L, const bf16_t* P, float lb, const float* gain, int b, int c, int h, const float* ST, bf16_t* MIX, int tid, int wave) {
    const int d = tid & 63, tq = wave, lane = tid & 63, row0 = b * SEQ + c * 64;
    const bf16_t* pr = P + (size_t)(row0 + 8 * tq) * PW + h * 64 + d;
    float bl[8], kk[8], q[8]; bf16_t iv[8]; float run = 0.f;
#pragma unroll
    for (int i = 0; i < 8; ++i) { const float fz = bf2f(pr[(size_t)i * PW + P_HF]); q[i] = bf2f(pr[(size_t)i * PW + P_HQ]); iv[i] = pr[(size_t)i * PW + P_HI];
        const float sg = sigmoidf_(fz), f = lb + (1.f - lb) * sg; kk[i] = (1.f - lb) * (1.f - sg); run += __logf(f); bl[i] = run; }
    LAS float* part = (LAS float*)(L + L_PART);
    part[tq * 64 + d] = run;
    load_state_tile(L + L_T4, ST, tid);
    *(LAS v4u*)(L + L_T3 + d * TS + tq * 16) = pack8h(iv);
    __syncthreads();
    float off = 0.f, bref = 0.f;
#pragma unroll
    for (int w = 0; w < 8; ++w) { const float pv = part[w * 64 + d]; if (w < 4) bref += pv; if (w < tq) off += pv; }
#pragma unroll
    for (int i = 0; i < 8; ++i) { const float bb = off + bl[i]; const int t = 8 * tq + i;
        st16(L + L_T0 + t * TS + d * 2, q[i] * __expf(bb - bref));
        st16(L + L_T1 + t * TS + d * 2, kk[i] * __expf(bref - bb));
        st16(L + L_T2 + t * TS + d * 2, q[i] * __expf(bb)); }
    __syncthreads();
    { const int mt = wave >> 1;
#pragma unroll
      for (int nn = 0; nn < 2; ++nn) { const int nt = 2 * (wave & 1) + nn; f32x4 acc = {0.f, 0.f, 0.f, 0.f};
          acc = mma64(L + L_T1, L + L_T0, mt * 16, nt * 16, lane, acc);
          const int s0 = mt * 16 + 4 * (lane >> 4), t = nt * 16 + (lane & 15);
          v2u w; w.x = pk2(s0 <= t ? acc[0] : 0.f, s0 + 1 <= t ? acc[1] : 0.f); w.y = pk2(s0 + 2 <= t ? acc[2] : 0.f, s0 + 3 <= t ? acc[3] : 0.f);
          *(LAS v2u*)(L + L_T5 + t * TS + s0 * 2) = w; } }
    __syncthreads();
    store_o_tiles(L, L + L_T5, L + L_T3, L + L_T2, L + L_T4, wave, lane);
    __syncthreads();
    { const int t = tid >> 3, v0 = (tid & 7) * 8;
      head_epilogue<false>(L, 1.f, P + (size_t)(row0 + t) * PW + P_HG + h * 64 + v0, gain + h * 64 + v0, MIX + (size_t)(row0 + t) * D + h * 64 + v0, tid); }
    __syncthreads();
}
__device__ __forceinline__ void mlstm_d_item(LAS unsigned char* L, const bf16_t* P, const float* G, const float* conv, const float* b_i, const float* b_f, const float* gain, int b, int c, int h,
                                             const float* CT, const float* NP, float mprev, bf16_t* MIX, int tid, int wave) {
    const int d = tid & 63, tq = wave, lane = tid & 63, row0 = b * SEQ + c * 64;
    float bcum, a; mlstm_gates(G, b_i, b_f, row0, h, lane, bcum, a);
    const float M = fmaxf(wave_incl_max(a, lane), mprev), sint = __expf(mprev - M);
    LAS float* vec = (LAS float*)(L + L_VEC);
    if (wave == 0) { vec[lane] = a; vec[64 + lane] = M; vec[128 + lane] = __expf(-bcum - M); vec[192 + lane] = NP[lane]; }
    float qc[8], kc[8]; const bool fz3 = (c == 0 && tq == 0);
    conv_silu8(P + (size_t)(row0 + 8 * tq) * PW + P_MQ + h * 64 + d, fz3, conv + h * 64 + d, 1.f, qc);
    conv_silu8(P + (size_t)(row0 + 8 * tq) * PW + P_MK + h * 64 + d, fz3, conv + 256 + h * 64 + d, 0.125f, kc);
    bf16_t vv[8];
#pragma unroll
    for (int i = 0; i < 8; ++i) { vv[i] = P[(size_t)(row0 + 8 * tq + i) * PW + P_MV + h * 64 + d]; const int t = 8 * tq + i;
        st16(L + L_T0 + t * TS + d * 2, qc[i]);
        st16(L + L_T1 + t * TS + d * 2, kc[i]);
        st16(L + L_T2 + t * TS + d * 2, qc[i] * __shfl(sint, t)); }
    *(LAS v4u*)(L + L_T3 + d * TS + tq * 16) = pack8h(vv);
    load_state_tile(L + L_T4, CT, tid);
    __syncthreads();
    { const int mt = wave >> 1;
#pragma unroll
      for (int nn = 0; nn < 2; ++nn) { const int nt = 2 * (wave & 1) + nn; f32x4 acc = {0.f, 0.f, 0.f, 0.f};
          acc = mma64(L + L_T1, L + L_T0, mt * 16, nt * 16, lane, acc);
          const int s0 = mt * 16 + 4 * (lane >> 4), t = nt * 16 + (lane & 15); const float Mt = vec[64 + t];
          float wv[4];
#pragma unroll
          for (int r = 0; r < 4; ++r) wv[r] = (s0 + r <= t) ? acc[r] * __expf(vec[s0 + r] - Mt) : 0.f;
          v2u w; w.x = pk2(wv[0], wv[1]); w.y = pk2(wv[2], wv[3]); *(LAS v2u*)(L + L_T5 + t * TS + s0 * 2) = w; } }
    __syncthreads();
    store_o_tiles(L, L + L_T5, L + L_T3, L + L_T2, L + L_T4, wave, lane);
    __syncthreads();
    { const int t = tid >> 3, c8 = (tid & 7) * 8;
      const v4u pw = *(LAS const v4u*)(L + L_T5 + t * TS + c8 * 2), qw = *(LAS const v4u*)(L + L_T2 + t * TS + c8 * 2);
      const unsigned pu[4] = {pw.x, pw.y, pw.z, pw.w}, qu[4] = {qw.x, qw.y, qw.z, qw.w}; float den = 0.f;
#pragma unroll
      for (int i = 0; i < 8; ++i) { den += bf2f((bf16_t)((pu[i >> 1] >> (16 * (i & 1))) & 0xffff)) + bf2f((bf16_t)((qu[i >> 1] >> (16 * (i & 1))) & 0xffff)) * vec[192 + c8 + i]; }
      den += __shfl_xor(den, 1); den += __shfl_xor(den, 2); den += __shfl_xor(den, 4);
      const float inv = 1.f / fmaxf(fabsf(den), vec[128 + t]);
      head_epilogue<true>(L, inv, P + (size_t)(row0 + t) * PW + P_MO + h * 64 + c8, gain + h * 64 + c8, MIX + (size_t)(row0 + t) * D + 256 + h * 64 + c8, tid); }
    __syncthreads();
}
}
constexpr int N_PHASES = 21;
template <int PH, bool REP = false> __device__ __forceinline__ void run_phase(const MArgs& a, LAS unsigned char* L, const int tid, const int wave, const int G, const int bx, const int vcu) {
    const int lane = tid & 63, gw = vcu * NWAVES + wave, NGW = G * NWAVES;
    unsigned char* ws = a.ws; float* X = a.out;
    int* ctl = (int*)(ws + WS_CTL); int* cnt = ctl + CW_CNT;
    float* Gt = (float*)(ws + WS_G); float* CF = (float*)(ws + WS_CF); int4* tokinfo = (int4*)(ws + WS_TOKINFO); float2* tgate = (float2*)(ws + WS_TGATE); int* toklist = (int*)(ws + WS_TOKLIST);
    bf16_t* P = (bf16_t*)(ws + WS_P); bf16_t* HID = (bf16_t*)(ws + WS_HID); signed char* H = (signed char*)(ws + WS_H); float* SH = (float*)(ws + WS_SH); bf16_t* MIX = (bf16_t*)(ws + WS_MIX);
    signed char* XG = (signed char*)(ws + WS_XG); float* SXG = (float*)(ws + WS_SXG); bf16_t* Y = (bf16_t*)(ws + WS_XG);
    LAS float* scr = (LAS float*)(L + RING_OFF + wave * 16384);
    (void)ctl; (void)Gt; (void)CF; (void)tokinfo; (void)tgate; (void)toklist; (void)P; (void)HID; (void)H; (void)SH; (void)SXG; (void)MIX; (void)XG; (void)Y; (void)scr; (void)cnt; (void)lane; (void)gw; (void)NGW;
    constexpr int p = PH, l = p >= 10 ? 1 : 0, k = p == 0 ? -1 : (l ? p - 10 : p - 1);
    if constexpr (p == 0) {
            LAS float* img = (LAS float*)(L + RING_OFF); LAS float* pm = (LAS float*)(L + LDSCTL_OFF + 1024);
            for (int it = vcu; it < 400; it += G) {
                int r = it;
                if (r < 224) { const int ll = r / 112, nb = r % 112, sc = 32 * nb + (nb >= 56 ? 8 : 0);
                    conv8_block(a.in[I_W_IN] + (size_t)ll * D * DIN + sc, DIN, (signed char*)(ws + WS_WIN) + (size_t)ll * PW * D + (size_t)32 * nb * D, (float*)(ws + WS_SWIN) + ll * PW + 32 * nb, img, pm, tid, wave); }
                else { r -= 224; const int up = r / 88, nb = r % 88, c = 32 * nb;
                    conv8_block((up ? a.in[I_DUP] : a.in[I_DGATE]) + c, FF, (signed char*)(ws + WS_WDGU) + (size_t)glu_row(c, up) * D, (float*)(ws + WS_SWDGU) + glu_row(c, up), img, pm, tid, wave); }
            }
            for (int it = gw; it < 2432; it += NGW) {
                int r = it;
                if (r < 1024) { const int ll = r / 512; r %= 512; const int kb = r / 32, nb = r % 32;
                    tr_item(a.in[I_W_OUT] + (size_t)ll * D * D + 32 * nb, D, D, (bf16_t*)(ws + WS_WOUT) + (size_t)ll * D * D + (size_t)32 * nb * D, scr, 64 * kb, lane); continue; }
                r -= 1024;
                { const int kb = r / 32, nb = r % 32; tr_item(a.in[I_DDOWN] + 32 * nb, D, FF, (bf16_t*)(ws + WS_WDDN) + (size_t)32 * nb * FF, scr, 64 * kb, lane); }
            }
            __syncthreads();
            LAS float* tab = (LAS float*)(L + RING_OFF); load_gate_tab(tab, a.in[I_W_IN], tid); __syncthreads();
            float lg[8];
            for (int row = gw; row < NTOK; row += NGW) mrow<0>(a.in[I_X], X, H, SH, a.in[I_ATTN_NORM], tab, Gt, row, lane, lg);
        } else if constexpr (k == 0) {
            pg8::GOrder S; S.so.init(NTOK, PW, G, bx); S.A = (const char*)H; S.B = (const char*)(ws + WS_WIN) + (size_t)l * PW * D; S.a_tile = (size_t)256 * D; S.b_tile = (size_t)256 * D; S.b_exp = 0;
            S.tb1 = S.tb2 = S.tb3 = S.tb4 = S.tb5 = S.tb6 = S.tb7 = 0x7fffffff;
            pg8::EpiBf8 E; E.O = P; E.ldc = PW; E.s_lo = P_FQ / 256; E.s_hi = P_FK / 256; E.scale = QSCALE; E.sA = SH; E.sB = (const float*)(ws + WS_SWIN) + l * PW;
            pg8::Gemm g{D / 2};
            pg8::gemm_phase<pg8::EpiBf8, pg8::GOrder, true, true, true>(L + RING_OFF, g, S, E);
        } else if constexpr (l == 1 && k == 9) {
            pg8::GOrder S; pg8::EpiBf E; int t[8]; int acc = 0;
#pragma unroll
            for (int e = 0; e < NE; ++e) { t[e] = acc; acc += (cnt[e] + 255) >> 8; }
            S.so.init(acc * 256, D, G, bx); S.A = (const char*)HID; S.B = (const char*)(ws + WS_WMDN); S.a_tile = (size_t)256 * FE * 2; S.b_tile = (size_t)256 * FE * 2; S.b_exp = (size_t)D * FE * 2;
            S.tb1 = t[1]; S.tb2 = t[2]; S.tb3 = t[3]; S.tb4 = t[4]; S.tb5 = t[5]; S.tb6 = t[6]; S.tb7 = t[7]; E.O = Y; E.ldc = D; E.s_lo = 0; E.s_hi = 0; E.scale = 1.f;
            pg8::Gemm g{FE};
            pg8::gemm_phase<pg8::EpiBf, pg8::GOrder, true, true>(L + RING_OFF, g, S, E);
        } else if constexpr (k == 4 || (l == 0 && k == 7)) {
            pg8::GOrder S; S.so.init(NTOK, D, G, bx); S.b_exp = 0; S.tb1 = S.tb2 = S.tb3 = S.tb4 = S.tb5 = S.tb6 = S.tb7 = 0x7fffffff; int K;
            if constexpr (k == 4) { K = D; S.A = (const char*)MIX; S.B = (const char*)(ws + WS_WOUT) + (size_t)l * D * D * 2; }
            else { K = FF; S.A = (const char*)HID; S.B = (const char*)(ws + WS_WDDN); }
            S.a_tile = (size_t)256 * K * 2; S.b_tile = (size_t)256 * K * 2;
            pg8::EpiResid E{X, D}; pg8::Gemm g{K};
            pg8::gemm_phase<pg8::EpiResid, pg8::GOrder, true, true>(L + RING_OFF, g, S, E);
        } else if constexpr ((l == 0 && k == 6) || (l == 1 && k == 7)) {
            pg8::GOrder S; pg8::EpiSwiglu8 E; S.a_tile = (size_t)256 * D; S.b_tile = (size_t)256 * D; E.O = HID;
            if constexpr (l == 0) { S.so.init(NTOK, 2 * FF, G, bx); S.A = (const char*)H; S.B = (const char*)(ws + WS_WDGU); S.b_exp = 0; S.tb1 = S.tb2 = S.tb3 = S.tb4 = S.tb5 = S.tb6 = S.tb7 = 0x7fffffff;
                E.ldc = FF; E.sA = SH; E.sB = (const float*)(ws + WS_SWDGU); E.sb_exp = 0; }
            else { int t[8]; int acc = 0;
#pragma unroll
                for (int e = 0; e < NE; ++e) { t[e] = acc; acc += (cnt[e] + 255) >> 8; }
                S.so.init(acc * 256, 2 * FE, G, bx); S.A = (const char*)XG; S.B = (const char*)(ws + WS_WMGU); S.b_exp = (size_t)2 * FE * D;
                S.tb1 = t[1]; S.tb2 = t[2]; S.tb3 = t[3]; S.tb4 = t[4]; S.tb5 = t[5]; S.tb6 = t[6]; S.tb7 = t[7]; E.ldc = FE; E.sA = SXG; E.sB = (const float*)(ws + WS_SWMGU); E.sb_exp = 2 * FE; }
            E.tb1 = S.tb1; E.tb2 = S.tb2; E.tb3 = S.tb3; E.tb4 = S.tb4; E.tb5 = S.tb5; E.tb6 = S.tb6; E.tb7 = S.tb7;
            pg8::Gemm g{D / 2};
            pg8::gemm_phase<pg8::EpiSwiglu8, pg8::GOrder, true, true, true>(L + RING_OFF, g, S, E);
        } else if constexpr (k == 5 && l == 0) {
            float lg[8];
            for (int row = gw; row < NTOK; row += NGW) mrow<1>(X, X, H, SH, a.in[I_FFN_NORM], nullptr, nullptr, row, lane, lg);
        } else if constexpr (k == 8 && l == 0) {
            LAS float* tab = (LAS float*)(L + RING_OFF); load_gate_tab(tab, a.in[I_W_IN] + (size_t)D * DIN, tid); __syncthreads();
            float lg[8];
            for (int row = gw; row < NTOK; row += NGW) mrow<0>(X, X, H, SH, a.in[I_ATTN_NORM] + D, tab, Gt, row, lane, lg);
        } else if constexpr (k == 5 && l == 1) {
            LAS int* sel_e = (LAS int*)(L + RING_OFF);
            LAS float* sel_g = (LAS float*)(L + RING_OFF + 512);
            LAS int* lcnt = (LAS int*)(L + RING_OFF + 1024);
            LAS float* tab = (LAS float*)(L + RING_OFF + 4096); load_router_tab(tab, a.in[I_ROUTER], tid); __syncthreads();
            for (int rb = bx; rb < NTOK / 64; rb += G) {
                if (tid < 16) lcnt[tid] = 0;
                for (int i = 0; i < 8; ++i) { const int rl = wave * 8 + i, row = rb * 64 + rl; float lg[8];
                    mrow<2>(X, X, H, SH, a.in[I_FFN_NORM] + D, tab, nullptr, row, lane, lg);
                    if (lane == 0) { const float v0 = lg[0], v1 = lg[1]; const int e0 = __float_as_int(lg[2]), e1 = __float_as_int(lg[3]);
                        const float g1 = 1.f / (1.f + __expf(v0 - v1));
                        sel_e[2 * rl] = e0; sel_e[2 * rl + 1] = e1; sel_g[2 * rl] = 1.f - g1; sel_g[2 * rl + 1] = g1; } }
                __syncthreads();
                int e0 = 0, e1 = 0, r0 = 0, r1 = 0;
                if (tid < 64) { e0 = sel_e[2 * tid]; e1 = sel_e[2 * tid + 1]; r0 = __hip_atomic_fetch_add(lcnt + e0, 1, __ATOMIC_RELAXED, __HIP_MEMORY_SCOPE_WORKGROUP); r1 = __hip_atomic_fetch_add(lcnt + e1, 1, __ATOMIC_RELAXED, __HIP_MEMORY_SCOPE_WORKGROUP); }
                __syncthreads();
                if (tid < 8) lcnt[8 + tid] = atomicAdd(cnt + tid, (int)lcnt[tid]);
                __syncthreads();
                if (tid < 64) { const int row = rb * 64 + tid, s0 = lcnt[8 + e0] + r0, s1 = lcnt[8 + e1] + r1;
                    toklist[e0 * NTOK + s0] = row; toklist[e1 * NTOK + s1] = row; tokinfo[row] = make_int4(e0, s0, e1, s1); tgate[row] = make_float2(sel_g[2 * tid], sel_g[2 * tid + 1]); }
                __syncthreads();
            }
        } else if constexpr (k == 6 && l == 1) {
            { int base[NE]; int acc = 0;
#pragma unroll
              for (int e = 0; e < NE; ++e) { base[e] = acc; acc += (cnt[e] + 255) & ~255; }
              for (int r = gw; r < acc; r += NGW) { int e = 0, be = 0;
#pragma unroll
                  for (int c = 1; c < NE; ++c) if (r >= base[c]) { e = c; be = base[c]; }
                  const int s = r - be; v4u v0 = {0u, 0u, 0u, 0u}; float sv = 0.f;
                  if (s < cnt[e]) { const int tok = toklist[e * NTOK + s]; v0 = *((const v4u*)(H + (size_t)tok * D) + lane); sv = SH[tok]; }
                  *((v4u*)(XG + (size_t)r * D) + lane) = v0; if (lane == 0) SXG[r] = sv; } }
            __syncthreads();
            { LAS float* img = (LAS float*)(L + RING_OFF); LAS float* pm = (LAS float*)(L + LDSCTL_OFF + 1024);
              for (int it = vcu; it < 1792; it += G) { const int e = it / 224; int r = it % 224; const int up = r / 112, nb = r % 112, c = 32 * nb;
                  conv8_block((up ? a.in[I_MUP] : a.in[I_MGATE]) + (size_t)e * D * FE + c, FE, (signed char*)(ws + WS_WMGU) + (size_t)e * 2 * FE * D + (size_t)glu_row(c, up) * D, (float*)(ws + WS_SWMGU) + e * 2 * FE + glu_row(c, up), img, pm, tid, wave); } }
            for (int it = gw; it < 14336; it += NGW) { const int e = it / 1792, r = it % 1792, kb = r / 32, nb = r % 32;
                tr_item(a.in[I_MDOWN] + (size_t)e * FE * D + 32 * nb, D, FE, (bf16_t*)(ws + WS_WMDN) + (size_t)e * D * FE + (size_t)32 * nb * FE, scr, 64 * kb, lane); }
        } else if constexpr (k == 8 && l == 1) {
        } else if constexpr (k == 10 && l == 1) {
            int base[NE]; { int acc = 0;
#pragma unroll
              for (int e = 0; e < NE; ++e) { base[e] = acc; acc += (cnt[e] + 255) & ~255; } }
            for (int row = gw; row < NTOK; row += NGW) {
                float4* xr = (float4*)(X + (size_t)row * D) + lane; float4 v[4];
#pragma unroll
                for (int j = 0; j < 4; ++j) v[j] = xr[64 * j];
                const int4 ti = tokinfo[row]; const float2 tg = tgate[row]; int b0 = 0, b1 = 0;
#pragma unroll
                for (int c = 0; c < NE; ++c) { if (c == ti.x) b0 = base[c]; if (c == ti.z) b1 = base[c]; }
                const bf16_t* y0 = Y + (size_t)(b0 + ti.y) * D; const bf16_t* y1 = Y + (size_t)(b1 + ti.w) * D;
#pragma unroll
                for (int j = 0; j < 4; ++j) { const uint2 q = *((const uint2*)y0 + 64 * j + lane), c = *((const uint2*)y1 + 64 * j + lane);
                    v[j].x += tg.x * bf2f((bf16_t)(q.x & 0xffff)) + tg.y * bf2f((bf16_t)(c.x & 0xffff)); v[j].y += tg.x * bf2f((bf16_t)(q.x >> 16)) + tg.y * bf2f((bf16_t)(c.x >> 16));
                    v[j].z += tg.x * bf2f((bf16_t)(q.y & 0xffff)) + tg.y * bf2f((bf16_t)(c.y & 0xffff)); v[j].w += tg.x * bf2f((bf16_t)(q.y >> 16)) + tg.y * bf2f((bf16_t)(c.y >> 16)); }
                float ss = 0.f;
#pragma unroll
                for (int j = 0; j < 4; ++j) ss += v[j].x * v[j].x + v[j].y * v[j].y + v[j].z * v[j].z + v[j].w * v[j].w;
                ss = wave_sum(ss); const float r = rsqrtf(ss * (1.f / D) + EPS);
#pragma unroll
                for (int j = 0; j < 4; ++j) { const float4 g = *((const float4*)a.in[I_FINAL_NORM] + 64 * j + lane); xr[64 * j] = make_float4(v[j].x * r * g.x, v[j].y * r * g.y, v[j].z * r * g.z, v[j].w * r * g.w); }
            }
        } else {
            if constexpr (k == 1) {
                unsigned char* sc = ws + WS_SCAN; const int wv = wave;
                for (int it = bx; it < 2048; it += G) { const int item = it & 1023, h = item & 3, c = (item >> 2) & 127, b = item >> 9;
                    if (it < 1024) { const int ch = h * 64 + (tid & 63); const float lb = l == 0 ? 0.f : 1.f / (1.f + __expf(a.in[I_HGRN_LB][ch] - a.in[I_HGRN_LB][256 + ch]));
                        scan::hgrn_b_item(L, P, lb, b, c, h, (float*)(sc + scan::SC_LHG) + (size_t)item * 4096, (float*)(sc + scan::SC_DEC) + item * 64, tid, wv); }
                    else scan::mlstm_b_item(L, P, Gt, a.in[I_MLSTM_CONV] + l * 2048, a.in[I_MLSTM_BI] + l * 4, a.in[I_MLSTM_BF] + l * 4, b, c, h, (float*)(sc + scan::SC_LML) + (size_t)item * 4096,
                                            (float*)(sc + scan::SC_NL) + item * 64, (float*)(sc + scan::SC_AMAX) + item, (float*)(sc + scan::SC_BEND) + item, tid, wv); }
                for (int bh = bx; bh < 16; bh += G) scan::fox_cumsum_item(L, Gt, a.in[I_FOX_BF] + l * 8, CF, bh, tid, wv);
                { LAS unsigned* lst = (LAS unsigned*)(L + LDSCTL_OFF + 64);
                  if (tid < 32) lst[tid] = 0u; __syncthreads();
                  float mq0 = 0.f, mq1 = 0.f, mk0 = 0.f, mk1 = 0.f;
                  for (int row = gw; row < NTOK; row += NGW) {
                      const v4u wq = *((const v4u*)(P + (size_t)row * PW + P_FQ) + lane), wk = *((const v4u*)(P + (size_t)row * PW + P_FK) + lane);
                      float sq = 0.f, sk = 0.f;
#pragma unroll
                      for (int i = 0; i < 4; ++i) { const float q0 = bf2f((bf16_t)(wq[i] & 0xffff)), q1 = bf2f((bf16_t)(wq[i] >> 16)), k0 = bf2f((bf16_t)(wk[i] & 0xffff)), k1 = bf2f((bf16_t)(wk[i] >> 16));
                          sq += q0 * q0 + q1 * q1; sk += k0 * k0 + k1 * k1; }
                      sq += __shfl_xor(sq, 1); sq += __shfl_xor(sq, 2); sq += __shfl_xor(sq, 4); sk += __shfl_xor(sk, 1); sk += __shfl_xor(sk, 2); sk += __shfl_xor(sk, 4);
                      if (row < SEQ) { mq0 = fmaxf(mq0, sq); mk0 = fmaxf(mk0, sk); } else { mq1 = fmaxf(mq1, sq); mk1 = fmaxf(mk1, sk); } }
                  if ((lane & 7) == 0) { const int hh = lane >> 3;
                      __hip_atomic_fetch_max(lst + hh * 2, __float_as_uint(mq0), __ATOMIC_RELAXED, __HIP_MEMORY_SCOPE_WORKGROUP); __hip_atomic_fetch_max(lst + hh * 2 + 1, __float_as_uint(mk0), __ATOMIC_RELAXED, __HIP_MEMORY_SCOPE_WORKGROUP);
                      __hip_atomic_fetch_max(lst + 16 + hh * 2, __float_as_uint(mq1), __ATOMIC_RELAXED, __HIP_MEMORY_SCOPE_WORKGROUP); __hip_atomic_fetch_max(lst + 16 + hh * 2 + 1, __float_as_uint(mk1), __ATOMIC_RELAXED, __HIP_MEMORY_SCOPE_WORKGROUP); }
                  __syncthreads();
                  if (tid < 32) __hip_atomic_fetch_max((unsigned*)ctl + CW_STAT + l * 32 + tid, lst[tid], __ATOMIC_RELAXED, __HIP_MEMORY_SCOPE_AGENT); }
            } else if constexpr (k == 2) {
                if constexpr (!REP) { for (int j = bx; j < 256; j += G) scan::scan_c_block(ws + WS_SCAN, j, tid); }
            } else if constexpr (k == 3) {
                static_assert(attn_body::ATTN_LDS_BYTES <= RING_BYTES, "attention LDS");
                unsigned char* sc = ws + WS_SCAN; const int wv = wave;
                const float* stat = (const float*)(ctl + CW_STAT + l * 32);
                LAS unsigned* slot = (LAS unsigned*)(L + LDSCTL_OFF);
                int v;
                for (;;) {
                    if (tid == 0) *slot = __hip_atomic_fetch_add((unsigned*)ctl + CW_QCTR + l, 1u, __ATOMIC_RELAXED, __HIP_MEMORY_SCOPE_AGENT);
                    __syncthreads();
                    v = __builtin_amdgcn_readfirstlane((int)*(volatile LAS unsigned*)slot);
                    if (v >= 512) break;
                    const int qb = 31 - (v >> 4), bh = v & 15;
                    const float Tsk = 40.f + 2.f * __builtin_sqrtf(stat[bh * 2] * stat[bh * 2 + 1]) * 1.01f + 1.f;
                    attn_body::attn_unit<8>(bh >> 3, bh & 7, qb, (const attn_body::bf16*)(P + P_FQ), (const attn_body::bf16*)(P + P_FK), (const attn_body::bf16*)(P + P_FV), (attn_body::bf16*)(MIX + 512), CF + (size_t)bh * SEQ, Tsk, (char*)L + RING_OFF);
                    __syncthreads();
                }
                int tid2 = tid; asm volatile("" : "+v"(tid2));
                while (v < 1024) {
                    for (int it = (v - 512) * 4; it < (v - 512) * 4 + 4; ++it) { const int item = it & 1023, h = item & 3, c = (item >> 2) & 127, b = item >> 9;
                        if (it < 1024) { const int ch = h * 64 + (tid2 & 63); const float lb = l == 0 ? 0.f : 1.f / (1.f + __expf(a.in[I_HGRN_LB][ch] - a.in[I_HGRN_LB][256 + ch]));
                            scan::hgrn_d_item(L, P, lb, a.in[I_HGRN_NORM] + l * 256, b, c, h, (const float*)(sc + scan::SC_LHG) + (size_t)item * 4096, MIX, tid2, wv); }
                        else scan::mlstm_d_item(L, P, Gt, a.in[I_MLSTM_CONV] + l * 2048, a.in[I_MLSTM_BI] + l * 4, a.in[I_MLSTM_BF] + l * 4, a.in[I_MLSTM_NORM] + l * 256, b, c, h,
                                                (const float*)(sc + scan::SC_LML) + (size_t)item * 4096, (const float*)(sc + scan::SC_NL) + item * 64, ((const float*)(sc + scan::SC_MPREV))[item], MIX, tid2, wv); }
                    __syncthreads();
                    if (tid2 == 0) *slot = __hip_atomic_fetch_add((unsigned*)ctl + CW_QCTR + l, 1u, __ATOMIC_RELAXED, __HIP_MEMORY_SCOPE_AGENT);
                    __syncthreads();
                    v = __builtin_amdgcn_readfirstlane((int)*(volatile LAS unsigned*)slot);
                }
            }

        }
}
__global__ void __launch_bounds__(NTHR, 2) mega(MArgs a) {
    extern __shared__ __attribute__((aligned(16))) unsigned char lds[];
    LAS unsigned char* L = (LAS unsigned char*)lds;
    volatile LAS unsigned* MISC = (volatile LAS unsigned*)(L + MISC_OFF);
    const int tid = threadIdx.x, wave = __builtin_amdgcn_readfirstlane(tid >> 6);
    const int G = gridDim.x, bx = blockIdx.x, vcu = (G % 8 == 0) ? (bx % 8) * (G / 8) + bx / 8 : bx;
    for (int u = tid; u < (LDS_BYTES - LDSCTL_OFF) / 4; u += NTHR) ((LAS unsigned*)(L + LDSCTL_OFF))[u] = 0u;
    __syncthreads();
    const int lo = a.ph_lo, hi = a.ph_hi;
    XcdBarrier bar; bar.bar = (unsigned*)(a.ws + WS_CTL) + CW_BAR; bar.x = 0; bar.st = nullptr;
    if (hi - lo > 1) bar = xcd_barrier_post((unsigned*)(a.ws + WS_CTL) + CW_BAR, MISC + 8);
#ifndef REPEAT_MASK
#define REPEAT_MASK 0u
#endif
#define PHASE(k) if (lo <= (k) && (k) < hi) { run_phase<k>(a, L, tid, wave, G, bx, vcu); if constexpr ((REPEAT_MASK >> (k)) & 1u) { xcd_barrier(bar); run_phase<k, true>(a, L, tid, wave, G, bx, vcu); } if ((k) + 1 < hi) xcd_barrier(bar); }
    PHASE(0) PHASE(1) PHASE(2) PHASE(3) PHASE(4) PHASE(5) PHASE(6) PHASE(7) PHASE(8) PHASE(9) PHASE(10)
    PHASE(11) PHASE(12) PHASE(13) PHASE(14) PHASE(15) PHASE(16) PHASE(17) PHASE(19) PHASE(20)
#undef PHASE
}
#ifndef MEGA_MASK
#define MEGA_MASK 0x1FFFFFu
#endif
#ifndef FUSE_RUNS
#define FUSE_RUNS 1
#endif
extern "C" void kernel_launch(void* const* d_in, const int* in_sizes, int n_in, void* d_out, int out_size, void* d_ws, size_t ws_size, hipStream_t stream) {
    static int grid = 0;
    if (grid == 0) {
        if (n_in != 20 || ws_size < WS_END || out_size != NTOK * D) { fprintf(stderr, "kernel_launch: unexpected n_in %d / ws %zu / out %d\n", n_in, ws_size, out_size); grid = -1; return; }
        int dev = 0, cus = 0, per_cu = 0;
        if (hipGetDevice(&dev) != hipSuccess || hipDeviceGetAttribute(&cus, hipDeviceAttributeMultiprocessorCount, dev) != hipSuccess) { grid = -1; return; }
        if (hipFuncSetAttribute((const void*)mega, hipFuncAttributeMaxDynamicSharedMemorySize, LDS_BYTES) != hipSuccess) { fprintf(stderr, "kernel_launch: hipFuncSetAttribute failed\n"); grid = -1; return; }
        if (hipOccupancyMaxActiveBlocksPerMultiprocessor(&per_cu, (const void*)mega, NTHR, LDS_BYTES) != hipSuccess || per_cu < 1) { fprintf(stderr, "kernel_launch: occupancy query says %d\n", per_cu); per_cu = 1; }
        (void)hipGetLastError();
        grid = cus;
        if (grid > 256) grid = 256;
    }
    if (grid < 0) return;
    const float* const* in = (const float* const*)d_in;
    unsigned char* ws = (unsigned char*)d_ws; float* X = (float*)d_out;
    (void)hipMemsetAsync(ws + WS_CTL, 0, CTL_BYTES, stream);
    MArgs ma; memset(&ma, 0, sizeof ma);
    for (int i = 0; i < 20; ++i) ma.in[i] = in[i];
    ma.out = X; ma.ws = ws;
    ma.ph_lo = 0; ma.ph_hi = N_PHASES;
    hipLaunchKernelGGL(mega, dim3(grid), dim3(NTHR), LDS_BYTES, stream, ma);
}
```

```cpp
#include <hip/hip_runtime.h>
#include <hip/hip_bf16.h>
#include <cstdint>
#include <cstdio>
#include <cstring>

namespace cfg {
constexpr int NTOK = 16384, D = 1024, SEQ = 8192, NB = 2, DIN = 3600, PW = 3584, GW = 16;
constexpr int FF = 2816, FE = 3584, NE = 8, MAXROWS = 34816;
constexpr float EPS = 1e-6f;
constexpr float LOG2E = 1.4426950408889634f;
constexpr float QSCALE = 0.125f * LOG2E;
constexpr int P_HQ = 0, P_HF = 256, P_HI = 512, P_HG = 768, P_MQ = 1024, P_MK = 1280, P_MV = 1536, P_MO = 1792, P_FQ = 2048, P_FK = 2560, P_FV = 3072;
constexpr size_t MiB = 1u << 20;
constexpr size_t WS_CTL = 0, CTL_BYTES = 1 * MiB;
constexpr size_t WS_G = 2 * MiB;
constexpr size_t WS_CF = 3 * MiB;
constexpr size_t WS_TOKINFO = 3 * MiB + 512 * 1024;
constexpr size_t WS_TGATE = 3 * MiB + 768 * 1024;
constexpr size_t WS_TOKLIST = 4 * MiB;
constexpr size_t WS_P = 8 * MiB;
constexpr size_t WS_SCAN = 120 * MiB;
constexpr size_t WS_HID = 8 * MiB;
constexpr size_t WS_H = 246 * MiB;
constexpr size_t WS_MIX = 278 * MiB;
constexpr size_t WS_XG = 278 * MiB;
constexpr size_t WS_W = 346 * MiB;
constexpr size_t WS_Y = 346 * MiB;
constexpr size_t WS_END = 466 * MiB;
constexpr int CW_CNT = 64;
constexpr int CW_STAT = 128;
constexpr int CW_QCTR = 256;
constexpr int CW_AFLAG = 512;
}
using namespace cfg;
typedef unsigned short bf16_t;

__device__ __forceinline__ bf16_t f2bf(float f) { unsigned u = __builtin_bit_cast(unsigned, f); return (bf16_t)((u + 0x7fffu + ((u >> 16) & 1u)) >> 16); }
__device__ __forceinline__ float bf2f(bf16_t h) { return __builtin_bit_cast(float, (unsigned)h << 16); }
__device__ __forceinline__ float wave_sum(float v) {
#pragma unroll
    for (int o = 1; o < 64; o <<= 1) v += __shfl_xor(v, o);
    return v;
}
__device__ __forceinline__ float sigmoidf_(float z) { return 1.f / (1.f + __expf(-z)); }
__device__ __forceinline__ float siluf_(float z) { return z / (1.f + __expf(-z)); }
__device__ __forceinline__ float log_sigmoidf_(float z) { return fminf(z, 0.f) - log1pf(__expf(-fabsf(z))); }

__device__ __forceinline__ int moe_bases(const int* cnt, int* base) {
    int acc = 0;
#pragma unroll
    for (int e = 0; e < NE; ++e) { base[e] = acc; acc += (cnt[e] + 255) & ~255; }
    return acc;
}

namespace pg8 {
#define PG8_LAS __attribute__((address_space(3)))
typedef unsigned short bf16_t;
typedef short bf16x8 __attribute__((ext_vector_type(8)));
typedef float f32x4 __attribute__((ext_vector_type(4)));
typedef unsigned u32x4 __attribute__((ext_vector_type(4)));
constexpr int BM = 256, BK = 64, HALF = 128, HTB = HALF * BK * 2  , STAGE_BYTES = 8 * HTB, NXCD = 8, WGM = 8;

__host__ __device__ __forceinline__ int lds_byte(int r, int c) { const int st = (r >> 4) * 2 + (c >> 5), rr = r & 15, cc = c & 31, ob = rr * 64 + cc * 2; return st * 1024 + (ob ^ (((ob >> 9) & 1) << 5)); }
__host__ __device__ __forceinline__ void stage_rc(int b, int& R, int& C) { const int st = b / 1024, sb = b % 1024, swz = sb ^ (((sb >> 9) & 1) << 5); R = (st >> 1) * 16 + swz / 64; C = (st & 1) * 32 + (swz % 64) / 2; }
__host__ __device__ __forceinline__ int perm32(int rho) { const int n = rho >> 4, i = rho & 15; return 8 * (i >> 2) + 4 * n + (i & 3); }

struct Unit { int pm, pn; };
struct Gemm { int K; };

struct StaticOrder {
    int nM, nN, nwg, G, c;
    __host__ __device__ void init(int M, int N, int G_, int c_) { nM = M / BM; nN = N / BM; nwg = nM * nN; G = G_; c = c_; }
    __host__ __device__ bool next(int i, Unit& u) const {
        const long L = (long)i * G + c; if (L >= nwg) return false;
        int wgid = (int)L; { const int q = nwg / NXCD, r = nwg % NXCD, xcd = wgid % NXCD, off = wgid / NXCD; wgid = (xcd < r ? xcd * (q + 1) : r * (q + 1) + (xcd - r) * q) + off; }
        const int nig = WGM * nN, gid = wgid / nig, fm = gid * WGM, gsz = (nM - fm) < WGM ? (nM - fm) : WGM;
        u.pm = fm + ((wgid % nig) % gsz); u.pn = (wgid % nig) / gsz; return true;
    }
    __device__ __forceinline__ void a_ready(const Unit&) const {}
    __device__ __forceinline__ void done(const Unit&) const {}
};

__device__ __forceinline__ unsigned cvt_pk_bf16(float lo, float hi) { unsigned r; asm volatile("v_cvt_pk_bf16_f32 %0, %1, %2" : "=v"(r) : "v"(lo), "v"(hi)); return r; }
typedef int i32x4 __attribute__((ext_vector_type(4)));
template <bool I8> struct AccT { typedef f32x4 type; };
template <> struct AccT<true> { typedef i32x4 type; };
__device__ __forceinline__ f32x4 mma_sel(bf16x8 b, bf16x8 a, f32x4 c) { return __builtin_amdgcn_mfma_f32_16x16x32_bf16(b, a, c, 0, 0, 0); }
__device__ __forceinline__ i32x4 mma_sel(bf16x8 b, bf16x8 a, i32x4 c) { return __builtin_amdgcn_mfma_i32_16x16x64_i8(__builtin_bit_cast(i32x4, b), __builtin_bit_cast(i32x4, a), c, 0, 0, 0); }
struct EpiBf {
    static constexpr bool PERM = true, AFTER_DRAIN = false;
    bf16_t* O; int ldc; int s_lo, s_hi; float scale;
    __device__ __forceinline__ void operator()(const f32x4 (&acc)[2][2][4][2], const Unit& u, int wr, int wc, int fr, int fq) const {
        const int row0 = u.pm * BM + wr * 64 + fr, col0 = u.pn * BM + wc * 32 + 8 * fq;
        const float sc = (u.pn >= s_lo && u.pn < s_hi) ? scale : 1.f;
#pragma unroll
        for (int ai = 0; ai < 2; ++ai)
#pragma unroll
            for (int m = 0; m < 4; ++m) { bf16_t* rowp = O + (size_t)(row0 + ai * HALF + m * 16) * ldc + col0;
#pragma unroll
                for (int bj = 0; bj < 2; ++bj) { const f32x4 v0 = acc[ai][bj][m][0] * sc, v1 = acc[ai][bj][m][1] * sc;
                    u32x4 w; w.x = cvt_pk_bf16(v0[0], v0[1]); w.y = cvt_pk_bf16(v0[2], v0[3]); w.z = cvt_pk_bf16(v1[0], v1[1]); w.w = cvt_pk_bf16(v1[2], v1[3]);
                    *(u32x4*)(rowp + bj * HALF) = w; } }
    }
};
__device__ __forceinline__ float silu_mul(float g, float u) { return g * __builtin_amdgcn_rcpf(1.f + __expf(-g)) * u; }
struct EpiSwiglu {
    static constexpr bool PERM = true, AFTER_DRAIN = false;
    bf16_t* O; int ldc;
    __device__ __forceinline__ void operator()(const f32x4 (&acc)[2][2][4][2], const Unit& u, int wr, int wc, int fr, int fq) const {
        const int row0 = u.pm * BM + wr * 64 + fr, col0 = u.pn * HALF + wc * 32 + 8 * fq;
#pragma unroll
        for (int ai = 0; ai < 2; ++ai)
#pragma unroll
            for (int m = 0; m < 4; ++m) { bf16_t* rowp = O + (size_t)(row0 + ai * HALF + m * 16) * ldc + col0;
                const f32x4 g0 = acc[ai][0][m][0], g1 = acc[ai][0][m][1], u0 = acc[ai][1][m][0], u1 = acc[ai][1][m][1];
                u32x4 w; w.x = cvt_pk_bf16(silu_mul(g0[0], u0[0]), silu_mul(g0[1], u0[1])); w.y = cvt_pk_bf16(silu_mul(g0[2], u0[2]), silu_mul(g0[3], u0[3]));
                w.z = cvt_pk_bf16(silu_mul(g1[0], u1[0]), silu_mul(g1[1], u1[1])); w.w = cvt_pk_bf16(silu_mul(g1[2], u1[2]), silu_mul(g1[3], u1[3]));
                *(u32x4*)rowp = w; }
    }
};
struct EpiResid {
    static constexpr bool PERM = false, AFTER_DRAIN = false;
    float* X; int ldc;
    __device__ __forceinline__ void operator()(const f32x4 (&acc)[2][2][4][2], const Unit& u, int wr, int wc, int fr, int fq) const {
        const int row0 = u.pm * BM + wr * 64 + fr, col0 = u.pn * BM + wc * 32 + 4 * fq;
#pragma unroll
        for (int ai = 0; ai < 2; ++ai)
#pragma unroll
            for (int m = 0; m < 4; ++m) { float* rowp = X + (size_t)(row0 + ai * HALF + m * 16) * ldc + col0;
#pragma unroll
                for (int bj = 0; bj < 2; ++bj)
#pragma unroll
                    for (int n = 0; n < 2; ++n) { f32x4* p = (f32x4*)(rowp + bj * HALF + n * 16); *p = *p + acc[ai][bj][m][n]; }
                asm volatile("" ::: "memory"); }
    }
};
struct EpiBf8 {
    static constexpr bool PERM = true, AFTER_DRAIN = false;
    bf16_t* O; int ldc; int s_lo, s_hi; float scale; const float* sA; const float* sB;
    __device__ __forceinline__ void operator()(const i32x4 (&acc)[2][2][4][2], const Unit& u, int wr, int wc, int fr, int fq) const {
        const int row0 = u.pm * BM + wr * 64 + fr, col0 = u.pn * BM + wc * 32 + 8 * fq;
        const float sc = (u.pn >= s_lo && u.pn < s_hi) ? scale : 1.f;
        f32x4 cb[2][2];
#pragma unroll
        for (int bj = 0; bj < 2; ++bj)
#pragma unroll
            for (int n = 0; n < 2; ++n) cb[bj][n] = *(const f32x4*)(sB + col0 + bj * HALF + 4 * n) * sc;
#pragma unroll
        for (int ai = 0; ai < 2; ++ai)
#pragma unroll
            for (int m = 0; m < 4; ++m) { const int row = row0 + ai * HALF + m * 16; const float ra = sA[row]; bf16_t* rowp = O + (size_t)row * ldc + col0;
#pragma unroll
                for (int bj = 0; bj < 2; ++bj) { const f32x4 v0 = __builtin_convertvector(acc[ai][bj][m][0], f32x4) * cb[bj][0] * ra, v1 = __builtin_convertvector(acc[ai][bj][m][1], f32x4) * cb[bj][1] * ra;
                    u32x4 w; w.x = cvt_pk_bf16(v0[0], v0[1]); w.y = cvt_pk_bf16(v0[2], v0[3]); w.z = cvt_pk_bf16(v1[0], v1[1]); w.w = cvt_pk_bf16(v1[2], v1[3]);
                    *(u32x4*)(rowp + bj * HALF) = w; } }
    }
};
struct EpiSwiglu8 {
    static constexpr bool PERM = true, AFTER_DRAIN = false;
    bf16_t* O; int ldc; const float* sA; const float* sB; int sb_exp; int tb1, tb2, tb3, tb4, tb5, tb6, tb7;
    __device__ __forceinline__ void operator()(const i32x4 (&acc)[2][2][4][2], const Unit& u, int wr, int wc, int fr, int fq) const {
        const int row0 = u.pm * BM + wr * 64 + fr, col0 = u.pn * HALF + wc * 32 + 8 * fq;
        const int e = (u.pm >= tb1) + (u.pm >= tb2) + (u.pm >= tb3) + (u.pm >= tb4) + (u.pm >= tb5) + (u.pm >= tb6) + (u.pm >= tb7);
        const float* sb = sB + (size_t)e * sb_exp + u.pn * BM + wc * 32 + 8 * fq;
        const f32x4 sg0 = *(const f32x4*)sb, sg1 = *(const f32x4*)(sb + 4), su0 = *(const f32x4*)(sb + HALF), su1 = *(const f32x4*)(sb + HALF + 4);
#pragma unroll
        for (int ai = 0; ai < 2; ++ai)
#pragma unroll
            for (int m = 0; m < 4; ++m) { const int row = row0 + ai * HALF + m * 16; const float ra = sA[row]; bf16_t* rowp = O + (size_t)row * ldc + col0;
                const f32x4 g0 = __builtin_convertvector(acc[ai][0][m][0], f32x4) * sg0 * ra, g1 = __builtin_convertvector(acc[ai][0][m][1], f32x4) * sg1 * ra;
                const f32x4 u0 = __builtin_convertvector(acc[ai][1][m][0], f32x4) * su0 * ra, u1 = __builtin_convertvector(acc[ai][1][m][1], f32x4) * su1 * ra;
                u32x4 w; w.x = cvt_pk_bf16(silu_mul(g0[0], u0[0]), silu_mul(g0[1], u0[1])); w.y = cvt_pk_bf16(silu_mul(g0[2], u0[2]), silu_mul(g0[3], u0[3]));
                w.z = cvt_pk_bf16(silu_mul(g1[0], u1[0]), silu_mul(g1[1], u1[1])); w.w = cvt_pk_bf16(silu_mul(g1[2], u1[2]), silu_mul(g1[3], u1[3]));
                *(u32x4*)rowp = w; }
    }
};
struct GOrder {
    StaticOrder so; const char* A; const char* B; size_t a_tile, b_tile, b_exp; int tb1, tb2, tb3, tb4, tb5, tb6, tb7;
    __device__ __forceinline__ bool next(int i, Unit& u) const { return so.next(i, u); }
    __device__ __forceinline__ const char* a_base(const Unit& u) const { return A + (size_t)u.pm * a_tile; }
    __device__ __forceinline__ const char* b_base(const Unit& u) const {
        const int e = (u.pm >= tb1) + (u.pm >= tb2) + (u.pm >= tb3) + (u.pm >= tb4) + (u.pm >= tb5) + (u.pm >= tb6) + (u.pm >= tb7);
        return B + (size_t)e * b_exp + (size_t)u.pn * b_tile; }
    __device__ __forceinline__ void a_ready(const Unit&) const {}
    __device__ __forceinline__ void done(const Unit&) const {}
};
template <class Epi, class Sched, bool ALIGN_EPI = false, bool SP2 = false, bool I8 = false>
__device__ __forceinline__ void gemm_phase(PG8_LAS unsigned char* lds, const Gemm g, const Sched& S, const Epi& E) {
    const int tid = threadIdx.x, wid = __builtin_amdgcn_readfirstlane(tid >> 6), lane = tid & 63, wr = wid >> 2, wc = wid & 3, fr = lane & 15, fq = lane >> 4;
    const int K = g.K, nt = K / BK;
    unsigned voffA[2], voffB[2];
#pragma unroll
    for (int i = 0; i < 2; ++i) { int R, C; stage_rc(tid * 16 + i * 8192, R, C); const int Rb = Epi::PERM ? ((R & ~31) + perm32(R & 31)) : R;
        voffA[i] = (unsigned)(R * K + C) * 2u; voffB[i] = (unsigned)(Rb * K + C) * 2u; }
    const size_t kstep = (size_t)(BK * 2);
    const size_t hstep = (size_t)HALF * K * 2;
        const unsigned ldsw = (unsigned)wid * 1024u;
    const int aoff = lds_byte(wr * 64 + fr, fq * 8), boff = lds_byte(wc * 32 + fr, fq * 8);
#define PG8_SA(b, h) (((b) * 2 + (h)) * HTB)
#define PG8_SB(b, h) ((4 + (b) * 2 + (h)) * HTB)
#define PG8_STAGE(bufoff, gbase, voff) do { _Pragma("unroll") for (int _i = 0; _i < 2; ++_i) \
        __builtin_amdgcn_global_load_lds((const unsigned*)((const char*)(gbase) + (voff)[_i]), (PG8_LAS unsigned*)(lds + (bufoff) + ldsw + _i * 8192), 16, 0, 0); } while (0)
#define PG8_LDA(dst, b, h) do { _Pragma("unroll") for (int m = 0; m < 4; ++m) _Pragma("unroll") for (int k = 0; k < 2; ++k) dst[m][k] = *(const PG8_LAS bf16x8*)(lds + PG8_SA(b, h) + aoff + m * 2048 + k * 1024); } while (0)
#define PG8_LDB(dst, b, h) do { _Pragma("unroll") for (int n = 0; n < 2; ++n) _Pragma("unroll") for (int k = 0; k < 2; ++k) dst[n][k] = *(const PG8_LAS bf16x8*)(lds + PG8_SB(b, h) + boff + n * 2048 + k * 1024); } while (0)
#define PG8_MMA(ai, bj, At, Bt) do { __builtin_amdgcn_s_setprio(1); _Pragma("unroll") for (int m = 0; m < 4; ++m) _Pragma("unroll") for (int n = 0; n < 2; ++n) _Pragma("unroll") for (int k = 0; k < 2; ++k) \
        acc[ai][bj][m][n] = mma_sel(Bt[n][k], At[m][k], acc[ai][bj][m][n]); __builtin_amdgcn_s_setprio(0); } while (0)
#define PG8_WAIT_V(n) asm volatile("s_waitcnt vmcnt(" #n ")" ::: "memory")
#define PG8_WAIT_L(n) asm volatile("s_waitcnt lgkmcnt(" #n ")" ::: "memory")
#define PG8_BAR __builtin_amdgcn_s_barrier()
#define PG8_SCHED __builtin_amdgcn_sched_barrier(0)
    Unit cur, nxt; int ui = 0;
    if (!S.next(0, cur)) return;
    typename AccT<I8>::type acc[2][2][4][2];
#pragma unroll
    for (int a = 0; a < 2; ++a)
#pragma unroll
        for (int b = 0; b < 2; ++b)
#pragma unroll
            for (int m = 0; m < 4; ++m)
#pragma unroll
                for (int n = 0; n < 2; ++n) acc[a][b][m][n] = typename AccT<I8>::type{};
    bf16x8 At[4][2], B0[2][2], B1[2][2];
    const char* cA = S.a_base(cur); const char* cB = S.b_base(cur);
    S.a_ready(cur);
    if constexpr (SP2) {
        PG8_STAGE(PG8_SB(0, 0), cB, voffB); PG8_STAGE(PG8_SB(0, 1), cB + hstep, voffB); PG8_STAGE(PG8_SA(0, 0), cA, voffA); PG8_STAGE(PG8_SA(0, 1), cA + hstep, voffA);
        if (wr == 1) PG8_BAR;
        PG8_WAIT_V(2); PG8_BAR;
        PG8_STAGE(PG8_SB(1, 0), cB + kstep, voffB); PG8_STAGE(PG8_SA(1, 0), cA + kstep, voffA); PG8_STAGE(PG8_SB(1, 1), cB + hstep + kstep, voffB);
        PG8_WAIT_V(6); PG8_BAR;
    } else {
        PG8_STAGE(PG8_SB(0, 0), cB, voffB); PG8_STAGE(PG8_SA(0, 0), cA, voffA); PG8_STAGE(PG8_SB(0, 1), cB + hstep, voffB); PG8_STAGE(PG8_SA(0, 1), cA + hstep, voffA);
        if (wr == 1) PG8_BAR;
        PG8_WAIT_V(4); PG8_BAR;
        PG8_STAGE(PG8_SB(1, 0), cB + kstep, voffB); PG8_STAGE(PG8_SA(1, 0), cA + kstep, voffA); PG8_STAGE(PG8_SB(1, 1), cB + hstep + kstep, voffB);
        PG8_WAIT_V(6); PG8_BAR;
    }
    for (;;) {
        const bool has_next = S.next(ui + 1, nxt);
        const char* nA = has_next ? S.a_base(nxt) : cA; const char* nB = has_next ? S.b_base(nxt) : cB;
        for (int t = 0; t < nt; t += 2) {
            const bool last = (t == nt - 2);
            const char* a1 = cA + (size_t)(t + 1) * kstep;
            const char* a2 = last ? nA : cA + (size_t)(t + 2) * kstep; const char* b2 = last ? nB : cB + (size_t)(t + 2) * kstep;
            const char* a3 = a2 + kstep; const char* b3 = b2 + kstep;
            if (last && has_next) S.a_ready(nxt);
            if constexpr (SP2) {
            PG8_LDB(B0, 0, 0); PG8_LDB(B1, 0, 1); PG8_SCHED; PG8_LDA(At, 0, 0); PG8_STAGE(PG8_SA(1, 1), a1 + hstep, voffA);
            PG8_WAIT_V(8); PG8_WAIT_L(0); PG8_BAR; PG8_MMA(0, 0, At, B0); PG8_MMA(0, 1, At, B1); PG8_BAR; PG8_SCHED;
            PG8_LDA(At, 0, 1); PG8_STAGE(PG8_SB(0, 0), b2, voffB); PG8_STAGE(PG8_SB(0, 1), b2 + hstep, voffB); PG8_STAGE(PG8_SA(0, 0), a2, voffA);
            PG8_WAIT_V(8); PG8_WAIT_L(0); PG8_BAR; PG8_MMA(1, 0, At, B0); PG8_MMA(1, 1, At, B1); PG8_BAR; PG8_SCHED;
            PG8_LDB(B0, 1, 0); PG8_LDB(B1, 1, 1); PG8_SCHED; PG8_LDA(At, 1, 0); PG8_STAGE(PG8_SA(0, 1), a2 + hstep, voffA);
            PG8_WAIT_V(8); PG8_WAIT_L(0); PG8_BAR; PG8_MMA(0, 0, At, B0); PG8_MMA(0, 1, At, B1); PG8_BAR; PG8_SCHED;
            PG8_LDA(At, 1, 1); PG8_STAGE(PG8_SB(1, 0), b3, voffB); PG8_STAGE(PG8_SB(1, 1), b3 + hstep, voffB); PG8_STAGE(PG8_SA(1, 0), a3, voffA);
            PG8_WAIT_V(8); PG8_WAIT_L(0); PG8_BAR; PG8_MMA(1, 0, At, B0); PG8_MMA(1, 1, At, B1); PG8_BAR; PG8_SCHED;
            } else {
            PG8_LDB(B0, 0, 0); PG8_SCHED; PG8_LDA(At, 0, 0); PG8_STAGE(PG8_SA(1, 1), a1 + hstep, voffA);
            PG8_WAIT_L(8); PG8_BAR; PG8_WAIT_L(0); PG8_MMA(0, 0, At, B0); PG8_BAR; PG8_SCHED;
            PG8_LDB(B1, 0, 1); PG8_STAGE(PG8_SB(0, 0), b2, voffB);
            PG8_BAR; PG8_WAIT_L(0); PG8_MMA(0, 1, At, B1); PG8_BAR;
            PG8_LDA(At, 0, 1); PG8_STAGE(PG8_SA(0, 0), a2, voffA);
            PG8_BAR; PG8_WAIT_L(0); PG8_MMA(1, 0, At, B0); PG8_BAR; PG8_SCHED;
            PG8_STAGE(PG8_SB(0, 1), b2 + hstep, voffB);
            PG8_WAIT_V(6); PG8_BAR; PG8_MMA(1, 1, At, B1); PG8_BAR;
            PG8_LDB(B0, 1, 0); PG8_SCHED; PG8_LDA(At, 1, 0); PG8_STAGE(PG8_SA(0, 1), a2 + hstep, voffA);
            PG8_WAIT_L(8); PG8_BAR; PG8_WAIT_L(0); PG8_MMA(0, 0, At, B0); PG8_BAR; PG8_SCHED;
            PG8_LDB(B1, 1, 1); PG8_STAGE(PG8_SB(1, 0), b3, voffB);
            PG8_BAR; PG8_WAIT_L(0); PG8_MMA(0, 1, At, B1); PG8_BAR;
            PG8_LDA(At, 1, 1); PG8_STAGE(PG8_SA(1, 0), a3, voffA);
            PG8_BAR; PG8_WAIT_L(0); PG8_MMA(1, 0, At, B0); PG8_BAR; PG8_SCHED;
            PG8_STAGE(PG8_SB(1, 1), b3 + hstep, voffB);
            PG8_WAIT_V(6); PG8_BAR; PG8_MMA(1, 1, At, B1); PG8_BAR;
            }
        }
        if constexpr (ALIGN_EPI) { if (wr == 0) PG8_BAR; }
        if constexpr (!Epi::AFTER_DRAIN) { E(acc, cur, wr, wc, fr, fq); S.done(cur); }
        if (!has_next) break;
#pragma unroll
        for (int a = 0; a < 2; ++a)
#pragma unroll
            for (int b = 0; b < 2; ++b)
#pragma unroll
                for (int m = 0; m < 4; ++m)
#pragma unroll
                    for (int n = 0; n < 2; ++n) acc[a][b][m][n] = typename AccT<I8>::type{};
        cur = nxt; cA = nA; cB = nB; ++ui;
        if constexpr (ALIGN_EPI) { if (wr == 1) PG8_BAR; }
    }
    PG8_WAIT_V(0);
    if constexpr (!ALIGN_EPI) { if (wr == 0) PG8_BAR; }
    PG8_BAR;
    if constexpr (Epi::AFTER_DRAIN) { E.fused(acc, cur, wr, wc, fr, fq, lds, wid, lane); S.done(cur); }
#undef PG8_SA
#undef PG8_SB
#undef PG8_STAGE
#undef PG8_LDA
#undef PG8_LDB
#undef PG8_MMA
#undef PG8_WAIT_V
#undef PG8_WAIT_L
#undef PG8_BAR
#undef PG8_SCHED
}
}
#include <hip/hip_bf16.h>
#include <cmath>
namespace attn_body {
using bf16=__hip_bfloat16;
using bf16x8=__attribute__((ext_vector_type(8)))short;
using s16x4=__attribute__((ext_vector_type(4)))short;
using f32x16=__attribute__((ext_vector_type(16)))float;
using u32x4=__attribute__((ext_vector_type(4)))unsigned;
constexpr int BATCH=2,NHEAD=8,SEQ=8192,D=64,DM=3584,OPITCH=1024;
constexpr int NW=8,QBLK=32,QB=QBLK*NW,KVBLK=64,NQB=SEQ/QB;
constexpr int ATTN_PITCH=DM, ATTN_UNIT_ROWS=QB;
__device__ __forceinline__ int crow(int r,int hi){return (r&3)+8*(r>>2)+4*hi;}
#define SBAR() __builtin_amdgcn_sched_barrier(0)
__device__ __forceinline__ void cmask(f32x16&p0,f32x16&p1,int jb,int qrel,int hi){
  const float NEG=-INFINITY; int kb=64*jb+4*hi;
  #pragma unroll
  for(int r=0;r<16;++r){int kv=kb+(r&3)+8*(r>>2); if(kv>qrel)p0[r]=NEG; if(kv+32>qrel)p1[r]=NEG;}
}

constexpr int NSLOT=3, SLOTB=8192, SPLIT_NT=72, PART_F=256*64+512;
constexpr int LDS_K=0, LDS_V=NSLOT*SLOTB, LDS_WS=2*NSLOT*SLOTB, LDS_OST=LDS_WS+NW*64*4, LDS_CK=LDS_OST+NW*4096, LDS_BYTES=LDS_CK+SEQ*4;
constexpr float C2=0.125f*1.4426950408889634f;
__device__ __forceinline__ void glds16(const void*gsrc,unsigned lds_dst){unsigned keep;
  asm volatile("s_mov_b32 %0, m0\n\ts_mov_b32 m0, %2\n\ts_nop 0\n\tglobal_load_lds_dwordx4 %1, off\n\ts_mov_b32 m0, %0":"=&s"(keep):"v"(gsrc),"s"(lds_dst):"memory");}
__device__ __forceinline__ float max3f(float a,float b,float c){float r;asm("v_max3_f32 %0, %1, %2, %3":"=v"(r):"v"(a),"v"(b),"v"(c));return r;}
__device__ __forceinline__ float max2f(float a,float b){float r;asm("v_max_f32_e32 %0, %1, %2":"=v"(r):"v"(a),"v"(b));return r;}
__device__ __forceinline__ float fadd_s(float a,float b){float r;asm("v_add_f32_e32 %0, %1, %2":"=v"(r):"v"(a),"v"(b));return r;}
__device__ __forceinline__ float fsub_s(float a,float b){float r;asm("v_sub_f32_e32 %0, %1, %2":"=v"(r):"v"(a),"v"(b));return r;}
typedef float f32x2_t __attribute__((ext_vector_type(2))); typedef float f32x4_t __attribute__((ext_vector_type(4))); typedef __bf16 bf16x2_t __attribute__((ext_vector_type(2)));
__device__ __forceinline__ unsigned cvtpk_s(float lo,float hi){f32x2_t v={lo,hi};bf16x2_t b=__builtin_convertvector(v,bf16x2_t);return __builtin_bit_cast(unsigned,b);}
#define WAIT_BAR(N) asm volatile("s_waitcnt vmcnt(" #N ") lgkmcnt(0)\n\ts_barrier":::"memory")

__device__ __forceinline__ void qkt(f32x16&p0,f32x16&p1,const char*Kslot,const bf16x8*qr,const f32x16&negm,int r32,int hi){
  const char*kb=Kslot+hi*1024+r32*16;
  #pragma unroll
  for(int d0=0;d0<4;++d0){
    const bf16x8 b0=*reinterpret_cast<const bf16x8*>(kb+d0*2048);
    const bf16x8 b1=*reinterpret_cast<const bf16x8*>(kb+d0*2048+512);
    if(d0==0){p0=__builtin_amdgcn_mfma_f32_32x32x16_bf16(b0,qr[0],negm,0,0,0);p1=__builtin_amdgcn_mfma_f32_32x32x16_bf16(b1,qr[0],negm,0,0,0);}
    else{p0=__builtin_amdgcn_mfma_f32_32x32x16_bf16(b0,qr[d0],p0,0,0,0);p1=__builtin_amdgcn_mfma_f32_32x32x16_bf16(b1,qr[d0],p1,0,0,0);}}
}
typedef __attribute__((address_space(3))) const char* lds_cptr;
typedef short v4i16_t __attribute__((ext_vector_type(4)));
__device__ __forceinline__ void kload8(bf16x8*kf,lds_cptr kp){
  kf[0]=*(const __attribute__((address_space(3))) bf16x8*)(kp);      kf[1]=*(const __attribute__((address_space(3))) bf16x8*)(kp+512);
  kf[2]=*(const __attribute__((address_space(3))) bf16x8*)(kp+2048); kf[3]=*(const __attribute__((address_space(3))) bf16x8*)(kp+2560);
  kf[4]=*(const __attribute__((address_space(3))) bf16x8*)(kp+4096); kf[5]=*(const __attribute__((address_space(3))) bf16x8*)(kp+4608);
  kf[6]=*(const __attribute__((address_space(3))) bf16x8*)(kp+6144); kf[7]=*(const __attribute__((address_space(3))) bf16x8*)(kp+6656);
}
__device__ __forceinline__ void kload2(bf16x8*kf,lds_cptr kp,int j){ kf[2*j]=*(const __attribute__((address_space(3))) bf16x8*)(kp+j*2048); kf[2*j+1]=*(const __attribute__((address_space(3))) bf16x8*)(kp+j*2048+512); }
__device__ __forceinline__ s16x4 vtr(lds_cptr p){ return __builtin_bit_cast(s16x4,__builtin_amdgcn_ds_read_tr16_b64_v4i16((__attribute__((address_space(3))) v4i16_t*)p)); }
__device__ __forceinline__ float rowmax(const f32x16&p0,const f32x16&p1){
  float a=max3f(p0[0],p0[1],p1[0]),b=max3f(p0[2],p0[3],p1[1]);a=max3f(a,p1[2],p1[3]);
  #pragma unroll
  for(int r=4;r<16;r+=4){a=max3f(a,p0[r],p0[r+1]);b=max3f(b,p0[r+2],p0[r+3]);a=max3f(a,p1[r],p1[r+1]);b=max3f(b,p1[r+2],p1[r+3]);}
  const float m=max2f(a,b);
  auto rr=__builtin_amdgcn_permlane32_swap(__float_as_uint(m),__float_as_uint(m),false,false);
  return max2f(__uint_as_float(rr[0]),__uint_as_float(rr[1]));
}
__device__ __forceinline__ void pv(f32x16*o,int vb,bf16x8 pa0,bf16x8 pa1,bf16x8 pa2,bf16x8 pa3){
  #pragma unroll
  for(int d0=0;d0<2;++d0){s16x4 lo[4],hi[4];
    #pragma unroll
    for(int ks=0;ks<4;++ks){
      asm volatile("ds_read_b64_tr_b16 %0,%1 offset:%c2":"=&v"(lo[ks]):"v"(vb),"i"(d0*4096+ks*1024):"memory");
      asm volatile("ds_read_b64_tr_b16 %0,%1 offset:%c2":"=&v"(hi[ks]):"v"(vb),"i"(d0*4096+ks*1024+512):"memory");}
    asm volatile("s_waitcnt lgkmcnt(0)":::"memory");SBAR();
    #define PK(k) (bf16x8){lo[k][0],lo[k][1],lo[k][2],lo[k][3],hi[k][0],hi[k][1],hi[k][2],hi[k][3]}
    o[d0]=__builtin_amdgcn_mfma_f32_32x32x16_bf16(pa0,PK(0),o[d0],0,0,0);
    o[d0]=__builtin_amdgcn_mfma_f32_32x32x16_bf16(pa1,PK(1),o[d0],0,0,0);
    o[d0]=__builtin_amdgcn_mfma_f32_32x32x16_bf16(pa2,PK(2),o[d0],0,0,0);
    o[d0]=__builtin_amdgcn_mfma_f32_32x32x16_bf16(pa3,PK(3),o[d0],0,0,0);
    #undef PK
  }
}

#ifndef ATTN_STORE16
#define ATTN_STORE16(p,v) (*(u32x4*)(p)=(v))
#endif
template<int THRL> __device__ __forceinline__ void attn_unit(int b,int h,int qb,const bf16*Q,const bf16*__restrict__ K,const bf16*__restrict__ V,bf16*O,const float*__restrict__ cf,const float Tskip,const int part,float*PART,unsigned*flag,char*shm){
  int tid_=threadIdx.x; asm volatile("":"+v"(tid_));
  const int tid=tid_,lane=tid&63,r32=lane&31,hi=lane>>5; const int wid=__builtin_amdgcn_readfirstlane(tid>>6);
  const long rowbase=(long)b*SEQ; const int q0=qb*QB;
  const bf16*Qw=Q+(rowbase+q0+wid*QBLK)*DM+h*D;
  const unsigned lds0=(unsigned)(uintptr_t)shm;
  float*wsf=(float*)(shm+LDS_WS)+wid*64;
  const unsigned kdst=lds0+LDS_K+wid*1024, vdst=lds0+LDS_V+wid*1024;
  #define DMA_K(t,slot) glds16(ksrc+(long)(t)*KVBLK*DM,(unsigned)__builtin_amdgcn_readfirstlane(kdst+(slot)))
  #define DMA_V(t,slot) glds16(vsrc+(long)(t)*KVBLK*DM,(unsigned)__builtin_amdgcn_readfirstlane(vdst+(slot)))
  const int vb0=(int)(lds0+LDS_V)+((lane>>4)&1)*32+(lane&3)*8+(4*hi+((lane&15)>>2))*64;
  const char*Kbase=shm+LDS_K; bf16x8 kf[8];
  const lds_cptr shm3=(lds_cptr)shm; const lds_cptr kp0=shm3+LDS_K+hi*1024+r32*16; const lds_cptr vp0=shm3+LDS_V+((lane>>4)&1)*32+(lane&3)*8+(4*hi+((lane&15)>>2))*64;
  typedef __attribute__((address_space(3))) float lds_f32; typedef __attribute__((address_space(3))) const f32x4_t* lds_cf4;
  const int NT0=(q0+QB)/KVBLK;
  int tb;
  { const float thr=cf[q0]+Tskip; const int t1=lane,t2=lane+64;
    const bool n1=(t1<NT0)&&(cf[64*t1+63]>thr), n2=(t2<NT0)&&(cf[64*t2+63]>thr);
    const int t0=(int)__popcll(__ballot(n1))+(int)__popcll(__ballot(n2));
    tb=t0&~1; if(tb>NT0-4)tb=NT0-4; tb=__builtin_amdgcn_readfirstlane(tb); }
  int NT=NT0-tb; bool band=true; const bool split=(PART!=nullptr)&&(NT>SPLIT_NT);
  if(PART!=nullptr){ if(!split){ if(part==1)return; } else { const int mid=(NT>>1)&~1; if(part==0){NT=mid;band=false;} else {tb+=mid;NT-=mid;} } }
  { lds_f32* ckw=(lds_f32*)((lds_cptr)shm+LDS_CK); int i0_=tb*KVBLK+tid; asm volatile("":"+v"(i0_)); _Pragma("nounroll") for(int i=i0_;i<q0+QB;i+=NW*64)ckw[i]=cf[i]; }
  const float cq=cf[q0+wid*QBLK+(lane&31)];
  asm volatile("s_waitcnt vmcnt(0) lgkmcnt(0)\n\ts_barrier":::"memory");
  const bf16*Kh=K+(rowbase+(long)tb*KVBLK)*DM+h*D,*Vh=V+(rowbase+(long)tb*KVBLK)*DM+h*D;
  const bf16*ksrc=Kh+(long)lane*DM+wid*8;
  const bf16*vsrc=Vh+(long)(16*(wid&3)+(lane>>2))*DM+(wid>>2)*32+(lane&3)*8;
  const lds_cptr ckl=(lds_cptr)shm+LDS_CK+256*tb+16*(lane>>5);
  #define CBIAS(P0,P1,t) do{ const lds_cptr cb_=ckl+256*(t); _Pragma("unroll") for(int g_=0;g_<4;++g_){ const f32x4_t a_=*(lds_cf4)(cb_+32*g_), b_=*(lds_cf4)(cb_+128+32*g_); \
      _Pragma("unroll") for(int i_=0;i_<4;++i_){ P0[4*g_+i_]-=(a_[i_]+mm); P1[4*g_+i_]-=(b_[i_]+mm); } } }while(0)
  f32x4_t cbA[4],cbB[4]; float clast;
  #define CBLD(t) do{ const lds_cptr cb_=ckl+256*(t); _Pragma("unroll") for(int g_=0;g_<4;++g_){ cbA[g_]=*(lds_cf4)(cb_+32*g_); cbB[g_]=*(lds_cf4)(cb_+128+32*g_); } \
      clast=*(const __attribute__((address_space(3))) float*)((lds_cptr)shm+LDS_CK+256*tb+256*(t)+252); }while(0)
  DMA_K(0,0);DMA_V(0,0);DMA_K(1,SLOTB);
  bf16x8 qr[4];
  #pragma unroll
  for(int d0=0;d0<4;++d0)qr[d0]=*reinterpret_cast<const bf16x8*>(&Qw[(long)r32*DM+d0*16+hi*8]);
  float mhat=0.f,l_reg=0.f;f32x16 o[2];o[0]=f32x16{};o[1]=f32x16{};float mm=-cq; const f32x16 negm=f32x16{};
  const int qrel=wid*QBLK+r32;
  #define CMASK(P0,P1,t) do{int jb_=(t)-(NT-4); if(band&&jb_>=0)cmask(P0,P1,jb_,qrel,hi);}while(0)
  bool resc=false;
  #define START(P0,P1) do{ const float rm=rowmax(P0,P1); resc=false; \
    { const float dl=rm; mhat=fadd_s(mhat,dl); \
      _Pragma("unroll") for(int r=0;r<16;++r){P0[r]=fsub_s(P0[r],dl);P1[r]=fsub_s(P1[r],dl);} \
      mm+=dl; } \
    _Pragma("unroll") for(int r=0;r<16;++r)P0[r]=__builtin_amdgcn_exp2f(P0[r]); }while(0)
  #define RESC() do{ if(resc){ asm volatile("s_waitcnt lgkmcnt(0)":::"memory"); \
      _Pragma("unroll") for(int d_=0;d_<2;++d_) _Pragma("unroll") for(int r=0;r<16;++r)o[d_][r]*=wsf[crow(r,hi)]; } }while(0)
  f32x16 pA0,pA1,pB0,pB1;
  int sl_prev=0,sl_cur=0,sl_next=SLOTB;
  #define ROT() do{sl_prev=sl_cur;sl_cur=sl_next;sl_next=(sl_next==(NSLOT-1)*SLOTB)?0:sl_next+SLOTB;}while(0)
  DMA_K(2,2*SLOTB);
  WAIT_BAR(3);
  qkt(pA0,pA1,Kbase,qr,negm,r32,hi);asm volatile("s_nop 15\n\ts_nop 7":"+v"(pA0),"+v"(pA1));CBIAS(pA0,pA1,0);CMASK(pA0,pA1,0);
  START(pA0,pA1);
  _Pragma("unroll") for(int r=0;r<16;++r)pA1[r]=__builtin_amdgcn_exp2f(pA1[r]);
  WAIT_BAR(0);
  DMA_K(3,0);DMA_V(1,SLOTB);
  ROT();
  kload8(kf,kp0+sl_cur);
  WAIT_BAR(2);
  s16x4 vlo[8],vhi[8]; u32x4 pw0,pw1,pw2,pw3;
  #define PKW(P,B) cvtpk_s(P[B],P[B+1])
  #define PAF(k) __builtin_bit_cast(bf16x8,pw##k)
  #define VFR(i) (bf16x8){vlo[i][0],vlo[i][1],vlo[i][2],vlo[i][3],vhi[i][0],vhi[i][1],vhi[i][2],vhi[i][3]}
  #define PIN(x) asm volatile("":"+v"(x))
  #define MX3(a,b,c) __builtin_fmaxf(__builtin_fmaxf((a),(b)),(c))
  #define GAPA(MF,A0,A1,A2,A3,W0,W1,PW) do{ MF; sacc+=A0; sacc+=A1; sacc+=A2; sacc+=A3; PIN(sacc); W0; W1; PIN(PW); SBAR(); }while(0)
  #define EX(v) __builtin_amdgcn_exp2f(v)
  #define GAPB(MF,X,B,CB) do{ MF; { const f32x4_t t_=(CB)+mm; X[B]=EX(X[B]-t_[0]); X[B+1]=EX(X[B+1]-t_[1]); X[B+2]=EX(X[B+2]-t_[2]); X[B+3]=EX(X[B+3]-t_[3]); } PIN(X); SBAR(); }while(0)
  #define VRD(i) do{ vlo[i]=vtr(vp_+(((i)>>2)*4096+((i)&3)*1024)); vhi[i]=vtr(vp_+(((i)>>2)*4096+((i)&3)*1024+512)); }while(0)
  #define KRD(G,j) do{ if(G){ kload2(kf,kp0+sl_next,j); SBAR(); } }while(0)
  #define STEP(C0,C1,P0,P1,t,GK,GV,GL) do{ SBAR(); \
    const lds_cptr vp_=vp0+sl_prev; \
    VRD(0); SBAR(); float sacc=(P0[0]+P0[1]); \
    GAPA(C0=__builtin_amdgcn_mfma_f32_32x32x16_bf16(kf[0],qr[0],negm,0,0,0), P0[2],P0[3],P0[4],P0[5],     pw0[0]=PKW(P0,0), pw0[1]=PKW(P0,2), pw0); \
    VRD(4); SBAR(); GAPA(C1=__builtin_amdgcn_mfma_f32_32x32x16_bf16(kf[1],qr[0],negm,0,0,0), P0[6],P0[7],P0[8],P0[9],     pw0[2]=PKW(P0,4), pw0[3]=PKW(P0,6), pw0); \
    VRD(1); SBAR(); GAPA(C0=__builtin_amdgcn_mfma_f32_32x32x16_bf16(kf[2],qr[1],C0,0,0,0),   P0[10],P0[11],P0[12],P0[13], pw1[0]=PKW(P0,8), pw1[1]=PKW(P0,10), pw1); \
    VRD(5); SBAR(); GAPA(C1=__builtin_amdgcn_mfma_f32_32x32x16_bf16(kf[3],qr[1],C1,0,0,0),   P0[14],P0[15],P1[0],P1[1],   pw1[2]=PKW(P0,12),pw1[3]=PKW(P0,14), pw1); \
    VRD(2); SBAR(); GAPA(C0=__builtin_amdgcn_mfma_f32_32x32x16_bf16(kf[4],qr[2],C0,0,0,0),   P1[2],P1[3],P1[4],P1[5],     pw2[0]=PKW(P1,0), pw2[1]=PKW(P1,2), pw2); \
    VRD(6); SBAR(); GAPA(C1=__builtin_amdgcn_mfma_f32_32x32x16_bf16(kf[5],qr[2],C1,0,0,0),   P1[6],P1[7],P1[8],P1[9],     pw2[2]=PKW(P1,4), pw2[3]=PKW(P1,6), pw2); \
    VRD(3); SBAR(); GAPA(C0=__builtin_amdgcn_mfma_f32_32x32x16_bf16(kf[6],qr[3],C0,0,0,0),   P1[10],P1[11],P1[12],P1[13], pw3[0]=PKW(P1,8), pw3[1]=PKW(P1,10), pw3); \
    VRD(7); SBAR(); GAPA(C1=__builtin_amdgcn_mfma_f32_32x32x16_bf16(kf[7],qr[3],C1,0,0,0),   P1[14],P1[15],0.f,0.f,       pw3[2]=PKW(P1,12),pw3[3]=PKW(P1,14), pw3); \
    l_reg+=sacc; \
    if(GK){DMA_K((t)+3,sl_cur);} if(GV){DMA_V((t)+1,sl_next);} \
    CBLD(t); CMASK(C0,C1,t); \
    { float a=MX3(C0[0],C0[1],C1[0]),b=MX3(C0[2],C0[3],C1[1]); a=MX3(a,C1[2],C1[3]); \
      _Pragma("unroll") for(int r=4;r<16;r+=4){a=MX3(a,C0[r],C0[r+1]);b=MX3(b,C0[r+2],C0[r+3]);a=MX3(a,C1[r],C1[r+1]);b=MX3(b,C1[r+2],C1[r+3]);} \
      float rm=__builtin_fmaxf(a,b); { auto rr=__builtin_amdgcn_permlane32_swap(__float_as_uint(rm),__float_as_uint(rm),false,false); rm=__builtin_fmaxf(__uint_as_float(rr[0]),__uint_as_float(rr[1])); } rm=rm-clast-mm; \
      resc=false; \
      if(__builtin_expect(__any(rm>(float)THRL),0)){ const float dl=__builtin_fmaxf(rm,0.f); mhat+=dl; \
        mm+=dl; \
        const float f=__builtin_amdgcn_exp2f(-dl); l_reg*=f; if(hi==0)wsf[r32]=f; resc=true; } } \
    SBAR(); \
    GAPB(o[0]=__builtin_amdgcn_mfma_f32_32x32x16_bf16(PAF(0),VFR(0),o[0],0,0,0), C0,0,cbA[0]); \
    GAPB(o[1]=__builtin_amdgcn_mfma_f32_32x32x16_bf16(PAF(0),VFR(4),o[1],0,0,0), C0,4,cbA[1]); \
    KRD(GL,0); GAPB(o[0]=__builtin_amdgcn_mfma_f32_32x32x16_bf16(PAF(1),VFR(1),o[0],0,0,0), C0,8,cbA[2]); \
    KRD(GL,1); GAPB(o[1]=__builtin_amdgcn_mfma_f32_32x32x16_bf16(PAF(1),VFR(5),o[1],0,0,0), C0,12,cbA[3]); \
    KRD(GL,2); GAPB(o[0]=__builtin_amdgcn_mfma_f32_32x32x16_bf16(PAF(2),VFR(2),o[0],0,0,0), C1,0,cbB[0]); \
    KRD(GL,3); GAPB(o[1]=__builtin_amdgcn_mfma_f32_32x32x16_bf16(PAF(2),VFR(6),o[1],0,0,0), C1,4,cbB[1]); \
    GAPB(o[0]=__builtin_amdgcn_mfma_f32_32x32x16_bf16(PAF(3),VFR(3),o[0],0,0,0), C1,8,cbB[2]); \
    GAPB(o[1]=__builtin_amdgcn_mfma_f32_32x32x16_bf16(PAF(3),VFR(7),o[1],0,0,0), C1,12,cbB[3]); \
    }while(0)
  int t=1;
  #undef CMASK
  #define CMASK(P0,P1,t) do{}while(0)
  for(;t+5<NT;t+=2){
    STEP(pB0,pB1,pA0,pA1,t,true,true,true);     WAIT_BAR(2); RESC(); ROT();
    STEP(pA0,pA1,pB0,pB1,t+1,true,true,true);   WAIT_BAR(2); RESC(); ROT();
  }
  #undef CMASK
  #define CMASK(P0,P1,t) do{int jb_=(t)-(NT-4); if(band&&jb_>=0)cmask(P0,P1,jb_,qrel,hi);}while(0)
  #define ENDW(tt) do{ if((tt)+3<NT){WAIT_BAR(2);} else if((tt)+2<NT){WAIT_BAR(1);} else {WAIT_BAR(0);} }while(0)
  for(;t+1<NT;t+=2){
    STEP(pB0,pB1,pA0,pA1,t,(t+3<NT),(t+1<NT),(t+1<NT));       ENDW(t);   RESC(); ROT();
    STEP(pA0,pA1,pB0,pB1,t+1,(t+4<NT),(t+2<NT),(t+2<NT));     ENDW(t+1); RESC(); ROT();
  }
  STEP(pB0,pB1,pA0,pA1,NT-1,false,false,false); RESC();
  { float sacc=pB0[0]+pB0[1]; _Pragma("unroll") for(int r=2;r<16;++r)sacc+=pB0[r]; _Pragma("unroll") for(int r=0;r<16;++r)sacc+=pB1[r]; l_reg+=sacc;
    pw0=(u32x4){PKW(pB0,0),PKW(pB0,2),PKW(pB0,4),PKW(pB0,6)};pw1=(u32x4){PKW(pB0,8),PKW(pB0,10),PKW(pB0,12),PKW(pB0,14)};pw2=(u32x4){PKW(pB1,0),PKW(pB1,2),PKW(pB1,4),PKW(pB1,6)};pw3=(u32x4){PKW(pB1,8),PKW(pB1,10),PKW(pB1,12),PKW(pB1,14)};
    SBAR(); pv(o,vb0+sl_cur,PAF(0),PAF(1),PAF(2),PAF(3)); }
  #undef PKW
  #undef PAF
  #undef VFR
  #undef PIN
  #undef MX3
  #undef GAPA
  #undef GAPB
  #undef EX
  #undef VRD
  #undef KRD
  #undef STEP
  #undef ENDW
  {auto rr=__builtin_amdgcn_permlane32_swap(__float_as_uint(l_reg),__float_as_uint(l_reg),false,false);l_reg=__uint_as_float(rr[0])+__uint_as_float(rr[1]);}
  if(hi==0)wsf[32+r32]=l_reg;asm volatile("s_waitcnt lgkmcnt(0)":::"memory");
  float rli[16];
  if(split){
    float*Pm=PART+(size_t)part*PART_F; const float*Po=PART+(size_t)(1-part)*PART_F;
    #pragma unroll
    for(int r=0;r<16;++r){
      #pragma unroll
      for(int d0=0;d0<2;++d0)Pm[(wid*QBLK+crow(r,hi))*64+d0*32+r32]=o[d0][r];}
    if(hi==0){Pm[QB*64+(wid*QBLK+r32)*2]=mm+cq;Pm[QB*64+(wid*QBLK+r32)*2+1]=l_reg;wsf[r32]=mm+cq;}
    asm volatile("s_waitcnt vmcnt(0) lgkmcnt(0)\n\ts_barrier":::"memory");
    if(tid==0){ __builtin_amdgcn_fence(__ATOMIC_RELEASE,"agent"); asm volatile("s_waitcnt vmcnt(0)":::"memory");
      *(volatile __attribute__((address_space(3))) unsigned*)((__attribute__((address_space(3))) char*)shm+LDS_OST)=__hip_atomic_fetch_add(flag,1u,__ATOMIC_RELAXED,__HIP_MEMORY_SCOPE_AGENT); }
    asm volatile("s_waitcnt vmcnt(0) lgkmcnt(0)\n\ts_barrier":::"memory");
    const unsigned old=*(volatile __attribute__((address_space(3))) unsigned*)((__attribute__((address_space(3))) char*)shm+LDS_OST);
    asm volatile("s_waitcnt lgkmcnt(0)\n\ts_barrier":::"memory");
    if(old==0u)return;
    __builtin_amdgcn_fence(__ATOMIC_ACQUIRE,"agent"); asm volatile("s_waitcnt vmcnt(0)":::"memory");
    #pragma unroll
    for(int r=0;r<16;++r){ const int row=crow(r,hi); const float mo=wsf[row],lo=wsf[32+row],mt=Po[QB*64+(wid*QBLK+row)*2],lt=Po[QB*64+(wid*QBLK+row)*2+1];
      const float m=__builtin_fmaxf(mo,mt),fo=__builtin_amdgcn_exp2f(mo-m),ft=__builtin_amdgcn_exp2f(mt-m),inv=__builtin_amdgcn_rcpf(lo*fo+lt*ft);
      #pragma unroll
      for(int d0=0;d0<2;++d0)o[d0][r]=(o[d0][r]*fo+Po[(wid*QBLK+row)*64+d0*32+r32]*ft)*inv;
      rli[r]=1.f; }
  } else {
  #pragma unroll
  for(int r=0;r<16;++r)rli[r]=__builtin_amdgcn_rcpf(wsf[32+crow(r,hi)]);
  }
  bf16*Ow=O+(rowbase+q0+wid*QBLK)*OPITCH+h*D;
  { bf16*stg=(bf16*)(shm+LDS_OST)+wid*2048;
    #pragma unroll
    for(int r=0;r<16;++r){const int orow=crow(r,hi);
      #pragma unroll
      for(int d0=0;d0<2;++d0)stg[orow*64+d0*32+r32]=__float2bfloat16(o[d0][r]*rli[r]);}
    asm volatile("s_waitcnt lgkmcnt(0)":::"memory");
    #pragma unroll
    for(int i=0;i<4;++i){const int row=i*8+(lane>>3),ch=lane&7; const u32x4 v=*(const u32x4*)(stg+row*64+ch*8); ATTN_STORE16(Ow+(long)row*OPITCH+ch*8,v);} }
  asm volatile("s_waitcnt lgkmcnt(0)\n\ts_barrier":::"memory");
  #undef CBIAS
  #undef CBLD
  #undef DMA_K
  #undef DMA_V
  #undef CMASK
  #undef START
  #undef RESC
  #undef ROT
}
constexpr int ATTN_LDS_BYTES=LDS_BYTES;
struct AttnTensors { const bf16* Q; const bf16* K; const bf16* V; bf16* O; const float* CF; const float* stat; };
struct AttnUnit { int bh; int qb; };
struct StaticOrder {
  int vcu;
  __device__ __forceinline__ explicit StaticOrder(int grid,int block):vcu((grid%8==0)?(block%8)*(grid/8)+block/8:block),G_(grid){}
  int G_;
  __device__ __forceinline__ bool next(int i,AttnUnit&u)const{ const int v=vcu+(i>>1)*G_; if(v>=256)return false; const int s=v&15; u.bh=v>>4; u.qb=(i&1)?31-s:s; return true; }
  __device__ __forceinline__ void a_ready(const AttnUnit&)const{}
  __device__ __forceinline__ void done(const AttnUnit&)const{}
};
struct QueueOrder {
  unsigned* ctr; __attribute__((address_space(3))) unsigned* slot;
  __device__ __forceinline__ bool next(int,AttnUnit&u)const{
    if(threadIdx.x==0)*slot=__hip_atomic_fetch_add(ctr,1u,__ATOMIC_RELAXED,__HIP_MEMORY_SCOPE_AGENT);
    asm volatile("s_waitcnt vmcnt(0) lgkmcnt(0)\n\ts_barrier":::"memory");
    const unsigned v=*(volatile __attribute__((address_space(3))) unsigned*)slot; const int vv=__builtin_amdgcn_readfirstlane((int)v);
    if(vv>=512)return false; u.qb=31-(vv>>4); u.bh=vv&15; return true; }
  __device__ __forceinline__ void a_ready(const AttnUnit&)const{}
  __device__ __forceinline__ void done(const AttnUnit&)const{}
};
template<class Sched,int THRL=8> __device__ __forceinline__ void attn_phase(char*lds,const AttnTensors&T,const Sched&S){
  AttnUnit u;
  for(int i=0;S.next(i,u);++i){ S.a_ready(u); const float Tsk=40.f+2.f*__builtin_sqrtf(T.stat[u.bh*2]*T.stat[u.bh*2+1])*1.01f+1.f;
    attn_unit<THRL>(u.bh/NHEAD,u.bh%NHEAD,u.qb,T.Q,T.K,T.V,T.O,T.CF+(long)u.bh*SEQ,Tsk,0,nullptr,nullptr,lds); S.done(u); }
}
#undef SBAR
#undef WAIT_BAR
}
#define GAS __attribute__((address_space(1)))
#define LAS __attribute__((address_space(3)))
typedef unsigned v4u __attribute__((ext_vector_type(4)));
typedef float f32x4 __attribute__((ext_vector_type(4)));
typedef short bf16x8 __attribute__((ext_vector_type(8)));
typedef GAS unsigned gu32;
typedef GAS unsigned long long gu64;
#define RLX_AGENT __ATOMIC_RELAXED, __HIP_MEMORY_SCOPE_AGENT
#define LDS_WAIT() asm volatile("s_waitcnt lgkmcnt(0)" ::: "memory")
#define VM_WAIT() asm volatile("s_waitcnt vmcnt(0)" ::: "memory")
__device__ __forceinline__ unsigned long long rt() { return __builtin_amdgcn_s_memrealtime(); }
__device__ __forceinline__ unsigned pk2(float lo, float hi) { return (unsigned)f2bf(lo) | ((unsigned)f2bf(hi) << 16); }

#define XB_TMO      128
#define XB_XCNT(j)  (256  + 64 * (j))
#define XB_XSUB(j)  (1280 + 64 * (j))
#define XB_XGEN(j)  (2304 + 64 * (j))
#define XB_TOP      3328
#define XB_TOPGEN   3392
#define XCD_BAR_WORDS 3456
#define XB_SPIN_CAP (1u << 18)

__device__ __forceinline__ unsigned xb_ld(unsigned* p)              { return __hip_atomic_load(p, __ATOMIC_RELAXED, __HIP_MEMORY_SCOPE_AGENT); }
__device__ __forceinline__ unsigned xb_add(unsigned* p, unsigned v) { return __hip_atomic_fetch_add(p, v, __ATOMIC_RELAXED, __HIP_MEMORY_SCOPE_AGENT); }
__device__ __forceinline__ unsigned xb_xcc_id() { return (unsigned)__builtin_amdgcn_s_getreg((3 << 11) | 20) & 0xFu; }
#define XB_SPIN(cond, bar) do { unsigned _sp = 0; while (cond) { __builtin_amdgcn_s_sleep(1); \
    if ((++_sp & 255u) == 0u) { if (xb_ld(&(bar)[XB_TMO])) break; if (_sp > XB_SPIN_CAP) { atomicAdd(&(bar)[XB_TMO], 1u); break; } } } } while (0)

struct XcdBarrier {
    unsigned* bar; unsigned x;
    volatile LAS unsigned* st;
};

__device__ __forceinline__ XcdBarrier xcd_barrier_post(unsigned* bar, volatile LAS unsigned* st) {
    XcdBarrier b; b.bar = bar; b.x = xb_xcc_id(); b.st = st;
    if (threadIdx.x == 0) (void)xb_add(&bar[XB_XCNT(b.x)], 1u);
    return b;
}
__device__ __forceinline__ void xcd_barrier_complete(unsigned* bar, unsigned x, unsigned& nloc, unsigned& nx) {
    const unsigned G = gridDim.x * gridDim.y * gridDim.z;
    unsigned sum, cnt, mine, sp = 0u;
    for (;;) {
        sum = 0u; cnt = 0u; mine = 0u;
#pragma unroll
        for (unsigned j = 0; j < 16; ++j) { const unsigned c = xb_ld(&bar[XB_XCNT(j)]); sum += c; cnt += (c > 0u) ? 1u : 0u; mine = (j == x) ? c : mine; }
        if (sum == G) break;
        __builtin_amdgcn_s_sleep(1);
        if ((++sp & 255u) == 0u) { if (xb_ld(&bar[XB_TMO])) break; if (sp > XB_SPIN_CAP) { atomicAdd(&bar[XB_TMO], 1u); break; } }
    }
    nloc = mine > 0u ? mine : 1u; nx = cnt > 0u ? cnt : 1u;
}

__device__ __forceinline__ void xcd_barrier(const XcdBarrier& b) {
    asm volatile("s_waitcnt vmcnt(0)" ::: "memory");
    __syncthreads();
    if (threadIdx.x == 0) {
        unsigned* bar = b.bar;
        __builtin_amdgcn_s_waitcnt(0);
        unsigned nloc = b.st[0], nx = b.st[1];
        if (nloc == 0u) { xcd_barrier_complete(bar, b.x, nloc, nx); b.st[0] = nloc; b.st[1] = nx; }
        const unsigned old = xb_add(&bar[XB_XSUB(b.x)], 1u);
        const unsigned gen = old / nloc;
        if (old + 1u == (gen + 1u) * nloc) {
            __builtin_amdgcn_fence(__ATOMIC_RELEASE, "agent");
            asm volatile("s_waitcnt vmcnt(0)" ::: "memory");
            const unsigned og = xb_add(&bar[XB_TOP], 1u);
            const unsigned tg = og / nx;
            if (og + 1u == (tg + 1u) * nx) xb_add(&bar[XB_TOPGEN], 1u);
            else XB_SPIN(xb_ld(&bar[XB_TOPGEN]) == tg, bar);
            __builtin_amdgcn_fence(__ATOMIC_ACQUIRE, "agent");
            xb_add(&bar[XB_XGEN(b.x)], 1u);
            asm volatile("s_waitcnt vmcnt(0)" ::: "memory");
        } else {
            XB_SPIN(xb_ld(&bar[XB_XGEN(b.x)]) == gen, bar);
            __builtin_amdgcn_fence(__ATOMIC_ACQUIRE, "agent");
            asm volatile("s_waitcnt vmcnt(0)" ::: "memory");
        }
    }
    __syncthreads();
}
constexpr int NWAVES = 8, NTHR = 512;
constexpr int RING_OFF = 0, RING_BYTES = 131072, LDSCTL_OFF = RING_BYTES, MISC_OFF = LDSCTL_OFF + 320, LDS_BYTES = 147456;
constexpr int CW_BAR = 4096;
constexpr size_t WS_WIN = WS_W  , WS_SWIN = WS_W + 8 * MiB  , WS_WOUT = WS_W + 14 * MiB  , WS_WDGU = WS_W + 18 * MiB  , WS_SWDGU = WS_W + 24 * MiB  , WS_WDDN = WS_W + 29 * MiB  ;
constexpr size_t WS_SH = WS_H + 16 * MiB  , WS_SXG = WS_XG + 34 * MiB  ;
constexpr size_t WS_WMGU = WS_W  , WS_SWMGU = WS_W + 60 * MiB  , WS_WMDN = WS_W + 64 * MiB  ;
static_assert(WS_WMDN + 56 * MiB <= 469 * MiB, "ws");
struct MArgs { const float* in[20]; float* out; unsigned char* ws; int ph_lo, ph_hi; };
enum { I_X = 0, I_ATTN_NORM, I_W_IN, I_HGRN_LB, I_HGRN_NORM, I_MLSTM_CONV, I_MLSTM_BI, I_MLSTM_BF, I_MLSTM_NORM, I_FOX_BF, I_W_OUT, I_FFN_NORM, I_DGATE, I_DUP, I_DDOWN, I_ROUTER, I_MGATE, I_MUP, I_MDOWN, I_FINAL_NORM };

__device__ __forceinline__ void tr_item(const float* W, int ldw, int K, bf16_t* WT, LAS float* scr, int k0, int lane) {
#pragma unroll 8
    for (int i = 0; i < 32; ++i) { const int kk = 2 * i + (lane >> 5); scr[kk * 33 + (lane & 31)] = W[(size_t)(k0 + kk) * ldw + (lane & 31)]; }
    LDS_WAIT(); asm volatile("" ::: "memory");
    const int c = lane & 7;
#pragma unroll
    for (int j = 0; j < 4; ++j) { const int n = (lane >> 3) + 8 * j; const LAS float* s = scr + (8 * c) * 33 + n;
        v4u o; o.x = pk2(s[0 * 33], s[1 * 33]); o.y = pk2(s[2 * 33], s[3 * 33]); o.z = pk2(s[4 * 33], s[5 * 33]); o.w = pk2(s[6 * 33], s[7 * 33]);
        *(GAS v4u*)(WT + (size_t)n * K + k0 + 8 * c) = o; }
    LDS_WAIT(); asm volatile("" ::: "memory");
}
__device__ __forceinline__ int glu_row(int c, int up) { return (c >> 7) * 256 + (c & 127) + up * 128; }

template <int MODE> __device__ __forceinline__ void mrow(const float* src, float* X, signed char* H8, float* SH, const float* gain, const LAS float* tab, float* G, int row, int lane, float (&lg)[8]) {
    const float4* xr = (const float4*)(src + (size_t)row * D) + lane;
    float4 v[4]; float ss = 0.f;
#pragma unroll
    for (int j = 0; j < 4; ++j) { v[j] = xr[64 * j]; ss += v[j].x * v[j].x + v[j].y * v[j].y + v[j].z * v[j].z + v[j].w * v[j].w; }
    ss = wave_sum(ss);
    const float r = rsqrtf(ss * (1.f / D) + EPS);
    if (X != src) { float4* xo = (float4*)(X + (size_t)row * D) + lane;
#pragma unroll
        for (int j = 0; j < 4; ++j) xo[64 * j] = v[j]; }
    float h[16];
#pragma unroll
    for (int j = 0; j < 4; ++j) { const float4 g = *((const float4*)gain + 64 * j + lane);
        h[4 * j + 0] = v[j].x * r * g.x; h[4 * j + 1] = v[j].y * r * g.y; h[4 * j + 2] = v[j].z * r * g.z; h[4 * j + 3] = v[j].w * r * g.w; }
    { float am = 0.f;
#pragma unroll
      for (int i = 0; i < 16; ++i) am = fmaxf(am, fabsf(h[i]));
#pragma unroll
      for (int o = 1; o < 64; o <<= 1) am = fmaxf(am, __shfl_xor(am, o));
      const float inv = am > 0.f ? 127.f / am : 0.f;
#pragma unroll
      for (int j = 0; j < 4; ++j) { const int q0 = (int)rintf(h[4 * j] * inv), q1 = (int)rintf(h[4 * j + 1] * inv), q2 = (int)rintf(h[4 * j + 2] * inv), q3 = (int)rintf(h[4 * j + 3] * inv);
          *((unsigned*)(H8 + (size_t)row * D) + 64 * j + lane) = (unsigned)(q0 & 255) | ((unsigned)(q1 & 255) << 8) | ((unsigned)(q2 & 255) << 16) | ((unsigned)(q3 & 255) << 24); }
      if (lane == 0) SH[row] = am > 0.f ? am * (1.f / 127.f) : 1.f; }
    if (MODE == 0) {
        float mine = 0.f;
#pragma unroll 2
        for (int c = 0; c < 16; ++c) { float s = 0.f;
#pragma unroll
            for (int j = 0; j < 4; ++j) { const f32x4 w = *(const LAS f32x4*)(tab + c * 1024 + 256 * j + 4 * lane); s += h[4 * j] * w[0] + h[4 * j + 1] * w[1] + h[4 * j + 2] * w[2] + h[4 * j + 3] * w[3]; }
            s = wave_sum(s); if (lane == c) mine = s; }
        if (lane < 16) G[(size_t)row * GW + lane] = mine;
    }
    if (MODE == 2) {
        float v0 = -INFINITY, v1 = -INFINITY; int e0 = 0, e1 = 0;
#pragma unroll 2
        for (int c = 0; c < 8; ++c) { float s = 0.f;
#pragma unroll
            for (int j = 0; j < 4; ++j) { const f32x4 w = *(const LAS f32x4*)(tab + c * 1024 + 256 * j + 4 * lane); s += h[4 * j] * w[0] + h[4 * j + 1] * w[1] + h[4 * j + 2] * w[2] + h[4 * j + 3] * w[3]; }
            s = wave_sum(s);
            if (s > v0) { v1 = v0; e1 = e0; v0 = s; e0 = c; } else if (s > v1) { v1 = s; e1 = c; } }
        lg[0] = v0; lg[1] = v1; lg[2] = __int_as_float(e0); lg[3] = __int_as_float(e1);
    }
}
__device__ __forceinline__ void load_gate_tab(LAS float* tab, const float* w_in, int tid) {
    for (int k = tid; k < D; k += NTHR) { const float4* w0 = (const float4*)(w_in + (size_t)k * DIN + 1792); const float4* w1 = (const float4*)(w_in + (size_t)k * DIN + 3592);
        const float4 a0 = w0[0], a1 = w0[1], b0 = w1[0], b1 = w1[1];
        tab[0 * 1024 + k] = a0.x; tab[1 * 1024 + k] = a0.y; tab[2 * 1024 + k] = a0.z; tab[3 * 1024 + k] = a0.w; tab[4 * 1024 + k] = a1.x; tab[5 * 1024 + k] = a1.y; tab[6 * 1024 + k] = a1.z; tab[7 * 1024 + k] = a1.w;
        tab[8 * 1024 + k] = b0.x; tab[9 * 1024 + k] = b0.y; tab[10 * 1024 + k] = b0.z; tab[11 * 1024 + k] = b0.w; tab[12 * 1024 + k] = b1.x; tab[13 * 1024 + k] = b1.y; tab[14 * 1024 + k] = b1.z; tab[15 * 1024 + k] = b1.w; }
}
__device__ __forceinline__ void load_router_tab(LAS float* tab, const float* router, int tid) {
    for (int k = tid; k < D; k += NTHR) { const float4* w0 = (const float4*)(router + (size_t)k * NE); const float4 a0 = w0[0], a1 = w0[1];
        tab[0 * 1024 + k] = a0.x; tab[1 * 1024 + k] = a0.y; tab[2 * 1024 + k] = a0.z; tab[3 * 1024 + k] = a0.w; tab[4 * 1024 + k] = a1.x; tab[5 * 1024 + k] = a1.y; tab[6 * 1024 + k] = a1.z; tab[7 * 1024 + k] = a1.w; }
}
__device__ __forceinline__ void conv8_block(const float* W, int ldw, signed char* WT8, float* S, LAS float* img, LAS float* pm, int tid, int wave) {
    const int lane = tid & 63, n = lane & 31, kp = lane >> 5;
    float m = 0.f;
#pragma unroll 8
    for (int i = 0; i < 64; ++i) { const int k = 128 * wave + 2 * i + kp; const float v = W[(size_t)k * ldw + n]; img[k * 32 + n] = v; m = fmaxf(m, fabsf(v)); }
    m = fmaxf(m, __shfl_xor(m, 32));
    if (lane < 32) pm[wave * 32 + lane] = m;
    __syncthreads();
    const int no = lane >> 1, kh = 128 * wave + 64 * (lane & 1);
    float cm = 0.f;
#pragma unroll
    for (int w = 0; w < 8; ++w) cm = fmaxf(cm, pm[w * 32 + no]);
    const float inv = cm > 0.f ? 127.f / cm : 0.f;
    if (wave == 0 && (lane & 1) == 0) S[no] = cm > 0.f ? cm * (1.f / 127.f) : 1.f;
    const LAS float* sp = img + kh * 32 + no;
#pragma unroll
    for (int q = 0; q < 4; ++q) { unsigned wq[4];
#pragma unroll
        for (int j = 0; j < 4; ++j) { const int kk = 16 * q + 4 * j; const int q0 = (int)rintf(sp[kk * 32] * inv), q1 = (int)rintf(sp[(kk + 1) * 32] * inv), q2 = (int)rintf(sp[(kk + 2) * 32] * inv), q3 = (int)rintf(sp[(kk + 3) * 32] * inv);
            wq[j] = (unsigned)(q0 & 255) | ((unsigned)(q1 & 255) << 8) | ((unsigned)(q2 & 255) << 16) | ((unsigned)(q3 & 255) << 24); }
        v4u o; o.x = wq[0]; o.y = wq[1]; o.z = wq[2]; o.w = wq[3];
        *(GAS v4u*)(WT8 + (size_t)no * 1024 + kh + 16 * q) = o; }
    __syncthreads();
}
namespace scan {
typedef short bf16x8 __attribute__((ext_vector_type(8)));
typedef float f32x4 __attribute__((ext_vector_type(4)));
typedef unsigned v2u __attribute__((ext_vector_type(2)));
constexpr int TS = 144, TB = 64 * TS;
constexpr int L_T0 = 0, L_T1 = TB, L_T2 = 2 * TB, L_T3 = 3 * TB, L_T4 = 4 * TB, L_T5 = 5 * TB, L_O = 6 * TB, OS = 68  , L_PART = L_O + 64 * OS * 4, L_VEC = L_PART + 8 * 64 * 4, L_END = L_VEC + 8 * 64 * 4;
static_assert(L_END <= RING_BYTES, "scan LDS");
constexpr size_t SC_LHG = 0, SC_LML = 16 * MiB, SC_DEC = 32 * MiB  , SC_NL = 32 * MiB + 256 * 1024  , SC_AMAX = 32 * MiB + 512 * 1024, SC_BEND = SC_AMAX + 4096, SC_MPREV = SC_BEND + 4096;

__device__ __forceinline__ float wave_incl_add(float v, int lane) {
#pragma unroll
    for (int o = 1; o < 64; o <<= 1) { const float u = __shfl_up(v, o); if (lane >= o) v += u; }
    return v;
}
__device__ __forceinline__ float wave_incl_max(float v, int lane) {
#pragma unroll
    for (int o = 1; o < 64; o <<= 1) { const float u = __shfl_up(v, o); if (lane >= o) v = fmaxf(v, u); }
    return v;
}
__device__ __forceinline__ float wave_max(float v) {
#pragma unroll
    for (int o = 1; o < 64; o <<= 1) v = fmaxf(v, __shfl_xor(v, o));
    return v;
}
__device__ __forceinline__ f32x4 mma64(LAS const unsigned char* A, LAS const unsigned char* B, int m0, int n0, int lane, f32x4 acc) {
    const int r = lane & 15, kq = lane >> 4;
#pragma unroll
    for (int ks = 0; ks < 2; ++ks) {
        const bf16x8 a = *(LAS const bf16x8*)(A + (m0 + r) * TS + kq * 16 + ks * 64);
        const bf16x8 b = *(LAS const bf16x8*)(B + (n0 + r) * TS + kq * 16 + ks * 64);
        acc = __builtin_amdgcn_mfma_f32_16x16x32_bf16(a, b, acc, 0, 0, 0);
    }
    return acc;
}
__device__ __forceinline__ v4u pack8(const float (&v)[8]) { v4u w; w.x = pk2(v[0], v[1]); w.y = pk2(v[2], v[3]); w.z = pk2(v[4], v[5]); w.w = pk2(v[6], v[7]); return w; }
__device__ __forceinline__ v4u pack8h(const bf16_t (&v)[8]) { v4u w; w.x = v[0] | ((unsigned)v[1] << 16); w.y = v[2] | ((unsigned)v[3] << 16); w.z = v[4] | ((unsigned)v[5] << 16); w.w = v[6] | ((unsigned)v[7] << 16); return w; }
__device__ __forceinline__ void st16(LAS unsigned char* p, float v) { *(LAS bf16_t*)p = f2bf(v); }
__device__ __forceinline__ void load_state_tile(LAS unsigned char* T, const float* S, int tid) {
    const int v = tid >> 3, d0 = (tid & 7) * 8; const float4 x0 = *(const float4*)(S + v * 64 + d0), x1 = *(const float4*)(S + v * 64 + d0 + 4);
    v4u w; w.x = pk2(x0.x, x0.y); w.y = pk2(x0.z, x0.w); w.z = pk2(x1.x, x1.y); w.w = pk2(x1.z, x1.w);
    *(LAS v4u*)(T + v * TS + d0 * 2) = w;
}
__device__ __forceinline__ void local_state_mma_store(LAS unsigned char* L, float* LT, int wave, int lane) {
    const int mt = wave >> 1;
#pragma unroll
    for (int nn = 0; nn < 2; ++nn) { const int nt = 2 * (wave & 1) + nn; f32x4 acc = {0.f, 0.f, 0.f, 0.f};
        acc = mma64(L + L_T1, L + L_T0, mt * 16, nt * 16, lane, acc);
#pragma unroll
        for (int r = 0; r < 4; ++r) LT[(mt * 16 + 4 * (lane >> 4) + r) * 64 + nt * 16 + (lane & 15)] = acc[r]; }
}

struct HgIn { bf16_t fz[8], q[8], iv[8]; v4u gate; float4 s0, s1; };
template <bool DPH> __device__ __forceinline__ void hgrn_load(HgIn& R, const bf16_t* P, int b, int c, int h, const float* ST, int tid, int wave) {
    const int d = tid & 63, tq = wave, row0 = b * SEQ + c * 64; const bf16_t* pr = P + (size_t)(row0 + 8 * tq) * PW + h * 64 + d;
#pragma unroll
    for (int i = 0; i < 8; ++i) { R.fz[i] = pr[(size_t)i * PW + P_HF]; R.iv[i] = pr[(size_t)i * PW + P_HI]; if (DPH) R.q[i] = pr[(size_t)i * PW + P_HQ]; }
    if (DPH) { const int t = tid >> 3, v0 = (tid & 7) * 8; R.gate = *(const v4u*)(P + (size_t)(row0 + t) * PW + P_HG + h * 64 + v0);
        R.s0 = *(const float4*)(ST + t * 64 + v0); R.s1 = *(const float4*)(ST + t * 64 + v0 + 4); }
}
struct MlIn { bf16_t qr[11], kr[11], vv[8]; float ig, fg, np, mprev; v4u gate; float4 s0, s1; };
template <bool DPH> __device__ __forceinline__ void mlstm_load(MlIn& R, const bf16_t* P, const float* G, int b, int c, int h, const float* CT, const float* NP, const float* MP, int tid, int wave) {
    const int d = tid & 63, tq = wave, lane = tid & 63, row0 = b * SEQ + c * 64; const bool fz3 = (c == 0 && tq == 0);
    const bf16_t* pk = P + (size_t)(row0 + 8 * tq) * PW + P_MK + h * 64 + d; const bf16_t* pq = P + (size_t)(row0 + 8 * tq) * PW + P_MQ + h * 64 + d;
#pragma unroll
    for (int j = 0; j < 11; ++j) { R.kr[j] = (j < 3 && fz3) ? (bf16_t)0 : pk[((long)j - 3) * PW]; if (DPH) R.qr[j] = (j < 3 && fz3) ? (bf16_t)0 : pq[((long)j - 3) * PW]; }
#pragma unroll
    for (int i = 0; i < 8; ++i) R.vv[i] = P[(size_t)(row0 + 8 * tq + i) * PW + P_MV + h * 64 + d];
    R.ig = G[(size_t)(row0 + lane) * GW + h]; R.fg = G[(size_t)(row0 + lane) * GW + 4 + h];
    if (DPH) { const int t = tid >> 3, v0 = (tid & 7) * 8; R.gate = *(const v4u*)(P + (size_t)(row0 + t) * PW + P_MO + h * 64 + v0);
        R.s0 = *(const float4*)(CT + t * 64 + v0); R.s1 = *(const float4*)(CT + t * 64 + v0 + 4); R.np = NP[lane]; R.mprev = MP[0]; }
}
__device__ __forceinline__ void store_state_tile(LAS unsigned char* T, const float4& x0, const float4& x1, int tid) {
    const int v = tid >> 3, d0 = (tid & 7) * 8; v4u w; w.x = pk2(x0.x, x0.y); w.y = pk2(x0.z, x0.w); w.z = pk2(x1.x, x1.y); w.w = pk2(x1.z, x1.w);
    *(LAS v4u*)(T + v * TS + d0 * 2) = w;
}
__device__ __forceinline__ void conv_silu8r(const bf16_t (&raw)[11], const float* w4  , float scale, float (&out)[8]) {
    const float w0 = w4[0], w1 = w4[512], w2 = w4[1024], w3 = w4[1536];
#pragma unroll
    for (int i = 0; i < 8; ++i) out[i] = siluf_(w0 * bf2f(raw[i]) + w1 * bf2f(raw[i + 1]) + w2 * bf2f(raw[i + 2]) + w3 * bf2f(raw[i + 3])) * scale;
}
__device__ __forceinline__ void hgrn_b_item(LAS unsigned char* L, const HgIn& R, float lb, float* LT, float* DEC, int tid, int wave) {
    const int d = tid & 63, tq = wave;
    float bl[8], kh[8]; float run = 0.f;
#pragma unroll
    for (int i = 0; i < 8; ++i) { const float fz = bf2f(R.fz[i]);
        const float sg = sigmoidf_(fz), f = lb + (1.f - lb) * sg; kh[i] = (1.f - lb) * (1.f - sg); run += __logf(f); bl[i] = run; }
    LAS float* part = (LAS float*)(L + L_PART);
    part[tq * 64 + d] = run; __syncthreads();
    float off = 0.f, btot = 0.f;
#pragma unroll
    for (int w = 0; w < 8; ++w) { const float pv = part[w * 64 + d]; btot += pv; if (w < tq) off += pv; }
#pragma unroll
    for (int i = 0; i < 8; ++i) kh[i] *= __expf(btot - (off + bl[i]));
    *(LAS v4u*)(L + L_T0 + d * TS + tq * 16) = pack8(kh);
    *(LAS v4u*)(L + L_T1 + d * TS + tq * 16) = pack8h(R.iv);
    if (tq == 0) DEC[d] = __expf(btot);
    __syncthreads();
    local_state_mma_store(L, LT, wave, tid & 63);
    __syncthreads();
}
__device__ __forceinline__ void mlstm_gates(float ig, float fg, const float* b_i, const float* b_f, int h, int lane, float& bcum, float& a) {
    bcum = wave_incl_add(log_sigmoidf_(fg + b_f[h]), lane); a = ig + b_i[h] - bcum;
}
__device__ __forceinline__ void mlstm_b_item(LAS unsigned char* L, const MlIn& R, const float* conv, const float* b_i, const float* b_f, int h, float* LT, float* NL, float* AMAX, float* BEND, int tid, int wave) {
    const int d = tid & 63, tq = wave, lane = tid & 63;
    float bcum, a; mlstm_gates(R.ig, R.fg, b_i, b_f, h, lane, bcum, a);
    const float A = wave_max(a), bend = __shfl(bcum, 63);
    float kh[8]; conv_silu8r(R.kr, conv + 256 + h * 64 + d, 0.125f, kh);
    float nsum = 0.f;
#pragma unroll
    for (int i = 0; i < 8; ++i) { kh[i] *= __expf(__shfl(a, 8 * tq + i) - A); nsum += bf2f(f2bf(kh[i])); }
    *(LAS v4u*)(L + L_T0 + d * TS + tq * 16) = pack8(kh);
    *(LAS v4u*)(L + L_T1 + d * TS + tq * 16) = pack8h(R.vv);
    LAS float* part = (LAS float*)(L + L_PART); part[tq * 64 + d] = nsum;
    __syncthreads();
    if (tq == 0) { float s = 0.f;
#pragma unroll
        for (int w = 0; w < 8; ++w) s += part[w * 64 + d];
        NL[d] = s; if (lane == 0) { AMAX[0] = A; BEND[0] = bend; } }
    local_state_mma_store(L, LT, wave, lane);
    __syncthreads();
}
__device__ __forceinline__ void fox_cumsum_item(LAS unsigned char* L, const float* G, const float* fox_bf, float* CF, int bh, int tid, int wave) {
    const int b = bh >> 3, h = bh & 7, lane = tid & 63; const float bf = fox_bf[h];
    float loc[16]; float s = 0.f;
#pragma unroll
    for (int i = 0; i < 16; ++i) { s += log_sigmoidf_(G[((size_t)b * SEQ + tid * 16 + i) * GW + 8 + h] + bf); loc[i] = s; }
    const float incl = wave_incl_add(s, lane);
    LAS float* wt = (LAS float*)(L + L_PART);
    if (lane == 63) wt[wave] = incl;
    __syncthreads();
    float off = incl - s;
#pragma unroll
    for (int w = 0; w < 8; ++w) if (w < wave) off += wt[w];
#pragma unroll
    for (int i = 0; i < 16; ++i) CF[(size_t)bh * SEQ + tid * 16 + i] = (off + loc[i]) * LOG2E;
    __syncthreads();
}

__device__ __forceinline__ void scan_c_block(unsigned char* sc, int j, int tid) {
    if (j < 128) {
        if (tid < 256) { const int chain = j >> 4, e = (j & 15) * 256 + tid, b = chain >> 2, h = chain & 3;
            float* p = (float*)(sc + SC_LHG) + ((size_t)(b * 128) * 4 + h) * 4096 + e; const float* dp = (const float*)(sc + SC_DEC) + ((size_t)(b * 128) * 4 + h) * 64 + (e & 63);
            float S = 0.f;
#pragma unroll 8
            for (int c = 0; c < 128; ++c) { const float Lc = p[(size_t)c * 4 * 4096], dec = dp[(size_t)c * 4 * 64]; p[(size_t)c * 4 * 4096] = S; S = dec * S + Lc; } }
    } else {
        const int jj = j - 128, chain = jj >> 4, part = jj & 15, b = chain >> 2, h = chain & 3;
        if (tid < 260) { const bool isn = tid >= 256; const size_t it0 = (size_t)(b * 128) * 4 + h;
            float* p = isn ? (float*)(sc + SC_NL) + it0 * 64 + part * 4 + (tid - 256) : (float*)(sc + SC_LML) + it0 * 4096 + part * 256 + tid;
            const size_t stride = isn ? 4 * 64 : 4 * 4096;
            const float* am = (const float*)(sc + SC_AMAX) + it0; const float* be = (const float*)(sc + SC_BEND) + it0; float* mp = (float*)(sc + SC_MPREV) + it0;
            const bool writer = (part == 0 && tid == 0);
            float S = 0.f, m = 0.f;
#pragma unroll 8
            for (int c = 0; c < 128; ++c) { const float A = am[c * 4], bb = be[c * 4], Lc = p[c * stride]; const float Mx = fmaxf(m, A);
                p[c * stride] = S; S = __expf(m - Mx) * S + __expf(A - Mx) * Lc; if (writer) mp[c * 4] = m; m = bb + Mx; } }
    }
}

template <bool SIG> __device__ __forceinline__ void head_epilogue(LAS unsigned char* L, float inv, const v4u& gw  , const float* gain  , bf16_t* out  , int tid) {
    const int t = tid >> 3, v0 = (tid & 7) * 8; const LAS float* o = (const LAS float*)(L + L_O) + t * OS + v0;
    float x[8]; float ss = 0.f;
#pragma unroll
    for (int i = 0; i < 8; ++i) { x[i] = o[i] * inv; ss += x[i] * x[i]; }
    ss += __shfl_xor(ss, 1); ss += __shfl_xor(ss, 2); ss += __shfl_xor(ss, 4);
    const float r = rsqrtf(ss * (1.f / 64.f) + EPS);
    const unsigned gu[4] = {gw.x, gw.y, gw.z, gw.w};
    float y[8];
#pragma unroll
    for (int i = 0; i < 8; ++i) { const float gz = bf2f((bf16_t)((gu[i >> 1] >> (16 * (i & 1))) & 0xffff)); y[i] = x[i] * r * gain[i] * (SIG ? sigmoidf_(gz) : siluf_(gz)); }
    *(v4u*)out = pack8(y);
}
__device__ __forceinline__ void store_o_tiles(LAS unsigned char* L, LAS const unsigned char* A1, LAS const unsigned char* B1, LAS const unsigned char* A2, LAS const unsigned char* B2, int wave, int lane) {
    const int mt = wave >> 1;
#pragma unroll
    for (int nn = 0; nn < 2; ++nn) { const int nt = 2 * (wave & 1) + nn; f32x4 acc = {0.f, 0.f, 0.f, 0.f};
        acc = mma64(A1, B1, mt * 16, nt * 16, lane, acc); acc = mma64(A2, B2, mt * 16, nt * 16, lane, acc);
        LAS float* o = (LAS float*)(L + L_O);
#pragma unroll
        for (int r = 0; r < 4; ++r) o[(mt * 16 + 4 * (lane >> 4) + r) * OS + nt * 16 + (lane & 15)] = acc[r]; }
}
__device__ __forceinline__ void hgrn_d_item(LAS unsigned char* L, const HgIn& R, float lb, const float* gain  , bf16_t* out  , int tid, int wave) {
    const int d = tid & 63, tq = wave, lane = tid & 63;
    float bl[8], kk[8], q[8]; float run = 0.f;
#pragma unroll
    for (int i = 0; i < 8; ++i) { const float fz = bf2f(R.fz[i]); q[i] = bf2f(R.q[i]);
        const float sg = sigmoidf_(fz), f = lb + (1.f - lb) * sg; kk[i] = (1.f - lb) * (1.f - sg); run += __logf(f); bl[i] = run; }
    LAS float* part = (LAS float*)(L + L_PART);
    part[tq * 64 + d] = run;
    store_state_tile(L + L_T4, R.s0, R.s1, tid);
    *(LAS v4u*)(L + L_T3 + d * TS + tq * 16) = pack8h(R.iv);
    __syncthreads();
    float off = 0.f, bref = 0.f;
#pragma unroll
    for (int w = 0; w < 8; ++w) { const float pv = part[w * 64 + d]; if (w < 4) bref += pv; if (w < tq) off += pv; }
#pragma unroll
    for (int i = 0; i < 8; ++i) { const float bb = off + bl[i]; const int t = 8 * tq + i;
        st16(L + L_T0 + t * TS + d * 2, q[i] * __expf(bb - bref));
        st16(L + L_T1 + t * TS + d * 2, kk[i] * __expf(bref - bb));
        st16(L + L_T2 + t * TS + d * 2, q[i] * __expf(bb)); }
    __syncthreads();
    { const int mt = wave >> 1;
#pragma unroll
      for (int nn = 0; nn < 2; ++nn) { const int nt = 2 * (wave & 1) + nn; f32x4 acc = {0.f, 0.f, 0.f, 0.f};
          acc = mma64(L + L_T1, L + L_T0, mt * 16, nt * 16, lane, acc);
          const int s0 = mt * 16 + 4 * (lane >> 4), t = nt * 16 + (lane & 15);
          v2u w; w.x = pk2(s0 <= t ? acc[0] : 0.f, s0 + 1 <= t ? acc[1] : 0.f); w.y = pk2(s0 + 2 <= t ? acc[2] : 0.f, s0 + 3 <= t ? acc[3] : 0.f);
          *(LAS v2u*)(L + L_T5 + t * TS + s0 * 2) = w; } }
    __syncthreads();
    store_o_tiles(L, L + L_T5, L + L_T3, L + L_T2, L + L_T4, wave, lane);
    __syncthreads();
    { const int t = tid >> 3, v0 = (tid & 7) * 8; head_epilogue<false>(L, 1.f, R.gate, gain + v0, out + (size_t)t * D + v0, tid); }
    __syncthreads();
}
__device__ __forceinline__ void mlstm_d_item(LAS unsigned char* L, const MlIn& R, const float* conv, const float* b_i, const float* b_f, const float* gain  , int h, bf16_t* out  , int tid, int wave) {
    const int d = tid & 63, tq = wave, lane = tid & 63; const float mprev = R.mprev;
    float bcum, a; mlstm_gates(R.ig, R.fg, b_i, b_f, h, lane, bcum, a);
    const float M = fmaxf(wave_incl_max(a, lane), mprev), sint = __expf(mprev - M);
    LAS float* vec = (LAS float*)(L + L_VEC);
    if (wave == 0) { vec[lane] = a; vec[64 + lane] = M; vec[128 + lane] = __expf(-bcum - M); vec[192 + lane] = R.np; }
    float qc[8], kc[8];
    conv_silu8r(R.qr, conv + h * 64 + d, 1.f, qc);
    conv_silu8r(R.kr, conv + 256 + h * 64 + d, 0.125f, kc);
#pragma unroll
    for (int i = 0; i < 8; ++i) { const int t = 8 * tq + i;
        st16(L + L_T0 + t * TS + d * 2, qc[i]);
        st16(L + L_T1 + t * TS + d * 2, kc[i]);
        st16(L + L_T2 + t * TS + d * 2, qc[i] * __shfl(sint, t)); }
    *(LAS v4u*)(L + L_T3 + d * TS + tq * 16) = pack8h(R.vv);
    store_state_tile(L + L_T4, R.s0, R.s1, tid);
    __syncthreads();
    { const int mt = wave >> 1;
#pragma unroll
      for (int nn = 0; nn < 2; ++nn) { const int nt = 2 * (wave & 1) + nn; f32x4 acc = {0.f, 0.f, 0.f, 0.f};
          acc = mma64(L + L_T1, L + L_T0, mt * 16, nt * 16, lane, acc);
          const int s0 = mt * 16 + 4 * (lane >> 4), t = nt * 16 + (lane & 15); const float Mt = vec[64 + t];
          float wv[4];
#pragma unroll
          for (int r = 0; r < 4; ++r) wv[r] = (s0 + r <= t) ? acc[r] * __expf(vec[s0 + r] - Mt) : 0.f;
          v2u w; w.x = pk2(wv[0], wv[1]); w.y = pk2(wv[2], wv[3]); *(LAS v2u*)(L + L_T5 + t * TS + s0 * 2) = w; } }
    __syncthreads();
    store_o_tiles(L, L + L_T5, L + L_T3, L + L_T2, L + L_T4, wave, lane);
    __syncthreads();
    { const int t = tid >> 3, c8 = (tid & 7) * 8;
      const v4u pw = *(LAS const v4u*)(L + L_T5 + t * TS + c8 * 2), qw = *(LAS const v4u*)(L + L_T2 + t * TS + c8 * 2);
      const unsigned pu[4] = {pw.x, pw.y, pw.z, pw.w}, qu[4] = {qw.x, qw.y, qw.z, qw.w}; float den = 0.f;
#pragma unroll
      for (int i = 0; i < 8; ++i) { den += bf2f((bf16_t)((pu[i >> 1] >> (16 * (i & 1))) & 0xffff)) + bf2f((bf16_t)((qu[i >> 1] >> (16 * (i & 1))) & 0xffff)) * vec[192 + c8 + i]; }
      den += __shfl_xor(den, 1); den += __shfl_xor(den, 2); den += __shfl_xor(den, 4);
      const float inv = 1.f / fmaxf(fabsf(den), vec[128 + t]);
      head_epilogue<true>(L, inv, R.gate, gain + c8, out + (size_t)t * D + c8, tid); }
    __syncthreads();
}
}
constexpr int N_PHASES = 21;
template <int PH, bool REP = false> __device__ __forceinline__ void run_phase(const MArgs& a, LAS unsigned char* L, const int tid, const int wave, const int G, const int bx, const int vcu) {
    const int lane = tid & 63, gw = vcu * NWAVES + wave, NGW = G * NWAVES;
    unsigned char* ws = a.ws; float* X = a.out;
    int* ctl = (int*)(ws + WS_CTL); int* cnt = ctl + CW_CNT;
    float* Gt = (float*)(ws + WS_G); float* CF = (float*)(ws + WS_CF); int4* tokinfo = (int4*)(ws + WS_TOKINFO); float2* tgate = (float2*)(ws + WS_TGATE); int* toklist = (int*)(ws + WS_TOKLIST);
    bf16_t* P = (bf16_t*)(ws + WS_P); bf16_t* HID = (bf16_t*)(ws + WS_HID); signed char* H = (signed char*)(ws + WS_H); float* SH = (float*)(ws + WS_SH); bf16_t* MIX = (bf16_t*)(ws + WS_MIX);
    signed char* XG = (signed char*)(ws + WS_XG); float* SXG = (float*)(ws + WS_SXG); bf16_t* Y = (bf16_t*)(ws + WS_XG);
    LAS float* scr = (LAS float*)(L + RING_OFF + wave * 16384);
    (void)ctl; (void)Gt; (void)CF; (void)tokinfo; (void)tgate; (void)toklist; (void)P; (void)HID; (void)H; (void)SH; (void)SXG; (void)MIX; (void)XG; (void)Y; (void)scr; (void)cnt; (void)lane; (void)gw; (void)NGW;
    constexpr int p = PH, l = p >= 10 ? 1 : 0, k = p == 0 ? -1 : (l ? p - 10 : p - 1);
    if constexpr (p == 0) {
            LAS float* img = (LAS float*)(L + RING_OFF); LAS float* pm = (LAS float*)(L + LDSCTL_OFF + 1024);
            for (int it = vcu; it < 400; it += G) {
                int r = it;
                if (r < 224) { const int ll = r / 112, nb = r % 112, sc = 32 * nb + (nb >= 56 ? 8 : 0);
                    conv8_block(a.in[I_W_IN] + (size_t)ll * D * DIN + sc, DIN, (signed char*)(ws + WS_WIN) + (size_t)ll * PW * D + (size_t)32 * nb * D, (float*)(ws + WS_SWIN) + ll * PW + 32 * nb, img, pm, tid, wave); }
                else { r -= 224; const int up = r / 88, nb = r % 88, c = 32 * nb;
                    conv8_block((up ? a.in[I_DUP] : a.in[I_DGATE]) + c, FF, (signed char*)(ws + WS_WDGU) + (size_t)glu_row(c, up) * D, (float*)(ws + WS_SWDGU) + glu_row(c, up), img, pm, tid, wave); }
            }
            for (int it = gw; it < 2432; it += NGW) {
                int r = it;
                if (r < 1024) { const int ll = r / 512; r %= 512; const int kb = r / 32, nb = r % 32;
                    tr_item(a.in[I_W_OUT] + (size_t)ll * D * D + 32 * nb, D, D, (bf16_t*)(ws + WS_WOUT) + (size_t)ll * D * D + (size_t)32 * nb * D, scr, 64 * kb, lane); continue; }
                r -= 1024;
                { const int kb = r / 32, nb = r % 32; tr_item(a.in[I_DDOWN] + 32 * nb, D, FF, (bf16_t*)(ws + WS_WDDN) + (size_t)32 * nb * FF, scr, 64 * kb, lane); }
            }
            __syncthreads();
            LAS float* tab = (LAS float*)(L + RING_OFF); load_gate_tab(tab, a.in[I_W_IN], tid); __syncthreads();
            float lg[8];
            for (int row = gw; row < NTOK; row += NGW) mrow<0>(a.in[I_X], X, H, SH, a.in[I_ATTN_NORM], tab, Gt, row, lane, lg);
        } else if constexpr (k == 0) {
            pg8::GOrder S; S.so.init(NTOK, PW, G, bx); S.A = (const char*)H; S.B = (const char*)(ws + WS_WIN) + (size_t)l * PW * D; S.a_tile = (size_t)256 * D; S.b_tile = (size_t)256 * D; S.b_exp = 0;
            S.tb1 = S.tb2 = S.tb3 = S.tb4 = S.tb5 = S.tb6 = S.tb7 = 0x7fffffff;
            pg8::EpiBf8 E; E.O = P; E.ldc = PW; E.s_lo = P_FQ / 256; E.s_hi = P_FK / 256; E.scale = QSCALE; E.sA = SH; E.sB = (const float*)(ws + WS_SWIN) + l * PW;
            pg8::Gemm g{D / 2};
            pg8::gemm_phase<pg8::EpiBf8, pg8::GOrder, true, true, true>(L + RING_OFF, g, S, E);
        } else if constexpr (l == 1 && k == 9) {
            pg8::GOrder S; pg8::EpiBf E; int t[8]; int acc = 0;
#pragma unroll
            for (int e = 0; e < NE; ++e) { t[e] = acc; acc += (cnt[e] + 255) >> 8; }
            S.so.init(acc * 256, D, G, bx); S.A = (const char*)HID; S.B = (const char*)(ws + WS_WMDN); S.a_tile = (size_t)256 * FE * 2; S.b_tile = (size_t)256 * FE * 2; S.b_exp = (size_t)D * FE * 2;
            S.tb1 = t[1]; S.tb2 = t[2]; S.tb3 = t[3]; S.tb4 = t[4]; S.tb5 = t[5]; S.tb6 = t[6]; S.tb7 = t[7]; E.O = Y; E.ldc = D; E.s_lo = 0; E.s_hi = 0; E.scale = 1.f;
            pg8::Gemm g{FE};
            pg8::gemm_phase<pg8::EpiBf, pg8::GOrder, true, true>(L + RING_OFF, g, S, E);
        } else if constexpr (k == 4 || (l == 0 && k == 7)) {
            pg8::GOrder S; S.so.init(NTOK, D, G, bx); S.b_exp = 0; S.tb1 = S.tb2 = S.tb3 = S.tb4 = S.tb5 = S.tb6 = S.tb7 = 0x7fffffff; int K;
            if constexpr (k == 4) { K = D; S.A = (const char*)MIX; S.B = (const char*)(ws + WS_WOUT) + (size_t)l * D * D * 2; }
            else { K = FF; S.A = (const char*)HID; S.B = (const char*)(ws + WS_WDDN); }
            S.a_tile = (size_t)256 * K * 2; S.b_tile = (size_t)256 * K * 2;
            pg8::EpiResid E{X, D}; pg8::Gemm g{K};
            pg8::gemm_phase<pg8::EpiResid, pg8::GOrder, true, true>(L + RING_OFF, g, S, E);
        } else if constexpr ((l == 0 && k == 6) || (l == 1 && k == 7)) {
            pg8::GOrder S; pg8::EpiSwiglu8 E; S.a_tile = (size_t)256 * D; S.b_tile = (size_t)256 * D; E.O = HID;
            if constexpr (l == 0) { S.so.init(NTOK, 2 * FF, G, bx); S.A = (const char*)H; S.B = (const char*)(ws + WS_WDGU); S.b_exp = 0; S.tb1 = S.tb2 = S.tb3 = S.tb4 = S.tb5 = S.tb6 = S.tb7 = 0x7fffffff;
                E.ldc = FF; E.sA = SH; E.sB = (const float*)(ws + WS_SWDGU); E.sb_exp = 0; }
            else { int t[8]; int acc = 0;
#pragma unroll
                for (int e = 0; e < NE; ++e) { t[e] = acc; acc += (cnt[e] + 255) >> 8; }
                S.so.init(acc * 256, 2 * FE, G, bx); S.A = (const char*)XG; S.B = (const char*)(ws + WS_WMGU); S.b_exp = (size_t)2 * FE * D;
                S.tb1 = t[1]; S.tb2 = t[2]; S.tb3 = t[3]; S.tb4 = t[4]; S.tb5 = t[5]; S.tb6 = t[6]; S.tb7 = t[7]; E.ldc = FE; E.sA = SXG; E.sB = (const float*)(ws + WS_SWMGU); E.sb_exp = 2 * FE; }
            E.tb1 = S.tb1; E.tb2 = S.tb2; E.tb3 = S.tb3; E.tb4 = S.tb4; E.tb5 = S.tb5; E.tb6 = S.tb6; E.tb7 = S.tb7;
            pg8::Gemm g{D / 2};
            pg8::gemm_phase<pg8::EpiSwiglu8, pg8::GOrder, true, true, true>(L + RING_OFF, g, S, E);
        } else if constexpr (k == 5 && l == 0) {
            float lg[8];
            for (int row = gw; row < NTOK; row += NGW) mrow<1>(X, X, H, SH, a.in[I_FFN_NORM], nullptr, nullptr, row, lane, lg);
        } else if constexpr (k == 8 && l == 0) {
            LAS float* tab = (LAS float*)(L + RING_OFF); load_gate_tab(tab, a.in[I_W_IN] + (size_t)D * DIN, tid); __syncthreads();
            float lg[8];
            for (int row = gw; row < NTOK; row += NGW) mrow<0>(X, X, H, SH, a.in[I_ATTN_NORM] + D, tab, Gt, row, lane, lg);
        } else if constexpr (k == 5 && l == 1) {
            LAS int* sel_e = (LAS int*)(L + RING_OFF);
            LAS float* sel_g = (LAS float*)(L + RING_OFF + 512);
            LAS int* lcnt = (LAS int*)(L + RING_OFF + 1024);
            LAS float* tab = (LAS float*)(L + RING_OFF + 4096); load_router_tab(tab, a.in[I_ROUTER], tid); __syncthreads();
            for (int rb = bx; rb < NTOK / 64; rb += G) {
                if (tid < 16) lcnt[tid] = 0;
                for (int i = 0; i < 8; ++i) { const int rl = wave * 8 + i, row = rb * 64 + rl; float lg[8];
                    mrow<2>(X, X, H, SH, a.in[I_FFN_NORM] + D, tab, nullptr, row, lane, lg);
                    if (lane == 0) { const float v0 = lg[0], v1 = lg[1]; const int e0 = __float_as_int(lg[2]), e1 = __float_as_int(lg[3]);
                        const float g1 = 1.f / (1.f + __expf(v0 - v1));
                        sel_e[2 * rl] = e0; sel_e[2 * rl + 1] = e1; sel_g[2 * rl] = 1.f - g1; sel_g[2 * rl + 1] = g1; } }
                __syncthreads();
                int e0 = 0, e1 = 0, r0 = 0, r1 = 0;
                if (tid < 64) { e0 = sel_e[2 * tid]; e1 = sel_e[2 * tid + 1]; r0 = __hip_atomic_fetch_add(lcnt + e0, 1, __ATOMIC_RELAXED, __HIP_MEMORY_SCOPE_WORKGROUP); r1 = __hip_atomic_fetch_add(lcnt + e1, 1, __ATOMIC_RELAXED, __HIP_MEMORY_SCOPE_WORKGROUP); }
                __syncthreads();
                if (tid < 8) lcnt[8 + tid] = atomicAdd(cnt + tid, (int)lcnt[tid]);
                __syncthreads();
                if (tid < 64) { const int row = rb * 64 + tid, s0 = lcnt[8 + e0] + r0, s1 = lcnt[8 + e1] + r1;
                    toklist[e0 * NTOK + s0] = row; toklist[e1 * NTOK + s1] = row; tokinfo[row] = make_int4(e0, s0, e1, s1); tgate[row] = make_float2(sel_g[2 * tid], sel_g[2 * tid + 1]); }
                __syncthreads();
            }
        } else if constexpr (k == 6 && l == 1) {
            { int base[NE]; int acc = 0;
#pragma unroll
              for (int e = 0; e < NE; ++e) { base[e] = acc; acc += (cnt[e] + 255) & ~255; }
              for (int r = gw; r < acc; r += NGW) { int e = 0, be = 0;
#pragma unroll
                  for (int c = 1; c < NE; ++c) if (r >= base[c]) { e = c; be = base[c]; }
                  const int s = r - be; v4u v0 = {0u, 0u, 0u, 0u}; float sv = 0.f;
                  if (s < cnt[e]) { const int tok = toklist[e * NTOK + s]; v0 = *((const v4u*)(H + (size_t)tok * D) + lane); sv = SH[tok]; }
                  *((v4u*)(XG + (size_t)r * D) + lane) = v0; if (lane == 0) SXG[r] = sv; } }
            __syncthreads();
            { LAS float* img = (LAS float*)(L + RING_OFF); LAS float* pm = (LAS float*)(L + LDSCTL_OFF + 1024);
              for (int it = vcu; it < 1792; it += G) { const int e = it / 224; int r = it % 224; const int up = r / 112, nb = r % 112, c = 32 * nb;
                  conv8_block((up ? a.in[I_MUP] : a.in[I_MGATE]) + (size_t)e * D * FE + c, FE, (signed char*)(ws + WS_WMGU) + (size_t)e * 2 * FE * D + (size_t)glu_row(c, up) * D, (float*)(ws + WS_SWMGU) + e * 2 * FE + glu_row(c, up), img, pm, tid, wave); } }
            for (int it = gw; it < 14336; it += NGW) { const int e = it / 1792, r = it % 1792, kb = r / 32, nb = r % 32;
                tr_item(a.in[I_MDOWN] + (size_t)e * FE * D + 32 * nb, D, FE, (bf16_t*)(ws + WS_WMDN) + (size_t)e * D * FE + (size_t)32 * nb * FE, scr, 64 * kb, lane); }
        } else if constexpr (k == 8 && l == 1) {
        } else if constexpr (k == 10 && l == 1) {
            int base[NE]; { int acc = 0;
#pragma unroll
              for (int e = 0; e < NE; ++e) { base[e] = acc; acc += (cnt[e] + 255) & ~255; } }
            for (int row = gw; row < NTOK; row += NGW) {
                float4* xr = (float4*)(X + (size_t)row * D) + lane; float4 v[4];
#pragma unroll
                for (int j = 0; j < 4; ++j) v[j] = xr[64 * j];
                const int4 ti = tokinfo[row]; const float2 tg = tgate[row]; int b0 = 0, b1 = 0;
#pragma unroll
                for (int c = 0; c < NE; ++c) { if (c == ti.x) b0 = base[c]; if (c == ti.z) b1 = base[c]; }
                const bf16_t* y0 = Y + (size_t)(b0 + ti.y) * D; const bf16_t* y1 = Y + (size_t)(b1 + ti.w) * D;
#pragma unroll
                for (int j = 0; j < 4; ++j) { const uint2 q = *((const uint2*)y0 + 64 * j + lane), c = *((const uint2*)y1 + 64 * j + lane);
                    v[j].x += tg.x * bf2f((bf16_t)(q.x & 0xffff)) + tg.y * bf2f((bf16_t)(c.x & 0xffff)); v[j].y += tg.x * bf2f((bf16_t)(q.x >> 16)) + tg.y * bf2f((bf16_t)(c.x >> 16));
                    v[j].z += tg.x * bf2f((bf16_t)(q.y & 0xffff)) + tg.y * bf2f((bf16_t)(c.y & 0xffff)); v[j].w += tg.x * bf2f((bf16_t)(q.y >> 16)) + tg.y * bf2f((bf16_t)(c.y >> 16)); }
                float ss = 0.f;
#pragma unroll
                for (int j = 0; j < 4; ++j) ss += v[j].x * v[j].x + v[j].y * v[j].y + v[j].z * v[j].z + v[j].w * v[j].w;
                ss = wave_sum(ss); const float r = rsqrtf(ss * (1.f / D) + EPS);
#pragma unroll
                for (int j = 0; j < 4; ++j) { const float4 g = *((const float4*)a.in[I_FINAL_NORM] + 64 * j + lane); xr[64 * j] = make_float4(v[j].x * r * g.x, v[j].y * r * g.y, v[j].z * r * g.z, v[j].w * r * g.w); }
            }
        } else {
            if constexpr (k == 1) {
                unsigned char* sc = ws + WS_SCAN; const int wv = wave;
#define ITEM_DECODE(it_) const int item = (it_) & 1023, h = item & 3, c = (item >> 2) & 127, b = item >> 9
#define HG_LB(h_) (l == 0 ? 0.f : 1.f / (1.f + __expf(a.in[I_HGRN_LB][(h_) * 64 + (tl & 63)] - a.in[I_HGRN_LB][256 + (h_) * 64 + (tl & 63)])))
                { scan::HgIn R, Rn; int it = bx;
                  if (it < 1024) { ITEM_DECODE(it); scan::hgrn_load<false>(R, P, b, c, h, nullptr, tid, wv); }
                  for (; it < 1024; it += G) { const int nx = it + G; int tl = tid; asm volatile("" : "+v"(tl));
                      if (nx < 1024) { ITEM_DECODE(nx); scan::hgrn_load<false>(Rn, P, b, c, h, nullptr, tl, wv); }
                      asm volatile("" ::: "memory");
                      { ITEM_DECODE(it); (void)b; (void)c; scan::hgrn_b_item(L, R, HG_LB(h), (float*)(sc + scan::SC_LHG) + (size_t)item * 4096, (float*)(sc + scan::SC_DEC) + item * 64, tl, wv); }
                      if (nx < 1024) R = Rn; } }
                { scan::MlIn R, Rn; int it = bx; while (it < 1024) it += G;
                  if (it < 2048) { ITEM_DECODE(it); scan::mlstm_load<false>(R, P, Gt, b, c, h, nullptr, nullptr, nullptr, tid, wv); }
                  for (; it < 2048; it += G) { const int nx = it + G; int tl = tid; asm volatile("" : "+v"(tl));
                      if (nx < 2048) { ITEM_DECODE(nx); scan::mlstm_load<false>(Rn, P, Gt, b, c, h, nullptr, nullptr, nullptr, tl, wv); }
                      asm volatile("" ::: "memory");
                      { ITEM_DECODE(it); (void)b; (void)c; scan::mlstm_b_item(L, R, a.in[I_MLSTM_CONV] + l * 2048, a.in[I_MLSTM_BI] + l * 4, a.in[I_MLSTM_BF] + l * 4, h, (float*)(sc + scan::SC_LML) + (size_t)item * 4096,
                                            (float*)(sc + scan::SC_NL) + item * 64, (float*)(sc + scan::SC_AMAX) + item, (float*)(sc + scan::SC_BEND) + item, tl, wv); }
                      if (nx < 2048) R = Rn; } }
                for (int bh = bx; bh < 16; bh += G) scan::fox_cumsum_item(L, Gt, a.in[I_FOX_BF] + l * 8, CF, bh, tid, wv);
                { LAS unsigned* lst = (LAS unsigned*)(L + LDSCTL_OFF + 64);
                  if (tid < 32) lst[tid] = 0u; __syncthreads();
                  float mq0 = 0.f, mq1 = 0.f, mk0 = 0.f, mk1 = 0.f;
                  for (int row = gw; row < NTOK; row += NGW) {
                      const v4u wq = *((const v4u*)(P + (size_t)row * PW + P_FQ) + lane), wk = *((const v4u*)(P + (size_t)row * PW + P_FK) + lane);
                      float sq = 0.f, sk = 0.f;
#pragma unroll
                      for (int i = 0; i < 4; ++i) { const float q0 = bf2f((bf16_t)(wq[i] & 0xffff)), q1 = bf2f((bf16_t)(wq[i] >> 16)), k0 = bf2f((bf16_t)(wk[i] & 0xffff)), k1 = bf2f((bf16_t)(wk[i] >> 16));
                          sq += q0 * q0 + q1 * q1; sk += k0 * k0 + k1 * k1; }
                      sq += __shfl_xor(sq, 1); sq += __shfl_xor(sq, 2); sq += __shfl_xor(sq, 4); sk += __shfl_xor(sk, 1); sk += __shfl_xor(sk, 2); sk += __shfl_xor(sk, 4);
                      if (row < SEQ) { mq0 = fmaxf(mq0, sq); mk0 = fmaxf(mk0, sk); } else { mq1 = fmaxf(mq1, sq); mk1 = fmaxf(mk1, sk); } }
                  if ((lane & 7) == 0) { const int hh = lane >> 3;
                      __hip_atomic_fetch_max(lst + hh * 2, __float_as_uint(mq0), __ATOMIC_RELAXED, __HIP_MEMORY_SCOPE_WORKGROUP); __hip_atomic_fetch_max(lst + hh * 2 + 1, __float_as_uint(mk0), __ATOMIC_RELAXED, __HIP_MEMORY_SCOPE_WORKGROUP);
                      __hip_atomic_fetch_max(lst + 16 + hh * 2, __float_as_uint(mq1), __ATOMIC_RELAXED, __HIP_MEMORY_SCOPE_WORKGROUP); __hip_atomic_fetch_max(lst + 16 + hh * 2 + 1, __float_as_uint(mk1), __ATOMIC_RELAXED, __HIP_MEMORY_SCOPE_WORKGROUP); }
                  __syncthreads();
                  if (tid < 32) __hip_atomic_fetch_max((unsigned*)ctl + CW_STAT + l * 32 + tid, lst[tid], __ATOMIC_RELAXED, __HIP_MEMORY_SCOPE_AGENT); }
            } else if constexpr (k == 2) {
                if constexpr (!REP) { for (int j = bx; j < 256; j += G) scan::scan_c_block(ws + WS_SCAN, j, tid); }
            } else if constexpr (k == 3) {
                static_assert(attn_body::ATTN_LDS_BYTES <= RING_BYTES, "attention LDS");
                unsigned char* sc = ws + WS_SCAN; const int wv = wave;
                const float* stat = (const float*)(ctl + CW_STAT + l * 32);
                LAS unsigned* slot = (LAS unsigned*)(L + LDSCTL_OFF);
                int v;
                for (;;) {
                    if (tid == 0) *slot = __hip_atomic_fetch_add((unsigned*)ctl + CW_QCTR + l + (REP ? 2 : 0), 1u, __ATOMIC_RELAXED, __HIP_MEMORY_SCOPE_AGENT);
                    __syncthreads();
                    v = __builtin_amdgcn_readfirstlane((int)*(volatile LAS unsigned*)slot);
                    if (v >= 736) break;
                    int qb, bh, part = 0; float* PART = nullptr;
                    if (v < 448) { qb = 31 - (v >> 5); bh = v & 15; part = (v >> 4) & 1; PART = (float*)(ws + WS_SCAN + (40 + 32 * l) * MiB) + (size_t)(bh * 14 + (qb - 18)) * 2 * attn_body::PART_F; }
                    else { const int u2 = v - 448; qb = 17 - (u2 >> 4); bh = u2 & 15; }
                    const float Tsk = 40.f + 2.f * __builtin_sqrtf(stat[bh * 2] * stat[bh * 2 + 1]) * 1.01f + 1.f;
                    attn_body::attn_unit<8>(bh >> 3, bh & 7, qb, (const attn_body::bf16*)(P + P_FQ), (const attn_body::bf16*)(P + P_FK), (const attn_body::bf16*)(P + P_FV), (attn_body::bf16*)(MIX + 512), CF + (size_t)bh * SEQ, Tsk,
                                            part, PART, (unsigned*)ctl + CW_AFLAG + (l + (REP ? 2 : 0)) * 512 + bh * 32 + qb, (char*)L + RING_OFF);
                    __syncthreads();
                }
                int tid2 = tid; asm volatile("" : "+v"(tid2));
                while (v < 736 + 512) {
                    const int it0 = (v - 736) * 4;
                    if (it0 < 1024) { scan::HgIn R, Rn; { ITEM_DECODE(it0); scan::hgrn_load<true>(R, P, b, c, h, (const float*)(sc + scan::SC_LHG) + (size_t)item * 4096, tid2, wv); }
#pragma unroll 1
                        for (int j = 0; j < 4; ++j) { const int it = it0 + j; int tl = tid2; asm volatile("" : "+v"(tl));
                            if (j < 3) { ITEM_DECODE(it + 1); scan::hgrn_load<true>(Rn, P, b, c, h, (const float*)(sc + scan::SC_LHG) + (size_t)item * 4096, tl, wv); }
                            asm volatile("" ::: "memory");
                            { ITEM_DECODE(it); const float lb = l == 0 ? 0.f : 1.f / (1.f + __expf(a.in[I_HGRN_LB][h * 64 + (tl & 63)] - a.in[I_HGRN_LB][256 + h * 64 + (tl & 63)]));
                              scan::hgrn_d_item(L, R, lb, a.in[I_HGRN_NORM] + l * 256 + h * 64, MIX + (size_t)(b * SEQ + c * 64) * D + h * 64, tl, wv); }
                            if (j < 3) R = Rn; } }
                    else { scan::MlIn R, Rn; { ITEM_DECODE(it0); scan::mlstm_load<true>(R, P, Gt, b, c, h, (const float*)(sc + scan::SC_LML) + (size_t)item * 4096, (const float*)(sc + scan::SC_NL) + item * 64, (const float*)(sc + scan::SC_MPREV) + item, tid2, wv); }
#pragma unroll 1
                        for (int j = 0; j < 4; ++j) { const int it = it0 + j; int tl = tid2; asm volatile("" : "+v"(tl));
                            if (j < 3) { ITEM_DECODE(it + 1); scan::mlstm_load<true>(Rn, P, Gt, b, c, h, (const float*)(sc + scan::SC_LML) + (size_t)item * 4096, (const float*)(sc + scan::SC_NL) + item * 64, (const float*)(sc + scan::SC_MPREV) + item, tl, wv); }
                            asm volatile("" ::: "memory");
                            { ITEM_DECODE(it); scan::mlstm_d_item(L, R, a.in[I_MLSTM_CONV] + l * 2048, a.in[I_MLSTM_BI] + l * 4, a.in[I_MLSTM_BF] + l * 4, a.in[I_MLSTM_NORM] + l * 256 + h * 64, h, MIX + (size_t)(b * SEQ + c * 64) * D + 256 + h * 64, tl, wv); }
                            if (j < 3) R = Rn; } }
                    __syncthreads();
                    if (tid2 == 0) *slot = __hip_atomic_fetch_add((unsigned*)ctl + CW_QCTR + l + (REP ? 2 : 0), 1u, __ATOMIC_RELAXED, __HIP_MEMORY_SCOPE_AGENT);
                    __syncthreads();
                    v = __builtin_amdgcn_readfirstlane((int)*(volatile LAS unsigned*)slot);
                }
            }

        }
}
__global__ void __launch_bounds__(NTHR, 2) mega(MArgs a) {
    extern __shared__ __attribute__((aligned(16))) unsigned char lds[];
    LAS unsigned char* L = (LAS unsigned char*)lds;
    volatile LAS unsigned* MISC = (volatile LAS unsigned*)(L + MISC_OFF);
    const int tid = threadIdx.x, wave = __builtin_amdgcn_readfirstlane(tid >> 6);
    const int G = gridDim.x, bx = blockIdx.x, vcu = (G % 8 == 0) ? (bx % 8) * (G / 8) + bx / 8 : bx;
    for (int u = tid; u < (LDS_BYTES - LDSCTL_OFF) / 4; u += NTHR) ((LAS unsigned*)(L + LDSCTL_OFF))[u] = 0u;
    __syncthreads();
    const int lo = a.ph_lo, hi = a.ph_hi;
    XcdBarrier bar; bar.bar = (unsigned*)(a.ws + WS_CTL) + CW_BAR; bar.x = 0; bar.st = nullptr;
    if (hi - lo > 1) bar = xcd_barrier_post((unsigned*)(a.ws + WS_CTL) + CW_BAR, MISC + 8);
#ifndef REPEAT_MASK
#define REPEAT_MASK 0u
#endif
#define PHASE(k) if (lo <= (k) && (k) < hi) { run_phase<k>(a, L, tid, wave, G, bx, vcu); if constexpr ((REPEAT_MASK >> (k)) & 1u) { xcd_barrier(bar); run_phase<k, true>(a, L, tid, wave, G, bx, vcu); } if ((k) + 1 < hi) xcd_barrier(bar); }
    PHASE(0) PHASE(1) PHASE(2) PHASE(3) PHASE(4) PHASE(5) PHASE(6) PHASE(7) PHASE(8) PHASE(9) PHASE(10)
    PHASE(11) PHASE(12) PHASE(13) PHASE(14) PHASE(15) PHASE(16) PHASE(17) PHASE(19) PHASE(20)
#undef PHASE
}
#ifndef MEGA_MASK
#define MEGA_MASK 0x1FFFFFu
#endif
#ifndef FUSE_RUNS
#define FUSE_RUNS 1
#endif
extern "C" void kernel_launch(void* const* d_in, const int* in_sizes, int n_in, void* d_out, int out_size, void* d_ws, size_t ws_size, hipStream_t stream) {
    static int grid = 0;
    if (grid == 0) {
        if (n_in != 20 || ws_size < WS_END || out_size != NTOK * D) { fprintf(stderr, "kernel_launch: unexpected n_in %d / ws %zu / out %d\n", n_in, ws_size, out_size); grid = -1; return; }
        int dev = 0, cus = 0, per_cu = 0;
        if (hipGetDevice(&dev) != hipSuccess || hipDeviceGetAttribute(&cus, hipDeviceAttributeMultiprocessorCount, dev) != hipSuccess) { grid = -1; return; }
        if (hipFuncSetAttribute((const void*)mega, hipFuncAttributeMaxDynamicSharedMemorySize, LDS_BYTES) != hipSuccess) { fprintf(stderr, "kernel_launch: hipFuncSetAttribute failed\n"); grid = -1; return; }
        if (hipOccupancyMaxActiveBlocksPerMultiprocessor(&per_cu, (const void*)mega, NTHR, LDS_BYTES) != hipSuccess || per_cu < 1) { fprintf(stderr, "kernel_launch: occupancy query says %d\n", per_cu); per_cu = 1; }
        (void)hipGetLastError();
        grid = cus;
        if (grid > 256) grid = 256;
    }
    if (grid < 0) return;
    const float* const* in = (const float* const*)d_in;
    unsigned char* ws = (unsigned char*)d_ws; float* X = (float*)d_out;
    (void)hipMemsetAsync(ws + WS_CTL, 0, CTL_BYTES, stream);
    MArgs ma; memset(&ma, 0, sizeof ma);
    for (int i = 0; i < 20; ++i) ma.in[i] = in[i];
    ma.out = X; ma.ws = ws;
    ma.ph_lo = 0; ma.ph_hi = N_PHASES;
    hipLaunchKernelGGL(mega, dim3(grid), dim3(NTHR), LDS_BYTES, stream, ma);
}
```

```cpp
#include <hip/hip_runtime.h>
#include <hip/hip_bf16.h>
#include <cstdint>
#include <cstdio>
#include <cstring>

namespace cfg {
constexpr int NTOK = 16384, D = 1024, SEQ = 8192, NB = 2, DIN = 3600, PW = 3584, GW = 16;
constexpr int FF = 2816, FE = 3584, NE = 8, MAXROWS = 34816;
constexpr float EPS = 1e-6f;
constexpr float LOG2E = 1.4426950408889634f;
constexpr float QSCALE = 0.125f * LOG2E;
constexpr int P_HQ = 0, P_HF = 256, P_HI = 512, P_HG = 768, P_MQ = 1024, P_MK = 1280, P_MV = 1536, P_MO = 1792, P_FQ = 2048, P_FK = 2560, P_FV = 3072;
constexpr size_t MiB = 1u << 20;
constexpr size_t WS_CTL = 0, CTL_BYTES = 1 * MiB;
constexpr size_t WS_G = 2 * MiB;
constexpr size_t WS_CF = 3 * MiB;
constexpr size_t WS_TOKINFO = 3 * MiB + 512 * 1024;
constexpr size_t WS_TGATE = 3 * MiB + 768 * 1024;
constexpr size_t WS_TOKLIST = 4 * MiB;
constexpr size_t WS_P = 8 * MiB;
constexpr size_t WS_SCAN = 120 * MiB;
constexpr size_t WS_HID = 8 * MiB;
constexpr size_t WS_H = 246 * MiB;
constexpr size_t WS_MIX = 278 * MiB;
constexpr size_t WS_XG = 278 * MiB;
constexpr size_t WS_W = 346 * MiB;
constexpr size_t WS_Y = 346 * MiB;
constexpr size_t WS_END = 466 * MiB;
constexpr int CW_CNT = 64;
constexpr int CW_STAT = 128;
constexpr int CW_QCTR = 256;
constexpr int CW_AFLAG = 512;
}
using namespace cfg;
typedef unsigned short bf16_t;

__device__ __forceinline__ bf16_t f2bf(float f) { unsigned u = __builtin_bit_cast(unsigned, f); return (bf16_t)((u + 0x7fffu + ((u >> 16) & 1u)) >> 16); }
__device__ __forceinline__ float bf2f(bf16_t h) { return __builtin_bit_cast(float, (unsigned)h << 16); }
__device__ __forceinline__ float wave_sum(float v) {
#pragma unroll
    for (int o = 1; o < 64; o <<= 1) v += __shfl_xor(v, o);
    return v;
}
__device__ __forceinline__ float sigmoidf_(float z) { return 1.f / (1.f + __expf(-z)); }
__device__ __forceinline__ float siluf_(float z) { return z / (1.f + __expf(-z)); }
__device__ __forceinline__ float log_sigmoidf_(float z) { return fminf(z, 0.f) - log1pf(__expf(-fabsf(z))); }

__device__ __forceinline__ int moe_bases(const int* cnt, int* base) {
    int acc = 0;
#pragma unroll
    for (int e = 0; e < NE; ++e) { base[e] = acc; acc += (cnt[e] + 255) & ~255; }
    return acc;
}

namespace pg8 {
#define PG8_LAS __attribute__((address_space(3)))
typedef unsigned short bf16_t;
typedef short bf16x8 __attribute__((ext_vector_type(8)));
typedef float f32x4 __attribute__((ext_vector_type(4)));
typedef unsigned u32x4 __attribute__((ext_vector_type(4)));
constexpr int BM = 256, BK = 64, HALF = 128, HTB = HALF * BK * 2  , STAGE_BYTES = 8 * HTB, NXCD = 8, WGM = 8;

__host__ __device__ __forceinline__ int lds_byte(int r, int c) { const int st = (r >> 4) * 2 + (c >> 5), rr = r & 15, cc = c & 31, ob = rr * 64 + cc * 2; return st * 1024 + (ob ^ (((ob >> 9) & 1) << 5)); }
__host__ __device__ __forceinline__ void stage_rc(int b, int& R, int& C) { const int st = b / 1024, sb = b % 1024, swz = sb ^ (((sb >> 9) & 1) << 5); R = (st >> 1) * 16 + swz / 64; C = (st & 1) * 32 + (swz % 64) / 2; }
__host__ __device__ __forceinline__ int perm32(int rho) { const int n = rho >> 4, i = rho & 15; return 8 * (i >> 2) + 4 * n + (i & 3); }

struct Unit { int pm, pn; };
struct Gemm { int K; };

struct StaticOrder {
    int nM, nN, nwg, G, c;
    __host__ __device__ void init(int M, int N, int G_, int c_) { nM = M / BM; nN = N / BM; nwg = nM * nN; G = G_; c = c_; }
    __host__ __device__ bool next(int i, Unit& u) const {
        const long L = (long)i * G + c; if (L >= nwg) return false;
        int wgid = (int)L; { const int q = nwg / NXCD, r = nwg % NXCD, xcd = wgid % NXCD, off = wgid / NXCD; wgid = (xcd < r ? xcd * (q + 1) : r * (q + 1) + (xcd - r) * q) + off; }
        const int nig = WGM * nN, gid = wgid / nig, fm = gid * WGM, gsz = (nM - fm) < WGM ? (nM - fm) : WGM;
        u.pm = fm + ((wgid % nig) % gsz); u.pn = (wgid % nig) / gsz; return true;
    }
    __device__ __forceinline__ void a_ready(const Unit&) const {}
    __device__ __forceinline__ void done(const Unit&) const {}
};

__device__ __forceinline__ unsigned cvt_pk_bf16(float lo, float hi) { unsigned r; asm volatile("v_cvt_pk_bf16_f32 %0, %1, %2" : "=v"(r) : "v"(lo), "v"(hi)); return r; }
typedef int i32x4 __attribute__((ext_vector_type(4)));
template <bool I8> struct AccT { typedef f32x4 type; };
template <> struct AccT<true> { typedef i32x4 type; };
__device__ __forceinline__ f32x4 mma_sel(bf16x8 b, bf16x8 a, f32x4 c) { return __builtin_amdgcn_mfma_f32_16x16x32_bf16(b, a, c, 0, 0, 0); }
__device__ __forceinline__ i32x4 mma_sel(bf16x8 b, bf16x8 a, i32x4 c) { return __builtin_amdgcn_mfma_i32_16x16x64_i8(__builtin_bit_cast(i32x4, b), __builtin_bit_cast(i32x4, a), c, 0, 0, 0); }
struct EpiBf {
    static constexpr bool PERM = true, AFTER_DRAIN = false;
    bf16_t* O; int ldc; int s_lo, s_hi; float scale;
    __device__ __forceinline__ void operator()(const f32x4 (&acc)[2][2][4][2], const Unit& u, int wr, int wc, int fr, int fq) const {
        const int row0 = u.pm * BM + wr * 64 + fr, col0 = u.pn * BM + wc * 32 + 8 * fq;
        const float sc = (u.pn >= s_lo && u.pn < s_hi) ? scale : 1.f;
#pragma unroll
        for (int ai = 0; ai < 2; ++ai)
#pragma unroll
            for (int m = 0; m < 4; ++m) { bf16_t* rowp = O + (size_t)(row0 + ai * HALF + m * 16) * ldc + col0;
#pragma unroll
                for (int bj = 0; bj < 2; ++bj) { const f32x4 v0 = acc[ai][bj][m][0] * sc, v1 = acc[ai][bj][m][1] * sc;
                    u32x4 w; w.x = cvt_pk_bf16(v0[0], v0[1]); w.y = cvt_pk_bf16(v0[2], v0[3]); w.z = cvt_pk_bf16(v1[0], v1[1]); w.w = cvt_pk_bf16(v1[2], v1[3]);
                    *(u32x4*)(rowp + bj * HALF) = w; } }
    }
};
__device__ __forceinline__ float silu_mul(float g, float u) { return g * __builtin_amdgcn_rcpf(1.f + __expf(-g)) * u; }
struct EpiSwiglu {
    static constexpr bool PERM = true, AFTER_DRAIN = false;
    bf16_t* O; int ldc;
    __device__ __forceinline__ void operator()(const f32x4 (&acc)[2][2][4][2], const Unit& u, int wr, int wc, int fr, int fq) const {
        const int row0 = u.pm * BM + wr * 64 + fr, col0 = u.pn * HALF + wc * 32 + 8 * fq;
#pragma unroll
        for (int ai = 0; ai < 2; ++ai)
#pragma unroll
            for (int m = 0; m < 4; ++m) { bf16_t* rowp = O + (size_t)(row0 + ai * HALF + m * 16) * ldc + col0;
                const f32x4 g0 = acc[ai][0][m][0], g1 = acc[ai][0][m][1], u0 = acc[ai][1][m][0], u1 = acc[ai][1][m][1];
                u32x4 w; w.x = cvt_pk_bf16(silu_mul(g0[0], u0[0]), silu_mul(g0[1], u0[1])); w.y = cvt_pk_bf16(silu_mul(g0[2], u0[2]), silu_mul(g0[3], u0[3]));
                w.z = cvt_pk_bf16(silu_mul(g1[0], u1[0]), silu_mul(g1[1], u1[1])); w.w = cvt_pk_bf16(silu_mul(g1[2], u1[2]), silu_mul(g1[3], u1[3]));
                *(u32x4*)rowp = w; }
    }
};
struct EpiResid {
    static constexpr bool PERM = false, AFTER_DRAIN = false;
    const float* Xin; float* X; int ldc;
    __device__ __forceinline__ void operator()(const f32x4 (&acc)[2][2][4][2], const Unit& u, int wr, int wc, int fr, int fq) const {
        const int row0 = u.pm * BM + wr * 64 + fr, col0 = u.pn * BM + wc * 32 + 4 * fq;
#pragma unroll
        for (int ai = 0; ai < 2; ++ai)
#pragma unroll
            for (int m = 0; m < 4; ++m) { const size_t ro = (size_t)(row0 + ai * HALF + m * 16) * ldc + col0; float* rowp = X + ro; const float* rowi = Xin + ro;
#pragma unroll
                for (int bj = 0; bj < 2; ++bj)
#pragma unroll
                    for (int n = 0; n < 2; ++n) { *(f32x4*)(rowp + bj * HALF + n * 16) = *(const f32x4*)(rowi + bj * HALF + n * 16) + acc[ai][bj][m][n]; }
                asm volatile("" ::: "memory"); }
    }
};
struct EpiBf8 {
    static constexpr bool PERM = true, AFTER_DRAIN = false;
    bf16_t* O; int ldc; int s_lo, s_hi; float scale; const float* sA; const float* sB;
    __device__ __forceinline__ void operator()(const i32x4 (&acc)[2][2][4][2], const Unit& u, int wr, int wc, int fr, int fq) const {
        const int row0 = u.pm * BM + wr * 64 + fr, col0 = u.pn * BM + wc * 32 + 8 * fq;
        const float sc = (u.pn >= s_lo && u.pn < s_hi) ? scale : 1.f;
        f32x4 cb[2][2];
#pragma unroll
        for (int bj = 0; bj < 2; ++bj)
#pragma unroll
            for (int n = 0; n < 2; ++n) cb[bj][n] = *(const f32x4*)(sB + col0 + bj * HALF + 4 * n) * sc;
#pragma unroll
        for (int ai = 0; ai < 2; ++ai)
#pragma unroll
            for (int m = 0; m < 4; ++m) { const int row = row0 + ai * HALF + m * 16; const float ra = sA[row]; bf16_t* rowp = O + (size_t)row * ldc + col0;
#pragma unroll
                for (int bj = 0; bj < 2; ++bj) { const f32x4 v0 = __builtin_convertvector(acc[ai][bj][m][0], f32x4) * cb[bj][0] * ra, v1 = __builtin_convertvector(acc[ai][bj][m][1], f32x4) * cb[bj][1] * ra;
                    u32x4 w; w.x = cvt_pk_bf16(v0[0], v0[1]); w.y = cvt_pk_bf16(v0[2], v0[3]); w.z = cvt_pk_bf16(v1[0], v1[1]); w.w = cvt_pk_bf16(v1[2], v1[3]);
                    *(u32x4*)(rowp + bj * HALF) = w; } }
    }
};
struct EpiSwiglu8 {
    static constexpr bool PERM = true, AFTER_DRAIN = false;
    bf16_t* O; int ldc; const float* sA; const float* sB; int sb_exp; int tb1, tb2, tb3, tb4, tb5, tb6, tb7;
    __device__ __forceinline__ void operator()(const i32x4 (&acc)[2][2][4][2], const Unit& u, int wr, int wc, int fr, int fq) const {
        const int row0 = u.pm * BM + wr * 64 + fr, col0 = u.pn * HALF + wc * 32 + 8 * fq;
        const int e = (u.pm >= tb1) + (u.pm >= tb2) + (u.pm >= tb3) + (u.pm >= tb4) + (u.pm >= tb5) + (u.pm >= tb6) + (u.pm >= tb7);
        const float* sb = sB + (size_t)e * sb_exp + u.pn * BM + wc * 32 + 8 * fq;
        const f32x4 sg0 = *(const f32x4*)sb, sg1 = *(const f32x4*)(sb + 4), su0 = *(const f32x4*)(sb + HALF), su1 = *(const f32x4*)(sb + HALF + 4);
#pragma unroll
        for (int ai = 0; ai < 2; ++ai)
#pragma unroll
            for (int m = 0; m < 4; ++m) { const int row = row0 + ai * HALF + m * 16; const float ra = sA[row]; bf16_t* rowp = O + (size_t)row * ldc + col0;
                const f32x4 g0 = __builtin_convertvector(acc[ai][0][m][0], f32x4) * sg0 * ra, g1 = __builtin_convertvector(acc[ai][0][m][1], f32x4) * sg1 * ra;
                const f32x4 u0 = __builtin_convertvector(acc[ai][1][m][0], f32x4) * su0 * ra, u1 = __builtin_convertvector(acc[ai][1][m][1], f32x4) * su1 * ra;
                u32x4 w; w.x = cvt_pk_bf16(silu_mul(g0[0], u0[0]), silu_mul(g0[1], u0[1])); w.y = cvt_pk_bf16(silu_mul(g0[2], u0[2]), silu_mul(g0[3], u0[3]));
                w.z = cvt_pk_bf16(silu_mul(g1[0], u1[0]), silu_mul(g1[1], u1[1])); w.w = cvt_pk_bf16(silu_mul(g1[2], u1[2]), silu_mul(g1[3], u1[3]));
                *(u32x4*)rowp = w; }
    }
};
struct GOrder {
    StaticOrder so; const char* A; const char* B; size_t a_tile, b_tile, b_exp; int tb1, tb2, tb3, tb4, tb5, tb6, tb7;
    __device__ __forceinline__ bool next(int i, Unit& u) const { return so.next(i, u); }
    __device__ __forceinline__ const char* a_base(const Unit& u) const { return A + (size_t)u.pm * a_tile; }
    __device__ __forceinline__ const char* b_base(const Unit& u) const {
        const int e = (u.pm >= tb1) + (u.pm >= tb2) + (u.pm >= tb3) + (u.pm >= tb4) + (u.pm >= tb5) + (u.pm >= tb6) + (u.pm >= tb7);
        return B + (size_t)e * b_exp + (size_t)u.pn * b_tile; }
    __device__ __forceinline__ void a_ready(const Unit&) const {}
    __device__ __forceinline__ void done(const Unit&) const {}
};
template <class Epi, class Sched, bool ALIGN_EPI = false, bool SP2 = false, bool I8 = false>
__device__ __forceinline__ void gemm_phase(PG8_LAS unsigned char* lds, const Gemm g, const Sched& S, const Epi& E) {
    const int tid = threadIdx.x, wid = __builtin_amdgcn_readfirstlane(tid >> 6), lane = tid & 63, wr = wid >> 2, wc = wid & 3, fr = lane & 15, fq = lane >> 4;
    const int K = g.K, nt = K / BK;
    unsigned voffA[2], voffB[2];
#pragma unroll
    for (int i = 0; i < 2; ++i) { int R, C; stage_rc(tid * 16 + i * 8192, R, C); const int Rb = Epi::PERM ? ((R & ~31) + perm32(R & 31)) : R;
        voffA[i] = (unsigned)(R * K + C) * 2u; voffB[i] = (unsigned)(Rb * K + C) * 2u; }
    const size_t kstep = (size_t)(BK * 2);
    const size_t hstep = (size_t)HALF * K * 2;
        const unsigned ldsw = (unsigned)wid * 1024u;
    const int aoff = lds_byte(wr * 64 + fr, fq * 8), boff = lds_byte(wc * 32 + fr, fq * 8);
#define PG8_SA(b, h) (((b) * 2 + (h)) * HTB)
#define PG8_SB(b, h) ((4 + (b) * 2 + (h)) * HTB)
#define PG8_STAGE(bufoff, gbase, voff) do { _Pragma("unroll") for (int _i = 0; _i < 2; ++_i) \
        __builtin_amdgcn_global_load_lds((const unsigned*)((const char*)(gbase) + (voff)[_i]), (PG8_LAS unsigned*)(lds + (bufoff) + ldsw + _i * 8192), 16, 0, 0); } while (0)
#define PG8_LDA(dst, b, h) do { _Pragma("unroll") for (int m = 0; m < 4; ++m) _Pragma("unroll") for (int k = 0; k < 2; ++k) dst[m][k] = *(const PG8_LAS bf16x8*)(lds + PG8_SA(b, h) + aoff + m * 2048 + k * 1024); } while (0)
#define PG8_LDB(dst, b, h) do { _Pragma("unroll") for (int n = 0; n < 2; ++n) _Pragma("unroll") for (int k = 0; k < 2; ++k) dst[n][k] = *(const PG8_LAS bf16x8*)(lds + PG8_SB(b, h) + boff + n * 2048 + k * 1024); } while (0)
#define PG8_MMA(ai, bj, At, Bt) do { __builtin_amdgcn_s_setprio(1); _Pragma("unroll") for (int m = 0; m < 4; ++m) _Pragma("unroll") for (int n = 0; n < 2; ++n) _Pragma("unroll") for (int k = 0; k < 2; ++k) \
        acc[ai][bj][m][n] = mma_sel(Bt[n][k], At[m][k], acc[ai][bj][m][n]); __builtin_amdgcn_s_setprio(0); } while (0)
#define PG8_WAIT_V(n) asm volatile("s_waitcnt vmcnt(" #n ")" ::: "memory")
#define PG8_WAIT_L(n) asm volatile("s_waitcnt lgkmcnt(" #n ")" ::: "memory")
#define PG8_BAR __builtin_amdgcn_s_barrier()
#define PG8_SCHED __builtin_amdgcn_sched_barrier(0)
    Unit cur, nxt; int ui = 0;
    if (!S.next(0, cur)) return;
    typename AccT<I8>::type acc[2][2][4][2];
#pragma unroll
    for (int a = 0; a < 2; ++a)
#pragma unroll
        for (int b = 0; b < 2; ++b)
#pragma unroll
            for (int m = 0; m < 4; ++m)
#pragma unroll
                for (int n = 0; n < 2; ++n) acc[a][b][m][n] = typename AccT<I8>::type{};
    bf16x8 At[4][2], B0[2][2], B1[2][2];
    const char* cA = S.a_base(cur); const char* cB = S.b_base(cur);
    S.a_ready(cur);
    if constexpr (SP2) {
        PG8_STAGE(PG8_SB(0, 0), cB, voffB); PG8_STAGE(PG8_SB(0, 1), cB + hstep, voffB); PG8_STAGE(PG8_SA(0, 0), cA, voffA); PG8_STAGE(PG8_SA(0, 1), cA + hstep, voffA);
        if (wr == 1) PG8_BAR;
        PG8_WAIT_V(2); PG8_BAR;
        PG8_STAGE(PG8_SB(1, 0), cB + kstep, voffB); PG8_STAGE(PG8_SA(1, 0), cA + kstep, voffA); PG8_STAGE(PG8_SB(1, 1), cB + hstep + kstep, voffB);
        PG8_WAIT_V(6); PG8_BAR;
    } else {
        PG8_STAGE(PG8_SB(0, 0), cB, voffB); PG8_STAGE(PG8_SA(0, 0), cA, voffA); PG8_STAGE(PG8_SB(0, 1), cB + hstep, voffB); PG8_STAGE(PG8_SA(0, 1), cA + hstep, voffA);
        if (wr == 1) PG8_BAR;
        PG8_WAIT_V(4); PG8_BAR;
        PG8_STAGE(PG8_SB(1, 0), cB + kstep, voffB); PG8_STAGE(PG8_SA(1, 0), cA + kstep, voffA); PG8_STAGE(PG8_SB(1, 1), cB + hstep + kstep, voffB);
        PG8_WAIT_V(6); PG8_BAR;
    }
    for (;;) {
        const bool has_next = S.next(ui + 1, nxt);
        const char* nA = has_next ? S.a_base(nxt) : cA; const char* nB = has_next ? S.b_base(nxt) : cB;
        for (int t = 0; t < nt; t += 2) {
            const bool last = (t == nt - 2);
            const char* a1 = cA + (size_t)(t + 1) * kstep;
            const char* a2 = last ? nA : cA + (size_t)(t + 2) * kstep; const char* b2 = last ? nB : cB + (size_t)(t + 2) * kstep;
            const char* a3 = a2 + kstep; const char* b3 = b2 + kstep;
            if (last && has_next) S.a_ready(nxt);
            if constexpr (SP2) {
            PG8_LDB(B0, 0, 0); PG8_LDB(B1, 0, 1); PG8_SCHED; PG8_LDA(At, 0, 0); PG8_STAGE(PG8_SA(1, 1), a1 + hstep, voffA);
            PG8_WAIT_V(8); PG8_WAIT_L(0); PG8_BAR; PG8_MMA(0, 0, At, B0); PG8_MMA(0, 1, At, B1); PG8_BAR; PG8_SCHED;
            PG8_LDA(At, 0, 1); PG8_STAGE(PG8_SB(0, 0), b2, voffB); PG8_STAGE(PG8_SB(0, 1), b2 + hstep, voffB); PG8_STAGE(PG8_SA(0, 0), a2, voffA);
            PG8_WAIT_V(8); PG8_WAIT_L(0); PG8_BAR; PG8_MMA(1, 0, At, B0); PG8_MMA(1, 1, At, B1); PG8_BAR; PG8_SCHED;
            PG8_LDB(B0, 1, 0); PG8_LDB(B1, 1, 1); PG8_SCHED; PG8_LDA(At, 1, 0); PG8_STAGE(PG8_SA(0, 1), a2 + hstep, voffA);
            PG8_WAIT_V(8); PG8_WAIT_L(0); PG8_BAR; PG8_MMA(0, 0, At, B0); PG8_MMA(0, 1, At, B1); PG8_BAR; PG8_SCHED;
            PG8_LDA(At, 1, 1); PG8_STAGE(PG8_SB(1, 0), b3, voffB); PG8_STAGE(PG8_SB(1, 1), b3 + hstep, voffB); PG8_STAGE(PG8_SA(1, 0), a3, voffA);
            PG8_WAIT_V(8); PG8_WAIT_L(0); PG8_BAR; PG8_MMA(1, 0, At, B0); PG8_MMA(1, 1, At, B1); PG8_BAR; PG8_SCHED;
            } else {
            PG8_LDB(B0, 0, 0); PG8_SCHED; PG8_LDA(At, 0, 0); PG8_STAGE(PG8_SA(1, 1), a1 + hstep, voffA);
            PG8_WAIT_L(8); PG8_BAR; PG8_WAIT_L(0); PG8_MMA(0, 0, At, B0); PG8_BAR; PG8_SCHED;
            PG8_LDB(B1, 0, 1); PG8_STAGE(PG8_SB(0, 0), b2, voffB);
            PG8_BAR; PG8_WAIT_L(0); PG8_MMA(0, 1, At, B1); PG8_BAR;
            PG8_LDA(At, 0, 1); PG8_STAGE(PG8_SA(0, 0), a2, voffA);
            PG8_BAR; PG8_WAIT_L(0); PG8_MMA(1, 0, At, B0); PG8_BAR; PG8_SCHED;
            PG8_STAGE(PG8_SB(0, 1), b2 + hstep, voffB);
            PG8_WAIT_V(6); PG8_BAR; PG8_MMA(1, 1, At, B1); PG8_BAR;
            PG8_LDB(B0, 1, 0); PG8_SCHED; PG8_LDA(At, 1, 0); PG8_STAGE(PG8_SA(0, 1), a2 + hstep, voffA);
            PG8_WAIT_L(8); PG8_BAR; PG8_WAIT_L(0); PG8_MMA(0, 0, At, B0); PG8_BAR; PG8_SCHED;
            PG8_LDB(B1, 1, 1); PG8_STAGE(PG8_SB(1, 0), b3, voffB);
            PG8_BAR; PG8_WAIT_L(0); PG8_MMA(0, 1, At, B1); PG8_BAR;
            PG8_LDA(At, 1, 1); PG8_STAGE(PG8_SA(1, 0), a3, voffA);
            PG8_BAR; PG8_WAIT_L(0); PG8_MMA(1, 0, At, B0); PG8_BAR; PG8_SCHED;
            PG8_STAGE(PG8_SB(1, 1), b3 + hstep, voffB);
            PG8_WAIT_V(6); PG8_BAR; PG8_MMA(1, 1, At, B1); PG8_BAR;
            }
        }
        if constexpr (ALIGN_EPI) { if (wr == 0) PG8_BAR; }
        if constexpr (!Epi::AFTER_DRAIN) { E(acc, cur, wr, wc, fr, fq); S.done(cur); }
        if (!has_next) break;
#pragma unroll
        for (int a = 0; a < 2; ++a)
#pragma unroll
            for (int b = 0; b < 2; ++b)
#pragma unroll
                for (int m = 0; m < 4; ++m)
#pragma unroll
                    for (int n = 0; n < 2; ++n) acc[a][b][m][n] = typename AccT<I8>::type{};
        cur = nxt; cA = nA; cB = nB; ++ui;
        if constexpr (ALIGN_EPI) { if (wr == 1) PG8_BAR; }
    }
    PG8_WAIT_V(0);
    if constexpr (!ALIGN_EPI) { if (wr == 0) PG8_BAR; }
    PG8_BAR;
    if constexpr (Epi::AFTER_DRAIN) { E.fused(acc, cur, wr, wc, fr, fq, lds, wid, lane); S.done(cur); }
#undef PG8_SA
#undef PG8_SB
#undef PG8_STAGE
#undef PG8_LDA
#undef PG8_LDB
#undef PG8_MMA
#undef PG8_WAIT_V
#undef PG8_WAIT_L
#undef PG8_BAR
#undef PG8_SCHED
}
}
#include <hip/hip_bf16.h>
#include <cmath>
namespace attn_body {
using bf16=__hip_bfloat16;
using bf16x8=__attribute__((ext_vector_type(8)))short;
using s16x4=__attribute__((ext_vector_type(4)))short;
using f32x16=__attribute__((ext_vector_type(16)))float;
using u32x4=__attribute__((ext_vector_type(4)))unsigned;
constexpr int BATCH=2,NHEAD=8,SEQ=8192,D=64,DM=3584,OPITCH=1024;
constexpr int NW=8,QBLK=32,QB=QBLK*NW,KVBLK=64,NQB=SEQ/QB;
constexpr int ATTN_PITCH=DM, ATTN_UNIT_ROWS=QB;
__device__ __forceinline__ int crow(int r,int hi){return (r&3)+8*(r>>2)+4*hi;}
#define SBAR() __builtin_amdgcn_sched_barrier(0)
__device__ __forceinline__ void cmask(f32x16&p0,f32x16&p1,int jb,int qrel,int hi){
  const float NEG=-INFINITY; int kb=64*jb+4*hi;
  #pragma unroll
  for(int r=0;r<16;++r){int kv=kb+(r&3)+8*(r>>2); if(kv>qrel)p0[r]=NEG; if(kv+32>qrel)p1[r]=NEG;}
}

constexpr int NSLOT=3, SLOTB=8192, SPLIT_NT=72, PART_F=256*64+512;
constexpr int LDS_K=0, LDS_V=NSLOT*SLOTB, LDS_WS=2*NSLOT*SLOTB, LDS_OST=LDS_WS+NW*64*4, LDS_CK=LDS_OST+NW*4096, LDS_BYTES=LDS_CK+SEQ*4;
constexpr float C2=0.125f*1.4426950408889634f;
__device__ __forceinline__ void glds16(const void*gsrc,unsigned lds_dst){unsigned keep;
  asm volatile("s_mov_b32 %0, m0\n\ts_mov_b32 m0, %2\n\ts_nop 0\n\tglobal_load_lds_dwordx4 %1, off\n\ts_mov_b32 m0, %0":"=&s"(keep):"v"(gsrc),"s"(lds_dst):"memory");}
__device__ __forceinline__ float max3f(float a,float b,float c){float r;asm("v_max3_f32 %0, %1, %2, %3":"=v"(r):"v"(a),"v"(b),"v"(c));return r;}
__device__ __forceinline__ float max2f(float a,float b){float r;asm("v_max_f32_e32 %0, %1, %2":"=v"(r):"v"(a),"v"(b));return r;}
__device__ __forceinline__ float fadd_s(float a,float b){float r;asm("v_add_f32_e32 %0, %1, %2":"=v"(r):"v"(a),"v"(b));return r;}
__device__ __forceinline__ float fsub_s(float a,float b){float r;asm("v_sub_f32_e32 %0, %1, %2":"=v"(r):"v"(a),"v"(b));return r;}
typedef float f32x2_t __attribute__((ext_vector_type(2))); typedef float f32x4_t __attribute__((ext_vector_type(4))); typedef __bf16 bf16x2_t __attribute__((ext_vector_type(2)));
__device__ __forceinline__ unsigned cvtpk_s(float lo,float hi){f32x2_t v={lo,hi};bf16x2_t b=__builtin_convertvector(v,bf16x2_t);return __builtin_bit_cast(unsigned,b);}
#define WAIT_BAR(N) asm volatile("s_waitcnt vmcnt(" #N ") lgkmcnt(0)\n\ts_barrier":::"memory")

__device__ __forceinline__ void qkt(f32x16&p0,f32x16&p1,const char*Kslot,const bf16x8*qr,const f32x16&negm,int r32,int hi){
  const char*kb=Kslot+hi*1024+r32*16;
  #pragma unroll
  for(int d0=0;d0<4;++d0){
    const bf16x8 b0=*reinterpret_cast<const bf16x8*>(kb+d0*2048);
    const bf16x8 b1=*reinterpret_cast<const bf16x8*>(kb+d0*2048+512);
    if(d0==0){p0=__builtin_amdgcn_mfma_f32_32x32x16_bf16(b0,qr[0],negm,0,0,0);p1=__builtin_amdgcn_mfma_f32_32x32x16_bf16(b1,qr[0],negm,0,0,0);}
    else{p0=__builtin_amdgcn_mfma_f32_32x32x16_bf16(b0,qr[d0],p0,0,0,0);p1=__builtin_amdgcn_mfma_f32_32x32x16_bf16(b1,qr[d0],p1,0,0,0);}}
}
typedef __attribute__((address_space(3))) const char* lds_cptr;
typedef short v4i16_t __attribute__((ext_vector_type(4)));
__device__ __forceinline__ void kload8(bf16x8*kf,lds_cptr kp){
  kf[0]=*(const __attribute__((address_space(3))) bf16x8*)(kp);      kf[1]=*(const __attribute__((address_space(3))) bf16x8*)(kp+512);
  kf[2]=*(const __attribute__((address_space(3))) bf16x8*)(kp+2048); kf[3]=*(const __attribute__((address_space(3))) bf16x8*)(kp+2560);
  kf[4]=*(const __attribute__((address_space(3))) bf16x8*)(kp+4096); kf[5]=*(const __attribute__((address_space(3))) bf16x8*)(kp+4608);
  kf[6]=*(const __attribute__((address_space(3))) bf16x8*)(kp+6144); kf[7]=*(const __attribute__((address_space(3))) bf16x8*)(kp+6656);
}
__device__ __forceinline__ void kload2(bf16x8*kf,lds_cptr kp,int j){ kf[2*j]=*(const __attribute__((address_space(3))) bf16x8*)(kp+j*2048); kf[2*j+1]=*(const __attribute__((address_space(3))) bf16x8*)(kp+j*2048+512); }
__device__ __forceinline__ s16x4 vtr(lds_cptr p){ return __builtin_bit_cast(s16x4,__builtin_amdgcn_ds_read_tr16_b64_v4i16((__attribute__((address_space(3))) v4i16_t*)p)); }
__device__ __forceinline__ float rowmax(const f32x16&p0,const f32x16&p1){
  float a=max3f(p0[0],p0[1],p1[0]),b=max3f(p0[2],p0[3],p1[1]);a=max3f(a,p1[2],p1[3]);
  #pragma unroll
  for(int r=4;r<16;r+=4){a=max3f(a,p0[r],p0[r+1]);b=max3f(b,p0[r+2],p0[r+3]);a=max3f(a,p1[r],p1[r+1]);b=max3f(b,p1[r+2],p1[r+3]);}
  const float m=max2f(a,b);
  auto rr=__builtin_amdgcn_permlane32_swap(__float_as_uint(m),__float_as_uint(m),false,false);
  return max2f(__uint_as_float(rr[0]),__uint_as_float(rr[1]));
}
__device__ __forceinline__ void pv(f32x16*o,int vb,bf16x8 pa0,bf16x8 pa1,bf16x8 pa2,bf16x8 pa3){
  #pragma unroll
  for(int d0=0;d0<2;++d0){s16x4 lo[4],hi[4];
    #pragma unroll
    for(int ks=0;ks<4;++ks){
      asm volatile("ds_read_b64_tr_b16 %0,%1 offset:%c2":"=&v"(lo[ks]):"v"(vb),"i"(d0*4096+ks*1024):"memory");
      asm volatile("ds_read_b64_tr_b16 %0,%1 offset:%c2":"=&v"(hi[ks]):"v"(vb),"i"(d0*4096+ks*1024+512):"memory");}
    asm volatile("s_waitcnt lgkmcnt(0)":::"memory");SBAR();
    #define PK(k) (bf16x8){lo[k][0],lo[k][1],lo[k][2],lo[k][3],hi[k][0],hi[k][1],hi[k][2],hi[k][3]}
    o[d0]=__builtin_amdgcn_mfma_f32_32x32x16_bf16(pa0,PK(0),o[d0],0,0,0);
    o[d0]=__builtin_amdgcn_mfma_f32_32x32x16_bf16(pa1,PK(1),o[d0],0,0,0);
    o[d0]=__builtin_amdgcn_mfma_f32_32x32x16_bf16(pa2,PK(2),o[d0],0,0,0);
    o[d0]=__builtin_amdgcn_mfma_f32_32x32x16_bf16(pa3,PK(3),o[d0],0,0,0);
    #undef PK
  }
}

#ifndef ATTN_STORE16
#define ATTN_STORE16(p,v) (*(u32x4*)(p)=(v))
#endif
template<int THRL> __device__ __forceinline__ void attn_unit(int b,int h,int qb,const bf16*Q,const bf16*__restrict__ K,const bf16*__restrict__ V,bf16*O,const float*__restrict__ cf,const float Tskip,const int part,float*PART,unsigned*flag,char*shm){
  int tid_=threadIdx.x; asm volatile("":"+v"(tid_));
  const int tid=tid_,lane=tid&63,r32=lane&31,hi=lane>>5; const int wid=__builtin_amdgcn_readfirstlane(tid>>6);
  const long rowbase=(long)b*SEQ; const int q0=qb*QB;
  const bf16*Qw=Q+(rowbase+q0+wid*QBLK)*DM+h*D;
  const unsigned lds0=(unsigned)(uintptr_t)shm;
  float*wsf=(float*)(shm+LDS_WS)+wid*64;
  const unsigned kdst=lds0+LDS_K+wid*1024, vdst=lds0+LDS_V+wid*1024;
  #define DMA_K(t,slot) glds16(ksrc+(long)(t)*KVBLK*DM,(unsigned)__builtin_amdgcn_readfirstlane(kdst+(slot)))
  #define DMA_V(t,slot) glds16(vsrc+(long)(t)*KVBLK*DM,(unsigned)__builtin_amdgcn_readfirstlane(vdst+(slot)))
  const int vb0=(int)(lds0+LDS_V)+((lane>>4)&1)*32+(lane&3)*8+(4*hi+((lane&15)>>2))*64;
  const char*Kbase=shm+LDS_K; bf16x8 kf[8];
  const lds_cptr shm3=(lds_cptr)shm; const lds_cptr kp0=shm3+LDS_K+hi*1024+r32*16; const lds_cptr vp0=shm3+LDS_V+((lane>>4)&1)*32+(lane&3)*8+(4*hi+((lane&15)>>2))*64;
  typedef __attribute__((address_space(3))) float lds_f32; typedef __attribute__((address_space(3))) const f32x4_t* lds_cf4;
  const int NT0=(q0+QB)/KVBLK;
  int tb;
  { const float thr=cf[q0]+Tskip; const int t1=lane,t2=lane+64;
    const bool n1=(t1<NT0)&&(cf[64*t1+63]>thr), n2=(t2<NT0)&&(cf[64*t2+63]>thr);
    const int t0=(int)__popcll(__ballot(n1))+(int)__popcll(__ballot(n2));
    tb=t0&~1; if(tb>NT0-4)tb=NT0-4; tb=__builtin_amdgcn_readfirstlane(tb); }
  int NT=NT0-tb; bool band=true; const bool split=(PART!=nullptr)&&(NT>SPLIT_NT);
  if(PART!=nullptr){ if(!split){ if(part==1)return; } else { const int mid=(NT>>1)&~1; if(part==0){NT=mid;band=false;} else {tb+=mid;NT-=mid;} } }
  { lds_f32* ckw=(lds_f32*)((lds_cptr)shm+LDS_CK); int i0_=tb*KVBLK+tid; asm volatile("":"+v"(i0_)); _Pragma("nounroll") for(int i=i0_;i<q0+QB;i+=NW*64)ckw[i]=cf[i]; }
  const float cq=cf[q0+wid*QBLK+(lane&31)];
  asm volatile("s_waitcnt vmcnt(0) lgkmcnt(0)\n\ts_barrier":::"memory");
  const bf16*Kh=K+(rowbase+(long)tb*KVBLK)*DM+h*D,*Vh=V+(rowbase+(long)tb*KVBLK)*DM+h*D;
  const bf16*ksrc=Kh+(long)lane*DM+wid*8;
  const bf16*vsrc=Vh+(long)(16*(wid&3)+(lane>>2))*DM+(wid>>2)*32+(lane&3)*8;
  const lds_cptr ckl=(lds_cptr)shm+LDS_CK+256*tb+16*(lane>>5);
  #define CBIAS(P0,P1,t) do{ const lds_cptr cb_=ckl+256*(t); _Pragma("unroll") for(int g_=0;g_<4;++g_){ const f32x4_t a_=*(lds_cf4)(cb_+32*g_), b_=*(lds_cf4)(cb_+128+32*g_); \
      _Pragma("unroll") for(int i_=0;i_<4;++i_){ P0[4*g_+i_]-=(a_[i_]+mm); P1[4*g_+i_]-=(b_[i_]+mm); } } }while(0)
  f32x4_t cbA[4],cbB[4]; float clast;
  #define CBLD(t) do{ const lds_cptr cb_=ckl+256*(t); _Pragma("unroll") for(int g_=0;g_<4;++g_){ cbA[g_]=*(lds_cf4)(cb_+32*g_); cbB[g_]=*(lds_cf4)(cb_+128+32*g_); } \
      clast=*(const __attribute__((address_space(3))) float*)((lds_cptr)shm+LDS_CK+256*tb+256*(t)+252); }while(0)
  DMA_K(0,0);DMA_V(0,0);DMA_K(1,SLOTB);
  bf16x8 qr[4];
  #pragma unroll
  for(int d0=0;d0<4;++d0)qr[d0]=*reinterpret_cast<const bf16x8*>(&Qw[(long)r32*DM+d0*16+hi*8]);
  float mhat=0.f,l_reg=0.f;f32x16 o[2];o[0]=f32x16{};o[1]=f32x16{};float mm=-cq; const f32x16 negm=f32x16{};
  const int qrel=wid*QBLK+r32;
  #define CMASK(P0,P1,t) do{int jb_=(t)-(NT-4); if(band&&jb_>=0)cmask(P0,P1,jb_,qrel,hi);}while(0)
  bool resc=false;
  #define START(P0,P1) do{ const float rm=rowmax(P0,P1); resc=false; \
    { const float dl=rm; mhat=fadd_s(mhat,dl); \
      _Pragma("unroll") for(int r=0;r<16;++r){P0[r]=fsub_s(P0[r],dl);P1[r]=fsub_s(P1[r],dl);} \
      mm+=dl; } \
    _Pragma("unroll") for(int r=0;r<16;++r)P0[r]=__builtin_amdgcn_exp2f(P0[r]); }while(0)
  #define RESC() do{ if(resc){ asm volatile("s_waitcnt lgkmcnt(0)":::"memory"); \
      _Pragma("unroll") for(int d_=0;d_<2;++d_) _Pragma("unroll") for(int r=0;r<16;++r)o[d_][r]*=wsf[crow(r,hi)]; } }while(0)
  f32x16 pA0,pA1,pB0,pB1;
  int sl_prev=0,sl_cur=0,sl_next=SLOTB;
  #define ROT() do{sl_prev=sl_cur;sl_cur=sl_next;sl_next=(sl_next==(NSLOT-1)*SLOTB)?0:sl_next+SLOTB;}while(0)
  DMA_K(2,2*SLOTB);
  WAIT_BAR(3);
  qkt(pA0,pA1,Kbase,qr,negm,r32,hi);asm volatile("s_nop 15\n\ts_nop 7":"+v"(pA0),"+v"(pA1));CBIAS(pA0,pA1,0);CMASK(pA0,pA1,0);
  START(pA0,pA1);
  _Pragma("unroll") for(int r=0;r<16;++r)pA1[r]=__builtin_amdgcn_exp2f(pA1[r]);
  WAIT_BAR(0);
  DMA_K(3,0);DMA_V(1,SLOTB);
  ROT();
  kload8(kf,kp0+sl_cur);
  WAIT_BAR(2);
  s16x4 vlo[8],vhi[8]; u32x4 pw0,pw1,pw2,pw3;
  #define PKW(P,B) cvtpk_s(P[B],P[B+1])
  #define PAF(k) __builtin_bit_cast(bf16x8,pw##k)
  #define VFR(i) (bf16x8){vlo[i][0],vlo[i][1],vlo[i][2],vlo[i][3],vhi[i][0],vhi[i][1],vhi[i][2],vhi[i][3]}
  #define PIN(x) asm volatile("":"+v"(x))
  #define MX3(a,b,c) __builtin_fmaxf(__builtin_fmaxf((a),(b)),(c))
  #define GAPA(MF,A0,A1,A2,A3,W0,W1,PW) do{ MF; sacc+=A0; sacc+=A1; sacc+=A2; sacc+=A3; PIN(sacc); W0; W1; PIN(PW); SBAR(); }while(0)
  #define EX(v) __builtin_amdgcn_exp2f(v)
  #define GAPB(MF,X,B,CB) do{ MF; { const f32x4_t t_=(CB)+mm; X[B]=EX(X[B]-t_[0]); X[B+1]=EX(X[B+1]-t_[1]); X[B+2]=EX(X[B+2]-t_[2]); X[B+3]=EX(X[B+3]-t_[3]); } PIN(X); SBAR(); }while(0)
  #define VRD(i) do{ vlo[i]=vtr(vp_+(((i)>>2)*4096+((i)&3)*1024)); vhi[i]=vtr(vp_+(((i)>>2)*4096+((i)&3)*1024+512)); }while(0)
  #define KRD(G,j) do{ if(G){ kload2(kf,kp0+sl_next,j); SBAR(); } }while(0)
  #define STEP(C0,C1,P0,P1,t,GK,GV,GL) do{ SBAR(); \
    const lds_cptr vp_=vp0+sl_prev; \
    VRD(0); SBAR(); float sacc=(P0[0]+P0[1]); \
    GAPA(C0=__builtin_amdgcn_mfma_f32_32x32x16_bf16(kf[0],qr[0],negm,0,0,0), P0[2],P0[3],P0[4],P0[5],     pw0[0]=PKW(P0,0), pw0[1]=PKW(P0,2), pw0); \
    VRD(4); SBAR(); GAPA(C1=__builtin_amdgcn_mfma_f32_32x32x16_bf16(kf[1],qr[0],negm,0,0,0), P0[6],P0[7],P0[8],P0[9],     pw0[2]=PKW(P0,4), pw0[3]=PKW(P0,6), pw0); \
    VRD(1); SBAR(); GAPA(C0=__builtin_amdgcn_mfma_f32_32x32x16_bf16(kf[2],qr[1],C0,0,0,0),   P0[10],P0[11],P0[12],P0[13], pw1[0]=PKW(P0,8), pw1[1]=PKW(P0,10), pw1); \
    VRD(5); SBAR(); GAPA(C1=__builtin_amdgcn_mfma_f32_32x32x16_bf16(kf[3],qr[1],C1,0,0,0),   P0[14],P0[15],P1[0],P1[1],   pw1[2]=PKW(P0,12),pw1[3]=PKW(P0,14), pw1); \
    VRD(2); SBAR(); GAPA(C0=__builtin_amdgcn_mfma_f32_32x32x16_bf16(kf[4],qr[2],C0,0,0,0),   P1[2],P1[3],P1[4],P1[5],     pw2[0]=PKW(P1,0), pw2[1]=PKW(P1,2), pw2); \
    VRD(6); SBAR(); GAPA(C1=__builtin_amdgcn_mfma_f32_32x32x16_bf16(kf[5],qr[2],C1,0,0,0),   P1[6],P1[7],P1[8],P1[9],     pw2[2]=PKW(P1,4), pw2[3]=PKW(P1,6), pw2); \
    VRD(3); SBAR(); GAPA(C0=__builtin_amdgcn_mfma_f32_32x32x16_bf16(kf[6],qr[3],C0,0,0,0),   P1[10],P1[11],P1[12],P1[13], pw3[0]=PKW(P1,8), pw3[1]=PKW(P1,10), pw3); \
    VRD(7); SBAR(); GAPA(C1=__builtin_amdgcn_mfma_f32_32x32x16_bf16(kf[7],qr[3],C1,0,0,0),   P1[14],P1[15],0.f,0.f,       pw3[2]=PKW(P1,12),pw3[3]=PKW(P1,14), pw3); \
    l_reg+=sacc; \
    if(GK){DMA_K((t)+3,sl_cur);} if(GV){DMA_V((t)+1,sl_next);} \
    CBLD(t); CMASK(C0,C1,t); \
    { float a=MX3(C0[0],C0[1],C1[0]),b=MX3(C0[2],C0[3],C1[1]); a=MX3(a,C1[2],C1[3]); \
      _Pragma("unroll") for(int r=4;r<16;r+=4){a=MX3(a,C0[r],C0[r+1]);b=MX3(b,C0[r+2],C0[r+3]);a=MX3(a,C1[r],C1[r+1]);b=MX3(b,C1[r+2],C1[r+3]);} \
      float rm=__builtin_fmaxf(a,b); { auto rr=__builtin_amdgcn_permlane32_swap(__float_as_uint(rm),__float_as_uint(rm),false,false); rm=__builtin_fmaxf(__uint_as_float(rr[0]),__uint_as_float(rr[1])); } rm=rm-clast-mm; \
      resc=false; \
      if(__builtin_expect(__any(rm>(float)THRL),0)){ const float dl=__builtin_fmaxf(rm,0.f); mhat+=dl; \
        mm+=dl; \
        const float f=__builtin_amdgcn_exp2f(-dl); l_reg*=f; if(hi==0)wsf[r32]=f; resc=true; } } \
    SBAR(); \
    GAPB(o[0]=__builtin_amdgcn_mfma_f32_32x32x16_bf16(PAF(0),VFR(0),o[0],0,0,0), C0,0,cbA[0]); \
    GAPB(o[1]=__builtin_amdgcn_mfma_f32_32x32x16_bf16(PAF(0),VFR(4),o[1],0,0,0), C0,4,cbA[1]); \
    KRD(GL,0); GAPB(o[0]=__builtin_amdgcn_mfma_f32_32x32x16_bf16(PAF(1),VFR(1),o[0],0,0,0), C0,8,cbA[2]); \
    KRD(GL,1); GAPB(o[1]=__builtin_amdgcn_mfma_f32_32x32x16_bf16(PAF(1),VFR(5),o[1],0,0,0), C0,12,cbA[3]); \
    KRD(GL,2); GAPB(o[0]=__builtin_amdgcn_mfma_f32_32x32x16_bf16(PAF(2),VFR(2),o[0],0,0,0), C1,0,cbB[0]); \
    KRD(GL,3); GAPB(o[1]=__builtin_amdgcn_mfma_f32_32x32x16_bf16(PAF(2),VFR(6),o[1],0,0,0), C1,4,cbB[1]); \
    GAPB(o[0]=__builtin_amdgcn_mfma_f32_32x32x16_bf16(PAF(3),VFR(3),o[0],0,0,0), C1,8,cbB[2]); \
    GAPB(o[1]=__builtin_amdgcn_mfma_f32_32x32x16_bf16(PAF(3),VFR(7),o[1],0,0,0), C1,12,cbB[3]); \
    }while(0)
  int t=1;
  #undef CMASK
  #define CMASK(P0,P1,t) do{}while(0)
  for(;t+5<NT;t+=2){
    STEP(pB0,pB1,pA0,pA1,t,true,true,true);     WAIT_BAR(2); RESC(); ROT();
    STEP(pA0,pA1,pB0,pB1,t+1,true,true,true);   WAIT_BAR(2); RESC(); ROT();
  }
  #undef CMASK
  #define CMASK(P0,P1,t) do{int jb_=(t)-(NT-4); if(band&&jb_>=0)cmask(P0,P1,jb_,qrel,hi);}while(0)
  #define ENDW(tt) do{ if((tt)+3<NT){WAIT_BAR(2);} else if((tt)+2<NT){WAIT_BAR(1);} else {WAIT_BAR(0);} }while(0)
  for(;t+1<NT;t+=2){
    STEP(pB0,pB1,pA0,pA1,t,(t+3<NT),(t+1<NT),(t+1<NT));       ENDW(t);   RESC(); ROT();
    STEP(pA0,pA1,pB0,pB1,t+1,(t+4<NT),(t+2<NT),(t+2<NT));     ENDW(t+1); RESC(); ROT();
  }
  STEP(pB0,pB1,pA0,pA1,NT-1,false,false,false); RESC();
  { float sacc=pB0[0]+pB0[1]; _Pragma("unroll") for(int r=2;r<16;++r)sacc+=pB0[r]; _Pragma("unroll") for(int r=0;r<16;++r)sacc+=pB1[r]; l_reg+=sacc;
    pw0=(u32x4){PKW(pB0,0),PKW(pB0,2),PKW(pB0,4),PKW(pB0,6)};pw1=(u32x4){PKW(pB0,8),PKW(pB0,10),PKW(pB0,12),PKW(pB0,14)};pw2=(u32x4){PKW(pB1,0),PKW(pB1,2),PKW(pB1,4),PKW(pB1,6)};pw3=(u32x4){PKW(pB1,8),PKW(pB1,10),PKW(pB1,12),PKW(pB1,14)};
    SBAR(); pv(o,vb0+sl_cur,PAF(0),PAF(1),PAF(2),PAF(3)); }
  #undef PKW
  #undef PAF
  #undef VFR
  #undef PIN
  #undef MX3
  #undef GAPA
  #undef GAPB
  #undef EX
  #undef VRD
  #undef KRD
  #undef STEP
  #undef ENDW
  {auto rr=__builtin_amdgcn_permlane32_swap(__float_as_uint(l_reg),__float_as_uint(l_reg),false,false);l_reg=__uint_as_float(rr[0])+__uint_as_float(rr[1]);}
  if(hi==0)wsf[32+r32]=l_reg;asm volatile("s_waitcnt lgkmcnt(0)":::"memory");
  float rli[16];
  if(split){
    float*Pm=PART+(size_t)part*PART_F; const float*Po=PART+(size_t)(1-part)*PART_F;
    #pragma unroll
    for(int r=0;r<16;++r){
      #pragma unroll
      for(int d0=0;d0<2;++d0)Pm[(wid*QBLK+crow(r,hi))*64+d0*32+r32]=o[d0][r];}
    if(hi==0){Pm[QB*64+(wid*QBLK+r32)*2]=mm+cq;Pm[QB*64+(wid*QBLK+r32)*2+1]=l_reg;wsf[r32]=mm+cq;}
    asm volatile("s_waitcnt vmcnt(0) lgkmcnt(0)\n\ts_barrier":::"memory");
    if(tid==0){ __builtin_amdgcn_fence(__ATOMIC_RELEASE,"agent"); asm volatile("s_waitcnt vmcnt(0)":::"memory");
      *(volatile __attribute__((address_space(3))) unsigned*)((__attribute__((address_space(3))) char*)shm+LDS_OST)=__hip_atomic_fetch_add(flag,1u,__ATOMIC_RELAXED,__HIP_MEMORY_SCOPE_AGENT); }
    asm volatile("s_waitcnt vmcnt(0) lgkmcnt(0)\n\ts_barrier":::"memory");
    const unsigned old=*(volatile __attribute__((address_space(3))) unsigned*)((__attribute__((address_space(3))) char*)shm+LDS_OST);
    asm volatile("s_waitcnt lgkmcnt(0)\n\ts_barrier":::"memory");
    if(old==0u)return;
    __builtin_amdgcn_fence(__ATOMIC_ACQUIRE,"agent"); asm volatile("s_waitcnt vmcnt(0)":::"memory");
    #pragma unroll
    for(int r=0;r<16;++r){ const int row=crow(r,hi); const float mo=wsf[row],lo=wsf[32+row],mt=Po[QB*64+(wid*QBLK+row)*2],lt=Po[QB*64+(wid*QBLK+row)*2+1];
      const float m=__builtin_fmaxf(mo,mt),fo=__builtin_amdgcn_exp2f(mo-m),ft=__builtin_amdgcn_exp2f(mt-m),inv=__builtin_amdgcn_rcpf(lo*fo+lt*ft);
      #pragma unroll
      for(int d0=0;d0<2;++d0)o[d0][r]=(o[d0][r]*fo+Po[(wid*QBLK+row)*64+d0*32+r32]*ft)*inv;
      rli[r]=1.f; }
  } else {
  #pragma unroll
  for(int r=0;r<16;++r)rli[r]=__builtin_amdgcn_rcpf(wsf[32+crow(r,hi)]);
  }
  bf16*Ow=O+(rowbase+q0+wid*QBLK)*OPITCH+h*D;
  { bf16*stg=(bf16*)(shm+LDS_OST)+wid*2048;
    #pragma unroll
    for(int r=0;r<16;++r){const int orow=crow(r,hi);
      #pragma unroll
      for(int d0=0;d0<2;++d0)stg[orow*64+d0*32+r32]=__float2bfloat16(o[d0][r]*rli[r]);}
    asm volatile("s_waitcnt lgkmcnt(0)":::"memory");
    #pragma unroll
    for(int i=0;i<4;++i){const int row=i*8+(lane>>3),ch=lane&7; const u32x4 v=*(const u32x4*)(stg+row*64+ch*8); ATTN_STORE16(Ow+(long)row*OPITCH+ch*8,v);} }
  asm volatile("s_waitcnt lgkmcnt(0)\n\ts_barrier":::"memory");
  #undef CBIAS
  #undef CBLD
  #undef DMA_K
  #undef DMA_V
  #undef CMASK
  #undef START
  #undef RESC
  #undef ROT
}
constexpr int ATTN_LDS_BYTES=LDS_BYTES;
struct AttnTensors { const bf16* Q; const bf16* K; const bf16* V; bf16* O; const float* CF; const float* stat; };
struct AttnUnit { int bh; int qb; };
struct StaticOrder {
  int vcu;
  __device__ __forceinline__ explicit StaticOrder(int grid,int block):vcu((grid%8==0)?(block%8)*(grid/8)+block/8:block),G_(grid){}
  int G_;
  __device__ __forceinline__ bool next(int i,AttnUnit&u)const{ const int v=vcu+(i>>1)*G_; if(v>=256)return false; const int s=v&15; u.bh=v>>4; u.qb=(i&1)?31-s:s; return true; }
  __device__ __forceinline__ void a_ready(const AttnUnit&)const{}
  __device__ __forceinline__ void done(const AttnUnit&)const{}
};
struct QueueOrder {
  unsigned* ctr; __attribute__((address_space(3))) unsigned* slot;
  __device__ __forceinline__ bool next(int,AttnUnit&u)const{
    if(threadIdx.x==0)*slot=__hip_atomic_fetch_add(ctr,1u,__ATOMIC_RELAXED,__HIP_MEMORY_SCOPE_AGENT);
    asm volatile("s_waitcnt vmcnt(0) lgkmcnt(0)\n\ts_barrier":::"memory");
    const unsigned v=*(volatile __attribute__((address_space(3))) unsigned*)slot; const int vv=__builtin_amdgcn_readfirstlane((int)v);
    if(vv>=512)return false; u.qb=31-(vv>>4); u.bh=vv&15; return true; }
  __device__ __forceinline__ void a_ready(const AttnUnit&)const{}
  __device__ __forceinline__ void done(const AttnUnit&)const{}
};
template<class Sched,int THRL=8> __device__ __forceinline__ void attn_phase(char*lds,const AttnTensors&T,const Sched&S){
  AttnUnit u;
  for(int i=0;S.next(i,u);++i){ S.a_ready(u); const float Tsk=40.f+2.f*__builtin_sqrtf(T.stat[u.bh*2]*T.stat[u.bh*2+1])*1.01f+1.f;
    attn_unit<THRL>(u.bh/NHEAD,u.bh%NHEAD,u.qb,T.Q,T.K,T.V,T.O,T.CF+(long)u.bh*SEQ,Tsk,0,nullptr,nullptr,lds); S.done(u); }
}
#undef SBAR
#undef WAIT_BAR
}
#define GAS __attribute__((address_space(1)))
#define LAS __attribute__((address_space(3)))
typedef unsigned v4u __attribute__((ext_vector_type(4)));
typedef float f32x4 __attribute__((ext_vector_type(4)));
typedef short bf16x8 __attribute__((ext_vector_type(8)));
typedef GAS unsigned gu32;
typedef GAS unsigned long long gu64;
#define RLX_AGENT __ATOMIC_RELAXED, __HIP_MEMORY_SCOPE_AGENT
#define LDS_WAIT() asm volatile("s_waitcnt lgkmcnt(0)" ::: "memory")
#define VM_WAIT() asm volatile("s_waitcnt vmcnt(0)" ::: "memory")
__device__ __forceinline__ unsigned long long rt() { return __builtin_amdgcn_s_memrealtime(); }
__device__ __forceinline__ unsigned pk2(float lo, float hi) { return (unsigned)f2bf(lo) | ((unsigned)f2bf(hi) << 16); }

#define XB_TMO      128
#define XB_XCNT(j)  (256  + 64 * (j))
#define XB_XSUB(j)  (1280 + 64 * (j))
#define XB_XGEN(j)  (2304 + 64 * (j))
#define XB_TOP      3328
#define XB_TOPGEN   3392
#define XCD_BAR_WORDS 3456
#define XB_SPIN_CAP (1u << 18)

__device__ __forceinline__ unsigned xb_ld(unsigned* p)              { return __hip_atomic_load(p, __ATOMIC_RELAXED, __HIP_MEMORY_SCOPE_AGENT); }
__device__ __forceinline__ unsigned xb_add(unsigned* p, unsigned v) { return __hip_atomic_fetch_add(p, v, __ATOMIC_RELAXED, __HIP_MEMORY_SCOPE_AGENT); }
__device__ __forceinline__ unsigned xb_xcc_id() { return (unsigned)__builtin_amdgcn_s_getreg((3 << 11) | 20) & 0xFu; }
#define XB_SPIN(cond, bar) do { unsigned _sp = 0; while (cond) { __builtin_amdgcn_s_sleep(1); \
    if ((++_sp & 255u) == 0u) { if (xb_ld(&(bar)[XB_TMO])) break; if (_sp > XB_SPIN_CAP) { atomicAdd(&(bar)[XB_TMO], 1u); break; } } } } while (0)

struct XcdBarrier {
    unsigned* bar; unsigned x;
    volatile LAS unsigned* st;
};

__device__ __forceinline__ XcdBarrier xcd_barrier_post(unsigned* bar, volatile LAS unsigned* st) {
    XcdBarrier b; b.bar = bar; b.x = xb_xcc_id(); b.st = st;
    if (threadIdx.x == 0) (void)xb_add(&bar[XB_XCNT(b.x)], 1u);
    return b;
}
__device__ __forceinline__ void xcd_barrier_complete(unsigned* bar, unsigned x, unsigned& nloc, unsigned& nx) {
    const unsigned G = gridDim.x * gridDim.y * gridDim.z;
    unsigned sum, cnt, mine, sp = 0u;
    for (;;) {
        sum = 0u; cnt = 0u; mine = 0u;
#pragma unroll
        for (unsigned j = 0; j < 16; ++j) { const unsigned c = xb_ld(&bar[XB_XCNT(j)]); sum += c; cnt += (c > 0u) ? 1u : 0u; mine = (j == x) ? c : mine; }
        if (sum == G) break;
        __builtin_amdgcn_s_sleep(1);
        if ((++sp & 255u) == 0u) { if (xb_ld(&bar[XB_TMO])) break; if (sp > XB_SPIN_CAP) { atomicAdd(&bar[XB_TMO], 1u); break; } }
    }
    nloc = mine > 0u ? mine : 1u; nx = cnt > 0u ? cnt : 1u;
}

__device__ __forceinline__ void xcd_barrier(const XcdBarrier& b) {
    asm volatile("s_waitcnt vmcnt(0)" ::: "memory");
    __syncthreads();
    if (threadIdx.x == 0) {
        unsigned* bar = b.bar;
        __builtin_amdgcn_s_waitcnt(0);
        unsigned nloc = b.st[0], nx = b.st[1];
        if (nloc == 0u) { xcd_barrier_complete(bar, b.x, nloc, nx); b.st[0] = nloc; b.st[1] = nx; }
        const unsigned old = xb_add(&bar[XB_XSUB(b.x)], 1u);
        const unsigned gen = old / nloc;
        if (old + 1u == (gen + 1u) * nloc) {
            __builtin_amdgcn_fence(__ATOMIC_RELEASE, "agent");
            asm volatile("s_waitcnt vmcnt(0)" ::: "memory");
            const unsigned og = xb_add(&bar[XB_TOP], 1u);
            const unsigned tg = og / nx;
            if (og + 1u == (tg + 1u) * nx) xb_add(&bar[XB_TOPGEN], 1u);
            else XB_SPIN(xb_ld(&bar[XB_TOPGEN]) == tg, bar);
            __builtin_amdgcn_fence(__ATOMIC_ACQUIRE, "agent");
            xb_add(&bar[XB_XGEN(b.x)], 1u);
            asm volatile("s_waitcnt vmcnt(0)" ::: "memory");
        } else {
            XB_SPIN(xb_ld(&bar[XB_XGEN(b.x)]) == gen, bar);
            __builtin_amdgcn_fence(__ATOMIC_ACQUIRE, "agent");
            asm volatile("s_waitcnt vmcnt(0)" ::: "memory");
        }
    }
    __syncthreads();
}
constexpr int NWAVES = 8, NTHR = 512;
constexpr int RING_OFF = 0, RING_BYTES = 131072, LDSCTL_OFF = RING_BYTES, MISC_OFF = LDSCTL_OFF + 320, LDS_BYTES = 147456;
constexpr int CW_BAR = 4096;
constexpr size_t WS_WIN = WS_W  , WS_SWIN = WS_W + 8 * MiB  , WS_WOUT = WS_W + 14 * MiB  , WS_WDGU = WS_W + 18 * MiB  , WS_SWDGU = WS_W + 24 * MiB  , WS_WDDN = WS_W + 29 * MiB  ;
constexpr size_t WS_SH = WS_H + 16 * MiB  , WS_SXG = WS_XG + 34 * MiB  ;
constexpr size_t WS_WMGU = WS_W  , WS_SWMGU = WS_W + 60 * MiB  , WS_WMDN = WS_W + 64 * MiB  ;
static_assert(WS_WMDN + 56 * MiB <= 469 * MiB, "ws");
struct MArgs { const float* in[20]; float* out; unsigned char* ws; int ph_lo, ph_hi; };
enum { I_X = 0, I_ATTN_NORM, I_W_IN, I_HGRN_LB, I_HGRN_NORM, I_MLSTM_CONV, I_MLSTM_BI, I_MLSTM_BF, I_MLSTM_NORM, I_FOX_BF, I_W_OUT, I_FFN_NORM, I_DGATE, I_DUP, I_DDOWN, I_ROUTER, I_MGATE, I_MUP, I_MDOWN, I_FINAL_NORM };

__device__ __forceinline__ void tr_item(const float* W, int ldw, int K, bf16_t* WT, LAS float* scr, int k0, int lane) {
#pragma unroll 32
    for (int i = 0; i < 32; ++i) { const int kk = 2 * i + (lane >> 5); scr[kk * 33 + (lane & 31)] = W[(size_t)(k0 + kk) * ldw + (lane & 31)]; }
    LDS_WAIT(); asm volatile("" ::: "memory");
    const int c = lane & 7;
#pragma unroll
    for (int j = 0; j < 4; ++j) { const int n = (lane >> 3) + 8 * j; const LAS float* s = scr + (8 * c) * 33 + n;
        v4u o; o.x = pk2(s[0 * 33], s[1 * 33]); o.y = pk2(s[2 * 33], s[3 * 33]); o.z = pk2(s[4 * 33], s[5 * 33]); o.w = pk2(s[6 * 33], s[7 * 33]);
        *(GAS v4u*)(WT + (size_t)n * K + k0 + 8 * c) = o; }
    LDS_WAIT(); asm volatile("" ::: "memory");
}
__device__ __forceinline__ int glu_row(int c, int up) { return (c >> 7) * 256 + (c & 127) + up * 128; }

struct RowIn { float4 v[4]; };
__device__ __forceinline__ void mrow_load(RowIn& R, const float* src, int row, int lane) { const float4* xr = (const float4*)(src + (size_t)row * D) + lane;
#pragma unroll
    for (int j = 0; j < 4; ++j) R.v[j] = xr[64 * j]; }
template <int MODE> __device__ __forceinline__ void mrow(const RowIn& R, const float* src, float* X, signed char* H8, float* SH, const float* gain, const LAS float* tab, float* G, int row, int lane, float (&lg)[8]) {
    float4 v[4]; float ss = 0.f;
#pragma unroll
    for (int j = 0; j < 4; ++j) { v[j] = R.v[j]; ss += v[j].x * v[j].x + v[j].y * v[j].y + v[j].z * v[j].z + v[j].w * v[j].w; }
    ss = wave_sum(ss);
    const float r = rsqrtf(ss * (1.f / D) + EPS);
    if (X != src) { float4* xo = (float4*)(X + (size_t)row * D) + lane;
#pragma unroll
        for (int j = 0; j < 4; ++j) xo[64 * j] = v[j]; }
    float h[16];
#pragma unroll
    for (int j = 0; j < 4; ++j) { const float4 g = *((const float4*)gain + 64 * j + lane);
        h[4 * j + 0] = v[j].x * r * g.x; h[4 * j + 1] = v[j].y * r * g.y; h[4 * j + 2] = v[j].z * r * g.z; h[4 * j + 3] = v[j].w * r * g.w; }
    { float am = 0.f;
#pragma unroll
      for (int i = 0; i < 16; ++i) am = fmaxf(am, fabsf(h[i]));
#pragma unroll
      for (int o = 1; o < 64; o <<= 1) am = fmaxf(am, __shfl_xor(am, o));
      const float inv = am > 0.f ? 127.f / am : 0.f;
#pragma unroll
      for (int j = 0; j < 4; ++j) { const int q0 = (int)rintf(h[4 * j] * inv), q1 = (int)rintf(h[4 * j + 1] * inv), q2 = (int)rintf(h[4 * j + 2] * inv), q3 = (int)rintf(h[4 * j + 3] * inv);
          *((unsigned*)(H8 + (size_t)row * D) + 64 * j + lane) = (unsigned)(q0 & 255) | ((unsigned)(q1 & 255) << 8) | ((unsigned)(q2 & 255) << 16) | ((unsigned)(q3 & 255) << 24); }
      if (lane == 0) SH[row] = am > 0.f ? am * (1.f / 127.f) : 1.f; }
    if (MODE == 0) {
        float mine = 0.f;
#pragma unroll 2
        for (int c = 0; c < 16; ++c) { float s = 0.f;
#pragma unroll
            for (int j = 0; j < 4; ++j) { const f32x4 w = *(const LAS f32x4*)(tab + c * 1024 + 256 * j + 4 * lane); s += h[4 * j] * w[0] + h[4 * j + 1] * w[1] + h[4 * j + 2] * w[2] + h[4 * j + 3] * w[3]; }
            s = wave_sum(s); if (lane == c) mine = s; }
        if (lane < 16) G[(size_t)row * GW + lane] = mine;
    }
    if (MODE == 2) {
        float v0 = -INFINITY, v1 = -INFINITY; int e0 = 0, e1 = 0;
#pragma unroll 2
        for (int c = 0; c < 8; ++c) { float s = 0.f;
#pragma unroll
            for (int j = 0; j < 4; ++j) { const f32x4 w = *(const LAS f32x4*)(tab + c * 1024 + 256 * j + 4 * lane); s += h[4 * j] * w[0] + h[4 * j + 1] * w[1] + h[4 * j + 2] * w[2] + h[4 * j + 3] * w[3]; }
            s = wave_sum(s);
            if (s > v0) { v1 = v0; e1 = e0; v0 = s; e0 = c; } else if (s > v1) { v1 = s; e1 = c; } }
        lg[0] = v0; lg[1] = v1; lg[2] = __int_as_float(e0); lg[3] = __int_as_float(e1);
    }
}
__device__ __forceinline__ void load_gate_tab(LAS float* tab, const float* w_in, int tid) {
    for (int k = tid; k < D; k += NTHR) { const float4* w0 = (const float4*)(w_in + (size_t)k * DIN + 1792); const float4* w1 = (const float4*)(w_in + (size_t)k * DIN + 3592);
        const float4 a0 = w0[0], a1 = w0[1], b0 = w1[0], b1 = w1[1];
        tab[0 * 1024 + k] = a0.x; tab[1 * 1024 + k] = a0.y; tab[2 * 1024 + k] = a0.z; tab[3 * 1024 + k] = a0.w; tab[4 * 1024 + k] = a1.x; tab[5 * 1024 + k] = a1.y; tab[6 * 1024 + k] = a1.z; tab[7 * 1024 + k] = a1.w;
        tab[8 * 1024 + k] = b0.x; tab[9 * 1024 + k] = b0.y; tab[10 * 1024 + k] = b0.z; tab[11 * 1024 + k] = b0.w; tab[12 * 1024 + k] = b1.x; tab[13 * 1024 + k] = b1.y; tab[14 * 1024 + k] = b1.z; tab[15 * 1024 + k] = b1.w; }
}
__device__ __forceinline__ void load_router_tab(LAS float* tab, const float* router, int tid) {
    for (int k = tid; k < D; k += NTHR) { const float4* w0 = (const float4*)(router + (size_t)k * NE); const float4 a0 = w0[0], a1 = w0[1];
        tab[0 * 1024 + k] = a0.x; tab[1 * 1024 + k] = a0.y; tab[2 * 1024 + k] = a0.z; tab[3 * 1024 + k] = a0.w; tab[4 * 1024 + k] = a1.x; tab[5 * 1024 + k] = a1.y; tab[6 * 1024 + k] = a1.z; tab[7 * 1024 + k] = a1.w; }
}
__device__ __forceinline__ void conv8_block(const float* W, int ldw, signed char* WT8, float* S, LAS float* img, LAS float* pm, int tid, int wave) {
    const int lane = tid & 63, n = lane & 31, kp = lane >> 5;
    float m = 0.f;
#pragma unroll 32
    for (int i = 0; i < 64; ++i) { const int k = 128 * wave + 2 * i + kp; const float v = W[(size_t)k * ldw + n]; img[k * 32 + n] = v; m = fmaxf(m, fabsf(v)); }
    m = fmaxf(m, __shfl_xor(m, 32));
    if (lane < 32) pm[wave * 32 + lane] = m;
    __syncthreads();
    const int no = lane >> 1, kh = 128 * wave + 64 * (lane & 1);
    float cm = 0.f;
#pragma unroll
    for (int w = 0; w < 8; ++w) cm = fmaxf(cm, pm[w * 32 + no]);
    const float inv = cm > 0.f ? 127.f / cm : 0.f;
    if (wave == 0 && (lane & 1) == 0) S[no] = cm > 0.f ? cm * (1.f / 127.f) : 1.f;
    const LAS float* sp = img + kh * 32 + no;
#pragma unroll
    for (int q = 0; q < 4; ++q) { unsigned wq[4];
#pragma unroll
        for (int j = 0; j < 4; ++j) { const int kk = 16 * q + 4 * j; const int q0 = (int)rintf(sp[kk * 32] * inv), q1 = (int)rintf(sp[(kk + 1) * 32] * inv), q2 = (int)rintf(sp[(kk + 2) * 32] * inv), q3 = (int)rintf(sp[(kk + 3) * 32] * inv);
            wq[j] = (unsigned)(q0 & 255) | ((unsigned)(q1 & 255) << 8) | ((unsigned)(q2 & 255) << 16) | ((unsigned)(q3 & 255) << 24); }
        v4u o; o.x = wq[0]; o.y = wq[1]; o.z = wq[2]; o.w = wq[3];
        *(GAS v4u*)(WT8 + (size_t)no * 1024 + kh + 16 * q) = o; }
    __syncthreads();
}
namespace scan {
typedef short bf16x8 __attribute__((ext_vector_type(8)));
typedef float f32x4 __attribute__((ext_vector_type(4)));
typedef unsigned v2u __attribute__((ext_vector_type(2)));
constexpr int TS = 144, TB = 64 * TS;
constexpr int L_T0 = 0, L_T1 = TB, L_T2 = 2 * TB, L_T3 = 3 * TB, L_T4 = 4 * TB, L_T5 = 5 * TB, L_O = 6 * TB, OS = 68  , L_PART = L_O + 64 * OS * 4, L_VEC = L_PART + 8 * 64 * 4, L_END = L_VEC + 8 * 64 * 4;
static_assert(L_END <= RING_BYTES, "scan LDS");
constexpr size_t SC_LHG = 0, SC_LML = 16 * MiB, SC_DEC = 32 * MiB  , SC_NL = 32 * MiB + 256 * 1024  , SC_AMAX = 32 * MiB + 512 * 1024, SC_BEND = SC_AMAX + 4096, SC_MPREV = SC_BEND + 4096;

__device__ __forceinline__ float wave_incl_add(float v, int lane) {
#pragma unroll
    for (int o = 1; o < 64; o <<= 1) { const float u = __shfl_up(v, o); if (lane >= o) v += u; }
    return v;
}
__device__ __forceinline__ float wave_incl_max(float v, int lane) {
#pragma unroll
    for (int o = 1; o < 64; o <<= 1) { const float u = __shfl_up(v, o); if (lane >= o) v = fmaxf(v, u); }
    return v;
}
__device__ __forceinline__ float wave_max(float v) {
#pragma unroll
    for (int o = 1; o < 64; o <<= 1) v = fmaxf(v, __shfl_xor(v, o));
    return v;
}
__device__ __forceinline__ f32x4 mma64(LAS const unsigned char* A, LAS const unsigned char* B, int m0, int n0, int lane, f32x4 acc) {
    const int r = lane & 15, kq = lane >> 4;
#pragma unroll
    for (int ks = 0; ks < 2; ++ks) {
        const bf16x8 a = *(LAS const bf16x8*)(A + (m0 + r) * TS + kq * 16 + ks * 64);
        const bf16x8 b = *(LAS const bf16x8*)(B + (n0 + r) * TS + kq * 16 + ks * 64);
        acc = __builtin_amdgcn_mfma_f32_16x16x32_bf16(a, b, acc, 0, 0, 0);
    }
    return acc;
}
__device__ __forceinline__ v4u pack8(const float (&v)[8]) { v4u w; w.x = pk2(v[0], v[1]); w.y = pk2(v[2], v[3]); w.z = pk2(v[4], v[5]); w.w = pk2(v[6], v[7]); return w; }
__device__ __forceinline__ v4u pack8h(const bf16_t (&v)[8]) { v4u w; w.x = v[0] | ((unsigned)v[1] << 16); w.y = v[2] | ((unsigned)v[3] << 16); w.z = v[4] | ((unsigned)v[5] << 16); w.w = v[6] | ((unsigned)v[7] << 16); return w; }
__device__ __forceinline__ void st16(LAS unsigned char* p, float v) { *(LAS bf16_t*)p = f2bf(v); }
__device__ __forceinline__ void load_state_tile(LAS unsigned char* T, const float* S, int tid) {
    const int v = tid >> 3, d0 = (tid & 7) * 8; const float4 x0 = *(const float4*)(S + v * 64 + d0), x1 = *(const float4*)(S + v * 64 + d0 + 4);
    v4u w; w.x = pk2(x0.x, x0.y); w.y = pk2(x0.z, x0.w); w.z = pk2(x1.x, x1.y); w.w = pk2(x1.z, x1.w);
    *(LAS v4u*)(T + v * TS + d0 * 2) = w;
}
__device__ __forceinline__ void local_state_mma_store(LAS unsigned char* L, float* LT, int wave, int lane) {
    const int mt = wave >> 1;
#pragma unroll
    for (int nn = 0; nn < 2; ++nn) { const int nt = 2 * (wave & 1) + nn; f32x4 acc = {0.f, 0.f, 0.f, 0.f};
        acc = mma64(L + L_T1, L + L_T0, mt * 16, nt * 16, lane, acc);
#pragma unroll
        for (int r = 0; r < 4; ++r) LT[(mt * 16 + 4 * (lane >> 4) + r) * 64 + nt * 16 + (lane & 15)] = acc[r]; }
}

struct HgIn { bf16_t fz[8], q[8], iv[8]; v4u gate; float4 s0, s1; };
template <bool DPH> __device__ __forceinline__ void hgrn_load(HgIn& R, const bf16_t* P, int b, int c, int h, const float* ST, int tid, int wave) {
    const int d = tid & 63, tq = wave, row0 = b * SEQ + c * 64; const bf16_t* pr = P + (size_t)(row0 + 8 * tq) * PW + h * 64 + d;
#pragma unroll
    for (int i = 0; i < 8; ++i) { R.fz[i] = pr[(size_t)i * PW + P_HF]; R.iv[i] = pr[(size_t)i * PW + P_HI]; if (DPH) R.q[i] = pr[(size_t)i * PW + P_HQ]; }
    if (DPH) { const int t = tid >> 3, v0 = (tid & 7) * 8; R.gate = *(const v4u*)(P + (size_t)(row0 + t) * PW + P_HG + h * 64 + v0);
        R.s0 = *(const float4*)(ST + t * 64 + v0); R.s1 = *(const float4*)(ST + t * 64 + v0 + 4); }
}
struct MlIn { bf16_t qr[11], kr[11], vv[8]; float ig, fg, np, mprev; v4u gate; float4 s0, s1; };
template <bool DPH> __device__ __forceinline__ void mlstm_load(MlIn& R, const bf16_t* P, const float* G, int b, int c, int h, const float* CT, const float* NP, const float* MP, int tid, int wave) {
    const int d = tid & 63, tq = wave, lane = tid & 63, row0 = b * SEQ + c * 64; const bool fz3 = (c == 0 && tq == 0);
    const bf16_t* pk = P + (size_t)(row0 + 8 * tq) * PW + P_MK + h * 64 + d; const bf16_t* pq = P + (size_t)(row0 + 8 * tq) * PW + P_MQ + h * 64 + d;
#pragma unroll
    for (int j = 0; j < 11; ++j) { R.kr[j] = (j < 3 && fz3) ? (bf16_t)0 : pk[((long)j - 3) * PW]; if (DPH) R.qr[j] = (j < 3 && fz3) ? (bf16_t)0 : pq[((long)j - 3) * PW]; }
#pragma unroll
    for (int i = 0; i < 8; ++i) R.vv[i] = P[(size_t)(row0 + 8 * tq + i) * PW + P_MV + h * 64 + d];
    R.ig = G[(size_t)(row0 + lane) * GW + h]; R.fg = G[(size_t)(row0 + lane) * GW + 4 + h];
    if (DPH) { const int t = tid >> 3, v0 = (tid & 7) * 8; R.gate = *(const v4u*)(P + (size_t)(row0 + t) * PW + P_MO + h * 64 + v0);
        R.s0 = *(const float4*)(CT + t * 64 + v0); R.s1 = *(const float4*)(CT + t * 64 + v0 + 4); R.np = NP[lane]; R.mprev = MP[0]; }
}
__device__ __forceinline__ void store_state_tile(LAS unsigned char* T, const float4& x0, const float4& x1, int tid) {
    const int v = tid >> 3, d0 = (tid & 7) * 8; v4u w; w.x = pk2(x0.x, x0.y); w.y = pk2(x0.z, x0.w); w.z = pk2(x1.x, x1.y); w.w = pk2(x1.z, x1.w);
    *(LAS v4u*)(T + v * TS + d0 * 2) = w;
}
__device__ __forceinline__ void conv_silu8r(const bf16_t (&raw)[11], const float* w4  , float scale, float (&out)[8]) {
    const float w0 = w4[0], w1 = w4[512], w2 = w4[1024], w3 = w4[1536];
#pragma unroll
    for (int i = 0; i < 8; ++i) out[i] = siluf_(w0 * bf2f(raw[i]) + w1 * bf2f(raw[i + 1]) + w2 * bf2f(raw[i + 2]) + w3 * bf2f(raw[i + 3])) * scale;
}
__device__ __forceinline__ void hgrn_b_item(LAS unsigned char* L, const HgIn& R, float lb, float* LT, float* DEC, int tid, int wave) {
    const int d = tid & 63, tq = wave;
    float bl[8], kh[8]; float run = 0.f;
#pragma unroll
    for (int i = 0; i < 8; ++i) { const float fz = bf2f(R.fz[i]);
        const float sg = sigmoidf_(fz), f = lb + (1.f - lb) * sg; kh[i] = (1.f - lb) * (1.f - sg); run += __logf(f); bl[i] = run; }
    LAS float* part = (LAS float*)(L + L_PART);
    part[tq * 64 + d] = run; __syncthreads();
    float off = 0.f, btot = 0.f;
#pragma unroll
    for (int w = 0; w < 8; ++w) { const float pv = part[w * 64 + d]; btot += pv; if (w < tq) off += pv; }
#pragma unroll
    for (int i = 0; i < 8; ++i) kh[i] *= __expf(btot - (off + bl[i]));
    *(LAS v4u*)(L + L_T0 + d * TS + tq * 16) = pack8(kh);
    *(LAS v4u*)(L + L_T1 + d * TS + tq * 16) = pack8h(R.iv);
    if (tq == 0) DEC[d] = __expf(btot);
    __syncthreads();
    local_state_mma_store(L, LT, wave, tid & 63);
    __syncthreads();
}
__device__ __forceinline__ void mlstm_gates(float ig, float fg, const float* b_i, const float* b_f, int h, int lane, float& bcum, float& a) {
    bcum = wave_incl_add(log_sigmoidf_(fg + b_f[h]), lane); a = ig + b_i[h] - bcum;
}
__device__ __forceinline__ void mlstm_b_item(LAS unsigned char* L, const MlIn& R, const float* conv, const float* b_i, const float* b_f, int h, float* LT, float* NL, float* AMAX, float* BEND, int tid, int wave) {
    const int d = tid & 63, tq = wave, lane = tid & 63;
    float bcum, a; mlstm_gates(R.ig, R.fg, b_i, b_f, h, lane, bcum, a);
    const float A = wave_max(a), bend = __shfl(bcum, 63);
    float kh[8]; conv_silu8r(R.kr, conv + 256 + h * 64 + d, 0.125f, kh);
    float nsum = 0.f;
#pragma unroll
    for (int i = 0; i < 8; ++i) { kh[i] *= __expf(__shfl(a, 8 * tq + i) - A); nsum += bf2f(f2bf(kh[i])); }
    *(LAS v4u*)(L + L_T0 + d * TS + tq * 16) = pack8(kh);
    *(LAS v4u*)(L + L_T1 + d * TS + tq * 16) = pack8h(R.vv);
    LAS float* part = (LAS float*)(L + L_PART); part[tq * 64 + d] = nsum;
    __syncthreads();
    if (tq == 0) { float s = 0.f;
#pragma unroll
        for (int w = 0; w < 8; ++w) s += part[w * 64 + d];
        NL[d] = s; if (lane == 0) { AMAX[0] = A; BEND[0] = bend; } }
    local_state_mma_store(L, LT, wave, lane);
    __syncthreads();
}
__device__ __forceinline__ void fox_cumsum_item(LAS unsigned char* L, const float* G, const float* fox_bf, float* CF, int bh, int tid, int wave) {
    const int b = bh >> 3, h = bh & 7, lane = tid & 63; const float bf = fox_bf[h];
    float loc[16]; float s = 0.f;
#pragma unroll
    for (int i = 0; i < 16; ++i) { s += log_sigmoidf_(G[((size_t)b * SEQ + tid * 16 + i) * GW + 8 + h] + bf); loc[i] = s; }
    const float incl = wave_incl_add(s, lane);
    LAS float* wt = (LAS float*)(L + L_PART);
    if (lane == 63) wt[wave] = incl;
    __syncthreads();
    float off = incl - s;
#pragma unroll
    for (int w = 0; w < 8; ++w) if (w < wave) off += wt[w];
#pragma unroll
    for (int i = 0; i < 16; ++i) CF[(size_t)bh * SEQ + tid * 16 + i] = (off + loc[i]) * LOG2E;
    __syncthreads();
}

template <bool DUMMY = false> __device__ __forceinline__ void scan_c_block(unsigned char* sc, int j, int tid) {
    constexpr size_t DOFF = DUMMY ? 104 * MiB / 4 : 0;
    constexpr int CB = 16;
    if (j < 128) {
        if (tid < 256) { const int chain = j >> 4, e = (j & 15) * 256 + tid, b = chain >> 2, h = chain & 3;
            float* p = (float*)(sc + SC_LHG) + ((size_t)(b * 128) * 4 + h) * 4096 + e; const float* dp = (const float*)(sc + SC_DEC) + ((size_t)(b * 128) * 4 + h) * 64 + (e & 63);
            float S = 0.f;
            for (int c0 = 0; c0 < 128; c0 += CB) { float Lc[CB], dc[CB];
#pragma unroll
                for (int i = 0; i < CB; ++i) { Lc[i] = p[(size_t)(c0 + i) * 4 * 4096]; dc[i] = dp[(size_t)(c0 + i) * 4 * 64]; }
#pragma unroll
                for (int i = 0; i < CB; ++i) { const float So = S; S = dc[i] * S + Lc[i]; Lc[i] = So; }
#pragma unroll
                for (int i = 0; i < CB; ++i) (p + DOFF)[(size_t)(c0 + i) * 4 * 4096] = Lc[i]; } }
    } else {
        const int jj = j - 128, chain = jj >> 4, part = jj & 15, b = chain >> 2, h = chain & 3;
        if (tid < 260) { const bool isn = tid >= 256; const size_t it0 = (size_t)(b * 128) * 4 + h;
            float* p = isn ? (float*)(sc + SC_NL) + it0 * 64 + part * 4 + (tid - 256) : (float*)(sc + SC_LML) + it0 * 4096 + part * 256 + tid;
            const size_t stride = isn ? 4 * 64 : 4 * 4096;
            const float* am = (const float*)(sc + SC_AMAX) + it0; const float* be = (const float*)(sc + SC_BEND) + it0; float* mp = (float*)(sc + SC_MPREV) + it0;
            const bool writer = (part == 0 && tid == 0);
            float S = 0.f, m = 0.f;
            for (int c0 = 0; c0 < 128; c0 += CB) { float Lc[CB], A[CB], bb[CB];
#pragma unroll
                for (int i = 0; i < CB; ++i) { Lc[i] = p[(size_t)(c0 + i) * stride]; A[i] = am[(c0 + i) * 4]; bb[i] = be[(c0 + i) * 4]; }
#pragma unroll
                for (int i = 0; i < CB; ++i) { const float Mx = fmaxf(m, A[i]), So = S; S = __expf(m - Mx) * S + __expf(A[i] - Mx) * Lc[i]; Lc[i] = So; A[i] = m; m = bb[i] + Mx; }
#pragma unroll
                for (int i = 0; i < CB; ++i) { (p + DOFF)[(size_t)(c0 + i) * stride] = Lc[i]; if (writer) (mp + DOFF)[(c0 + i) * 4] = A[i]; } } }
    }
}

template <bool SIG> __device__ __forceinline__ void head_epilogue(LAS unsigned char* L, float inv, const v4u& gw  , const float* gain  , bf16_t* out  , int tid) {
    const int t = tid >> 3, v0 = (tid & 7) * 8; const LAS float* o = (const LAS float*)(L + L_O) + t * OS + v0;
    float x[8]; float ss = 0.f;
#pragma unroll
    for (int i = 0; i < 8; ++i) { x[i] = o[i] * inv; ss += x[i] * x[i]; }
    ss += __shfl_xor(ss, 1); ss += __shfl_xor(ss, 2); ss += __shfl_xor(ss, 4);
    const float r = rsqrtf(ss * (1.f / 64.f) + EPS);
    const unsigned gu[4] = {gw.x, gw.y, gw.z, gw.w};
    float y[8];
#pragma unroll
    for (int i = 0; i < 8; ++i) { const float gz = bf2f((bf16_t)((gu[i >> 1] >> (16 * (i & 1))) & 0xffff)); y[i] = x[i] * r * gain[i] * (SIG ? sigmoidf_(gz) : siluf_(gz)); }
    *(v4u*)out = pack8(y);
}
__device__ __forceinline__ void store_o_tiles(LAS unsigned char* L, LAS const unsigned char* A1, LAS const unsigned char* B1, LAS const unsigned char* A2, LAS const unsigned char* B2, int wave, int lane) {
    const int mt = wave >> 1;
#pragma unroll
    for (int nn = 0; nn < 2; ++nn) { const int nt = 2 * (wave & 1) + nn; f32x4 acc = {0.f, 0.f, 0.f, 0.f};
        acc = mma64(A1, B1, mt * 16, nt * 16, lane, acc); acc = mma64(A2, B2, mt * 16, nt * 16, lane, acc);
        LAS float* o = (LAS float*)(L + L_O);
#pragma unroll
        for (int r = 0; r < 4; ++r) o[(mt * 16 + 4 * (lane >> 4) + r) * OS + nt * 16 + (lane & 15)] = acc[r]; }
}
__device__ __forceinline__ void hgrn_d_item(LAS unsigned char* L, const HgIn& R, float lb, const float* gain  , bf16_t* out  , int tid, int wave) {
    const int d = tid & 63, tq = wave, lane = tid & 63;
    float bl[8], kk[8], q[8]; float run = 0.f;
#pragma unroll
    for (int i = 0; i < 8; ++i) { const float fz = bf2f(R.fz[i]); q[i] = bf2f(R.q[i]);
        const float sg = sigmoidf_(fz), f = lb + (1.f - lb) * sg; kk[i] = (1.f - lb) * (1.f - sg); run += __logf(f); bl[i] = run; }
    LAS float* part = (LAS float*)(L + L_PART);
    part[tq * 64 + d] = run;
    store_state_tile(L + L_T4, R.s0, R.s1, tid);
    *(LAS v4u*)(L + L_T3 + d * TS + tq * 16) = pack8h(R.iv);
    __syncthreads();
    float off = 0.f, bref = 0.f;
#pragma unroll
    for (int w = 0; w < 8; ++w) { const float pv = part[w * 64 + d]; if (w < 4) bref += pv; if (w < tq) off += pv; }
#pragma unroll
    for (int i = 0; i < 8; ++i) { const float bb = off + bl[i]; const int t = 8 * tq + i;
        st16(L + L_T0 + t * TS + d * 2, q[i] * __expf(bb - bref));
        st16(L + L_T1 + t * TS + d * 2, kk[i] * __expf(bref - bb));
        st16(L + L_T2 + t * TS + d * 2, q[i] * __expf(bb)); }
    __syncthreads();
    { const int mt = wave >> 1;
#pragma unroll
      for (int nn = 0; nn < 2; ++nn) { const int nt = 2 * (wave & 1) + nn; f32x4 acc = {0.f, 0.f, 0.f, 0.f};
          acc = mma64(L + L_T1, L + L_T0, mt * 16, nt * 16, lane, acc);
          const int s0 = mt * 16 + 4 * (lane >> 4), t = nt * 16 + (lane & 15);
          v2u w; w.x = pk2(s0 <= t ? acc[0] : 0.f, s0 + 1 <= t ? acc[1] : 0.f); w.y = pk2(s0 + 2 <= t ? acc[2] : 0.f, s0 + 3 <= t ? acc[3] : 0.f);
          *(LAS v2u*)(L + L_T5 + t * TS + s0 * 2) = w; } }
    __syncthreads();
    store_o_tiles(L, L + L_T5, L + L_T3, L + L_T2, L + L_T4, wave, lane);
    __syncthreads();
    { const int t = tid >> 3, v0 = (tid & 7) * 8; head_epilogue<false>(L, 1.f, R.gate, gain + v0, out + (size_t)t * D + v0, tid); }
    __syncthreads();
}
__device__ __forceinline__ void mlstm_d_item(LAS unsigned char* L, const MlIn& R, const float* conv, const float* b_i, const float* b_f, const float* gain  , int h, bf16_t* out  , int tid, int wave) {
    const int d = tid & 63, tq = wave, lane = tid & 63; const float mprev = R.mprev;
    float bcum, a; mlstm_gates(R.ig, R.fg, b_i, b_f, h, lane, bcum, a);
    const float M = fmaxf(wave_incl_max(a, lane), mprev), sint = __expf(mprev - M);
    LAS float* vec = (LAS float*)(L + L_VEC);
    if (wave == 0) { vec[lane] = a; vec[64 + lane] = M; vec[128 + lane] = __expf(-bcum - M); vec[192 + lane] = R.np; }
    float qc[8], kc[8];
    conv_silu8r(R.qr, conv + h * 64 + d, 1.f, qc);
    conv_silu8r(R.kr, conv + 256 + h * 64 + d, 0.125f, kc);
#pragma unroll
    for (int i = 0; i < 8; ++i) { const int t = 8 * tq + i;
        st16(L + L_T0 + t * TS + d * 2, qc[i]);
        st16(L + L_T1 + t * TS + d * 2, kc[i]);
        st16(L + L_T2 + t * TS + d * 2, qc[i] * __shfl(sint, t)); }
    *(LAS v4u*)(L + L_T3 + d * TS + tq * 16) = pack8h(R.vv);
    store_state_tile(L + L_T4, R.s0, R.s1, tid);
    __syncthreads();
    { const int mt = wave >> 1;
#pragma unroll
      for (int nn = 0; nn < 2; ++nn) { const int nt = 2 * (wave & 1) + nn; f32x4 acc = {0.f, 0.f, 0.f, 0.f};
          acc = mma64(L + L_T1, L + L_T0, mt * 16, nt * 16, lane, acc);
          const int s0 = mt * 16 + 4 * (lane >> 4), t = nt * 16 + (lane & 15); const float Mt = vec[64 + t];
          float wv[4];
#pragma unroll
          for (int r = 0; r < 4; ++r) wv[r] = (s0 + r <= t) ? acc[r] * __expf(vec[s0 + r] - Mt) : 0.f;
          v2u w; w.x = pk2(wv[0], wv[1]); w.y = pk2(wv[2], wv[3]); *(LAS v2u*)(L + L_T5 + t * TS + s0 * 2) = w; } }
    __syncthreads();
    store_o_tiles(L, L + L_T5, L + L_T3, L + L_T2, L + L_T4, wave, lane);
    __syncthreads();
    { const int t = tid >> 3, c8 = (tid & 7) * 8;
      const v4u pw = *(LAS const v4u*)(L + L_T5 + t * TS + c8 * 2), qw = *(LAS const v4u*)(L + L_T2 + t * TS + c8 * 2);
      const unsigned pu[4] = {pw.x, pw.y, pw.z, pw.w}, qu[4] = {qw.x, qw.y, qw.z, qw.w}; float den = 0.f;
#pragma unroll
      for (int i = 0; i < 8; ++i) { den += bf2f((bf16_t)((pu[i >> 1] >> (16 * (i & 1))) & 0xffff)) + bf2f((bf16_t)((qu[i >> 1] >> (16 * (i & 1))) & 0xffff)) * vec[192 + c8 + i]; }
      den += __shfl_xor(den, 1); den += __shfl_xor(den, 2); den += __shfl_xor(den, 4);
      const float inv = 1.f / fmaxf(fabsf(den), vec[128 + t]);
      head_epilogue<true>(L, inv, R.gate, gain + c8, out + (size_t)t * D + c8, tid); }
    __syncthreads();
}
}
constexpr int N_PHASES = 21;
template <int PH, bool REP = false> __device__ __forceinline__ void run_phase(const MArgs& a, LAS unsigned char* L, const int tid, const int wave, const int G, const int bx, const int vcu) {
    const int lane = tid & 63, gw = vcu * NWAVES + wave, NGW = G * NWAVES;
    unsigned char* ws = a.ws; float* X = a.out;
    int* ctl = (int*)(ws + WS_CTL); int* cnt = ctl + CW_CNT;
    float* Gt = (float*)(ws + WS_G); float* CF = (float*)(ws + WS_CF); int4* tokinfo = (int4*)(ws + WS_TOKINFO); float2* tgate = (float2*)(ws + WS_TGATE); int* toklist = (int*)(ws + WS_TOKLIST);
    bf16_t* P = (bf16_t*)(ws + WS_P); bf16_t* HID = (bf16_t*)(ws + WS_HID); signed char* H = (signed char*)(ws + WS_H); float* SH = (float*)(ws + WS_SH); bf16_t* MIX = (bf16_t*)(ws + WS_MIX);
    signed char* XG = (signed char*)(ws + WS_XG); float* SXG = (float*)(ws + WS_SXG); bf16_t* Y = (bf16_t*)(ws + WS_XG);
    LAS float* scr = (LAS float*)(L + RING_OFF + wave * 16384);
    (void)ctl; (void)Gt; (void)CF; (void)tokinfo; (void)tgate; (void)toklist; (void)P; (void)HID; (void)H; (void)SH; (void)SXG; (void)MIX; (void)XG; (void)Y; (void)scr; (void)cnt; (void)lane; (void)gw; (void)NGW;
    constexpr int p = PH, l = p >= 10 ? 1 : 0, k = p == 0 ? -1 : (l ? p - 10 : p - 1);
    if constexpr (p == 0) {
            LAS float* img = (LAS float*)(L + RING_OFF); LAS float* pm = (LAS float*)(L + LDSCTL_OFF + 1024);
            for (int it = vcu; it < 400; it += G) {
                int r = it;
                if (r < 224) { const int ll = r / 112, nb = r % 112, sc = 32 * nb + (nb >= 56 ? 8 : 0);
                    conv8_block(a.in[I_W_IN] + (size_t)ll * D * DIN + sc, DIN, (signed char*)(ws + WS_WIN) + (size_t)ll * PW * D + (size_t)32 * nb * D, (float*)(ws + WS_SWIN) + ll * PW + 32 * nb, img, pm, tid, wave); }
                else { r -= 224; const int up = r / 88, nb = r % 88, c = 32 * nb;
                    conv8_block((up ? a.in[I_DUP] : a.in[I_DGATE]) + c, FF, (signed char*)(ws + WS_WDGU) + (size_t)glu_row(c, up) * D, (float*)(ws + WS_SWDGU) + glu_row(c, up), img, pm, tid, wave); }
            }
            for (int it = gw; it < 2432; it += NGW) {
                int r = it;
                if (r < 1024) { const int ll = r / 512; r %= 512; const int kb = r / 32, nb = r % 32;
                    tr_item(a.in[I_W_OUT] + (size_t)ll * D * D + 32 * nb, D, D, (bf16_t*)(ws + WS_WOUT) + (size_t)ll * D * D + (size_t)32 * nb * D, scr, 64 * kb, lane); continue; }
                r -= 1024;
                { const int kb = r / 32, nb = r % 32; tr_item(a.in[I_DDOWN] + 32 * nb, D, FF, (bf16_t*)(ws + WS_WDDN) + (size_t)32 * nb * FF, scr, 64 * kb, lane); }
            }
            __syncthreads();
            LAS float* tab = (LAS float*)(L + RING_OFF); load_gate_tab(tab, a.in[I_W_IN], tid); __syncthreads();
            float lg[8];
            { RowIn R, Rn; int row = gw; if (row < NTOK) mrow_load(R, a.in[I_X], row, lane);
              for (; row < NTOK; row += NGW) { const int nx = row + NGW; if (nx < NTOK) mrow_load(Rn, a.in[I_X], nx, lane); asm volatile("" ::: "memory");
                  mrow<0>(R, a.in[I_X], const_cast<float*>(a.in[I_X]), H, SH, a.in[I_ATTN_NORM], tab, Gt, row, lane, lg); if (nx < NTOK) R = Rn; } }
        } else if constexpr (k == 0) {
            { const int cb = (G >= 144) ? bx - 128 : bx; for (int bh = cb; bh >= 0 && bh < 16; bh += G) scan::fox_cumsum_item(L, Gt, a.in[I_FOX_BF] + l * 8, CF, bh, tid, wave); }
            pg8::GOrder S; S.so.init(NTOK, PW, G, bx); S.A = (const char*)H; S.B = (const char*)(ws + WS_WIN) + (size_t)l * PW * D; S.a_tile = (size_t)256 * D; S.b_tile = (size_t)256 * D; S.b_exp = 0;
            S.tb1 = S.tb2 = S.tb3 = S.tb4 = S.tb5 = S.tb6 = S.tb7 = 0x7fffffff;
            pg8::EpiBf8 E; E.O = P; E.ldc = PW; E.s_lo = P_FQ / 256; E.s_hi = P_FK / 256; E.scale = QSCALE; E.sA = SH; E.sB = (const float*)(ws + WS_SWIN) + l * PW;
            pg8::Gemm g{D / 2};
            pg8::gemm_phase<pg8::EpiBf8, pg8::GOrder, true, true, true>(L + RING_OFF, g, S, E);
        } else if constexpr (l == 1 && k == 9) {
            pg8::GOrder S; pg8::EpiBf E; int t[8]; int acc = 0;
#pragma unroll
            for (int e = 0; e < NE; ++e) { t[e] = acc; acc += (cnt[e] + 255) >> 8; }
            S.so.init(acc * 256, D, G, bx); S.A = (const char*)HID; S.B = (const char*)(ws + WS_WMDN); S.a_tile = (size_t)256 * FE * 2; S.b_tile = (size_t)256 * FE * 2; S.b_exp = (size_t)D * FE * 2;
            S.tb1 = t[1]; S.tb2 = t[2]; S.tb3 = t[3]; S.tb4 = t[4]; S.tb5 = t[5]; S.tb6 = t[6]; S.tb7 = t[7]; E.O = Y; E.ldc = D; E.s_lo = 0; E.s_hi = 0; E.scale = 1.f;
            pg8::Gemm g{FE};
            pg8::gemm_phase<pg8::EpiBf, pg8::GOrder, true, true>(L + RING_OFF, g, S, E);
        } else if constexpr (k == 4 || (l == 0 && k == 7)) {
            pg8::GOrder S; S.so.init(NTOK, D, G, bx); S.b_exp = 0; S.tb1 = S.tb2 = S.tb3 = S.tb4 = S.tb5 = S.tb6 = S.tb7 = 0x7fffffff; int K;
            if constexpr (k == 4) { K = D; S.A = (const char*)MIX; S.B = (const char*)(ws + WS_WOUT) + (size_t)l * D * D * 2; }
            else { K = FF; S.A = (const char*)HID; S.B = (const char*)(ws + WS_WDDN); }
            S.a_tile = (size_t)256 * K * 2; S.b_tile = (size_t)256 * K * 2;
            pg8::EpiResid E{(k == 4 && l == 0) ? a.in[I_X] : (const float*)X, X, D}; pg8::Gemm g{K};
            pg8::gemm_phase<pg8::EpiResid, pg8::GOrder, true, true>(L + RING_OFF, g, S, E);
        } else if constexpr ((l == 0 && k == 6) || (l == 1 && k == 7)) {
            pg8::GOrder S; pg8::EpiSwiglu8 E; S.a_tile = (size_t)256 * D; S.b_tile = (size_t)256 * D; E.O = HID;
            if constexpr (l == 0) { S.so.init(NTOK, 2 * FF, G, bx); S.A = (const char*)H; S.B = (const char*)(ws + WS_WDGU); S.b_exp = 0; S.tb1 = S.tb2 = S.tb3 = S.tb4 = S.tb5 = S.tb6 = S.tb7 = 0x7fffffff;
                E.ldc = FF; E.sA = SH; E.sB = (const float*)(ws + WS_SWDGU); E.sb_exp = 0; }
            else { int t[8]; int acc = 0;
#pragma unroll
                for (int e = 0; e < NE; ++e) { t[e] = acc; acc += (cnt[e] + 255) >> 8; }
                S.so.init(acc * 256, 2 * FE, G, bx); S.A = (const char*)XG; S.B = (const char*)(ws + WS_WMGU); S.b_exp = (size_t)2 * FE * D;
                S.tb1 = t[1]; S.tb2 = t[2]; S.tb3 = t[3]; S.tb4 = t[4]; S.tb5 = t[5]; S.tb6 = t[6]; S.tb7 = t[7]; E.ldc = FE; E.sA = SXG; E.sB = (const float*)(ws + WS_SWMGU); E.sb_exp = 2 * FE; }
            E.tb1 = S.tb1; E.tb2 = S.tb2; E.tb3 = S.tb3; E.tb4 = S.tb4; E.tb5 = S.tb5; E.tb6 = S.tb6; E.tb7 = S.tb7;
            pg8::Gemm g{D / 2};
            pg8::gemm_phase<pg8::EpiSwiglu8, pg8::GOrder, true, true, true>(L + RING_OFF, g, S, E);
        } else if constexpr (k == 5 && l == 0) {
            float lg[8];
            { RowIn R, Rn; int row = gw; if (row < NTOK) mrow_load(R, X, row, lane);
              for (; row < NTOK; row += NGW) { const int nx = row + NGW; if (nx < NTOK) mrow_load(Rn, X, nx, lane); asm volatile("" ::: "memory");
                  mrow<1>(R, X, X, H, SH, a.in[I_FFN_NORM], nullptr, nullptr, row, lane, lg); if (nx < NTOK) R = Rn; } }
        } else if constexpr (k == 8 && l == 0) {
            LAS float* tab = (LAS float*)(L + RING_OFF); load_gate_tab(tab, a.in[I_W_IN] + (size_t)D * DIN, tid); __syncthreads();
            float lg[8];
            { RowIn R, Rn; int row = gw; if (row < NTOK) mrow_load(R, X, row, lane);
              for (; row < NTOK; row += NGW) { const int nx = row + NGW; if (nx < NTOK) mrow_load(Rn, X, nx, lane); asm volatile("" ::: "memory");
                  mrow<0>(R, X, X, H, SH, a.in[I_ATTN_NORM] + D, tab, Gt, row, lane, lg); if (nx < NTOK) R = Rn; } }
        } else if constexpr (k == 5 && l == 1) {
            LAS int* sel_e = (LAS int*)(L + RING_OFF);
            LAS float* sel_g = (LAS float*)(L + RING_OFF + 512);
            LAS int* lcnt = (LAS int*)(L + RING_OFF + 1024);
            LAS float* tab = (LAS float*)(L + RING_OFF + 4096); load_router_tab(tab, a.in[I_ROUTER], tid); __syncthreads();
            for (int rb = bx; rb < NTOK / 64; rb += G) {
                if (tid < 16) lcnt[tid] = 0;
                RowIn R, Rn; mrow_load(R, X, rb * 64 + wave * 8, lane);
                for (int i = 0; i < 8; ++i) { const int rl = wave * 8 + i, row = rb * 64 + rl; float lg[8];
                    if (i < 7) mrow_load(Rn, X, row + 1, lane); asm volatile("" ::: "memory");
                    mrow<2>(R, X, X, H, SH, a.in[I_FFN_NORM] + D, tab, nullptr, row, lane, lg); if (i < 7) R = Rn;
                    if (lane == 0) { const float v0 = lg[0], v1 = lg[1]; const int e0 = __float_as_int(lg[2]), e1 = __float_as_int(lg[3]);
                        const float g1 = 1.f / (1.f + __expf(v0 - v1));
                        sel_e[2 * rl] = e0; sel_e[2 * rl + 1] = e1; sel_g[2 * rl] = 1.f - g1; sel_g[2 * rl + 1] = g1; } }
                __syncthreads();
                int e0 = 0, e1 = 0, r0 = 0, r1 = 0;
                if (tid < 64) { e0 = sel_e[2 * tid]; e1 = sel_e[2 * tid + 1]; r0 = __hip_atomic_fetch_add(lcnt + e0, 1, __ATOMIC_RELAXED, __HIP_MEMORY_SCOPE_WORKGROUP); r1 = __hip_atomic_fetch_add(lcnt + e1, 1, __ATOMIC_RELAXED, __HIP_MEMORY_SCOPE_WORKGROUP); }
                __syncthreads();
                if (tid < 8) lcnt[8 + tid] = atomicAdd(cnt + tid, (int)lcnt[tid]);
                __syncthreads();
                if (tid < 64) { const int row = rb * 64 + tid, s0 = lcnt[8 + e0] + r0, s1 = lcnt[8 + e1] + r1;
                    toklist[e0 * NTOK + s0] = row; toklist[e1 * NTOK + s1] = row; tokinfo[row] = make_int4(e0, s0, e1, s1); tgate[row] = make_float2(sel_g[2 * tid], sel_g[2 * tid + 1]); }
                __syncthreads();
            }
        } else if constexpr (k == 6 && l == 1) {
            { int base[NE]; int acc = 0;
#pragma unroll
              for (int e = 0; e < NE; ++e) { base[e] = acc; acc += (cnt[e] + 255) & ~255; }
              for (int r = gw; r < acc; r += NGW) { int e = 0, be = 0;
#pragma unroll
                  for (int c = 1; c < NE; ++c) if (r >= base[c]) { e = c; be = base[c]; }
                  const int s = r - be; v4u v0 = {0u, 0u, 0u, 0u}; float sv = 0.f;
                  if (s < cnt[e]) { const int tok = toklist[e * NTOK + s]; v0 = *((const v4u*)(H + (size_t)tok * D) + lane); sv = SH[tok]; }
                  *((v4u*)(XG + (size_t)r * D) + lane) = v0; if (lane == 0) SXG[r] = sv; } }
            __syncthreads();
            { LAS float* img = (LAS float*)(L + RING_OFF); LAS float* pm = (LAS float*)(L + LDSCTL_OFF + 1024);
              for (int it = vcu; it < 1792; it += G) { const int e = it / 224; int r = it % 224; const int up = r / 112, nb = r % 112, c = 32 * nb;
                  conv8_block((up ? a.in[I_MUP] : a.in[I_MGATE]) + (size_t)e * D * FE + c, FE, (signed char*)(ws + WS_WMGU) + (size_t)e * 2 * FE * D + (size_t)glu_row(c, up) * D, (float*)(ws + WS_SWMGU) + e * 2 * FE + glu_row(c, up), img, pm, tid, wave); } }
            for (int it = gw; it < 14336; it += NGW) { const int e = it / 1792, r = it % 1792, kb = r / 32, nb = r % 32;
                tr_item(a.in[I_MDOWN] + (size_t)e * FE * D + 32 * nb, D, FE, (bf16_t*)(ws + WS_WMDN) + (size_t)e * D * FE + (size_t)32 * nb * FE, scr, 64 * kb, lane); }
        } else if constexpr (k == 8 && l == 1) {
        } else if constexpr (k == 10 && l == 1) {
            int base[NE]; { int acc = 0;
#pragma unroll
              for (int e = 0; e < NE; ++e) { base[e] = acc; acc += (cnt[e] + 255) & ~255; } }
            struct FA { float4 v[4]; int4 ti; float2 tg; }; struct FB { uint2 y0[4], y1[4]; };
            auto loadA = [&](FA& A, int row) { const float4* xr = (const float4*)(X + (size_t)row * D) + lane;
#pragma unroll
                for (int j = 0; j < 4; ++j) A.v[j] = xr[64 * j];
                A.ti = tokinfo[row]; A.tg = tgate[row]; };
            auto loadB = [&](FB& B, const FA& A) { int b0 = 0, b1 = 0;
#pragma unroll
                for (int c = 0; c < NE; ++c) { if (c == A.ti.x) b0 = base[c]; if (c == A.ti.z) b1 = base[c]; }
                const uint2* y0 = (const uint2*)(Y + (size_t)(b0 + A.ti.y) * D) + lane; const uint2* y1 = (const uint2*)(Y + (size_t)(b1 + A.ti.w) * D) + lane;
#pragma unroll
                for (int j = 0; j < 4; ++j) { B.y0[j] = y0[64 * j]; B.y1[j] = y1[64 * j]; } };
            FA A0, A1, A2; FB B0, B1; int row = gw;
            if (row < NTOK) { loadA(A0, row); if (row + NGW < NTOK) loadA(A1, row + NGW); loadB(B0, A0); }
            for (; row < NTOK; row += NGW) {
                const bool h1 = row + NGW < NTOK, h2 = row + 2 * NGW < NTOK;
                if (h2) loadA(A2, row + 2 * NGW);
                if (h1) loadB(B1, A1);
                asm volatile("" ::: "memory");
                float4 v[4]; const float2 tg = A0.tg;
#pragma unroll
                for (int j = 0; j < 4; ++j) { const uint2 q = B0.y0[j], c = B0.y1[j]; v[j] = A0.v[j];
                    v[j].x += tg.x * bf2f((bf16_t)(q.x & 0xffff)) + tg.y * bf2f((bf16_t)(c.x & 0xffff)); v[j].y += tg.x * bf2f((bf16_t)(q.x >> 16)) + tg.y * bf2f((bf16_t)(c.x >> 16));
                    v[j].z += tg.x * bf2f((bf16_t)(q.y & 0xffff)) + tg.y * bf2f((bf16_t)(c.y & 0xffff)); v[j].w += tg.x * bf2f((bf16_t)(q.y >> 16)) + tg.y * bf2f((bf16_t)(c.y >> 16)); }
                float ss = 0.f;
#pragma unroll
                for (int j = 0; j < 4; ++j) ss += v[j].x * v[j].x + v[j].y * v[j].y + v[j].z * v[j].z + v[j].w * v[j].w;
                ss = wave_sum(ss); const float r = rsqrtf(ss * (1.f / D) + EPS);
                float4* xo = (float4*)(X + (size_t)row * D) + lane;
#pragma unroll
                for (int j = 0; j < 4; ++j) { const float4 g = *((const float4*)a.in[I_FINAL_NORM] + 64 * j + lane); xo[64 * j] = make_float4(v[j].x * r * g.x, v[j].y * r * g.y, v[j].z * r * g.z, v[j].w * r * g.w); }
                if (h1) { A0 = A1; B0 = B1; } if (h2) A1 = A2;
            }
        } else {
            if constexpr (k == 1) {
                unsigned char* sc = ws + WS_SCAN; const int wv = wave;
#define ITEM_DECODE(it_) const int item = (it_) & 1023, h = item & 3, c = (item >> 2) & 127, b = item >> 9
#define HG_LB(h_) (l == 0 ? 0.f : 1.f / (1.f + __expf(a.in[I_HGRN_LB][(h_) * 64 + (tl & 63)] - a.in[I_HGRN_LB][256 + (h_) * 64 + (tl & 63)])))
                { scan::HgIn R, Rn; int it = bx;
                  if (it < 1024) { ITEM_DECODE(it); scan::hgrn_load<false>(R, P, b, c, h, nullptr, tid, wv); }
                  for (; it < 1024; it += G) { const int nx = it + G; int tl = tid; asm volatile("" : "+v"(tl));
                      if (nx < 1024) { ITEM_DECODE(nx); scan::hgrn_load<false>(Rn, P, b, c, h, nullptr, tl, wv); }
                      asm volatile("" ::: "memory");
                      { ITEM_DECODE(it); (void)b; (void)c; scan::hgrn_b_item(L, R, HG_LB(h), (float*)(sc + scan::SC_LHG) + (size_t)item * 4096, (float*)(sc + scan::SC_DEC) + item * 64, tl, wv); }
                      if (nx < 1024) R = Rn; } }
                { scan::MlIn R, Rn; int it = bx; while (it < 1024) it += G;
                  if (it < 2048) { ITEM_DECODE(it); scan::mlstm_load<false>(R, P, Gt, b, c, h, nullptr, nullptr, nullptr, tid, wv); }
                  for (; it < 2048; it += G) { const int nx = it + G; int tl = tid; asm volatile("" : "+v"(tl));
                      if (nx < 2048) { ITEM_DECODE(nx); scan::mlstm_load<false>(Rn, P, Gt, b, c, h, nullptr, nullptr, nullptr, tl, wv); }
                      asm volatile("" ::: "memory");
                      { ITEM_DECODE(it); (void)b; (void)c; scan::mlstm_b_item(L, R, a.in[I_MLSTM_CONV] + l * 2048, a.in[I_MLSTM_BI] + l * 4, a.in[I_MLSTM_BF] + l * 4, h, (float*)(sc + scan::SC_LML) + (size_t)item * 4096,
                                            (float*)(sc + scan::SC_NL) + item * 64, (float*)(sc + scan::SC_AMAX) + item, (float*)(sc + scan::SC_BEND) + item, tl, wv); }
                      if (nx < 2048) R = Rn; } }
                { LAS unsigned* lst = (LAS unsigned*)(L + LDSCTL_OFF + 64);
                  if (tid < 32) lst[tid] = 0u; __syncthreads();
                  float mq0 = 0.f, mq1 = 0.f, mk0 = 0.f, mk1 = 0.f;
                  for (int row = gw; row < NTOK; row += NGW) {
                      const v4u wq = *((const v4u*)(P + (size_t)row * PW + P_FQ) + lane), wk = *((const v4u*)(P + (size_t)row * PW + P_FK) + lane);
                      float sq = 0.f, sk = 0.f;
#pragma unroll
                      for (int i = 0; i < 4; ++i) { const float q0 = bf2f((bf16_t)(wq[i] & 0xffff)), q1 = bf2f((bf16_t)(wq[i] >> 16)), k0 = bf2f((bf16_t)(wk[i] & 0xffff)), k1 = bf2f((bf16_t)(wk[i] >> 16));
                          sq += q0 * q0 + q1 * q1; sk += k0 * k0 + k1 * k1; }
                      sq += __shfl_xor(sq, 1); sq += __shfl_xor(sq, 2); sq += __shfl_xor(sq, 4); sk += __shfl_xor(sk, 1); sk += __shfl_xor(sk, 2); sk += __shfl_xor(sk, 4);
                      if (row < SEQ) { mq0 = fmaxf(mq0, sq); mk0 = fmaxf(mk0, sk); } else { mq1 = fmaxf(mq1, sq); mk1 = fmaxf(mk1, sk); } }
                  if ((lane & 7) == 0) { const int hh = lane >> 3;
                      __hip_atomic_fetch_max(lst + hh * 2, __float_as_uint(mq0), __ATOMIC_RELAXED, __HIP_MEMORY_SCOPE_WORKGROUP); __hip_atomic_fetch_max(lst + hh * 2 + 1, __float_as_uint(mk0), __ATOMIC_RELAXED, __HIP_MEMORY_SCOPE_WORKGROUP);
                      __hip_atomic_fetch_max(lst + 16 + hh * 2, __float_as_uint(mq1), __ATOMIC_RELAXED, __HIP_MEMORY_SCOPE_WORKGROUP); __hip_atomic_fetch_max(lst + 16 + hh * 2 + 1, __float_as_uint(mk1), __ATOMIC_RELAXED, __HIP_MEMORY_SCOPE_WORKGROUP); }
                  __syncthreads();
                  if (tid < 32) __hip_atomic_fetch_max((unsigned*)ctl + CW_STAT + l * 32 + tid, lst[tid], __ATOMIC_RELAXED, __HIP_MEMORY_SCOPE_AGENT); }
            } else if constexpr (k == 2) {
                for (int j = bx; j < 256; j += G) scan::scan_c_block<REP>(ws + WS_SCAN, j, tid);
            } else if constexpr (k == 3) {
                static_assert(attn_body::ATTN_LDS_BYTES <= RING_BYTES, "attention LDS");
                unsigned char* sc = ws + WS_SCAN; const int wv = wave;
                const float* stat = (const float*)(ctl + CW_STAT + l * 32);
                LAS unsigned* slot = (LAS unsigned*)(L + LDSCTL_OFF);
                int v;
                for (;;) {
                    if (tid == 0) *slot = __hip_atomic_fetch_add((unsigned*)ctl + CW_QCTR + l + (REP ? 2 : 0), 1u, __ATOMIC_RELAXED, __HIP_MEMORY_SCOPE_AGENT);
                    __syncthreads();
                    v = __builtin_amdgcn_readfirstlane((int)*(volatile LAS unsigned*)slot);
                    if (v >= 736) break;
                    int qb, bh, part = 0; float* PART = nullptr;
                    if (v < 448) { qb = 31 - (v >> 5); bh = v & 15; part = (v >> 4) & 1; PART = (float*)(ws + WS_SCAN + (40 + 32 * l) * MiB) + (size_t)(bh * 14 + (qb - 18)) * 2 * attn_body::PART_F; }
                    else { const int u2 = v - 448; qb = 17 - (u2 >> 4); bh = u2 & 15; }
                    const float Tsk = 30.f + 2.f * __builtin_sqrtf(stat[bh * 2] * stat[bh * 2 + 1]) * 1.01f + 1.f;
                    attn_body::attn_unit<8>(bh >> 3, bh & 7, qb, (const attn_body::bf16*)(P + P_FQ), (const attn_body::bf16*)(P + P_FK), (const attn_body::bf16*)(P + P_FV), (attn_body::bf16*)(MIX + 512), CF + (size_t)bh * SEQ, Tsk,
                                            part, PART, (unsigned*)ctl + CW_AFLAG + (l + (REP ? 2 : 0)) * 512 + bh * 32 + qb, (char*)L + RING_OFF);
                    __syncthreads();
                }
                int tid2 = tid; asm volatile("" : "+v"(tid2));
                while (v < 736 + 512) {
                    const int it0 = (v - 736) * 4;
                    if (it0 < 1024) { scan::HgIn R, Rn; { ITEM_DECODE(it0); scan::hgrn_load<true>(R, P, b, c, h, (const float*)(sc + scan::SC_LHG) + (size_t)item * 4096, tid2, wv); }
#pragma unroll 1
                        for (int j = 0; j < 4; ++j) { const int it = it0 + j; int tl = tid2; asm volatile("" : "+v"(tl));
                            if (j < 3) { ITEM_DECODE(it + 1); scan::hgrn_load<true>(Rn, P, b, c, h, (const float*)(sc + scan::SC_LHG) + (size_t)item * 4096, tl, wv); }
                            asm volatile("" ::: "memory");
                            { ITEM_DECODE(it); const float lb = l == 0 ? 0.f : 1.f / (1.f + __expf(a.in[I_HGRN_LB][h * 64 + (tl & 63)] - a.in[I_HGRN_LB][256 + h * 64 + (tl & 63)]));
                              scan::hgrn_d_item(L, R, lb, a.in[I_HGRN_NORM] + l * 256 + h * 64, MIX + (size_t)(b * SEQ + c * 64) * D + h * 64, tl, wv); }
                            if (j < 3) R = Rn; } }
                    else { scan::MlIn R, Rn; { ITEM_DECODE(it0); scan::mlstm_load<true>(R, P, Gt, b, c, h, (const float*)(sc + scan::SC_LML) + (size_t)item * 4096, (const float*)(sc + scan::SC_NL) + item * 64, (const float*)(sc + scan::SC_MPREV) + item, tid2, wv); }
#pragma unroll 1
                        for (int j = 0; j < 4; ++j) { const int it = it0 + j; int tl = tid2; asm volatile("" : "+v"(tl));
                            if (j < 3) { ITEM_DECODE(it + 1); scan::mlstm_load<true>(Rn, P, Gt, b, c, h, (const float*)(sc + scan::SC_LML) + (size_t)item * 4096, (const float*)(sc + scan::SC_NL) + item * 64, (const float*)(sc + scan::SC_MPREV) + item, tl, wv); }
                            asm volatile("" ::: "memory");
                            { ITEM_DECODE(it); scan::mlstm_d_item(L, R, a.in[I_MLSTM_CONV] + l * 2048, a.in[I_MLSTM_BI] + l * 4, a.in[I_MLSTM_BF] + l * 4, a.in[I_MLSTM_NORM] + l * 256 + h * 64, h, MIX + (size_t)(b * SEQ + c * 64) * D + 256 + h * 64, tl, wv); }
                            if (j < 3) R = Rn; } }
                    __syncthreads();
                    if (tid2 == 0) *slot = __hip_atomic_fetch_add((unsigned*)ctl + CW_QCTR + l + (REP ? 2 : 0), 1u, __ATOMIC_RELAXED, __HIP_MEMORY_SCOPE_AGENT);
                    __syncthreads();
                    v = __builtin_amdgcn_readfirstlane((int)*(volatile LAS unsigned*)slot);
                }
            }

        }
}
__global__ void __launch_bounds__(NTHR, 2) mega(MArgs a) {
    extern __shared__ __attribute__((aligned(16))) unsigned char lds[];
    LAS unsigned char* L = (LAS unsigned char*)lds;
    volatile LAS unsigned* MISC = (volatile LAS unsigned*)(L + MISC_OFF);
    const int tid = threadIdx.x, wave = __builtin_amdgcn_readfirstlane(tid >> 6);
    const int G = gridDim.x, bx = blockIdx.x, vcu = (G % 8 == 0) ? (bx % 8) * (G / 8) + bx / 8 : bx;
    for (int u = tid; u < (LDS_BYTES - LDSCTL_OFF) / 4; u += NTHR) ((LAS unsigned*)(L + LDSCTL_OFF))[u] = 0u;
    __syncthreads();
    const int lo = a.ph_lo, hi = a.ph_hi;
    XcdBarrier bar; bar.bar = (unsigned*)(a.ws + WS_CTL) + CW_BAR; bar.x = 0; bar.st = nullptr;
    if (hi - lo > 1) bar = xcd_barrier_post((unsigned*)(a.ws + WS_CTL) + CW_BAR, MISC + 8);
#ifndef REPEAT_MASK
#define REPEAT_MASK 0u
#endif
#define PHASE(k) if (lo <= (k) && (k) < hi) { run_phase<k>(a, L, tid, wave, G, bx, vcu); if constexpr ((REPEAT_MASK >> (k)) & 1u) { xcd_barrier(bar); run_phase<k, true>(a, L, tid, wave, G, bx, vcu); } if ((k) + 1 < hi) xcd_barrier(bar); }
    PHASE(0) PHASE(1) PHASE(2) PHASE(3) PHASE(4) PHASE(5) PHASE(6) PHASE(7) PHASE(8) PHASE(9) PHASE(10)
    PHASE(11) PHASE(12) PHASE(13) PHASE(14) PHASE(15) PHASE(16) PHASE(17) PHASE(19) PHASE(20)
#undef PHASE
}
#ifndef MEGA_MASK
#define MEGA_MASK 0x1FFFFFu
#endif
#ifndef FUSE_RUNS
#define FUSE_RUNS 1
#endif
extern "C" void kernel_launch(void* const* d_in, const int* in_sizes, int n_in, void* d_out, int out_size, void* d_ws, size_t ws_size, hipStream_t stream) {
    static int grid = 0;
    if (grid == 0) {
        if (n_in != 20 || ws_size < WS_END || out_size != NTOK * D) { fprintf(stderr, "kernel_launch: unexpected n_in %d / ws %zu / out %d\n", n_in, ws_size, out_size); grid = -1; return; }
        int dev = 0, cus = 0, per_cu = 0;
        if (hipGetDevice(&dev) != hipSuccess || hipDeviceGetAttribute(&cus, hipDeviceAttributeMultiprocessorCount, dev) != hipSuccess) { grid = -1; return; }
        if (hipFuncSetAttribute((const void*)mega, hipFuncAttributeMaxDynamicSharedMemorySize, LDS_BYTES) != hipSuccess) { fprintf(stderr, "kernel_launch: hipFuncSetAttribute failed\n"); grid = -1; return; }
        if (hipOccupancyMaxActiveBlocksPerMultiprocessor(&per_cu, (const void*)mega, NTHR, LDS_BYTES) != hipSuccess || per_cu < 1) { fprintf(stderr, "kernel_launch: occupancy query says %d\n", per_cu); per_cu = 1; }
        (void)hipGetLastError();
        grid = cus;
        if (grid > 256) grid = 256;
    }
    if (grid < 0) return;
    const float* const* in = (const float* const*)d_in;
    unsigned char* ws = (unsigned char*)d_ws; float* X = (float*)d_out;
    (void)hipMemsetAsync(ws + WS_CTL, 0, CTL_BYTES, stream);
    MArgs ma; memset(&ma, 0, sizeof ma);
    for (int i = 0; i < 20; ++i) ma.in[i] = in[i];
    ma.out = X; ma.ws = ws;
    ma.ph_lo = 0; ma.ph_hi = N_PHASES;
    hipLaunchKernelGGL(mega, dim3(grid), dim3(NTHR), LDS_BYTES, stream, ma);
}
```

```cpp
#include <hip/hip_runtime.h>
#include <hip/hip_bf16.h>
#include <cstdint>
#include <cstdio>
#include <cstring>

namespace cfg {
constexpr int NTOK = 16384, D = 1024, SEQ = 8192, NB = 2, DIN = 3600, PW = 3584, GW = 16;
constexpr int FF = 2816, FE = 3584, NE = 8, MAXROWS = 34816;
constexpr float EPS = 1e-6f;
constexpr float LOG2E = 1.4426950408889634f;
constexpr float QSCALE = 0.125f * LOG2E;
constexpr int P_HQ = 0, P_HF = 256, P_HI = 512, P_HG = 768, P_MQ = 1024, P_MK = 1280, P_MV = 1536, P_MO = 1792, P_FQ = 2048, P_FK = 2560, P_FV = 3072;
constexpr size_t MiB = 1u << 20;
constexpr size_t WS_CTL = 0, CTL_BYTES = 1 * MiB;
constexpr size_t WS_G = 2 * MiB;
constexpr size_t WS_CF = 3 * MiB;
constexpr size_t WS_TOKINFO = 3 * MiB + 512 * 1024;
constexpr size_t WS_TGATE = 3 * MiB + 768 * 1024;
constexpr size_t WS_TOKLIST = 4 * MiB;
constexpr size_t WS_P = 8 * MiB;
constexpr size_t WS_SCAN = 120 * MiB;
constexpr size_t WS_HID = 8 * MiB;
constexpr size_t WS_H = 246 * MiB;
constexpr size_t WS_MIX = 278 * MiB;
constexpr size_t WS_XG = 278 * MiB;
constexpr size_t WS_W = 346 * MiB;
constexpr size_t WS_Y = 346 * MiB;
constexpr size_t WS_END = 466 * MiB;
constexpr int CW_CNT = 64;
constexpr int CW_STAT = 128;
constexpr int CW_QCTR = 256;
constexpr int CW_AFLAG = 512;
}
using namespace cfg;
typedef unsigned short bf16_t;

__device__ __forceinline__ bf16_t f2bf(float f) { unsigned u = __builtin_bit_cast(unsigned, f); return (bf16_t)((u + 0x7fffu + ((u >> 16) & 1u)) >> 16); }
__device__ __forceinline__ float bf2f(bf16_t h) { return __builtin_bit_cast(float, (unsigned)h << 16); }
__device__ __forceinline__ float wave_sum(float v) {
#pragma unroll
    for (int o = 1; o < 64; o <<= 1) v += __shfl_xor(v, o);
    return v;
}
__device__ __forceinline__ float sigmoidf_(float z) { return 1.f / (1.f + __expf(-z)); }
__device__ __forceinline__ float siluf_(float z) { return z / (1.f + __expf(-z)); }
__device__ __forceinline__ float log_sigmoidf_(float z) { return fminf(z, 0.f) - log1pf(__expf(-fabsf(z))); }

__device__ __forceinline__ int moe_bases(const int* cnt, int* base) {
    int acc = 0;
#pragma unroll
    for (int e = 0; e < NE; ++e) { base[e] = acc; acc += (cnt[e] + 255) & ~255; }
    return acc;
}

namespace pg8 {
#define PG8_LAS __attribute__((address_space(3)))
typedef unsigned short bf16_t;
typedef short bf16x8 __attribute__((ext_vector_type(8)));
typedef float f32x4 __attribute__((ext_vector_type(4)));
typedef unsigned u32x4 __attribute__((ext_vector_type(4)));
constexpr int BM = 256, BK = 64, HALF = 128, HTB = HALF * BK * 2  , STAGE_BYTES = 8 * HTB, NXCD = 8, WGM = 8;

__host__ __device__ __forceinline__ int lds_byte(int r, int c) { const int st = (r >> 4) * 2 + (c >> 5), rr = r & 15, cc = c & 31, ob = rr * 64 + cc * 2; return st * 1024 + (ob ^ (((ob >> 9) & 1) << 5)); }
__host__ __device__ __forceinline__ void stage_rc(int b, int& R, int& C) { const int st = b / 1024, sb = b % 1024, swz = sb ^ (((sb >> 9) & 1) << 5); R = (st >> 1) * 16 + swz / 64; C = (st & 1) * 32 + (swz % 64) / 2; }
__host__ __device__ __forceinline__ int perm32(int rho) { const int n = rho >> 4, i = rho & 15; return 8 * (i >> 2) + 4 * n + (i & 3); }

struct Unit { int pm, pn; };
struct Gemm { int K; };

struct StaticOrder {
    int nM, nN, nwg, G, c;
    __host__ __device__ void init(int M, int N, int G_, int c_) { nM = M / BM; nN = N / BM; nwg = nM * nN; G = G_; c = c_; }
    __host__ __device__ bool next(int i, Unit& u) const {
        const long L = (long)i * G + c; if (L >= nwg) return false;
        int wgid = (int)L; { const int q = nwg / NXCD, r = nwg % NXCD, xcd = wgid % NXCD, off = wgid / NXCD; wgid = (xcd < r ? xcd * (q + 1) : r * (q + 1) + (xcd - r) * q) + off; }
        const int nig = WGM * nN, gid = wgid / nig, fm = gid * WGM, gsz = (nM - fm) < WGM ? (nM - fm) : WGM;
        u.pm = fm + ((wgid % nig) % gsz); u.pn = (wgid % nig) / gsz; return true;
    }
    __device__ __forceinline__ void a_ready(const Unit&) const {}
    __device__ __forceinline__ void done(const Unit&) const {}
};

__device__ __forceinline__ unsigned cvt_pk_bf16(float lo, float hi) { unsigned r; asm volatile("v_cvt_pk_bf16_f32 %0, %1, %2" : "=v"(r) : "v"(lo), "v"(hi)); return r; }
typedef int i32x4 __attribute__((ext_vector_type(4)));
template <bool I8> struct AccT { typedef f32x4 type; };
template <> struct AccT<true> { typedef i32x4 type; };
__device__ __forceinline__ f32x4 mma_sel(bf16x8 b, bf16x8 a, f32x4 c) { return __builtin_amdgcn_mfma_f32_16x16x32_bf16(b, a, c, 0, 0, 0); }
__device__ __forceinline__ i32x4 mma_sel(bf16x8 b, bf16x8 a, i32x4 c) { return __builtin_amdgcn_mfma_i32_16x16x64_i8(__builtin_bit_cast(i32x4, b), __builtin_bit_cast(i32x4, a), c, 0, 0, 0); }
struct EpiBf {
    static constexpr bool PERM = true, AFTER_DRAIN = false;
    bf16_t* O; int ldc; int s_lo, s_hi; float scale;
    struct Pre {}; __device__ __forceinline__ void prefetch(Pre&, const Unit&, int, int, int, int, int) const {} __device__ __forceinline__ void commit(const Pre&, int, int, int, int, int) const {}
    __device__ __forceinline__ void operator()(const f32x4 (&acc)[2][2][4][2], const Unit& u, int wr, int wc, int fr, int fq, const Pre&, int) const {
        const int row0 = u.pm * BM + wr * 64 + fr, col0 = u.pn * BM + wc * 32 + 8 * fq;
        const float sc = (u.pn >= s_lo && u.pn < s_hi) ? scale : 1.f;
#pragma unroll
        for (int ai = 0; ai < 2; ++ai)
#pragma unroll
            for (int m = 0; m < 4; ++m) { bf16_t* rowp = O + (size_t)(row0 + ai * HALF + m * 16) * ldc + col0;
#pragma unroll
                for (int bj = 0; bj < 2; ++bj) { const f32x4 v0 = acc[ai][bj][m][0] * sc, v1 = acc[ai][bj][m][1] * sc;
                    u32x4 w; w.x = cvt_pk_bf16(v0[0], v0[1]); w.y = cvt_pk_bf16(v0[2], v0[3]); w.z = cvt_pk_bf16(v1[0], v1[1]); w.w = cvt_pk_bf16(v1[2], v1[3]);
                    *(u32x4*)(rowp + bj * HALF) = w; } }
    }
};
__device__ __forceinline__ float silu_mul(float g, float u) { return g * __builtin_amdgcn_rcpf(1.f + __expf(-g)) * u; }
struct EpiSwiglu {
    static constexpr bool PERM = true, AFTER_DRAIN = false;
    bf16_t* O; int ldc;
    struct Pre {}; __device__ __forceinline__ void prefetch(Pre&, const Unit&, int, int, int, int, int) const {} __device__ __forceinline__ void commit(const Pre&, int, int, int, int, int) const {}
    __device__ __forceinline__ void operator()(const f32x4 (&acc)[2][2][4][2], const Unit& u, int wr, int wc, int fr, int fq, const Pre&, int) const {
        const int row0 = u.pm * BM + wr * 64 + fr, col0 = u.pn * HALF + wc * 32 + 8 * fq;
#pragma unroll
        for (int ai = 0; ai < 2; ++ai)
#pragma unroll
            for (int m = 0; m < 4; ++m) { bf16_t* rowp = O + (size_t)(row0 + ai * HALF + m * 16) * ldc + col0;
                const f32x4 g0 = acc[ai][0][m][0], g1 = acc[ai][0][m][1], u0 = acc[ai][1][m][0], u1 = acc[ai][1][m][1];
                u32x4 w; w.x = cvt_pk_bf16(silu_mul(g0[0], u0[0]), silu_mul(g0[1], u0[1])); w.y = cvt_pk_bf16(silu_mul(g0[2], u0[2]), silu_mul(g0[3], u0[3]));
                w.z = cvt_pk_bf16(silu_mul(g1[0], u1[0]), silu_mul(g1[1], u1[1])); w.w = cvt_pk_bf16(silu_mul(g1[2], u1[2]), silu_mul(g1[3], u1[3]));
                *(u32x4*)rowp = w; }
    }
};
template <bool IN_F32> struct EpiResid {
    static constexpr bool PERM = true, AFTER_DRAIN = false;
    const void* Xin; bf16_t* X; int ldc;
    struct Pre {}; __device__ __forceinline__ void prefetch(Pre&, const Unit&, int, int, int, int, int) const {} __device__ __forceinline__ void commit(const Pre&, int, int, int, int, int) const {}
    __device__ __forceinline__ void operator()(const f32x4 (&acc)[2][2][4][2], const Unit& u, int wr, int wc, int fr, int fq, const Pre&, int) const {
        const int row0 = u.pm * BM + wr * 64 + fr, col0 = u.pn * BM + wc * 32 + 8 * fq;
#pragma unroll
        for (int ai = 0; ai < 2; ++ai)
#pragma unroll
            for (int m = 0; m < 4; ++m) { const size_t ro = (size_t)(row0 + ai * HALF + m * 16) * ldc + col0;
#pragma unroll
                for (int bj = 0; bj < 2; ++bj) { f32x4 x0, x1;
                    if (IN_F32) { const float* p = (const float*)Xin + ro + bj * HALF; x0 = *(const f32x4*)p; x1 = *(const f32x4*)(p + 4); }
                    else { const u32x4 w = *(const u32x4*)((const bf16_t*)Xin + ro + bj * HALF);
                        x0 = (f32x4){__builtin_bit_cast(float, w.x << 16), __builtin_bit_cast(float, w.x & 0xffff0000u), __builtin_bit_cast(float, w.y << 16), __builtin_bit_cast(float, w.y & 0xffff0000u)};
                        x1 = (f32x4){__builtin_bit_cast(float, w.z << 16), __builtin_bit_cast(float, w.z & 0xffff0000u), __builtin_bit_cast(float, w.w << 16), __builtin_bit_cast(float, w.w & 0xffff0000u)}; }
                    const f32x4 v0 = x0 + acc[ai][bj][m][0], v1 = x1 + acc[ai][bj][m][1];
                    u32x4 o; o.x = cvt_pk_bf16(v0[0], v0[1]); o.y = cvt_pk_bf16(v0[2], v0[3]); o.z = cvt_pk_bf16(v1[0], v1[1]); o.w = cvt_pk_bf16(v1[2], v1[3]);
                    *(u32x4*)(X + ro + bj * HALF) = o; }
                asm volatile("" ::: "memory"); }
    }
};
struct EpiBf8 {
    static constexpr bool PERM = true, AFTER_DRAIN = false;
    bf16_t* O; int ldc; int s_lo, s_hi; float scale; const float* sA; const float* sB; PG8_LAS float* sc;
    struct Pre { f32x4 v; };
    __device__ __forceinline__ void prefetch(Pre& p, const Unit& u, int wr, int wc, int fr, int fq, int) const {
        const int wid = wr * 4 + wc, lane = fq * 16 + fr;
        if (wid == 0) p.v = *(const f32x4*)(sA + u.pm * BM + 4 * lane);
        if (wid == 1) p.v = *(const f32x4*)(sB + u.pn * BM + 4 * lane);
    }
    __device__ __forceinline__ void commit(const Pre& p, int wr, int wc, int fr, int fq, int ui) const {
        const int wid = wr * 4 + wc, lane = fq * 16 + fr; PG8_LAS float* d = sc + (ui & 1) * 512;
        if (wid < 2) { *(PG8_LAS f32x4*)(d + 256 * wid + 4 * lane) = p.v; asm volatile("s_waitcnt lgkmcnt(0)" ::: "memory"); }
    }
    __device__ __forceinline__ void operator()(const i32x4 (&acc)[2][2][4][2], const Unit& u, int wr, int wc, int fr, int fq, const Pre&, int ui) const {
        const int row0 = u.pm * BM + wr * 64 + fr, col0 = u.pn * BM + wc * 32 + 8 * fq; const PG8_LAS float* d = sc + (ui & 1) * 512;
        const float sc0 = (u.pn >= s_lo && u.pn < s_hi) ? scale : 1.f;
        f32x4 cb[2][2];
#pragma unroll
        for (int bj = 0; bj < 2; ++bj)
#pragma unroll
            for (int n = 0; n < 2; ++n) cb[bj][n] = *(const PG8_LAS f32x4*)(d + 256 + wc * 32 + 8 * fq + bj * HALF + 4 * n) * sc0;
#pragma unroll
        for (int ai = 0; ai < 2; ++ai)
#pragma unroll
            for (int m = 0; m < 4; ++m) { const int row = row0 + ai * HALF + m * 16; const float ra = d[wr * 64 + fr + ai * HALF + m * 16]; bf16_t* rowp = O + (size_t)row * ldc + col0;
#pragma unroll
                for (int bj = 0; bj < 2; ++bj) { const f32x4 v0 = __builtin_convertvector(acc[ai][bj][m][0], f32x4) * cb[bj][0] * ra, v1 = __builtin_convertvector(acc[ai][bj][m][1], f32x4) * cb[bj][1] * ra;
                    u32x4 w; w.x = cvt_pk_bf16(v0[0], v0[1]); w.y = cvt_pk_bf16(v0[2], v0[3]); w.z = cvt_pk_bf16(v1[0], v1[1]); w.w = cvt_pk_bf16(v1[2], v1[3]);
                    *(u32x4*)(rowp + bj * HALF) = w; } }
    }
};
struct EpiSwiglu8 {
    static constexpr bool PERM = true, AFTER_DRAIN = false;
    bf16_t* O; int ldc; const float* sA; const float* sB; int sb_exp; int tb1, tb2, tb3, tb4, tb5, tb6, tb7; PG8_LAS float* sc;
    struct Pre { f32x4 v; };
    __device__ __forceinline__ void prefetch(Pre& p, const Unit& u, int wr, int wc, int fr, int fq, int) const {
        const int wid = wr * 4 + wc, lane = fq * 16 + fr;
        const int e = (u.pm >= tb1) + (u.pm >= tb2) + (u.pm >= tb3) + (u.pm >= tb4) + (u.pm >= tb5) + (u.pm >= tb6) + (u.pm >= tb7);
        if (wid == 0) p.v = *(const f32x4*)(sA + u.pm * BM + 4 * lane);
        if (wid == 1) p.v = *(const f32x4*)(sB + (size_t)e * sb_exp + u.pn * BM + 4 * lane);
    }
    __device__ __forceinline__ void commit(const Pre& p, int wr, int wc, int fr, int fq, int ui) const {
        const int wid = wr * 4 + wc, lane = fq * 16 + fr; PG8_LAS float* d = sc + (ui & 1) * 512;
        if (wid < 2) { *(PG8_LAS f32x4*)(d + 256 * wid + 4 * lane) = p.v; asm volatile("s_waitcnt lgkmcnt(0)" ::: "memory"); }
    }
    __device__ __forceinline__ void operator()(const i32x4 (&acc)[2][2][4][2], const Unit& u, int wr, int wc, int fr, int fq, const Pre&, int ui) const {
        const int row0 = u.pm * BM + wr * 64 + fr, col0 = u.pn * HALF + wc * 32 + 8 * fq; const PG8_LAS float* d = sc + (ui & 1) * 512;
        const PG8_LAS float* sb = d + 256 + wc * 32 + 8 * fq;
        const f32x4 sg0 = *(const PG8_LAS f32x4*)sb, sg1 = *(const PG8_LAS f32x4*)(sb + 4), su0 = *(const PG8_LAS f32x4*)(sb + HALF), su1 = *(const PG8_LAS f32x4*)(sb + HALF + 4);
#pragma unroll
        for (int ai = 0; ai < 2; ++ai)
#pragma unroll
            for (int m = 0; m < 4; ++m) { const int row = row0 + ai * HALF + m * 16; const float ra = d[wr * 64 + fr + ai * HALF + m * 16]; bf16_t* rowp = O + (size_t)row * ldc + col0;
                const f32x4 g0 = __builtin_convertvector(acc[ai][0][m][0], f32x4) * sg0 * ra, g1 = __builtin_convertvector(acc[ai][0][m][1], f32x4) * sg1 * ra;
                const f32x4 u0 = __builtin_convertvector(acc[ai][1][m][0], f32x4) * su0 * ra, u1 = __builtin_convertvector(acc[ai][1][m][1], f32x4) * su1 * ra;
                u32x4 w; w.x = cvt_pk_bf16(silu_mul(g0[0], u0[0]), silu_mul(g0[1], u0[1])); w.y = cvt_pk_bf16(silu_mul(g0[2], u0[2]), silu_mul(g0[3], u0[3]));
                w.z = cvt_pk_bf16(silu_mul(g1[0], u1[0]), silu_mul(g1[1], u1[1])); w.w = cvt_pk_bf16(silu_mul(g1[2], u1[2]), silu_mul(g1[3], u1[3]));
                *(u32x4*)rowp = w; }
    }
};
struct GOrder {
    StaticOrder so; const char* A; const char* B; size_t a_tile, b_tile, b_exp; int tb1, tb2, tb3, tb4, tb5, tb6, tb7;
    __device__ __forceinline__ bool next(int i, Unit& u) const { return so.next(i, u); }
    __device__ __forceinline__ const char* a_base(const Unit& u) const { return A + (size_t)u.pm * a_tile; }
    __device__ __forceinline__ const char* b_base(const Unit& u) const {
        const int e = (u.pm >= tb1) + (u.pm >= tb2) + (u.pm >= tb3) + (u.pm >= tb4) + (u.pm >= tb5) + (u.pm >= tb6) + (u.pm >= tb7);
        return B + (size_t)e * b_exp + (size_t)u.pn * b_tile; }
    __device__ __forceinline__ void a_ready(const Unit&) const {}
    __device__ __forceinline__ void done(const Unit&) const {}
};
template <class Epi, class Sched, bool ALIGN_EPI = false, bool SP2 = false, bool I8 = false>
__device__ __forceinline__ void gemm_phase(PG8_LAS unsigned char* lds, const Gemm g, const Sched& S, const Epi& E) {
    const int tid = threadIdx.x, wid = __builtin_amdgcn_readfirstlane(tid >> 6), lane = tid & 63, wr = wid >> 2, wc = wid & 3, fr = lane & 15, fq = lane >> 4;
    const int K = g.K, nt = K / BK;
    unsigned voffA[2], voffB[2];
#pragma unroll
    for (int i = 0; i < 2; ++i) { int R, C; stage_rc(tid * 16 + i * 8192, R, C); const int Rb = Epi::PERM ? ((R & ~31) + perm32(R & 31)) : R;
        voffA[i] = (unsigned)(R * K + C) * 2u; voffB[i] = (unsigned)(Rb * K + C) * 2u; }
    const size_t kstep = (size_t)(BK * 2);
    const size_t hstep = (size_t)HALF * K * 2;
        const unsigned ldsw = (unsigned)wid * 1024u;
    const int aoff = lds_byte(wr * 64 + fr, fq * 8), boff = lds_byte(wc * 32 + fr, fq * 8);
#define PG8_SA(b, h) (((b) * 2 + (h)) * HTB)
#define PG8_SB(b, h) ((4 + (b) * 2 + (h)) * HTB)
#define PG8_STAGE(bufoff, gbase, voff) do { _Pragma("unroll") for (int _i = 0; _i < 2; ++_i) \
        __builtin_amdgcn_global_load_lds((const unsigned*)((const char*)(gbase) + (voff)[_i]), (PG8_LAS unsigned*)(lds + (bufoff) + ldsw + _i * 8192), 16, 0, 0); } while (0)
#define PG8_LDA(dst, b, h) do { _Pragma("unroll") for (int m = 0; m < 4; ++m) _Pragma("unroll") for (int k = 0; k < 2; ++k) dst[m][k] = *(const PG8_LAS bf16x8*)(lds + PG8_SA(b, h) + aoff + m * 2048 + k * 1024); } while (0)
#define PG8_LDB(dst, b, h) do { _Pragma("unroll") for (int n = 0; n < 2; ++n) _Pragma("unroll") for (int k = 0; k < 2; ++k) dst[n][k] = *(const PG8_LAS bf16x8*)(lds + PG8_SB(b, h) + boff + n * 2048 + k * 1024); } while (0)
#define PG8_MMA(ai, bj, At, Bt) do { __builtin_amdgcn_s_setprio(1); _Pragma("unroll") for (int m = 0; m < 4; ++m) _Pragma("unroll") for (int n = 0; n < 2; ++n) _Pragma("unroll") for (int k = 0; k < 2; ++k) \
        acc[ai][bj][m][n] = mma_sel(Bt[n][k], At[m][k], acc[ai][bj][m][n]); __builtin_amdgcn_s_setprio(0); } while (0)
#define PG8_WAIT_V(n) asm volatile("s_waitcnt vmcnt(" #n ")" ::: "memory")
#define PG8_WAIT_L(n) asm volatile("s_waitcnt lgkmcnt(" #n ")" ::: "memory")
#define PG8_BAR __builtin_amdgcn_s_barrier()
#define PG8_SCHED __builtin_amdgcn_sched_barrier(0)
    Unit cur, nxt; int ui = 0; typename Epi::Pre pre;
    if (!S.next(0, cur)) return;
    typename AccT<I8>::type acc[2][2][4][2];
#pragma unroll
    for (int a = 0; a < 2; ++a)
#pragma unroll
        for (int b = 0; b < 2; ++b)
#pragma unroll
            for (int m = 0; m < 4; ++m)
#pragma unroll
                for (int n = 0; n < 2; ++n) acc[a][b][m][n] = typename AccT<I8>::type{};
    bf16x8 At[4][2], B0[2][2], B1[2][2];
    const char* cA = S.a_base(cur); const char* cB = S.b_base(cur);
    S.a_ready(cur);
    if constexpr (SP2) {
        PG8_STAGE(PG8_SB(0, 0), cB, voffB); PG8_STAGE(PG8_SB(0, 1), cB + hstep, voffB); PG8_STAGE(PG8_SA(0, 0), cA, voffA); PG8_STAGE(PG8_SA(0, 1), cA + hstep, voffA);
        if (wr == 1) PG8_BAR;
        PG8_WAIT_V(2); PG8_BAR;
        PG8_STAGE(PG8_SB(1, 0), cB + kstep, voffB); PG8_STAGE(PG8_SA(1, 0), cA + kstep, voffA); PG8_STAGE(PG8_SB(1, 1), cB + hstep + kstep, voffB);
        PG8_WAIT_V(6); PG8_BAR;
    } else {
        PG8_STAGE(PG8_SB(0, 0), cB, voffB); PG8_STAGE(PG8_SA(0, 0), cA, voffA); PG8_STAGE(PG8_SB(0, 1), cB + hstep, voffB); PG8_STAGE(PG8_SA(0, 1), cA + hstep, voffA);
        if (wr == 1) PG8_BAR;
        PG8_WAIT_V(4); PG8_BAR;
        PG8_STAGE(PG8_SB(1, 0), cB + kstep, voffB); PG8_STAGE(PG8_SA(1, 0), cA + kstep, voffA); PG8_STAGE(PG8_SB(1, 1), cB + hstep + kstep, voffB);
        PG8_WAIT_V(6); PG8_BAR;
    }
    for (;;) {
        const bool has_next = S.next(ui + 1, nxt);
        const char* nA = has_next ? S.a_base(nxt) : cA; const char* nB = has_next ? S.b_base(nxt) : cB;
        for (int t = 0; t < nt; t += 2) {
            const bool last = (t == nt - 2);
            const char* a1 = cA + (size_t)(t + 1) * kstep;
            const char* a2 = last ? nA : cA + (size_t)(t + 2) * kstep; const char* b2 = last ? nB : cB + (size_t)(t + 2) * kstep;
            const char* a3 = a2 + kstep; const char* b3 = b2 + kstep;
            if (last && has_next) S.a_ready(nxt);
            if (last) E.prefetch(pre, cur, wr, wc, fr, fq, ui);
            if constexpr (SP2) {
            PG8_LDB(B0, 0, 0); PG8_LDB(B1, 0, 1); PG8_SCHED; PG8_LDA(At, 0, 0); PG8_STAGE(PG8_SA(1, 1), a1 + hstep, voffA);
            PG8_WAIT_V(8); PG8_WAIT_L(0); PG8_BAR; PG8_MMA(0, 0, At, B0); PG8_MMA(0, 1, At, B1); PG8_BAR; PG8_SCHED;
            PG8_LDA(At, 0, 1); PG8_STAGE(PG8_SB(0, 0), b2, voffB); PG8_STAGE(PG8_SB(0, 1), b2 + hstep, voffB); PG8_STAGE(PG8_SA(0, 0), a2, voffA);
            PG8_WAIT_V(8); PG8_WAIT_L(0); PG8_BAR; PG8_MMA(1, 0, At, B0); PG8_MMA(1, 1, At, B1); PG8_BAR; PG8_SCHED;
            PG8_LDB(B0, 1, 0); PG8_LDB(B1, 1, 1); PG8_SCHED; PG8_LDA(At, 1, 0); PG8_STAGE(PG8_SA(0, 1), a2 + hstep, voffA);
            PG8_WAIT_V(8); PG8_WAIT_L(0); PG8_BAR; PG8_MMA(0, 0, At, B0); PG8_MMA(0, 1, At, B1); PG8_BAR; PG8_SCHED;
            PG8_LDA(At, 1, 1); PG8_STAGE(PG8_SB(1, 0), b3, voffB); PG8_STAGE(PG8_SB(1, 1), b3 + hstep, voffB); PG8_STAGE(PG8_SA(1, 0), a3, voffA);
            PG8_WAIT_V(8); PG8_WAIT_L(0); PG8_BAR; PG8_MMA(1, 0, At, B0); PG8_MMA(1, 1, At, B1); PG8_BAR; PG8_SCHED;
            } else {
            PG8_LDB(B0, 0, 0); PG8_SCHED; PG8_LDA(At, 0, 0); PG8_STAGE(PG8_SA(1, 1), a1 + hstep, voffA);
            PG8_WAIT_L(8); PG8_BAR; PG8_WAIT_L(0); PG8_MMA(0, 0, At, B0); PG8_BAR; PG8_SCHED;
            PG8_LDB(B1, 0, 1); PG8_STAGE(PG8_SB(0, 0), b2, voffB);
            PG8_BAR; PG8_WAIT_L(0); PG8_MMA(0, 1, At, B1); PG8_BAR;
            PG8_LDA(At, 0, 1); PG8_STAGE(PG8_SA(0, 0), a2, voffA);
            PG8_BAR; PG8_WAIT_L(0); PG8_MMA(1, 0, At, B0); PG8_BAR; PG8_SCHED;
            PG8_STAGE(PG8_SB(0, 1), b2 + hstep, voffB);
            PG8_WAIT_V(6); PG8_BAR; PG8_MMA(1, 1, At, B1); PG8_BAR;
            PG8_LDB(B0, 1, 0); PG8_SCHED; PG8_LDA(At, 1, 0); PG8_STAGE(PG8_SA(0, 1), a2 + hstep, voffA);
            PG8_WAIT_L(8); PG8_BAR; PG8_WAIT_L(0); PG8_MMA(0, 0, At, B0); PG8_BAR; PG8_SCHED;
            PG8_LDB(B1, 1, 1); PG8_STAGE(PG8_SB(1, 0), b3, voffB);
            PG8_BAR; PG8_WAIT_L(0); PG8_MMA(0, 1, At, B1); PG8_BAR;
            PG8_LDA(At, 1, 1); PG8_STAGE(PG8_SA(1, 0), a3, voffA);
            PG8_BAR; PG8_WAIT_L(0); PG8_MMA(1, 0, At, B0); PG8_BAR; PG8_SCHED;
            PG8_STAGE(PG8_SB(1, 1), b3 + hstep, voffB);
            PG8_WAIT_V(6); PG8_BAR; PG8_MMA(1, 1, At, B1); PG8_BAR;
            }
        }
        E.commit(pre, wr, wc, fr, fq, ui);
        if constexpr (ALIGN_EPI) { if (wr == 0) PG8_BAR; }
        if constexpr (!Epi::AFTER_DRAIN) { E(acc, cur, wr, wc, fr, fq, pre, ui); S.done(cur); }
        if (!has_next) break;
#pragma unroll
        for (int a = 0; a < 2; ++a)
#pragma unroll
            for (int b = 0; b < 2; ++b)
#pragma unroll
                for (int m = 0; m < 4; ++m)
#pragma unroll
                    for (int n = 0; n < 2; ++n) acc[a][b][m][n] = typename AccT<I8>::type{};
        cur = nxt; cA = nA; cB = nB; ++ui;
        if constexpr (ALIGN_EPI) { if (wr == 1) PG8_BAR; }
    }
    PG8_WAIT_V(0);
    if constexpr (!ALIGN_EPI) { if (wr == 0) PG8_BAR; }
    PG8_BAR;
    if constexpr (Epi::AFTER_DRAIN) { E.fused(acc, cur, wr, wc, fr, fq, lds, wid, lane); S.done(cur); }
#undef PG8_SA
#undef PG8_SB
#undef PG8_STAGE
#undef PG8_LDA
#undef PG8_LDB
#undef PG8_MMA
#undef PG8_WAIT_V
#undef PG8_WAIT_L
#undef PG8_BAR
#undef PG8_SCHED
}
}
#include <hip/hip_bf16.h>
#include <cmath>
namespace attn_body {
using bf16=__hip_bfloat16;
using bf16x8=__attribute__((ext_vector_type(8)))short;
using s16x4=__attribute__((ext_vector_type(4)))short;
using f32x16=__attribute__((ext_vector_type(16)))float;
using u32x4=__attribute__((ext_vector_type(4)))unsigned;
constexpr int BATCH=2,NHEAD=8,SEQ=8192,D=64,DM=3584,OPITCH=1024;
constexpr int NW=8,QBLK=32,QB=QBLK*NW,KVBLK=64,NQB=SEQ/QB;
constexpr int ATTN_PITCH=DM, ATTN_UNIT_ROWS=QB;
__device__ __forceinline__ int crow(int r,int hi){return (r&3)+8*(r>>2)+4*hi;}
#define SBAR() __builtin_amdgcn_sched_barrier(0)
__device__ __forceinline__ void cmask(f32x16&p0,f32x16&p1,int jb,int qrel,int hi){
  const float NEG=-INFINITY; int kb=64*jb+4*hi;
  #pragma unroll
  for(int r=0;r<16;++r){int kv=kb+(r&3)+8*(r>>2); if(kv>qrel)p0[r]=NEG; if(kv+32>qrel)p1[r]=NEG;}
}

constexpr int NSLOT=3, SLOTB=8192, SPLIT_NT=72, PART_F=256*64+512;
constexpr int LDS_K=0, LDS_V=NSLOT*SLOTB, LDS_WS=2*NSLOT*SLOTB, LDS_OST=LDS_WS+NW*64*4, LDS_CK=LDS_OST+NW*4096, LDS_BYTES=LDS_CK+SEQ*4;
constexpr float C2=0.125f*1.4426950408889634f;
__device__ __forceinline__ void glds16(const void*gsrc,unsigned lds_dst){unsigned keep;
  asm volatile("s_mov_b32 %0, m0\n\ts_mov_b32 m0, %2\n\ts_nop 0\n\tglobal_load_lds_dwordx4 %1, off\n\ts_mov_b32 m0, %0":"=&s"(keep):"v"(gsrc),"s"(lds_dst):"memory");}
__device__ __forceinline__ float max3f(float a,float b,float c){float r;asm("v_max3_f32 %0, %1, %2, %3":"=v"(r):"v"(a),"v"(b),"v"(c));return r;}
__device__ __forceinline__ float max2f(float a,float b){float r;asm("v_max_f32_e32 %0, %1, %2":"=v"(r):"v"(a),"v"(b));return r;}
__device__ __forceinline__ float fadd_s(float a,float b){float r;asm("v_add_f32_e32 %0, %1, %2":"=v"(r):"v"(a),"v"(b));return r;}
__device__ __forceinline__ float fsub_s(float a,float b){float r;asm("v_sub_f32_e32 %0, %1, %2":"=v"(r):"v"(a),"v"(b));return r;}
typedef float f32x2_t __attribute__((ext_vector_type(2))); typedef float f32x4_t __attribute__((ext_vector_type(4))); typedef __bf16 bf16x2_t __attribute__((ext_vector_type(2)));
__device__ __forceinline__ unsigned cvtpk_s(float lo,float hi){f32x2_t v={lo,hi};bf16x2_t b=__builtin_convertvector(v,bf16x2_t);return __builtin_bit_cast(unsigned,b);}
#define WAIT_BAR(N) asm volatile("s_waitcnt vmcnt(" #N ") lgkmcnt(0)\n\ts_barrier":::"memory")

__device__ __forceinline__ void qkt(f32x16&p0,f32x16&p1,const char*Kslot,const bf16x8*qr,const f32x16&negm,int r32,int hi){
  const char*kb=Kslot+hi*1024+r32*16;
  #pragma unroll
  for(int d0=0;d0<4;++d0){
    const bf16x8 b0=*reinterpret_cast<const bf16x8*>(kb+d0*2048);
    const bf16x8 b1=*reinterpret_cast<const bf16x8*>(kb+d0*2048+512);
    if(d0==0){p0=__builtin_amdgcn_mfma_f32_32x32x16_bf16(b0,qr[0],negm,0,0,0);p1=__builtin_amdgcn_mfma_f32_32x32x16_bf16(b1,qr[0],negm,0,0,0);}
    else{p0=__builtin_amdgcn_mfma_f32_32x32x16_bf16(b0,qr[d0],p0,0,0,0);p1=__builtin_amdgcn_mfma_f32_32x32x16_bf16(b1,qr[d0],p1,0,0,0);}}
}
typedef __attribute__((address_space(3))) const char* lds_cptr;
typedef short v4i16_t __attribute__((ext_vector_type(4)));
__device__ __forceinline__ void kload8(bf16x8*kf,lds_cptr kp){
  kf[0]=*(const __attribute__((address_space(3))) bf16x8*)(kp);      kf[1]=*(const __attribute__((address_space(3))) bf16x8*)(kp+512);
  kf[2]=*(const __attribute__((address_space(3))) bf16x8*)(kp+2048); kf[3]=*(const __attribute__((address_space(3))) bf16x8*)(kp+2560);
  kf[4]=*(const __attribute__((address_space(3))) bf16x8*)(kp+4096); kf[5]=*(const __attribute__((address_space(3))) bf16x8*)(kp+4608);
  kf[6]=*(const __attribute__((address_space(3))) bf16x8*)(kp+6144); kf[7]=*(const __attribute__((address_space(3))) bf16x8*)(kp+6656);
}
__device__ __forceinline__ void kload2(bf16x8*kf,lds_cptr kp,int j){ kf[2*j]=*(const __attribute__((address_space(3))) bf16x8*)(kp+j*2048); kf[2*j+1]=*(const __attribute__((address_space(3))) bf16x8*)(kp+j*2048+512); }
__device__ __forceinline__ s16x4 vtr(lds_cptr p){ return __builtin_bit_cast(s16x4,__builtin_amdgcn_ds_read_tr16_b64_v4i16((__attribute__((address_space(3))) v4i16_t*)p)); }
__device__ __forceinline__ float rowmax(const f32x16&p0,const f32x16&p1){
  float a=max3f(p0[0],p0[1],p1[0]),b=max3f(p0[2],p0[3],p1[1]);a=max3f(a,p1[2],p1[3]);
  #pragma unroll
  for(int r=4;r<16;r+=4){a=max3f(a,p0[r],p0[r+1]);b=max3f(b,p0[r+2],p0[r+3]);a=max3f(a,p1[r],p1[r+1]);b=max3f(b,p1[r+2],p1[r+3]);}
  const float m=max2f(a,b);
  auto rr=__builtin_amdgcn_permlane32_swap(__float_as_uint(m),__float_as_uint(m),false,false);
  return max2f(__uint_as_float(rr[0]),__uint_as_float(rr[1]));
}
__device__ __forceinline__ void pv(f32x16*o,int vb,bf16x8 pa0,bf16x8 pa1,bf16x8 pa2,bf16x8 pa3){
  #pragma unroll
  for(int d0=0;d0<2;++d0){s16x4 lo[4],hi[4];
    #pragma unroll
    for(int ks=0;ks<4;++ks){
      asm volatile("ds_read_b64_tr_b16 %0,%1 offset:%c2":"=&v"(lo[ks]):"v"(vb),"i"(d0*4096+ks*1024):"memory");
      asm volatile("ds_read_b64_tr_b16 %0,%1 offset:%c2":"=&v"(hi[ks]):"v"(vb),"i"(d0*4096+ks*1024+512):"memory");}
    asm volatile("s_waitcnt lgkmcnt(0)":::"memory");SBAR();
    #define PK(k) (bf16x8){lo[k][0],lo[k][1],lo[k][2],lo[k][3],hi[k][0],hi[k][1],hi[k][2],hi[k][3]}
    o[d0]=__builtin_amdgcn_mfma_f32_32x32x16_bf16(pa0,PK(0),o[d0],0,0,0);
    o[d0]=__builtin_amdgcn_mfma_f32_32x32x16_bf16(pa1,PK(1),o[d0],0,0,0);
    o[d0]=__builtin_amdgcn_mfma_f32_32x32x16_bf16(pa2,PK(2),o[d0],0,0,0);
    o[d0]=__builtin_amdgcn_mfma_f32_32x32x16_bf16(pa3,PK(3),o[d0],0,0,0);
    #undef PK
  }
}

#ifndef ATTN_STORE16
#define ATTN_STORE16(p,v) (*(u32x4*)(p)=(v))
#endif
template<int THRL> __device__ __forceinline__ void attn_unit(int b,int h,int qb,const bf16*Q,const bf16*__restrict__ K,const bf16*__restrict__ V,bf16*O,const float*__restrict__ cf,const float Tskip,const int part,float*PART,unsigned*flag,char*shm){
  int tid_=threadIdx.x; asm volatile("":"+v"(tid_));
  const int tid=tid_,lane=tid&63,r32=lane&31,hi=lane>>5; const int wid=__builtin_amdgcn_readfirstlane(tid>>6);
  const long rowbase=(long)b*SEQ; const int q0=qb*QB;
  const bf16*Qw=Q+(rowbase+q0+wid*QBLK)*DM+h*D;
  const unsigned lds0=(unsigned)(uintptr_t)shm;
  float*wsf=(float*)(shm+LDS_WS)+wid*64;
  const unsigned kdst=lds0+LDS_K+wid*1024, vdst=lds0+LDS_V+wid*1024;
  #define DMA_K(t,slot) glds16(ksrc+(long)(t)*KVBLK*DM,(unsigned)__builtin_amdgcn_readfirstlane(kdst+(slot)))
  #define DMA_V(t,slot) glds16(vsrc+(long)(t)*KVBLK*DM,(unsigned)__builtin_amdgcn_readfirstlane(vdst+(slot)))
  const int vb0=(int)(lds0+LDS_V)+((lane>>4)&1)*32+(lane&3)*8+(4*hi+((lane&15)>>2))*64;
  const char*Kbase=shm+LDS_K; bf16x8 kf[8];
  const lds_cptr shm3=(lds_cptr)shm; const lds_cptr kp0=shm3+LDS_K+hi*1024+r32*16; const lds_cptr vp0=shm3+LDS_V+((lane>>4)&1)*32+(lane&3)*8+(4*hi+((lane&15)>>2))*64;
  typedef __attribute__((address_space(3))) float lds_f32; typedef __attribute__((address_space(3))) const f32x4_t* lds_cf4;
  const int NT0=(q0+QB)/KVBLK;
  int tb;
  { const float thr=cf[q0]+Tskip; const int t1=lane,t2=lane+64;
    const bool n1=(t1<NT0)&&(cf[64*t1+63]>thr), n2=(t2<NT0)&&(cf[64*t2+63]>thr);
    const int t0=(int)__popcll(__ballot(n1))+(int)__popcll(__ballot(n2));
    tb=t0&~1; if(tb>NT0-4)tb=NT0-4; tb=__builtin_amdgcn_readfirstlane(tb); }
  int NT=NT0-tb; bool band=true; const bool split=(PART!=nullptr)&&(NT>SPLIT_NT);
  if(PART!=nullptr){ if(!split){ if(part==1)return; } else { const int mid=(NT>>1)&~1; if(part==0){NT=mid;band=false;} else {tb+=mid;NT-=mid;} } }
  { lds_f32* ckw=(lds_f32*)((lds_cptr)shm+LDS_CK); int i0_=tb*KVBLK+tid; asm volatile("":"+v"(i0_)); _Pragma("nounroll") for(int i=i0_;i<q0+QB;i+=NW*64)ckw[i]=cf[i]; }
  const float cq=cf[q0+wid*QBLK+(lane&31)];
  asm volatile("s_waitcnt vmcnt(0) lgkmcnt(0)\n\ts_barrier":::"memory");
  const bf16*Kh=K+(rowbase+(long)tb*KVBLK)*DM+h*D,*Vh=V+(rowbase+(long)tb*KVBLK)*DM+h*D;
  const bf16*ksrc=Kh+(long)lane*DM+wid*8;
  const bf16*vsrc=Vh+(long)(16*(wid&3)+(lane>>2))*DM+(wid>>2)*32+(lane&3)*8;
  const lds_cptr ckl=(lds_cptr)shm+LDS_CK+256*tb+16*(lane>>5);
  #define CBIAS(P0,P1,t) do{ const lds_cptr cb_=ckl+256*(t); _Pragma("unroll") for(int g_=0;g_<4;++g_){ const f32x4_t a_=*(lds_cf4)(cb_+32*g_), b_=*(lds_cf4)(cb_+128+32*g_); \
      _Pragma("unroll") for(int i_=0;i_<4;++i_){ P0[4*g_+i_]-=(a_[i_]+mm); P1[4*g_+i_]-=(b_[i_]+mm); } } }while(0)
  f32x4_t cbA[4],cbB[4]; float clast;
  #define CBLD(t) do{ const lds_cptr cb_=ckl+256*(t); _Pragma("unroll") for(int g_=0;g_<4;++g_){ cbA[g_]=*(lds_cf4)(cb_+32*g_); cbB[g_]=*(lds_cf4)(cb_+128+32*g_); } \
      clast=*(const __attribute__((address_space(3))) float*)((lds_cptr)shm+LDS_CK+256*tb+256*(t)+252); }while(0)
  DMA_K(0,0);DMA_V(0,0);DMA_K(1,SLOTB);
  bf16x8 qr[4];
  #pragma unroll
  for(int d0=0;d0<4;++d0)qr[d0]=*reinterpret_cast<const bf16x8*>(&Qw[(long)r32*DM+d0*16+hi*8]);
  float mhat=0.f,l_reg=0.f;f32x16 o[2];o[0]=f32x16{};o[1]=f32x16{};float mm=-cq; const f32x16 negm=f32x16{};
  const int qrel=wid*QBLK+r32;
  #define CMASK(P0,P1,t) do{int jb_=(t)-(NT-4); if(band&&jb_>=0)cmask(P0,P1,jb_,qrel,hi);}while(0)
  bool resc=false;
  #define START(P0,P1) do{ const float rm=rowmax(P0,P1); resc=false; \
    { const float dl=rm; mhat=fadd_s(mhat,dl); \
      _Pragma("unroll") for(int r=0;r<16;++r){P0[r]=fsub_s(P0[r],dl);P1[r]=fsub_s(P1[r],dl);} \
      mm+=dl; } \
    _Pragma("unroll") for(int r=0;r<16;++r)P0[r]=__builtin_amdgcn_exp2f(P0[r]); }while(0)
  #define RESC() do{ if(resc){ asm volatile("s_waitcnt lgkmcnt(0)":::"memory"); \
      _Pragma("unroll") for(int d_=0;d_<2;++d_) _Pragma("unroll") for(int r=0;r<16;++r)o[d_][r]*=wsf[crow(r,hi)]; } }while(0)
  f32x16 pA0,pA1,pB0,pB1;
  int sl_prev=0,sl_cur=0,sl_next=SLOTB;
  #define ROT() do{sl_prev=sl_cur;sl_cur=sl_next;sl_next=(sl_next==(NSLOT-1)*SLOTB)?0:sl_next+SLOTB;}while(0)
  DMA_K(2,2*SLOTB);
  WAIT_BAR(3);
  qkt(pA0,pA1,Kbase,qr,negm,r32,hi);asm volatile("s_nop 15\n\ts_nop 7":"+v"(pA0),"+v"(pA1));CBIAS(pA0,pA1,0);CMASK(pA0,pA1,0);
  START(pA0,pA1);
  _Pragma("unroll") for(int r=0;r<16;++r)pA1[r]=__builtin_amdgcn_exp2f(pA1[r]);
  WAIT_BAR(0);
  DMA_K(3,0);DMA_V(1,SLOTB);
  ROT();
  kload8(kf,kp0+sl_cur);
  WAIT_BAR(2);
  s16x4 vlo[8],vhi[8]; u32x4 pw0,pw1,pw2,pw3;
  #define PKW(P,B) cvtpk_s(P[B],P[B+1])
  #define PAF(k) __builtin_bit_cast(bf16x8,pw##k)
  #define VFR(i) (bf16x8){vlo[i][0],vlo[i][1],vlo[i][2],vlo[i][3],vhi[i][0],vhi[i][1],vhi[i][2],vhi[i][3]}
  #define PIN(x) asm volatile("":"+v"(x))
  #define MX3(a,b,c) __builtin_fmaxf(__builtin_fmaxf((a),(b)),(c))
  #define GAPA(MF,A0,A1,A2,A3,W0,W1,PW) do{ MF; sacc+=A0; sacc+=A1; sacc+=A2; sacc+=A3; PIN(sacc); W0; W1; PIN(PW); SBAR(); }while(0)
  #define EX(v) __builtin_amdgcn_exp2f(v)
  #define GAPB(MF,X,B,CB) do{ MF; { const f32x4_t t_=(CB)+mm; X[B]=EX(X[B]-t_[0]); X[B+1]=EX(X[B+1]-t_[1]); X[B+2]=EX(X[B+2]-t_[2]); X[B+3]=EX(X[B+3]-t_[3]); } PIN(X); SBAR(); }while(0)
  #define VRD(i) do{ vlo[i]=vtr(vp_+(((i)>>2)*4096+((i)&3)*1024)); vhi[i]=vtr(vp_+(((i)>>2)*4096+((i)&3)*1024+512)); }while(0)
  #define KRD(G,j) do{ if(G){ kload2(kf,kp0+sl_next,j); SBAR(); } }while(0)
  #define STEP(C0,C1,P0,P1,t,GK,GV,GL) do{ SBAR(); \
    const lds_cptr vp_=vp0+sl_prev; \
    VRD(0); SBAR(); float sacc=(P0[0]+P0[1]); \
    GAPA(C0=__builtin_amdgcn_mfma_f32_32x32x16_bf16(kf[0],qr[0],negm,0,0,0), P0[2],P0[3],P0[4],P0[5],     pw0[0]=PKW(P0,0), pw0[1]=PKW(P0,2), pw0); \
    VRD(4); SBAR(); GAPA(C1=__builtin_amdgcn_mfma_f32_32x32x16_bf16(kf[1],qr[0],negm,0,0,0), P0[6],P0[7],P0[8],P0[9],     pw0[2]=PKW(P0,4), pw0[3]=PKW(P0,6), pw0); \
    VRD(1); SBAR(); GAPA(C0=__builtin_amdgcn_mfma_f32_32x32x16_bf16(kf[2],qr[1],C0,0,0,0),   P0[10],P0[11],P0[12],P0[13], pw1[0]=PKW(P0,8), pw1[1]=PKW(P0,10), pw1); \
    VRD(5); SBAR(); GAPA(C1=__builtin_amdgcn_mfma_f32_32x32x16_bf16(kf[3],qr[1],C1,0,0,0),   P0[14],P0[15],P1[0],P1[1],   pw1[2]=PKW(P0,12),pw1[3]=PKW(P0,14), pw1); \
    VRD(2); SBAR(); GAPA(C0=__builtin_amdgcn_mfma_f32_32x32x16_bf16(kf[4],qr[2],C0,0,0,0),   P1[2],P1[3],P1[4],P1[5],     pw2[0]=PKW(P1,0), pw2[1]=PKW(P1,2), pw2); \
    VRD(6); SBAR(); GAPA(C1=__builtin_amdgcn_mfma_f32_32x32x16_bf16(kf[5],qr[2],C1,0,0,0),   P1[6],P1[7],P1[8],P1[9],     pw2[2]=PKW(P1,4), pw2[3]=PKW(P1,6), pw2); \
    VRD(3); SBAR(); GAPA(C0=__builtin_amdgcn_mfma_f32_32x32x16_bf16(kf[6],qr[3],C0,0,0,0),   P1[10],P1[11],P1[12],P1[13], pw3[0]=PKW(P1,8), pw3[1]=PKW(P1,10), pw3); \
    VRD(7); SBAR(); GAPA(C1=__builtin_amdgcn_mfma_f32_32x32x16_bf16(kf[7],qr[3],C1,0,0,0),   P1[14],P1[15],0.f,0.f,       pw3[2]=PKW(P1,12),pw3[3]=PKW(P1,14), pw3); \
    l_reg+=sacc; \
    if(GK){DMA_K((t)+3,sl_cur);} if(GV){DMA_V((t)+1,sl_next);} \
    CBLD(t); CMASK(C0,C1,t); \
    { float a=MX3(C0[0],C0[1],C1[0]),b=MX3(C0[2],C0[3],C1[1]); a=MX3(a,C1[2],C1[3]); \
      _Pragma("unroll") for(int r=4;r<16;r+=4){a=MX3(a,C0[r],C0[r+1]);b=MX3(b,C0[r+2],C0[r+3]);a=MX3(a,C1[r],C1[r+1]);b=MX3(b,C1[r+2],C1[r+3]);} \
      float rm=__builtin_fmaxf(a,b); { auto rr=__builtin_amdgcn_permlane32_swap(__float_as_uint(rm),__float_as_uint(rm),false,false); rm=__builtin_fmaxf(__uint_as_float(rr[0]),__uint_as_float(rr[1])); } rm=rm-clast-mm; \
      resc=false; \
      if(__builtin_expect(__any(rm>(float)THRL),0)){ const float dl=__builtin_fmaxf(rm,0.f); mhat+=dl; \
        mm+=dl; \
        const float f=__builtin_amdgcn_exp2f(-dl); l_reg*=f; if(hi==0)wsf[r32]=f; resc=true; } } \
    SBAR(); \
    GAPB(o[0]=__builtin_amdgcn_mfma_f32_32x32x16_bf16(PAF(0),VFR(0),o[0],0,0,0), C0,0,cbA[0]); \
    GAPB(o[1]=__builtin_amdgcn_mfma_f32_32x32x16_bf16(PAF(0),VFR(4),o[1],0,0,0), C0,4,cbA[1]); \
    KRD(GL,0); GAPB(o[0]=__builtin_amdgcn_mfma_f32_32x32x16_bf16(PAF(1),VFR(1),o[0],0,0,0), C0,8,cbA[2]); \
    KRD(GL,1); GAPB(o[1]=__builtin_amdgcn_mfma_f32_32x32x16_bf16(PAF(1),VFR(5),o[1],0,0,0), C0,12,cbA[3]); \
    KRD(GL,2); GAPB(o[0]=__builtin_amdgcn_mfma_f32_32x32x16_bf16(PAF(2),VFR(2),o[0],0,0,0), C1,0,cbB[0]); \
    KRD(GL,3); GAPB(o[1]=__builtin_amdgcn_mfma_f32_32x32x16_bf16(PAF(2),VFR(6),o[1],0,0,0), C1,4,cbB[1]); \
    GAPB(o[0]=__builtin_amdgcn_mfma_f32_32x32x16_bf16(PAF(3),VFR(3),o[0],0,0,0), C1,8,cbB[2]); \
    GAPB(o[1]=__builtin_amdgcn_mfma_f32_32x32x16_bf16(PAF(3),VFR(7),o[1],0,0,0), C1,12,cbB[3]); \
    }while(0)
  int t=1;
  #undef CMASK
  #define CMASK(P0,P1,t) do{}while(0)
  for(;t+5<NT;t+=2){
    STEP(pB0,pB1,pA0,pA1,t,true,true,true);     WAIT_BAR(2); RESC(); ROT();
    STEP(pA0,pA1,pB0,pB1,t+1,true,true,true);   WAIT_BAR(2); RESC(); ROT();
  }
  #undef CMASK
  #define CMASK(P0,P1,t) do{int jb_=(t)-(NT-4); if(band&&jb_>=0)cmask(P0,P1,jb_,qrel,hi);}while(0)
  #define ENDW(tt) do{ if((tt)+3<NT){WAIT_BAR(2);} else if((tt)+2<NT){WAIT_BAR(1);} else {WAIT_BAR(0);} }while(0)
  for(;t+1<NT;t+=2){
    STEP(pB0,pB1,pA0,pA1,t,(t+3<NT),(t+1<NT),(t+1<NT));       ENDW(t);   RESC(); ROT();
    STEP(pA0,pA1,pB0,pB1,t+1,(t+4<NT),(t+2<NT),(t+2<NT));     ENDW(t+1); RESC(); ROT();
  }
  STEP(pB0,pB1,pA0,pA1,NT-1,false,false,false); RESC();
  { float sacc=pB0[0]+pB0[1]; _Pragma("unroll") for(int r=2;r<16;++r)sacc+=pB0[r]; _Pragma("unroll") for(int r=0;r<16;++r)sacc+=pB1[r]; l_reg+=sacc;
    pw0=(u32x4){PKW(pB0,0),PKW(pB0,2),PKW(pB0,4),PKW(pB0,6)};pw1=(u32x4){PKW(pB0,8),PKW(pB0,10),PKW(pB0,12),PKW(pB0,14)};pw2=(u32x4){PKW(pB1,0),PKW(pB1,2),PKW(pB1,4),PKW(pB1,6)};pw3=(u32x4){PKW(pB1,8),PKW(pB1,10),PKW(pB1,12),PKW(pB1,14)};
    SBAR(); pv(o,vb0+sl_cur,PAF(0),PAF(1),PAF(2),PAF(3)); }
  #undef PKW
  #undef PAF
  #undef VFR
  #undef PIN
  #undef MX3
  #undef GAPA
  #undef GAPB
  #undef EX
  #undef VRD
  #undef KRD
  #undef STEP
  #undef ENDW
  {auto rr=__builtin_amdgcn_permlane32_swap(__float_as_uint(l_reg),__float_as_uint(l_reg),false,false);l_reg=__uint_as_float(rr[0])+__uint_as_float(rr[1]);}
  if(hi==0)wsf[32+r32]=l_reg;asm volatile("s_waitcnt lgkmcnt(0)":::"memory");
  float rli[16];
  if(split){
    float*Pm=PART+(size_t)part*PART_F; const float*Po=PART+(size_t)(1-part)*PART_F;
    #pragma unroll
    for(int r=0;r<16;++r){
      #pragma unroll
      for(int d0=0;d0<2;++d0)Pm[(wid*QBLK+crow(r,hi))*64+d0*32+r32]=o[d0][r];}
    if(hi==0){Pm[QB*64+(wid*QBLK+r32)*2]=mm+cq;Pm[QB*64+(wid*QBLK+r32)*2+1]=l_reg;wsf[r32]=mm+cq;}
    asm volatile("s_waitcnt vmcnt(0) lgkmcnt(0)\n\ts_barrier":::"memory");
    if(tid==0){ __builtin_amdgcn_fence(__ATOMIC_RELEASE,"agent"); asm volatile("s_waitcnt vmcnt(0)":::"memory");
      *(volatile __attribute__((address_space(3))) unsigned*)((__attribute__((address_space(3))) char*)shm+LDS_OST)=__hip_atomic_fetch_add(flag,1u,__ATOMIC_RELAXED,__HIP_MEMORY_SCOPE_AGENT); }
    asm volatile("s_waitcnt vmcnt(0) lgkmcnt(0)\n\ts_barrier":::"memory");
    const unsigned old=*(volatile __attribute__((address_space(3))) unsigned*)((__attribute__((address_space(3))) char*)shm+LDS_OST);
    asm volatile("s_waitcnt lgkmcnt(0)\n\ts_barrier":::"memory");
    if(old==0u)return;
    __builtin_amdgcn_fence(__ATOMIC_ACQUIRE,"agent"); asm volatile("s_waitcnt vmcnt(0)":::"memory");
    #pragma unroll
    for(int r=0;r<16;++r){ const int row=crow(r,hi); const float mo=wsf[row],lo=wsf[32+row],mt=Po[QB*64+(wid*QBLK+row)*2],lt=Po[QB*64+(wid*QBLK+row)*2+1];
      const float m=__builtin_fmaxf(mo,mt),fo=__builtin_amdgcn_exp2f(mo-m),ft=__builtin_amdgcn_exp2f(mt-m),inv=__builtin_amdgcn_rcpf(lo*fo+lt*ft);
      #pragma unroll
      for(int d0=0;d0<2;++d0)o[d0][r]=(o[d0][r]*fo+Po[(wid*QBLK+row)*64+d0*32+r32]*ft)*inv;
      rli[r]=1.f; }
  } else {
  #pragma unroll
  for(int r=0;r<16;++r)rli[r]=__builtin_amdgcn_rcpf(wsf[32+crow(r,hi)]);
  }
  bf16*Ow=O+(rowbase+q0+wid*QBLK)*OPITCH+h*D;
  { bf16*stg=(bf16*)(shm+LDS_OST)+wid*2048;
    #pragma unroll
    for(int r=0;r<16;++r){const int orow=crow(r,hi);
      #pragma unroll
      for(int d0=0;d0<2;++d0)stg[orow*64+d0*32+r32]=__float2bfloat16(o[d0][r]*rli[r]);}
    asm volatile("s_waitcnt lgkmcnt(0)":::"memory");
    #pragma unroll
    for(int i=0;i<4;++i){const int row=i*8+(lane>>3),ch=lane&7; const u32x4 v=*(const u32x4*)(stg+row*64+ch*8); ATTN_STORE16(Ow+(long)row*OPITCH+ch*8,v);} }
  asm volatile("s_waitcnt lgkmcnt(0)\n\ts_barrier":::"memory");
  #undef CBIAS
  #undef CBLD
  #undef DMA_K
  #undef DMA_V
  #undef CMASK
  #undef START
  #undef RESC
  #undef ROT
}
constexpr int ATTN_LDS_BYTES=LDS_BYTES;
struct AttnTensors { const bf16* Q; const bf16* K; const bf16* V; bf16* O; const float* CF; const float* stat; };
struct AttnUnit { int bh; int qb; };
struct StaticOrder {
  int vcu;
  __device__ __forceinline__ explicit StaticOrder(int grid,int block):vcu((grid%8==0)?(block%8)*(grid/8)+block/8:block),G_(grid){}
  int G_;
  __device__ __forceinline__ bool next(int i,AttnUnit&u)const{ const int v=vcu+(i>>1)*G_; if(v>=256)return false; const int s=v&15; u.bh=v>>4; u.qb=(i&1)?31-s:s; return true; }
  __device__ __forceinline__ void a_ready(const AttnUnit&)const{}
  __device__ __forceinline__ void done(const AttnUnit&)const{}
};
struct QueueOrder {
  unsigned* ctr; __attribute__((address_space(3))) unsigned* slot;
  __device__ __forceinline__ bool next(int,AttnUnit&u)const{
    if(threadIdx.x==0)*slot=__hip_atomic_fetch_add(ctr,1u,__ATOMIC_RELAXED,__HIP_MEMORY_SCOPE_AGENT);
    asm volatile("s_waitcnt vmcnt(0) lgkmcnt(0)\n\ts_barrier":::"memory");
    const unsigned v=*(volatile __attribute__((address_space(3))) unsigned*)slot; const int vv=__builtin_amdgcn_readfirstlane((int)v);
    if(vv>=512)return false; u.qb=31-(vv>>4); u.bh=vv&15; return true; }
  __device__ __forceinline__ void a_ready(const AttnUnit&)const{}
  __device__ __forceinline__ void done(const AttnUnit&)const{}
};
template<class Sched,int THRL=8> __device__ __forceinline__ void attn_phase(char*lds,const AttnTensors&T,const Sched&S){
  AttnUnit u;
  for(int i=0;S.next(i,u);++i){ S.a_ready(u); const float Tsk=40.f+2.f*__builtin_sqrtf(T.stat[u.bh*2]*T.stat[u.bh*2+1])*1.01f+1.f;
    attn_unit<THRL>(u.bh/NHEAD,u.bh%NHEAD,u.qb,T.Q,T.K,T.V,T.O,T.CF+(long)u.bh*SEQ,Tsk,0,nullptr,nullptr,lds); S.done(u); }
}
#undef SBAR
#undef WAIT_BAR
}
#define GAS __attribute__((address_space(1)))
#define LAS __attribute__((address_space(3)))
typedef unsigned v4u __attribute__((ext_vector_type(4)));
typedef float f32x4 __attribute__((ext_vector_type(4)));
typedef short bf16x8 __attribute__((ext_vector_type(8)));
typedef GAS unsigned gu32;
typedef GAS unsigned long long gu64;
#define RLX_AGENT __ATOMIC_RELAXED, __HIP_MEMORY_SCOPE_AGENT
#define LDS_WAIT() asm volatile("s_waitcnt lgkmcnt(0)" ::: "memory")
#define VM_WAIT() asm volatile("s_waitcnt vmcnt(0)" ::: "memory")
__device__ __forceinline__ unsigned long long rt() { return __builtin_amdgcn_s_memrealtime(); }
__device__ __forceinline__ unsigned pk2(float lo, float hi) { return (unsigned)f2bf(lo) | ((unsigned)f2bf(hi) << 16); }

#define XB_TMO      128
#define XB_XCNT(j)  (256  + 64 * (j))
#define XB_XSUB(j)  (1280 + 64 * (j))
#define XB_XGEN(j)  (2304 + 64 * (j))
#define XB_TOP      3328
#define XB_TOPGEN   3392
#define XCD_BAR_WORDS 3456
#define XB_SPIN_CAP (1u << 18)

__device__ __forceinline__ unsigned xb_ld(unsigned* p)              { return __hip_atomic_load(p, __ATOMIC_RELAXED, __HIP_MEMORY_SCOPE_AGENT); }
__device__ __forceinline__ unsigned xb_add(unsigned* p, unsigned v) { return __hip_atomic_fetch_add(p, v, __ATOMIC_RELAXED, __HIP_MEMORY_SCOPE_AGENT); }
__device__ __forceinline__ unsigned xb_xcc_id() { return (unsigned)__builtin_amdgcn_s_getreg((3 << 11) | 20) & 0xFu; }
#define XB_SPIN(cond, bar) do { unsigned _sp = 0; while (cond) { __builtin_amdgcn_s_sleep(1); \
    if ((++_sp & 255u) == 0u) { if (xb_ld(&(bar)[XB_TMO])) break; if (_sp > XB_SPIN_CAP) { atomicAdd(&(bar)[XB_TMO], 1u); break; } } } } while (0)

struct XcdBarrier {
    unsigned* bar; unsigned x;
    volatile LAS unsigned* st;
};

__device__ __forceinline__ XcdBarrier xcd_barrier_post(unsigned* bar, volatile LAS unsigned* st) {
    XcdBarrier b; b.bar = bar; b.x = xb_xcc_id(); b.st = st;
    if (threadIdx.x == 0) (void)xb_add(&bar[XB_XCNT(b.x)], 1u);
    return b;
}
__device__ __forceinline__ void xcd_barrier_complete(unsigned* bar, unsigned x, unsigned& nloc, unsigned& nx) {
    const unsigned G = gridDim.x * gridDim.y * gridDim.z;
    unsigned sum, cnt, mine, sp = 0u;
    for (;;) {
        sum = 0u; cnt = 0u; mine = 0u;
#pragma unroll
        for (unsigned j = 0; j < 16; ++j) { const unsigned c = xb_ld(&bar[XB_XCNT(j)]); sum += c; cnt += (c > 0u) ? 1u : 0u; mine = (j == x) ? c : mine; }
        if (sum == G) break;
        __builtin_amdgcn_s_sleep(1);
        if ((++sp & 255u) == 0u) { if (xb_ld(&bar[XB_TMO])) break; if (sp > XB_SPIN_CAP) { atomicAdd(&bar[XB_TMO], 1u); break; } }
    }
    nloc = mine > 0u ? mine : 1u; nx = cnt > 0u ? cnt : 1u;
}

__device__ __forceinline__ void xcd_barrier(const XcdBarrier& b) {
    asm volatile("s_waitcnt vmcnt(0)" ::: "memory");
    __syncthreads();
    if (threadIdx.x == 0) {
        unsigned* bar = b.bar;
        __builtin_amdgcn_s_waitcnt(0);
        unsigned nloc = b.st[0], nx = b.st[1];
        if (nloc == 0u) { xcd_barrier_complete(bar, b.x, nloc, nx); b.st[0] = nloc; b.st[1] = nx; }
        const unsigned old = xb_add(&bar[XB_XSUB(b.x)], 1u);
        const unsigned gen = old / nloc;
        if (old + 1u == (gen + 1u) * nloc) {
            __builtin_amdgcn_fence(__ATOMIC_RELEASE, "agent");
            asm volatile("s_waitcnt vmcnt(0)" ::: "memory");
            const unsigned og = xb_add(&bar[XB_TOP], 1u);
            const unsigned tg = og / nx;
            if (og + 1u == (tg + 1u) * nx) xb_add(&bar[XB_TOPGEN], 1u);
            else XB_SPIN(xb_ld(&bar[XB_TOPGEN]) == tg, bar);
            __builtin_amdgcn_fence(__ATOMIC_ACQUIRE, "agent");
            xb_add(&bar[XB_XGEN(b.x)], 1u);
            asm volatile("s_waitcnt vmcnt(0)" ::: "memory");
        } else {
            XB_SPIN(xb_ld(&bar[XB_XGEN(b.x)]) == gen, bar);
            __builtin_amdgcn_fence(__ATOMIC_ACQUIRE, "agent");
            asm volatile("s_waitcnt vmcnt(0)" ::: "memory");
        }
    }
    __syncthreads();
}
constexpr int NWAVES = 8, NTHR = 512;
constexpr int RING_OFF = 0, RING_BYTES = 131072, LDSCTL_OFF = RING_BYTES, MISC_OFF = LDSCTL_OFF + 320, LDS_BYTES = 147456;
constexpr int CW_BAR = 4096;
constexpr size_t WS_WIN = WS_W  , WS_SWIN = WS_W + 8 * MiB  , WS_WOUT = WS_W + 14 * MiB  , WS_WDGU = WS_W + 18 * MiB  , WS_SWDGU = WS_W + 24 * MiB  , WS_WDDN = WS_W + 29 * MiB  ;
constexpr size_t WS_SH = WS_H + 16 * MiB  , WS_SXG = WS_XG + 34 * MiB  ;
constexpr size_t WS_WMGU = WS_W  , WS_SWMGU = WS_W + 60 * MiB  , WS_WMDN = WS_W + 64 * MiB  ;
static_assert(WS_WMDN + 56 * MiB <= 469 * MiB, "ws");
struct MArgs { const float* in[20]; float* out; unsigned char* ws; int ph_lo, ph_hi; };
enum { I_X = 0, I_ATTN_NORM, I_W_IN, I_HGRN_LB, I_HGRN_NORM, I_MLSTM_CONV, I_MLSTM_BI, I_MLSTM_BF, I_MLSTM_NORM, I_FOX_BF, I_W_OUT, I_FFN_NORM, I_DGATE, I_DUP, I_DDOWN, I_ROUTER, I_MGATE, I_MUP, I_MDOWN, I_FINAL_NORM };

__device__ __forceinline__ void tr_item(const float* W, int ldw, int K, bf16_t* WT, LAS float* scr, int k0, int lane) {
#pragma unroll 32
    for (int i = 0; i < 32; ++i) { const int kk = 2 * i + (lane >> 5); scr[kk * 33 + (lane & 31)] = W[(size_t)(k0 + kk) * ldw + (lane & 31)]; }
    LDS_WAIT(); asm volatile("" ::: "memory");
    const int c = lane & 7;
#pragma unroll
    for (int j = 0; j < 4; ++j) { const int n = (lane >> 3) + 8 * j; const LAS float* s = scr + (8 * c) * 33 + n;
        v4u o; o.x = pk2(s[0 * 33], s[1 * 33]); o.y = pk2(s[2 * 33], s[3 * 33]); o.z = pk2(s[4 * 33], s[5 * 33]); o.w = pk2(s[6 * 33], s[7 * 33]);
        *(GAS v4u*)(WT + (size_t)n * K + k0 + 8 * c) = o; }
    LDS_WAIT(); asm volatile("" ::: "memory");
}
__device__ __forceinline__ int glu_row(int c, int up) { return (c >> 7) * 256 + (c & 127) + up * 128; }

struct RowIn { float4 v[4]; };
template <bool BF> __device__ __forceinline__ void mrow_load(RowIn& R, const void* src, int row, int lane) {
    if (BF) { const uint2* xr = (const uint2*)((const bf16_t*)src + (size_t)row * D) + lane;
#pragma unroll
        for (int j = 0; j < 4; ++j) { const uint2 w = xr[64 * j]; R.v[j] = make_float4(__uint_as_float(w.x << 16), __uint_as_float(w.x & 0xffff0000u), __uint_as_float(w.y << 16), __uint_as_float(w.y & 0xffff0000u)); } }
    else { const float4* xr = (const float4*)((const float*)src + (size_t)row * D) + lane;
#pragma unroll
        for (int j = 0; j < 4; ++j) R.v[j] = xr[64 * j]; } }
template <int MODE> __device__ __forceinline__ void mrow(const RowIn& R, signed char* H8, float* SH, const float* gain, const LAS float* tab, float* G, int row, int lane, float (&lg)[8]) {
    float4 v[4]; float ss = 0.f;
#pragma unroll
    for (int j = 0; j < 4; ++j) { v[j] = R.v[j]; ss += v[j].x * v[j].x + v[j].y * v[j].y + v[j].z * v[j].z + v[j].w * v[j].w; }
    ss = wave_sum(ss);
    const float r = rsqrtf(ss * (1.f / D) + EPS);
    float h[16];
#pragma unroll
    for (int j = 0; j < 4; ++j) { const float4 g = *((const float4*)gain + 64 * j + lane);
        h[4 * j + 0] = v[j].x * r * g.x; h[4 * j + 1] = v[j].y * r * g.y; h[4 * j + 2] = v[j].z * r * g.z; h[4 * j + 3] = v[j].w * r * g.w; }
    { float am = 0.f;
#pragma unroll
      for (int i = 0; i < 16; ++i) am = fmaxf(am, fabsf(h[i]));
#pragma unroll
      for (int o = 1; o < 64; o <<= 1) am = fmaxf(am, __shfl_xor(am, o));
      const float inv = am > 0.f ? 127.f / am : 0.f;
#pragma unroll
      for (int j = 0; j < 4; ++j) { const int q0 = (int)rintf(h[4 * j] * inv), q1 = (int)rintf(h[4 * j + 1] * inv), q2 = (int)rintf(h[4 * j + 2] * inv), q3 = (int)rintf(h[4 * j + 3] * inv);
          *((unsigned*)(H8 + (size_t)row * D) + 64 * j + lane) = (unsigned)(q0 & 255) | ((unsigned)(q1 & 255) << 8) | ((unsigned)(q2 & 255) << 16) | ((unsigned)(q3 & 255) << 24); }
      if (lane == 0) SH[row] = am > 0.f ? am * (1.f / 127.f) : 1.f; }
    if (MODE == 0) {
        float mine = 0.f;
#pragma unroll 2
        for (int c = 0; c < 16; ++c) { float s = 0.f;
#pragma unroll
            for (int j = 0; j < 4; ++j) { const f32x4 w = *(const LAS f32x4*)(tab + c * 1024 + 256 * j + 4 * lane); s += h[4 * j] * w[0] + h[4 * j + 1] * w[1] + h[4 * j + 2] * w[2] + h[4 * j + 3] * w[3]; }
            s = wave_sum(s); if (lane == c) mine = s; }
        if (lane < 16) G[(size_t)row * GW + lane] = mine;
    }
    if (MODE == 2) {
        float v0 = -INFINITY, v1 = -INFINITY; int e0 = 0, e1 = 0;
#pragma unroll 2
        for (int c = 0; c < 8; ++c) { float s = 0.f;
#pragma unroll
            for (int j = 0; j < 4; ++j) { const f32x4 w = *(const LAS f32x4*)(tab + c * 1024 + 256 * j + 4 * lane); s += h[4 * j] * w[0] + h[4 * j + 1] * w[1] + h[4 * j + 2] * w[2] + h[4 * j + 3] * w[3]; }
            s = wave_sum(s);
            if (s > v0) { v1 = v0; e1 = e0; v0 = s; e0 = c; } else if (s > v1) { v1 = s; e1 = c; } }
        lg[0] = v0; lg[1] = v1; lg[2] = __int_as_float(e0); lg[3] = __int_as_float(e1);
    }
}
__device__ __forceinline__ void load_gate_tab(LAS float* tab, const float* w_in, int tid) {
    for (int k = tid; k < D; k += NTHR) { const float4* w0 = (const float4*)(w_in + (size_t)k * DIN + 1792); const float4* w1 = (const float4*)(w_in + (size_t)k * DIN + 3592);
        const float4 a0 = w0[0], a1 = w0[1], b0 = w1[0], b1 = w1[1];
        tab[0 * 1024 + k] = a0.x; tab[1 * 1024 + k] = a0.y; tab[2 * 1024 + k] = a0.z; tab[3 * 1024 + k] = a0.w; tab[4 * 1024 + k] = a1.x; tab[5 * 1024 + k] = a1.y; tab[6 * 1024 + k] = a1.z; tab[7 * 1024 + k] = a1.w;
        tab[8 * 1024 + k] = b0.x; tab[9 * 1024 + k] = b0.y; tab[10 * 1024 + k] = b0.z; tab[11 * 1024 + k] = b0.w; tab[12 * 1024 + k] = b1.x; tab[13 * 1024 + k] = b1.y; tab[14 * 1024 + k] = b1.z; tab[15 * 1024 + k] = b1.w; }
}
__device__ __forceinline__ void load_router_tab(LAS float* tab, const float* router, int tid) {
    for (int k = tid; k < D; k += NTHR) { const float4* w0 = (const float4*)(router + (size_t)k * NE); const float4 a0 = w0[0], a1 = w0[1];
        tab[0 * 1024 + k] = a0.x; tab[1 * 1024 + k] = a0.y; tab[2 * 1024 + k] = a0.z; tab[3 * 1024 + k] = a0.w; tab[4 * 1024 + k] = a1.x; tab[5 * 1024 + k] = a1.y; tab[6 * 1024 + k] = a1.z; tab[7 * 1024 + k] = a1.w; }
}
__device__ __forceinline__ void conv8_block(const float* W, int ldw, signed char* WT8, float* S, LAS float* img, LAS float* pm, int tid, int wave) {
    const int lane = tid & 63, n = lane & 31, kp = lane >> 5;
    float m = 0.f;
#pragma unroll 32
    for (int i = 0; i < 64; ++i) { const int k = 128 * wave + 2 * i + kp; const float v = W[(size_t)k * ldw + n]; img[k * 32 + n] = v; m = fmaxf(m, fabsf(v)); }
    m = fmaxf(m, __shfl_xor(m, 32));
    if (lane < 32) pm[wave * 32 + lane] = m;
    __syncthreads();
    const int no = lane >> 1, kh = 128 * wave + 64 * (lane & 1);
    float cm = 0.f;
#pragma unroll
    for (int w = 0; w < 8; ++w) cm = fmaxf(cm, pm[w * 32 + no]);
    const float inv = cm > 0.f ? 127.f / cm : 0.f;
    if (wave == 0 && (lane & 1) == 0) S[no] = cm > 0.f ? cm * (1.f / 127.f) : 1.f;
    const LAS float* sp = img + kh * 32 + no;
#pragma unroll
    for (int q = 0; q < 4; ++q) { unsigned wq[4];
#pragma unroll
        for (int j = 0; j < 4; ++j) { const int kk = 16 * q + 4 * j; const int q0 = (int)rintf(sp[kk * 32] * inv), q1 = (int)rintf(sp[(kk + 1) * 32] * inv), q2 = (int)rintf(sp[(kk + 2) * 32] * inv), q3 = (int)rintf(sp[(kk + 3) * 32] * inv);
            wq[j] = (unsigned)(q0 & 255) | ((unsigned)(q1 & 255) << 8) | ((unsigned)(q2 & 255) << 16) | ((unsigned)(q3 & 255) << 24); }
        v4u o; o.x = wq[0]; o.y = wq[1]; o.z = wq[2]; o.w = wq[3];
        *(GAS v4u*)(WT8 + (size_t)no * 1024 + kh + 16 * q) = o; }
    __syncthreads();
}
namespace scan {
typedef short bf16x8 __attribute__((ext_vector_type(8)));
typedef float f32x4 __attribute__((ext_vector_type(4)));
typedef unsigned v2u __attribute__((ext_vector_type(2)));
constexpr int TS = 144, TB = 64 * TS;
constexpr int L_T0 = 0, L_T1 = TB, L_T2 = 2 * TB, L_T3 = 3 * TB, L_T4 = 4 * TB, L_T5 = 5 * TB, L_O = 6 * TB, OS = 68  , L_PART = L_O + 64 * OS * 4, L_VEC = L_PART + 8 * 64 * 4, L_END = L_VEC + 8 * 64 * 4;
static_assert(L_END <= RING_BYTES, "scan LDS");
constexpr size_t SC_LHG = 0, SC_LML = 16 * MiB, SC_DEC = 32 * MiB  , SC_NL = 32 * MiB + 256 * 1024  , SC_AMAX = 32 * MiB + 512 * 1024, SC_BEND = SC_AMAX + 4096, SC_MPREV = SC_BEND + 4096;

__device__ __forceinline__ float wave_incl_add(float v, int lane) {
#pragma unroll
    for (int o = 1; o < 64; o <<= 1) { const float u = __shfl_up(v, o); if (lane >= o) v += u; }
    return v;
}
__device__ __forceinline__ float wave_incl_max(float v, int lane) {
#pragma unroll
    for (int o = 1; o < 64; o <<= 1) { const float u = __shfl_up(v, o); if (lane >= o) v = fmaxf(v, u); }
    return v;
}
__device__ __forceinline__ float wave_max(float v) {
#pragma unroll
    for (int o = 1; o < 64; o <<= 1) v = fmaxf(v, __shfl_xor(v, o));
    return v;
}
__device__ __forceinline__ f32x4 mma64(LAS const unsigned char* A, LAS const unsigned char* B, int m0, int n0, int lane, f32x4 acc) {
    const int r = lane & 15, kq = lane >> 4;
#pragma unroll
    for (int ks = 0; ks < 2; ++ks) {
        const bf16x8 a = *(LAS const bf16x8*)(A + (m0 + r) * TS + kq * 16 + ks * 64);
        const bf16x8 b = *(LAS const bf16x8*)(B + (n0 + r) * TS + kq * 16 + ks * 64);
        acc = __builtin_amdgcn_mfma_f32_16x16x32_bf16(a, b, acc, 0, 0, 0);
    }
    return acc;
}
__device__ __forceinline__ v4u pack8(const float (&v)[8]) { v4u w; w.x = pk2(v[0], v[1]); w.y = pk2(v[2], v[3]); w.z = pk2(v[4], v[5]); w.w = pk2(v[6], v[7]); return w; }
__device__ __forceinline__ v4u pack8h(const bf16_t (&v)[8]) { v4u w; w.x = v[0] | ((unsigned)v[1] << 16); w.y = v[2] | ((unsigned)v[3] << 16); w.z = v[4] | ((unsigned)v[5] << 16); w.w = v[6] | ((unsigned)v[7] << 16); return w; }
__device__ __forceinline__ void st16(LAS unsigned char* p, float v) { *(LAS bf16_t*)p = f2bf(v); }
__device__ __forceinline__ void load_state_tile(LAS unsigned char* T, const float* S, int tid) {
    const int v = tid >> 3, d0 = (tid & 7) * 8; const float4 x0 = *(const float4*)(S + v * 64 + d0), x1 = *(const float4*)(S + v * 64 + d0 + 4);
    v4u w; w.x = pk2(x0.x, x0.y); w.y = pk2(x0.z, x0.w); w.z = pk2(x1.x, x1.y); w.w = pk2(x1.z, x1.w);
    *(LAS v4u*)(T + v * TS + d0 * 2) = w;
}
__device__ __forceinline__ void local_state_mma_store(LAS unsigned char* L, float* LT, int wave, int lane) {
    const int mt = wave >> 1;
#pragma unroll
    for (int nn = 0; nn < 2; ++nn) { const int nt = 2 * (wave & 1) + nn; f32x4 acc = {0.f, 0.f, 0.f, 0.f};
        acc = mma64(L + L_T1, L + L_T0, mt * 16, nt * 16, lane, acc);
#pragma unroll
        for (int r = 0; r < 4; ++r) LT[(mt * 16 + 4 * (lane >> 4) + r) * 64 + nt * 16 + (lane & 15)] = acc[r]; }
}

struct HgIn { bf16_t fz[8], q[8], iv[8]; v4u gate; float4 s0, s1; };
template <bool DPH> __device__ __forceinline__ void hgrn_load(HgIn& R, const bf16_t* P, int b, int c, int h, const float* ST, int tid, int wave) {
    const int d = tid & 63, tq = wave, row0 = b * SEQ + c * 64; const bf16_t* pr = P + (size_t)(row0 + 8 * tq) * PW + h * 64 + d;
#pragma unroll
    for (int i = 0; i < 8; ++i) { R.fz[i] = pr[(size_t)i * PW + P_HF]; R.iv[i] = pr[(size_t)i * PW + P_HI]; if (DPH) R.q[i] = pr[(size_t)i * PW + P_HQ]; }
    if (DPH) { const int t = tid >> 3, v0 = (tid & 7) * 8; R.gate = *(const v4u*)(P + (size_t)(row0 + t) * PW + P_HG + h * 64 + v0);
        R.s0 = *(const float4*)(ST + t * 64 + v0); R.s1 = *(const float4*)(ST + t * 64 + v0 + 4); }
}
struct MlIn { bf16_t qr[11], kr[11], vv[8]; float ig, fg, np, mprev; v4u gate; float4 s0, s1; };
template <bool DPH> __device__ __forceinline__ void mlstm_load(MlIn& R, const bf16_t* P, const float* G, int b, int c, int h, const float* CT, const float* NP, const float* MP, int tid, int wave) {
    const int d = tid & 63, tq = wave, lane = tid & 63, row0 = b * SEQ + c * 64; const bool fz3 = (c == 0 && tq == 0);
    const bf16_t* pk = P + (size_t)(row0 + 8 * tq) * PW + P_MK + h * 64 + d; const bf16_t* pq = P + (size_t)(row0 + 8 * tq) * PW + P_MQ + h * 64 + d;
#pragma unroll
    for (int j = 0; j < 11; ++j) { R.kr[j] = (j < 3 && fz3) ? (bf16_t)0 : pk[((long)j - 3) * PW]; if (DPH) R.qr[j] = (j < 3 && fz3) ? (bf16_t)0 : pq[((long)j - 3) * PW]; }
#pragma unroll
    for (int i = 0; i < 8; ++i) R.vv[i] = P[(size_t)(row0 + 8 * tq + i) * PW + P_MV + h * 64 + d];
    R.ig = G[(size_t)(row0 + lane) * GW + h]; R.fg = G[(size_t)(row0 + lane) * GW + 4 + h];
    if (DPH) { const int t = tid >> 3, v0 = (tid & 7) * 8; R.gate = *(const v4u*)(P + (size_t)(row0 + t) * PW + P_MO + h * 64 + v0);
        R.s0 = *(const float4*)(CT + t * 64 + v0); R.s1 = *(const float4*)(CT + t * 64 + v0 + 4); R.np = NP[lane]; R.mprev = MP[0]; }
}
__device__ __forceinline__ void store_state_tile(LAS unsigned char* T, const float4& x0, const float4& x1, int tid) {
    const int v = tid >> 3, d0 = (tid & 7) * 8; v4u w; w.x = pk2(x0.x, x0.y); w.y = pk2(x0.z, x0.w); w.z = pk2(x1.x, x1.y); w.w = pk2(x1.z, x1.w);
    *(LAS v4u*)(T + v * TS + d0 * 2) = w;
}
__device__ __forceinline__ void conv_silu8r(const bf16_t (&raw)[11], const float* w4  , float scale, float (&out)[8]) {
    const float w0 = w4[0], w1 = w4[512], w2 = w4[1024], w3 = w4[1536];
#pragma unroll
    for (int i = 0; i < 8; ++i) out[i] = siluf_(w0 * bf2f(raw[i]) + w1 * bf2f(raw[i + 1]) + w2 * bf2f(raw[i + 2]) + w3 * bf2f(raw[i + 3])) * scale;
}
__device__ __forceinline__ void hgrn_b_item(LAS unsigned char* L, const HgIn& R, float lb, float* LT, float* DEC, int tid, int wave) {
    const int d = tid & 63, tq = wave;
    float bl[8], kh[8]; float run = 0.f;
#pragma unroll
    for (int i = 0; i < 8; ++i) { const float fz = bf2f(R.fz[i]);
        const float sg = sigmoidf_(fz), f = lb + (1.f - lb) * sg; kh[i] = (1.f - lb) * (1.f - sg); run += __logf(f); bl[i] = run; }
    LAS float* part = (LAS float*)(L + L_PART);
    part[tq * 64 + d] = run; __syncthreads();
    float off = 0.f, btot = 0.f;
#pragma unroll
    for (int w = 0; w < 8; ++w) { const float pv = part[w * 64 + d]; btot += pv; if (w < tq) off += pv; }
#pragma unroll
    for (int i = 0; i < 8; ++i) kh[i] *= __expf(btot - (off + bl[i]));
    *(LAS v4u*)(L + L_T0 + d * TS + tq * 16) = pack8(kh);
    *(LAS v4u*)(L + L_T1 + d * TS + tq * 16) = pack8h(R.iv);
    if (tq == 0) DEC[d] = __expf(btot);
    __syncthreads();
    local_state_mma_store(L, LT, wave, tid & 63);
    __syncthreads();
}
__device__ __forceinline__ void mlstm_gates(float ig, float fg, const float* b_i, const float* b_f, int h, int lane, float& bcum, float& a) {
    bcum = wave_incl_add(log_sigmoidf_(fg + b_f[h]), lane); a = ig + b_i[h] - bcum;
}
__device__ __forceinline__ void mlstm_b_item(LAS unsigned char* L, const MlIn& R, const float* conv, const float* b_i, const float* b_f, int h, float* LT, float* NL, float* AMAX, float* BEND, int tid, int wave) {
    const int d = tid & 63, tq = wave, lane = tid & 63;
    float bcum, a; mlstm_gates(R.ig, R.fg, b_i, b_f, h, lane, bcum, a);
    const float A = wave_max(a), bend = __shfl(bcum, 63);
    float kh[8]; conv_silu8r(R.kr, conv + 256 + h * 64 + d, 0.125f, kh);
    float nsum = 0.f;
#pragma unroll
    for (int i = 0; i < 8; ++i) { kh[i] *= __expf(__shfl(a, 8 * tq + i) - A); nsum += bf2f(f2bf(kh[i])); }
    *(LAS v4u*)(L + L_T0 + d * TS + tq * 16) = pack8(kh);
    *(LAS v4u*)(L + L_T1 + d * TS + tq * 16) = pack8h(R.vv);
    LAS float* part = (LAS float*)(L + L_PART); part[tq * 64 + d] = nsum;
    __syncthreads();
    if (tq == 0) { float s = 0.f;
#pragma unroll
        for (int w = 0; w < 8; ++w) s += part[w * 64 + d];
        NL[d] = s; if (lane == 0) { AMAX[0] = A; BEND[0] = bend; } }
    local_state_mma_store(L, LT, wave, lane);
    __syncthreads();
}
__device__ __forceinline__ void fox_cumsum_item(LAS unsigned char* L, const float* G, const float* fox_bf, float* CF, int bh, int tid, int wave) {
    const int b = bh >> 3, h = bh & 7, lane = tid & 63; const float bf = fox_bf[h];
    float loc[16]; float s = 0.f;
#pragma unroll
    for (int i = 0; i < 16; ++i) { s += log_sigmoidf_(G[((size_t)b * SEQ + tid * 16 + i) * GW + 8 + h] + bf); loc[i] = s; }
    const float incl = wave_incl_add(s, lane);
    LAS float* wt = (LAS float*)(L + L_PART);
    if (lane == 63) wt[wave] = incl;
    __syncthreads();
    float off = incl - s;
#pragma unroll
    for (int w = 0; w < 8; ++w) if (w < wave) off += wt[w];
#pragma unroll
    for (int i = 0; i < 16; ++i) CF[(size_t)bh * SEQ + tid * 16 + i] = (off + loc[i]) * LOG2E;
    __syncthreads();
}

template <bool DUMMY = false> __device__ __forceinline__ void scan_c_block(unsigned char* sc, int j, int tid) {
    constexpr size_t DOFF = DUMMY ? 104 * MiB / 4 : 0;
    constexpr int CB = 16;
    if (j < 128) {
        if (tid < 256) { const int chain = j >> 4, e = (j & 15) * 256 + tid, b = chain >> 2, h = chain & 3;
            float* p = (float*)(sc + SC_LHG) + ((size_t)(b * 128) * 4 + h) * 4096 + e; const float* dp = (const float*)(sc + SC_DEC) + ((size_t)(b * 128) * 4 + h) * 64 + (e & 63);
            float S = 0.f;
            for (int c0 = 0; c0 < 128; c0 += CB) { float Lc[CB], dc[CB];
#pragma unroll
                for (int i = 0; i < CB; ++i) { Lc[i] = p[(size_t)(c0 + i) * 4 * 4096]; dc[i] = dp[(size_t)(c0 + i) * 4 * 64]; }
#pragma unroll
                for (int i = 0; i < CB; ++i) { const float So = S; S = dc[i] * S + Lc[i]; Lc[i] = So; }
#pragma unroll
                for (int i = 0; i < CB; ++i) (p + DOFF)[(size_t)(c0 + i) * 4 * 4096] = Lc[i]; } }
    } else {
        const int jj = j - 128, chain = jj >> 4, part = jj & 15, b = chain >> 2, h = chain & 3;
        if (tid < 260) { const bool isn = tid >= 256; const size_t it0 = (size_t)(b * 128) * 4 + h;
            float* p = isn ? (float*)(sc + SC_NL) + it0 * 64 + part * 4 + (tid - 256) : (float*)(sc + SC_LML) + it0 * 4096 + part * 256 + tid;
            const size_t stride = isn ? 4 * 64 : 4 * 4096;
            const float* am = (const float*)(sc + SC_AMAX) + it0; const float* be = (const float*)(sc + SC_BEND) + it0; float* mp = (float*)(sc + SC_MPREV) + it0;
            const bool writer = (part == 0 && tid == 0);
            float S = 0.f, m = 0.f;
            for (int c0 = 0; c0 < 128; c0 += CB) { float Lc[CB], A[CB], bb[CB];
#pragma unroll
                for (int i = 0; i < CB; ++i) { Lc[i] = p[(size_t)(c0 + i) * stride]; A[i] = am[(c0 + i) * 4]; bb[i] = be[(c0 + i) * 4]; }
#pragma unroll
                for (int i = 0; i < CB; ++i) { const float Mx = fmaxf(m, A[i]), So = S; S = __expf(m - Mx) * S + __expf(A[i] - Mx) * Lc[i]; Lc[i] = So; A[i] = m; m = bb[i] + Mx; }
#pragma unroll
                for (int i = 0; i < CB; ++i) { (p + DOFF)[(size_t)(c0 + i) * stride] = Lc[i]; if (writer) (mp + DOFF)[(c0 + i) * 4] = A[i]; } } }
    }
}

template <bool SIG> __device__ __forceinline__ void head_epilogue(LAS unsigned char* L, float inv, const v4u& gw  , const float* gain  , bf16_t* out  , int tid) {
    const int t = tid >> 3, v0 = (tid & 7) * 8; const LAS float* o = (const LAS float*)(L + L_O) + t * OS + v0;
    float x[8]; float ss = 0.f;
#pragma unroll
    for (int i = 0; i < 8; ++i) { x[i] = o[i] * inv; ss += x[i] * x[i]; }
    ss += __shfl_xor(ss, 1); ss += __shfl_xor(ss, 2); ss += __shfl_xor(ss, 4);
    const float r = rsqrtf(ss * (1.f / 64.f) + EPS);
    const unsigned gu[4] = {gw.x, gw.y, gw.z, gw.w};
    float y[8];
#pragma unroll
    for (int i = 0; i < 8; ++i) { const float gz = bf2f((bf16_t)((gu[i >> 1] >> (16 * (i & 1))) & 0xffff)); y[i] = x[i] * r * gain[i] * (SIG ? sigmoidf_(gz) : siluf_(gz)); }
    *(v4u*)out = pack8(y);
}
__device__ __forceinline__ void store_o_tiles(LAS unsigned char* L, LAS const unsigned char* A1, LAS const unsigned char* B1, LAS const unsigned char* A2, LAS const unsigned char* B2, int wave, int lane) {
    const int mt = wave >> 1;
#pragma unroll
    for (int nn = 0; nn < 2; ++nn) { const int nt = 2 * (wave & 1) + nn; f32x4 acc = {0.f, 0.f, 0.f, 0.f};
        acc = mma64(A1, B1, mt * 16, nt * 16, lane, acc); acc = mma64(A2, B2, mt * 16, nt * 16, lane, acc);
        LAS float* o = (LAS float*)(L + L_O);
#pragma unroll
        for (int r = 0; r < 4; ++r) o[(mt * 16 + 4 * (lane >> 4) + r) * OS + nt * 16 + (lane & 15)] = acc[r]; }
}
__device__ __forceinline__ void hgrn_d_item(LAS unsigned char* L, const HgIn& R, float lb, const float* gain  , bf16_t* out  , int tid, int wave) {
    const int d = tid & 63, tq = wave, lane = tid & 63;
    float bl[8], kk[8], q[8]; float run = 0.f;
#pragma unroll
    for (int i = 0; i < 8; ++i) { const float fz = bf2f(R.fz[i]); q[i] = bf2f(R.q[i]);
        const float sg = sigmoidf_(fz), f = lb + (1.f - lb) * sg; kk[i] = (1.f - lb) * (1.f - sg); run += __logf(f); bl[i] = run; }
    LAS float* part = (LAS float*)(L + L_PART);
    part[tq * 64 + d] = run;
    store_state_tile(L + L_T4, R.s0, R.s1, tid);
    *(LAS v4u*)(L + L_T3 + d * TS + tq * 16) = pack8h(R.iv);
    __syncthreads();
    float off = 0.f, bref = 0.f;
#pragma unroll
    for (int w = 0; w < 8; ++w) { const float pv = part[w * 64 + d]; if (w < 4) bref += pv; if (w < tq) off += pv; }
#pragma unroll
    for (int i = 0; i < 8; ++i) { const float bb = off + bl[i]; const int t = 8 * tq + i;
        st16(L + L_T0 + t * TS + d * 2, q[i] * __expf(bb - bref));
        st16(L + L_T1 + t * TS + d * 2, kk[i] * __expf(bref - bb));
        st16(L + L_T2 + t * TS + d * 2, q[i] * __expf(bb)); }
    __syncthreads();
    { const int mt = wave >> 1;
#pragma unroll
      for (int nn = 0; nn < 2; ++nn) { const int nt = 2 * (wave & 1) + nn; f32x4 acc = {0.f, 0.f, 0.f, 0.f};
          acc = mma64(L + L_T1, L + L_T0, mt * 16, nt * 16, lane, acc);
          const int s0 = mt * 16 + 4 * (lane >> 4), t = nt * 16 + (lane & 15);
          v2u w; w.x = pk2(s0 <= t ? acc[0] : 0.f, s0 + 1 <= t ? acc[1] : 0.f); w.y = pk2(s0 + 2 <= t ? acc[2] : 0.f, s0 + 3 <= t ? acc[3] : 0.f);
          *(LAS v2u*)(L + L_T5 + t * TS + s0 * 2) = w; } }
    __syncthreads();
    store_o_tiles(L, L + L_T5, L + L_T3, L + L_T2, L + L_T4, wave, lane);
    __syncthreads();
    { const int t = tid >> 3, v0 = (tid & 7) * 8; head_epilogue<false>(L, 1.f, R.gate, gain + v0, out + (size_t)t * D + v0, tid); }
    __syncthreads();
}
__device__ __forceinline__ void mlstm_d_item(LAS unsigned char* L, const MlIn& R, const float* conv, const float* b_i, const float* b_f, const float* gain  , int h, bf16_t* out  , int tid, int wave) {
    const int d = tid & 63, tq = wave, lane = tid & 63; const float mprev = R.mprev;
    float bcum, a; mlstm_gates(R.ig, R.fg, b_i, b_f, h, lane, bcum, a);
    const float M = fmaxf(wave_incl_max(a, lane), mprev), sint = __expf(mprev - M);
    LAS float* vec = (LAS float*)(L + L_VEC);
    if (wave == 0) { vec[lane] = a; vec[64 + lane] = M; vec[128 + lane] = __expf(-bcum - M); vec[192 + lane] = R.np; }
    float qc[8], kc[8];
    conv_silu8r(R.qr, conv + h * 64 + d, 1.f, qc);
    conv_silu8r(R.kr, conv + 256 + h * 64 + d, 0.125f, kc);
#pragma unroll
    for (int i = 0; i < 8; ++i) { const int t = 8 * tq + i;
        st16(L + L_T0 + t * TS + d * 2, qc[i]);
        st16(L + L_T1 + t * TS + d * 2, kc[i]);
        st16(L + L_T2 + t * TS + d * 2, qc[i] * __shfl(sint, t)); }
    *(LAS v4u*)(L + L_T3 + d * TS + tq * 16) = pack8h(R.vv);
    store_state_tile(L + L_T4, R.s0, R.s1, tid);
    __syncthreads();
    { const int mt = wave >> 1;
#pragma unroll
      for (int nn = 0; nn < 2; ++nn) { const int nt = 2 * (wave & 1) + nn; f32x4 acc = {0.f, 0.f, 0.f, 0.f};
          acc = mma64(L + L_T1, L + L_T0, mt * 16, nt * 16, lane, acc);
          const int s0 = mt * 16 + 4 * (lane >> 4), t = nt * 16 + (lane & 15); const float Mt = vec[64 + t];
          float wv[4];
#pragma unroll
          for (int r = 0; r < 4; ++r) wv[r] = (s0 + r <= t) ? acc[r] * __expf(vec[s0 + r] - Mt) : 0.f;
          v2u w; w.x = pk2(wv[0], wv[1]); w.y = pk2(wv[2], wv[3]); *(LAS v2u*)(L + L_T5 + t * TS + s0 * 2) = w; } }
    __syncthreads();
    store_o_tiles(L, L + L_T5, L + L_T3, L + L_T2, L + L_T4, wave, lane);
    __syncthreads();
    { const int t = tid >> 3, c8 = (tid & 7) * 8;
      const v4u pw = *(LAS const v4u*)(L + L_T5 + t * TS + c8 * 2), qw = *(LAS const v4u*)(L + L_T2 + t * TS + c8 * 2);
      const unsigned pu[4] = {pw.x, pw.y, pw.z, pw.w}, qu[4] = {qw.x, qw.y, qw.z, qw.w}; float den = 0.f;
#pragma unroll
      for (int i = 0; i < 8; ++i) { den += bf2f((bf16_t)((pu[i >> 1] >> (16 * (i & 1))) & 0xffff)) + bf2f((bf16_t)((qu[i >> 1] >> (16 * (i & 1))) & 0xffff)) * vec[192 + c8 + i]; }
      den += __shfl_xor(den, 1); den += __shfl_xor(den, 2); den += __shfl_xor(den, 4);
      const float inv = 1.f / fmaxf(fabsf(den), vec[128 + t]);
      head_epilogue<true>(L, inv, R.gate, gain + c8, out + (size_t)t * D + c8, tid); }
    __syncthreads();
}
}
constexpr int N_PHASES = 22;
template <int PH, bool REP = false> __device__ __forceinline__ void run_phase(const MArgs& a, LAS unsigned char* L, const int tid, const int wave, const int G, const int bx, const int vcu) {
    const int lane = tid & 63, gw = vcu * NWAVES + wave, NGW = G * NWAVES;
    unsigned char* ws = a.ws; bf16_t* X = (bf16_t*)a.out;
    int* ctl = (int*)(ws + WS_CTL); int* cnt = ctl + CW_CNT;
    float* Gt = (float*)(ws + WS_G); float* CF = (float*)(ws + WS_CF); int4* tokinfo = (int4*)(ws + WS_TOKINFO); float2* tgate = (float2*)(ws + WS_TGATE); int* toklist = (int*)(ws + WS_TOKLIST);
    bf16_t* P = (bf16_t*)(ws + WS_P); bf16_t* HID = (bf16_t*)(ws + WS_HID); signed char* H = (signed char*)(ws + WS_H); float* SH = (float*)(ws + WS_SH); bf16_t* MIX = (bf16_t*)(ws + WS_MIX);
    signed char* XG = (signed char*)(ws + WS_XG); float* SXG = (float*)(ws + WS_SXG); bf16_t* Y = (bf16_t*)(ws + WS_XG);
    LAS float* scr = (LAS float*)(L + RING_OFF + wave * 16384);
    (void)ctl; (void)Gt; (void)CF; (void)tokinfo; (void)tgate; (void)toklist; (void)P; (void)HID; (void)H; (void)SH; (void)SXG; (void)MIX; (void)XG; (void)Y; (void)scr; (void)cnt; (void)lane; (void)gw; (void)NGW;
    constexpr int p = PH, l = p >= 10 ? 1 : 0, k = p == 0 ? -1 : (l ? p - 10 : p - 1);
    if constexpr (p == 0) {
            LAS float* img = (LAS float*)(L + RING_OFF); LAS float* pm = (LAS float*)(L + LDSCTL_OFF + 1024);
            for (int it = vcu; it < 400; it += G) {
                int r = it;
                if (r < 224) { const int ll = r / 112, nb = r % 112, sc = 32 * nb + (nb >= 56 ? 8 : 0);
                    conv8_block(a.in[I_W_IN] + (size_t)ll * D * DIN + sc, DIN, (signed char*)(ws + WS_WIN) + (size_t)ll * PW * D + (size_t)32 * nb * D, (float*)(ws + WS_SWIN) + ll * PW + 32 * nb, img, pm, tid, wave); }
                else { r -= 224; const int up = r / 88, nb = r % 88, c = 32 * nb;
                    conv8_block((up ? a.in[I_DUP] : a.in[I_DGATE]) + c, FF, (signed char*)(ws + WS_WDGU) + (size_t)glu_row(c, up) * D, (float*)(ws + WS_SWDGU) + glu_row(c, up), img, pm, tid, wave); }
            }
            for (int it = gw; it < 2432; it += NGW) {
                int r = it;
                if (r < 1024) { const int ll = r / 512; r %= 512; const int kb = r / 32, nb = r % 32;
                    tr_item(a.in[I_W_OUT] + (size_t)ll * D * D + 32 * nb, D, D, (bf16_t*)(ws + WS_WOUT) + (size_t)ll * D * D + (size_t)32 * nb * D, scr, 64 * kb, lane); continue; }
                r -= 1024;
                { const int kb = r / 32, nb = r % 32; tr_item(a.in[I_DDOWN] + 32 * nb, D, FF, (bf16_t*)(ws + WS_WDDN) + (size_t)32 * nb * FF, scr, 64 * kb, lane); }
            }
            __syncthreads();
            LAS float* tab = (LAS float*)(L + RING_OFF); load_gate_tab(tab, a.in[I_W_IN], tid); __syncthreads();
            float lg[8];
            { RowIn R, Rn; int row = gw; if (row < NTOK) mrow_load<false>(R, a.in[I_X], row, lane);
              for (; row < NTOK; row += NGW) { const int nx = row + NGW; if (nx < NTOK) mrow_load<false>(Rn, a.in[I_X], nx, lane); asm volatile("" ::: "memory");
                  mrow<0>(R, H, SH, a.in[I_ATTN_NORM], tab, Gt, row, lane, lg); if (nx < NTOK) R = Rn; } }
        } else if constexpr (k == 0) {
            { const int cb = (G >= 144) ? bx - 128 : bx; for (int bh = cb; bh >= 0 && bh < 16; bh += G) scan::fox_cumsum_item(L, Gt, a.in[I_FOX_BF] + l * 8, CF, bh, tid, wave); }
            pg8::GOrder S; S.so.init(NTOK, PW, G, bx); S.A = (const char*)H; S.B = (const char*)(ws + WS_WIN) + (size_t)l * PW * D; S.a_tile = (size_t)256 * D; S.b_tile = (size_t)256 * D; S.b_exp = 0;
            S.tb1 = S.tb2 = S.tb3 = S.tb4 = S.tb5 = S.tb6 = S.tb7 = 0x7fffffff;
            pg8::EpiBf8 E; E.O = P; E.ldc = PW; E.s_lo = P_FQ / 256; E.s_hi = P_FK / 256; E.scale = QSCALE; E.sA = SH; E.sB = (const float*)(ws + WS_SWIN) + l * PW; E.sc = (LAS float*)(L + LDSCTL_OFF + 4096);
            pg8::Gemm g{D / 2};
            pg8::gemm_phase<pg8::EpiBf8, pg8::GOrder, true, true, true>(L + RING_OFF, g, S, E);
        } else if constexpr (l == 1 && k == 9) {
            pg8::GOrder S; pg8::EpiBf E; int t[8]; int acc = 0;
#pragma unroll
            for (int e = 0; e < NE; ++e) { t[e] = acc; acc += (cnt[e] + 255) >> 8; }
            S.so.init(acc * 256, D, G, bx); S.A = (const char*)HID; S.B = (const char*)(ws + WS_WMDN); S.a_tile = (size_t)256 * FE * 2; S.b_tile = (size_t)256 * FE * 2; S.b_exp = (size_t)D * FE * 2;
            S.tb1 = t[1]; S.tb2 = t[2]; S.tb3 = t[3]; S.tb4 = t[4]; S.tb5 = t[5]; S.tb6 = t[6]; S.tb7 = t[7]; E.O = Y; E.ldc = D; E.s_lo = 0; E.s_hi = 0; E.scale = 1.f;
            pg8::Gemm g{FE};
            pg8::gemm_phase<pg8::EpiBf, pg8::GOrder, true, true>(L + RING_OFF, g, S, E);
        } else if constexpr (k == 4 || (l == 0 && k == 7)) {
            pg8::GOrder S; S.so.init(NTOK, D, G, bx); S.b_exp = 0; S.tb1 = S.tb2 = S.tb3 = S.tb4 = S.tb5 = S.tb6 = S.tb7 = 0x7fffffff; int K;
            if constexpr (k == 4) { K = D; S.A = (const char*)MIX; S.B = (const char*)(ws + WS_WOUT) + (size_t)l * D * D * 2; }
            else { K = FF; S.A = (const char*)HID; S.B = (const char*)(ws + WS_WDDN); }
            S.a_tile = (size_t)256 * K * 2; S.b_tile = (size_t)256 * K * 2;
            pg8::Gemm g{K};
            if constexpr (k == 4 && l == 0) { pg8::EpiResid<true> E{a.in[I_X], X, D}; pg8::gemm_phase<pg8::EpiResid<true>, pg8::GOrder, true, true>(L + RING_OFF, g, S, E); }
            else { pg8::EpiResid<false> E{X, X, D}; pg8::gemm_phase<pg8::EpiResid<false>, pg8::GOrder, true, true>(L + RING_OFF, g, S, E); }
        } else if constexpr ((l == 0 && k == 6) || (l == 1 && k == 7)) {
            pg8::GOrder S; pg8::EpiSwiglu8 E; S.a_tile = (size_t)256 * D; S.b_tile = (size_t)256 * D; E.O = HID; E.sc = (LAS float*)(L + LDSCTL_OFF + 4096);
            if constexpr (l == 0) { S.so.init(NTOK, 2 * FF, G, bx); S.A = (const char*)H; S.B = (const char*)(ws + WS_WDGU); S.b_exp = 0; S.tb1 = S.tb2 = S.tb3 = S.tb4 = S.tb5 = S.tb6 = S.tb7 = 0x7fffffff;
                E.ldc = FF; E.sA = SH; E.sB = (const float*)(ws + WS_SWDGU); E.sb_exp = 0; }
            else { int t[8]; int acc = 0;
#pragma unroll
                for (int e = 0; e < NE; ++e) { t[e] = acc; acc += (cnt[e] + 255) >> 8; }
                S.so.init(acc * 256, 2 * FE, G, bx); S.A = (const char*)XG; S.B = (const char*)(ws + WS_WMGU); S.b_exp = (size_t)2 * FE * D;
                S.tb1 = t[1]; S.tb2 = t[2]; S.tb3 = t[3]; S.tb4 = t[4]; S.tb5 = t[5]; S.tb6 = t[6]; S.tb7 = t[7]; E.ldc = FE; E.sA = SXG; E.sB = (const float*)(ws + WS_SWMGU); E.sb_exp = 2 * FE; }
            E.tb1 = S.tb1; E.tb2 = S.tb2; E.tb3 = S.tb3; E.tb4 = S.tb4; E.tb5 = S.tb5; E.tb6 = S.tb6; E.tb7 = S.tb7;
            pg8::Gemm g{D / 2};
            pg8::gemm_phase<pg8::EpiSwiglu8, pg8::GOrder, true, true, true>(L + RING_OFF, g, S, E);
        } else if constexpr (k == 5 && l == 0) {
            float lg[8];
            { RowIn R, Rn; int row = gw; if (row < NTOK) mrow_load<true>(R, X, row, lane);
              for (; row < NTOK; row += NGW) { const int nx = row + NGW; if (nx < NTOK) mrow_load<true>(Rn, X, nx, lane); asm volatile("" ::: "memory");
                  mrow<1>(R, H, SH, a.in[I_FFN_NORM], nullptr, nullptr, row, lane, lg); if (nx < NTOK) R = Rn; } }
        } else if constexpr (k == 8 && l == 0) {
            LAS float* tab = (LAS float*)(L + RING_OFF); load_gate_tab(tab, a.in[I_W_IN] + (size_t)D * DIN, tid); __syncthreads();
            float lg[8];
            { RowIn R, Rn; int row = gw; if (row < NTOK) mrow_load<true>(R, X, row, lane);
              for (; row < NTOK; row += NGW) { const int nx = row + NGW; if (nx < NTOK) mrow_load<true>(Rn, X, nx, lane); asm volatile("" ::: "memory");
                  mrow<0>(R, H, SH, a.in[I_ATTN_NORM] + D, tab, Gt, row, lane, lg); if (nx < NTOK) R = Rn; } }
        } else if constexpr (k == 5 && l == 1) {
            LAS int* sel_e = (LAS int*)(L + RING_OFF);
            LAS float* sel_g = (LAS float*)(L + RING_OFF + 512);
            LAS int* lcnt = (LAS int*)(L + RING_OFF + 1024);
            LAS float* tab = (LAS float*)(L + RING_OFF + 4096); load_router_tab(tab, a.in[I_ROUTER], tid); __syncthreads();
            for (int rb = bx; rb < NTOK / 64; rb += G) {
                if (tid < 16) lcnt[tid] = 0;
                RowIn R, Rn; mrow_load<true>(R, X, rb * 64 + wave * 8, lane);
                for (int i = 0; i < 8; ++i) { const int rl = wave * 8 + i, row = rb * 64 + rl; float lg[8];
                    if (i < 7) mrow_load<true>(Rn, X, row + 1, lane); asm volatile("" ::: "memory");
                    mrow<2>(R, H, SH, a.in[I_FFN_NORM] + D, tab, nullptr, row, lane, lg); if (i < 7) R = Rn;
                    if (lane == 0) { const float v0 = lg[0], v1 = lg[1]; const int e0 = __float_as_int(lg[2]), e1 = __float_as_int(lg[3]);
                        const float g1 = 1.f / (1.f + __expf(v0 - v1));
                        sel_e[2 * rl] = e0; sel_e[2 * rl + 1] = e1; sel_g[2 * rl] = 1.f - g1; sel_g[2 * rl + 1] = g1; } }
                __syncthreads();
                int e0 = 0, e1 = 0, r0 = 0, r1 = 0;
                if (tid < 64) { e0 = sel_e[2 * tid]; e1 = sel_e[2 * tid + 1]; r0 = __hip_atomic_fetch_add(lcnt + e0, 1, __ATOMIC_RELAXED, __HIP_MEMORY_SCOPE_WORKGROUP); r1 = __hip_atomic_fetch_add(lcnt + e1, 1, __ATOMIC_RELAXED, __HIP_MEMORY_SCOPE_WORKGROUP); }
                __syncthreads();
                if (tid < 8) lcnt[8 + tid] = atomicAdd(cnt + tid, (int)lcnt[tid]);
                __syncthreads();
                if (tid < 64) { const int row = rb * 64 + tid, s0 = lcnt[8 + e0] + r0, s1 = lcnt[8 + e1] + r1;
                    toklist[e0 * NTOK + s0] = row; toklist[e1 * NTOK + s1] = row; tokinfo[row] = make_int4(e0, s0, e1, s1); tgate[row] = make_float2(sel_g[2 * tid], sel_g[2 * tid + 1]); }
                __syncthreads();
            }
        } else if constexpr (k == 6 && l == 1) {
            { int base[NE]; int acc = 0;
#pragma unroll
              for (int e = 0; e < NE; ++e) { base[e] = acc; acc += (cnt[e] + 255) & ~255; }
              for (int r = gw; r < acc; r += NGW) { int e = 0, be = 0;
#pragma unroll
                  for (int c = 1; c < NE; ++c) if (r >= base[c]) { e = c; be = base[c]; }
                  const int s = r - be; v4u v0 = {0u, 0u, 0u, 0u}; float sv = 0.f;
                  if (s < cnt[e]) { const int tok = toklist[e * NTOK + s]; v0 = *((const v4u*)(H + (size_t)tok * D) + lane); sv = SH[tok]; }
                  *((v4u*)(XG + (size_t)r * D) + lane) = v0; if (lane == 0) SXG[r] = sv; } }
            __syncthreads();
            { LAS float* img = (LAS float*)(L + RING_OFF); LAS float* pm = (LAS float*)(L + LDSCTL_OFF + 1024);
              for (int it = vcu; it < 1792; it += G) { const int e = it / 224; int r = it % 224; const int up = r / 112, nb = r % 112, c = 32 * nb;
                  conv8_block((up ? a.in[I_MUP] : a.in[I_MGATE]) + (size_t)e * D * FE + c, FE, (signed char*)(ws + WS_WMGU) + (size_t)e * 2 * FE * D + (size_t)glu_row(c, up) * D, (float*)(ws + WS_SWMGU) + e * 2 * FE + glu_row(c, up), img, pm, tid, wave); } }
            for (int it = gw; it < 14336; it += NGW) { const int e = it / 1792, r = it % 1792, kb = r / 32, nb = r % 32;
                tr_item(a.in[I_MDOWN] + (size_t)e * FE * D + 32 * nb, D, FE, (bf16_t*)(ws + WS_WMDN) + (size_t)e * D * FE + (size_t)32 * nb * FE, scr, 64 * kb, lane); }
        } else if constexpr (k == 8 && l == 1) {
        } else if constexpr (l == 1 && (k == 10 || k == 11)) {
            int base[NE]; { int acc = 0;
#pragma unroll
              for (int e = 0; e < NE; ++e) { base[e] = acc; acc += (cnt[e] + 255) & ~255; } }
            constexpr int HALFR = NTOK / 2; constexpr int rlo = (k == 10) ? HALFR : 0;
            bf16_t* stash = (bf16_t*)(ws + WS_H);
            const bf16_t* Xs = (k == 10) ? X + (size_t)HALFR * D : stash;
            float* out = (float*)a.out;
            if constexpr (k == 10) { for (int r = gw; r < HALFR; r += NGW) { const v4u* s4 = (const v4u*)(X + (size_t)r * D); v4u* d4 = (v4u*)(stash + (size_t)r * D); d4[lane] = s4[lane]; d4[64 + lane] = s4[64 + lane]; } }
            struct FA { uint2 v[4]; int4 ti; float2 tg; }; struct FB { uint2 y0[4], y1[4]; };
            auto loadA = [&](FA& A, int rr) { const uint2* xr = (const uint2*)(Xs + (size_t)rr * D) + lane;
#pragma unroll
                for (int j = 0; j < 4; ++j) A.v[j] = xr[64 * j];
                A.ti = tokinfo[rlo + rr]; A.tg = tgate[rlo + rr]; };
            auto loadB = [&](FB& B, const FA& A) { int b0 = 0, b1 = 0;
#pragma unroll
                for (int c = 0; c < NE; ++c) { if (c == A.ti.x) b0 = base[c]; if (c == A.ti.z) b1 = base[c]; }
                const uint2* y0 = (const uint2*)(Y + (size_t)(b0 + A.ti.y) * D) + lane; const uint2* y1 = (const uint2*)(Y + (size_t)(b1 + A.ti.w) * D) + lane;
#pragma unroll
                for (int j = 0; j < 4; ++j) { B.y0[j] = y0[64 * j]; B.y1[j] = y1[64 * j]; } };
            FA A0, A1, A2; FB B0, B1; int rr = gw;
            if (rr < HALFR) { loadA(A0, rr); if (rr + NGW < HALFR) loadA(A1, rr + NGW); loadB(B0, A0); }
            for (; rr < HALFR; rr += NGW) {
                const bool h1 = rr + NGW < HALFR, h2 = rr + 2 * NGW < HALFR;
                if (h2) loadA(A2, rr + 2 * NGW);
                if (h1) loadB(B1, A1);
                asm volatile("" ::: "memory");
                float4 v[4]; const float2 tg = A0.tg;
#pragma unroll
                for (int j = 0; j < 4; ++j) { const uint2 q = B0.y0[j], c = B0.y1[j], x = A0.v[j];
                    v[j].x = __uint_as_float(x.x << 16) + tg.x * bf2f((bf16_t)(q.x & 0xffff)) + tg.y * bf2f((bf16_t)(c.x & 0xffff)); v[j].y = __uint_as_float(x.x & 0xffff0000u) + tg.x * bf2f((bf16_t)(q.x >> 16)) + tg.y * bf2f((bf16_t)(c.x >> 16));
                    v[j].z = __uint_as_float(x.y << 16) + tg.x * bf2f((bf16_t)(q.y & 0xffff)) + tg.y * bf2f((bf16_t)(c.y & 0xffff)); v[j].w = __uint_as_float(x.y & 0xffff0000u) + tg.x * bf2f((bf16_t)(q.y >> 16)) + tg.y * bf2f((bf16_t)(c.y >> 16)); }
                float ss = 0.f;
#pragma unroll
                for (int j = 0; j < 4; ++j) ss += v[j].x * v[j].x + v[j].y * v[j].y + v[j].z * v[j].z + v[j].w * v[j].w;
                ss = wave_sum(ss); const float r = rsqrtf(ss * (1.f / D) + EPS);
                float4* xo = (float4*)(out + (size_t)(rlo + rr) * D) + lane;
#pragma unroll
                for (int j = 0; j < 4; ++j) { const float4 g = *((const float4*)a.in[I_FINAL_NORM] + 64 * j + lane); xo[64 * j] = make_float4(v[j].x * r * g.x, v[j].y * r * g.y, v[j].z * r * g.z, v[j].w * r * g.w); }
                if (h1) { A0 = A1; B0 = B1; } if (h2) A1 = A2;
            }
        } else {
            if constexpr (k == 1) {
                unsigned char* sc = ws + WS_SCAN; const int wv = wave;
#define ITEM_DECODE(it_) const int item = (it_) & 1023, h = item & 3, c = (item >> 2) & 127, b = item >> 9
#define HG_LB(h_) (l == 0 ? 0.f : 1.f / (1.f + __expf(a.in[I_HGRN_LB][(h_) * 64 + (tl & 63)] - a.in[I_HGRN_LB][256 + (h_) * 64 + (tl & 63)])))
                { scan::HgIn R, Rn; int it = bx;
                  if (it < 1024) { ITEM_DECODE(it); scan::hgrn_load<false>(R, P, b, c, h, nullptr, tid, wv); }
                  for (; it < 1024; it += G) { const int nx = it + G; int tl = tid; asm volatile("" : "+v"(tl));
                      if (nx < 1024) { ITEM_DECODE(nx); scan::hgrn_load<false>(Rn, P, b, c, h, nullptr, tl, wv); }
                      asm volatile("" ::: "memory");
                      { ITEM_DECODE(it); (void)b; (void)c; scan::hgrn_b_item(L, R, HG_LB(h), (float*)(sc + scan::SC_LHG) + (size_t)item * 4096, (float*)(sc + scan::SC_DEC) + item * 64, tl, wv); }
                      if (nx < 1024) R = Rn; } }
                { scan::MlIn R, Rn; int it = bx; while (it < 1024) it += G;
                  if (it < 2048) { ITEM_DECODE(it); scan::mlstm_load<false>(R, P, Gt, b, c, h, nullptr, nullptr, nullptr, tid, wv); }
                  for (; it < 2048; it += G) { const int nx = it + G; int tl = tid; asm volatile("" : "+v"(tl));
                      if (nx < 2048) { ITEM_DECODE(nx); scan::mlstm_load<false>(Rn, P, Gt, b, c, h, nullptr, nullptr, nullptr, tl, wv); }
                      asm volatile("" ::: "memory");
                      { ITEM_DECODE(it); (void)b; (void)c; scan::mlstm_b_item(L, R, a.in[I_MLSTM_CONV] + l * 2048, a.in[I_MLSTM_BI] + l * 4, a.in[I_MLSTM_BF] + l * 4, h, (float*)(sc + scan::SC_LML) + (size_t)item * 4096,
                                            (float*)(sc + scan::SC_NL) + item * 64, (float*)(sc + scan::SC_AMAX) + item, (float*)(sc + scan::SC_BEND) + item, tl, wv); }
                      if (nx < 2048) R = Rn; } }
                { LAS unsigned* lst = (LAS unsigned*)(L + LDSCTL_OFF + 64);
                  if (tid < 32) lst[tid] = 0u; __syncthreads();
                  float mq0 = 0.f, mq1 = 0.f, mk0 = 0.f, mk1 = 0.f;
                  for (int row = gw; row < NTOK; row += NGW) {
                      const v4u wq = *((const v4u*)(P + (size_t)row * PW + P_FQ) + lane), wk = *((const v4u*)(P + (size_t)row * PW + P_FK) + lane);
                      float sq = 0.f, sk = 0.f;
#pragma unroll
                      for (int i = 0; i < 4; ++i) { const float q0 = bf2f((bf16_t)(wq[i] & 0xffff)), q1 = bf2f((bf16_t)(wq[i] >> 16)), k0 = bf2f((bf16_t)(wk[i] & 0xffff)), k1 = bf2f((bf16_t)(wk[i] >> 16));
                          sq += q0 * q0 + q1 * q1; sk += k0 * k0 + k1 * k1; }
                      sq += __shfl_xor(sq, 1); sq += __shfl_xor(sq, 2); sq += __shfl_xor(sq, 4); sk += __shfl_xor(sk, 1); sk += __shfl_xor(sk, 2); sk += __shfl_xor(sk, 4);
                      if (row < SEQ) { mq0 = fmaxf(mq0, sq); mk0 = fmaxf(mk0, sk); } else { mq1 = fmaxf(mq1, sq); mk1 = fmaxf(mk1, sk); } }
                  if ((lane & 7) == 0) { const int hh = lane >> 3;
                      __hip_atomic_fetch_max(lst + hh * 2, __float_as_uint(mq0), __ATOMIC_RELAXED, __HIP_MEMORY_SCOPE_WORKGROUP); __hip_atomic_fetch_max(lst + hh * 2 + 1, __float_as_uint(mk0), __ATOMIC_RELAXED, __HIP_MEMORY_SCOPE_WORKGROUP);
                      __hip_atomic_fetch_max(lst + 16 + hh * 2, __float_as_uint(mq1), __ATOMIC_RELAXED, __HIP_MEMORY_SCOPE_WORKGROUP); __hip_atomic_fetch_max(lst + 16 + hh * 2 + 1, __float_as_uint(mk1), __ATOMIC_RELAXED, __HIP_MEMORY_SCOPE_WORKGROUP); }
                  __syncthreads();
                  if (tid < 32) __hip_atomic_fetch_max((unsigned*)ctl + CW_STAT + l * 32 + tid, lst[tid], __ATOMIC_RELAXED, __HIP_MEMORY_SCOPE_AGENT); }
            } else if constexpr (k == 2) {
                for (int j = bx; j < 256; j += G) scan::scan_c_block<REP>(ws + WS_SCAN, j, tid);
            } else if constexpr (k == 3) {
                static_assert(attn_body::ATTN_LDS_BYTES <= RING_BYTES, "attention LDS");
                unsigned char* sc = ws + WS_SCAN; const int wv = wave;
                const float* stat = (const float*)(ctl + CW_STAT + l * 32);
                LAS unsigned* slot = (LAS unsigned*)(L + LDSCTL_OFF);
                int v;
                for (;;) {
                    if (tid == 0) *slot = __hip_atomic_fetch_add((unsigned*)ctl + CW_QCTR + l + (REP ? 2 : 0), 1u, __ATOMIC_RELAXED, __HIP_MEMORY_SCOPE_AGENT);
                    __syncthreads();
                    v = __builtin_amdgcn_readfirstlane((int)*(volatile LAS unsigned*)slot);
                    if (v >= 736) break;
                    int qb, bh, part = 0; float* PART = nullptr;
                    if (v < 448) { qb = 31 - (v >> 5); bh = v & 15; part = (v >> 4) & 1; PART = (float*)(ws + WS_SCAN + (40 + 32 * l) * MiB) + (size_t)(bh * 14 + (qb - 18)) * 2 * attn_body::PART_F; }
                    else { const int u2 = v - 448; qb = 17 - (u2 >> 4); bh = u2 & 15; }
                    const float Tsk = 30.f + 2.f * __builtin_sqrtf(stat[bh * 2] * stat[bh * 2 + 1]) * 1.01f + 1.f;
                    attn_body::attn_unit<8>(bh >> 3, bh & 7, qb, (const attn_body::bf16*)(P + P_FQ), (const attn_body::bf16*)(P + P_FK), (const attn_body::bf16*)(P + P_FV), (attn_body::bf16*)(MIX + 512), CF + (size_t)bh * SEQ, Tsk,
                                            part, PART, (unsigned*)ctl + CW_AFLAG + (l + (REP ? 2 : 0)) * 512 + bh * 32 + qb, (char*)L + RING_OFF);
                    __syncthreads();
                }
                int tid2 = tid; asm volatile("" : "+v"(tid2));
                while (v < 736 + 512) {
                    const int it0 = (v - 736) * 4;
                    if (it0 < 1024) { scan::HgIn R, Rn; { ITEM_DECODE(it0); scan::hgrn_load<true>(R, P, b, c, h, (const float*)(sc + scan::SC_LHG) + (size_t)item * 4096, tid2, wv); }
#pragma unroll 1
                        for (int j = 0; j < 4; ++j) { const int it = it0 + j; int tl = tid2; asm volatile("" : "+v"(tl));
                            if (j < 3) { ITEM_DECODE(it + 1); scan::hgrn_load<true>(Rn, P, b, c, h, (const float*)(sc + scan::SC_LHG) + (size_t)item * 4096, tl, wv); }
                            asm volatile("" ::: "memory");
                            { ITEM_DECODE(it); const float lb = l == 0 ? 0.f : 1.f / (1.f + __expf(a.in[I_HGRN_LB][h * 64 + (tl & 63)] - a.in[I_HGRN_LB][256 + h * 64 + (tl & 63)]));
                              scan::hgrn_d_item(L, R, lb, a.in[I_HGRN_NORM] + l * 256 + h * 64, MIX + (size_t)(b * SEQ + c * 64) * D + h * 64, tl, wv); }
                            if (j < 3) R = Rn; } }
                    else { scan::MlIn R, Rn; { ITEM_DECODE(it0); scan::mlstm_load<true>(R, P, Gt, b, c, h, (const float*)(sc + scan::SC_LML) + (size_t)item * 4096, (const float*)(sc + scan::SC_NL) + item * 64, (const float*)(sc + scan::SC_MPREV) + item, tid2, wv); }
#pragma unroll 1
                        for (int j = 0; j < 4; ++j) { const int it = it0 + j; int tl = tid2; asm volatile("" : "+v"(tl));
                            if (j < 3) { ITEM_DECODE(it + 1); scan::mlstm_load<true>(Rn, P, Gt, b, c, h, (const float*)(sc + scan::SC_LML) + (size_t)item * 4096, (const float*)(sc + scan::SC_NL) + item * 64, (const float*)(sc + scan::SC_MPREV) + item, tl, wv); }
                            asm volatile("" ::: "memory");
                            { ITEM_DECODE(it); scan::mlstm_d_item(L, R, a.in[I_MLSTM_CONV] + l * 2048, a.in[I_MLSTM_BI] + l * 4, a.in[I_MLSTM_BF] + l * 4, a.in[I_MLSTM_NORM] + l * 256 + h * 64, h, MIX + (size_t)(b * SEQ + c * 64) * D + 256 + h * 64, tl, wv); }
                            if (j < 3) R = Rn; } }
                    __syncthreads();
                    if (tid2 == 0) *slot = __hip_atomic_fetch_add((unsigned*)ctl + CW_QCTR + l + (REP ? 2 : 0), 1u, __ATOMIC_RELAXED, __HIP_MEMORY_SCOPE_AGENT);
                    __syncthreads();
                    v = __builtin_amdgcn_readfirstlane((int)*(volatile LAS unsigned*)slot);
                }
            }

        }
}
__global__ void __launch_bounds__(NTHR, 2) mega(MArgs a) {
    extern __shared__ __attribute__((aligned(16))) unsigned char lds[];
    LAS unsigned char* L = (LAS unsigned char*)lds;
    volatile LAS unsigned* MISC = (volatile LAS unsigned*)(L + MISC_OFF);
    const int tid = threadIdx.x, wave = __builtin_amdgcn_readfirstlane(tid >> 6);
    const int G = gridDim.x, bx = blockIdx.x, vcu = (G % 8 == 0) ? (bx % 8) * (G / 8) + bx / 8 : bx;
    for (int u = tid; u < (LDS_BYTES - LDSCTL_OFF) / 4; u += NTHR) ((LAS unsigned*)(L + LDSCTL_OFF))[u] = 0u;
    __syncthreads();
    const int lo = a.ph_lo, hi = a.ph_hi;
    XcdBarrier bar; bar.bar = (unsigned*)(a.ws + WS_CTL) + CW_BAR; bar.x = 0; bar.st = nullptr;
    if (hi - lo > 1) bar = xcd_barrier_post((unsigned*)(a.ws + WS_CTL) + CW_BAR, MISC + 8);
#ifndef REPEAT_MASK
#define REPEAT_MASK 0u
#endif
#define PHASE(k) if (lo <= (k) && (k) < hi) { run_phase<k>(a, L, tid, wave, G, bx, vcu); if constexpr ((REPEAT_MASK >> (k)) & 1u) { xcd_barrier(bar); run_phase<k, true>(a, L, tid, wave, G, bx, vcu); } if ((k) + 1 < hi) xcd_barrier(bar); }
    PHASE(0) PHASE(1) PHASE(2) PHASE(3) PHASE(4) PHASE(5) PHASE(6) PHASE(7) PHASE(8) PHASE(9) PHASE(10)
    PHASE(11) PHASE(12) PHASE(13) PHASE(14) PHASE(15) PHASE(16) PHASE(17) PHASE(19) PHASE(20) PHASE(21)
#undef PHASE
}
#ifndef MEGA_MASK
#define MEGA_MASK 0x1FFFFFu
#endif
#ifndef FUSE_RUNS
#define FUSE_RUNS 1
#endif
extern "C" void kernel_launch(void* const* d_in, const int* in_sizes, int n_in, void* d_out, int out_size, void* d_ws, size_t ws_size, hipStream_t stream) {
    static int grid = 0;
    if (grid == 0) {
        if (n_in != 20 || ws_size < WS_END || out_size != NTOK * D) { fprintf(stderr, "kernel_launch: unexpected n_in %d / ws %zu / out %d\n", n_in, ws_size, out_size); grid = -1; return; }
        int dev = 0, cus = 0, per_cu = 0;
        if (hipGetDevice(&dev) != hipSuccess || hipDeviceGetAttribute(&cus, hipDeviceAttributeMultiprocessorCount, dev) != hipSuccess) { grid = -1; return; }
        if (hipFuncSetAttribute((const void*)mega, hipFuncAttributeMaxDynamicSharedMemorySize, LDS_BYTES) != hipSuccess) { fprintf(stderr, "kernel_launch: hipFuncSetAttribute failed\n"); grid = -1; return; }
        if (hipOccupancyMaxActiveBlocksPerMultiprocessor(&per_cu, (const void*)mega, NTHR, LDS_BYTES) != hipSuccess || per_cu < 1) { fprintf(stderr, "kernel_launch: occupancy query says %d\n", per_cu); per_cu = 1; }
        (void)hipGetLastError();
        grid = cus;
        if (grid > 256) grid = 256;
    }
    if (grid < 0) return;
    const float* const* in = (const float* const*)d_in;
    unsigned char* ws = (unsigned char*)d_ws; float* X = (float*)d_out;
    (void)hipMemsetAsync(ws + WS_CTL, 0, CTL_BYTES, stream);
    MArgs ma; memset(&ma, 0, sizeof ma);
    for (int i = 0; i < 20; ++i) ma.in[i] = in[i];
    ma.out = X; ma.ws = ws;
    ma.ph_lo = 0; ma.ph_hi = N_PHASES;
    hipLaunchKernelGGL(mega, dim3(grid), dim3(NTHR), LDS_BYTES, stream, ma);
}
```

```cpp
#include <hip/hip_runtime.h>
#include <hip/hip_bf16.h>
#include <cstdint>
#include <cstdio>
#include <cstring>

namespace cfg {
constexpr int NTOK = 16384, D = 1024, SEQ = 8192, NB = 2, DIN = 3600, PW = 3584, GW = 16;
constexpr int FF = 2816, FE = 3584, NE = 8, MAXROWS = 34816;
constexpr float EPS = 1e-6f;
constexpr float LOG2E = 1.4426950408889634f;
constexpr float QSCALE = 0.125f * LOG2E;
constexpr int P_HQ = 0, P_HF = 256, P_HI = 512, P_HG = 768, P_MQ = 1024, P_MK = 1280, P_MV = 1536, P_MO = 1792, P_FQ = 2048, P_FK = 2560, P_FV = 3072;
constexpr size_t MiB = 1u << 20;
constexpr size_t WS_CTL = 0, CTL_BYTES = 1 * MiB;
constexpr size_t WS_G = 2 * MiB;
constexpr size_t WS_CF = 3 * MiB;
constexpr size_t WS_TOKINFO = 3 * MiB + 512 * 1024;
constexpr size_t WS_TGATE = 3 * MiB + 768 * 1024;
constexpr size_t WS_TOKLIST = 4 * MiB;
constexpr size_t WS_P = 8 * MiB;
constexpr size_t WS_SCAN = 120 * MiB;
constexpr size_t WS_HID = 8 * MiB;
constexpr size_t WS_H = 246 * MiB;
constexpr size_t WS_MIX = 278 * MiB;
constexpr size_t WS_XG = 278 * MiB;
constexpr size_t WS_W = 346 * MiB;
constexpr size_t WS_Y = 346 * MiB;
constexpr size_t WS_END = 466 * MiB;
constexpr int CW_CNT = 64;
constexpr int CW_STAT = 128;
constexpr int CW_QCTR = 256;
constexpr int CW_AFLAG = 512;
}
using namespace cfg;
typedef unsigned short bf16_t;

__device__ __forceinline__ bf16_t f2bf(float f) { unsigned u = __builtin_bit_cast(unsigned, f); return (bf16_t)((u + 0x7fffu + ((u >> 16) & 1u)) >> 16); }
__device__ __forceinline__ float bf2f(bf16_t h) { return __builtin_bit_cast(float, (unsigned)h << 16); }
__device__ __forceinline__ float wave_sum(float v) {
#pragma unroll
    for (int o = 1; o < 64; o <<= 1) v += __shfl_xor(v, o);
    return v;
}
__device__ __forceinline__ float sigmoidf_(float z) { return 1.f / (1.f + __expf(-z)); }
__device__ __forceinline__ float siluf_(float z) { return z / (1.f + __expf(-z)); }
__device__ __forceinline__ float log_sigmoidf_(float z) { return fminf(z, 0.f) - log1pf(__expf(-fabsf(z))); }

__device__ __forceinline__ int moe_bases(const int* cnt, int* base) {
    int acc = 0;
#pragma unroll
    for (int e = 0; e < NE; ++e) { base[e] = acc; acc += (cnt[e] + 255) & ~255; }
    return acc;
}

namespace pg8 {
#define PG8_LAS __attribute__((address_space(3)))
typedef unsigned short bf16_t;
typedef short bf16x8 __attribute__((ext_vector_type(8)));
typedef float f32x4 __attribute__((ext_vector_type(4)));
typedef unsigned u32x4 __attribute__((ext_vector_type(4)));
constexpr int BM = 256, BK = 64, HALF = 128, HTB = HALF * BK * 2  , STAGE_BYTES = 8 * HTB, NXCD = 8, WGM = 8;

__host__ __device__ __forceinline__ int lds_byte(int r, int c) { const int st = (r >> 4) * 2 + (c >> 5), rr = r & 15, cc = c & 31, ob = rr * 64 + cc * 2; return st * 1024 + (ob ^ (((ob >> 9) & 1) << 5)); }
__host__ __device__ __forceinline__ void stage_rc(int b, int& R, int& C) { const int st = b / 1024, sb = b % 1024, swz = sb ^ (((sb >> 9) & 1) << 5); R = (st >> 1) * 16 + swz / 64; C = (st & 1) * 32 + (swz % 64) / 2; }
__host__ __device__ __forceinline__ int perm32(int rho) { const int n = rho >> 4, i = rho & 15; return 8 * (i >> 2) + 4 * n + (i & 3); }

struct Unit { int pm, pn; };
struct Gemm { int K; };

struct StaticOrder {
    int nM, nN, nwg, G, c;
    __host__ __device__ void init(int M, int N, int G_, int c_) { nM = M / BM; nN = N / BM; nwg = nM * nN; G = G_; c = c_; }
    __host__ __device__ bool next(int i, Unit& u) const {
        const long L = (long)i * G + c; if (L >= nwg) return false;
        int wgid = (int)L; { const int q = nwg / NXCD, r = nwg % NXCD, xcd = wgid % NXCD, off = wgid / NXCD; wgid = (xcd < r ? xcd * (q + 1) : r * (q + 1) + (xcd - r) * q) + off; }
        const int nig = WGM * nN, gid = wgid / nig, fm = gid * WGM, gsz = (nM - fm) < WGM ? (nM - fm) : WGM;
        u.pm = fm + ((wgid % nig) % gsz); u.pn = (wgid % nig) / gsz; return true;
    }
    __device__ __forceinline__ void a_ready(const Unit&) const {}
    __device__ __forceinline__ void done(const Unit&) const {}
};

__device__ __forceinline__ unsigned cvt_pk_bf16(float lo, float hi) { unsigned r; asm volatile("v_cvt_pk_bf16_f32 %0, %1, %2" : "=v"(r) : "v"(lo), "v"(hi)); return r; }
typedef int i32x4 __attribute__((ext_vector_type(4)));
constexpr float F8_HSCALE = 4.f, F8_WSCALE = 64.f;
template <bool I8> struct AccT { typedef f32x4 type; };
template <> struct AccT<true> { typedef i32x4 type; };
__device__ __forceinline__ f32x4 mma_sel(bf16x8 b, bf16x8 a, f32x4 c) { return __builtin_amdgcn_mfma_f32_16x16x32_bf16(b, a, c, 0, 0, 0); }
__device__ __forceinline__ i32x4 mma_sel(bf16x8 b, bf16x8 a, i32x4 c) { return __builtin_amdgcn_mfma_i32_16x16x64_i8(__builtin_bit_cast(i32x4, b), __builtin_bit_cast(i32x4, a), c, 0, 0, 0); }
typedef int i32x8 __attribute__((ext_vector_type(8)));
struct Frag2 { bf16x8 k[2]; };
template <int MODE> struct Frag { typedef Frag2 type; };
template <> struct Frag<2> { typedef i32x8 type; };
template <int MODE> __device__ __forceinline__ typename Frag<MODE>::type ldfrag(PG8_LAS const unsigned char* p) {
    if constexpr (MODE == 2) { const i32x4 lo = *(const PG8_LAS i32x4*)p, hi = *(const PG8_LAS i32x4*)(p + 1024); return (i32x8){lo[0], lo[1], lo[2], lo[3], hi[0], hi[1], hi[2], hi[3]}; }
    else { Frag2 f; f.k[0] = *(const PG8_LAS bf16x8*)p; f.k[1] = *(const PG8_LAS bf16x8*)(p + 1024); return f; }
}
__device__ __forceinline__ void mma_step_(f32x4& acc, const Frag2& b, const Frag2& a) { acc = mma_sel(b.k[0], a.k[0], acc); acc = mma_sel(b.k[1], a.k[1], acc); }
__device__ __forceinline__ void mma_step_(i32x4& acc, const Frag2& b, const Frag2& a) { acc = mma_sel(b.k[0], a.k[0], acc); acc = mma_sel(b.k[1], a.k[1], acc); }
__device__ __forceinline__ void mma_step_(f32x4& acc, const i32x8& b, const i32x8& a) {
#if defined(__HIP_DEVICE_COMPILE__)
    const int scl = 0x7f7f7f7f;
    asm volatile("v_mfma_scale_f32_16x16x128_f8f6f4 %0, %1, %2, %0, %3, %3 op_sel_hi:[0,0,0]" : "+v"(acc) : "v"(b), "v"(a), "v"(scl));
#endif
}
template <int MODE, class ACC, class F> __device__ __forceinline__ void mma_step(ACC& acc, const F& b, const F& a) { mma_step_(acc, b, a); }
struct EpiBf {
    static constexpr bool PERM = true, AFTER_DRAIN = false;
    bf16_t* O; int ldc; int s_lo, s_hi; float scale;
    struct Pre {}; __device__ __forceinline__ void prefetch(Pre&, const Unit&, int, int, int, int, int) const {} __device__ __forceinline__ void commit(const Pre&, int, int, int, int, int) const {}
    __device__ __forceinline__ void operator()(const f32x4 (&acc)[2][2][4][2], const Unit& u, int wr, int wc, int fr_, int fq_, const Pre&, int) const {
        int fr = fr_, fq = fq_; asm volatile("" : "+v"(fr), "+v"(fq));
        const int row0 = u.pm * BM + wr * 64 + fr, col0 = u.pn * BM + wc * 32 + 8 * fq;
        const float sc = (u.pn >= s_lo && u.pn < s_hi) ? scale : 1.f;
#pragma unroll
        for (int ai = 0; ai < 2; ++ai)
#pragma unroll
            for (int m = 0; m < 4; ++m) { bf16_t* rowp = O + (size_t)(row0 + ai * HALF + m * 16) * ldc + col0;
#pragma unroll
                for (int bj = 0; bj < 2; ++bj) { const f32x4 v0 = acc[ai][bj][m][0] * sc, v1 = acc[ai][bj][m][1] * sc;
                    u32x4 w; w.x = cvt_pk_bf16(v0[0], v0[1]); w.y = cvt_pk_bf16(v0[2], v0[3]); w.z = cvt_pk_bf16(v1[0], v1[1]); w.w = cvt_pk_bf16(v1[2], v1[3]);
                    *(u32x4*)(rowp + bj * HALF) = w; } }
    }
};
__device__ __forceinline__ float silu_mul(float g, float u) { return g * __builtin_amdgcn_rcpf(1.f + __expf(-g)) * u; }
struct EpiSwiglu {
    static constexpr bool PERM = true, AFTER_DRAIN = false;
    bf16_t* O; int ldc;
    struct Pre {}; __device__ __forceinline__ void prefetch(Pre&, const Unit&, int, int, int, int, int) const {} __device__ __forceinline__ void commit(const Pre&, int, int, int, int, int) const {}
    __device__ __forceinline__ void operator()(const f32x4 (&acc)[2][2][4][2], const Unit& u, int wr, int wc, int fr, int fq, const Pre&, int) const {
        const int row0 = u.pm * BM + wr * 64 + fr, col0 = u.pn * HALF + wc * 32 + 8 * fq;
#pragma unroll
        for (int ai = 0; ai < 2; ++ai)
#pragma unroll
            for (int m = 0; m < 4; ++m) { bf16_t* rowp = O + (size_t)(row0 + ai * HALF + m * 16) * ldc + col0;
                const f32x4 g0 = acc[ai][0][m][0], g1 = acc[ai][0][m][1], u0 = acc[ai][1][m][0], u1 = acc[ai][1][m][1];
                u32x4 w; w.x = cvt_pk_bf16(silu_mul(g0[0], u0[0]), silu_mul(g0[1], u0[1])); w.y = cvt_pk_bf16(silu_mul(g0[2], u0[2]), silu_mul(g0[3], u0[3]));
                w.z = cvt_pk_bf16(silu_mul(g1[0], u1[0]), silu_mul(g1[1], u1[1])); w.w = cvt_pk_bf16(silu_mul(g1[2], u1[2]), silu_mul(g1[3], u1[3]));
                *(u32x4*)rowp = w; }
    }
};
template <bool IN_F32> struct EpiResid {
    static constexpr bool PERM = true, AFTER_DRAIN = false;
    const void* Xin; bf16_t* X; int ldc;
    struct Pre {}; __device__ __forceinline__ void prefetch(Pre&, const Unit&, int, int, int, int, int) const {} __device__ __forceinline__ void commit(const Pre&, int, int, int, int, int) const {}
    __device__ __forceinline__ void operator()(const f32x4 (&acc)[2][2][4][2], const Unit& u, int wr, int wc, int fr, int fq, const Pre&, int) const {
        const int row0 = u.pm * BM + wr * 64 + fr, col0 = u.pn * BM + wc * 32 + 8 * fq;
#pragma unroll
        for (int ai = 0; ai < 2; ++ai)
#pragma unroll
            for (int m = 0; m < 4; ++m) { const size_t ro = (size_t)(row0 + ai * HALF + m * 16) * ldc + col0;
#pragma unroll
                for (int bj = 0; bj < 2; ++bj) { f32x4 x0, x1;
                    if (IN_F32) { const float* p = (const float*)Xin + ro + bj * HALF; x0 = *(const f32x4*)p; x1 = *(const f32x4*)(p + 4); }
                    else { const u32x4 w = *(const u32x4*)((const bf16_t*)Xin + ro + bj * HALF);
                        x0 = (f32x4){__builtin_bit_cast(float, w.x << 16), __builtin_bit_cast(float, w.x & 0xffff0000u), __builtin_bit_cast(float, w.y << 16), __builtin_bit_cast(float, w.y & 0xffff0000u)};
                        x1 = (f32x4){__builtin_bit_cast(float, w.z << 16), __builtin_bit_cast(float, w.z & 0xffff0000u), __builtin_bit_cast(float, w.w << 16), __builtin_bit_cast(float, w.w & 0xffff0000u)}; }
                    const f32x4 v0 = x0 + acc[ai][bj][m][0], v1 = x1 + acc[ai][bj][m][1];
                    u32x4 o; o.x = cvt_pk_bf16(v0[0], v0[1]); o.y = cvt_pk_bf16(v0[2], v0[3]); o.z = cvt_pk_bf16(v1[0], v1[1]); o.w = cvt_pk_bf16(v1[2], v1[3]);
                    *(u32x4*)(X + ro + bj * HALF) = o; }
                asm volatile("" ::: "memory"); }
    }
};
struct EpiBf8 {
    static constexpr bool PERM = true, AFTER_DRAIN = false;
    bf16_t* O; int ldc; int s_lo, s_hi; float scale; const float* sA; const float* sB; PG8_LAS float* sc;
    struct Pre { f32x4 v; };
    __device__ __forceinline__ void prefetch(Pre& p, const Unit& u, int wr, int wc, int fr, int fq, int) const {
        const int wid = wr * 4 + wc, lane = fq * 16 + fr;
        if (wid == 0) p.v = *(const f32x4*)(sA + u.pm * BM + 4 * lane);
        if (wid == 1) p.v = *(const f32x4*)(sB + u.pn * BM + 4 * lane);
    }
    __device__ __forceinline__ void commit(const Pre& p, int wr, int wc, int fr, int fq, int ui) const {
        const int wid = wr * 4 + wc, lane = fq * 16 + fr; PG8_LAS float* d = sc + (ui & 1) * 512;
        if (wid < 2) { *(PG8_LAS f32x4*)(d + 256 * wid + 4 * lane) = p.v; asm volatile("s_waitcnt lgkmcnt(0)" ::: "memory"); }
    }
    __device__ __forceinline__ void operator()(const i32x4 (&acc)[2][2][4][2], const Unit& u, int wr, int wc, int fr, int fq, const Pre&, int ui) const {
        const int row0 = u.pm * BM + wr * 64 + fr, col0 = u.pn * BM + wc * 32 + 8 * fq; const PG8_LAS float* d = sc + (ui & 1) * 512;
        const float sc0 = (u.pn >= s_lo && u.pn < s_hi) ? scale : 1.f;
        f32x4 cb[2][2];
#pragma unroll
        for (int bj = 0; bj < 2; ++bj)
#pragma unroll
            for (int n = 0; n < 2; ++n) cb[bj][n] = *(const PG8_LAS f32x4*)(d + 256 + wc * 32 + 8 * fq + bj * HALF + 4 * n) * sc0;
#pragma unroll
        for (int ai = 0; ai < 2; ++ai)
#pragma unroll
            for (int m = 0; m < 4; ++m) { const int row = row0 + ai * HALF + m * 16; const float ra = d[wr * 64 + fr + ai * HALF + m * 16]; bf16_t* rowp = O + (size_t)row * ldc + col0;
#pragma unroll
                for (int bj = 0; bj < 2; ++bj) { const f32x4 v0 = __builtin_convertvector(acc[ai][bj][m][0], f32x4) * cb[bj][0] * ra, v1 = __builtin_convertvector(acc[ai][bj][m][1], f32x4) * cb[bj][1] * ra;
                    u32x4 w; w.x = cvt_pk_bf16(v0[0], v0[1]); w.y = cvt_pk_bf16(v0[2], v0[3]); w.z = cvt_pk_bf16(v1[0], v1[1]); w.w = cvt_pk_bf16(v1[2], v1[3]);
                    *(u32x4*)(rowp + bj * HALF) = w; } }
    }
};
template <bool F8OUT> struct EpiSwiglu8 {
    static constexpr bool PERM = true, AFTER_DRAIN = false;
    bf16_t* O; int ldc; const float* sA; const float* sB; int sb_exp; int tb1, tb2, tb3, tb4, tb5, tb6, tb7; PG8_LAS float* sc;
    struct Pre { f32x4 v; };
    __device__ __forceinline__ void prefetch(Pre& p, const Unit& u, int wr, int wc, int fr, int fq, int) const {
        const int wid = wr * 4 + wc, lane = fq * 16 + fr;
        const int e = (u.pm >= tb1) + (u.pm >= tb2) + (u.pm >= tb3) + (u.pm >= tb4) + (u.pm >= tb5) + (u.pm >= tb6) + (u.pm >= tb7);
        if (wid == 0) p.v = *(const f32x4*)(sA + u.pm * BM + 4 * lane);
        if (wid == 1) p.v = *(const f32x4*)(sB + (size_t)e * sb_exp + u.pn * BM + 4 * lane);
    }
    __device__ __forceinline__ void commit(const Pre& p, int wr, int wc, int fr, int fq, int ui) const {
        const int wid = wr * 4 + wc, lane = fq * 16 + fr; PG8_LAS float* d = sc + (ui & 1) * 512;
        if (wid < 2) { *(PG8_LAS f32x4*)(d + 256 * wid + 4 * lane) = p.v; asm volatile("s_waitcnt lgkmcnt(0)" ::: "memory"); }
    }
    __device__ __forceinline__ void operator()(const i32x4 (&acc)[2][2][4][2], const Unit& u, int wr, int wc, int fr, int fq, const Pre&, int ui) const {
        const int row0 = u.pm * BM + wr * 64 + fr, col0 = u.pn * HALF + wc * 32 + 8 * fq; const PG8_LAS float* d = sc + (ui & 1) * 512;
        const PG8_LAS float* sb = d + 256 + wc * 32 + 8 * fq;
        const f32x4 sg0 = *(const PG8_LAS f32x4*)sb, sg1 = *(const PG8_LAS f32x4*)(sb + 4), su0 = *(const PG8_LAS f32x4*)(sb + HALF), su1 = *(const PG8_LAS f32x4*)(sb + HALF + 4);
#pragma unroll
        for (int ai = 0; ai < 2; ++ai)
#pragma unroll
            for (int m = 0; m < 4; ++m) { const int row = row0 + ai * HALF + m * 16; const float ra = d[wr * 64 + fr + ai * HALF + m * 16];
                const f32x4 g0 = __builtin_convertvector(acc[ai][0][m][0], f32x4) * sg0 * ra, g1 = __builtin_convertvector(acc[ai][0][m][1], f32x4) * sg1 * ra;
                const f32x4 u0 = __builtin_convertvector(acc[ai][1][m][0], f32x4) * su0 * ra, u1 = __builtin_convertvector(acc[ai][1][m][1], f32x4) * su1 * ra;
                if constexpr (F8OUT) { float h[8];
#pragma unroll
                    for (int i = 0; i < 4; ++i) { h[i] = __builtin_fminf(__builtin_fmaxf(silu_mul(g0[i], u0[i]) * F8_HSCALE, -448.f), 448.f); h[4 + i] = __builtin_fminf(__builtin_fmaxf(silu_mul(g1[i], u1[i]) * F8_HSCALE, -448.f), 448.f); }
                    unsigned w0 = 0u, w1 = 0u; w0 = __builtin_amdgcn_cvt_pk_fp8_f32(h[0], h[1], w0, false); w0 = __builtin_amdgcn_cvt_pk_fp8_f32(h[2], h[3], w0, true);
                    w1 = __builtin_amdgcn_cvt_pk_fp8_f32(h[4], h[5], w1, false); w1 = __builtin_amdgcn_cvt_pk_fp8_f32(h[6], h[7], w1, true);
                    typedef unsigned u32x2 __attribute__((ext_vector_type(2))); *(u32x2*)((unsigned char*)O + (size_t)row * ldc + col0) = (u32x2){w0, w1}; }
                else { bf16_t* rowp = O + (size_t)row * ldc + col0;
                u32x4 w; w.x = cvt_pk_bf16(silu_mul(g0[0], u0[0]), silu_mul(g0[1], u0[1])); w.y = cvt_pk_bf16(silu_mul(g0[2], u0[2]), silu_mul(g0[3], u0[3]));
                w.z = cvt_pk_bf16(silu_mul(g1[0], u1[0]), silu_mul(g1[1], u1[1])); w.w = cvt_pk_bf16(silu_mul(g1[2], u1[2]), silu_mul(g1[3], u1[3]));
                *(u32x4*)rowp = w; } }
    }
};
struct GOrder {
    StaticOrder so; const char* A; const char* B; size_t a_tile, b_tile, b_exp; int tb1, tb2, tb3, tb4, tb5, tb6, tb7;
    __device__ __forceinline__ bool next(int i, Unit& u) const { return so.next(i, u); }
    __device__ __forceinline__ const char* a_base(const Unit& u) const { return A + (size_t)u.pm * a_tile; }
    __device__ __forceinline__ const char* b_base(const Unit& u) const {
        const int e = (u.pm >= tb1) + (u.pm >= tb2) + (u.pm >= tb3) + (u.pm >= tb4) + (u.pm >= tb5) + (u.pm >= tb6) + (u.pm >= tb7);
        return B + (size_t)e * b_exp + (size_t)u.pn * b_tile; }
    __device__ __forceinline__ void a_ready(const Unit&) const {}
    __device__ __forceinline__ void done(const Unit&) const {}
};
template <class Epi, class Sched, bool ALIGN_EPI = false, bool SP2 = false, int MODE = 0  >
__device__ __forceinline__ void gemm_phase(PG8_LAS unsigned char* lds, const Gemm g, const Sched& S, const Epi& E) {
    const int tid = threadIdx.x, wid = __builtin_amdgcn_readfirstlane(tid >> 6), lane = tid & 63, wr = wid >> 2, wc = wid & 3, fr = lane & 15, fq = lane >> 4;
    const int K = g.K, nt = K / BK;
    unsigned voffA[2], voffB[2];
#pragma unroll
    for (int i = 0; i < 2; ++i) { int R, C; stage_rc(tid * 16 + i * 8192, R, C); const int Rb = Epi::PERM ? ((R & ~31) + perm32(R & 31)) : R;
        voffA[i] = (unsigned)(R * K + C) * 2u; voffB[i] = (unsigned)(Rb * K + C) * 2u; }
    const size_t kstep = (size_t)(BK * 2);
    const size_t hstep = (size_t)HALF * K * 2;
        const unsigned ldsw = (unsigned)wid * 1024u;
    const int aoff = lds_byte(wr * 64 + fr, fq * 8), boff = lds_byte(wc * 32 + fr, fq * 8);
#define PG8_SA(b, h) (((b) * 2 + (h)) * HTB)
#define PG8_SB(b, h) ((4 + (b) * 2 + (h)) * HTB)
#define PG8_STAGE(bufoff, gbase, voff) do { _Pragma("unroll") for (int _i = 0; _i < 2; ++_i) \
        __builtin_amdgcn_global_load_lds((const unsigned*)((const char*)(gbase) + (voff)[_i]), (PG8_LAS unsigned*)(lds + (bufoff) + ldsw + _i * 8192), 16, 0, 0); } while (0)
#define PG8_LDA(dst, b, h) do { _Pragma("unroll") for (int m = 0; m < 4; ++m) dst[m] = ldfrag<MODE>(lds + PG8_SA(b, h) + aoff + m * 2048); } while (0)
#define PG8_LDB(dst, b, h) do { _Pragma("unroll") for (int n = 0; n < 2; ++n) dst[n] = ldfrag<MODE>(lds + PG8_SB(b, h) + boff + n * 2048); } while (0)
#define PG8_MMA(ai, bj, At, Bt) do { __builtin_amdgcn_s_setprio(1); _Pragma("unroll") for (int m = 0; m < 4; ++m) _Pragma("unroll") for (int n = 0; n < 2; ++n) \
        mma_step<MODE>(acc[ai][bj][m][n], Bt[n], At[m]); __builtin_amdgcn_s_setprio(0); } while (0)
#define PG8_WAIT_V(n) asm volatile("s_waitcnt vmcnt(" #n ")" ::: "memory")
#define PG8_WAIT_L(n) asm volatile("s_waitcnt lgkmcnt(" #n ")" ::: "memory")
#define PG8_BAR __builtin_amdgcn_s_barrier()
#define PG8_SCHED __builtin_amdgcn_sched_barrier(0)
    Unit cur, nxt; int ui = 0; typename Epi::Pre pre;
    if (!S.next(0, cur)) return;
    typename AccT<MODE == 1>::type acc[2][2][4][2];
#pragma unroll
    for (int a = 0; a < 2; ++a)
#pragma unroll
        for (int b = 0; b < 2; ++b)
#pragma unroll
            for (int m = 0; m < 4; ++m)
#pragma unroll
                for (int n = 0; n < 2; ++n) acc[a][b][m][n] = typename AccT<MODE == 1>::type{};
    typename Frag<MODE>::type At[4], B0[2], B1[2];
    const char* cA = S.a_base(cur); const char* cB = S.b_base(cur);
    S.a_ready(cur);
    if constexpr (SP2) {
        PG8_STAGE(PG8_SB(0, 0), cB, voffB); PG8_STAGE(PG8_SB(0, 1), cB + hstep, voffB); PG8_STAGE(PG8_SA(0, 0), cA, voffA); PG8_STAGE(PG8_SA(0, 1), cA + hstep, voffA);
        if (wr == 1) PG8_BAR;
        PG8_WAIT_V(2); PG8_BAR;
        PG8_STAGE(PG8_SB(1, 0), cB + kstep, voffB); PG8_STAGE(PG8_SA(1, 0), cA + kstep, voffA); PG8_STAGE(PG8_SB(1, 1), cB + hstep + kstep, voffB);
        PG8_WAIT_V(6); PG8_BAR;
    } else {
        PG8_STAGE(PG8_SB(0, 0), cB, voffB); PG8_STAGE(PG8_SA(0, 0), cA, voffA); PG8_STAGE(PG8_SB(0, 1), cB + hstep, voffB); PG8_STAGE(PG8_SA(0, 1), cA + hstep, voffA);
        if (wr == 1) PG8_BAR;
        PG8_WAIT_V(4); PG8_BAR;
        PG8_STAGE(PG8_SB(1, 0), cB + kstep, voffB); PG8_STAGE(PG8_SA(1, 0), cA + kstep, voffA); PG8_STAGE(PG8_SB(1, 1), cB + hstep + kstep, voffB);
        PG8_WAIT_V(6); PG8_BAR;
    }
    for (;;) {
        const bool has_next = S.next(ui + 1, nxt);
        const char* nA = has_next ? S.a_base(nxt) : cA; const char* nB = has_next ? S.b_base(nxt) : cB;
        for (int t = 0; t < nt; t += 2) {
            const bool last = (t == nt - 2);
            const char* a1 = cA + (size_t)(t + 1) * kstep;
            const char* a2 = last ? nA : cA + (size_t)(t + 2) * kstep; const char* b2 = last ? nB : cB + (size_t)(t + 2) * kstep;
            const char* a3 = a2 + kstep; const char* b3 = b2 + kstep;
            if (last && has_next) S.a_ready(nxt);
            if (last) E.prefetch(pre, cur, wr, wc, fr, fq, ui);
            if constexpr (SP2) {
            PG8_LDB(B0, 0, 0); PG8_LDB(B1, 0, 1); PG8_SCHED; PG8_LDA(At, 0, 0); PG8_STAGE(PG8_SA(1, 1), a1 + hstep, voffA);
            PG8_WAIT_V(8); PG8_WAIT_L(0); PG8_BAR; PG8_MMA(0, 0, At, B0); PG8_MMA(0, 1, At, B1); PG8_BAR; PG8_SCHED;
            PG8_LDA(At, 0, 1); PG8_STAGE(PG8_SB(0, 0), b2, voffB); PG8_STAGE(PG8_SB(0, 1), b2 + hstep, voffB); PG8_STAGE(PG8_SA(0, 0), a2, voffA);
            PG8_WAIT_V(8); PG8_WAIT_L(0); PG8_BAR; PG8_MMA(1, 0, At, B0); PG8_MMA(1, 1, At, B1); PG8_BAR; PG8_SCHED;
            PG8_LDB(B0, 1, 0); PG8_LDB(B1, 1, 1); PG8_SCHED; PG8_LDA(At, 1, 0); PG8_STAGE(PG8_SA(0, 1), a2 + hstep, voffA);
            PG8_WAIT_V(8); PG8_WAIT_L(0); PG8_BAR; PG8_MMA(0, 0, At, B0); PG8_MMA(0, 1, At, B1); PG8_BAR; PG8_SCHED;
            PG8_LDA(At, 1, 1); PG8_STAGE(PG8_SB(1, 0), b3, voffB); PG8_STAGE(PG8_SB(1, 1), b3 + hstep, voffB); PG8_STAGE(PG8_SA(1, 0), a3, voffA);
            PG8_WAIT_V(8); PG8_WAIT_L(0); PG8_BAR; PG8_MMA(1, 0, At, B0); PG8_MMA(1, 1, At, B1); PG8_BAR; PG8_SCHED;
            } else {
            PG8_LDB(B0, 0, 0); PG8_SCHED; PG8_LDA(At, 0, 0); PG8_STAGE(PG8_SA(1, 1), a1 + hstep, voffA);
            PG8_WAIT_L(8); PG8_BAR; PG8_WAIT_L(0); PG8_MMA(0, 0, At, B0); PG8_BAR; PG8_SCHED;
            PG8_LDB(B1, 0, 1); PG8_STAGE(PG8_SB(0, 0), b2, voffB);
            PG8_BAR; PG8_WAIT_L(0); PG8_MMA(0, 1, At, B1); PG8_BAR;
            PG8_LDA(At, 0, 1); PG8_STAGE(PG8_SA(0, 0), a2, voffA);
            PG8_BAR; PG8_WAIT_L(0); PG8_MMA(1, 0, At, B0); PG8_BAR; PG8_SCHED;
            PG8_STAGE(PG8_SB(0, 1), b2 + hstep, voffB);
            PG8_WAIT_V(6); PG8_BAR; PG8_MMA(1, 1, At, B1); PG8_BAR;
            PG8_LDB(B0, 1, 0); PG8_SCHED; PG8_LDA(At, 1, 0); PG8_STAGE(PG8_SA(0, 1), a2 + hstep, voffA);
            PG8_WAIT_L(8); PG8_BAR; PG8_WAIT_L(0); PG8_MMA(0, 0, At, B0); PG8_BAR; PG8_SCHED;
            PG8_LDB(B1, 1, 1); PG8_STAGE(PG8_SB(1, 0), b3, voffB);
            PG8_BAR; PG8_WAIT_L(0); PG8_MMA(0, 1, At, B1); PG8_BAR;
            PG8_LDA(At, 1, 1); PG8_STAGE(PG8_SA(1, 0), a3, voffA);
            PG8_BAR; PG8_WAIT_L(0); PG8_MMA(1, 0, At, B0); PG8_BAR; PG8_SCHED;
            PG8_STAGE(PG8_SB(1, 1), b3 + hstep, voffB);
            PG8_WAIT_V(6); PG8_BAR; PG8_MMA(1, 1, At, B1); PG8_BAR;
            }
        }
        E.commit(pre, wr, wc, fr, fq, ui);
        if constexpr (ALIGN_EPI) { if (wr == 0) PG8_BAR; }
        if constexpr (MODE == 2) asm volatile("s_nop 15\n\ts_nop 7" ::: "memory");
        if constexpr (!Epi::AFTER_DRAIN) { E(acc, cur, wr, wc, fr, fq, pre, ui); S.done(cur); }
        if (!has_next) break;
#pragma unroll
        for (int a = 0; a < 2; ++a)
#pragma unroll
            for (int b = 0; b < 2; ++b)
#pragma unroll
                for (int m = 0; m < 4; ++m)
#pragma unroll
                    for (int n = 0; n < 2; ++n) acc[a][b][m][n] = typename AccT<MODE == 1>::type{};
        cur = nxt; cA = nA; cB = nB; ++ui;
        if constexpr (ALIGN_EPI) { if (wr == 1) PG8_BAR; }
    }
    PG8_WAIT_V(0);
    if constexpr (!ALIGN_EPI) { if (wr == 0) PG8_BAR; }
    PG8_BAR;
    if constexpr (Epi::AFTER_DRAIN) { E.fused(acc, cur, wr, wc, fr, fq, lds, wid, lane); S.done(cur); }
#undef PG8_SA
#undef PG8_SB
#undef PG8_STAGE
#undef PG8_LDA
#undef PG8_LDB
#undef PG8_MMA
#undef PG8_WAIT_V
#undef PG8_WAIT_L
#undef PG8_BAR
#undef PG8_SCHED
}
}
#include <hip/hip_bf16.h>
#include <cmath>
namespace attn_body {
using bf16=__hip_bfloat16;
using bf16x8=__attribute__((ext_vector_type(8)))short;
using s16x4=__attribute__((ext_vector_type(4)))short;
using f32x16=__attribute__((ext_vector_type(16)))float;
using u32x4=__attribute__((ext_vector_type(4)))unsigned;
constexpr int BATCH=2,NHEAD=8,SEQ=8192,D=64,DM=3584,OPITCH=1024;
constexpr int NW=8,QBLK=32,QB=QBLK*NW,KVBLK=64,NQB=SEQ/QB;
constexpr int ATTN_PITCH=DM, ATTN_UNIT_ROWS=QB;
__device__ __forceinline__ int crow(int r,int hi){return (r&3)+8*(r>>2)+4*hi;}
#define SBAR() __builtin_amdgcn_sched_barrier(0)
__device__ __forceinline__ void cmask(f32x16&p0,f32x16&p1,int jb,int qrel,int hi){
  const float NEG=-INFINITY; int kb=64*jb+4*hi;
  #pragma unroll
  for(int r=0;r<16;++r){int kv=kb+(r&3)+8*(r>>2); if(kv>qrel)p0[r]=NEG; if(kv+32>qrel)p1[r]=NEG;}
}

constexpr int NSLOT=3, SLOTB=8192, SPLIT_NT=72, PART_F=256*64+512;
constexpr int LDS_K=0, LDS_V=NSLOT*SLOTB, LDS_WS=2*NSLOT*SLOTB, LDS_OST=LDS_WS+NW*64*4, LDS_CK=LDS_OST+NW*4096, LDS_BYTES=LDS_CK+SEQ*4;
constexpr float C2=0.125f*1.4426950408889634f;
__device__ __forceinline__ void glds16(const void*gsrc,unsigned lds_dst){unsigned keep;
  asm volatile("s_mov_b32 %0, m0\n\ts_mov_b32 m0, %2\n\ts_nop 0\n\tglobal_load_lds_dwordx4 %1, off\n\ts_mov_b32 m0, %0":"=&s"(keep):"v"(gsrc),"s"(lds_dst):"memory");}
__device__ __forceinline__ float max3f(float a,float b,float c){float r;asm("v_max3_f32 %0, %1, %2, %3":"=v"(r):"v"(a),"v"(b),"v"(c));return r;}
__device__ __forceinline__ float max2f(float a,float b){float r;asm("v_max_f32_e32 %0, %1, %2":"=v"(r):"v"(a),"v"(b));return r;}
__device__ __forceinline__ float fadd_s(float a,float b){float r;asm("v_add_f32_e32 %0, %1, %2":"=v"(r):"v"(a),"v"(b));return r;}
__device__ __forceinline__ float fsub_s(float a,float b){float r;asm("v_sub_f32_e32 %0, %1, %2":"=v"(r):"v"(a),"v"(b));return r;}
typedef float f32x2_t __attribute__((ext_vector_type(2))); typedef float f32x4_t __attribute__((ext_vector_type(4))); typedef __bf16 bf16x2_t __attribute__((ext_vector_type(2)));
__device__ __forceinline__ unsigned cvtpk_s(float lo,float hi){f32x2_t v={lo,hi};bf16x2_t b=__builtin_convertvector(v,bf16x2_t);return __builtin_bit_cast(unsigned,b);}
#define WAIT_BAR(N) asm volatile("s_waitcnt vmcnt(" #N ") lgkmcnt(0)\n\ts_barrier":::"memory")

__device__ __forceinline__ void qkt(f32x16&p0,f32x16&p1,const char*Kslot,const bf16x8*qr,const f32x16&negm,int r32,int hi){
  const char*kb=Kslot+hi*1024+r32*16;
  #pragma unroll
  for(int d0=0;d0<4;++d0){
    const bf16x8 b0=*reinterpret_cast<const bf16x8*>(kb+d0*2048);
    const bf16x8 b1=*reinterpret_cast<const bf16x8*>(kb+d0*2048+512);
    if(d0==0){p0=__builtin_amdgcn_mfma_f32_32x32x16_bf16(b0,qr[0],negm,0,0,0);p1=__builtin_amdgcn_mfma_f32_32x32x16_bf16(b1,qr[0],negm,0,0,0);}
    else{p0=__builtin_amdgcn_mfma_f32_32x32x16_bf16(b0,qr[d0],p0,0,0,0);p1=__builtin_amdgcn_mfma_f32_32x32x16_bf16(b1,qr[d0],p1,0,0,0);}}
}
typedef __attribute__((address_space(3))) const char* lds_cptr;
typedef short v4i16_t __attribute__((ext_vector_type(4)));
__device__ __forceinline__ void kload8(bf16x8*kf,lds_cptr kp){
  kf[0]=*(const __attribute__((address_space(3))) bf16x8*)(kp);      kf[1]=*(const __attribute__((address_space(3))) bf16x8*)(kp+512);
  kf[2]=*(const __attribute__((address_space(3))) bf16x8*)(kp+2048); kf[3]=*(const __attribute__((address_space(3))) bf16x8*)(kp+2560);
  kf[4]=*(const __attribute__((address_space(3))) bf16x8*)(kp+4096); kf[5]=*(const __attribute__((address_space(3))) bf16x8*)(kp+4608);
  kf[6]=*(const __attribute__((address_space(3))) bf16x8*)(kp+6144); kf[7]=*(const __attribute__((address_space(3))) bf16x8*)(kp+6656);
}
__device__ __forceinline__ void kload2(bf16x8*kf,lds_cptr kp,int j){ kf[2*j]=*(const __attribute__((address_space(3))) bf16x8*)(kp+j*2048); kf[2*j+1]=*(const __attribute__((address_space(3))) bf16x8*)(kp+j*2048+512); }
__device__ __forceinline__ s16x4 vtr(lds_cptr p){ return __builtin_bit_cast(s16x4,__builtin_amdgcn_ds_read_tr16_b64_v4i16((__attribute__((address_space(3))) v4i16_t*)p)); }
__device__ __forceinline__ float rowmax(const f32x16&p0,const f32x16&p1){
  float a=max3f(p0[0],p0[1],p1[0]),b=max3f(p0[2],p0[3],p1[1]);a=max3f(a,p1[2],p1[3]);
  #pragma unroll
  for(int r=4;r<16;r+=4){a=max3f(a,p0[r],p0[r+1]);b=max3f(b,p0[r+2],p0[r+3]);a=max3f(a,p1[r],p1[r+1]);b=max3f(b,p1[r+2],p1[r+3]);}
  const float m=max2f(a,b);
  auto rr=__builtin_amdgcn_permlane32_swap(__float_as_uint(m),__float_as_uint(m),false,false);
  return max2f(__uint_as_float(rr[0]),__uint_as_float(rr[1]));
}
__device__ __forceinline__ void pv(f32x16*o,int vb,bf16x8 pa0,bf16x8 pa1,bf16x8 pa2,bf16x8 pa3){
  #pragma unroll
  for(int d0=0;d0<2;++d0){s16x4 lo[4],hi[4];
    #pragma unroll
    for(int ks=0;ks<4;++ks){
      asm volatile("ds_read_b64_tr_b16 %0,%1 offset:%c2":"=&v"(lo[ks]):"v"(vb),"i"(d0*4096+ks*1024):"memory");
      asm volatile("ds_read_b64_tr_b16 %0,%1 offset:%c2":"=&v"(hi[ks]):"v"(vb),"i"(d0*4096+ks*1024+512):"memory");}
    asm volatile("s_waitcnt lgkmcnt(0)":::"memory");SBAR();
    #define PK(k) (bf16x8){lo[k][0],lo[k][1],lo[k][2],lo[k][3],hi[k][0],hi[k][1],hi[k][2],hi[k][3]}
    o[d0]=__builtin_amdgcn_mfma_f32_32x32x16_bf16(pa0,PK(0),o[d0],0,0,0);
    o[d0]=__builtin_amdgcn_mfma_f32_32x32x16_bf16(pa1,PK(1),o[d0],0,0,0);
    o[d0]=__builtin_amdgcn_mfma_f32_32x32x16_bf16(pa2,PK(2),o[d0],0,0,0);
    o[d0]=__builtin_amdgcn_mfma_f32_32x32x16_bf16(pa3,PK(3),o[d0],0,0,0);
    #undef PK
  }
}

#ifndef ATTN_STORE16
#define ATTN_STORE16(p,v) (*(u32x4*)(p)=(v))
#endif
template<int THRL> __device__ __forceinline__ void attn_unit(int b,int h,int qb,const bf16*Q,const bf16*__restrict__ K,const bf16*__restrict__ V,bf16*O,const float*__restrict__ cf,const float Tskip,const int part,float*PART,unsigned*flag,char*shm){
  int tid_=threadIdx.x; asm volatile("":"+v"(tid_));
  const int tid=tid_,lane=tid&63,r32=lane&31,hi=lane>>5; const int wid=__builtin_amdgcn_readfirstlane(tid>>6);
  const long rowbase=(long)b*SEQ; const int q0=qb*QB;
  const bf16*Qw=Q+(rowbase+q0+wid*QBLK)*DM+h*D;
  const unsigned lds0=(unsigned)(uintptr_t)shm;
  float*wsf=(float*)(shm+LDS_WS)+wid*64;
  const unsigned kdst=lds0+LDS_K+wid*1024, vdst=lds0+LDS_V+wid*1024;
  #define DMA_K(t,slot) glds16(ksrc+(long)(t)*KVBLK*DM,(unsigned)__builtin_amdgcn_readfirstlane(kdst+(slot)))
  #define DMA_V(t,slot) glds16(vsrc+(long)(t)*KVBLK*DM,(unsigned)__builtin_amdgcn_readfirstlane(vdst+(slot)))
  const int vb0=(int)(lds0+LDS_V)+((lane>>4)&1)*32+(lane&3)*8+(4*hi+((lane&15)>>2))*64;
  const char*Kbase=shm+LDS_K; bf16x8 kf[8];
  const lds_cptr shm3=(lds_cptr)shm; const lds_cptr kp0=shm3+LDS_K+hi*1024+r32*16; const lds_cptr vp0=shm3+LDS_V+((lane>>4)&1)*32+(lane&3)*8+(4*hi+((lane&15)>>2))*64;
  typedef __attribute__((address_space(3))) float lds_f32; typedef __attribute__((address_space(3))) const f32x4_t* lds_cf4;
  const int NT0=(q0+QB)/KVBLK;
  int tb;
  { const float thr=cf[q0]+Tskip; const int t1=lane,t2=lane+64;
    const bool n1=(t1<NT0)&&(cf[64*t1+63]>thr), n2=(t2<NT0)&&(cf[64*t2+63]>thr);
    const int t0=(int)__popcll(__ballot(n1))+(int)__popcll(__ballot(n2));
    tb=t0&~1; if(tb>NT0-4)tb=NT0-4; tb=__builtin_amdgcn_readfirstlane(tb); }
  int NT=NT0-tb; bool band=true; const bool split=(PART!=nullptr)&&(NT>SPLIT_NT);
  if(PART!=nullptr){ if(!split){ if(part==1)return; } else { const int mid=(NT>>1)&~1; if(part==0){NT=mid;band=false;} else {tb+=mid;NT-=mid;} } }
  { lds_f32* ckw=(lds_f32*)((lds_cptr)shm+LDS_CK); int i0_=tb*KVBLK+tid; asm volatile("":"+v"(i0_)); _Pragma("nounroll") for(int i=i0_;i<q0+QB;i+=NW*64)ckw[i]=cf[i]; }
  const float cq=cf[q0+wid*QBLK+(lane&31)];
  asm volatile("s_waitcnt vmcnt(0) lgkmcnt(0)\n\ts_barrier":::"memory");
  const bf16*Kh=K+(rowbase+(long)tb*KVBLK)*DM+h*D,*Vh=V+(rowbase+(long)tb*KVBLK)*DM+h*D;
  const bf16*ksrc=Kh+(long)lane*DM+wid*8;
  const bf16*vsrc=Vh+(long)(16*(wid&3)+(lane>>2))*DM+(wid>>2)*32+(lane&3)*8;
  const lds_cptr ckl=(lds_cptr)shm+LDS_CK+256*tb+16*(lane>>5);
  #define CBIAS(P0,P1,t) do{ const lds_cptr cb_=ckl+256*(t); _Pragma("unroll") for(int g_=0;g_<4;++g_){ const f32x4_t a_=*(lds_cf4)(cb_+32*g_), b_=*(lds_cf4)(cb_+128+32*g_); \
      _Pragma("unroll") for(int i_=0;i_<4;++i_){ P0[4*g_+i_]-=(a_[i_]+mm); P1[4*g_+i_]-=(b_[i_]+mm); } } }while(0)
  f32x4_t cbA[4],cbB[4]; float clast;
  #define CBLD(t) do{ const lds_cptr cb_=ckl+256*(t); _Pragma("unroll") for(int g_=0;g_<4;++g_){ cbA[g_]=*(lds_cf4)(cb_+32*g_); cbB[g_]=*(lds_cf4)(cb_+128+32*g_); } \
      clast=*(const __attribute__((address_space(3))) float*)((lds_cptr)shm+LDS_CK+256*tb+256*(t)+252); }while(0)
  DMA_K(0,0);DMA_V(0,0);DMA_K(1,SLOTB);
  bf16x8 qr[4];
  #pragma unroll
  for(int d0=0;d0<4;++d0)qr[d0]=*reinterpret_cast<const bf16x8*>(&Qw[(long)r32*DM+d0*16+hi*8]);
  float mhat=0.f,l_reg=0.f;f32x16 o[2];o[0]=f32x16{};o[1]=f32x16{};float mm=-cq; const f32x16 negm=f32x16{};
  const int qrel=wid*QBLK+r32;
  #define CMASK(P0,P1,t) do{int jb_=(t)-(NT-4); if(band&&jb_>=0)cmask(P0,P1,jb_,qrel,hi);}while(0)
  bool resc=false;
  #define START(P0,P1) do{ const float rm=rowmax(P0,P1); resc=false; \
    { const float dl=rm; mhat=fadd_s(mhat,dl); \
      _Pragma("unroll") for(int r=0;r<16;++r){P0[r]=fsub_s(P0[r],dl);P1[r]=fsub_s(P1[r],dl);} \
      mm+=dl; } \
    _Pragma("unroll") for(int r=0;r<16;++r)P0[r]=__builtin_amdgcn_exp2f(P0[r]); }while(0)
  #define RESC() do{ if(resc){ asm volatile("s_waitcnt lgkmcnt(0)":::"memory"); \
      _Pragma("unroll") for(int d_=0;d_<2;++d_) _Pragma("unroll") for(int r=0;r<16;++r)o[d_][r]*=wsf[crow(r,hi)]; } }while(0)
  f32x16 pA0,pA1,pB0,pB1;
  int sl_prev=0,sl_cur=0,sl_next=SLOTB;
  #define ROT() do{sl_prev=sl_cur;sl_cur=sl_next;sl_next=(sl_next==(NSLOT-1)*SLOTB)?0:sl_next+SLOTB;}while(0)
  DMA_K(2,2*SLOTB);
  WAIT_BAR(3);
  qkt(pA0,pA1,Kbase,qr,negm,r32,hi);asm volatile("s_nop 15\n\ts_nop 7":"+v"(pA0),"+v"(pA1));CBIAS(pA0,pA1,0);CMASK(pA0,pA1,0);
  START(pA0,pA1);
  _Pragma("unroll") for(int r=0;r<16;++r)pA1[r]=__builtin_amdgcn_exp2f(pA1[r]);
  WAIT_BAR(0);
  DMA_K(3,0);DMA_V(1,SLOTB);
  ROT();
  kload8(kf,kp0+sl_cur);
  WAIT_BAR(2);
  s16x4 vlo[8],vhi[8]; u32x4 pw0,pw1,pw2,pw3;
  #define PKW(P,B) cvtpk_s(P[B],P[B+1])
  #define PAF(k) __builtin_bit_cast(bf16x8,pw##k)
  #define VFR(i) (bf16x8){vlo[i][0],vlo[i][1],vlo[i][2],vlo[i][3],vhi[i][0],vhi[i][1],vhi[i][2],vhi[i][3]}
  #define PIN(x) asm volatile("":"+v"(x))
  #define MX3(a,b,c) __builtin_fmaxf(__builtin_fmaxf((a),(b)),(c))
  #define GAPA(MF,A0,A1,A2,A3,W0,W1,PW) do{ MF; sacc+=A0; sacc+=A1; sacc+=A2; sacc+=A3; PIN(sacc); W0; W1; PIN(PW); SBAR(); }while(0)
  #define EX(v) __builtin_amdgcn_exp2f(v)
  #define GAPB(MF,X,B,CB) do{ MF; { const f32x4_t t_=(CB)+mm; X[B]=EX(X[B]-t_[0]); X[B+1]=EX(X[B+1]-t_[1]); X[B+2]=EX(X[B+2]-t_[2]); X[B+3]=EX(X[B+3]-t_[3]); } PIN(X); SBAR(); }while(0)
  #define VRD(i) do{ vlo[i]=vtr(vp_+(((i)>>2)*4096+((i)&3)*1024)); vhi[i]=vtr(vp_+(((i)>>2)*4096+((i)&3)*1024+512)); }while(0)
  #define KRD(G,j) do{ if(G){ kload2(kf,kp0+sl_next,j); SBAR(); } }while(0)
  #define STEP(C0,C1,P0,P1,t,GK,GV,GL) do{ SBAR(); \
    const lds_cptr vp_=vp0+sl_prev; \
    VRD(0); SBAR(); float sacc=(P0[0]+P0[1]); \
    GAPA(C0=__builtin_amdgcn_mfma_f32_32x32x16_bf16(kf[0],qr[0],negm,0,0,0), P0[2],P0[3],P0[4],P0[5],     pw0[0]=PKW(P0,0), pw0[1]=PKW(P0,2), pw0); \
    VRD(4); SBAR(); GAPA(C1=__builtin_amdgcn_mfma_f32_32x32x16_bf16(kf[1],qr[0],negm,0,0,0), P0[6],P0[7],P0[8],P0[9],     pw0[2]=PKW(P0,4), pw0[3]=PKW(P0,6), pw0); \
    VRD(1); SBAR(); GAPA(C0=__builtin_amdgcn_mfma_f32_32x32x16_bf16(kf[2],qr[1],C0,0,0,0),   P0[10],P0[11],P0[12],P0[13], pw1[0]=PKW(P0,8), pw1[1]=PKW(P0,10), pw1); \
    VRD(5); SBAR(); GAPA(C1=__builtin_amdgcn_mfma_f32_32x32x16_bf16(kf[3],qr[1],C1,0,0,0),   P0[14],P0[15],P1[0],P1[1],   pw1[2]=PKW(P0,12),pw1[3]=PKW(P0,14), pw1); \
    VRD(2); SBAR(); GAPA(C0=__builtin_amdgcn_mfma_f32_32x32x16_bf16(kf[4],qr[2],C0,0,0,0),   P1[2],P1[3],P1[4],P1[5],     pw2[0]=PKW(P1,0), pw2[1]=PKW(P1,2), pw2); \
    VRD(6); SBAR(); GAPA(C1=__builtin_amdgcn_mfma_f32_32x32x16_bf16(kf[5],qr[2],C1,0,0,0),   P1[6],P1[7],P1[8],P1[9],     pw2[2]=PKW(P1,4), pw2[3]=PKW(P1,6), pw2); \
    VRD(3); SBAR(); GAPA(C0=__builtin_amdgcn_mfma_f32_32x32x16_bf16(kf[6],qr[3],C0,0,0,0),   P1[10],P1[11],P1[12],P1[13], pw3[0]=PKW(P1,8), pw3[1]=PKW(P1,10), pw3); \
    VRD(7); SBAR(); GAPA(C1=__builtin_amdgcn_mfma_f32_32x32x16_bf16(kf[7],qr[3],C1,0,0,0),   P1[14],P1[15],0.f,0.f,       pw3[2]=PKW(P1,12),pw3[3]=PKW(P1,14), pw3); \
    l_reg+=sacc; \
    if(GK){DMA_K((t)+3,sl_cur);} if(GV){DMA_V((t)+1,sl_next);} \
    CBLD(t); CMASK(C0,C1,t); \
    { float a=MX3(C0[0],C0[1],C1[0]),b=MX3(C0[2],C0[3],C1[1]); a=MX3(a,C1[2],C1[3]); \
      _Pragma("unroll") for(int r=4;r<16;r+=4){a=MX3(a,C0[r],C0[r+1]);b=MX3(b,C0[r+2],C0[r+3]);a=MX3(a,C1[r],C1[r+1]);b=MX3(b,C1[r+2],C1[r+3]);} \
      float rm=__builtin_fmaxf(a,b); { auto rr=__builtin_amdgcn_permlane32_swap(__float_as_uint(rm),__float_as_uint(rm),false,false); rm=__builtin_fmaxf(__uint_as_float(rr[0]),__uint_as_float(rr[1])); } rm=rm-clast-mm; \
      resc=false; \
      if(__builtin_expect(__any(rm>(float)THRL),0)){ const float dl=__builtin_fmaxf(rm,0.f); mhat+=dl; \
        mm+=dl; \
        const float f=__builtin_amdgcn_exp2f(-dl); l_reg*=f; if(hi==0)wsf[r32]=f; resc=true; } } \
    SBAR(); \
    GAPB(o[0]=__builtin_amdgcn_mfma_f32_32x32x16_bf16(PAF(0),VFR(0),o[0],0,0,0), C0,0,cbA[0]); \
    GAPB(o[1]=__builtin_amdgcn_mfma_f32_32x32x16_bf16(PAF(0),VFR(4),o[1],0,0,0), C0,4,cbA[1]); \
    KRD(GL,0); GAPB(o[0]=__builtin_amdgcn_mfma_f32_32x32x16_bf16(PAF(1),VFR(1),o[0],0,0,0), C0,8,cbA[2]); \
    KRD(GL,1); GAPB(o[1]=__builtin_amdgcn_mfma_f32_32x32x16_bf16(PAF(1),VFR(5),o[1],0,0,0), C0,12,cbA[3]); \
    KRD(GL,2); GAPB(o[0]=__builtin_amdgcn_mfma_f32_32x32x16_bf16(PAF(2),VFR(2),o[0],0,0,0), C1,0,cbB[0]); \
    KRD(GL,3); GAPB(o[1]=__builtin_amdgcn_mfma_f32_32x32x16_bf16(PAF(2),VFR(6),o[1],0,0,0), C1,4,cbB[1]); \
    GAPB(o[0]=__builtin_amdgcn_mfma_f32_32x32x16_bf16(PAF(3),VFR(3),o[0],0,0,0), C1,8,cbB[2]); \
    GAPB(o[1]=__builtin_amdgcn_mfma_f32_32x32x16_bf16(PAF(3),VFR(7),o[1],0,0,0), C1,12,cbB[3]); \
    }while(0)
  int t=1;
  #undef CMASK
  #define CMASK(P0,P1,t) do{}while(0)
  for(;t+5<NT;t+=2){
    STEP(pB0,pB1,pA0,pA1,t,true,true,true);     WAIT_BAR(2); RESC(); ROT();
    STEP(pA0,pA1,pB0,pB1,t+1,true,true,true);   WAIT_BAR(2); RESC(); ROT();
  }
  #undef CMASK
  #define CMASK(P0,P1,t) do{int jb_=(t)-(NT-4); if(band&&jb_>=0)cmask(P0,P1,jb_,qrel,hi);}while(0)
  #define ENDW(tt) do{ if((tt)+3<NT){WAIT_BAR(2);} else if((tt)+2<NT){WAIT_BAR(1);} else {WAIT_BAR(0);} }while(0)
  for(;t+1<NT;t+=2){
    STEP(pB0,pB1,pA0,pA1,t,(t+3<NT),(t+1<NT),(t+1<NT));       ENDW(t);   RESC(); ROT();
    STEP(pA0,pA1,pB0,pB1,t+1,(t+4<NT),(t+2<NT),(t+2<NT));     ENDW(t+1); RESC(); ROT();
  }
  STEP(pB0,pB1,pA0,pA1,NT-1,false,false,false); RESC();
  { float sacc=pB0[0]+pB0[1]; _Pragma("unroll") for(int r=2;r<16;++r)sacc+=pB0[r]; _Pragma("unroll") for(int r=0;r<16;++r)sacc+=pB1[r]; l_reg+=sacc;
    pw0=(u32x4){PKW(pB0,0),PKW(pB0,2),PKW(pB0,4),PKW(pB0,6)};pw1=(u32x4){PKW(pB0,8),PKW(pB0,10),PKW(pB0,12),PKW(pB0,14)};pw2=(u32x4){PKW(pB1,0),PKW(pB1,2),PKW(pB1,4),PKW(pB1,6)};pw3=(u32x4){PKW(pB1,8),PKW(pB1,10),PKW(pB1,12),PKW(pB1,14)};
    SBAR(); pv(o,vb0+sl_cur,PAF(0),PAF(1),PAF(2),PAF(3)); }
  #undef PKW
  #undef PAF
  #undef VFR
  #undef PIN
  #undef MX3
  #undef GAPA
  #undef GAPB
  #undef EX
  #undef VRD
  #undef KRD
  #undef STEP
  #undef ENDW
  {auto rr=__builtin_amdgcn_permlane32_swap(__float_as_uint(l_reg),__float_as_uint(l_reg),false,false);l_reg=__uint_as_float(rr[0])+__uint_as_float(rr[1]);}
  if(hi==0)wsf[32+r32]=l_reg;asm volatile("s_waitcnt lgkmcnt(0)":::"memory");
  float rli[16];
  if(split){
    float*Pm=PART+(size_t)part*PART_F; const float*Po=PART+(size_t)(1-part)*PART_F;
    #pragma unroll
    for(int r=0;r<16;++r){
      #pragma unroll
      for(int d0=0;d0<2;++d0)Pm[(wid*QBLK+crow(r,hi))*64+d0*32+r32]=o[d0][r];}
    if(hi==0){Pm[QB*64+(wid*QBLK+r32)*2]=mm+cq;Pm[QB*64+(wid*QBLK+r32)*2+1]=l_reg;wsf[r32]=mm+cq;}
    asm volatile("s_waitcnt vmcnt(0) lgkmcnt(0)\n\ts_barrier":::"memory");
    if(tid==0){ __builtin_amdgcn_fence(__ATOMIC_RELEASE,"agent"); asm volatile("s_waitcnt vmcnt(0)":::"memory");
      *(volatile __attribute__((address_space(3))) unsigned*)((__attribute__((address_space(3))) char*)shm+LDS_OST)=__hip_atomic_fetch_add(flag,1u,__ATOMIC_RELAXED,__HIP_MEMORY_SCOPE_AGENT); }
    asm volatile("s_waitcnt vmcnt(0) lgkmcnt(0)\n\ts_barrier":::"memory");
    const unsigned old=*(volatile __attribute__((address_space(3))) unsigned*)((__attribute__((address_space(3))) char*)shm+LDS_OST);
    asm volatile("s_waitcnt lgkmcnt(0)\n\ts_barrier":::"memory");
    if(old==0u)return;
    __builtin_amdgcn_fence(__ATOMIC_ACQUIRE,"agent"); asm volatile("s_waitcnt vmcnt(0)":::"memory");
    #pragma unroll
    for(int r=0;r<16;++r){ const int row=crow(r,hi); const float mo=wsf[row],lo=wsf[32+row],mt=Po[QB*64+(wid*QBLK+row)*2],lt=Po[QB*64+(wid*QBLK+row)*2+1];
      const float m=__builtin_fmaxf(mo,mt),fo=__builtin_amdgcn_exp2f(mo-m),ft=__builtin_amdgcn_exp2f(mt-m),inv=__builtin_amdgcn_rcpf(lo*fo+lt*ft);
      #pragma unroll
      for(int d0=0;d0<2;++d0)o[d0][r]=(o[d0][r]*fo+Po[(wid*QBLK+row)*64+d0*32+r32]*ft)*inv;
      rli[r]=1.f; }
  } else {
  #pragma unroll
  for(int r=0;r<16;++r)rli[r]=__builtin_amdgcn_rcpf(wsf[32+crow(r,hi)]);
  }
  bf16*Ow=O+(rowbase+q0+wid*QBLK)*OPITCH+h*D;
  { bf16*stg=(bf16*)(shm+LDS_OST)+wid*2048;
    #pragma unroll
    for(int r=0;r<16;++r){const int orow=crow(r,hi);
      #pragma unroll
      for(int d0=0;d0<2;++d0)stg[orow*64+d0*32+r32]=__float2bfloat16(o[d0][r]*rli[r]);}
    asm volatile("s_waitcnt lgkmcnt(0)":::"memory");
    #pragma unroll
    for(int i=0;i<4;++i){const int row=i*8+(lane>>3),ch=lane&7; const u32x4 v=*(const u32x4*)(stg+row*64+ch*8); ATTN_STORE16(Ow+(long)row*OPITCH+ch*8,v);} }
  asm volatile("s_waitcnt lgkmcnt(0)\n\ts_barrier":::"memory");
  #undef CBIAS
  #undef CBLD
  #undef DMA_K
  #undef DMA_V
  #undef CMASK
  #undef START
  #undef RESC
  #undef ROT
}
constexpr int ATTN_LDS_BYTES=LDS_BYTES;
struct AttnTensors { const bf16* Q; const bf16* K; const bf16* V; bf16* O; const float* CF; const float* stat; };
struct AttnUnit { int bh; int qb; };
struct StaticOrder {
  int vcu;
  __device__ __forceinline__ explicit StaticOrder(int grid,int block):vcu((grid%8==0)?(block%8)*(grid/8)+block/8:block),G_(grid){}
  int G_;
  __device__ __forceinline__ bool next(int i,AttnUnit&u)const{ const int v=vcu+(i>>1)*G_; if(v>=256)return false; const int s=v&15; u.bh=v>>4; u.qb=(i&1)?31-s:s; return true; }
  __device__ __forceinline__ void a_ready(const AttnUnit&)const{}
  __device__ __forceinline__ void done(const AttnUnit&)const{}
};
struct QueueOrder {
  unsigned* ctr; __attribute__((address_space(3))) unsigned* slot;
  __device__ __forceinline__ bool next(int,AttnUnit&u)const{
    if(threadIdx.x==0)*slot=__hip_atomic_fetch_add(ctr,1u,__ATOMIC_RELAXED,__HIP_MEMORY_SCOPE_AGENT);
    asm volatile("s_waitcnt vmcnt(0) lgkmcnt(0)\n\ts_barrier":::"memory");
    const unsigned v=*(volatile __attribute__((address_space(3))) unsigned*)slot; const int vv=__builtin_amdgcn_readfirstlane((int)v);
    if(vv>=512)return false; u.qb=31-(vv>>4); u.bh=vv&15; return true; }
  __device__ __forceinline__ void a_ready(const AttnUnit&)const{}
  __device__ __forceinline__ void done(const AttnUnit&)const{}
};
template<class Sched,int THRL=8> __device__ __forceinline__ void attn_phase(char*lds,const AttnTensors&T,const Sched&S){
  AttnUnit u;
  for(int i=0;S.next(i,u);++i){ S.a_ready(u); const float Tsk=40.f+2.f*__builtin_sqrtf(T.stat[u.bh*2]*T.stat[u.bh*2+1])*1.01f+1.f;
    attn_unit<THRL>(u.bh/NHEAD,u.bh%NHEAD,u.qb,T.Q,T.K,T.V,T.O,T.CF+(long)u.bh*SEQ,Tsk,0,nullptr,nullptr,lds); S.done(u); }
}
#undef SBAR
#undef WAIT_BAR
}
#define GAS __attribute__((address_space(1)))
#define LAS __attribute__((address_space(3)))
typedef unsigned v4u __attribute__((ext_vector_type(4)));
typedef float f32x4 __attribute__((ext_vector_type(4)));
typedef short bf16x8 __attribute__((ext_vector_type(8)));
typedef GAS unsigned gu32;
typedef GAS unsigned long long gu64;
#define RLX_AGENT __ATOMIC_RELAXED, __HIP_MEMORY_SCOPE_AGENT
#define LDS_WAIT() asm volatile("s_waitcnt lgkmcnt(0)" ::: "memory")
#define VM_WAIT() asm volatile("s_waitcnt vmcnt(0)" ::: "memory")
__device__ __forceinline__ unsigned long long rt() { return __builtin_amdgcn_s_memrealtime(); }
__device__ __forceinline__ unsigned pk2(float lo, float hi) { return (unsigned)f2bf(lo) | ((unsigned)f2bf(hi) << 16); }

#define XB_TMO      128
#define XB_XCNT(j)  (256  + 64 * (j))
#define XB_XSUB(j)  (1280 + 64 * (j))
#define XB_XGEN(j)  (2304 + 64 * (j))
#define XB_TOP      3328
#define XB_TOPGEN   3392
#define XCD_BAR_WORDS 3456
#define XB_SPIN_CAP (1u << 18)

__device__ __forceinline__ unsigned xb_ld(unsigned* p)              { return __hip_atomic_load(p, __ATOMIC_RELAXED, __HIP_MEMORY_SCOPE_AGENT); }
__device__ __forceinline__ unsigned xb_add(unsigned* p, unsigned v) { return __hip_atomic_fetch_add(p, v, __ATOMIC_RELAXED, __HIP_MEMORY_SCOPE_AGENT); }
__device__ __forceinline__ unsigned xb_xcc_id() { return (unsigned)__builtin_amdgcn_s_getreg((3 << 11) | 20) & 0xFu; }
#define XB_SPIN(cond, bar) do { unsigned _sp = 0; while (cond) { __builtin_amdgcn_s_sleep(1); \
    if ((++_sp & 255u) == 0u) { if (xb_ld(&(bar)[XB_TMO])) break; if (_sp > XB_SPIN_CAP) { atomicAdd(&(bar)[XB_TMO], 1u); break; } } } } while (0)

struct XcdBarrier {
    unsigned* bar; unsigned x;
    volatile LAS unsigned* st;
};

__device__ __forceinline__ XcdBarrier xcd_barrier_post(unsigned* bar, volatile LAS unsigned* st) {
    XcdBarrier b; b.bar = bar; b.x = xb_xcc_id(); b.st = st;
    if (threadIdx.x == 0) (void)xb_add(&bar[XB_XCNT(b.x)], 1u);
    return b;
}
__device__ __forceinline__ void xcd_barrier_complete(unsigned* bar, unsigned x, unsigned& nloc, unsigned& nx) {
    const unsigned G = gridDim.x * gridDim.y * gridDim.z;
    unsigned sum, cnt, mine, sp = 0u;
    for (;;) {
        sum = 0u; cnt = 0u; mine = 0u;
#pragma unroll
        for (unsigned j = 0; j < 16; ++j) { const unsigned c = xb_ld(&bar[XB_XCNT(j)]); sum += c; cnt += (c > 0u) ? 1u : 0u; mine = (j == x) ? c : mine; }
        if (sum == G) break;
        __builtin_amdgcn_s_sleep(1);
        if ((++sp & 255u) == 0u) { if (xb_ld(&bar[XB_TMO])) break; if (sp > XB_SPIN_CAP) { atomicAdd(&bar[XB_TMO], 1u); break; } }
    }
    nloc = mine > 0u ? mine : 1u; nx = cnt > 0u ? cnt : 1u;
}

__device__ __forceinline__ void xcd_barrier(const XcdBarrier& b) {
    asm volatile("s_waitcnt vmcnt(0)" ::: "memory");
    __syncthreads();
    if (threadIdx.x == 0) {
        unsigned* bar = b.bar;
        __builtin_amdgcn_s_waitcnt(0);
        unsigned nloc = b.st[0], nx = b.st[1];
        if (nloc == 0u) { xcd_barrier_complete(bar, b.x, nloc, nx); b.st[0] = nloc; b.st[1] = nx; }
        const unsigned old = xb_add(&bar[XB_XSUB(b.x)], 1u);
        const unsigned gen = old / nloc;
        if (old + 1u == (gen + 1u) * nloc) {
            __builtin_amdgcn_fence(__ATOMIC_RELEASE, "agent");
            asm volatile("s_waitcnt vmcnt(0)" ::: "memory");
            const unsigned og = xb_add(&bar[XB_TOP], 1u);
            const unsigned tg = og / nx;
            if (og + 1u == (tg + 1u) * nx) xb_add(&bar[XB_TOPGEN], 1u);
            else XB_SPIN(xb_ld(&bar[XB_TOPGEN]) == tg, bar);
            __builtin_amdgcn_fence(__ATOMIC_ACQUIRE, "agent");
            xb_add(&bar[XB_XGEN(b.x)], 1u);
            asm volatile("s_waitcnt vmcnt(0)" ::: "memory");
        } else {
            XB_SPIN(xb_ld(&bar[XB_XGEN(b.x)]) == gen, bar);
            __builtin_amdgcn_fence(__ATOMIC_ACQUIRE, "agent");
            asm volatile("s_waitcnt vmcnt(0)" ::: "memory");
        }
    }
    __syncthreads();
}
constexpr int NWAVES = 8, NTHR = 512;
constexpr int RING_OFF = 0, RING_BYTES = 131072, LDSCTL_OFF = RING_BYTES, MISC_OFF = LDSCTL_OFF + 320, LDS_BYTES = 147456;
constexpr int CW_BAR = 4096;
constexpr size_t WS_WIN = WS_W  , WS_SWIN = WS_W + 8 * MiB  , WS_WOUT = WS_W + 14 * MiB  , WS_WDGU = WS_W + 18 * MiB  , WS_SWDGU = WS_W + 24 * MiB  , WS_WDDN = WS_W + 29 * MiB  ;
constexpr size_t WS_SH = WS_H + 16 * MiB  , WS_SXG = WS_XG + 34 * MiB  ;
constexpr size_t WS_WMGU = WS_W  , WS_SWMGU = WS_W + 60 * MiB  , WS_WMDN = WS_W + 64 * MiB  ;
static_assert(WS_WMDN + 56 * MiB <= 469 * MiB, "ws");
struct MArgs { const float* in[20]; float* out; unsigned char* ws; int ph_lo, ph_hi; };
enum { I_X = 0, I_ATTN_NORM, I_W_IN, I_HGRN_LB, I_HGRN_NORM, I_MLSTM_CONV, I_MLSTM_BI, I_MLSTM_BF, I_MLSTM_NORM, I_FOX_BF, I_W_OUT, I_FFN_NORM, I_DGATE, I_DUP, I_DDOWN, I_ROUTER, I_MGATE, I_MUP, I_MDOWN, I_FINAL_NORM };

__device__ __forceinline__ void tr_item(const float* W, int ldw, int K, bf16_t* WT, LAS float* scr, int k0, int lane) {
#pragma unroll 32
    for (int i = 0; i < 32; ++i) { const int kk = 2 * i + (lane >> 5); scr[kk * 33 + (lane & 31)] = W[(size_t)(k0 + kk) * ldw + (lane & 31)]; }
    LDS_WAIT(); asm volatile("" ::: "memory");
    const int c = lane & 7;
#pragma unroll
    for (int j = 0; j < 4; ++j) { const int n = (lane >> 3) + 8 * j; const LAS float* s = scr + (8 * c) * 33 + n;
        v4u o; o.x = pk2(s[0 * 33], s[1 * 33]); o.y = pk2(s[2 * 33], s[3 * 33]); o.z = pk2(s[4 * 33], s[5 * 33]); o.w = pk2(s[6 * 33], s[7 * 33]);
        *(GAS v4u*)(WT + (size_t)n * K + k0 + 8 * c) = o; }
    LDS_WAIT(); asm volatile("" ::: "memory");
}
__device__ __forceinline__ void tr_item_f8(const float* W, int ldw, int K, unsigned char* WT8, LAS float* scr, int k0, int lane) {
#pragma unroll 8
    for (int i = 0; i < 32; ++i) { const int kk = 2 * i + (lane >> 5); scr[kk * 33 + (lane & 31)] = W[(size_t)(k0 + kk) * ldw + (lane & 31)]; }
    LDS_WAIT(); asm volatile("" ::: "memory");
    const int c = lane & 7;
#pragma unroll
    for (int j = 0; j < 4; ++j) { const int n = (lane >> 3) + 8 * j; const LAS float* s = scr + (8 * c) * 33 + n; float h[8];
#pragma unroll
        for (int i = 0; i < 8; ++i) h[i] = __builtin_fminf(__builtin_fmaxf(s[i * 33] * pg8::F8_WSCALE, -448.f), 448.f);
        unsigned w0 = 0u, w1 = 0u; w0 = __builtin_amdgcn_cvt_pk_fp8_f32(h[0], h[1], w0, false); w0 = __builtin_amdgcn_cvt_pk_fp8_f32(h[2], h[3], w0, true);
        w1 = __builtin_amdgcn_cvt_pk_fp8_f32(h[4], h[5], w1, false); w1 = __builtin_amdgcn_cvt_pk_fp8_f32(h[6], h[7], w1, true);
        typedef unsigned u32x2_ __attribute__((ext_vector_type(2))); *(GAS u32x2_*)(WT8 + (size_t)n * K + k0 + 8 * c) = (u32x2_){w0, w1}; }
    LDS_WAIT(); asm volatile("" ::: "memory");
}
__device__ __forceinline__ int glu_row(int c, int up) { return (c >> 7) * 256 + (c & 127) + up * 128; }

struct RowIn { float4 v[4]; };
template <bool BF> __device__ __forceinline__ void mrow_load(RowIn& R, const void* src, int row, int lane) {
    if (BF) { const uint2* xr = (const uint2*)((const bf16_t*)src + (size_t)row * D) + lane;
#pragma unroll
        for (int j = 0; j < 4; ++j) { const uint2 w = xr[64 * j]; R.v[j] = make_float4(__uint_as_float(w.x << 16), __uint_as_float(w.x & 0xffff0000u), __uint_as_float(w.y << 16), __uint_as_float(w.y & 0xffff0000u)); } }
    else { const float4* xr = (const float4*)((const float*)src + (size_t)row * D) + lane;
#pragma unroll
        for (int j = 0; j < 4; ++j) R.v[j] = xr[64 * j]; } }
template <int MODE> __device__ __forceinline__ void mrow(const RowIn& R, signed char* H8, float* SH, const float* gain, const LAS float* tab, float* G, int row, int lane, float (&lg)[8]) {
    float4 v[4]; float ss = 0.f;
#pragma unroll
    for (int j = 0; j < 4; ++j) { v[j] = R.v[j]; ss += v[j].x * v[j].x + v[j].y * v[j].y + v[j].z * v[j].z + v[j].w * v[j].w; }
    ss = wave_sum(ss);
    const float r = rsqrtf(ss * (1.f / D) + EPS);
    float h[16];
#pragma unroll
    for (int j = 0; j < 4; ++j) { const float4 g = *((const float4*)gain + 64 * j + lane);
        h[4 * j + 0] = v[j].x * r * g.x; h[4 * j + 1] = v[j].y * r * g.y; h[4 * j + 2] = v[j].z * r * g.z; h[4 * j + 3] = v[j].w * r * g.w; }
    { float am = 0.f;
#pragma unroll
      for (int i = 0; i < 16; ++i) am = fmaxf(am, fabsf(h[i]));
#pragma unroll
      for (int o = 1; o < 64; o <<= 1) am = fmaxf(am, __shfl_xor(am, o));
      const float inv = am > 0.f ? 127.f / am : 0.f;
#pragma unroll
      for (int j = 0; j < 4; ++j) { const int q0 = (int)rintf(h[4 * j] * inv), q1 = (int)rintf(h[4 * j + 1] * inv), q2 = (int)rintf(h[4 * j + 2] * inv), q3 = (int)rintf(h[4 * j + 3] * inv);
          *((unsigned*)(H8 + (size_t)row * D) + 64 * j + lane) = (unsigned)(q0 & 255) | ((unsigned)(q1 & 255) << 8) | ((unsigned)(q2 & 255) << 16) | ((unsigned)(q3 & 255) << 24); }
      if (lane == 0) SH[row] = am > 0.f ? am * (1.f / 127.f) : 1.f; }
    if (MODE == 0) {
        float mine = 0.f;
#pragma unroll 2
        for (int c = 0; c < 16; ++c) { float s = 0.f;
#pragma unroll
            for (int j = 0; j < 4; ++j) { const f32x4 w = *(const LAS f32x4*)(tab + c * 1024 + 256 * j + 4 * lane); s += h[4 * j] * w[0] + h[4 * j + 1] * w[1] + h[4 * j + 2] * w[2] + h[4 * j + 3] * w[3]; }
            s = wave_sum(s); if (lane == c) mine = s; }
        if (lane < 16) G[(size_t)row * GW + lane] = mine;
    }
    if (MODE == 2) {
        float v0 = -INFINITY, v1 = -INFINITY; int e0 = 0, e1 = 0;
#pragma unroll 2
        for (int c = 0; c < 8; ++c) { float s = 0.f;
#pragma unroll
            for (int j = 0; j < 4; ++j) { const f32x4 w = *(const LAS f32x4*)(tab + c * 1024 + 256 * j + 4 * lane); s += h[4 * j] * w[0] + h[4 * j + 1] * w[1] + h[4 * j + 2] * w[2] + h[4 * j + 3] * w[3]; }
            s = wave_sum(s);
            if (s > v0) { v1 = v0; e1 = e0; v0 = s; e0 = c; } else if (s > v1) { v1 = s; e1 = c; } }
        lg[0] = v0; lg[1] = v1; lg[2] = __int_as_float(e0); lg[3] = __int_as_float(e1);
    }
}
__device__ __forceinline__ void load_gate_tab(LAS float* tab, const float* w_in, int tid) {
    for (int k = tid; k < D; k += NTHR) { const float4* w0 = (const float4*)(w_in + (size_t)k * DIN + 1792); const float4* w1 = (const float4*)(w_in + (size_t)k * DIN + 3592);
        const float4 a0 = w0[0], a1 = w0[1], b0 = w1[0], b1 = w1[1];
        tab[0 * 1024 + k] = a0.x; tab[1 * 1024 + k] = a0.y; tab[2 * 1024 + k] = a0.z; tab[3 * 1024 + k] = a0.w; tab[4 * 1024 + k] = a1.x; tab[5 * 1024 + k] = a1.y; tab[6 * 1024 + k] = a1.z; tab[7 * 1024 + k] = a1.w;
        tab[8 * 1024 + k] = b0.x; tab[9 * 1024 + k] = b0.y; tab[10 * 1024 + k] = b0.z; tab[11 * 1024 + k] = b0.w; tab[12 * 1024 + k] = b1.x; tab[13 * 1024 + k] = b1.y; tab[14 * 1024 + k] = b1.z; tab[15 * 1024 + k] = b1.w; }
}
__device__ __forceinline__ void load_router_tab(LAS float* tab, const float* router, int tid) {
    for (int k = tid; k < D; k += NTHR) { const float4* w0 = (const float4*)(router + (size_t)k * NE); const float4 a0 = w0[0], a1 = w0[1];
        tab[0 * 1024 + k] = a0.x; tab[1 * 1024 + k] = a0.y; tab[2 * 1024 + k] = a0.z; tab[3 * 1024 + k] = a0.w; tab[4 * 1024 + k] = a1.x; tab[5 * 1024 + k] = a1.y; tab[6 * 1024 + k] = a1.z; tab[7 * 1024 + k] = a1.w; }
}
struct Conv8Job { const float* W; int ldw; signed char* WT8; float* S; };
__device__ __forceinline__ void conv8_load(float (&v)[64], const Conv8Job& j, int tid, int wave) {
    const int lane = tid & 63, n = lane & 31, kp = lane >> 5;
#pragma unroll
    for (int i = 0; i < 64; ++i) v[i] = j.W[(size_t)(128 * wave + 2 * i + kp) * j.ldw + n];
}
__device__ __forceinline__ void conv8_stage(const float (&v)[64], LAS float* img, LAS float* pm, int tid, int wave) {
    const int lane = tid & 63, n = lane & 31, kp = lane >> 5; float m = 0.f;
#pragma unroll
    for (int i = 0; i < 64; ++i) { img[(128 * wave + 2 * i + kp) * 32 + n] = v[i]; m = fmaxf(m, fabsf(v[i])); }
    m = fmaxf(m, __shfl_xor(m, 32));
    if (lane < 32) pm[wave * 32 + lane] = m;
    __syncthreads();
}
__device__ __forceinline__ void conv8_quant(const Conv8Job& j, LAS float* img, LAS float* pm, int tid, int wave) {
    const int lane = tid & 63, no = lane >> 1, kh = 128 * wave + 64 * (lane & 1);
    float cm = 0.f;
#pragma unroll
    for (int w = 0; w < 8; ++w) cm = fmaxf(cm, pm[w * 32 + no]);
    const float inv = cm > 0.f ? 127.f / cm : 0.f;
    if (wave == 0 && (lane & 1) == 0) j.S[no] = cm > 0.f ? cm * (1.f / 127.f) : 1.f;
    const LAS float* sp = img + kh * 32 + no;
#pragma unroll
    for (int q = 0; q < 4; ++q) { unsigned wq[4];
#pragma unroll
        for (int jj = 0; jj < 4; ++jj) { const int kk = 16 * q + 4 * jj; const int q0 = (int)rintf(sp[kk * 32] * inv), q1 = (int)rintf(sp[(kk + 1) * 32] * inv), q2 = (int)rintf(sp[(kk + 2) * 32] * inv), q3 = (int)rintf(sp[(kk + 3) * 32] * inv);
            wq[jj] = (unsigned)(q0 & 255) | ((unsigned)(q1 & 255) << 8) | ((unsigned)(q2 & 255) << 16) | ((unsigned)(q3 & 255) << 24); }
        v4u o; o.x = wq[0]; o.y = wq[1]; o.z = wq[2]; o.w = wq[3];
        *(GAS v4u*)(j.WT8 + (size_t)no * 1024 + kh + 16 * q) = o; }
    __syncthreads();
}
namespace scan {
typedef short bf16x8 __attribute__((ext_vector_type(8)));
typedef float f32x4 __attribute__((ext_vector_type(4)));
typedef unsigned v2u __attribute__((ext_vector_type(2)));
constexpr int TS = 144, TB = 64 * TS;
constexpr int L_T0 = 0, L_T1 = TB, L_T2 = 2 * TB, L_T3 = 3 * TB, L_T4 = 4 * TB, L_T5 = 5 * TB, L_O = 6 * TB, OS = 68  , L_PART = L_O + 64 * OS * 4, L_VEC = L_PART + 8 * 64 * 4, L_END = L_VEC + 8 * 64 * 4;
static_assert(L_END <= RING_BYTES, "scan LDS");
constexpr size_t SC_LHG = 0, SC_LML = 16 * MiB, SC_DEC = 32 * MiB  , SC_NL = 32 * MiB + 256 * 1024  , SC_AMAX = 32 * MiB + 512 * 1024, SC_BEND = SC_AMAX + 4096, SC_MPREV = SC_BEND + 4096;

__device__ __forceinline__ float wave_incl_add(float v, int lane) {
#pragma unroll
    for (int o = 1; o < 64; o <<= 1) { const float u = __shfl_up(v, o); if (lane >= o) v += u; }
    return v;
}
__device__ __forceinline__ float wave_incl_max(float v, int lane) {
#pragma unroll
    for (int o = 1; o < 64; o <<= 1) { const float u = __shfl_up(v, o); if (lane >= o) v = fmaxf(v, u); }
    return v;
}
__device__ __forceinline__ float wave_max(float v) {
#pragma unroll
    for (int o = 1; o < 64; o <<= 1) v = fmaxf(v, __shfl_xor(v, o));
    return v;
}
__device__ __forceinline__ f32x4 mma64(LAS const unsigned char* A, LAS const unsigned char* B, int m0, int n0, int lane, f32x4 acc) {
    const int r = lane & 15, kq = lane >> 4;
#pragma unroll
    for (int ks = 0; ks < 2; ++ks) {
        const bf16x8 a = *(LAS const bf16x8*)(A + (m0 + r) * TS + kq * 16 + ks * 64);
        const bf16x8 b = *(LAS const bf16x8*)(B + (n0 + r) * TS + kq * 16 + ks * 64);
        acc = __builtin_amdgcn_mfma_f32_16x16x32_bf16(a, b, acc, 0, 0, 0);
    }
    return acc;
}
__device__ __forceinline__ v4u pack8(const float (&v)[8]) { v4u w; w.x = pk2(v[0], v[1]); w.y = pk2(v[2], v[3]); w.z = pk2(v[4], v[5]); w.w = pk2(v[6], v[7]); return w; }
__device__ __forceinline__ v4u pack8h(const bf16_t (&v)[8]) { v4u w; w.x = v[0] | ((unsigned)v[1] << 16); w.y = v[2] | ((unsigned)v[3] << 16); w.z = v[4] | ((unsigned)v[5] << 16); w.w = v[6] | ((unsigned)v[7] << 16); return w; }
__device__ __forceinline__ void st16(LAS unsigned char* p, float v) { *(LAS bf16_t*)p = f2bf(v); }
__device__ __forceinline__ void load_state_tile(LAS unsigned char* T, const float* S, int tid) {
    const int v = tid >> 3, d0 = (tid & 7) * 8; const float4 x0 = *(const float4*)(S + v * 64 + d0), x1 = *(const float4*)(S + v * 64 + d0 + 4);
    v4u w; w.x = pk2(x0.x, x0.y); w.y = pk2(x0.z, x0.w); w.z = pk2(x1.x, x1.y); w.w = pk2(x1.z, x1.w);
    *(LAS v4u*)(T + v * TS + d0 * 2) = w;
}
__device__ __forceinline__ void local_state_mma_store(LAS unsigned char* L, float* LT, int wave, int lane) {
    const int mt = wave >> 1;
#pragma unroll
    for (int nn = 0; nn < 2; ++nn) { const int nt = 2 * (wave & 1) + nn; f32x4 acc = {0.f, 0.f, 0.f, 0.f};
        acc = mma64(L + L_T1, L + L_T0, mt * 16, nt * 16, lane, acc);
#pragma unroll
        for (int r = 0; r < 4; ++r) LT[(mt * 16 + 4 * (lane >> 4) + r) * 64 + nt * 16 + (lane & 15)] = acc[r]; }
}

struct HgIn { bf16_t fz[8], q[8], iv[8]; v4u gate; float4 s0, s1; };
template <bool DPH> __device__ __forceinline__ void hgrn_load(HgIn& R, const bf16_t* P, int b, int c, int h, const float* ST, int tid, int wave) {
    const int d = tid & 63, tq = wave, row0 = b * SEQ + c * 64; const bf16_t* pr = P + (size_t)(row0 + 8 * tq) * PW + h * 64 + d;
#pragma unroll
    for (int i = 0; i < 8; ++i) { R.fz[i] = pr[(size_t)i * PW + P_HF]; R.iv[i] = pr[(size_t)i * PW + P_HI]; if (DPH) R.q[i] = pr[(size_t)i * PW + P_HQ]; }
    if (DPH) { const int t = tid >> 3, v0 = (tid & 7) * 8; R.gate = *(const v4u*)(P + (size_t)(row0 + t) * PW + P_HG + h * 64 + v0);
        R.s0 = *(const float4*)(ST + t * 64 + v0); R.s1 = *(const float4*)(ST + t * 64 + v0 + 4); }
}
struct MlIn { bf16_t qr[11], kr[11], vv[8]; float ig, fg, np, mprev; v4u gate; float4 s0, s1; };
template <bool DPH> __device__ __forceinline__ void mlstm_load(MlIn& R, const bf16_t* P, const float* G, int b, int c, int h, const float* CT, const float* NP, const float* MP, int tid, int wave) {
    const int d = tid & 63, tq = wave, lane = tid & 63, row0 = b * SEQ + c * 64; const bool fz3 = (c == 0 && tq == 0);
    const bf16_t* pk = P + (size_t)(row0 + 8 * tq) * PW + P_MK + h * 64 + d; const bf16_t* pq = P + (size_t)(row0 + 8 * tq) * PW + P_MQ + h * 64 + d;
#pragma unroll
    for (int j = 0; j < 11; ++j) { R.kr[j] = (j < 3 && fz3) ? (bf16_t)0 : pk[((long)j - 3) * PW]; if (DPH) R.qr[j] = (j < 3 && fz3) ? (bf16_t)0 : pq[((long)j - 3) * PW]; }
#pragma unroll
    for (int i = 0; i < 8; ++i) R.vv[i] = P[(size_t)(row0 + 8 * tq + i) * PW + P_MV + h * 64 + d];
    R.ig = G[(size_t)(row0 + lane) * GW + h]; R.fg = G[(size_t)(row0 + lane) * GW + 4 + h];
    if (DPH) { const int t = tid >> 3, v0 = (tid & 7) * 8; R.gate = *(const v4u*)(P + (size_t)(row0 + t) * PW + P_MO + h * 64 + v0);
        R.s0 = *(const float4*)(CT + t * 64 + v0); R.s1 = *(const float4*)(CT + t * 64 + v0 + 4); R.np = NP[lane]; R.mprev = MP[0]; }
}
__device__ __forceinline__ void store_state_tile(LAS unsigned char* T, const float4& x0, const float4& x1, int tid) {
    const int v = tid >> 3, d0 = (tid & 7) * 8; v4u w; w.x = pk2(x0.x, x0.y); w.y = pk2(x0.z, x0.w); w.z = pk2(x1.x, x1.y); w.w = pk2(x1.z, x1.w);
    *(LAS v4u*)(T + v * TS + d0 * 2) = w;
}
__device__ __forceinline__ void conv_silu8r(const bf16_t (&raw)[11], const float* w4  , float scale, float (&out)[8]) {
    const float w0 = w4[0], w1 = w4[512], w2 = w4[1024], w3 = w4[1536];
#pragma unroll
    for (int i = 0; i < 8; ++i) out[i] = siluf_(w0 * bf2f(raw[i]) + w1 * bf2f(raw[i + 1]) + w2 * bf2f(raw[i + 2]) + w3 * bf2f(raw[i + 3])) * scale;
}
__device__ __forceinline__ void hgrn_b_item(LAS unsigned char* L, const HgIn& R, float lb, float* LT, float* DEC, int tid, int wave) {
    const int d = tid & 63, tq = wave;
    float bl[8], kh[8]; float run = 0.f;
#pragma unroll
    for (int i = 0; i < 8; ++i) { const float fz = bf2f(R.fz[i]);
        const float sg = sigmoidf_(fz), f = lb + (1.f - lb) * sg; kh[i] = (1.f - lb) * (1.f - sg); run += __logf(f); bl[i] = run; }
    LAS float* part = (LAS float*)(L + L_PART);
    part[tq * 64 + d] = run; __syncthreads();
    float off = 0.f, btot = 0.f;
#pragma unroll
    for (int w = 0; w < 8; ++w) { const float pv = part[w * 64 + d]; btot += pv; if (w < tq) off += pv; }
#pragma unroll
    for (int i = 0; i < 8; ++i) kh[i] *= __expf(btot - (off + bl[i]));
    *(LAS v4u*)(L + L_T0 + d * TS + tq * 16) = pack8(kh);
    *(LAS v4u*)(L + L_T1 + d * TS + tq * 16) = pack8h(R.iv);
    if (tq == 0) DEC[d] = __expf(btot);
    __syncthreads();
    local_state_mma_store(L, LT, wave, tid & 63);
    __syncthreads();
}
__device__ __forceinline__ void mlstm_gates(float ig, float fg, const float* b_i, const float* b_f, int h, int lane, float& bcum, float& a) {
    bcum = wave_incl_add(log_sigmoidf_(fg + b_f[h]), lane); a = ig + b_i[h] - bcum;
}
__device__ __forceinline__ void mlstm_b_item(LAS unsigned char* L, const MlIn& R, const float* conv, const float* b_i, const float* b_f, int h, float* LT, float* NL, float* AMAX, float* BEND, int tid, int wave) {
    const int d = tid & 63, tq = wave, lane = tid & 63;
    float bcum, a; mlstm_gates(R.ig, R.fg, b_i, b_f, h, lane, bcum, a);
    const float A = wave_max(a), bend = __shfl(bcum, 63);
    float kh[8]; conv_silu8r(R.kr, conv + 256 + h * 64 + d, 0.125f, kh);
    float nsum = 0.f;
#pragma unroll
    for (int i = 0; i < 8; ++i) { kh[i] *= __expf(__shfl(a, 8 * tq + i) - A); nsum += bf2f(f2bf(kh[i])); }
    *(LAS v4u*)(L + L_T0 + d * TS + tq * 16) = pack8(kh);
    *(LAS v4u*)(L + L_T1 + d * TS + tq * 16) = pack8h(R.vv);
    LAS float* part = (LAS float*)(L + L_PART); part[tq * 64 + d] = nsum;
    __syncthreads();
    if (tq == 0) { float s = 0.f;
#pragma unroll
        for (int w = 0; w < 8; ++w) s += part[w * 64 + d];
        NL[d] = s; if (lane == 0) { AMAX[0] = A; BEND[0] = bend; } }
    local_state_mma_store(L, LT, wave, lane);
    __syncthreads();
}
__device__ __forceinline__ void fox_cumsum_item(LAS unsigned char* L, const float* G, const float* fox_bf, float* CF, int bh, int tid, int wave) {
    const int b = bh >> 3, h = bh & 7, lane = tid & 63; const float bf = fox_bf[h];
    float loc[16]; float s = 0.f;
#pragma unroll
    for (int i = 0; i < 16; ++i) { s += log_sigmoidf_(G[((size_t)b * SEQ + tid * 16 + i) * GW + 8 + h] + bf); loc[i] = s; }
    const float incl = wave_incl_add(s, lane);
    LAS float* wt = (LAS float*)(L + L_PART);
    if (lane == 63) wt[wave] = incl;
    __syncthreads();
    float off = incl - s;
#pragma unroll
    for (int w = 0; w < 8; ++w) if (w < wave) off += wt[w];
#pragma unroll
    for (int i = 0; i < 16; ++i) CF[(size_t)bh * SEQ + tid * 16 + i] = (off + loc[i]) * LOG2E;
    __syncthreads();
}

template <bool DUMMY = false> __device__ __forceinline__ void scan_c_block(unsigned char* sc, int j, int tid) {
    constexpr size_t DOFF = DUMMY ? 104 * MiB / 4 : 0;
    constexpr int CB = 16;
    if (j < 128) {
        if (tid < 256) { const int chain = j >> 4, e = (j & 15) * 256 + tid, b = chain >> 2, h = chain & 3;
            float* p = (float*)(sc + SC_LHG) + ((size_t)(b * 128) * 4 + h) * 4096 + e; const float* dp = (const float*)(sc + SC_DEC) + ((size_t)(b * 128) * 4 + h) * 64 + (e & 63);
            float S = 0.f;
            for (int c0 = 0; c0 < 128; c0 += CB) { float Lc[CB], dc[CB];
#pragma unroll
                for (int i = 0; i < CB; ++i) { Lc[i] = p[(size_t)(c0 + i) * 4 * 4096]; dc[i] = dp[(size_t)(c0 + i) * 4 * 64]; }
#pragma unroll
                for (int i = 0; i < CB; ++i) { const float So = S; S = dc[i] * S + Lc[i]; Lc[i] = So; }
#pragma unroll
                for (int i = 0; i < CB; ++i) (p + DOFF)[(size_t)(c0 + i) * 4 * 4096] = Lc[i]; } }
    } else {
        const int jj = j - 128, chain = jj >> 4, part = jj & 15, b = chain >> 2, h = chain & 3;
        if (tid < 260) { const bool isn = tid >= 256; const size_t it0 = (size_t)(b * 128) * 4 + h;
            float* p = isn ? (float*)(sc + SC_NL) + it0 * 64 + part * 4 + (tid - 256) : (float*)(sc + SC_LML) + it0 * 4096 + part * 256 + tid;
            const size_t stride = isn ? 4 * 64 : 4 * 4096;
            const float* am = (const float*)(sc + SC_AMAX) + it0; const float* be = (const float*)(sc + SC_BEND) + it0; float* mp = (float*)(sc + SC_MPREV) + it0;
            const bool writer = (part == 0 && tid == 0);
            float S = 0.f, m = 0.f;
            for (int c0 = 0; c0 < 128; c0 += CB) { float Lc[CB], A[CB], bb[CB];
#pragma unroll
                for (int i = 0; i < CB; ++i) { Lc[i] = p[(size_t)(c0 + i) * stride]; A[i] = am[(c0 + i) * 4]; bb[i] = be[(c0 + i) * 4]; }
#pragma unroll
                for (int i = 0; i < CB; ++i) { const float Mx = fmaxf(m, A[i]), So = S; S = __expf(m - Mx) * S + __expf(A[i] - Mx) * Lc[i]; Lc[i] = So; A[i] = m; m = bb[i] + Mx; }
#pragma unroll
                for (int i = 0; i < CB; ++i) { (p + DOFF)[(size_t)(c0 + i) * stride] = Lc[i]; if (writer) (mp + DOFF)[(c0 + i) * 4] = A[i]; } } }
    }
}

template <bool SIG> __device__ __forceinline__ void head_epilogue(LAS unsigned char* L, float inv, const v4u& gw  , const float* gain  , bf16_t* out  , int tid) {
    const int t = tid >> 3, v0 = (tid & 7) * 8; const LAS float* o = (const LAS float*)(L + L_O) + t * OS + v0;
    float x[8]; float ss = 0.f;
#pragma unroll
    for (int i = 0; i < 8; ++i) { x[i] = o[i] * inv; ss += x[i] * x[i]; }
    ss += __shfl_xor(ss, 1); ss += __shfl_xor(ss, 2); ss += __shfl_xor(ss, 4);
    const float r = rsqrtf(ss * (1.f / 64.f) + EPS);
    const unsigned gu[4] = {gw.x, gw.y, gw.z, gw.w};
    float y[8];
#pragma unroll
    for (int i = 0; i < 8; ++i) { const float gz = bf2f((bf16_t)((gu[i >> 1] >> (16 * (i & 1))) & 0xffff)); y[i] = x[i] * r * gain[i] * (SIG ? sigmoidf_(gz) : siluf_(gz)); }
    *(v4u*)out = pack8(y);
}
__device__ __forceinline__ void store_o_tiles(LAS unsigned char* L, LAS const unsigned char* A1, LAS const unsigned char* B1, LAS const unsigned char* A2, LAS const unsigned char* B2, int wave, int lane) {
    const int mt = wave >> 1;
#pragma unroll
    for (int nn = 0; nn < 2; ++nn) { const int nt = 2 * (wave & 1) + nn; f32x4 acc = {0.f, 0.f, 0.f, 0.f};
        acc = mma64(A1, B1, mt * 16, nt * 16, lane, acc); acc = mma64(A2, B2, mt * 16, nt * 16, lane, acc);
        LAS float* o = (LAS float*)(L + L_O);
#pragma unroll
        for (int r = 0; r < 4; ++r) o[(mt * 16 + 4 * (lane >> 4) + r) * OS + nt * 16 + (lane & 15)] = acc[r]; }
}
__device__ __forceinline__ void hgrn_d_item(LAS unsigned char* L, const HgIn& R, float lb, const float* gain  , bf16_t* out  , int tid, int wave) {
    const int d = tid & 63, tq = wave, lane = tid & 63;
    float bl[8], kk[8], q[8]; float run = 0.f;
#pragma unroll
    for (int i = 0; i < 8; ++i) { const float fz = bf2f(R.fz[i]); q[i] = bf2f(R.q[i]);
        const float sg = sigmoidf_(fz), f = lb + (1.f - lb) * sg; kk[i] = (1.f - lb) * (1.f - sg); run += __logf(f); bl[i] = run; }
    LAS float* part = (LAS float*)(L + L_PART);
    part[tq * 64 + d] = run;
    store_state_tile(L + L_T4, R.s0, R.s1, tid);
    *(LAS v4u*)(L + L_T3 + d * TS + tq * 16) = pack8h(R.iv);
    __syncthreads();
    float off = 0.f, bref = 0.f;
#pragma unroll
    for (int w = 0; w < 8; ++w) { const float pv = part[w * 64 + d]; if (w < 4) bref += pv; if (w < tq) off += pv; }
#pragma unroll
    for (int i = 0; i < 8; ++i) { const float bb = off + bl[i]; const int t = 8 * tq + i;
        st16(L + L_T0 + t * TS + d * 2, q[i] * __expf(bb - bref));
        st16(L + L_T1 + t * TS + d * 2, kk[i] * __expf(bref - bb));
        st16(L + L_T2 + t * TS + d * 2, q[i] * __expf(bb)); }
    __syncthreads();
    { const int mt = wave >> 1;
#pragma unroll
      for (int nn = 0; nn < 2; ++nn) { const int nt = 2 * (wave & 1) + nn; f32x4 acc = {0.f, 0.f, 0.f, 0.f};
          acc = mma64(L + L_T1, L + L_T0, mt * 16, nt * 16, lane, acc);
          const int s0 = mt * 16 + 4 * (lane >> 4), t = nt * 16 + (lane & 15);
          v2u w; w.x = pk2(s0 <= t ? acc[0] : 0.f, s0 + 1 <= t ? acc[1] : 0.f); w.y = pk2(s0 + 2 <= t ? acc[2] : 0.f, s0 + 3 <= t ? acc[3] : 0.f);
          *(LAS v2u*)(L + L_T5 + t * TS + s0 * 2) = w; } }
    __syncthreads();
    store_o_tiles(L, L + L_T5, L + L_T3, L + L_T2, L + L_T4, wave, lane);
    __syncthreads();
    { const int t = tid >> 3, v0 = (tid & 7) * 8; head_epilogue<false>(L, 1.f, R.gate, gain + v0, out + (size_t)t * D + v0, tid); }
    __syncthreads();
}
__device__ __forceinline__ void mlstm_d_item(LAS unsigned char* L, const MlIn& R, const float* conv, const float* b_i, const float* b_f, const float* gain  , int h, bf16_t* out  , int tid, int wave) {
    const int d = tid & 63, tq = wave, lane = tid & 63; const float mprev = R.mprev;
    float bcum, a; mlstm_gates(R.ig, R.fg, b_i, b_f, h, lane, bcum, a);
    const float M = fmaxf(wave_incl_max(a, lane), mprev), sint = __expf(mprev - M);
    LAS float* vec = (LAS float*)(L + L_VEC);
    if (wave == 0) { vec[lane] = a; vec[64 + lane] = M; vec[128 + lane] = __expf(-bcum - M); vec[192 + lane] = R.np; }
    float qc[8], kc[8];
    conv_silu8r(R.qr, conv + h * 64 + d, 1.f, qc);
    conv_silu8r(R.kr, conv + 256 + h * 64 + d, 0.125f, kc);
#pragma unroll
    for (int i = 0; i < 8; ++i) { const int t = 8 * tq + i;
        st16(L + L_T0 + t * TS + d * 2, qc[i]);
        st16(L + L_T1 + t * TS + d * 2, kc[i]);
        st16(L + L_T2 + t * TS + d * 2, qc[i] * __shfl(sint, t)); }
    *(LAS v4u*)(L + L_T3 + d * TS + tq * 16) = pack8h(R.vv);
    store_state_tile(L + L_T4, R.s0, R.s1, tid);
    __syncthreads();
    { const int mt = wave >> 1;
#pragma unroll
      for (int nn = 0; nn < 2; ++nn) { const int nt = 2 * (wave & 1) + nn; f32x4 acc = {0.f, 0.f, 0.f, 0.f};
          acc = mma64(L + L_T1, L + L_T0, mt * 16, nt * 16, lane, acc);
          const int s0 = mt * 16 + 4 * (lane >> 4), t = nt * 16 + (lane & 15); const float Mt = vec[64 + t];
          float wv[4];
#pragma unroll
          for (int r = 0; r < 4; ++r) wv[r] = (s0 + r <= t) ? acc[r] * __expf(vec[s0 + r] - Mt) : 0.f;
          v2u w; w.x = pk2(wv[0], wv[1]); w.y = pk2(wv[2], wv[3]); *(LAS v2u*)(L + L_T5 + t * TS + s0 * 2) = w; } }
    __syncthreads();
    store_o_tiles(L, L + L_T5, L + L_T3, L + L_T2, L + L_T4, wave, lane);
    __syncthreads();
    { const int t = tid >> 3, c8 = (tid & 7) * 8;
      const v4u pw = *(LAS const v4u*)(L + L_T5 + t * TS + c8 * 2), qw = *(LAS const v4u*)(L + L_T2 + t * TS + c8 * 2);
      const unsigned pu[4] = {pw.x, pw.y, pw.z, pw.w}, qu[4] = {qw.x, qw.y, qw.z, qw.w}; float den = 0.f;
#pragma unroll
      for (int i = 0; i < 8; ++i) { den += bf2f((bf16_t)((pu[i >> 1] >> (16 * (i & 1))) & 0xffff)) + bf2f((bf16_t)((qu[i >> 1] >> (16 * (i & 1))) & 0xffff)) * vec[192 + c8 + i]; }
      den += __shfl_xor(den, 1); den += __shfl_xor(den, 2); den += __shfl_xor(den, 4);
      const float inv = 1.f / fmaxf(fabsf(den), vec[128 + t]);
      head_epilogue<true>(L, inv, R.gate, gain + c8, out + (size_t)t * D + c8, tid); }
    __syncthreads();
}
}
constexpr int N_PHASES = 22;
template <int PH, bool REP = false> __device__ __forceinline__ void run_phase(const MArgs& a, LAS unsigned char* L, const int tid, const int wave, const int G, const int bx, const int vcu) {
    const int lane = tid & 63, gw = vcu * NWAVES + wave, NGW = G * NWAVES;
    unsigned char* ws = a.ws; bf16_t* X = (bf16_t*)a.out;
    int* ctl = (int*)(ws + WS_CTL); int* cnt = ctl + CW_CNT;
    float* Gt = (float*)(ws + WS_G); float* CF = (float*)(ws + WS_CF); int4* tokinfo = (int4*)(ws + WS_TOKINFO); float2* tgate = (float2*)(ws + WS_TGATE); int* toklist = (int*)(ws + WS_TOKLIST);
    bf16_t* P = (bf16_t*)(ws + WS_P); bf16_t* HID = (bf16_t*)(ws + WS_HID); signed char* H = (signed char*)(ws + WS_H); float* SH = (float*)(ws + WS_SH); bf16_t* MIX = (bf16_t*)(ws + WS_MIX);
    signed char* XG = (signed char*)(ws + WS_XG); float* SXG = (float*)(ws + WS_SXG); bf16_t* Y = (bf16_t*)(ws + WS_XG);
    LAS float* scr = (LAS float*)(L + RING_OFF + wave * 16384);
    (void)ctl; (void)Gt; (void)CF; (void)tokinfo; (void)tgate; (void)toklist; (void)P; (void)HID; (void)H; (void)SH; (void)SXG; (void)MIX; (void)XG; (void)Y; (void)scr; (void)cnt; (void)lane; (void)gw; (void)NGW;
    constexpr int p = PH, l = p >= 10 ? 1 : 0, k = p == 0 ? -1 : (l ? p - 10 : p - 1);
    if constexpr (p == 0) {
            LAS float* img = (LAS float*)(L + RING_OFF); LAS float* pm = (LAS float*)(L + LDSCTL_OFF + 1024);
            { auto job = [&](int it) { Conv8Job j; int r = it;
                  if (r < 224) { const int ll = r / 112, nb = r % 112, sc = 32 * nb + (nb >= 56 ? 8 : 0);
                      j.W = a.in[I_W_IN] + (size_t)ll * D * DIN + sc; j.ldw = DIN; j.WT8 = (signed char*)(ws + WS_WIN) + (size_t)ll * PW * D + (size_t)32 * nb * D; j.S = (float*)(ws + WS_SWIN) + ll * PW + 32 * nb; }
                  else { r -= 224; const int up = r / 88, nb = r % 88, c = 32 * nb;
                      j.W = (up ? a.in[I_DUP] : a.in[I_DGATE]) + c; j.ldw = FF; j.WT8 = (signed char*)(ws + WS_WDGU) + (size_t)glu_row(c, up) * D; j.S = (float*)(ws + WS_SWDGU) + glu_row(c, up); }
                  return j; };
              float v[64]; int it = vcu; if (it < 400) conv8_load(v, job(it), tid, wave);
              for (; it < 400; it += G) { const Conv8Job j = job(it); conv8_stage(v, img, pm, tid, wave); if (it + G < 400) conv8_load(v, job(it + G), tid, wave); conv8_quant(j, img, pm, tid, wave); } }
            for (int it = gw; it < 2432; it += NGW) {
                int r = it;
                if (r < 1024) { const int ll = r / 512; r %= 512; const int kb = r / 32, nb = r % 32;
                    tr_item(a.in[I_W_OUT] + (size_t)ll * D * D + 32 * nb, D, D, (bf16_t*)(ws + WS_WOUT) + (size_t)ll * D * D + (size_t)32 * nb * D, scr, 64 * kb, lane); continue; }
                r -= 1024;
                { const int kb = r / 32, nb = r % 32; tr_item(a.in[I_DDOWN] + 32 * nb, D, FF, (bf16_t*)(ws + WS_WDDN) + (size_t)32 * nb * FF, scr, 64 * kb, lane); }
            }
            __syncthreads();
            LAS float* tab = (LAS float*)(L + RING_OFF); load_gate_tab(tab, a.in[I_W_IN], tid); __syncthreads();
            float lg[8];
            { RowIn R, Rn; int row = gw; if (row < NTOK) mrow_load<false>(R, a.in[I_X], row, lane);
              for (; row < NTOK; row += NGW) { const int nx = row + NGW; if (nx < NTOK) mrow_load<false>(Rn, a.in[I_X], nx, lane); asm volatile("" ::: "memory");
                  mrow<0>(R, H, SH, a.in[I_ATTN_NORM], tab, Gt, row, lane, lg); if (nx < NTOK) R = Rn; } }
        } else if constexpr (k == 0) {
            { const int cb = (G >= 144) ? bx - 128 : bx; for (int bh = cb; bh >= 0 && bh < 16; bh += G) scan::fox_cumsum_item(L, Gt, a.in[I_FOX_BF] + l * 8, CF, bh, tid, wave); }
            pg8::GOrder S; S.so.init(NTOK, PW, G, bx); S.A = (const char*)H; S.B = (const char*)(ws + WS_WIN) + (size_t)l * PW * D; S.a_tile = (size_t)256 * D; S.b_tile = (size_t)256 * D; S.b_exp = 0;
            S.tb1 = S.tb2 = S.tb3 = S.tb4 = S.tb5 = S.tb6 = S.tb7 = 0x7fffffff;
            pg8::EpiBf8 E; E.O = P; E.ldc = PW; E.s_lo = P_FQ / 256; E.s_hi = P_FK / 256; E.scale = QSCALE; E.sA = SH; E.sB = (const float*)(ws + WS_SWIN) + l * PW; E.sc = (LAS float*)(L + LDSCTL_OFF + 4096);
            pg8::Gemm g{D / 2};
            pg8::gemm_phase<pg8::EpiBf8, pg8::GOrder, true, true, 1>(L + RING_OFF, g, S, E);
        } else if constexpr (l == 1 && k == 9) {
            pg8::GOrder S; pg8::EpiBf E; int t[8]; int acc = 0;
#pragma unroll
            for (int e = 0; e < NE; ++e) { t[e] = acc; acc += (cnt[e] + 255) >> 8; }
            S.so.init(acc * 256, D, G, bx); S.A = (const char*)HID; S.B = (const char*)(ws + WS_WMDN); S.a_tile = (size_t)256 * FE; S.b_tile = (size_t)256 * FE; S.b_exp = (size_t)D * FE;
            S.tb1 = t[1]; S.tb2 = t[2]; S.tb3 = t[3]; S.tb4 = t[4]; S.tb5 = t[5]; S.tb6 = t[6]; S.tb7 = t[7]; E.O = Y; E.ldc = D; E.s_lo = 0; E.s_hi = 4; E.scale = 1.f / (pg8::F8_HSCALE * pg8::F8_WSCALE);
            pg8::Gemm g{FE / 2};
            pg8::gemm_phase<pg8::EpiBf, pg8::GOrder, true, true, 2>(L + RING_OFF, g, S, E);
        } else if constexpr (k == 4 || (l == 0 && k == 7)) {
            pg8::GOrder S; S.so.init(NTOK, D, G, bx); S.b_exp = 0; S.tb1 = S.tb2 = S.tb3 = S.tb4 = S.tb5 = S.tb6 = S.tb7 = 0x7fffffff; int K;
            if constexpr (k == 4) { K = D; S.A = (const char*)MIX; S.B = (const char*)(ws + WS_WOUT) + (size_t)l * D * D * 2; }
            else { K = FF; S.A = (const char*)HID; S.B = (const char*)(ws + WS_WDDN); }
            S.a_tile = (size_t)256 * K * 2; S.b_tile = (size_t)256 * K * 2;
            pg8::Gemm g{K};
            if constexpr (k == 4 && l == 0) { pg8::EpiResid<true> E{a.in[I_X], X, D}; pg8::gemm_phase<pg8::EpiResid<true>, pg8::GOrder, true, true>(L + RING_OFF, g, S, E); }
            else { pg8::EpiResid<false> E{X, X, D}; pg8::gemm_phase<pg8::EpiResid<false>, pg8::GOrder, true, true>(L + RING_OFF, g, S, E); }
        } else if constexpr ((l == 0 && k == 6) || (l == 1 && k == 7)) {
            pg8::GOrder S; pg8::EpiSwiglu8<(l == 1)> E; S.a_tile = (size_t)256 * D; S.b_tile = (size_t)256 * D; E.O = HID; E.sc = (LAS float*)(L + LDSCTL_OFF + 4096);
            if constexpr (l == 0) { S.so.init(NTOK, 2 * FF, G, bx); S.A = (const char*)H; S.B = (const char*)(ws + WS_WDGU); S.b_exp = 0; S.tb1 = S.tb2 = S.tb3 = S.tb4 = S.tb5 = S.tb6 = S.tb7 = 0x7fffffff;
                E.ldc = FF; E.sA = SH; E.sB = (const float*)(ws + WS_SWDGU); E.sb_exp = 0; }
            else { int t[8]; int acc = 0;
#pragma unroll
                for (int e = 0; e < NE; ++e) { t[e] = acc; acc += (cnt[e] + 255) >> 8; }
                S.so.init(acc * 256, 2 * FE, G, bx); S.A = (const char*)XG; S.B = (const char*)(ws + WS_WMGU); S.b_exp = (size_t)2 * FE * D;
                S.tb1 = t[1]; S.tb2 = t[2]; S.tb3 = t[3]; S.tb4 = t[4]; S.tb5 = t[5]; S.tb6 = t[6]; S.tb7 = t[7]; E.ldc = FE; E.sA = SXG; E.sB = (const float*)(ws + WS_SWMGU); E.sb_exp = 2 * FE; }
            E.tb1 = S.tb1; E.tb2 = S.tb2; E.tb3 = S.tb3; E.tb4 = S.tb4; E.tb5 = S.tb5; E.tb6 = S.tb6; E.tb7 = S.tb7;
            pg8::Gemm g{D / 2};
            pg8::gemm_phase<pg8::EpiSwiglu8<(l == 1)>, pg8::GOrder, true, true, 1>(L + RING_OFF, g, S, E);
        } else if constexpr (k == 5 && l == 0) {
            float lg[8];
            { RowIn R, Rn; int row = gw; if (row < NTOK) mrow_load<true>(R, X, row, lane);
              for (; row < NTOK; row += NGW) { const int nx = row + NGW; if (nx < NTOK) mrow_load<true>(Rn, X, nx, lane); asm volatile("" ::: "memory");
                  mrow<1>(R, H, SH, a.in[I_FFN_NORM], nullptr, nullptr, row, lane, lg); if (nx < NTOK) R = Rn; } }
        } else if constexpr (k == 8 && l == 0) {
            LAS float* tab = (LAS float*)(L + RING_OFF); load_gate_tab(tab, a.in[I_W_IN] + (size_t)D * DIN, tid); __syncthreads();
            float lg[8];
            { RowIn R, Rn; int row = gw; if (row < NTOK) mrow_load<true>(R, X, row, lane);
              for (; row < NTOK; row += NGW) { const int nx = row + NGW; if (nx < NTOK) mrow_load<true>(Rn, X, nx, lane); asm volatile("" ::: "memory");
                  mrow<0>(R, H, SH, a.in[I_ATTN_NORM] + D, tab, Gt, row, lane, lg); if (nx < NTOK) R = Rn; } }
        } else if constexpr (k == 5 && l == 1) {
            LAS int* sel_e = (LAS int*)(L + RING_OFF);
            LAS float* sel_g = (LAS float*)(L + RING_OFF + 512);
            LAS int* lcnt = (LAS int*)(L + RING_OFF + 1024);
            LAS float* tab = (LAS float*)(L + RING_OFF + 4096); load_router_tab(tab, a.in[I_ROUTER], tid); __syncthreads();
            for (int rb = bx; rb < NTOK / 64; rb += G) {
                if (tid < 16) lcnt[tid] = 0;
                RowIn R, Rn; mrow_load<true>(R, X, rb * 64 + wave * 8, lane);
                for (int i = 0; i < 8; ++i) { const int rl = wave * 8 + i, row = rb * 64 + rl; float lg[8];
                    if (i < 7) mrow_load<true>(Rn, X, row + 1, lane); asm volatile("" ::: "memory");
                    mrow<2>(R, H, SH, a.in[I_FFN_NORM] + D, tab, nullptr, row, lane, lg); if (i < 7) R = Rn;
                    if (lane == 0) { const float v0 = lg[0], v1 = lg[1]; const int e0 = __float_as_int(lg[2]), e1 = __float_as_int(lg[3]);
                        const float g1 = 1.f / (1.f + __expf(v0 - v1));
                        sel_e[2 * rl] = e0; sel_e[2 * rl + 1] = e1; sel_g[2 * rl] = 1.f - g1; sel_g[2 * rl + 1] = g1; } }
                __syncthreads();
                int e0 = 0, e1 = 0, r0 = 0, r1 = 0;
                if (tid < 64) { e0 = sel_e[2 * tid]; e1 = sel_e[2 * tid + 1]; r0 = __hip_atomic_fetch_add(lcnt + e0, 1, __ATOMIC_RELAXED, __HIP_MEMORY_SCOPE_WORKGROUP); r1 = __hip_atomic_fetch_add(lcnt + e1, 1, __ATOMIC_RELAXED, __HIP_MEMORY_SCOPE_WORKGROUP); }
                __syncthreads();
                if (tid < 8) lcnt[8 + tid] = atomicAdd(cnt + tid, (int)lcnt[tid]);
                __syncthreads();
                if (tid < 64) { const int row = rb * 64 + tid, s0 = lcnt[8 + e0] + r0, s1 = lcnt[8 + e1] + r1;
                    toklist[e0 * NTOK + s0] = row; toklist[e1 * NTOK + s1] = row; tokinfo[row] = make_int4(e0, s0, e1, s1); tgate[row] = make_float2(sel_g[2 * tid], sel_g[2 * tid + 1]); }
                __syncthreads();
            }
        } else if constexpr (k == 6 && l == 1) {
            { int base[NE]; int acc = 0;
#pragma unroll
              for (int e = 0; e < NE; ++e) { base[e] = acc; acc += (cnt[e] + 255) & ~255; }
              for (int r = gw; r < acc; r += NGW) { int e = 0, be = 0;
#pragma unroll
                  for (int c = 1; c < NE; ++c) if (r >= base[c]) { e = c; be = base[c]; }
                  const int s = r - be; v4u v0 = {0u, 0u, 0u, 0u}; float sv = 0.f;
                  if (s < cnt[e]) { const int tok = toklist[e * NTOK + s]; v0 = *((const v4u*)(H + (size_t)tok * D) + lane); sv = SH[tok]; }
                  *((v4u*)(XG + (size_t)r * D) + lane) = v0; if (lane == 0) SXG[r] = sv; } }
            __syncthreads();
            { LAS float* img = (LAS float*)(L + RING_OFF); LAS float* pm = (LAS float*)(L + LDSCTL_OFF + 1024);
              auto job = [&](int it) { Conv8Job j; const int e = it / 224; int r = it % 224; const int up = r / 112, nb = r % 112, c = 32 * nb;
                  j.W = (up ? a.in[I_MUP] : a.in[I_MGATE]) + (size_t)e * D * FE + c; j.ldw = FE; j.WT8 = (signed char*)(ws + WS_WMGU) + (size_t)e * 2 * FE * D + (size_t)glu_row(c, up) * D; j.S = (float*)(ws + WS_SWMGU) + e * 2 * FE + glu_row(c, up); return j; };
              float v[64]; int it = vcu; if (it < 1792) conv8_load(v, job(it), tid, wave);
              for (; it < 1792; it += G) { const Conv8Job j = job(it); conv8_stage(v, img, pm, tid, wave); if (it + G < 1792) conv8_load(v, job(it + G), tid, wave); conv8_quant(j, img, pm, tid, wave); } }
            for (int it = gw; it < 14336; it += NGW) { const int e = it / 1792, r = it % 1792, kb = r / 32, nb = r % 32;
                tr_item_f8(a.in[I_MDOWN] + (size_t)e * FE * D + 32 * nb, D, FE, (unsigned char*)(ws + WS_WMDN) + (size_t)e * D * FE + (size_t)32 * nb * FE, scr, 64 * kb, lane); }
        } else if constexpr (k == 8 && l == 1) {
        } else if constexpr (l == 1 && (k == 10 || k == 11)) {
            int base[NE]; { int acc = 0;
#pragma unroll
              for (int e = 0; e < NE; ++e) { base[e] = acc; acc += (cnt[e] + 255) & ~255; } }
            constexpr int HALFR = NTOK / 2; constexpr int rlo = (k == 10) ? HALFR : 0;
            bf16_t* stash = (bf16_t*)(ws + WS_H);
            const bf16_t* Xs = (k == 10) ? X + (size_t)HALFR * D : stash;
            float* out = (float*)a.out;
            if constexpr (k == 10) { for (int r = gw; r < HALFR; r += NGW) { const v4u* s4 = (const v4u*)(X + (size_t)r * D); v4u* d4 = (v4u*)(stash + (size_t)r * D); d4[lane] = s4[lane]; d4[64 + lane] = s4[64 + lane]; } }
            struct FA { uint2 v[4]; int4 ti; float2 tg; }; struct FB { uint2 y0[4], y1[4]; };
            auto loadA = [&](FA& A, int rr) { const uint2* xr = (const uint2*)(Xs + (size_t)rr * D) + lane;
#pragma unroll
                for (int j = 0; j < 4; ++j) A.v[j] = xr[64 * j];
                A.ti = tokinfo[rlo + rr]; A.tg = tgate[rlo + rr]; };
            auto loadB = [&](FB& B, const FA& A) { int b0 = 0, b1 = 0;
#pragma unroll
                for (int c = 0; c < NE; ++c) { if (c == A.ti.x) b0 = base[c]; if (c == A.ti.z) b1 = base[c]; }
                const uint2* y0 = (const uint2*)(Y + (size_t)(b0 + A.ti.y) * D) + lane; const uint2* y1 = (const uint2*)(Y + (size_t)(b1 + A.ti.w) * D) + lane;
#pragma unroll
                for (int j = 0; j < 4; ++j) { B.y0[j] = y0[64 * j]; B.y1[j] = y1[64 * j]; } };
            FA A0, A1, A2; FB B0, B1; int rr = gw;
            if (rr < HALFR) { loadA(A0, rr); if (rr + NGW < HALFR) loadA(A1, rr + NGW); loadB(B0, A0); }
            for (; rr < HALFR; rr += NGW) {
                const bool h1 = rr + NGW < HALFR, h2 = rr + 2 * NGW < HALFR;
                if (h2) loadA(A2, rr + 2 * NGW);
                if (h1) loadB(B1, A1);
                asm volatile("" ::: "memory");
                float4 v[4]; const float2 tg = A0.tg;
#pragma unroll
                for (int j = 0; j < 4; ++j) { const uint2 q = B0.y0[j], c = B0.y1[j], x = A0.v[j];
                    v[j].x = __uint_as_float(x.x << 16) + tg.x * bf2f((bf16_t)(q.x & 0xffff)) + tg.y * bf2f((bf16_t)(c.x & 0xffff)); v[j].y = __uint_as_float(x.x & 0xffff0000u) + tg.x * bf2f((bf16_t)(q.x >> 16)) + tg.y * bf2f((bf16_t)(c.x >> 16));
                    v[j].z = __uint_as_float(x.y << 16) + tg.x * bf2f((bf16_t)(q.y & 0xffff)) + tg.y * bf2f((bf16_t)(c.y & 0xffff)); v[j].w = __uint_as_float(x.y & 0xffff0000u) + tg.x * bf2f((bf16_t)(q.y >> 16)) + tg.y * bf2f((bf16_t)(c.y >> 16)); }
                float ss = 0.f;
#pragma unroll
                for (int j = 0; j < 4; ++j) ss += v[j].x * v[j].x + v[j].y * v[j].y + v[j].z * v[j].z + v[j].w * v[j].w;
                ss = wave_sum(ss); const float r = rsqrtf(ss * (1.f / D) + EPS);
                float4* xo = (float4*)(out + (size_t)(rlo + rr) * D) + lane;
#pragma unroll
                for (int j = 0; j < 4; ++j) { const float4 g = *((const float4*)a.in[I_FINAL_NORM] + 64 * j + lane); xo[64 * j] = make_float4(v[j].x * r * g.x, v[j].y * r * g.y, v[j].z * r * g.z, v[j].w * r * g.w); }
                if (h1) { A0 = A1; B0 = B1; } if (h2) A1 = A2;
            }
        } else {
            if constexpr (k == 1) {
                unsigned char* sc = ws + WS_SCAN; const int wv = wave;
#define ITEM_DECODE(it_) const int item = (it_) & 1023, h = item & 3, c = (item >> 2) & 127, b = item >> 9
#define HG_LB(h_) (l == 0 ? 0.f : 1.f / (1.f + __expf(a.in[I_HGRN_LB][(h_) * 64 + (tl & 63)] - a.in[I_HGRN_LB][256 + (h_) * 64 + (tl & 63)])))
                { scan::HgIn R, Rn; int it = bx;
                  if (it < 1024) { ITEM_DECODE(it); scan::hgrn_load<false>(R, P, b, c, h, nullptr, tid, wv); }
                  for (; it < 1024; it += G) { const int nx = it + G; int tl = tid; asm volatile("" : "+v"(tl));
                      if (nx < 1024) { ITEM_DECODE(nx); scan::hgrn_load<false>(Rn, P, b, c, h, nullptr, tl, wv); }
                      asm volatile("" ::: "memory");
                      { ITEM_DECODE(it); (void)b; (void)c; scan::hgrn_b_item(L, R, HG_LB(h), (float*)(sc + scan::SC_LHG) + (size_t)item * 4096, (float*)(sc + scan::SC_DEC) + item * 64, tl, wv); }
                      if (nx < 1024) R = Rn; } }
                { scan::MlIn R, Rn; int it = bx; while (it < 1024) it += G;
                  if (it < 2048) { ITEM_DECODE(it); scan::mlstm_load<false>(R, P, Gt, b, c, h, nullptr, nullptr, nullptr, tid, wv); }
                  for (; it < 2048; it += G) { const int nx = it + G; int tl = tid; asm volatile("" : "+v"(tl));
                      if (nx < 2048) { ITEM_DECODE(nx); scan::mlstm_load<false>(Rn, P, Gt, b, c, h, nullptr, nullptr, nullptr, tl, wv); }
                      asm volatile("" ::: "memory");
                      { ITEM_DECODE(it); (void)b; (void)c; scan::mlstm_b_item(L, R, a.in[I_MLSTM_CONV] + l * 2048, a.in[I_MLSTM_BI] + l * 4, a.in[I_MLSTM_BF] + l * 4, h, (float*)(sc + scan::SC_LML) + (size_t)item * 4096,
                                            (float*)(sc + scan::SC_NL) + item * 64, (float*)(sc + scan::SC_AMAX) + item, (float*)(sc + scan::SC_BEND) + item, tl, wv); }
                      if (nx < 2048) R = Rn; } }
                { LAS unsigned* lst = (LAS unsigned*)(L + LDSCTL_OFF + 64);
                  if (tid < 32) lst[tid] = 0u; __syncthreads();
                  float mq0 = 0.f, mq1 = 0.f, mk0 = 0.f, mk1 = 0.f;
                  for (int row = gw; row < NTOK; row += NGW) {
                      const v4u wq = *((const v4u*)(P + (size_t)row * PW + P_FQ) + lane), wk = *((const v4u*)(P + (size_t)row * PW + P_FK) + lane);
                      float sq = 0.f, sk = 0.f;
#pragma unroll
                      for (int i = 0; i < 4; ++i) { const float q0 = bf2f((bf16_t)(wq[i] & 0xffff)), q1 = bf2f((bf16_t)(wq[i] >> 16)), k0 = bf2f((bf16_t)(wk[i] & 0xffff)), k1 = bf2f((bf16_t)(wk[i] >> 16));
                          sq += q0 * q0 + q1 * q1; sk += k0 * k0 + k1 * k1; }
                      sq += __shfl_xor(sq, 1); sq += __shfl_xor(sq, 2); sq += __shfl_xor(sq, 4); sk += __shfl_xor(sk, 1); sk += __shfl_xor(sk, 2); sk += __shfl_xor(sk, 4);
                      if (row < SEQ) { mq0 = fmaxf(mq0, sq); mk0 = fmaxf(mk0, sk); } else { mq1 = fmaxf(mq1, sq); mk1 = fmaxf(mk1, sk); } }
                  if ((lane & 7) == 0) { const int hh = lane >> 3;
                      __hip_atomic_fetch_max(lst + hh * 2, __float_as_uint(mq0), __ATOMIC_RELAXED, __HIP_MEMORY_SCOPE_WORKGROUP); __hip_atomic_fetch_max(lst + hh * 2 + 1, __float_as_uint(mk0), __ATOMIC_RELAXED, __HIP_MEMORY_SCOPE_WORKGROUP);
                      __hip_atomic_fetch_max(lst + 16 + hh * 2, __float_as_uint(mq1), __ATOMIC_RELAXED, __HIP_MEMORY_SCOPE_WORKGROUP); __hip_atomic_fetch_max(lst + 16 + hh * 2 + 1, __float_as_uint(mk1), __ATOMIC_RELAXED, __HIP_MEMORY_SCOPE_WORKGROUP); }
                  __syncthreads();
                  if (tid < 32) __hip_atomic_fetch_max((unsigned*)ctl + CW_STAT + l * 32 + tid, lst[tid], __ATOMIC_RELAXED, __HIP_MEMORY_SCOPE_AGENT); }
            } else if constexpr (k == 2) {
                for (int j = bx; j < 256; j += G) scan::scan_c_block<REP>(ws + WS_SCAN, j, tid);
            } else if constexpr (k == 3) {
                static_assert(attn_body::ATTN_LDS_BYTES <= RING_BYTES, "attention LDS");
                unsigned char* sc = ws + WS_SCAN; const int wv = wave;
                const float* stat = (const float*)(ctl + CW_STAT + l * 32);
                LAS unsigned* slot = (LAS unsigned*)(L + LDSCTL_OFF);
                int v;
                for (;;) {
                    if (tid == 0) *slot = __hip_atomic_fetch_add((unsigned*)ctl + CW_QCTR + l + (REP ? 2 : 0), 1u, __ATOMIC_RELAXED, __HIP_MEMORY_SCOPE_AGENT);
                    __syncthreads();
                    v = __builtin_amdgcn_readfirstlane((int)*(volatile LAS unsigned*)slot);
                    if (v >= 736) break;
                    int qb, bh, part = 0; float* PART = nullptr;
                    if (v < 448) { qb = 31 - (v >> 5); bh = v & 15; part = (v >> 4) & 1; PART = (float*)(ws + WS_SCAN + (40 + 32 * l) * MiB) + (size_t)(bh * 14 + (qb - 18)) * 2 * attn_body::PART_F; }
                    else { const int u2 = v - 448; qb = 17 - (u2 >> 4); bh = u2 & 15; }
                    const float Tsk = 30.f + 2.f * __builtin_sqrtf(stat[bh * 2] * stat[bh * 2 + 1]) * 1.01f + 1.f;
                    attn_body::attn_unit<8>(bh >> 3, bh & 7, qb, (const attn_body::bf16*)(P + P_FQ), (const attn_body::bf16*)(P + P_FK), (const attn_body::bf16*)(P + P_FV), (attn_body::bf16*)(MIX + 512), CF + (size_t)bh * SEQ, Tsk,
                                            part, PART, (unsigned*)ctl + CW_AFLAG + (l + (REP ? 2 : 0)) * 512 + bh * 32 + qb, (char*)L + RING_OFF);
                    __syncthreads();
                }
                int tid2 = tid; asm volatile("" : "+v"(tid2));
                while (v < 736 + 512) {
                    const int it0 = (v - 736) * 4;
                    if (it0 < 1024) { scan::HgIn R, Rn; { ITEM_DECODE(it0); scan::hgrn_load<true>(R, P, b, c, h, (const float*)(sc + scan::SC_LHG) + (size_t)item * 4096, tid2, wv); }
#pragma unroll 1
                        for (int j = 0; j < 4; ++j) { const int it = it0 + j; int tl = tid2; asm volatile("" : "+v"(tl));
                            if (j < 3) { ITEM_DECODE(it + 1); scan::hgrn_load<true>(Rn, P, b, c, h, (const float*)(sc + scan::SC_LHG) + (size_t)item * 4096, tl, wv); }
                            asm volatile("" ::: "memory");
                            { ITEM_DECODE(it); const float lb = l == 0 ? 0.f : 1.f / (1.f + __expf(a.in[I_HGRN_LB][h * 64 + (tl & 63)] - a.in[I_HGRN_LB][256 + h * 64 + (tl & 63)]));
                              scan::hgrn_d_item(L, R, lb, a.in[I_HGRN_NORM] + l * 256 + h * 64, MIX + (size_t)(b * SEQ + c * 64) * D + h * 64, tl, wv); }
                            if (j < 3) R = Rn; } }
                    else { scan::MlIn R, Rn; { ITEM_DECODE(it0); scan::mlstm_load<true>(R, P, Gt, b, c, h, (const float*)(sc + scan::SC_LML) + (size_t)item * 4096, (const float*)(sc + scan::SC_NL) + item * 64, (const float*)(sc + scan::SC_MPREV) + item, tid2, wv); }
#pragma unroll 1
                        for (int j = 0; j < 4; ++j) { const int it = it0 + j; int tl = tid2; asm volatile("" : "+v"(tl));
                            if (j < 3) { ITEM_DECODE(it + 1); scan::mlstm_load<true>(Rn, P, Gt, b, c, h, (const float*)(sc + scan::SC_LML) + (size_t)item * 4096, (const float*)(sc + scan::SC_NL) + item * 64, (const float*)(sc + scan::SC_MPREV) + item, tl, wv); }
                            asm volatile("" ::: "memory");
                            { ITEM_DECODE(it); scan::mlstm_d_item(L, R, a.in[I_MLSTM_CONV] + l * 2048, a.in[I_MLSTM_BI] + l * 4, a.in[I_MLSTM_BF] + l * 4, a.in[I_MLSTM_NORM] + l * 256 + h * 64, h, MIX + (size_t)(b * SEQ + c * 64) * D + 256 + h * 64, tl, wv); }
                            if (j < 3) R = Rn; } }
                    __syncthreads();
                    if (tid2 == 0) *slot = __hip_atomic_fetch_add((unsigned*)ctl + CW_QCTR + l + (REP ? 2 : 0), 1u, __ATOMIC_RELAXED, __HIP_MEMORY_SCOPE_AGENT);
                    __syncthreads();
                    v = __builtin_amdgcn_readfirstlane((int)*(volatile LAS unsigned*)slot);
                }
            }

        }
}
__global__ void __launch_bounds__(NTHR, 2) mega(MArgs a) {
    extern __shared__ __attribute__((aligned(16))) unsigned char lds[];
    LAS unsigned char* L = (LAS unsigned char*)lds;
    volatile LAS unsigned* MISC = (volatile LAS unsigned*)(L + MISC_OFF);
    const int tid = threadIdx.x, wave = __builtin_amdgcn_readfirstlane(tid >> 6);
    const int G = gridDim.x, bx = blockIdx.x, vcu = (G % 8 == 0) ? (bx % 8) * (G / 8) + bx / 8 : bx;
    for (int u = tid; u < (LDS_BYTES - LDSCTL_OFF) / 4; u += NTHR) ((LAS unsigned*)(L + LDSCTL_OFF))[u] = 0u;
    __syncthreads();
    const int lo = a.ph_lo, hi = a.ph_hi;
    XcdBarrier bar; bar.bar = (unsigned*)(a.ws + WS_CTL) + CW_BAR; bar.x = 0; bar.st = nullptr;
    if (hi - lo > 1) bar = xcd_barrier_post((unsigned*)(a.ws + WS_CTL) + CW_BAR, MISC + 8);
#ifndef REPEAT_MASK
#define REPEAT_MASK 0u
#endif
#define PHASE(k) if (lo <= (k) && (k) < hi) { run_phase<k>(a, L, tid, wave, G, bx, vcu); if constexpr ((REPEAT_MASK >> (k)) & 1u) { xcd_barrier(bar); run_phase<k, true>(a, L, tid, wave, G, bx, vcu); } if ((k) + 1 < hi) xcd_barrier(bar); }
    PHASE(0) PHASE(1) PHASE(2) PHASE(3) PHASE(4) PHASE(5) PHASE(6) PHASE(7) PHASE(8) PHASE(9) PHASE(10)
    PHASE(11) PHASE(12) PHASE(13) PHASE(14) PHASE(15) PHASE(16) PHASE(17) PHASE(19) PHASE(20) PHASE(21)
#undef PHASE
}
#ifndef MEGA_MASK
#define MEGA_MASK 0x1FFFFFu
#endif
#ifndef FUSE_RUNS
#define FUSE_RUNS 1
#endif
extern "C" void kernel_launch(void* const* d_in, const int* in_sizes, int n_in, void* d_out, int out_size, void* d_ws, size_t ws_size, hipStream_t stream) {
    static int grid = 0;
    if (grid == 0) {
        if (n_in != 20 || ws_size < WS_END || out_size != NTOK * D) { fprintf(stderr, "kernel_launch: unexpected n_in %d / ws %zu / out %d\n", n_in, ws_size, out_size); grid = -1; return; }
        int dev = 0, cus = 0, per_cu = 0;
        if (hipGetDevice(&dev) != hipSuccess || hipDeviceGetAttribute(&cus, hipDeviceAttributeMultiprocessorCount, dev) != hipSuccess) { grid = -1; return; }
        if (hipFuncSetAttribute((const void*)mega, hipFuncAttributeMaxDynamicSharedMemorySize, LDS_BYTES) != hipSuccess) { fprintf(stderr, "kernel_launch: hipFuncSetAttribute failed\n"); grid = -1; return; }
        if (hipOccupancyMaxActiveBlocksPerMultiprocessor(&per_cu, (const void*)mega, NTHR, LDS_BYTES) != hipSuccess || per_cu < 1) { fprintf(stderr, "kernel_launch: occupancy query says %d\n", per_cu); per_cu = 1; }
        (void)hipGetLastError();
        grid = cus;
        if (grid > 256) grid = 256;
    }
    if (grid < 0) return;
    const float* const* in = (const float* const*)d_in;
    unsigned char* ws = (unsigned char*)d_ws; float* X = (float*)d_out;
    (void)hipMemsetAsync(ws + WS_CTL, 0, CTL_BYTES, stream);
    MArgs ma; memset(&ma, 0, sizeof ma);
    for (int i = 0; i < 20; ++i) ma.in[i] = in[i];
    ma.out = X; ma.ws = ws;
    ma.ph_lo = 0; ma.ph_hi = N_PHASES;
    hipLaunchKernelGGL(mega, dim3(grid), dim3(NTHR), LDS_BYTES, stream, ma);
}
```

```cpp
#include <hip/hip_runtime.h>
#include <hip/hip_bf16.h>
#include <cstdint>
#include <cstdio>
#include <cstring>

namespace cfg {
constexpr int NTOK = 16384, D = 1024, SEQ = 8192, NB = 2, DIN = 3600, PW = 3584, GW = 16;
constexpr int FF = 2816, FE = 3584, NE = 8, MAXROWS = 34816;
constexpr float EPS = 1e-6f;
constexpr float LOG2E = 1.4426950408889634f;
constexpr float QSCALE = 0.125f * LOG2E;
constexpr int P_HQ = 0, P_HF = 256, P_HI = 512, P_HG = 768, P_MQ = 1024, P_MK = 1280, P_MV = 1536, P_MO = 1792, P_FQ = 2048, P_FK = 2560, P_FV = 3072;
constexpr size_t MiB = 1u << 20;
constexpr size_t WS_CTL = 0, CTL_BYTES = 1 * MiB;
constexpr size_t WS_G = 2 * MiB;
constexpr size_t WS_CF = 3 * MiB;
constexpr size_t WS_TOKINFO = 3 * MiB + 512 * 1024;
constexpr size_t WS_TGATE = 3 * MiB + 768 * 1024;
constexpr size_t WS_TOKLIST = 4 * MiB;
constexpr size_t WS_P = 8 * MiB;
constexpr size_t WS_SCAN = 120 * MiB;
constexpr size_t WS_HID = 8 * MiB;
constexpr size_t WS_H = 246 * MiB;
constexpr size_t WS_MIX = 278 * MiB;
constexpr size_t WS_XG = 278 * MiB;
constexpr size_t WS_W = 346 * MiB;
constexpr size_t WS_Y = 346 * MiB;
constexpr size_t WS_X2 = 130 * MiB;
constexpr size_t WS_END = 466 * MiB;
constexpr int CW_CNT = 64;
constexpr int CW_STAT = 128;
constexpr int CW_QCTR = 256;
constexpr int CW_AFLAG = 512;
}
using namespace cfg;
typedef unsigned short bf16_t;

__device__ __forceinline__ bf16_t f2bf(float f) { unsigned u = __builtin_bit_cast(unsigned, f); return (bf16_t)((u + 0x7fffu + ((u >> 16) & 1u)) >> 16); }
__device__ __forceinline__ float bf2f(bf16_t h) { return __builtin_bit_cast(float, (unsigned)h << 16); }
__device__ __forceinline__ float wave_sum(float v) {
#pragma unroll
    for (int o = 1; o < 64; o <<= 1) v += __shfl_xor(v, o);
    return v;
}
__device__ __forceinline__ float sigmoidf_(float z) { return 1.f / (1.f + __expf(-z)); }
__device__ __forceinline__ float siluf_(float z) { return z / (1.f + __expf(-z)); }
__device__ __forceinline__ float log_sigmoidf_(float z) { return fminf(z, 0.f) - log1pf(__expf(-fabsf(z))); }

__device__ __forceinline__ int moe_bases(const int* cnt, int* base) {
    int acc = 0;
#pragma unroll
    for (int e = 0; e < NE; ++e) { base[e] = acc; acc += (cnt[e] + 255) & ~255; }
    return acc;
}

namespace pg8 {
#define PG8_LAS __attribute__((address_space(3)))
typedef unsigned short bf16_t;
typedef short bf16x8 __attribute__((ext_vector_type(8)));
typedef float f32x4 __attribute__((ext_vector_type(4)));
typedef unsigned u32x4 __attribute__((ext_vector_type(4)));
constexpr int BM = 256, BK = 64, HALF = 128, HTB = HALF * BK * 2  , STAGE_BYTES = 8 * HTB, NXCD = 8, WGM = 8;

__host__ __device__ __forceinline__ int lds_byte(int r, int c) { const int st = (r >> 4) * 2 + (c >> 5), rr = r & 15, cc = c & 31, ob = rr * 64 + cc * 2; return st * 1024 + (ob ^ (((ob >> 9) & 1) << 5)); }
__host__ __device__ __forceinline__ void stage_rc(int b, int& R, int& C) { const int st = b / 1024, sb = b % 1024, swz = sb ^ (((sb >> 9) & 1) << 5); R = (st >> 1) * 16 + swz / 64; C = (st & 1) * 32 + (swz % 64) / 2; }
__host__ __device__ __forceinline__ int perm32(int rho) { const int n = rho >> 4, i = rho & 15; return 8 * (i >> 2) + 4 * n + (i & 3); }

struct Unit { int pm, pn; };
struct Gemm { int K; };

struct StaticOrder {
    int nM, nN, nwg, G, c;
    __host__ __device__ void init(int M, int N, int G_, int c_) { nM = M / BM; nN = N / BM; nwg = nM * nN; G = G_; c = c_; }
    __host__ __device__ bool next(int i, Unit& u) const {
        const long L = (long)i * G + c; if (L >= nwg) return false;
        int wgid = (int)L; { const int q = nwg / NXCD, r = nwg % NXCD, xcd = wgid % NXCD, off = wgid / NXCD; wgid = (xcd < r ? xcd * (q + 1) : r * (q + 1) + (xcd - r) * q) + off; }
        const int nig = WGM * nN, gid = wgid / nig, fm = gid * WGM, gsz = (nM - fm) < WGM ? (nM - fm) : WGM;
        u.pm = fm + ((wgid % nig) % gsz); u.pn = (wgid % nig) / gsz; return true;
    }
    __device__ __forceinline__ void a_ready(const Unit&) const {}
    __device__ __forceinline__ void done(const Unit&) const {}
};

__device__ __forceinline__ unsigned cvt_pk_bf16(float lo, float hi) { unsigned r; asm volatile("v_cvt_pk_bf16_f32 %0, %1, %2" : "=v"(r) : "v"(lo), "v"(hi)); return r; }
typedef int i32x4 __attribute__((ext_vector_type(4)));
constexpr float F8_HSCALE = 4.f, F8_WSCALE = 64.f;
template <bool I8> struct AccT { typedef f32x4 type; };
template <> struct AccT<true> { typedef i32x4 type; };
__device__ __forceinline__ f32x4 mma_sel(bf16x8 b, bf16x8 a, f32x4 c) { return __builtin_amdgcn_mfma_f32_16x16x32_bf16(b, a, c, 0, 0, 0); }
__device__ __forceinline__ i32x4 mma_sel(bf16x8 b, bf16x8 a, i32x4 c) { return __builtin_amdgcn_mfma_i32_16x16x64_i8(__builtin_bit_cast(i32x4, b), __builtin_bit_cast(i32x4, a), c, 0, 0, 0); }
typedef int i32x8 __attribute__((ext_vector_type(8)));
struct Frag2 { bf16x8 k[2]; };
template <int MODE> struct Frag { typedef Frag2 type; };
template <> struct Frag<2> { typedef i32x8 type; };
template <int MODE> __device__ __forceinline__ typename Frag<MODE>::type ldfrag(PG8_LAS const unsigned char* p) {
    if constexpr (MODE == 2) { const i32x4 lo = *(const PG8_LAS i32x4*)p, hi = *(const PG8_LAS i32x4*)(p + 1024); return (i32x8){lo[0], lo[1], lo[2], lo[3], hi[0], hi[1], hi[2], hi[3]}; }
    else { Frag2 f; f.k[0] = *(const PG8_LAS bf16x8*)p; f.k[1] = *(const PG8_LAS bf16x8*)(p + 1024); return f; }
}
__device__ __forceinline__ void mma_step_(f32x4& acc, const Frag2& b, const Frag2& a) { acc = mma_sel(b.k[0], a.k[0], acc); acc = mma_sel(b.k[1], a.k[1], acc); }
__device__ __forceinline__ void mma_step_(i32x4& acc, const Frag2& b, const Frag2& a) { acc = mma_sel(b.k[0], a.k[0], acc); acc = mma_sel(b.k[1], a.k[1], acc); }
__device__ __forceinline__ void mma_step_(f32x4& acc, const i32x8& b, const i32x8& a) {
#if defined(__HIP_DEVICE_COMPILE__)
    const int scl = 0x7f7f7f7f;
    asm volatile("v_mfma_scale_f32_16x16x128_f8f6f4 %0, %1, %2, %0, %3, %3 op_sel_hi:[0,0,0]" : "+v"(acc) : "v"(b), "v"(a), "v"(scl));
#endif
}
template <int MODE, class ACC, class F> __device__ __forceinline__ void mma_step(ACC& acc, const F& b, const F& a) { mma_step_(acc, b, a); }
struct EpiBf {
    static constexpr bool PERM = true, AFTER_DRAIN = false;
    bf16_t* O; int ldc; int s_lo, s_hi; float scale;
    struct Pre {}; __device__ __forceinline__ void prefetch(Pre&, const Unit&, int, int, int, int, int) const {} __device__ __forceinline__ void commit(const Pre&, int, int, int, int, int) const {}
    __device__ __forceinline__ void operator()(const f32x4 (&acc)[2][2][4][2], const Unit& u, int wr, int wc, int fr_, int fq_, const Pre&, int) const {
        int fr = fr_, fq = fq_; asm volatile("" : "+v"(fr), "+v"(fq));
        const int row0 = u.pm * BM + wr * 64 + fr, col0 = u.pn * BM + wc * 32 + 8 * fq;
        const float sc = (u.pn >= s_lo && u.pn < s_hi) ? scale : 1.f;
#pragma unroll
        for (int ai = 0; ai < 2; ++ai)
#pragma unroll
            for (int m = 0; m < 4; ++m) { bf16_t* rowp = O + (size_t)(row0 + ai * HALF + m * 16) * ldc + col0;
#pragma unroll
                for (int bj = 0; bj < 2; ++bj) { const f32x4 v0 = acc[ai][bj][m][0] * sc, v1 = acc[ai][bj][m][1] * sc;
                    u32x4 w; w.x = cvt_pk_bf16(v0[0], v0[1]); w.y = cvt_pk_bf16(v0[2], v0[3]); w.z = cvt_pk_bf16(v1[0], v1[1]); w.w = cvt_pk_bf16(v1[2], v1[3]);
                    *(u32x4*)(rowp + bj * HALF) = w; } }
    }
};
__device__ __forceinline__ float silu_mul(float g, float u) { return g * __builtin_amdgcn_rcpf(1.f + __expf(-g)) * u; }
__device__ __forceinline__ float silu2_mul(float g2, float u2) { return g2 * __builtin_amdgcn_rcpf(1.f + __builtin_amdgcn_exp2f(-g2)) * u2; }
struct EpiSwiglu {
    static constexpr bool PERM = true, AFTER_DRAIN = false;
    bf16_t* O; int ldc;
    struct Pre {}; __device__ __forceinline__ void prefetch(Pre&, const Unit&, int, int, int, int, int) const {} __device__ __forceinline__ void commit(const Pre&, int, int, int, int, int) const {}
    __device__ __forceinline__ void operator()(const f32x4 (&acc)[2][2][4][2], const Unit& u, int wr, int wc, int fr, int fq, const Pre&, int) const {
        const int row0 = u.pm * BM + wr * 64 + fr, col0 = u.pn * HALF + wc * 32 + 8 * fq;
#pragma unroll
        for (int ai = 0; ai < 2; ++ai)
#pragma unroll
            for (int m = 0; m < 4; ++m) { bf16_t* rowp = O + (size_t)(row0 + ai * HALF + m * 16) * ldc + col0;
                const f32x4 g0 = acc[ai][0][m][0], g1 = acc[ai][0][m][1], u0 = acc[ai][1][m][0], u1 = acc[ai][1][m][1];
                u32x4 w; w.x = cvt_pk_bf16(silu_mul(g0[0], u0[0]), silu_mul(g0[1], u0[1])); w.y = cvt_pk_bf16(silu_mul(g0[2], u0[2]), silu_mul(g0[3], u0[3]));
                w.z = cvt_pk_bf16(silu_mul(g1[0], u1[0]), silu_mul(g1[1], u1[1])); w.w = cvt_pk_bf16(silu_mul(g1[2], u1[2]), silu_mul(g1[3], u1[3]));
                *(u32x4*)rowp = w; }
    }
};
template <bool IN_F32> struct EpiResid {
    static constexpr bool PERM = true, AFTER_DRAIN = false;
    const void* Xin; bf16_t* X; int ldc;
    struct Pre {}; __device__ __forceinline__ void prefetch(Pre&, const Unit&, int, int, int, int, int) const {} __device__ __forceinline__ void commit(const Pre&, int, int, int, int, int) const {}
    __device__ __forceinline__ void operator()(const f32x4 (&acc)[2][2][4][2], const Unit& u, int wr, int wc, int fr, int fq, const Pre&, int) const {
        const int row0 = u.pm * BM + wr * 64 + fr, col0 = u.pn * BM + wc * 32 + 8 * fq;
#pragma unroll
        for (int ai = 0; ai < 2; ++ai)
#pragma unroll
            for (int m = 0; m < 4; ++m) { const size_t ro = (size_t)(row0 + ai * HALF + m * 16) * ldc + col0;
#pragma unroll
                for (int bj = 0; bj < 2; ++bj) { f32x4 x0, x1;
                    if (IN_F32) { const float* p = (const float*)Xin + ro + bj * HALF; x0 = *(const f32x4*)p; x1 = *(const f32x4*)(p + 4); }
                    else { const u32x4 w = *(const u32x4*)((const bf16_t*)Xin + ro + bj * HALF);
                        x0 = (f32x4){__builtin_bit_cast(float, w.x << 16), __builtin_bit_cast(float, w.x & 0xffff0000u), __builtin_bit_cast(float, w.y << 16), __builtin_bit_cast(float, w.y & 0xffff0000u)};
                        x1 = (f32x4){__builtin_bit_cast(float, w.z << 16), __builtin_bit_cast(float, w.z & 0xffff0000u), __builtin_bit_cast(float, w.w << 16), __builtin_bit_cast(float, w.w & 0xffff0000u)}; }
                    const f32x4 v0 = x0 + acc[ai][bj][m][0], v1 = x1 + acc[ai][bj][m][1];
                    u32x4 o; o.x = cvt_pk_bf16(v0[0], v0[1]); o.y = cvt_pk_bf16(v0[2], v0[3]); o.z = cvt_pk_bf16(v1[0], v1[1]); o.w = cvt_pk_bf16(v1[2], v1[3]);
                    *(u32x4*)(X + ro + bj * HALF) = o; }
                asm volatile("" ::: "memory"); }
    }
};
struct EpiBf8 {
    static constexpr bool PERM = true, AFTER_DRAIN = false;
    bf16_t* O; int ldc; int s_lo, s_hi; float scale; const float* sA; const float* sB; PG8_LAS float* sc;
    struct Pre { f32x4 v; };
    __device__ __forceinline__ void prefetch(Pre& p, const Unit& u, int wr, int wc, int fr, int fq, int) const {
        const int wid = wr * 4 + wc, lane = fq * 16 + fr;
        if (wid == 0) p.v = *(const f32x4*)(sA + u.pm * BM + 4 * lane);
        if (wid == 1) p.v = *(const f32x4*)(sB + u.pn * BM + 4 * lane);
    }
    __device__ __forceinline__ void commit(const Pre& p, int wr, int wc, int fr, int fq, int ui) const {
        const int wid = wr * 4 + wc, lane = fq * 16 + fr; PG8_LAS float* d = sc + (ui & 1) * 512;
        if (wid < 2) { *(PG8_LAS f32x4*)(d + 256 * wid + 4 * lane) = p.v; asm volatile("s_waitcnt lgkmcnt(0)" ::: "memory"); }
    }
    __device__ __forceinline__ void operator()(const i32x4 (&acc)[2][2][4][2], const Unit& u, int wr, int wc, int fr, int fq, const Pre&, int ui) const {
        const int row0 = u.pm * BM + wr * 64 + fr, col0 = u.pn * BM + wc * 32 + 8 * fq; const PG8_LAS float* d = sc + (ui & 1) * 512;
        const float sc0 = (u.pn >= s_lo && u.pn < s_hi) ? scale : 1.f;
        f32x4 cb[2][2];
#pragma unroll
        for (int bj = 0; bj < 2; ++bj)
#pragma unroll
            for (int n = 0; n < 2; ++n) cb[bj][n] = *(const PG8_LAS f32x4*)(d + 256 + wc * 32 + 8 * fq + bj * HALF + 4 * n) * sc0;
#pragma unroll
        for (int ai = 0; ai < 2; ++ai)
#pragma unroll
            for (int m = 0; m < 4; ++m) { const int row = row0 + ai * HALF + m * 16; const float ra = d[wr * 64 + fr + ai * HALF + m * 16]; bf16_t* rowp = O + (size_t)row * ldc + col0;
#pragma unroll
                for (int bj = 0; bj < 2; ++bj) { const f32x4 v0 = __builtin_convertvector(acc[ai][bj][m][0], f32x4) * cb[bj][0] * ra, v1 = __builtin_convertvector(acc[ai][bj][m][1], f32x4) * cb[bj][1] * ra;
                    u32x4 w; w.x = cvt_pk_bf16(v0[0], v0[1]); w.y = cvt_pk_bf16(v0[2], v0[3]); w.z = cvt_pk_bf16(v1[0], v1[1]); w.w = cvt_pk_bf16(v1[2], v1[3]);
                    *(u32x4*)(rowp + bj * HALF) = w; } }
    }
};
template <bool F8OUT> struct EpiSwiglu8 {
    static constexpr bool PERM = true, AFTER_DRAIN = false;
    bf16_t* O; int ldc; const float* sA; const float* sB; int sb_exp; int tb1, tb2, tb3, tb4, tb5, tb6, tb7; PG8_LAS float* sc;
    struct Pre { f32x4 v; };
    __device__ __forceinline__ void prefetch(Pre& p, const Unit& u, int wr, int wc, int fr, int fq, int) const {
        const int wid = wr * 4 + wc, lane = fq * 16 + fr;
        const int e = (u.pm >= tb1) + (u.pm >= tb2) + (u.pm >= tb3) + (u.pm >= tb4) + (u.pm >= tb5) + (u.pm >= tb6) + (u.pm >= tb7);
        if (wid == 0) p.v = *(const f32x4*)(sA + u.pm * BM + 4 * lane);
        if (wid == 1) p.v = *(const f32x4*)(sB + (size_t)e * sb_exp + u.pn * BM + 4 * lane);
    }
    __device__ __forceinline__ void commit(const Pre& p, int wr, int wc, int fr, int fq, int ui) const {
        const int wid = wr * 4 + wc, lane = fq * 16 + fr; PG8_LAS float* d = sc + (ui & 1) * 512;
        const float cm = wid == 0 ? 1.f : (lane < 32 ? 1.4426950408889634f : (F8OUT ? F8_HSCALE : 1.f) * 0.6931471805599453f);
        if (wid < 2) { *(PG8_LAS f32x4*)(d + 256 * wid + 4 * lane) = p.v * cm; asm volatile("s_waitcnt lgkmcnt(0)" ::: "memory"); }
    }
    __device__ __forceinline__ void operator()(const i32x4 (&acc)[2][2][4][2], const Unit& u, int wr, int wc, int fr, int fq, const Pre&, int ui) const {
        const int row0 = u.pm * BM + wr * 64 + fr, col0 = u.pn * HALF + wc * 32 + 8 * fq; const PG8_LAS float* d = sc + (ui & 1) * 512;
        const PG8_LAS float* sb = d + 256 + wc * 32 + 8 * fq;
        const f32x4 sg0 = *(const PG8_LAS f32x4*)sb, sg1 = *(const PG8_LAS f32x4*)(sb + 4), su0 = *(const PG8_LAS f32x4*)(sb + HALF), su1 = *(const PG8_LAS f32x4*)(sb + HALF + 4);
#pragma unroll
        for (int ai = 0; ai < 2; ++ai)
#pragma unroll
            for (int m = 0; m < 4; ++m) { const int row = row0 + ai * HALF + m * 16; const float ra = d[wr * 64 + fr + ai * HALF + m * 16];
                const f32x4 g0 = __builtin_convertvector(acc[ai][0][m][0], f32x4) * sg0 * ra, g1 = __builtin_convertvector(acc[ai][0][m][1], f32x4) * sg1 * ra;
                const f32x4 u0 = __builtin_convertvector(acc[ai][1][m][0], f32x4) * su0 * ra, u1 = __builtin_convertvector(acc[ai][1][m][1], f32x4) * su1 * ra;
                if constexpr (F8OUT) { float h[8];
#pragma unroll
                    for (int i = 0; i < 4; ++i) { h[i] = __builtin_fminf(__builtin_fmaxf(silu2_mul(g0[i], u0[i]), -448.f), 448.f); h[4 + i] = __builtin_fminf(__builtin_fmaxf(silu2_mul(g1[i], u1[i]), -448.f), 448.f); }
                    unsigned w0 = 0u, w1 = 0u; w0 = __builtin_amdgcn_cvt_pk_fp8_f32(h[0], h[1], w0, false); w0 = __builtin_amdgcn_cvt_pk_fp8_f32(h[2], h[3], w0, true);
                    w1 = __builtin_amdgcn_cvt_pk_fp8_f32(h[4], h[5], w1, false); w1 = __builtin_amdgcn_cvt_pk_fp8_f32(h[6], h[7], w1, true);
                    typedef unsigned u32x2 __attribute__((ext_vector_type(2))); *(u32x2*)((unsigned char*)O + (size_t)row * ldc + col0) = (u32x2){w0, w1}; }
                else { bf16_t* rowp = O + (size_t)row * ldc + col0;
                u32x4 w; w.x = cvt_pk_bf16(silu2_mul(g0[0], u0[0]), silu2_mul(g0[1], u0[1])); w.y = cvt_pk_bf16(silu2_mul(g0[2], u0[2]), silu2_mul(g0[3], u0[3]));
                w.z = cvt_pk_bf16(silu2_mul(g1[0], u1[0]), silu2_mul(g1[1], u1[1])); w.w = cvt_pk_bf16(silu2_mul(g1[2], u1[2]), silu2_mul(g1[3], u1[3]));
                *(u32x4*)rowp = w; } }
    }
};
struct GOrder {
    StaticOrder so; const char* A; const char* B; size_t a_tile, b_tile, b_exp; int tb1, tb2, tb3, tb4, tb5, tb6, tb7;
    __device__ __forceinline__ bool next(int i, Unit& u) const { return so.next(i, u); }
    __device__ __forceinline__ const char* a_base(const Unit& u) const { return A + (size_t)u.pm * a_tile; }
    __device__ __forceinline__ const char* b_base(const Unit& u) const {
        const int e = (u.pm >= tb1) + (u.pm >= tb2) + (u.pm >= tb3) + (u.pm >= tb4) + (u.pm >= tb5) + (u.pm >= tb6) + (u.pm >= tb7);
        return B + (size_t)e * b_exp + (size_t)u.pn * b_tile; }
    __device__ __forceinline__ void a_ready(const Unit&) const {}
    __device__ __forceinline__ void done(const Unit&) const {}
};
template <class Epi, class Sched, bool ALIGN_EPI = false, bool SP2 = false, int MODE = 0  >
__device__ __forceinline__ void gemm_phase(PG8_LAS unsigned char* lds, const Gemm g, const Sched& S, const Epi& E) {
    const int tid = threadIdx.x, wid = __builtin_amdgcn_readfirstlane(tid >> 6), lane = tid & 63, wr = wid >> 2, wc = wid & 3, fr = lane & 15, fq = lane >> 4;
    const int K = g.K, nt = K / BK;
    unsigned voffA[2], voffB[2];
#pragma unroll
    for (int i = 0; i < 2; ++i) { int R, C; stage_rc(tid * 16 + i * 8192, R, C); const int Rb = Epi::PERM ? ((R & ~31) + perm32(R & 31)) : R;
        voffA[i] = (unsigned)(R * K + C) * 2u; voffB[i] = (unsigned)(Rb * K + C) * 2u; }
    const size_t kstep = (size_t)(BK * 2);
    const size_t hstep = (size_t)HALF * K * 2;
        const unsigned ldsw = (unsigned)wid * 1024u;
    const int aoff = lds_byte(wr * 64 + fr, fq * 8), boff = lds_byte(wc * 32 + fr, fq * 8);
#define PG8_SA(b, h) (((b) * 2 + (h)) * HTB)
#define PG8_SB(b, h) ((4 + (b) * 2 + (h)) * HTB)
#define PG8_STAGE(bufoff, gbase, voff) do { _Pragma("unroll") for (int _i = 0; _i < 2; ++_i) \
        __builtin_amdgcn_global_load_lds((const unsigned*)((const char*)(gbase) + (voff)[_i]), (PG8_LAS unsigned*)(lds + (bufoff) + ldsw + _i * 8192), 16, 0, 0); } while (0)
#define PG8_LDA(dst, b, h) do { _Pragma("unroll") for (int m = 0; m < 4; ++m) dst[m] = ldfrag<MODE>(lds + PG8_SA(b, h) + aoff + m * 2048); } while (0)
#define PG8_LDB(dst, b, h) do { _Pragma("unroll") for (int n = 0; n < 2; ++n) dst[n] = ldfrag<MODE>(lds + PG8_SB(b, h) + boff + n * 2048); } while (0)
#define PG8_MMA(ai, bj, At, Bt) do { __builtin_amdgcn_s_setprio(1); _Pragma("unroll") for (int m = 0; m < 4; ++m) _Pragma("unroll") for (int n = 0; n < 2; ++n) \
        mma_step<MODE>(acc[ai][bj][m][n], Bt[n], At[m]); __builtin_amdgcn_s_setprio(0); } while (0)
#define PG8_WAIT_V(n) asm volatile("s_waitcnt vmcnt(" #n ")" ::: "memory")
#define PG8_WAIT_L(n) asm volatile("s_waitcnt lgkmcnt(" #n ")" ::: "memory")
#define PG8_BAR __builtin_amdgcn_s_barrier()
#define PG8_SCHED __builtin_amdgcn_sched_barrier(0)
    Unit cur, nxt; int ui = 0; typename Epi::Pre pre;
    if (!S.next(0, cur)) return;
    typename AccT<MODE == 1>::type acc[2][2][4][2];
#pragma unroll
    for (int a = 0; a < 2; ++a)
#pragma unroll
        for (int b = 0; b < 2; ++b)
#pragma unroll
            for (int m = 0; m < 4; ++m)
#pragma unroll
                for (int n = 0; n < 2; ++n) acc[a][b][m][n] = typename AccT<MODE == 1>::type{};
    typename Frag<MODE>::type At[4], B0[2], B1[2];
    const char* cA = S.a_base(cur); const char* cB = S.b_base(cur);
    S.a_ready(cur);
    if constexpr (SP2) {
        PG8_STAGE(PG8_SB(0, 0), cB, voffB); PG8_STAGE(PG8_SB(0, 1), cB + hstep, voffB); PG8_STAGE(PG8_SA(0, 0), cA, voffA); PG8_STAGE(PG8_SA(0, 1), cA + hstep, voffA);
        if (wr == 1) PG8_BAR;
        PG8_WAIT_V(2); PG8_BAR;
        PG8_STAGE(PG8_SB(1, 0), cB + kstep, voffB); PG8_STAGE(PG8_SA(1, 0), cA + kstep, voffA); PG8_STAGE(PG8_SB(1, 1), cB + hstep + kstep, voffB);
        PG8_WAIT_V(6); PG8_BAR;
    } else {
        PG8_STAGE(PG8_SB(0, 0), cB, voffB); PG8_STAGE(PG8_SA(0, 0), cA, voffA); PG8_STAGE(PG8_SB(0, 1), cB + hstep, voffB); PG8_STAGE(PG8_SA(0, 1), cA + hstep, voffA);
        if (wr == 1) PG8_BAR;
        PG8_WAIT_V(4); PG8_BAR;
        PG8_STAGE(PG8_SB(1, 0), cB + kstep, voffB); PG8_STAGE(PG8_SA(1, 0), cA + kstep, voffA); PG8_STAGE(PG8_SB(1, 1), cB + hstep + kstep, voffB);
        PG8_WAIT_V(6); PG8_BAR;
    }
    for (;;) {
        const bool has_next = S.next(ui + 1, nxt);
        const char* nA = has_next ? S.a_base(nxt) : cA; const char* nB = has_next ? S.b_base(nxt) : cB;
        for (int t = 0; t < nt; t += 2) {
            const bool last = (t == nt - 2);
            const char* a1 = cA + (size_t)(t + 1) * kstep;
            const char* a2 = last ? nA : cA + (size_t)(t + 2) * kstep; const char* b2 = last ? nB : cB + (size_t)(t + 2) * kstep;
            const char* a3 = a2 + kstep; const char* b3 = b2 + kstep;
            if (last && has_next) S.a_ready(nxt);
            if (last) E.prefetch(pre, cur, wr, wc, fr, fq, ui);
            if constexpr (SP2) {
            PG8_LDB(B0, 0, 0); PG8_LDB(B1, 0, 1); PG8_SCHED; PG8_LDA(At, 0, 0); PG8_STAGE(PG8_SA(1, 1), a1 + hstep, voffA);
            PG8_WAIT_V(8); PG8_WAIT_L(0); PG8_BAR; PG8_MMA(0, 0, At, B0); PG8_MMA(0, 1, At, B1); PG8_BAR; PG8_SCHED;
            PG8_LDA(At, 0, 1); PG8_STAGE(PG8_SB(0, 0), b2, voffB); PG8_STAGE(PG8_SB(0, 1), b2 + hstep, voffB); PG8_STAGE(PG8_SA(0, 0), a2, voffA);
            PG8_WAIT_V(8); PG8_WAIT_L(0); PG8_BAR; PG8_MMA(1, 0, At, B0); PG8_MMA(1, 1, At, B1); PG8_BAR; PG8_SCHED;
            PG8_LDB(B0, 1, 0); PG8_LDB(B1, 1, 1); PG8_SCHED; PG8_LDA(At, 1, 0); PG8_STAGE(PG8_SA(0, 1), a2 + hstep, voffA);
            PG8_WAIT_V(8); PG8_WAIT_L(0); PG8_BAR; PG8_MMA(0, 0, At, B0); PG8_MMA(0, 1, At, B1); PG8_BAR; PG8_SCHED;
            PG8_LDA(At, 1, 1); PG8_STAGE(PG8_SB(1, 0), b3, voffB); PG8_STAGE(PG8_SB(1, 1), b3 + hstep, voffB); PG8_STAGE(PG8_SA(1, 0), a3, voffA);
            PG8_WAIT_V(8); PG8_WAIT_L(0); PG8_BAR; PG8_MMA(1, 0, At, B0); PG8_MMA(1, 1, At, B1); PG8_BAR; PG8_SCHED;
            } else {
            PG8_LDB(B0, 0, 0); PG8_SCHED; PG8_LDA(At, 0, 0); PG8_STAGE(PG8_SA(1, 1), a1 + hstep, voffA);
            PG8_WAIT_L(8); PG8_BAR; PG8_WAIT_L(0); PG8_MMA(0, 0, At, B0); PG8_BAR; PG8_SCHED;
            PG8_LDB(B1, 0, 1); PG8_STAGE(PG8_SB(0, 0), b2, voffB);
            PG8_BAR; PG8_WAIT_L(0); PG8_MMA(0, 1, At, B1); PG8_BAR;
            PG8_LDA(At, 0, 1); PG8_STAGE(PG8_SA(0, 0), a2, voffA);
            PG8_BAR; PG8_WAIT_L(0); PG8_MMA(1, 0, At, B0); PG8_BAR; PG8_SCHED;
            PG8_STAGE(PG8_SB(0, 1), b2 + hstep, voffB);
            PG8_WAIT_V(6); PG8_BAR; PG8_MMA(1, 1, At, B1); PG8_BAR;
            PG8_LDB(B0, 1, 0); PG8_SCHED; PG8_LDA(At, 1, 0); PG8_STAGE(PG8_SA(0, 1), a2 + hstep, voffA);
            PG8_WAIT_L(8); PG8_BAR; PG8_WAIT_L(0); PG8_MMA(0, 0, At, B0); PG8_BAR; PG8_SCHED;
            PG8_LDB(B1, 1, 1); PG8_STAGE(PG8_SB(1, 0), b3, voffB);
            PG8_BAR; PG8_WAIT_L(0); PG8_MMA(0, 1, At, B1); PG8_BAR;
            PG8_LDA(At, 1, 1); PG8_STAGE(PG8_SA(1, 0), a3, voffA);
            PG8_BAR; PG8_WAIT_L(0); PG8_MMA(1, 0, At, B0); PG8_BAR; PG8_SCHED;
            PG8_STAGE(PG8_SB(1, 1), b3 + hstep, voffB);
            PG8_WAIT_V(6); PG8_BAR; PG8_MMA(1, 1, At, B1); PG8_BAR;
            }
        }
        E.commit(pre, wr, wc, fr, fq, ui);
        if constexpr (ALIGN_EPI) { if (wr == 0) PG8_BAR; }
        if constexpr (MODE == 2) asm volatile("s_nop 15\n\ts_nop 7" ::: "memory");
        if constexpr (!Epi::AFTER_DRAIN) { E(acc, cur, wr, wc, fr, fq, pre, ui); S.done(cur); }
        if (!has_next) break;
#pragma unroll
        for (int a = 0; a < 2; ++a)
#pragma unroll
            for (int b = 0; b < 2; ++b)
#pragma unroll
                for (int m = 0; m < 4; ++m)
#pragma unroll
                    for (int n = 0; n < 2; ++n) acc[a][b][m][n] = typename AccT<MODE == 1>::type{};
        cur = nxt; cA = nA; cB = nB; ++ui;
        if constexpr (ALIGN_EPI) { if (wr == 1) PG8_BAR; }
    }
    PG8_WAIT_V(0);
    if constexpr (!ALIGN_EPI) { if (wr == 0) PG8_BAR; }
    PG8_BAR;
    if constexpr (Epi::AFTER_DRAIN) { E.fused(acc, cur, wr, wc, fr, fq, lds, wid, lane); S.done(cur); }
#undef PG8_SA
#undef PG8_SB
#undef PG8_STAGE
#undef PG8_LDA
#undef PG8_LDB
#undef PG8_MMA
#undef PG8_WAIT_V
#undef PG8_WAIT_L
#undef PG8_BAR
#undef PG8_SCHED
}
}
#include <hip/hip_bf16.h>
#include <cmath>
namespace attn_body {
using bf16=__hip_bfloat16;
using bf16x8=__attribute__((ext_vector_type(8)))short;
using s16x4=__attribute__((ext_vector_type(4)))short;
using f32x16=__attribute__((ext_vector_type(16)))float;
using u32x4=__attribute__((ext_vector_type(4)))unsigned;
constexpr int BATCH=2,NHEAD=8,SEQ=8192,D=64,DM=3584,OPITCH=1024;
constexpr int NW=8,QBLK=32,QB=QBLK*NW,KVBLK=64,NQB=SEQ/QB;
constexpr int ATTN_PITCH=DM, ATTN_UNIT_ROWS=QB;
__device__ __forceinline__ int crow(int r,int hi){return (r&3)+8*(r>>2)+4*hi;}
#define SBAR() __builtin_amdgcn_sched_barrier(0)
__device__ __forceinline__ void cmask(f32x16&p0,f32x16&p1,int jb,int qrel,int hi){
  const float NEG=-INFINITY; int kb=64*jb+4*hi;
  #pragma unroll
  for(int r=0;r<16;++r){int kv=kb+(r&3)+8*(r>>2); if(kv>qrel)p0[r]=NEG; if(kv+32>qrel)p1[r]=NEG;}
}

constexpr int NSLOT=3, SLOTB=8192, SPLIT_NT=72, PART_F=256*64+512;
constexpr int LDS_K=0, LDS_V=NSLOT*SLOTB, LDS_WS=2*NSLOT*SLOTB, LDS_OST=LDS_WS+NW*64*4, LDS_CK=LDS_OST+NW*4096, LDS_BYTES=LDS_CK+SEQ*4;
constexpr float C2=0.125f*1.4426950408889634f;
__device__ __forceinline__ void glds16(const void*gsrc,unsigned lds_dst){unsigned keep;
  asm volatile("s_mov_b32 %0, m0\n\ts_mov_b32 m0, %2\n\ts_nop 0\n\tglobal_load_lds_dwordx4 %1, off\n\ts_mov_b32 m0, %0":"=&s"(keep):"v"(gsrc),"s"(lds_dst):"memory");}
__device__ __forceinline__ float max3f(float a,float b,float c){float r;asm("v_max3_f32 %0, %1, %2, %3":"=v"(r):"v"(a),"v"(b),"v"(c));return r;}
__device__ __forceinline__ float max2f(float a,float b){float r;asm("v_max_f32_e32 %0, %1, %2":"=v"(r):"v"(a),"v"(b));return r;}
__device__ __forceinline__ float fadd_s(float a,float b){float r;asm("v_add_f32_e32 %0, %1, %2":"=v"(r):"v"(a),"v"(b));return r;}
__device__ __forceinline__ float fsub_s(float a,float b){float r;asm("v_sub_f32_e32 %0, %1, %2":"=v"(r):"v"(a),"v"(b));return r;}
typedef float f32x2_t __attribute__((ext_vector_type(2))); typedef float f32x4_t __attribute__((ext_vector_type(4))); typedef __bf16 bf16x2_t __attribute__((ext_vector_type(2)));
__device__ __forceinline__ unsigned cvtpk_s(float lo,float hi){f32x2_t v={lo,hi};bf16x2_t b=__builtin_convertvector(v,bf16x2_t);return __builtin_bit_cast(unsigned,b);}
#define WAIT_BAR(N) asm volatile("s_waitcnt vmcnt(" #N ") lgkmcnt(0)\n\ts_barrier":::"memory")

__device__ __forceinline__ void qkt(f32x16&p0,f32x16&p1,const char*Kslot,const bf16x8*qr,const f32x16&negm,int r32,int hi){
  const char*kb=Kslot+hi*1024+r32*16;
  #pragma unroll
  for(int d0=0;d0<4;++d0){
    const bf16x8 b0=*reinterpret_cast<const bf16x8*>(kb+d0*2048);
    const bf16x8 b1=*reinterpret_cast<const bf16x8*>(kb+d0*2048+512);
    if(d0==0){p0=__builtin_amdgcn_mfma_f32_32x32x16_bf16(b0,qr[0],negm,0,0,0);p1=__builtin_amdgcn_mfma_f32_32x32x16_bf16(b1,qr[0],negm,0,0,0);}
    else{p0=__builtin_amdgcn_mfma_f32_32x32x16_bf16(b0,qr[d0],p0,0,0,0);p1=__builtin_amdgcn_mfma_f32_32x32x16_bf16(b1,qr[d0],p1,0,0,0);}}
}
typedef __attribute__((address_space(3))) const char* lds_cptr;
typedef short v4i16_t __attribute__((ext_vector_type(4)));
__device__ __forceinline__ void kload8(bf16x8*kf,lds_cptr kp){
  kf[0]=*(const __attribute__((address_space(3))) bf16x8*)(kp);      kf[1]=*(const __attribute__((address_space(3))) bf16x8*)(kp+512);
  kf[2]=*(const __attribute__((address_space(3))) bf16x8*)(kp+2048); kf[3]=*(const __attribute__((address_space(3))) bf16x8*)(kp+2560);
  kf[4]=*(const __attribute__((address_space(3))) bf16x8*)(kp+4096); kf[5]=*(const __attribute__((address_space(3))) bf16x8*)(kp+4608);
  kf[6]=*(const __attribute__((address_space(3))) bf16x8*)(kp+6144); kf[7]=*(const __attribute__((address_space(3))) bf16x8*)(kp+6656);
}
__device__ __forceinline__ void kload2(bf16x8*kf,lds_cptr kp,int j){ kf[2*j]=*(const __attribute__((address_space(3))) bf16x8*)(kp+j*2048); kf[2*j+1]=*(const __attribute__((address_space(3))) bf16x8*)(kp+j*2048+512); }
__device__ __forceinline__ s16x4 vtr(lds_cptr p){ return __builtin_bit_cast(s16x4,__builtin_amdgcn_ds_read_tr16_b64_v4i16((__attribute__((address_space(3))) v4i16_t*)p)); }
__device__ __forceinline__ float rowmax(const f32x16&p0,const f32x16&p1){
  float a=max3f(p0[0],p0[1],p1[0]),b=max3f(p0[2],p0[3],p1[1]);a=max3f(a,p1[2],p1[3]);
  #pragma unroll
  for(int r=4;r<16;r+=4){a=max3f(a,p0[r],p0[r+1]);b=max3f(b,p0[r+2],p0[r+3]);a=max3f(a,p1[r],p1[r+1]);b=max3f(b,p1[r+2],p1[r+3]);}
  const float m=max2f(a,b);
  auto rr=__builtin_amdgcn_permlane32_swap(__float_as_uint(m),__float_as_uint(m),false,false);
  return max2f(__uint_as_float(rr[0]),__uint_as_float(rr[1]));
}
__device__ __forceinline__ void pv(f32x16*o,int vb,bf16x8 pa0,bf16x8 pa1,bf16x8 pa2,bf16x8 pa3){
  #pragma unroll
  for(int d0=0;d0<2;++d0){s16x4 lo[4],hi[4];
    #pragma unroll
    for(int ks=0;ks<4;++ks){
      asm volatile("ds_read_b64_tr_b16 %0,%1 offset:%c2":"=&v"(lo[ks]):"v"(vb),"i"(d0*4096+ks*1024):"memory");
      asm volatile("ds_read_b64_tr_b16 %0,%1 offset:%c2":"=&v"(hi[ks]):"v"(vb),"i"(d0*4096+ks*1024+512):"memory");}
    asm volatile("s_waitcnt lgkmcnt(0)":::"memory");SBAR();
    #define PK(k) (bf16x8){lo[k][0],lo[k][1],lo[k][2],lo[k][3],hi[k][0],hi[k][1],hi[k][2],hi[k][3]}
    o[d0]=__builtin_amdgcn_mfma_f32_32x32x16_bf16(pa0,PK(0),o[d0],0,0,0);
    o[d0]=__builtin_amdgcn_mfma_f32_32x32x16_bf16(pa1,PK(1),o[d0],0,0,0);
    o[d0]=__builtin_amdgcn_mfma_f32_32x32x16_bf16(pa2,PK(2),o[d0],0,0,0);
    o[d0]=__builtin_amdgcn_mfma_f32_32x32x16_bf16(pa3,PK(3),o[d0],0,0,0);
    #undef PK
  }
}

#ifndef ATTN_STORE16
#define ATTN_STORE16(p,v) (*(u32x4*)(p)=(v))
#endif
template<int THRL> __device__ __forceinline__ void attn_unit(int b,int h,int qb,const bf16*Q,const bf16*__restrict__ K,const bf16*__restrict__ V,bf16*O,const float*__restrict__ cf,const float Tskip,const int part,float*PART,unsigned*flag,char*shm){
  int tid_=threadIdx.x; asm volatile("":"+v"(tid_));
  const int tid=tid_,lane=tid&63,r32=lane&31,hi=lane>>5; const int wid=__builtin_amdgcn_readfirstlane(tid>>6);
  const long rowbase=(long)b*SEQ; const int q0=qb*QB;
  const bf16*Qw=Q+(rowbase+q0+wid*QBLK)*DM+h*D;
  const unsigned lds0=(unsigned)(uintptr_t)shm;
  float*wsf=(float*)(shm+LDS_WS)+wid*64;
  const unsigned kdst=lds0+LDS_K+wid*1024, vdst=lds0+LDS_V+wid*1024;
  #define DMA_K(t,slot) glds16(ksrc+(long)(t)*KVBLK*DM,(unsigned)__builtin_amdgcn_readfirstlane(kdst+(slot)))
  #define DMA_V(t,slot) glds16(vsrc+(long)(t)*KVBLK*DM,(unsigned)__builtin_amdgcn_readfirstlane(vdst+(slot)))
  const int vb0=(int)(lds0+LDS_V)+((lane>>4)&1)*32+(lane&3)*8+(4*hi+((lane&15)>>2))*64;
  const char*Kbase=shm+LDS_K; bf16x8 kf[8];
  const lds_cptr shm3=(lds_cptr)shm; const lds_cptr kp0=shm3+LDS_K+hi*1024+r32*16; const lds_cptr vp0=shm3+LDS_V+((lane>>4)&1)*32+(lane&3)*8+(4*hi+((lane&15)>>2))*64;
  typedef __attribute__((address_space(3))) float lds_f32; typedef __attribute__((address_space(3))) const f32x4_t* lds_cf4;
  const int NT0=(q0+QB)/KVBLK;
  int tb;
  { const float thr=cf[q0]+Tskip; const int t1=lane,t2=lane+64;
    const bool n1=(t1<NT0)&&(cf[64*t1+63]>thr), n2=(t2<NT0)&&(cf[64*t2+63]>thr);
    const int t0=(int)__popcll(__ballot(n1))+(int)__popcll(__ballot(n2));
    tb=t0&~1; if(tb>NT0-4)tb=NT0-4; tb=__builtin_amdgcn_readfirstlane(tb); }
  int NT=NT0-tb; bool band=true; const bool split=(PART!=nullptr)&&(NT>SPLIT_NT);
  if(PART!=nullptr){ if(!split){ if(part==1)return; } else { const int mid=(NT>>1)&~1; if(part==0){NT=mid;band=false;} else {tb+=mid;NT-=mid;} } }
  { lds_f32* ckw=(lds_f32*)((lds_cptr)shm+LDS_CK); int i0_=tb*KVBLK+tid; asm volatile("":"+v"(i0_)); _Pragma("nounroll") for(int i=i0_;i<q0+QB;i+=NW*64)ckw[i]=cf[i]; }
  const float cq=cf[q0+wid*QBLK+(lane&31)];
  asm volatile("s_waitcnt vmcnt(0) lgkmcnt(0)\n\ts_barrier":::"memory");
  const bf16*Kh=K+(rowbase+(long)tb*KVBLK)*DM+h*D,*Vh=V+(rowbase+(long)tb*KVBLK)*DM+h*D;
  const bf16*ksrc=Kh+(long)lane*DM+wid*8;
  const bf16*vsrc=Vh+(long)(16*(wid&3)+(lane>>2))*DM+(wid>>2)*32+(lane&3)*8;
  const lds_cptr ckl=(lds_cptr)shm+LDS_CK+256*tb+16*(lane>>5);
  #define CBIAS(P0,P1,t) do{ const lds_cptr cb_=ckl+256*(t); _Pragma("unroll") for(int g_=0;g_<4;++g_){ const f32x4_t a_=*(lds_cf4)(cb_+32*g_), b_=*(lds_cf4)(cb_+128+32*g_); \
      _Pragma("unroll") for(int i_=0;i_<4;++i_){ P0[4*g_+i_]-=(a_[i_]+mm); P1[4*g_+i_]-=(b_[i_]+mm); } } }while(0)
  f32x4_t cbA[4],cbB[4]; float clast;
  #define CBLD(t) do{ const lds_cptr cb_=ckl+256*(t); _Pragma("unroll") for(int g_=0;g_<4;++g_){ cbA[g_]=*(lds_cf4)(cb_+32*g_); cbB[g_]=*(lds_cf4)(cb_+128+32*g_); } \
      clast=*(const __attribute__((address_space(3))) float*)((lds_cptr)shm+LDS_CK+256*tb+256*(t)+252); }while(0)
  DMA_K(0,0);DMA_V(0,0);DMA_K(1,SLOTB);
  bf16x8 qr[4];
  #pragma unroll
  for(int d0=0;d0<4;++d0)qr[d0]=*reinterpret_cast<const bf16x8*>(&Qw[(long)r32*DM+d0*16+hi*8]);
  float mhat=0.f,l_reg=0.f;f32x16 o[2];o[0]=f32x16{};o[1]=f32x16{};float mm=-cq; const f32x16 negm=f32x16{};
  const int qrel=wid*QBLK+r32;
  #define CMASK(P0,P1,t) do{int jb_=(t)-(NT-4); if(band&&jb_>=0)cmask(P0,P1,jb_,qrel,hi);}while(0)
  bool resc=false;
  #define START(P0,P1) do{ const float rm=rowmax(P0,P1); resc=false; \
    { const float dl=rm; mhat=fadd_s(mhat,dl); \
      _Pragma("unroll") for(int r=0;r<16;++r){P0[r]=fsub_s(P0[r],dl);P1[r]=fsub_s(P1[r],dl);} \
      mm+=dl; } \
    _Pragma("unroll") for(int r=0;r<16;++r)P0[r]=__builtin_amdgcn_exp2f(P0[r]); }while(0)
  #define RESC() do{ if(resc){ asm volatile("s_waitcnt lgkmcnt(0)":::"memory"); \
      _Pragma("unroll") for(int d_=0;d_<2;++d_) _Pragma("unroll") for(int r=0;r<16;++r)o[d_][r]*=wsf[crow(r,hi)]; } }while(0)
  f32x16 pA0,pA1,pB0,pB1;
  int sl_prev=0,sl_cur=0,sl_next=SLOTB;
  #define ROT() do{sl_prev=sl_cur;sl_cur=sl_next;sl_next=(sl_next==(NSLOT-1)*SLOTB)?0:sl_next+SLOTB;}while(0)
  DMA_K(2,2*SLOTB);
  WAIT_BAR(3);
  qkt(pA0,pA1,Kbase,qr,negm,r32,hi);asm volatile("s_nop 15\n\ts_nop 7":"+v"(pA0),"+v"(pA1));CBIAS(pA0,pA1,0);CMASK(pA0,pA1,0);
  START(pA0,pA1);
  _Pragma("unroll") for(int r=0;r<16;++r)pA1[r]=__builtin_amdgcn_exp2f(pA1[r]);
  WAIT_BAR(0);
  DMA_K(3,0);DMA_V(1,SLOTB);
  ROT();
  kload8(kf,kp0+sl_cur);
  WAIT_BAR(2);
  s16x4 vlo[8],vhi[8]; u32x4 pw0,pw1,pw2,pw3;
  #define PKW(P,B) cvtpk_s(P[B],P[B+1])
  #define PAF(k) __builtin_bit_cast(bf16x8,pw##k)
  #define VFR(i) (bf16x8){vlo[i][0],vlo[i][1],vlo[i][2],vlo[i][3],vhi[i][0],vhi[i][1],vhi[i][2],vhi[i][3]}
  #define PIN(x) asm volatile("":"+v"(x))
  #define MX3(a,b,c) __builtin_fmaxf(__builtin_fmaxf((a),(b)),(c))
  #define GAPA(MF,A0,A1,A2,A3,W0,W1,PW) do{ MF; sacc+=A0; sacc+=A1; sacc+=A2; sacc+=A3; PIN(sacc); W0; W1; PIN(PW); SBAR(); }while(0)
  #define EX(v) __builtin_amdgcn_exp2f(v)
  #define GAPB(MF,X,B,CB) do{ MF; { const f32x4_t t_=(CB)+mm; X[B]=EX(X[B]-t_[0]); X[B+1]=EX(X[B+1]-t_[1]); X[B+2]=EX(X[B+2]-t_[2]); X[B+3]=EX(X[B+3]-t_[3]); } PIN(X); SBAR(); }while(0)
  #define VRD(i) do{ vlo[i]=vtr(vp_+(((i)>>2)*4096+((i)&3)*1024)); vhi[i]=vtr(vp_+(((i)>>2)*4096+((i)&3)*1024+512)); }while(0)
  #define KRD(G,j) do{ if(G){ kload2(kf,kp0+sl_next,j); SBAR(); } }while(0)
  #define STEP(C0,C1,P0,P1,t,GK,GV,GL) do{ SBAR(); \
    const lds_cptr vp_=vp0+sl_prev; \
    VRD(0); SBAR(); float sacc=(P0[0]+P0[1]); \
    GAPA(C0=__builtin_amdgcn_mfma_f32_32x32x16_bf16(kf[0],qr[0],negm,0,0,0), P0[2],P0[3],P0[4],P0[5],     pw0[0]=PKW(P0,0), pw0[1]=PKW(P0,2), pw0); \
    VRD(4); SBAR(); GAPA(C1=__builtin_amdgcn_mfma_f32_32x32x16_bf16(kf[1],qr[0],negm,0,0,0), P0[6],P0[7],P0[8],P0[9],     pw0[2]=PKW(P0,4), pw0[3]=PKW(P0,6), pw0); \
    VRD(1); SBAR(); GAPA(C0=__builtin_amdgcn_mfma_f32_32x32x16_bf16(kf[2],qr[1],C0,0,0,0),   P0[10],P0[11],P0[12],P0[13], pw1[0]=PKW(P0,8), pw1[1]=PKW(P0,10), pw1); \
    VRD(5); SBAR(); GAPA(C1=__builtin_amdgcn_mfma_f32_32x32x16_bf16(kf[3],qr[1],C1,0,0,0),   P0[14],P0[15],P1[0],P1[1],   pw1[2]=PKW(P0,12),pw1[3]=PKW(P0,14), pw1); \
    VRD(2); SBAR(); GAPA(C0=__builtin_amdgcn_mfma_f32_32x32x16_bf16(kf[4],qr[2],C0,0,0,0),   P1[2],P1[3],P1[4],P1[5],     pw2[0]=PKW(P1,0), pw2[1]=PKW(P1,2), pw2); \
    VRD(6); SBAR(); GAPA(C1=__builtin_amdgcn_mfma_f32_32x32x16_bf16(kf[5],qr[2],C1,0,0,0),   P1[6],P1[7],P1[8],P1[9],     pw2[2]=PKW(P1,4), pw2[3]=PKW(P1,6), pw2); \
    VRD(3); SBAR(); GAPA(C0=__builtin_amdgcn_mfma_f32_32x32x16_bf16(kf[6],qr[3],C0,0,0,0),   P1[10],P1[11],P1[12],P1[13], pw3[0]=PKW(P1,8), pw3[1]=PKW(P1,10), pw3); \
    VRD(7); SBAR(); GAPA(C1=__builtin_amdgcn_mfma_f32_32x32x16_bf16(kf[7],qr[3],C1,0,0,0),   P1[14],P1[15],0.f,0.f,       pw3[2]=PKW(P1,12),pw3[3]=PKW(P1,14), pw3); \
    l_reg+=sacc; \
    if(GK){DMA_K((t)+3,sl_cur);} if(GV){DMA_V((t)+1,sl_next);} \
    CBLD(t); CMASK(C0,C1,t); \
    { float a=MX3(C0[0],C0[1],C1[0]),b=MX3(C0[2],C0[3],C1[1]); a=MX3(a,C1[2],C1[3]); \
      _Pragma("unroll") for(int r=4;r<16;r+=4){a=MX3(a,C0[r],C0[r+1]);b=MX3(b,C0[r+2],C0[r+3]);a=MX3(a,C1[r],C1[r+1]);b=MX3(b,C1[r+2],C1[r+3]);} \
      float rm=__builtin_fmaxf(a,b); { auto rr=__builtin_amdgcn_permlane32_swap(__float_as_uint(rm),__float_as_uint(rm),false,false); rm=__builtin_fmaxf(__uint_as_float(rr[0]),__uint_as_float(rr[1])); } rm=rm-clast-mm; \
      resc=false; \
      if(__builtin_expect(__any(rm>(float)THRL),0)){ const float dl=__builtin_fmaxf(rm,0.f); mhat+=dl; \
        mm+=dl; \
        const float f=__builtin_amdgcn_exp2f(-dl); l_reg*=f; if(hi==0)wsf[r32]=f; resc=true; } } \
    SBAR(); \
    GAPB(o[0]=__builtin_amdgcn_mfma_f32_32x32x16_bf16(PAF(0),VFR(0),o[0],0,0,0), C0,0,cbA[0]); \
    GAPB(o[1]=__builtin_amdgcn_mfma_f32_32x32x16_bf16(PAF(0),VFR(4),o[1],0,0,0), C0,4,cbA[1]); \
    KRD(GL,0); GAPB(o[0]=__builtin_amdgcn_mfma_f32_32x32x16_bf16(PAF(1),VFR(1),o[0],0,0,0), C0,8,cbA[2]); \
    KRD(GL,1); GAPB(o[1]=__builtin_amdgcn_mfma_f32_32x32x16_bf16(PAF(1),VFR(5),o[1],0,0,0), C0,12,cbA[3]); \
    KRD(GL,2); GAPB(o[0]=__builtin_amdgcn_mfma_f32_32x32x16_bf16(PAF(2),VFR(2),o[0],0,0,0), C1,0,cbB[0]); \
    KRD(GL,3); GAPB(o[1]=__builtin_amdgcn_mfma_f32_32x32x16_bf16(PAF(2),VFR(6),o[1],0,0,0), C1,4,cbB[1]); \
    GAPB(o[0]=__builtin_amdgcn_mfma_f32_32x32x16_bf16(PAF(3),VFR(3),o[0],0,0,0), C1,8,cbB[2]); \
    GAPB(o[1]=__builtin_amdgcn_mfma_f32_32x32x16_bf16(PAF(3),VFR(7),o[1],0,0,0), C1,12,cbB[3]); \
    }while(0)
  int t=1;
  #undef CMASK
  #define CMASK(P0,P1,t) do{}while(0)
  for(;t+5<NT;t+=2){
    STEP(pB0,pB1,pA0,pA1,t,true,true,true);     WAIT_BAR(2); RESC(); ROT();
    STEP(pA0,pA1,pB0,pB1,t+1,true,true,true);   WAIT_BAR(2); RESC(); ROT();
  }
  #undef CMASK
  #define CMASK(P0,P1,t) do{int jb_=(t)-(NT-4); if(band&&jb_>=0)cmask(P0,P1,jb_,qrel,hi);}while(0)
  #define ENDW(tt) do{ if((tt)+3<NT){WAIT_BAR(2);} else if((tt)+2<NT){WAIT_BAR(1);} else {WAIT_BAR(0);} }while(0)
  for(;t+1<NT;t+=2){
    STEP(pB0,pB1,pA0,pA1,t,(t+3<NT),(t+1<NT),(t+1<NT));       ENDW(t);   RESC(); ROT();
    STEP(pA0,pA1,pB0,pB1,t+1,(t+4<NT),(t+2<NT),(t+2<NT));     ENDW(t+1); RESC(); ROT();
  }
  STEP(pB0,pB1,pA0,pA1,NT-1,false,false,false); RESC();
  { float sacc=pB0[0]+pB0[1]; _Pragma("unroll") for(int r=2;r<16;++r)sacc+=pB0[r]; _Pragma("unroll") for(int r=0;r<16;++r)sacc+=pB1[r]; l_reg+=sacc;
    pw0=(u32x4){PKW(pB0,0),PKW(pB0,2),PKW(pB0,4),PKW(pB0,6)};pw1=(u32x4){PKW(pB0,8),PKW(pB0,10),PKW(pB0,12),PKW(pB0,14)};pw2=(u32x4){PKW(pB1,0),PKW(pB1,2),PKW(pB1,4),PKW(pB1,6)};pw3=(u32x4){PKW(pB1,8),PKW(pB1,10),PKW(pB1,12),PKW(pB1,14)};
    SBAR(); pv(o,vb0+sl_cur,PAF(0),PAF(1),PAF(2),PAF(3)); }
  #undef PKW
  #undef PAF
  #undef VFR
  #undef PIN
  #undef MX3
  #undef GAPA
  #undef GAPB
  #undef EX
  #undef VRD
  #undef KRD
  #undef STEP
  #undef ENDW
  {auto rr=__builtin_amdgcn_permlane32_swap(__float_as_uint(l_reg),__float_as_uint(l_reg),false,false);l_reg=__uint_as_float(rr[0])+__uint_as_float(rr[1]);}
  if(hi==0)wsf[32+r32]=l_reg;asm volatile("s_waitcnt lgkmcnt(0)":::"memory");
  float rli[16];
  if(split){
    float*Pm=PART+(size_t)part*PART_F; const float*Po=PART+(size_t)(1-part)*PART_F;
    #pragma unroll
    for(int r=0;r<16;++r){
      #pragma unroll
      for(int d0=0;d0<2;++d0)Pm[(wid*QBLK+crow(r,hi))*64+d0*32+r32]=o[d0][r];}
    if(hi==0){Pm[QB*64+(wid*QBLK+r32)*2]=mm+cq;Pm[QB*64+(wid*QBLK+r32)*2+1]=l_reg;wsf[r32]=mm+cq;}
    asm volatile("s_waitcnt vmcnt(0) lgkmcnt(0)\n\ts_barrier":::"memory");
    if(tid==0){ __builtin_amdgcn_fence(__ATOMIC_RELEASE,"agent"); asm volatile("s_waitcnt vmcnt(0)":::"memory");
      *(volatile __attribute__((address_space(3))) unsigned*)((__attribute__((address_space(3))) char*)shm+LDS_OST)=__hip_atomic_fetch_add(flag,1u,__ATOMIC_RELAXED,__HIP_MEMORY_SCOPE_AGENT); }
    asm volatile("s_waitcnt vmcnt(0) lgkmcnt(0)\n\ts_barrier":::"memory");
    const unsigned old=*(volatile __attribute__((address_space(3))) unsigned*)((__attribute__((address_space(3))) char*)shm+LDS_OST);
    asm volatile("s_waitcnt lgkmcnt(0)\n\ts_barrier":::"memory");
    if(old==0u)return;
    __builtin_amdgcn_fence(__ATOMIC_ACQUIRE,"agent"); asm volatile("s_waitcnt vmcnt(0)":::"memory");
    #pragma unroll
    for(int r=0;r<16;++r){ const int row=crow(r,hi); const float mo=wsf[row],lo=wsf[32+row],mt=Po[QB*64+(wid*QBLK+row)*2],lt=Po[QB*64+(wid*QBLK+row)*2+1];
      const float m=__builtin_fmaxf(mo,mt),fo=__builtin_amdgcn_exp2f(mo-m),ft=__builtin_amdgcn_exp2f(mt-m),inv=__builtin_amdgcn_rcpf(lo*fo+lt*ft);
      #pragma unroll
      for(int d0=0;d0<2;++d0)o[d0][r]=(o[d0][r]*fo+Po[(wid*QBLK+row)*64+d0*32+r32]*ft)*inv;
      rli[r]=1.f; }
  } else {
  #pragma unroll
  for(int r=0;r<16;++r)rli[r]=__builtin_amdgcn_rcpf(wsf[32+crow(r,hi)]);
  }
  bf16*Ow=O+(rowbase+q0+wid*QBLK)*OPITCH+h*D;
  { bf16*stg=(bf16*)(shm+LDS_OST)+wid*2048;
    #pragma unroll
    for(int r=0;r<16;++r){const int orow=crow(r,hi);
      #pragma unroll
      for(int d0=0;d0<2;++d0)stg[orow*64+d0*32+r32]=__float2bfloat16(o[d0][r]*rli[r]);}
    asm volatile("s_waitcnt lgkmcnt(0)":::"memory");
    #pragma unroll
    for(int i=0;i<4;++i){const int row=i*8+(lane>>3),ch=lane&7; const u32x4 v=*(const u32x4*)(stg+row*64+ch*8); ATTN_STORE16(Ow+(long)row*OPITCH+ch*8,v);} }
  asm volatile("s_waitcnt lgkmcnt(0)\n\ts_barrier":::"memory");
  #undef CBIAS
  #undef CBLD
  #undef DMA_K
  #undef DMA_V
  #undef CMASK
  #undef START
  #undef RESC
  #undef ROT
}
constexpr int ATTN_LDS_BYTES=LDS_BYTES;
struct AttnTensors { const bf16* Q; const bf16* K; const bf16* V; bf16* O; const float* CF; const float* stat; };
struct AttnUnit { int bh; int qb; };
struct StaticOrder {
  int vcu;
  __device__ __forceinline__ explicit StaticOrder(int grid,int block):vcu((grid%8==0)?(block%8)*(grid/8)+block/8:block),G_(grid){}
  int G_;
  __device__ __forceinline__ bool next(int i,AttnUnit&u)const{ const int v=vcu+(i>>1)*G_; if(v>=256)return false; const int s=v&15; u.bh=v>>4; u.qb=(i&1)?31-s:s; return true; }
  __device__ __forceinline__ void a_ready(const AttnUnit&)const{}
  __device__ __forceinline__ void done(const AttnUnit&)const{}
};
struct QueueOrder {
  unsigned* ctr; __attribute__((address_space(3))) unsigned* slot;
  __device__ __forceinline__ bool next(int,AttnUnit&u)const{
    if(threadIdx.x==0)*slot=__hip_atomic_fetch_add(ctr,1u,__ATOMIC_RELAXED,__HIP_MEMORY_SCOPE_AGENT);
    asm volatile("s_waitcnt vmcnt(0) lgkmcnt(0)\n\ts_barrier":::"memory");
    const unsigned v=*(volatile __attribute__((address_space(3))) unsigned*)slot; const int vv=__builtin_amdgcn_readfirstlane((int)v);
    if(vv>=512)return false; u.qb=31-(vv>>4); u.bh=vv&15; return true; }
  __device__ __forceinline__ void a_ready(const AttnUnit&)const{}
  __device__ __forceinline__ void done(const AttnUnit&)const{}
};
template<class Sched,int THRL=8> __device__ __forceinline__ void attn_phase(char*lds,const AttnTensors&T,const Sched&S){
  AttnUnit u;
  for(int i=0;S.next(i,u);++i){ S.a_ready(u); const float Tsk=40.f+2.f*__builtin_sqrtf(T.stat[u.bh*2]*T.stat[u.bh*2+1])*1.01f+1.f;
    attn_unit<THRL>(u.bh/NHEAD,u.bh%NHEAD,u.qb,T.Q,T.K,T.V,T.O,T.CF+(long)u.bh*SEQ,Tsk,0,nullptr,nullptr,lds); S.done(u); }
}
#undef SBAR
#undef WAIT_BAR
}
#define GAS __attribute__((address_space(1)))
#define LAS __attribute__((address_space(3)))
typedef unsigned v4u __attribute__((ext_vector_type(4)));
typedef float f32x4 __attribute__((ext_vector_type(4)));
typedef short bf16x8 __attribute__((ext_vector_type(8)));
typedef GAS unsigned gu32;
typedef GAS unsigned long long gu64;
#define RLX_AGENT __ATOMIC_RELAXED, __HIP_MEMORY_SCOPE_AGENT
#define LDS_WAIT() asm volatile("s_waitcnt lgkmcnt(0)" ::: "memory")
#define VM_WAIT() asm volatile("s_waitcnt vmcnt(0)" ::: "memory")
__device__ __forceinline__ unsigned long long rt() { return __builtin_amdgcn_s_memrealtime(); }
__device__ __forceinline__ unsigned pk2(float lo, float hi) { return (unsigned)f2bf(lo) | ((unsigned)f2bf(hi) << 16); }

#define XB_TMO      128
#define XB_XCNT(j)  (256  + 64 * (j))
#define XB_XSUB(j)  (1280 + 64 * (j))
#define XB_XGEN(j)  (2304 + 64 * (j))
#define XB_TOP      3328
#define XB_TOPGEN   3392
#define XCD_BAR_WORDS 3456
#define XB_SPIN_CAP (1u << 18)

__device__ __forceinline__ unsigned xb_ld(unsigned* p)              { return __hip_atomic_load(p, __ATOMIC_RELAXED, __HIP_MEMORY_SCOPE_AGENT); }
__device__ __forceinline__ unsigned xb_add(unsigned* p, unsigned v) { return __hip_atomic_fetch_add(p, v, __ATOMIC_RELAXED, __HIP_MEMORY_SCOPE_AGENT); }
__device__ __forceinline__ unsigned xb_xcc_id() { return (unsigned)__builtin_amdgcn_s_getreg((3 << 11) | 20) & 0xFu; }
#define XB_SPIN(cond, bar) do { unsigned _sp = 0; while (cond) { __builtin_amdgcn_s_sleep(1); \
    if ((++_sp & 255u) == 0u) { if (xb_ld(&(bar)[XB_TMO])) break; if (_sp > XB_SPIN_CAP) { atomicAdd(&(bar)[XB_TMO], 1u); break; } } } } while (0)

struct XcdBarrier {
    unsigned* bar; unsigned x;
    volatile LAS unsigned* st;
};

__device__ __forceinline__ XcdBarrier xcd_barrier_post(unsigned* bar, volatile LAS unsigned* st) {
    XcdBarrier b; b.bar = bar; b.x = xb_xcc_id(); b.st = st;
    if (threadIdx.x == 0) (void)xb_add(&bar[XB_XCNT(b.x)], 1u);
    return b;
}
__device__ __forceinline__ void xcd_barrier_complete(unsigned* bar, unsigned x, unsigned& nloc, unsigned& nx) {
    const unsigned G = gridDim.x * gridDim.y * gridDim.z;
    unsigned sum, cnt, mine, sp = 0u;
    for (;;) {
        sum = 0u; cnt = 0u; mine = 0u;
#pragma unroll
        for (unsigned j = 0; j < 16; ++j) { const unsigned c = xb_ld(&bar[XB_XCNT(j)]); sum += c; cnt += (c > 0u) ? 1u : 0u; mine = (j == x) ? c : mine; }
        if (sum == G) break;
        __builtin_amdgcn_s_sleep(1);
        if ((++sp & 255u) == 0u) { if (xb_ld(&bar[XB_TMO])) break; if (sp > XB_SPIN_CAP) { atomicAdd(&bar[XB_TMO], 1u); break; } }
    }
    nloc = mine > 0u ? mine : 1u; nx = cnt > 0u ? cnt : 1u;
}

__device__ __forceinline__ void xcd_barrier(const XcdBarrier& b) {
    asm volatile("s_waitcnt vmcnt(0)" ::: "memory");
    __syncthreads();
    if (threadIdx.x == 0) {
        unsigned* bar = b.bar;
        __builtin_amdgcn_s_waitcnt(0);
        unsigned nloc = b.st[0], nx = b.st[1];
        if (nloc == 0u) { xcd_barrier_complete(bar, b.x, nloc, nx); b.st[0] = nloc; b.st[1] = nx; }
        const unsigned old = xb_add(&bar[XB_XSUB(b.x)], 1u);
        const unsigned gen = old / nloc;
        if (old + 1u == (gen + 1u) * nloc) {
            __builtin_amdgcn_fence(__ATOMIC_RELEASE, "agent");
            asm volatile("s_waitcnt vmcnt(0)" ::: "memory");
            const unsigned og = xb_add(&bar[XB_TOP], 1u);
            const unsigned tg = og / nx;
            if (og + 1u == (tg + 1u) * nx) xb_add(&bar[XB_TOPGEN], 1u);
            else XB_SPIN(xb_ld(&bar[XB_TOPGEN]) == tg, bar);
            __builtin_amdgcn_fence(__ATOMIC_ACQUIRE, "agent");
            xb_add(&bar[XB_XGEN(b.x)], 1u);
            asm volatile("s_waitcnt vmcnt(0)" ::: "memory");
        } else {
            XB_SPIN(xb_ld(&bar[XB_XGEN(b.x)]) == gen, bar);
            __builtin_amdgcn_fence(__ATOMIC_ACQUIRE, "agent");
            asm volatile("s_waitcnt vmcnt(0)" ::: "memory");
        }
    }
    __syncthreads();
}
constexpr int NWAVES = 8, NTHR = 512;
constexpr int RING_OFF = 0, RING_BYTES = 131072, LDSCTL_OFF = RING_BYTES, MISC_OFF = LDSCTL_OFF + 320, LDS_BYTES = 147456;
constexpr int CW_BAR = 4096;
constexpr size_t WS_WIN = WS_W  , WS_SWIN = WS_W + 8 * MiB  , WS_WOUT = WS_W + 14 * MiB  , WS_WDGU = WS_W + 18 * MiB  , WS_SWDGU = WS_W + 24 * MiB  , WS_WDDN = WS_W + 29 * MiB  ;
constexpr size_t WS_SH = WS_H + 16 * MiB  , WS_SXG = WS_XG + 34 * MiB  ;
constexpr size_t WS_WMGU = WS_W  , WS_SWMGU = WS_W + 60 * MiB  , WS_WMDN = WS_W + 64 * MiB  ;
static_assert(WS_WMDN + 56 * MiB <= 469 * MiB, "ws");
struct MArgs { const float* in[20]; float* out; unsigned char* ws; int ph_lo, ph_hi; };
enum { I_X = 0, I_ATTN_NORM, I_W_IN, I_HGRN_LB, I_HGRN_NORM, I_MLSTM_CONV, I_MLSTM_BI, I_MLSTM_BF, I_MLSTM_NORM, I_FOX_BF, I_W_OUT, I_FFN_NORM, I_DGATE, I_DUP, I_DDOWN, I_ROUTER, I_MGATE, I_MUP, I_MDOWN, I_FINAL_NORM };

__device__ __forceinline__ void tr_item(const float* W, int ldw, int K, bf16_t* WT, LAS float* scr, int k0, int lane) {
#pragma unroll 32
    for (int i = 0; i < 32; ++i) { const int kk = 2 * i + (lane >> 5); scr[kk * 33 + (lane & 31)] = W[(size_t)(k0 + kk) * ldw + (lane & 31)]; }
    LDS_WAIT(); asm volatile("" ::: "memory");
    const int c = lane & 7;
#pragma unroll
    for (int j = 0; j < 4; ++j) { const int n = (lane >> 3) + 8 * j; const LAS float* s = scr + (8 * c) * 33 + n;
        v4u o; o.x = pk2(s[0 * 33], s[1 * 33]); o.y = pk2(s[2 * 33], s[3 * 33]); o.z = pk2(s[4 * 33], s[5 * 33]); o.w = pk2(s[6 * 33], s[7 * 33]);
        *(GAS v4u*)(WT + (size_t)n * K + k0 + 8 * c) = o; }
    LDS_WAIT(); asm volatile("" ::: "memory");
}
__device__ __forceinline__ void tr_item_f8(const float* W, int ldw, int K, unsigned char* WT8, LAS float* scr, int k0, int lane) {
#pragma unroll 8
    for (int i = 0; i < 32; ++i) { const int kk = 2 * i + (lane >> 5); scr[kk * 33 + (lane & 31)] = W[(size_t)(k0 + kk) * ldw + (lane & 31)]; }
    LDS_WAIT(); asm volatile("" ::: "memory");
    const int c = lane & 7;
#pragma unroll
    for (int j = 0; j < 4; ++j) { const int n = (lane >> 3) + 8 * j; const LAS float* s = scr + (8 * c) * 33 + n; float h[8];
#pragma unroll
        for (int i = 0; i < 8; ++i) h[i] = __builtin_fminf(__builtin_fmaxf(s[i * 33] * pg8::F8_WSCALE, -448.f), 448.f);
        unsigned w0 = 0u, w1 = 0u; w0 = __builtin_amdgcn_cvt_pk_fp8_f32(h[0], h[1], w0, false); w0 = __builtin_amdgcn_cvt_pk_fp8_f32(h[2], h[3], w0, true);
        w1 = __builtin_amdgcn_cvt_pk_fp8_f32(h[4], h[5], w1, false); w1 = __builtin_amdgcn_cvt_pk_fp8_f32(h[6], h[7], w1, true);
        typedef unsigned u32x2_ __attribute__((ext_vector_type(2))); *(GAS u32x2_*)(WT8 + (size_t)n * K + k0 + 8 * c) = (u32x2_){w0, w1}; }
    LDS_WAIT(); asm volatile("" ::: "memory");
}
__device__ __forceinline__ int glu_row(int c, int up) { return (c >> 7) * 256 + (c & 127) + up * 128; }

struct RowIn { float4 v[4]; };
template <bool BF> __device__ __forceinline__ void mrow_load(RowIn& R, const void* src, int row, int lane) {
    if (BF) { const uint2* xr = (const uint2*)((const bf16_t*)src + (size_t)row * D) + lane;
#pragma unroll
        for (int j = 0; j < 4; ++j) { const uint2 w = xr[64 * j]; R.v[j] = make_float4(__uint_as_float(w.x << 16), __uint_as_float(w.x & 0xffff0000u), __uint_as_float(w.y << 16), __uint_as_float(w.y & 0xffff0000u)); } }
    else { const float4* xr = (const float4*)((const float*)src + (size_t)row * D) + lane;
#pragma unroll
        for (int j = 0; j < 4; ++j) R.v[j] = xr[64 * j]; } }
template <int MODE> __device__ __forceinline__ void mrow(const RowIn& R, signed char* H8, float* SH, const float* gain, const LAS float* tab, float* G, int row, int lane, float (&lg)[8]) {
    float4 v[4]; float ss = 0.f;
#pragma unroll
    for (int j = 0; j < 4; ++j) { v[j] = R.v[j]; ss += v[j].x * v[j].x + v[j].y * v[j].y + v[j].z * v[j].z + v[j].w * v[j].w; }
    ss = wave_sum(ss);
    const float r = rsqrtf(ss * (1.f / D) + EPS);
    float h[16];
#pragma unroll
    for (int j = 0; j < 4; ++j) { const float4 g = *((const float4*)gain + 64 * j + lane);
        h[4 * j + 0] = v[j].x * r * g.x; h[4 * j + 1] = v[j].y * r * g.y; h[4 * j + 2] = v[j].z * r * g.z; h[4 * j + 3] = v[j].w * r * g.w; }
    { float am = 0.f;
#pragma unroll
      for (int i = 0; i < 16; ++i) am = fmaxf(am, fabsf(h[i]));
#pragma unroll
      for (int o = 1; o < 64; o <<= 1) am = fmaxf(am, __shfl_xor(am, o));
      const float inv = am > 0.f ? 127.f / am : 0.f;
#pragma unroll
      for (int j = 0; j < 4; ++j) { const int q0 = (int)rintf(h[4 * j] * inv), q1 = (int)rintf(h[4 * j + 1] * inv), q2 = (int)rintf(h[4 * j + 2] * inv), q3 = (int)rintf(h[4 * j + 3] * inv);
          *((unsigned*)(H8 + (size_t)row * D) + 64 * j + lane) = (unsigned)(q0 & 255) | ((unsigned)(q1 & 255) << 8) | ((unsigned)(q2 & 255) << 16) | ((unsigned)(q3 & 255) << 24); }
      if (lane == 0) SH[row] = am > 0.f ? am * (1.f / 127.f) : 1.f; }
    if (MODE == 0) {
        float mine = 0.f;
#pragma unroll 2
        for (int c = 0; c < 16; ++c) { float s = 0.f;
#pragma unroll
            for (int j = 0; j < 4; ++j) { const f32x4 w = *(const LAS f32x4*)(tab + c * 1024 + 256 * j + 4 * lane); s += h[4 * j] * w[0] + h[4 * j + 1] * w[1] + h[4 * j + 2] * w[2] + h[4 * j + 3] * w[3]; }
            s = wave_sum(s); if (lane == c) mine = s; }
        if (lane < 16) G[(size_t)row * GW + lane] = mine;
    }
    if (MODE == 2) {
        float v0 = -INFINITY, v1 = -INFINITY; int e0 = 0, e1 = 0;
#pragma unroll 2
        for (int c = 0; c < 8; ++c) { float s = 0.f;
#pragma unroll
            for (int j = 0; j < 4; ++j) { const f32x4 w = *(const LAS f32x4*)(tab + c * 1024 + 256 * j + 4 * lane); s += h[4 * j] * w[0] + h[4 * j + 1] * w[1] + h[4 * j + 2] * w[2] + h[4 * j + 3] * w[3]; }
            s = wave_sum(s);
            if (s > v0) { v1 = v0; e1 = e0; v0 = s; e0 = c; } else if (s > v1) { v1 = s; e1 = c; } }
        lg[0] = v0; lg[1] = v1; lg[2] = __int_as_float(e0); lg[3] = __int_as_float(e1);
    }
}
__device__ __forceinline__ void load_gate_tab(LAS float* tab, const float* w_in, int tid) {
    for (int k = tid; k < D; k += NTHR) { const float4* w0 = (const float4*)(w_in + (size_t)k * DIN + 1792); const float4* w1 = (const float4*)(w_in + (size_t)k * DIN + 3592);
        const float4 a0 = w0[0], a1 = w0[1], b0 = w1[0], b1 = w1[1];
        tab[0 * 1024 + k] = a0.x; tab[1 * 1024 + k] = a0.y; tab[2 * 1024 + k] = a0.z; tab[3 * 1024 + k] = a0.w; tab[4 * 1024 + k] = a1.x; tab[5 * 1024 + k] = a1.y; tab[6 * 1024 + k] = a1.z; tab[7 * 1024 + k] = a1.w;
        tab[8 * 1024 + k] = b0.x; tab[9 * 1024 + k] = b0.y; tab[10 * 1024 + k] = b0.z; tab[11 * 1024 + k] = b0.w; tab[12 * 1024 + k] = b1.x; tab[13 * 1024 + k] = b1.y; tab[14 * 1024 + k] = b1.z; tab[15 * 1024 + k] = b1.w; }
}
__device__ __forceinline__ void load_router_tab(LAS float* tab, const float* router, int tid) {
    for (int k = tid; k < D; k += NTHR) { const float4* w0 = (const float4*)(router + (size_t)k * NE); const float4 a0 = w0[0], a1 = w0[1];
        tab[0 * 1024 + k] = a0.x; tab[1 * 1024 + k] = a0.y; tab[2 * 1024 + k] = a0.z; tab[3 * 1024 + k] = a0.w; tab[4 * 1024 + k] = a1.x; tab[5 * 1024 + k] = a1.y; tab[6 * 1024 + k] = a1.z; tab[7 * 1024 + k] = a1.w; }
}
struct Conv8Job { const float* W; int ldw; signed char* WT8; float* S; };
__device__ __forceinline__ void conv8_load(float (&v)[64], const Conv8Job& j, int tid, int wave) {
    const int lane = tid & 63, n = lane & 31, kp = lane >> 5;
#pragma unroll
    for (int i = 0; i < 64; ++i) v[i] = j.W[(size_t)(128 * wave + 2 * i + kp) * j.ldw + n];
}
__device__ __forceinline__ void conv8_stage(const float (&v)[64], LAS float* img, LAS float* pm, int tid, int wave) {
    const int lane = tid & 63, n = lane & 31, kp = lane >> 5; float m = 0.f;
#pragma unroll
    for (int i = 0; i < 64; ++i) { img[(128 * wave + 2 * i + kp) * 32 + n] = v[i]; m = fmaxf(m, fabsf(v[i])); }
    m = fmaxf(m, __shfl_xor(m, 32));
    if (lane < 32) pm[wave * 32 + lane] = m;
    __syncthreads();
}
__device__ __forceinline__ void conv8_quant(const Conv8Job& j, LAS float* img, LAS float* pm, int tid, int wave) {
    const int lane = tid & 63, no = lane >> 1, kh = 128 * wave + 64 * (lane & 1);
    float cm = 0.f;
#pragma unroll
    for (int w = 0; w < 8; ++w) cm = fmaxf(cm, pm[w * 32 + no]);
    const float inv = cm > 0.f ? 127.f / cm : 0.f;
    if (wave == 0 && (lane & 1) == 0) j.S[no] = cm > 0.f ? cm * (1.f / 127.f) : 1.f;
    const LAS float* sp = img + kh * 32 + no;
#pragma unroll
    for (int q = 0; q < 4; ++q) { unsigned wq[4];
#pragma unroll
        for (int jj = 0; jj < 4; ++jj) { const int kk = 16 * q + 4 * jj; const int q0 = (int)rintf(sp[kk * 32] * inv), q1 = (int)rintf(sp[(kk + 1) * 32] * inv), q2 = (int)rintf(sp[(kk + 2) * 32] * inv), q3 = (int)rintf(sp[(kk + 3) * 32] * inv);
            wq[jj] = (unsigned)(q0 & 255) | ((unsigned)(q1 & 255) << 8) | ((unsigned)(q2 & 255) << 16) | ((unsigned)(q3 & 255) << 24); }
        v4u o; o.x = wq[0]; o.y = wq[1]; o.z = wq[2]; o.w = wq[3];
        *(GAS v4u*)(j.WT8 + (size_t)no * 1024 + kh + 16 * q) = o; }
    __syncthreads();
}
namespace scan {
typedef short bf16x8 __attribute__((ext_vector_type(8)));
typedef float f32x4 __attribute__((ext_vector_type(4)));
typedef unsigned v2u __attribute__((ext_vector_type(2)));
constexpr int TS = 144, TB = 64 * TS;
constexpr int L_T0 = 0, L_T1 = TB, L_T2 = 2 * TB, L_T3 = 3 * TB, L_T4 = 4 * TB, L_T5 = 5 * TB, L_O = 6 * TB, OS = 68  , L_PART = L_O + 64 * OS * 4, L_VEC = L_PART + 8 * 64 * 4, L_END = L_VEC + 8 * 64 * 4;
static_assert(L_END <= RING_BYTES, "scan LDS");
constexpr size_t SC_LHG = 0, SC_LML = 16 * MiB, SC_DEC = 32 * MiB  , SC_NL = 32 * MiB + 256 * 1024  , SC_AMAX = 32 * MiB + 512 * 1024, SC_BEND = SC_AMAX + 4096, SC_MPREV = SC_BEND + 4096;

__device__ __forceinline__ float wave_incl_add(float v, int lane) {
#pragma unroll
    for (int o = 1; o < 64; o <<= 1) { const float u = __shfl_up(v, o); if (lane >= o) v += u; }
    return v;
}
__device__ __forceinline__ float wave_incl_max(float v, int lane) {
#pragma unroll
    for (int o = 1; o < 64; o <<= 1) { const float u = __shfl_up(v, o); if (lane >= o) v = fmaxf(v, u); }
    return v;
}
__device__ __forceinline__ float wave_max(float v) {
#pragma unroll
    for (int o = 1; o < 64; o <<= 1) v = fmaxf(v, __shfl_xor(v, o));
    return v;
}
__device__ __forceinline__ f32x4 mma64(LAS const unsigned char* A, LAS const unsigned char* B, int m0, int n0, int lane, f32x4 acc) {
    const int r = lane & 15, kq = lane >> 4;
#pragma unroll
    for (int ks = 0; ks < 2; ++ks) {
        const bf16x8 a = *(LAS const bf16x8*)(A + (m0 + r) * TS + kq * 16 + ks * 64);
        const bf16x8 b = *(LAS const bf16x8*)(B + (n0 + r) * TS + kq * 16 + ks * 64);
        acc = __builtin_amdgcn_mfma_f32_16x16x32_bf16(a, b, acc, 0, 0, 0);
    }
    return acc;
}
__device__ __forceinline__ v4u pack8(const float (&v)[8]) { v4u w; w.x = pk2(v[0], v[1]); w.y = pk2(v[2], v[3]); w.z = pk2(v[4], v[5]); w.w = pk2(v[6], v[7]); return w; }
__device__ __forceinline__ v4u pack8h(const bf16_t (&v)[8]) { v4u w; w.x = v[0] | ((unsigned)v[1] << 16); w.y = v[2] | ((unsigned)v[3] << 16); w.z = v[4] | ((unsigned)v[5] << 16); w.w = v[6] | ((unsigned)v[7] << 16); return w; }
__device__ __forceinline__ void st16(LAS unsigned char* p, float v) { *(LAS bf16_t*)p = f2bf(v); }
__device__ __forceinline__ void load_state_tile(LAS unsigned char* T, const float* S, int tid) {
    const int v = tid >> 3, d0 = (tid & 7) * 8; const float4 x0 = *(const float4*)(S + v * 64 + d0), x1 = *(const float4*)(S + v * 64 + d0 + 4);
    v4u w; w.x = pk2(x0.x, x0.y); w.y = pk2(x0.z, x0.w); w.z = pk2(x1.x, x1.y); w.w = pk2(x1.z, x1.w);
    *(LAS v4u*)(T + v * TS + d0 * 2) = w;
}
__device__ __forceinline__ void local_state_mma_store(LAS unsigned char* L, float* LT, int wave, int lane) {
    const int mt = wave >> 1;
#pragma unroll
    for (int nn = 0; nn < 2; ++nn) { const int nt = 2 * (wave & 1) + nn; f32x4 acc = {0.f, 0.f, 0.f, 0.f};
        acc = mma64(L + L_T1, L + L_T0, mt * 16, nt * 16, lane, acc);
#pragma unroll
        for (int r = 0; r < 4; ++r) LT[(mt * 16 + 4 * (lane >> 4) + r) * 64 + nt * 16 + (lane & 15)] = acc[r]; }
}

struct HgIn { bf16_t fz[8], q[8], iv[8]; v4u gate; float4 s0, s1; };
template <bool DPH> __device__ __forceinline__ void hgrn_load(HgIn& R, const bf16_t* P, int b, int c, int h, const float* ST, int tid, int wave) {
    const int d = tid & 63, tq = wave, row0 = b * SEQ + c * 64; const bf16_t* pr = P + (size_t)(row0 + 8 * tq) * PW + h * 64 + d;
#pragma unroll
    for (int i = 0; i < 8; ++i) { R.fz[i] = pr[(size_t)i * PW + P_HF]; R.iv[i] = pr[(size_t)i * PW + P_HI]; if (DPH) R.q[i] = pr[(size_t)i * PW + P_HQ]; }
    if (DPH) { const int t = tid >> 3, v0 = (tid & 7) * 8; R.gate = *(const v4u*)(P + (size_t)(row0 + t) * PW + P_HG + h * 64 + v0);
        R.s0 = *(const float4*)(ST + t * 64 + v0); R.s1 = *(const float4*)(ST + t * 64 + v0 + 4); }
}
struct MlIn { bf16_t qr[11], kr[11], vv[8]; float ig, fg, np, mprev; v4u gate; float4 s0, s1; };
template <bool DPH> __device__ __forceinline__ void mlstm_load(MlIn& R, const bf16_t* P, const float* G, int b, int c, int h, const float* CT, const float* NP, const float* MP, int tid, int wave) {
    const int d = tid & 63, tq = wave, lane = tid & 63, row0 = b * SEQ + c * 64; const bool fz3 = (c == 0 && tq == 0);
    const bf16_t* pk = P + (size_t)(row0 + 8 * tq) * PW + P_MK + h * 64 + d; const bf16_t* pq = P + (size_t)(row0 + 8 * tq) * PW + P_MQ + h * 64 + d;
#pragma unroll
    for (int j = 0; j < 11; ++j) { R.kr[j] = (j < 3 && fz3) ? (bf16_t)0 : pk[((long)j - 3) * PW]; if (DPH) R.qr[j] = (j < 3 && fz3) ? (bf16_t)0 : pq[((long)j - 3) * PW]; }
#pragma unroll
    for (int i = 0; i < 8; ++i) R.vv[i] = P[(size_t)(row0 + 8 * tq + i) * PW + P_MV + h * 64 + d];
    R.ig = G[(size_t)(row0 + lane) * GW + h]; R.fg = G[(size_t)(row0 + lane) * GW + 4 + h];
    if (DPH) { const int t = tid >> 3, v0 = (tid & 7) * 8; R.gate = *(const v4u*)(P + (size_t)(row0 + t) * PW + P_MO + h * 64 + v0);
        R.s0 = *(const float4*)(CT + t * 64 + v0); R.s1 = *(const float4*)(CT + t * 64 + v0 + 4); R.np = NP[lane]; R.mprev = MP[0]; }
}
__device__ __forceinline__ void store_state_tile(LAS unsigned char* T, const float4& x0, const float4& x1, int tid) {
    const int v = tid >> 3, d0 = (tid & 7) * 8; v4u w; w.x = pk2(x0.x, x0.y); w.y = pk2(x0.z, x0.w); w.z = pk2(x1.x, x1.y); w.w = pk2(x1.z, x1.w);
    *(LAS v4u*)(T + v * TS + d0 * 2) = w;
}
__device__ __forceinline__ void conv_silu8r(const bf16_t (&raw)[11], const float* w4  , float scale, float (&out)[8]) {
    const float w0 = w4[0], w1 = w4[512], w2 = w4[1024], w3 = w4[1536];
#pragma unroll
    for (int i = 0; i < 8; ++i) out[i] = siluf_(w0 * bf2f(raw[i]) + w1 * bf2f(raw[i + 1]) + w2 * bf2f(raw[i + 2]) + w3 * bf2f(raw[i + 3])) * scale;
}
__device__ __forceinline__ void hgrn_b_item(LAS unsigned char* L, const HgIn& R, float lb, float* LT, float* DEC, int tid, int wave) {
    const int d = tid & 63, tq = wave;
    float bl[8], kh[8]; float run = 0.f;
#pragma unroll
    for (int i = 0; i < 8; ++i) { const float fz = bf2f(R.fz[i]);
        const float sg = sigmoidf_(fz), f = lb + (1.f - lb) * sg; kh[i] = (1.f - lb) * (1.f - sg); run += __logf(f); bl[i] = run; }
    LAS float* part = (LAS float*)(L + L_PART);
    part[tq * 64 + d] = run; __syncthreads();
    float off = 0.f, btot = 0.f;
#pragma unroll
    for (int w = 0; w < 8; ++w) { const float pv = part[w * 64 + d]; btot += pv; if (w < tq) off += pv; }
#pragma unroll
    for (int i = 0; i < 8; ++i) kh[i] *= __expf(btot - (off + bl[i]));
    *(LAS v4u*)(L + L_T0 + d * TS + tq * 16) = pack8(kh);
    *(LAS v4u*)(L + L_T1 + d * TS + tq * 16) = pack8h(R.iv);
    if (tq == 0) DEC[d] = __expf(btot);
    __syncthreads();
    local_state_mma_store(L, LT, wave, tid & 63);
    __syncthreads();
}
__device__ __forceinline__ void mlstm_gates(float ig, float fg, const float* b_i, const float* b_f, int h, int lane, float& bcum, float& a) {
    bcum = wave_incl_add(log_sigmoidf_(fg + b_f[h]), lane); a = ig + b_i[h] - bcum;
}
__device__ __forceinline__ void mlstm_b_item(LAS unsigned char* L, const MlIn& R, const float* conv, const float* b_i, const float* b_f, int h, float* LT, float* NL, float* AMAX, float* BEND, int tid, int wave) {
    const int d = tid & 63, tq = wave, lane = tid & 63;
    float bcum, a; mlstm_gates(R.ig, R.fg, b_i, b_f, h, lane, bcum, a);
    const float A = wave_max(a), bend = __shfl(bcum, 63);
    float kh[8]; conv_silu8r(R.kr, conv + 256 + h * 64 + d, 0.125f, kh);
    float nsum = 0.f;
#pragma unroll
    for (int i = 0; i < 8; ++i) { kh[i] *= __expf(__shfl(a, 8 * tq + i) - A); nsum += bf2f(f2bf(kh[i])); }
    *(LAS v4u*)(L + L_T0 + d * TS + tq * 16) = pack8(kh);
    *(LAS v4u*)(L + L_T1 + d * TS + tq * 16) = pack8h(R.vv);
    LAS float* part = (LAS float*)(L + L_PART); part[tq * 64 + d] = nsum;
    __syncthreads();
    if (tq == 0) { float s = 0.f;
#pragma unroll
        for (int w = 0; w < 8; ++w) s += part[w * 64 + d];
        NL[d] = s; if (lane == 0) { AMAX[0] = A; BEND[0] = bend; } }
    local_state_mma_store(L, LT, wave, lane);
    __syncthreads();
}
__device__ __forceinline__ void fox_cumsum_item(LAS unsigned char* L, const float* G, const float* fox_bf, float* CF, int bh, int tid, int wave) {
    const int b = bh >> 3, h = bh & 7, lane = tid & 63; const float bf = fox_bf[h];
    float loc[16]; float s = 0.f;
#pragma unroll
    for (int i = 0; i < 16; ++i) { s += log_sigmoidf_(G[((size_t)b * SEQ + tid * 16 + i) * GW + 8 + h] + bf); loc[i] = s; }
    const float incl = wave_incl_add(s, lane);
    LAS float* wt = (LAS float*)(L + L_PART);
    if (lane == 63) wt[wave] = incl;
    __syncthreads();
    float off = incl - s;
#pragma unroll
    for (int w = 0; w < 8; ++w) if (w < wave) off += wt[w];
#pragma unroll
    for (int i = 0; i < 16; ++i) CF[(size_t)bh * SEQ + tid * 16 + i] = (off + loc[i]) * LOG2E;
    __syncthreads();
}

template <bool DUMMY = false> __device__ __forceinline__ void scan_c_block(unsigned char* sc, int j, int tid) {
    constexpr size_t DOFF = DUMMY ? 104 * MiB / 4 : 0;
    constexpr int CB = 16;
    if (j < 128) {
        if (tid < 256) { const int chain = j >> 4, e = (j & 15) * 256 + tid, b = chain >> 2, h = chain & 3;
            float* p = (float*)(sc + SC_LHG) + ((size_t)(b * 128) * 4 + h) * 4096 + e; const float* dp = (const float*)(sc + SC_DEC) + ((size_t)(b * 128) * 4 + h) * 64 + (e & 63);
            float S = 0.f;
            for (int c0 = 0; c0 < 128; c0 += CB) { float Lc[CB], dc[CB];
#pragma unroll
                for (int i = 0; i < CB; ++i) { Lc[i] = p[(size_t)(c0 + i) * 4 * 4096]; dc[i] = dp[(size_t)(c0 + i) * 4 * 64]; }
#pragma unroll
                for (int i = 0; i < CB; ++i) { const float So = S; S = dc[i] * S + Lc[i]; Lc[i] = So; }
#pragma unroll
                for (int i = 0; i < CB; ++i) (p + DOFF)[(size_t)(c0 + i) * 4 * 4096] = Lc[i]; } }
    } else {
        const int jj = j - 128, chain = jj >> 4, part = jj & 15, b = chain >> 2, h = chain & 3;
        if (tid < 260) { const bool isn = tid >= 256; const size_t it0 = (size_t)(b * 128) * 4 + h;
            float* p = isn ? (float*)(sc + SC_NL) + it0 * 64 + part * 4 + (tid - 256) : (float*)(sc + SC_LML) + it0 * 4096 + part * 256 + tid;
            const size_t stride = isn ? 4 * 64 : 4 * 4096;
            const float* am = (const float*)(sc + SC_AMAX) + it0; const float* be = (const float*)(sc + SC_BEND) + it0; float* mp = (float*)(sc + SC_MPREV) + it0;
            const bool writer = (part == 0 && tid == 0);
            float S = 0.f, m = 0.f;
            for (int c0 = 0; c0 < 128; c0 += CB) { float Lc[CB], A[CB], bb[CB];
#pragma unroll
                for (int i = 0; i < CB; ++i) { Lc[i] = p[(size_t)(c0 + i) * stride]; A[i] = am[(c0 + i) * 4]; bb[i] = be[(c0 + i) * 4]; }
#pragma unroll
                for (int i = 0; i < CB; ++i) { const float Mx = fmaxf(m, A[i]), So = S; S = __expf(m - Mx) * S + __expf(A[i] - Mx) * Lc[i]; Lc[i] = So; A[i] = m; m = bb[i] + Mx; }
#pragma unroll
                for (int i = 0; i < CB; ++i) { (p + DOFF)[(size_t)(c0 + i) * stride] = Lc[i]; if (writer) (mp + DOFF)[(c0 + i) * 4] = A[i]; } } }
    }
}

template <bool SIG> __device__ __forceinline__ void head_epilogue(LAS unsigned char* L, float inv, const v4u& gw  , const float* gain  , bf16_t* out  , int tid) {
    const int t = tid >> 3, v0 = (tid & 7) * 8; const LAS float* o = (const LAS float*)(L + L_O) + t * OS + v0;
    float x[8]; float ss = 0.f;
#pragma unroll
    for (int i = 0; i < 8; ++i) { x[i] = o[i] * inv; ss += x[i] * x[i]; }
    ss += __shfl_xor(ss, 1); ss += __shfl_xor(ss, 2); ss += __shfl_xor(ss, 4);
    const float r = rsqrtf(ss * (1.f / 64.f) + EPS);
    const unsigned gu[4] = {gw.x, gw.y, gw.z, gw.w};
    float y[8];
#pragma unroll
    for (int i = 0; i < 8; ++i) { const float gz = bf2f((bf16_t)((gu[i >> 1] >> (16 * (i & 1))) & 0xffff)); y[i] = x[i] * r * gain[i] * (SIG ? sigmoidf_(gz) : siluf_(gz)); }
    *(v4u*)out = pack8(y);
}
__device__ __forceinline__ void store_o_tiles(LAS unsigned char* L, LAS const unsigned char* A1, LAS const unsigned char* B1, LAS const unsigned char* A2, LAS const unsigned char* B2, int wave, int lane) {
    const int mt = wave >> 1;
#pragma unroll
    for (int nn = 0; nn < 2; ++nn) { const int nt = 2 * (wave & 1) + nn; f32x4 acc = {0.f, 0.f, 0.f, 0.f};
        acc = mma64(A1, B1, mt * 16, nt * 16, lane, acc); acc = mma64(A2, B2, mt * 16, nt * 16, lane, acc);
        LAS float* o = (LAS float*)(L + L_O);
#pragma unroll
        for (int r = 0; r < 4; ++r) o[(mt * 16 + 4 * (lane >> 4) + r) * OS + nt * 16 + (lane & 15)] = acc[r]; }
}
__device__ __forceinline__ void hgrn_d_item(LAS unsigned char* L, const HgIn& R, float lb, const float* gain  , bf16_t* out  , int tid, int wave) {
    const int d = tid & 63, tq = wave, lane = tid & 63;
    float bl[8], kk[8], q[8]; float run = 0.f;
#pragma unroll
    for (int i = 0; i < 8; ++i) { const float fz = bf2f(R.fz[i]); q[i] = bf2f(R.q[i]);
        const float sg = sigmoidf_(fz), f = lb + (1.f - lb) * sg; kk[i] = (1.f - lb) * (1.f - sg); run += __logf(f); bl[i] = run; }
    LAS float* part = (LAS float*)(L + L_PART);
    part[tq * 64 + d] = run;
    store_state_tile(L + L_T4, R.s0, R.s1, tid);
    *(LAS v4u*)(L + L_T3 + d * TS + tq * 16) = pack8h(R.iv);
    __syncthreads();
    float off = 0.f, bref = 0.f;
#pragma unroll
    for (int w = 0; w < 8; ++w) { const float pv = part[w * 64 + d]; if (w < 4) bref += pv; if (w < tq) off += pv; }
#pragma unroll
    for (int i = 0; i < 8; ++i) { const float bb = off + bl[i]; const int t = 8 * tq + i;
        st16(L + L_T0 + t * TS + d * 2, q[i] * __expf(bb - bref));
        st16(L + L_T1 + t * TS + d * 2, kk[i] * __expf(bref - bb));
        st16(L + L_T2 + t * TS + d * 2, q[i] * __expf(bb)); }
    __syncthreads();
    { const int mt = wave >> 1;
#pragma unroll
      for (int nn = 0; nn < 2; ++nn) { const int nt = 2 * (wave & 1) + nn; f32x4 acc = {0.f, 0.f, 0.f, 0.f};
          acc = mma64(L + L_T1, L + L_T0, mt * 16, nt * 16, lane, acc);
          const int s0 = mt * 16 + 4 * (lane >> 4), t = nt * 16 + (lane & 15);
          v2u w; w.x = pk2(s0 <= t ? acc[0] : 0.f, s0 + 1 <= t ? acc[1] : 0.f); w.y = pk2(s0 + 2 <= t ? acc[2] : 0.f, s0 + 3 <= t ? acc[3] : 0.f);
          *(LAS v2u*)(L + L_T5 + t * TS + s0 * 2) = w; } }
    __syncthreads();
    store_o_tiles(L, L + L_T5, L + L_T3, L + L_T2, L + L_T4, wave, lane);
    __syncthreads();
    { const int t = tid >> 3, v0 = (tid & 7) * 8; head_epilogue<false>(L, 1.f, R.gate, gain + v0, out + (size_t)t * D + v0, tid); }
    __syncthreads();
}
__device__ __forceinline__ void mlstm_d_item(LAS unsigned char* L, const MlIn& R, const float* conv, const float* b_i, const float* b_f, const float* gain  , int h, bf16_t* out  , int tid, int wave) {
    const int d = tid & 63, tq = wave, lane = tid & 63; const float mprev = R.mprev;
    float bcum, a; mlstm_gates(R.ig, R.fg, b_i, b_f, h, lane, bcum, a);
    const float M = fmaxf(wave_incl_max(a, lane), mprev), sint = __expf(mprev - M);
    LAS float* vec = (LAS float*)(L + L_VEC);
    if (wave == 0) { vec[lane] = a; vec[64 + lane] = M; vec[128 + lane] = __expf(-bcum - M); vec[192 + lane] = R.np; }
    float qc[8], kc[8];
    conv_silu8r(R.qr, conv + h * 64 + d, 1.f, qc);
    conv_silu8r(R.kr, conv + 256 + h * 64 + d, 0.125f, kc);
#pragma unroll
    for (int i = 0; i < 8; ++i) { const int t = 8 * tq + i;
        st16(L + L_T0 + t * TS + d * 2, qc[i]);
        st16(L + L_T1 + t * TS + d * 2, kc[i]);
        st16(L + L_T2 + t * TS + d * 2, qc[i] * __shfl(sint, t)); }
    *(LAS v4u*)(L + L_T3 + d * TS + tq * 16) = pack8h(R.vv);
    store_state_tile(L + L_T4, R.s0, R.s1, tid);
    __syncthreads();
    { const int mt = wave >> 1;
#pragma unroll
      for (int nn = 0; nn < 2; ++nn) { const int nt = 2 * (wave & 1) + nn; f32x4 acc = {0.f, 0.f, 0.f, 0.f};
          acc = mma64(L + L_T1, L + L_T0, mt * 16, nt * 16, lane, acc);
          const int s0 = mt * 16 + 4 * (lane >> 4), t = nt * 16 + (lane & 15); const float Mt = vec[64 + t];
          float wv[4];
#pragma unroll
          for (int r = 0; r < 4; ++r) wv[r] = (s0 + r <= t) ? acc[r] * __expf(vec[s0 + r] - Mt) : 0.f;
          v2u w; w.x = pk2(wv[0], wv[1]); w.y = pk2(wv[2], wv[3]); *(LAS v2u*)(L + L_T5 + t * TS + s0 * 2) = w; } }
    __syncthreads();
    store_o_tiles(L, L + L_T5, L + L_T3, L + L_T2, L + L_T4, wave, lane);
    __syncthreads();
    { const int t = tid >> 3, c8 = (tid & 7) * 8;
      const v4u pw = *(LAS const v4u*)(L + L_T5 + t * TS + c8 * 2), qw = *(LAS const v4u*)(L + L_T2 + t * TS + c8 * 2);
      const unsigned pu[4] = {pw.x, pw.y, pw.z, pw.w}, qu[4] = {qw.x, qw.y, qw.z, qw.w}; float den = 0.f;
#pragma unroll
      for (int i = 0; i < 8; ++i) { den += bf2f((bf16_t)((pu[i >> 1] >> (16 * (i & 1))) & 0xffff)) + bf2f((bf16_t)((qu[i >> 1] >> (16 * (i & 1))) & 0xffff)) * vec[192 + c8 + i]; }
      den += __shfl_xor(den, 1); den += __shfl_xor(den, 2); den += __shfl_xor(den, 4);
      const float inv = 1.f / fmaxf(fabsf(den), vec[128 + t]);
      head_epilogue<true>(L, inv, R.gate, gain + c8, out + (size_t)t * D + c8, tid); }
    __syncthreads();
}
}
constexpr int N_PHASES = 21;
template <int PH, bool REP = false> __device__ __forceinline__ void run_phase(const MArgs& a, LAS unsigned char* L, const int tid, const int wave, const int G, const int bx, const int vcu) {
    const int lane = tid & 63, gw = vcu * NWAVES + wave, NGW = G * NWAVES;
    unsigned char* ws = a.ws; bf16_t* X = (bf16_t*)a.out;
    bf16_t* X2 = (bf16_t*)(ws + WS_X2); (void)X2;
    int* ctl = (int*)(ws + WS_CTL); int* cnt = ctl + CW_CNT;
    float* Gt = (float*)(ws + WS_G); float* CF = (float*)(ws + WS_CF); int4* tokinfo = (int4*)(ws + WS_TOKINFO); float2* tgate = (float2*)(ws + WS_TGATE); int* toklist = (int*)(ws + WS_TOKLIST);
    bf16_t* P = (bf16_t*)(ws + WS_P); bf16_t* HID = (bf16_t*)(ws + WS_HID); signed char* H = (signed char*)(ws + WS_H); float* SH = (float*)(ws + WS_SH); bf16_t* MIX = (bf16_t*)(ws + WS_MIX);
    signed char* XG = (signed char*)(ws + WS_XG); float* SXG = (float*)(ws + WS_SXG); bf16_t* Y = (bf16_t*)(ws + WS_XG);
    LAS float* scr = (LAS float*)(L + RING_OFF + wave * 16384);
    (void)ctl; (void)Gt; (void)CF; (void)tokinfo; (void)tgate; (void)toklist; (void)P; (void)HID; (void)H; (void)SH; (void)SXG; (void)MIX; (void)XG; (void)Y; (void)scr; (void)cnt; (void)lane; (void)gw; (void)NGW;
    constexpr int p = PH, l = p >= 10 ? 1 : 0, k = p == 0 ? -1 : (l ? p - 10 : p - 1);
    if constexpr (p == 0) {
            LAS float* img = (LAS float*)(L + RING_OFF); LAS float* pm = (LAS float*)(L + LDSCTL_OFF + 1024);
            { auto job = [&](int it) { Conv8Job j; int r = it;
                  if (r < 224) { const int ll = r / 112, nb = r % 112, sc = 32 * nb + (nb >= 56 ? 8 : 0);
                      j.W = a.in[I_W_IN] + (size_t)ll * D * DIN + sc; j.ldw = DIN; j.WT8 = (signed char*)(ws + WS_WIN) + (size_t)ll * PW * D + (size_t)32 * nb * D; j.S = (float*)(ws + WS_SWIN) + ll * PW + 32 * nb; }
                  else { r -= 224; const int up = r / 88, nb = r % 88, c = 32 * nb;
                      j.W = (up ? a.in[I_DUP] : a.in[I_DGATE]) + c; j.ldw = FF; j.WT8 = (signed char*)(ws + WS_WDGU) + (size_t)glu_row(c, up) * D; j.S = (float*)(ws + WS_SWDGU) + glu_row(c, up); }
                  return j; };
              float v[64]; int it = vcu; if (it < 400) conv8_load(v, job(it), tid, wave);
              for (; it < 400; it += G) { const Conv8Job j = job(it); conv8_stage(v, img, pm, tid, wave); if (it + G < 400) conv8_load(v, job(it + G), tid, wave); conv8_quant(j, img, pm, tid, wave); } }
            for (int it = gw; it < 2432; it += NGW) {
                int r = it;
                if (r < 1024) { const int ll = r / 512; r %= 512; const int kb = r / 32, nb = r % 32;
                    tr_item(a.in[I_W_OUT] + (size_t)ll * D * D + 32 * nb, D, D, (bf16_t*)(ws + WS_WOUT) + (size_t)ll * D * D + (size_t)32 * nb * D, scr, 64 * kb, lane); continue; }
                r -= 1024;
                { const int kb = r / 32, nb = r % 32; tr_item(a.in[I_DDOWN] + 32 * nb, D, FF, (bf16_t*)(ws + WS_WDDN) + (size_t)32 * nb * FF, scr, 64 * kb, lane); }
            }
            __syncthreads();
            LAS float* tab = (LAS float*)(L + RING_OFF); load_gate_tab(tab, a.in[I_W_IN], tid); __syncthreads();
            float lg[8];
            { RowIn R, Rn; int row = gw; if (row < NTOK) mrow_load<false>(R, a.in[I_X], row, lane);
              for (; row < NTOK; row += NGW) { const int nx = row + NGW; if (nx < NTOK) mrow_load<false>(Rn, a.in[I_X], nx, lane); asm volatile("" ::: "memory");
                  mrow<0>(R, H, SH, a.in[I_ATTN_NORM], tab, Gt, row, lane, lg); if (nx < NTOK) R = Rn; } }
        } else if constexpr (k == 0) {
            { const int cb = (G >= 144) ? bx - 128 : bx; for (int bh = cb; bh >= 0 && bh < 16; bh += G) scan::fox_cumsum_item(L, Gt, a.in[I_FOX_BF] + l * 8, CF, bh, tid, wave); }
            pg8::GOrder S; S.so.init(NTOK, PW, G, bx); S.A = (const char*)H; S.B = (const char*)(ws + WS_WIN) + (size_t)l * PW * D; S.a_tile = (size_t)256 * D; S.b_tile = (size_t)256 * D; S.b_exp = 0;
            S.tb1 = S.tb2 = S.tb3 = S.tb4 = S.tb5 = S.tb6 = S.tb7 = 0x7fffffff;
            pg8::EpiBf8 E; E.O = P; E.ldc = PW; E.s_lo = P_FQ / 256; E.s_hi = P_FK / 256; E.scale = QSCALE; E.sA = SH; E.sB = (const float*)(ws + WS_SWIN) + l * PW; E.sc = (LAS float*)(L + LDSCTL_OFF + 4096);
            pg8::Gemm g{D / 2};
            pg8::gemm_phase<pg8::EpiBf8, pg8::GOrder, true, true, 1>(L + RING_OFF, g, S, E);
        } else if constexpr (l == 1 && k == 9) {
            pg8::GOrder S; pg8::EpiBf E; int t[8]; int acc = 0;
#pragma unroll
            for (int e = 0; e < NE; ++e) { t[e] = acc; acc += (cnt[e] + 255) >> 8; }
            S.so.init(acc * 256, D, G, bx); S.A = (const char*)HID; S.B = (const char*)(ws + WS_WMDN); S.a_tile = (size_t)256 * FE; S.b_tile = (size_t)256 * FE; S.b_exp = (size_t)D * FE;
            S.tb1 = t[1]; S.tb2 = t[2]; S.tb3 = t[3]; S.tb4 = t[4]; S.tb5 = t[5]; S.tb6 = t[6]; S.tb7 = t[7]; E.O = Y; E.ldc = D; E.s_lo = 0; E.s_hi = 4; E.scale = 1.f / (pg8::F8_HSCALE * pg8::F8_WSCALE);
            pg8::Gemm g{FE / 2};
            pg8::gemm_phase<pg8::EpiBf, pg8::GOrder, true, true, 2>(L + RING_OFF, g, S, E);
        } else if constexpr (k == 4 || (l == 0 && k == 7)) {
            pg8::GOrder S; S.so.init(NTOK, D, G, bx); S.b_exp = 0; S.tb1 = S.tb2 = S.tb3 = S.tb4 = S.tb5 = S.tb6 = S.tb7 = 0x7fffffff; int K;
            if constexpr (k == 4) { K = D; S.A = (const char*)MIX; S.B = (const char*)(ws + WS_WOUT) + (size_t)l * D * D * 2; }
            else { K = FF; S.A = (const char*)HID; S.B = (const char*)(ws + WS_WDDN); }
            S.a_tile = (size_t)256 * K * 2; S.b_tile = (size_t)256 * K * 2;
            pg8::Gemm g{K};
            if constexpr (k == 4 && l == 0) { pg8::EpiResid<true> E{a.in[I_X], X, D}; pg8::gemm_phase<pg8::EpiResid<true>, pg8::GOrder, true, true>(L + RING_OFF, g, S, E); }
            else { pg8::EpiResid<false> E{X, (k == 4 && l == 1) ? X2 : X, D}; pg8::gemm_phase<pg8::EpiResid<false>, pg8::GOrder, true, true>(L + RING_OFF, g, S, E); }
        } else if constexpr ((l == 0 && k == 6) || (l == 1 && k == 7)) {
            pg8::GOrder S; pg8::EpiSwiglu8<(l == 1)> E; S.a_tile = (size_t)256 * D; S.b_tile = (size_t)256 * D; E.O = HID; E.sc = (LAS float*)(L + LDSCTL_OFF + 4096);
            if constexpr (l == 0) { S.so.init(NTOK, 2 * FF, G, bx); S.A = (const char*)H; S.B = (const char*)(ws + WS_WDGU); S.b_exp = 0; S.tb1 = S.tb2 = S.tb3 = S.tb4 = S.tb5 = S.tb6 = S.tb7 = 0x7fffffff;
                E.ldc = FF; E.sA = SH; E.sB = (const float*)(ws + WS_SWDGU); E.sb_exp = 0; }
            else { int t[8]; int acc = 0;
#pragma unroll
                for (int e = 0; e < NE; ++e) { t[e] = acc; acc += (cnt[e] + 255) >> 8; }
                S.so.init(acc * 256, 2 * FE, G, bx); S.A = (const char*)XG; S.B = (const char*)(ws + WS_WMGU); S.b_exp = (size_t)2 * FE * D;
                S.tb1 = t[1]; S.tb2 = t[2]; S.tb3 = t[3]; S.tb4 = t[4]; S.tb5 = t[5]; S.tb6 = t[6]; S.tb7 = t[7]; E.ldc = FE; E.sA = SXG; E.sB = (const float*)(ws + WS_SWMGU); E.sb_exp = 2 * FE; }
            E.tb1 = S.tb1; E.tb2 = S.tb2; E.tb3 = S.tb3; E.tb4 = S.tb4; E.tb5 = S.tb5; E.tb6 = S.tb6; E.tb7 = S.tb7;
            pg8::Gemm g{D / 2};
            pg8::gemm_phase<pg8::EpiSwiglu8<(l == 1)>, pg8::GOrder, true, true, 1>(L + RING_OFF, g, S, E);
        } else if constexpr (k == 5 && l == 0) {
            float lg[8];
            { RowIn R, Rn; int row = gw; if (row < NTOK) mrow_load<true>(R, X, row, lane);
              for (; row < NTOK; row += NGW) { const int nx = row + NGW; if (nx < NTOK) mrow_load<true>(Rn, X, nx, lane); asm volatile("" ::: "memory");
                  mrow<1>(R, H, SH, a.in[I_FFN_NORM], nullptr, nullptr, row, lane, lg); if (nx < NTOK) R = Rn; } }
        } else if constexpr (k == 8 && l == 0) {
            LAS float* tab = (LAS float*)(L + RING_OFF); load_gate_tab(tab, a.in[I_W_IN] + (size_t)D * DIN, tid); __syncthreads();
            float lg[8];
            { RowIn R, Rn; int row = gw; if (row < NTOK) mrow_load<true>(R, X, row, lane);
              for (; row < NTOK; row += NGW) { const int nx = row + NGW; if (nx < NTOK) mrow_load<true>(Rn, X, nx, lane); asm volatile("" ::: "memory");
                  mrow<0>(R, H, SH, a.in[I_ATTN_NORM] + D, tab, Gt, row, lane, lg); if (nx < NTOK) R = Rn; } }
        } else if constexpr (k == 5 && l == 1) {
            LAS int* sel_e = (LAS int*)(L + RING_OFF);
            LAS float* sel_g = (LAS float*)(L + RING_OFF + 512);
            LAS int* lcnt = (LAS int*)(L + RING_OFF + 1024);
            LAS float* tab = (LAS float*)(L + RING_OFF + 4096); load_router_tab(tab, a.in[I_ROUTER], tid); __syncthreads();
            for (int rb = bx; rb < NTOK / 64; rb += G) {
                if (tid < 16) lcnt[tid] = 0;
                RowIn R, Rn; mrow_load<true>(R, X2, rb * 64 + wave * 8, lane);
                for (int i = 0; i < 8; ++i) { const int rl = wave * 8 + i, row = rb * 64 + rl; float lg[8];
                    if (i < 7) mrow_load<true>(Rn, X2, row + 1, lane); asm volatile("" ::: "memory");
                    mrow<2>(R, H, SH, a.in[I_FFN_NORM] + D, tab, nullptr, row, lane, lg); if (i < 7) R = Rn;
                    if (lane == 0) { const float v0 = lg[0], v1 = lg[1]; const int e0 = __float_as_int(lg[2]), e1 = __float_as_int(lg[3]);
                        const float g1 = 1.f / (1.f + __expf(v0 - v1));
                        sel_e[2 * rl] = e0; sel_e[2 * rl + 1] = e1; sel_g[2 * rl] = 1.f - g1; sel_g[2 * rl + 1] = g1; } }
                __syncthreads();
                int e0 = 0, e1 = 0, r0 = 0, r1 = 0;
                if (tid < 64) { e0 = sel_e[2 * tid]; e1 = sel_e[2 * tid + 1]; r0 = __hip_atomic_fetch_add(lcnt + e0, 1, __ATOMIC_RELAXED, __HIP_MEMORY_SCOPE_WORKGROUP); r1 = __hip_atomic_fetch_add(lcnt + e1, 1, __ATOMIC_RELAXED, __HIP_MEMORY_SCOPE_WORKGROUP); }
                __syncthreads();
                if (tid < 8) lcnt[8 + tid] = atomicAdd(cnt + tid, (int)lcnt[tid]);
                __syncthreads();
                if (tid < 64) { const int row = rb * 64 + tid, s0 = lcnt[8 + e0] + r0, s1 = lcnt[8 + e1] + r1;
                    toklist[e0 * NTOK + s0] = row; toklist[e1 * NTOK + s1] = row; tokinfo[row] = make_int4(e0, s0, e1, s1); tgate[row] = make_float2(sel_g[2 * tid], sel_g[2 * tid + 1]); }
                __syncthreads();
            }
        } else if constexpr (k == 6 && l == 1) {
            { int base[NE]; int acc = 0;
#pragma unroll
              for (int e = 0; e < NE; ++e) { base[e] = acc; acc += (cnt[e] + 255) & ~255; }
              for (int r = gw; r < acc; r += NGW) { int e = 0, be = 0;
#pragma unroll
                  for (int c = 1; c < NE; ++c) if (r >= base[c]) { e = c; be = base[c]; }
                  const int s = r - be; v4u v0 = {0u, 0u, 0u, 0u}; float sv = 0.f;
                  if (s < cnt[e]) { const int tok = toklist[e * NTOK + s]; v0 = *((const v4u*)(H + (size_t)tok * D) + lane); sv = SH[tok]; }
                  *((v4u*)(XG + (size_t)r * D) + lane) = v0; if (lane == 0) SXG[r] = sv; } }
            __syncthreads();
            { LAS float* img = (LAS float*)(L + RING_OFF); LAS float* pm = (LAS float*)(L + LDSCTL_OFF + 1024);
              auto job = [&](int it) { Conv8Job j; const int e = it / 224; int r = it % 224; const int up = r / 112, nb = r % 112, c = 32 * nb;
                  j.W = (up ? a.in[I_MUP] : a.in[I_MGATE]) + (size_t)e * D * FE + c; j.ldw = FE; j.WT8 = (signed char*)(ws + WS_WMGU) + (size_t)e * 2 * FE * D + (size_t)glu_row(c, up) * D; j.S = (float*)(ws + WS_SWMGU) + e * 2 * FE + glu_row(c, up); return j; };
              float v[64]; int it = vcu; if (it < 1792) conv8_load(v, job(it), tid, wave);
              for (; it < 1792; it += G) { const Conv8Job j = job(it); conv8_stage(v, img, pm, tid, wave); if (it + G < 1792) conv8_load(v, job(it + G), tid, wave); conv8_quant(j, img, pm, tid, wave); } }
            for (int it = gw; it < 14336; it += NGW) { const int e = it / 1792, r = it % 1792, kb = r / 32, nb = r % 32;
                tr_item_f8(a.in[I_MDOWN] + (size_t)e * FE * D + 32 * nb, D, FE, (unsigned char*)(ws + WS_WMDN) + (size_t)e * D * FE + (size_t)32 * nb * FE, scr, 64 * kb, lane); }
        } else if constexpr (k == 8 && l == 1) {
        } else if constexpr (l == 1 && k == 10) {
            int base[NE]; { int acc = 0;
#pragma unroll
              for (int e = 0; e < NE; ++e) { base[e] = acc; acc += (cnt[e] + 255) & ~255; } }
            constexpr int HALFR = NTOK; constexpr int rlo = 0;
            const bf16_t* Xs = X2;
            float* out = (float*)a.out;
            struct FA { uint2 v[4]; int4 ti; float2 tg; }; struct FB { uint2 y0[4], y1[4]; };
            auto loadA = [&](FA& A, int rr) { const uint2* xr = (const uint2*)(Xs + (size_t)rr * D) + lane;
#pragma unroll
                for (int j = 0; j < 4; ++j) A.v[j] = xr[64 * j];
                A.ti = tokinfo[rlo + rr]; A.tg = tgate[rlo + rr]; };
            auto loadB = [&](FB& B, const FA& A) { int b0 = 0, b1 = 0;
#pragma unroll
                for (int c = 0; c < NE; ++c) { if (c == A.ti.x) b0 = base[c]; if (c == A.ti.z) b1 = base[c]; }
                const uint2* y0 = (const uint2*)(Y + (size_t)(b0 + A.ti.y) * D) + lane; const uint2* y1 = (const uint2*)(Y + (size_t)(b1 + A.ti.w) * D) + lane;
#pragma unroll
                for (int j = 0; j < 4; ++j) { B.y0[j] = y0[64 * j]; B.y1[j] = y1[64 * j]; } };
            FA A0, A1, A2; FB B0, B1; int rr = gw;
            if (rr < HALFR) { loadA(A0, rr); if (rr + NGW < HALFR) loadA(A1, rr + NGW); loadB(B0, A0); }
            for (; rr < HALFR; rr += NGW) {
                const bool h1 = rr + NGW < HALFR, h2 = rr + 2 * NGW < HALFR;
                if (h2) loadA(A2, rr + 2 * NGW);
                if (h1) loadB(B1, A1);
                asm volatile("" ::: "memory");
                float4 v[4]; const float2 tg = A0.tg;
#pragma unroll
                for (int j = 0; j < 4; ++j) { const uint2 q = B0.y0[j], c = B0.y1[j], x = A0.v[j];
                    v[j].x = __uint_as_float(x.x << 16) + tg.x * bf2f((bf16_t)(q.x & 0xffff)) + tg.y * bf2f((bf16_t)(c.x & 0xffff)); v[j].y = __uint_as_float(x.x & 0xffff0000u) + tg.x * bf2f((bf16_t)(q.x >> 16)) + tg.y * bf2f((bf16_t)(c.x >> 16));
                    v[j].z = __uint_as_float(x.y << 16) + tg.x * bf2f((bf16_t)(q.y & 0xffff)) + tg.y * bf2f((bf16_t)(c.y & 0xffff)); v[j].w = __uint_as_float(x.y & 0xffff0000u) + tg.x * bf2f((bf16_t)(q.y >> 16)) + tg.y * bf2f((bf16_t)(c.y >> 16)); }
                float ss = 0.f;
#pragma unroll
                for (int j = 0; j < 4; ++j) ss += v[j].x * v[j].x + v[j].y * v[j].y + v[j].z * v[j].z + v[j].w * v[j].w;
                ss = wave_sum(ss); const float r = rsqrtf(ss * (1.f / D) + EPS);
                float4* xo = (float4*)(out + (size_t)(rlo + rr) * D) + lane;
#pragma unroll
                for (int j = 0; j < 4; ++j) { const float4 g = *((const float4*)a.in[I_FINAL_NORM] + 64 * j + lane); xo[64 * j] = make_float4(v[j].x * r * g.x, v[j].y * r * g.y, v[j].z * r * g.z, v[j].w * r * g.w); }
                if (h1) { A0 = A1; B0 = B1; } if (h2) A1 = A2;
            }
        } else {
            if constexpr (k == 1) {
                unsigned char* sc = ws + WS_SCAN; const int wv = wave;
#define ITEM_DECODE(it_) const int item = (it_) & 1023, h = item & 3, c = (item >> 2) & 127, b = item >> 9
#define HG_LB(h_) (l == 0 ? 0.f : 1.f / (1.f + __expf(a.in[I_HGRN_LB][(h_) * 64 + (tl & 63)] - a.in[I_HGRN_LB][256 + (h_) * 64 + (tl & 63)])))
                { scan::HgIn R, Rn; int it = bx;
                  if (it < 1024) { ITEM_DECODE(it); scan::hgrn_load<false>(R, P, b, c, h, nullptr, tid, wv); }
                  for (; it < 1024; it += G) { const int nx = it + G; int tl = tid; asm volatile("" : "+v"(tl));
                      if (nx < 1024) { ITEM_DECODE(nx); scan::hgrn_load<false>(Rn, P, b, c, h, nullptr, tl, wv); }
                      asm volatile("" ::: "memory");
                      { ITEM_DECODE(it); (void)b; (void)c; scan::hgrn_b_item(L, R, HG_LB(h), (float*)(sc + scan::SC_LHG) + (size_t)item * 4096, (float*)(sc + scan::SC_DEC) + item * 64, tl, wv); }
                      if (nx < 1024) R = Rn; } }
                { scan::MlIn R, Rn; int it = bx; while (it < 1024) it += G;
                  if (it < 2048) { ITEM_DECODE(it); scan::mlstm_load<false>(R, P, Gt, b, c, h, nullptr, nullptr, nullptr, tid, wv); }
                  for (; it < 2048; it += G) { const int nx = it + G; int tl = tid; asm volatile("" : "+v"(tl));
                      if (nx < 2048) { ITEM_DECODE(nx); scan::mlstm_load<false>(Rn, P, Gt, b, c, h, nullptr, nullptr, nullptr, tl, wv); }
                      asm volatile("" ::: "memory");
                      { ITEM_DECODE(it); (void)b; (void)c; scan::mlstm_b_item(L, R, a.in[I_MLSTM_CONV] + l * 2048, a.in[I_MLSTM_BI] + l * 4, a.in[I_MLSTM_BF] + l * 4, h, (float*)(sc + scan::SC_LML) + (size_t)item * 4096,
                                            (float*)(sc + scan::SC_NL) + item * 64, (float*)(sc + scan::SC_AMAX) + item, (float*)(sc + scan::SC_BEND) + item, tl, wv); }
                      if (nx < 2048) R = Rn; } }
                { LAS unsigned* lst = (LAS unsigned*)(L + LDSCTL_OFF + 64);
                  if (tid < 32) lst[tid] = 0u; __syncthreads();
                  float mq0 = 0.f, mq1 = 0.f, mk0 = 0.f, mk1 = 0.f;
                  for (int row = gw; row < NTOK; row += NGW) {
                      const v4u wq = *((const v4u*)(P + (size_t)row * PW + P_FQ) + lane), wk = *((const v4u*)(P + (size_t)row * PW + P_FK) + lane);
                      float sq = 0.f, sk = 0.f;
#pragma unroll
                      for (int i = 0; i < 4; ++i) { const float q0 = bf2f((bf16_t)(wq[i] & 0xffff)), q1 = bf2f((bf16_t)(wq[i] >> 16)), k0 = bf2f((bf16_t)(wk[i] & 0xffff)), k1 = bf2f((bf16_t)(wk[i] >> 16));
                          sq += q0 * q0 + q1 * q1; sk += k0 * k0 + k1 * k1; }
                      sq += __shfl_xor(sq, 1); sq += __shfl_xor(sq, 2); sq += __shfl_xor(sq, 4); sk += __shfl_xor(sk, 1); sk += __shfl_xor(sk, 2); sk += __shfl_xor(sk, 4);
                      if (row < SEQ) { mq0 = fmaxf(mq0, sq); mk0 = fmaxf(mk0, sk); } else { mq1 = fmaxf(mq1, sq); mk1 = fmaxf(mk1, sk); } }
                  if ((lane & 7) == 0) { const int hh = lane >> 3;
                      __hip_atomic_fetch_max(lst + hh * 2, __float_as_uint(mq0), __ATOMIC_RELAXED, __HIP_MEMORY_SCOPE_WORKGROUP); __hip_atomic_fetch_max(lst + hh * 2 + 1, __float_as_uint(mk0), __ATOMIC_RELAXED, __HIP_MEMORY_SCOPE_WORKGROUP);
                      __hip_atomic_fetch_max(lst + 16 + hh * 2, __float_as_uint(mq1), __ATOMIC_RELAXED, __HIP_MEMORY_SCOPE_WORKGROUP); __hip_atomic_fetch_max(lst + 16 + hh * 2 + 1, __float_as_uint(mk1), __ATOMIC_RELAXED, __HIP_MEMORY_SCOPE_WORKGROUP); }
                  __syncthreads();
                  if (tid < 32) __hip_atomic_fetch_max((unsigned*)ctl + CW_STAT + l * 32 + tid, lst[tid], __ATOMIC_RELAXED, __HIP_MEMORY_SCOPE_AGENT); }
            } else if constexpr (k == 2) {
                for (int j = bx; j < 256; j += G) scan::scan_c_block<REP>(ws + WS_SCAN, j, tid);
            } else if constexpr (k == 3) {
                static_assert(attn_body::ATTN_LDS_BYTES <= RING_BYTES, "attention LDS");
                unsigned char* sc = ws + WS_SCAN; const int wv = wave;
                const float* stat = (const float*)(ctl + CW_STAT + l * 32);
                LAS unsigned* slot = (LAS unsigned*)(L + LDSCTL_OFF);
                int v;
                for (;;) {
                    if (tid == 0) *slot = __hip_atomic_fetch_add((unsigned*)ctl + CW_QCTR + l + (REP ? 2 : 0), 1u, __ATOMIC_RELAXED, __HIP_MEMORY_SCOPE_AGENT);
                    __syncthreads();
                    v = __builtin_amdgcn_readfirstlane((int)*(volatile LAS unsigned*)slot);
                    if (v >= 736) break;
                    int qb, bh, part = 0; float* PART = nullptr;
                    if (v < 448) { qb = 31 - (v >> 5); bh = v & 15; part = (v >> 4) & 1; PART = (float*)(ws + WS_SCAN + (40 + 32 * l) * MiB) + (size_t)(bh * 14 + (qb - 18)) * 2 * attn_body::PART_F; }
                    else { const int u2 = v - 448; qb = 17 - (u2 >> 4); bh = u2 & 15; }
                    const float Tsk = 30.f + 2.f * __builtin_sqrtf(stat[bh * 2] * stat[bh * 2 + 1]) * 1.01f + 1.f;
                    attn_body::attn_unit<8>(bh >> 3, bh & 7, qb, (const attn_body::bf16*)(P + P_FQ), (const attn_body::bf16*)(P + P_FK), (const attn_body::bf16*)(P + P_FV), (attn_body::bf16*)(MIX + 512), CF + (size_t)bh * SEQ, Tsk,
                                            part, PART, (unsigned*)ctl + CW_AFLAG + (l + (REP ? 2 : 0)) * 512 + bh * 32 + qb, (char*)L + RING_OFF);
                    __syncthreads();
                }
                int tid2 = tid; asm volatile("" : "+v"(tid2));
                while (v < 736 + 512) {
                    const int it0 = (v - 736) * 4;
                    if (it0 < 1024) { scan::HgIn R, Rn; { ITEM_DECODE(it0); scan::hgrn_load<true>(R, P, b, c, h, (const float*)(sc + scan::SC_LHG) + (size_t)item * 4096, tid2, wv); }
#pragma unroll 1
                        for (int j = 0; j < 4; ++j) { const int it = it0 + j; int tl = tid2; asm volatile("" : "+v"(tl));
                            if (j < 3) { ITEM_DECODE(it + 1); scan::hgrn_load<true>(Rn, P, b, c, h, (const float*)(sc + scan::SC_LHG) + (size_t)item * 4096, tl, wv); }
                            asm volatile("" ::: "memory");
                            { ITEM_DECODE(it); const float lb = l == 0 ? 0.f : 1.f / (1.f + __expf(a.in[I_HGRN_LB][h * 64 + (tl & 63)] - a.in[I_HGRN_LB][256 + h * 64 + (tl & 63)]));
                              scan::hgrn_d_item(L, R, lb, a.in[I_HGRN_NORM] + l * 256 + h * 64, MIX + (size_t)(b * SEQ + c * 64) * D + h * 64, tl, wv); }
                            if (j < 3) R = Rn; } }
                    else { scan::MlIn R, Rn; { ITEM_DECODE(it0); scan::mlstm_load<true>(R, P, Gt, b, c, h, (const float*)(sc + scan::SC_LML) + (size_t)item * 4096, (const float*)(sc + scan::SC_NL) + item * 64, (const float*)(sc + scan::SC_MPREV) + item, tid2, wv); }
#pragma unroll 1
                        for (int j = 0; j < 4; ++j) { const int it = it0 + j; int tl = tid2; asm volatile("" : "+v"(tl));
                            if (j < 3) { ITEM_DECODE(it + 1); scan::mlstm_load<true>(Rn, P, Gt, b, c, h, (const float*)(sc + scan::SC_LML) + (size_t)item * 4096, (const float*)(sc + scan::SC_NL) + item * 64, (const float*)(sc + scan::SC_MPREV) + item, tl, wv); }
                            asm volatile("" ::: "memory");
                            { ITEM_DECODE(it); scan::mlstm_d_item(L, R, a.in[I_MLSTM_CONV] + l * 2048, a.in[I_MLSTM_BI] + l * 4, a.in[I_MLSTM_BF] + l * 4, a.in[I_MLSTM_NORM] + l * 256 + h * 64, h, MIX + (size_t)(b * SEQ + c * 64) * D + 256 + h * 64, tl, wv); }
                            if (j < 3) R = Rn; } }
                    __syncthreads();
                    if (tid2 == 0) *slot = __hip_atomic_fetch_add((unsigned*)ctl + CW_QCTR + l + (REP ? 2 : 0), 1u, __ATOMIC_RELAXED, __HIP_MEMORY_SCOPE_AGENT);
                    __syncthreads();
                    v = __builtin_amdgcn_readfirstlane((int)*(volatile LAS unsigned*)slot);
                }
            }

        }
}
__global__ void __launch_bounds__(NTHR, 2) mega(MArgs a) {
    extern __shared__ __attribute__((aligned(16))) unsigned char lds[];
    LAS unsigned char* L = (LAS unsigned char*)lds;
    volatile LAS unsigned* MISC = (volatile LAS unsigned*)(L + MISC_OFF);
    const int tid = threadIdx.x, wave = __builtin_amdgcn_readfirstlane(tid >> 6);
    const int G = gridDim.x, bx = blockIdx.x, vcu = (G % 8 == 0) ? (bx % 8) * (G / 8) + bx / 8 : bx;
    for (int u = tid; u < (LDS_BYTES - LDSCTL_OFF) / 4; u += NTHR) ((LAS unsigned*)(L + LDSCTL_OFF))[u] = 0u;
    __syncthreads();
    const int lo = a.ph_lo, hi = a.ph_hi;
    XcdBarrier bar; bar.bar = (unsigned*)(a.ws + WS_CTL) + CW_BAR; bar.x = 0; bar.st = nullptr;
    if (hi - lo > 1) bar = xcd_barrier_post((unsigned*)(a.ws + WS_CTL) + CW_BAR, MISC + 8);
#ifndef REPEAT_MASK
#define REPEAT_MASK 0u
#endif
#define PHASE(k) if (lo <= (k) && (k) < hi) { run_phase<k>(a, L, tid, wave, G, bx, vcu); if constexpr ((REPEAT_MASK >> (k)) & 1u) { xcd_barrier(bar); run_phase<k, true>(a, L, tid, wave, G, bx, vcu); } if ((k) + 1 < hi) xcd_barrier(bar); }
    PHASE(0) PHASE(1) PHASE(2) PHASE(3) PHASE(4) PHASE(5) PHASE(6) PHASE(7) PHASE(8) PHASE(9) PHASE(10)
    PHASE(11) PHASE(12) PHASE(13) PHASE(14) PHASE(15) PHASE(16) PHASE(17) PHASE(19) PHASE(20)
#undef PHASE
}
#ifndef MEGA_MASK
#define MEGA_MASK 0x1FFFFFu
#endif
#ifndef FUSE_RUNS
#define FUSE_RUNS 1
#endif
extern "C" void kernel_launch(void* const* d_in, const int* in_sizes, int n_in, void* d_out, int out_size, void* d_ws, size_t ws_size, hipStream_t stream) {
    static int grid = 0;
    if (grid == 0) {
        if (n_in != 20 || ws_size < WS_END || out_size != NTOK * D) { fprintf(stderr, "kernel_launch: unexpected n_in %d / ws %zu / out %d\n", n_in, ws_size, out_size); grid = -1; return; }
        int dev = 0, cus = 0, per_cu = 0;
        if (hipGetDevice(&dev) != hipSuccess || hipDeviceGetAttribute(&cus, hipDeviceAttributeMultiprocessorCount, dev) != hipSuccess) { grid = -1; return; }
        if (hipFuncSetAttribute((const void*)mega, hipFuncAttributeMaxDynamicSharedMemorySize, LDS_BYTES) != hipSuccess) { fprintf(stderr, "kernel_launch: hipFuncSetAttribute failed\n"); grid = -1; return; }
        if (hipOccupancyMaxActiveBlocksPerMultiprocessor(&per_cu, (const void*)mega, NTHR, LDS_BYTES) != hipSuccess || per_cu < 1) { fprintf(stderr, "kernel_launch: occupancy query says %d\n", per_cu); per_cu = 1; }
        (void)hipGetLastError();
        grid = cus;
        if (grid > 256) grid = 256;
    }
    if (grid < 0) return;
    const float* const* in = (const float* const*)d_in;
    unsigned char* ws = (unsigned char*)d_ws; float* X = (float*)d_out;
    (void)hipMemsetAsync(ws + WS_CTL, 0, CTL_BYTES, stream);
    MArgs ma; memset(&ma, 0, sizeof ma);
    for (int i = 0; i < 20; ++i) ma.in[i] = in[i];
    ma.out = X; ma.ws = ws;
    ma.ph_lo = 0; ma.ph_hi = N_PHASES;
    hipLaunchKernelGGL(mega, dim3(grid), dim3(NTHR), LDS_BYTES, stream, ma);
}
```

```cpp
#include <hip/hip_runtime.h>
#include <hip/hip_bf16.h>
#include <cstdint>
#include <cstdio>
#include <cstring>

namespace cfg {
constexpr int NTOK = 16384, D = 1024, SEQ = 8192, NB = 2, DIN = 3600, PW = 3584, GW = 16;
constexpr int FF = 2816, FE = 3584, NE = 8, MAXROWS = 34816;
constexpr float EPS = 1e-6f;
constexpr float LOG2E = 1.4426950408889634f;
constexpr float QSCALE = 0.125f * LOG2E;
constexpr int P_HQ = 0, P_HF = 256, P_HI = 512, P_HG = 768, P_MQ = 1024, P_MK = 1280, P_MV = 1536, P_MO = 1792, P_FQ = 2048, P_FK = 2560, P_FV = 3072;
constexpr size_t MiB = 1u << 20;
constexpr size_t WS_CTL = 0, CTL_BYTES = 1 * MiB;
constexpr size_t WS_G = 2 * MiB;
constexpr size_t WS_CF = 3 * MiB;
constexpr size_t WS_TOKINFO = 3 * MiB + 512 * 1024;
constexpr size_t WS_TGATE = 3 * MiB + 768 * 1024;
constexpr size_t WS_TOKLIST = 4 * MiB;
constexpr size_t WS_P = 8 * MiB;
constexpr size_t WS_SCAN = 120 * MiB;
constexpr size_t WS_HID = 8 * MiB;
constexpr size_t WS_H = 246 * MiB;
constexpr size_t WS_MIX = 278 * MiB;
constexpr size_t WS_XG = 278 * MiB;
constexpr size_t WS_W = 346 * MiB;
constexpr size_t WS_Y = 346 * MiB;
constexpr size_t WS_X2 = 130 * MiB;
constexpr size_t WS_END = 466 * MiB;
constexpr int CW_CNT = 64;
constexpr int CW_STAT = 128;
constexpr int CW_QCTR = 256;
constexpr int CW_AFLAG = 512;
}
using namespace cfg;
typedef unsigned short bf16_t;

__device__ __forceinline__ bf16_t f2bf(float f) { unsigned u = __builtin_bit_cast(unsigned, f); return (bf16_t)((u + 0x7fffu + ((u >> 16) & 1u)) >> 16); }
__device__ __forceinline__ float bf2f(bf16_t h) { return __builtin_bit_cast(float, (unsigned)h << 16); }
__device__ __forceinline__ float wave_sum(float v) {
#pragma unroll
    for (int o = 1; o < 64; o <<= 1) v += __shfl_xor(v, o);
    return v;
}
__device__ __forceinline__ float sigmoidf_(float z) { return 1.f / (1.f + __expf(-z)); }
__device__ __forceinline__ float siluf_(float z) { return z / (1.f + __expf(-z)); }
__device__ __forceinline__ float log_sigmoidf_(float z) { return fminf(z, 0.f) - log1pf(__expf(-fabsf(z))); }

__device__ __forceinline__ int moe_bases(const int* cnt, int* base) {
    int acc = 0;
#pragma unroll
    for (int e = 0; e < NE; ++e) { base[e] = acc; acc += (cnt[e] + 255) & ~255; }
    return acc;
}

namespace pg8 {
#define PG8_LAS __attribute__((address_space(3)))
typedef unsigned short bf16_t;
typedef short bf16x8 __attribute__((ext_vector_type(8)));
typedef float f32x4 __attribute__((ext_vector_type(4)));
typedef unsigned u32x4 __attribute__((ext_vector_type(4)));
constexpr int BM = 256, BK = 64, HALF = 128, HTB = HALF * BK * 2  , STAGE_BYTES = 8 * HTB, NXCD = 8, WGM = 8;

__host__ __device__ __forceinline__ int lds_byte(int r, int c) { const int st = (r >> 4) * 2 + (c >> 5), rr = r & 15, cc = c & 31, ob = rr * 64 + cc * 2; return st * 1024 + (ob ^ (((ob >> 9) & 1) << 5)); }
__host__ __device__ __forceinline__ void stage_rc(int b, int& R, int& C) { const int st = b / 1024, sb = b % 1024, swz = sb ^ (((sb >> 9) & 1) << 5); R = (st >> 1) * 16 + swz / 64; C = (st & 1) * 32 + (swz % 64) / 2; }
__host__ __device__ __forceinline__ int perm32(int rho) { const int n = rho >> 4, i = rho & 15; return 8 * (i >> 2) + 4 * n + (i & 3); }

struct Unit { int pm, pn; };
struct Gemm { int K; };

struct StaticOrder {
    int nM, nN, nwg, G, c;
    __host__ __device__ void init(int M, int N, int G_, int c_) { nM = M / BM; nN = N / BM; nwg = nM * nN; G = G_; c = c_; }
    __host__ __device__ bool next(int i, Unit& u) const {
        const long L = (long)i * G + c; if (L >= nwg) return false;
        int wgid = (int)L; { const int q = nwg / NXCD, r = nwg % NXCD, xcd = wgid % NXCD, off = wgid / NXCD; wgid = (xcd < r ? xcd * (q + 1) : r * (q + 1) + (xcd - r) * q) + off; }
        const int nig = WGM * nN, gid = wgid / nig, fm = gid * WGM, gsz = (nM - fm) < WGM ? (nM - fm) : WGM;
        u.pm = fm + ((wgid % nig) % gsz); u.pn = (wgid % nig) / gsz; return true;
    }
    __device__ __forceinline__ void a_ready(const Unit&) const {}
    __device__ __forceinline__ void done(const Unit&) const {}
};

__device__ __forceinline__ unsigned cvt_pk_bf16(float lo, float hi) { unsigned r; asm volatile("v_cvt_pk_bf16_f32 %0, %1, %2" : "=v"(r) : "v"(lo), "v"(hi)); return r; }
typedef int i32x4 __attribute__((ext_vector_type(4)));
constexpr float F8_HSCALE = 4.f, F8_WSCALE = 64.f, F8_ASCALE = 16.f, F8_GSCALE = 32.f;
template <bool I8> struct AccT { typedef f32x4 type; };
template <> struct AccT<true> { typedef i32x4 type; };
__device__ __forceinline__ f32x4 mma_sel(bf16x8 b, bf16x8 a, f32x4 c) { return __builtin_amdgcn_mfma_f32_16x16x32_bf16(b, a, c, 0, 0, 0); }
__device__ __forceinline__ i32x4 mma_sel(bf16x8 b, bf16x8 a, i32x4 c) { return __builtin_amdgcn_mfma_i32_16x16x64_i8(__builtin_bit_cast(i32x4, b), __builtin_bit_cast(i32x4, a), c, 0, 0, 0); }
typedef int i32x8 __attribute__((ext_vector_type(8)));
struct Frag2 { bf16x8 k[2]; };
template <int MODE> struct Frag { typedef Frag2 type; };
template <> struct Frag<2> { typedef i32x8 type; };
template <int MODE> __device__ __forceinline__ typename Frag<MODE>::type ldfrag(PG8_LAS const unsigned char* p) {
    if constexpr (MODE == 2) { const i32x4 lo = *(const PG8_LAS i32x4*)p, hi = *(const PG8_LAS i32x4*)(p + 1024); return (i32x8){lo[0], lo[1], lo[2], lo[3], hi[0], hi[1], hi[2], hi[3]}; }
    else { Frag2 f; f.k[0] = *(const PG8_LAS bf16x8*)p; f.k[1] = *(const PG8_LAS bf16x8*)(p + 1024); return f; }
}
__device__ __forceinline__ void mma_step_(f32x4& acc, const Frag2& b, const Frag2& a) { acc = mma_sel(b.k[0], a.k[0], acc); acc = mma_sel(b.k[1], a.k[1], acc); }
__device__ __forceinline__ void mma_step_(i32x4& acc, const Frag2& b, const Frag2& a) { acc = mma_sel(b.k[0], a.k[0], acc); acc = mma_sel(b.k[1], a.k[1], acc); }
__device__ __forceinline__ void mma_step_(f32x4& acc, const i32x8& b, const i32x8& a) {
#if defined(__HIP_DEVICE_COMPILE__)
    const int scl = 0x7f7f7f7f;
    asm volatile("v_mfma_scale_f32_16x16x128_f8f6f4 %0, %1, %2, %0, %3, %3 op_sel_hi:[0,0,0]" : "+v"(acc) : "v"(b), "v"(a), "v"(scl));
#endif
}
template <int MODE, class ACC, class F> __device__ __forceinline__ void mma_step(ACC& acc, const F& b, const F& a) { mma_step_(acc, b, a); }
struct EpiBf {
    static constexpr bool PERM = true, AFTER_DRAIN = false;
    bf16_t* O; int ldc; int s_lo, s_hi; float scale;
    struct Pre {}; __device__ __forceinline__ void prefetch(Pre&, const Unit&, int, int, int, int, int) const {} __device__ __forceinline__ void commit(const Pre&, int, int, int, int, int) const {}
    __device__ __forceinline__ void operator()(const f32x4 (&acc)[2][2][4][2], const Unit& u, int wr, int wc, int fr_, int fq_, const Pre&, int) const {
        int fr = fr_, fq = fq_; asm volatile("" : "+v"(fr), "+v"(fq));
        const int row0 = u.pm * BM + wr * 64 + fr, col0 = u.pn * BM + wc * 32 + 8 * fq;
        const float sc = (u.pn >= s_lo && u.pn < s_hi) ? scale : 1.f;
#pragma unroll
        for (int ai = 0; ai < 2; ++ai)
#pragma unroll
            for (int m = 0; m < 4; ++m) { bf16_t* rowp = O + (size_t)(row0 + ai * HALF + m * 16) * ldc + col0;
#pragma unroll
                for (int bj = 0; bj < 2; ++bj) { const f32x4 v0 = acc[ai][bj][m][0] * sc, v1 = acc[ai][bj][m][1] * sc;
                    u32x4 w; w.x = cvt_pk_bf16(v0[0], v0[1]); w.y = cvt_pk_bf16(v0[2], v0[3]); w.z = cvt_pk_bf16(v1[0], v1[1]); w.w = cvt_pk_bf16(v1[2], v1[3]);
                    *(u32x4*)(rowp + bj * HALF) = w; } }
    }
};
__device__ __forceinline__ float silu_mul(float g, float u) { return g * __builtin_amdgcn_rcpf(1.f + __expf(-g)) * u; }
__device__ __forceinline__ float silu2_mul(float g2, float u2) { return g2 * __builtin_amdgcn_rcpf(1.f + __builtin_amdgcn_exp2f(-g2)) * u2; }
struct EpiSwiglu {
    static constexpr bool PERM = true, AFTER_DRAIN = false;
    bf16_t* O; int ldc;
    struct Pre {}; __device__ __forceinline__ void prefetch(Pre&, const Unit&, int, int, int, int, int) const {} __device__ __forceinline__ void commit(const Pre&, int, int, int, int, int) const {}
    __device__ __forceinline__ void operator()(const f32x4 (&acc)[2][2][4][2], const Unit& u, int wr, int wc, int fr, int fq, const Pre&, int) const {
        const int row0 = u.pm * BM + wr * 64 + fr, col0 = u.pn * HALF + wc * 32 + 8 * fq;
#pragma unroll
        for (int ai = 0; ai < 2; ++ai)
#pragma unroll
            for (int m = 0; m < 4; ++m) { bf16_t* rowp = O + (size_t)(row0 + ai * HALF + m * 16) * ldc + col0;
                const f32x4 g0 = acc[ai][0][m][0], g1 = acc[ai][0][m][1], u0 = acc[ai][1][m][0], u1 = acc[ai][1][m][1];
                u32x4 w; w.x = cvt_pk_bf16(silu_mul(g0[0], u0[0]), silu_mul(g0[1], u0[1])); w.y = cvt_pk_bf16(silu_mul(g0[2], u0[2]), silu_mul(g0[3], u0[3]));
                w.z = cvt_pk_bf16(silu_mul(g1[0], u1[0]), silu_mul(g1[1], u1[1])); w.w = cvt_pk_bf16(silu_mul(g1[2], u1[2]), silu_mul(g1[3], u1[3]));
                *(u32x4*)rowp = w; }
    }
};
struct EpiSwigluF8 {
    static constexpr bool PERM = true, AFTER_DRAIN = false;
    unsigned char* O; int ldc;
    struct Pre {}; __device__ __forceinline__ void prefetch(Pre&, const Unit&, int, int, int, int, int) const {} __device__ __forceinline__ void commit(const Pre&, int, int, int, int, int) const {}
    __device__ __forceinline__ void operator()(const f32x4 (&acc)[2][2][4][2], const Unit& u, int wr, int wc, int fr, int fq, const Pre&, int) const {
        const int row0 = u.pm * BM + wr * 64 + fr, col0 = u.pn * HALF + wc * 32 + 8 * fq;
        constexpr float CG = 1.4426950408889634f / (F8_ASCALE * F8_GSCALE), CU = F8_HSCALE * 0.6931471805599453f / (F8_ASCALE * F8_GSCALE);
#pragma unroll
        for (int ai = 0; ai < 2; ++ai)
#pragma unroll
            for (int m = 0; m < 4; ++m) { const int row = row0 + ai * HALF + m * 16;
                const f32x4 g0 = acc[ai][0][m][0] * CG, g1 = acc[ai][0][m][1] * CG, u0 = acc[ai][1][m][0] * CU, u1 = acc[ai][1][m][1] * CU;
                float h[8];
#pragma unroll
                for (int i = 0; i < 4; ++i) { h[i] = __builtin_fminf(__builtin_fmaxf(silu2_mul(g0[i], u0[i]), -448.f), 448.f); h[4 + i] = __builtin_fminf(__builtin_fmaxf(silu2_mul(g1[i], u1[i]), -448.f), 448.f); }
                unsigned w0 = 0u, w1 = 0u; w0 = __builtin_amdgcn_cvt_pk_fp8_f32(h[0], h[1], w0, false); w0 = __builtin_amdgcn_cvt_pk_fp8_f32(h[2], h[3], w0, true);
                w1 = __builtin_amdgcn_cvt_pk_fp8_f32(h[4], h[5], w1, false); w1 = __builtin_amdgcn_cvt_pk_fp8_f32(h[6], h[7], w1, true);
                typedef unsigned u32x2 __attribute__((ext_vector_type(2))); *(u32x2*)(O + (size_t)row * ldc + col0) = (u32x2){w0, w1}; }
    }
};
template <bool IN_F32> struct EpiResid {
    static constexpr bool PERM = true, AFTER_DRAIN = false;
    const void* Xin; bf16_t* X; int ldc;
    struct Pre {}; __device__ __forceinline__ void prefetch(Pre&, const Unit&, int, int, int, int, int) const {} __device__ __forceinline__ void commit(const Pre&, int, int, int, int, int) const {}
    __device__ __forceinline__ void operator()(const f32x4 (&acc)[2][2][4][2], const Unit& u, int wr, int wc, int fr, int fq, const Pre&, int) const {
        const int row0 = u.pm * BM + wr * 64 + fr, col0 = u.pn * BM + wc * 32 + 8 * fq;
#pragma unroll
        for (int ai = 0; ai < 2; ++ai)
#pragma unroll
            for (int m = 0; m < 4; ++m) { const size_t ro = (size_t)(row0 + ai * HALF + m * 16) * ldc + col0;
#pragma unroll
                for (int bj = 0; bj < 2; ++bj) { f32x4 x0, x1;
                    if (IN_F32) { const float* p = (const float*)Xin + ro + bj * HALF; x0 = *(const f32x4*)p; x1 = *(const f32x4*)(p + 4); }
                    else { const u32x4 w = *(const u32x4*)((const bf16_t*)Xin + ro + bj * HALF);
                        x0 = (f32x4){__builtin_bit_cast(float, w.x << 16), __builtin_bit_cast(float, w.x & 0xffff0000u), __builtin_bit_cast(float, w.y << 16), __builtin_bit_cast(float, w.y & 0xffff0000u)};
                        x1 = (f32x4){__builtin_bit_cast(float, w.z << 16), __builtin_bit_cast(float, w.z & 0xffff0000u), __builtin_bit_cast(float, w.w << 16), __builtin_bit_cast(float, w.w & 0xffff0000u)}; }
                    const f32x4 v0 = x0 + acc[ai][bj][m][0], v1 = x1 + acc[ai][bj][m][1];
                    u32x4 o; o.x = cvt_pk_bf16(v0[0], v0[1]); o.y = cvt_pk_bf16(v0[2], v0[3]); o.z = cvt_pk_bf16(v1[0], v1[1]); o.w = cvt_pk_bf16(v1[2], v1[3]);
                    *(u32x4*)(X + ro + bj * HALF) = o; }
                asm volatile("" ::: "memory"); }
    }
};
struct EpiBf8 {
    static constexpr bool PERM = true, AFTER_DRAIN = false;
    bf16_t* O; int ldc; int s_lo, s_hi; float scale; const float* sA; const float* sB; PG8_LAS float* sc;
    struct Pre {};
    __device__ __forceinline__ void prefetch(Pre&, const Unit& u, int wr, int wc, int fr, int fq, int ui) const {
        const int wid = wr * 4 + wc, lane = fq * 16 + fr; PG8_LAS float* d = sc + (ui & 1) * 512;
        if (wid < 2) { const float* src = (wid == 0 ? sA + u.pm * BM : sB + u.pn * BM) + 4 * lane;
            __builtin_amdgcn_global_load_lds((const unsigned*)src, (PG8_LAS unsigned*)(d + 256 * wid), 16, 0, 0); }
    }
    __device__ __forceinline__ void commit(const Pre&, int, int, int, int, int) const {}
    __device__ __forceinline__ void operator()(const i32x4 (&acc)[2][2][4][2], const Unit& u, int wr, int wc, int fr, int fq, const Pre&, int ui) const {
        const int row0 = u.pm * BM + wr * 64 + fr, col0 = u.pn * BM + wc * 32 + 8 * fq; const PG8_LAS float* d = sc + (ui & 1) * 512;
        const float sc0 = (u.pn >= s_lo && u.pn < s_hi) ? scale : 1.f;
        f32x4 cb[2][2];
#pragma unroll
        for (int bj = 0; bj < 2; ++bj)
#pragma unroll
            for (int n = 0; n < 2; ++n) cb[bj][n] = *(const PG8_LAS f32x4*)(d + 256 + wc * 32 + 8 * fq + bj * HALF + 4 * n) * sc0;
#pragma unroll
        for (int ai = 0; ai < 2; ++ai)
#pragma unroll
            for (int m = 0; m < 4; ++m) { const int row = row0 + ai * HALF + m * 16; const float ra = d[wr * 64 + fr + ai * HALF + m * 16]; bf16_t* rowp = O + (size_t)row * ldc + col0;
#pragma unroll
                for (int bj = 0; bj < 2; ++bj) { const f32x4 v0 = __builtin_convertvector(acc[ai][bj][m][0], f32x4) * cb[bj][0] * ra, v1 = __builtin_convertvector(acc[ai][bj][m][1], f32x4) * cb[bj][1] * ra;
                    u32x4 w; w.x = cvt_pk_bf16(v0[0], v0[1]); w.y = cvt_pk_bf16(v0[2], v0[3]); w.z = cvt_pk_bf16(v1[0], v1[1]); w.w = cvt_pk_bf16(v1[2], v1[3]);
                    *(u32x4*)(rowp + bj * HALF) = w; } }
    }
};
template <bool F8OUT> struct EpiSwiglu8 {
    static constexpr bool PERM = true, AFTER_DRAIN = false;
    bf16_t* O; int ldc; const float* sA; const float* sB; int sb_exp; int tb1, tb2, tb3, tb4, tb5, tb6, tb7; PG8_LAS float* sc;
    struct Pre {};
    __device__ __forceinline__ void prefetch(Pre&, const Unit& u, int wr, int wc, int fr, int fq, int ui) const {
        const int wid = wr * 4 + wc, lane = fq * 16 + fr; PG8_LAS float* d = sc + (ui & 1) * 512;
        const int e = (u.pm >= tb1) + (u.pm >= tb2) + (u.pm >= tb3) + (u.pm >= tb4) + (u.pm >= tb5) + (u.pm >= tb6) + (u.pm >= tb7);
        if (wid < 2) { const float* src = (wid == 0 ? sA + u.pm * BM : sB + (size_t)e * sb_exp + u.pn * BM) + 4 * lane;
            __builtin_amdgcn_global_load_lds((const unsigned*)src, (PG8_LAS unsigned*)(d + 256 * wid), 16, 0, 0); }
    }
    __device__ __forceinline__ void commit(const Pre&, int, int, int, int, int) const {}
    __device__ __forceinline__ void operator()(const i32x4 (&acc)[2][2][4][2], const Unit& u, int wr, int wc, int fr, int fq, const Pre&, int ui) const {
        const int row0 = u.pm * BM + wr * 64 + fr, col0 = u.pn * HALF + wc * 32 + 8 * fq; const PG8_LAS float* d = sc + (ui & 1) * 512;
        const PG8_LAS float* sb = d + 256 + wc * 32 + 8 * fq;
        constexpr float CG = 1.4426950408889634f, CU = (F8OUT ? F8_HSCALE : 1.f) * 0.6931471805599453f;
        const f32x4 sg0 = *(const PG8_LAS f32x4*)sb * CG, sg1 = *(const PG8_LAS f32x4*)(sb + 4) * CG, su0 = *(const PG8_LAS f32x4*)(sb + HALF) * CU, su1 = *(const PG8_LAS f32x4*)(sb + HALF + 4) * CU;
#pragma unroll
        for (int ai = 0; ai < 2; ++ai)
#pragma unroll
            for (int m = 0; m < 4; ++m) { const int row = row0 + ai * HALF + m * 16; const float ra = d[wr * 64 + fr + ai * HALF + m * 16];
                const f32x4 g0 = __builtin_convertvector(acc[ai][0][m][0], f32x4) * sg0 * ra, g1 = __builtin_convertvector(acc[ai][0][m][1], f32x4) * sg1 * ra;
                const f32x4 u0 = __builtin_convertvector(acc[ai][1][m][0], f32x4) * su0 * ra, u1 = __builtin_convertvector(acc[ai][1][m][1], f32x4) * su1 * ra;
                if constexpr (F8OUT) { float h[8];
#pragma unroll
                    for (int i = 0; i < 4; ++i) { h[i] = __builtin_fminf(__builtin_fmaxf(silu2_mul(g0[i], u0[i]), -448.f), 448.f); h[4 + i] = __builtin_fminf(__builtin_fmaxf(silu2_mul(g1[i], u1[i]), -448.f), 448.f); }
                    unsigned w0 = 0u, w1 = 0u; w0 = __builtin_amdgcn_cvt_pk_fp8_f32(h[0], h[1], w0, false); w0 = __builtin_amdgcn_cvt_pk_fp8_f32(h[2], h[3], w0, true);
                    w1 = __builtin_amdgcn_cvt_pk_fp8_f32(h[4], h[5], w1, false); w1 = __builtin_amdgcn_cvt_pk_fp8_f32(h[6], h[7], w1, true);
                    typedef unsigned u32x2 __attribute__((ext_vector_type(2))); *(u32x2*)((unsigned char*)O + (size_t)row * ldc + col0) = (u32x2){w0, w1}; }
                else { bf16_t* rowp = O + (size_t)row * ldc + col0;
                u32x4 w; w.x = cvt_pk_bf16(silu2_mul(g0[0], u0[0]), silu2_mul(g0[1], u0[1])); w.y = cvt_pk_bf16(silu2_mul(g0[2], u0[2]), silu2_mul(g0[3], u0[3]));
                w.z = cvt_pk_bf16(silu2_mul(g1[0], u1[0]), silu2_mul(g1[1], u1[1])); w.w = cvt_pk_bf16(silu2_mul(g1[2], u1[2]), silu2_mul(g1[3], u1[3]));
                *(u32x4*)rowp = w; } }
    }
};
struct GOrder {
    StaticOrder so; const char* A; const char* B; size_t a_tile, b_tile, b_exp; int tb1, tb2, tb3, tb4, tb5, tb6, tb7;
    __device__ __forceinline__ bool next(int i, Unit& u) const { return so.next(i, u); }
    __device__ __forceinline__ const char* a_base(const Unit& u) const { return A + (size_t)u.pm * a_tile; }
    __device__ __forceinline__ const char* b_base(const Unit& u) const {
        const int e = (u.pm >= tb1) + (u.pm >= tb2) + (u.pm >= tb3) + (u.pm >= tb4) + (u.pm >= tb5) + (u.pm >= tb6) + (u.pm >= tb7);
        return B + (size_t)e * b_exp + (size_t)u.pn * b_tile; }
    __device__ __forceinline__ void a_ready(const Unit&) const {}
    __device__ __forceinline__ void done(const Unit&) const {}
};
template <class Epi, class Sched, bool ALIGN_EPI = false, bool SP2 = false, int MODE = 0  >
__device__ __forceinline__ void gemm_phase(PG8_LAS unsigned char* lds, const Gemm g, const Sched& S, const Epi& E) {
    const int tid = threadIdx.x, wid = __builtin_amdgcn_readfirstlane(tid >> 6), lane = tid & 63, wr = wid >> 2, wc = wid & 3, fr = lane & 15, fq = lane >> 4;
    const int K = g.K, nt = K / BK;
    unsigned voffA[2], voffB[2];
#pragma unroll
    for (int i = 0; i < 2; ++i) { int R, C; stage_rc(tid * 16 + i * 8192, R, C); const int Rb = Epi::PERM ? ((R & ~31) + perm32(R & 31)) : R;
        voffA[i] = (unsigned)(R * K + C) * 2u; voffB[i] = (unsigned)(Rb * K + C) * 2u; }
    const size_t kstep = (size_t)(BK * 2);
    const size_t hstep = (size_t)HALF * K * 2;
        const unsigned ldsw = (unsigned)wid * 1024u;
    const int aoff = lds_byte(wr * 64 + fr, fq * 8), boff = lds_byte(wc * 32 + fr, fq * 8);
#define PG8_SA(b, h) (((b) * 2 + (h)) * HTB)
#define PG8_SB(b, h) ((4 + (b) * 2 + (h)) * HTB)
#define PG8_STAGE(bufoff, gbase, voff) do { _Pragma("unroll") for (int _i = 0; _i < 2; ++_i) \
        __builtin_amdgcn_global_load_lds((const unsigned*)((const char*)(gbase) + (voff)[_i]), (PG8_LAS unsigned*)(lds + (bufoff) + ldsw + _i * 8192), 16, 0, 0); } while (0)
#define PG8_LDA(dst, b, h) do { _Pragma("unroll") for (int m = 0; m < 4; ++m) dst[m] = ldfrag<MODE>(lds + PG8_SA(b, h) + aoff + m * 2048); } while (0)
#define PG8_LDB(dst, b, h) do { _Pragma("unroll") for (int n = 0; n < 2; ++n) dst[n] = ldfrag<MODE>(lds + PG8_SB(b, h) + boff + n * 2048); } while (0)
#define PG8_MMA(ai, bj, At, Bt) do { __builtin_amdgcn_s_setprio(1); _Pragma("unroll") for (int m = 0; m < 4; ++m) _Pragma("unroll") for (int n = 0; n < 2; ++n) \
        mma_step<MODE>(acc[ai][bj][m][n], Bt[n], At[m]); __builtin_amdgcn_s_setprio(0); } while (0)
#define PG8_WAIT_V(n) asm volatile("s_waitcnt vmcnt(" #n ")" ::: "memory")
#define PG8_WAIT_L(n) asm volatile("s_waitcnt lgkmcnt(" #n ")" ::: "memory")
#define PG8_BAR __builtin_amdgcn_s_barrier()
#define PG8_SCHED __builtin_amdgcn_sched_barrier(0)
    Unit cur, nxt; int ui = 0; typename Epi::Pre pre;
    if (!S.next(0, cur)) return;
    typename AccT<MODE == 1>::type acc[2][2][4][2];
#pragma unroll
    for (int a = 0; a < 2; ++a)
#pragma unroll
        for (int b = 0; b < 2; ++b)
#pragma unroll
            for (int m = 0; m < 4; ++m)
#pragma unroll
                for (int n = 0; n < 2; ++n) acc[a][b][m][n] = typename AccT<MODE == 1>::type{};
    typename Frag<MODE>::type At[4], B0[2], B1[2];
    const char* cA = S.a_base(cur); const char* cB = S.b_base(cur);
    S.a_ready(cur);
    if constexpr (SP2) {
        PG8_STAGE(PG8_SB(0, 0), cB, voffB); PG8_STAGE(PG8_SB(0, 1), cB + hstep, voffB); PG8_STAGE(PG8_SA(0, 0), cA, voffA); PG8_STAGE(PG8_SA(0, 1), cA + hstep, voffA);
        if (wr == 1) PG8_BAR;
        PG8_WAIT_V(2); PG8_BAR;
        PG8_STAGE(PG8_SB(1, 0), cB + kstep, voffB); PG8_STAGE(PG8_SA(1, 0), cA + kstep, voffA); PG8_STAGE(PG8_SB(1, 1), cB + hstep + kstep, voffB);
        PG8_WAIT_V(6); PG8_BAR;
    } else {
        PG8_STAGE(PG8_SB(0, 0), cB, voffB); PG8_STAGE(PG8_SA(0, 0), cA, voffA); PG8_STAGE(PG8_SB(0, 1), cB + hstep, voffB); PG8_STAGE(PG8_SA(0, 1), cA + hstep, voffA);
        if (wr == 1) PG8_BAR;
        PG8_WAIT_V(4); PG8_BAR;
        PG8_STAGE(PG8_SB(1, 0), cB + kstep, voffB); PG8_STAGE(PG8_SA(1, 0), cA + kstep, voffA); PG8_STAGE(PG8_SB(1, 1), cB + hstep + kstep, voffB);
        PG8_WAIT_V(6); PG8_BAR;
    }
    for (;;) {
        const bool has_next = S.next(ui + 1, nxt);
        const char* nA = has_next ? S.a_base(nxt) : cA; const char* nB = has_next ? S.b_base(nxt) : cB;
        for (int t = 0; t < nt; t += 2) {
            const bool last = (t == nt - 2);
            const char* a1 = cA + (size_t)(t + 1) * kstep;
            const char* a2 = last ? nA : cA + (size_t)(t + 2) * kstep; const char* b2 = last ? nB : cB + (size_t)(t + 2) * kstep;
            const char* a3 = a2 + kstep; const char* b3 = b2 + kstep;
            if (last && has_next) S.a_ready(nxt);
            if (last) E.prefetch(pre, cur, wr, wc, fr, fq, ui);
            if constexpr (SP2) {
            PG8_LDB(B0, 0, 0); PG8_LDB(B1, 0, 1); PG8_SCHED; PG8_LDA(At, 0, 0); PG8_STAGE(PG8_SA(1, 1), a1 + hstep, voffA);
            PG8_WAIT_V(8); PG8_WAIT_L(0); PG8_BAR; PG8_MMA(0, 0, At, B0); PG8_MMA(0, 1, At, B1); PG8_BAR; PG8_SCHED;
            PG8_LDA(At, 0, 1); PG8_STAGE(PG8_SB(0, 0), b2, voffB); PG8_STAGE(PG8_SB(0, 1), b2 + hstep, voffB); PG8_STAGE(PG8_SA(0, 0), a2, voffA);
            PG8_WAIT_V(8); PG8_WAIT_L(0); PG8_BAR; PG8_MMA(1, 0, At, B0); PG8_MMA(1, 1, At, B1); PG8_BAR; PG8_SCHED;
            PG8_LDB(B0, 1, 0); PG8_LDB(B1, 1, 1); PG8_SCHED; PG8_LDA(At, 1, 0); PG8_STAGE(PG8_SA(0, 1), a2 + hstep, voffA);
            PG8_WAIT_V(8); PG8_WAIT_L(0); PG8_BAR; PG8_MMA(0, 0, At, B0); PG8_MMA(0, 1, At, B1); PG8_BAR; PG8_SCHED;
            PG8_LDA(At, 1, 1); PG8_STAGE(PG8_SB(1, 0), b3, voffB); PG8_STAGE(PG8_SB(1, 1), b3 + hstep, voffB); PG8_STAGE(PG8_SA(1, 0), a3, voffA);
            PG8_WAIT_V(8); PG8_WAIT_L(0); PG8_BAR; PG8_MMA(1, 0, At, B0); PG8_MMA(1, 1, At, B1); PG8_BAR; PG8_SCHED;
            } else {
            PG8_LDB(B0, 0, 0); PG8_SCHED; PG8_LDA(At, 0, 0); PG8_STAGE(PG8_SA(1, 1), a1 + hstep, voffA);
            PG8_WAIT_L(8); PG8_BAR; PG8_WAIT_L(0); PG8_MMA(0, 0, At, B0); PG8_BAR; PG8_SCHED;
            PG8_LDB(B1, 0, 1); PG8_STAGE(PG8_SB(0, 0), b2, voffB);
            PG8_BAR; PG8_WAIT_L(0); PG8_MMA(0, 1, At, B1); PG8_BAR;
            PG8_LDA(At, 0, 1); PG8_STAGE(PG8_SA(0, 0), a2, voffA);
            PG8_BAR; PG8_WAIT_L(0); PG8_MMA(1, 0, At, B0); PG8_BAR; PG8_SCHED;
            PG8_STAGE(PG8_SB(0, 1), b2 + hstep, voffB);
            PG8_WAIT_V(6); PG8_BAR; PG8_MMA(1, 1, At, B1); PG8_BAR;
            PG8_LDB(B0, 1, 0); PG8_SCHED; PG8_LDA(At, 1, 0); PG8_STAGE(PG8_SA(0, 1), a2 + hstep, voffA);
            PG8_WAIT_L(8); PG8_BAR; PG8_WAIT_L(0); PG8_MMA(0, 0, At, B0); PG8_BAR; PG8_SCHED;
            PG8_LDB(B1, 1, 1); PG8_STAGE(PG8_SB(1, 0), b3, voffB);
            PG8_BAR; PG8_WAIT_L(0); PG8_MMA(0, 1, At, B1); PG8_BAR;
            PG8_LDA(At, 1, 1); PG8_STAGE(PG8_SA(1, 0), a3, voffA);
            PG8_BAR; PG8_WAIT_L(0); PG8_MMA(1, 0, At, B0); PG8_BAR; PG8_SCHED;
            PG8_STAGE(PG8_SB(1, 1), b3 + hstep, voffB);
            PG8_WAIT_V(6); PG8_BAR; PG8_MMA(1, 1, At, B1); PG8_BAR;
            }
        }
        E.commit(pre, wr, wc, fr, fq, ui);
        if constexpr (ALIGN_EPI) { if (wr == 0) PG8_BAR; }
        if constexpr (MODE == 2) asm volatile("s_nop 15\n\ts_nop 7" ::: "memory");
        if constexpr (!Epi::AFTER_DRAIN) { E(acc, cur, wr, wc, fr, fq, pre, ui); S.done(cur); }
        if (!has_next) break;
#pragma unroll
        for (int a = 0; a < 2; ++a)
#pragma unroll
            for (int b = 0; b < 2; ++b)
#pragma unroll
                for (int m = 0; m < 4; ++m)
#pragma unroll
                    for (int n = 0; n < 2; ++n) acc[a][b][m][n] = typename AccT<MODE == 1>::type{};
        cur = nxt; cA = nA; cB = nB; ++ui;
        if constexpr (ALIGN_EPI) { if (wr == 1) PG8_BAR; }
    }
    PG8_WAIT_V(0);
    if constexpr (!ALIGN_EPI) { if (wr == 0) PG8_BAR; }
    PG8_BAR;
    if constexpr (Epi::AFTER_DRAIN) { E.fused(acc, cur, wr, wc, fr, fq, lds, wid, lane); S.done(cur); }
#undef PG8_SA
#undef PG8_SB
#undef PG8_STAGE
#undef PG8_LDA
#undef PG8_LDB
#undef PG8_MMA
#undef PG8_WAIT_V
#undef PG8_WAIT_L
#undef PG8_BAR
#undef PG8_SCHED
}
}
#include <hip/hip_bf16.h>
#include <cmath>
namespace attn_body {
using bf16=__hip_bfloat16;
using bf16x8=__attribute__((ext_vector_type(8)))short;
using s16x4=__attribute__((ext_vector_type(4)))short;
using f32x16=__attribute__((ext_vector_type(16)))float;
using u32x4=__attribute__((ext_vector_type(4)))unsigned;
constexpr int BATCH=2,NHEAD=8,SEQ=8192,D=64,DM=3584,OPITCH=1024;
constexpr int NW=8,QBLK=32,QB=QBLK*NW,KVBLK=64,NQB=SEQ/QB;
constexpr int ATTN_PITCH=DM, ATTN_UNIT_ROWS=QB;
__device__ __forceinline__ int crow(int r,int hi){return (r&3)+8*(r>>2)+4*hi;}
#define SBAR() __builtin_amdgcn_sched_barrier(0)
__device__ __forceinline__ void cmask(f32x16&p0,f32x16&p1,int jb,int qrel,int hi){
  const float NEG=-INFINITY; int kb=64*jb+4*hi;
  #pragma unroll
  for(int r=0;r<16;++r){int kv=kb+(r&3)+8*(r>>2); if(kv>qrel)p0[r]=NEG; if(kv+32>qrel)p1[r]=NEG;}
}

constexpr int NSLOT=3, SLOTB=8192, SPLIT_NT=72, PART_F=256*64+512;
constexpr int LDS_K=0, LDS_V=NSLOT*SLOTB, LDS_WS=2*NSLOT*SLOTB, LDS_OST=LDS_WS+NW*64*4, LDS_CK=LDS_OST+NW*4096, LDS_BYTES=LDS_CK+SEQ*4;
constexpr float C2=0.125f*1.4426950408889634f;
__device__ __forceinline__ void glds16(const void*gsrc,unsigned lds_dst){unsigned keep;
  asm volatile("s_mov_b32 %0, m0\n\ts_mov_b32 m0, %2\n\ts_nop 0\n\tglobal_load_lds_dwordx4 %1, off\n\ts_mov_b32 m0, %0":"=&s"(keep):"v"(gsrc),"s"(lds_dst):"memory");}
__device__ __forceinline__ float max3f(float a,float b,float c){float r;asm("v_max3_f32 %0, %1, %2, %3":"=v"(r):"v"(a),"v"(b),"v"(c));return r;}
__device__ __forceinline__ float max2f(float a,float b){float r;asm("v_max_f32_e32 %0, %1, %2":"=v"(r):"v"(a),"v"(b));return r;}
__device__ __forceinline__ float fadd_s(float a,float b){float r;asm("v_add_f32_e32 %0, %1, %2":"=v"(r):"v"(a),"v"(b));return r;}
__device__ __forceinline__ float fsub_s(float a,float b){float r;asm("v_sub_f32_e32 %0, %1, %2":"=v"(r):"v"(a),"v"(b));return r;}
typedef float f32x2_t __attribute__((ext_vector_type(2))); typedef float f32x4_t __attribute__((ext_vector_type(4))); typedef __bf16 bf16x2_t __attribute__((ext_vector_type(2)));
__device__ __forceinline__ unsigned cvtpk_s(float lo,float hi){f32x2_t v={lo,hi};bf16x2_t b=__builtin_convertvector(v,bf16x2_t);return __builtin_bit_cast(unsigned,b);}
#define WAIT_BAR(N) asm volatile("s_waitcnt vmcnt(" #N ") lgkmcnt(0)\n\ts_barrier":::"memory")

__device__ __forceinline__ void qkt(f32x16&p0,f32x16&p1,const char*Kslot,const bf16x8*qr,const f32x16&negm,int r32,int hi){
  const char*kb=Kslot+hi*1024+r32*16;
  #pragma unroll
  for(int d0=0;d0<4;++d0){
    const bf16x8 b0=*reinterpret_cast<const bf16x8*>(kb+d0*2048);
    const bf16x8 b1=*reinterpret_cast<const bf16x8*>(kb+d0*2048+512);
    if(d0==0){p0=__builtin_amdgcn_mfma_f32_32x32x16_bf16(b0,qr[0],negm,0,0,0);p1=__builtin_amdgcn_mfma_f32_32x32x16_bf16(b1,qr[0],negm,0,0,0);}
    else{p0=__builtin_amdgcn_mfma_f32_32x32x16_bf16(b0,qr[d0],p0,0,0,0);p1=__builtin_amdgcn_mfma_f32_32x32x16_bf16(b1,qr[d0],p1,0,0,0);}}
}
typedef __attribute__((address_space(3))) const char* lds_cptr;
typedef short v4i16_t __attribute__((ext_vector_type(4)));
__device__ __forceinline__ void kload8(bf16x8*kf,lds_cptr kp){
  kf[0]=*(const __attribute__((address_space(3))) bf16x8*)(kp);      kf[1]=*(const __attribute__((address_space(3))) bf16x8*)(kp+512);
  kf[2]=*(const __attribute__((address_space(3))) bf16x8*)(kp+2048); kf[3]=*(const __attribute__((address_space(3))) bf16x8*)(kp+2560);
  kf[4]=*(const __attribute__((address_space(3))) bf16x8*)(kp+4096); kf[5]=*(const __attribute__((address_space(3))) bf16x8*)(kp+4608);
  kf[6]=*(const __attribute__((address_space(3))) bf16x8*)(kp+6144); kf[7]=*(const __attribute__((address_space(3))) bf16x8*)(kp+6656);
}
__device__ __forceinline__ void kload2(bf16x8*kf,lds_cptr kp,int j){ kf[2*j]=*(const __attribute__((address_space(3))) bf16x8*)(kp+j*2048); kf[2*j+1]=*(const __attribute__((address_space(3))) bf16x8*)(kp+j*2048+512); }
__device__ __forceinline__ s16x4 vtr(lds_cptr p){ return __builtin_bit_cast(s16x4,__builtin_amdgcn_ds_read_tr16_b64_v4i16((__attribute__((address_space(3))) v4i16_t*)p)); }
__device__ __forceinline__ float rowmax(const f32x16&p0,const f32x16&p1){
  float a=max3f(p0[0],p0[1],p1[0]),b=max3f(p0[2],p0[3],p1[1]);a=max3f(a,p1[2],p1[3]);
  #pragma unroll
  for(int r=4;r<16;r+=4){a=max3f(a,p0[r],p0[r+1]);b=max3f(b,p0[r+2],p0[r+3]);a=max3f(a,p1[r],p1[r+1]);b=max3f(b,p1[r+2],p1[r+3]);}
  const float m=max2f(a,b);
  auto rr=__builtin_amdgcn_permlane32_swap(__float_as_uint(m),__float_as_uint(m),false,false);
  return max2f(__uint_as_float(rr[0]),__uint_as_float(rr[1]));
}
__device__ __forceinline__ void pv(f32x16*o,int vb,bf16x8 pa0,bf16x8 pa1,bf16x8 pa2,bf16x8 pa3){
  #pragma unroll
  for(int d0=0;d0<2;++d0){s16x4 lo[4],hi[4];
    #pragma unroll
    for(int ks=0;ks<4;++ks){
      asm volatile("ds_read_b64_tr_b16 %0,%1 offset:%c2":"=&v"(lo[ks]):"v"(vb),"i"(d0*4096+ks*1024):"memory");
      asm volatile("ds_read_b64_tr_b16 %0,%1 offset:%c2":"=&v"(hi[ks]):"v"(vb),"i"(d0*4096+ks*1024+512):"memory");}
    asm volatile("s_waitcnt lgkmcnt(0)":::"memory");SBAR();
    #define PK(k) (bf16x8){lo[k][0],lo[k][1],lo[k][2],lo[k][3],hi[k][0],hi[k][1],hi[k][2],hi[k][3]}
    o[d0]=__builtin_amdgcn_mfma_f32_32x32x16_bf16(pa0,PK(0),o[d0],0,0,0);
    o[d0]=__builtin_amdgcn_mfma_f32_32x32x16_bf16(pa1,PK(1),o[d0],0,0,0);
    o[d0]=__builtin_amdgcn_mfma_f32_32x32x16_bf16(pa2,PK(2),o[d0],0,0,0);
    o[d0]=__builtin_amdgcn_mfma_f32_32x32x16_bf16(pa3,PK(3),o[d0],0,0,0);
    #undef PK
  }
}

#ifndef ATTN_STORE16
#define ATTN_STORE16(p,v) (*(u32x4*)(p)=(v))
#endif
template<int THRL> __device__ __forceinline__ void attn_unit(int b,int h,int qb,const bf16*Q,const bf16*__restrict__ K,const bf16*__restrict__ V,bf16*O,const float*__restrict__ cf,const float Tskip,const int part,float*PART,unsigned*flag,char*shm){
  int tid_=threadIdx.x; asm volatile("":"+v"(tid_));
  const int tid=tid_,lane=tid&63,r32=lane&31,hi=lane>>5; const int wid=__builtin_amdgcn_readfirstlane(tid>>6);
  const long rowbase=(long)b*SEQ; const int q0=qb*QB;
  const bf16*Qw=Q+(rowbase+q0+wid*QBLK)*DM+h*D;
  const unsigned lds0=(unsigned)(uintptr_t)shm;
  float*wsf=(float*)(shm+LDS_WS)+wid*64;
  const unsigned kdst=lds0+LDS_K+wid*1024, vdst=lds0+LDS_V+wid*1024;
  #define DMA_K(t,slot) glds16(ksrc+(long)(t)*KVBLK*DM,(unsigned)__builtin_amdgcn_readfirstlane(kdst+(slot)))
  #define DMA_V(t,slot) glds16(vsrc+(long)(t)*KVBLK*DM,(unsigned)__builtin_amdgcn_readfirstlane(vdst+(slot)))
  const int vb0=(int)(lds0+LDS_V)+((lane>>4)&1)*32+(lane&3)*8+(4*hi+((lane&15)>>2))*64;
  const char*Kbase=shm+LDS_K; bf16x8 kf[8];
  const lds_cptr shm3=(lds_cptr)shm; const lds_cptr kp0=shm3+LDS_K+hi*1024+r32*16; const lds_cptr vp0=shm3+LDS_V+((lane>>4)&1)*32+(lane&3)*8+(4*hi+((lane&15)>>2))*64;
  typedef __attribute__((address_space(3))) float lds_f32; typedef __attribute__((address_space(3))) const f32x4_t* lds_cf4;
  const int NT0=(q0+QB)/KVBLK;
  int tb;
  { const float thr=cf[q0]+Tskip; const int t1=lane,t2=lane+64;
    const bool n1=(t1<NT0)&&(cf[64*t1+63]>thr), n2=(t2<NT0)&&(cf[64*t2+63]>thr);
    const int t0=(int)__popcll(__ballot(n1))+(int)__popcll(__ballot(n2));
    tb=t0&~1; if(tb>NT0-4)tb=NT0-4; tb=__builtin_amdgcn_readfirstlane(tb); }
  int NT=NT0-tb; bool band=true; const bool split=(PART!=nullptr)&&(NT>SPLIT_NT);
  if(PART!=nullptr){ if(!split){ if(part==1)return; } else { const int mid=(NT>>1)&~1; if(part==0){NT=mid;band=false;} else {tb+=mid;NT-=mid;} } }
  { lds_f32* ckw=(lds_f32*)((lds_cptr)shm+LDS_CK); int i0_=tb*KVBLK+tid; asm volatile("":"+v"(i0_)); _Pragma("nounroll") for(int i=i0_;i<q0+QB;i+=NW*64)ckw[i]=cf[i]; }
  const float cq=cf[q0+wid*QBLK+(lane&31)];
  asm volatile("s_waitcnt vmcnt(0) lgkmcnt(0)\n\ts_barrier":::"memory");
  const bf16*Kh=K+(rowbase+(long)tb*KVBLK)*DM+h*D,*Vh=V+(rowbase+(long)tb*KVBLK)*DM+h*D;
  const bf16*ksrc=Kh+(long)lane*DM+wid*8;
  const bf16*vsrc=Vh+(long)(16*(wid&3)+(lane>>2))*DM+(wid>>2)*32+(lane&3)*8;
  const lds_cptr ckl=(lds_cptr)shm+LDS_CK+256*tb+16*(lane>>5);
  #define CBIAS(P0,P1,t) do{ const lds_cptr cb_=ckl+256*(t); _Pragma("unroll") for(int g_=0;g_<4;++g_){ const f32x4_t a_=*(lds_cf4)(cb_+32*g_), b_=*(lds_cf4)(cb_+128+32*g_); \
      _Pragma("unroll") for(int i_=0;i_<4;++i_){ P0[4*g_+i_]-=(a_[i_]+mm); P1[4*g_+i_]-=(b_[i_]+mm); } } }while(0)
  f32x4_t cbA[4],cbB[4]; float clast;
  #define CBLD(t) do{ const lds_cptr cb_=ckl+256*(t); _Pragma("unroll") for(int g_=0;g_<4;++g_){ cbA[g_]=*(lds_cf4)(cb_+32*g_); cbB[g_]=*(lds_cf4)(cb_+128+32*g_); } \
      clast=*(const __attribute__((address_space(3))) float*)((lds_cptr)shm+LDS_CK+256*tb+256*(t)+252); }while(0)
  DMA_K(0,0);DMA_V(0,0);DMA_K(1,SLOTB);
  bf16x8 qr[4];
  #pragma unroll
  for(int d0=0;d0<4;++d0)qr[d0]=*reinterpret_cast<const bf16x8*>(&Qw[(long)r32*DM+d0*16+hi*8]);
  float mhat=0.f,l_reg=0.f;f32x16 o[2];o[0]=f32x16{};o[1]=f32x16{};float mm=-cq; const f32x16 negm=f32x16{};
  const int qrel=wid*QBLK+r32;
  #define CMASK(P0,P1,t) do{int jb_=(t)-(NT-4); if(band&&jb_>=0)cmask(P0,P1,jb_,qrel,hi);}while(0)
  bool resc=false;
  #define START(P0,P1) do{ const float rm=rowmax(P0,P1); resc=false; \
    { const float dl=rm; mhat=fadd_s(mhat,dl); \
      _Pragma("unroll") for(int r=0;r<16;++r){P0[r]=fsub_s(P0[r],dl);P1[r]=fsub_s(P1[r],dl);} \
      mm+=dl; } \
    _Pragma("unroll") for(int r=0;r<16;++r)P0[r]=__builtin_amdgcn_exp2f(P0[r]); }while(0)
  #define RESC() do{ if(resc){ asm volatile("s_waitcnt lgkmcnt(0)":::"memory"); \
      _Pragma("unroll") for(int d_=0;d_<2;++d_) _Pragma("unroll") for(int r=0;r<16;++r)o[d_][r]*=wsf[crow(r,hi)]; } }while(0)
  f32x16 pA0,pA1,pB0,pB1;
  int sl_prev=0,sl_cur=0,sl_next=SLOTB;
  #define ROT() do{sl_prev=sl_cur;sl_cur=sl_next;sl_next=(sl_next==(NSLOT-1)*SLOTB)?0:sl_next+SLOTB;}while(0)
  DMA_K(2,2*SLOTB);
  WAIT_BAR(3);
  qkt(pA0,pA1,Kbase,qr,negm,r32,hi);asm volatile("s_nop 15\n\ts_nop 7":"+v"(pA0),"+v"(pA1));CBIAS(pA0,pA1,0);CMASK(pA0,pA1,0);
  START(pA0,pA1);
  _Pragma("unroll") for(int r=0;r<16;++r)pA1[r]=__builtin_amdgcn_exp2f(pA1[r]);
  WAIT_BAR(0);
  DMA_K(3,0);DMA_V(1,SLOTB);
  ROT();
  kload8(kf,kp0+sl_cur);
  WAIT_BAR(2);
  s16x4 vlo[8],vhi[8]; u32x4 pw0,pw1,pw2,pw3;
  #define PKW(P,B) cvtpk_s(P[B],P[B+1])
  #define PAF(k) __builtin_bit_cast(bf16x8,pw##k)
  #define VFR(i) (bf16x8){vlo[i][0],vlo[i][1],vlo[i][2],vlo[i][3],vhi[i][0],vhi[i][1],vhi[i][2],vhi[i][3]}
  #define PIN(x) asm volatile("":"+v"(x))
  #define MX3(a,b,c) __builtin_fmaxf(__builtin_fmaxf((a),(b)),(c))
  #define GAPA(MF,A0,A1,A2,A3,W0,W1,PW) do{ MF; sacc+=A0; sacc+=A1; sacc+=A2; sacc+=A3; PIN(sacc); W0; W1; PIN(PW); SBAR(); }while(0)
  #define EX(v) __builtin_amdgcn_exp2f(v)
  #define GAPB(MF,X,B,CB) do{ MF; { const f32x4_t t_=(CB)+mm; X[B]=EX(X[B]-t_[0]); X[B+1]=EX(X[B+1]-t_[1]); X[B+2]=EX(X[B+2]-t_[2]); X[B+3]=EX(X[B+3]-t_[3]); } PIN(X); SBAR(); }while(0)
  #define VRD(i) do{ vlo[i]=vtr(vp_+(((i)>>2)*4096+((i)&3)*1024)); vhi[i]=vtr(vp_+(((i)>>2)*4096+((i)&3)*1024+512)); }while(0)
  #define KRD(G,j) do{ if(G){ kload2(kf,kp0+sl_next,j); SBAR(); } }while(0)
  #define STEP(C0,C1,P0,P1,t,GK,GV,GL) do{ SBAR(); \
    const lds_cptr vp_=vp0+sl_prev; \
    VRD(0); SBAR(); float sacc=(P0[0]+P0[1]); \
    GAPA(C0=__builtin_amdgcn_mfma_f32_32x32x16_bf16(kf[0],qr[0],negm,0,0,0), P0[2],P0[3],P0[4],P0[5],     pw0[0]=PKW(P0,0), pw0[1]=PKW(P0,2), pw0); \
    VRD(4); SBAR(); GAPA(C1=__builtin_amdgcn_mfma_f32_32x32x16_bf16(kf[1],qr[0],negm,0,0,0), P0[6],P0[7],P0[8],P0[9],     pw0[2]=PKW(P0,4), pw0[3]=PKW(P0,6), pw0); \
    VRD(1); SBAR(); GAPA(C0=__builtin_amdgcn_mfma_f32_32x32x16_bf16(kf[2],qr[1],C0,0,0,0),   P0[10],P0[11],P0[12],P0[13], pw1[0]=PKW(P0,8), pw1[1]=PKW(P0,10), pw1); \
    VRD(5); SBAR(); GAPA(C1=__builtin_amdgcn_mfma_f32_32x32x16_bf16(kf[3],qr[1],C1,0,0,0),   P0[14],P0[15],P1[0],P1[1],   pw1[2]=PKW(P0,12),pw1[3]=PKW(P0,14), pw1); \
    VRD(2); SBAR(); GAPA(C0=__builtin_amdgcn_mfma_f32_32x32x16_bf16(kf[4],qr[2],C0,0,0,0),   P1[2],P1[3],P1[4],P1[5],     pw2[0]=PKW(P1,0), pw2[1]=PKW(P1,2), pw2); \
    VRD(6); SBAR(); GAPA(C1=__builtin_amdgcn_mfma_f32_32x32x16_bf16(kf[5],qr[2],C1,0,0,0),   P1[6],P1[7],P1[8],P1[9],     pw2[2]=PKW(P1,4), pw2[3]=PKW(P1,6), pw2); \
    VRD(3); SBAR(); GAPA(C0=__builtin_amdgcn_mfma_f32_32x32x16_bf16(kf[6],qr[3],C0,0,0,0),   P1[10],P1[11],P1[12],P1[13], pw3[0]=PKW(P1,8), pw3[1]=PKW(P1,10), pw3); \
    VRD(7); SBAR(); GAPA(C1=__builtin_amdgcn_mfma_f32_32x32x16_bf16(kf[7],qr[3],C1,0,0,0),   P1[14],P1[15],0.f,0.f,       pw3[2]=PKW(P1,12),pw3[3]=PKW(P1,14), pw3); \
    l_reg+=sacc; \
    if(GK){DMA_K((t)+3,sl_cur);} if(GV){DMA_V((t)+1,sl_next);} \
    CBLD(t); CMASK(C0,C1,t); \
    { float a=MX3(C0[0],C0[1],C1[0]),b=MX3(C0[2],C0[3],C1[1]); a=MX3(a,C1[2],C1[3]); \
      _Pragma("unroll") for(int r=4;r<16;r+=4){a=MX3(a,C0[r],C0[r+1]);b=MX3(b,C0[r+2],C0[r+3]);a=MX3(a,C1[r],C1[r+1]);b=MX3(b,C1[r+2],C1[r+3]);} \
      float rm=__builtin_fmaxf(a,b); { auto rr=__builtin_amdgcn_permlane32_swap(__float_as_uint(rm),__float_as_uint(rm),false,false); rm=__builtin_fmaxf(__uint_as_float(rr[0]),__uint_as_float(rr[1])); } rm=rm-clast-mm; \
      resc=false; \
      if(__builtin_expect(__any(rm>(float)THRL),0)){ const float dl=__builtin_fmaxf(rm,0.f); mhat+=dl; \
        mm+=dl; \
        const float f=__builtin_amdgcn_exp2f(-dl); l_reg*=f; if(hi==0)wsf[r32]=f; resc=true; } } \
    SBAR(); \
    GAPB(o[0]=__builtin_amdgcn_mfma_f32_32x32x16_bf16(PAF(0),VFR(0),o[0],0,0,0), C0,0,cbA[0]); \
    GAPB(o[1]=__builtin_amdgcn_mfma_f32_32x32x16_bf16(PAF(0),VFR(4),o[1],0,0,0), C0,4,cbA[1]); \
    KRD(GL,0); GAPB(o[0]=__builtin_amdgcn_mfma_f32_32x32x16_bf16(PAF(1),VFR(1),o[0],0,0,0), C0,8,cbA[2]); \
    KRD(GL,1); GAPB(o[1]=__builtin_amdgcn_mfma_f32_32x32x16_bf16(PAF(1),VFR(5),o[1],0,0,0), C0,12,cbA[3]); \
    KRD(GL,2); GAPB(o[0]=__builtin_amdgcn_mfma_f32_32x32x16_bf16(PAF(2),VFR(2),o[0],0,0,0), C1,0,cbB[0]); \
    KRD(GL,3); GAPB(o[1]=__builtin_amdgcn_mfma_f32_32x32x16_bf16(PAF(2),VFR(6),o[1],0,0,0), C1,4,cbB[1]); \
    GAPB(o[0]=__builtin_amdgcn_mfma_f32_32x32x16_bf16(PAF(3),VFR(3),o[0],0,0,0), C1,8,cbB[2]); \
    GAPB(o[1]=__builtin_amdgcn_mfma_f32_32x32x16_bf16(PAF(3),VFR(7),o[1],0,0,0), C1,12,cbB[3]); \
    }while(0)
  int t=1;
  #undef CMASK
  #define CMASK(P0,P1,t) do{}while(0)
  for(;t+5<NT;t+=2){
    STEP(pB0,pB1,pA0,pA1,t,true,true,true);     WAIT_BAR(2); RESC(); ROT();
    STEP(pA0,pA1,pB0,pB1,t+1,true,true,true);   WAIT_BAR(2); RESC(); ROT();
  }
  #undef CMASK
  #define CMASK(P0,P1,t) do{int jb_=(t)-(NT-4); if(band&&jb_>=0)cmask(P0,P1,jb_,qrel,hi);}while(0)
  #define ENDW(tt) do{ if((tt)+3<NT){WAIT_BAR(2);} else if((tt)+2<NT){WAIT_BAR(1);} else {WAIT_BAR(0);} }while(0)
  for(;t+1<NT;t+=2){
    STEP(pB0,pB1,pA0,pA1,t,(t+3<NT),(t+1<NT),(t+1<NT));       ENDW(t);   RESC(); ROT();
    STEP(pA0,pA1,pB0,pB1,t+1,(t+4<NT),(t+2<NT),(t+2<NT));     ENDW(t+1); RESC(); ROT();
  }
  STEP(pB0,pB1,pA0,pA1,NT-1,false,false,false); RESC();
  { float sacc=pB0[0]+pB0[1]; _Pragma("unroll") for(int r=2;r<16;++r)sacc+=pB0[r]; _Pragma("unroll") for(int r=0;r<16;++r)sacc+=pB1[r]; l_reg+=sacc;
    pw0=(u32x4){PKW(pB0,0),PKW(pB0,2),PKW(pB0,4),PKW(pB0,6)};pw1=(u32x4){PKW(pB0,8),PKW(pB0,10),PKW(pB0,12),PKW(pB0,14)};pw2=(u32x4){PKW(pB1,0),PKW(pB1,2),PKW(pB1,4),PKW(pB1,6)};pw3=(u32x4){PKW(pB1,8),PKW(pB1,10),PKW(pB1,12),PKW(pB1,14)};
    SBAR(); pv(o,vb0+sl_cur,PAF(0),PAF(1),PAF(2),PAF(3)); }
  #undef PKW
  #undef PAF
  #undef VFR
  #undef PIN
  #undef MX3
  #undef GAPA
  #undef GAPB
  #undef EX
  #undef VRD
  #undef KRD
  #undef STEP
  #undef ENDW
  {auto rr=__builtin_amdgcn_permlane32_swap(__float_as_uint(l_reg),__float_as_uint(l_reg),false,false);l_reg=__uint_as_float(rr[0])+__uint_as_float(rr[1]);}
  if(hi==0)wsf[32+r32]=l_reg;asm volatile("s_waitcnt lgkmcnt(0)":::"memory");
  float rli[16];
  if(split){
    float*Pm=PART+(size_t)part*PART_F; const float*Po=PART+(size_t)(1-part)*PART_F;
    #pragma unroll
    for(int r=0;r<16;++r){
      #pragma unroll
      for(int d0=0;d0<2;++d0)Pm[(wid*QBLK+crow(r,hi))*64+d0*32+r32]=o[d0][r];}
    if(hi==0){Pm[QB*64+(wid*QBLK+r32)*2]=mm+cq;Pm[QB*64+(wid*QBLK+r32)*2+1]=l_reg;wsf[r32]=mm+cq;}
    asm volatile("s_waitcnt vmcnt(0) lgkmcnt(0)\n\ts_barrier":::"memory");
    if(tid==0){ __builtin_amdgcn_fence(__ATOMIC_RELEASE,"agent"); asm volatile("s_waitcnt vmcnt(0)":::"memory");
      *(volatile __attribute__((address_space(3))) unsigned*)((__attribute__((address_space(3))) char*)shm+LDS_OST)=__hip_atomic_fetch_add(flag,1u,__ATOMIC_RELAXED,__HIP_MEMORY_SCOPE_AGENT); }
    asm volatile("s_waitcnt vmcnt(0) lgkmcnt(0)\n\ts_barrier":::"memory");
    const unsigned old=*(volatile __attribute__((address_space(3))) unsigned*)((__attribute__((address_space(3))) char*)shm+LDS_OST);
    asm volatile("s_waitcnt lgkmcnt(0)\n\ts_barrier":::"memory");
    if(old==0u)return;
    __builtin_amdgcn_fence(__ATOMIC_ACQUIRE,"agent"); asm volatile("s_waitcnt vmcnt(0)":::"memory");
    #pragma unroll
    for(int r=0;r<16;++r){ const int row=crow(r,hi); const float mo=wsf[row],lo=wsf[32+row],mt=Po[QB*64+(wid*QBLK+row)*2],lt=Po[QB*64+(wid*QBLK+row)*2+1];
      const float m=__builtin_fmaxf(mo,mt),fo=__builtin_amdgcn_exp2f(mo-m),ft=__builtin_amdgcn_exp2f(mt-m),inv=__builtin_amdgcn_rcpf(lo*fo+lt*ft);
      #pragma unroll
      for(int d0=0;d0<2;++d0)o[d0][r]=(o[d0][r]*fo+Po[(wid*QBLK+row)*64+d0*32+r32]*ft)*inv;
      rli[r]=1.f; }
  } else {
  #pragma unroll
  for(int r=0;r<16;++r)rli[r]=__builtin_amdgcn_rcpf(wsf[32+crow(r,hi)]);
  }
  bf16*Ow=O+(rowbase+q0+wid*QBLK)*OPITCH+h*D;
  { bf16*stg=(bf16*)(shm+LDS_OST)+wid*2048;
    #pragma unroll
    for(int r=0;r<16;++r){const int orow=crow(r,hi);
      #pragma unroll
      for(int d0=0;d0<2;++d0)stg[orow*64+d0*32+r32]=__float2bfloat16(o[d0][r]*rli[r]);}
    asm volatile("s_waitcnt lgkmcnt(0)":::"memory");
    #pragma unroll
    for(int i=0;i<4;++i){const int row=i*8+(lane>>3),ch=lane&7; const u32x4 v=*(const u32x4*)(stg+row*64+ch*8); ATTN_STORE16(Ow+(long)row*OPITCH+ch*8,v);} }
  asm volatile("s_waitcnt lgkmcnt(0)\n\ts_barrier":::"memory");
  #undef CBIAS
  #undef CBLD
  #undef DMA_K
  #undef DMA_V
  #undef CMASK
  #undef START
  #undef RESC
  #undef ROT
}
constexpr int ATTN_LDS_BYTES=LDS_BYTES;
struct AttnTensors { const bf16* Q; const bf16* K; const bf16* V; bf16* O; const float* CF; const float* stat; };
struct AttnUnit { int bh; int qb; };
struct StaticOrder {
  int vcu;
  __device__ __forceinline__ explicit StaticOrder(int grid,int block):vcu((grid%8==0)?(block%8)*(grid/8)+block/8:block),G_(grid){}
  int G_;
  __device__ __forceinline__ bool next(int i,AttnUnit&u)const{ const int v=vcu+(i>>1)*G_; if(v>=256)return false; const int s=v&15; u.bh=v>>4; u.qb=(i&1)?31-s:s; return true; }
  __device__ __forceinline__ void a_ready(const AttnUnit&)const{}
  __device__ __forceinline__ void done(const AttnUnit&)const{}
};
struct QueueOrder {
  unsigned* ctr; __attribute__((address_space(3))) unsigned* slot;
  __device__ __forceinline__ bool next(int,AttnUnit&u)const{
    if(threadIdx.x==0)*slot=__hip_atomic_fetch_add(ctr,1u,__ATOMIC_RELAXED,__HIP_MEMORY_SCOPE_AGENT);
    asm volatile("s_waitcnt vmcnt(0) lgkmcnt(0)\n\ts_barrier":::"memory");
    const unsigned v=*(volatile __attribute__((address_space(3))) unsigned*)slot; const int vv=__builtin_amdgcn_readfirstlane((int)v);
    if(vv>=512)return false; u.qb=31-(vv>>4); u.bh=vv&15; return true; }
  __device__ __forceinline__ void a_ready(const AttnUnit&)const{}
  __device__ __forceinline__ void done(const AttnUnit&)const{}
};
template<class Sched,int THRL=8> __device__ __forceinline__ void attn_phase(char*lds,const AttnTensors&T,const Sched&S){
  AttnUnit u;
  for(int i=0;S.next(i,u);++i){ S.a_ready(u); const float Tsk=40.f+2.f*__builtin_sqrtf(T.stat[u.bh*2]*T.stat[u.bh*2+1])*1.01f+1.f;
    attn_unit<THRL>(u.bh/NHEAD,u.bh%NHEAD,u.qb,T.Q,T.K,T.V,T.O,T.CF+(long)u.bh*SEQ,Tsk,0,nullptr,nullptr,lds); S.done(u); }
}
#undef SBAR
#undef WAIT_BAR
}
#define GAS __attribute__((address_space(1)))
#define LAS __attribute__((address_space(3)))
typedef unsigned v4u __attribute__((ext_vector_type(4)));
typedef float f32x4 __attribute__((ext_vector_type(4)));
typedef short bf16x8 __attribute__((ext_vector_type(8)));
typedef GAS unsigned gu32;
typedef GAS unsigned long long gu64;
#define RLX_AGENT __ATOMIC_RELAXED, __HIP_MEMORY_SCOPE_AGENT
#define LDS_WAIT() asm volatile("s_waitcnt lgkmcnt(0)" ::: "memory")
#define VM_WAIT() asm volatile("s_waitcnt vmcnt(0)" ::: "memory")
__device__ __forceinline__ unsigned long long rt() { return __builtin_amdgcn_s_memrealtime(); }
__device__ __forceinline__ unsigned pk2(float lo, float hi) { return (unsigned)f2bf(lo) | ((unsigned)f2bf(hi) << 16); }

#define XB_TMO      128
#define XB_XCNT(j)  (256  + 64 * (j))
#define XB_XSUB(j)  (1280 + 64 * (j))
#define XB_XGEN(j)  (2304 + 64 * (j))
#define XB_TOP      3328
#define XB_TOPGEN   3392
#define XCD_BAR_WORDS 3456
#define XB_SPIN_CAP (1u << 18)

__device__ __forceinline__ unsigned xb_ld(unsigned* p)              { return __hip_atomic_load(p, __ATOMIC_RELAXED, __HIP_MEMORY_SCOPE_AGENT); }
__device__ __forceinline__ unsigned xb_add(unsigned* p, unsigned v) { return __hip_atomic_fetch_add(p, v, __ATOMIC_RELAXED, __HIP_MEMORY_SCOPE_AGENT); }
__device__ __forceinline__ unsigned xb_xcc_id() { return (unsigned)__builtin_amdgcn_s_getreg((3 << 11) | 20) & 0xFu; }
#define XB_SPIN(cond, bar) do { unsigned _sp = 0; while (cond) { __builtin_amdgcn_s_sleep(1); \
    if ((++_sp & 255u) == 0u) { if (xb_ld(&(bar)[XB_TMO])) break; if (_sp > XB_SPIN_CAP) { atomicAdd(&(bar)[XB_TMO], 1u); break; } } } } while (0)

struct XcdBarrier {
    unsigned* bar; unsigned x;
    volatile LAS unsigned* st;
};

__device__ __forceinline__ XcdBarrier xcd_barrier_post(unsigned* bar, volatile LAS unsigned* st) {
    XcdBarrier b; b.bar = bar; b.x = xb_xcc_id(); b.st = st;
    if (threadIdx.x == 0) (void)xb_add(&bar[XB_XCNT(b.x)], 1u);
    return b;
}
__device__ __forceinline__ void xcd_barrier_complete(unsigned* bar, unsigned x, unsigned& nloc, unsigned& nx) {
    const unsigned G = gridDim.x * gridDim.y * gridDim.z;
    unsigned sum, cnt, mine, sp = 0u;
    for (;;) {
        sum = 0u; cnt = 0u; mine = 0u;
#pragma unroll
        for (unsigned j = 0; j < 16; ++j) { const unsigned c = xb_ld(&bar[XB_XCNT(j)]); sum += c; cnt += (c > 0u) ? 1u : 0u; mine = (j == x) ? c : mine; }
        if (sum == G) break;
        __builtin_amdgcn_s_sleep(1);
        if ((++sp & 255u) == 0u) { if (xb_ld(&bar[XB_TMO])) break; if (sp > XB_SPIN_CAP) { atomicAdd(&bar[XB_TMO], 1u); break; } }
    }
    nloc = mine > 0u ? mine : 1u; nx = cnt > 0u ? cnt : 1u;
}

__device__ __forceinline__ void xcd_barrier(const XcdBarrier& b) {
    asm volatile("s_waitcnt vmcnt(0)" ::: "memory");
    __syncthreads();
    if (threadIdx.x == 0) {
        unsigned* bar = b.bar;
        __builtin_amdgcn_s_waitcnt(0);
        unsigned nloc = b.st[0], nx = b.st[1];
        if (nloc == 0u) { xcd_barrier_complete(bar, b.x, nloc, nx); b.st[0] = nloc; b.st[1] = nx; }
        const unsigned old = xb_add(&bar[XB_XSUB(b.x)], 1u);
        const unsigned gen = old / nloc;
        if (old + 1u == (gen + 1u) * nloc) {
            __builtin_amdgcn_fence(__ATOMIC_RELEASE, "agent");
            asm volatile("s_waitcnt vmcnt(0)" ::: "memory");
            const unsigned og = xb_add(&bar[XB_TOP], 1u);
            const unsigned tg = og / nx;
            if (og + 1u == (tg + 1u) * nx) xb_add(&bar[XB_TOPGEN], 1u);
            else XB_SPIN(xb_ld(&bar[XB_TOPGEN]) == tg, bar);
            __builtin_amdgcn_fence(__ATOMIC_ACQUIRE, "agent");
            xb_add(&bar[XB_XGEN(b.x)], 1u);
            asm volatile("s_waitcnt vmcnt(0)" ::: "memory");
        } else {
            XB_SPIN(xb_ld(&bar[XB_XGEN(b.x)]) == gen, bar);
            __builtin_amdgcn_fence(__ATOMIC_ACQUIRE, "agent");
            asm volatile("s_waitcnt vmcnt(0)" ::: "memory");
        }
    }
    __syncthreads();
}
constexpr int NWAVES = 8, NTHR = 512;
constexpr int RING_OFF = 0, RING_BYTES = 131072, LDSCTL_OFF = RING_BYTES, MISC_OFF = LDSCTL_OFF + 320, LDS_BYTES = 147456;
constexpr int CW_BAR = 4096;
constexpr size_t WS_WIN = WS_W  , WS_SWIN = WS_W + 8 * MiB  , WS_WOUT = WS_W + 14 * MiB  , WS_WDGU = WS_W + 18 * MiB  , WS_SWDGU = WS_W + 24 * MiB  , WS_WDDN = WS_W + 29 * MiB  ;
constexpr size_t WS_SH = WS_H + 16 * MiB  , WS_SXG = WS_XG + 34 * MiB  ;
constexpr size_t WS_WMGU = WS_W  , WS_SWMGU = WS_W + 60 * MiB  , WS_WMDN = WS_W + 64 * MiB  ;
static_assert(WS_WMDN + 56 * MiB <= 469 * MiB, "ws");
struct MArgs { const float* in[20]; float* out; unsigned char* ws; int ph_lo, ph_hi; };
enum { I_X = 0, I_ATTN_NORM, I_W_IN, I_HGRN_LB, I_HGRN_NORM, I_MLSTM_CONV, I_MLSTM_BI, I_MLSTM_BF, I_MLSTM_NORM, I_FOX_BF, I_W_OUT, I_FFN_NORM, I_DGATE, I_DUP, I_DDOWN, I_ROUTER, I_MGATE, I_MUP, I_MDOWN, I_FINAL_NORM };

__device__ __forceinline__ void tr_item(const float* W, int ldw, int K, bf16_t* WT, LAS float* scr, int k0, int lane) {
#pragma unroll 32
    for (int i = 0; i < 32; ++i) { const int kk = 2 * i + (lane >> 5); scr[kk * 33 + (lane & 31)] = W[(size_t)(k0 + kk) * ldw + (lane & 31)]; }
    LDS_WAIT(); asm volatile("" ::: "memory");
    const int c = lane & 7;
#pragma unroll
    for (int j = 0; j < 4; ++j) { const int n = (lane >> 3) + 8 * j; const LAS float* s = scr + (8 * c) * 33 + n;
        v4u o; o.x = pk2(s[0 * 33], s[1 * 33]); o.y = pk2(s[2 * 33], s[3 * 33]); o.z = pk2(s[4 * 33], s[5 * 33]); o.w = pk2(s[6 * 33], s[7 * 33]);
        *(GAS v4u*)(WT + (size_t)n * K + k0 + 8 * c) = o; }
    LDS_WAIT(); asm volatile("" ::: "memory");
}
__device__ __forceinline__ void tr_item_f8(const float* W, int ldw, int K, unsigned char* WT8, LAS float* scr, int k0, int lane, const float wscale) {
#pragma unroll 8
    for (int i = 0; i < 32; ++i) { const int kk = 2 * i + (lane >> 5); scr[kk * 33 + (lane & 31)] = W[(size_t)(k0 + kk) * ldw + (lane & 31)]; }
    LDS_WAIT(); asm volatile("" ::: "memory");
    const int c = lane & 7;
#pragma unroll
    for (int j = 0; j < 4; ++j) { const int n = (lane >> 3) + 8 * j; const LAS float* s = scr + (8 * c) * 33 + n; float h[8];
#pragma unroll
        for (int i = 0; i < 8; ++i) h[i] = __builtin_fminf(__builtin_fmaxf(s[i * 33] * wscale, -448.f), 448.f);
        unsigned w0 = 0u, w1 = 0u; w0 = __builtin_amdgcn_cvt_pk_fp8_f32(h[0], h[1], w0, false); w0 = __builtin_amdgcn_cvt_pk_fp8_f32(h[2], h[3], w0, true);
        w1 = __builtin_amdgcn_cvt_pk_fp8_f32(h[4], h[5], w1, false); w1 = __builtin_amdgcn_cvt_pk_fp8_f32(h[6], h[7], w1, true);
        typedef unsigned u32x2_ __attribute__((ext_vector_type(2))); *(GAS u32x2_*)(WT8 + (size_t)n * K + k0 + 8 * c) = (u32x2_){w0, w1}; }
    LDS_WAIT(); asm volatile("" ::: "memory");
}
__device__ __forceinline__ int glu_row(int c, int up) { return (c >> 7) * 256 + (c & 127) + up * 128; }

struct RowIn { float4 v[4]; };
template <bool BF> __device__ __forceinline__ void mrow_load(RowIn& R, const void* src, int row, int lane) {
    if (BF) { const uint2* xr = (const uint2*)((const bf16_t*)src + (size_t)row * D) + lane;
#pragma unroll
        for (int j = 0; j < 4; ++j) { const uint2 w = xr[64 * j]; R.v[j] = make_float4(__uint_as_float(w.x << 16), __uint_as_float(w.x & 0xffff0000u), __uint_as_float(w.y << 16), __uint_as_float(w.y & 0xffff0000u)); } }
    else { const float4* xr = (const float4*)((const float*)src + (size_t)row * D) + lane;
#pragma unroll
        for (int j = 0; j < 4; ++j) R.v[j] = xr[64 * j]; } }
template <int MODE> __device__ __forceinline__ void mrow(const RowIn& R, signed char* H8, float* SH, const float* gain, const LAS float* tab, float* G, int row, int lane, float (&lg)[8]) {
    float4 v[4]; float ss = 0.f;
#pragma unroll
    for (int j = 0; j < 4; ++j) { v[j] = R.v[j]; ss += v[j].x * v[j].x + v[j].y * v[j].y + v[j].z * v[j].z + v[j].w * v[j].w; }
    ss = wave_sum(ss);
    const float r = rsqrtf(ss * (1.f / D) + EPS);
    float h[16];
#pragma unroll
    for (int j = 0; j < 4; ++j) { const float4 g = *((const float4*)gain + 64 * j + lane);
        h[4 * j + 0] = v[j].x * r * g.x; h[4 * j + 1] = v[j].y * r * g.y; h[4 * j + 2] = v[j].z * r * g.z; h[4 * j + 3] = v[j].w * r * g.w; }
    if (MODE == 2) {
#pragma unroll
      for (int j = 0; j < 4; ++j) { float q[4];
#pragma unroll
          for (int i = 0; i < 4; ++i) q[i] = __builtin_fminf(__builtin_fmaxf(h[4 * j + i] * pg8::F8_ASCALE, -448.f), 448.f);
          unsigned w = 0u; w = __builtin_amdgcn_cvt_pk_fp8_f32(q[0], q[1], w, false); w = __builtin_amdgcn_cvt_pk_fp8_f32(q[2], q[3], w, true);
          *((unsigned*)(H8 + (size_t)row * D) + 64 * j + lane) = w; }
    } else
    { float am = 0.f;
#pragma unroll
      for (int i = 0; i < 16; ++i) am = fmaxf(am, fabsf(h[i]));
#pragma unroll
      for (int o = 1; o < 64; o <<= 1) am = fmaxf(am, __shfl_xor(am, o));
      const float inv = am > 0.f ? 127.f / am : 0.f;
#pragma unroll
      for (int j = 0; j < 4; ++j) { const int q0 = (int)rintf(h[4 * j] * inv), q1 = (int)rintf(h[4 * j + 1] * inv), q2 = (int)rintf(h[4 * j + 2] * inv), q3 = (int)rintf(h[4 * j + 3] * inv);
          *((unsigned*)(H8 + (size_t)row * D) + 64 * j + lane) = (unsigned)(q0 & 255) | ((unsigned)(q1 & 255) << 8) | ((unsigned)(q2 & 255) << 16) | ((unsigned)(q3 & 255) << 24); }
      if (lane == 0) SH[row] = am > 0.f ? am * (1.f / 127.f) : 1.f; }
    if (MODE == 0) {
        float mine = 0.f;
#pragma unroll 2
        for (int c = 0; c < 16; ++c) { float s = 0.f;
#pragma unroll
            for (int j = 0; j < 4; ++j) { const f32x4 w = *(const LAS f32x4*)(tab + c * 1024 + 256 * j + 4 * lane); s += h[4 * j] * w[0] + h[4 * j + 1] * w[1] + h[4 * j + 2] * w[2] + h[4 * j + 3] * w[3]; }
            s = wave_sum(s); if (lane == c) mine = s; }
        if (lane < 16) G[(size_t)row * GW + lane] = mine;
    }
    if (MODE == 2) {
        float v0 = -INFINITY, v1 = -INFINITY; int e0 = 0, e1 = 0;
#pragma unroll 2
        for (int c = 0; c < 8; ++c) { float s = 0.f;
#pragma unroll
            for (int j = 0; j < 4; ++j) { const f32x4 w = *(const LAS f32x4*)(tab + c * 1024 + 256 * j + 4 * lane); s += h[4 * j] * w[0] + h[4 * j + 1] * w[1] + h[4 * j + 2] * w[2] + h[4 * j + 3] * w[3]; }
            s = wave_sum(s);
            if (s > v0) { v1 = v0; e1 = e0; v0 = s; e0 = c; } else if (s > v1) { v1 = s; e1 = c; } }
        lg[0] = v0; lg[1] = v1; lg[2] = __int_as_float(e0); lg[3] = __int_as_float(e1);
    }
}
__device__ __forceinline__ void load_gate_tab(LAS float* tab, const float* w_in, int tid) {
    for (int k = tid; k < D; k += NTHR) { const float4* w0 = (const float4*)(w_in + (size_t)k * DIN + 1792); const float4* w1 = (const float4*)(w_in + (size_t)k * DIN + 3592);
        const float4 a0 = w0[0], a1 = w0[1], b0 = w1[0], b1 = w1[1];
        tab[0 * 1024 + k] = a0.x; tab[1 * 1024 + k] = a0.y; tab[2 * 1024 + k] = a0.z; tab[3 * 1024 + k] = a0.w; tab[4 * 1024 + k] = a1.x; tab[5 * 1024 + k] = a1.y; tab[6 * 1024 + k] = a1.z; tab[7 * 1024 + k] = a1.w;
        tab[8 * 1024 + k] = b0.x; tab[9 * 1024 + k] = b0.y; tab[10 * 1024 + k] = b0.z; tab[11 * 1024 + k] = b0.w; tab[12 * 1024 + k] = b1.x; tab[13 * 1024 + k] = b1.y; tab[14 * 1024 + k] = b1.z; tab[15 * 1024 + k] = b1.w; }
}
__device__ __forceinline__ void load_router_tab(LAS float* tab, const float* router, int tid) {
    for (int k = tid; k < D; k += NTHR) { const float4* w0 = (const float4*)(router + (size_t)k * NE); const float4 a0 = w0[0], a1 = w0[1];
        tab[0 * 1024 + k] = a0.x; tab[1 * 1024 + k] = a0.y; tab[2 * 1024 + k] = a0.z; tab[3 * 1024 + k] = a0.w; tab[4 * 1024 + k] = a1.x; tab[5 * 1024 + k] = a1.y; tab[6 * 1024 + k] = a1.z; tab[7 * 1024 + k] = a1.w; }
}
struct Conv8Job { const float* W; int ldw; signed char* WT8; float* S; };
__device__ __forceinline__ void conv8_load(float (&v)[64], const Conv8Job& j, int tid, int wave) {
    const int lane = tid & 63, n = lane & 31, kp = lane >> 5;
#pragma unroll
    for (int i = 0; i < 64; ++i) v[i] = j.W[(size_t)(128 * wave + 2 * i + kp) * j.ldw + n];
}
__device__ __forceinline__ void conv8_stage(const float (&v)[64], LAS float* img, LAS float* pm, int tid, int wave) {
    const int lane = tid & 63, n = lane & 31, kp = lane >> 5; float m = 0.f;
#pragma unroll
    for (int i = 0; i < 64; ++i) { img[(128 * wave + 2 * i + kp) * 32 + n] = v[i]; m = fmaxf(m, fabsf(v[i])); }
    m = fmaxf(m, __shfl_xor(m, 32));
    if (lane < 32) pm[wave * 32 + lane] = m;
    __syncthreads();
}
__device__ __forceinline__ void conv8_quant(const Conv8Job& j, LAS float* img, LAS float* pm, int tid, int wave) {
    const int lane = tid & 63, no = lane >> 1, kh = 128 * wave + 64 * (lane & 1);
    float cm = 0.f;
#pragma unroll
    for (int w = 0; w < 8; ++w) cm = fmaxf(cm, pm[w * 32 + no]);
    const float inv = cm > 0.f ? 127.f / cm : 0.f;
    if (wave == 0 && (lane & 1) == 0) j.S[no] = cm > 0.f ? cm * (1.f / 127.f) : 1.f;
    const LAS float* sp = img + kh * 32 + no;
#pragma unroll
    for (int q = 0; q < 4; ++q) { unsigned wq[4];
#pragma unroll
        for (int jj = 0; jj < 4; ++jj) { const int kk = 16 * q + 4 * jj; const int q0 = (int)rintf(sp[kk * 32] * inv), q1 = (int)rintf(sp[(kk + 1) * 32] * inv), q2 = (int)rintf(sp[(kk + 2) * 32] * inv), q3 = (int)rintf(sp[(kk + 3) * 32] * inv);
            wq[jj] = (unsigned)(q0 & 255) | ((unsigned)(q1 & 255) << 8) | ((unsigned)(q2 & 255) << 16) | ((unsigned)(q3 & 255) << 24); }
        v4u o; o.x = wq[0]; o.y = wq[1]; o.z = wq[2]; o.w = wq[3];
        *(GAS v4u*)(j.WT8 + (size_t)no * 1024 + kh + 16 * q) = o; }
    __syncthreads();
}
namespace scan {
typedef short bf16x8 __attribute__((ext_vector_type(8)));
typedef float f32x4 __attribute__((ext_vector_type(4)));
typedef unsigned v2u __attribute__((ext_vector_type(2)));
constexpr int TS = 144, TB = 64 * TS;
constexpr int L_T0 = 0, L_T1 = TB, L_T2 = 2 * TB, L_T3 = 3 * TB, L_T4 = 4 * TB, L_T5 = 5 * TB, L_O = 6 * TB, OS = 68  , L_PART = L_O + 64 * OS * 4, L_VEC = L_PART + 8 * 64 * 4, L_END = L_VEC + 8 * 64 * 4;
static_assert(L_END <= RING_BYTES, "scan LDS");
constexpr size_t SC_LHG = 0, SC_LML = 16 * MiB, SC_DEC = 32 * MiB  , SC_NL = 32 * MiB + 256 * 1024  , SC_AMAX = 32 * MiB + 512 * 1024, SC_BEND = SC_AMAX + 4096, SC_MPREV = SC_BEND + 4096;

__device__ __forceinline__ float wave_incl_add(float v, int lane) {
#pragma unroll
    for (int o = 1; o < 64; o <<= 1) { const float u = __shfl_up(v, o); if (lane >= o) v += u; }
    return v;
}
__device__ __forceinline__ float wave_incl_max(float v, int lane) {
#pragma unroll
    for (int o = 1; o < 64; o <<= 1) { const float u = __shfl_up(v, o); if (lane >= o) v = fmaxf(v, u); }
    return v;
}
__device__ __forceinline__ float wave_max(float v) {
#pragma unroll
    for (int o = 1; o < 64; o <<= 1) v = fmaxf(v, __shfl_xor(v, o));
    return v;
}
__device__ __forceinline__ f32x4 mma64(LAS const unsigned char* A, LAS const unsigned char* B, int m0, int n0, int lane, f32x4 acc) {
    const int r = lane & 15, kq = lane >> 4;
#pragma unroll
    for (int ks = 0; ks < 2; ++ks) {
        const bf16x8 a = *(LAS const bf16x8*)(A + (m0 + r) * TS + kq * 16 + ks * 64);
        const bf16x8 b = *(LAS const bf16x8*)(B + (n0 + r) * TS + kq * 16 + ks * 64);
        acc = __builtin_amdgcn_mfma_f32_16x16x32_bf16(a, b, acc, 0, 0, 0);
    }
    return acc;
}
__device__ __forceinline__ v4u pack8(const float (&v)[8]) { v4u w; w.x = pk2(v[0], v[1]); w.y = pk2(v[2], v[3]); w.z = pk2(v[4], v[5]); w.w = pk2(v[6], v[7]); return w; }
__device__ __forceinline__ v4u pack8h(const bf16_t (&v)[8]) { v4u w; w.x = v[0] | ((unsigned)v[1] << 16); w.y = v[2] | ((unsigned)v[3] << 16); w.z = v[4] | ((unsigned)v[5] << 16); w.w = v[6] | ((unsigned)v[7] << 16); return w; }
__device__ __forceinline__ void st16(LAS unsigned char* p, float v) { *(LAS bf16_t*)p = f2bf(v); }
__device__ __forceinline__ void load_state_tile(LAS unsigned char* T, const float* S, int tid) {
    const int v = tid >> 3, d0 = (tid & 7) * 8; const float4 x0 = *(const float4*)(S + v * 64 + d0), x1 = *(const float4*)(S + v * 64 + d0 + 4);
    v4u w; w.x = pk2(x0.x, x0.y); w.y = pk2(x0.z, x0.w); w.z = pk2(x1.x, x1.y); w.w = pk2(x1.z, x1.w);
    *(LAS v4u*)(T + v * TS + d0 * 2) = w;
}
__device__ __forceinline__ void local_state_mma_store(LAS unsigned char* L, float* LT, int wave, int lane) {
    const int mt = wave >> 1;
#pragma unroll
    for (int nn = 0; nn < 2; ++nn) { const int nt = 2 * (wave & 1) + nn; f32x4 acc = {0.f, 0.f, 0.f, 0.f};
        acc = mma64(L + L_T1, L + L_T0, mt * 16, nt * 16, lane, acc);
#pragma unroll
        for (int r = 0; r < 4; ++r) LT[(mt * 16 + 4 * (lane >> 4) + r) * 64 + nt * 16 + (lane & 15)] = acc[r]; }
}

struct HgIn { bf16_t fz[8], q[8], iv[8]; v4u gate; float4 s0, s1; };
template <bool DPH> __device__ __forceinline__ void hgrn_load(HgIn& R, const bf16_t* P, int b, int c, int h, const float* ST, int tid, int wave) {
    const int d = tid & 63, tq = wave, row0 = b * SEQ + c * 64; const bf16_t* pr = P + (size_t)(row0 + 8 * tq) * PW + h * 64 + d;
#pragma unroll
    for (int i = 0; i < 8; ++i) { R.fz[i] = pr[(size_t)i * PW + P_HF]; R.iv[i] = pr[(size_t)i * PW + P_HI]; if (DPH) R.q[i] = pr[(size_t)i * PW + P_HQ]; }
    if (DPH) { const int t = tid >> 3, v0 = (tid & 7) * 8; R.gate = *(const v4u*)(P + (size_t)(row0 + t) * PW + P_HG + h * 64 + v0);
        R.s0 = *(const float4*)(ST + t * 64 + v0); R.s1 = *(const float4*)(ST + t * 64 + v0 + 4); }
}
struct MlIn { bf16_t qr[11], kr[11], vv[8]; float ig, fg, np, mprev; v4u gate; float4 s0, s1; };
template <bool DPH> __device__ __forceinline__ void mlstm_load(MlIn& R, const bf16_t* P, const float* G, int b, int c, int h, const float* CT, const float* NP, const float* MP, int tid, int wave) {
    const int d = tid & 63, tq = wave, lane = tid & 63, row0 = b * SEQ + c * 64; const bool fz3 = (c == 0 && tq == 0);
    const bf16_t* pk = P + (size_t)(row0 + 8 * tq) * PW + P_MK + h * 64 + d; const bf16_t* pq = P + (size_t)(row0 + 8 * tq) * PW + P_MQ + h * 64 + d;
#pragma unroll
    for (int j = 0; j < 11; ++j) { R.kr[j] = (j < 3 && fz3) ? (bf16_t)0 : pk[((long)j - 3) * PW]; if (DPH) R.qr[j] = (j < 3 && fz3) ? (bf16_t)0 : pq[((long)j - 3) * PW]; }
#pragma unroll
    for (int i = 0; i < 8; ++i) R.vv[i] = P[(size_t)(row0 + 8 * tq + i) * PW + P_MV + h * 64 + d];
    R.ig = G[(size_t)(row0 + lane) * GW + h]; R.fg = G[(size_t)(row0 + lane) * GW + 4 + h];
    if (DPH) { const int t = tid >> 3, v0 = (tid & 7) * 8; R.gate = *(const v4u*)(P + (size_t)(row0 + t) * PW + P_MO + h * 64 + v0);
        R.s0 = *(const float4*)(CT + t * 64 + v0); R.s1 = *(const float4*)(CT + t * 64 + v0 + 4); R.np = NP[lane]; R.mprev = MP[0]; }
}
__device__ __forceinline__ void store_state_tile(LAS unsigned char* T, const float4& x0, const float4& x1, int tid) {
    const int v = tid >> 3, d0 = (tid & 7) * 8; v4u w; w.x = pk2(x0.x, x0.y); w.y = pk2(x0.z, x0.w); w.z = pk2(x1.x, x1.y); w.w = pk2(x1.z, x1.w);
    *(LAS v4u*)(T + v * TS + d0 * 2) = w;
}
__device__ __forceinline__ void conv_silu8r(const bf16_t (&raw)[11], const float* w4  , float scale, float (&out)[8]) {
    const float w0 = w4[0], w1 = w4[512], w2 = w4[1024], w3 = w4[1536];
#pragma unroll
    for (int i = 0; i < 8; ++i) out[i] = siluf_(w0 * bf2f(raw[i]) + w1 * bf2f(raw[i + 1]) + w2 * bf2f(raw[i + 2]) + w3 * bf2f(raw[i + 3])) * scale;
}
__device__ __forceinline__ void hgrn_b_item(LAS unsigned char* L, const HgIn& R, float lb, float* LT, float* DEC, int tid, int wave) {
    const int d = tid & 63, tq = wave;
    float bl[8], kh[8]; float run = 0.f;
#pragma unroll
    for (int i = 0; i < 8; ++i) { const float fz = bf2f(R.fz[i]);
        const float sg = sigmoidf_(fz), f = lb + (1.f - lb) * sg; kh[i] = (1.f - lb) * (1.f - sg); run += __logf(f); bl[i] = run; }
    LAS float* part = (LAS float*)(L + L_PART);
    part[tq * 64 + d] = run; __syncthreads();
    float off = 0.f, btot = 0.f;
#pragma unroll
    for (int w = 0; w < 8; ++w) { const float pv = part[w * 64 + d]; btot += pv; if (w < tq) off += pv; }
#pragma unroll
    for (int i = 0; i < 8; ++i) kh[i] *= __expf(btot - (off + bl[i]));
    *(LAS v4u*)(L + L_T0 + d * TS + tq * 16) = pack8(kh);
    *(LAS v4u*)(L + L_T1 + d * TS + tq * 16) = pack8h(R.iv);
    if (tq == 0) DEC[d] = __expf(btot);
    __syncthreads();
    local_state_mma_store(L, LT, wave, tid & 63);
    __syncthreads();
}
__device__ __forceinline__ void mlstm_gates(float ig, float fg, const float* b_i, const float* b_f, int h, int lane, float& bcum, float& a) {
    bcum = wave_incl_add(log_sigmoidf_(fg + b_f[h]), lane); a = ig + b_i[h] - bcum;
}
__device__ __forceinline__ void mlstm_b_item(LAS unsigned char* L, const MlIn& R, const float* conv, const float* b_i, const float* b_f, int h, float* LT, float* NL, float* AMAX, float* BEND, int tid, int wave) {
    const int d = tid & 63, tq = wave, lane = tid & 63;
    float bcum, a; mlstm_gates(R.ig, R.fg, b_i, b_f, h, lane, bcum, a);
    const float A = wave_max(a), bend = __shfl(bcum, 63);
    float kh[8]; conv_silu8r(R.kr, conv + 256 + h * 64 + d, 0.125f, kh);
    float nsum = 0.f;
#pragma unroll
    for (int i = 0; i < 8; ++i) { kh[i] *= __expf(__shfl(a, 8 * tq + i) - A); nsum += bf2f(f2bf(kh[i])); }
    *(LAS v4u*)(L + L_T0 + d * TS + tq * 16) = pack8(kh);
    *(LAS v4u*)(L + L_T1 + d * TS + tq * 16) = pack8h(R.vv);
    LAS float* part = (LAS float*)(L + L_PART); part[tq * 64 + d] = nsum;
    __syncthreads();
    if (tq == 0) { float s = 0.f;
#pragma unroll
        for (int w = 0; w < 8; ++w) s += part[w * 64 + d];
        NL[d] = s; if (lane == 0) { AMAX[0] = A; BEND[0] = bend; } }
    local_state_mma_store(L, LT, wave, lane);
    __syncthreads();
}
__device__ __forceinline__ void fox_cumsum_item(LAS unsigned char* L, const float* G, const float* fox_bf, float* CF, int bh, int tid, int wave) {
    const int b = bh >> 3, h = bh & 7, lane = tid & 63; const float bf = fox_bf[h];
    float loc[16]; float s = 0.f;
#pragma unroll
    for (int i = 0; i < 16; ++i) { s += log_sigmoidf_(G[((size_t)b * SEQ + tid * 16 + i) * GW + 8 + h] + bf); loc[i] = s; }
    const float incl = wave_incl_add(s, lane);
    LAS float* wt = (LAS float*)(L + L_PART);
    if (lane == 63) wt[wave] = incl;
    __syncthreads();
    float off = incl - s;
#pragma unroll
    for (int w = 0; w < 8; ++w) if (w < wave) off += wt[w];
#pragma unroll
    for (int i = 0; i < 16; ++i) CF[(size_t)bh * SEQ + tid * 16 + i] = (off + loc[i]) * LOG2E;
    __syncthreads();
}

template <bool DUMMY = false> __device__ __forceinline__ void scan_c_block(unsigned char* sc, int j, int tid) {
    constexpr size_t DOFF = DUMMY ? 104 * MiB / 4 : 0;
    constexpr int CB = 16;
    if (j < 128) {
        if (tid < 256) { const int chain = j >> 4, e = (j & 15) * 256 + tid, b = chain >> 2, h = chain & 3;
            float* p = (float*)(sc + SC_LHG) + ((size_t)(b * 128) * 4 + h) * 4096 + e; const float* dp = (const float*)(sc + SC_DEC) + ((size_t)(b * 128) * 4 + h) * 64 + (e & 63);
            float S = 0.f;
            for (int c0 = 0; c0 < 128; c0 += CB) { float Lc[CB], dc[CB];
#pragma unroll
                for (int i = 0; i < CB; ++i) { Lc[i] = p[(size_t)(c0 + i) * 4 * 4096]; dc[i] = dp[(size_t)(c0 + i) * 4 * 64]; }
#pragma unroll
                for (int i = 0; i < CB; ++i) { const float So = S; S = dc[i] * S + Lc[i]; Lc[i] = So; }
#pragma unroll
                for (int i = 0; i < CB; ++i) (p + DOFF)[(size_t)(c0 + i) * 4 * 4096] = Lc[i]; } }
    } else {
        const int jj = j - 128, chain = jj >> 4, part = jj & 15, b = chain >> 2, h = chain & 3;
        if (tid < 260) { const bool isn = tid >= 256; const size_t it0 = (size_t)(b * 128) * 4 + h;
            float* p = isn ? (float*)(sc + SC_NL) + it0 * 64 + part * 4 + (tid - 256) : (float*)(sc + SC_LML) + it0 * 4096 + part * 256 + tid;
            const size_t stride = isn ? 4 * 64 : 4 * 4096;
            const float* am = (const float*)(sc + SC_AMAX) + it0; const float* be = (const float*)(sc + SC_BEND) + it0; float* mp = (float*)(sc + SC_MPREV) + it0;
            const bool writer = (part == 0 && tid == 0);
            float S = 0.f, m = 0.f;
            for (int c0 = 0; c0 < 128; c0 += CB) { float Lc[CB], A[CB], bb[CB];
#pragma unroll
                for (int i = 0; i < CB; ++i) { Lc[i] = p[(size_t)(c0 + i) * stride]; A[i] = am[(c0 + i) * 4]; bb[i] = be[(c0 + i) * 4]; }
#pragma unroll
                for (int i = 0; i < CB; ++i) { const float Mx = fmaxf(m, A[i]), So = S; S = __expf(m - Mx) * S + __expf(A[i] - Mx) * Lc[i]; Lc[i] = So; A[i] = m; m = bb[i] + Mx; }
#pragma unroll
                for (int i = 0; i < CB; ++i) { (p + DOFF)[(size_t)(c0 + i) * stride] = Lc[i]; if (writer) (mp + DOFF)[(c0 + i) * 4] = A[i]; } } }
    }
}

template <bool SIG> __device__ __forceinline__ void head_epilogue(LAS unsigned char* L, float inv, const v4u& gw  , const float* gain  , bf16_t* out  , int tid) {
    const int t = tid >> 3, v0 = (tid & 7) * 8; const LAS float* o = (const LAS float*)(L + L_O) + t * OS + v0;
    float x[8]; float ss = 0.f;
#pragma unroll
    for (int i = 0; i < 8; ++i) { x[i] = o[i] * inv; ss += x[i] * x[i]; }
    ss += __shfl_xor(ss, 1); ss += __shfl_xor(ss, 2); ss += __shfl_xor(ss, 4);
    const float r = rsqrtf(ss * (1.f / 64.f) + EPS);
    const unsigned gu[4] = {gw.x, gw.y, gw.z, gw.w};
    float y[8];
#pragma unroll
    for (int i = 0; i < 8; ++i) { const float gz = bf2f((bf16_t)((gu[i >> 1] >> (16 * (i & 1))) & 0xffff)); y[i] = x[i] * r * gain[i] * (SIG ? sigmoidf_(gz) : siluf_(gz)); }
    *(v4u*)out = pack8(y);
}
__device__ __forceinline__ void store_o_tiles(LAS unsigned char* L, LAS const unsigned char* A1, LAS const unsigned char* B1, LAS const unsigned char* A2, LAS const unsigned char* B2, int wave, int lane) {
    const int mt = wave >> 1;
#pragma unroll
    for (int nn = 0; nn < 2; ++nn) { const int nt = 2 * (wave & 1) + nn; f32x4 acc = {0.f, 0.f, 0.f, 0.f};
        acc = mma64(A1, B1, mt * 16, nt * 16, lane, acc); acc = mma64(A2, B2, mt * 16, nt * 16, lane, acc);
        LAS float* o = (LAS float*)(L + L_O);
#pragma unroll
        for (int r = 0; r < 4; ++r) o[(mt * 16 + 4 * (lane >> 4) + r) * OS + nt * 16 + (lane & 15)] = acc[r]; }
}
__device__ __forceinline__ void hgrn_d_item(LAS unsigned char* L, const HgIn& R, float lb, const float* gain  , bf16_t* out  , int tid, int wave) {
    const int d = tid & 63, tq = wave, lane = tid & 63;
    float bl[8], kk[8], q[8]; float run = 0.f;
#pragma unroll
    for (int i = 0; i < 8; ++i) { const float fz = bf2f(R.fz[i]); q[i] = bf2f(R.q[i]);
        const float sg = sigmoidf_(fz), f = lb + (1.f - lb) * sg; kk[i] = (1.f - lb) * (1.f - sg); run += __logf(f); bl[i] = run; }
    LAS float* part = (LAS float*)(L + L_PART);
    part[tq * 64 + d] = run;
    store_state_tile(L + L_T4, R.s0, R.s1, tid);
    *(LAS v4u*)(L + L_T3 + d * TS + tq * 16) = pack8h(R.iv);
    __syncthreads();
    float off = 0.f, bref = 0.f;
#pragma unroll
    for (int w = 0; w < 8; ++w) { const float pv = part[w * 64 + d]; if (w < 4) bref += pv; if (w < tq) off += pv; }
#pragma unroll
    for (int i = 0; i < 8; ++i) { const float bb = off + bl[i]; const int t = 8 * tq + i;
        st16(L + L_T0 + t * TS + d * 2, q[i] * __expf(bb - bref));
        st16(L + L_T1 + t * TS + d * 2, kk[i] * __expf(bref - bb));
        st16(L + L_T2 + t * TS + d * 2, q[i] * __expf(bb)); }
    __syncthreads();
    { const int mt = wave >> 1;
#pragma unroll
      for (int nn = 0; nn < 2; ++nn) { const int nt = 2 * (wave & 1) + nn; f32x4 acc = {0.f, 0.f, 0.f, 0.f};
          acc = mma64(L + L_T1, L + L_T0, mt * 16, nt * 16, lane, acc);
          const int s0 = mt * 16 + 4 * (lane >> 4), t = nt * 16 + (lane & 15);
          v2u w; w.x = pk2(s0 <= t ? acc[0] : 0.f, s0 + 1 <= t ? acc[1] : 0.f); w.y = pk2(s0 + 2 <= t ? acc[2] : 0.f, s0 + 3 <= t ? acc[3] : 0.f);
          *(LAS v2u*)(L + L_T5 + t * TS + s0 * 2) = w; } }
    __syncthreads();
    store_o_tiles(L, L + L_T5, L + L_T3, L + L_T2, L + L_T4, wave, lane);
    __syncthreads();
    { const int t = tid >> 3, v0 = (tid & 7) * 8; head_epilogue<false>(L, 1.f, R.gate, gain + v0, out + (size_t)t * D + v0, tid); }
    __syncthreads();
}
__device__ __forceinline__ void mlstm_d_item(LAS unsigned char* L, const MlIn& R, const float* conv, const float* b_i, const float* b_f, const float* gain  , int h, bf16_t* out  , int tid, int wave) {
    const int d = tid & 63, tq = wave, lane = tid & 63; const float mprev = R.mprev;
    float bcum, a; mlstm_gates(R.ig, R.fg, b_i, b_f, h, lane, bcum, a);
    const float M = fmaxf(wave_incl_max(a, lane), mprev), sint = __expf(mprev - M);
    LAS float* vec = (LAS float*)(L + L_VEC);
    if (wave == 0) { vec[lane] = a; vec[64 + lane] = M; vec[128 + lane] = __expf(-bcum - M); vec[192 + lane] = R.np; }
    float qc[8], kc[8];
    conv_silu8r(R.qr, conv + h * 64 + d, 1.f, qc);
    conv_silu8r(R.kr, conv + 256 + h * 64 + d, 0.125f, kc);
#pragma unroll
    for (int i = 0; i < 8; ++i) { const int t = 8 * tq + i;
        st16(L + L_T0 + t * TS + d * 2, qc[i]);
        st16(L + L_T1 + t * TS + d * 2, kc[i]);
        st16(L + L_T2 + t * TS + d * 2, qc[i] * __shfl(sint, t)); }
    *(LAS v4u*)(L + L_T3 + d * TS + tq * 16) = pack8h(R.vv);
    store_state_tile(L + L_T4, R.s0, R.s1, tid);
    __syncthreads();
    { const int mt = wave >> 1;
#pragma unroll
      for (int nn = 0; nn < 2; ++nn) { const int nt = 2 * (wave & 1) + nn; f32x4 acc = {0.f, 0.f, 0.f, 0.f};
          acc = mma64(L + L_T1, L + L_T0, mt * 16, nt * 16, lane, acc);
          const int s0 = mt * 16 + 4 * (lane >> 4), t = nt * 16 + (lane & 15); const float Mt = vec[64 + t];
          float wv[4];
#pragma unroll
          for (int r = 0; r < 4; ++r) wv[r] = (s0 + r <= t) ? acc[r] * __expf(vec[s0 + r] - Mt) : 0.f;
          v2u w; w.x = pk2(wv[0], wv[1]); w.y = pk2(wv[2], wv[3]); *(LAS v2u*)(L + L_T5 + t * TS + s0 * 2) = w; } }
    __syncthreads();
    store_o_tiles(L, L + L_T5, L + L_T3, L + L_T2, L + L_T4, wave, lane);
    __syncthreads();
    { const int t = tid >> 3, c8 = (tid & 7) * 8;
      const v4u pw = *(LAS const v4u*)(L + L_T5 + t * TS + c8 * 2), qw = *(LAS const v4u*)(L + L_T2 + t * TS + c8 * 2);
      const unsigned pu[4] = {pw.x, pw.y, pw.z, pw.w}, qu[4] = {qw.x, qw.y, qw.z, qw.w}; float den = 0.f;
#pragma unroll
      for (int i = 0; i < 8; ++i) { den += bf2f((bf16_t)((pu[i >> 1] >> (16 * (i & 1))) & 0xffff)) + bf2f((bf16_t)((qu[i >> 1] >> (16 * (i & 1))) & 0xffff)) * vec[192 + c8 + i]; }
      den += __shfl_xor(den, 1); den += __shfl_xor(den, 2); den += __shfl_xor(den, 4);
      const float inv = 1.f / fmaxf(fabsf(den), vec[128 + t]);
      head_epilogue<true>(L, inv, R.gate, gain + c8, out + (size_t)t * D + c8, tid); }
    __syncthreads();
}
}
constexpr int N_PHASES = 21;
template <int PH, bool REP = false> __device__ __forceinline__ void run_phase(const MArgs& a, LAS unsigned char* L, const int tid, const int wave, const int G, const int bx, const int vcu) {
    const int lane = tid & 63, gw = vcu * NWAVES + wave, NGW = G * NWAVES;
    unsigned char* ws = a.ws; bf16_t* X = (bf16_t*)a.out;
    bf16_t* X2 = (bf16_t*)(ws + WS_X2); (void)X2;
    int* ctl = (int*)(ws + WS_CTL); int* cnt = ctl + CW_CNT;
    float* Gt = (float*)(ws + WS_G); float* CF = (float*)(ws + WS_CF); int4* tokinfo = (int4*)(ws + WS_TOKINFO); float2* tgate = (float2*)(ws + WS_TGATE); int* toklist = (int*)(ws + WS_TOKLIST);
    bf16_t* P = (bf16_t*)(ws + WS_P); bf16_t* HID = (bf16_t*)(ws + WS_HID); signed char* H = (signed char*)(ws + WS_H); float* SH = (float*)(ws + WS_SH); bf16_t* MIX = (bf16_t*)(ws + WS_MIX);
    signed char* XG = (signed char*)(ws + WS_XG); float* SXG = (float*)(ws + WS_SXG); bf16_t* Y = (bf16_t*)(ws + WS_XG);
    LAS float* scr = (LAS float*)(L + RING_OFF + wave * 16384);
    (void)ctl; (void)Gt; (void)CF; (void)tokinfo; (void)tgate; (void)toklist; (void)P; (void)HID; (void)H; (void)SH; (void)SXG; (void)MIX; (void)XG; (void)Y; (void)scr; (void)cnt; (void)lane; (void)gw; (void)NGW;
    constexpr int p = PH, l = p >= 10 ? 1 : 0, k = p == 0 ? -1 : (l ? p - 10 : p - 1);
    if constexpr (p == 0) {
            LAS float* img = (LAS float*)(L + RING_OFF); LAS float* pm = (LAS float*)(L + LDSCTL_OFF + 1024);
            { auto job = [&](int it) { Conv8Job j; int r = it;
                  if (r < 224) { const int ll = r / 112, nb = r % 112, sc = 32 * nb + (nb >= 56 ? 8 : 0);
                      j.W = a.in[I_W_IN] + (size_t)ll * D * DIN + sc; j.ldw = DIN; j.WT8 = (signed char*)(ws + WS_WIN) + (size_t)ll * PW * D + (size_t)32 * nb * D; j.S = (float*)(ws + WS_SWIN) + ll * PW + 32 * nb; }
                  else { r -= 224; const int up = r / 88, nb = r % 88, c = 32 * nb;
                      j.W = (up ? a.in[I_DUP] : a.in[I_DGATE]) + c; j.ldw = FF; j.WT8 = (signed char*)(ws + WS_WDGU) + (size_t)glu_row(c, up) * D; j.S = (float*)(ws + WS_SWDGU) + glu_row(c, up); }
                  return j; };
              float v[64]; int it = vcu; if (it < 400) conv8_load(v, job(it), tid, wave);
              for (; it < 400; it += G) { const Conv8Job j = job(it); conv8_stage(v, img, pm, tid, wave); if (it + G < 400) conv8_load(v, job(it + G), tid, wave); conv8_quant(j, img, pm, tid, wave); } }
            for (int it = gw; it < 2432; it += NGW) {
                int r = it;
                if (r < 1024) { const int ll = r / 512; r %= 512; const int kb = r / 32, nb = r % 32;
                    tr_item(a.in[I_W_OUT] + (size_t)ll * D * D + 32 * nb, D, D, (bf16_t*)(ws + WS_WOUT) + (size_t)ll * D * D + (size_t)32 * nb * D, scr, 64 * kb, lane); continue; }
                r -= 1024;
                { const int kb = r / 32, nb = r % 32; tr_item(a.in[I_DDOWN] + 32 * nb, D, FF, (bf16_t*)(ws + WS_WDDN) + (size_t)32 * nb * FF, scr, 64 * kb, lane); }
            }
            __syncthreads();
            LAS float* tab = (LAS float*)(L + RING_OFF); load_gate_tab(tab, a.in[I_W_IN], tid); __syncthreads();
            float lg[8];
            { RowIn R, Rn; int row = gw; if (row < NTOK) mrow_load<false>(R, a.in[I_X], row, lane);
              for (; row < NTOK; row += NGW) { const int nx = row + NGW; if (nx < NTOK) mrow_load<false>(Rn, a.in[I_X], nx, lane); asm volatile("" ::: "memory");
                  mrow<0>(R, H, SH, a.in[I_ATTN_NORM], tab, Gt, row, lane, lg); if (nx < NTOK) R = Rn; } }
        } else if constexpr (k == 0) {
            { const int cb = (G >= 144) ? bx - 128 : bx; for (int bh = cb; bh >= 0 && bh < 16; bh += G) scan::fox_cumsum_item(L, Gt, a.in[I_FOX_BF] + l * 8, CF, bh, tid, wave); }
            pg8::GOrder S; S.so.init(NTOK, PW, G, bx); S.A = (const char*)H; S.B = (const char*)(ws + WS_WIN) + (size_t)l * PW * D; S.a_tile = (size_t)256 * D; S.b_tile = (size_t)256 * D; S.b_exp = 0;
            S.tb1 = S.tb2 = S.tb3 = S.tb4 = S.tb5 = S.tb6 = S.tb7 = 0x7fffffff;
            pg8::EpiBf8 E; E.O = P; E.ldc = PW; E.s_lo = P_FQ / 256; E.s_hi = P_FK / 256; E.scale = QSCALE; E.sA = SH; E.sB = (const float*)(ws + WS_SWIN) + l * PW; E.sc = (LAS float*)(L + LDSCTL_OFF + 4096);
            pg8::Gemm g{D / 2};
            pg8::gemm_phase<pg8::EpiBf8, pg8::GOrder, true, true, 1>(L + RING_OFF, g, S, E);
        } else if constexpr (l == 1 && k == 9) {
            pg8::GOrder S; pg8::EpiBf E; int t[8]; int acc = 0;
#pragma unroll
            for (int e = 0; e < NE; ++e) { t[e] = acc; acc += (cnt[e] + 255) >> 8; }
            S.so.init(acc * 256, D, G, bx); S.A = (const char*)HID; S.B = (const char*)(ws + WS_WMDN); S.a_tile = (size_t)256 * FE; S.b_tile = (size_t)256 * FE; S.b_exp = (size_t)D * FE;
            S.tb1 = t[1]; S.tb2 = t[2]; S.tb3 = t[3]; S.tb4 = t[4]; S.tb5 = t[5]; S.tb6 = t[6]; S.tb7 = t[7]; E.O = Y; E.ldc = D; E.s_lo = 0; E.s_hi = 4; E.scale = 1.f / (pg8::F8_HSCALE * pg8::F8_WSCALE);
            pg8::Gemm g{FE / 2};
            pg8::gemm_phase<pg8::EpiBf, pg8::GOrder, true, true, 2>(L + RING_OFF, g, S, E);
        } else if constexpr (k == 4 || (l == 0 && k == 7)) {
            pg8::GOrder S; S.so.init(NTOK, D, G, bx); S.b_exp = 0; S.tb1 = S.tb2 = S.tb3 = S.tb4 = S.tb5 = S.tb6 = S.tb7 = 0x7fffffff; int K;
            if constexpr (k == 4) { K = D; S.A = (const char*)MIX; S.B = (const char*)(ws + WS_WOUT) + (size_t)l * D * D * 2; }
            else { K = FF; S.A = (const char*)HID; S.B = (const char*)(ws + WS_WDDN); }
            S.a_tile = (size_t)256 * K * 2; S.b_tile = (size_t)256 * K * 2;
            pg8::Gemm g{K};
            if constexpr (k == 4 && l == 0) { pg8::EpiResid<true> E{a.in[I_X], X, D}; pg8::gemm_phase<pg8::EpiResid<true>, pg8::GOrder, true, true>(L + RING_OFF, g, S, E); }
            else { pg8::EpiResid<false> E{X, (k == 4 && l == 1) ? X2 : X, D}; pg8::gemm_phase<pg8::EpiResid<false>, pg8::GOrder, true, true>(L + RING_OFF, g, S, E); }
        } else if constexpr (l == 0 && k == 6) {
            pg8::GOrder S; pg8::EpiSwiglu8<false> E; S.a_tile = (size_t)256 * D; S.b_tile = (size_t)256 * D; E.O = HID; E.sc = (LAS float*)(L + LDSCTL_OFF + 4096);
            S.so.init(NTOK, 2 * FF, G, bx); S.A = (const char*)H; S.B = (const char*)(ws + WS_WDGU); S.b_exp = 0; S.tb1 = S.tb2 = S.tb3 = S.tb4 = S.tb5 = S.tb6 = S.tb7 = 0x7fffffff;
            E.ldc = FF; E.sA = SH; E.sB = (const float*)(ws + WS_SWDGU); E.sb_exp = 0;
            E.tb1 = S.tb1; E.tb2 = S.tb2; E.tb3 = S.tb3; E.tb4 = S.tb4; E.tb5 = S.tb5; E.tb6 = S.tb6; E.tb7 = S.tb7;
            pg8::Gemm g{D / 2};
            pg8::gemm_phase<pg8::EpiSwiglu8<false>, pg8::GOrder, true, true, 1>(L + RING_OFF, g, S, E);
        } else if constexpr (l == 1 && k == 7) {
            pg8::GOrder S; pg8::EpiSwigluF8 E; S.a_tile = (size_t)256 * D; S.b_tile = (size_t)256 * D; E.O = (unsigned char*)HID; E.ldc = FE;
            int t[8]; int acc = 0;
#pragma unroll
            for (int e = 0; e < NE; ++e) { t[e] = acc; acc += (cnt[e] + 255) >> 8; }
            S.so.init(acc * 256, 2 * FE, G, bx); S.A = (const char*)XG; S.B = (const char*)(ws + WS_WMGU); S.b_exp = (size_t)2 * FE * D;
            S.tb1 = t[1]; S.tb2 = t[2]; S.tb3 = t[3]; S.tb4 = t[4]; S.tb5 = t[5]; S.tb6 = t[6]; S.tb7 = t[7];
            pg8::Gemm g{D / 2};
            pg8::gemm_phase<pg8::EpiSwigluF8, pg8::GOrder, true, true, 2>(L + RING_OFF, g, S, E);
        } else if constexpr (k == 5 && l == 0) {
            float lg[8];
            { RowIn R, Rn; int row = gw; if (row < NTOK) mrow_load<true>(R, X, row, lane);
              for (; row < NTOK; row += NGW) { const int nx = row + NGW; if (nx < NTOK) mrow_load<true>(Rn, X, nx, lane); asm volatile("" ::: "memory");
                  mrow<1>(R, H, SH, a.in[I_FFN_NORM], nullptr, nullptr, row, lane, lg); if (nx < NTOK) R = Rn; } }
        } else if constexpr (k == 8 && l == 0) {
            LAS float* tab = (LAS float*)(L + RING_OFF); load_gate_tab(tab, a.in[I_W_IN] + (size_t)D * DIN, tid); __syncthreads();
            float lg[8];
            { RowIn R, Rn; int row = gw; if (row < NTOK) mrow_load<true>(R, X, row, lane);
              for (; row < NTOK; row += NGW) { const int nx = row + NGW; if (nx < NTOK) mrow_load<true>(Rn, X, nx, lane); asm volatile("" ::: "memory");
                  mrow<0>(R, H, SH, a.in[I_ATTN_NORM] + D, tab, Gt, row, lane, lg); if (nx < NTOK) R = Rn; } }
        } else if constexpr (k == 5 && l == 1) {
            LAS int* sel_e = (LAS int*)(L + RING_OFF);
            LAS float* sel_g = (LAS float*)(L + RING_OFF + 512);
            LAS int* lcnt = (LAS int*)(L + RING_OFF + 1024);
            LAS float* tab = (LAS float*)(L + RING_OFF + 4096); load_router_tab(tab, a.in[I_ROUTER], tid); __syncthreads();
            for (int rb = bx; rb < NTOK / 64; rb += G) {
                if (tid < 16) lcnt[tid] = 0;
                RowIn R, Rn; mrow_load<true>(R, X2, rb * 64 + wave * 8, lane);
                for (int i = 0; i < 8; ++i) { const int rl = wave * 8 + i, row = rb * 64 + rl; float lg[8];
                    if (i < 7) mrow_load<true>(Rn, X2, row + 1, lane); asm volatile("" ::: "memory");
                    mrow<2>(R, H, SH, a.in[I_FFN_NORM] + D, tab, nullptr, row, lane, lg); if (i < 7) R = Rn;
                    if (lane == 0) { const float v0 = lg[0], v1 = lg[1]; const int e0 = __float_as_int(lg[2]), e1 = __float_as_int(lg[3]);
                        const float g1 = 1.f / (1.f + __expf(v0 - v1));
                        sel_e[2 * rl] = e0; sel_e[2 * rl + 1] = e1; sel_g[2 * rl] = 1.f - g1; sel_g[2 * rl + 1] = g1; } }
                __syncthreads();
                int e0 = 0, e1 = 0, r0 = 0, r1 = 0;
                if (tid < 64) { e0 = sel_e[2 * tid]; e1 = sel_e[2 * tid + 1]; r0 = __hip_atomic_fetch_add(lcnt + e0, 1, __ATOMIC_RELAXED, __HIP_MEMORY_SCOPE_WORKGROUP); r1 = __hip_atomic_fetch_add(lcnt + e1, 1, __ATOMIC_RELAXED, __HIP_MEMORY_SCOPE_WORKGROUP); }
                __syncthreads();
                if (tid < 8) lcnt[8 + tid] = atomicAdd(cnt + tid, (int)lcnt[tid]);
                __syncthreads();
                if (tid < 64) { const int row = rb * 64 + tid, s0 = lcnt[8 + e0] + r0, s1 = lcnt[8 + e1] + r1;
                    toklist[e0 * NTOK + s0] = row; toklist[e1 * NTOK + s1] = row; tokinfo[row] = make_int4(e0, s0, e1, s1); tgate[row] = make_float2(sel_g[2 * tid], sel_g[2 * tid + 1]); }
                __syncthreads();
            }
        } else if constexpr (k == 6 && l == 1) {
            { int base[NE]; int acc = 0;
#pragma unroll
              for (int e = 0; e < NE; ++e) { base[e] = acc; acc += (cnt[e] + 255) & ~255; }
              for (int r = gw; r < acc; r += NGW) { int e = 0, be = 0;
#pragma unroll
                  for (int c = 1; c < NE; ++c) if (r >= base[c]) { e = c; be = base[c]; }
                  const int s = r - be; v4u v0 = {0u, 0u, 0u, 0u}; float sv = 0.f;
                  if (s < cnt[e]) { const int tok = toklist[e * NTOK + s]; v0 = *((const v4u*)(H + (size_t)tok * D) + lane); sv = SH[tok]; }
                  *((v4u*)(XG + (size_t)r * D) + lane) = v0; if (lane == 0) SXG[r] = sv; } }
            for (int it = gw; it < 28672; it += NGW) { const int e = it / 3584; int r = it % 3584; const int up = r / 1792; r %= 1792; const int kb = r / 112, nb = r % 112, c = 32 * nb;
                tr_item_f8((up ? a.in[I_MUP] : a.in[I_MGATE]) + (size_t)e * D * FE + c, FE, D, (unsigned char*)(ws + WS_WMGU) + (size_t)e * 2 * FE * D + (size_t)glu_row(c, up) * D, scr, 64 * kb, lane, pg8::F8_GSCALE); }
            for (int it = gw; it < 14336; it += NGW) { const int e = it / 1792, r = it % 1792, kb = r / 32, nb = r % 32;
                tr_item_f8(a.in[I_MDOWN] + (size_t)e * FE * D + 32 * nb, D, FE, (unsigned char*)(ws + WS_WMDN) + (size_t)e * D * FE + (size_t)32 * nb * FE, scr, 64 * kb, lane, pg8::F8_WSCALE); }
        } else if constexpr (k == 8 && l == 1) {
        } else if constexpr (l == 1 && k == 10) {
            int base[NE]; { int acc = 0;
#pragma unroll
              for (int e = 0; e < NE; ++e) { base[e] = acc; acc += (cnt[e] + 255) & ~255; } }
            constexpr int HALFR = NTOK; constexpr int rlo = 0;
            const bf16_t* Xs = X2;
            float* out = (float*)a.out;
            struct FA { uint2 v[4]; int4 ti; float2 tg; }; struct FB { uint2 y0[4], y1[4]; };
            auto loadA = [&](FA& A, int rr) { const uint2* xr = (const uint2*)(Xs + (size_t)rr * D) + lane;
#pragma unroll
                for (int j = 0; j < 4; ++j) A.v[j] = xr[64 * j];
                A.ti = tokinfo[rlo + rr]; A.tg = tgate[rlo + rr]; };
            auto loadB = [&](FB& B, const FA& A) { int b0 = 0, b1 = 0;
#pragma unroll
                for (int c = 0; c < NE; ++c) { if (c == A.ti.x) b0 = base[c]; if (c == A.ti.z) b1 = base[c]; }
                const uint2* y0 = (const uint2*)(Y + (size_t)(b0 + A.ti.y) * D) + lane; const uint2* y1 = (const uint2*)(Y + (size_t)(b1 + A.ti.w) * D) + lane;
#pragma unroll
                for (int j = 0; j < 4; ++j) { B.y0[j] = y0[64 * j]; B.y1[j] = y1[64 * j]; } };
            FA A0, A1, A2; FB B0, B1; int rr = gw;
            if (rr < HALFR) { loadA(A0, rr); if (rr + NGW < HALFR) loadA(A1, rr + NGW); loadB(B0, A0); }
            for (; rr < HALFR; rr += NGW) {
                const bool h1 = rr + NGW < HALFR, h2 = rr + 2 * NGW < HALFR;
                if (h2) loadA(A2, rr + 2 * NGW);
                if (h1) loadB(B1, A1);
                asm volatile("" ::: "memory");
                float4 v[4]; const float2 tg = A0.tg;
#pragma unroll
                for (int j = 0; j < 4; ++j) { const uint2 q = B0.y0[j], c = B0.y1[j], x = A0.v[j];
                    v[j].x = __uint_as_float(x.x << 16) + tg.x * bf2f((bf16_t)(q.x & 0xffff)) + tg.y * bf2f((bf16_t)(c.x & 0xffff)); v[j].y = __uint_as_float(x.x & 0xffff0000u) + tg.x * bf2f((bf16_t)(q.x >> 16)) + tg.y * bf2f((bf16_t)(c.x >> 16));
                    v[j].z = __uint_as_float(x.y << 16) + tg.x * bf2f((bf16_t)(q.y & 0xffff)) + tg.y * bf2f((bf16_t)(c.y & 0xffff)); v[j].w = __uint_as_float(x.y & 0xffff0000u) + tg.x * bf2f((bf16_t)(q.y >> 16)) + tg.y * bf2f((bf16_t)(c.y >> 16)); }
                float ss = 0.f;
#pragma unroll
                for (int j = 0; j < 4; ++j) ss += v[j].x * v[j].x + v[j].y * v[j].y + v[j].z * v[j].z + v[j].w * v[j].w;
                ss = wave_sum(ss); const float r = rsqrtf(ss * (1.f / D) + EPS);
                float4* xo = (float4*)(out + (size_t)(rlo + rr) * D) + lane;
#pragma unroll
                for (int j = 0; j < 4; ++j) { const float4 g = *((const float4*)a.in[I_FINAL_NORM] + 64 * j + lane); xo[64 * j] = make_float4(v[j].x * r * g.x, v[j].y * r * g.y, v[j].z * r * g.z, v[j].w * r * g.w); }
                if (h1) { A0 = A1; B0 = B1; } if (h2) A1 = A2;
            }
        } else {
            if constexpr (k == 1) {
                unsigned char* sc = ws + WS_SCAN; const int wv = wave;
#define ITEM_DECODE(it_) const int item = (it_) & 1023, h = item & 3, c = (item >> 2) & 127, b = item >> 9
#define HG_LB(h_) (l == 0 ? 0.f : 1.f / (1.f + __expf(a.in[I_HGRN_LB][(h_) * 64 + (tl & 63)] - a.in[I_HGRN_LB][256 + (h_) * 64 + (tl & 63)])))
                { scan::HgIn R, Rn; int it = bx;
                  if (it < 1024) { ITEM_DECODE(it); scan::hgrn_load<false>(R, P, b, c, h, nullptr, tid, wv); }
                  for (; it < 1024; it += G) { const int nx = it + G; int tl = tid; asm volatile("" : "+v"(tl));
                      if (nx < 1024) { ITEM_DECODE(nx); scan::hgrn_load<false>(Rn, P, b, c, h, nullptr, tl, wv); }
                      asm volatile("" ::: "memory");
                      { ITEM_DECODE(it); (void)b; (void)c; scan::hgrn_b_item(L, R, HG_LB(h), (float*)(sc + scan::SC_LHG) + (size_t)item * 4096, (float*)(sc + scan::SC_DEC) + item * 64, tl, wv); }
                      if (nx < 1024) R = Rn; } }
                { scan::MlIn R, Rn; int it = bx; while (it < 1024) it += G;
                  if (it < 2048) { ITEM_DECODE(it); scan::mlstm_load<false>(R, P, Gt, b, c, h, nullptr, nullptr, nullptr, tid, wv); }
                  for (; it < 2048; it += G) { const int nx = it + G; int tl = tid; asm volatile("" : "+v"(tl));
                      if (nx < 2048) { ITEM_DECODE(nx); scan::mlstm_load<false>(Rn, P, Gt, b, c, h, nullptr, nullptr, nullptr, tl, wv); }
                      asm volatile("" ::: "memory");
                      { ITEM_DECODE(it); (void)b; (void)c; scan::mlstm_b_item(L, R, a.in[I_MLSTM_CONV] + l * 2048, a.in[I_MLSTM_BI] + l * 4, a.in[I_MLSTM_BF] + l * 4, h, (float*)(sc + scan::SC_LML) + (size_t)item * 4096,
                                            (float*)(sc + scan::SC_NL) + item * 64, (float*)(sc + scan::SC_AMAX) + item, (float*)(sc + scan::SC_BEND) + item, tl, wv); }
                      if (nx < 2048) R = Rn; } }
                { LAS unsigned* lst = (LAS unsigned*)(L + LDSCTL_OFF + 64);
                  if (tid < 32) lst[tid] = 0u; __syncthreads();
                  float mq0 = 0.f, mq1 = 0.f, mk0 = 0.f, mk1 = 0.f;
                  for (int row = gw; row < NTOK; row += NGW) {
                      const v4u wq = *((const v4u*)(P + (size_t)row * PW + P_FQ) + lane), wk = *((const v4u*)(P + (size_t)row * PW + P_FK) + lane);
                      float sq = 0.f, sk = 0.f;
#pragma unroll
                      for (int i = 0; i < 4; ++i) { const float q0 = bf2f((bf16_t)(wq[i] & 0xffff)), q1 = bf2f((bf16_t)(wq[i] >> 16)), k0 = bf2f((bf16_t)(wk[i] & 0xffff)), k1 = bf2f((bf16_t)(wk[i] >> 16));
                          sq += q0 * q0 + q1 * q1; sk += k0 * k0 + k1 * k1; }
                      sq += __shfl_xor(sq, 1); sq += __shfl_xor(sq, 2); sq += __shfl_xor(sq, 4); sk += __shfl_xor(sk, 1); sk += __shfl_xor(sk, 2); sk += __shfl_xor(sk, 4);
                      if (row < SEQ) { mq0 = fmaxf(mq0, sq); mk0 = fmaxf(mk0, sk); } else { mq1 = fmaxf(mq1, sq); mk1 = fmaxf(mk1, sk); } }
                  if ((lane & 7) == 0) { const int hh = lane >> 3;
                      __hip_atomic_fetch_max(lst + hh * 2, __float_as_uint(mq0), __ATOMIC_RELAXED, __HIP_MEMORY_SCOPE_WORKGROUP); __hip_atomic_fetch_max(lst + hh * 2 + 1, __float_as_uint(mk0), __ATOMIC_RELAXED, __HIP_MEMORY_SCOPE_WORKGROUP);
                      __hip_atomic_fetch_max(lst + 16 + hh * 2, __float_as_uint(mq1), __ATOMIC_RELAXED, __HIP_MEMORY_SCOPE_WORKGROUP); __hip_atomic_fetch_max(lst + 16 + hh * 2 + 1, __float_as_uint(mk1), __ATOMIC_RELAXED, __HIP_MEMORY_SCOPE_WORKGROUP); }
                  __syncthreads();
                  if (tid < 32) __hip_atomic_fetch_max((unsigned*)ctl + CW_STAT + l * 32 + tid, lst[tid], __ATOMIC_RELAXED, __HIP_MEMORY_SCOPE_AGENT); }
            } else if constexpr (k == 2) {
                for (int j = bx; j < 256; j += G) scan::scan_c_block<REP>(ws + WS_SCAN, j, tid);
            } else if constexpr (k == 3) {
                static_assert(attn_body::ATTN_LDS_BYTES <= RING_BYTES, "attention LDS");
                unsigned char* sc = ws + WS_SCAN; const int wv = wave;
                const float* stat = (const float*)(ctl + CW_STAT + l * 32);
                LAS unsigned* slot = (LAS unsigned*)(L + LDSCTL_OFF);
                int v;
                for (;;) {
                    if (tid == 0) *slot = __hip_atomic_fetch_add((unsigned*)ctl + CW_QCTR + l + (REP ? 2 : 0), 1u, __ATOMIC_RELAXED, __HIP_MEMORY_SCOPE_AGENT);
                    __syncthreads();
                    v = __builtin_amdgcn_readfirstlane((int)*(volatile LAS unsigned*)slot);
                    if (v >= 736) break;
                    int qb, bh, part = 0; float* PART = nullptr;
                    if (v < 448) { qb = 31 - (v >> 5); bh = v & 15; part = (v >> 4) & 1; PART = (float*)(ws + WS_SCAN + (40 + 32 * l) * MiB) + (size_t)(bh * 14 + (qb - 18)) * 2 * attn_body::PART_F; }
                    else { const int u2 = v - 448; qb = 17 - (u2 >> 4); bh = u2 & 15; }
                    const float Tsk = 30.f + 2.f * __builtin_sqrtf(stat[bh * 2] * stat[bh * 2 + 1]) * 1.01f + 1.f;
                    attn_body::attn_unit<8>(bh >> 3, bh & 7, qb, (const attn_body::bf16*)(P + P_FQ), (const attn_body::bf16*)(P + P_FK), (const attn_body::bf16*)(P + P_FV), (attn_body::bf16*)(MIX + 512), CF + (size_t)bh * SEQ, Tsk,
                                            part, PART, (unsigned*)ctl + CW_AFLAG + (l + (REP ? 2 : 0)) * 512 + bh * 32 + qb, (char*)L + RING_OFF);
                    __syncthreads();
                }
                int tid2 = tid; asm volatile("" : "+v"(tid2));
                while (v < 736 + 512) {
                    const int it0 = (v - 736) * 4;
                    if (it0 < 1024) { scan::HgIn R, Rn; { ITEM_DECODE(it0); scan::hgrn_load<true>(R, P, b, c, h, (const float*)(sc + scan::SC_LHG) + (size_t)item * 4096, tid2, wv); }
#pragma unroll 1
                        for (int j = 0; j < 4; ++j) { const int it = it0 + j; int tl = tid2; asm volatile("" : "+v"(tl));
                            if (j < 3) { ITEM_DECODE(it + 1); scan::hgrn_load<true>(Rn, P, b, c, h, (const float*)(sc + scan::SC_LHG) + (size_t)item * 4096, tl, wv); }
                            asm volatile("" ::: "memory");
                            { ITEM_DECODE(it); const float lb = l == 0 ? 0.f : 1.f / (1.f + __expf(a.in[I_HGRN_LB][h * 64 + (tl & 63)] - a.in[I_HGRN_LB][256 + h * 64 + (tl & 63)]));
                              scan::hgrn_d_item(L, R, lb, a.in[I_HGRN_NORM] + l * 256 + h * 64, MIX + (size_t)(b * SEQ + c * 64) * D + h * 64, tl, wv); }
                            if (j < 3) R = Rn; } }
                    else { scan::MlIn R, Rn; { ITEM_DECODE(it0); scan::mlstm_load<true>(R, P, Gt, b, c, h, (const float*)(sc + scan::SC_LML) + (size_t)item * 4096, (const float*)(sc + scan::SC_NL) + item * 64, (const float*)(sc + scan::SC_MPREV) + item, tid2, wv); }
#pragma unroll 1
                        for (int j = 0; j < 4; ++j) { const int it = it0 + j; int tl = tid2; asm volatile("" : "+v"(tl));
                            if (j < 3) { ITEM_DECODE(it + 1); scan::mlstm_load<true>(Rn, P, Gt, b, c, h, (const float*)(sc + scan::SC_LML) + (size_t)item * 4096, (const float*)(sc + scan::SC_NL) + item * 64, (const float*)(sc + scan::SC_MPREV) + item, tl, wv); }
                            asm volatile("" ::: "memory");
                            { ITEM_DECODE(it); scan::mlstm_d_item(L, R, a.in[I_MLSTM_CONV] + l * 2048, a.in[I_MLSTM_BI] + l * 4, a.in[I_MLSTM_BF] + l * 4, a.in[I_MLSTM_NORM] + l * 256 + h * 64, h, MIX + (size_t)(b * SEQ + c * 64) * D + 256 + h * 64, tl, wv); }
                            if (j < 3) R = Rn; } }
                    __syncthreads();
                    if (tid2 == 0) *slot = __hip_atomic_fetch_add((unsigned*)ctl + CW_QCTR + l + (REP ? 2 : 0), 1u, __ATOMIC_RELAXED, __HIP_MEMORY_SCOPE_AGENT);
                    __syncthreads();
                    v = __builtin_amdgcn_readfirstlane((int)*(volatile LAS unsigned*)slot);
                }
            }

        }
}
__global__ void __launch_bounds__(NTHR, 2) mega(MArgs a) {
    extern __shared__ __attribute__((aligned(16))) unsigned char lds[];
    LAS unsigned char* L = (LAS unsigned char*)lds;
    volatile LAS unsigned* MISC = (volatile LAS unsigned*)(L + MISC_OFF);
    const int tid = threadIdx.x, wave = __builtin_amdgcn_readfirstlane(tid >> 6);
    const int G = gridDim.x, bx = blockIdx.x, vcu = (G % 8 == 0) ? (bx % 8) * (G / 8) + bx / 8 : bx;
    for (int u = tid; u < (LDS_BYTES - LDSCTL_OFF) / 4; u += NTHR) ((LAS unsigned*)(L + LDSCTL_OFF))[u] = 0u;
    __syncthreads();
    const int lo = a.ph_lo, hi = a.ph_hi;
    XcdBarrier bar; bar.bar = (unsigned*)(a.ws + WS_CTL) + CW_BAR; bar.x = 0; bar.st = nullptr;
    if (hi - lo > 1) bar = xcd_barrier_post((unsigned*)(a.ws + WS_CTL) + CW_BAR, MISC + 8);
#ifndef REPEAT_MASK
#define REPEAT_MASK 0u
#endif
#define PHASE(k) if (lo <= (k) && (k) < hi) { run_phase<k>(a, L, tid, wave, G, bx, vcu); if constexpr ((REPEAT_MASK >> (k)) & 1u) { xcd_barrier(bar); run_phase<k, true>(a, L, tid, wave, G, bx, vcu); } if ((k) + 1 < hi) xcd_barrier(bar); }
    PHASE(0) PHASE(1) PHASE(2) PHASE(3) PHASE(4) PHASE(5) PHASE(6) PHASE(7) PHASE(8) PHASE(9) PHASE(10)
    PHASE(11) PHASE(12) PHASE(13) PHASE(14) PHASE(15) PHASE(16) PHASE(17) PHASE(19) PHASE(20)
#undef PHASE
}
#ifndef MEGA_MASK
#define MEGA_MASK 0x1FFFFFu
#endif
#ifndef FUSE_RUNS
#define FUSE_RUNS 1
#endif
extern "C" void kernel_launch(void* const* d_in, const int* in_sizes, int n_in, void* d_out, int out_size, void* d_ws, size_t ws_size, hipStream_t stream) {
    static int grid = 0;
    if (grid == 0) {
        if (n_in != 20 || ws_size < WS_END || out_size != NTOK * D) { fprintf(stderr, "kernel_launch: unexpected n_in %d / ws %zu / out %d\n", n_in, ws_size, out_size); grid = -1; return; }
        int dev = 0, cus = 0, per_cu = 0;
        if (hipGetDevice(&dev) != hipSuccess || hipDeviceGetAttribute(&cus, hipDeviceAttributeMultiprocessorCount, dev) != hipSuccess) { grid = -1; return; }
        if (hipFuncSetAttribute((const void*)mega, hipFuncAttributeMaxDynamicSharedMemorySize, LDS_BYTES) != hipSuccess) { fprintf(stderr, "kernel_launch: hipFuncSetAttribute failed\n"); grid = -1; return; }
        if (hipOccupancyMaxActiveBlocksPerMultiprocessor(&per_cu, (const void*)mega, NTHR, LDS_BYTES) != hipSuccess || per_cu < 1) { fprintf(stderr, "kernel_launch: occupancy query says %d\n", per_cu); per_cu = 1; }
        (void)hipGetLastError();
        grid = cus;
        if (grid > 256) grid = 256;
    }
    if (grid < 0) return;
    const float* const* in = (const float* const*)d_in;
    unsigned char* ws = (unsigned char*)d_ws; float* X = (float*)d_out;
    (void)hipMemsetAsync(ws + WS_CTL, 0, CTL_BYTES, stream);
    MArgs ma; memset(&ma, 0, sizeof ma);
    for (int i = 0; i < 20; ++i) ma.in[i] = in[i];
    ma.out = X; ma.ws = ws;
    ma.ph_lo = 0; ma.ph_hi = N_PHASES;
    hipLaunchKernelGGL(mega, dim3(grid), dim3(NTHR), LDS_BYTES, stream, ma);
}
```

```cpp
#include <hip/hip_runtime.h>
#include <hip/hip_bf16.h>
#include <cstdint>
#include <cstdio>
#include <cstring>

namespace cfg {
constexpr int NTOK = 16384, D = 1024, SEQ = 8192, NB = 2, DIN = 3600, PW = 3584, GW = 16;
constexpr int FF = 2816, FE = 3584, NE = 8, MAXROWS = 34816;
constexpr float EPS = 1e-6f;
constexpr float LOG2E = 1.4426950408889634f;
constexpr float QSCALE = 0.125f * LOG2E;
constexpr int P_HQ = 0, P_HF = 256, P_HI = 512, P_HG = 768, P_MQ = 1024, P_MK = 1280, P_MV = 1536, P_MO = 1792, P_FQ = 2048, P_FK = 2560, P_FV = 3072;
constexpr size_t MiB = 1u << 20;
constexpr size_t WS_CTL = 0, CTL_BYTES = 1 * MiB;
constexpr size_t WS_G = 2 * MiB;
constexpr size_t WS_CF = 3 * MiB;
constexpr size_t WS_TOKINFO = 3 * MiB + 512 * 1024;
constexpr size_t WS_TGATE = 3 * MiB + 768 * 1024;
constexpr size_t WS_TOKLIST = 4 * MiB;
constexpr size_t WS_P = 8 * MiB;
constexpr size_t WS_SCAN = 120 * MiB;
constexpr size_t WS_HID = 8 * MiB;
constexpr size_t WS_H = 246 * MiB;
constexpr size_t WS_MIX = 278 * MiB;
constexpr size_t WS_XG = 278 * MiB;
constexpr size_t WS_W = 346 * MiB;
constexpr size_t WS_Y = 346 * MiB;
constexpr size_t WS_X2 = 130 * MiB;
constexpr size_t WS_PB = 164 * MiB;
constexpr size_t WS_END = 466 * MiB;
constexpr int CW_CNT = 64;
constexpr int CW_STAT = 128;
constexpr int CW_QCTR = 256;
constexpr int CW_PQ = 262;
constexpr int CW_AQ = 272;
constexpr int CW_TFLAG = 384;
constexpr int CW_AFLAG = 512;
}
using namespace cfg;
typedef unsigned short bf16_t;

__device__ __forceinline__ bf16_t f2bf(float f) { unsigned u = __builtin_bit_cast(unsigned, f); return (bf16_t)((u + 0x7fffu + ((u >> 16) & 1u)) >> 16); }
__device__ __forceinline__ float bf2f(bf16_t h) { return __builtin_bit_cast(float, (unsigned)h << 16); }
#define DPP_F(old_, v_, ctrl_, rmask_) __int_as_float(__builtin_amdgcn_update_dpp(__float_as_int(old_), __float_as_int(v_), ctrl_, rmask_, 0xf, false))
__device__ __forceinline__ float wave_sum(float v) {
    v += DPP_F(0.f, v, 0xB1, 0xf); v += DPP_F(0.f, v, 0x4E, 0xf); v += DPP_F(0.f, v, 0x141, 0xf); v += DPP_F(0.f, v, 0x140, 0xf);
    v += DPP_F(0.f, v, 0x142, 0xa); v += DPP_F(0.f, v, 0x143, 0xc);
    return __int_as_float(__builtin_amdgcn_readlane(__float_as_int(v), 63));
}
__device__ __forceinline__ float wave_max_nn(float v) {
    v = fmaxf(v, DPP_F(0.f, v, 0xB1, 0xf)); v = fmaxf(v, DPP_F(0.f, v, 0x4E, 0xf)); v = fmaxf(v, DPP_F(0.f, v, 0x141, 0xf)); v = fmaxf(v, DPP_F(0.f, v, 0x140, 0xf));
    v = fmaxf(v, DPP_F(0.f, v, 0x142, 0xa)); v = fmaxf(v, DPP_F(0.f, v, 0x143, 0xc));
    return __int_as_float(__builtin_amdgcn_readlane(__float_as_int(v), 63));
}
__device__ __forceinline__ float sigmoidf_(float z) { return 1.f / (1.f + __expf(-z)); }
__device__ __forceinline__ float siluf_(float z) { return z / (1.f + __expf(-z)); }
__device__ __forceinline__ float log_sigmoidf_(float z) { return fminf(z, 0.f) - log1pf(__expf(-fabsf(z))); }

__device__ __forceinline__ int moe_bases(const int* cnt, int* base) {
    int acc = 0;
#pragma unroll
    for (int e = 0; e < NE; ++e) { base[e] = acc; acc += (cnt[e] + 255) & ~255; }
    return acc;
}

namespace pg8 {
#define PG8_LAS __attribute__((address_space(3)))
typedef unsigned short bf16_t;
typedef short bf16x8 __attribute__((ext_vector_type(8)));
typedef float f32x4 __attribute__((ext_vector_type(4)));
typedef unsigned u32x4 __attribute__((ext_vector_type(4)));
constexpr int BM = 256, BK = 64, HALF = 128, HTB = HALF * BK * 2  , STAGE_BYTES = 8 * HTB, NXCD = 8, WGM = 8;

__host__ __device__ __forceinline__ int lds_byte(int r, int c) { const int st = (r >> 4) * 2 + (c >> 5), rr = r & 15, cc = c & 31, ob = rr * 64 + cc * 2; return st * 1024 + (ob ^ (((ob >> 9) & 1) << 5)); }
__host__ __device__ __forceinline__ void stage_rc(int b, int& R, int& C) { const int st = b / 1024, sb = b % 1024, swz = sb ^ (((sb >> 9) & 1) << 5); R = (st >> 1) * 16 + swz / 64; C = (st & 1) * 32 + (swz % 64) / 2; }
__host__ __device__ __forceinline__ int perm32(int rho) { const int n = rho >> 4, i = rho & 15; return 8 * (i >> 2) + 4 * n + (i & 3); }

struct Unit { int pm, pn, tq; };
struct Gemm { int K; };

struct StaticOrder {
    int nM, nN, nwg, G, c;
    __host__ __device__ void init(int M, int N, int G_, int c_) { nM = M / BM; nN = N / BM; nwg = nM * nN; G = G_; c = c_; }
    __host__ __device__ bool next(int i, Unit& u) const {
        const long L = (long)i * G + c; if (L >= nwg) return false;
        int wgid = (int)L; { const int q = nwg / NXCD, r = nwg % NXCD, xcd = wgid % NXCD, off = wgid / NXCD; wgid = (xcd < r ? xcd * (q + 1) : r * (q + 1) + (xcd - r) * q) + off; }
        const int nig = WGM * nN, gid = wgid / nig, fm = gid * WGM, gsz = (nM - fm) < WGM ? (nM - fm) : WGM;
        u.pm = fm + ((wgid % nig) % gsz); u.pn = (wgid % nig) / gsz; return true;
    }
    __device__ __forceinline__ void a_ready(const Unit&) const {}
    __device__ __forceinline__ void done(const Unit&) const {}
};

__device__ __forceinline__ unsigned cvt_pk_bf16(float lo, float hi) { unsigned r; asm volatile("v_cvt_pk_bf16_f32 %0, %1, %2" : "=v"(r) : "v"(lo), "v"(hi)); return r; }
typedef int i32x4 __attribute__((ext_vector_type(4)));
constexpr float F8_HSCALE = 4.f, F8_WSCALE = 64.f, F8_ASCALE = 16.f, F8_GSCALE = 32.f;
template <bool I8> struct AccT { typedef f32x4 type; };
template <> struct AccT<true> { typedef i32x4 type; };
__device__ __forceinline__ f32x4 mma_sel(bf16x8 b, bf16x8 a, f32x4 c) { return __builtin_amdgcn_mfma_f32_16x16x32_bf16(b, a, c, 0, 0, 0); }
__device__ __forceinline__ i32x4 mma_sel(bf16x8 b, bf16x8 a, i32x4 c) { return __builtin_amdgcn_mfma_i32_16x16x64_i8(__builtin_bit_cast(i32x4, b), __builtin_bit_cast(i32x4, a), c, 0, 0, 0); }
typedef int i32x8 __attribute__((ext_vector_type(8)));
struct Frag2 { bf16x8 k[2]; };
template <int MODE> struct Frag { typedef Frag2 type; };
template <> struct Frag<2> { typedef i32x8 type; };
template <int MODE> __device__ __forceinline__ typename Frag<MODE>::type ldfrag(PG8_LAS const unsigned char* p) {
    if constexpr (MODE == 2) { const i32x4 lo = *(const PG8_LAS i32x4*)p, hi = *(const PG8_LAS i32x4*)(p + 1024); return (i32x8){lo[0], lo[1], lo[2], lo[3], hi[0], hi[1], hi[2], hi[3]}; }
    else { Frag2 f; f.k[0] = *(const PG8_LAS bf16x8*)p; f.k[1] = *(const PG8_LAS bf16x8*)(p + 1024); return f; }
}
__device__ __forceinline__ void mma_step_(f32x4& acc, const Frag2& b, const Frag2& a) { acc = mma_sel(b.k[0], a.k[0], acc); acc = mma_sel(b.k[1], a.k[1], acc); }
__device__ __forceinline__ void mma_step_(i32x4& acc, const Frag2& b, const Frag2& a) { acc = mma_sel(b.k[0], a.k[0], acc); acc = mma_sel(b.k[1], a.k[1], acc); }
__device__ __forceinline__ void mma_step_(f32x4& acc, const i32x8& b, const i32x8& a) {
#if defined(__HIP_DEVICE_COMPILE__)
    const int scl = 0x7f7f7f7f;
    asm volatile("v_mfma_scale_f32_16x16x128_f8f6f4 %0, %1, %2, %0, %3, %3 op_sel_hi:[0,0,0]" : "+v"(acc) : "v"(b), "v"(a), "v"(scl));
#endif
}
template <int MODE, class ACC, class F> __device__ __forceinline__ void mma_step(ACC& acc, const F& b, const F& a) { mma_step_(acc, b, a); }
struct EpiBf {
    static constexpr bool PERM = true, AFTER_DRAIN = false;
    bf16_t* O; int ldc; int s_lo, s_hi; float scale;
    struct Pre {}; __device__ __forceinline__ void prefetch(Pre&, const Unit&, int, int, int, int, int) const {} __device__ __forceinline__ void commit(const Pre&, int, int, int, int, int) const {}
    __device__ __forceinline__ void operator()(const f32x4 (&acc)[2][2][4][2], const Unit& u, int wr, int wc, int fr_, int fq_, const Pre&, int) const {
        int fr = fr_, fq = fq_; asm volatile("" : "+v"(fr), "+v"(fq));
        const int row0 = u.pm * BM + wr * 64 + fr, col0 = u.pn * BM + wc * 32 + 8 * fq;
        const float sc = (u.pn >= s_lo && u.pn < s_hi) ? scale : 1.f;
#pragma unroll
        for (int ai = 0; ai < 2; ++ai)
#pragma unroll
            for (int m = 0; m < 4; ++m) { bf16_t* rowp = O + (size_t)(row0 + ai * HALF + m * 16) * ldc + col0;
#pragma unroll
                for (int bj = 0; bj < 2; ++bj) { const f32x4 v0 = acc[ai][bj][m][0] * sc, v1 = acc[ai][bj][m][1] * sc;
                    u32x4 w; w.x = cvt_pk_bf16(v0[0], v0[1]); w.y = cvt_pk_bf16(v0[2], v0[3]); w.z = cvt_pk_bf16(v1[0], v1[1]); w.w = cvt_pk_bf16(v1[2], v1[3]);
                    *(u32x4*)(rowp + bj * HALF) = w; } }
    }
};
__device__ __forceinline__ float silu_mul(float g, float u) { return g * __builtin_amdgcn_rcpf(1.f + __expf(-g)) * u; }
__device__ __forceinline__ float silu2_mul(float g2, float u2) { return g2 * __builtin_amdgcn_rcpf(1.f + __builtin_amdgcn_exp2f(-g2)) * u2; }
struct EpiSwiglu {
    static constexpr bool PERM = true, AFTER_DRAIN = false;
    bf16_t* O; int ldc;
    struct Pre {}; __device__ __forceinline__ void prefetch(Pre&, const Unit&, int, int, int, int, int) const {} __device__ __forceinline__ void commit(const Pre&, int, int, int, int, int) const {}
    __device__ __forceinline__ void operator()(const f32x4 (&acc)[2][2][4][2], const Unit& u, int wr, int wc, int fr, int fq, const Pre&, int) const {
        const int row0 = u.pm * BM + wr * 64 + fr, col0 = u.pn * HALF + wc * 32 + 8 * fq;
#pragma unroll
        for (int ai = 0; ai < 2; ++ai)
#pragma unroll
            for (int m = 0; m < 4; ++m) { bf16_t* rowp = O + (size_t)(row0 + ai * HALF + m * 16) * ldc + col0;
                const f32x4 g0 = acc[ai][0][m][0], g1 = acc[ai][0][m][1], u0 = acc[ai][1][m][0], u1 = acc[ai][1][m][1];
                u32x4 w; w.x = cvt_pk_bf16(silu_mul(g0[0], u0[0]), silu_mul(g0[1], u0[1])); w.y = cvt_pk_bf16(silu_mul(g0[2], u0[2]), silu_mul(g0[3], u0[3]));
                w.z = cvt_pk_bf16(silu_mul(g1[0], u1[0]), silu_mul(g1[1], u1[1])); w.w = cvt_pk_bf16(silu_mul(g1[2], u1[2]), silu_mul(g1[3], u1[3]));
                *(u32x4*)rowp = w; }
    }
};
struct EpiSwigluF8 {
    static constexpr bool PERM = true, AFTER_DRAIN = false;
    unsigned char* O; int ldc;
    struct Pre {}; __device__ __forceinline__ void prefetch(Pre&, const Unit&, int, int, int, int, int) const {} __device__ __forceinline__ void commit(const Pre&, int, int, int, int, int) const {}
    __device__ __forceinline__ void operator()(const f32x4 (&acc)[2][2][4][2], const Unit& u, int wr, int wc, int fr, int fq, const Pre&, int) const {
        const int row0 = u.pm * BM + wr * 64 + fr, col0 = u.pn * HALF + wc * 32 + 8 * fq;
        constexpr float CG = 1.4426950408889634f / (F8_ASCALE * F8_GSCALE), CU = F8_HSCALE * 0.6931471805599453f / (F8_ASCALE * F8_GSCALE);
#pragma unroll
        for (int ai = 0; ai < 2; ++ai)
#pragma unroll
            for (int m = 0; m < 4; ++m) { const int row = row0 + ai * HALF + m * 16;
                const f32x4 g0 = acc[ai][0][m][0] * CG, g1 = acc[ai][0][m][1] * CG, u0 = acc[ai][1][m][0] * CU, u1 = acc[ai][1][m][1] * CU;
                float h[8];
#pragma unroll
                for (int i = 0; i < 4; ++i) { h[i] = __builtin_fminf(__builtin_fmaxf(silu2_mul(g0[i], u0[i]), -448.f), 448.f); h[4 + i] = __builtin_fminf(__builtin_fmaxf(silu2_mul(g1[i], u1[i]), -448.f), 448.f); }
                unsigned w0 = 0u, w1 = 0u; w0 = __builtin_amdgcn_cvt_pk_fp8_f32(h[0], h[1], w0, false); w0 = __builtin_amdgcn_cvt_pk_fp8_f32(h[2], h[3], w0, true);
                w1 = __builtin_amdgcn_cvt_pk_fp8_f32(h[4], h[5], w1, false); w1 = __builtin_amdgcn_cvt_pk_fp8_f32(h[6], h[7], w1, true);
                typedef unsigned u32x2 __attribute__((ext_vector_type(2))); *(u32x2*)(O + (size_t)row * ldc + col0) = (u32x2){w0, w1}; }
    }
};
struct EpiNull {
    static constexpr bool PERM = true, AFTER_DRAIN = false;
    unsigned char* O; int ldc;
    struct Pre {}; __device__ __forceinline__ void prefetch(Pre&, const Unit&, int, int, int, int, int) const {} __device__ __forceinline__ void commit(const Pre&, int, int, int, int, int) const {}
    __device__ __forceinline__ void operator()(const f32x4 (&acc)[2][2][4][2], const Unit& u, int wr, int wc, int fr, int fq, const Pre&, int) const {
        f32x4 s = (f32x4){0.f, 0.f, 0.f, 0.f};
#pragma unroll
        for (int ai = 0; ai < 2; ++ai)
#pragma unroll
            for (int bj = 0; bj < 2; ++bj)
#pragma unroll
                for (int m = 0; m < 4; ++m)
#pragma unroll
                    for (int n = 0; n < 2; ++n) s += acc[ai][bj][m][n];
        if (s[0] + s[1] + s[2] + s[3] == 12345.678f) O[(size_t)(u.pm * BM + wr * 64 + fr) * ldc + u.pn * HALF + wc * 32 + 8 * fq] = 1;
    }
};
template <bool IN_F32> struct EpiResid {
    static constexpr bool PERM = true, AFTER_DRAIN = false;
    const void* Xin; bf16_t* X; int ldc;
    struct Pre {}; __device__ __forceinline__ void prefetch(Pre&, const Unit&, int, int, int, int, int) const {} __device__ __forceinline__ void commit(const Pre&, int, int, int, int, int) const {}
    __device__ __forceinline__ void operator()(const f32x4 (&acc)[2][2][4][2], const Unit& u, int wr, int wc, int fr, int fq, const Pre&, int) const {
        const int row0 = u.pm * BM + wr * 64 + fr, col0 = u.pn * BM + wc * 32 + 8 * fq;
#pragma unroll
        for (int ai = 0; ai < 2; ++ai)
#pragma unroll
            for (int m = 0; m < 4; ++m) { const size_t ro = (size_t)(row0 + ai * HALF + m * 16) * ldc + col0;
#pragma unroll
                for (int bj = 0; bj < 2; ++bj) { f32x4 x0, x1;
                    if (IN_F32) { const float* p = (const float*)Xin + ro + bj * HALF; x0 = *(const f32x4*)p; x1 = *(const f32x4*)(p + 4); }
                    else { const u32x4 w = *(const u32x4*)((const bf16_t*)Xin + ro + bj * HALF);
                        x0 = (f32x4){__builtin_bit_cast(float, w.x << 16), __builtin_bit_cast(float, w.x & 0xffff0000u), __builtin_bit_cast(float, w.y << 16), __builtin_bit_cast(float, w.y & 0xffff0000u)};
                        x1 = (f32x4){__builtin_bit_cast(float, w.z << 16), __builtin_bit_cast(float, w.z & 0xffff0000u), __builtin_bit_cast(float, w.w << 16), __builtin_bit_cast(float, w.w & 0xffff0000u)}; }
                    const f32x4 v0 = x0 + acc[ai][bj][m][0], v1 = x1 + acc[ai][bj][m][1];
                    u32x4 o; o.x = cvt_pk_bf16(v0[0], v0[1]); o.y = cvt_pk_bf16(v0[2], v0[3]); o.z = cvt_pk_bf16(v1[0], v1[1]); o.w = cvt_pk_bf16(v1[2], v1[3]);
                    *(u32x4*)(X + ro + bj * HALF) = o; }
                asm volatile("" ::: "memory"); }
    }
};
struct EpiBf8 {
    static constexpr bool PERM = true, AFTER_DRAIN = false;
    bf16_t* O; int ldc; int s_lo, s_hi; float scale; const float* sA; const float* sB; PG8_LAS float* sc;
    struct Pre {};
    __device__ __forceinline__ void prefetch(Pre&, const Unit& u, int wr, int wc, int fr, int fq, int ui) const {
        const int wid = wr * 4 + wc, lane = fq * 16 + fr; PG8_LAS float* d = sc + (ui & 1) * 512;
        if (wid < 2) { const float* src = (wid == 0 ? sA + u.pm * BM : sB + u.pn * BM) + 4 * lane;
            __builtin_amdgcn_global_load_lds((const unsigned*)src, (PG8_LAS unsigned*)(d + 256 * wid), 16, 0, 0); }
    }
    __device__ __forceinline__ void commit(const Pre&, int, int, int, int, int) const {}
    __device__ __forceinline__ void operator()(const i32x4 (&acc)[2][2][4][2], const Unit& u, int wr, int wc, int fr, int fq, const Pre&, int ui) const {
        const int row0 = u.pm * BM + wr * 64 + fr, col0 = u.pn * BM + wc * 32 + 8 * fq; const PG8_LAS float* d = sc + (ui & 1) * 512;
        const float sc0 = (u.pn >= s_lo && u.pn < s_hi) ? scale : 1.f;
        f32x4 cb[2][2];
#pragma unroll
        for (int bj = 0; bj < 2; ++bj)
#pragma unroll
            for (int n = 0; n < 2; ++n) cb[bj][n] = *(const PG8_LAS f32x4*)(d + 256 + wc * 32 + 8 * fq + bj * HALF + 4 * n) * sc0;
#pragma unroll
        for (int ai = 0; ai < 2; ++ai)
#pragma unroll
            for (int m = 0; m < 4; ++m) { const int row = row0 + ai * HALF + m * 16; const float ra = d[wr * 64 + fr + ai * HALF + m * 16]; bf16_t* rowp = O + (size_t)row * ldc + col0;
#pragma unroll
                for (int bj = 0; bj < 2; ++bj) { const f32x4 v0 = __builtin_convertvector(acc[ai][bj][m][0], f32x4) * cb[bj][0] * ra, v1 = __builtin_convertvector(acc[ai][bj][m][1], f32x4) * cb[bj][1] * ra;
                    u32x4 w; w.x = cvt_pk_bf16(v0[0], v0[1]); w.y = cvt_pk_bf16(v0[2], v0[3]); w.z = cvt_pk_bf16(v1[0], v1[1]); w.w = cvt_pk_bf16(v1[2], v1[3]);
                    *(u32x4*)(rowp + bj * HALF) = w; } }
    }
};
template <bool F8OUT> struct EpiSwiglu8 {
    static constexpr bool PERM = true, AFTER_DRAIN = false;
    bf16_t* O; int ldc; const float* sA; const float* sB; int sb_exp; int tb1, tb2, tb3, tb4, tb5, tb6, tb7; PG8_LAS float* sc;
    struct Pre {};
    __device__ __forceinline__ void prefetch(Pre&, const Unit& u, int wr, int wc, int fr, int fq, int ui) const {
        const int wid = wr * 4 + wc, lane = fq * 16 + fr; PG8_LAS float* d = sc + (ui & 1) * 512;
        const int e = (u.pm >= tb1) + (u.pm >= tb2) + (u.pm >= tb3) + (u.pm >= tb4) + (u.pm >= tb5) + (u.pm >= tb6) + (u.pm >= tb7);
        if (wid < 2) { const float* src = (wid == 0 ? sA + u.pm * BM : sB + (size_t)e * sb_exp + u.pn * BM) + 4 * lane;
            __builtin_amdgcn_global_load_lds((const unsigned*)src, (PG8_LAS unsigned*)(d + 256 * wid), 16, 0, 0); }
    }
    __device__ __forceinline__ void commit(const Pre&, int, int, int, int, int) const {}
    __device__ __forceinline__ void operator()(const i32x4 (&acc)[2][2][4][2], const Unit& u, int wr, int wc, int fr, int fq, const Pre&, int ui) const {
        const int row0 = u.pm * BM + wr * 64 + fr, col0 = u.pn * HALF + wc * 32 + 8 * fq; const PG8_LAS float* d = sc + (ui & 1) * 512;
        const PG8_LAS float* sb = d + 256 + wc * 32 + 8 * fq;
        constexpr float CG = 1.4426950408889634f, CU = (F8OUT ? F8_HSCALE : 1.f) * 0.6931471805599453f;
        const f32x4 sg0 = *(const PG8_LAS f32x4*)sb * CG, sg1 = *(const PG8_LAS f32x4*)(sb + 4) * CG, su0 = *(const PG8_LAS f32x4*)(sb + HALF) * CU, su1 = *(const PG8_LAS f32x4*)(sb + HALF + 4) * CU;
#pragma unroll
        for (int ai = 0; ai < 2; ++ai)
#pragma unroll
            for (int m = 0; m < 4; ++m) { const int row = row0 + ai * HALF + m * 16; const float ra = d[wr * 64 + fr + ai * HALF + m * 16];
                const f32x4 g0 = __builtin_convertvector(acc[ai][0][m][0], f32x4) * sg0 * ra, g1 = __builtin_convertvector(acc[ai][0][m][1], f32x4) * sg1 * ra;
                const f32x4 u0 = __builtin_convertvector(acc[ai][1][m][0], f32x4) * su0 * ra, u1 = __builtin_convertvector(acc[ai][1][m][1], f32x4) * su1 * ra;
                if constexpr (F8OUT) { float h[8];
#pragma unroll
                    for (int i = 0; i < 4; ++i) { h[i] = __builtin_fminf(__builtin_fmaxf(silu2_mul(g0[i], u0[i]), -448.f), 448.f); h[4 + i] = __builtin_fminf(__builtin_fmaxf(silu2_mul(g1[i], u1[i]), -448.f), 448.f); }
                    unsigned w0 = 0u, w1 = 0u; w0 = __builtin_amdgcn_cvt_pk_fp8_f32(h[0], h[1], w0, false); w0 = __builtin_amdgcn_cvt_pk_fp8_f32(h[2], h[3], w0, true);
                    w1 = __builtin_amdgcn_cvt_pk_fp8_f32(h[4], h[5], w1, false); w1 = __builtin_amdgcn_cvt_pk_fp8_f32(h[6], h[7], w1, true);
                    typedef unsigned u32x2 __attribute__((ext_vector_type(2))); *(u32x2*)((unsigned char*)O + (size_t)row * ldc + col0) = (u32x2){w0, w1}; }
                else { bf16_t* rowp = O + (size_t)row * ldc + col0;
                u32x4 w; w.x = cvt_pk_bf16(silu2_mul(g0[0], u0[0]), silu2_mul(g0[1], u0[1])); w.y = cvt_pk_bf16(silu2_mul(g0[2], u0[2]), silu2_mul(g0[3], u0[3]));
                w.z = cvt_pk_bf16(silu2_mul(g1[0], u1[0]), silu2_mul(g1[1], u1[1])); w.w = cvt_pk_bf16(silu2_mul(g1[2], u1[2]), silu2_mul(g1[3], u1[3]));
                *(u32x4*)rowp = w; } }
    }
};
struct GOrder {
    StaticOrder so; const char* A; const char* B; size_t a_tile, b_tile, b_exp; int tb1, tb2, tb3, tb4, tb5, tb6, tb7;
    __device__ __forceinline__ bool next(int i, Unit& u) const { return so.next(i, u); }
    __device__ __forceinline__ const char* a_base(const Unit& u) const { return A + (size_t)u.pm * a_tile; }
    __device__ __forceinline__ const char* b_base(const Unit& u) const {
        const int e = (u.pm >= tb1) + (u.pm >= tb2) + (u.pm >= tb3) + (u.pm >= tb4) + (u.pm >= tb5) + (u.pm >= tb6) + (u.pm >= tb7);
        return B + (size_t)e * b_exp + (size_t)u.pn * b_tile; }
    __device__ __forceinline__ int nt(const Unit&, int full) const { return full; }
    __device__ __forceinline__ void a_ready(const Unit&) const {}
    __device__ __forceinline__ void done(const Unit&) const {}
};
struct GOrderTail {
    static constexpr int MAIN_M = 128, NTF = 28;
    StaticOrder so; const char* A; const char* B; size_t a_tile, b_tile, b_exp; int tb1, tb2, tb3, tb4, tb5, tb6, tb7; int n_main, n_piece;
    __device__ __forceinline__ void init(int n_mtiles, int N, int G, int c) { so.init(MAIN_M * BM, N, G, c); n_main = c < so.nwg ? (so.nwg - c + G - 1) / G : 0; n_piece = (n_mtiles - MAIN_M) * 4 * 8; }
    __device__ __forceinline__ bool next(int i, Unit& u) const {
        const bool mainu = i < n_main; const int q = (i - n_main) * so.G + so.c, ut = q >> 3;
        Unit m; m.pm = 0; m.pn = 0; m.tq = -1; so.next(mainu ? i : 0, m);
        u.pm = mainu ? m.pm : MAIN_M + (ut >> 2); u.pn = mainu ? m.pn : (ut & 3); u.tq = mainu ? -1 : q;
        return mainu || q < n_piece; }
    __device__ __forceinline__ int nt(const Unit& u, int full) const { return u.tq < 0 ? full : ((u.tq & 7) < 6 ? 4 : 2); }
    __device__ __forceinline__ const char* a_base(const Unit& u) const { const int kp = u.tq & 7, k0 = u.tq < 0 ? 0 : (kp < 6 ? 4 * kp : 2 * kp + 12); return A + (size_t)u.pm * a_tile + (size_t)k0 * (BK * 2); }
    __device__ __forceinline__ const char* b_base(const Unit& u) const {
        const int e = (u.pm >= tb1) + (u.pm >= tb2) + (u.pm >= tb3) + (u.pm >= tb4) + (u.pm >= tb5) + (u.pm >= tb6) + (u.pm >= tb7);
        const int kp = u.tq & 7, k0 = u.tq < 0 ? 0 : (kp < 6 ? 4 * kp : 2 * kp + 12);
        return B + (size_t)e * b_exp + (size_t)u.pn * b_tile + (size_t)k0 * (BK * 2); }
    __device__ __forceinline__ void a_ready(const Unit&) const {}
    __device__ __forceinline__ void done(const Unit&) const {}
};
struct EpiBfPart {
    static constexpr bool PERM = true, AFTER_DRAIN = false; static constexpr int YP_TILE0 = 136;
    bf16_t* O; int ldc; float scale;
    struct Pre {}; __device__ __forceinline__ void prefetch(Pre&, const Unit&, int, int, int, int, int) const {} __device__ __forceinline__ void commit(const Pre&, int, int, int, int, int) const {}
    __device__ __forceinline__ void operator()(const f32x4 (&acc)[2][2][4][2], const Unit& u, int wr, int wc, int fr_, int fq_, const Pre&, int) const {
        int fr = fr_, fq = fq_; asm volatile("" : "+v"(fr), "+v"(fq));
        const int vt = u.tq < 0 ? u.pm : YP_TILE0 + (u.tq & 7) * 8 + (u.pm - GOrderTail::MAIN_M);
        const int row0 = vt * BM + wr * 64 + fr, col0 = u.pn * BM + wc * 32 + 8 * fq;
#pragma unroll
        for (int ai = 0; ai < 2; ++ai)
#pragma unroll
            for (int m = 0; m < 4; ++m) { bf16_t* rowp = O + (size_t)(row0 + ai * HALF + m * 16) * ldc + col0;
#pragma unroll
                for (int bj = 0; bj < 2; ++bj) { const f32x4 v0 = acc[ai][bj][m][0] * scale, v1 = acc[ai][bj][m][1] * scale;
                    u32x4 w; w.x = cvt_pk_bf16(v0[0], v0[1]); w.y = cvt_pk_bf16(v0[2], v0[3]); w.z = cvt_pk_bf16(v1[0], v1[1]); w.w = cvt_pk_bf16(v1[2], v1[3]);
                    *(u32x4*)(rowp + bj * HALF) = w; } }
    }
};
template <class Epi, class Sched, bool ALIGN_EPI = false, bool SP2 = false, int MODE = 0  , int XEXP = 0  >
__device__ __forceinline__ void gemm_phase(PG8_LAS unsigned char* lds, const Gemm g, const Sched& S, const Epi& E) {
    const int tid = threadIdx.x, wid = __builtin_amdgcn_readfirstlane(tid >> 6), lane = tid & 63, wr = wid >> 2, wc = wid & 3, fr = lane & 15, fq = lane >> 4;
    const int K = g.K, nt = K / BK;
    unsigned voffA[2], voffB[2];
#pragma unroll
    for (int i = 0; i < 2; ++i) { int R, C; stage_rc(tid * 16 + i * 8192, R, C); const int Rb = Epi::PERM ? ((R & ~31) + perm32(R & 31)) : R;
        voffA[i] = (unsigned)(R * K + C) * 2u; voffB[i] = (unsigned)(Rb * K + C) * 2u; }
    const size_t kstep = (size_t)(BK * 2);
    const size_t hstep = (size_t)HALF * K * 2;
        const unsigned ldsw = (unsigned)wid * 1024u;
    const int aoff = lds_byte(wr * 64 + fr, fq * 8), boff = lds_byte(wc * 32 + fr, fq * 8);
#define PG8_SA(b, h) (((b) * 2 + (h)) * HTB)
#define PG8_SB(b, h) ((4 + (b) * 2 + (h)) * HTB)
#define PG8_STAGE(bufoff, gbase, voff) do { if constexpr (XEXP != 2) _Pragma("unroll") for (int _i = 0; _i < 2; ++_i) \
        __builtin_amdgcn_global_load_lds((const unsigned*)((const char*)(gbase) + (voff)[_i]), (PG8_LAS unsigned*)(lds + (bufoff) + ldsw + _i * 8192), 16, 0, 0); } while (0)
#define PG8_LDA(dst, b, h) do { if constexpr (XEXP < 3) _Pragma("unroll") for (int m = 0; m < 4; ++m) dst[m] = ldfrag<MODE>(lds + PG8_SA(b, h) + aoff + m * 2048); } while (0)
#define PG8_LDB(dst, b, h) do { if constexpr (XEXP < 3) _Pragma("unroll") for (int n = 0; n < 2; ++n) dst[n] = ldfrag<MODE>(lds + PG8_SB(b, h) + boff + n * 2048); } while (0)
#define PG8_MMA(ai, bj, At, Bt) do { __builtin_amdgcn_s_setprio(1); _Pragma("unroll") for (int m = 0; m < 4; ++m) _Pragma("unroll") for (int n = 0; n < 2; ++n) \
        mma_step<MODE>(acc[ai][bj][m][n], Bt[n], At[m]); __builtin_amdgcn_s_setprio(0); } while (0)
#define PG8_WAIT_V(n) do { if constexpr (XEXP != 1) asm volatile("s_waitcnt vmcnt(" #n ")" ::: "memory"); } while (0)
#define PG8_WAIT_L(n) asm volatile("s_waitcnt lgkmcnt(" #n ")" ::: "memory")
#define PG8_BAR do { if constexpr (XEXP < 4) __builtin_amdgcn_s_barrier(); } while (0)
#define PG8_SCHED __builtin_amdgcn_sched_barrier(0)
    Unit cur, nxt; int ui = 0; typename Epi::Pre pre;
    if (!S.next(0, cur)) return;
    typename AccT<MODE == 1>::type acc[2][2][4][2];
#pragma unroll
    for (int a = 0; a < 2; ++a)
#pragma unroll
        for (int b = 0; b < 2; ++b)
#pragma unroll
            for (int m = 0; m < 4; ++m)
#pragma unroll
                for (int n = 0; n < 2; ++n) acc[a][b][m][n] = typename AccT<MODE == 1>::type{};
    typename Frag<MODE>::type At[4], B0[2], B1[2];
    const char* cA = S.a_base(cur); const char* cB = S.b_base(cur);
    S.a_ready(cur);
    if constexpr (SP2) {
        PG8_STAGE(PG8_SB(0, 0), cB, voffB); PG8_STAGE(PG8_SB(0, 1), cB + hstep, voffB); PG8_STAGE(PG8_SA(0, 0), cA, voffA); PG8_STAGE(PG8_SA(0, 1), cA + hstep, voffA);
        if (wr == 1) PG8_BAR;
        PG8_WAIT_V(2); PG8_BAR;
        PG8_STAGE(PG8_SB(1, 0), cB + kstep, voffB); PG8_STAGE(PG8_SA(1, 0), cA + kstep, voffA); PG8_STAGE(PG8_SB(1, 1), cB + hstep + kstep, voffB);
        PG8_WAIT_V(6); PG8_BAR;
    } else {
        PG8_STAGE(PG8_SB(0, 0), cB, voffB); PG8_STAGE(PG8_SA(0, 0), cA, voffA); PG8_STAGE(PG8_SB(0, 1), cB + hstep, voffB); PG8_STAGE(PG8_SA(0, 1), cA + hstep, voffA);
        if (wr == 1) PG8_BAR;
        PG8_WAIT_V(4); PG8_BAR;
        PG8_STAGE(PG8_SB(1, 0), cB + kstep, voffB); PG8_STAGE(PG8_SA(1, 0), cA + kstep, voffA); PG8_STAGE(PG8_SB(1, 1), cB + hstep + kstep, voffB);
        PG8_WAIT_V(6); PG8_BAR;
    }
    for (;;) {
        const bool has_next = S.next(ui + 1, nxt);
        const char* nA = has_next ? S.a_base(nxt) : cA; const char* nB = has_next ? S.b_base(nxt) : cB;
        const int ntc = S.nt(cur, nt);
        for (int t = 0; t < ntc; t += 2) {
            const bool last = (t == ntc - 2);
            const char* a1 = cA + (size_t)(t + 1) * kstep;
            const char* a2 = last ? nA : cA + (size_t)(t + 2) * kstep; const char* b2 = last ? nB : cB + (size_t)(t + 2) * kstep;
            const char* a3 = a2 + kstep; const char* b3 = b2 + kstep;
            if (last && has_next) S.a_ready(nxt);
            if (last) E.prefetch(pre, cur, wr, wc, fr, fq, ui);
            if constexpr (SP2) {
            PG8_LDB(B0, 0, 0); PG8_LDB(B1, 0, 1); PG8_SCHED; PG8_LDA(At, 0, 0); PG8_STAGE(PG8_SA(1, 1), a1 + hstep, voffA);
            PG8_WAIT_V(8); PG8_WAIT_L(0); PG8_BAR; PG8_MMA(0, 0, At, B0); PG8_MMA(0, 1, At, B1); PG8_BAR; PG8_SCHED;
            PG8_LDA(At, 0, 1); PG8_STAGE(PG8_SB(0, 0), b2, voffB); PG8_STAGE(PG8_SB(0, 1), b2 + hstep, voffB); PG8_STAGE(PG8_SA(0, 0), a2, voffA);
            PG8_WAIT_V(8); PG8_WAIT_L(0); PG8_BAR; PG8_MMA(1, 0, At, B0); PG8_MMA(1, 1, At, B1); PG8_BAR; PG8_SCHED;
            PG8_LDB(B0, 1, 0); PG8_LDB(B1, 1, 1); PG8_SCHED; PG8_LDA(At, 1, 0); PG8_STAGE(PG8_SA(0, 1), a2 + hstep, voffA);
            PG8_WAIT_V(8); PG8_WAIT_L(0); PG8_BAR; PG8_MMA(0, 0, At, B0); PG8_MMA(0, 1, At, B1); PG8_BAR; PG8_SCHED;
            PG8_LDA(At, 1, 1); PG8_STAGE(PG8_SB(1, 0), b3, voffB); PG8_STAGE(PG8_SB(1, 1), b3 + hstep, voffB); PG8_STAGE(PG8_SA(1, 0), a3, voffA);
            PG8_WAIT_V(8); PG8_WAIT_L(0); PG8_BAR; PG8_MMA(1, 0, At, B0); PG8_MMA(1, 1, At, B1); PG8_BAR; PG8_SCHED;
            } else {
            PG8_LDB(B0, 0, 0); PG8_SCHED; PG8_LDA(At, 0, 0); PG8_STAGE(PG8_SA(1, 1), a1 + hstep, voffA);
            PG8_WAIT_L(8); PG8_BAR; PG8_WAIT_L(0); PG8_MMA(0, 0, At, B0); PG8_BAR; PG8_SCHED;
            PG8_LDB(B1, 0, 1); PG8_STAGE(PG8_SB(0, 0), b2, voffB);
            PG8_BAR; PG8_WAIT_L(0); PG8_MMA(0, 1, At, B1); PG8_BAR;
            PG8_LDA(At, 0, 1); PG8_STAGE(PG8_SA(0, 0), a2, voffA);
            PG8_BAR; PG8_WAIT_L(0); PG8_MMA(1, 0, At, B0); PG8_BAR; PG8_SCHED;
            PG8_STAGE(PG8_SB(0, 1), b2 + hstep, voffB);
            PG8_WAIT_V(6); PG8_BAR; PG8_MMA(1, 1, At, B1); PG8_BAR;
            PG8_LDB(B0, 1, 0); PG8_SCHED; PG8_LDA(At, 1, 0); PG8_STAGE(PG8_SA(0, 1), a2 + hstep, voffA);
            PG8_WAIT_L(8); PG8_BAR; PG8_WAIT_L(0); PG8_MMA(0, 0, At, B0); PG8_BAR; PG8_SCHED;
            PG8_LDB(B1, 1, 1); PG8_STAGE(PG8_SB(1, 0), b3, voffB);
            PG8_BAR; PG8_WAIT_L(0); PG8_MMA(0, 1, At, B1); PG8_BAR;
            PG8_LDA(At, 1, 1); PG8_STAGE(PG8_SA(1, 0), a3, voffA);
            PG8_BAR; PG8_WAIT_L(0); PG8_MMA(1, 0, At, B0); PG8_BAR; PG8_SCHED;
            PG8_STAGE(PG8_SB(1, 1), b3 + hstep, voffB);
            PG8_WAIT_V(6); PG8_BAR; PG8_MMA(1, 1, At, B1); PG8_BAR;
            }
        }
        E.commit(pre, wr, wc, fr, fq, ui);
        if constexpr (ALIGN_EPI) { if (wr == 0) PG8_BAR; }
        if constexpr (MODE == 2) asm volatile("s_nop 15\n\ts_nop 7" ::: "memory");
        if constexpr (!Epi::AFTER_DRAIN) { E(acc, cur, wr, wc, fr, fq, pre, ui); S.done(cur); }
        if (!has_next) break;
#pragma unroll
        for (int a = 0; a < 2; ++a)
#pragma unroll
            for (int b = 0; b < 2; ++b)
#pragma unroll
                for (int m = 0; m < 4; ++m)
#pragma unroll
                    for (int n = 0; n < 2; ++n) acc[a][b][m][n] = typename AccT<MODE == 1>::type{};
        cur = nxt; cA = nA; cB = nB; ++ui;
        if constexpr (ALIGN_EPI) { if (wr == 1) PG8_BAR; }
    }
    PG8_WAIT_V(0);
    if constexpr (!ALIGN_EPI) { if (wr == 0) PG8_BAR; }
    PG8_BAR;
    if constexpr (Epi::AFTER_DRAIN) { E.fused(acc, cur, wr, wc, fr, fq, lds, wid, lane); S.done(cur); }
#undef PG8_SA
#undef PG8_SB
#undef PG8_STAGE
#undef PG8_LDA
#undef PG8_LDB
#undef PG8_MMA
#undef PG8_WAIT_V
#undef PG8_WAIT_L
#undef PG8_BAR
#undef PG8_SCHED
}
}
#include <hip/hip_bf16.h>
#include <cmath>
namespace attn_body {
using bf16=__hip_bfloat16;
using bf16x8=__attribute__((ext_vector_type(8)))short;
using s16x4=__attribute__((ext_vector_type(4)))short;
using f32x16=__attribute__((ext_vector_type(16)))float;
using u32x4=__attribute__((ext_vector_type(4)))unsigned;
constexpr int BATCH=2,NHEAD=8,SEQ=8192,D=64,DM=3584,OPITCH=1024;
constexpr int NW=8,QBLK=32,QB=QBLK*NW,KVBLK=64,NQB=SEQ/QB;
constexpr int ATTN_PITCH=DM, ATTN_UNIT_ROWS=QB;
__device__ __forceinline__ int crow(int r,int hi){return (r&3)+8*(r>>2)+4*hi;}
#define SBAR() __builtin_amdgcn_sched_barrier(0)
__device__ __forceinline__ void cmask(f32x16&p0,f32x16&p1,int jb,int qrel,int hi){
  const float NEG=-INFINITY; int kb=64*jb+4*hi;
  #pragma unroll
  for(int r=0;r<16;++r){int kv=kb+(r&3)+8*(r>>2); if(kv>qrel)p0[r]=NEG; if(kv+32>qrel)p1[r]=NEG;}
}

constexpr int NSLOT=3, SLOTB=8192, SPLIT_NT=72, PART_F=256*64+512;
constexpr int LDS_K=0, LDS_V=NSLOT*SLOTB, LDS_WS=2*NSLOT*SLOTB, LDS_OST=LDS_WS+NW*64*4, LDS_CK=LDS_OST+NW*4096, LDS_BYTES=LDS_CK+SEQ*4;
constexpr float C2=0.125f*1.4426950408889634f;
__device__ __forceinline__ void glds16(const void*gsrc,unsigned lds_dst){unsigned keep;
  asm volatile("s_mov_b32 %0, m0\n\ts_mov_b32 m0, %2\n\ts_nop 0\n\tglobal_load_lds_dwordx4 %1, off\n\ts_mov_b32 m0, %0":"=&s"(keep):"v"(gsrc),"s"(lds_dst):"memory");}
__device__ __forceinline__ float max3f(float a,float b,float c){float r;asm("v_max3_f32 %0, %1, %2, %3":"=v"(r):"v"(a),"v"(b),"v"(c));return r;}
__device__ __forceinline__ float max2f(float a,float b){float r;asm("v_max_f32_e32 %0, %1, %2":"=v"(r):"v"(a),"v"(b));return r;}
__device__ __forceinline__ float fadd_s(float a,float b){float r;asm("v_add_f32_e32 %0, %1, %2":"=v"(r):"v"(a),"v"(b));return r;}
__device__ __forceinline__ float fsub_s(float a,float b){float r;asm("v_sub_f32_e32 %0, %1, %2":"=v"(r):"v"(a),"v"(b));return r;}
typedef float f32x2_t __attribute__((ext_vector_type(2))); typedef float f32x4_t __attribute__((ext_vector_type(4))); typedef __bf16 bf16x2_t __attribute__((ext_vector_type(2)));
__device__ __forceinline__ unsigned cvtpk_s(float lo,float hi){f32x2_t v={lo,hi};bf16x2_t b=__builtin_convertvector(v,bf16x2_t);return __builtin_bit_cast(unsigned,b);}
#define WAIT_BAR(N) asm volatile("s_waitcnt vmcnt(" #N ") lgkmcnt(0)\n\ts_barrier":::"memory")

__device__ __forceinline__ void qkt(f32x16&p0,f32x16&p1,const char*Kslot,const bf16x8*qr,const f32x16&negm,int r32,int hi){
  const char*kb=Kslot+hi*1024+r32*16;
  #pragma unroll
  for(int d0=0;d0<4;++d0){
    const bf16x8 b0=*reinterpret_cast<const bf16x8*>(kb+d0*2048);
    const bf16x8 b1=*reinterpret_cast<const bf16x8*>(kb+d0*2048+512);
    if(d0==0){p0=__builtin_amdgcn_mfma_f32_32x32x16_bf16(b0,qr[0],negm,0,0,0);p1=__builtin_amdgcn_mfma_f32_32x32x16_bf16(b1,qr[0],negm,0,0,0);}
    else{p0=__builtin_amdgcn_mfma_f32_32x32x16_bf16(b0,qr[d0],p0,0,0,0);p1=__builtin_amdgcn_mfma_f32_32x32x16_bf16(b1,qr[d0],p1,0,0,0);}}
}
typedef __attribute__((address_space(3))) const char* lds_cptr;
typedef short v4i16_t __attribute__((ext_vector_type(4)));
__device__ __forceinline__ void kload8(bf16x8*kf,lds_cptr kp){
  kf[0]=*(const __attribute__((address_space(3))) bf16x8*)(kp);      kf[1]=*(const __attribute__((address_space(3))) bf16x8*)(kp+512);
  kf[2]=*(const __attribute__((address_space(3))) bf16x8*)(kp+2048); kf[3]=*(const __attribute__((address_space(3))) bf16x8*)(kp+2560);
  kf[4]=*(const __attribute__((address_space(3))) bf16x8*)(kp+4096); kf[5]=*(const __attribute__((address_space(3))) bf16x8*)(kp+4608);
  kf[6]=*(const __attribute__((address_space(3))) bf16x8*)(kp+6144); kf[7]=*(const __attribute__((address_space(3))) bf16x8*)(kp+6656);
}
__device__ __forceinline__ void kload2(bf16x8*kf,lds_cptr kp,int j){ kf[2*j]=*(const __attribute__((address_space(3))) bf16x8*)(kp+j*2048); kf[2*j+1]=*(const __attribute__((address_space(3))) bf16x8*)(kp+j*2048+512); }
__device__ __forceinline__ s16x4 vtr(lds_cptr p){ return __builtin_bit_cast(s16x4,__builtin_amdgcn_ds_read_tr16_b64_v4i16((__attribute__((address_space(3))) v4i16_t*)p)); }
__device__ __forceinline__ float rowmax(const f32x16&p0,const f32x16&p1){
  float a=max3f(p0[0],p0[1],p1[0]),b=max3f(p0[2],p0[3],p1[1]);a=max3f(a,p1[2],p1[3]);
  #pragma unroll
  for(int r=4;r<16;r+=4){a=max3f(a,p0[r],p0[r+1]);b=max3f(b,p0[r+2],p0[r+3]);a=max3f(a,p1[r],p1[r+1]);b=max3f(b,p1[r+2],p1[r+3]);}
  const float m=max2f(a,b);
  auto rr=__builtin_amdgcn_permlane32_swap(__float_as_uint(m),__float_as_uint(m),false,false);
  return max2f(__uint_as_float(rr[0]),__uint_as_float(rr[1]));
}
__device__ __forceinline__ void pv(f32x16*o,int vb,bf16x8 pa0,bf16x8 pa1,bf16x8 pa2,bf16x8 pa3){
  #pragma unroll
  for(int d0=0;d0<2;++d0){s16x4 lo[4],hi[4];
    #pragma unroll
    for(int ks=0;ks<4;++ks){
      asm volatile("ds_read_b64_tr_b16 %0,%1 offset:%c2":"=&v"(lo[ks]):"v"(vb),"i"(d0*4096+ks*1024):"memory");
      asm volatile("ds_read_b64_tr_b16 %0,%1 offset:%c2":"=&v"(hi[ks]):"v"(vb),"i"(d0*4096+ks*1024+512):"memory");}
    asm volatile("s_waitcnt lgkmcnt(0)":::"memory");SBAR();
    #define PK(k) (bf16x8){lo[k][0],lo[k][1],lo[k][2],lo[k][3],hi[k][0],hi[k][1],hi[k][2],hi[k][3]}
    o[d0]=__builtin_amdgcn_mfma_f32_32x32x16_bf16(pa0,PK(0),o[d0],0,0,0);
    o[d0]=__builtin_amdgcn_mfma_f32_32x32x16_bf16(pa1,PK(1),o[d0],0,0,0);
    o[d0]=__builtin_amdgcn_mfma_f32_32x32x16_bf16(pa2,PK(2),o[d0],0,0,0);
    o[d0]=__builtin_amdgcn_mfma_f32_32x32x16_bf16(pa3,PK(3),o[d0],0,0,0);
    #undef PK
  }
}

#ifndef ATTN_STORE16
#define ATTN_STORE16(p,v) (*(u32x4*)(p)=(v))
#endif
template<int THRL> __device__ __forceinline__ void attn_unit(int b,int h,int qb,const bf16*Q,const bf16*__restrict__ K,const bf16*__restrict__ V,bf16*O,const float*__restrict__ cf,const float Tskip,const int part,float*PART,unsigned*flag,char*shm){
  int tid_=threadIdx.x; asm volatile("":"+v"(tid_));
  const int tid=tid_,lane=tid&63,r32=lane&31,hi=lane>>5; const int wid=__builtin_amdgcn_readfirstlane(tid>>6);
  const long rowbase=(long)b*SEQ; const int q0=qb*QB;
  const bf16*Qw=Q+(rowbase+q0+wid*QBLK)*DM+h*D;
  const unsigned lds0=(unsigned)(uintptr_t)shm;
  float*wsf=(float*)(shm+LDS_WS)+wid*64;
  const unsigned kdst=lds0+LDS_K+wid*1024, vdst=lds0+LDS_V+wid*1024;
  #define DMA_K(t,slot) glds16(ksrc+(long)(t)*KVBLK*DM,(unsigned)__builtin_amdgcn_readfirstlane(kdst+(slot)))
  #define DMA_V(t,slot) glds16(vsrc+(long)(t)*KVBLK*DM,(unsigned)__builtin_amdgcn_readfirstlane(vdst+(slot)))
  const int vb0=(int)(lds0+LDS_V)+((lane>>4)&1)*32+(lane&3)*8+(4*hi+((lane&15)>>2))*64;
  const char*Kbase=shm+LDS_K; bf16x8 kf[8];
  const lds_cptr shm3=(lds_cptr)shm; const lds_cptr kp0=shm3+LDS_K+hi*1024+r32*16; const lds_cptr vp0=shm3+LDS_V+((lane>>4)&1)*32+(lane&3)*8+(4*hi+((lane&15)>>2))*64;
  typedef __attribute__((address_space(3))) float lds_f32; typedef __attribute__((address_space(3))) const f32x4_t* lds_cf4;
  const int NT0=(q0+QB)/KVBLK;
  int tb;
  { const float thr=cf[q0]+Tskip; const int t1=lane,t2=lane+64;
    const bool n1=(t1<NT0)&&(cf[64*t1+63]>thr), n2=(t2<NT0)&&(cf[64*t2+63]>thr);
    const int t0=(int)__popcll(__ballot(n1))+(int)__popcll(__ballot(n2));
    tb=t0&~1; if(tb>NT0-4)tb=NT0-4; tb=__builtin_amdgcn_readfirstlane(tb); }
  int NT=NT0-tb; bool band=true; const bool split=(PART!=nullptr)&&(NT>SPLIT_NT);
  if(PART!=nullptr){ if(!split){ if(part==1)return; } else { const int mid=(NT>>1)&~1; if(part==0){NT=mid;band=false;} else {tb+=mid;NT-=mid;} } }
  { lds_f32* ckw=(lds_f32*)((lds_cptr)shm+LDS_CK); int i0_=tb*KVBLK+tid; asm volatile("":"+v"(i0_)); _Pragma("nounroll") for(int i=i0_;i<q0+QB;i+=NW*64)ckw[i]=cf[i]; }
  const float cq=cf[q0+wid*QBLK+(lane&31)];
  asm volatile("s_waitcnt vmcnt(0) lgkmcnt(0)\n\ts_barrier":::"memory");
  const bf16*Kh=K+(rowbase+(long)tb*KVBLK)*DM+h*D,*Vh=V+(rowbase+(long)tb*KVBLK)*DM+h*D;
  const bf16*ksrc=Kh+(long)lane*DM+wid*8;
  const bf16*vsrc=Vh+(long)(16*(wid&3)+(lane>>2))*DM+(wid>>2)*32+(lane&3)*8;
  const lds_cptr ckl=(lds_cptr)shm+LDS_CK+256*tb+16*(lane>>5);
  #define CBIAS(P0,P1,t) do{ const lds_cptr cb_=ckl+256*(t); _Pragma("unroll") for(int g_=0;g_<4;++g_){ const f32x4_t a_=*(lds_cf4)(cb_+32*g_), b_=*(lds_cf4)(cb_+128+32*g_); \
      _Pragma("unroll") for(int i_=0;i_<4;++i_){ P0[4*g_+i_]-=(a_[i_]+mm); P1[4*g_+i_]-=(b_[i_]+mm); } } }while(0)
  f32x4_t cbA[4],cbB[4]; float clast;
  #define CBLD(t) do{ const lds_cptr cb_=ckl+256*(t); _Pragma("unroll") for(int g_=0;g_<4;++g_){ cbA[g_]=*(lds_cf4)(cb_+32*g_); cbB[g_]=*(lds_cf4)(cb_+128+32*g_); } \
      clast=*(const __attribute__((address_space(3))) float*)((lds_cptr)shm+LDS_CK+256*tb+256*(t)+252); }while(0)
  DMA_K(0,0);DMA_V(0,0);DMA_K(1,SLOTB);
  bf16x8 qr[4];
  #pragma unroll
  for(int d0=0;d0<4;++d0)qr[d0]=*reinterpret_cast<const bf16x8*>(&Qw[(long)r32*DM+d0*16+hi*8]);
  float mhat=0.f,l_reg=0.f;f32x16 o[2];o[0]=f32x16{};o[1]=f32x16{};float mm=-cq; const f32x16 negm=f32x16{};
  const int qrel=wid*QBLK+r32;
  #define CMASK(P0,P1,t) do{int jb_=(t)-(NT-4); if(band&&jb_>=0)cmask(P0,P1,jb_,qrel,hi);}while(0)
  bool resc=false;
  #define START(P0,P1) do{ const float rm=rowmax(P0,P1); resc=false; \
    { const float dl=rm; mhat=fadd_s(mhat,dl); \
      _Pragma("unroll") for(int r=0;r<16;++r){P0[r]=fsub_s(P0[r],dl);P1[r]=fsub_s(P1[r],dl);} \
      mm+=dl; } \
    _Pragma("unroll") for(int r=0;r<16;++r)P0[r]=__builtin_amdgcn_exp2f(P0[r]); }while(0)
  #define RESC() do{ if(resc){ asm volatile("s_waitcnt lgkmcnt(0)":::"memory"); \
      _Pragma("unroll") for(int d_=0;d_<2;++d_) _Pragma("unroll") for(int r=0;r<16;++r)o[d_][r]*=wsf[crow(r,hi)]; } }while(0)
  f32x16 pA0,pA1,pB0,pB1;
  int sl_prev=0,sl_cur=0,sl_next=SLOTB;
  #define ROT() do{sl_prev=sl_cur;sl_cur=sl_next;sl_next=(sl_next==(NSLOT-1)*SLOTB)?0:sl_next+SLOTB;}while(0)
  DMA_K(2,2*SLOTB);
  WAIT_BAR(3);
  qkt(pA0,pA1,Kbase,qr,negm,r32,hi);asm volatile("s_nop 15\n\ts_nop 7":"+v"(pA0),"+v"(pA1));CBIAS(pA0,pA1,0);CMASK(pA0,pA1,0);
  START(pA0,pA1);
  _Pragma("unroll") for(int r=0;r<16;++r)pA1[r]=__builtin_amdgcn_exp2f(pA1[r]);
  WAIT_BAR(0);
  DMA_K(3,0);DMA_V(1,SLOTB);
  ROT();
  kload8(kf,kp0+sl_cur);
  WAIT_BAR(2);
  s16x4 vlo[8],vhi[8]; u32x4 pw0,pw1,pw2,pw3;
  #define PKW(P,B) cvtpk_s(P[B],P[B+1])
  #define PAF(k) __builtin_bit_cast(bf16x8,pw##k)
  #define VFR(i) (bf16x8){vlo[i][0],vlo[i][1],vlo[i][2],vlo[i][3],vhi[i][0],vhi[i][1],vhi[i][2],vhi[i][3]}
  #define PIN(x) asm volatile("":"+v"(x))
  #define MX3(a,b,c) __builtin_fmaxf(__builtin_fmaxf((a),(b)),(c))
  #define GAPA(MF,A0,A1,A2,A3,W0,W1,PW) do{ MF; sacc+=A0; sacc+=A1; sacc+=A2; sacc+=A3; PIN(sacc); W0; W1; PIN(PW); SBAR(); }while(0)
  #define EX(v) __builtin_amdgcn_exp2f(v)
  #define GAPB(MF,X,B,CB) do{ MF; { const f32x4_t t_=(CB)+mm; X[B]=EX(X[B]-t_[0]); X[B+1]=EX(X[B+1]-t_[1]); X[B+2]=EX(X[B+2]-t_[2]); X[B+3]=EX(X[B+3]-t_[3]); } PIN(X); SBAR(); }while(0)
  #define VRD(i) do{ vlo[i]=vtr(vp_+(((i)>>2)*4096+((i)&3)*1024)); vhi[i]=vtr(vp_+(((i)>>2)*4096+((i)&3)*1024+512)); }while(0)
  #define KRD(G,j) do{ if(G){ kload2(kf,kp0+sl_next,j); SBAR(); } }while(0)
  #define STEP(C0,C1,P0,P1,t,GK,GV,GL) do{ SBAR(); \
    const lds_cptr vp_=vp0+sl_prev; \
    VRD(0); SBAR(); float sacc=(P0[0]+P0[1]); \
    GAPA(C0=__builtin_amdgcn_mfma_f32_32x32x16_bf16(kf[0],qr[0],negm,0,0,0), P0[2],P0[3],P0[4],P0[5],     pw0[0]=PKW(P0,0), pw0[1]=PKW(P0,2), pw0); \
    VRD(4); SBAR(); GAPA(C1=__builtin_amdgcn_mfma_f32_32x32x16_bf16(kf[1],qr[0],negm,0,0,0), P0[6],P0[7],P0[8],P0[9],     pw0[2]=PKW(P0,4), pw0[3]=PKW(P0,6), pw0); \
    VRD(1); SBAR(); GAPA(C0=__builtin_amdgcn_mfma_f32_32x32x16_bf16(kf[2],qr[1],C0,0,0,0),   P0[10],P0[11],P0[12],P0[13], pw1[0]=PKW(P0,8), pw1[1]=PKW(P0,10), pw1); \
    VRD(5); SBAR(); GAPA(C1=__builtin_amdgcn_mfma_f32_32x32x16_bf16(kf[3],qr[1],C1,0,0,0),   P0[14],P0[15],P1[0],P1[1],   pw1[2]=PKW(P0,12),pw1[3]=PKW(P0,14), pw1); \
    VRD(2); SBAR(); GAPA(C0=__builtin_amdgcn_mfma_f32_32x32x16_bf16(kf[4],qr[2],C0,0,0,0),   P1[2],P1[3],P1[4],P1[5],     pw2[0]=PKW(P1,0), pw2[1]=PKW(P1,2), pw2); \
    VRD(6); SBAR(); GAPA(C1=__builtin_amdgcn_mfma_f32_32x32x16_bf16(kf[5],qr[2],C1,0,0,0),   P1[6],P1[7],P1[8],P1[9],     pw2[2]=PKW(P1,4), pw2[3]=PKW(P1,6), pw2); \
    VRD(3); SBAR(); GAPA(C0=__builtin_amdgcn_mfma_f32_32x32x16_bf16(kf[6],qr[3],C0,0,0,0),   P1[10],P1[11],P1[12],P1[13], pw3[0]=PKW(P1,8), pw3[1]=PKW(P1,10), pw3); \
    VRD(7); SBAR(); GAPA(C1=__builtin_amdgcn_mfma_f32_32x32x16_bf16(kf[7],qr[3],C1,0,0,0),   P1[14],P1[15],0.f,0.f,       pw3[2]=PKW(P1,12),pw3[3]=PKW(P1,14), pw3); \
    l_reg+=sacc; \
    if(GK){DMA_K((t)+3,sl_cur);} if(GV){DMA_V((t)+1,sl_next);} \
    CBLD(t); CMASK(C0,C1,t); \
    { float a=MX3(C0[0],C0[1],C1[0]),b=MX3(C0[2],C0[3],C1[1]); a=MX3(a,C1[2],C1[3]); \
      _Pragma("unroll") for(int r=4;r<16;r+=4){a=MX3(a,C0[r],C0[r+1]);b=MX3(b,C0[r+2],C0[r+3]);a=MX3(a,C1[r],C1[r+1]);b=MX3(b,C1[r+2],C1[r+3]);} \
      float rm=__builtin_fmaxf(a,b); { auto rr=__builtin_amdgcn_permlane32_swap(__float_as_uint(rm),__float_as_uint(rm),false,false); rm=__builtin_fmaxf(__uint_as_float(rr[0]),__uint_as_float(rr[1])); } rm=rm-clast-mm; \
      resc=false; \
      if(__builtin_expect(__any(rm>(float)THRL),0)){ const float dl=__builtin_fmaxf(rm,0.f); mhat+=dl; \
        mm+=dl; \
        const float f=__builtin_amdgcn_exp2f(-dl); l_reg*=f; if(hi==0)wsf[r32]=f; resc=true; } } \
    SBAR(); \
    GAPB(o[0]=__builtin_amdgcn_mfma_f32_32x32x16_bf16(PAF(0),VFR(0),o[0],0,0,0), C0,0,cbA[0]); \
    GAPB(o[1]=__builtin_amdgcn_mfma_f32_32x32x16_bf16(PAF(0),VFR(4),o[1],0,0,0), C0,4,cbA[1]); \
    KRD(GL,0); GAPB(o[0]=__builtin_amdgcn_mfma_f32_32x32x16_bf16(PAF(1),VFR(1),o[0],0,0,0), C0,8,cbA[2]); \
    KRD(GL,1); GAPB(o[1]=__builtin_amdgcn_mfma_f32_32x32x16_bf16(PAF(1),VFR(5),o[1],0,0,0), C0,12,cbA[3]); \
    KRD(GL,2); GAPB(o[0]=__builtin_amdgcn_mfma_f32_32x32x16_bf16(PAF(2),VFR(2),o[0],0,0,0), C1,0,cbB[0]); \
    KRD(GL,3); GAPB(o[1]=__builtin_amdgcn_mfma_f32_32x32x16_bf16(PAF(2),VFR(6),o[1],0,0,0), C1,4,cbB[1]); \
    GAPB(o[0]=__builtin_amdgcn_mfma_f32_32x32x16_bf16(PAF(3),VFR(3),o[0],0,0,0), C1,8,cbB[2]); \
    GAPB(o[1]=__builtin_amdgcn_mfma_f32_32x32x16_bf16(PAF(3),VFR(7),o[1],0,0,0), C1,12,cbB[3]); \
    }while(0)
  int t=1;
  #undef CMASK
  #define CMASK(P0,P1,t) do{}while(0)
  for(;t+5<NT;t+=2){
    STEP(pB0,pB1,pA0,pA1,t,true,true,true);     WAIT_BAR(2); RESC(); ROT();
    STEP(pA0,pA1,pB0,pB1,t+1,true,true,true);   WAIT_BAR(2); RESC(); ROT();
  }
  #undef CMASK
  #define CMASK(P0,P1,t) do{int jb_=(t)-(NT-4); if(band&&jb_>=0)cmask(P0,P1,jb_,qrel,hi);}while(0)
  #define ENDW(tt) do{ if((tt)+3<NT){WAIT_BAR(2);} else if((tt)+2<NT){WAIT_BAR(1);} else {WAIT_BAR(0);} }while(0)
  for(;t+1<NT;t+=2){
    STEP(pB0,pB1,pA0,pA1,t,(t+3<NT),(t+1<NT),(t+1<NT));       ENDW(t);   RESC(); ROT();
    STEP(pA0,pA1,pB0,pB1,t+1,(t+4<NT),(t+2<NT),(t+2<NT));     ENDW(t+1); RESC(); ROT();
  }
  STEP(pB0,pB1,pA0,pA1,NT-1,false,false,false); RESC();
  { float sacc=pB0[0]+pB0[1]; _Pragma("unroll") for(int r=2;r<16;++r)sacc+=pB0[r]; _Pragma("unroll") for(int r=0;r<16;++r)sacc+=pB1[r]; l_reg+=sacc;
    pw0=(u32x4){PKW(pB0,0),PKW(pB0,2),PKW(pB0,4),PKW(pB0,6)};pw1=(u32x4){PKW(pB0,8),PKW(pB0,10),PKW(pB0,12),PKW(pB0,14)};pw2=(u32x4){PKW(pB1,0),PKW(pB1,2),PKW(pB1,4),PKW(pB1,6)};pw3=(u32x4){PKW(pB1,8),PKW(pB1,10),PKW(pB1,12),PKW(pB1,14)};
    SBAR(); pv(o,vb0+sl_cur,PAF(0),PAF(1),PAF(2),PAF(3)); }
  #undef PKW
  #undef PAF
  #undef VFR
  #undef PIN
  #undef MX3
  #undef GAPA
  #undef GAPB
  #undef EX
  #undef VRD
  #undef KRD
  #undef STEP
  #undef ENDW
  {auto rr=__builtin_amdgcn_permlane32_swap(__float_as_uint(l_reg),__float_as_uint(l_reg),false,false);l_reg=__uint_as_float(rr[0])+__uint_as_float(rr[1]);}
  if(hi==0)wsf[32+r32]=l_reg;asm volatile("s_waitcnt lgkmcnt(0)":::"memory");
  float rli[16];
  if(split){
    float*Pm=PART+(size_t)part*PART_F; const float*Po=PART+(size_t)(1-part)*PART_F;
    #pragma unroll
    for(int r=0;r<16;++r){
      #pragma unroll
      for(int d0=0;d0<2;++d0)Pm[(wid*QBLK+crow(r,hi))*64+d0*32+r32]=o[d0][r];}
    if(hi==0){Pm[QB*64+(wid*QBLK+r32)*2]=mm+cq;Pm[QB*64+(wid*QBLK+r32)*2+1]=l_reg;wsf[r32]=mm+cq;}
    asm volatile("s_waitcnt vmcnt(0) lgkmcnt(0)\n\ts_barrier":::"memory");
    if(tid==0){ __builtin_amdgcn_fence(__ATOMIC_RELEASE,"agent"); asm volatile("s_waitcnt vmcnt(0)":::"memory");
      *(volatile __attribute__((address_space(3))) unsigned*)((__attribute__((address_space(3))) char*)shm+LDS_OST)=__hip_atomic_fetch_add(flag,1u,__ATOMIC_RELAXED,__HIP_MEMORY_SCOPE_AGENT); }
    asm volatile("s_waitcnt vmcnt(0) lgkmcnt(0)\n\ts_barrier":::"memory");
    const unsigned old=*(volatile __attribute__((address_space(3))) unsigned*)((__attribute__((address_space(3))) char*)shm+LDS_OST);
    asm volatile("s_waitcnt lgkmcnt(0)\n\ts_barrier":::"memory");
    if(old==0u)return;
    __builtin_amdgcn_fence(__ATOMIC_ACQUIRE,"agent"); asm volatile("s_waitcnt vmcnt(0)":::"memory");
    #pragma unroll
    for(int r=0;r<16;++r){ const int row=crow(r,hi); const float mo=wsf[row],lo=wsf[32+row],mt=Po[QB*64+(wid*QBLK+row)*2],lt=Po[QB*64+(wid*QBLK+row)*2+1];
      const float m=__builtin_fmaxf(mo,mt),fo=__builtin_amdgcn_exp2f(mo-m),ft=__builtin_amdgcn_exp2f(mt-m),inv=__builtin_amdgcn_rcpf(lo*fo+lt*ft);
      #pragma unroll
      for(int d0=0;d0<2;++d0)o[d0][r]=(o[d0][r]*fo+Po[(wid*QBLK+row)*64+d0*32+r32]*ft)*inv;
      rli[r]=1.f; }
  } else {
  #pragma unroll
  for(int r=0;r<16;++r)rli[r]=__builtin_amdgcn_rcpf(wsf[32+crow(r,hi)]);
  }
  bf16*Ow=O+(rowbase+q0+wid*QBLK)*OPITCH+h*D;
  { bf16*stg=(bf16*)(shm+LDS_OST)+wid*2048;
    #pragma unroll
    for(int r=0;r<16;++r){const int orow=crow(r,hi);
      #pragma unroll
      for(int d0=0;d0<2;++d0)stg[orow*64+d0*32+r32]=__float2bfloat16(o[d0][r]*rli[r]);}
    asm volatile("s_waitcnt lgkmcnt(0)":::"memory");
    #pragma unroll
    for(int i=0;i<4;++i){const int row=i*8+(lane>>3),ch=lane&7; const u32x4 v=*(const u32x4*)(stg+row*64+ch*8); ATTN_STORE16(Ow+(long)row*OPITCH+ch*8,v);} }
  asm volatile("s_waitcnt lgkmcnt(0)\n\ts_barrier":::"memory");
  #undef CBIAS
  #undef CBLD
  #undef DMA_K
  #undef DMA_V
  #undef CMASK
  #undef START
  #undef RESC
  #undef ROT
}
constexpr int ATTN_LDS_BYTES=LDS_BYTES;
struct AttnTensors { const bf16* Q; const bf16* K; const bf16* V; bf16* O; const float* CF; const float* stat; };
struct AttnUnit { int bh; int qb; };
struct StaticOrder {
  int vcu;
  __device__ __forceinline__ explicit StaticOrder(int grid,int block):vcu((grid%8==0)?(block%8)*(grid/8)+block/8:block),G_(grid){}
  int G_;
  __device__ __forceinline__ bool next(int i,AttnUnit&u)const{ const int v=vcu+(i>>1)*G_; if(v>=256)return false; const int s=v&15; u.bh=v>>4; u.qb=(i&1)?31-s:s; return true; }
  __device__ __forceinline__ void a_ready(const AttnUnit&)const{}
  __device__ __forceinline__ void done(const AttnUnit&)const{}
};
struct QueueOrder {
  unsigned* ctr; __attribute__((address_space(3))) unsigned* slot;
  __device__ __forceinline__ bool next(int,AttnUnit&u)const{
    if(threadIdx.x==0)*slot=__hip_atomic_fetch_add(ctr,1u,__ATOMIC_RELAXED,__HIP_MEMORY_SCOPE_AGENT);
    asm volatile("s_waitcnt vmcnt(0) lgkmcnt(0)\n\ts_barrier":::"memory");
    const unsigned v=*(volatile __attribute__((address_space(3))) unsigned*)slot; const int vv=__builtin_amdgcn_readfirstlane((int)v);
    if(vv>=512)return false; u.qb=31-(vv>>4); u.bh=vv&15; return true; }
  __device__ __forceinline__ void a_ready(const AttnUnit&)const{}
  __device__ __forceinline__ void done(const AttnUnit&)const{}
};
template<class Sched,int THRL=8> __device__ __forceinline__ void attn_phase(char*lds,const AttnTensors&T,const Sched&S){
  AttnUnit u;
  for(int i=0;S.next(i,u);++i){ S.a_ready(u); const float Tsk=40.f+2.f*__builtin_sqrtf(T.stat[u.bh*2]*T.stat[u.bh*2+1])*1.01f+1.f;
    attn_unit<THRL>(u.bh/NHEAD,u.bh%NHEAD,u.qb,T.Q,T.K,T.V,T.O,T.CF+(long)u.bh*SEQ,Tsk,0,nullptr,nullptr,lds); S.done(u); }
}
#undef SBAR
#undef WAIT_BAR
}
#define GAS __attribute__((address_space(1)))
#define LAS __attribute__((address_space(3)))
typedef unsigned v4u __attribute__((ext_vector_type(4)));
typedef float f32x4 __attribute__((ext_vector_type(4)));
typedef short bf16x8 __attribute__((ext_vector_type(8)));
typedef GAS unsigned gu32;
typedef GAS unsigned long long gu64;
#define RLX_AGENT __ATOMIC_RELAXED, __HIP_MEMORY_SCOPE_AGENT
#define LDS_WAIT() asm volatile("s_waitcnt lgkmcnt(0)" ::: "memory")
#define VM_WAIT() asm volatile("s_waitcnt vmcnt(0)" ::: "memory")
__device__ __forceinline__ unsigned long long rt() { return __builtin_amdgcn_s_memrealtime(); }
__device__ __forceinline__ unsigned pk2(float lo, float hi) { return (unsigned)f2bf(lo) | ((unsigned)f2bf(hi) << 16); }

#define XB_TMO      128
#define XB_XCNT(j)  (256  + 64 * (j))
#define XB_XSUB(j)  (1280 + 64 * (j))
#define XB_XGEN(j)  (2304 + 64 * (j))
#define XB_TOP      3328
#define XB_TOPGEN   3392
#define XCD_BAR_WORDS 3456
#define XB_SPIN_CAP (1u << 18)

__device__ __forceinline__ unsigned xb_ld(unsigned* p)              { return __hip_atomic_load(p, __ATOMIC_RELAXED, __HIP_MEMORY_SCOPE_AGENT); }
__device__ __forceinline__ unsigned xb_add(unsigned* p, unsigned v) { return __hip_atomic_fetch_add(p, v, __ATOMIC_RELAXED, __HIP_MEMORY_SCOPE_AGENT); }
__device__ __forceinline__ unsigned xb_xcc_id() { return (unsigned)__builtin_amdgcn_s_getreg((3 << 11) | 20) & 0xFu; }
#define XB_SPIN(cond, bar) do { unsigned _sp = 0; while (cond) { __builtin_amdgcn_s_sleep(1); \
    if ((++_sp & 255u) == 0u) { if (xb_ld(&(bar)[XB_TMO])) break; if (_sp > XB_SPIN_CAP) { atomicAdd(&(bar)[XB_TMO], 1u); break; } } } } while (0)

struct XcdBarrier {
    unsigned* bar; unsigned x;
    volatile LAS unsigned* st;
};

__device__ __forceinline__ XcdBarrier xcd_barrier_post(unsigned* bar, volatile LAS unsigned* st) {
    XcdBarrier b; b.bar = bar; b.x = xb_xcc_id(); b.st = st;
    if (threadIdx.x == 0) (void)xb_add(&bar[XB_XCNT(b.x)], 1u);
    return b;
}
__device__ __forceinline__ void xcd_barrier_complete(unsigned* bar, unsigned x, unsigned& nloc, unsigned& nx) {
    const unsigned G = gridDim.x * gridDim.y * gridDim.z;
    unsigned sum, cnt, mine, sp = 0u;
    for (;;) {
        sum = 0u; cnt = 0u; mine = 0u;
#pragma unroll
        for (unsigned j = 0; j < 16; ++j) { const unsigned c = xb_ld(&bar[XB_XCNT(j)]); sum += c; cnt += (c > 0u) ? 1u : 0u; mine = (j == x) ? c : mine; }
        if (sum == G) break;
        __builtin_amdgcn_s_sleep(1);
        if ((++sp & 255u) == 0u) { if (xb_ld(&bar[XB_TMO])) break; if (sp > XB_SPIN_CAP) { atomicAdd(&bar[XB_TMO], 1u); break; } }
    }
    nloc = mine > 0u ? mine : 1u; nx = cnt > 0u ? cnt : 1u;
}

__device__ __forceinline__ void xcd_barrier(const XcdBarrier& b) {
    asm volatile("s_waitcnt vmcnt(0)" ::: "memory");
    __syncthreads();
    if (threadIdx.x == 0) {
        unsigned* bar = b.bar;
        __builtin_amdgcn_s_waitcnt(0);
        unsigned nloc = b.st[0], nx = b.st[1];
        if (nloc == 0u) { xcd_barrier_complete(bar, b.x, nloc, nx); b.st[0] = nloc; b.st[1] = nx; }
        const unsigned old = xb_add(&bar[XB_XSUB(b.x)], 1u);
        const unsigned gen = old / nloc;
        if (old + 1u == (gen + 1u) * nloc) {
            __builtin_amdgcn_fence(__ATOMIC_RELEASE, "agent");
            asm volatile("s_waitcnt vmcnt(0)" ::: "memory");
            const unsigned og = xb_add(&bar[XB_TOP], 1u);
            const unsigned tg = og / nx;
            if (og + 1u == (tg + 1u) * nx) xb_add(&bar[XB_TOPGEN], 1u);
            else XB_SPIN(xb_ld(&bar[XB_TOPGEN]) == tg, bar);
            __builtin_amdgcn_fence(__ATOMIC_ACQUIRE, "agent");
            xb_add(&bar[XB_XGEN(b.x)], 1u);
            asm volatile("s_waitcnt vmcnt(0)" ::: "memory");
        } else {
            XB_SPIN(xb_ld(&bar[XB_XGEN(b.x)]) == gen, bar);
            __builtin_amdgcn_fence(__ATOMIC_ACQUIRE, "agent");
            asm volatile("s_waitcnt vmcnt(0)" ::: "memory");
        }
    }
    __syncthreads();
}
constexpr int NWAVES = 8, NTHR = 512;
constexpr int RING_OFF = 0, RING_BYTES = 131072, LDSCTL_OFF = RING_BYTES, MISC_OFF = LDSCTL_OFF + 320, LDS_BYTES = 147456;
constexpr int CW_BAR = 4096;
constexpr size_t WS_WSM = 402 * MiB;
constexpr size_t WS_WIN = WS_WSM  , WS_SWIN = WS_WSM + 8 * MiB  , WS_WOUT = WS_WSM + 14 * MiB  , WS_WDGU = WS_WSM + 18 * MiB  , WS_SWDGU = WS_WSM + 24 * MiB  , WS_WDDN = WS_WSM + 29 * MiB  ;
constexpr size_t WS_SH = WS_H + 16 * MiB  , WS_SXG = WS_XG + 34 * MiB  ;
constexpr size_t WS_WMGU = WS_W  , WS_WMDN = 437 * MiB  ;
static_assert(WS_WDDN + 6 * MiB <= WS_WMDN && WS_WMGU + 56 * MiB <= WS_WSM && WS_WMDN + 28 * MiB <= WS_END, "ws");
struct MArgs { const float* in[20]; float* out; unsigned char* ws; int ph_lo, ph_hi; };
enum { I_X = 0, I_ATTN_NORM, I_W_IN, I_HGRN_LB, I_HGRN_NORM, I_MLSTM_CONV, I_MLSTM_BI, I_MLSTM_BF, I_MLSTM_NORM, I_FOX_BF, I_W_OUT, I_FFN_NORM, I_DGATE, I_DUP, I_DDOWN, I_ROUTER, I_MGATE, I_MUP, I_MDOWN, I_FINAL_NORM };

__device__ __forceinline__ void tr_item(const float* W, int ldw, int K, bf16_t* WT, LAS float* scr, int k0, int lane) {
#pragma unroll 32
    for (int i = 0; i < 32; ++i) { const int kk = 2 * i + (lane >> 5); scr[kk * 33 + (lane & 31)] = W[(size_t)(k0 + kk) * ldw + (lane & 31)]; }
    LDS_WAIT(); asm volatile("" ::: "memory");
    const int c = lane & 7;
#pragma unroll
    for (int j = 0; j < 4; ++j) { const int n = (lane >> 3) + 8 * j; const LAS float* s = scr + (8 * c) * 33 + n;
        v4u o; o.x = pk2(s[0 * 33], s[1 * 33]); o.y = pk2(s[2 * 33], s[3 * 33]); o.z = pk2(s[4 * 33], s[5 * 33]); o.w = pk2(s[6 * 33], s[7 * 33]);
        *(GAS v4u*)(WT + (size_t)n * K + k0 + 8 * c) = o; }
    LDS_WAIT(); asm volatile("" ::: "memory");
}
__device__ __forceinline__ int glu_row(int c, int up) { return (c >> 7) * 256 + (c & 127) + up * 128; }
constexpr int MOE_GU_ITEMS = 28672, MOE_ITEMS = 43008, MOE_FILL = 4, MOE_FILL_ITEMS = 128 * NWAVES * MOE_FILL;
__device__ __forceinline__ int moe_prefilled(int G) { return G == 256 ? 3 * MOE_FILL_ITEMS : 0; }
struct F8Item { const float* W; unsigned char* dst; int ldw, K; float sc; };
__device__ __forceinline__ F8Item moe_item(const MArgs& a, unsigned char* ws, int it) {
    const bool gu = it < MOE_GU_ITEMS; const int r0 = gu ? it : it - MOE_GU_ITEMS;
    const int e = gu ? r0 / 3584 : r0 / 1792; int r = gu ? r0 % 3584 : r0 % 1792; const int up = gu ? r / 1792 : 0; if (gu) r %= 1792;
    const int kb = gu ? r / 112 : r / 32, nb = gu ? r % 112 : r % 32, c = 32 * nb, k0 = 64 * kb;
    F8Item I; I.ldw = gu ? FE : D; I.K = gu ? D : FE; I.sc = gu ? pg8::F8_GSCALE : pg8::F8_WSCALE;
    I.W = (gu ? (up ? a.in[I_MUP] : a.in[I_MGATE]) + (size_t)e * D * FE : a.in[I_MDOWN] + (size_t)e * FE * D) + c + (size_t)k0 * I.ldw;
    I.dst = (gu ? (unsigned char*)(ws + WS_WMGU) + (size_t)e * 2 * FE * D + (size_t)glu_row(c, up) * D : (unsigned char*)(ws + WS_WMDN) + (size_t)e * D * FE + (size_t)c * FE) + k0;
    return I;
}
__device__ __forceinline__ void f8_load(float (&v)[32], const F8Item& I, int lane) {
    const float* p = I.W + (size_t)(lane >> 5) * I.ldw + (lane & 31);
#pragma unroll
    for (int i = 0; i < 32; ++i) v[i] = p[(size_t)(2 * i) * I.ldw];
}
__device__ __forceinline__ void f8_stage(const float (&v)[32], LAS float* scr, int lane) {
#pragma unroll
    for (int i = 0; i < 32; ++i) scr[(2 * i + (lane >> 5)) * 33 + (lane & 31)] = v[i];
}
__device__ __forceinline__ void f8_out(const F8Item& I, LAS float* scr, int lane) {
    LDS_WAIT(); asm volatile("" ::: "memory");
    const int c = lane & 7;
#pragma unroll
    for (int j = 0; j < 4; ++j) { const int n = (lane >> 3) + 8 * j; const LAS float* s = scr + (8 * c) * 33 + n; float h[8];
#pragma unroll
        for (int i = 0; i < 8; ++i) h[i] = __builtin_fminf(__builtin_fmaxf(s[i * 33] * I.sc, -448.f), 448.f);
        unsigned w0 = 0u, w1 = 0u; w0 = __builtin_amdgcn_cvt_pk_fp8_f32(h[0], h[1], w0, false); w0 = __builtin_amdgcn_cvt_pk_fp8_f32(h[2], h[3], w0, true);
        w1 = __builtin_amdgcn_cvt_pk_fp8_f32(h[4], h[5], w1, false); w1 = __builtin_amdgcn_cvt_pk_fp8_f32(h[6], h[7], w1, true);
        typedef unsigned u32x2_ __attribute__((ext_vector_type(2))); *(GAS u32x2_*)(I.dst + (size_t)n * I.K + 8 * c) = (u32x2_){w0, w1}; }
    LDS_WAIT(); asm volatile("" ::: "memory");
}
__device__ __forceinline__ void moe_conv_range(const MArgs& a, unsigned char* ws, LAS float* scr, int first, int step, int end, int lane) {
    float v[32]; int it = first; F8Item cur;
    if (it < end) { cur = moe_item(a, ws, it); f8_load(v, cur, lane); }
#pragma unroll 1
    for (; it < end; it += step) {
        f8_stage(v, scr, lane);
        F8Item nxt = cur; const int nx = it + step;
        if (nx < end) { nxt = moe_item(a, ws, nx); f8_load(v, nxt, lane); }
        f8_out(cur, scr, lane); cur = nxt;
    }
}
constexpr int MOE_FILL17 = 3;
__device__ __forceinline__ int moe_tail_idle(const int* cnt, int G) { int acc = 0;
#pragma unroll
    for (int e = 0; e < NE; ++e) acc += (cnt[e] + 255) >> 8;
    const int r = (acc * (2 * FE / 256)) % 256; return (G == 256 && r) ? 256 - r : 0; }
__device__ __forceinline__ void moe_fill(const MArgs& a, unsigned char* ws, LAS float* scr, int slot, int G, int bx, int wave, int lane) {
    if (G != 256 || bx < 128) return;
    const int first = slot * MOE_FILL_ITEMS + (bx - 128) * NWAVES + wave;
    moe_conv_range(a, ws, scr, first, 128 * NWAVES, first + MOE_FILL * 128 * NWAVES, lane);
}
struct RowIn { float4 v[4]; };
template <bool BF> __device__ __forceinline__ void mrow_load(RowIn& R, const void* src, int row, int lane) {
    if (BF) { const uint2* xr = (const uint2*)((const bf16_t*)src + (size_t)row * D) + lane;
#pragma unroll
        for (int j = 0; j < 4; ++j) { const uint2 w = xr[64 * j]; R.v[j] = make_float4(__uint_as_float(w.x << 16), __uint_as_float(w.x & 0xffff0000u), __uint_as_float(w.y << 16), __uint_as_float(w.y & 0xffff0000u)); } }
    else { const float4* xr = (const float4*)((const float*)src + (size_t)row * D) + lane;
#pragma unroll
        for (int j = 0; j < 4; ++j) R.v[j] = xr[64 * j]; } }
template <int MODE> __device__ __forceinline__ void mrow(const RowIn& R, signed char* H8, float* SH, const float* gain, const LAS float* tab, float* G, int row, int lane, float (&lg)[8]) {
    float4 v[4]; float ss = 0.f;
#pragma unroll
    for (int j = 0; j < 4; ++j) { v[j] = R.v[j]; ss += v[j].x * v[j].x + v[j].y * v[j].y + v[j].z * v[j].z + v[j].w * v[j].w; }
    ss = wave_sum(ss);
    const float r = rsqrtf(ss * (1.f / D) + EPS);
    float h[16];
#pragma unroll
    for (int j = 0; j < 4; ++j) { const float4 g = *((const float4*)gain + 64 * j + lane);
        h[4 * j + 0] = v[j].x * r * g.x; h[4 * j + 1] = v[j].y * r * g.y; h[4 * j + 2] = v[j].z * r * g.z; h[4 * j + 3] = v[j].w * r * g.w; }
    if (MODE == 2) {
#pragma unroll
      for (int j = 0; j < 4; ++j) { float q[4];
#pragma unroll
          for (int i = 0; i < 4; ++i) q[i] = __builtin_fminf(__builtin_fmaxf(h[4 * j + i] * pg8::F8_ASCALE, -448.f), 448.f);
          unsigned w = 0u; w = __builtin_amdgcn_cvt_pk_fp8_f32(q[0], q[1], w, false); w = __builtin_amdgcn_cvt_pk_fp8_f32(q[2], q[3], w, true);
          *((unsigned*)(H8 + (size_t)row * D) + 64 * j + lane) = w; }
    } else
    { float am = 0.f;
#pragma unroll
      for (int i = 0; i < 16; ++i) am = fmaxf(am, fabsf(h[i]));
      am = wave_max_nn(am);
      const float inv = am > 0.f ? 127.f / am : 0.f;
#pragma unroll
      for (int j = 0; j < 4; ++j) { const int q0 = (int)rintf(h[4 * j] * inv), q1 = (int)rintf(h[4 * j + 1] * inv), q2 = (int)rintf(h[4 * j + 2] * inv), q3 = (int)rintf(h[4 * j + 3] * inv);
          *((unsigned*)(H8 + (size_t)row * D) + 64 * j + lane) = (unsigned)(q0 & 255) | ((unsigned)(q1 & 255) << 8) | ((unsigned)(q2 & 255) << 16) | ((unsigned)(q3 & 255) << 24); }
      if (lane == 0) SH[row] = am > 0.f ? am * (1.f / 127.f) : 1.f; }
    if (MODE == 0) {
        float pa[16];
#pragma unroll
        for (int c = 0; c < 16; ++c) { float s = 0.f;
#pragma unroll
            for (int j = 0; j < 4; ++j) { const f32x4 w = *(const LAS f32x4*)(tab + c * 1024 + 256 * j + 4 * lane); s += h[4 * j] * w[0] + h[4 * j + 1] * w[1] + h[4 * j + 2] * w[2] + h[4 * j + 3] * w[3]; }
            pa[c] = s; }
#pragma unroll
        for (int c = 0; c < 8; ++c) { const bool up = (lane & 32) != 0; const float send = up ? pa[c] : pa[c + 8], keep = up ? pa[c + 8] : pa[c]; pa[c] = keep + __shfl_xor(send, 32); }
#pragma unroll
        for (int c = 0; c < 4; ++c) { const bool up = (lane & 16) != 0; const float send = up ? pa[c] : pa[c + 4], keep = up ? pa[c + 4] : pa[c]; pa[c] = keep + __shfl_xor(send, 16); }
#pragma unroll
        for (int c = 0; c < 2; ++c) { const bool up = (lane & 8) != 0; const float send = up ? pa[c] : pa[c + 2], keep = up ? pa[c + 2] : pa[c]; pa[c] = keep + __shfl_xor(send, 8); }
        { const bool up = (lane & 4) != 0; const float send = up ? pa[0] : pa[1], keep = up ? pa[1] : pa[0]; pa[0] = keep + __shfl_xor(send, 4); }
        pa[0] += __shfl_xor(pa[0], 2); pa[0] += __shfl_xor(pa[0], 1);
        if ((lane & 3) == 0) G[(size_t)row * GW + 8 * ((lane >> 5) & 1) + 4 * ((lane >> 4) & 1) + 2 * ((lane >> 3) & 1) + ((lane >> 2) & 1)] = pa[0];
    }
    if (MODE == 2) {
        float pa[8];
#pragma unroll
        for (int c = 0; c < 8; ++c) { float s = 0.f;
#pragma unroll
            for (int j = 0; j < 4; ++j) { const f32x4 w = *(const LAS f32x4*)(tab + c * 1024 + 256 * j + 4 * lane); s += h[4 * j] * w[0] + h[4 * j + 1] * w[1] + h[4 * j + 2] * w[2] + h[4 * j + 3] * w[3]; }
            pa[c] = s; }
#pragma unroll
        for (int c = 0; c < 4; ++c) { const bool up = (lane & 32) != 0; const float send = up ? pa[c] : pa[c + 4], keep = up ? pa[c + 4] : pa[c]; pa[c] = keep + __shfl_xor(send, 32); }
#pragma unroll
        for (int c = 0; c < 2; ++c) { const bool up = (lane & 16) != 0; const float send = up ? pa[c] : pa[c + 2], keep = up ? pa[c + 2] : pa[c]; pa[c] = keep + __shfl_xor(send, 16); }
        { const bool up = (lane & 8) != 0; const float send = up ? pa[0] : pa[1], keep = up ? pa[1] : pa[0]; pa[0] = keep + __shfl_xor(send, 8); }
        pa[0] += __shfl_xor(pa[0], 4); pa[0] += __shfl_xor(pa[0], 2); pa[0] += __shfl_xor(pa[0], 1);
        float v0 = -INFINITY, v1 = -INFINITY; int e0 = 0, e1 = 0;
#pragma unroll
        for (int c = 0; c < 8; ++c) { const float sv = __shfl(pa[0], 8 * c);
            if (sv > v0) { v1 = v0; e1 = e0; v0 = sv; e0 = c; } else if (sv > v1) { v1 = sv; e1 = c; } }
        lg[0] = v0; lg[1] = v1; lg[2] = __int_as_float(e0); lg[3] = __int_as_float(e1);
    }
}
__device__ __forceinline__ void load_gate_tab(LAS float* tab, const float* w_in, int tid) {
    for (int k = tid; k < D; k += NTHR) { const float4* w0 = (const float4*)(w_in + (size_t)k * DIN + 1792); const float4* w1 = (const float4*)(w_in + (size_t)k * DIN + 3592);
        const float4 a0 = w0[0], a1 = w0[1], b0 = w1[0], b1 = w1[1];
        tab[0 * 1024 + k] = a0.x; tab[1 * 1024 + k] = a0.y; tab[2 * 1024 + k] = a0.z; tab[3 * 1024 + k] = a0.w; tab[4 * 1024 + k] = a1.x; tab[5 * 1024 + k] = a1.y; tab[6 * 1024 + k] = a1.z; tab[7 * 1024 + k] = a1.w;
        tab[8 * 1024 + k] = b0.x; tab[9 * 1024 + k] = b0.y; tab[10 * 1024 + k] = b0.z; tab[11 * 1024 + k] = b0.w; tab[12 * 1024 + k] = b1.x; tab[13 * 1024 + k] = b1.y; tab[14 * 1024 + k] = b1.z; tab[15 * 1024 + k] = b1.w; }
}
__device__ __forceinline__ void load_router_tab(LAS float* tab, const float* router, int tid) {
    for (int k = tid; k < D; k += NTHR) { const float4* w0 = (const float4*)(router + (size_t)k * NE); const float4 a0 = w0[0], a1 = w0[1];
        tab[0 * 1024 + k] = a0.x; tab[1 * 1024 + k] = a0.y; tab[2 * 1024 + k] = a0.z; tab[3 * 1024 + k] = a0.w; tab[4 * 1024 + k] = a1.x; tab[5 * 1024 + k] = a1.y; tab[6 * 1024 + k] = a1.z; tab[7 * 1024 + k] = a1.w; }
}
struct Conv8Job { const float* W; int ldw; signed char* WT8; float* S; };
__device__ __forceinline__ void conv8_load(float (&v)[64], const Conv8Job& j, int tid, int wave) {
    const int lane = tid & 63, n = lane & 31, kp = lane >> 5;
#pragma unroll
    for (int i = 0; i < 64; ++i) v[i] = j.W[(size_t)(128 * wave + 2 * i + kp) * j.ldw + n];
}
__device__ __forceinline__ void conv8_stage(const float (&v)[64], LAS float* img, LAS float* pm, int tid, int wave) {
    const int lane = tid & 63, n = lane & 31, kp = lane >> 5; float m = 0.f;
#pragma unroll
    for (int i = 0; i < 64; ++i) { img[(128 * wave + 2 * i + kp) * 32 + n] = v[i]; m = fmaxf(m, fabsf(v[i])); }
    m = fmaxf(m, __shfl_xor(m, 32));
    if (lane < 32) pm[wave * 32 + lane] = m;
    __syncthreads();
}
__device__ __forceinline__ void conv8_quant(const Conv8Job& j, LAS float* img, LAS float* pm, int tid, int wave) {
    const int lane = tid & 63, no = lane >> 1, kh = 128 * wave + 64 * (lane & 1);
    float cm = 0.f;
#pragma unroll
    for (int w = 0; w < 8; ++w) cm = fmaxf(cm, pm[w * 32 + no]);
    const float inv = cm > 0.f ? 127.f / cm : 0.f;
    if (wave == 0 && (lane & 1) == 0) j.S[no] = cm > 0.f ? cm * (1.f / 127.f) : 1.f;
    const LAS float* sp = img + kh * 32 + no;
#pragma unroll
    for (int q = 0; q < 4; ++q) { unsigned wq[4];
#pragma unroll
        for (int jj = 0; jj < 4; ++jj) { const int kk = 16 * q + 4 * jj; const int q0 = (int)rintf(sp[kk * 32] * inv), q1 = (int)rintf(sp[(kk + 1) * 32] * inv), q2 = (int)rintf(sp[(kk + 2) * 32] * inv), q3 = (int)rintf(sp[(kk + 3) * 32] * inv);
            wq[jj] = (unsigned)(q0 & 255) | ((unsigned)(q1 & 255) << 8) | ((unsigned)(q2 & 255) << 16) | ((unsigned)(q3 & 255) << 24); }
        v4u o; o.x = wq[0]; o.y = wq[1]; o.z = wq[2]; o.w = wq[3];
        *(GAS v4u*)(j.WT8 + (size_t)no * 1024 + kh + 16 * q) = o; }
    __syncthreads();
}
namespace scan {
typedef short bf16x8 __attribute__((ext_vector_type(8)));
typedef float f32x4 __attribute__((ext_vector_type(4)));
typedef unsigned v2u __attribute__((ext_vector_type(2)));
constexpr int TS = 144, TB = 64 * TS;
constexpr int L_T0 = 0, L_T1 = TB, L_T2 = 2 * TB, L_T3 = 3 * TB, L_T4 = 4 * TB, L_T5 = 5 * TB, L_O = 6 * TB, OS = 68  , L_PART = L_O + 64 * OS * 4, L_VEC = L_PART + 8 * 64 * 4, L_END = L_VEC + 8 * 64 * 4;
static_assert(L_END <= RING_BYTES, "scan LDS");
constexpr size_t SC_LHG = 0, SC_LML = 16 * MiB, SC_DEC = 32 * MiB  , SC_NL = 32 * MiB + 256 * 1024  , SC_AMAX = 32 * MiB + 512 * 1024, SC_BEND = SC_AMAX + 4096, SC_MPREV = SC_BEND + 4096;

__device__ __forceinline__ float wave_incl_add(float v, int) {
    v += DPP_F(0.f, v, 0x111, 0xf); v += DPP_F(0.f, v, 0x112, 0xf); v += DPP_F(0.f, v, 0x114, 0xf); v += DPP_F(0.f, v, 0x118, 0xf);
    v += DPP_F(0.f, v, 0x142, 0xa); v += DPP_F(0.f, v, 0x143, 0xc);
    return v;
}
__device__ __forceinline__ float wave_incl_max(float v, int) {
    const float NI = -INFINITY;
    v = fmaxf(v, DPP_F(NI, v, 0x111, 0xf)); v = fmaxf(v, DPP_F(NI, v, 0x112, 0xf)); v = fmaxf(v, DPP_F(NI, v, 0x114, 0xf)); v = fmaxf(v, DPP_F(NI, v, 0x118, 0xf));
    v = fmaxf(v, DPP_F(NI, v, 0x142, 0xa)); v = fmaxf(v, DPP_F(NI, v, 0x143, 0xc));
    return v;
}
__device__ __forceinline__ float wave_max(float v) { return __int_as_float(__builtin_amdgcn_readlane(__float_as_int(wave_incl_max(v, 0)), 63)); }
__device__ __forceinline__ float lane_bcast(float v, int uniform_lane) { return __int_as_float(__builtin_amdgcn_readlane(__float_as_int(v), uniform_lane)); }
__device__ __forceinline__ f32x4 mma64(LAS const unsigned char* A, LAS const unsigned char* B, int m0, int n0, int lane, f32x4 acc) {
    const int r = lane & 15, kq = lane >> 4;
#pragma unroll
    for (int ks = 0; ks < 2; ++ks) {
        const bf16x8 a = *(LAS const bf16x8*)(A + (m0 + r) * TS + kq * 16 + ks * 64);
        const bf16x8 b = *(LAS const bf16x8*)(B + (n0 + r) * TS + kq * 16 + ks * 64);
        acc = __builtin_amdgcn_mfma_f32_16x16x32_bf16(a, b, acc, 0, 0, 0);
    }
    return acc;
}
__device__ __forceinline__ v4u pack8(const float (&v)[8]) { v4u w; w.x = pk2(v[0], v[1]); w.y = pk2(v[2], v[3]); w.z = pk2(v[4], v[5]); w.w = pk2(v[6], v[7]); return w; }
__device__ __forceinline__ v4u pack8h(const bf16_t (&v)[8]) { v4u w; w.x = v[0] | ((unsigned)v[1] << 16); w.y = v[2] | ((unsigned)v[3] << 16); w.z = v[4] | ((unsigned)v[5] << 16); w.w = v[6] | ((unsigned)v[7] << 16); return w; }
__device__ __forceinline__ void st16(LAS unsigned char* p, float v) { *(LAS bf16_t*)p = f2bf(v); }
__device__ __forceinline__ void load_state_tile(LAS unsigned char* T, const float* S, int tid) {
    const int v = tid >> 3, d0 = (tid & 7) * 8; const float4 x0 = *(const float4*)(S + v * 64 + d0), x1 = *(const float4*)(S + v * 64 + d0 + 4);
    v4u w; w.x = pk2(x0.x, x0.y); w.y = pk2(x0.z, x0.w); w.z = pk2(x1.x, x1.y); w.w = pk2(x1.z, x1.w);
    *(LAS v4u*)(T + v * TS + d0 * 2) = w;
}
typedef short s16x2 __attribute__((ext_vector_type(2)));
constexpr int IW = 4, TK = 64 / IW, CPT = 64 / IW, TPW = 16 / IW;
constexpr int HLDS = 6 * TB + 4096;
constexpr int H_O = L_T0, H_PART = 6 * TB, H_VEC = 6 * TB + 2048;
static_assert(2 * HLDS <= RING_BYTES && 64 * OS * 4 <= 2 * TB, "scan LDS (two halves)");
__device__ __forceinline__ void pack16w(LAS unsigned char* dst, const float (&v)[TK]) {
    v4u w0, w1; w0.x = pk2(v[0], v[1]); w0.y = pk2(v[2], v[3]); w0.z = pk2(v[4], v[5]); w0.w = pk2(v[6], v[7]); w1.x = pk2(v[8], v[9]); w1.y = pk2(v[10], v[11]); w1.z = pk2(v[12], v[13]); w1.w = pk2(v[14], v[15]);
    *(LAS v4u*)dst = w0; *(LAS v4u*)(dst + 16) = w1; }
__device__ __forceinline__ void pack16h(LAS unsigned char* dst, const s16x2 (&v)[TK / 2]) {
    v4u w0, w1; w0.x = __builtin_bit_cast(unsigned, v[0]); w0.y = __builtin_bit_cast(unsigned, v[1]); w0.z = __builtin_bit_cast(unsigned, v[2]); w0.w = __builtin_bit_cast(unsigned, v[3]);
    w1.x = __builtin_bit_cast(unsigned, v[4]); w1.y = __builtin_bit_cast(unsigned, v[5]); w1.z = __builtin_bit_cast(unsigned, v[6]); w1.w = __builtin_bit_cast(unsigned, v[7]);
    *(LAS v4u*)dst = w0; *(LAS v4u*)(dst + 16) = w1; }
__device__ __forceinline__ void local_state_mma_store(LAS unsigned char* Lh, float* LT, int tq, int lane) {
#pragma unroll
    for (int nn = 0; nn < TPW; ++nn) { const int ti = tq * TPW + nn, mt = ti >> 2, nt = ti & 3; f32x4 acc = {0.f, 0.f, 0.f, 0.f};
        acc = mma64(Lh + L_T1, Lh + L_T0, mt * 16, nt * 16, lane, acc);
#pragma unroll
        for (int r = 0; r < 4; ++r) LT[(mt * 16 + 4 * (lane >> 4) + r) * 64 + nt * 16 + (lane & 15)] = acc[r]; }
}
__device__ __forceinline__ float sigmoid_fast(float z) { return __builtin_amdgcn_rcpf(1.f + __builtin_amdgcn_exp2f(-1.4426950408889634f * z)); }
__device__ __forceinline__ float silu_fast(float z) { return z * sigmoid_fast(z); }
__device__ __forceinline__ void hgrn_gate(float lb, float z, float& sg, float& omsg, float& lf) {
    const float e = __builtin_amdgcn_exp2f(-1.4426950408889634f * fabsf(z)), ope = 1.f + e, r = __builtin_amdgcn_rcpf(ope), er = e * r; const bool pos = z >= 0.f;
    sg = pos ? r : er; omsg = pos ? er : r;
    lf = lb > 0.f ? __logf(lb + (1.f - lb) * sg) : (fminf(z, 0.f) - __logf(ope)); }
#define BFP(arr, i) bf2f((bf16_t)(arr)[(i) >> 1][(i) & 1])
struct HgIn { s16x2 fz[TK / 2], q[TK / 2], iv[TK / 2]; v4u gate[2]; float4 s[4]; };
template <bool DPH> __device__ __forceinline__ void hgrn_load(HgIn& R, const bf16_t* P, int b, int c, int h, const float* ST, int tl, int tq) {
    const int d = tl & 63, row0 = b * SEQ + c * 64; const bf16_t* pr = P + (size_t)(row0 + TK * tq) * PW + h * 64 + d;
#pragma unroll
    for (int i = 0; i < TK; ++i) { R.fz[i >> 1][i & 1] = (short)pr[(size_t)i * PW + P_HF]; R.iv[i >> 1][i & 1] = (short)pr[(size_t)i * PW + P_HI]; if (DPH) R.q[i >> 1][i & 1] = (short)pr[(size_t)i * PW + P_HQ]; }
    if (DPH) { const int t = tl / IW, v0 = (tl % IW) * CPT; const v4u* gp = (const v4u*)(P + (size_t)(row0 + t) * PW + P_HG + h * 64 + v0); R.gate[0] = gp[0]; R.gate[1] = gp[1];
#pragma unroll
        for (int j = 0; j < 4; ++j) R.s[j] = *(const float4*)(ST + t * 64 + v0 + 4 * j); }
}
struct MlIn { s16x2 qr[(TK + 4) / 2], kr[(TK + 4) / 2], vv[TK / 2]; float ig, fg, np, mprev; v4u gate[2]; float4 s[4]; };
template <bool DPH> __device__ __forceinline__ void mlstm_load(MlIn& R, const bf16_t* P, const float* G, int b, int c, int h, const float* CT, const float* NP, const float* MP, int tl, int tq) {
    const int d = tl & 63, lane = tl & 63, row0 = b * SEQ + c * 64; const bool fz3 = (c == 0 && tq == 0);
    const bf16_t* pk = P + (size_t)(row0 + TK * tq) * PW + P_MK + h * 64 + d; const bf16_t* pq = P + (size_t)(row0 + TK * tq) * PW + P_MQ + h * 64 + d;
#pragma unroll
    for (int j = 0; j < TK + 3; ++j) { R.kr[j >> 1][j & 1] = (j < 3 && fz3) ? (short)0 : (short)pk[((long)j - 3) * PW]; if (DPH) R.qr[j >> 1][j & 1] = (j < 3 && fz3) ? (short)0 : (short)pq[((long)j - 3) * PW]; }
#pragma unroll
    for (int i = 0; i < TK; ++i) R.vv[i >> 1][i & 1] = (short)P[(size_t)(row0 + TK * tq + i) * PW + P_MV + h * 64 + d];
    R.ig = G[(size_t)(row0 + lane) * GW + h]; R.fg = G[(size_t)(row0 + lane) * GW + 4 + h];
    if (DPH) { const int t = tl / IW, v0 = (tl % IW) * CPT; const v4u* gp = (const v4u*)(P + (size_t)(row0 + t) * PW + P_MO + h * 64 + v0); R.gate[0] = gp[0]; R.gate[1] = gp[1];
#pragma unroll
        for (int j = 0; j < 4; ++j) R.s[j] = *(const float4*)(CT + t * 64 + v0 + 4 * j);
        R.np = NP[lane]; R.mprev = MP[0]; }
}
__device__ __forceinline__ void store_state_tile(LAS unsigned char* T, const float4 (&x)[4], int tl) {
    const int v = tl / IW, d0 = (tl % IW) * CPT; v4u w0, w1; w0.x = pk2(x[0].x, x[0].y); w0.y = pk2(x[0].z, x[0].w); w0.z = pk2(x[1].x, x[1].y); w0.w = pk2(x[1].z, x[1].w);
    w1.x = pk2(x[2].x, x[2].y); w1.y = pk2(x[2].z, x[2].w); w1.z = pk2(x[3].x, x[3].y); w1.w = pk2(x[3].z, x[3].w);
    *(LAS v4u*)(T + v * TS + d0 * 2) = w0; *(LAS v4u*)(T + v * TS + d0 * 2 + 16) = w1;
}
__device__ __forceinline__ void conv_silu_r(const s16x2 (&raw)[(TK + 4) / 2], const float* w4  , float scale, float (&out)[TK]) {
    const float w0 = w4[0], w1 = w4[512], w2 = w4[1024], w3 = w4[1536];
#pragma unroll
    for (int i = 0; i < TK; ++i) out[i] = silu_fast(w0 * BFP(raw, i) + w1 * BFP(raw, i + 1) + w2 * BFP(raw, i + 2) + w3 * BFP(raw, i + 3)) * scale;
}
__device__ __forceinline__ void hgrn_b_item(LAS unsigned char* Lh, const HgIn& R, float lb, float* LT, float* DEC, int tl, int tq) {
    const int d = tl & 63;
    float bl[TK], kh[TK]; float run = 0.f;
#pragma unroll
    for (int i = 0; i < TK; ++i) { const float fz = BFP(R.fz, i);
        float sg, omsg, lf; hgrn_gate(lb, fz, sg, omsg, lf); kh[i] = (1.f - lb) * omsg; run += lf; bl[i] = run; }
    LAS float* part = (LAS float*)(Lh + H_PART);
    part[tq * 64 + d] = run; __syncthreads();
    float off = 0.f, btot = 0.f;
#pragma unroll
    for (int w = 0; w < IW; ++w) { const float pv = part[w * 64 + d]; btot += pv; if (w < tq) off += pv; }
#pragma unroll
    for (int i = 0; i < TK; ++i) kh[i] *= __expf(btot - (off + bl[i]));
    pack16w(Lh + L_T0 + d * TS + tq * (2 * TK), kh);
    pack16h(Lh + L_T1 + d * TS + tq * (2 * TK), R.iv);
    if (tq == 0) DEC[d] = __expf(btot);
    __syncthreads();
    local_state_mma_store(Lh, LT, tq, tl & 63);
    __syncthreads();
}
__device__ __forceinline__ void mlstm_gates(float ig, float fg, const float* b_i, const float* b_f, int h, int lane, float& bcum, float& a) {
    const float z = fg + b_f[h]; bcum = wave_incl_add(fminf(z, 0.f) - __logf(1.f + __builtin_amdgcn_exp2f(-1.4426950408889634f * fabsf(z))), lane); a = ig + b_i[h] - bcum;
}
__device__ __forceinline__ void mlstm_b_item(LAS unsigned char* Lh, const MlIn& R, const float* conv, const float* b_i, const float* b_f, int h, float* LT, float* NL, float* AMAX, float* BEND, int tl, int tq) {
    const int d = tl & 63, lane = tl & 63;
    float bcum, a; mlstm_gates(R.ig, R.fg, b_i, b_f, h, lane, bcum, a);
    const float A = wave_max(a), bend = lane_bcast(bcum, 63);
    float kh[TK]; conv_silu_r(R.kr, conv + 256 + h * 64 + d, 0.125f, kh);
    float nsum = 0.f;
#pragma unroll
    for (int i = 0; i < TK; ++i) { kh[i] *= __expf(lane_bcast(a, TK * tq + i) - A); nsum += bf2f(f2bf(kh[i])); }
    pack16w(Lh + L_T0 + d * TS + tq * (2 * TK), kh);
    pack16h(Lh + L_T1 + d * TS + tq * (2 * TK), R.vv);
    LAS float* part = (LAS float*)(Lh + H_PART); part[tq * 64 + d] = nsum;
    __syncthreads();
    if (tq == 0) { float s = 0.f;
#pragma unroll
        for (int w = 0; w < IW; ++w) s += part[w * 64 + d];
        NL[d] = s; if (lane == 0) { AMAX[0] = A; BEND[0] = bend; } }
    local_state_mma_store(Lh, LT, tq, lane);
    __syncthreads();
}
__device__ __forceinline__ void fox_cumsum_item(LAS unsigned char* L, const float* G, const float* fox_bf, float* CF, int bh, int tid, int wave) {
    const int b = bh >> 3, h = bh & 7, lane = tid & 63; const float bf = fox_bf[h];
    float loc[16]; float s = 0.f;
#pragma unroll
    for (int i = 0; i < 16; ++i) { s += log_sigmoidf_(G[((size_t)b * SEQ + tid * 16 + i) * GW + 8 + h] + bf); loc[i] = s; }
    const float incl = wave_incl_add(s, lane);
    LAS float* wt = (LAS float*)(L + L_PART);
    if (lane == 63) wt[wave] = incl;
    __syncthreads();
    float off = incl - s;
#pragma unroll
    for (int w = 0; w < 8; ++w) if (w < wave) off += wt[w];
#pragma unroll
    for (int i = 0; i < 16; ++i) CF[(size_t)bh * SEQ + tid * 16 + i] = (off + loc[i]) * LOG2E;
    __syncthreads();
}

template <bool DUMMY = false> __device__ __forceinline__ void scan_c_block(unsigned char* sc, int j, int tid) {
    constexpr size_t DOFF = DUMMY ? 104 * MiB / 4 : 0;
    constexpr int CB = 32;
    if (j < 128) {
        if (tid < 256) { const int chain = j >> 4, e = (j & 15) * 256 + tid, b = chain >> 2, h = chain & 3;
            float* p = (float*)(sc + SC_LHG) + ((size_t)(b * 128) * 4 + h) * 4096 + e; const float* dp = (const float*)(sc + SC_DEC) + ((size_t)(b * 128) * 4 + h) * 64 + (e & 63);
            float S = 0.f;
            for (int c0 = 0; c0 < 128; c0 += CB) { float Lc[CB], dc[CB];
#pragma unroll
                for (int i = 0; i < CB; ++i) { Lc[i] = p[(size_t)(c0 + i) * 4 * 4096]; dc[i] = dp[(size_t)(c0 + i) * 4 * 64]; }
#pragma unroll
                for (int i = 0; i < CB; ++i) { const float So = S; S = dc[i] * S + Lc[i]; Lc[i] = So; }
#pragma unroll
                for (int i = 0; i < CB; ++i) (p + DOFF)[(size_t)(c0 + i) * 4 * 4096] = Lc[i]; } }
    } else {
        const int jj = j - 128, chain = jj >> 4, part = jj & 15, b = chain >> 2, h = chain & 3;
        if (tid < 260) { const bool isn = tid >= 256; const size_t it0 = (size_t)(b * 128) * 4 + h;
            float* p = isn ? (float*)(sc + SC_NL) + it0 * 64 + part * 4 + (tid - 256) : (float*)(sc + SC_LML) + it0 * 4096 + part * 256 + tid;
            const size_t stride = isn ? 4 * 64 : 4 * 4096;
            const float* am = (const float*)(sc + SC_AMAX) + it0; const float* be = (const float*)(sc + SC_BEND) + it0; float* mp = (float*)(sc + SC_MPREV) + it0;
            const bool writer = (part == 0 && tid == 0);
            float S = 0.f, m = 0.f;
            for (int c0 = 0; c0 < 128; c0 += CB) { float Lc[CB], A[CB], bb[CB];
#pragma unroll
                for (int i = 0; i < CB; ++i) { Lc[i] = p[(size_t)(c0 + i) * stride]; A[i] = am[(c0 + i) * 4]; bb[i] = be[(c0 + i) * 4]; }
#pragma unroll
                for (int i = 0; i < CB; ++i) { const float Mx = fmaxf(m, A[i]), So = S; S = __expf(m - Mx) * S + __expf(A[i] - Mx) * Lc[i]; Lc[i] = So; A[i] = m; m = bb[i] + Mx; }
#pragma unroll
                for (int i = 0; i < CB; ++i) { (p + DOFF)[(size_t)(c0 + i) * stride] = Lc[i]; if (writer) (mp + DOFF)[(c0 + i) * 4] = A[i]; } } }
    }
}

template <bool SIG> __device__ __forceinline__ void head_epilogue(LAS unsigned char* Lh, float inv, const v4u (&gw)[2]  , const float* gain  , bf16_t* out  , int tl) {
    const int t = tl / IW, v0 = (tl % IW) * CPT; const LAS float* o = (const LAS float*)(Lh + H_O) + t * OS + v0;
    float x[CPT]; float ss = 0.f;
#pragma unroll
    for (int i = 0; i < CPT; ++i) { x[i] = o[i] * inv; ss += x[i] * x[i]; }
#pragma unroll
    for (int m = 1; m < IW; m <<= 1) ss += __shfl_xor(ss, m);
    const float r = rsqrtf(ss * (1.f / 64.f) + EPS);
    const unsigned gu[8] = {gw[0].x, gw[0].y, gw[0].z, gw[0].w, gw[1].x, gw[1].y, gw[1].z, gw[1].w};
    float y[CPT];
#pragma unroll
    for (int i = 0; i < CPT; ++i) { const float gz = bf2f((bf16_t)((gu[i >> 1] >> (16 * (i & 1))) & 0xffff)); y[i] = x[i] * r * gain[i] * (SIG ? sigmoid_fast(gz) : silu_fast(gz)); }
    v4u w0, w1; w0.x = pk2(y[0], y[1]); w0.y = pk2(y[2], y[3]); w0.z = pk2(y[4], y[5]); w0.w = pk2(y[6], y[7]); w1.x = pk2(y[8], y[9]); w1.y = pk2(y[10], y[11]); w1.z = pk2(y[12], y[13]); w1.w = pk2(y[14], y[15]);
    *(v4u*)out = w0; *((v4u*)out + 1) = w1;
}
__device__ __forceinline__ void store_o_tiles(LAS unsigned char* Lh, LAS const unsigned char* A1, LAS const unsigned char* B1, LAS const unsigned char* A2, LAS const unsigned char* B2, int tq, int lane) {
#pragma unroll
    for (int nn = 0; nn < TPW; ++nn) { const int ti = tq * TPW + nn, mt = ti >> 2, nt = ti & 3; f32x4 acc = {0.f, 0.f, 0.f, 0.f};
        acc = mma64(A1, B1, mt * 16, nt * 16, lane, acc); acc = mma64(A2, B2, mt * 16, nt * 16, lane, acc);
        LAS float* o = (LAS float*)(Lh + H_O);
#pragma unroll
        for (int r = 0; r < 4; ++r) o[(mt * 16 + 4 * (lane >> 4) + r) * OS + nt * 16 + (lane & 15)] = acc[r]; }
}
__device__ __forceinline__ void hgrn_d_item(LAS unsigned char* Lh, const HgIn& R, float lb, const float* gain  , bf16_t* out  , int tl, int tq) {
    const int d = tl & 63, lane = tl & 63;
    float bl[TK], kk[TK], q[TK]; float run = 0.f;
#pragma unroll
    for (int i = 0; i < TK; ++i) { const float fz = BFP(R.fz, i); q[i] = BFP(R.q, i);
        float sg, omsg, lf; hgrn_gate(lb, fz, sg, omsg, lf); kk[i] = (1.f - lb) * omsg; run += lf; bl[i] = run; }
    LAS float* part = (LAS float*)(Lh + H_PART);
    part[tq * 64 + d] = run;
    store_state_tile(Lh + L_T4, R.s, tl);
    pack16h(Lh + L_T3 + d * TS + tq * (2 * TK), R.iv);
    __syncthreads();
    float off = 0.f, bref = 0.f;
#pragma unroll
    for (int w = 0; w < IW; ++w) { const float pv = part[w * 64 + d]; if (w < IW / 2) bref += pv; if (w < tq) off += pv; }
#pragma unroll
    for (int i = 0; i < TK; ++i) { const float bb = off + bl[i]; const int t = TK * tq + i;
        st16(Lh + L_T0 + t * TS + d * 2, q[i] * __expf(bb - bref));
        st16(Lh + L_T1 + t * TS + d * 2, kk[i] * __expf(bref - bb));
        st16(Lh + L_T2 + t * TS + d * 2, q[i] * __expf(bb)); }
    __syncthreads();
#pragma unroll
    for (int nn = 0; nn < TPW; ++nn) { const int ti = tq * TPW + nn, mt = ti >> 2, nt = ti & 3; f32x4 acc = {0.f, 0.f, 0.f, 0.f};
        acc = mma64(Lh + L_T1, Lh + L_T0, mt * 16, nt * 16, lane, acc);
        const int s0 = mt * 16 + 4 * (lane >> 4), t = nt * 16 + (lane & 15);
        v2u w; w.x = pk2(s0 <= t ? acc[0] : 0.f, s0 + 1 <= t ? acc[1] : 0.f); w.y = pk2(s0 + 2 <= t ? acc[2] : 0.f, s0 + 3 <= t ? acc[3] : 0.f);
        *(LAS v2u*)(Lh + L_T5 + t * TS + s0 * 2) = w; }
    __syncthreads();
    store_o_tiles(Lh, Lh + L_T5, Lh + L_T3, Lh + L_T2, Lh + L_T4, tq, lane);
    __syncthreads();
    { const int t = tl / IW, v0 = (tl % IW) * CPT; head_epilogue<false>(Lh, 1.f, R.gate, gain + v0, out + (size_t)t * D + v0, tl); }
    __syncthreads();
}
__device__ __forceinline__ void mlstm_d_item(LAS unsigned char* Lh, const MlIn& R, const float* conv, const float* b_i, const float* b_f, const float* gain  , int h, bf16_t* out  , int tl, int tq) {
    const int d = tl & 63, lane = tl & 63; const float mprev = R.mprev;
    float bcum, a; mlstm_gates(R.ig, R.fg, b_i, b_f, h, lane, bcum, a);
    const float M = fmaxf(wave_incl_max(a, lane), mprev), sint = __expf(mprev - M);
    LAS float* vec = (LAS float*)(Lh + H_VEC);
    if (tq == 0) { vec[lane] = a; vec[64 + lane] = M; vec[128 + lane] = __expf(-bcum - M); vec[192 + lane] = R.np; }
    float qc[TK], kc[TK];
    conv_silu_r(R.qr, conv + h * 64 + d, 1.f, qc);
    conv_silu_r(R.kr, conv + 256 + h * 64 + d, 0.125f, kc);
#pragma unroll
    for (int i = 0; i < TK; ++i) { const int t = TK * tq + i;
        st16(Lh + L_T0 + t * TS + d * 2, qc[i]);
        st16(Lh + L_T1 + t * TS + d * 2, kc[i]);
        st16(Lh + L_T2 + t * TS + d * 2, qc[i] * lane_bcast(sint, t)); }
    pack16h(Lh + L_T3 + d * TS + tq * (2 * TK), R.vv);
    store_state_tile(Lh + L_T4, R.s, tl);
    __syncthreads();
#pragma unroll
    for (int nn = 0; nn < TPW; ++nn) { const int ti = tq * TPW + nn, mt = ti >> 2, nt = ti & 3; f32x4 acc = {0.f, 0.f, 0.f, 0.f};
        acc = mma64(Lh + L_T1, Lh + L_T0, mt * 16, nt * 16, lane, acc);
        const int s0 = mt * 16 + 4 * (lane >> 4), t = nt * 16 + (lane & 15); const float Mt = vec[64 + t];
        float wv[4];
#pragma unroll
        for (int r = 0; r < 4; ++r) wv[r] = (s0 + r <= t) ? acc[r] * __expf(vec[s0 + r] - Mt) : 0.f;
        v2u w; w.x = pk2(wv[0], wv[1]); w.y = pk2(wv[2], wv[3]); *(LAS v2u*)(Lh + L_T5 + t * TS + s0 * 2) = w; }
    __syncthreads();
    float inv;
    { const int t = tl / IW, c0 = (tl % IW) * CPT; float den = 0.f;
#pragma unroll
      for (int hh = 0; hh < 2; ++hh) { const v4u pw = *(LAS const v4u*)(Lh + L_T5 + t * TS + (c0 + 8 * hh) * 2), qw = *(LAS const v4u*)(Lh + L_T2 + t * TS + (c0 + 8 * hh) * 2);
          const unsigned pu[4] = {pw.x, pw.y, pw.z, pw.w}, qu[4] = {qw.x, qw.y, qw.z, qw.w};
#pragma unroll
          for (int i = 0; i < 8; ++i) den += bf2f((bf16_t)((pu[i >> 1] >> (16 * (i & 1))) & 0xffff)) + bf2f((bf16_t)((qu[i >> 1] >> (16 * (i & 1))) & 0xffff)) * vec[192 + c0 + 8 * hh + i]; }
#pragma unroll
      for (int m = 1; m < IW; m <<= 1) den += __shfl_xor(den, m);
      inv = __builtin_amdgcn_rcpf(fmaxf(fabsf(den), vec[128 + t])); }
    store_o_tiles(Lh, Lh + L_T5, Lh + L_T3, Lh + L_T2, Lh + L_T4, tq, lane);
    __syncthreads();
    { const int t = tl / IW, c0 = (tl % IW) * CPT; head_epilogue<true>(Lh, inv, R.gate, gain + c0, out + (size_t)t * D + c0, tl); }
    __syncthreads();
}
}
constexpr int N_PHASES = 21;
template <int PH, bool REP = false> __device__ __forceinline__ void run_phase(const MArgs& a, LAS unsigned char* L, const int tid, const int wave, const int G, const int bx, const int vcu) {
    const int lane = tid & 63, gw = vcu * NWAVES + wave, NGW = G * NWAVES;
    unsigned char* ws = a.ws; bf16_t* X = (bf16_t*)a.out;
    bf16_t* X2 = (bf16_t*)(ws + WS_X2); (void)X2;
    int* ctl = (int*)(ws + WS_CTL); int* cnt = ctl + CW_CNT;
    float* Gt = (float*)(ws + WS_G); float* CF = (float*)(ws + WS_CF); int4* tokinfo = (int4*)(ws + WS_TOKINFO); float2* tgate = (float2*)(ws + WS_TGATE); int* toklist = (int*)(ws + WS_TOKLIST);
    bf16_t* P = (bf16_t*)(ws + WS_P); bf16_t* HID = (bf16_t*)(ws + WS_HID); signed char* H = (signed char*)(ws + WS_H); float* SH = (float*)(ws + WS_SH); bf16_t* MIX = (bf16_t*)(ws + WS_MIX);
    signed char* XG = (signed char*)(ws + WS_XG); float* SXG = (float*)(ws + WS_SXG); bf16_t* Y = (bf16_t*)(ws + WS_XG);
    LAS float* scr = (LAS float*)(L + RING_OFF + wave * 16384);
    (void)ctl; (void)Gt; (void)CF; (void)tokinfo; (void)tgate; (void)toklist; (void)P; (void)HID; (void)H; (void)SH; (void)SXG; (void)MIX; (void)XG; (void)Y; (void)scr; (void)cnt; (void)lane; (void)gw; (void)NGW;
    constexpr int p = PH, l = p >= 10 ? 1 : 0, k = p == 0 ? -1 : (l ? p - 10 : p - 1);
    if constexpr (p == 0) {
            LAS float* img = (LAS float*)(L + RING_OFF); LAS float* pm = (LAS float*)(L + LDSCTL_OFF + 1024);
            { auto job = [&](int it) { Conv8Job j; int r = it;
                  if (r < 224) { const int ll = r / 112, nb = r % 112, sc = 32 * nb + (nb >= 56 ? 8 : 0);
                      j.W = a.in[I_W_IN] + (size_t)ll * D * DIN + sc; j.ldw = DIN; j.WT8 = (signed char*)(ws + WS_WIN) + (size_t)ll * PW * D + (size_t)32 * nb * D; j.S = (float*)(ws + WS_SWIN) + ll * PW + 32 * nb; }
                  else { r -= 224; const int up = r / 88, nb = r % 88, c = 32 * nb;
                      j.W = (up ? a.in[I_DUP] : a.in[I_DGATE]) + c; j.ldw = FF; j.WT8 = (signed char*)(ws + WS_WDGU) + (size_t)glu_row(c, up) * D; j.S = (float*)(ws + WS_SWDGU) + glu_row(c, up); }
                  return j; };
              float v[64]; int it = vcu; if (it < 400) conv8_load(v, job(it), tid, wave);
              for (; it < 400; it += G) { const Conv8Job j = job(it); conv8_stage(v, img, pm, tid, wave); if (it + G < 400) conv8_load(v, job(it + G), tid, wave); conv8_quant(j, img, pm, tid, wave); } }
            { LAS unsigned* slot = (LAS unsigned*)(L + LDSCTL_OFF); LAS float* tab = (LAS float*)(L + RING_OFF); bool tabbed = false;
              for (;;) {
                  __syncthreads();
                  if (tid == 0) *slot = __hip_atomic_fetch_add((unsigned*)ctl + CW_PQ + (REP ? 1 : 0), 1u, __ATOMIC_RELAXED, __HIP_MEMORY_SCOPE_AGENT);
                  __syncthreads();
                  const int t = __builtin_amdgcn_readfirstlane((int)*(volatile LAS unsigned*)slot);
                  if (t >= 560) break;
                  if (t < 304) { int r = 8 * t + wave;
                      if (r < 1024) { const int ll = r / 512; r %= 512; const int kb = r / 32, nb = r % 32;
                          tr_item(a.in[I_W_OUT] + (size_t)ll * D * D + 32 * nb, D, D, (bf16_t*)(ws + WS_WOUT) + (size_t)ll * D * D + (size_t)32 * nb * D, scr, 64 * kb, lane); }
                      else { r -= 1024; const int kb = r / 32, nb = r % 32; tr_item(a.in[I_DDOWN] + 32 * nb, D, FF, (bf16_t*)(ws + WS_WDDN) + (size_t)32 * nb * FF, scr, 64 * kb, lane); } }
                  else {
                      if (!tabbed) { __syncthreads(); load_gate_tab(tab, a.in[I_W_IN], tid); __syncthreads(); tabbed = true; }
                      float lg[8]; RowIn R, Rn; const int row0 = (t - 304) * 64 + wave * 8; mrow_load<false>(R, a.in[I_X], row0, lane);
#pragma unroll 1
                      for (int i = 0; i < 8; ++i) { if (i < 7) mrow_load<false>(Rn, a.in[I_X], row0 + i + 1, lane); asm volatile("" ::: "memory");
                          mrow<0>(R, H, SH, a.in[I_ATTN_NORM], tab, Gt, row0 + i, lane, lg); if (i < 7) R = Rn; } }
              } }
        } else if constexpr (k == 0) {
            { const int cb = (G >= 144) ? bx - 128 : bx; for (int bh = cb; bh >= 0 && bh < 16; bh += G) scan::fox_cumsum_item(L, Gt, a.in[I_FOX_BF] + l * 8, CF, bh, tid, wave); }
            pg8::GOrder S; S.so.init(NTOK, PW, G, bx); S.A = (const char*)H; S.B = (const char*)(ws + WS_WIN) + (size_t)l * PW * D; S.a_tile = (size_t)256 * D; S.b_tile = (size_t)256 * D; S.b_exp = 0;
            S.tb1 = S.tb2 = S.tb3 = S.tb4 = S.tb5 = S.tb6 = S.tb7 = 0x7fffffff;
            pg8::EpiBf8 E; E.O = P; E.ldc = PW; E.s_lo = P_FQ / 256; E.s_hi = P_FK / 256; E.scale = QSCALE; E.sA = SH; E.sB = (const float*)(ws + WS_SWIN) + l * PW; E.sc = (LAS float*)(L + LDSCTL_OFF + 4096);
            pg8::Gemm g{D / 2};
            pg8::gemm_phase<pg8::EpiBf8, pg8::GOrder, true, true, 1>(L + RING_OFF, g, S, E);
            if constexpr (!REP) moe_fill(a, ws, scr, l ? 2 : 0, G, bx, wave, lane);
        } else if constexpr (l == 1 && k == 9) {
            pg8::GOrderTail S; pg8::EpiBfPart E; int t[8]; int acc = 0;
#pragma unroll
            for (int e = 0; e < NE; ++e) { t[e] = acc; acc += (cnt[e] + 255) >> 8; }
            S.init(acc, D, G, bx); S.A = (const char*)HID; S.B = (const char*)(ws + WS_WMDN); S.a_tile = (size_t)256 * FE; S.b_tile = (size_t)256 * FE; S.b_exp = (size_t)D * FE;
            S.tb1 = t[1]; S.tb2 = t[2]; S.tb3 = t[3]; S.tb4 = t[4]; S.tb5 = t[5]; S.tb6 = t[6]; S.tb7 = t[7]; E.O = Y; E.ldc = D; E.scale = 1.f / (pg8::F8_HSCALE * pg8::F8_WSCALE);
            pg8::Gemm g{FE / 2};
            pg8::gemm_phase<pg8::EpiBfPart, pg8::GOrderTail, true, true, 2>(L + RING_OFF, g, S, E);
        } else if constexpr (k == 4 || (l == 0 && k == 7)) {
            pg8::GOrder S; S.so.init(NTOK, D, G, bx); S.b_exp = 0; S.tb1 = S.tb2 = S.tb3 = S.tb4 = S.tb5 = S.tb6 = S.tb7 = 0x7fffffff; int K;
            if constexpr (k == 4) { K = D; S.A = (const char*)MIX; S.B = (const char*)(ws + WS_WOUT) + (size_t)l * D * D * 2; }
            else { K = FF; S.A = (const char*)HID; S.B = (const char*)(ws + WS_WDDN); }
            S.a_tile = (size_t)256 * K * 2; S.b_tile = (size_t)256 * K * 2;
            pg8::Gemm g{K};
            if constexpr (k == 4 && l == 0) { pg8::EpiResid<true> E{a.in[I_X], X, D}; pg8::gemm_phase<pg8::EpiResid<true>, pg8::GOrder, true, true>(L + RING_OFF, g, S, E); }
            else { pg8::EpiResid<false> E{X, (k == 4 && l == 1) ? X2 : X, D}; pg8::gemm_phase<pg8::EpiResid<false>, pg8::GOrder, true, true>(L + RING_OFF, g, S, E); }
        } else if constexpr (l == 0 && k == 6) {
            pg8::GOrder S; pg8::EpiSwiglu8<false> E; S.a_tile = (size_t)256 * D; S.b_tile = (size_t)256 * D; E.O = HID; E.sc = (LAS float*)(L + LDSCTL_OFF + 4096);
            S.so.init(NTOK, 2 * FF, G, bx); S.A = (const char*)H; S.B = (const char*)(ws + WS_WDGU); S.b_exp = 0; S.tb1 = S.tb2 = S.tb3 = S.tb4 = S.tb5 = S.tb6 = S.tb7 = 0x7fffffff;
            E.ldc = FF; E.sA = SH; E.sB = (const float*)(ws + WS_SWDGU); E.sb_exp = 0;
            E.tb1 = S.tb1; E.tb2 = S.tb2; E.tb3 = S.tb3; E.tb4 = S.tb4; E.tb5 = S.tb5; E.tb6 = S.tb6; E.tb7 = S.tb7;
            pg8::Gemm g{D / 2};
            pg8::gemm_phase<pg8::EpiSwiglu8<false>, pg8::GOrder, true, true, 1>(L + RING_OFF, g, S, E);
            if constexpr (!REP) moe_fill(a, ws, scr, 1, G, bx, wave, lane);
        } else if constexpr (l == 1 && k == 7) {
            pg8::GOrder S; pg8::EpiSwigluF8 E; S.a_tile = (size_t)256 * D; S.b_tile = (size_t)256 * D; E.O = (unsigned char*)HID; E.ldc = FE;
            int t[8]; int acc = 0;
#pragma unroll
            for (int e = 0; e < NE; ++e) { t[e] = acc; acc += (cnt[e] + 255) >> 8; }
            S.so.init(acc * 256, 2 * FE, G, bx); S.A = (const char*)XG; S.B = (const char*)(ws + WS_WMGU); S.b_exp = (size_t)2 * FE * D;
            S.tb1 = t[1]; S.tb2 = t[2]; S.tb3 = t[3]; S.tb4 = t[4]; S.tb5 = t[5]; S.tb6 = t[6]; S.tb7 = t[7];
            pg8::Gemm g{D / 2};
#ifdef EXP_NULL_EPI
            if constexpr (REP) { pg8::EpiNull E0; E0.O = (unsigned char*)HID; E0.ldc = FE; pg8::gemm_phase<pg8::EpiNull, pg8::GOrder, true, true, 2>(L + RING_OFF, g, S, E0); } else
#endif
            pg8::gemm_phase<pg8::EpiSwigluF8, pg8::GOrder, true, true, 2>(L + RING_OFF, g, S, E);
            if constexpr (!REP) { const int ni = moe_tail_idle(cnt, G), ci = bx - (256 - ni);
                if (ni && ci >= 0) { const int first = MOE_ITEMS - ni * NWAVES * MOE_FILL17 + ci * NWAVES + wave; moe_conv_range(a, ws, scr, first, ni * NWAVES, MOE_ITEMS, lane); } }
        } else if constexpr (k == 5 && l == 0) {
            float lg[8];
            { RowIn R, Rn; int row = gw; if (row < NTOK) mrow_load<true>(R, X, row, lane);
              for (; row < NTOK; row += NGW) { const int nx = row + NGW; if (nx < NTOK) mrow_load<true>(Rn, X, nx, lane); asm volatile("" ::: "memory");
                  mrow<1>(R, H, SH, a.in[I_FFN_NORM], nullptr, nullptr, row, lane, lg); if (nx < NTOK) R = Rn; } }
        } else if constexpr (k == 8 && l == 0) {
            LAS float* tab = (LAS float*)(L + RING_OFF); load_gate_tab(tab, a.in[I_W_IN] + (size_t)D * DIN, tid); __syncthreads();
            float lg[8];
            { RowIn R, Rn; int row = gw; if (row < NTOK) mrow_load<true>(R, X, row, lane);
              for (; row < NTOK; row += NGW) { const int nx = row + NGW; if (nx < NTOK) mrow_load<true>(Rn, X, nx, lane); asm volatile("" ::: "memory");
                  mrow<0>(R, H, SH, a.in[I_ATTN_NORM] + D, tab, Gt, row, lane, lg); if (nx < NTOK) R = Rn; } }
        } else if constexpr (k == 5 && l == 1) {
            LAS int* sel_e = (LAS int*)(L + RING_OFF);
            LAS float* sel_g = (LAS float*)(L + RING_OFF + 512);
            LAS int* lcnt = (LAS int*)(L + RING_OFF + 1024);
            LAS float* tab = (LAS float*)(L + RING_OFF + 4096); load_router_tab(tab, a.in[I_ROUTER], tid); __syncthreads();
            for (int rb = bx; rb < NTOK / 64; rb += G) {
                if (tid < 16) lcnt[tid] = 0;
                RowIn R, Rn; mrow_load<true>(R, X2, rb * 64 + wave * 8, lane);
                for (int i = 0; i < 8; ++i) { const int rl = wave * 8 + i, row = rb * 64 + rl; float lg[8];
                    if (i < 7) mrow_load<true>(Rn, X2, row + 1, lane); asm volatile("" ::: "memory");
                    mrow<2>(R, H, SH, a.in[I_FFN_NORM] + D, tab, nullptr, row, lane, lg); if (i < 7) R = Rn;
                    if (lane == 0) { const float v0 = lg[0], v1 = lg[1]; const int e0 = __float_as_int(lg[2]), e1 = __float_as_int(lg[3]);
                        const float g1 = 1.f / (1.f + __expf(v0 - v1));
                        sel_e[2 * rl] = e0; sel_e[2 * rl + 1] = e1; sel_g[2 * rl] = 1.f - g1; sel_g[2 * rl + 1] = g1; } }
                __syncthreads();
                int e0 = 0, e1 = 0, r0 = 0, r1 = 0;
                if (tid < 64) { e0 = sel_e[2 * tid]; e1 = sel_e[2 * tid + 1]; r0 = __hip_atomic_fetch_add(lcnt + e0, 1, __ATOMIC_RELAXED, __HIP_MEMORY_SCOPE_WORKGROUP); r1 = __hip_atomic_fetch_add(lcnt + e1, 1, __ATOMIC_RELAXED, __HIP_MEMORY_SCOPE_WORKGROUP); }
                __syncthreads();
                if (tid < 8) lcnt[8 + tid] = atomicAdd(cnt + tid, (int)lcnt[tid]);
                __syncthreads();
                if (tid < 64) { const int row = rb * 64 + tid, s0 = lcnt[8 + e0] + r0, s1 = lcnt[8 + e1] + r1;
                    toklist[e0 * NTOK + s0] = row; toklist[e1 * NTOK + s1] = row; tokinfo[row] = make_int4(e0, s0, e1, s1); tgate[row] = make_float2(sel_g[2 * tid], sel_g[2 * tid + 1]); }
                __syncthreads();
            }
        } else if constexpr (k == 6 && l == 1) {
            { int base[NE]; int acc = 0;
#pragma unroll
              for (int e = 0; e < NE; ++e) { base[e] = acc; acc += (cnt[e] + 255) & ~255; }
              for (int r = gw; r < acc; r += NGW) { int e = 0, be = 0;
#pragma unroll
                  for (int c = 1; c < NE; ++c) if (r >= base[c]) { e = c; be = base[c]; }
                  const int s = r - be; v4u v0 = {0u, 0u, 0u, 0u}; float sv = 0.f;
                  if (s < cnt[e]) { const int tok = toklist[e * NTOK + s]; v0 = *((const v4u*)(H + (size_t)tok * D) + lane); sv = SH[tok]; }
                  *((v4u*)(XG + (size_t)r * D) + lane) = v0; if (lane == 0) SXG[r] = sv; } }
            moe_conv_range(a, ws, scr, moe_prefilled(G) + gw, NGW, MOE_ITEMS - moe_tail_idle(cnt, G) * NWAVES * MOE_FILL17, lane);
        } else if constexpr (k == 8 && l == 1) {
        } else if constexpr (l == 1 && k == 10) {
            int base[NE]; { int acc = 0;
#pragma unroll
              for (int e = 0; e < NE; ++e) { base[e] = acc; acc += (cnt[e] + 255) & ~255; } }
            constexpr int HALFR = NTOK; constexpr int rlo = 0;
            const bf16_t* Xs = X2;
            float* out = (float*)a.out;
            struct FA { uint2 v[4]; int4 ti; float2 tg; }; struct FB { uint2 y0[4], y1[4]; };
            auto loadA = [&](FA& A, int rr) { const uint2* xr = (const uint2*)(Xs + (size_t)rr * D) + lane;
#pragma unroll
                for (int j = 0; j < 4; ++j) A.v[j] = xr[64 * j];
                A.ti = tokinfo[rlo + rr]; A.tg = tgate[rlo + rr]; };
            auto ldrow = [&](uint2 (&y)[4], int r) {
                if ((r >> 8) < pg8::GOrderTail::MAIN_M) { const uint2* p = (const uint2*)(Y + (size_t)r * D) + lane;
#pragma unroll
                    for (int j = 0; j < 4; ++j) y[j] = p[64 * j]; }
                else { float s[16];
#pragma unroll
                    for (int i = 0; i < 16; ++i) s[i] = 0.f;
#pragma unroll 2
                    for (int kp = 0; kp < 8; ++kp) { const uint2* p = (const uint2*)(Y + (size_t)((pg8::EpiBfPart::YP_TILE0 + kp * 8 + (r >> 8) - pg8::GOrderTail::MAIN_M) * 256 + (r & 255)) * D) + lane;
#pragma unroll
                        for (int j = 0; j < 4; ++j) { const uint2 q = p[64 * j]; s[4 * j] += __uint_as_float(q.x << 16); s[4 * j + 1] += __uint_as_float(q.x & 0xffff0000u); s[4 * j + 2] += __uint_as_float(q.y << 16); s[4 * j + 3] += __uint_as_float(q.y & 0xffff0000u); } }
#pragma unroll
                    for (int j = 0; j < 4; ++j) { y[j].x = pk2(s[4 * j], s[4 * j + 1]); y[j].y = pk2(s[4 * j + 2], s[4 * j + 3]); } } };
            auto loadB = [&](FB& B, const FA& A) { int b0 = 0, b1 = 0;
#pragma unroll
                for (int c = 0; c < NE; ++c) { if (c == A.ti.x) b0 = base[c]; if (c == A.ti.z) b1 = base[c]; }
                ldrow(B.y0, b0 + A.ti.y); ldrow(B.y1, b1 + A.ti.w); };
            FA A0, A1, A2; FB B0, B1; int rr = gw;
            if (rr < HALFR) { loadA(A0, rr); if (rr + NGW < HALFR) loadA(A1, rr + NGW); loadB(B0, A0); }
            for (; rr < HALFR; rr += NGW) {
                const bool h1 = rr + NGW < HALFR, h2 = rr + 2 * NGW < HALFR;
                if (h2) loadA(A2, rr + 2 * NGW);
                if (h1) loadB(B1, A1);
                asm volatile("" ::: "memory");
                float4 v[4]; const float2 tg = A0.tg;
#pragma unroll
                for (int j = 0; j < 4; ++j) { const uint2 q = B0.y0[j], c = B0.y1[j], x = A0.v[j];
                    v[j].x = __uint_as_float(x.x << 16) + tg.x * bf2f((bf16_t)(q.x & 0xffff)) + tg.y * bf2f((bf16_t)(c.x & 0xffff)); v[j].y = __uint_as_float(x.x & 0xffff0000u) + tg.x * bf2f((bf16_t)(q.x >> 16)) + tg.y * bf2f((bf16_t)(c.x >> 16));
                    v[j].z = __uint_as_float(x.y << 16) + tg.x * bf2f((bf16_t)(q.y & 0xffff)) + tg.y * bf2f((bf16_t)(c.y & 0xffff)); v[j].w = __uint_as_float(x.y & 0xffff0000u) + tg.x * bf2f((bf16_t)(q.y >> 16)) + tg.y * bf2f((bf16_t)(c.y >> 16)); }
                float ss = 0.f;
#pragma unroll
                for (int j = 0; j < 4; ++j) ss += v[j].x * v[j].x + v[j].y * v[j].y + v[j].z * v[j].z + v[j].w * v[j].w;
                ss = wave_sum(ss); const float r = rsqrtf(ss * (1.f / D) + EPS);
                float4* xo = (float4*)(out + (size_t)(rlo + rr) * D) + lane;
#pragma unroll
                for (int j = 0; j < 4; ++j) { const float4 g = *((const float4*)a.in[I_FINAL_NORM] + 64 * j + lane); xo[64 * j] = make_float4(v[j].x * r * g.x, v[j].y * r * g.y, v[j].z * r * g.z, v[j].w * r * g.w); }
                if (h1) { A0 = A1; B0 = B1; } if (h2) A1 = A2;
            }
        } else {
            if constexpr (k == 1) {
                unsigned char* sc = ws + WS_SCAN; const int wv = wave;
#define ITEM_DECODE(it_) const int item = (it_) & 1023, h = item & 3, c = (item >> 2) & 127, b = item >> 9
#define HG_LB(h_) (l == 0 ? 0.f : 1.f / (1.f + __expf(a.in[I_HGRN_LB][(h_) * 64 + (tl & 63)] - a.in[I_HGRN_LB][256 + (h_) * 64 + (tl & 63)])))
                const int hf = wave >> 2, tq4 = wave & 3; LAS unsigned char* Lh = L + hf * scan::HLDS;
                { scan::HgIn R, Rn;
                  auto itemOf = [&](int pp) { const int it = bx + (2 * pp + hf) * G; return it < 1024 ? it : it - G; };
                  int pp = 0; if (bx < 1024) { ITEM_DECODE(itemOf(0)); scan::hgrn_load<false>(R, P, b, c, h, nullptr, tid & 255, tq4); }
                  for (; bx + 2 * pp * G < 1024; ++pp) { const bool nx = bx + 2 * (pp + 1) * G < 1024; int tl = tid & 255; asm volatile("" : "+v"(tl));
                      if (nx) { ITEM_DECODE(itemOf(pp + 1)); scan::hgrn_load<false>(Rn, P, b, c, h, nullptr, tl, tq4); }
                      asm volatile("" ::: "memory");
                      { ITEM_DECODE(itemOf(pp)); (void)b; (void)c; scan::hgrn_b_item(Lh, R, HG_LB(h), (float*)(sc + scan::SC_LHG) + (size_t)item * 4096, (float*)(sc + scan::SC_DEC) + item * 64, tl, tq4); }
                      if (nx) R = Rn; } }
                { scan::MlIn R, Rn; int base = bx; while (base < 1024) base += G;
                  auto itemOf = [&](int pp) { const int it = base + (2 * pp + hf) * G; return it < 2048 ? it : it - G; };
                  int pp = 0; if (base < 2048) { ITEM_DECODE(itemOf(0)); scan::mlstm_load<false>(R, P, Gt, b, c, h, nullptr, nullptr, nullptr, tid & 255, tq4); }
                  for (; base + 2 * pp * G < 2048; ++pp) { const bool nx = base + 2 * (pp + 1) * G < 2048; int tl = tid & 255; asm volatile("" : "+v"(tl));
                      if (nx) { ITEM_DECODE(itemOf(pp + 1)); scan::mlstm_load<false>(Rn, P, Gt, b, c, h, nullptr, nullptr, nullptr, tl, tq4); }
                      asm volatile("" ::: "memory");
                      { ITEM_DECODE(itemOf(pp)); (void)b; (void)c; scan::mlstm_b_item(Lh, R, a.in[I_MLSTM_CONV] + l * 2048, a.in[I_MLSTM_BI] + l * 4, a.in[I_MLSTM_BF] + l * 4, h, (float*)(sc + scan::SC_LML) + (size_t)item * 4096,
                                            (float*)(sc + scan::SC_NL) + item * 64, (float*)(sc + scan::SC_AMAX) + item, (float*)(sc + scan::SC_BEND) + item, tl, tq4); }
                      if (nx) R = Rn; } }
                { LAS unsigned* lst = (LAS unsigned*)(L + LDSCTL_OFF + 64);
                  if (tid < 32) lst[tid] = 0u; __syncthreads();
                  float mq0 = 0.f, mq1 = 0.f, mk0 = 0.f, mk1 = 0.f;
                  for (int row = gw; row < NTOK; row += NGW) {
                      const v4u wq = *((const v4u*)(P + (size_t)row * PW + P_FQ) + lane), wk = *((const v4u*)(P + (size_t)row * PW + P_FK) + lane);
                      float sq = 0.f, sk = 0.f;
#pragma unroll
                      for (int i = 0; i < 4; ++i) { const float q0 = bf2f((bf16_t)(wq[i] & 0xffff)), q1 = bf2f((bf16_t)(wq[i] >> 16)), k0 = bf2f((bf16_t)(wk[i] & 0xffff)), k1 = bf2f((bf16_t)(wk[i] >> 16));
                          sq += q0 * q0 + q1 * q1; sk += k0 * k0 + k1 * k1; }
                      sq += __shfl_xor(sq, 1); sq += __shfl_xor(sq, 2); sq += __shfl_xor(sq, 4); sk += __shfl_xor(sk, 1); sk += __shfl_xor(sk, 2); sk += __shfl_xor(sk, 4);
                      if (row < SEQ) { mq0 = fmaxf(mq0, sq); mk0 = fmaxf(mk0, sk); } else { mq1 = fmaxf(mq1, sq); mk1 = fmaxf(mk1, sk); } }
                  if ((lane & 7) == 0) { const int hh = lane >> 3;
                      __hip_atomic_fetch_max(lst + hh * 2, __float_as_uint(mq0), __ATOMIC_RELAXED, __HIP_MEMORY_SCOPE_WORKGROUP); __hip_atomic_fetch_max(lst + hh * 2 + 1, __float_as_uint(mk0), __ATOMIC_RELAXED, __HIP_MEMORY_SCOPE_WORKGROUP);
                      __hip_atomic_fetch_max(lst + 16 + hh * 2, __float_as_uint(mq1), __ATOMIC_RELAXED, __HIP_MEMORY_SCOPE_WORKGROUP); __hip_atomic_fetch_max(lst + 16 + hh * 2 + 1, __float_as_uint(mk1), __ATOMIC_RELAXED, __HIP_MEMORY_SCOPE_WORKGROUP); }
                  __syncthreads();
                  if (tid < 32) __hip_atomic_fetch_max((unsigned*)ctl + CW_STAT + l * 32 + tid, lst[tid], __ATOMIC_RELAXED, __HIP_MEMORY_SCOPE_AGENT); }
            } else if constexpr (k == 2) {
                for (int j = bx; j < 256; j += G) scan::scan_c_block<REP>(ws + WS_SCAN, j, tid);
            } else if constexpr (k == 3) {
                static_assert(attn_body::ATTN_LDS_BYTES <= RING_BYTES, "attention LDS");
                unsigned char* sc = ws + WS_SCAN; const int wv = wave;
                const float* stat = (const float*)(ctl + CW_STAT + l * 32);
                LAS unsigned* slot = (LAS unsigned*)(L + LDSCTL_OFF);
                unsigned* aq = (unsigned*)ctl + CW_AQ + (l + (REP ? 2 : 0)) * 8;
                { bool home_done = false; const unsigned home = xb_xcc_id() & 7u;
                for (;;) {
                    if (tid == 0) { unsigned q = home, t = 92u;
                        if (!home_done) { t = __hip_atomic_fetch_add(aq + q, 1u, __ATOMIC_RELAXED, __HIP_MEMORY_SCOPE_AGENT); if (t >= 92u) home_done = true; }
                        while (t >= 92u) { unsigned best = 92u, bq = 0u;
#pragma unroll
                            for (unsigned j = 0; j < 8; ++j) { const unsigned c = __hip_atomic_load(aq + j, __ATOMIC_RELAXED, __HIP_MEMORY_SCOPE_AGENT); if (c < best) { best = c; bq = j; } }
                            if (best >= 92u) break;
                            q = bq; t = __hip_atomic_fetch_add(aq + q, 1u, __ATOMIC_RELAXED, __HIP_MEMORY_SCOPE_AGENT); }
                        *slot = t < 92u ? q * 128u + t : 0xffffffffu; }
                    __syncthreads();
                    const unsigned vv = (unsigned)__builtin_amdgcn_readfirstlane((int)*(volatile LAS unsigned*)slot);
                    if (vv == 0xffffffffu) break;
                    const int xq = (int)(vv >> 7), ti = (int)(vv & 127u), j = ti >> 1, bh = (ti & 1) ? 15 - xq : xq;
                    int qb, part = 0; float* PART = nullptr;
                    if (j < 28) { qb = 31 - (j >> 1); part = j & 1; PART = (float*)(ws + WS_SCAN + (40 + 32 * l) * MiB) + (size_t)(bh * 14 + (qb - 18)) * 2 * attn_body::PART_F; }
                    else qb = 45 - j;
                    const float Tsk = 30.f + 2.f * __builtin_sqrtf(stat[bh * 2] * stat[bh * 2 + 1]) * 1.01f + 1.f;
                    attn_body::attn_unit<8>(bh >> 3, bh & 7, qb, (const attn_body::bf16*)(P + P_FQ), (const attn_body::bf16*)(P + P_FK), (const attn_body::bf16*)(P + P_FV), (attn_body::bf16*)(MIX + 512), CF + (size_t)bh * SEQ, Tsk,
                                            part, PART, (unsigned*)ctl + CW_AFLAG + (l + (REP ? 2 : 0)) * 512 + bh * 32 + qb, (char*)L + RING_OFF);
                    __syncthreads();
                } }
                int v;
                if (tid == 0) *slot = __hip_atomic_fetch_add((unsigned*)ctl + CW_QCTR + l + (REP ? 2 : 0), 1u, __ATOMIC_RELAXED, __HIP_MEMORY_SCOPE_AGENT);
                __syncthreads();
                v = __builtin_amdgcn_readfirstlane((int)*(volatile LAS unsigned*)slot) + 736;
                int tid2 = tid; asm volatile("" : "+v"(tid2));
                while (v < 736 + 384 + 256) {
                    const int it0 = v < 1120 ? (v - 736) * 4 : 1536 + (v - 1120) * 2, nj = v < 1120 ? 2 : 1;
                    const int hf = wv >> 2, tq4 = wv & 3; LAS unsigned char* Lh = L + hf * scan::HLDS;
#pragma unroll 1
                    for (int j = 0; j < nj; ++j) { const int it = it0 + 2 * j + hf; int tl = tid2 & 255; asm volatile("" : "+v"(tl)); ITEM_DECODE(it);
                        if (it0 < 1024) { scan::HgIn R; scan::hgrn_load<true>(R, P, b, c, h, (const float*)(sc + scan::SC_LHG) + (size_t)item * 4096, tl, tq4);
                            const float lb = l == 0 ? 0.f : 1.f / (1.f + __expf(a.in[I_HGRN_LB][h * 64 + (tl & 63)] - a.in[I_HGRN_LB][256 + h * 64 + (tl & 63)]));
                            scan::hgrn_d_item(Lh, R, lb, a.in[I_HGRN_NORM] + l * 256 + h * 64, MIX + (size_t)(b * SEQ + c * 64) * D + h * 64, tl, tq4); }
                        else { scan::MlIn R; scan::mlstm_load<true>(R, P, Gt, b, c, h, (const float*)(sc + scan::SC_LML) + (size_t)item * 4096, (const float*)(sc + scan::SC_NL) + item * 64, (const float*)(sc + scan::SC_MPREV) + item, tl, tq4);
                            scan::mlstm_d_item(Lh, R, a.in[I_MLSTM_CONV] + l * 2048, a.in[I_MLSTM_BI] + l * 4, a.in[I_MLSTM_BF] + l * 4, a.in[I_MLSTM_NORM] + l * 256 + h * 64, h, MIX + (size_t)(b * SEQ + c * 64) * D + 256 + h * 64, tl, tq4); } }
                    __syncthreads();
                    if (tid2 == 0) *slot = __hip_atomic_fetch_add((unsigned*)ctl + CW_QCTR + l + (REP ? 2 : 0), 1u, __ATOMIC_RELAXED, __HIP_MEMORY_SCOPE_AGENT);
                    __syncthreads();
                    v = __builtin_amdgcn_readfirstlane((int)*(volatile LAS unsigned*)slot) + 736;
                }
            }

        }
}
__global__ void __launch_bounds__(NTHR, 2) mega(MArgs a) {
    extern __shared__ __attribute__((aligned(16))) unsigned char lds[];
    LAS unsigned char* L = (LAS unsigned char*)lds;
    volatile LAS unsigned* MISC = (volatile LAS unsigned*)(L + MISC_OFF);
    const int tid = threadIdx.x, wave = __builtin_amdgcn_readfirstlane(tid >> 6);
    const int G = gridDim.x, bx = blockIdx.x, vcu = (G % 8 == 0) ? (bx % 8) * (G / 8) + bx / 8 : bx;
    for (int u = tid; u < (LDS_BYTES - LDSCTL_OFF) / 4; u += NTHR) ((LAS unsigned*)(L + LDSCTL_OFF))[u] = 0u;
    __syncthreads();
    const int lo = a.ph_lo, hi = a.ph_hi;
    XcdBarrier bar; bar.bar = (unsigned*)(a.ws + WS_CTL) + CW_BAR; bar.x = 0; bar.st = nullptr;
    if (hi - lo > 1) bar = xcd_barrier_post((unsigned*)(a.ws + WS_CTL) + CW_BAR, MISC + 8);
#ifndef REPEAT_MASK
#define REPEAT_MASK 0u
#endif
#define PHASE(k) if (lo <= (k) && (k) < hi) { run_phase<k>(a, L, tid, wave, G, bx, vcu); if constexpr ((REPEAT_MASK >> (k)) & 1u) { xcd_barrier(bar); run_phase<k, true>(a, L, tid, wave, G, bx, vcu); } if ((k) + 1 < hi) xcd_barrier(bar); }
    PHASE(0) PHASE(1) PHASE(2) PHASE(3) PHASE(4) PHASE(5) PHASE(6) PHASE(7) PHASE(8) PHASE(9) PHASE(10)
    PHASE(11) PHASE(12) PHASE(13) PHASE(14) PHASE(15) PHASE(16) PHASE(17) PHASE(19) PHASE(20)
#undef PHASE
}
#ifndef MEGA_MASK
#define MEGA_MASK 0x1FFFFFu
#endif
#ifndef FUSE_RUNS
#define FUSE_RUNS 1
#endif
extern "C" void kernel_launch(void* const* d_in, const int* in_sizes, int n_in, void* d_out, int out_size, void* d_ws, size_t ws_size, hipStream_t stream) {
    static int grid = 0;
    if (grid == 0) {
        if (n_in != 20 || ws_size < WS_END || out_size != NTOK * D) { fprintf(stderr, "kernel_launch: unexpected n_in %d / ws %zu / out %d\n", n_in, ws_size, out_size); grid = -1; return; }
        int dev = 0, cus = 0, per_cu = 0;
        if (hipGetDevice(&dev) != hipSuccess || hipDeviceGetAttribute(&cus, hipDeviceAttributeMultiprocessorCount, dev) != hipSuccess) { grid = -1; return; }
        if (hipFuncSetAttribute((const void*)mega, hipFuncAttributeMaxDynamicSharedMemorySize, LDS_BYTES) != hipSuccess) { fprintf(stderr, "kernel_launch: hipFuncSetAttribute failed\n"); grid = -1; return; }
        if (hipOccupancyMaxActiveBlocksPerMultiprocessor(&per_cu, (const void*)mega, NTHR, LDS_BYTES) != hipSuccess || per_cu < 1) { fprintf(stderr, "kernel_launch: occupancy query says %d\n", per_cu); per_cu = 1; }
        (void)hipGetLastError();
        grid = cus;
        if (grid > 256) grid = 256;
    }
    if (grid < 0) return;
    const float* const* in = (const float* const*)d_in;
    unsigned char* ws = (unsigned char*)d_ws; float* X = (float*)d_out;
    (void)hipMemsetAsync(ws + WS_CTL, 0, CTL_BYTES, stream);
    MArgs ma; memset(&ma, 0, sizeof ma);
    for (int i = 0; i < 20; ++i) ma.in[i] = in[i];
    ma.out = X; ma.ws = ws;
    ma.ph_lo = 0; ma.ph_hi = N_PHASES;
    hipLaunchKernelGGL(mega, dim3(grid), dim3(NTHR), LDS_BYTES, stream, ma);
}
```

```cpp
#include <hip/hip_runtime.h>
#include <hip/hip_bf16.h>
#include <cstdint>
#include <cstdio>
#include <cstring>

namespace cfg {
constexpr int NTOK = 16384, D = 1024, SEQ = 8192, NB = 2, DIN = 3600, PW = 3584, GW = 16;
constexpr int FF = 2816, FE = 3584, NE = 8, MAXROWS = 34816;
constexpr float EPS = 1e-6f;
constexpr float LOG2E = 1.4426950408889634f;
constexpr float QSCALE = 0.125f * LOG2E;
constexpr int P_HQ = 0, P_HF = 256, P_HI = 512, P_HG = 768, P_MQ = 1024, P_MK = 1280, P_MV = 1536, P_MO = 1792, P_FQ = 2048, P_FK = 2560, P_FV = 3072;
constexpr size_t MiB = 1u << 20;
constexpr size_t WS_CTL = 0, CTL_BYTES = 1 * MiB;
constexpr size_t WS_G = 2 * MiB;
constexpr size_t WS_CF = 3 * MiB;
constexpr size_t WS_TOKINFO = 3 * MiB + 512 * 1024;
constexpr size_t WS_TGATE = 3 * MiB + 768 * 1024;
constexpr size_t WS_TOKLIST = 4 * MiB;
constexpr size_t WS_P = 8 * MiB;
constexpr size_t WS_SCAN = 120 * MiB;
constexpr size_t WS_HID = 8 * MiB;
constexpr size_t WS_H = 246 * MiB;
constexpr size_t WS_MIX = 278 * MiB;
constexpr size_t WS_XG = 278 * MiB;
constexpr size_t WS_W = 346 * MiB;
constexpr size_t WS_Y = 346 * MiB;
constexpr size_t WS_X2 = 130 * MiB;
constexpr size_t WS_PB = 164 * MiB;
constexpr size_t WS_END = 466 * MiB;
constexpr int CW_CNT = 64;
constexpr int CW_STAT = 128;
constexpr int CW_QCTR = 256;
constexpr int CW_PQ = 262;
constexpr int CW_TFLAG = 384;
constexpr int CW_AFLAG = 512;
}
using namespace cfg;
typedef unsigned short bf16_t;

__device__ __forceinline__ bf16_t f2bf(float f) { unsigned u = __builtin_bit_cast(unsigned, f); return (bf16_t)((u + 0x7fffu + ((u >> 16) & 1u)) >> 16); }
__device__ __forceinline__ float bf2f(bf16_t h) { return __builtin_bit_cast(float, (unsigned)h << 16); }
#define DPP_F(old_, v_, ctrl_, rmask_) __int_as_float(__builtin_amdgcn_update_dpp(__float_as_int(old_), __float_as_int(v_), ctrl_, rmask_, 0xf, false))
__device__ __forceinline__ float wave_sum(float v) {
    v += DPP_F(0.f, v, 0xB1, 0xf); v += DPP_F(0.f, v, 0x4E, 0xf); v += DPP_F(0.f, v, 0x141, 0xf); v += DPP_F(0.f, v, 0x140, 0xf);
    v += DPP_F(0.f, v, 0x142, 0xa); v += DPP_F(0.f, v, 0x143, 0xc);
    return __int_as_float(__builtin_amdgcn_readlane(__float_as_int(v), 63));
}
__device__ __forceinline__ float wave_max_nn(float v) {
    v = fmaxf(v, DPP_F(0.f, v, 0xB1, 0xf)); v = fmaxf(v, DPP_F(0.f, v, 0x4E, 0xf)); v = fmaxf(v, DPP_F(0.f, v, 0x141, 0xf)); v = fmaxf(v, DPP_F(0.f, v, 0x140, 0xf));
    v = fmaxf(v, DPP_F(0.f, v, 0x142, 0xa)); v = fmaxf(v, DPP_F(0.f, v, 0x143, 0xc));
    return __int_as_float(__builtin_amdgcn_readlane(__float_as_int(v), 63));
}
__device__ __forceinline__ float sigmoidf_(float z) { return 1.f / (1.f + __expf(-z)); }
__device__ __forceinline__ float siluf_(float z) { return z / (1.f + __expf(-z)); }
__device__ __forceinline__ float log_sigmoidf_(float z) { return fminf(z, 0.f) - log1pf(__expf(-fabsf(z))); }

__device__ __forceinline__ int moe_bases(const int* cnt, int* base) {
    int acc = 0;
#pragma unroll
    for (int e = 0; e < NE; ++e) { base[e] = acc; acc += (cnt[e] + 255) & ~255; }
    return acc;
}

namespace pg8 {
#define PG8_LAS __attribute__((address_space(3)))
typedef unsigned short bf16_t;
typedef short bf16x8 __attribute__((ext_vector_type(8)));
typedef float f32x4 __attribute__((ext_vector_type(4)));
typedef unsigned u32x4 __attribute__((ext_vector_type(4)));
constexpr int BM = 256, BK = 64, HALF = 128, HTB = HALF * BK * 2  , STAGE_BYTES = 8 * HTB, NXCD = 8, WGM = 8;

__host__ __device__ __forceinline__ int lds_byte(int r, int c) { const int st = (r >> 4) * 2 + (c >> 5), rr = r & 15, cc = c & 31, ob = rr * 64 + cc * 2; return st * 1024 + (ob ^ (((ob >> 9) & 1) << 5)); }
__host__ __device__ __forceinline__ void stage_rc(int b, int& R, int& C) { const int st = b / 1024, sb = b % 1024, swz = sb ^ (((sb >> 9) & 1) << 5); R = (st >> 1) * 16 + swz / 64; C = (st & 1) * 32 + (swz % 64) / 2; }
__host__ __device__ __forceinline__ int perm32(int rho) { const int n = rho >> 4, i = rho & 15; return 8 * (i >> 2) + 4 * n + (i & 3); }

struct Unit { int pm, pn, tq; };
struct Gemm { int K; };

struct StaticOrder {
    int nM, nN, nwg, G, c;
    __host__ __device__ void init(int M, int N, int G_, int c_) { nM = M / BM; nN = N / BM; nwg = nM * nN; G = G_; c = c_; }
    __host__ __device__ bool next(int i, Unit& u) const {
        const long L = (long)i * G + c; if (L >= nwg) return false;
        int wgid = (int)L; { const int q = nwg / NXCD, r = nwg % NXCD, xcd = wgid % NXCD, off = wgid / NXCD; wgid = (xcd < r ? xcd * (q + 1) : r * (q + 1) + (xcd - r) * q) + off; }
        const int nig = WGM * nN, gid = wgid / nig, fm = gid * WGM, gsz = (nM - fm) < WGM ? (nM - fm) : WGM;
        u.pm = fm + ((wgid % nig) % gsz); u.pn = (wgid % nig) / gsz; return true;
    }
    __device__ __forceinline__ void a_ready(const Unit&) const {}
    __device__ __forceinline__ void done(const Unit&) const {}
};

__device__ __forceinline__ unsigned cvt_pk_bf16(float lo, float hi) { unsigned r; asm volatile("v_cvt_pk_bf16_f32 %0, %1, %2" : "=v"(r) : "v"(lo), "v"(hi)); return r; }
typedef int i32x4 __attribute__((ext_vector_type(4)));
constexpr float F8_HSCALE = 4.f, F8_WSCALE = 64.f, F8_ASCALE = 16.f, F8_GSCALE = 32.f;
template <bool I8> struct AccT { typedef f32x4 type; };
template <> struct AccT<true> { typedef i32x4 type; };
__device__ __forceinline__ f32x4 mma_sel(bf16x8 b, bf16x8 a, f32x4 c) { return __builtin_amdgcn_mfma_f32_16x16x32_bf16(b, a, c, 0, 0, 0); }
__device__ __forceinline__ i32x4 mma_sel(bf16x8 b, bf16x8 a, i32x4 c) { return __builtin_amdgcn_mfma_i32_16x16x64_i8(__builtin_bit_cast(i32x4, b), __builtin_bit_cast(i32x4, a), c, 0, 0, 0); }
typedef int i32x8 __attribute__((ext_vector_type(8)));
struct Frag2 { bf16x8 k[2]; };
template <int MODE> struct Frag { typedef Frag2 type; };
template <> struct Frag<2> { typedef i32x8 type; };
template <int MODE> __device__ __forceinline__ typename Frag<MODE>::type ldfrag(PG8_LAS const unsigned char* p) {
    if constexpr (MODE == 2) { const i32x4 lo = *(const PG8_LAS i32x4*)p, hi = *(const PG8_LAS i32x4*)(p + 1024); return (i32x8){lo[0], lo[1], lo[2], lo[3], hi[0], hi[1], hi[2], hi[3]}; }
    else { Frag2 f; f.k[0] = *(const PG8_LAS bf16x8*)p; f.k[1] = *(const PG8_LAS bf16x8*)(p + 1024); return f; }
}
__device__ __forceinline__ void mma_step_(f32x4& acc, const Frag2& b, const Frag2& a) { acc = mma_sel(b.k[0], a.k[0], acc); acc = mma_sel(b.k[1], a.k[1], acc); }
__device__ __forceinline__ void mma_step_(i32x4& acc, const Frag2& b, const Frag2& a) { acc = mma_sel(b.k[0], a.k[0], acc); acc = mma_sel(b.k[1], a.k[1], acc); }
__device__ __forceinline__ void mma_step_(f32x4& acc, const i32x8& b, const i32x8& a) {
#if defined(__HIP_DEVICE_COMPILE__)
    const int scl = 0x7f7f7f7f;
    asm volatile("v_mfma_scale_f32_16x16x128_f8f6f4 %0, %1, %2, %0, %3, %3 op_sel_hi:[0,0,0]" : "+v"(acc) : "v"(b), "v"(a), "v"(scl));
#endif
}
template <int MODE, class ACC, class F> __device__ __forceinline__ void mma_step(ACC& acc, const F& b, const F& a) { mma_step_(acc, b, a); }
struct EpiBf {
    static constexpr bool PERM = true, AFTER_DRAIN = false;
    bf16_t* O; int ldc; int s_lo, s_hi; float scale;
    struct Pre {}; __device__ __forceinline__ void prefetch(Pre&, const Unit&, int, int, int, int, int) const {} __device__ __forceinline__ void commit(const Pre&, int, int, int, int, int) const {}
    __device__ __forceinline__ void operator()(const f32x4 (&acc)[2][2][4][2], const Unit& u, int wr, int wc, int fr_, int fq_, const Pre&, int) const {
        int fr = fr_, fq = fq_; asm volatile("" : "+v"(fr), "+v"(fq));
        const int row0 = u.pm * BM + wr * 64 + fr, col0 = u.pn * BM + wc * 32 + 8 * fq;
        const float sc = (u.pn >= s_lo && u.pn < s_hi) ? scale : 1.f;
#pragma unroll
        for (int ai = 0; ai < 2; ++ai)
#pragma unroll
            for (int m = 0; m < 4; ++m) { bf16_t* rowp = O + (size_t)(row0 + ai * HALF + m * 16) * ldc + col0;
#pragma unroll
                for (int bj = 0; bj < 2; ++bj) { const f32x4 v0 = acc[ai][bj][m][0] * sc, v1 = acc[ai][bj][m][1] * sc;
                    u32x4 w; w.x = cvt_pk_bf16(v0[0], v0[1]); w.y = cvt_pk_bf16(v0[2], v0[3]); w.z = cvt_pk_bf16(v1[0], v1[1]); w.w = cvt_pk_bf16(v1[2], v1[3]);
                    *(u32x4*)(rowp + bj * HALF) = w; } }
    }
};
__device__ __forceinline__ float silu_mul(float g, float u) { return g * __builtin_amdgcn_rcpf(1.f + __expf(-g)) * u; }
__device__ __forceinline__ float silu2_mul(float g2, float u2) { return g2 * __builtin_amdgcn_rcpf(1.f + __builtin_amdgcn_exp2f(-g2)) * u2; }
struct EpiSwiglu {
    static constexpr bool PERM = true, AFTER_DRAIN = false;
    bf16_t* O; int ldc;
    struct Pre {}; __device__ __forceinline__ void prefetch(Pre&, const Unit&, int, int, int, int, int) const {} __device__ __forceinline__ void commit(const Pre&, int, int, int, int, int) const {}
    __device__ __forceinline__ void operator()(const f32x4 (&acc)[2][2][4][2], const Unit& u, int wr, int wc, int fr, int fq, const Pre&, int) const {
        const int row0 = u.pm * BM + wr * 64 + fr, col0 = u.pn * HALF + wc * 32 + 8 * fq;
#pragma unroll
        for (int ai = 0; ai < 2; ++ai)
#pragma unroll
            for (int m = 0; m < 4; ++m) { bf16_t* rowp = O + (size_t)(row0 + ai * HALF + m * 16) * ldc + col0;
                const f32x4 g0 = acc[ai][0][m][0], g1 = acc[ai][0][m][1], u0 = acc[ai][1][m][0], u1 = acc[ai][1][m][1];
                u32x4 w; w.x = cvt_pk_bf16(silu_mul(g0[0], u0[0]), silu_mul(g0[1], u0[1])); w.y = cvt_pk_bf16(silu_mul(g0[2], u0[2]), silu_mul(g0[3], u0[3]));
                w.z = cvt_pk_bf16(silu_mul(g1[0], u1[0]), silu_mul(g1[1], u1[1])); w.w = cvt_pk_bf16(silu_mul(g1[2], u1[2]), silu_mul(g1[3], u1[3]));
                *(u32x4*)rowp = w; }
    }
};
struct EpiSwigluF8 {
    static constexpr bool PERM = true, AFTER_DRAIN = false;
    unsigned char* O; int ldc;
    struct Pre {}; __device__ __forceinline__ void prefetch(Pre&, const Unit&, int, int, int, int, int) const {} __device__ __forceinline__ void commit(const Pre&, int, int, int, int, int) const {}
    __device__ __forceinline__ void operator()(const f32x4 (&acc)[2][2][4][2], const Unit& u, int wr, int wc, int fr, int fq, const Pre&, int) const {
        const int row0 = u.pm * BM + wr * 64 + fr, col0 = u.pn * HALF + wc * 32 + 8 * fq;
        constexpr float CG = 1.4426950408889634f / (F8_ASCALE * F8_GSCALE), CU = F8_HSCALE * 0.6931471805599453f / (F8_ASCALE * F8_GSCALE);
#pragma unroll
        for (int ai = 0; ai < 2; ++ai)
#pragma unroll
            for (int m = 0; m < 4; ++m) { const int row = row0 + ai * HALF + m * 16;
                const f32x4 g0 = acc[ai][0][m][0] * CG, g1 = acc[ai][0][m][1] * CG, u0 = acc[ai][1][m][0] * CU, u1 = acc[ai][1][m][1] * CU;
                float h[8];
#pragma unroll
                for (int i = 0; i < 4; ++i) { h[i] = __builtin_fminf(__builtin_fmaxf(silu2_mul(g0[i], u0[i]), -448.f), 448.f); h[4 + i] = __builtin_fminf(__builtin_fmaxf(silu2_mul(g1[i], u1[i]), -448.f), 448.f); }
                unsigned w0 = 0u, w1 = 0u; w0 = __builtin_amdgcn_cvt_pk_fp8_f32(h[0], h[1], w0, false); w0 = __builtin_amdgcn_cvt_pk_fp8_f32(h[2], h[3], w0, true);
                w1 = __builtin_amdgcn_cvt_pk_fp8_f32(h[4], h[5], w1, false); w1 = __builtin_amdgcn_cvt_pk_fp8_f32(h[6], h[7], w1, true);
                typedef unsigned u32x2 __attribute__((ext_vector_type(2))); *(u32x2*)(O + (size_t)row * ldc + col0) = (u32x2){w0, w1}; }
    }
};
struct EpiNull {
    static constexpr bool PERM = true, AFTER_DRAIN = false;
    unsigned char* O; int ldc;
    struct Pre {}; __device__ __forceinline__ void prefetch(Pre&, const Unit&, int, int, int, int, int) const {} __device__ __forceinline__ void commit(const Pre&, int, int, int, int, int) const {}
    __device__ __forceinline__ void operator()(const f32x4 (&acc)[2][2][4][2], const Unit& u, int wr, int wc, int fr, int fq, const Pre&, int) const {
        f32x4 s = (f32x4){0.f, 0.f, 0.f, 0.f};
#pragma unroll
        for (int ai = 0; ai < 2; ++ai)
#pragma unroll
            for (int bj = 0; bj < 2; ++bj)
#pragma unroll
                for (int m = 0; m < 4; ++m)
#pragma unroll
                    for (int n = 0; n < 2; ++n) s += acc[ai][bj][m][n];
        if (s[0] + s[1] + s[2] + s[3] == 12345.678f) O[(size_t)(u.pm * BM + wr * 64 + fr) * ldc + u.pn * HALF + wc * 32 + 8 * fq] = 1;
    }
};
template <bool IN_F32> struct EpiResid {
    static constexpr bool PERM = true, AFTER_DRAIN = false;
    const void* Xin; bf16_t* X; int ldc;
    struct Pre {}; __device__ __forceinline__ void prefetch(Pre&, const Unit&, int, int, int, int, int) const {} __device__ __forceinline__ void commit(const Pre&, int, int, int, int, int) const {}
    __device__ __forceinline__ void operator()(const f32x4 (&acc)[2][2][4][2], const Unit& u, int wr, int wc, int fr, int fq, const Pre&, int) const {
        const int row0 = u.pm * BM + wr * 64 + fr, col0 = u.pn * BM + wc * 32 + 8 * fq;
#pragma unroll
        for (int ai = 0; ai < 2; ++ai)
#pragma unroll
            for (int m = 0; m < 4; ++m) { const size_t ro = (size_t)(row0 + ai * HALF + m * 16) * ldc + col0;
#pragma unroll
                for (int bj = 0; bj < 2; ++bj) { f32x4 x0, x1;
                    if (IN_F32) { const float* p = (const float*)Xin + ro + bj * HALF; x0 = *(const f32x4*)p; x1 = *(const f32x4*)(p + 4); }
                    else { const u32x4 w = *(const u32x4*)((const bf16_t*)Xin + ro + bj * HALF);
                        x0 = (f32x4){__builtin_bit_cast(float, w.x << 16), __builtin_bit_cast(float, w.x & 0xffff0000u), __builtin_bit_cast(float, w.y << 16), __builtin_bit_cast(float, w.y & 0xffff0000u)};
                        x1 = (f32x4){__builtin_bit_cast(float, w.z << 16), __builtin_bit_cast(float, w.z & 0xffff0000u), __builtin_bit_cast(float, w.w << 16), __builtin_bit_cast(float, w.w & 0xffff0000u)}; }
                    const f32x4 v0 = x0 + acc[ai][bj][m][0], v1 = x1 + acc[ai][bj][m][1];
                    u32x4 o; o.x = cvt_pk_bf16(v0[0], v0[1]); o.y = cvt_pk_bf16(v0[2], v0[3]); o.z = cvt_pk_bf16(v1[0], v1[1]); o.w = cvt_pk_bf16(v1[2], v1[3]);
                    *(u32x4*)(X + ro + bj * HALF) = o; }
                asm volatile("" ::: "memory"); }
    }
};
struct EpiBf8 {
    static constexpr bool PERM = true, AFTER_DRAIN = false;
    bf16_t* O; int ldc; int s_lo, s_hi; float scale; const float* sA; const float* sB; PG8_LAS float* sc;
    struct Pre {};
    __device__ __forceinline__ void prefetch(Pre&, const Unit& u, int wr, int wc, int fr, int fq, int ui) const {
        const int wid = wr * 4 + wc, lane = fq * 16 + fr; PG8_LAS float* d = sc + (ui & 1) * 512;
        if (wid < 2) { const float* src = (wid == 0 ? sA + u.pm * BM : sB + u.pn * BM) + 4 * lane;
            __builtin_amdgcn_global_load_lds((const unsigned*)src, (PG8_LAS unsigned*)(d + 256 * wid), 16, 0, 0); }
    }
    __device__ __forceinline__ void commit(const Pre&, int, int, int, int, int) const {}
    __device__ __forceinline__ void operator()(const i32x4 (&acc)[2][2][4][2], const Unit& u, int wr, int wc, int fr, int fq, const Pre&, int ui) const {
        const int row0 = u.pm * BM + wr * 64 + fr, col0 = u.pn * BM + wc * 32 + 8 * fq; const PG8_LAS float* d = sc + (ui & 1) * 512;
        const float sc0 = (u.pn >= s_lo && u.pn < s_hi) ? scale : 1.f;
        f32x4 cb[2][2];
#pragma unroll
        for (int bj = 0; bj < 2; ++bj)
#pragma unroll
            for (int n = 0; n < 2; ++n) cb[bj][n] = *(const PG8_LAS f32x4*)(d + 256 + wc * 32 + 8 * fq + bj * HALF + 4 * n) * sc0;
#pragma unroll
        for (int ai = 0; ai < 2; ++ai)
#pragma unroll
            for (int m = 0; m < 4; ++m) { const int row = row0 + ai * HALF + m * 16; const float ra = d[wr * 64 + fr + ai * HALF + m * 16]; bf16_t* rowp = O + (size_t)row * ldc + col0;
#pragma unroll
                for (int bj = 0; bj < 2; ++bj) { const f32x4 v0 = __builtin_convertvector(acc[ai][bj][m][0], f32x4) * cb[bj][0] * ra, v1 = __builtin_convertvector(acc[ai][bj][m][1], f32x4) * cb[bj][1] * ra;
                    u32x4 w; w.x = cvt_pk_bf16(v0[0], v0[1]); w.y = cvt_pk_bf16(v0[2], v0[3]); w.z = cvt_pk_bf16(v1[0], v1[1]); w.w = cvt_pk_bf16(v1[2], v1[3]);
                    *(u32x4*)(rowp + bj * HALF) = w; } }
    }
};
template <bool F8OUT> struct EpiSwiglu8 {
    static constexpr bool PERM = true, AFTER_DRAIN = false;
    bf16_t* O; int ldc; const float* sA; const float* sB; int sb_exp; int tb1, tb2, tb3, tb4, tb5, tb6, tb7; PG8_LAS float* sc;
    struct Pre {};
    __device__ __forceinline__ void prefetch(Pre&, const Unit& u, int wr, int wc, int fr, int fq, int ui) const {
        const int wid = wr * 4 + wc, lane = fq * 16 + fr; PG8_LAS float* d = sc + (ui & 1) * 512;
        const int e = (u.pm >= tb1) + (u.pm >= tb2) + (u.pm >= tb3) + (u.pm >= tb4) + (u.pm >= tb5) + (u.pm >= tb6) + (u.pm >= tb7);
        if (wid < 2) { const float* src = (wid == 0 ? sA + u.pm * BM : sB + (size_t)e * sb_exp + u.pn * BM) + 4 * lane;
            __builtin_amdgcn_global_load_lds((const unsigned*)src, (PG8_LAS unsigned*)(d + 256 * wid), 16, 0, 0); }
    }
    __device__ __forceinline__ void commit(const Pre&, int, int, int, int, int) const {}
    __device__ __forceinline__ void operator()(const i32x4 (&acc)[2][2][4][2], const Unit& u, int wr, int wc, int fr, int fq, const Pre&, int ui) const {
        const int row0 = u.pm * BM + wr * 64 + fr, col0 = u.pn * HALF + wc * 32 + 8 * fq; const PG8_LAS float* d = sc + (ui & 1) * 512;
        const PG8_LAS float* sb = d + 256 + wc * 32 + 8 * fq;
        constexpr float CG = 1.4426950408889634f, CU = (F8OUT ? F8_HSCALE : 1.f) * 0.6931471805599453f;
        const f32x4 sg0 = *(const PG8_LAS f32x4*)sb * CG, sg1 = *(const PG8_LAS f32x4*)(sb + 4) * CG, su0 = *(const PG8_LAS f32x4*)(sb + HALF) * CU, su1 = *(const PG8_LAS f32x4*)(sb + HALF + 4) * CU;
#pragma unroll
        for (int ai = 0; ai < 2; ++ai)
#pragma unroll
            for (int m = 0; m < 4; ++m) { const int row = row0 + ai * HALF + m * 16; const float ra = d[wr * 64 + fr + ai * HALF + m * 16];
                const f32x4 g0 = __builtin_convertvector(acc[ai][0][m][0], f32x4) * sg0 * ra, g1 = __builtin_convertvector(acc[ai][0][m][1], f32x4) * sg1 * ra;
                const f32x4 u0 = __builtin_convertvector(acc[ai][1][m][0], f32x4) * su0 * ra, u1 = __builtin_convertvector(acc[ai][1][m][1], f32x4) * su1 * ra;
                if constexpr (F8OUT) { float h[8];
#pragma unroll
                    for (int i = 0; i < 4; ++i) { h[i] = __builtin_fminf(__builtin_fmaxf(silu2_mul(g0[i], u0[i]), -448.f), 448.f); h[4 + i] = __builtin_fminf(__builtin_fmaxf(silu2_mul(g1[i], u1[i]), -448.f), 448.f); }
                    unsigned w0 = 0u, w1 = 0u; w0 = __builtin_amdgcn_cvt_pk_fp8_f32(h[0], h[1], w0, false); w0 = __builtin_amdgcn_cvt_pk_fp8_f32(h[2], h[3], w0, true);
                    w1 = __builtin_amdgcn_cvt_pk_fp8_f32(h[4], h[5], w1, false); w1 = __builtin_amdgcn_cvt_pk_fp8_f32(h[6], h[7], w1, true);
                    typedef unsigned u32x2 __attribute__((ext_vector_type(2))); *(u32x2*)((unsigned char*)O + (size_t)row * ldc + col0) = (u32x2){w0, w1}; }
                else { bf16_t* rowp = O + (size_t)row * ldc + col0;
                u32x4 w; w.x = cvt_pk_bf16(silu2_mul(g0[0], u0[0]), silu2_mul(g0[1], u0[1])); w.y = cvt_pk_bf16(silu2_mul(g0[2], u0[2]), silu2_mul(g0[3], u0[3]));
                w.z = cvt_pk_bf16(silu2_mul(g1[0], u1[0]), silu2_mul(g1[1], u1[1])); w.w = cvt_pk_bf16(silu2_mul(g1[2], u1[2]), silu2_mul(g1[3], u1[3]));
                *(u32x4*)rowp = w; } }
    }
};
struct GOrder {
    StaticOrder so; const char* A; const char* B; size_t a_tile, b_tile, b_exp; int tb1, tb2, tb3, tb4, tb5, tb6, tb7;
    __device__ __forceinline__ bool next(int i, Unit& u) const { return so.next(i, u); }
    __device__ __forceinline__ const char* a_base(const Unit& u) const { return A + (size_t)u.pm * a_tile; }
    __device__ __forceinline__ const char* b_base(const Unit& u) const {
        const int e = (u.pm >= tb1) + (u.pm >= tb2) + (u.pm >= tb3) + (u.pm >= tb4) + (u.pm >= tb5) + (u.pm >= tb6) + (u.pm >= tb7);
        return B + (size_t)e * b_exp + (size_t)u.pn * b_tile; }
    __device__ __forceinline__ int nt(const Unit&, int full) const { return full; }
    __device__ __forceinline__ void a_ready(const Unit&) const {}
    __device__ __forceinline__ void done(const Unit&) const {}
};
struct GOrderTail {
    static constexpr int MAIN_M = 128, NTF = 28;
    StaticOrder so; const char* A; const char* B; size_t a_tile, b_tile, b_exp; int tb1, tb2, tb3, tb4, tb5, tb6, tb7; int n_main, n_piece;
    __device__ __forceinline__ void init(int n_mtiles, int N, int G, int c) { so.init(MAIN_M * BM, N, G, c); n_main = c < so.nwg ? (so.nwg - c + G - 1) / G : 0; n_piece = (n_mtiles - MAIN_M) * 4 * 8; }
    __device__ __forceinline__ bool next(int i, Unit& u) const {
        const bool mainu = i < n_main; const int q = (i - n_main) * so.G + so.c, ut = q >> 3;
        Unit m; m.pm = 0; m.pn = 0; m.tq = -1; so.next(mainu ? i : 0, m);
        u.pm = mainu ? m.pm : MAIN_M + (ut >> 2); u.pn = mainu ? m.pn : (ut & 3); u.tq = mainu ? -1 : q;
        return mainu || q < n_piece; }
    __device__ __forceinline__ int nt(const Unit& u, int full) const { return u.tq < 0 ? full : ((u.tq & 7) < 6 ? 4 : 2); }
    __device__ __forceinline__ const char* a_base(const Unit& u) const { const int kp = u.tq & 7, k0 = u.tq < 0 ? 0 : (kp < 6 ? 4 * kp : 2 * kp + 12); return A + (size_t)u.pm * a_tile + (size_t)k0 * (BK * 2); }
    __device__ __forceinline__ const char* b_base(const Unit& u) const {
        const int e = (u.pm >= tb1) + (u.pm >= tb2) + (u.pm >= tb3) + (u.pm >= tb4) + (u.pm >= tb5) + (u.pm >= tb6) + (u.pm >= tb7);
        const int kp = u.tq & 7, k0 = u.tq < 0 ? 0 : (kp < 6 ? 4 * kp : 2 * kp + 12);
        return B + (size_t)e * b_exp + (size_t)u.pn * b_tile + (size_t)k0 * (BK * 2); }
    __device__ __forceinline__ void a_ready(const Unit&) const {}
    __device__ __forceinline__ void done(const Unit&) const {}
};
struct EpiBfPart {
    static constexpr bool PERM = true, AFTER_DRAIN = false; static constexpr int YP_TILE0 = 136;
    bf16_t* O; int ldc; float scale;
    struct Pre {}; __device__ __forceinline__ void prefetch(Pre&, const Unit&, int, int, int, int, int) const {} __device__ __forceinline__ void commit(const Pre&, int, int, int, int, int) const {}
    __device__ __forceinline__ void operator()(const f32x4 (&acc)[2][2][4][2], const Unit& u, int wr, int wc, int fr_, int fq_, const Pre&, int) const {
        int fr = fr_, fq = fq_; asm volatile("" : "+v"(fr), "+v"(fq));
        const int vt = u.tq < 0 ? u.pm : YP_TILE0 + (u.tq & 7) * 8 + (u.pm - GOrderTail::MAIN_M);
        const int row0 = vt * BM + wr * 64 + fr, col0 = u.pn * BM + wc * 32 + 8 * fq;
#pragma unroll
        for (int ai = 0; ai < 2; ++ai)
#pragma unroll
            for (int m = 0; m < 4; ++m) { bf16_t* rowp = O + (size_t)(row0 + ai * HALF + m * 16) * ldc + col0;
#pragma unroll
                for (int bj = 0; bj < 2; ++bj) { const f32x4 v0 = acc[ai][bj][m][0] * scale, v1 = acc[ai][bj][m][1] * scale;
                    u32x4 w; w.x = cvt_pk_bf16(v0[0], v0[1]); w.y = cvt_pk_bf16(v0[2], v0[3]); w.z = cvt_pk_bf16(v1[0], v1[1]); w.w = cvt_pk_bf16(v1[2], v1[3]);
                    *(u32x4*)(rowp + bj * HALF) = w; } }
    }
};
template <class Epi, class Sched, bool ALIGN_EPI = false, bool SP2 = false, int MODE = 0  , int XEXP = 0  >
__device__ __forceinline__ void gemm_phase(PG8_LAS unsigned char* lds, const Gemm g, const Sched& S, const Epi& E) {
    const int tid = threadIdx.x, wid = __builtin_amdgcn_readfirstlane(tid >> 6), lane = tid & 63, wr = wid >> 2, wc = wid & 3, fr = lane & 15, fq = lane >> 4;
    const int K = g.K, nt = K / BK;
    unsigned voffA[2], voffB[2];
#pragma unroll
    for (int i = 0; i < 2; ++i) { int R, C; stage_rc(tid * 16 + i * 8192, R, C); const int Rb = Epi::PERM ? ((R & ~31) + perm32(R & 31)) : R;
        voffA[i] = (unsigned)(R * K + C) * 2u; voffB[i] = (unsigned)(Rb * K + C) * 2u; }
    const size_t kstep = (size_t)(BK * 2);
    const size_t hstep = (size_t)HALF * K * 2;
        const unsigned ldsw = (unsigned)wid * 1024u;
    const int aoff = lds_byte(wr * 64 + fr, fq * 8), boff = lds_byte(wc * 32 + fr, fq * 8);
#define PG8_SA(b, h) (((b) * 2 + (h)) * HTB)
#define PG8_SB(b, h) ((4 + (b) * 2 + (h)) * HTB)
#define PG8_STAGE(bufoff, gbase, voff) do { if constexpr (XEXP != 2) _Pragma("unroll") for (int _i = 0; _i < 2; ++_i) \
        __builtin_amdgcn_global_load_lds((const unsigned*)((const char*)(gbase) + (voff)[_i]), (PG8_LAS unsigned*)(lds + (bufoff) + ldsw + _i * 8192), 16, 0, 0); } while (0)
#define PG8_LDA(dst, b, h) do { if constexpr (XEXP < 3) _Pragma("unroll") for (int m = 0; m < 4; ++m) dst[m] = ldfrag<MODE>(lds + PG8_SA(b, h) + aoff + m * 2048); } while (0)
#define PG8_LDB(dst, b, h) do { if constexpr (XEXP < 3) _Pragma("unroll") for (int n = 0; n < 2; ++n) dst[n] = ldfrag<MODE>(lds + PG8_SB(b, h) + boff + n * 2048); } while (0)
#define PG8_MMA(ai, bj, At, Bt) do { __builtin_amdgcn_s_setprio(1); _Pragma("unroll") for (int m = 0; m < 4; ++m) _Pragma("unroll") for (int n = 0; n < 2; ++n) \
        mma_step<MODE>(acc[ai][bj][m][n], Bt[n], At[m]); __builtin_amdgcn_s_setprio(0); } while (0)
#define PG8_WAIT_V(n) do { if constexpr (XEXP != 1) asm volatile("s_waitcnt vmcnt(" #n ")" ::: "memory"); } while (0)
#define PG8_WAIT_L(n) asm volatile("s_waitcnt lgkmcnt(" #n ")" ::: "memory")
#define PG8_BAR do { if constexpr (XEXP < 4) __builtin_amdgcn_s_barrier(); } while (0)
#define PG8_SCHED __builtin_amdgcn_sched_barrier(0)
    Unit cur, nxt; int ui = 0; typename Epi::Pre pre;
    if (!S.next(0, cur)) return;
    typename AccT<MODE == 1>::type acc[2][2][4][2];
#pragma unroll
    for (int a = 0; a < 2; ++a)
#pragma unroll
        for (int b = 0; b < 2; ++b)
#pragma unroll
            for (int m = 0; m < 4; ++m)
#pragma unroll
                for (int n = 0; n < 2; ++n) acc[a][b][m][n] = typename AccT<MODE == 1>::type{};
    typename Frag<MODE>::type At[4], B0[2], B1[2];
    const char* cA = S.a_base(cur); const char* cB = S.b_base(cur);
    S.a_ready(cur);
    if constexpr (SP2) {
        PG8_STAGE(PG8_SB(0, 0), cB, voffB); PG8_STAGE(PG8_SB(0, 1), cB + hstep, voffB); PG8_STAGE(PG8_SA(0, 0), cA, voffA); PG8_STAGE(PG8_SA(0, 1), cA + hstep, voffA);
        if (wr == 1) PG8_BAR;
        PG8_WAIT_V(2); PG8_BAR;
        PG8_STAGE(PG8_SB(1, 0), cB + kstep, voffB); PG8_STAGE(PG8_SA(1, 0), cA + kstep, voffA); PG8_STAGE(PG8_SB(1, 1), cB + hstep + kstep, voffB);
        PG8_WAIT_V(6); PG8_BAR;
    } else {
        PG8_STAGE(PG8_SB(0, 0), cB, voffB); PG8_STAGE(PG8_SA(0, 0), cA, voffA); PG8_STAGE(PG8_SB(0, 1), cB + hstep, voffB); PG8_STAGE(PG8_SA(0, 1), cA + hstep, voffA);
        if (wr == 1) PG8_BAR;
        PG8_WAIT_V(4); PG8_BAR;
        PG8_STAGE(PG8_SB(1, 0), cB + kstep, voffB); PG8_STAGE(PG8_SA(1, 0), cA + kstep, voffA); PG8_STAGE(PG8_SB(1, 1), cB + hstep + kstep, voffB);
        PG8_WAIT_V(6); PG8_BAR;
    }
    for (;;) {
        const bool has_next = S.next(ui + 1, nxt);
        const char* nA = has_next ? S.a_base(nxt) : cA; const char* nB = has_next ? S.b_base(nxt) : cB;
        const int ntc = S.nt(cur, nt);
        for (int t = 0; t < ntc; t += 2) {
            const bool last = (t == ntc - 2);
            const char* a1 = cA + (size_t)(t + 1) * kstep;
            const char* a2 = last ? nA : cA + (size_t)(t + 2) * kstep; const char* b2 = last ? nB : cB + (size_t)(t + 2) * kstep;
            const char* a3 = a2 + kstep; const char* b3 = b2 + kstep;
            if (last && has_next) S.a_ready(nxt);
            if (last) E.prefetch(pre, cur, wr, wc, fr, fq, ui);
            if constexpr (SP2) {
            PG8_LDB(B0, 0, 0); PG8_LDB(B1, 0, 1); PG8_SCHED; PG8_LDA(At, 0, 0); PG8_STAGE(PG8_SA(1, 1), a1 + hstep, voffA);
            PG8_WAIT_V(8); PG8_WAIT_L(0); PG8_BAR; PG8_MMA(0, 0, At, B0); PG8_MMA(0, 1, At, B1); PG8_BAR; PG8_SCHED;
            PG8_LDA(At, 0, 1); PG8_STAGE(PG8_SB(0, 0), b2, voffB); PG8_STAGE(PG8_SB(0, 1), b2 + hstep, voffB); PG8_STAGE(PG8_SA(0, 0), a2, voffA);
            PG8_WAIT_V(8); PG8_WAIT_L(0); PG8_BAR; PG8_MMA(1, 0, At, B0); PG8_MMA(1, 1, At, B1); PG8_BAR; PG8_SCHED;
            PG8_LDB(B0, 1, 0); PG8_LDB(B1, 1, 1); PG8_SCHED; PG8_LDA(At, 1, 0); PG8_STAGE(PG8_SA(0, 1), a2 + hstep, voffA);
            PG8_WAIT_V(8); PG8_WAIT_L(0); PG8_BAR; PG8_MMA(0, 0, At, B0); PG8_MMA(0, 1, At, B1); PG8_BAR; PG8_SCHED;
            PG8_LDA(At, 1, 1); PG8_STAGE(PG8_SB(1, 0), b3, voffB); PG8_STAGE(PG8_SB(1, 1), b3 + hstep, voffB); PG8_STAGE(PG8_SA(1, 0), a3, voffA);
            PG8_WAIT_V(8); PG8_WAIT_L(0); PG8_BAR; PG8_MMA(1, 0, At, B0); PG8_MMA(1, 1, At, B1); PG8_BAR; PG8_SCHED;
            } else {
            PG8_LDB(B0, 0, 0); PG8_SCHED; PG8_LDA(At, 0, 0); PG8_STAGE(PG8_SA(1, 1), a1 + hstep, voffA);
            PG8_WAIT_L(8); PG8_BAR; PG8_WAIT_L(0); PG8_MMA(0, 0, At, B0); PG8_BAR; PG8_SCHED;
            PG8_LDB(B1, 0, 1); PG8_STAGE(PG8_SB(0, 0), b2, voffB);
            PG8_BAR; PG8_WAIT_L(0); PG8_MMA(0, 1, At, B1); PG8_BAR;
            PG8_LDA(At, 0, 1); PG8_STAGE(PG8_SA(0, 0), a2, voffA);
            PG8_BAR; PG8_WAIT_L(0); PG8_MMA(1, 0, At, B0); PG8_BAR; PG8_SCHED;
            PG8_STAGE(PG8_SB(0, 1), b2 + hstep, voffB);
            PG8_WAIT_V(6); PG8_BAR; PG8_MMA(1, 1, At, B1); PG8_BAR;
            PG8_LDB(B0, 1, 0); PG8_SCHED; PG8_LDA(At, 1, 0); PG8_STAGE(PG8_SA(0, 1), a2 + hstep, voffA);
            PG8_WAIT_L(8); PG8_BAR; PG8_WAIT_L(0); PG8_MMA(0, 0, At, B0); PG8_BAR; PG8_SCHED;
            PG8_LDB(B1, 1, 1); PG8_STAGE(PG8_SB(1, 0), b3, voffB);
            PG8_BAR; PG8_WAIT_L(0); PG8_MMA(0, 1, At, B1); PG8_BAR;
            PG8_LDA(At, 1, 1); PG8_STAGE(PG8_SA(1, 0), a3, voffA);
            PG8_BAR; PG8_WAIT_L(0); PG8_MMA(1, 0, At, B0); PG8_BAR; PG8_SCHED;
            PG8_STAGE(PG8_SB(1, 1), b3 + hstep, voffB);
            PG8_WAIT_V(6); PG8_BAR; PG8_MMA(1, 1, At, B1); PG8_BAR;
            }
        }
        E.commit(pre, wr, wc, fr, fq, ui);
        if constexpr (ALIGN_EPI) { if (wr == 0) PG8_BAR; }
        if constexpr (MODE == 2) asm volatile("s_nop 15\n\ts_nop 7" ::: "memory");
        if constexpr (!Epi::AFTER_DRAIN) { E(acc, cur, wr, wc, fr, fq, pre, ui); S.done(cur); }
        if (!has_next) break;
#pragma unroll
        for (int a = 0; a < 2; ++a)
#pragma unroll
            for (int b = 0; b < 2; ++b)
#pragma unroll
                for (int m = 0; m < 4; ++m)
#pragma unroll
                    for (int n = 0; n < 2; ++n) acc[a][b][m][n] = typename AccT<MODE == 1>::type{};
        cur = nxt; cA = nA; cB = nB; ++ui;
        if constexpr (ALIGN_EPI) { if (wr == 1) PG8_BAR; }
    }
    PG8_WAIT_V(0);
    if constexpr (!ALIGN_EPI) { if (wr == 0) PG8_BAR; }
    PG8_BAR;
    if constexpr (Epi::AFTER_DRAIN) { E.fused(acc, cur, wr, wc, fr, fq, lds, wid, lane); S.done(cur); }
#undef PG8_SA
#undef PG8_SB
#undef PG8_STAGE
#undef PG8_LDA
#undef PG8_LDB
#undef PG8_MMA
#undef PG8_WAIT_V
#undef PG8_WAIT_L
#undef PG8_BAR
#undef PG8_SCHED
}
}
#include <hip/hip_bf16.h>
#include <cmath>
namespace attn_body {
using bf16=__hip_bfloat16;
using bf16x8=__attribute__((ext_vector_type(8)))short;
using s16x4=__attribute__((ext_vector_type(4)))short;
using f32x16=__attribute__((ext_vector_type(16)))float;
using u32x4=__attribute__((ext_vector_type(4)))unsigned;
constexpr int BATCH=2,NHEAD=8,SEQ=8192,D=64,DM=3584,OPITCH=1024;
constexpr int NW=8,QBLK=32,QB=QBLK*NW,KVBLK=64,NQB=SEQ/QB;
constexpr int ATTN_PITCH=DM, ATTN_UNIT_ROWS=QB;
__device__ __forceinline__ int crow(int r,int hi){return (r&3)+8*(r>>2)+4*hi;}
#define SBAR() __builtin_amdgcn_sched_barrier(0)
__device__ __forceinline__ void cmask(f32x16&p0,f32x16&p1,int jb,int qrel,int hi){
  const float NEG=-INFINITY; int kb=64*jb+4*hi;
  #pragma unroll
  for(int r=0;r<16;++r){int kv=kb+(r&3)+8*(r>>2); if(kv>qrel)p0[r]=NEG; if(kv+32>qrel)p1[r]=NEG;}
}

constexpr int NSLOT=3, SLOTB=8192, SPLIT_NT=72, PART_F=256*64+512;
constexpr int LDS_K=0, LDS_V=NSLOT*SLOTB, LDS_WS=2*NSLOT*SLOTB, LDS_OST=LDS_WS+NW*64*4, LDS_CK=LDS_OST+NW*4096, LDS_BYTES=LDS_CK+SEQ*4;
constexpr float C2=0.125f*1.4426950408889634f;
__device__ __forceinline__ void glds16(const void*gsrc,unsigned lds_dst){unsigned keep;
  asm volatile("s_mov_b32 %0, m0\n\ts_mov_b32 m0, %2\n\ts_nop 0\n\tglobal_load_lds_dwordx4 %1, off\n\ts_mov_b32 m0, %0":"=&s"(keep):"v"(gsrc),"s"(lds_dst):"memory");}
__device__ __forceinline__ float max3f(float a,float b,float c){float r;asm("v_max3_f32 %0, %1, %2, %3":"=v"(r):"v"(a),"v"(b),"v"(c));return r;}
__device__ __forceinline__ float max2f(float a,float b){float r;asm("v_max_f32_e32 %0, %1, %2":"=v"(r):"v"(a),"v"(b));return r;}
__device__ __forceinline__ float fadd_s(float a,float b){float r;asm("v_add_f32_e32 %0, %1, %2":"=v"(r):"v"(a),"v"(b));return r;}
__device__ __forceinline__ float fsub_s(float a,float b){float r;asm("v_sub_f32_e32 %0, %1, %2":"=v"(r):"v"(a),"v"(b));return r;}
typedef float f32x2_t __attribute__((ext_vector_type(2))); typedef float f32x4_t __attribute__((ext_vector_type(4))); typedef __bf16 bf16x2_t __attribute__((ext_vector_type(2)));
__device__ __forceinline__ unsigned cvtpk_s(float lo,float hi){f32x2_t v={lo,hi};bf16x2_t b=__builtin_convertvector(v,bf16x2_t);return __builtin_bit_cast(unsigned,b);}
#define WAIT_BAR(N) asm volatile("s_waitcnt vmcnt(" #N ") lgkmcnt(0)\n\ts_barrier":::"memory")

__device__ __forceinline__ void qkt(f32x16&p0,f32x16&p1,const char*Kslot,const bf16x8*qr,const f32x16&negm,int r32,int hi){
  const char*kb=Kslot+hi*1024+r32*16;
  #pragma unroll
  for(int d0=0;d0<4;++d0){
    const bf16x8 b0=*reinterpret_cast<const bf16x8*>(kb+d0*2048);
    const bf16x8 b1=*reinterpret_cast<const bf16x8*>(kb+d0*2048+512);
    if(d0==0){p0=__builtin_amdgcn_mfma_f32_32x32x16_bf16(b0,qr[0],negm,0,0,0);p1=__builtin_amdgcn_mfma_f32_32x32x16_bf16(b1,qr[0],negm,0,0,0);}
    else{p0=__builtin_amdgcn_mfma_f32_32x32x16_bf16(b0,qr[d0],p0,0,0,0);p1=__builtin_amdgcn_mfma_f32_32x32x16_bf16(b1,qr[d0],p1,0,0,0);}}
}
typedef __attribute__((address_space(3))) const char* lds_cptr;
typedef short v4i16_t __attribute__((ext_vector_type(4)));
__device__ __forceinline__ void kload8(bf16x8*kf,lds_cptr kp){
  kf[0]=*(const __attribute__((address_space(3))) bf16x8*)(kp);      kf[1]=*(const __attribute__((address_space(3))) bf16x8*)(kp+512);
  kf[2]=*(const __attribute__((address_space(3))) bf16x8*)(kp+2048); kf[3]=*(const __attribute__((address_space(3))) bf16x8*)(kp+2560);
  kf[4]=*(const __attribute__((address_space(3))) bf16x8*)(kp+4096); kf[5]=*(const __attribute__((address_space(3))) bf16x8*)(kp+4608);
  kf[6]=*(const __attribute__((address_space(3))) bf16x8*)(kp+6144); kf[7]=*(const __attribute__((address_space(3))) bf16x8*)(kp+6656);
}
__device__ __forceinline__ void kload2(bf16x8*kf,lds_cptr kp,int j){ kf[2*j]=*(const __attribute__((address_space(3))) bf16x8*)(kp+j*2048); kf[2*j+1]=*(const __attribute__((address_space(3))) bf16x8*)(kp+j*2048+512); }
__device__ __forceinline__ s16x4 vtr(lds_cptr p){ return __builtin_bit_cast(s16x4,__builtin_amdgcn_ds_read_tr16_b64_v4i16((__attribute__((address_space(3))) v4i16_t*)p)); }
__device__ __forceinline__ float rowmax(const f32x16&p0,const f32x16&p1){
  float a=max3f(p0[0],p0[1],p1[0]),b=max3f(p0[2],p0[3],p1[1]);a=max3f(a,p1[2],p1[3]);
  #pragma unroll
  for(int r=4;r<16;r+=4){a=max3f(a,p0[r],p0[r+1]);b=max3f(b,p0[r+2],p0[r+3]);a=max3f(a,p1[r],p1[r+1]);b=max3f(b,p1[r+2],p1[r+3]);}
  const float m=max2f(a,b);
  auto rr=__builtin_amdgcn_permlane32_swap(__float_as_uint(m),__float_as_uint(m),false,false);
  return max2f(__uint_as_float(rr[0]),__uint_as_float(rr[1]));
}
__device__ __forceinline__ void pv(f32x16*o,int vb,bf16x8 pa0,bf16x8 pa1,bf16x8 pa2,bf16x8 pa3){
  #pragma unroll
  for(int d0=0;d0<2;++d0){s16x4 lo[4],hi[4];
    #pragma unroll
    for(int ks=0;ks<4;++ks){
      asm volatile("ds_read_b64_tr_b16 %0,%1 offset:%c2":"=&v"(lo[ks]):"v"(vb),"i"(d0*4096+ks*1024):"memory");
      asm volatile("ds_read_b64_tr_b16 %0,%1 offset:%c2":"=&v"(hi[ks]):"v"(vb),"i"(d0*4096+ks*1024+512):"memory");}
    asm volatile("s_waitcnt lgkmcnt(0)":::"memory");SBAR();
    #define PK(k) (bf16x8){lo[k][0],lo[k][1],lo[k][2],lo[k][3],hi[k][0],hi[k][1],hi[k][2],hi[k][3]}
    o[d0]=__builtin_amdgcn_mfma_f32_32x32x16_bf16(pa0,PK(0),o[d0],0,0,0);
    o[d0]=__builtin_amdgcn_mfma_f32_32x32x16_bf16(pa1,PK(1),o[d0],0,0,0);
    o[d0]=__builtin_amdgcn_mfma_f32_32x32x16_bf16(pa2,PK(2),o[d0],0,0,0);
    o[d0]=__builtin_amdgcn_mfma_f32_32x32x16_bf16(pa3,PK(3),o[d0],0,0,0);
    #undef PK
  }
}

#ifndef ATTN_STORE16
#define ATTN_STORE16(p,v) (*(u32x4*)(p)=(v))
#endif
template<int THRL> __device__ __forceinline__ void attn_unit(int b,int h,int qb,const bf16*Q,const bf16*__restrict__ K,const bf16*__restrict__ V,bf16*O,const float*__restrict__ cf,const float Tskip,const int part,float*PART,unsigned*flag,char*shm){
  int tid_=threadIdx.x; asm volatile("":"+v"(tid_));
  const int tid=tid_,lane=tid&63,r32=lane&31,hi=lane>>5; const int wid=__builtin_amdgcn_readfirstlane(tid>>6);
  const long rowbase=(long)b*SEQ; const int q0=qb*QB;
  const bf16*Qw=Q+(rowbase+q0+wid*QBLK)*DM+h*D;
  const unsigned lds0=(unsigned)(uintptr_t)shm;
  float*wsf=(float*)(shm+LDS_WS)+wid*64;
  const unsigned kdst=lds0+LDS_K+wid*1024, vdst=lds0+LDS_V+wid*1024;
  #define DMA_K(t,slot) glds16(ksrc+(long)(t)*KVBLK*DM,(unsigned)__builtin_amdgcn_readfirstlane(kdst+(slot)))
  #define DMA_V(t,slot) glds16(vsrc+(long)(t)*KVBLK*DM,(unsigned)__builtin_amdgcn_readfirstlane(vdst+(slot)))
  const int vb0=(int)(lds0+LDS_V)+((lane>>4)&1)*32+(lane&3)*8+(4*hi+((lane&15)>>2))*64;
  const char*Kbase=shm+LDS_K; bf16x8 kf[8];
  const lds_cptr shm3=(lds_cptr)shm; const lds_cptr kp0=shm3+LDS_K+hi*1024+r32*16; const lds_cptr vp0=shm3+LDS_V+((lane>>4)&1)*32+(lane&3)*8+(4*hi+((lane&15)>>2))*64;
  typedef __attribute__((address_space(3))) float lds_f32; typedef __attribute__((address_space(3))) const f32x4_t* lds_cf4;
  const int NT0=(q0+QB)/KVBLK;
  int tb;
  { const float thr=cf[q0]+Tskip; const int t1=lane,t2=lane+64;
    const bool n1=(t1<NT0)&&(cf[64*t1+63]>thr), n2=(t2<NT0)&&(cf[64*t2+63]>thr);
    const int t0=(int)__popcll(__ballot(n1))+(int)__popcll(__ballot(n2));
    tb=t0&~1; if(tb>NT0-4)tb=NT0-4; tb=__builtin_amdgcn_readfirstlane(tb); }
  int NT=NT0-tb; bool band=true; const bool split=(PART!=nullptr)&&(NT>SPLIT_NT);
  if(PART!=nullptr){ if(!split){ if(part==1)return; } else { const int mid=(NT>>1)&~1; if(part==0){NT=mid;band=false;} else {tb+=mid;NT-=mid;} } }
  { lds_f32* ckw=(lds_f32*)((lds_cptr)shm+LDS_CK); int i0_=tb*KVBLK+tid; asm volatile("":"+v"(i0_)); _Pragma("nounroll") for(int i=i0_;i<q0+QB;i+=NW*64)ckw[i]=cf[i]; }
  const float cq=cf[q0+wid*QBLK+(lane&31)];
  asm volatile("s_waitcnt vmcnt(0) lgkmcnt(0)\n\ts_barrier":::"memory");
  const bf16*Kh=K+(rowbase+(long)tb*KVBLK)*DM+h*D,*Vh=V+(rowbase+(long)tb*KVBLK)*DM+h*D;
  const bf16*ksrc=Kh+(long)lane*DM+wid*8;
  const bf16*vsrc=Vh+(long)(16*(wid&3)+(lane>>2))*DM+(wid>>2)*32+(lane&3)*8;
  const lds_cptr ckl=(lds_cptr)shm+LDS_CK+256*tb+16*(lane>>5);
  #define CBIAS(P0,P1,t) do{ const lds_cptr cb_=ckl+256*(t); _Pragma("unroll") for(int g_=0;g_<4;++g_){ const f32x4_t a_=*(lds_cf4)(cb_+32*g_), b_=*(lds_cf4)(cb_+128+32*g_); \
      _Pragma("unroll") for(int i_=0;i_<4;++i_){ P0[4*g_+i_]-=(a_[i_]+mm); P1[4*g_+i_]-=(b_[i_]+mm); } } }while(0)
  f32x4_t cbA[4],cbB[4]; float clast;
  #define CBLD(t) do{ const lds_cptr cb_=ckl+256*(t); _Pragma("unroll") for(int g_=0;g_<4;++g_){ cbA[g_]=*(lds_cf4)(cb_+32*g_); cbB[g_]=*(lds_cf4)(cb_+128+32*g_); } \
      clast=*(const __attribute__((address_space(3))) float*)((lds_cptr)shm+LDS_CK+256*tb+256*(t)+252); }while(0)
  DMA_K(0,0);DMA_V(0,0);DMA_K(1,SLOTB);
  bf16x8 qr[4];
  #pragma unroll
  for(int d0=0;d0<4;++d0)qr[d0]=*reinterpret_cast<const bf16x8*>(&Qw[(long)r32*DM+d0*16+hi*8]);
  float mhat=0.f,l_reg=0.f;f32x16 o[2];o[0]=f32x16{};o[1]=f32x16{};float mm=-cq; const f32x16 negm=f32x16{};
  const int qrel=wid*QBLK+r32;
  #define CMASK(P0,P1,t) do{int jb_=(t)-(NT-4); if(band&&jb_>=0)cmask(P0,P1,jb_,qrel,hi);}while(0)
  bool resc=false;
  #define START(P0,P1) do{ const float rm=rowmax(P0,P1); resc=false; \
    { const float dl=rm; mhat=fadd_s(mhat,dl); \
      _Pragma("unroll") for(int r=0;r<16;++r){P0[r]=fsub_s(P0[r],dl);P1[r]=fsub_s(P1[r],dl);} \
      mm+=dl; } \
    _Pragma("unroll") for(int r=0;r<16;++r)P0[r]=__builtin_amdgcn_exp2f(P0[r]); }while(0)
  #define RESC() do{ if(resc){ asm volatile("s_waitcnt lgkmcnt(0)":::"memory"); \
      _Pragma("unroll") for(int d_=0;d_<2;++d_) _Pragma("unroll") for(int r=0;r<16;++r)o[d_][r]*=wsf[crow(r,hi)]; } }while(0)
  f32x16 pA0,pA1,pB0,pB1;
  int sl_prev=0,sl_cur=0,sl_next=SLOTB;
  #define ROT() do{sl_prev=sl_cur;sl_cur=sl_next;sl_next=(sl_next==(NSLOT-1)*SLOTB)?0:sl_next+SLOTB;}while(0)
  DMA_K(2,2*SLOTB);
  WAIT_BAR(3);
  qkt(pA0,pA1,Kbase,qr,negm,r32,hi);asm volatile("s_nop 15\n\ts_nop 7":"+v"(pA0),"+v"(pA1));CBIAS(pA0,pA1,0);CMASK(pA0,pA1,0);
  START(pA0,pA1);
  _Pragma("unroll") for(int r=0;r<16;++r)pA1[r]=__builtin_amdgcn_exp2f(pA1[r]);
  WAIT_BAR(0);
  DMA_K(3,0);DMA_V(1,SLOTB);
  ROT();
  kload8(kf,kp0+sl_cur);
  WAIT_BAR(2);
  s16x4 vlo[8],vhi[8]; u32x4 pw0,pw1,pw2,pw3;
  #define PKW(P,B) cvtpk_s(P[B],P[B+1])
  #define PAF(k) __builtin_bit_cast(bf16x8,pw##k)
  #define VFR(i) (bf16x8){vlo[i][0],vlo[i][1],vlo[i][2],vlo[i][3],vhi[i][0],vhi[i][1],vhi[i][2],vhi[i][3]}
  #define PIN(x) asm volatile("":"+v"(x))
  #define MX3(a,b,c) __builtin_fmaxf(__builtin_fmaxf((a),(b)),(c))
  #define GAPA(MF,A0,A1,A2,A3,W0,W1,PW) do{ MF; sacc+=(f32x2_t){A0,A1}; sacc+=(f32x2_t){A2,A3}; PIN(sacc); W0; W1; PIN(PW); SBAR(); }while(0)
  #define EX(v) __builtin_amdgcn_exp2f(v)
  #define GAPB(MF,X,B,CB) do{ MF; { const f32x4_t t_=(CB)+mm; X[B]=EX(X[B]-t_[0]); X[B+1]=EX(X[B+1]-t_[1]); X[B+2]=EX(X[B+2]-t_[2]); X[B+3]=EX(X[B+3]-t_[3]); } PIN(X); SBAR(); }while(0)
  #define VRD(i) do{ vlo[i]=vtr(vp_+(((i)>>2)*4096+((i)&3)*1024)); vhi[i]=vtr(vp_+(((i)>>2)*4096+((i)&3)*1024+512)); }while(0)
  #define KRD(G,j) do{ if(G){ kload2(kf,kp0+sl_next,j); SBAR(); } }while(0)
  #define STEP(C0,C1,P0,P1,t,GK,GV,GL) do{ SBAR(); \
    const lds_cptr vp_=vp0+sl_prev; \
    VRD(0); SBAR(); f32x2_t sacc={P0[0],P0[1]}; \
    GAPA(C0=__builtin_amdgcn_mfma_f32_32x32x16_bf16(kf[0],qr[0],negm,0,0,0), P0[2],P0[3],P0[4],P0[5],     pw0[0]=PKW(P0,0), pw0[1]=PKW(P0,2), pw0); \
    VRD(4); SBAR(); GAPA(C1=__builtin_amdgcn_mfma_f32_32x32x16_bf16(kf[1],qr[0],negm,0,0,0), P0[6],P0[7],P0[8],P0[9],     pw0[2]=PKW(P0,4), pw0[3]=PKW(P0,6), pw0); \
    VRD(1); SBAR(); GAPA(C0=__builtin_amdgcn_mfma_f32_32x32x16_bf16(kf[2],qr[1],C0,0,0,0),   P0[10],P0[11],P0[12],P0[13], pw1[0]=PKW(P0,8), pw1[1]=PKW(P0,10), pw1); \
    VRD(5); SBAR(); GAPA(C1=__builtin_amdgcn_mfma_f32_32x32x16_bf16(kf[3],qr[1],C1,0,0,0),   P0[14],P0[15],P1[0],P1[1],   pw1[2]=PKW(P0,12),pw1[3]=PKW(P0,14), pw1); \
    VRD(2); SBAR(); GAPA(C0=__builtin_amdgcn_mfma_f32_32x32x16_bf16(kf[4],qr[2],C0,0,0,0),   P1[2],P1[3],P1[4],P1[5],     pw2[0]=PKW(P1,0), pw2[1]=PKW(P1,2), pw2); \
    VRD(6); SBAR(); GAPA(C1=__builtin_amdgcn_mfma_f32_32x32x16_bf16(kf[5],qr[2],C1,0,0,0),   P1[6],P1[7],P1[8],P1[9],     pw2[2]=PKW(P1,4), pw2[3]=PKW(P1,6), pw2); \
    VRD(3); SBAR(); GAPA(C0=__builtin_amdgcn_mfma_f32_32x32x16_bf16(kf[6],qr[3],C0,0,0,0),   P1[10],P1[11],P1[12],P1[13], pw3[0]=PKW(P1,8), pw3[1]=PKW(P1,10), pw3); \
    VRD(7); SBAR(); GAPA(C1=__builtin_amdgcn_mfma_f32_32x32x16_bf16(kf[7],qr[3],C1,0,0,0),   P1[14],P1[15],0.f,0.f,       pw3[2]=PKW(P1,12),pw3[3]=PKW(P1,14), pw3); \
    l_reg+=sacc[0]+sacc[1]; \
    if(GK){DMA_K((t)+3,sl_cur);} if(GV){DMA_V((t)+1,sl_next);} \
    CBLD(t); CMASK(C0,C1,t); \
    { float a=MX3(C0[0],C0[1],C1[0]),b=MX3(C0[2],C0[3],C1[1]); a=MX3(a,C1[2],C1[3]); \
      _Pragma("unroll") for(int r=4;r<16;r+=4){a=MX3(a,C0[r],C0[r+1]);b=MX3(b,C0[r+2],C0[r+3]);a=MX3(a,C1[r],C1[r+1]);b=MX3(b,C1[r+2],C1[r+3]);} \
      float rm=__builtin_fmaxf(a,b); { auto rr=__builtin_amdgcn_permlane32_swap(__float_as_uint(rm),__float_as_uint(rm),false,false); rm=__builtin_fmaxf(__uint_as_float(rr[0]),__uint_as_float(rr[1])); } rm=rm-clast-mm; \
      resc=false; \
      if(__builtin_expect(__any(rm>(float)THRL),0)){ const float dl=__builtin_fmaxf(rm,0.f); mhat+=dl; \
        mm+=dl; \
        const float f=__builtin_amdgcn_exp2f(-dl); l_reg*=f; if(hi==0)wsf[r32]=f; resc=true; } } \
    SBAR(); \
    GAPB(o[0]=__builtin_amdgcn_mfma_f32_32x32x16_bf16(PAF(0),VFR(0),o[0],0,0,0), C0,0,cbA[0]); \
    GAPB(o[1]=__builtin_amdgcn_mfma_f32_32x32x16_bf16(PAF(0),VFR(4),o[1],0,0,0), C0,4,cbA[1]); \
    KRD(GL,0); GAPB(o[0]=__builtin_amdgcn_mfma_f32_32x32x16_bf16(PAF(1),VFR(1),o[0],0,0,0), C0,8,cbA[2]); \
    KRD(GL,1); GAPB(o[1]=__builtin_amdgcn_mfma_f32_32x32x16_bf16(PAF(1),VFR(5),o[1],0,0,0), C0,12,cbA[3]); \
    KRD(GL,2); GAPB(o[0]=__builtin_amdgcn_mfma_f32_32x32x16_bf16(PAF(2),VFR(2),o[0],0,0,0), C1,0,cbB[0]); \
    KRD(GL,3); GAPB(o[1]=__builtin_amdgcn_mfma_f32_32x32x16_bf16(PAF(2),VFR(6),o[1],0,0,0), C1,4,cbB[1]); \
    GAPB(o[0]=__builtin_amdgcn_mfma_f32_32x32x16_bf16(PAF(3),VFR(3),o[0],0,0,0), C1,8,cbB[2]); \
    GAPB(o[1]=__builtin_amdgcn_mfma_f32_32x32x16_bf16(PAF(3),VFR(7),o[1],0,0,0), C1,12,cbB[3]); \
    }while(0)
  int t=1;
  #undef CMASK
  #define CMASK(P0,P1,t) do{}while(0)
  for(;t+5<NT;t+=2){
    STEP(pB0,pB1,pA0,pA1,t,true,true,true);     WAIT_BAR(2); RESC(); ROT();
    STEP(pA0,pA1,pB0,pB1,t+1,true,true,true);   WAIT_BAR(2); RESC(); ROT();
  }
  #undef CMASK
  #define CMASK(P0,P1,t) do{int jb_=(t)-(NT-4); if(band&&jb_>=0)cmask(P0,P1,jb_,qrel,hi);}while(0)
  #define ENDW(tt) do{ if((tt)+3<NT){WAIT_BAR(2);} else if((tt)+2<NT){WAIT_BAR(1);} else {WAIT_BAR(0);} }while(0)
  for(;t+1<NT;t+=2){
    STEP(pB0,pB1,pA0,pA1,t,(t+3<NT),(t+1<NT),(t+1<NT));       ENDW(t);   RESC(); ROT();
    STEP(pA0,pA1,pB0,pB1,t+1,(t+4<NT),(t+2<NT),(t+2<NT));     ENDW(t+1); RESC(); ROT();
  }
  STEP(pB0,pB1,pA0,pA1,NT-1,false,false,false); RESC();
  { float sacc=pB0[0]+pB0[1]; _Pragma("unroll") for(int r=2;r<16;++r)sacc+=pB0[r]; _Pragma("unroll") for(int r=0;r<16;++r)sacc+=pB1[r]; l_reg+=sacc;
    pw0=(u32x4){PKW(pB0,0),PKW(pB0,2),PKW(pB0,4),PKW(pB0,6)};pw1=(u32x4){PKW(pB0,8),PKW(pB0,10),PKW(pB0,12),PKW(pB0,14)};pw2=(u32x4){PKW(pB1,0),PKW(pB1,2),PKW(pB1,4),PKW(pB1,6)};pw3=(u32x4){PKW(pB1,8),PKW(pB1,10),PKW(pB1,12),PKW(pB1,14)};
    SBAR(); pv(o,vb0+sl_cur,PAF(0),PAF(1),PAF(2),PAF(3)); }
  #undef PKW
  #undef PAF
  #undef VFR
  #undef PIN
  #undef MX3
  #undef GAPA
  #undef GAPB
  #undef EX
  #undef VRD
  #undef KRD
  #undef STEP
  #undef ENDW
  {auto rr=__builtin_amdgcn_permlane32_swap(__float_as_uint(l_reg),__float_as_uint(l_reg),false,false);l_reg=__uint_as_float(rr[0])+__uint_as_float(rr[1]);}
  if(hi==0)wsf[32+r32]=l_reg;asm volatile("s_waitcnt lgkmcnt(0)":::"memory");
  float rli[16];
  if(split){
    float*Pm=PART+(size_t)part*PART_F; const float*Po=PART+(size_t)(1-part)*PART_F;
    #pragma unroll
    for(int r=0;r<16;++r){
      #pragma unroll
      for(int d0=0;d0<2;++d0)Pm[(wid*QBLK+crow(r,hi))*64+d0*32+r32]=o[d0][r];}
    if(hi==0){Pm[QB*64+(wid*QBLK+r32)*2]=mm+cq;Pm[QB*64+(wid*QBLK+r32)*2+1]=l_reg;wsf[r32]=mm+cq;}
    asm volatile("s_waitcnt vmcnt(0) lgkmcnt(0)\n\ts_barrier":::"memory");
    if(tid==0){ __builtin_amdgcn_fence(__ATOMIC_RELEASE,"agent"); asm volatile("s_waitcnt vmcnt(0)":::"memory");
      *(volatile __attribute__((address_space(3))) unsigned*)((__attribute__((address_space(3))) char*)shm+LDS_OST)=__hip_atomic_fetch_add(flag,1u,__ATOMIC_RELAXED,__HIP_MEMORY_SCOPE_AGENT); }
    asm volatile("s_waitcnt vmcnt(0) lgkmcnt(0)\n\ts_barrier":::"memory");
    const unsigned old=*(volatile __attribute__((address_space(3))) unsigned*)((__attribute__((address_space(3))) char*)shm+LDS_OST);
    asm volatile("s_waitcnt lgkmcnt(0)\n\ts_barrier":::"memory");
    if(old==0u)return;
    __builtin_amdgcn_fence(__ATOMIC_ACQUIRE,"agent"); asm volatile("s_waitcnt vmcnt(0)":::"memory");
    #pragma unroll
    for(int r=0;r<16;++r){ const int row=crow(r,hi); const float mo=wsf[row],lo=wsf[32+row],mt=Po[QB*64+(wid*QBLK+row)*2],lt=Po[QB*64+(wid*QBLK+row)*2+1];
      const float m=__builtin_fmaxf(mo,mt),fo=__builtin_amdgcn_exp2f(mo-m),ft=__builtin_amdgcn_exp2f(mt-m),inv=__builtin_amdgcn_rcpf(lo*fo+lt*ft);
      #pragma unroll
      for(int d0=0;d0<2;++d0)o[d0][r]=(o[d0][r]*fo+Po[(wid*QBLK+row)*64+d0*32+r32]*ft)*inv;
      rli[r]=1.f; }
  } else {
  #pragma unroll
  for(int r=0;r<16;++r)rli[r]=__builtin_amdgcn_rcpf(wsf[32+crow(r,hi)]);
  }
  bf16*Ow=O+(rowbase+q0+wid*QBLK)*OPITCH+h*D;
  { bf16*stg=(bf16*)(shm+LDS_OST)+wid*2048;
    #pragma unroll
    for(int r=0;r<16;++r){const int orow=crow(r,hi);
      #pragma unroll
      for(int d0=0;d0<2;++d0)stg[orow*64+d0*32+r32]=__float2bfloat16(o[d0][r]*rli[r]);}
    asm volatile("s_waitcnt lgkmcnt(0)":::"memory");
    #pragma unroll
    for(int i=0;i<4;++i){const int row=i*8+(lane>>3),ch=lane&7; const u32x4 v=*(const u32x4*)(stg+row*64+ch*8); ATTN_STORE16(Ow+(long)row*OPITCH+ch*8,v);} }
  asm volatile("s_waitcnt lgkmcnt(0)\n\ts_barrier":::"memory");
  #undef CBIAS
  #undef CBLD
  #undef DMA_K
  #undef DMA_V
  #undef CMASK
  #undef START
  #undef RESC
  #undef ROT
}
constexpr int ATTN_LDS_BYTES=LDS_BYTES;
struct AttnTensors { const bf16* Q; const bf16* K; const bf16* V; bf16* O; const float* CF; const float* stat; };
struct AttnUnit { int bh; int qb; };
struct StaticOrder {
  int vcu;
  __device__ __forceinline__ explicit StaticOrder(int grid,int block):vcu((grid%8==0)?(block%8)*(grid/8)+block/8:block),G_(grid){}
  int G_;
  __device__ __forceinline__ bool next(int i,AttnUnit&u)const{ const int v=vcu+(i>>1)*G_; if(v>=256)return false; const int s=v&15; u.bh=v>>4; u.qb=(i&1)?31-s:s; return true; }
  __device__ __forceinline__ void a_ready(const AttnUnit&)const{}
  __device__ __forceinline__ void done(const AttnUnit&)const{}
};
struct QueueOrder {
  unsigned* ctr; __attribute__((address_space(3))) unsigned* slot;
  __device__ __forceinline__ bool next(int,AttnUnit&u)const{
    if(threadIdx.x==0)*slot=__hip_atomic_fetch_add(ctr,1u,__ATOMIC_RELAXED,__HIP_MEMORY_SCOPE_AGENT);
    asm volatile("s_waitcnt vmcnt(0) lgkmcnt(0)\n\ts_barrier":::"memory");
    const unsigned v=*(volatile __attribute__((address_space(3))) unsigned*)slot; const int vv=__builtin_amdgcn_readfirstlane((int)v);
    if(vv>=512)return false; u.qb=31-(vv>>4); u.bh=vv&15; return true; }
  __device__ __forceinline__ void a_ready(const AttnUnit&)const{}
  __device__ __forceinline__ void done(const AttnUnit&)const{}
};
template<class Sched,int THRL=8> __device__ __forceinline__ void attn_phase(char*lds,const AttnTensors&T,const Sched&S){
  AttnUnit u;
  for(int i=0;S.next(i,u);++i){ S.a_ready(u); const float Tsk=40.f+2.f*__builtin_sqrtf(T.stat[u.bh*2]*T.stat[u.bh*2+1])*1.01f+1.f;
    attn_unit<THRL>(u.bh/NHEAD,u.bh%NHEAD,u.qb,T.Q,T.K,T.V,T.O,T.CF+(long)u.bh*SEQ,Tsk,0,nullptr,nullptr,lds); S.done(u); }
}
#undef SBAR
#undef WAIT_BAR
}
#define GAS __attribute__((address_space(1)))
#define LAS __attribute__((address_space(3)))
typedef unsigned v4u __attribute__((ext_vector_type(4)));
typedef float f32x4 __attribute__((ext_vector_type(4)));
typedef short bf16x8 __attribute__((ext_vector_type(8)));
typedef GAS unsigned gu32;
typedef GAS unsigned long long gu64;
#define RLX_AGENT __ATOMIC_RELAXED, __HIP_MEMORY_SCOPE_AGENT
#define LDS_WAIT() asm volatile("s_waitcnt lgkmcnt(0)" ::: "memory")
#define VM_WAIT() asm volatile("s_waitcnt vmcnt(0)" ::: "memory")
__device__ __forceinline__ unsigned long long rt() { return __builtin_amdgcn_s_memrealtime(); }
__device__ __forceinline__ unsigned pk2(float lo, float hi) { return (unsigned)f2bf(lo) | ((unsigned)f2bf(hi) << 16); }

#define XB_TMO      128
#define XB_XCNT(j)  (256  + 64 * (j))
#define XB_XSUB(j)  (1280 + 64 * (j))
#define XB_XGEN(j)  (2304 + 64 * (j))
#define XB_TOP      3328
#define XB_TOPGEN   3392
#define XCD_BAR_WORDS 3456
#define XB_SPIN_CAP (1u << 18)

__device__ __forceinline__ unsigned xb_ld(unsigned* p)              { return __hip_atomic_load(p, __ATOMIC_RELAXED, __HIP_MEMORY_SCOPE_AGENT); }
__device__ __forceinline__ unsigned xb_add(unsigned* p, unsigned v) { return __hip_atomic_fetch_add(p, v, __ATOMIC_RELAXED, __HIP_MEMORY_SCOPE_AGENT); }
__device__ __forceinline__ unsigned xb_xcc_id() { return (unsigned)__builtin_amdgcn_s_getreg((3 << 11) | 20) & 0xFu; }
#define XB_SPIN(cond, bar) do { unsigned _sp = 0; while (cond) { __builtin_amdgcn_s_sleep(1); \
    if ((++_sp & 255u) == 0u) { if (xb_ld(&(bar)[XB_TMO])) break; if (_sp > XB_SPIN_CAP) { atomicAdd(&(bar)[XB_TMO], 1u); break; } } } } while (0)

struct XcdBarrier {
    unsigned* bar; unsigned x;
    volatile LAS unsigned* st;
};

__device__ __forceinline__ XcdBarrier xcd_barrier_post(unsigned* bar, volatile LAS unsigned* st) {
    XcdBarrier b; b.bar = bar; b.x = xb_xcc_id(); b.st = st;
    if (threadIdx.x == 0) (void)xb_add(&bar[XB_XCNT(b.x)], 1u);
    return b;
}
__device__ __forceinline__ void xcd_barrier_complete(unsigned* bar, unsigned x, unsigned& nloc, unsigned& nx) {
    const unsigned G = gridDim.x * gridDim.y * gridDim.z;
    unsigned sum, cnt, mine, sp = 0u;
    for (;;) {
        sum = 0u; cnt = 0u; mine = 0u;
#pragma unroll
        for (unsigned j = 0; j < 16; ++j) { const unsigned c = xb_ld(&bar[XB_XCNT(j)]); sum += c; cnt += (c > 0u) ? 1u : 0u; mine = (j == x) ? c : mine; }
        if (sum == G) break;
        __builtin_amdgcn_s_sleep(1);
        if ((++sp & 255u) == 0u) { if (xb_ld(&bar[XB_TMO])) break; if (sp > XB_SPIN_CAP) { atomicAdd(&bar[XB_TMO], 1u); break; } }
    }
    nloc = mine > 0u ? mine : 1u; nx = cnt > 0u ? cnt : 1u;
}

__device__ __forceinline__ void xcd_barrier(const XcdBarrier& b) {
    asm volatile("s_waitcnt vmcnt(0)" ::: "memory");
    __syncthreads();
    if (threadIdx.x == 0) {
        unsigned* bar = b.bar;
        __builtin_amdgcn_s_waitcnt(0);
        unsigned nloc = b.st[0], nx = b.st[1];
        if (nloc == 0u) { xcd_barrier_complete(bar, b.x, nloc, nx); b.st[0] = nloc; b.st[1] = nx; }
        const unsigned old = xb_add(&bar[XB_XSUB(b.x)], 1u);
        const unsigned gen = old / nloc;
        if (old + 1u == (gen + 1u) * nloc) {
            __builtin_amdgcn_fence(__ATOMIC_RELEASE, "agent");
            asm volatile("s_waitcnt vmcnt(0)" ::: "memory");
            const unsigned og = xb_add(&bar[XB_TOP], 1u);
            const unsigned tg = og / nx;
            if (og + 1u == (tg + 1u) * nx) xb_add(&bar[XB_TOPGEN], 1u);
            else XB_SPIN(xb_ld(&bar[XB_TOPGEN]) == tg, bar);
            __builtin_amdgcn_fence(__ATOMIC_ACQUIRE, "agent");
            xb_add(&bar[XB_XGEN(b.x)], 1u);
            asm volatile("s_waitcnt vmcnt(0)" ::: "memory");
        } else {
            XB_SPIN(xb_ld(&bar[XB_XGEN(b.x)]) == gen, bar);
            __builtin_amdgcn_fence(__ATOMIC_ACQUIRE, "agent");
            asm volatile("s_waitcnt vmcnt(0)" ::: "memory");
        }
    }
    __syncthreads();
}
constexpr int NWAVES = 8, NTHR = 512;
constexpr int RING_OFF = 0, RING_BYTES = 131072, LDSCTL_OFF = RING_BYTES, MISC_OFF = LDSCTL_OFF + 320, LDS_BYTES = 147456;
constexpr int CW_BAR = 4096;
constexpr size_t WS_WSM = 402 * MiB;
constexpr size_t WS_WIN = WS_WSM  , WS_SWIN = WS_WSM + 8 * MiB  , WS_WOUT = WS_WSM + 14 * MiB  , WS_WDGU = WS_WSM + 18 * MiB  , WS_SWDGU = WS_WSM + 24 * MiB  , WS_WDDN = WS_WSM + 29 * MiB  ;
constexpr size_t WS_SH = WS_H + 16 * MiB  , WS_SXG = WS_XG + 34 * MiB  ;
constexpr size_t WS_WMGU = WS_W  , WS_WMDN = 437 * MiB  ;
static_assert(WS_WDDN + 6 * MiB <= WS_WMDN && WS_WMGU + 56 * MiB <= WS_WSM && WS_WMDN + 28 * MiB <= WS_END, "ws");
struct MArgs { const float* in[20]; float* out; unsigned char* ws; int ph_lo, ph_hi; };
enum { I_X = 0, I_ATTN_NORM, I_W_IN, I_HGRN_LB, I_HGRN_NORM, I_MLSTM_CONV, I_MLSTM_BI, I_MLSTM_BF, I_MLSTM_NORM, I_FOX_BF, I_W_OUT, I_FFN_NORM, I_DGATE, I_DUP, I_DDOWN, I_ROUTER, I_MGATE, I_MUP, I_MDOWN, I_FINAL_NORM };

__device__ __forceinline__ void tr_item(const float* W, int ldw, int K, bf16_t* WT, LAS float* scr, int k0, int lane) {
#pragma unroll 32
    for (int i = 0; i < 32; ++i) { const int kk = 2 * i + (lane >> 5); scr[kk * 33 + (lane & 31)] = W[(size_t)(k0 + kk) * ldw + (lane & 31)]; }
    LDS_WAIT(); asm volatile("" ::: "memory");
    const int c = lane & 7;
#pragma unroll
    for (int j = 0; j < 4; ++j) { const int n = (lane >> 3) + 8 * j; const LAS float* s = scr + (8 * c) * 33 + n;
        v4u o; o.x = pk2(s[0 * 33], s[1 * 33]); o.y = pk2(s[2 * 33], s[3 * 33]); o.z = pk2(s[4 * 33], s[5 * 33]); o.w = pk2(s[6 * 33], s[7 * 33]);
        *(GAS v4u*)(WT + (size_t)n * K + k0 + 8 * c) = o; }
    LDS_WAIT(); asm volatile("" ::: "memory");
}
__device__ __forceinline__ int glu_row(int c, int up) { return (c >> 7) * 256 + (c & 127) + up * 128; }
constexpr int MOE_GU_ITEMS = 28672, MOE_ITEMS = 43008, MOE_FILL = 4, MOE_FILL_ITEMS = 128 * NWAVES * MOE_FILL;
__device__ __forceinline__ int moe_prefilled(int G) { return G == 256 ? 3 * MOE_FILL_ITEMS : 0; }
struct F8Item { const float* W; unsigned char* dst; int ldw, K; float sc; };
__device__ __forceinline__ F8Item moe_item(const MArgs& a, unsigned char* ws, int it) {
    const bool gu = it < MOE_GU_ITEMS; const int r0 = gu ? it : it - MOE_GU_ITEMS;
    const int e = gu ? r0 / 3584 : r0 / 1792; int r = gu ? r0 % 3584 : r0 % 1792; const int up = gu ? r / 1792 : 0; if (gu) r %= 1792;
    const int kb = gu ? r / 112 : r / 32, nb = gu ? r % 112 : r % 32, c = 32 * nb, k0 = 64 * kb;
    F8Item I; I.ldw = gu ? FE : D; I.K = gu ? D : FE; I.sc = gu ? pg8::F8_GSCALE : pg8::F8_WSCALE;
    I.W = (gu ? (up ? a.in[I_MUP] : a.in[I_MGATE]) + (size_t)e * D * FE : a.in[I_MDOWN] + (size_t)e * FE * D) + c + (size_t)k0 * I.ldw;
    I.dst = (gu ? (unsigned char*)(ws + WS_WMGU) + (size_t)e * 2 * FE * D + (size_t)glu_row(c, up) * D : (unsigned char*)(ws + WS_WMDN) + (size_t)e * D * FE + (size_t)c * FE) + k0;
    return I;
}
__device__ __forceinline__ void f8_load(float (&v)[32], const F8Item& I, int lane) {
    const float* p = I.W + (size_t)(lane >> 5) * I.ldw + (lane & 31);
#pragma unroll
    for (int i = 0; i < 32; ++i) v[i] = p[(size_t)(2 * i) * I.ldw];
}
__device__ __forceinline__ void f8_stage(const float (&v)[32], LAS float* scr, int lane) {
#pragma unroll
    for (int i = 0; i < 32; ++i) scr[(2 * i + (lane >> 5)) * 33 + (lane & 31)] = v[i];
}
__device__ __forceinline__ void f8_out(const F8Item& I, LAS float* scr, int lane) {
    LDS_WAIT(); asm volatile("" ::: "memory");
    const int c = lane & 7;
#pragma unroll
    for (int j = 0; j < 4; ++j) { const int n = (lane >> 3) + 8 * j; const LAS float* s = scr + (8 * c) * 33 + n; float h[8];
#pragma unroll
        for (int i = 0; i < 8; ++i) h[i] = __builtin_fminf(__builtin_fmaxf(s[i * 33] * I.sc, -448.f), 448.f);
        unsigned w0 = 0u, w1 = 0u; w0 = __builtin_amdgcn_cvt_pk_fp8_f32(h[0], h[1], w0, false); w0 = __builtin_amdgcn_cvt_pk_fp8_f32(h[2], h[3], w0, true);
        w1 = __builtin_amdgcn_cvt_pk_fp8_f32(h[4], h[5], w1, false); w1 = __builtin_amdgcn_cvt_pk_fp8_f32(h[6], h[7], w1, true);
        typedef unsigned u32x2_ __attribute__((ext_vector_type(2))); *(GAS u32x2_*)(I.dst + (size_t)n * I.K + 8 * c) = (u32x2_){w0, w1}; }
    LDS_WAIT(); asm volatile("" ::: "memory");
}
__device__ __forceinline__ void moe_conv_range(const MArgs& a, unsigned char* ws, LAS float* scr, int first, int step, int end, int lane) {
    float v[32]; int it = first; F8Item cur;
    if (it < end) { cur = moe_item(a, ws, it); f8_load(v, cur, lane); }
#pragma unroll 1
    for (; it < end; it += step) {
        f8_stage(v, scr, lane);
        F8Item nxt = cur; const int nx = it + step;
        if (nx < end) { nxt = moe_item(a, ws, nx); f8_load(v, nxt, lane); }
        f8_out(cur, scr, lane); cur = nxt;
    }
}
constexpr int MOE_FILL17 = 3;
__device__ __forceinline__ int moe_tail_idle(const int* cnt, int G) { int acc = 0;
#pragma unroll
    for (int e = 0; e < NE; ++e) acc += (cnt[e] + 255) >> 8;
    const int r = (acc * (2 * FE / 256)) % 256; return (G == 256 && r) ? 256 - r : 0; }
__device__ __forceinline__ void moe_fill(const MArgs& a, unsigned char* ws, LAS float* scr, int slot, int G, int bx, int wave, int lane) {
    if (G != 256 || bx < 128) return;
    const int first = slot * MOE_FILL_ITEMS + (bx - 128) * NWAVES + wave;
    moe_conv_range(a, ws, scr, first, 128 * NWAVES, first + MOE_FILL * 128 * NWAVES, lane);
}
struct RowIn { float4 v[4]; };
template <bool BF> __device__ __forceinline__ void mrow_load(RowIn& R, const void* src, int row, int lane) {
    if (BF) { const uint2* xr = (const uint2*)((const bf16_t*)src + (size_t)row * D) + lane;
#pragma unroll
        for (int j = 0; j < 4; ++j) { const uint2 w = xr[64 * j]; R.v[j] = make_float4(__uint_as_float(w.x << 16), __uint_as_float(w.x & 0xffff0000u), __uint_as_float(w.y << 16), __uint_as_float(w.y & 0xffff0000u)); } }
    else { const float4* xr = (const float4*)((const float*)src + (size_t)row * D) + lane;
#pragma unroll
        for (int j = 0; j < 4; ++j) R.v[j] = xr[64 * j]; } }
template <int MODE> __device__ __forceinline__ void mrow(const RowIn& R, signed char* H8, float* SH, const float* gain, const LAS float* tab, float* G, int row, int lane, float (&lg)[8]) {
    float4 v[4]; float ss = 0.f;
#pragma unroll
    for (int j = 0; j < 4; ++j) { v[j] = R.v[j]; ss += v[j].x * v[j].x + v[j].y * v[j].y + v[j].z * v[j].z + v[j].w * v[j].w; }
    ss = wave_sum(ss);
    const float r = rsqrtf(ss * (1.f / D) + EPS);
    float h[16];
#pragma unroll
    for (int j = 0; j < 4; ++j) { const float4 g = *((const float4*)gain + 64 * j + lane);
        h[4 * j + 0] = v[j].x * r * g.x; h[4 * j + 1] = v[j].y * r * g.y; h[4 * j + 2] = v[j].z * r * g.z; h[4 * j + 3] = v[j].w * r * g.w; }
    if (MODE == 2) {
#pragma unroll
      for (int j = 0; j < 4; ++j) { float q[4];
#pragma unroll
          for (int i = 0; i < 4; ++i) q[i] = __builtin_fminf(__builtin_fmaxf(h[4 * j + i] * pg8::F8_ASCALE, -448.f), 448.f);
          unsigned w = 0u; w = __builtin_amdgcn_cvt_pk_fp8_f32(q[0], q[1], w, false); w = __builtin_amdgcn_cvt_pk_fp8_f32(q[2], q[3], w, true);
          *((unsigned*)(H8 + (size_t)row * D) + 64 * j + lane) = w; }
    } else
    { float am = 0.f;
#pragma unroll
      for (int i = 0; i < 16; ++i) am = fmaxf(am, fabsf(h[i]));
      am = wave_max_nn(am);
      const float inv = am > 0.f ? 127.f / am : 0.f;
#pragma unroll
      for (int j = 0; j < 4; ++j) { const int q0 = (int)rintf(h[4 * j] * inv), q1 = (int)rintf(h[4 * j + 1] * inv), q2 = (int)rintf(h[4 * j + 2] * inv), q3 = (int)rintf(h[4 * j + 3] * inv);
          *((unsigned*)(H8 + (size_t)row * D) + 64 * j + lane) = (unsigned)(q0 & 255) | ((unsigned)(q1 & 255) << 8) | ((unsigned)(q2 & 255) << 16) | ((unsigned)(q3 & 255) << 24); }
      if (lane == 0) SH[row] = am > 0.f ? am * (1.f / 127.f) : 1.f; }
    if (MODE == 0) {
        float pa[16];
#pragma unroll
        for (int c = 0; c < 16; ++c) { float s = 0.f;
#pragma unroll
            for (int j = 0; j < 4; ++j) { const f32x4 w = *(const LAS f32x4*)(tab + c * 1024 + 256 * j + 4 * lane); s += h[4 * j] * w[0] + h[4 * j + 1] * w[1] + h[4 * j + 2] * w[2] + h[4 * j + 3] * w[3]; }
            pa[c] = s; }
#pragma unroll
        for (int c = 0; c < 8; ++c) { const bool up = (lane & 32) != 0; const float send = up ? pa[c] : pa[c + 8], keep = up ? pa[c + 8] : pa[c]; pa[c] = keep + __shfl_xor(send, 32); }
#pragma unroll
        for (int c = 0; c < 4; ++c) { const bool up = (lane & 16) != 0; const float send = up ? pa[c] : pa[c + 4], keep = up ? pa[c + 4] : pa[c]; pa[c] = keep + __shfl_xor(send, 16); }
#pragma unroll
        for (int c = 0; c < 2; ++c) { const bool up = (lane & 8) != 0; const float send = up ? pa[c] : pa[c + 2], keep = up ? pa[c + 2] : pa[c]; pa[c] = keep + __shfl_xor(send, 8); }
        { const bool up = (lane & 4) != 0; const float send = up ? pa[0] : pa[1], keep = up ? pa[1] : pa[0]; pa[0] = keep + __shfl_xor(send, 4); }
        pa[0] += __shfl_xor(pa[0], 2); pa[0] += __shfl_xor(pa[0], 1);
        if ((lane & 3) == 0) G[(size_t)row * GW + 8 * ((lane >> 5) & 1) + 4 * ((lane >> 4) & 1) + 2 * ((lane >> 3) & 1) + ((lane >> 2) & 1)] = pa[0];
    }
    if (MODE == 2) {
        float pa[8];
#pragma unroll
        for (int c = 0; c < 8; ++c) { float s = 0.f;
#pragma unroll
            for (int j = 0; j < 4; ++j) { const f32x4 w = *(const LAS f32x4*)(tab + c * 1024 + 256 * j + 4 * lane); s += h[4 * j] * w[0] + h[4 * j + 1] * w[1] + h[4 * j + 2] * w[2] + h[4 * j + 3] * w[3]; }
            pa[c] = s; }
#pragma unroll
        for (int c = 0; c < 4; ++c) { const bool up = (lane & 32) != 0; const float send = up ? pa[c] : pa[c + 4], keep = up ? pa[c + 4] : pa[c]; pa[c] = keep + __shfl_xor(send, 32); }
#pragma unroll
        for (int c = 0; c < 2; ++c) { const bool up = (lane & 16) != 0; const float send = up ? pa[c] : pa[c + 2], keep = up ? pa[c + 2] : pa[c]; pa[c] = keep + __shfl_xor(send, 16); }
        { const bool up = (lane & 8) != 0; const float send = up ? pa[0] : pa[1], keep = up ? pa[1] : pa[0]; pa[0] = keep + __shfl_xor(send, 8); }
        pa[0] += __shfl_xor(pa[0], 4); pa[0] += __shfl_xor(pa[0], 2); pa[0] += __shfl_xor(pa[0], 1);
        float v0 = -INFINITY, v1 = -INFINITY; int e0 = 0, e1 = 0;
#pragma unroll
        for (int c = 0; c < 8; ++c) { const float sv = __shfl(pa[0], 8 * c);
            if (sv > v0) { v1 = v0; e1 = e0; v0 = sv; e0 = c; } else if (sv > v1) { v1 = sv; e1 = c; } }
        lg[0] = v0; lg[1] = v1; lg[2] = __int_as_float(e0); lg[3] = __int_as_float(e1);
    }
}
__device__ __forceinline__ void load_gate_tab(LAS float* tab, const float* w_in, int tid) {
    for (int k = tid; k < D; k += NTHR) { const float4* w0 = (const float4*)(w_in + (size_t)k * DIN + 1792); const float4* w1 = (const float4*)(w_in + (size_t)k * DIN + 3592);
        const float4 a0 = w0[0], a1 = w0[1], b0 = w1[0], b1 = w1[1];
        tab[0 * 1024 + k] = a0.x; tab[1 * 1024 + k] = a0.y; tab[2 * 1024 + k] = a0.z; tab[3 * 1024 + k] = a0.w; tab[4 * 1024 + k] = a1.x; tab[5 * 1024 + k] = a1.y; tab[6 * 1024 + k] = a1.z; tab[7 * 1024 + k] = a1.w;
        tab[8 * 1024 + k] = b0.x; tab[9 * 1024 + k] = b0.y; tab[10 * 1024 + k] = b0.z; tab[11 * 1024 + k] = b0.w; tab[12 * 1024 + k] = b1.x; tab[13 * 1024 + k] = b1.y; tab[14 * 1024 + k] = b1.z; tab[15 * 1024 + k] = b1.w; }
}
__device__ __forceinline__ void load_router_tab(LAS float* tab, const float* router, int tid) {
    for (int k = tid; k < D; k += NTHR) { const float4* w0 = (const float4*)(router + (size_t)k * NE); const float4 a0 = w0[0], a1 = w0[1];
        tab[0 * 1024 + k] = a0.x; tab[1 * 1024 + k] = a0.y; tab[2 * 1024 + k] = a0.z; tab[3 * 1024 + k] = a0.w; tab[4 * 1024 + k] = a1.x; tab[5 * 1024 + k] = a1.y; tab[6 * 1024 + k] = a1.z; tab[7 * 1024 + k] = a1.w; }
}
struct Conv8Job { const float* W; int ldw; signed char* WT8; float* S; };
__device__ __forceinline__ void conv8_load(float (&v)[64], const Conv8Job& j, int tid, int wave) {
    const int lane = tid & 63, n = lane & 31, kp = lane >> 5;
#pragma unroll
    for (int i = 0; i < 64; ++i) v[i] = j.W[(size_t)(128 * wave + 2 * i + kp) * j.ldw + n];
}
__device__ __forceinline__ void conv8_stage(const float (&v)[64], LAS float* img, LAS float* pm, int tid, int wave) {
    const int lane = tid & 63, n = lane & 31, kp = lane >> 5; float m = 0.f;
#pragma unroll
    for (int i = 0; i < 64; ++i) { img[(128 * wave + 2 * i + kp) * 32 + n] = v[i]; m = fmaxf(m, fabsf(v[i])); }
    m = fmaxf(m, __shfl_xor(m, 32));
    if (lane < 32) pm[wave * 32 + lane] = m;
    __syncthreads();
}
__device__ __forceinline__ void conv8_quant(const Conv8Job& j, LAS float* img, LAS float* pm, int tid, int wave) {
    const int lane = tid & 63, no = lane >> 1, kh = 128 * wave + 64 * (lane & 1);
    float cm = 0.f;
#pragma unroll
    for (int w = 0; w < 8; ++w) cm = fmaxf(cm, pm[w * 32 + no]);
    const float inv = cm > 0.f ? 127.f / cm : 0.f;
    if (wave == 0 && (lane & 1) == 0) j.S[no] = cm > 0.f ? cm * (1.f / 127.f) : 1.f;
    const LAS float* sp = img + kh * 32 + no;
#pragma unroll
    for (int q = 0; q < 4; ++q) { unsigned wq[4];
#pragma unroll
        for (int jj = 0; jj < 4; ++jj) { const int kk = 16 * q + 4 * jj; const int q0 = (int)rintf(sp[kk * 32] * inv), q1 = (int)rintf(sp[(kk + 1) * 32] * inv), q2 = (int)rintf(sp[(kk + 2) * 32] * inv), q3 = (int)rintf(sp[(kk + 3) * 32] * inv);
            wq[jj] = (unsigned)(q0 & 255) | ((unsigned)(q1 & 255) << 8) | ((unsigned)(q2 & 255) << 16) | ((unsigned)(q3 & 255) << 24); }
        v4u o; o.x = wq[0]; o.y = wq[1]; o.z = wq[2]; o.w = wq[3];
        *(GAS v4u*)(j.WT8 + (size_t)no * 1024 + kh + 16 * q) = o; }
    __syncthreads();
}
namespace scan {
typedef short bf16x8 __attribute__((ext_vector_type(8)));
typedef float f32x4 __attribute__((ext_vector_type(4)));
typedef unsigned v2u __attribute__((ext_vector_type(2)));
constexpr int TS = 144, TB = 64 * TS;
constexpr int L_T0 = 0, L_T1 = TB, L_T2 = 2 * TB, L_T3 = 3 * TB, L_T4 = 4 * TB, L_T5 = 5 * TB, L_O = 6 * TB, OS = 68  , L_PART = L_O + 64 * OS * 4, L_VEC = L_PART + 8 * 64 * 4, L_END = L_VEC + 8 * 64 * 4;
static_assert(L_END <= RING_BYTES, "scan LDS");
constexpr size_t SC_LHG = 0, SC_LML = 16 * MiB, SC_DEC = 32 * MiB  , SC_NL = 32 * MiB + 256 * 1024  , SC_AMAX = 32 * MiB + 512 * 1024, SC_BEND = SC_AMAX + 4096, SC_MPREV = SC_BEND + 4096;

__device__ __forceinline__ float wave_incl_add(float v, int) {
    v += DPP_F(0.f, v, 0x111, 0xf); v += DPP_F(0.f, v, 0x112, 0xf); v += DPP_F(0.f, v, 0x114, 0xf); v += DPP_F(0.f, v, 0x118, 0xf);
    v += DPP_F(0.f, v, 0x142, 0xa); v += DPP_F(0.f, v, 0x143, 0xc);
    return v;
}
__device__ __forceinline__ float wave_incl_max(float v, int) {
    const float NI = -INFINITY;
    v = fmaxf(v, DPP_F(NI, v, 0x111, 0xf)); v = fmaxf(v, DPP_F(NI, v, 0x112, 0xf)); v = fmaxf(v, DPP_F(NI, v, 0x114, 0xf)); v = fmaxf(v, DPP_F(NI, v, 0x118, 0xf));
    v = fmaxf(v, DPP_F(NI, v, 0x142, 0xa)); v = fmaxf(v, DPP_F(NI, v, 0x143, 0xc));
    return v;
}
__device__ __forceinline__ float wave_max(float v) { return __int_as_float(__builtin_amdgcn_readlane(__float_as_int(wave_incl_max(v, 0)), 63)); }
__device__ __forceinline__ float lane_bcast(float v, int uniform_lane) { return __int_as_float(__builtin_amdgcn_readlane(__float_as_int(v), uniform_lane)); }
__device__ __forceinline__ f32x4 mma64(LAS const unsigned char* A, LAS const unsigned char* B, int m0, int n0, int lane, f32x4 acc) {
    const int r = lane & 15, kq = lane >> 4;
#pragma unroll
    for (int ks = 0; ks < 2; ++ks) {
        const bf16x8 a = *(LAS const bf16x8*)(A + (m0 + r) * TS + kq * 16 + ks * 64);
        const bf16x8 b = *(LAS const bf16x8*)(B + (n0 + r) * TS + kq * 16 + ks * 64);
        acc = __builtin_amdgcn_mfma_f32_16x16x32_bf16(a, b, acc, 0, 0, 0);
    }
    return acc;
}
__device__ __forceinline__ v4u pack8(const float (&v)[8]) { v4u w; w.x = pk2(v[0], v[1]); w.y = pk2(v[2], v[3]); w.z = pk2(v[4], v[5]); w.w = pk2(v[6], v[7]); return w; }
__device__ __forceinline__ v4u pack8h(const bf16_t (&v)[8]) { v4u w; w.x = v[0] | ((unsigned)v[1] << 16); w.y = v[2] | ((unsigned)v[3] << 16); w.z = v[4] | ((unsigned)v[5] << 16); w.w = v[6] | ((unsigned)v[7] << 16); return w; }
__device__ __forceinline__ void st16(LAS unsigned char* p, float v) { *(LAS bf16_t*)p = f2bf(v); }
__device__ __forceinline__ void load_state_tile(LAS unsigned char* T, const float* S, int tid) {
    const int v = tid >> 3, d0 = (tid & 7) * 8; const float4 x0 = *(const float4*)(S + v * 64 + d0), x1 = *(const float4*)(S + v * 64 + d0 + 4);
    v4u w; w.x = pk2(x0.x, x0.y); w.y = pk2(x0.z, x0.w); w.z = pk2(x1.x, x1.y); w.w = pk2(x1.z, x1.w);
    *(LAS v4u*)(T + v * TS + d0 * 2) = w;
}
typedef short s16x2 __attribute__((ext_vector_type(2)));
constexpr int IW = 4, TK = 64 / IW, CPT = 64 / IW, TPW = 16 / IW;
constexpr int HLDS = 6 * TB + 4096;
constexpr int H_O = L_T0, H_PART = 6 * TB, H_VEC = 6 * TB + 2048;
static_assert(2 * HLDS <= RING_BYTES && 64 * OS * 4 <= 2 * TB, "scan LDS (two halves)");
__device__ __forceinline__ void pack16w(LAS unsigned char* dst, const float (&v)[TK]) {
    v4u w0, w1; w0.x = pk2(v[0], v[1]); w0.y = pk2(v[2], v[3]); w0.z = pk2(v[4], v[5]); w0.w = pk2(v[6], v[7]); w1.x = pk2(v[8], v[9]); w1.y = pk2(v[10], v[11]); w1.z = pk2(v[12], v[13]); w1.w = pk2(v[14], v[15]);
    *(LAS v4u*)dst = w0; *(LAS v4u*)(dst + 16) = w1; }
__device__ __forceinline__ void pack16h(LAS unsigned char* dst, const s16x2 (&v)[TK / 2]) {
    v4u w0, w1; w0.x = __builtin_bit_cast(unsigned, v[0]); w0.y = __builtin_bit_cast(unsigned, v[1]); w0.z = __builtin_bit_cast(unsigned, v[2]); w0.w = __builtin_bit_cast(unsigned, v[3]);
    w1.x = __builtin_bit_cast(unsigned, v[4]); w1.y = __builtin_bit_cast(unsigned, v[5]); w1.z = __builtin_bit_cast(unsigned, v[6]); w1.w = __builtin_bit_cast(unsigned, v[7]);
    *(LAS v4u*)dst = w0; *(LAS v4u*)(dst + 16) = w1; }
__device__ __forceinline__ void local_state_mma_store(LAS unsigned char* Lh, float* LT, int tq, int lane) {
#pragma unroll
    for (int nn = 0; nn < TPW; ++nn) { const int ti = tq * TPW + nn, mt = ti >> 2, nt = ti & 3; f32x4 acc = {0.f, 0.f, 0.f, 0.f};
        acc = mma64(Lh + L_T1, Lh + L_T0, mt * 16, nt * 16, lane, acc);
#pragma unroll
        for (int r = 0; r < 4; ++r) LT[(mt * 16 + 4 * (lane >> 4) + r) * 64 + nt * 16 + (lane & 15)] = acc[r]; }
}
__device__ __forceinline__ float sigmoid_fast(float z) { return __builtin_amdgcn_rcpf(1.f + __builtin_amdgcn_exp2f(-1.4426950408889634f * z)); }
__device__ __forceinline__ float silu_fast(float z) { return z * sigmoid_fast(z); }
__device__ __forceinline__ void hgrn_gate(float lb, float z, float& sg, float& omsg, float& lf) {
    const float e = __builtin_amdgcn_exp2f(-1.4426950408889634f * fabsf(z)), ope = 1.f + e, r = __builtin_amdgcn_rcpf(ope), er = e * r; const bool pos = z >= 0.f;
    sg = pos ? r : er; omsg = pos ? er : r;
    lf = lb > 0.f ? __logf(lb + (1.f - lb) * sg) : (fminf(z, 0.f) - __logf(ope)); }
#define BFP(arr, i) bf2f((bf16_t)(arr)[(i) >> 1][(i) & 1])
struct HgIn { s16x2 fz[TK / 2], q[TK / 2], iv[TK / 2]; v4u gate[2]; float4 s[4]; };
template <bool DPH> __device__ __forceinline__ void hgrn_load(HgIn& R, const bf16_t* P, int b, int c, int h, const float* ST, int tl, int tq) {
    const int d = tl & 63, row0 = b * SEQ + c * 64; const bf16_t* pr = P + (size_t)(row0 + TK * tq) * PW + h * 64 + d;
#pragma unroll
    for (int i = 0; i < TK; ++i) { R.fz[i >> 1][i & 1] = (short)pr[(size_t)i * PW + P_HF]; R.iv[i >> 1][i & 1] = (short)pr[(size_t)i * PW + P_HI]; if (DPH) R.q[i >> 1][i & 1] = (short)pr[(size_t)i * PW + P_HQ]; }
    if (DPH) { const int t = tl / IW, v0 = (tl % IW) * CPT; const v4u* gp = (const v4u*)(P + (size_t)(row0 + t) * PW + P_HG + h * 64 + v0); R.gate[0] = gp[0]; R.gate[1] = gp[1];
#pragma unroll
        for (int j = 0; j < 4; ++j) R.s[j] = *(const float4*)(ST + t * 64 + v0 + 4 * j); }
}
struct MlIn { s16x2 qr[(TK + 4) / 2], kr[(TK + 4) / 2], vv[TK / 2]; float ig, fg, np, mprev; v4u gate[2]; float4 s[4]; };
template <bool DPH> __device__ __forceinline__ void mlstm_load(MlIn& R, const bf16_t* P, const float* G, int b, int c, int h, const float* CT, const float* NP, const float* MP, int tl, int tq) {
    const int d = tl & 63, lane = tl & 63, row0 = b * SEQ + c * 64; const bool fz3 = (c == 0 && tq == 0);
    const bf16_t* pk = P + (size_t)(row0 + TK * tq) * PW + P_MK + h * 64 + d; const bf16_t* pq = P + (size_t)(row0 + TK * tq) * PW + P_MQ + h * 64 + d;
#pragma unroll
    for (int j = 0; j < TK + 3; ++j) { R.kr[j >> 1][j & 1] = (j < 3 && fz3) ? (short)0 : (short)pk[((long)j - 3) * PW]; if (DPH) R.qr[j >> 1][j & 1] = (j < 3 && fz3) ? (short)0 : (short)pq[((long)j - 3) * PW]; }
#pragma unroll
    for (int i = 0; i < TK; ++i) R.vv[i >> 1][i & 1] = (short)P[(size_t)(row0 + TK * tq + i) * PW + P_MV + h * 64 + d];
    R.ig = G[(size_t)(row0 + lane) * GW + h]; R.fg = G[(size_t)(row0 + lane) * GW + 4 + h];
    if (DPH) { const int t = tl / IW, v0 = (tl % IW) * CPT; const v4u* gp = (const v4u*)(P + (size_t)(row0 + t) * PW + P_MO + h * 64 + v0); R.gate[0] = gp[0]; R.gate[1] = gp[1];
#pragma unroll
        for (int j = 0; j < 4; ++j) R.s[j] = *(const float4*)(CT + t * 64 + v0 + 4 * j);
        R.np = NP[lane]; R.mprev = MP[0]; }
}
__device__ __forceinline__ void store_state_tile(LAS unsigned char* T, const float4 (&x)[4], int tl) {
    const int v = tl / IW, d0 = (tl % IW) * CPT; v4u w0, w1; w0.x = pk2(x[0].x, x[0].y); w0.y = pk2(x[0].z, x[0].w); w0.z = pk2(x[1].x, x[1].y); w0.w = pk2(x[1].z, x[1].w);
    w1.x = pk2(x[2].x, x[2].y); w1.y = pk2(x[2].z, x[2].w); w1.z = pk2(x[3].x, x[3].y); w1.w = pk2(x[3].z, x[3].w);
    *(LAS v4u*)(T + v * TS + d0 * 2) = w0; *(LAS v4u*)(T + v * TS + d0 * 2 + 16) = w1;
}
__device__ __forceinline__ void conv_silu_r(const s16x2 (&raw)[(TK + 4) / 2], const float* w4  , float scale, float (&out)[TK]) {
    const float w0 = w4[0], w1 = w4[512], w2 = w4[1024], w3 = w4[1536];
#pragma unroll
    for (int i = 0; i < TK; ++i) out[i] = silu_fast(w0 * BFP(raw, i) + w1 * BFP(raw, i + 1) + w2 * BFP(raw, i + 2) + w3 * BFP(raw, i + 3)) * scale;
}
__device__ __forceinline__ void hgrn_b_item(LAS unsigned char* Lh, const HgIn& R, float lb, float* LT, float* DEC, int tl, int tq) {
    const int d = tl & 63;
    float bl[TK], kh[TK]; float run = 0.f;
#pragma unroll
    for (int i = 0; i < TK; ++i) { const float fz = BFP(R.fz, i);
        float sg, omsg, lf; hgrn_gate(lb, fz, sg, omsg, lf); kh[i] = (1.f - lb) * omsg; run += lf; bl[i] = run; }
    LAS float* part = (LAS float*)(Lh + H_PART);
    part[tq * 64 + d] = run; __syncthreads();
    float off = 0.f, btot = 0.f;
#pragma unroll
    for (int w = 0; w < IW; ++w) { const float pv = part[w * 64 + d]; btot += pv; if (w < tq) off += pv; }
#pragma unroll
    for (int i = 0; i < TK; ++i) kh[i] *= __expf(btot - (off + bl[i]));
    pack16w(Lh + L_T0 + d * TS + tq * (2 * TK), kh);
    pack16h(Lh + L_T1 + d * TS + tq * (2 * TK), R.iv);
    if (tq == 0) DEC[d] = __expf(btot);
    __syncthreads();
    local_state_mma_store(Lh, LT, tq, tl & 63);
    __syncthreads();
}
__device__ __forceinline__ void mlstm_gates(float ig, float fg, const float* b_i, const float* b_f, int h, int lane, float& bcum, float& a) {
    const float z = fg + b_f[h]; bcum = wave_incl_add(fminf(z, 0.f) - __logf(1.f + __builtin_amdgcn_exp2f(-1.4426950408889634f * fabsf(z))), lane); a = ig + b_i[h] - bcum;
}
__device__ __forceinline__ void mlstm_b_item(LAS unsigned char* Lh, const MlIn& R, const float* conv, const float* b_i, const float* b_f, int h, float* LT, float* NL, float* AMAX, float* BEND, int tl, int tq) {
    const int d = tl & 63, lane = tl & 63;
    float bcum, a; mlstm_gates(R.ig, R.fg, b_i, b_f, h, lane, bcum, a);
    const float A = wave_max(a), bend = lane_bcast(bcum, 63);
    float kh[TK]; conv_silu_r(R.kr, conv + 256 + h * 64 + d, 0.125f, kh);
    float nsum = 0.f;
#pragma unroll
    for (int i = 0; i < TK; ++i) { kh[i] *= __expf(lane_bcast(a, TK * tq + i) - A); nsum += bf2f(f2bf(kh[i])); }
    pack16w(Lh + L_T0 + d * TS + tq * (2 * TK), kh);
    pack16h(Lh + L_T1 + d * TS + tq * (2 * TK), R.vv);
    LAS float* part = (LAS float*)(Lh + H_PART); part[tq * 64 + d] = nsum;
    __syncthreads();
    if (tq == 0) { float s = 0.f;
#pragma unroll
        for (int w = 0; w < IW; ++w) s += part[w * 64 + d];
        NL[d] = s; if (lane == 0) { AMAX[0] = A; BEND[0] = bend; } }
    local_state_mma_store(Lh, LT, tq, lane);
    __syncthreads();
}
__device__ __forceinline__ void fox_cumsum_item(LAS unsigned char* L, const float* G, const float* fox_bf, float* CF, int bh, int tid, int wave) {
    const int b = bh >> 3, h = bh & 7, lane = tid & 63; const float bf = fox_bf[h];
    float loc[16]; float s = 0.f;
#pragma unroll
    for (int i = 0; i < 16; ++i) { s += log_sigmoidf_(G[((size_t)b * SEQ + tid * 16 + i) * GW + 8 + h] + bf); loc[i] = s; }
    const float incl = wave_incl_add(s, lane);
    LAS float* wt = (LAS float*)(L + L_PART);
    if (lane == 63) wt[wave] = incl;
    __syncthreads();
    float off = incl - s;
#pragma unroll
    for (int w = 0; w < 8; ++w) if (w < wave) off += wt[w];
#pragma unroll
    for (int i = 0; i < 16; ++i) CF[(size_t)bh * SEQ + tid * 16 + i] = (off + loc[i]) * LOG2E;
    __syncthreads();
}

template <bool DUMMY = false> __device__ __forceinline__ void scan_c_block(unsigned char* sc, int j, int tid) {
    constexpr size_t DOFF = DUMMY ? 104 * MiB / 4 : 0;
    constexpr int CB = 32;
    if (j < 128) {
        if (tid < 256) { const int chain = j >> 4, e = (j & 15) * 256 + tid, b = chain >> 2, h = chain & 3;
            float* p = (float*)(sc + SC_LHG) + ((size_t)(b * 128) * 4 + h) * 4096 + e; const float* dp = (const float*)(sc + SC_DEC) + ((size_t)(b * 128) * 4 + h) * 64 + (e & 63);
            float S = 0.f;
            for (int c0 = 0; c0 < 128; c0 += CB) { float Lc[CB], dc[CB];
#pragma unroll
                for (int i = 0; i < CB; ++i) { Lc[i] = p[(size_t)(c0 + i) * 4 * 4096]; dc[i] = dp[(size_t)(c0 + i) * 4 * 64]; }
#pragma unroll
                for (int i = 0; i < CB; ++i) { const float So = S; S = dc[i] * S + Lc[i]; Lc[i] = So; }
#pragma unroll
                for (int i = 0; i < CB; ++i) (p + DOFF)[(size_t)(c0 + i) * 4 * 4096] = Lc[i]; } }
    } else {
        const int jj = j - 128, chain = jj >> 4, part = jj & 15, b = chain >> 2, h = chain & 3;
        if (tid < 260) { const bool isn = tid >= 256; const size_t it0 = (size_t)(b * 128) * 4 + h;
            float* p = isn ? (float*)(sc + SC_NL) + it0 * 64 + part * 4 + (tid - 256) : (float*)(sc + SC_LML) + it0 * 4096 + part * 256 + tid;
            const size_t stride = isn ? 4 * 64 : 4 * 4096;
            const float* am = (const float*)(sc + SC_AMAX) + it0; const float* be = (const float*)(sc + SC_BEND) + it0; float* mp = (float*)(sc + SC_MPREV) + it0;
            const bool writer = (part == 0 && tid == 0);
            float S = 0.f, m = 0.f;
            for (int c0 = 0; c0 < 128; c0 += CB) { float Lc[CB], A[CB], bb[CB];
#pragma unroll
                for (int i = 0; i < CB; ++i) { Lc[i] = p[(size_t)(c0 + i) * stride]; A[i] = am[(c0 + i) * 4]; bb[i] = be[(c0 + i) * 4]; }
#pragma unroll
                for (int i = 0; i < CB; ++i) { const float Mx = fmaxf(m, A[i]), So = S; S = __expf(m - Mx) * S + __expf(A[i] - Mx) * Lc[i]; Lc[i] = So; A[i] = m; m = bb[i] + Mx; }
#pragma unroll
                for (int i = 0; i < CB; ++i) { (p + DOFF)[(size_t)(c0 + i) * stride] = Lc[i]; if (writer) (mp + DOFF)[(c0 + i) * 4] = A[i]; } } }
    }
}

template <bool SIG> __device__ __forceinline__ void head_epilogue(LAS unsigned char* Lh, float inv, const v4u (&gw)[2]  , const float* gain  , bf16_t* out  , int tl) {
    const int t = tl / IW, v0 = (tl % IW) * CPT; const LAS float* o = (const LAS float*)(Lh + H_O) + t * OS + v0;
    float x[CPT]; float ss = 0.f;
#pragma unroll
    for (int i = 0; i < CPT; ++i) { x[i] = o[i] * inv; ss += x[i] * x[i]; }
#pragma unroll
    for (int m = 1; m < IW; m <<= 1) ss += __shfl_xor(ss, m);
    const float r = rsqrtf(ss * (1.f / 64.f) + EPS);
    const unsigned gu[8] = {gw[0].x, gw[0].y, gw[0].z, gw[0].w, gw[1].x, gw[1].y, gw[1].z, gw[1].w};
    float y[CPT];
#pragma unroll
    for (int i = 0; i < CPT; ++i) { const float gz = bf2f((bf16_t)((gu[i >> 1] >> (16 * (i & 1))) & 0xffff)); y[i] = x[i] * r * gain[i] * (SIG ? sigmoid_fast(gz) : silu_fast(gz)); }
    v4u w0, w1; w0.x = pk2(y[0], y[1]); w0.y = pk2(y[2], y[3]); w0.z = pk2(y[4], y[5]); w0.w = pk2(y[6], y[7]); w1.x = pk2(y[8], y[9]); w1.y = pk2(y[10], y[11]); w1.z = pk2(y[12], y[13]); w1.w = pk2(y[14], y[15]);
    *(v4u*)out = w0; *((v4u*)out + 1) = w1;
}
__device__ __forceinline__ void store_o_tiles(LAS unsigned char* Lh, LAS const unsigned char* A1, LAS const unsigned char* B1, LAS const unsigned char* A2, LAS const unsigned char* B2, int tq, int lane) {
#pragma unroll
    for (int nn = 0; nn < TPW; ++nn) { const int ti = tq * TPW + nn, mt = ti >> 2, nt = ti & 3; f32x4 acc = {0.f, 0.f, 0.f, 0.f};
        acc = mma64(A1, B1, mt * 16, nt * 16, lane, acc); acc = mma64(A2, B2, mt * 16, nt * 16, lane, acc);
        LAS float* o = (LAS float*)(Lh + H_O);
#pragma unroll
        for (int r = 0; r < 4; ++r) o[(mt * 16 + 4 * (lane >> 4) + r) * OS + nt * 16 + (lane & 15)] = acc[r]; }
}
__device__ __forceinline__ void hgrn_d_item(LAS unsigned char* Lh, const HgIn& R, float lb, const float* gain  , bf16_t* out  , int tl, int tq) {
    const int d = tl & 63, lane = tl & 63;
    float bl[TK], kk[TK], q[TK]; float run = 0.f;
#pragma unroll
    for (int i = 0; i < TK; ++i) { const float fz = BFP(R.fz, i); q[i] = BFP(R.q, i);
        float sg, omsg, lf; hgrn_gate(lb, fz, sg, omsg, lf); kk[i] = (1.f - lb) * omsg; run += lf; bl[i] = run; }
    LAS float* part = (LAS float*)(Lh + H_PART);
    part[tq * 64 + d] = run;
    store_state_tile(Lh + L_T4, R.s, tl);
    pack16h(Lh + L_T3 + d * TS + tq * (2 * TK), R.iv);
    __syncthreads();
    float off = 0.f, bref = 0.f;
#pragma unroll
    for (int w = 0; w < IW; ++w) { const float pv = part[w * 64 + d]; if (w < IW / 2) bref += pv; if (w < tq) off += pv; }
#pragma unroll
    for (int i = 0; i < TK; ++i) { const float bb = off + bl[i]; const int t = TK * tq + i;
        st16(Lh + L_T0 + t * TS + d * 2, q[i] * __expf(bb - bref));
        st16(Lh + L_T1 + t * TS + d * 2, kk[i] * __expf(bref - bb));
        st16(Lh + L_T2 + t * TS + d * 2, q[i] * __expf(bb)); }
    __syncthreads();
#pragma unroll
    for (int nn = 0; nn < TPW; ++nn) { const int ti = tq * TPW + nn, mt = ti >> 2, nt = ti & 3; f32x4 acc = {0.f, 0.f, 0.f, 0.f};
        acc = mma64(Lh + L_T1, Lh + L_T0, mt * 16, nt * 16, lane, acc);
        const int s0 = mt * 16 + 4 * (lane >> 4), t = nt * 16 + (lane & 15);
        v2u w; w.x = pk2(s0 <= t ? acc[0] : 0.f, s0 + 1 <= t ? acc[1] : 0.f); w.y = pk2(s0 + 2 <= t ? acc[2] : 0.f, s0 + 3 <= t ? acc[3] : 0.f);
        *(LAS v2u*)(Lh + L_T5 + t * TS + s0 * 2) = w; }
    __syncthreads();
    store_o_tiles(Lh, Lh + L_T5, Lh + L_T3, Lh + L_T2, Lh + L_T4, tq, lane);
    __syncthreads();
    { const int t = tl / IW, v0 = (tl % IW) * CPT; head_epilogue<false>(Lh, 1.f, R.gate, gain + v0, out + (size_t)t * D + v0, tl); }
    __syncthreads();
}
__device__ __forceinline__ void mlstm_d_item(LAS unsigned char* Lh, const MlIn& R, const float* conv, const float* b_i, const float* b_f, const float* gain  , int h, bf16_t* out  , int tl, int tq) {
    const int d = tl & 63, lane = tl & 63; const float mprev = R.mprev;
    float bcum, a; mlstm_gates(R.ig, R.fg, b_i, b_f, h, lane, bcum, a);
    const float M = fmaxf(wave_incl_max(a, lane), mprev), sint = __expf(mprev - M);
    LAS float* vec = (LAS float*)(Lh + H_VEC);
    if (tq == 0) { vec[lane] = a; vec[64 + lane] = M; vec[128 + lane] = __expf(-bcum - M); vec[192 + lane] = R.np; }
    float qc[TK], kc[TK];
    conv_silu_r(R.qr, conv + h * 64 + d, 1.f, qc);
    conv_silu_r(R.kr, conv + 256 + h * 64 + d, 0.125f, kc);
#pragma unroll
    for (int i = 0; i < TK; ++i) { const int t = TK * tq + i;
        st16(Lh + L_T0 + t * TS + d * 2, qc[i]);
        st16(Lh + L_T1 + t * TS + d * 2, kc[i]);
        st16(Lh + L_T2 + t * TS + d * 2, qc[i] * lane_bcast(sint, t)); }
    pack16h(Lh + L_T3 + d * TS + tq * (2 * TK), R.vv);
    store_state_tile(Lh + L_T4, R.s, tl);
    __syncthreads();
#pragma unroll
    for (int nn = 0; nn < TPW; ++nn) { const int ti = tq * TPW + nn, mt = ti >> 2, nt = ti & 3; f32x4 acc = {0.f, 0.f, 0.f, 0.f};
        acc = mma64(Lh + L_T1, Lh + L_T0, mt * 16, nt * 16, lane, acc);
        const int s0 = mt * 16 + 4 * (lane >> 4), t = nt * 16 + (lane & 15); const float Mt = vec[64 + t];
        float wv[4];
#pragma unroll
        for (int r = 0; r < 4; ++r) wv[r] = (s0 + r <= t) ? acc[r] * __expf(vec[s0 + r] - Mt) : 0.f;
        v2u w; w.x = pk2(wv[0], wv[1]); w.y = pk2(wv[2], wv[3]); *(LAS v2u*)(Lh + L_T5 + t * TS + s0 * 2) = w; }
    __syncthreads();
    float inv;
    { const int t = tl / IW, c0 = (tl % IW) * CPT; float den = 0.f;
#pragma unroll
      for (int hh = 0; hh < 2; ++hh) { const v4u pw = *(LAS const v4u*)(Lh + L_T5 + t * TS + (c0 + 8 * hh) * 2), qw = *(LAS const v4u*)(Lh + L_T2 + t * TS + (c0 + 8 * hh) * 2);
          const unsigned pu[4] = {pw.x, pw.y, pw.z, pw.w}, qu[4] = {qw.x, qw.y, qw.z, qw.w};
#pragma unroll
          for (int i = 0; i < 8; ++i) den += bf2f((bf16_t)((pu[i >> 1] >> (16 * (i & 1))) & 0xffff)) + bf2f((bf16_t)((qu[i >> 1] >> (16 * (i & 1))) & 0xffff)) * vec[192 + c0 + 8 * hh + i]; }
#pragma unroll
      for (int m = 1; m < IW; m <<= 1) den += __shfl_xor(den, m);
      inv = __builtin_amdgcn_rcpf(fmaxf(fabsf(den), vec[128 + t])); }
    store_o_tiles(Lh, Lh + L_T5, Lh + L_T3, Lh + L_T2, Lh + L_T4, tq, lane);
    __syncthreads();
    { const int t = tl / IW, c0 = (tl % IW) * CPT; head_epilogue<true>(Lh, inv, R.gate, gain + c0, out + (size_t)t * D + c0, tl); }
    __syncthreads();
}
}
constexpr int N_PHASES = 21;
template <int PH, bool REP = false> __device__ __forceinline__ void run_phase(const MArgs& a, LAS unsigned char* L, const int tid, const int wave, const int G, const int bx, const int vcu) {
    const int lane = tid & 63, gw = vcu * NWAVES + wave, NGW = G * NWAVES;
    unsigned char* ws = a.ws; bf16_t* X = (bf16_t*)a.out;
    bf16_t* X2 = (bf16_t*)(ws + WS_X2); (void)X2;
    int* ctl = (int*)(ws + WS_CTL); int* cnt = ctl + CW_CNT;
    float* Gt = (float*)(ws + WS_G); float* CF = (float*)(ws + WS_CF); int4* tokinfo = (int4*)(ws + WS_TOKINFO); float2* tgate = (float2*)(ws + WS_TGATE); int* toklist = (int*)(ws + WS_TOKLIST);
    bf16_t* P = (bf16_t*)(ws + WS_P); bf16_t* HID = (bf16_t*)(ws + WS_HID); signed char* H = (signed char*)(ws + WS_H); float* SH = (float*)(ws + WS_SH); bf16_t* MIX = (bf16_t*)(ws + WS_MIX);
    signed char* XG = (signed char*)(ws + WS_XG); float* SXG = (float*)(ws + WS_SXG); bf16_t* Y = (bf16_t*)(ws + WS_XG);
    LAS float* scr = (LAS float*)(L + RING_OFF + wave * 16384);
    (void)ctl; (void)Gt; (void)CF; (void)tokinfo; (void)tgate; (void)toklist; (void)P; (void)HID; (void)H; (void)SH; (void)SXG; (void)MIX; (void)XG; (void)Y; (void)scr; (void)cnt; (void)lane; (void)gw; (void)NGW;
    constexpr int p = PH, l = p >= 10 ? 1 : 0, k = p == 0 ? -1 : (l ? p - 10 : p - 1);
    if constexpr (p == 0) {
            LAS float* img = (LAS float*)(L + RING_OFF); LAS float* pm = (LAS float*)(L + LDSCTL_OFF + 1024);
            { auto job = [&](int it) { Conv8Job j; int r = it;
                  if (r < 224) { const int ll = r / 112, nb = r % 112, sc = 32 * nb + (nb >= 56 ? 8 : 0);
                      j.W = a.in[I_W_IN] + (size_t)ll * D * DIN + sc; j.ldw = DIN; j.WT8 = (signed char*)(ws + WS_WIN) + (size_t)ll * PW * D + (size_t)32 * nb * D; j.S = (float*)(ws + WS_SWIN) + ll * PW + 32 * nb; }
                  else { r -= 224; const int up = r / 88, nb = r % 88, c = 32 * nb;
                      j.W = (up ? a.in[I_DUP] : a.in[I_DGATE]) + c; j.ldw = FF; j.WT8 = (signed char*)(ws + WS_WDGU) + (size_t)glu_row(c, up) * D; j.S = (float*)(ws + WS_SWDGU) + glu_row(c, up); }
                  return j; };
              float v[64]; int it = vcu; if (it < 400) conv8_load(v, job(it), tid, wave);
              for (; it < 400; it += G) { const Conv8Job j = job(it); conv8_stage(v, img, pm, tid, wave); if (it + G < 400) conv8_load(v, job(it + G), tid, wave); conv8_quant(j, img, pm, tid, wave); } }
            { LAS unsigned* slot = (LAS unsigned*)(L + LDSCTL_OFF); LAS float* tab = (LAS float*)(L + RING_OFF); bool tabbed = false;
              for (;;) {
                  __syncthreads();
                  if (tid == 0) *slot = __hip_atomic_fetch_add((unsigned*)ctl + CW_PQ + (REP ? 1 : 0), 1u, __ATOMIC_RELAXED, __HIP_MEMORY_SCOPE_AGENT);
                  __syncthreads();
                  const int t = __builtin_amdgcn_readfirstlane((int)*(volatile LAS unsigned*)slot);
                  if (t >= 560) break;
                  if (t < 304) { int r = 8 * t + wave;
                      if (r < 1024) { const int ll = r / 512; r %= 512; const int kb = r / 32, nb = r % 32;
                          tr_item(a.in[I_W_OUT] + (size_t)ll * D * D + 32 * nb, D, D, (bf16_t*)(ws + WS_WOUT) + (size_t)ll * D * D + (size_t)32 * nb * D, scr, 64 * kb, lane); }
                      else { r -= 1024; const int kb = r / 32, nb = r % 32; tr_item(a.in[I_DDOWN] + 32 * nb, D, FF, (bf16_t*)(ws + WS_WDDN) + (size_t)32 * nb * FF, scr, 64 * kb, lane); } }
                  else {
                      if (!tabbed) { __syncthreads(); load_gate_tab(tab, a.in[I_W_IN], tid); __syncthreads(); tabbed = true; }
                      float lg[8]; RowIn R, Rn; const int row0 = (t - 304) * 64 + wave * 8; mrow_load<false>(R, a.in[I_X], row0, lane);
#pragma unroll 1
                      for (int i = 0; i < 8; ++i) { if (i < 7) mrow_load<false>(Rn, a.in[I_X], row0 + i + 1, lane); asm volatile("" ::: "memory");
                          mrow<0>(R, H, SH, a.in[I_ATTN_NORM], tab, Gt, row0 + i, lane, lg); if (i < 7) R = Rn; } }
              } }
        } else if constexpr (k == 0) {
            { const int cb = (G >= 144) ? bx - 128 : bx; for (int bh = cb; bh >= 0 && bh < 16; bh += G) scan::fox_cumsum_item(L, Gt, a.in[I_FOX_BF] + l * 8, CF, bh, tid, wave); }
            pg8::GOrder S; S.so.init(NTOK, PW, G, bx); S.A = (const char*)H; S.B = (const char*)(ws + WS_WIN) + (size_t)l * PW * D; S.a_tile = (size_t)256 * D; S.b_tile = (size_t)256 * D; S.b_exp = 0;
            S.tb1 = S.tb2 = S.tb3 = S.tb4 = S.tb5 = S.tb6 = S.tb7 = 0x7fffffff;
            pg8::EpiBf8 E; E.O = P; E.ldc = PW; E.s_lo = P_FQ / 256; E.s_hi = P_FK / 256; E.scale = QSCALE; E.sA = SH; E.sB = (const float*)(ws + WS_SWIN) + l * PW; E.sc = (LAS float*)(L + LDSCTL_OFF + 4096);
            pg8::Gemm g{D / 2};
            pg8::gemm_phase<pg8::EpiBf8, pg8::GOrder, true, true, 1>(L + RING_OFF, g, S, E);
            if constexpr (!REP) moe_fill(a, ws, scr, l ? 2 : 0, G, bx, wave, lane);
        } else if constexpr (l == 1 && k == 9) {
            pg8::GOrderTail S; pg8::EpiBfPart E; int t[8]; int acc = 0;
#pragma unroll
            for (int e = 0; e < NE; ++e) { t[e] = acc; acc += (cnt[e] + 255) >> 8; }
            S.init(acc, D, G, bx); S.A = (const char*)HID; S.B = (const char*)(ws + WS_WMDN); S.a_tile = (size_t)256 * FE; S.b_tile = (size_t)256 * FE; S.b_exp = (size_t)D * FE;
            S.tb1 = t[1]; S.tb2 = t[2]; S.tb3 = t[3]; S.tb4 = t[4]; S.tb5 = t[5]; S.tb6 = t[6]; S.tb7 = t[7]; E.O = Y; E.ldc = D; E.scale = 1.f / (pg8::F8_HSCALE * pg8::F8_WSCALE);
            pg8::Gemm g{FE / 2};
            pg8::gemm_phase<pg8::EpiBfPart, pg8::GOrderTail, true, true, 2>(L + RING_OFF, g, S, E);
        } else if constexpr (k == 4 || (l == 0 && k == 7)) {
            pg8::GOrder S; S.so.init(NTOK, D, G, bx); S.b_exp = 0; S.tb1 = S.tb2 = S.tb3 = S.tb4 = S.tb5 = S.tb6 = S.tb7 = 0x7fffffff; int K;
            if constexpr (k == 4) { K = D; S.A = (const char*)MIX; S.B = (const char*)(ws + WS_WOUT) + (size_t)l * D * D * 2; }
            else { K = FF; S.A = (const char*)HID; S.B = (const char*)(ws + WS_WDDN); }
            S.a_tile = (size_t)256 * K * 2; S.b_tile = (size_t)256 * K * 2;
            pg8::Gemm g{K};
            if constexpr (k == 4 && l == 0) { pg8::EpiResid<true> E{a.in[I_X], X, D}; pg8::gemm_phase<pg8::EpiResid<true>, pg8::GOrder, true, true>(L + RING_OFF, g, S, E); }
            else { pg8::EpiResid<false> E{X, (k == 4 && l == 1) ? X2 : X, D}; pg8::gemm_phase<pg8::EpiResid<false>, pg8::GOrder, true, true>(L + RING_OFF, g, S, E); }
        } else if constexpr (l == 0 && k == 6) {
            pg8::GOrder S; pg8::EpiSwiglu8<false> E; S.a_tile = (size_t)256 * D; S.b_tile = (size_t)256 * D; E.O = HID; E.sc = (LAS float*)(L + LDSCTL_OFF + 4096);
            S.so.init(NTOK, 2 * FF, G, bx); S.A = (const char*)H; S.B = (const char*)(ws + WS_WDGU); S.b_exp = 0; S.tb1 = S.tb2 = S.tb3 = S.tb4 = S.tb5 = S.tb6 = S.tb7 = 0x7fffffff;
            E.ldc = FF; E.sA = SH; E.sB = (const float*)(ws + WS_SWDGU); E.sb_exp = 0;
            E.tb1 = S.tb1; E.tb2 = S.tb2; E.tb3 = S.tb3; E.tb4 = S.tb4; E.tb5 = S.tb5; E.tb6 = S.tb6; E.tb7 = S.tb7;
            pg8::Gemm g{D / 2};
            pg8::gemm_phase<pg8::EpiSwiglu8<false>, pg8::GOrder, true, true, 1>(L + RING_OFF, g, S, E);
            if constexpr (!REP) moe_fill(a, ws, scr, 1, G, bx, wave, lane);
        } else if constexpr (l == 1 && k == 7) {
            pg8::GOrder S; pg8::EpiSwigluF8 E; S.a_tile = (size_t)256 * D; S.b_tile = (size_t)256 * D; E.O = (unsigned char*)HID; E.ldc = FE;
            int t[8]; int acc = 0;
#pragma unroll
            for (int e = 0; e < NE; ++e) { t[e] = acc; acc += (cnt[e] + 255) >> 8; }
            S.so.init(acc * 256, 2 * FE, G, bx); S.A = (const char*)XG; S.B = (const char*)(ws + WS_WMGU); S.b_exp = (size_t)2 * FE * D;
            S.tb1 = t[1]; S.tb2 = t[2]; S.tb3 = t[3]; S.tb4 = t[4]; S.tb5 = t[5]; S.tb6 = t[6]; S.tb7 = t[7];
            pg8::Gemm g{D / 2};
#ifdef EXP_NULL_EPI
            if constexpr (REP) { pg8::EpiNull E0; E0.O = (unsigned char*)HID; E0.ldc = FE; pg8::gemm_phase<pg8::EpiNull, pg8::GOrder, true, true, 2>(L + RING_OFF, g, S, E0); } else
#endif
            pg8::gemm_phase<pg8::EpiSwigluF8, pg8::GOrder, true, true, 2>(L + RING_OFF, g, S, E);
            if constexpr (!REP) { const int ni = moe_tail_idle(cnt, G), ci = bx - (256 - ni);
                if (ni && ci >= 0) { const int first = MOE_ITEMS - ni * NWAVES * MOE_FILL17 + ci * NWAVES + wave; moe_conv_range(a, ws, scr, first, ni * NWAVES, MOE_ITEMS, lane); } }
        } else if constexpr (k == 5 && l == 0) {
            float lg[8];
            { RowIn R, Rn; int row = gw; if (row < NTOK) mrow_load<true>(R, X, row, lane);
              for (; row < NTOK; row += NGW) { const int nx = row + NGW; if (nx < NTOK) mrow_load<true>(Rn, X, nx, lane); asm volatile("" ::: "memory");
                  mrow<1>(R, H, SH, a.in[I_FFN_NORM], nullptr, nullptr, row, lane, lg); if (nx < NTOK) R = Rn; } }
        } else if constexpr (k == 8 && l == 0) {
            LAS float* tab = (LAS float*)(L + RING_OFF); load_gate_tab(tab, a.in[I_W_IN] + (size_t)D * DIN, tid); __syncthreads();
            float lg[8];
            { RowIn R, Rn; int row = gw; if (row < NTOK) mrow_load<true>(R, X, row, lane);
              for (; row < NTOK; row += NGW) { const int nx = row + NGW; if (nx < NTOK) mrow_load<true>(Rn, X, nx, lane); asm volatile("" ::: "memory");
                  mrow<0>(R, H, SH, a.in[I_ATTN_NORM] + D, tab, Gt, row, lane, lg); if (nx < NTOK) R = Rn; } }
        } else if constexpr (k == 5 && l == 1) {
            LAS int* sel_e = (LAS int*)(L + RING_OFF);
            LAS float* sel_g = (LAS float*)(L + RING_OFF + 512);
            LAS int* lcnt = (LAS int*)(L + RING_OFF + 1024);
            LAS float* tab = (LAS float*)(L + RING_OFF + 4096); load_router_tab(tab, a.in[I_ROUTER], tid); __syncthreads();
            for (int rb = bx; rb < NTOK / 64; rb += G) {
                if (tid < 16) lcnt[tid] = 0;
                RowIn R, Rn; mrow_load<true>(R, X2, rb * 64 + wave * 8, lane);
                for (int i = 0; i < 8; ++i) { const int rl = wave * 8 + i, row = rb * 64 + rl; float lg[8];
                    if (i < 7) mrow_load<true>(Rn, X2, row + 1, lane); asm volatile("" ::: "memory");
                    mrow<2>(R, H, SH, a.in[I_FFN_NORM] + D, tab, nullptr, row, lane, lg); if (i < 7) R = Rn;
                    if (lane == 0) { const float v0 = lg[0], v1 = lg[1]; const int e0 = __float_as_int(lg[2]), e1 = __float_as_int(lg[3]);
                        const float g1 = 1.f / (1.f + __expf(v0 - v1));
                        sel_e[2 * rl] = e0; sel_e[2 * rl + 1] = e1; sel_g[2 * rl] = 1.f - g1; sel_g[2 * rl + 1] = g1; } }
                __syncthreads();
                int e0 = 0, e1 = 0, r0 = 0, r1 = 0;
                if (tid < 64) { e0 = sel_e[2 * tid]; e1 = sel_e[2 * tid + 1]; r0 = __hip_atomic_fetch_add(lcnt + e0, 1, __ATOMIC_RELAXED, __HIP_MEMORY_SCOPE_WORKGROUP); r1 = __hip_atomic_fetch_add(lcnt + e1, 1, __ATOMIC_RELAXED, __HIP_MEMORY_SCOPE_WORKGROUP); }
                __syncthreads();
                if (tid < 8) lcnt[8 + tid] = atomicAdd(cnt + tid, (int)lcnt[tid]);
                __syncthreads();
                if (tid < 64) { const int row = rb * 64 + tid, s0 = lcnt[8 + e0] + r0, s1 = lcnt[8 + e1] + r1;
                    toklist[e0 * NTOK + s0] = row; toklist[e1 * NTOK + s1] = row; tokinfo[row] = make_int4(e0, s0, e1, s1); tgate[row] = make_float2(sel_g[2 * tid], sel_g[2 * tid + 1]); }
                __syncthreads();
            }
        } else if constexpr (k == 6 && l == 1) {
            { int base[NE]; int acc = 0;
#pragma unroll
              for (int e = 0; e < NE; ++e) { base[e] = acc; acc += (cnt[e] + 255) & ~255; }
              for (int r = gw; r < acc; r += NGW) { int e = 0, be = 0;
#pragma unroll
                  for (int c = 1; c < NE; ++c) if (r >= base[c]) { e = c; be = base[c]; }
                  const int s = r - be; v4u v0 = {0u, 0u, 0u, 0u}; float sv = 0.f;
                  if (s < cnt[e]) { const int tok = toklist[e * NTOK + s]; v0 = *((const v4u*)(H + (size_t)tok * D) + lane); sv = SH[tok]; }
                  *((v4u*)(XG + (size_t)r * D) + lane) = v0; if (lane == 0) SXG[r] = sv; } }
            moe_conv_range(a, ws, scr, moe_prefilled(G) + gw, NGW, MOE_ITEMS - moe_tail_idle(cnt, G) * NWAVES * MOE_FILL17, lane);
        } else if constexpr (k == 8 && l == 1) {
        } else if constexpr (l == 1 && k == 10) {
            int base[NE]; { int acc = 0;
#pragma unroll
              for (int e = 0; e < NE; ++e) { base[e] = acc; acc += (cnt[e] + 255) & ~255; } }
            constexpr int HALFR = NTOK; constexpr int rlo = 0;
            const bf16_t* Xs = X2;
            float* out = (float*)a.out;
            struct FA { uint2 v[4]; int4 ti; float2 tg; }; struct FB { uint2 y0[4], y1[4]; };
            auto loadA = [&](FA& A, int rr) { const uint2* xr = (const uint2*)(Xs + (size_t)rr * D) + lane;
#pragma unroll
                for (int j = 0; j < 4; ++j) A.v[j] = xr[64 * j];
                A.ti = tokinfo[rlo + rr]; A.tg = tgate[rlo + rr]; };
            auto ldrow = [&](uint2 (&y)[4], int r) {
                if ((r >> 8) < pg8::GOrderTail::MAIN_M) { const uint2* p = (const uint2*)(Y + (size_t)r * D) + lane;
#pragma unroll
                    for (int j = 0; j < 4; ++j) y[j] = p[64 * j]; }
                else { float s[16];
#pragma unroll
                    for (int i = 0; i < 16; ++i) s[i] = 0.f;
#pragma unroll 2
                    for (int kp = 0; kp < 8; ++kp) { const uint2* p = (const uint2*)(Y + (size_t)((pg8::EpiBfPart::YP_TILE0 + kp * 8 + (r >> 8) - pg8::GOrderTail::MAIN_M) * 256 + (r & 255)) * D) + lane;
#pragma unroll
                        for (int j = 0; j < 4; ++j) { const uint2 q = p[64 * j]; s[4 * j] += __uint_as_float(q.x << 16); s[4 * j + 1] += __uint_as_float(q.x & 0xffff0000u); s[4 * j + 2] += __uint_as_float(q.y << 16); s[4 * j + 3] += __uint_as_float(q.y & 0xffff0000u); } }
#pragma unroll
                    for (int j = 0; j < 4; ++j) { y[j].x = pk2(s[4 * j], s[4 * j + 1]); y[j].y = pk2(s[4 * j + 2], s[4 * j + 3]); } } };
            auto loadB = [&](FB& B, const FA& A) { int b0 = 0, b1 = 0;
#pragma unroll
                for (int c = 0; c < NE; ++c) { if (c == A.ti.x) b0 = base[c]; if (c == A.ti.z) b1 = base[c]; }
                ldrow(B.y0, b0 + A.ti.y); ldrow(B.y1, b1 + A.ti.w); };
            FA A0, A1, A2; FB B0, B1; int rr = gw;
            if (rr < HALFR) { loadA(A0, rr); if (rr + NGW < HALFR) loadA(A1, rr + NGW); loadB(B0, A0); }
            for (; rr < HALFR; rr += NGW) {
                const bool h1 = rr + NGW < HALFR, h2 = rr + 2 * NGW < HALFR;
                if (h2) loadA(A2, rr + 2 * NGW);
                if (h1) loadB(B1, A1);
                asm volatile("" ::: "memory");
                float4 v[4]; const float2 tg = A0.tg;
#pragma unroll
                for (int j = 0; j < 4; ++j) { const uint2 q = B0.y0[j], c = B0.y1[j], x = A0.v[j];
                    v[j].x = __uint_as_float(x.x << 16) + tg.x * bf2f((bf16_t)(q.x & 0xffff)) + tg.y * bf2f((bf16_t)(c.x & 0xffff)); v[j].y = __uint_as_float(x.x & 0xffff0000u) + tg.x * bf2f((bf16_t)(q.x >> 16)) + tg.y * bf2f((bf16_t)(c.x >> 16));
                    v[j].z = __uint_as_float(x.y << 16) + tg.x * bf2f((bf16_t)(q.y & 0xffff)) + tg.y * bf2f((bf16_t)(c.y & 0xffff)); v[j].w = __uint_as_float(x.y & 0xffff0000u) + tg.x * bf2f((bf16_t)(q.y >> 16)) + tg.y * bf2f((bf16_t)(c.y >> 16)); }
                float ss = 0.f;
#pragma unroll
                for (int j = 0; j < 4; ++j) ss += v[j].x * v[j].x + v[j].y * v[j].y + v[j].z * v[j].z + v[j].w * v[j].w;
                ss = wave_sum(ss); const float r = rsqrtf(ss * (1.f / D) + EPS);
                float4* xo = (float4*)(out + (size_t)(rlo + rr) * D) + lane;
#pragma unroll
                for (int j = 0; j < 4; ++j) { const float4 g = *((const float4*)a.in[I_FINAL_NORM] + 64 * j + lane); xo[64 * j] = make_float4(v[j].x * r * g.x, v[j].y * r * g.y, v[j].z * r * g.z, v[j].w * r * g.w); }
                if (h1) { A0 = A1; B0 = B1; } if (h2) A1 = A2;
            }
        } else {
            if constexpr (k == 1) {
                unsigned char* sc = ws + WS_SCAN; const int wv = wave;
#define ITEM_DECODE(it_) const int item = (it_) & 1023, h = item & 3, c = (item >> 2) & 127, b = item >> 9
#define HG_LB(h_) (l == 0 ? 0.f : 1.f / (1.f + __expf(a.in[I_HGRN_LB][(h_) * 64 + (tl & 63)] - a.in[I_HGRN_LB][256 + (h_) * 64 + (tl & 63)])))
                const int hf = wave >> 2, tq4 = wave & 3; LAS unsigned char* Lh = L + hf * scan::HLDS;
                { scan::HgIn R, Rn;
                  auto itemOf = [&](int pp) { const int it = bx + (2 * pp + hf) * G; return it < 1024 ? it : it - G; };
                  int pp = 0; if (bx < 1024) { ITEM_DECODE(itemOf(0)); scan::hgrn_load<false>(R, P, b, c, h, nullptr, tid & 255, tq4); }
                  for (; bx + 2 * pp * G < 1024; ++pp) { const bool nx = bx + 2 * (pp + 1) * G < 1024; int tl = tid & 255; asm volatile("" : "+v"(tl));
                      if (nx) { ITEM_DECODE(itemOf(pp + 1)); scan::hgrn_load<false>(Rn, P, b, c, h, nullptr, tl, tq4); }
                      asm volatile("" ::: "memory");
                      { ITEM_DECODE(itemOf(pp)); (void)b; (void)c; scan::hgrn_b_item(Lh, R, HG_LB(h), (float*)(sc + scan::SC_LHG) + (size_t)item * 4096, (float*)(sc + scan::SC_DEC) + item * 64, tl, tq4); }
                      if (nx) R = Rn; } }
                { scan::MlIn R, Rn; int base = bx; while (base < 1024) base += G;
                  auto itemOf = [&](int pp) { const int it = base + (2 * pp + hf) * G; return it < 2048 ? it : it - G; };
                  int pp = 0; if (base < 2048) { ITEM_DECODE(itemOf(0)); scan::mlstm_load<false>(R, P, Gt, b, c, h, nullptr, nullptr, nullptr, tid & 255, tq4); }
                  for (; base + 2 * pp * G < 2048; ++pp) { const bool nx = base + 2 * (pp + 1) * G < 2048; int tl = tid & 255; asm volatile("" : "+v"(tl));
                      if (nx) { ITEM_DECODE(itemOf(pp + 1)); scan::mlstm_load<false>(Rn, P, Gt, b, c, h, nullptr, nullptr, nullptr, tl, tq4); }
                      asm volatile("" ::: "memory");
                      { ITEM_DECODE(itemOf(pp)); (void)b; (void)c; scan::mlstm_b_item(Lh, R, a.in[I_MLSTM_CONV] + l * 2048, a.in[I_MLSTM_BI] + l * 4, a.in[I_MLSTM_BF] + l * 4, h, (float*)(sc + scan::SC_LML) + (size_t)item * 4096,
                                            (float*)(sc + scan::SC_NL) + item * 64, (float*)(sc + scan::SC_AMAX) + item, (float*)(sc + scan::SC_BEND) + item, tl, tq4); }
                      if (nx) R = Rn; } }
                { LAS unsigned* lst = (LAS unsigned*)(L + LDSCTL_OFF + 64);
                  if (tid < 32) lst[tid] = 0u; __syncthreads();
                  float mq0 = 0.f, mq1 = 0.f, mk0 = 0.f, mk1 = 0.f;
                  for (int row = gw; row < NTOK; row += NGW) {
                      const v4u wq = *((const v4u*)(P + (size_t)row * PW + P_FQ) + lane), wk = *((const v4u*)(P + (size_t)row * PW + P_FK) + lane);
                      float sq = 0.f, sk = 0.f;
#pragma unroll
                      for (int i = 0; i < 4; ++i) { const float q0 = bf2f((bf16_t)(wq[i] & 0xffff)), q1 = bf2f((bf16_t)(wq[i] >> 16)), k0 = bf2f((bf16_t)(wk[i] & 0xffff)), k1 = bf2f((bf16_t)(wk[i] >> 16));
                          sq += q0 * q0 + q1 * q1; sk += k0 * k0 + k1 * k1; }
                      sq += __shfl_xor(sq, 1); sq += __shfl_xor(sq, 2); sq += __shfl_xor(sq, 4); sk += __shfl_xor(sk, 1); sk += __shfl_xor(sk, 2); sk += __shfl_xor(sk, 4);
                      if (row < SEQ) { mq0 = fmaxf(mq0, sq); mk0 = fmaxf(mk0, sk); } else { mq1 = fmaxf(mq1, sq); mk1 = fmaxf(mk1, sk); } }
                  if ((lane & 7) == 0) { const int hh = lane >> 3;
                      __hip_atomic_fetch_max(lst + hh * 2, __float_as_uint(mq0), __ATOMIC_RELAXED, __HIP_MEMORY_SCOPE_WORKGROUP); __hip_atomic_fetch_max(lst + hh * 2 + 1, __float_as_uint(mk0), __ATOMIC_RELAXED, __HIP_MEMORY_SCOPE_WORKGROUP);
                      __hip_atomic_fetch_max(lst + 16 + hh * 2, __float_as_uint(mq1), __ATOMIC_RELAXED, __HIP_MEMORY_SCOPE_WORKGROUP); __hip_atomic_fetch_max(lst + 16 + hh * 2 + 1, __float_as_uint(mk1), __ATOMIC_RELAXED, __HIP_MEMORY_SCOPE_WORKGROUP); }
                  __syncthreads();
                  if (tid < 32) __hip_atomic_fetch_max((unsigned*)ctl + CW_STAT + l * 32 + tid, lst[tid], __ATOMIC_RELAXED, __HIP_MEMORY_SCOPE_AGENT); }
            } else if constexpr (k == 2) {
                for (int j = bx; j < 256; j += G) scan::scan_c_block<REP>(ws + WS_SCAN, j, tid);
            } else if constexpr (k == 3) {
                static_assert(attn_body::ATTN_LDS_BYTES <= RING_BYTES, "attention LDS");
                unsigned char* sc = ws + WS_SCAN; const int wv = wave;
                const float* stat = (const float*)(ctl + CW_STAT + l * 32);
                LAS unsigned* slot = (LAS unsigned*)(L + LDSCTL_OFF);
                int v;
                for (;;) {
                    if (tid == 0) *slot = __hip_atomic_fetch_add((unsigned*)ctl + CW_QCTR + l + (REP ? 2 : 0), 1u, __ATOMIC_RELAXED, __HIP_MEMORY_SCOPE_AGENT);
                    __syncthreads();
                    v = __builtin_amdgcn_readfirstlane((int)*(volatile LAS unsigned*)slot);
                    if (v >= 736) break;
                    int qb, bh, part = 0; float* PART = nullptr;
                    if (v < 448) { qb = 31 - (v >> 5); bh = v & 15; part = (v >> 4) & 1; PART = (float*)(ws + WS_SCAN + (40 + 32 * l) * MiB) + (size_t)(bh * 14 + (qb - 18)) * 2 * attn_body::PART_F; }
                    else { const int u2 = v - 448; qb = 17 - (u2 >> 4); bh = u2 & 15; }
                    const float Tsk = 30.f + 2.f * __builtin_sqrtf(stat[bh * 2] * stat[bh * 2 + 1]) * 1.01f + 1.f;
                    attn_body::attn_unit<8>(bh >> 3, bh & 7, qb, (const attn_body::bf16*)(P + P_FQ), (const attn_body::bf16*)(P + P_FK), (const attn_body::bf16*)(P + P_FV), (attn_body::bf16*)(MIX + 512), CF + (size_t)bh * SEQ, Tsk,
                                            part, PART, (unsigned*)ctl + CW_AFLAG + (l + (REP ? 2 : 0)) * 512 + bh * 32 + qb, (char*)L + RING_OFF);
                    __syncthreads();
                }
                int tid2 = tid; asm volatile("" : "+v"(tid2));
                while (v < 736 + 384 + 256) {
                    const int it0 = v < 1120 ? (v - 736) * 4 : 1536 + (v - 1120) * 2, nj = v < 1120 ? 2 : 1;
                    const int hf = wv >> 2, tq4 = wv & 3; LAS unsigned char* Lh = L + hf * scan::HLDS;
#pragma unroll 1
                    for (int j = 0; j < nj; ++j) { const int it = it0 + 2 * j + hf; int tl = tid2 & 255; asm volatile("" : "+v"(tl)); ITEM_DECODE(it);
                        if (it0 < 1024) { scan::HgIn R; scan::hgrn_load<true>(R, P, b, c, h, (const float*)(sc + scan::SC_LHG) + (size_t)item * 4096, tl, tq4);
                            const float lb = l == 0 ? 0.f : 1.f / (1.f + __expf(a.in[I_HGRN_LB][h * 64 + (tl & 63)] - a.in[I_HGRN_LB][256 + h * 64 + (tl & 63)]));
                            scan::hgrn_d_item(Lh, R, lb, a.in[I_HGRN_NORM] + l * 256 + h * 64, MIX + (size_t)(b * SEQ + c * 64) * D + h * 64, tl, tq4); }
                        else { scan::MlIn R; scan::mlstm_load<true>(R, P, Gt, b, c, h, (const float*)(sc + scan::SC_LML) + (size_t)item * 4096, (const float*)(sc + scan::SC_NL) + item * 64, (const float*)(sc + scan::SC_MPREV) + item, tl, tq4);
                            scan::mlstm_d_item(Lh, R, a.in[I_MLSTM_CONV] + l * 2048, a.in[I_MLSTM_BI] + l * 4, a.in[I_MLSTM_BF] + l * 4, a.in[I_MLSTM_NORM] + l * 256 + h * 64, h, MIX + (size_t)(b * SEQ + c * 64) * D + 256 + h * 64, tl, tq4); } }
                    __syncthreads();
                    if (tid2 == 0) *slot = __hip_atomic_fetch_add((unsigned*)ctl + CW_QCTR + l + (REP ? 2 : 0), 1u, __ATOMIC_RELAXED, __HIP_MEMORY_SCOPE_AGENT);
                    __syncthreads();
                    v = __builtin_amdgcn_readfirstlane((int)*(volatile LAS unsigned*)slot);
                }
            }

        }
}
__global__ void __launch_bounds__(NTHR, 2) mega(MArgs a) {
    extern __shared__ __attribute__((aligned(16))) unsigned char lds[];
    LAS unsigned char* L = (LAS unsigned char*)lds;
    volatile LAS unsigned* MISC = (volatile LAS unsigned*)(L + MISC_OFF);
    const int tid = threadIdx.x, wave = __builtin_amdgcn_readfirstlane(tid >> 6);
    const int G = gridDim.x, bx = blockIdx.x, vcu = (G % 8 == 0) ? (bx % 8) * (G / 8) + bx / 8 : bx;
    for (int u = tid; u < (LDS_BYTES - LDSCTL_OFF) / 4; u += NTHR) ((LAS unsigned*)(L + LDSCTL_OFF))[u] = 0u;
    __syncthreads();
    const int lo = a.ph_lo, hi = a.ph_hi;
    XcdBarrier bar; bar.bar = (unsigned*)(a.ws + WS_CTL) + CW_BAR; bar.x = 0; bar.st = nullptr;
    if (hi - lo > 1) bar = xcd_barrier_post((unsigned*)(a.ws + WS_CTL) + CW_BAR, MISC + 8);
#ifndef REPEAT_MASK
#define REPEAT_MASK 0u
#endif
#define PHASE(k) if (lo <= (k) && (k) < hi) { run_phase<k>(a, L, tid, wave, G, bx, vcu); if constexpr ((REPEAT_MASK >> (k)) & 1u) { xcd_barrier(bar); run_phase<k, true>(a, L, tid, wave, G, bx, vcu); } if ((k) + 1 < hi) xcd_barrier(bar); }
    PHASE(0) PHASE(1) PHASE(2) PHASE(3) PHASE(4) PHASE(5) PHASE(6) PHASE(7) PHASE(8) PHASE(9) PHASE(10)
    PHASE(11) PHASE(12) PHASE(13) PHASE(14) PHASE(15) PHASE(16) PHASE(17) PHASE(19) PHASE(20)
#undef PHASE
}
#ifndef MEGA_MASK
#define MEGA_MASK 0x1FFFFFu
#endif
#ifndef FUSE_RUNS
#define FUSE_RUNS 1
#endif
extern "C" void kernel_launch(void* const* d_in, const int* in_sizes, int n_in, void* d_out, int out_size, void* d_ws, size_t ws_size, hipStream_t stream) {
    static int grid = 0;
    if (grid == 0) {
        if (n_in != 20 || ws_size < WS_END || out_size != NTOK * D) { fprintf(stderr, "kernel_launch: unexpected n_in %d / ws %zu / out %d\n", n_in, ws_size, out_size); grid = -1; return; }
        int dev = 0, cus = 0, per_cu = 0;
        if (hipGetDevice(&dev) != hipSuccess || hipDeviceGetAttribute(&cus, hipDeviceAttributeMultiprocessorCount, dev) != hipSuccess) { grid = -1; return; }
        if (hipFuncSetAttribute((const void*)mega, hipFuncAttributeMaxDynamicSharedMemorySize, LDS_BYTES) != hipSuccess) { fprintf(stderr, "kernel_launch: hipFuncSetAttribute failed\n"); grid = -1; return; }
        if (hipOccupancyMaxActiveBlocksPerMultiprocessor(&per_cu, (const void*)mega, NTHR, LDS_BYTES) != hipSuccess || per_cu < 1) { fprintf(stderr, "kernel_launch: occupancy query says %d\n", per_cu); per_cu = 1; }
        (void)hipGetLastError();
        grid = cus;
        if (grid > 256) grid = 256;
    }
    if (grid < 0) return;
    const float* const* in = (const float* const*)d_in;
    unsigned char* ws = (unsigned char*)d_ws; float* X = (float*)d_out;
    (void)hipMemsetAsync(ws + WS_CTL, 0, CTL_BYTES, stream);
    MArgs ma; memset(&ma, 0, sizeof ma);
    for (int i = 0; i < 20; ++i) ma.in[i] = in[i];
    ma.out = X; ma.ws = ws;
    ma.ph_lo = 0; ma.ph_hi = N_PHASES;
    hipLaunchKernelGGL(mega, dim3(grid), dim3(NTHR), LDS_BYTES, stream, ma);
}
```

```cpp
#include <hip/hip_runtime.h>
#include <hip/hip_bf16.h>
#include <cstdint>
#include <cstdio>
#include <cstring>

namespace cfg {
constexpr int NTOK = 16384, D = 1024, SEQ = 8192, NB = 2, DIN = 3600, PW = 3584, GW = 16;
constexpr int FF = 2816, FE = 3584, NE = 8, MAXROWS = 34816;
constexpr float EPS = 1e-6f;
constexpr float LOG2E = 1.4426950408889634f;
constexpr float QSCALE = 0.125f * LOG2E;
constexpr int P_HQ = 0, P_HF = 256, P_HI = 512, P_HG = 768, P_MQ = 1024, P_MK = 1280, P_MV = 1536, P_MO = 1792, P_FQ = 2048, P_FK = 2560, P_FV = 3072;
constexpr size_t MiB = 1u << 20;
constexpr size_t WS_CTL = 0, CTL_BYTES = 1 * MiB;
constexpr size_t WS_G = 2 * MiB;
constexpr size_t WS_CF = 3 * MiB;
constexpr size_t WS_TOKINFO = 3 * MiB + 512 * 1024;
constexpr size_t WS_TGATE = 3 * MiB + 768 * 1024;
constexpr size_t WS_TOKLIST = 4 * MiB;
constexpr size_t WS_P = 8 * MiB;
constexpr size_t WS_SCAN = 120 * MiB;
constexpr size_t WS_HID = 8 * MiB;
constexpr size_t WS_H = 246 * MiB;
constexpr size_t WS_MIX = 278 * MiB;
constexpr size_t WS_XG = 278 * MiB;
constexpr size_t WS_W = 346 * MiB;
constexpr size_t WS_Y = 346 * MiB;
constexpr size_t WS_X2 = 130 * MiB;
constexpr size_t WS_PB = 164 * MiB;
constexpr size_t WS_END = 466 * MiB;
constexpr int CW_CNT = 64;
constexpr int CW_STAT = 128;
constexpr int CW_STAT3 = 192;
constexpr int CW_QCTR = 256;
constexpr int CW_PQ = 262;
constexpr int CW_TFLAG = 384;
constexpr int CW_AFLAG = 512;
}
using namespace cfg;
typedef unsigned short bf16_t;

__device__ __forceinline__ bf16_t f2bf(float f) { unsigned u = __builtin_bit_cast(unsigned, f); return (bf16_t)((u + 0x7fffu + ((u >> 16) & 1u)) >> 16); }
__device__ __forceinline__ float bf2f(bf16_t h) { return __builtin_bit_cast(float, (unsigned)h << 16); }
#define DPP_F(old_, v_, ctrl_, rmask_) __int_as_float(__builtin_amdgcn_update_dpp(__float_as_int(old_), __float_as_int(v_), ctrl_, rmask_, 0xf, false))
__device__ __forceinline__ float wave_sum(float v) {
    v += DPP_F(0.f, v, 0xB1, 0xf); v += DPP_F(0.f, v, 0x4E, 0xf); v += DPP_F(0.f, v, 0x141, 0xf); v += DPP_F(0.f, v, 0x140, 0xf);
    v += DPP_F(0.f, v, 0x142, 0xa); v += DPP_F(0.f, v, 0x143, 0xc);
    return __int_as_float(__builtin_amdgcn_readlane(__float_as_int(v), 63));
}
__device__ __forceinline__ float wave_max_nn(float v) {
    v = fmaxf(v, DPP_F(0.f, v, 0xB1, 0xf)); v = fmaxf(v, DPP_F(0.f, v, 0x4E, 0xf)); v = fmaxf(v, DPP_F(0.f, v, 0x141, 0xf)); v = fmaxf(v, DPP_F(0.f, v, 0x140, 0xf));
    v = fmaxf(v, DPP_F(0.f, v, 0x142, 0xa)); v = fmaxf(v, DPP_F(0.f, v, 0x143, 0xc));
    return __int_as_float(__builtin_amdgcn_readlane(__float_as_int(v), 63));
}
__device__ __forceinline__ float sigmoidf_(float z) { return 1.f / (1.f + __expf(-z)); }
__device__ __forceinline__ float siluf_(float z) { return z / (1.f + __expf(-z)); }
__device__ __forceinline__ float log_sigmoidf_(float z) { return fminf(z, 0.f) - log1pf(__expf(-fabsf(z))); }

__device__ __forceinline__ int moe_bases(const int* cnt, int* base) {
    int acc = 0;
#pragma unroll
    for (int e = 0; e < NE; ++e) { base[e] = acc; acc += (cnt[e] + 255) & ~255; }
    return acc;
}

namespace pg8 {
#define PG8_LAS __attribute__((address_space(3)))
typedef unsigned short bf16_t;
typedef short bf16x8 __attribute__((ext_vector_type(8)));
typedef float f32x4 __attribute__((ext_vector_type(4)));
typedef unsigned u32x4 __attribute__((ext_vector_type(4)));
constexpr int BM = 256, BK = 64, HALF = 128, HTB = HALF * BK * 2  , STAGE_BYTES = 8 * HTB, NXCD = 8, WGM = 8;

__host__ __device__ __forceinline__ int lds_byte(int r, int c) { const int st = (r >> 4) * 2 + (c >> 5), rr = r & 15, cc = c & 31, ob = rr * 64 + cc * 2; return st * 1024 + (ob ^ (((ob >> 9) & 1) << 5)); }
__host__ __device__ __forceinline__ void stage_rc(int b, int& R, int& C) { const int st = b / 1024, sb = b % 1024, swz = sb ^ (((sb >> 9) & 1) << 5); R = (st >> 1) * 16 + swz / 64; C = (st & 1) * 32 + (swz % 64) / 2; }
__host__ __device__ __forceinline__ int perm32(int rho) { const int n = rho >> 4, i = rho & 15; return 8 * (i >> 2) + 4 * n + (i & 3); }

struct Unit { int pm, pn, tq; };
struct Gemm { int K; };

struct StaticOrder {
    int nM, nN, nwg, G, c;
    __host__ __device__ void init(int M, int N, int G_, int c_) { nM = M / BM; nN = N / BM; nwg = nM * nN; G = G_; c = c_; }
    __host__ __device__ bool next(int i, Unit& u) const {
        const long L = (long)i * G + c; if (L >= nwg) return false;
        int wgid = (int)L; { const int q = nwg / NXCD, r = nwg % NXCD, xcd = wgid % NXCD, off = wgid / NXCD; wgid = (xcd < r ? xcd * (q + 1) : r * (q + 1) + (xcd - r) * q) + off; }
        const int nig = WGM * nN, gid = wgid / nig, fm = gid * WGM, gsz = (nM - fm) < WGM ? (nM - fm) : WGM;
        u.pm = fm + ((wgid % nig) % gsz); u.pn = (wgid % nig) / gsz; return true;
    }
    __device__ __forceinline__ void a_ready(const Unit&) const {}
    __device__ __forceinline__ void done(const Unit&) const {}
};

__device__ __forceinline__ unsigned cvt_pk_bf16(float lo, float hi) { unsigned r; asm volatile("v_cvt_pk_bf16_f32 %0, %1, %2" : "=v"(r) : "v"(lo), "v"(hi)); return r; }
typedef int i32x4 __attribute__((ext_vector_type(4)));
constexpr float F8_HSCALE = 4.f, F8_WSCALE = 64.f, F8_ASCALE = 16.f, F8_GSCALE = 32.f;
template <bool I8> struct AccT { typedef f32x4 type; };
template <> struct AccT<true> { typedef i32x4 type; };
__device__ __forceinline__ f32x4 mma_sel(bf16x8 b, bf16x8 a, f32x4 c) { return __builtin_amdgcn_mfma_f32_16x16x32_bf16(b, a, c, 0, 0, 0); }
__device__ __forceinline__ i32x4 mma_sel(bf16x8 b, bf16x8 a, i32x4 c) { return __builtin_amdgcn_mfma_i32_16x16x64_i8(__builtin_bit_cast(i32x4, b), __builtin_bit_cast(i32x4, a), c, 0, 0, 0); }
typedef int i32x8 __attribute__((ext_vector_type(8)));
struct Frag2 { bf16x8 k[2]; };
template <int MODE> struct Frag { typedef Frag2 type; };
template <> struct Frag<2> { typedef i32x8 type; };
template <int MODE> __device__ __forceinline__ typename Frag<MODE>::type ldfrag(PG8_LAS const unsigned char* p) {
    if constexpr (MODE == 2) { const i32x4 lo = *(const PG8_LAS i32x4*)p, hi = *(const PG8_LAS i32x4*)(p + 1024); return (i32x8){lo[0], lo[1], lo[2], lo[3], hi[0], hi[1], hi[2], hi[3]}; }
    else { Frag2 f; f.k[0] = *(const PG8_LAS bf16x8*)p; f.k[1] = *(const PG8_LAS bf16x8*)(p + 1024); return f; }
}
__device__ __forceinline__ void mma_step_(f32x4& acc, const Frag2& b, const Frag2& a) { acc = mma_sel(b.k[0], a.k[0], acc); acc = mma_sel(b.k[1], a.k[1], acc); }
__device__ __forceinline__ void mma_step_(i32x4& acc, const Frag2& b, const Frag2& a) { acc = mma_sel(b.k[0], a.k[0], acc); acc = mma_sel(b.k[1], a.k[1], acc); }
__device__ __forceinline__ void mma_step_(f32x4& acc, const i32x8& b, const i32x8& a) {
#if defined(__HIP_DEVICE_COMPILE__)
    const int scl = 0x7f7f7f7f;
    asm volatile("v_mfma_scale_f32_16x16x128_f8f6f4 %0, %1, %2, %0, %3, %3 op_sel_hi:[0,0,0]" : "+v"(acc) : "v"(b), "v"(a), "v"(scl));
#endif
}
template <int MODE, class ACC, class F> __device__ __forceinline__ void mma_step(ACC& acc, const F& b, const F& a) { mma_step_(acc, b, a); }
struct EpiBf {
    static constexpr bool PERM = true, AFTER_DRAIN = false;
    bf16_t* O; int ldc; int s_lo, s_hi; float scale;
    struct Pre {}; __device__ __forceinline__ void prefetch(Pre&, const Unit&, int, int, int, int, int) const {} __device__ __forceinline__ void commit(const Pre&, int, int, int, int, int) const {}
    __device__ __forceinline__ void operator()(const f32x4 (&acc)[2][2][4][2], const Unit& u, int wr, int wc, int fr_, int fq_, const Pre&, int) const {
        int fr = fr_, fq = fq_; asm volatile("" : "+v"(fr), "+v"(fq));
        const int row0 = u.pm * BM + wr * 64 + fr, col0 = u.pn * BM + wc * 32 + 8 * fq;
        const float sc = (u.pn >= s_lo && u.pn < s_hi) ? scale : 1.f;
#pragma unroll
        for (int ai = 0; ai < 2; ++ai)
#pragma unroll
            for (int m = 0; m < 4; ++m) { bf16_t* rowp = O + (size_t)(row0 + ai * HALF + m * 16) * ldc + col0;
#pragma unroll
                for (int bj = 0; bj < 2; ++bj) { const f32x4 v0 = acc[ai][bj][m][0] * sc, v1 = acc[ai][bj][m][1] * sc;
                    u32x4 w; w.x = cvt_pk_bf16(v0[0], v0[1]); w.y = cvt_pk_bf16(v0[2], v0[3]); w.z = cvt_pk_bf16(v1[0], v1[1]); w.w = cvt_pk_bf16(v1[2], v1[3]);
                    *(u32x4*)(rowp + bj * HALF) = w; } }
    }
};
__device__ __forceinline__ float silu_mul(float g, float u) { return g * __builtin_amdgcn_rcpf(1.f + __expf(-g)) * u; }
__device__ __forceinline__ float silu2_mul(float g2, float u2) { return g2 * __builtin_amdgcn_rcpf(1.f + __builtin_amdgcn_exp2f(-g2)) * u2; }
struct EpiSwiglu {
    static constexpr bool PERM = true, AFTER_DRAIN = false;
    bf16_t* O; int ldc;
    struct Pre {}; __device__ __forceinline__ void prefetch(Pre&, const Unit&, int, int, int, int, int) const {} __device__ __forceinline__ void commit(const Pre&, int, int, int, int, int) const {}
    __device__ __forceinline__ void operator()(const f32x4 (&acc)[2][2][4][2], const Unit& u, int wr, int wc, int fr, int fq, const Pre&, int) const {
        const int row0 = u.pm * BM + wr * 64 + fr, col0 = u.pn * HALF + wc * 32 + 8 * fq;
#pragma unroll
        for (int ai = 0; ai < 2; ++ai)
#pragma unroll
            for (int m = 0; m < 4; ++m) { bf16_t* rowp = O + (size_t)(row0 + ai * HALF + m * 16) * ldc + col0;
                const f32x4 g0 = acc[ai][0][m][0], g1 = acc[ai][0][m][1], u0 = acc[ai][1][m][0], u1 = acc[ai][1][m][1];
                u32x4 w; w.x = cvt_pk_bf16(silu_mul(g0[0], u0[0]), silu_mul(g0[1], u0[1])); w.y = cvt_pk_bf16(silu_mul(g0[2], u0[2]), silu_mul(g0[3], u0[3]));
                w.z = cvt_pk_bf16(silu_mul(g1[0], u1[0]), silu_mul(g1[1], u1[1])); w.w = cvt_pk_bf16(silu_mul(g1[2], u1[2]), silu_mul(g1[3], u1[3]));
                *(u32x4*)rowp = w; }
    }
};
struct EpiSwigluF8 {
    static constexpr bool PERM = true, AFTER_DRAIN = false;
    unsigned char* O; int ldc;
    struct Pre {}; __device__ __forceinline__ void prefetch(Pre&, const Unit&, int, int, int, int, int) const {} __device__ __forceinline__ void commit(const Pre&, int, int, int, int, int) const {}
    __device__ __forceinline__ void operator()(const f32x4 (&acc)[2][2][4][2], const Unit& u, int wr, int wc, int fr, int fq, const Pre&, int) const {
        const int row0 = u.pm * BM + wr * 64 + fr, col0 = u.pn * HALF + wc * 32 + 8 * fq;
        constexpr float CG = 1.4426950408889634f / (F8_ASCALE * F8_GSCALE), CU = F8_HSCALE * 0.6931471805599453f / (F8_ASCALE * F8_GSCALE);
#pragma unroll
        for (int ai = 0; ai < 2; ++ai)
#pragma unroll
            for (int m = 0; m < 4; ++m) { const int row = row0 + ai * HALF + m * 16;
                const f32x4 g0 = acc[ai][0][m][0] * CG, g1 = acc[ai][0][m][1] * CG, u0 = acc[ai][1][m][0] * CU, u1 = acc[ai][1][m][1] * CU;
                float h[8];
#pragma unroll
                for (int i = 0; i < 4; ++i) { h[i] = __builtin_fminf(__builtin_fmaxf(silu2_mul(g0[i], u0[i]), -448.f), 448.f); h[4 + i] = __builtin_fminf(__builtin_fmaxf(silu2_mul(g1[i], u1[i]), -448.f), 448.f); }
                unsigned w0 = 0u, w1 = 0u; w0 = __builtin_amdgcn_cvt_pk_fp8_f32(h[0], h[1], w0, false); w0 = __builtin_amdgcn_cvt_pk_fp8_f32(h[2], h[3], w0, true);
                w1 = __builtin_amdgcn_cvt_pk_fp8_f32(h[4], h[5], w1, false); w1 = __builtin_amdgcn_cvt_pk_fp8_f32(h[6], h[7], w1, true);
                typedef unsigned u32x2 __attribute__((ext_vector_type(2))); *(u32x2*)(O + (size_t)row * ldc + col0) = (u32x2){w0, w1}; }
    }
};
struct EpiNull {
    static constexpr bool PERM = true, AFTER_DRAIN = false;
    unsigned char* O; int ldc;
    struct Pre {}; __device__ __forceinline__ void prefetch(Pre&, const Unit&, int, int, int, int, int) const {} __device__ __forceinline__ void commit(const Pre&, int, int, int, int, int) const {}
    __device__ __forceinline__ void operator()(const f32x4 (&acc)[2][2][4][2], const Unit& u, int wr, int wc, int fr, int fq, const Pre&, int) const {
        f32x4 s = (f32x4){0.f, 0.f, 0.f, 0.f};
#pragma unroll
        for (int ai = 0; ai < 2; ++ai)
#pragma unroll
            for (int bj = 0; bj < 2; ++bj)
#pragma unroll
                for (int m = 0; m < 4; ++m)
#pragma unroll
                    for (int n = 0; n < 2; ++n) s += acc[ai][bj][m][n];
        if (s[0] + s[1] + s[2] + s[3] == 12345.678f) O[(size_t)(u.pm * BM + wr * 64 + fr) * ldc + u.pn * HALF + wc * 32 + 8 * fq] = 1;
    }
};
template <bool IN_F32> struct EpiResid {
    static constexpr bool PERM = true, AFTER_DRAIN = false;
    const void* Xin; bf16_t* X; int ldc;
    struct Pre {}; __device__ __forceinline__ void prefetch(Pre&, const Unit&, int, int, int, int, int) const {} __device__ __forceinline__ void commit(const Pre&, int, int, int, int, int) const {}
    __device__ __forceinline__ void operator()(const f32x4 (&acc)[2][2][4][2], const Unit& u, int wr, int wc, int fr, int fq, const Pre&, int) const {
        const int row0 = u.pm * BM + wr * 64 + fr, col0 = u.pn * BM + wc * 32 + 8 * fq;
#pragma unroll
        for (int ai = 0; ai < 2; ++ai)
#pragma unroll
            for (int m = 0; m < 4; ++m) { const size_t ro = (size_t)(row0 + ai * HALF + m * 16) * ldc + col0;
#pragma unroll
                for (int bj = 0; bj < 2; ++bj) { f32x4 x0, x1;
                    if (IN_F32) { const float* p = (const float*)Xin + ro + bj * HALF; x0 = *(const f32x4*)p; x1 = *(const f32x4*)(p + 4); }
                    else { const u32x4 w = *(const u32x4*)((const bf16_t*)Xin + ro + bj * HALF);
                        x0 = (f32x4){__builtin_bit_cast(float, w.x << 16), __builtin_bit_cast(float, w.x & 0xffff0000u), __builtin_bit_cast(float, w.y << 16), __builtin_bit_cast(float, w.y & 0xffff0000u)};
                        x1 = (f32x4){__builtin_bit_cast(float, w.z << 16), __builtin_bit_cast(float, w.z & 0xffff0000u), __builtin_bit_cast(float, w.w << 16), __builtin_bit_cast(float, w.w & 0xffff0000u)}; }
                    const f32x4 v0 = x0 + acc[ai][bj][m][0], v1 = x1 + acc[ai][bj][m][1];
                    u32x4 o; o.x = cvt_pk_bf16(v0[0], v0[1]); o.y = cvt_pk_bf16(v0[2], v0[3]); o.z = cvt_pk_bf16(v1[0], v1[1]); o.w = cvt_pk_bf16(v1[2], v1[3]);
                    *(u32x4*)(X + ro + bj * HALF) = o; }
                asm volatile("" ::: "memory"); }
    }
};
struct EpiBf8 {
    static constexpr bool PERM = true, AFTER_DRAIN = false;
    bf16_t* O; int ldc; int s_lo, s_hi; float scale; const float* sA; const float* sB; PG8_LAS float* sc;
    struct Pre {};
    __device__ __forceinline__ void prefetch(Pre&, const Unit& u, int wr, int wc, int fr, int fq, int ui) const {
        const int wid = wr * 4 + wc, lane = fq * 16 + fr; PG8_LAS float* d = sc + (ui & 1) * 512;
        if (wid < 2) { const float* src = (wid == 0 ? sA + u.pm * BM : sB + u.pn * BM) + 4 * lane;
            __builtin_amdgcn_global_load_lds((const unsigned*)src, (PG8_LAS unsigned*)(d + 256 * wid), 16, 0, 0); }
    }
    __device__ __forceinline__ void commit(const Pre&, int, int, int, int, int) const {}
    __device__ __forceinline__ void operator()(const i32x4 (&acc)[2][2][4][2], const Unit& u, int wr, int wc, int fr, int fq, const Pre&, int ui) const {
        const int row0 = u.pm * BM + wr * 64 + fr, col0 = u.pn * BM + wc * 32 + 8 * fq; const PG8_LAS float* d = sc + (ui & 1) * 512;
        const float sc0 = (u.pn >= s_lo && u.pn < s_hi) ? scale : 1.f;
        f32x4 cb[2][2];
#pragma unroll
        for (int bj = 0; bj < 2; ++bj)
#pragma unroll
            for (int n = 0; n < 2; ++n) cb[bj][n] = *(const PG8_LAS f32x4*)(d + 256 + wc * 32 + 8 * fq + bj * HALF + 4 * n) * sc0;
#pragma unroll
        for (int ai = 0; ai < 2; ++ai)
#pragma unroll
            for (int m = 0; m < 4; ++m) { const int row = row0 + ai * HALF + m * 16; const float ra = d[wr * 64 + fr + ai * HALF + m * 16]; bf16_t* rowp = O + (size_t)row * ldc + col0;
#pragma unroll
                for (int bj = 0; bj < 2; ++bj) { const f32x4 v0 = __builtin_convertvector(acc[ai][bj][m][0], f32x4) * cb[bj][0] * ra, v1 = __builtin_convertvector(acc[ai][bj][m][1], f32x4) * cb[bj][1] * ra;
                    u32x4 w; w.x = cvt_pk_bf16(v0[0], v0[1]); w.y = cvt_pk_bf16(v0[2], v0[3]); w.z = cvt_pk_bf16(v1[0], v1[1]); w.w = cvt_pk_bf16(v1[2], v1[3]);
                    *(u32x4*)(rowp + bj * HALF) = w; } }
    }
};
template <bool F8OUT> struct EpiSwiglu8 {
    static constexpr bool PERM = true, AFTER_DRAIN = false;
    bf16_t* O; int ldc; const float* sA; const float* sB; int sb_exp; int tb1, tb2, tb3, tb4, tb5, tb6, tb7; PG8_LAS float* sc;
    struct Pre {};
    __device__ __forceinline__ void prefetch(Pre&, const Unit& u, int wr, int wc, int fr, int fq, int ui) const {
        const int wid = wr * 4 + wc, lane = fq * 16 + fr; PG8_LAS float* d = sc + (ui & 1) * 512;
        const int e = (u.pm >= tb1) + (u.pm >= tb2) + (u.pm >= tb3) + (u.pm >= tb4) + (u.pm >= tb5) + (u.pm >= tb6) + (u.pm >= tb7);
        if (wid < 2) { const float* src = (wid == 0 ? sA + u.pm * BM : sB + (size_t)e * sb_exp + u.pn * BM) + 4 * lane;
            __builtin_amdgcn_global_load_lds((const unsigned*)src, (PG8_LAS unsigned*)(d + 256 * wid), 16, 0, 0); }
    }
    __device__ __forceinline__ void commit(const Pre&, int, int, int, int, int) const {}
    __device__ __forceinline__ void operator()(const i32x4 (&acc)[2][2][4][2], const Unit& u, int wr, int wc, int fr, int fq, const Pre&, int ui) const {
        const int row0 = u.pm * BM + wr * 64 + fr, col0 = u.pn * HALF + wc * 32 + 8 * fq; const PG8_LAS float* d = sc + (ui & 1) * 512;
        const PG8_LAS float* sb = d + 256 + wc * 32 + 8 * fq;
        constexpr float CG = 1.4426950408889634f, CU = (F8OUT ? F8_HSCALE : 1.f) * 0.6931471805599453f;
        const f32x4 sg0 = *(const PG8_LAS f32x4*)sb * CG, sg1 = *(const PG8_LAS f32x4*)(sb + 4) * CG, su0 = *(const PG8_LAS f32x4*)(sb + HALF) * CU, su1 = *(const PG8_LAS f32x4*)(sb + HALF + 4) * CU;
#pragma unroll
        for (int ai = 0; ai < 2; ++ai)
#pragma unroll
            for (int m = 0; m < 4; ++m) { const int row = row0 + ai * HALF + m * 16; const float ra = d[wr * 64 + fr + ai * HALF + m * 16];
                const f32x4 g0 = __builtin_convertvector(acc[ai][0][m][0], f32x4) * sg0 * ra, g1 = __builtin_convertvector(acc[ai][0][m][1], f32x4) * sg1 * ra;
                const f32x4 u0 = __builtin_convertvector(acc[ai][1][m][0], f32x4) * su0 * ra, u1 = __builtin_convertvector(acc[ai][1][m][1], f32x4) * su1 * ra;
                if constexpr (F8OUT) { float h[8];
#pragma unroll
                    for (int i = 0; i < 4; ++i) { h[i] = __builtin_fminf(__builtin_fmaxf(silu2_mul(g0[i], u0[i]), -448.f), 448.f); h[4 + i] = __builtin_fminf(__builtin_fmaxf(silu2_mul(g1[i], u1[i]), -448.f), 448.f); }
                    unsigned w0 = 0u, w1 = 0u; w0 = __builtin_amdgcn_cvt_pk_fp8_f32(h[0], h[1], w0, false); w0 = __builtin_amdgcn_cvt_pk_fp8_f32(h[2], h[3], w0, true);
                    w1 = __builtin_amdgcn_cvt_pk_fp8_f32(h[4], h[5], w1, false); w1 = __builtin_amdgcn_cvt_pk_fp8_f32(h[6], h[7], w1, true);
                    typedef unsigned u32x2 __attribute__((ext_vector_type(2))); *(u32x2*)((unsigned char*)O + (size_t)row * ldc + col0) = (u32x2){w0, w1}; }
                else { bf16_t* rowp = O + (size_t)row * ldc + col0;
                u32x4 w; w.x = cvt_pk_bf16(silu2_mul(g0[0], u0[0]), silu2_mul(g0[1], u0[1])); w.y = cvt_pk_bf16(silu2_mul(g0[2], u0[2]), silu2_mul(g0[3], u0[3]));
                w.z = cvt_pk_bf16(silu2_mul(g1[0], u1[0]), silu2_mul(g1[1], u1[1])); w.w = cvt_pk_bf16(silu2_mul(g1[2], u1[2]), silu2_mul(g1[3], u1[3]));
                *(u32x4*)rowp = w; } }
    }
};
struct GOrder {
    StaticOrder so; const char* A; const char* B; size_t a_tile, b_tile, b_exp; int tb1, tb2, tb3, tb4, tb5, tb6, tb7;
    __device__ __forceinline__ bool next(int i, Unit& u) const { return so.next(i, u); }
    __device__ __forceinline__ const char* a_base(const Unit& u) const { return A + (size_t)u.pm * a_tile; }
    __device__ __forceinline__ const char* b_base(const Unit& u) const {
        const int e = (u.pm >= tb1) + (u.pm >= tb2) + (u.pm >= tb3) + (u.pm >= tb4) + (u.pm >= tb5) + (u.pm >= tb6) + (u.pm >= tb7);
        return B + (size_t)e * b_exp + (size_t)u.pn * b_tile; }
    __device__ __forceinline__ int nt(const Unit&, int full) const { return full; }
    __device__ __forceinline__ void a_ready(const Unit&) const {}
    __device__ __forceinline__ void done(const Unit&) const {}
};
struct GOrderTail {
    static constexpr int MAIN_M = 128, NTF = 28;
    StaticOrder so; const char* A; const char* B; size_t a_tile, b_tile, b_exp; int tb1, tb2, tb3, tb4, tb5, tb6, tb7; int n_main, n_piece;
    __device__ __forceinline__ void init(int n_mtiles, int N, int G, int c) { so.init(MAIN_M * BM, N, G, c); n_main = c < so.nwg ? (so.nwg - c + G - 1) / G : 0; n_piece = (n_mtiles - MAIN_M) * 4 * 8; }
    __device__ __forceinline__ bool next(int i, Unit& u) const {
        const bool mainu = i < n_main; const int q = (i - n_main) * so.G + so.c, ut = q >> 3;
        Unit m; m.pm = 0; m.pn = 0; m.tq = -1; so.next(mainu ? i : 0, m);
        u.pm = mainu ? m.pm : MAIN_M + (ut >> 2); u.pn = mainu ? m.pn : (ut & 3); u.tq = mainu ? -1 : q;
        return mainu || q < n_piece; }
    __device__ __forceinline__ int nt(const Unit& u, int full) const { return u.tq < 0 ? full : ((u.tq & 7) < 6 ? 4 : 2); }
    __device__ __forceinline__ const char* a_base(const Unit& u) const { const int kp = u.tq & 7, k0 = u.tq < 0 ? 0 : (kp < 6 ? 4 * kp : 2 * kp + 12); return A + (size_t)u.pm * a_tile + (size_t)k0 * (BK * 2); }
    __device__ __forceinline__ const char* b_base(const Unit& u) const {
        const int e = (u.pm >= tb1) + (u.pm >= tb2) + (u.pm >= tb3) + (u.pm >= tb4) + (u.pm >= tb5) + (u.pm >= tb6) + (u.pm >= tb7);
        const int kp = u.tq & 7, k0 = u.tq < 0 ? 0 : (kp < 6 ? 4 * kp : 2 * kp + 12);
        return B + (size_t)e * b_exp + (size_t)u.pn * b_tile + (size_t)k0 * (BK * 2); }
    __device__ __forceinline__ void a_ready(const Unit&) const {}
    __device__ __forceinline__ void done(const Unit&) const {}
};
struct EpiBfPart {
    static constexpr bool PERM = true, AFTER_DRAIN = false; static constexpr int YP_TILE0 = 136;
    bf16_t* O; int ldc; float scale;
    struct Pre {}; __device__ __forceinline__ void prefetch(Pre&, const Unit&, int, int, int, int, int) const {} __device__ __forceinline__ void commit(const Pre&, int, int, int, int, int) const {}
    __device__ __forceinline__ void operator()(const f32x4 (&acc)[2][2][4][2], const Unit& u, int wr, int wc, int fr_, int fq_, const Pre&, int) const {
        int fr = fr_, fq = fq_; asm volatile("" : "+v"(fr), "+v"(fq));
        const int vt = u.tq < 0 ? u.pm : YP_TILE0 + (u.tq & 7) * 8 + (u.pm - GOrderTail::MAIN_M);
        const int row0 = vt * BM + wr * 64 + fr, col0 = u.pn * BM + wc * 32 + 8 * fq;
#pragma unroll
        for (int ai = 0; ai < 2; ++ai)
#pragma unroll
            for (int m = 0; m < 4; ++m) { bf16_t* rowp = O + (size_t)(row0 + ai * HALF + m * 16) * ldc + col0;
#pragma unroll
                for (int bj = 0; bj < 2; ++bj) { const f32x4 v0 = acc[ai][bj][m][0] * scale, v1 = acc[ai][bj][m][1] * scale;
                    u32x4 w; w.x = cvt_pk_bf16(v0[0], v0[1]); w.y = cvt_pk_bf16(v0[2], v0[3]); w.z = cvt_pk_bf16(v1[0], v1[1]); w.w = cvt_pk_bf16(v1[2], v1[3]);
                    *(u32x4*)(rowp + bj * HALF) = w; } }
    }
};
template <class Epi, class Sched, bool ALIGN_EPI = false, bool SP2 = false, int MODE = 0  , int XEXP = 0  >
__device__ __forceinline__ void gemm_phase(PG8_LAS unsigned char* lds, const Gemm g, const Sched& S, const Epi& E) {
    const int tid = threadIdx.x, wid = __builtin_amdgcn_readfirstlane(tid >> 6), lane = tid & 63, wr = wid >> 2, wc = wid & 3, fr = lane & 15, fq = lane >> 4;
    const int K = g.K, nt = K / BK;
    unsigned voffA[2], voffB[2];
#pragma unroll
    for (int i = 0; i < 2; ++i) { int R, C; stage_rc(tid * 16 + i * 8192, R, C); const int Rb = Epi::PERM ? ((R & ~31) + perm32(R & 31)) : R;
        voffA[i] = (unsigned)(R * K + C) * 2u; voffB[i] = (unsigned)(Rb * K + C) * 2u; }
    const size_t kstep = (size_t)(BK * 2);
    const size_t hstep = (size_t)HALF * K * 2;
        const unsigned ldsw = (unsigned)wid * 1024u;
    const int aoff = lds_byte(wr * 64 + fr, fq * 8), boff = lds_byte(wc * 32 + fr, fq * 8);
#define PG8_SA(b, h) (((b) * 2 + (h)) * HTB)
#define PG8_SB(b, h) ((4 + (b) * 2 + (h)) * HTB)
#define PG8_STAGE(bufoff, gbase, voff) do { if constexpr (XEXP != 2) _Pragma("unroll") for (int _i = 0; _i < 2; ++_i) \
        __builtin_amdgcn_global_load_lds((const unsigned*)((const char*)(gbase) + (voff)[_i]), (PG8_LAS unsigned*)(lds + (bufoff) + ldsw + _i * 8192), 16, 0, 0); } while (0)
#define PG8_LDA(dst, b, h) do { if constexpr (XEXP < 3) _Pragma("unroll") for (int m = 0; m < 4; ++m) dst[m] = ldfrag<MODE>(lds + PG8_SA(b, h) + aoff + m * 2048); } while (0)
#define PG8_LDB(dst, b, h) do { if constexpr (XEXP < 3) _Pragma("unroll") for (int n = 0; n < 2; ++n) dst[n] = ldfrag<MODE>(lds + PG8_SB(b, h) + boff + n * 2048); } while (0)
#define PG8_MMA(ai, bj, At, Bt) do { __builtin_amdgcn_s_setprio(1); _Pragma("unroll") for (int m = 0; m < 4; ++m) _Pragma("unroll") for (int n = 0; n < 2; ++n) \
        mma_step<MODE>(acc[ai][bj][m][n], Bt[n], At[m]); __builtin_amdgcn_s_setprio(0); } while (0)
#define PG8_WAIT_V(n) do { if constexpr (XEXP != 1) asm volatile("s_waitcnt vmcnt(" #n ")" ::: "memory"); } while (0)
#define PG8_WAIT_L(n) asm volatile("s_waitcnt lgkmcnt(" #n ")" ::: "memory")
#define PG8_BAR do { if constexpr (XEXP < 4) __builtin_amdgcn_s_barrier(); } while (0)
#define PG8_SCHED __builtin_amdgcn_sched_barrier(0)
    Unit cur, nxt; int ui = 0; typename Epi::Pre pre;
    if (!S.next(0, cur)) return;
    typename AccT<MODE == 1>::type acc[2][2][4][2];
#pragma unroll
    for (int a = 0; a < 2; ++a)
#pragma unroll
        for (int b = 0; b < 2; ++b)
#pragma unroll
            for (int m = 0; m < 4; ++m)
#pragma unroll
                for (int n = 0; n < 2; ++n) acc[a][b][m][n] = typename AccT<MODE == 1>::type{};
    typename Frag<MODE>::type At[4], B0[2], B1[2];
    const char* cA = S.a_base(cur); const char* cB = S.b_base(cur);
    S.a_ready(cur);
    if constexpr (SP2) {
        PG8_STAGE(PG8_SB(0, 0), cB, voffB); PG8_STAGE(PG8_SB(0, 1), cB + hstep, voffB); PG8_STAGE(PG8_SA(0, 0), cA, voffA); PG8_STAGE(PG8_SA(0, 1), cA + hstep, voffA);
        if (wr == 1) PG8_BAR;
        PG8_WAIT_V(2); PG8_BAR;
        PG8_STAGE(PG8_SB(1, 0), cB + kstep, voffB); PG8_STAGE(PG8_SA(1, 0), cA + kstep, voffA); PG8_STAGE(PG8_SB(1, 1), cB + hstep + kstep, voffB);
        PG8_WAIT_V(6); PG8_BAR;
    } else {
        PG8_STAGE(PG8_SB(0, 0), cB, voffB); PG8_STAGE(PG8_SA(0, 0), cA, voffA); PG8_STAGE(PG8_SB(0, 1), cB + hstep, voffB); PG8_STAGE(PG8_SA(0, 1), cA + hstep, voffA);
        if (wr == 1) PG8_BAR;
        PG8_WAIT_V(4); PG8_BAR;
        PG8_STAGE(PG8_SB(1, 0), cB + kstep, voffB); PG8_STAGE(PG8_SA(1, 0), cA + kstep, voffA); PG8_STAGE(PG8_SB(1, 1), cB + hstep + kstep, voffB);
        PG8_WAIT_V(6); PG8_BAR;
    }
    for (;;) {
        const bool has_next = S.next(ui + 1, nxt);
        const char* nA = has_next ? S.a_base(nxt) : cA; const char* nB = has_next ? S.b_base(nxt) : cB;
        const int ntc = S.nt(cur, nt);
        for (int t = 0; t < ntc; t += 2) {
            const bool last = (t == ntc - 2);
            const char* a1 = cA + (size_t)(t + 1) * kstep;
            const char* a2 = last ? nA : cA + (size_t)(t + 2) * kstep; const char* b2 = last ? nB : cB + (size_t)(t + 2) * kstep;
            const char* a3 = a2 + kstep; const char* b3 = b2 + kstep;
            if (last && has_next) S.a_ready(nxt);
            if (last) E.prefetch(pre, cur, wr, wc, fr, fq, ui);
            if constexpr (SP2) {
            PG8_LDB(B0, 0, 0); PG8_LDB(B1, 0, 1); PG8_SCHED; PG8_LDA(At, 0, 0); PG8_STAGE(PG8_SA(1, 1), a1 + hstep, voffA);
            PG8_WAIT_V(8); PG8_WAIT_L(0); PG8_BAR; PG8_MMA(0, 0, At, B0); PG8_MMA(0, 1, At, B1); PG8_BAR; PG8_SCHED;
            PG8_LDA(At, 0, 1); PG8_STAGE(PG8_SB(0, 0), b2, voffB); PG8_STAGE(PG8_SB(0, 1), b2 + hstep, voffB); PG8_STAGE(PG8_SA(0, 0), a2, voffA);
            PG8_WAIT_V(8); PG8_WAIT_L(0); PG8_BAR; PG8_MMA(1, 0, At, B0); PG8_MMA(1, 1, At, B1); PG8_BAR; PG8_SCHED;
            PG8_LDB(B0, 1, 0); PG8_LDB(B1, 1, 1); PG8_SCHED; PG8_LDA(At, 1, 0); PG8_STAGE(PG8_SA(0, 1), a2 + hstep, voffA);
            PG8_WAIT_V(8); PG8_WAIT_L(0); PG8_BAR; PG8_MMA(0, 0, At, B0); PG8_MMA(0, 1, At, B1); PG8_BAR; PG8_SCHED;
            PG8_LDA(At, 1, 1); PG8_STAGE(PG8_SB(1, 0), b3, voffB); PG8_STAGE(PG8_SB(1, 1), b3 + hstep, voffB); PG8_STAGE(PG8_SA(1, 0), a3, voffA);
            PG8_WAIT_V(8); PG8_WAIT_L(0); PG8_BAR; PG8_MMA(1, 0, At, B0); PG8_MMA(1, 1, At, B1); PG8_BAR; PG8_SCHED;
            } else {
            PG8_LDB(B0, 0, 0); PG8_SCHED; PG8_LDA(At, 0, 0); PG8_STAGE(PG8_SA(1, 1), a1 + hstep, voffA);
            PG8_WAIT_L(8); PG8_BAR; PG8_WAIT_L(0); PG8_MMA(0, 0, At, B0); PG8_BAR; PG8_SCHED;
            PG8_LDB(B1, 0, 1); PG8_STAGE(PG8_SB(0, 0), b2, voffB);
            PG8_BAR; PG8_WAIT_L(0); PG8_MMA(0, 1, At, B1); PG8_BAR;
            PG8_LDA(At, 0, 1); PG8_STAGE(PG8_SA(0, 0), a2, voffA);
            PG8_BAR; PG8_WAIT_L(0); PG8_MMA(1, 0, At, B0); PG8_BAR; PG8_SCHED;
            PG8_STAGE(PG8_SB(0, 1), b2 + hstep, voffB);
            PG8_WAIT_V(6); PG8_BAR; PG8_MMA(1, 1, At, B1); PG8_BAR;
            PG8_LDB(B0, 1, 0); PG8_SCHED; PG8_LDA(At, 1, 0); PG8_STAGE(PG8_SA(0, 1), a2 + hstep, voffA);
            PG8_WAIT_L(8); PG8_BAR; PG8_WAIT_L(0); PG8_MMA(0, 0, At, B0); PG8_BAR; PG8_SCHED;
            PG8_LDB(B1, 1, 1); PG8_STAGE(PG8_SB(1, 0), b3, voffB);
            PG8_BAR; PG8_WAIT_L(0); PG8_MMA(0, 1, At, B1); PG8_BAR;
            PG8_LDA(At, 1, 1); PG8_STAGE(PG8_SA(1, 0), a3, voffA);
            PG8_BAR; PG8_WAIT_L(0); PG8_MMA(1, 0, At, B0); PG8_BAR; PG8_SCHED;
            PG8_STAGE(PG8_SB(1, 1), b3 + hstep, voffB);
            PG8_WAIT_V(6); PG8_BAR; PG8_MMA(1, 1, At, B1); PG8_BAR;
            }
        }
        E.commit(pre, wr, wc, fr, fq, ui);
        if constexpr (ALIGN_EPI) { if (wr == 0) PG8_BAR; }
        if constexpr (MODE == 2) asm volatile("s_nop 15\n\ts_nop 7" ::: "memory");
        if constexpr (!Epi::AFTER_DRAIN) { E(acc, cur, wr, wc, fr, fq, pre, ui); S.done(cur); }
        if (!has_next) break;
#pragma unroll
        for (int a = 0; a < 2; ++a)
#pragma unroll
            for (int b = 0; b < 2; ++b)
#pragma unroll
                for (int m = 0; m < 4; ++m)
#pragma unroll
                    for (int n = 0; n < 2; ++n) acc[a][b][m][n] = typename AccT<MODE == 1>::type{};
        cur = nxt; cA = nA; cB = nB; ++ui;
        if constexpr (ALIGN_EPI) { if (wr == 1) PG8_BAR; }
    }
    PG8_WAIT_V(0);
    if constexpr (!ALIGN_EPI) { if (wr == 0) PG8_BAR; }
    PG8_BAR;
    if constexpr (Epi::AFTER_DRAIN) { E.fused(acc, cur, wr, wc, fr, fq, lds, wid, lane); S.done(cur); }
#undef PG8_SA
#undef PG8_SB
#undef PG8_STAGE
#undef PG8_LDA
#undef PG8_LDB
#undef PG8_MMA
#undef PG8_WAIT_V
#undef PG8_WAIT_L
#undef PG8_BAR
#undef PG8_SCHED
}
}
#include <hip/hip_bf16.h>
#include <cmath>
namespace attn_body {
using bf16=__hip_bfloat16;
using bf16x8=__attribute__((ext_vector_type(8)))short;
using s16x4=__attribute__((ext_vector_type(4)))short;
using f32x16=__attribute__((ext_vector_type(16)))float;
using u32x4=__attribute__((ext_vector_type(4)))unsigned;
constexpr int BATCH=2,NHEAD=8,SEQ=8192,D=64,DM=3584,OPITCH=1024;
constexpr int NW=8,QBLK=32,QB=QBLK*NW,KVBLK=64,NQB=SEQ/QB;
constexpr int ATTN_PITCH=DM, ATTN_UNIT_ROWS=QB;
__device__ __forceinline__ int crow(int r,int hi){return (r&3)+8*(r>>2)+4*hi;}
#define SBAR() __builtin_amdgcn_sched_barrier(0)
__device__ __forceinline__ void cmask(f32x16&p0,f32x16&p1,int jb,int qrel,int hi){
  const float NEG=-INFINITY; int kb=64*jb+4*hi;
  #pragma unroll
  for(int r=0;r<16;++r){int kv=kb+(r&3)+8*(r>>2); if(kv>qrel)p0[r]=NEG; if(kv+32>qrel)p1[r]=NEG;}
}

constexpr int NSLOT=3, SLOTB=8192, SPLIT_NT=72, PART_F=256*64+512;
constexpr int LDS_K=0, LDS_V=NSLOT*SLOTB, LDS_WS=2*NSLOT*SLOTB, LDS_OST=LDS_WS+NW*64*4, LDS_CK=LDS_OST+NW*4096, LDS_BYTES=LDS_CK+SEQ*4;
constexpr float C2=0.125f*1.4426950408889634f;
__device__ __forceinline__ void glds16(const void*gsrc,unsigned lds_dst){unsigned keep;
  asm volatile("s_mov_b32 %0, m0\n\ts_mov_b32 m0, %2\n\ts_nop 0\n\tglobal_load_lds_dwordx4 %1, off\n\ts_mov_b32 m0, %0":"=&s"(keep):"v"(gsrc),"s"(lds_dst):"memory");}
__device__ __forceinline__ float max3f(float a,float b,float c){float r;asm("v_max3_f32 %0, %1, %2, %3":"=v"(r):"v"(a),"v"(b),"v"(c));return r;}
__device__ __forceinline__ float max2f(float a,float b){float r;asm("v_max_f32_e32 %0, %1, %2":"=v"(r):"v"(a),"v"(b));return r;}
__device__ __forceinline__ float fadd_s(float a,float b){float r;asm("v_add_f32_e32 %0, %1, %2":"=v"(r):"v"(a),"v"(b));return r;}
__device__ __forceinline__ float fsub_s(float a,float b){float r;asm("v_sub_f32_e32 %0, %1, %2":"=v"(r):"v"(a),"v"(b));return r;}
typedef float f32x2_t __attribute__((ext_vector_type(2))); typedef float f32x4_t __attribute__((ext_vector_type(4))); typedef __bf16 bf16x2_t __attribute__((ext_vector_type(2)));
__device__ __forceinline__ unsigned cvtpk_s(float lo,float hi){f32x2_t v={lo,hi};bf16x2_t b=__builtin_convertvector(v,bf16x2_t);return __builtin_bit_cast(unsigned,b);}
#define WAIT_BAR(N) asm volatile("s_waitcnt vmcnt(" #N ") lgkmcnt(0)\n\ts_barrier":::"memory")

__device__ __forceinline__ void qkt(f32x16&p0,f32x16&p1,const char*Kslot,const bf16x8*qr,const f32x16&negm,int r32,int hi){
  const char*kb=Kslot+hi*1024+r32*16;
  #pragma unroll
  for(int d0=0;d0<4;++d0){
    const bf16x8 b0=*reinterpret_cast<const bf16x8*>(kb+d0*2048);
    const bf16x8 b1=*reinterpret_cast<const bf16x8*>(kb+d0*2048+512);
    if(d0==0){p0=__builtin_amdgcn_mfma_f32_32x32x16_bf16(b0,qr[0],negm,0,0,0);p1=__builtin_amdgcn_mfma_f32_32x32x16_bf16(b1,qr[0],negm,0,0,0);}
    else{p0=__builtin_amdgcn_mfma_f32_32x32x16_bf16(b0,qr[d0],p0,0,0,0);p1=__builtin_amdgcn_mfma_f32_32x32x16_bf16(b1,qr[d0],p1,0,0,0);}}
}
typedef __attribute__((address_space(3))) const char* lds_cptr;
typedef short v4i16_t __attribute__((ext_vector_type(4)));
__device__ __forceinline__ void kload8(bf16x8*kf,lds_cptr kp){
  kf[0]=*(const __attribute__((address_space(3))) bf16x8*)(kp);      kf[1]=*(const __attribute__((address_space(3))) bf16x8*)(kp+512);
  kf[2]=*(const __attribute__((address_space(3))) bf16x8*)(kp+2048); kf[3]=*(const __attribute__((address_space(3))) bf16x8*)(kp+2560);
  kf[4]=*(const __attribute__((address_space(3))) bf16x8*)(kp+4096); kf[5]=*(const __attribute__((address_space(3))) bf16x8*)(kp+4608);
  kf[6]=*(const __attribute__((address_space(3))) bf16x8*)(kp+6144); kf[7]=*(const __attribute__((address_space(3))) bf16x8*)(kp+6656);
}
__device__ __forceinline__ void kload2(bf16x8*kf,lds_cptr kp,int j){ kf[2*j]=*(const __attribute__((address_space(3))) bf16x8*)(kp+j*2048); kf[2*j+1]=*(const __attribute__((address_space(3))) bf16x8*)(kp+j*2048+512); }
__device__ __forceinline__ s16x4 vtr(lds_cptr p){ return __builtin_bit_cast(s16x4,__builtin_amdgcn_ds_read_tr16_b64_v4i16((__attribute__((address_space(3))) v4i16_t*)p)); }
__device__ __forceinline__ float rowmax(const f32x16&p0,const f32x16&p1){
  float a=max3f(p0[0],p0[1],p1[0]),b=max3f(p0[2],p0[3],p1[1]);a=max3f(a,p1[2],p1[3]);
  #pragma unroll
  for(int r=4;r<16;r+=4){a=max3f(a,p0[r],p0[r+1]);b=max3f(b,p0[r+2],p0[r+3]);a=max3f(a,p1[r],p1[r+1]);b=max3f(b,p1[r+2],p1[r+3]);}
  const float m=max2f(a,b);
  auto rr=__builtin_amdgcn_permlane32_swap(__float_as_uint(m),__float_as_uint(m),false,false);
  return max2f(__uint_as_float(rr[0]),__uint_as_float(rr[1]));
}
__device__ __forceinline__ void pv(f32x16*o,int vb,bf16x8 pa0,bf16x8 pa1,bf16x8 pa2,bf16x8 pa3){
  #pragma unroll
  for(int d0=0;d0<2;++d0){s16x4 lo[4],hi[4];
    #pragma unroll
    for(int ks=0;ks<4;++ks){
      asm volatile("ds_read_b64_tr_b16 %0,%1 offset:%c2":"=&v"(lo[ks]):"v"(vb),"i"(d0*4096+ks*1024):"memory");
      asm volatile("ds_read_b64_tr_b16 %0,%1 offset:%c2":"=&v"(hi[ks]):"v"(vb),"i"(d0*4096+ks*1024+512):"memory");}
    asm volatile("s_waitcnt lgkmcnt(0)":::"memory");SBAR();
    #define PK(k) (bf16x8){lo[k][0],lo[k][1],lo[k][2],lo[k][3],hi[k][0],hi[k][1],hi[k][2],hi[k][3]}
    o[d0]=__builtin_amdgcn_mfma_f32_32x32x16_bf16(pa0,PK(0),o[d0],0,0,0);
    o[d0]=__builtin_amdgcn_mfma_f32_32x32x16_bf16(pa1,PK(1),o[d0],0,0,0);
    o[d0]=__builtin_amdgcn_mfma_f32_32x32x16_bf16(pa2,PK(2),o[d0],0,0,0);
    o[d0]=__builtin_amdgcn_mfma_f32_32x32x16_bf16(pa3,PK(3),o[d0],0,0,0);
    #undef PK
  }
}

#ifndef ATTN_STORE16
#define ATTN_STORE16(p,v) (*(u32x4*)(p)=(v))
#endif
template<int THRL> __device__ __forceinline__ void attn_unit(int b,int h,int qb,const bf16*Q,const bf16*__restrict__ K,const bf16*__restrict__ V,bf16*O,const float*__restrict__ cf,const float Tskip,const int part,float*PART,unsigned*flag,char*shm){
  int tid_=threadIdx.x; asm volatile("":"+v"(tid_));
  const int tid=tid_,lane=tid&63,r32=lane&31,hi=lane>>5; const int wid=__builtin_amdgcn_readfirstlane(tid>>6);
  const long rowbase=(long)b*SEQ; const int q0=qb*QB;
  const bf16*Qw=Q+(rowbase+q0+wid*QBLK)*DM+h*D;
  const unsigned lds0=(unsigned)(uintptr_t)shm;
  float*wsf=(float*)(shm+LDS_WS)+wid*64;
  const unsigned kdst=lds0+LDS_K+wid*1024, vdst=lds0+LDS_V+wid*1024;
  #define DMA_K(t,slot) glds16(ksrc+(long)(t)*KVBLK*DM,(unsigned)__builtin_amdgcn_readfirstlane(kdst+(slot)))
  #define DMA_V(t,slot) glds16(vsrc+(long)(t)*KVBLK*DM,(unsigned)__builtin_amdgcn_readfirstlane(vdst+(slot)))
  const int vb0=(int)(lds0+LDS_V)+((lane>>4)&1)*32+(lane&3)*8+(4*hi+((lane&15)>>2))*64;
  const char*Kbase=shm+LDS_K; bf16x8 kf[8];
  const lds_cptr shm3=(lds_cptr)shm; const lds_cptr kp0=shm3+LDS_K+hi*1024+r32*16; const lds_cptr vp0=shm3+LDS_V+((lane>>4)&1)*32+(lane&3)*8+(4*hi+((lane&15)>>2))*64;
  typedef __attribute__((address_space(3))) float lds_f32; typedef __attribute__((address_space(3))) const f32x4_t* lds_cf4;
  const int NT0=(q0+QB)/KVBLK;
  int tb;
  { const float thr=cf[q0]+Tskip; const int t1=lane,t2=lane+64;
    const bool n1=(t1<NT0)&&(cf[64*t1+63]>thr), n2=(t2<NT0)&&(cf[64*t2+63]>thr);
    const int t0=(int)__popcll(__ballot(n1))+(int)__popcll(__ballot(n2));
    tb=t0&~1; if(tb>NT0-4)tb=NT0-4; tb=__builtin_amdgcn_readfirstlane(tb); }
  int NT=NT0-tb; bool band=true; const bool split=(PART!=nullptr)&&(NT>SPLIT_NT);
  if(PART!=nullptr){ if(!split){ if(part==1)return; } else { const int mid=(NT>>1)&~1; if(part==0){NT=mid;band=false;} else {tb+=mid;NT-=mid;} } }
  { lds_f32* ckw=(lds_f32*)((lds_cptr)shm+LDS_CK); int i0_=tb*KVBLK+tid; asm volatile("":"+v"(i0_)); _Pragma("nounroll") for(int i=i0_;i<q0+QB;i+=NW*64)ckw[i]=cf[i]; }
  const float cq=cf[q0+wid*QBLK+(lane&31)];
  asm volatile("s_waitcnt vmcnt(0) lgkmcnt(0)\n\ts_barrier":::"memory");
  const bf16*Kh=K+(rowbase+(long)tb*KVBLK)*DM+h*D,*Vh=V+(rowbase+(long)tb*KVBLK)*DM+h*D;
  const bf16*ksrc=Kh+(long)lane*DM+wid*8;
  const bf16*vsrc=Vh+(long)(16*(wid&3)+(lane>>2))*DM+(wid>>2)*32+(lane&3)*8;
  const lds_cptr ckl=(lds_cptr)shm+LDS_CK+256*tb+16*(lane>>5);
  #define CBIAS(P0,P1,t) do{ const lds_cptr cb_=ckl+256*(t); _Pragma("unroll") for(int g_=0;g_<4;++g_){ const f32x4_t a_=*(lds_cf4)(cb_+32*g_), b_=*(lds_cf4)(cb_+128+32*g_); \
      _Pragma("unroll") for(int i_=0;i_<4;++i_){ P0[4*g_+i_]-=(a_[i_]+mm); P1[4*g_+i_]-=(b_[i_]+mm); } } }while(0)
  f32x4_t cbA[4],cbB[4]; float clast;
  #define CBLD(t) do{ const lds_cptr cb_=ckl+256*(t); _Pragma("unroll") for(int g_=0;g_<4;++g_){ cbA[g_]=*(lds_cf4)(cb_+32*g_); cbB[g_]=*(lds_cf4)(cb_+128+32*g_); } \
      clast=*(const __attribute__((address_space(3))) float*)((lds_cptr)shm+LDS_CK+256*tb+256*(t)+252); }while(0)
  DMA_K(0,0);DMA_V(0,0);DMA_K(1,SLOTB);
  bf16x8 qr[4];
  #pragma unroll
  for(int d0=0;d0<4;++d0)qr[d0]=*reinterpret_cast<const bf16x8*>(&Qw[(long)r32*DM+d0*16+hi*8]);
  float mhat=0.f,l_reg=0.f;f32x16 o[2];o[0]=f32x16{};o[1]=f32x16{};float mm=-cq; const f32x16 negm=f32x16{};
  const int qrel=wid*QBLK+r32;
  #define CMASK(P0,P1,t) do{int jb_=(t)-(NT-4); if(band&&jb_>=0)cmask(P0,P1,jb_,qrel,hi);}while(0)
  bool resc=false;
  #define START(P0,P1) do{ const float rm=rowmax(P0,P1); resc=false; \
    { const float dl=rm; mhat=fadd_s(mhat,dl); \
      _Pragma("unroll") for(int r=0;r<16;++r){P0[r]=fsub_s(P0[r],dl);P1[r]=fsub_s(P1[r],dl);} \
      mm+=dl; } \
    _Pragma("unroll") for(int r=0;r<16;++r)P0[r]=__builtin_amdgcn_exp2f(P0[r]); }while(0)
  #define RESC() do{ if(resc){ asm volatile("s_waitcnt lgkmcnt(0)":::"memory"); \
      _Pragma("unroll") for(int d_=0;d_<2;++d_) _Pragma("unroll") for(int r=0;r<16;++r)o[d_][r]*=wsf[crow(r,hi)]; } }while(0)
  f32x16 pA0,pA1,pB0,pB1;
  int sl_prev=0,sl_cur=0,sl_next=SLOTB;
  #define ROT() do{sl_prev=sl_cur;sl_cur=sl_next;sl_next=(sl_next==(NSLOT-1)*SLOTB)?0:sl_next+SLOTB;}while(0)
  DMA_K(2,2*SLOTB);
  WAIT_BAR(3);
  qkt(pA0,pA1,Kbase,qr,negm,r32,hi);asm volatile("s_nop 15\n\ts_nop 7":"+v"(pA0),"+v"(pA1));CBIAS(pA0,pA1,0);CMASK(pA0,pA1,0);
  START(pA0,pA1);
  _Pragma("unroll") for(int r=0;r<16;++r)pA1[r]=__builtin_amdgcn_exp2f(pA1[r]);
  WAIT_BAR(0);
  DMA_K(3,0);DMA_V(1,SLOTB);
  ROT();
  kload8(kf,kp0+sl_cur);
  WAIT_BAR(2);
  s16x4 vlo[8],vhi[8]; u32x4 pw0,pw1,pw2,pw3;
  #define PKW(P,B) cvtpk_s(P[B],P[B+1])
  #define PAF(k) __builtin_bit_cast(bf16x8,pw##k)
  #define VFR(i) (bf16x8){vlo[i][0],vlo[i][1],vlo[i][2],vlo[i][3],vhi[i][0],vhi[i][1],vhi[i][2],vhi[i][3]}
  #define PIN(x) asm volatile("":"+v"(x))
  #define MX3(a,b,c) __builtin_fmaxf(__builtin_fmaxf((a),(b)),(c))
  #define GAPA(MF,A0,A1,A2,A3,W0,W1,PW) do{ MF; sacc+=A0; sacc+=A1; sacc+=A2; sacc+=A3; PIN(sacc); W0; W1; PIN(PW); SBAR(); }while(0)
  #define EX(v) __builtin_amdgcn_exp2f(v)
  #define GAPB(MF,X,B,CB) do{ MF; { const f32x4_t t_=(CB)+mm; X[B]=EX(X[B]-t_[0]); X[B+1]=EX(X[B+1]-t_[1]); X[B+2]=EX(X[B+2]-t_[2]); X[B+3]=EX(X[B+3]-t_[3]); } PIN(X); SBAR(); }while(0)
  #define VRD(i) do{ vlo[i]=vtr(vp_+(((i)>>2)*4096+((i)&3)*1024)); vhi[i]=vtr(vp_+(((i)>>2)*4096+((i)&3)*1024+512)); }while(0)
  #define KRD(G,j) do{ if(G){ kload2(kf,kp0+sl_next,j); SBAR(); } }while(0)
  #define STEP(C0,C1,P0,P1,t,GK,GV,GL) do{ SBAR(); \
    const lds_cptr vp_=vp0+sl_prev; \
    VRD(0); SBAR(); float sacc=(P0[0]+P0[1]); \
    GAPA(C0=__builtin_amdgcn_mfma_f32_32x32x16_bf16(kf[0],qr[0],negm,0,0,0), P0[2],P0[3],P0[4],P0[5],     pw0[0]=PKW(P0,0), pw0[1]=PKW(P0,2), pw0); \
    VRD(4); SBAR(); GAPA(C1=__builtin_amdgcn_mfma_f32_32x32x16_bf16(kf[1],qr[0],negm,0,0,0), P0[6],P0[7],P0[8],P0[9],     pw0[2]=PKW(P0,4), pw0[3]=PKW(P0,6), pw0); \
    VRD(1); SBAR(); GAPA(C0=__builtin_amdgcn_mfma_f32_32x32x16_bf16(kf[2],qr[1],C0,0,0,0),   P0[10],P0[11],P0[12],P0[13], pw1[0]=PKW(P0,8), pw1[1]=PKW(P0,10), pw1); \
    VRD(5); SBAR(); GAPA(C1=__builtin_amdgcn_mfma_f32_32x32x16_bf16(kf[3],qr[1],C1,0,0,0),   P0[14],P0[15],P1[0],P1[1],   pw1[2]=PKW(P0,12),pw1[3]=PKW(P0,14), pw1); \
    VRD(2); SBAR(); GAPA(C0=__builtin_amdgcn_mfma_f32_32x32x16_bf16(kf[4],qr[2],C0,0,0,0),   P1[2],P1[3],P1[4],P1[5],     pw2[0]=PKW(P1,0), pw2[1]=PKW(P1,2), pw2); \
    VRD(6); SBAR(); GAPA(C1=__builtin_amdgcn_mfma_f32_32x32x16_bf16(kf[5],qr[2],C1,0,0,0),   P1[6],P1[7],P1[8],P1[9],     pw2[2]=PKW(P1,4), pw2[3]=PKW(P1,6), pw2); \
    VRD(3); SBAR(); GAPA(C0=__builtin_amdgcn_mfma_f32_32x32x16_bf16(kf[6],qr[3],C0,0,0,0),   P1[10],P1[11],P1[12],P1[13], pw3[0]=PKW(P1,8), pw3[1]=PKW(P1,10), pw3); \
    VRD(7); SBAR(); GAPA(C1=__builtin_amdgcn_mfma_f32_32x32x16_bf16(kf[7],qr[3],C1,0,0,0),   P1[14],P1[15],0.f,0.f,       pw3[2]=PKW(P1,12),pw3[3]=PKW(P1,14), pw3); \
    l_reg+=sacc; \
    if(GK){DMA_K((t)+3,sl_cur);} if(GV){DMA_V((t)+1,sl_next);} \
    CBLD(t); CMASK(C0,C1,t); \
    { float a=MX3(C0[0],C0[1],C1[0]),b=MX3(C0[2],C0[3],C1[1]); a=MX3(a,C1[2],C1[3]); \
      _Pragma("unroll") for(int r=4;r<16;r+=4){a=MX3(a,C0[r],C0[r+1]);b=MX3(b,C0[r+2],C0[r+3]);a=MX3(a,C1[r],C1[r+1]);b=MX3(b,C1[r+2],C1[r+3]);} \
      float rm=__builtin_fmaxf(a,b); { auto rr=__builtin_amdgcn_permlane32_swap(__float_as_uint(rm),__float_as_uint(rm),false,false); rm=__builtin_fmaxf(__uint_as_float(rr[0]),__uint_as_float(rr[1])); } rm=rm-clast-mm; \
      resc=false; \
      if(__builtin_expect(__any(rm>(float)THRL),0)){ const float dl=__builtin_fmaxf(rm,0.f); mhat+=dl; \
        mm+=dl; \
        const float f=__builtin_amdgcn_exp2f(-dl); l_reg*=f; if(hi==0)wsf[r32]=f; resc=true; } } \
    SBAR(); \
    GAPB(o[0]=__builtin_amdgcn_mfma_f32_32x32x16_bf16(PAF(0),VFR(0),o[0],0,0,0), C0,0,cbA[0]); \
    GAPB(o[1]=__builtin_amdgcn_mfma_f32_32x32x16_bf16(PAF(0),VFR(4),o[1],0,0,0), C0,4,cbA[1]); \
    KRD(GL,0); GAPB(o[0]=__builtin_amdgcn_mfma_f32_32x32x16_bf16(PAF(1),VFR(1),o[0],0,0,0), C0,8,cbA[2]); \
    KRD(GL,1); GAPB(o[1]=__builtin_amdgcn_mfma_f32_32x32x16_bf16(PAF(1),VFR(5),o[1],0,0,0), C0,12,cbA[3]); \
    KRD(GL,2); GAPB(o[0]=__builtin_amdgcn_mfma_f32_32x32x16_bf16(PAF(2),VFR(2),o[0],0,0,0), C1,0,cbB[0]); \
    KRD(GL,3); GAPB(o[1]=__builtin_amdgcn_mfma_f32_32x32x16_bf16(PAF(2),VFR(6),o[1],0,0,0), C1,4,cbB[1]); \
    GAPB(o[0]=__builtin_amdgcn_mfma_f32_32x32x16_bf16(PAF(3),VFR(3),o[0],0,0,0), C1,8,cbB[2]); \
    GAPB(o[1]=__builtin_amdgcn_mfma_f32_32x32x16_bf16(PAF(3),VFR(7),o[1],0,0,0), C1,12,cbB[3]); \
    }while(0)
  int t=1;
  #undef CMASK
  #define CMASK(P0,P1,t) do{}while(0)
  for(;t+5<NT;t+=2){
    STEP(pB0,pB1,pA0,pA1,t,true,true,true);     WAIT_BAR(2); RESC(); ROT();
    STEP(pA0,pA1,pB0,pB1,t+1,true,true,true);   WAIT_BAR(2); RESC(); ROT();
  }
  #undef CMASK
  #define CMASK(P0,P1,t) do{int jb_=(t)-(NT-4); if(band&&jb_>=0)cmask(P0,P1,jb_,qrel,hi);}while(0)
  #define ENDW(tt) do{ if((tt)+3<NT){WAIT_BAR(2);} else if((tt)+2<NT){WAIT_BAR(1);} else {WAIT_BAR(0);} }while(0)
  for(;t+1<NT;t+=2){
    STEP(pB0,pB1,pA0,pA1,t,(t+3<NT),(t+1<NT),(t+1<NT));       ENDW(t);   RESC(); ROT();
    STEP(pA0,pA1,pB0,pB1,t+1,(t+4<NT),(t+2<NT),(t+2<NT));     ENDW(t+1); RESC(); ROT();
  }
  STEP(pB0,pB1,pA0,pA1,NT-1,false,false,false); RESC();
  { float sacc=pB0[0]+pB0[1]; _Pragma("unroll") for(int r=2;r<16;++r)sacc+=pB0[r]; _Pragma("unroll") for(int r=0;r<16;++r)sacc+=pB1[r]; l_reg+=sacc;
    pw0=(u32x4){PKW(pB0,0),PKW(pB0,2),PKW(pB0,4),PKW(pB0,6)};pw1=(u32x4){PKW(pB0,8),PKW(pB0,10),PKW(pB0,12),PKW(pB0,14)};pw2=(u32x4){PKW(pB1,0),PKW(pB1,2),PKW(pB1,4),PKW(pB1,6)};pw3=(u32x4){PKW(pB1,8),PKW(pB1,10),PKW(pB1,12),PKW(pB1,14)};
    SBAR(); pv(o,vb0+sl_cur,PAF(0),PAF(1),PAF(2),PAF(3)); }
  #undef PKW
  #undef PAF
  #undef VFR
  #undef PIN
  #undef MX3
  #undef GAPA
  #undef GAPB
  #undef EX
  #undef VRD
  #undef KRD
  #undef STEP
  #undef ENDW
  {auto rr=__builtin_amdgcn_permlane32_swap(__float_as_uint(l_reg),__float_as_uint(l_reg),false,false);l_reg=__uint_as_float(rr[0])+__uint_as_float(rr[1]);}
  if(hi==0)wsf[32+r32]=l_reg;asm volatile("s_waitcnt lgkmcnt(0)":::"memory");
  float rli[16];
  if(split){
    float*Pm=PART+(size_t)part*PART_F; const float*Po=PART+(size_t)(1-part)*PART_F;
    #pragma unroll
    for(int r=0;r<16;++r){
      #pragma unroll
      for(int d0=0;d0<2;++d0)Pm[(wid*QBLK+crow(r,hi))*64+d0*32+r32]=o[d0][r];}
    if(hi==0){Pm[QB*64+(wid*QBLK+r32)*2]=mm+cq;Pm[QB*64+(wid*QBLK+r32)*2+1]=l_reg;wsf[r32]=mm+cq;}
    asm volatile("s_waitcnt vmcnt(0) lgkmcnt(0)\n\ts_barrier":::"memory");
    if(tid==0){ __builtin_amdgcn_fence(__ATOMIC_RELEASE,"agent"); asm volatile("s_waitcnt vmcnt(0)":::"memory");
      *(volatile __attribute__((address_space(3))) unsigned*)((__attribute__((address_space(3))) char*)shm+LDS_OST)=__hip_atomic_fetch_add(flag,1u,__ATOMIC_RELAXED,__HIP_MEMORY_SCOPE_AGENT); }
    asm volatile("s_waitcnt vmcnt(0) lgkmcnt(0)\n\ts_barrier":::"memory");
    const unsigned old=*(volatile __attribute__((address_space(3))) unsigned*)((__attribute__((address_space(3))) char*)shm+LDS_OST);
    asm volatile("s_waitcnt lgkmcnt(0)\n\ts_barrier":::"memory");
    if(old==0u)return;
    __builtin_amdgcn_fence(__ATOMIC_ACQUIRE,"agent"); asm volatile("s_waitcnt vmcnt(0)":::"memory");
    #pragma unroll
    for(int r=0;r<16;++r){ const int row=crow(r,hi); const float mo=wsf[row],lo=wsf[32+row],mt=Po[QB*64+(wid*QBLK+row)*2],lt=Po[QB*64+(wid*QBLK+row)*2+1];
      const float m=__builtin_fmaxf(mo,mt),fo=__builtin_amdgcn_exp2f(mo-m),ft=__builtin_amdgcn_exp2f(mt-m),inv=__builtin_amdgcn_rcpf(lo*fo+lt*ft);
      #pragma unroll
      for(int d0=0;d0<2;++d0)o[d0][r]=(o[d0][r]*fo+Po[(wid*QBLK+row)*64+d0*32+r32]*ft)*inv;
      rli[r]=1.f; }
  } else {
  #pragma unroll
  for(int r=0;r<16;++r)rli[r]=__builtin_amdgcn_rcpf(wsf[32+crow(r,hi)]);
  }
  bf16*Ow=O+(rowbase+q0+wid*QBLK)*OPITCH+h*D;
  { bf16*stg=(bf16*)(shm+LDS_OST)+wid*2048;
    #pragma unroll
    for(int r=0;r<16;++r){const int orow=crow(r,hi);
      #pragma unroll
      for(int d0=0;d0<2;++d0)stg[orow*64+d0*32+r32]=__float2bfloat16(o[d0][r]*rli[r]);}
    asm volatile("s_waitcnt lgkmcnt(0)":::"memory");
    #pragma unroll
    for(int i=0;i<4;++i){const int row=i*8+(lane>>3),ch=lane&7; const u32x4 v=*(const u32x4*)(stg+row*64+ch*8); ATTN_STORE16(Ow+(long)row*OPITCH+ch*8,v);} }
  asm volatile("s_waitcnt lgkmcnt(0)\n\ts_barrier":::"memory");
  #undef CBIAS
  #undef CBLD
  #undef DMA_K
  #undef DMA_V
  #undef CMASK
  #undef START
  #undef RESC
  #undef ROT
}
constexpr int ATTN_LDS_BYTES=LDS_BYTES;
struct AttnTensors { const bf16* Q; const bf16* K; const bf16* V; bf16* O; const float* CF; const float* stat; };
struct AttnUnit { int bh; int qb; };
struct StaticOrder {
  int vcu;
  __device__ __forceinline__ explicit StaticOrder(int grid,int block):vcu((grid%8==0)?(block%8)*(grid/8)+block/8:block),G_(grid){}
  int G_;
  __device__ __forceinline__ bool next(int i,AttnUnit&u)const{ const int v=vcu+(i>>1)*G_; if(v>=256)return false; const int s=v&15; u.bh=v>>4; u.qb=(i&1)?31-s:s; return true; }
  __device__ __forceinline__ void a_ready(const AttnUnit&)const{}
  __device__ __forceinline__ void done(const AttnUnit&)const{}
};
struct QueueOrder {
  unsigned* ctr; __attribute__((address_space(3))) unsigned* slot;
  __device__ __forceinline__ bool next(int,AttnUnit&u)const{
    if(threadIdx.x==0)*slot=__hip_atomic_fetch_add(ctr,1u,__ATOMIC_RELAXED,__HIP_MEMORY_SCOPE_AGENT);
    asm volatile("s_waitcnt vmcnt(0) lgkmcnt(0)\n\ts_barrier":::"memory");
    const unsigned v=*(volatile __attribute__((address_space(3))) unsigned*)slot; const int vv=__builtin_amdgcn_readfirstlane((int)v);
    if(vv>=512)return false; u.qb=31-(vv>>4); u.bh=vv&15; return true; }
  __device__ __forceinline__ void a_ready(const AttnUnit&)const{}
  __device__ __forceinline__ void done(const AttnUnit&)const{}
};
template<class Sched,int THRL=8> __device__ __forceinline__ void attn_phase(char*lds,const AttnTensors&T,const Sched&S){
  AttnUnit u;
  for(int i=0;S.next(i,u);++i){ S.a_ready(u); const float Tsk=40.f+2.f*__builtin_sqrtf(T.stat[u.bh*2]*T.stat[u.bh*2+1])*1.01f+1.f;
    attn_unit<THRL>(u.bh/NHEAD,u.bh%NHEAD,u.qb,T.Q,T.K,T.V,T.O,T.CF+(long)u.bh*SEQ,Tsk,0,nullptr,nullptr,lds); S.done(u); }
}
#undef SBAR
#undef WAIT_BAR
}
#define GAS __attribute__((address_space(1)))
#define LAS __attribute__((address_space(3)))
typedef unsigned v4u __attribute__((ext_vector_type(4)));
typedef float f32x4 __attribute__((ext_vector_type(4)));
typedef short bf16x8 __attribute__((ext_vector_type(8)));
typedef GAS unsigned gu32;
typedef GAS unsigned long long gu64;
#define RLX_AGENT __ATOMIC_RELAXED, __HIP_MEMORY_SCOPE_AGENT
#define LDS_WAIT() asm volatile("s_waitcnt lgkmcnt(0)" ::: "memory")
#define VM_WAIT() asm volatile("s_waitcnt vmcnt(0)" ::: "memory")
__device__ __forceinline__ unsigned long long rt() { return __builtin_amdgcn_s_memrealtime(); }
__device__ __forceinline__ unsigned pk2(float lo, float hi) { return (unsigned)f2bf(lo) | ((unsigned)f2bf(hi) << 16); }

#define XB_TMO      128
#define XB_XCNT(j)  (256  + 64 * (j))
#define XB_XSUB(j)  (1280 + 64 * (j))
#define XB_XGEN(j)  (2304 + 64 * (j))
#define XB_TOP      3328
#define XB_TOPGEN   3392
#define XCD_BAR_WORDS 3456
#define XB_SPIN_CAP (1u << 18)

__device__ __forceinline__ unsigned xb_ld(unsigned* p)              { return __hip_atomic_load(p, __ATOMIC_RELAXED, __HIP_MEMORY_SCOPE_AGENT); }
__device__ __forceinline__ unsigned xb_add(unsigned* p, unsigned v) { return __hip_atomic_fetch_add(p, v, __ATOMIC_RELAXED, __HIP_MEMORY_SCOPE_AGENT); }
__device__ __forceinline__ unsigned xb_xcc_id() { return (unsigned)__builtin_amdgcn_s_getreg((3 << 11) | 20) & 0xFu; }
#define XB_SPIN(cond, bar) do { unsigned _sp = 0; while (cond) { __builtin_amdgcn_s_sleep(1); \
    if ((++_sp & 255u) == 0u) { if (xb_ld(&(bar)[XB_TMO])) break; if (_sp > XB_SPIN_CAP) { atomicAdd(&(bar)[XB_TMO], 1u); break; } } } } while (0)

struct XcdBarrier {
    unsigned* bar; unsigned x;
    volatile LAS unsigned* st;
};

__device__ __forceinline__ XcdBarrier xcd_barrier_post(unsigned* bar, volatile LAS unsigned* st) {
    XcdBarrier b; b.bar = bar; b.x = xb_xcc_id(); b.st = st;
    if (threadIdx.x == 0) (void)xb_add(&bar[XB_XCNT(b.x)], 1u);
    return b;
}
__device__ __forceinline__ void xcd_barrier_complete(unsigned* bar, unsigned x, unsigned& nloc, unsigned& nx) {
    const unsigned G = gridDim.x * gridDim.y * gridDim.z;
    unsigned sum, cnt, mine, sp = 0u;
    for (;;) {
        sum = 0u; cnt = 0u; mine = 0u;
#pragma unroll
        for (unsigned j = 0; j < 16; ++j) { const unsigned c = xb_ld(&bar[XB_XCNT(j)]); sum += c; cnt += (c > 0u) ? 1u : 0u; mine = (j == x) ? c : mine; }
        if (sum == G) break;
        __builtin_amdgcn_s_sleep(1);
        if ((++sp & 255u) == 0u) { if (xb_ld(&bar[XB_TMO])) break; if (sp > XB_SPIN_CAP) { atomicAdd(&bar[XB_TMO], 1u); break; } }
    }
    nloc = mine > 0u ? mine : 1u; nx = cnt > 0u ? cnt : 1u;
}

__device__ __forceinline__ void xcd_barrier(const XcdBarrier& b) {
    asm volatile("s_waitcnt vmcnt(0)" ::: "memory");
    __syncthreads();
    if (threadIdx.x == 0) {
        unsigned* bar = b.bar;
        __builtin_amdgcn_s_waitcnt(0);
        unsigned nloc = b.st[0], nx = b.st[1];
        if (nloc == 0u) { xcd_barrier_complete(bar, b.x, nloc, nx); b.st[0] = nloc; b.st[1] = nx; }
        const unsigned old = xb_add(&bar[XB_XSUB(b.x)], 1u);
        const unsigned gen = old / nloc;
        if (old + 1u == (gen + 1u) * nloc) {
            __builtin_amdgcn_fence(__ATOMIC_RELEASE, "agent");
            asm volatile("s_waitcnt vmcnt(0)" ::: "memory");
            const unsigned og = xb_add(&bar[XB_TOP], 1u);
            const unsigned tg = og / nx;
            if (og + 1u == (tg + 1u) * nx) xb_add(&bar[XB_TOPGEN], 1u);
            else XB_SPIN(xb_ld(&bar[XB_TOPGEN]) == tg, bar);
            __builtin_amdgcn_fence(__ATOMIC_ACQUIRE, "agent");
            xb_add(&bar[XB_XGEN(b.x)], 1u);
            asm volatile("s_waitcnt vmcnt(0)" ::: "memory");
        } else {
            XB_SPIN(xb_ld(&bar[XB_XGEN(b.x)]) == gen, bar);
            __builtin_amdgcn_fence(__ATOMIC_ACQUIRE, "agent");
            asm volatile("s_waitcnt vmcnt(0)" ::: "memory");
        }
    }
    __syncthreads();
}
constexpr int NWAVES = 8, NTHR = 512;
constexpr int RING_OFF = 0, RING_BYTES = 131072, LDSCTL_OFF = RING_BYTES, MISC_OFF = LDSCTL_OFF + 320, LDS_BYTES = 147456;
constexpr int CW_BAR = 4096;
constexpr size_t WS_WSM = 402 * MiB;
constexpr size_t WS_WIN = WS_WSM  , WS_SWIN = WS_WSM + 8 * MiB  , WS_WOUT = WS_WSM + 14 * MiB  , WS_WDGU = WS_WSM + 18 * MiB  , WS_SWDGU = WS_WSM + 24 * MiB  , WS_WDDN = WS_WSM + 29 * MiB  ;
constexpr size_t WS_SH = WS_H + 16 * MiB  , WS_SXG = WS_XG + 34 * MiB  ;
constexpr size_t WS_WMGU = WS_W  , WS_WMDN = 437 * MiB  ;
static_assert(WS_WDDN + 6 * MiB <= WS_WMDN && WS_WMGU + 56 * MiB <= WS_WSM && WS_WMDN + 28 * MiB <= WS_END, "ws");
struct MArgs { const float* in[20]; float* out; unsigned char* ws; int ph_lo, ph_hi; };
enum { I_X = 0, I_ATTN_NORM, I_W_IN, I_HGRN_LB, I_HGRN_NORM, I_MLSTM_CONV, I_MLSTM_BI, I_MLSTM_BF, I_MLSTM_NORM, I_FOX_BF, I_W_OUT, I_FFN_NORM, I_DGATE, I_DUP, I_DDOWN, I_ROUTER, I_MGATE, I_MUP, I_MDOWN, I_FINAL_NORM };

__device__ __forceinline__ void tr_item(const float* W, int ldw, int K, bf16_t* WT, LAS float* scr, int k0, int lane) {
#pragma unroll 32
    for (int i = 0; i < 32; ++i) { const int kk = 2 * i + (lane >> 5); scr[kk * 33 + (lane & 31)] = W[(size_t)(k0 + kk) * ldw + (lane & 31)]; }
    LDS_WAIT(); asm volatile("" ::: "memory");
    const int c = lane & 7;
#pragma unroll
    for (int j = 0; j < 4; ++j) { const int n = (lane >> 3) + 8 * j; const LAS float* s = scr + (8 * c) * 33 + n;
        v4u o; o.x = pk2(s[0 * 33], s[1 * 33]); o.y = pk2(s[2 * 33], s[3 * 33]); o.z = pk2(s[4 * 33], s[5 * 33]); o.w = pk2(s[6 * 33], s[7 * 33]);
        *(GAS v4u*)(WT + (size_t)n * K + k0 + 8 * c) = o; }
    LDS_WAIT(); asm volatile("" ::: "memory");
}
__device__ __forceinline__ int glu_row(int c, int up) { return (c >> 7) * 256 + (c & 127) + up * 128; }
constexpr int MOE_GU_ITEMS = 28672, MOE_ITEMS = 43008, MOE_FILL = 4, MOE_FILL_ITEMS = 128 * NWAVES * MOE_FILL;
__device__ __forceinline__ int moe_prefilled(int G) { return G == 256 ? 3 * MOE_FILL_ITEMS : 0; }
struct F8Item { const float* W; unsigned char* dst; int ldw, K; float sc; };
__device__ __forceinline__ F8Item moe_item(const MArgs& a, unsigned char* ws, int it) {
    const bool gu = it < MOE_GU_ITEMS; const int r0 = gu ? it : it - MOE_GU_ITEMS;
    const int e = gu ? r0 / 3584 : r0 / 1792; int r = gu ? r0 % 3584 : r0 % 1792; const int up = gu ? r / 1792 : 0; if (gu) r %= 1792;
    const int kb = gu ? r / 112 : r / 32, nb = gu ? r % 112 : r % 32, c = 32 * nb, k0 = 64 * kb;
    F8Item I; I.ldw = gu ? FE : D; I.K = gu ? D : FE; I.sc = gu ? pg8::F8_GSCALE : pg8::F8_WSCALE;
    I.W = (gu ? (up ? a.in[I_MUP] : a.in[I_MGATE]) + (size_t)e * D * FE : a.in[I_MDOWN] + (size_t)e * FE * D) + c + (size_t)k0 * I.ldw;
    I.dst = (gu ? (unsigned char*)(ws + WS_WMGU) + (size_t)e * 2 * FE * D + (size_t)glu_row(c, up) * D : (unsigned char*)(ws + WS_WMDN) + (size_t)e * D * FE + (size_t)c * FE) + k0;
    return I;
}
__device__ __forceinline__ void f8_load(float (&v)[32], const F8Item& I, int lane) {
    const float* p = I.W + (size_t)(lane >> 5) * I.ldw + (lane & 31);
#pragma unroll
    for (int i = 0; i < 32; ++i) v[i] = p[(size_t)(2 * i) * I.ldw];
}
__device__ __forceinline__ void f8_stage(const float (&v)[32], LAS float* scr, int lane) {
#pragma unroll
    for (int i = 0; i < 32; ++i) scr[(2 * i + (lane >> 5)) * 33 + (lane & 31)] = v[i];
}
__device__ __forceinline__ void f8_out(const F8Item& I, LAS float* scr, int lane) {
    LDS_WAIT(); asm volatile("" ::: "memory");
    const int c = lane & 7;
#pragma unroll
    for (int j = 0; j < 4; ++j) { const int n = (lane >> 3) + 8 * j; const LAS float* s = scr + (8 * c) * 33 + n; float h[8];
#pragma unroll
        for (int i = 0; i < 8; ++i) h[i] = __builtin_fminf(__builtin_fmaxf(s[i * 33] * I.sc, -448.f), 448.f);
        unsigned w0 = 0u, w1 = 0u; w0 = __builtin_amdgcn_cvt_pk_fp8_f32(h[0], h[1], w0, false); w0 = __builtin_amdgcn_cvt_pk_fp8_f32(h[2], h[3], w0, true);
        w1 = __builtin_amdgcn_cvt_pk_fp8_f32(h[4], h[5], w1, false); w1 = __builtin_amdgcn_cvt_pk_fp8_f32(h[6], h[7], w1, true);
        typedef unsigned u32x2_ __attribute__((ext_vector_type(2))); *(GAS u32x2_*)(I.dst + (size_t)n * I.K + 8 * c) = (u32x2_){w0, w1}; }
    LDS_WAIT(); asm volatile("" ::: "memory");
}
__device__ __forceinline__ void moe_conv_range(const MArgs& a, unsigned char* ws, LAS float* scr, int first, int step, int end, int lane) {
    float v[32]; int it = first; F8Item cur;
    if (it < end) { cur = moe_item(a, ws, it); f8_load(v, cur, lane); }
#pragma unroll 1
    for (; it < end; it += step) {
        f8_stage(v, scr, lane);
        F8Item nxt = cur; const int nx = it + step;
        if (nx < end) { nxt = moe_item(a, ws, nx); f8_load(v, nxt, lane); }
        f8_out(cur, scr, lane); cur = nxt;
    }
}
constexpr int MOE_FILL17 = 3;
__device__ __forceinline__ int moe_tail_idle(const int* cnt, int G) { int acc = 0;
#pragma unroll
    for (int e = 0; e < NE; ++e) acc += (cnt[e] + 255) >> 8;
    const int r = (acc * (2 * FE / 256)) % 256; return (G == 256 && r) ? 256 - r : 0; }
__device__ __forceinline__ void moe_fill(const MArgs& a, unsigned char* ws, LAS float* scr, int slot, int G, int bx, int wave, int lane) {
    if (G != 256 || bx < 128) return;
    const int first = slot * MOE_FILL_ITEMS + (bx - 128) * NWAVES + wave;
    moe_conv_range(a, ws, scr, first, 128 * NWAVES, first + MOE_FILL * 128 * NWAVES, lane);
}
struct RowIn { float4 v[4]; };
template <bool BF> __device__ __forceinline__ void mrow_load(RowIn& R, const void* src, int row, int lane) {
    if (BF) { const uint2* xr = (const uint2*)((const bf16_t*)src + (size_t)row * D) + lane;
#pragma unroll
        for (int j = 0; j < 4; ++j) { const uint2 w = xr[64 * j]; R.v[j] = make_float4(__uint_as_float(w.x << 16), __uint_as_float(w.x & 0xffff0000u), __uint_as_float(w.y << 16), __uint_as_float(w.y & 0xffff0000u)); } }
    else { const float4* xr = (const float4*)((const float*)src + (size_t)row * D) + lane;
#pragma unroll
        for (int j = 0; j < 4; ++j) R.v[j] = xr[64 * j]; } }
template <int MODE> __device__ __forceinline__ void mrow(const RowIn& R, signed char* H8, float* SH, const float* gain, const LAS float* tab, float* G, int row, int lane, float (&lg)[8]) {
    float4 v[4]; float ss = 0.f;
#pragma unroll
    for (int j = 0; j < 4; ++j) { v[j] = R.v[j]; ss += v[j].x * v[j].x + v[j].y * v[j].y + v[j].z * v[j].z + v[j].w * v[j].w; }
    ss = wave_sum(ss);
    const float r = rsqrtf(ss * (1.f / D) + EPS);
    float h[16];
#pragma unroll
    for (int j = 0; j < 4; ++j) { const float4 g = *((const float4*)gain + 64 * j + lane);
        h[4 * j + 0] = v[j].x * r * g.x; h[4 * j + 1] = v[j].y * r * g.y; h[4 * j + 2] = v[j].z * r * g.z; h[4 * j + 3] = v[j].w * r * g.w; }
    if (MODE == 2) {
#pragma unroll
      for (int j = 0; j < 4; ++j) { float q[4];
#pragma unroll
          for (int i = 0; i < 4; ++i) q[i] = __builtin_fminf(__builtin_fmaxf(h[4 * j + i] * pg8::F8_ASCALE, -448.f), 448.f);
          unsigned w = 0u; w = __builtin_amdgcn_cvt_pk_fp8_f32(q[0], q[1], w, false); w = __builtin_amdgcn_cvt_pk_fp8_f32(q[2], q[3], w, true);
          *((unsigned*)(H8 + (size_t)row * D) + 64 * j + lane) = w; }
    } else
    { float am = 0.f;
#pragma unroll
      for (int i = 0; i < 16; ++i) am = fmaxf(am, fabsf(h[i]));
      am = wave_max_nn(am);
      const float inv = am > 0.f ? 127.f / am : 0.f;
#pragma unroll
      for (int j = 0; j < 4; ++j) { const int q0 = (int)rintf(h[4 * j] * inv), q1 = (int)rintf(h[4 * j + 1] * inv), q2 = (int)rintf(h[4 * j + 2] * inv), q3 = (int)rintf(h[4 * j + 3] * inv);
          *((unsigned*)(H8 + (size_t)row * D) + 64 * j + lane) = (unsigned)(q0 & 255) | ((unsigned)(q1 & 255) << 8) | ((unsigned)(q2 & 255) << 16) | ((unsigned)(q3 & 255) << 24); }
      if (lane == 0) SH[row] = am > 0.f ? am * (1.f / 127.f) : 1.f; }
    if (MODE == 0) {
        float pa[16];
#pragma unroll
        for (int c = 0; c < 16; ++c) { float s = 0.f;
#pragma unroll
            for (int j = 0; j < 4; ++j) { const f32x4 w = *(const LAS f32x4*)(tab + c * 1024 + 256 * j + 4 * lane); s += h[4 * j] * w[0] + h[4 * j + 1] * w[1] + h[4 * j + 2] * w[2] + h[4 * j + 3] * w[3]; }
            pa[c] = s; }
#pragma unroll
        for (int c = 0; c < 8; ++c) { const bool up = (lane & 32) != 0; const float send = up ? pa[c] : pa[c + 8], keep = up ? pa[c + 8] : pa[c]; pa[c] = keep + __shfl_xor(send, 32); }
#pragma unroll
        for (int c = 0; c < 4; ++c) { const bool up = (lane & 16) != 0; const float send = up ? pa[c] : pa[c + 4], keep = up ? pa[c + 4] : pa[c]; pa[c] = keep + __shfl_xor(send, 16); }
#pragma unroll
        for (int c = 0; c < 2; ++c) { const bool up = (lane & 8) != 0; const float send = up ? pa[c] : pa[c + 2], keep = up ? pa[c + 2] : pa[c]; pa[c] = keep + __shfl_xor(send, 8); }
        { const bool up = (lane & 4) != 0; const float send = up ? pa[0] : pa[1], keep = up ? pa[1] : pa[0]; pa[0] = keep + __shfl_xor(send, 4); }
        pa[0] += __shfl_xor(pa[0], 2); pa[0] += __shfl_xor(pa[0], 1);
        if ((lane & 3) == 0) G[(size_t)row * GW + 8 * ((lane >> 5) & 1) + 4 * ((lane >> 4) & 1) + 2 * ((lane >> 3) & 1) + ((lane >> 2) & 1)] = pa[0];
    }
    if (MODE == 2) {
        float pa[8];
#pragma unroll
        for (int c = 0; c < 8; ++c) { float s = 0.f;
#pragma unroll
            for (int j = 0; j < 4; ++j) { const f32x4 w = *(const LAS f32x4*)(tab + c * 1024 + 256 * j + 4 * lane); s += h[4 * j] * w[0] + h[4 * j + 1] * w[1] + h[4 * j + 2] * w[2] + h[4 * j + 3] * w[3]; }
            pa[c] = s; }
#pragma unroll
        for (int c = 0; c < 4; ++c) { const bool up = (lane & 32) != 0; const float send = up ? pa[c] : pa[c + 4], keep = up ? pa[c + 4] : pa[c]; pa[c] = keep + __shfl_xor(send, 32); }
#pragma unroll
        for (int c = 0; c < 2; ++c) { const bool up = (lane & 16) != 0; const float send = up ? pa[c] : pa[c + 2], keep = up ? pa[c + 2] : pa[c]; pa[c] = keep + __shfl_xor(send, 16); }
        { const bool up = (lane & 8) != 0; const float send = up ? pa[0] : pa[1], keep = up ? pa[1] : pa[0]; pa[0] = keep + __shfl_xor(send, 8); }
        pa[0] += __shfl_xor(pa[0], 4); pa[0] += __shfl_xor(pa[0], 2); pa[0] += __shfl_xor(pa[0], 1);
        float v0 = -INFINITY, v1 = -INFINITY; int e0 = 0, e1 = 0;
#pragma unroll
        for (int c = 0; c < 8; ++c) { const float sv = __shfl(pa[0], 8 * c);
            if (sv > v0) { v1 = v0; e1 = e0; v0 = sv; e0 = c; } else if (sv > v1) { v1 = sv; e1 = c; } }
        lg[0] = v0; lg[1] = v1; lg[2] = __int_as_float(e0); lg[3] = __int_as_float(e1);
    }
}
__device__ __forceinline__ void load_gate_tab(LAS float* tab, const float* w_in, int tid) {
    for (int k = tid; k < D; k += NTHR) { const float4* w0 = (const float4*)(w_in + (size_t)k * DIN + 1792); const float4* w1 = (const float4*)(w_in + (size_t)k * DIN + 3592);
        const float4 a0 = w0[0], a1 = w0[1], b0 = w1[0], b1 = w1[1];
        tab[0 * 1024 + k] = a0.x; tab[1 * 1024 + k] = a0.y; tab[2 * 1024 + k] = a0.z; tab[3 * 1024 + k] = a0.w; tab[4 * 1024 + k] = a1.x; tab[5 * 1024 + k] = a1.y; tab[6 * 1024 + k] = a1.z; tab[7 * 1024 + k] = a1.w;
        tab[8 * 1024 + k] = b0.x; tab[9 * 1024 + k] = b0.y; tab[10 * 1024 + k] = b0.z; tab[11 * 1024 + k] = b0.w; tab[12 * 1024 + k] = b1.x; tab[13 * 1024 + k] = b1.y; tab[14 * 1024 + k] = b1.z; tab[15 * 1024 + k] = b1.w; }
}
__device__ __forceinline__ void load_router_tab(LAS float* tab, const float* router, int tid) {
    for (int k = tid; k < D; k += NTHR) { const float4* w0 = (const float4*)(router + (size_t)k * NE); const float4 a0 = w0[0], a1 = w0[1];
        tab[0 * 1024 + k] = a0.x; tab[1 * 1024 + k] = a0.y; tab[2 * 1024 + k] = a0.z; tab[3 * 1024 + k] = a0.w; tab[4 * 1024 + k] = a1.x; tab[5 * 1024 + k] = a1.y; tab[6 * 1024 + k] = a1.z; tab[7 * 1024 + k] = a1.w; }
}
struct Conv8Job { const float* W; int ldw; signed char* WT8; float* S; };
__device__ __forceinline__ void conv8_load(float (&v)[64], const Conv8Job& j, int tid, int wave) {
    const int lane = tid & 63, n = lane & 31, kp = lane >> 5;
#pragma unroll
    for (int i = 0; i < 64; ++i) v[i] = j.W[(size_t)(128 * wave + 2 * i + kp) * j.ldw + n];
}
__device__ __forceinline__ void conv8_stage(const float (&v)[64], LAS float* img, LAS float* pm, int tid, int wave) {
    const int lane = tid & 63, n = lane & 31, kp = lane >> 5; float m = 0.f;
#pragma unroll
    for (int i = 0; i < 64; ++i) { img[(128 * wave + 2 * i + kp) * 32 + n] = v[i]; m = fmaxf(m, fabsf(v[i])); }
    m = fmaxf(m, __shfl_xor(m, 32));
    if (lane < 32) pm[wave * 32 + lane] = m;
    __syncthreads();
}
__device__ __forceinline__ void conv8_quant(const Conv8Job& j, LAS float* img, LAS float* pm, int tid, int wave) {
    const int lane = tid & 63, no = lane >> 1, kh = 128 * wave + 64 * (lane & 1);
    float cm = 0.f;
#pragma unroll
    for (int w = 0; w < 8; ++w) cm = fmaxf(cm, pm[w * 32 + no]);
    const float inv = cm > 0.f ? 127.f / cm : 0.f;
    if (wave == 0 && (lane & 1) == 0) j.S[no] = cm > 0.f ? cm * (1.f / 127.f) : 1.f;
    const LAS float* sp = img + kh * 32 + no;
#pragma unroll
    for (int q = 0; q < 4; ++q) { unsigned wq[4];
#pragma unroll
        for (int jj = 0; jj < 4; ++jj) { const int kk = 16 * q + 4 * jj; const int q0 = (int)rintf(sp[kk * 32] * inv), q1 = (int)rintf(sp[(kk + 1) * 32] * inv), q2 = (int)rintf(sp[(kk + 2) * 32] * inv), q3 = (int)rintf(sp[(kk + 3) * 32] * inv);
            wq[jj] = (unsigned)(q0 & 255) | ((unsigned)(q1 & 255) << 8) | ((unsigned)(q2 & 255) << 16) | ((unsigned)(q3 & 255) << 24); }
        v4u o; o.x = wq[0]; o.y = wq[1]; o.z = wq[2]; o.w = wq[3];
        *(GAS v4u*)(j.WT8 + (size_t)no * 1024 + kh + 16 * q) = o; }
    __syncthreads();
}
namespace scan {
typedef short bf16x8 __attribute__((ext_vector_type(8)));
typedef float f32x4 __attribute__((ext_vector_type(4)));
typedef unsigned v2u __attribute__((ext_vector_type(2)));
constexpr int TS = 144, TB = 64 * TS;
constexpr int L_T0 = 0, L_T1 = TB, L_T2 = 2 * TB, L_T3 = 3 * TB, L_T4 = 4 * TB, L_T5 = 5 * TB, L_O = 6 * TB, OS = 68  , L_PART = L_O + 64 * OS * 4, L_VEC = L_PART + 8 * 64 * 4, L_END = L_VEC + 8 * 64 * 4;
static_assert(L_END <= RING_BYTES, "scan LDS");
constexpr size_t SC_LHG = 0, SC_LML = 16 * MiB, SC_DEC = 32 * MiB  , SC_NL = 32 * MiB + 256 * 1024  , SC_AMAX = 32 * MiB + 512 * 1024, SC_BEND = SC_AMAX + 4096, SC_MPREV = SC_BEND + 4096;

__device__ __forceinline__ float wave_incl_add(float v, int) {
    v += DPP_F(0.f, v, 0x111, 0xf); v += DPP_F(0.f, v, 0x112, 0xf); v += DPP_F(0.f, v, 0x114, 0xf); v += DPP_F(0.f, v, 0x118, 0xf);
    v += DPP_F(0.f, v, 0x142, 0xa); v += DPP_F(0.f, v, 0x143, 0xc);
    return v;
}
__device__ __forceinline__ float wave_incl_max(float v, int) {
    const float NI = -INFINITY;
    v = fmaxf(v, DPP_F(NI, v, 0x111, 0xf)); v = fmaxf(v, DPP_F(NI, v, 0x112, 0xf)); v = fmaxf(v, DPP_F(NI, v, 0x114, 0xf)); v = fmaxf(v, DPP_F(NI, v, 0x118, 0xf));
    v = fmaxf(v, DPP_F(NI, v, 0x142, 0xa)); v = fmaxf(v, DPP_F(NI, v, 0x143, 0xc));
    return v;
}
__device__ __forceinline__ float wave_max(float v) { return __int_as_float(__builtin_amdgcn_readlane(__float_as_int(wave_incl_max(v, 0)), 63)); }
__device__ __forceinline__ float lane_bcast(float v, int uniform_lane) { return __int_as_float(__builtin_amdgcn_readlane(__float_as_int(v), uniform_lane)); }
__device__ __forceinline__ f32x4 mma64(LAS const unsigned char* A, LAS const unsigned char* B, int m0, int n0, int lane, f32x4 acc) {
    const int r = lane & 15, kq = lane >> 4;
#pragma unroll
    for (int ks = 0; ks < 2; ++ks) {
        const bf16x8 a = *(LAS const bf16x8*)(A + (m0 + r) * TS + kq * 16 + ks * 64);
        const bf16x8 b = *(LAS const bf16x8*)(B + (n0 + r) * TS + kq * 16 + ks * 64);
        acc = __builtin_amdgcn_mfma_f32_16x16x32_bf16(a, b, acc, 0, 0, 0);
    }
    return acc;
}
__device__ __forceinline__ v4u pack8(const float (&v)[8]) { v4u w; w.x = pk2(v[0], v[1]); w.y = pk2(v[2], v[3]); w.z = pk2(v[4], v[5]); w.w = pk2(v[6], v[7]); return w; }
__device__ __forceinline__ v4u pack8h(const bf16_t (&v)[8]) { v4u w; w.x = v[0] | ((unsigned)v[1] << 16); w.y = v[2] | ((unsigned)v[3] << 16); w.z = v[4] | ((unsigned)v[5] << 16); w.w = v[6] | ((unsigned)v[7] << 16); return w; }
__device__ __forceinline__ void st16(LAS unsigned char* p, float v) { *(LAS bf16_t*)p = f2bf(v); }
__device__ __forceinline__ void load_state_tile(LAS unsigned char* T, const float* S, int tid) {
    const int v = tid >> 3, d0 = (tid & 7) * 8; const float4 x0 = *(const float4*)(S + v * 64 + d0), x1 = *(const float4*)(S + v * 64 + d0 + 4);
    v4u w; w.x = pk2(x0.x, x0.y); w.y = pk2(x0.z, x0.w); w.z = pk2(x1.x, x1.y); w.w = pk2(x1.z, x1.w);
    *(LAS v4u*)(T + v * TS + d0 * 2) = w;
}
typedef short s16x2 __attribute__((ext_vector_type(2)));
constexpr int IW = 4, TK = 64 / IW, CPT = 64 / IW, TPW = 16 / IW;
constexpr int HLDS = 6 * TB + 4096;
constexpr int H_O = L_T0, H_PART = 6 * TB, H_VEC = 6 * TB + 2048;
static_assert(2 * HLDS <= RING_BYTES && 64 * OS * 4 <= 2 * TB, "scan LDS (two halves)");
__device__ __forceinline__ void pack16w(LAS unsigned char* dst, const float (&v)[TK]) {
    v4u w0, w1; w0.x = pk2(v[0], v[1]); w0.y = pk2(v[2], v[3]); w0.z = pk2(v[4], v[5]); w0.w = pk2(v[6], v[7]); w1.x = pk2(v[8], v[9]); w1.y = pk2(v[10], v[11]); w1.z = pk2(v[12], v[13]); w1.w = pk2(v[14], v[15]);
    *(LAS v4u*)dst = w0; *(LAS v4u*)(dst + 16) = w1; }
__device__ __forceinline__ void pack16h(LAS unsigned char* dst, const s16x2 (&v)[TK / 2]) {
    v4u w0, w1; w0.x = __builtin_bit_cast(unsigned, v[0]); w0.y = __builtin_bit_cast(unsigned, v[1]); w0.z = __builtin_bit_cast(unsigned, v[2]); w0.w = __builtin_bit_cast(unsigned, v[3]);
    w1.x = __builtin_bit_cast(unsigned, v[4]); w1.y = __builtin_bit_cast(unsigned, v[5]); w1.z = __builtin_bit_cast(unsigned, v[6]); w1.w = __builtin_bit_cast(unsigned, v[7]);
    *(LAS v4u*)dst = w0; *(LAS v4u*)(dst + 16) = w1; }
__device__ __forceinline__ void local_state_mma_store(LAS unsigned char* Lh, float* LT, int tq, int lane) {
#pragma unroll
    for (int nn = 0; nn < TPW; ++nn) { const int ti = tq * TPW + nn, mt = ti >> 2, nt = ti & 3; f32x4 acc = {0.f, 0.f, 0.f, 0.f};
        acc = mma64(Lh + L_T1, Lh + L_T0, mt * 16, nt * 16, lane, acc);
#pragma unroll
        for (int r = 0; r < 4; ++r) LT[(mt * 16 + 4 * (lane >> 4) + r) * 64 + nt * 16 + (lane & 15)] = acc[r]; }
}
__device__ __forceinline__ float sigmoid_fast(float z) { return __builtin_amdgcn_rcpf(1.f + __builtin_amdgcn_exp2f(-1.4426950408889634f * z)); }
__device__ __forceinline__ float silu_fast(float z) { return z * sigmoid_fast(z); }
__device__ __forceinline__ void hgrn_gate(float lb, float z, float& sg, float& omsg, float& lf) {
    const float e = __builtin_amdgcn_exp2f(-1.4426950408889634f * fabsf(z)), ope = 1.f + e, r = __builtin_amdgcn_rcpf(ope), er = e * r; const bool pos = z >= 0.f;
    sg = pos ? r : er; omsg = pos ? er : r;
    lf = lb > 0.f ? __logf(lb + (1.f - lb) * sg) : (fminf(z, 0.f) - __logf(ope)); }
#define BFP(arr, i) bf2f((bf16_t)(arr)[(i) >> 1][(i) & 1])
struct HgIn { s16x2 fz[TK / 2], q[TK / 2], iv[TK / 2]; v4u gate[2]; float4 s[4]; };
template <bool DPH> __device__ __forceinline__ void hgrn_load(HgIn& R, const bf16_t* P, int b, int c, int h, const float* ST, int tl, int tq) {
    const int d = tl & 63, row0 = b * SEQ + c * 64; const bf16_t* pr = P + (size_t)(row0 + TK * tq) * PW + h * 64 + d;
#pragma unroll
    for (int i = 0; i < TK; ++i) { R.fz[i >> 1][i & 1] = (short)pr[(size_t)i * PW + P_HF]; R.iv[i >> 1][i & 1] = (short)pr[(size_t)i * PW + P_HI]; if (DPH) R.q[i >> 1][i & 1] = (short)pr[(size_t)i * PW + P_HQ]; }
    if (DPH) { const int t = tl / IW, v0 = (tl % IW) * CPT; const v4u* gp = (const v4u*)(P + (size_t)(row0 + t) * PW + P_HG + h * 64 + v0); R.gate[0] = gp[0]; R.gate[1] = gp[1];
#pragma unroll
        for (int j = 0; j < 4; ++j) R.s[j] = *(const float4*)(ST + t * 64 + v0 + 4 * j); }
}
struct MlIn { s16x2 qr[(TK + 4) / 2], kr[(TK + 4) / 2], vv[TK / 2]; float ig, fg, np, mprev; v4u gate[2]; float4 s[4]; };
template <bool DPH> __device__ __forceinline__ void mlstm_load(MlIn& R, const bf16_t* P, const float* G, int b, int c, int h, const float* CT, const float* NP, const float* MP, int tl, int tq) {
    const int d = tl & 63, lane = tl & 63, row0 = b * SEQ + c * 64; const bool fz3 = (c == 0 && tq == 0);
    const bf16_t* pk = P + (size_t)(row0 + TK * tq) * PW + P_MK + h * 64 + d; const bf16_t* pq = P + (size_t)(row0 + TK * tq) * PW + P_MQ + h * 64 + d;
#pragma unroll
    for (int j = 0; j < TK + 3; ++j) { R.kr[j >> 1][j & 1] = (j < 3 && fz3) ? (short)0 : (short)pk[((long)j - 3) * PW]; if (DPH) R.qr[j >> 1][j & 1] = (j < 3 && fz3) ? (short)0 : (short)pq[((long)j - 3) * PW]; }
#pragma unroll
    for (int i = 0; i < TK; ++i) R.vv[i >> 1][i & 1] = (short)P[(size_t)(row0 + TK * tq + i) * PW + P_MV + h * 64 + d];
    R.ig = G[(size_t)(row0 + lane) * GW + h]; R.fg = G[(size_t)(row0 + lane) * GW + 4 + h];
    if (DPH) { const int t = tl / IW, v0 = (tl % IW) * CPT; const v4u* gp = (const v4u*)(P + (size_t)(row0 + t) * PW + P_MO + h * 64 + v0); R.gate[0] = gp[0]; R.gate[1] = gp[1];
#pragma unroll
        for (int j = 0; j < 4; ++j) R.s[j] = *(const float4*)(CT + t * 64 + v0 + 4 * j);
        R.np = NP[lane]; R.mprev = MP[0]; }
}
__device__ __forceinline__ void store_state_tile(LAS unsigned char* T, const float4 (&x)[4], int tl) {
    const int v = tl / IW, d0 = (tl % IW) * CPT; v4u w0, w1; w0.x = pk2(x[0].x, x[0].y); w0.y = pk2(x[0].z, x[0].w); w0.z = pk2(x[1].x, x[1].y); w0.w = pk2(x[1].z, x[1].w);
    w1.x = pk2(x[2].x, x[2].y); w1.y = pk2(x[2].z, x[2].w); w1.z = pk2(x[3].x, x[3].y); w1.w = pk2(x[3].z, x[3].w);
    *(LAS v4u*)(T + v * TS + d0 * 2) = w0; *(LAS v4u*)(T + v * TS + d0 * 2 + 16) = w1;
}
__device__ __forceinline__ void conv_silu_r(const s16x2 (&raw)[(TK + 4) / 2], const float* w4  , float scale, float (&out)[TK]) {
    const float w0 = w4[0], w1 = w4[512], w2 = w4[1024], w3 = w4[1536];
#pragma unroll
    for (int i = 0; i < TK; ++i) out[i] = silu_fast(w0 * BFP(raw, i) + w1 * BFP(raw, i + 1) + w2 * BFP(raw, i + 2) + w3 * BFP(raw, i + 3)) * scale;
}
__device__ __forceinline__ void hgrn_b_item(LAS unsigned char* Lh, const HgIn& R, float lb, float* LT, float* DEC, int tl, int tq) {
    const int d = tl & 63;
    float bl[TK], kh[TK]; float run = 0.f;
#pragma unroll
    for (int i = 0; i < TK; ++i) { const float fz = BFP(R.fz, i);
        float sg, omsg, lf; hgrn_gate(lb, fz, sg, omsg, lf); kh[i] = (1.f - lb) * omsg; run += lf; bl[i] = run; }
    LAS float* part = (LAS float*)(Lh + H_PART);
    part[tq * 64 + d] = run; __syncthreads();
    float off = 0.f, btot = 0.f;
#pragma unroll
    for (int w = 0; w < IW; ++w) { const float pv = part[w * 64 + d]; btot += pv; if (w < tq) off += pv; }
#pragma unroll
    for (int i = 0; i < TK; ++i) kh[i] *= __expf(btot - (off + bl[i]));
    pack16w(Lh + L_T0 + d * TS + tq * (2 * TK), kh);
    pack16h(Lh + L_T1 + d * TS + tq * (2 * TK), R.iv);
    if (tq == 0) DEC[d] = __expf(btot);
    __syncthreads();
    local_state_mma_store(Lh, LT, tq, tl & 63);
    __syncthreads();
}
__device__ __forceinline__ void mlstm_gates(float ig, float fg, const float* b_i, const float* b_f, int h, int lane, float& bcum, float& a) {
    const float z = fg + b_f[h]; bcum = wave_incl_add(fminf(z, 0.f) - __logf(1.f + __builtin_amdgcn_exp2f(-1.4426950408889634f * fabsf(z))), lane); a = ig + b_i[h] - bcum;
}
__device__ __forceinline__ void mlstm_b_item(LAS unsigned char* Lh, const MlIn& R, const float* conv, const float* b_i, const float* b_f, int h, float* LT, float* NL, float* AMAX, float* BEND, int tl, int tq) {
    const int d = tl & 63, lane = tl & 63;
    float bcum, a; mlstm_gates(R.ig, R.fg, b_i, b_f, h, lane, bcum, a);
    const float A = wave_max(a), bend = lane_bcast(bcum, 63);
    float kh[TK]; conv_silu_r(R.kr, conv + 256 + h * 64 + d, 0.125f, kh);
    float nsum = 0.f;
#pragma unroll
    for (int i = 0; i < TK; ++i) { kh[i] *= __expf(lane_bcast(a, TK * tq + i) - A); nsum += bf2f(f2bf(kh[i])); }
    pack16w(Lh + L_T0 + d * TS + tq * (2 * TK), kh);
    pack16h(Lh + L_T1 + d * TS + tq * (2 * TK), R.vv);
    LAS float* part = (LAS float*)(Lh + H_PART); part[tq * 64 + d] = nsum;
    __syncthreads();
    if (tq == 0) { float s = 0.f;
#pragma unroll
        for (int w = 0; w < IW; ++w) s += part[w * 64 + d];
        NL[d] = s; if (lane == 0) { AMAX[0] = A; BEND[0] = bend; } }
    local_state_mma_store(Lh, LT, tq, lane);
    __syncthreads();
}
__device__ __forceinline__ void fox_cumsum_item(LAS unsigned char* L, const float* G, const float* fox_bf, float* CF, int bh, int tid, int wave) {
    const int b = bh >> 3, h = bh & 7, lane = tid & 63; const float bf = fox_bf[h];
    float loc[16]; float s = 0.f;
#pragma unroll
    for (int i = 0; i < 16; ++i) { s += log_sigmoidf_(G[((size_t)b * SEQ + tid * 16 + i) * GW + 8 + h] + bf); loc[i] = s; }
    const float incl = wave_incl_add(s, lane);
    LAS float* wt = (LAS float*)(L + L_PART);
    if (lane == 63) wt[wave] = incl;
    __syncthreads();
    float off = incl - s;
#pragma unroll
    for (int w = 0; w < 8; ++w) if (w < wave) off += wt[w];
#pragma unroll
    for (int i = 0; i < 16; ++i) CF[(size_t)bh * SEQ + tid * 16 + i] = (off + loc[i]) * LOG2E;
    __syncthreads();
}

template <bool DUMMY = false> __device__ __forceinline__ void scan_c_block(unsigned char* sc, int j, int tid) {
    constexpr size_t DOFF = DUMMY ? 104 * MiB / 4 : 0;
    constexpr int CB = 32;
    if (j < 128) {
        if (tid < 256) { const int chain = j >> 4, e = (j & 15) * 256 + tid, b = chain >> 2, h = chain & 3;
            float* p = (float*)(sc + SC_LHG) + ((size_t)(b * 128) * 4 + h) * 4096 + e; const float* dp = (const float*)(sc + SC_DEC) + ((size_t)(b * 128) * 4 + h) * 64 + (e & 63);
            float S = 0.f;
            for (int c0 = 0; c0 < 128; c0 += CB) { float Lc[CB], dc[CB];
#pragma unroll
                for (int i = 0; i < CB; ++i) { Lc[i] = p[(size_t)(c0 + i) * 4 * 4096]; dc[i] = dp[(size_t)(c0 + i) * 4 * 64]; }
#pragma unroll
                for (int i = 0; i < CB; ++i) { const float So = S; S = dc[i] * S + Lc[i]; Lc[i] = So; }
#pragma unroll
                for (int i = 0; i < CB; ++i) (p + DOFF)[(size_t)(c0 + i) * 4 * 4096] = Lc[i]; } }
    } else {
        const int jj = j - 128, chain = jj >> 4, part = jj & 15, b = chain >> 2, h = chain & 3;
        if (tid < 260) { const bool isn = tid >= 256; const size_t it0 = (size_t)(b * 128) * 4 + h;
            float* p = isn ? (float*)(sc + SC_NL) + it0 * 64 + part * 4 + (tid - 256) : (float*)(sc + SC_LML) + it0 * 4096 + part * 256 + tid;
            const size_t stride = isn ? 4 * 64 : 4 * 4096;
            const float* am = (const float*)(sc + SC_AMAX) + it0; const float* be = (const float*)(sc + SC_BEND) + it0; float* mp = (float*)(sc + SC_MPREV) + it0;
            const bool writer = (part == 0 && tid == 0);
            float S = 0.f, m = 0.f;
            for (int c0 = 0; c0 < 128; c0 += CB) { float Lc[CB], A[CB], bb[CB];
#pragma unroll
                for (int i = 0; i < CB; ++i) { Lc[i] = p[(size_t)(c0 + i) * stride]; A[i] = am[(c0 + i) * 4]; bb[i] = be[(c0 + i) * 4]; }
#pragma unroll
                for (int i = 0; i < CB; ++i) { const float Mx = fmaxf(m, A[i]), So = S; S = __expf(m - Mx) * S + __expf(A[i] - Mx) * Lc[i]; Lc[i] = So; A[i] = m; m = bb[i] + Mx; }
#pragma unroll
                for (int i = 0; i < CB; ++i) { (p + DOFF)[(size_t)(c0 + i) * stride] = Lc[i]; if (writer) (mp + DOFF)[(c0 + i) * 4] = A[i]; } } }
    }
}

template <bool SIG> __device__ __forceinline__ void head_epilogue(LAS unsigned char* Lh, float inv, const v4u (&gw)[2]  , const float* gain  , bf16_t* out  , int tl) {
    const int t = tl / IW, v0 = (tl % IW) * CPT; const LAS float* o = (const LAS float*)(Lh + H_O) + t * OS + v0;
    float x[CPT]; float ss = 0.f;
#pragma unroll
    for (int i = 0; i < CPT; ++i) { x[i] = o[i] * inv; ss += x[i] * x[i]; }
#pragma unroll
    for (int m = 1; m < IW; m <<= 1) ss += __shfl_xor(ss, m);
    const float r = rsqrtf(ss * (1.f / 64.f) + EPS);
    const unsigned gu[8] = {gw[0].x, gw[0].y, gw[0].z, gw[0].w, gw[1].x, gw[1].y, gw[1].z, gw[1].w};
    float y[CPT];
#pragma unroll
    for (int i = 0; i < CPT; ++i) { const float gz = bf2f((bf16_t)((gu[i >> 1] >> (16 * (i & 1))) & 0xffff)); y[i] = x[i] * r * gain[i] * (SIG ? sigmoid_fast(gz) : silu_fast(gz)); }
    v4u w0, w1; w0.x = pk2(y[0], y[1]); w0.y = pk2(y[2], y[3]); w0.z = pk2(y[4], y[5]); w0.w = pk2(y[6], y[7]); w1.x = pk2(y[8], y[9]); w1.y = pk2(y[10], y[11]); w1.z = pk2(y[12], y[13]); w1.w = pk2(y[14], y[15]);
    *(v4u*)out = w0; *((v4u*)out + 1) = w1;
}
__device__ __forceinline__ void store_o_tiles(LAS unsigned char* Lh, LAS const unsigned char* A1, LAS const unsigned char* B1, LAS const unsigned char* A2, LAS const unsigned char* B2, int tq, int lane) {
#pragma unroll
    for (int nn = 0; nn < TPW; ++nn) { const int ti = tq * TPW + nn, mt = ti >> 2, nt = ti & 3; f32x4 acc = {0.f, 0.f, 0.f, 0.f};
        acc = mma64(A1, B1, mt * 16, nt * 16, lane, acc); acc = mma64(A2, B2, mt * 16, nt * 16, lane, acc);
        LAS float* o = (LAS float*)(Lh + H_O);
#pragma unroll
        for (int r = 0; r < 4; ++r) o[(mt * 16 + 4 * (lane >> 4) + r) * OS + nt * 16 + (lane & 15)] = acc[r]; }
}
__device__ __forceinline__ void hgrn_d_item(LAS unsigned char* Lh, const HgIn& R, float lb, const float* gain  , bf16_t* out  , int tl, int tq) {
    const int d = tl & 63, lane = tl & 63;
    float bl[TK], kk[TK], q[TK]; float run = 0.f;
#pragma unroll
    for (int i = 0; i < TK; ++i) { const float fz = BFP(R.fz, i); q[i] = BFP(R.q, i);
        float sg, omsg, lf; hgrn_gate(lb, fz, sg, omsg, lf); kk[i] = (1.f - lb) * omsg; run += lf; bl[i] = run; }
    LAS float* part = (LAS float*)(Lh + H_PART);
    part[tq * 64 + d] = run;
    store_state_tile(Lh + L_T4, R.s, tl);
    pack16h(Lh + L_T3 + d * TS + tq * (2 * TK), R.iv);
    __syncthreads();
    float off = 0.f, bref = 0.f;
#pragma unroll
    for (int w = 0; w < IW; ++w) { const float pv = part[w * 64 + d]; if (w < IW / 2) bref += pv; if (w < tq) off += pv; }
#pragma unroll
    for (int i = 0; i < TK; ++i) { const float bb = off + bl[i]; const int t = TK * tq + i;
        st16(Lh + L_T0 + t * TS + d * 2, q[i] * __expf(bb - bref));
        st16(Lh + L_T1 + t * TS + d * 2, kk[i] * __expf(bref - bb));
        st16(Lh + L_T2 + t * TS + d * 2, q[i] * __expf(bb)); }
    __syncthreads();
#pragma unroll
    for (int nn = 0; nn < TPW; ++nn) { const int ti = tq * TPW + nn, mt = ti >> 2, nt = ti & 3; f32x4 acc = {0.f, 0.f, 0.f, 0.f};
        acc = mma64(Lh + L_T1, Lh + L_T0, mt * 16, nt * 16, lane, acc);
        const int s0 = mt * 16 + 4 * (lane >> 4), t = nt * 16 + (lane & 15);
        v2u w; w.x = pk2(s0 <= t ? acc[0] : 0.f, s0 + 1 <= t ? acc[1] : 0.f); w.y = pk2(s0 + 2 <= t ? acc[2] : 0.f, s0 + 3 <= t ? acc[3] : 0.f);
        *(LAS v2u*)(Lh + L_T5 + t * TS + s0 * 2) = w; }
    __syncthreads();
    store_o_tiles(Lh, Lh + L_T5, Lh + L_T3, Lh + L_T2, Lh + L_T4, tq, lane);
    __syncthreads();
    { const int t = tl / IW, v0 = (tl % IW) * CPT; head_epilogue<false>(Lh, 1.f, R.gate, gain + v0, out + (size_t)t * D + v0, tl); }
    __syncthreads();
}
__device__ __forceinline__ void mlstm_d_item(LAS unsigned char* Lh, const MlIn& R, const float* conv, const float* b_i, const float* b_f, const float* gain  , int h, bf16_t* out  , int tl, int tq) {
    const int d = tl & 63, lane = tl & 63; const float mprev = R.mprev;
    float bcum, a; mlstm_gates(R.ig, R.fg, b_i, b_f, h, lane, bcum, a);
    const float M = fmaxf(wave_incl_max(a, lane), mprev), sint = __expf(mprev - M);
    LAS float* vec = (LAS float*)(Lh + H_VEC);
    if (tq == 0) { vec[lane] = a; vec[64 + lane] = M; vec[128 + lane] = __expf(-bcum - M); vec[192 + lane] = R.np; }
    float qc[TK], kc[TK];
    conv_silu_r(R.qr, conv + h * 64 + d, 1.f, qc);
    conv_silu_r(R.kr, conv + 256 + h * 64 + d, 0.125f, kc);
#pragma unroll
    for (int i = 0; i < TK; ++i) { const int t = TK * tq + i;
        st16(Lh + L_T0 + t * TS + d * 2, qc[i]);
        st16(Lh + L_T1 + t * TS + d * 2, kc[i]);
        st16(Lh + L_T2 + t * TS + d * 2, qc[i] * lane_bcast(sint, t)); }
    pack16h(Lh + L_T3 + d * TS + tq * (2 * TK), R.vv);
    store_state_tile(Lh + L_T4, R.s, tl);
    __syncthreads();
#pragma unroll
    for (int nn = 0; nn < TPW; ++nn) { const int ti = tq * TPW + nn, mt = ti >> 2, nt = ti & 3; f32x4 acc = {0.f, 0.f, 0.f, 0.f};
        acc = mma64(Lh + L_T1, Lh + L_T0, mt * 16, nt * 16, lane, acc);
        const int s0 = mt * 16 + 4 * (lane >> 4), t = nt * 16 + (lane & 15); const float Mt = vec[64 + t];
        float wv[4];
#pragma unroll
        for (int r = 0; r < 4; ++r) wv[r] = (s0 + r <= t) ? acc[r] * __expf(vec[s0 + r] - Mt) : 0.f;
        v2u w; w.x = pk2(wv[0], wv[1]); w.y = pk2(wv[2], wv[3]); *(LAS v2u*)(Lh + L_T5 + t * TS + s0 * 2) = w; }
    __syncthreads();
    float inv;
    { const int t = tl / IW, c0 = (tl % IW) * CPT; float den = 0.f;
#pragma unroll
      for (int hh = 0; hh < 2; ++hh) { const v4u pw = *(LAS const v4u*)(Lh + L_T5 + t * TS + (c0 + 8 * hh) * 2), qw = *(LAS const v4u*)(Lh + L_T2 + t * TS + (c0 + 8 * hh) * 2);
          const unsigned pu[4] = {pw.x, pw.y, pw.z, pw.w}, qu[4] = {qw.x, qw.y, qw.z, qw.w};
#pragma unroll
          for (int i = 0; i < 8; ++i) den += bf2f((bf16_t)((pu[i >> 1] >> (16 * (i & 1))) & 0xffff)) + bf2f((bf16_t)((qu[i >> 1] >> (16 * (i & 1))) & 0xffff)) * vec[192 + c0 + 8 * hh + i]; }
#pragma unroll
      for (int m = 1; m < IW; m <<= 1) den += __shfl_xor(den, m);
      inv = __builtin_amdgcn_rcpf(fmaxf(fabsf(den), vec[128 + t])); }
    store_o_tiles(Lh, Lh + L_T5, Lh + L_T3, Lh + L_T2, Lh + L_T4, tq, lane);
    __syncthreads();
    { const int t = tl / IW, c0 = (tl % IW) * CPT; head_epilogue<true>(Lh, inv, R.gate, gain + c0, out + (size_t)t * D + c0, tl); }
    __syncthreads();
}
}
constexpr int N_PHASES = 21;
template <int PH, bool REP = false> __device__ __forceinline__ void run_phase(const MArgs& a, LAS unsigned char* L, const int tid, const int wave, const int G, const int bx, const int vcu) {
    const int lane = tid & 63, gw = vcu * NWAVES + wave, NGW = G * NWAVES;
    unsigned char* ws = a.ws; bf16_t* X = (bf16_t*)a.out;
    bf16_t* X2 = (bf16_t*)(ws + WS_X2); (void)X2;
    int* ctl = (int*)(ws + WS_CTL); int* cnt = ctl + CW_CNT;
    float* Gt = (float*)(ws + WS_G); float* CF = (float*)(ws + WS_CF); int4* tokinfo = (int4*)(ws + WS_TOKINFO); float2* tgate = (float2*)(ws + WS_TGATE); int* toklist = (int*)(ws + WS_TOKLIST);
    bf16_t* P = (bf16_t*)(ws + WS_P); bf16_t* HID = (bf16_t*)(ws + WS_HID); signed char* H = (signed char*)(ws + WS_H); float* SH = (float*)(ws + WS_SH); bf16_t* MIX = (bf16_t*)(ws + WS_MIX);
    signed char* XG = (signed char*)(ws + WS_XG); float* SXG = (float*)(ws + WS_SXG); bf16_t* Y = (bf16_t*)(ws + WS_XG);
    LAS float* scr = (LAS float*)(L + RING_OFF + wave * 16384);
    (void)ctl; (void)Gt; (void)CF; (void)tokinfo; (void)tgate; (void)toklist; (void)P; (void)HID; (void)H; (void)SH; (void)SXG; (void)MIX; (void)XG; (void)Y; (void)scr; (void)cnt; (void)lane; (void)gw; (void)NGW;
    constexpr int p = PH, l = p >= 10 ? 1 : 0, k = p == 0 ? -1 : (l ? p - 10 : p - 1);
    if constexpr (p == 0) {
            LAS float* img = (LAS float*)(L + RING_OFF); LAS float* pm = (LAS float*)(L + LDSCTL_OFF + 1024);
            { auto job = [&](int it) { Conv8Job j; int r = it;
                  if (r < 224) { const int ll = r / 112, nb = r % 112, sc = 32 * nb + (nb >= 56 ? 8 : 0);
                      j.W = a.in[I_W_IN] + (size_t)ll * D * DIN + sc; j.ldw = DIN; j.WT8 = (signed char*)(ws + WS_WIN) + (size_t)ll * PW * D + (size_t)32 * nb * D; j.S = (float*)(ws + WS_SWIN) + ll * PW + 32 * nb; }
                  else { r -= 224; const int up = r / 88, nb = r % 88, c = 32 * nb;
                      j.W = (up ? a.in[I_DUP] : a.in[I_DGATE]) + c; j.ldw = FF; j.WT8 = (signed char*)(ws + WS_WDGU) + (size_t)glu_row(c, up) * D; j.S = (float*)(ws + WS_SWDGU) + glu_row(c, up); }
                  return j; };
              float v[64]; int it = vcu; if (it < 400) conv8_load(v, job(it), tid, wave);
              for (; it < 400; it += G) { const Conv8Job j = job(it); conv8_stage(v, img, pm, tid, wave); if (it + G < 400) conv8_load(v, job(it + G), tid, wave); conv8_quant(j, img, pm, tid, wave); } }
            { LAS unsigned* slot = (LAS unsigned*)(L + LDSCTL_OFF); LAS float* tab = (LAS float*)(L + RING_OFF); bool tabbed = false;
              for (;;) {
                  __syncthreads();
                  if (tid == 0) *slot = __hip_atomic_fetch_add((unsigned*)ctl + CW_PQ + (REP ? 1 : 0), 1u, __ATOMIC_RELAXED, __HIP_MEMORY_SCOPE_AGENT);
                  __syncthreads();
                  const int t = __builtin_amdgcn_readfirstlane((int)*(volatile LAS unsigned*)slot);
                  if (t >= 560) break;
                  if (t < 304) { int r = 8 * t + wave;
                      if (r < 1024) { const int ll = r / 512; r %= 512; const int kb = r / 32, nb = r % 32;
                          tr_item(a.in[I_W_OUT] + (size_t)ll * D * D + 32 * nb, D, D, (bf16_t*)(ws + WS_WOUT) + (size_t)ll * D * D + (size_t)32 * nb * D, scr, 64 * kb, lane); }
                      else { r -= 1024; const int kb = r / 32, nb = r % 32; tr_item(a.in[I_DDOWN] + 32 * nb, D, FF, (bf16_t*)(ws + WS_WDDN) + (size_t)32 * nb * FF, scr, 64 * kb, lane); } }
                  else {
                      if (!tabbed) { __syncthreads(); load_gate_tab(tab, a.in[I_W_IN], tid); __syncthreads(); tabbed = true; }
                      float lg[8]; RowIn R, Rn; const int row0 = (t - 304) * 64 + wave * 8; mrow_load<false>(R, a.in[I_X], row0, lane);
#pragma unroll 1
                      for (int i = 0; i < 8; ++i) { if (i < 7) mrow_load<false>(Rn, a.in[I_X], row0 + i + 1, lane); asm volatile("" ::: "memory");
                          mrow<0>(R, H, SH, a.in[I_ATTN_NORM], tab, Gt, row0 + i, lane, lg); if (i < 7) R = Rn; } }
              } }
        } else if constexpr (k == 0) {
            { const int cb = (G >= 144) ? bx - 128 : bx; for (int bh = cb; bh >= 0 && bh < 16; bh += G) scan::fox_cumsum_item(L, Gt, a.in[I_FOX_BF] + l * 8, CF, bh, tid, wave); }
            pg8::GOrder S; S.so.init(NTOK, PW, G, bx); S.A = (const char*)H; S.B = (const char*)(ws + WS_WIN) + (size_t)l * PW * D; S.a_tile = (size_t)256 * D; S.b_tile = (size_t)256 * D; S.b_exp = 0;
            S.tb1 = S.tb2 = S.tb3 = S.tb4 = S.tb5 = S.tb6 = S.tb7 = 0x7fffffff;
            pg8::EpiBf8 E; E.O = P; E.ldc = PW; E.s_lo = P_FQ / 256; E.s_hi = P_FK / 256; E.scale = QSCALE; E.sA = SH; E.sB = (const float*)(ws + WS_SWIN) + l * PW; E.sc = (LAS float*)(L + LDSCTL_OFF + 4096);
            pg8::Gemm g{D / 2};
            pg8::gemm_phase<pg8::EpiBf8, pg8::GOrder, true, true, 1>(L + RING_OFF, g, S, E);
            if constexpr (!REP) moe_fill(a, ws, scr, l ? 2 : 0, G, bx, wave, lane);
        } else if constexpr (l == 1 && k == 9) {
            pg8::GOrderTail S; pg8::EpiBfPart E; int t[8]; int acc = 0;
#pragma unroll
            for (int e = 0; e < NE; ++e) { t[e] = acc; acc += (cnt[e] + 255) >> 8; }
            S.init(acc, D, G, bx); S.A = (const char*)HID; S.B = (const char*)(ws + WS_WMDN); S.a_tile = (size_t)256 * FE; S.b_tile = (size_t)256 * FE; S.b_exp = (size_t)D * FE;
            S.tb1 = t[1]; S.tb2 = t[2]; S.tb3 = t[3]; S.tb4 = t[4]; S.tb5 = t[5]; S.tb6 = t[6]; S.tb7 = t[7]; E.O = Y; E.ldc = D; E.scale = 1.f / (pg8::F8_HSCALE * pg8::F8_WSCALE);
            pg8::Gemm g{FE / 2};
            pg8::gemm_phase<pg8::EpiBfPart, pg8::GOrderTail, true, true, 2>(L + RING_OFF, g, S, E);
        } else if constexpr (k == 4 || (l == 0 && k == 7)) {
            pg8::GOrder S; S.so.init(NTOK, D, G, bx); S.b_exp = 0; S.tb1 = S.tb2 = S.tb3 = S.tb4 = S.tb5 = S.tb6 = S.tb7 = 0x7fffffff; int K;
            if constexpr (k == 4) { K = D; S.A = (const char*)MIX; S.B = (const char*)(ws + WS_WOUT) + (size_t)l * D * D * 2; }
            else { K = FF; S.A = (const char*)HID; S.B = (const char*)(ws + WS_WDDN); }
            S.a_tile = (size_t)256 * K * 2; S.b_tile = (size_t)256 * K * 2;
            pg8::Gemm g{K};
            if constexpr (k == 4 && l == 0) { pg8::EpiResid<true> E{a.in[I_X], X, D}; pg8::gemm_phase<pg8::EpiResid<true>, pg8::GOrder, true, true>(L + RING_OFF, g, S, E); }
            else { pg8::EpiResid<false> E{X, (k == 4 && l == 1) ? X2 : X, D}; pg8::gemm_phase<pg8::EpiResid<false>, pg8::GOrder, true, true>(L + RING_OFF, g, S, E); }
        } else if constexpr (l == 0 && k == 6) {
            pg8::GOrder S; pg8::EpiSwiglu8<false> E; S.a_tile = (size_t)256 * D; S.b_tile = (size_t)256 * D; E.O = HID; E.sc = (LAS float*)(L + LDSCTL_OFF + 4096);
            S.so.init(NTOK, 2 * FF, G, bx); S.A = (const char*)H; S.B = (const char*)(ws + WS_WDGU); S.b_exp = 0; S.tb1 = S.tb2 = S.tb3 = S.tb4 = S.tb5 = S.tb6 = S.tb7 = 0x7fffffff;
            E.ldc = FF; E.sA = SH; E.sB = (const float*)(ws + WS_SWDGU); E.sb_exp = 0;
            E.tb1 = S.tb1; E.tb2 = S.tb2; E.tb3 = S.tb3; E.tb4 = S.tb4; E.tb5 = S.tb5; E.tb6 = S.tb6; E.tb7 = S.tb7;
            pg8::Gemm g{D / 2};
            pg8::gemm_phase<pg8::EpiSwiglu8<false>, pg8::GOrder, true, true, 1>(L + RING_OFF, g, S, E);
            if constexpr (!REP) moe_fill(a, ws, scr, 1, G, bx, wave, lane);
        } else if constexpr (l == 1 && k == 7) {
            pg8::GOrder S; pg8::EpiSwigluF8 E; S.a_tile = (size_t)256 * D; S.b_tile = (size_t)256 * D; E.O = (unsigned char*)HID; E.ldc = FE;
            int t[8]; int acc = 0;
#pragma unroll
            for (int e = 0; e < NE; ++e) { t[e] = acc; acc += (cnt[e] + 255) >> 8; }
            S.so.init(acc * 256, 2 * FE, G, bx); S.A = (const char*)XG; S.B = (const char*)(ws + WS_WMGU); S.b_exp = (size_t)2 * FE * D;
            S.tb1 = t[1]; S.tb2 = t[2]; S.tb3 = t[3]; S.tb4 = t[4]; S.tb5 = t[5]; S.tb6 = t[6]; S.tb7 = t[7];
            pg8::Gemm g{D / 2};
#ifdef EXP_NULL_EPI
            if constexpr (REP) { pg8::EpiNull E0; E0.O = (unsigned char*)HID; E0.ldc = FE; pg8::gemm_phase<pg8::EpiNull, pg8::GOrder, true, true, 2>(L + RING_OFF, g, S, E0); } else
#endif
            pg8::gemm_phase<pg8::EpiSwigluF8, pg8::GOrder, true, true, 2>(L + RING_OFF, g, S, E);
            if constexpr (!REP) { const int ni = moe_tail_idle(cnt, G), ci = bx - (256 - ni);
                if (ni && ci >= 0) { const int first = MOE_ITEMS - ni * NWAVES * MOE_FILL17 + ci * NWAVES + wave; moe_conv_range(a, ws, scr, first, ni * NWAVES, MOE_ITEMS, lane); } }
        } else if constexpr (k == 5 && l == 0) {
            float lg[8];
            { RowIn R, Rn; int row = gw; if (row < NTOK) mrow_load<true>(R, X, row, lane);
              for (; row < NTOK; row += NGW) { const int nx = row + NGW; if (nx < NTOK) mrow_load<true>(Rn, X, nx, lane); asm volatile("" ::: "memory");
                  mrow<1>(R, H, SH, a.in[I_FFN_NORM], nullptr, nullptr, row, lane, lg); if (nx < NTOK) R = Rn; } }
        } else if constexpr (k == 8 && l == 0) {
            LAS float* tab = (LAS float*)(L + RING_OFF); load_gate_tab(tab, a.in[I_W_IN] + (size_t)D * DIN, tid); __syncthreads();
            float lg[8];
            { RowIn R, Rn; int row = gw; if (row < NTOK) mrow_load<true>(R, X, row, lane);
              for (; row < NTOK; row += NGW) { const int nx = row + NGW; if (nx < NTOK) mrow_load<true>(Rn, X, nx, lane); asm volatile("" ::: "memory");
                  mrow<0>(R, H, SH, a.in[I_ATTN_NORM] + D, tab, Gt, row, lane, lg); if (nx < NTOK) R = Rn; } }
        } else if constexpr (k == 5 && l == 1) {
            LAS int* sel_e = (LAS int*)(L + RING_OFF);
            LAS float* sel_g = (LAS float*)(L + RING_OFF + 512);
            LAS int* lcnt = (LAS int*)(L + RING_OFF + 1024);
            LAS float* tab = (LAS float*)(L + RING_OFF + 4096); load_router_tab(tab, a.in[I_ROUTER], tid); __syncthreads();
            for (int rb = bx; rb < NTOK / 64; rb += G) {
                if (tid < 16) lcnt[tid] = 0;
                RowIn R, Rn; mrow_load<true>(R, X2, rb * 64 + wave * 8, lane);
                for (int i = 0; i < 8; ++i) { const int rl = wave * 8 + i, row = rb * 64 + rl; float lg[8];
                    if (i < 7) mrow_load<true>(Rn, X2, row + 1, lane); asm volatile("" ::: "memory");
                    mrow<2>(R, H, SH, a.in[I_FFN_NORM] + D, tab, nullptr, row, lane, lg); if (i < 7) R = Rn;
                    if (lane == 0) { const float v0 = lg[0], v1 = lg[1]; const int e0 = __float_as_int(lg[2]), e1 = __float_as_int(lg[3]);
                        const float g1 = 1.f / (1.f + __expf(v0 - v1));
                        sel_e[2 * rl] = e0; sel_e[2 * rl + 1] = e1; sel_g[2 * rl] = 1.f - g1; sel_g[2 * rl + 1] = g1; } }
                __syncthreads();
                int e0 = 0, e1 = 0, r0 = 0, r1 = 0;
                if (tid < 64) { e0 = sel_e[2 * tid]; e1 = sel_e[2 * tid + 1]; r0 = __hip_atomic_fetch_add(lcnt + e0, 1, __ATOMIC_RELAXED, __HIP_MEMORY_SCOPE_WORKGROUP); r1 = __hip_atomic_fetch_add(lcnt + e1, 1, __ATOMIC_RELAXED, __HIP_MEMORY_SCOPE_WORKGROUP); }
                __syncthreads();
                if (tid < 8) lcnt[8 + tid] = atomicAdd(cnt + tid, (int)lcnt[tid]);
                __syncthreads();
                if (tid < 64) { const int row = rb * 64 + tid, s0 = lcnt[8 + e0] + r0, s1 = lcnt[8 + e1] + r1;
                    toklist[e0 * NTOK + s0] = row; toklist[e1 * NTOK + s1] = row; tokinfo[row] = make_int4(e0, s0, e1, s1); tgate[row] = make_float2(sel_g[2 * tid], sel_g[2 * tid + 1]); }
                __syncthreads();
            }
        } else if constexpr (k == 6 && l == 1) {
            { int base[NE]; int acc = 0;
#pragma unroll
              for (int e = 0; e < NE; ++e) { base[e] = acc; acc += (cnt[e] + 255) & ~255; }
              for (int r = gw; r < acc; r += NGW) { int e = 0, be = 0;
#pragma unroll
                  for (int c = 1; c < NE; ++c) if (r >= base[c]) { e = c; be = base[c]; }
                  const int s = r - be; v4u v0 = {0u, 0u, 0u, 0u}; float sv = 0.f;
                  if (s < cnt[e]) { const int tok = toklist[e * NTOK + s]; v0 = *((const v4u*)(H + (size_t)tok * D) + lane); sv = SH[tok]; }
                  *((v4u*)(XG + (size_t)r * D) + lane) = v0; if (lane == 0) SXG[r] = sv; } }
            moe_conv_range(a, ws, scr, moe_prefilled(G) + gw, NGW, MOE_ITEMS - moe_tail_idle(cnt, G) * NWAVES * MOE_FILL17, lane);
        } else if constexpr (k == 8 && l == 1) {
        } else if constexpr (l == 1 && k == 10) {
            int base[NE]; { int acc = 0;
#pragma unroll
              for (int e = 0; e < NE; ++e) { base[e] = acc; acc += (cnt[e] + 255) & ~255; } }
            constexpr int HALFR = NTOK; constexpr int rlo = 0;
            const bf16_t* Xs = X2;
            float* out = (float*)a.out;
            struct FA { uint2 v[4]; int4 ti; float2 tg; }; struct FB { uint2 y0[4], y1[4]; };
            auto loadA = [&](FA& A, int rr) { const uint2* xr = (const uint2*)(Xs + (size_t)rr * D) + lane;
#pragma unroll
                for (int j = 0; j < 4; ++j) A.v[j] = xr[64 * j];
                A.ti = tokinfo[rlo + rr]; A.tg = tgate[rlo + rr]; };
            auto ldrow = [&](uint2 (&y)[4], int r) {
                if ((r >> 8) < pg8::GOrderTail::MAIN_M) { const uint2* p = (const uint2*)(Y + (size_t)r * D) + lane;
#pragma unroll
                    for (int j = 0; j < 4; ++j) y[j] = p[64 * j]; }
                else { float s[16];
#pragma unroll
                    for (int i = 0; i < 16; ++i) s[i] = 0.f;
#pragma unroll 2
                    for (int kp = 0; kp < 8; ++kp) { const uint2* p = (const uint2*)(Y + (size_t)((pg8::EpiBfPart::YP_TILE0 + kp * 8 + (r >> 8) - pg8::GOrderTail::MAIN_M) * 256 + (r & 255)) * D) + lane;
#pragma unroll
                        for (int j = 0; j < 4; ++j) { const uint2 q = p[64 * j]; s[4 * j] += __uint_as_float(q.x << 16); s[4 * j + 1] += __uint_as_float(q.x & 0xffff0000u); s[4 * j + 2] += __uint_as_float(q.y << 16); s[4 * j + 3] += __uint_as_float(q.y & 0xffff0000u); } }
#pragma unroll
                    for (int j = 0; j < 4; ++j) { y[j].x = pk2(s[4 * j], s[4 * j + 1]); y[j].y = pk2(s[4 * j + 2], s[4 * j + 3]); } } };
            auto loadB = [&](FB& B, const FA& A) { int b0 = 0, b1 = 0;
#pragma unroll
                for (int c = 0; c < NE; ++c) { if (c == A.ti.x) b0 = base[c]; if (c == A.ti.z) b1 = base[c]; }
                ldrow(B.y0, b0 + A.ti.y); ldrow(B.y1, b1 + A.ti.w); };
            FA A0, A1, A2; FB B0, B1; int rr = gw;
            if (rr < HALFR) { loadA(A0, rr); if (rr + NGW < HALFR) loadA(A1, rr + NGW); loadB(B0, A0); }
            for (; rr < HALFR; rr += NGW) {
                const bool h1 = rr + NGW < HALFR, h2 = rr + 2 * NGW < HALFR;
                if (h2) loadA(A2, rr + 2 * NGW);
                if (h1) loadB(B1, A1);
                asm volatile("" ::: "memory");
                float4 v[4]; const float2 tg = A0.tg;
#pragma unroll
                for (int j = 0; j < 4; ++j) { const uint2 q = B0.y0[j], c = B0.y1[j], x = A0.v[j];
                    v[j].x = __uint_as_float(x.x << 16) + tg.x * bf2f((bf16_t)(q.x & 0xffff)) + tg.y * bf2f((bf16_t)(c.x & 0xffff)); v[j].y = __uint_as_float(x.x & 0xffff0000u) + tg.x * bf2f((bf16_t)(q.x >> 16)) + tg.y * bf2f((bf16_t)(c.x >> 16));
                    v[j].z = __uint_as_float(x.y << 16) + tg.x * bf2f((bf16_t)(q.y & 0xffff)) + tg.y * bf2f((bf16_t)(c.y & 0xffff)); v[j].w = __uint_as_float(x.y & 0xffff0000u) + tg.x * bf2f((bf16_t)(q.y >> 16)) + tg.y * bf2f((bf16_t)(c.y >> 16)); }
                float ss = 0.f;
#pragma unroll
                for (int j = 0; j < 4; ++j) ss += v[j].x * v[j].x + v[j].y * v[j].y + v[j].z * v[j].z + v[j].w * v[j].w;
                ss = wave_sum(ss); const float r = rsqrtf(ss * (1.f / D) + EPS);
                float4* xo = (float4*)(out + (size_t)(rlo + rr) * D) + lane;
#pragma unroll
                for (int j = 0; j < 4; ++j) { const float4 g = *((const float4*)a.in[I_FINAL_NORM] + 64 * j + lane); xo[64 * j] = make_float4(v[j].x * r * g.x, v[j].y * r * g.y, v[j].z * r * g.z, v[j].w * r * g.w); }
                if (h1) { A0 = A1; B0 = B1; } if (h2) A1 = A2;
            }
        } else {
            if constexpr (k == 1) {
                unsigned char* sc = ws + WS_SCAN; const int wv = wave;
#define ITEM_DECODE(it_) const int item = (it_) & 1023, h = item & 3, c = (item >> 2) & 127, b = item >> 9
#define HG_LB(h_) (l == 0 ? 0.f : 1.f / (1.f + __expf(a.in[I_HGRN_LB][(h_) * 64 + (tl & 63)] - a.in[I_HGRN_LB][256 + (h_) * 64 + (tl & 63)])))
                const int hf = wave >> 2, tq4 = wave & 3; LAS unsigned char* Lh = L + hf * scan::HLDS;
                { scan::HgIn R, Rn;
                  auto itemOf = [&](int pp) { const int it = bx + (2 * pp + hf) * G; return it < 1024 ? it : it - G; };
                  int pp = 0; if (bx < 1024) { ITEM_DECODE(itemOf(0)); scan::hgrn_load<false>(R, P, b, c, h, nullptr, tid & 255, tq4); }
                  for (; bx + 2 * pp * G < 1024; ++pp) { const bool nx = bx + 2 * (pp + 1) * G < 1024; int tl = tid & 255; asm volatile("" : "+v"(tl));
                      if (nx) { ITEM_DECODE(itemOf(pp + 1)); scan::hgrn_load<false>(Rn, P, b, c, h, nullptr, tl, tq4); }
                      asm volatile("" ::: "memory");
                      { ITEM_DECODE(itemOf(pp)); (void)b; (void)c; scan::hgrn_b_item(Lh, R, HG_LB(h), (float*)(sc + scan::SC_LHG) + (size_t)item * 4096, (float*)(sc + scan::SC_DEC) + item * 64, tl, tq4); }
                      if (nx) R = Rn; } }
                { scan::MlIn R, Rn; int base = bx; while (base < 1024) base += G;
                  auto itemOf = [&](int pp) { const int it = base + (2 * pp + hf) * G; return it < 2048 ? it : it - G; };
                  int pp = 0; if (base < 2048) { ITEM_DECODE(itemOf(0)); scan::mlstm_load<false>(R, P, Gt, b, c, h, nullptr, nullptr, nullptr, tid & 255, tq4); }
                  for (; base + 2 * pp * G < 2048; ++pp) { const bool nx = base + 2 * (pp + 1) * G < 2048; int tl = tid & 255; asm volatile("" : "+v"(tl));
                      if (nx) { ITEM_DECODE(itemOf(pp + 1)); scan::mlstm_load<false>(Rn, P, Gt, b, c, h, nullptr, nullptr, nullptr, tl, tq4); }
                      asm volatile("" ::: "memory");
                      { ITEM_DECODE(itemOf(pp)); (void)b; (void)c; scan::mlstm_b_item(Lh, R, a.in[I_MLSTM_CONV] + l * 2048, a.in[I_MLSTM_BI] + l * 4, a.in[I_MLSTM_BF] + l * 4, h, (float*)(sc + scan::SC_LML) + (size_t)item * 4096,
                                            (float*)(sc + scan::SC_NL) + item * 64, (float*)(sc + scan::SC_AMAX) + item, (float*)(sc + scan::SC_BEND) + item, tl, tq4); }
                      if (nx) R = Rn; } }
                { LAS unsigned* lst = (LAS unsigned*)(L + LDSCTL_OFF + 64);
                  if (tid < 48) lst[tid] = 0u; __syncthreads();
                  float mq0 = 0.f, mq1 = 0.f, mk0 = 0.f, mk1 = 0.f, md0 = 0.f, md1 = 0.f;
                  for (int row = gw; row < NTOK; row += NGW) {
                      const v4u wq = *((const v4u*)(P + (size_t)row * PW + P_FQ) + lane), wk = *((const v4u*)(P + (size_t)row * PW + P_FK) + lane);
                      float sq = 0.f, sk = 0.f, sd = 0.f;
#pragma unroll
                      for (int i = 0; i < 4; ++i) { const float q0 = bf2f((bf16_t)(wq[i] & 0xffff)), q1 = bf2f((bf16_t)(wq[i] >> 16)), k0 = bf2f((bf16_t)(wk[i] & 0xffff)), k1 = bf2f((bf16_t)(wk[i] >> 16));
                          sq += q0 * q0 + q1 * q1; sk += k0 * k0 + k1 * k1; sd += q0 * k0 + q1 * k1; }
                      sq += __shfl_xor(sq, 1); sq += __shfl_xor(sq, 2); sq += __shfl_xor(sq, 4); sk += __shfl_xor(sk, 1); sk += __shfl_xor(sk, 2); sk += __shfl_xor(sk, 4);
                      sd += __shfl_xor(sd, 1); sd += __shfl_xor(sd, 2); sd += __shfl_xor(sd, 4); sd = fmaxf(-sd, 0.f);
                      if (row < SEQ) { mq0 = fmaxf(mq0, sq); mk0 = fmaxf(mk0, sk); md0 = fmaxf(md0, sd); } else { mq1 = fmaxf(mq1, sq); mk1 = fmaxf(mk1, sk); md1 = fmaxf(md1, sd); } }
                  if ((lane & 7) == 0) { const int hh = lane >> 3;
                      __hip_atomic_fetch_max(lst + hh * 2, __float_as_uint(mq0), __ATOMIC_RELAXED, __HIP_MEMORY_SCOPE_WORKGROUP); __hip_atomic_fetch_max(lst + hh * 2 + 1, __float_as_uint(mk0), __ATOMIC_RELAXED, __HIP_MEMORY_SCOPE_WORKGROUP);
                      __hip_atomic_fetch_max(lst + 16 + hh * 2, __float_as_uint(mq1), __ATOMIC_RELAXED, __HIP_MEMORY_SCOPE_WORKGROUP); __hip_atomic_fetch_max(lst + 16 + hh * 2 + 1, __float_as_uint(mk1), __ATOMIC_RELAXED, __HIP_MEMORY_SCOPE_WORKGROUP);
                      __hip_atomic_fetch_max(lst + 32 + hh, __float_as_uint(md0), __ATOMIC_RELAXED, __HIP_MEMORY_SCOPE_WORKGROUP); __hip_atomic_fetch_max(lst + 40 + hh, __float_as_uint(md1), __ATOMIC_RELAXED, __HIP_MEMORY_SCOPE_WORKGROUP); }
                  __syncthreads();
                  if (tid < 32) __hip_atomic_fetch_max((unsigned*)ctl + CW_STAT + l * 32 + tid, lst[tid], __ATOMIC_RELAXED, __HIP_MEMORY_SCOPE_AGENT);
                  else if (tid < 48) __hip_atomic_fetch_max((unsigned*)ctl + CW_STAT3 + l * 16 + (tid - 32), lst[tid], __ATOMIC_RELAXED, __HIP_MEMORY_SCOPE_AGENT); }
            } else if constexpr (k == 2) {
                for (int j = bx; j < 256; j += G) scan::scan_c_block<REP>(ws + WS_SCAN, j, tid);
            } else if constexpr (k == 3) {
                static_assert(attn_body::ATTN_LDS_BYTES <= RING_BYTES, "attention LDS");
                unsigned char* sc = ws + WS_SCAN; const int wv = wave;
                const float* stat = (const float*)(ctl + CW_STAT + l * 32);
                LAS unsigned* slot = (LAS unsigned*)(L + LDSCTL_OFF);
                int v;
                for (;;) {
                    if (tid == 0) *slot = __hip_atomic_fetch_add((unsigned*)ctl + CW_QCTR + l + (REP ? 2 : 0), 1u, __ATOMIC_RELAXED, __HIP_MEMORY_SCOPE_AGENT);
                    __syncthreads();
                    v = __builtin_amdgcn_readfirstlane((int)*(volatile LAS unsigned*)slot);
                    if (v >= 736) break;
                    int qb, bh, part = 0; float* PART = nullptr;
                    if (v < 448) { qb = 31 - (v >> 5); bh = v & 15; part = (v >> 4) & 1; PART = (float*)(ws + WS_SCAN + (40 + 32 * l) * MiB) + (size_t)(bh * 14 + (qb - 18)) * 2 * attn_body::PART_F; }
                    else { const int u2 = v - 448; qb = 17 - (u2 >> 4); bh = u2 & 15; }
                    const float Tsk = 30.f + (__builtin_sqrtf(stat[bh * 2] * stat[bh * 2 + 1]) + ((const float*)(ctl + CW_STAT3 + l * 16))[bh]) * 1.01f + 1.f;
                    attn_body::attn_unit<8>(bh >> 3, bh & 7, qb, (const attn_body::bf16*)(P + P_FQ), (const attn_body::bf16*)(P + P_FK), (const attn_body::bf16*)(P + P_FV), (attn_body::bf16*)(MIX + 512), CF + (size_t)bh * SEQ, Tsk,
                                            part, PART, (unsigned*)ctl + CW_AFLAG + (l + (REP ? 2 : 0)) * 512 + bh * 32 + qb, (char*)L + RING_OFF);
                    __syncthreads();
                }
                int tid2 = tid; asm volatile("" : "+v"(tid2));
                while (v < 736 + 384 + 256) {
                    const int it0 = v < 1120 ? (v - 736) * 4 : 1536 + (v - 1120) * 2, nj = v < 1120 ? 2 : 1;
                    const int hf = wv >> 2, tq4 = wv & 3; LAS unsigned char* Lh = L + hf * scan::HLDS;
#pragma unroll 1
                    for (int j = 0; j < nj; ++j) { const int it = it0 + 2 * j + hf; int tl = tid2 & 255; asm volatile("" : "+v"(tl)); ITEM_DECODE(it);
                        if (it0 < 1024) { scan::HgIn R; scan::hgrn_load<true>(R, P, b, c, h, (const float*)(sc + scan::SC_LHG) + (size_t)item * 4096, tl, tq4);
                            const float lb = l == 0 ? 0.f : 1.f / (1.f + __expf(a.in[I_HGRN_LB][h * 64 + (tl & 63)] - a.in[I_HGRN_LB][256 + h * 64 + (tl & 63)]));
                            scan::hgrn_d_item(Lh, R, lb, a.in[I_HGRN_NORM] + l * 256 + h * 64, MIX + (size_t)(b * SEQ + c * 64) * D + h * 64, tl, tq4); }
                        else { scan::MlIn R; scan::mlstm_load<true>(R, P, Gt, b, c, h, (const float*)(sc + scan::SC_LML) + (size_t)item * 4096, (const float*)(sc + scan::SC_NL) + item * 64, (const float*)(sc + scan::SC_MPREV) + item, tl, tq4);
                            scan::mlstm_d_item(Lh, R, a.in[I_MLSTM_CONV] + l * 2048, a.in[I_MLSTM_BI] + l * 4, a.in[I_MLSTM_BF] + l * 4, a.in[I_MLSTM_NORM] + l * 256 + h * 64, h, MIX + (size_t)(b * SEQ + c * 64) * D + 256 + h * 64, tl, tq4); } }
                    __syncthreads();
                    if (tid2 == 0) *slot = __hip_atomic_fetch_add((unsigned*)ctl + CW_QCTR + l + (REP ? 2 : 0), 1u, __ATOMIC_RELAXED, __HIP_MEMORY_SCOPE_AGENT);
                    __syncthreads();
                    v = __builtin_amdgcn_readfirstlane((int)*(volatile LAS unsigned*)slot);
                }
            }

        }
}
__global__ void __launch_bounds__(NTHR, 2) mega(MArgs a) {
    extern __shared__ __attribute__((aligned(16))) unsigned char lds[];
    LAS unsigned char* L = (LAS unsigned char*)lds;
    volatile LAS unsigned* MISC = (volatile LAS unsigned*)(L + MISC_OFF);
    const int tid = threadIdx.x, wave = __builtin_amdgcn_readfirstlane(tid >> 6);
    const int G = gridDim.x, bx = blockIdx.x, vcu = (G % 8 == 0) ? (bx % 8) * (G / 8) + bx / 8 : bx;
    for (int u = tid; u < (LDS_BYTES - LDSCTL_OFF) / 4; u += NTHR) ((LAS unsigned*)(L + LDSCTL_OFF))[u] = 0u;
    __syncthreads();
    const int lo = a.ph_lo, hi = a.ph_hi;
    XcdBarrier bar; bar.bar = (unsigned*)(a.ws + WS_CTL) + CW_BAR; bar.x = 0; bar.st = nullptr;
    if (hi - lo > 1) bar = xcd_barrier_post((unsigned*)(a.ws + WS_CTL) + CW_BAR, MISC + 8);
#ifndef REPEAT_MASK
#define REPEAT_MASK 0u
#endif
#define PHASE(k) if (lo <= (k) && (k) < hi) { run_phase<k>(a, L, tid, wave, G, bx, vcu); if constexpr ((REPEAT_MASK >> (k)) & 1u) { xcd_barrier(bar); run_phase<k, true>(a, L, tid, wave, G, bx, vcu); } if ((k) + 1 < hi) xcd_barrier(bar); }
    PHASE(0) PHASE(1) PHASE(2) PHASE(3) PHASE(4) PHASE(5) PHASE(6) PHASE(7) PHASE(8) PHASE(9) PHASE(10)
    PHASE(11) PHASE(12) PHASE(13) PHASE(14) PHASE(15) PHASE(16) PHASE(17) PHASE(19) PHASE(20)
#undef PHASE
}
#ifndef MEGA_MASK
#define MEGA_MASK 0x1FFFFFu
#endif
#ifndef FUSE_RUNS
#define FUSE_RUNS 1
#endif
extern "C" void kernel_launch(void* const* d_in, const int* in_sizes, int n_in, void* d_out, int out_size, void* d_ws, size_t ws_size, hipStream_t stream) {
    static int grid = 0;
    if (grid == 0) {
        if (n_in != 20 || ws_size < WS_END || out_size != NTOK * D) { fprintf(stderr, "kernel_launch: unexpected n_in %d / ws %zu / out %d\n", n_in, ws_size, out_size); grid = -1; return; }
        int dev = 0, cus = 0, per_cu = 0;
        if (hipGetDevice(&dev) != hipSuccess || hipDeviceGetAttribute(&cus, hipDeviceAttributeMultiprocessorCount, dev) != hipSuccess) { grid = -1; return; }
        if (hipFuncSetAttribute((const void*)mega, hipFuncAttributeMaxDynamicSharedMemorySize, LDS_BYTES) != hipSuccess) { fprintf(stderr, "kernel_launch: hipFuncSetAttribute failed\n"); grid = -1; return; }
        if (hipOccupancyMaxActiveBlocksPerMultiprocessor(&per_cu, (const void*)mega, NTHR, LDS_BYTES) != hipSuccess || per_cu < 1) { fprintf(stderr, "kernel_launch: occupancy query says %d\n", per_cu); per_cu = 1; }
        (void)hipGetLastError();
        grid = cus;
        if (grid > 256) grid = 256;
    }
    if (grid < 0) return;
    const float* const* in = (const float* const*)d_in;
    unsigned char* ws = (unsigned char*)d_ws; float* X = (float*)d_out;
    (void)hipMemsetAsync(ws + WS_CTL, 0, CTL_BYTES, stream);
    MArgs ma; memset(&ma, 0, sizeof ma);
    for (int i = 0; i < 20; ++i) ma.in[i] = in[i];
    ma.out = X; ma.ws = ws;
    ma.ph_lo = 0; ma.ph_hi = N_PHASES;
    hipLaunchKernelGGL(mega, dim3(grid), dim3(NTHR), LDS_BYTES, stream, ma);
}
```

```cpp
#include <hip/hip_runtime.h>
#include <hip/hip_bf16.h>
#include <cstdint>
#include <cstdio>
#include <cstring>

namespace cfg {
constexpr int NTOK = 16384, D = 1024, SEQ = 8192, NB = 2, DIN = 3600, PW = 3584, GW = 16;
constexpr int FF = 2816, FE = 3584, NE = 8, MAXROWS = 34816;
constexpr float EPS = 1e-6f;
constexpr float LOG2E = 1.4426950408889634f;
constexpr float QSCALE = 0.125f * LOG2E;
constexpr int P_HQ = 0, P_HF = 256, P_HI = 512, P_HG = 768, P_MQ = 1024, P_MK = 1280, P_MV = 1536, P_MO = 1792, P_FQ = 2048, P_FK = 2560, P_FV = 3072;
constexpr size_t MiB = 1u << 20;
constexpr size_t WS_CTL = 0, CTL_BYTES = 1 * MiB;
constexpr size_t WS_G = 2 * MiB;
constexpr size_t WS_CF = 3 * MiB;
constexpr size_t WS_TOKINFO = 3 * MiB + 512 * 1024;
constexpr size_t WS_TGATE = 3 * MiB + 768 * 1024;
constexpr size_t WS_TOKLIST = 4 * MiB;
constexpr size_t WS_P = 8 * MiB;
constexpr size_t WS_SCAN = 120 * MiB;
constexpr size_t WS_HID = 8 * MiB;
constexpr size_t WS_H = 246 * MiB;
constexpr size_t WS_MIX = 278 * MiB;
constexpr size_t WS_XG = 278 * MiB;
constexpr size_t WS_W = 346 * MiB;
constexpr size_t WS_Y = 346 * MiB;
constexpr size_t WS_X2 = 130 * MiB;
constexpr size_t WS_PB = 164 * MiB;
constexpr size_t WS_END = 466 * MiB;
constexpr int CW_CNT = 64;
constexpr int CW_STAT = 128;
constexpr int CW_STAT3 = 192;
constexpr int CW_QCTR = 256;
constexpr int CW_PQ = 262;
constexpr int CW_TFLAG = 384;
constexpr int CW_AFLAG = 512;
}
using namespace cfg;
typedef unsigned short bf16_t;

__device__ __forceinline__ bf16_t f2bf(float f) { unsigned u = __builtin_bit_cast(unsigned, f); return (bf16_t)((u + 0x7fffu + ((u >> 16) & 1u)) >> 16); }
__device__ __forceinline__ float bf2f(bf16_t h) { return __builtin_bit_cast(float, (unsigned)h << 16); }
#define DPP_F(old_, v_, ctrl_, rmask_) __int_as_float(__builtin_amdgcn_update_dpp(__float_as_int(old_), __float_as_int(v_), ctrl_, rmask_, 0xf, false))
__device__ __forceinline__ float wave_sum(float v) {
    v += DPP_F(0.f, v, 0xB1, 0xf); v += DPP_F(0.f, v, 0x4E, 0xf); v += DPP_F(0.f, v, 0x141, 0xf); v += DPP_F(0.f, v, 0x140, 0xf);
    v += DPP_F(0.f, v, 0x142, 0xa); v += DPP_F(0.f, v, 0x143, 0xc);
    return __int_as_float(__builtin_amdgcn_readlane(__float_as_int(v), 63));
}
__device__ __forceinline__ float wave_max_nn(float v) {
    v = fmaxf(v, DPP_F(0.f, v, 0xB1, 0xf)); v = fmaxf(v, DPP_F(0.f, v, 0x4E, 0xf)); v = fmaxf(v, DPP_F(0.f, v, 0x141, 0xf)); v = fmaxf(v, DPP_F(0.f, v, 0x140, 0xf));
    v = fmaxf(v, DPP_F(0.f, v, 0x142, 0xa)); v = fmaxf(v, DPP_F(0.f, v, 0x143, 0xc));
    return __int_as_float(__builtin_amdgcn_readlane(__float_as_int(v), 63));
}
__device__ __forceinline__ float sigmoidf_(float z) { return 1.f / (1.f + __expf(-z)); }
__device__ __forceinline__ float siluf_(float z) { return z / (1.f + __expf(-z)); }
__device__ __forceinline__ float log_sigmoidf_(float z) { return fminf(z, 0.f) - log1pf(__expf(-fabsf(z))); }

__device__ __forceinline__ int moe_bases(const int* cnt, int* base) {
    int acc = 0;
#pragma unroll
    for (int e = 0; e < NE; ++e) { base[e] = acc; acc += (cnt[e] + 255) & ~255; }
    return acc;
}

namespace pg8 {
#define PG8_LAS __attribute__((address_space(3)))
typedef unsigned short bf16_t;
typedef short bf16x8 __attribute__((ext_vector_type(8)));
typedef float f32x4 __attribute__((ext_vector_type(4)));
typedef unsigned u32x4 __attribute__((ext_vector_type(4)));
constexpr int BM = 256, BK = 64, HALF = 128, HTB = HALF * BK * 2  , STAGE_BYTES = 8 * HTB, NXCD = 8, WGM = 8;

__host__ __device__ __forceinline__ int lds_byte(int r, int c) { const int st = (r >> 4) * 2 + (c >> 5), rr = r & 15, cc = c & 31, ob = rr * 64 + cc * 2; return st * 1024 + (ob ^ (((ob >> 9) & 1) << 5)); }
__host__ __device__ __forceinline__ void stage_rc(int b, int& R, int& C) { const int st = b / 1024, sb = b % 1024, swz = sb ^ (((sb >> 9) & 1) << 5); R = (st >> 1) * 16 + swz / 64; C = (st & 1) * 32 + (swz % 64) / 2; }
__host__ __device__ __forceinline__ int perm32(int rho) { const int n = rho >> 4, i = rho & 15; return 8 * (i >> 2) + 4 * n + (i & 3); }

struct Unit { int pm, pn, tq; };
struct Gemm { int K; };

struct StaticOrder {
    int nM, nN, nwg, G, c;
    __host__ __device__ void init(int M, int N, int G_, int c_) { nM = M / BM; nN = N / BM; nwg = nM * nN; G = G_; c = c_; }
    __host__ __device__ bool next(int i, Unit& u) const {
        const long L = (long)i * G + c; if (L >= nwg) return false;
        int wgid = (int)L; { const int q = nwg / NXCD, r = nwg % NXCD, xcd = wgid % NXCD, off = wgid / NXCD; wgid = (xcd < r ? xcd * (q + 1) : r * (q + 1) + (xcd - r) * q) + off; }
        const int nig = WGM * nN, gid = wgid / nig, fm = gid * WGM, gsz = (nM - fm) < WGM ? (nM - fm) : WGM;
        u.pm = fm + ((wgid % nig) % gsz); u.pn = (wgid % nig) / gsz; return true;
    }
    __device__ __forceinline__ void a_ready(const Unit&) const {}
    __device__ __forceinline__ void done(const Unit&) const {}
};

__device__ __forceinline__ unsigned cvt_pk_bf16(float lo, float hi) { unsigned r; asm volatile("v_cvt_pk_bf16_f32 %0, %1, %2" : "=v"(r) : "v"(lo), "v"(hi)); return r; }
typedef int i32x4 __attribute__((ext_vector_type(4)));
constexpr float F8_HSCALE = 4.f, F8_WSCALE = 64.f, F8_ASCALE = 16.f, F8_GSCALE = 32.f;
template <bool I8> struct AccT { typedef f32x4 type; };
template <> struct AccT<true> { typedef i32x4 type; };
__device__ __forceinline__ f32x4 mma_sel(bf16x8 b, bf16x8 a, f32x4 c) { return __builtin_amdgcn_mfma_f32_16x16x32_bf16(b, a, c, 0, 0, 0); }
__device__ __forceinline__ i32x4 mma_sel(bf16x8 b, bf16x8 a, i32x4 c) { return __builtin_amdgcn_mfma_i32_16x16x64_i8(__builtin_bit_cast(i32x4, b), __builtin_bit_cast(i32x4, a), c, 0, 0, 0); }
typedef int i32x8 __attribute__((ext_vector_type(8)));
struct Frag2 { bf16x8 k[2]; };
template <int MODE> struct Frag { typedef Frag2 type; };
template <> struct Frag<2> { typedef i32x8 type; };
template <int MODE> __device__ __forceinline__ typename Frag<MODE>::type ldfrag(PG8_LAS const unsigned char* p) {
    if constexpr (MODE == 2) { const i32x4 lo = *(const PG8_LAS i32x4*)p, hi = *(const PG8_LAS i32x4*)(p + 1024); return (i32x8){lo[0], lo[1], lo[2], lo[3], hi[0], hi[1], hi[2], hi[3]}; }
    else { Frag2 f; f.k[0] = *(const PG8_LAS bf16x8*)p; f.k[1] = *(const PG8_LAS bf16x8*)(p + 1024); return f; }
}
__device__ __forceinline__ void mma_step_(f32x4& acc, const Frag2& b, const Frag2& a) { acc = mma_sel(b.k[0], a.k[0], acc); acc = mma_sel(b.k[1], a.k[1], acc); }
__device__ __forceinline__ void mma_step_(i32x4& acc, const Frag2& b, const Frag2& a) { acc = mma_sel(b.k[0], a.k[0], acc); acc = mma_sel(b.k[1], a.k[1], acc); }
__device__ __forceinline__ void mma_step_(f32x4& acc, const i32x8& b, const i32x8& a) {
#if defined(__HIP_DEVICE_COMPILE__)
    const int scl = 0x7f7f7f7f;
    asm volatile("v_mfma_scale_f32_16x16x128_f8f6f4 %0, %1, %2, %0, %3, %3 op_sel_hi:[0,0,0]" : "+v"(acc) : "v"(b), "v"(a), "v"(scl));
#endif
}
template <int MODE, class ACC, class F> __device__ __forceinline__ void mma_step(ACC& acc, const F& b, const F& a) { mma_step_(acc, b, a); }
struct EpiBf {
    static constexpr bool PERM = true, AFTER_DRAIN = false;
    bf16_t* O; int ldc; int s_lo, s_hi; float scale;
    struct Pre {}; __device__ __forceinline__ void prefetch(Pre&, const Unit&, int, int, int, int, int) const {} __device__ __forceinline__ void commit(const Pre&, int, int, int, int, int) const {}
    __device__ __forceinline__ void operator()(const f32x4 (&acc)[2][2][4][2], const Unit& u, int wr, int wc, int fr_, int fq_, const Pre&, int) const {
        int fr = fr_, fq = fq_; asm volatile("" : "+v"(fr), "+v"(fq));
        const int row0 = u.pm * BM + wr * 64 + fr, col0 = u.pn * BM + wc * 32 + 8 * fq;
        const float sc = (u.pn >= s_lo && u.pn < s_hi) ? scale : 1.f;
#pragma unroll
        for (int ai = 0; ai < 2; ++ai)
#pragma unroll
            for (int m = 0; m < 4; ++m) { bf16_t* rowp = O + (size_t)(row0 + ai * HALF + m * 16) * ldc + col0;
#pragma unroll
                for (int bj = 0; bj < 2; ++bj) { const f32x4 v0 = acc[ai][bj][m][0] * sc, v1 = acc[ai][bj][m][1] * sc;
                    u32x4 w; w.x = cvt_pk_bf16(v0[0], v0[1]); w.y = cvt_pk_bf16(v0[2], v0[3]); w.z = cvt_pk_bf16(v1[0], v1[1]); w.w = cvt_pk_bf16(v1[2], v1[3]);
                    *(u32x4*)(rowp + bj * HALF) = w; } }
    }
};
__device__ __forceinline__ float silu_mul(float g, float u) { return g * __builtin_amdgcn_rcpf(1.f + __expf(-g)) * u; }
__device__ __forceinline__ float silu2_mul(float g2, float u2) { return g2 * __builtin_amdgcn_rcpf(1.f + __builtin_amdgcn_exp2f(-g2)) * u2; }
struct EpiSwiglu {
    static constexpr bool PERM = true, AFTER_DRAIN = false;
    bf16_t* O; int ldc;
    struct Pre {}; __device__ __forceinline__ void prefetch(Pre&, const Unit&, int, int, int, int, int) const {} __device__ __forceinline__ void commit(const Pre&, int, int, int, int, int) const {}
    __device__ __forceinline__ void operator()(const f32x4 (&acc)[2][2][4][2], const Unit& u, int wr, int wc, int fr, int fq, const Pre&, int) const {
        const int row0 = u.pm * BM + wr * 64 + fr, col0 = u.pn * HALF + wc * 32 + 8 * fq;
#pragma unroll
        for (int ai = 0; ai < 2; ++ai)
#pragma unroll
            for (int m = 0; m < 4; ++m) { bf16_t* rowp = O + (size_t)(row0 + ai * HALF + m * 16) * ldc + col0;
                const f32x4 g0 = acc[ai][0][m][0], g1 = acc[ai][0][m][1], u0 = acc[ai][1][m][0], u1 = acc[ai][1][m][1];
                u32x4 w; w.x = cvt_pk_bf16(silu_mul(g0[0], u0[0]), silu_mul(g0[1], u0[1])); w.y = cvt_pk_bf16(silu_mul(g0[2], u0[2]), silu_mul(g0[3], u0[3]));
                w.z = cvt_pk_bf16(silu_mul(g1[0], u1[0]), silu_mul(g1[1], u1[1])); w.w = cvt_pk_bf16(silu_mul(g1[2], u1[2]), silu_mul(g1[3], u1[3]));
                *(u32x4*)rowp = w; }
    }
};
struct EpiSwigluF8 {
    static constexpr bool PERM = true, AFTER_DRAIN = false;
    unsigned char* O; int ldc;
    struct Pre {}; __device__ __forceinline__ void prefetch(Pre&, const Unit&, int, int, int, int, int) const {} __device__ __forceinline__ void commit(const Pre&, int, int, int, int, int) const {}
    __device__ __forceinline__ void operator()(const f32x4 (&acc)[2][2][4][2], const Unit& u, int wr, int wc, int fr, int fq, const Pre&, int) const {
        const int row0 = u.pm * BM + wr * 64 + fr, col0 = u.pn * HALF + wc * 32 + 8 * fq;
        constexpr float CG = 1.4426950408889634f / (F8_ASCALE * F8_GSCALE), CU = F8_HSCALE * 0.6931471805599453f / (F8_ASCALE * F8_GSCALE);
#pragma unroll
        for (int ai = 0; ai < 2; ++ai)
#pragma unroll
            for (int m = 0; m < 4; ++m) { const int row = row0 + ai * HALF + m * 16;
                const f32x4 g0 = acc[ai][0][m][0] * CG, g1 = acc[ai][0][m][1] * CG, u0 = acc[ai][1][m][0] * CU, u1 = acc[ai][1][m][1] * CU;
                float h[8];
#pragma unroll
                for (int i = 0; i < 4; ++i) { h[i] = __builtin_fminf(__builtin_fmaxf(silu2_mul(g0[i], u0[i]), -448.f), 448.f); h[4 + i] = __builtin_fminf(__builtin_fmaxf(silu2_mul(g1[i], u1[i]), -448.f), 448.f); }
                unsigned w0 = 0u, w1 = 0u; w0 = __builtin_amdgcn_cvt_pk_fp8_f32(h[0], h[1], w0, false); w0 = __builtin_amdgcn_cvt_pk_fp8_f32(h[2], h[3], w0, true);
                w1 = __builtin_amdgcn_cvt_pk_fp8_f32(h[4], h[5], w1, false); w1 = __builtin_amdgcn_cvt_pk_fp8_f32(h[6], h[7], w1, true);
                typedef unsigned u32x2 __attribute__((ext_vector_type(2))); *(u32x2*)(O + (size_t)row * ldc + col0) = (u32x2){w0, w1}; }
    }
};
struct EpiNull {
    static constexpr bool PERM = true, AFTER_DRAIN = false;
    unsigned char* O; int ldc;
    struct Pre {}; __device__ __forceinline__ void prefetch(Pre&, const Unit&, int, int, int, int, int) const {} __device__ __forceinline__ void commit(const Pre&, int, int, int, int, int) const {}
    __device__ __forceinline__ void operator()(const f32x4 (&acc)[2][2][4][2], const Unit& u, int wr, int wc, int fr, int fq, const Pre&, int) const {
        f32x4 s = (f32x4){0.f, 0.f, 0.f, 0.f};
#pragma unroll
        for (int ai = 0; ai < 2; ++ai)
#pragma unroll
            for (int bj = 0; bj < 2; ++bj)
#pragma unroll
                for (int m = 0; m < 4; ++m)
#pragma unroll
                    for (int n = 0; n < 2; ++n) s += acc[ai][bj][m][n];
        if (s[0] + s[1] + s[2] + s[3] == 12345.678f) O[(size_t)(u.pm * BM + wr * 64 + fr) * ldc + u.pn * HALF + wc * 32 + 8 * fq] = 1;
    }
};
template <bool IN_F32> struct EpiResid {
    static constexpr bool PERM = true, AFTER_DRAIN = false;
    const void* Xin; bf16_t* X; int ldc;
    struct Pre {}; __device__ __forceinline__ void prefetch(Pre&, const Unit&, int, int, int, int, int) const {} __device__ __forceinline__ void commit(const Pre&, int, int, int, int, int) const {}
    __device__ __forceinline__ void operator()(const f32x4 (&acc)[2][2][4][2], const Unit& u, int wr, int wc, int fr, int fq, const Pre&, int) const {
        const int row0 = u.pm * BM + wr * 64 + fr, col0 = u.pn * BM + wc * 32 + 8 * fq;
#pragma unroll
        for (int ai = 0; ai < 2; ++ai)
#pragma unroll
            for (int m = 0; m < 4; ++m) { const size_t ro = (size_t)(row0 + ai * HALF + m * 16) * ldc + col0;
#pragma unroll
                for (int bj = 0; bj < 2; ++bj) { f32x4 x0, x1;
                    if (IN_F32) { const float* p = (const float*)Xin + ro + bj * HALF; x0 = *(const f32x4*)p; x1 = *(const f32x4*)(p + 4); }
                    else { const u32x4 w = *(const u32x4*)((const bf16_t*)Xin + ro + bj * HALF);
                        x0 = (f32x4){__builtin_bit_cast(float, w.x << 16), __builtin_bit_cast(float, w.x & 0xffff0000u), __builtin_bit_cast(float, w.y << 16), __builtin_bit_cast(float, w.y & 0xffff0000u)};
                        x1 = (f32x4){__builtin_bit_cast(float, w.z << 16), __builtin_bit_cast(float, w.z & 0xffff0000u), __builtin_bit_cast(float, w.w << 16), __builtin_bit_cast(float, w.w & 0xffff0000u)}; }
                    const f32x4 v0 = x0 + acc[ai][bj][m][0], v1 = x1 + acc[ai][bj][m][1];
                    u32x4 o; o.x = cvt_pk_bf16(v0[0], v0[1]); o.y = cvt_pk_bf16(v0[2], v0[3]); o.z = cvt_pk_bf16(v1[0], v1[1]); o.w = cvt_pk_bf16(v1[2], v1[3]);
                    *(u32x4*)(X + ro + bj * HALF) = o; }
                asm volatile("" ::: "memory"); }
    }
};
struct EpiBf8 {
    static constexpr bool PERM = true, AFTER_DRAIN = false;
    bf16_t* O; int ldc; int s_lo, s_hi; float scale; const float* sA; const float* sB; PG8_LAS float* sc;
    struct Pre {};
    __device__ __forceinline__ void prefetch(Pre&, const Unit& u, int wr, int wc, int fr, int fq, int ui) const {
        const int wid = wr * 4 + wc, lane = fq * 16 + fr; PG8_LAS float* d = sc + (ui & 1) * 512;
        if (wid < 2) { const float* src = (wid == 0 ? sA + u.pm * BM : sB + u.pn * BM) + 4 * lane;
            __builtin_amdgcn_global_load_lds((const unsigned*)src, (PG8_LAS unsigned*)(d + 256 * wid), 16, 0, 0); }
    }
    __device__ __forceinline__ void commit(const Pre&, int, int, int, int, int) const {}
    __device__ __forceinline__ void operator()(const i32x4 (&acc)[2][2][4][2], const Unit& u, int wr, int wc, int fr, int fq, const Pre&, int ui) const {
        const int row0 = u.pm * BM + wr * 64 + fr, col0 = u.pn * BM + wc * 32 + 8 * fq; const PG8_LAS float* d = sc + (ui & 1) * 512;
        const float sc0 = (u.pn >= s_lo && u.pn < s_hi) ? scale : 1.f;
        f32x4 cb[2][2];
#pragma unroll
        for (int bj = 0; bj < 2; ++bj)
#pragma unroll
            for (int n = 0; n < 2; ++n) cb[bj][n] = *(const PG8_LAS f32x4*)(d + 256 + wc * 32 + 8 * fq + bj * HALF + 4 * n) * sc0;
#pragma unroll
        for (int ai = 0; ai < 2; ++ai)
#pragma unroll
            for (int m = 0; m < 4; ++m) { const int row = row0 + ai * HALF + m * 16; const float ra = d[wr * 64 + fr + ai * HALF + m * 16]; bf16_t* rowp = O + (size_t)row * ldc + col0;
#pragma unroll
                for (int bj = 0; bj < 2; ++bj) { const f32x4 v0 = __builtin_convertvector(acc[ai][bj][m][0], f32x4) * cb[bj][0] * ra, v1 = __builtin_convertvector(acc[ai][bj][m][1], f32x4) * cb[bj][1] * ra;
                    u32x4 w; w.x = cvt_pk_bf16(v0[0], v0[1]); w.y = cvt_pk_bf16(v0[2], v0[3]); w.z = cvt_pk_bf16(v1[0], v1[1]); w.w = cvt_pk_bf16(v1[2], v1[3]);
                    *(u32x4*)(rowp + bj * HALF) = w; } }
    }
};
template <bool F8OUT> struct EpiSwiglu8 {
    static constexpr bool PERM = true, AFTER_DRAIN = false;
    bf16_t* O; int ldc; const float* sA; const float* sB; int sb_exp; int tb1, tb2, tb3, tb4, tb5, tb6, tb7; PG8_LAS float* sc;
    struct Pre {};
    __device__ __forceinline__ void prefetch(Pre&, const Unit& u, int wr, int wc, int fr, int fq, int ui) const {
        const int wid = wr * 4 + wc, lane = fq * 16 + fr; PG8_LAS float* d = sc + (ui & 1) * 512;
        const int e = (u.pm >= tb1) + (u.pm >= tb2) + (u.pm >= tb3) + (u.pm >= tb4) + (u.pm >= tb5) + (u.pm >= tb6) + (u.pm >= tb7);
        if (wid < 2) { const float* src = (wid == 0 ? sA + u.pm * BM : sB + (size_t)e * sb_exp + u.pn * BM) + 4 * lane;
            __builtin_amdgcn_global_load_lds((const unsigned*)src, (PG8_LAS unsigned*)(d + 256 * wid), 16, 0, 0); }
    }
    __device__ __forceinline__ void commit(const Pre&, int, int, int, int, int) const {}
    __device__ __forceinline__ void operator()(const i32x4 (&acc)[2][2][4][2], const Unit& u, int wr, int wc, int fr, int fq, const Pre&, int ui) const {
        const int row0 = u.pm * BM + wr * 64 + fr, col0 = u.pn * HALF + wc * 32 + 8 * fq; const PG8_LAS float* d = sc + (ui & 1) * 512;
        const PG8_LAS float* sb = d + 256 + wc * 32 + 8 * fq;
        constexpr float CG = 1.4426950408889634f, CU = (F8OUT ? F8_HSCALE : 1.f) * 0.6931471805599453f;
        const f32x4 sg0 = *(const PG8_LAS f32x4*)sb * CG, sg1 = *(const PG8_LAS f32x4*)(sb + 4) * CG, su0 = *(const PG8_LAS f32x4*)(sb + HALF) * CU, su1 = *(const PG8_LAS f32x4*)(sb + HALF + 4) * CU;
#pragma unroll
        for (int ai = 0; ai < 2; ++ai)
#pragma unroll
            for (int m = 0; m < 4; ++m) { const int row = row0 + ai * HALF + m * 16; const float ra = d[wr * 64 + fr + ai * HALF + m * 16];
                const f32x4 g0 = __builtin_convertvector(acc[ai][0][m][0], f32x4) * sg0 * ra, g1 = __builtin_convertvector(acc[ai][0][m][1], f32x4) * sg1 * ra;
                const f32x4 u0 = __builtin_convertvector(acc[ai][1][m][0], f32x4) * su0 * ra, u1 = __builtin_convertvector(acc[ai][1][m][1], f32x4) * su1 * ra;
                if constexpr (F8OUT) { float h[8];
#pragma unroll
                    for (int i = 0; i < 4; ++i) { h[i] = __builtin_fminf(__builtin_fmaxf(silu2_mul(g0[i], u0[i]), -448.f), 448.f); h[4 + i] = __builtin_fminf(__builtin_fmaxf(silu2_mul(g1[i], u1[i]), -448.f), 448.f); }
                    unsigned w0 = 0u, w1 = 0u; w0 = __builtin_amdgcn_cvt_pk_fp8_f32(h[0], h[1], w0, false); w0 = __builtin_amdgcn_cvt_pk_fp8_f32(h[2], h[3], w0, true);
                    w1 = __builtin_amdgcn_cvt_pk_fp8_f32(h[4], h[5], w1, false); w1 = __builtin_amdgcn_cvt_pk_fp8_f32(h[6], h[7], w1, true);
                    typedef unsigned u32x2 __attribute__((ext_vector_type(2))); *(u32x2*)((unsigned char*)O + (size_t)row * ldc + col0) = (u32x2){w0, w1}; }
                else { bf16_t* rowp = O + (size_t)row * ldc + col0;
                u32x4 w; w.x = cvt_pk_bf16(silu2_mul(g0[0], u0[0]), silu2_mul(g0[1], u0[1])); w.y = cvt_pk_bf16(silu2_mul(g0[2], u0[2]), silu2_mul(g0[3], u0[3]));
                w.z = cvt_pk_bf16(silu2_mul(g1[0], u1[0]), silu2_mul(g1[1], u1[1])); w.w = cvt_pk_bf16(silu2_mul(g1[2], u1[2]), silu2_mul(g1[3], u1[3]));
                *(u32x4*)rowp = w; } }
    }
};
struct GOrder {
    StaticOrder so; const char* A; const char* B; size_t a_tile, b_tile, b_exp; int tb1, tb2, tb3, tb4, tb5, tb6, tb7;
    __device__ __forceinline__ bool next(int i, Unit& u) const { return so.next(i, u); }
    __device__ __forceinline__ const char* a_base(const Unit& u) const { return A + (size_t)u.pm * a_tile; }
    __device__ __forceinline__ const char* b_base(const Unit& u) const {
        const int e = (u.pm >= tb1) + (u.pm >= tb2) + (u.pm >= tb3) + (u.pm >= tb4) + (u.pm >= tb5) + (u.pm >= tb6) + (u.pm >= tb7);
        return B + (size_t)e * b_exp + (size_t)u.pn * b_tile; }
    __device__ __forceinline__ int nt(const Unit&, int full) const { return full; }
    __device__ __forceinline__ void a_ready(const Unit&) const {}
    __device__ __forceinline__ void done(const Unit&) const {}
};
struct GOrderTail {
    static constexpr int MAIN_M = 128, NTF = 28;
    StaticOrder so; const char* A; const char* B; size_t a_tile, b_tile, b_exp; int tb1, tb2, tb3, tb4, tb5, tb6, tb7; int n_main, n_piece;
    __device__ __forceinline__ void init(int n_mtiles, int N, int G, int c) { so.init(MAIN_M * BM, N, G, c); n_main = c < so.nwg ? (so.nwg - c + G - 1) / G : 0; n_piece = (n_mtiles - MAIN_M) * 4 * 8; }
    __device__ __forceinline__ bool next(int i, Unit& u) const {
        const bool mainu = i < n_main; const int q = (i - n_main) * so.G + so.c, ut = q >> 3;
        Unit m; m.pm = 0; m.pn = 0; m.tq = -1; so.next(mainu ? i : 0, m);
        u.pm = mainu ? m.pm : MAIN_M + (ut >> 2); u.pn = mainu ? m.pn : (ut & 3); u.tq = mainu ? -1 : q;
        return mainu || q < n_piece; }
    __device__ __forceinline__ int nt(const Unit& u, int full) const { return u.tq < 0 ? full : ((u.tq & 7) < 6 ? 4 : 2); }
    __device__ __forceinline__ const char* a_base(const Unit& u) const { const int kp = u.tq & 7, k0 = u.tq < 0 ? 0 : (kp < 6 ? 4 * kp : 2 * kp + 12); return A + (size_t)u.pm * a_tile + (size_t)k0 * (BK * 2); }
    __device__ __forceinline__ const char* b_base(const Unit& u) const {
        const int e = (u.pm >= tb1) + (u.pm >= tb2) + (u.pm >= tb3) + (u.pm >= tb4) + (u.pm >= tb5) + (u.pm >= tb6) + (u.pm >= tb7);
        const int kp = u.tq & 7, k0 = u.tq < 0 ? 0 : (kp < 6 ? 4 * kp : 2 * kp + 12);
        return B + (size_t)e * b_exp + (size_t)u.pn * b_tile + (size_t)k0 * (BK * 2); }
    __device__ __forceinline__ void a_ready(const Unit&) const {}
    __device__ __forceinline__ void done(const Unit&) const {}
};
struct EpiBfPart {
    static constexpr bool PERM = true, AFTER_DRAIN = false; static constexpr int YP_TILE0 = 136;
    bf16_t* O; int ldc; float scale;
    struct Pre {}; __device__ __forceinline__ void prefetch(Pre&, const Unit&, int, int, int, int, int) const {} __device__ __forceinline__ void commit(const Pre&, int, int, int, int, int) const {}
    __device__ __forceinline__ void operator()(const f32x4 (&acc)[2][2][4][2], const Unit& u, int wr, int wc, int fr_, int fq_, const Pre&, int) const {
        int fr = fr_, fq = fq_; asm volatile("" : "+v"(fr), "+v"(fq));
        const int vt = u.tq < 0 ? u.pm : YP_TILE0 + (u.tq & 7) * 8 + (u.pm - GOrderTail::MAIN_M);
        const int row0 = vt * BM + wr * 64 + fr, col0 = u.pn * BM + wc * 32 + 8 * fq;
#pragma unroll
        for (int ai = 0; ai < 2; ++ai)
#pragma unroll
            for (int m = 0; m < 4; ++m) { bf16_t* rowp = O + (size_t)(row0 + ai * HALF + m * 16) * ldc + col0;
#pragma unroll
                for (int bj = 0; bj < 2; ++bj) { const f32x4 v0 = acc[ai][bj][m][0] * scale, v1 = acc[ai][bj][m][1] * scale;
                    u32x4 w; w.x = cvt_pk_bf16(v0[0], v0[1]); w.y = cvt_pk_bf16(v0[2], v0[3]); w.z = cvt_pk_bf16(v1[0], v1[1]); w.w = cvt_pk_bf16(v1[2], v1[3]);
                    *(u32x4*)(rowp + bj * HALF) = w; } }
    }
};
template <class Epi, class Sched, bool ALIGN_EPI = false, bool SP2 = false, int MODE = 0  , int XEXP = 0  >
__device__ __forceinline__ void gemm_phase(PG8_LAS unsigned char* lds, const Gemm g, const Sched& S, const Epi& E) {
    const int tid = threadIdx.x, wid = __builtin_amdgcn_readfirstlane(tid >> 6), lane = tid & 63, wr = wid >> 2, wc = wid & 3, fr = lane & 15, fq = lane >> 4;
    const int K = g.K, nt = K / BK;
    unsigned voffA[2], voffB[2];
#pragma unroll
    for (int i = 0; i < 2; ++i) { int R, C; stage_rc(tid * 16 + i * 8192, R, C); const int Rb = Epi::PERM ? ((R & ~31) + perm32(R & 31)) : R;
        voffA[i] = (unsigned)(R * K + C) * 2u; voffB[i] = (unsigned)(Rb * K + C) * 2u; }
    const size_t kstep = (size_t)(BK * 2);
    const size_t hstep = (size_t)HALF * K * 2;
        const unsigned ldsw = (unsigned)wid * 1024u;
    const int aoff = lds_byte(wr * 64 + fr, fq * 8), boff = lds_byte(wc * 32 + fr, fq * 8);
#define PG8_SA(b, h) (((b) * 2 + (h)) * HTB)
#define PG8_SB(b, h) ((4 + (b) * 2 + (h)) * HTB)
#define PG8_STAGE(bufoff, gbase, voff) do { if constexpr (XEXP != 2) _Pragma("unroll") for (int _i = 0; _i < 2; ++_i) \
        __builtin_amdgcn_global_load_lds((const unsigned*)((const char*)(gbase) + (voff)[_i]), (PG8_LAS unsigned*)(lds + (bufoff) + ldsw + _i * 8192), 16, 0, 0); } while (0)
#define PG8_LDA(dst, b, h) do { if constexpr (XEXP < 3) _Pragma("unroll") for (int m = 0; m < 4; ++m) dst[m] = ldfrag<MODE>(lds + PG8_SA(b, h) + aoff + m * 2048); } while (0)
#define PG8_LDB(dst, b, h) do { if constexpr (XEXP < 3) _Pragma("unroll") for (int n = 0; n < 2; ++n) dst[n] = ldfrag<MODE>(lds + PG8_SB(b, h) + boff + n * 2048); } while (0)
#define PG8_MMA(ai, bj, At, Bt) do { __builtin_amdgcn_s_setprio(1); _Pragma("unroll") for (int m = 0; m < 4; ++m) _Pragma("unroll") for (int n = 0; n < 2; ++n) \
        mma_step<MODE>(acc[ai][bj][m][n], Bt[n], At[m]); __builtin_amdgcn_s_setprio(0); } while (0)
#define PG8_WAIT_V(n) do { if constexpr (XEXP != 1) asm volatile("s_waitcnt vmcnt(" #n ")" ::: "memory"); } while (0)
#define PG8_WAIT_L(n) asm volatile("s_waitcnt lgkmcnt(" #n ")" ::: "memory")
#define PG8_BAR do { if constexpr (XEXP < 4) __builtin_amdgcn_s_barrier(); } while (0)
#define PG8_SCHED __builtin_amdgcn_sched_barrier(0)
    Unit cur, nxt; int ui = 0; typename Epi::Pre pre;
    if (!S.next(0, cur)) return;
    typename AccT<MODE == 1>::type acc[2][2][4][2];
#pragma unroll
    for (int a = 0; a < 2; ++a)
#pragma unroll
        for (int b = 0; b < 2; ++b)
#pragma unroll
            for (int m = 0; m < 4; ++m)
#pragma unroll
                for (int n = 0; n < 2; ++n) acc[a][b][m][n] = typename AccT<MODE == 1>::type{};
    typename Frag<MODE>::type At[4], B0[2], B1[2];
    const char* cA = S.a_base(cur); const char* cB = S.b_base(cur);
    S.a_ready(cur);
    if constexpr (SP2) {
        PG8_STAGE(PG8_SB(0, 0), cB, voffB); PG8_STAGE(PG8_SB(0, 1), cB + hstep, voffB); PG8_STAGE(PG8_SA(0, 0), cA, voffA); PG8_STAGE(PG8_SA(0, 1), cA + hstep, voffA);
        if (wr == 1) PG8_BAR;
        PG8_WAIT_V(2); PG8_BAR;
        PG8_STAGE(PG8_SB(1, 0), cB + kstep, voffB); PG8_STAGE(PG8_SA(1, 0), cA + kstep, voffA); PG8_STAGE(PG8_SB(1, 1), cB + hstep + kstep, voffB);
        PG8_WAIT_V(6); PG8_BAR;
    } else {
        PG8_STAGE(PG8_SB(0, 0), cB, voffB); PG8_STAGE(PG8_SA(0, 0), cA, voffA); PG8_STAGE(PG8_SB(0, 1), cB + hstep, voffB); PG8_STAGE(PG8_SA(0, 1), cA + hstep, voffA);
        if (wr == 1) PG8_BAR;
        PG8_WAIT_V(4); PG8_BAR;
        PG8_STAGE(PG8_SB(1, 0), cB + kstep, voffB); PG8_STAGE(PG8_SA(1, 0), cA + kstep, voffA); PG8_STAGE(PG8_SB(1, 1), cB + hstep + kstep, voffB);
        PG8_WAIT_V(6); PG8_BAR;
    }
    for (;;) {
        const bool has_next = S.next(ui + 1, nxt);
        const char* nA = has_next ? S.a_base(nxt) : cA; const char* nB = has_next ? S.b_base(nxt) : cB;
        const int ntc = S.nt(cur, nt);
        for (int t = 0; t < ntc; t += 2) {
            const bool last = (t == ntc - 2);
            const char* a1 = cA + (size_t)(t + 1) * kstep;
            const char* a2 = last ? nA : cA + (size_t)(t + 2) * kstep; const char* b2 = last ? nB : cB + (size_t)(t + 2) * kstep;
            const char* a3 = a2 + kstep; const char* b3 = b2 + kstep;
            if (last && has_next) S.a_ready(nxt);
            if (last) E.prefetch(pre, cur, wr, wc, fr, fq, ui);
            if constexpr (SP2) {
            PG8_LDB(B0, 0, 0); PG8_LDB(B1, 0, 1); PG8_SCHED; PG8_LDA(At, 0, 0); PG8_STAGE(PG8_SA(1, 1), a1 + hstep, voffA);
            PG8_WAIT_V(8); PG8_WAIT_L(0); PG8_BAR; PG8_MMA(0, 0, At, B0); PG8_MMA(0, 1, At, B1); PG8_BAR; PG8_SCHED;
            PG8_LDA(At, 0, 1); PG8_STAGE(PG8_SB(0, 0), b2, voffB); PG8_STAGE(PG8_SB(0, 1), b2 + hstep, voffB); PG8_STAGE(PG8_SA(0, 0), a2, voffA);
            PG8_WAIT_V(8); PG8_WAIT_L(0); PG8_BAR; PG8_MMA(1, 0, At, B0); PG8_MMA(1, 1, At, B1); PG8_BAR; PG8_SCHED;
            PG8_LDB(B0, 1, 0); PG8_LDB(B1, 1, 1); PG8_SCHED; PG8_LDA(At, 1, 0); PG8_STAGE(PG8_SA(0, 1), a2 + hstep, voffA);
            PG8_WAIT_V(8); PG8_WAIT_L(0); PG8_BAR; PG8_MMA(0, 0, At, B0); PG8_MMA(0, 1, At, B1); PG8_BAR; PG8_SCHED;
            PG8_LDA(At, 1, 1); PG8_STAGE(PG8_SB(1, 0), b3, voffB); PG8_STAGE(PG8_SB(1, 1), b3 + hstep, voffB); PG8_STAGE(PG8_SA(1, 0), a3, voffA);
            PG8_WAIT_V(8); PG8_WAIT_L(0); PG8_BAR; PG8_MMA(1, 0, At, B0); PG8_MMA(1, 1, At, B1); PG8_BAR; PG8_SCHED;
            } else {
            PG8_LDB(B0, 0, 0); PG8_SCHED; PG8_LDA(At, 0, 0); PG8_STAGE(PG8_SA(1, 1), a1 + hstep, voffA);
            PG8_WAIT_L(8); PG8_BAR; PG8_WAIT_L(0); PG8_MMA(0, 0, At, B0); PG8_BAR; PG8_SCHED;
            PG8_LDB(B1, 0, 1); PG8_STAGE(PG8_SB(0, 0), b2, voffB);
            PG8_BAR; PG8_WAIT_L(0); PG8_MMA(0, 1, At, B1); PG8_BAR;
            PG8_LDA(At, 0, 1); PG8_STAGE(PG8_SA(0, 0), a2, voffA);
            PG8_BAR; PG8_WAIT_L(0); PG8_MMA(1, 0, At, B0); PG8_BAR; PG8_SCHED;
            PG8_STAGE(PG8_SB(0, 1), b2 + hstep, voffB);
            PG8_WAIT_V(6); PG8_BAR; PG8_MMA(1, 1, At, B1); PG8_BAR;
            PG8_LDB(B0, 1, 0); PG8_SCHED; PG8_LDA(At, 1, 0); PG8_STAGE(PG8_SA(0, 1), a2 + hstep, voffA);
            PG8_WAIT_L(8); PG8_BAR; PG8_WAIT_L(0); PG8_MMA(0, 0, At, B0); PG8_BAR; PG8_SCHED;
            PG8_LDB(B1, 1, 1); PG8_STAGE(PG8_SB(1, 0), b3, voffB);
            PG8_BAR; PG8_WAIT_L(0); PG8_MMA(0, 1, At, B1); PG8_BAR;
            PG8_LDA(At, 1, 1); PG8_STAGE(PG8_SA(1, 0), a3, voffA);
            PG8_BAR; PG8_WAIT_L(0); PG8_MMA(1, 0, At, B0); PG8_BAR; PG8_SCHED;
            PG8_STAGE(PG8_SB(1, 1), b3 + hstep, voffB);
            PG8_WAIT_V(6); PG8_BAR; PG8_MMA(1, 1, At, B1); PG8_BAR;
            }
        }
        E.commit(pre, wr, wc, fr, fq, ui);
        if constexpr (ALIGN_EPI) { if (wr == 0) PG8_BAR; }
        if constexpr (MODE == 2) asm volatile("s_nop 15\n\ts_nop 7" ::: "memory");
        if constexpr (!Epi::AFTER_DRAIN) { E(acc, cur, wr, wc, fr, fq, pre, ui); S.done(cur); }
        if (!has_next) break;
#pragma unroll
        for (int a = 0; a < 2; ++a)
#pragma unroll
            for (int b = 0; b < 2; ++b)
#pragma unroll
                for (int m = 0; m < 4; ++m)
#pragma unroll
                    for (int n = 0; n < 2; ++n) acc[a][b][m][n] = typename AccT<MODE == 1>::type{};
        cur = nxt; cA = nA; cB = nB; ++ui;
        if constexpr (ALIGN_EPI) { if (wr == 1) PG8_BAR; }
    }
    PG8_WAIT_V(0);
    if constexpr (!ALIGN_EPI) { if (wr == 0) PG8_BAR; }
    PG8_BAR;
    if constexpr (Epi::AFTER_DRAIN) { E.fused(acc, cur, wr, wc, fr, fq, lds, wid, lane); S.done(cur); }
#undef PG8_SA
#undef PG8_SB
#undef PG8_STAGE
#undef PG8_LDA
#undef PG8_LDB
#undef PG8_MMA
#undef PG8_WAIT_V
#undef PG8_WAIT_L
#undef PG8_BAR
#undef PG8_SCHED
}
}
#include <hip/hip_bf16.h>
#include <cmath>
namespace attn_body {
using bf16=__hip_bfloat16;
using bf16x8=__attribute__((ext_vector_type(8)))short;
using s16x4=__attribute__((ext_vector_type(4)))short;
using f32x16=__attribute__((ext_vector_type(16)))float;
using u32x4=__attribute__((ext_vector_type(4)))unsigned;
constexpr int BATCH=2,NHEAD=8,SEQ=8192,D=64,DM=3584,OPITCH=1024;
constexpr int NW=8,QBLK=32,QB=QBLK*NW,KVBLK=64,NQB=SEQ/QB;
constexpr int ATTN_PITCH=DM, ATTN_UNIT_ROWS=QB;
__device__ __forceinline__ int crow(int r,int hi){return (r&3)+8*(r>>2)+4*hi;}
#define SBAR() __builtin_amdgcn_sched_barrier(0)
__device__ __forceinline__ void cmask(f32x16&p0,f32x16&p1,int jb,int qrel,int hi){
  const float NEG=-INFINITY; int kb=64*jb+4*hi;
  #pragma unroll
  for(int r=0;r<16;++r){int kv=kb+(r&3)+8*(r>>2); if(kv>qrel)p0[r]=NEG; if(kv+32>qrel)p1[r]=NEG;}
}

constexpr int NSLOT=3, SLOTB=8192, SPLIT_NT=72, PART_F=256*64+512;
constexpr int LDS_K=0, LDS_V=NSLOT*SLOTB, LDS_WS=2*NSLOT*SLOTB, LDS_OST=LDS_WS+NW*64*4, LDS_CK=LDS_OST+NW*4096, LDS_BYTES=LDS_CK+SEQ*4;
constexpr float C2=0.125f*1.4426950408889634f;
__device__ __forceinline__ void glds16(const void*gsrc,unsigned lds_dst){unsigned keep;
  asm volatile("s_mov_b32 %0, m0\n\ts_mov_b32 m0, %2\n\ts_nop 0\n\tglobal_load_lds_dwordx4 %1, off\n\ts_mov_b32 m0, %0":"=&s"(keep):"v"(gsrc),"s"(lds_dst):"memory");}
__device__ __forceinline__ float max3f(float a,float b,float c){float r;asm("v_max3_f32 %0, %1, %2, %3":"=v"(r):"v"(a),"v"(b),"v"(c));return r;}
__device__ __forceinline__ float max2f(float a,float b){float r;asm("v_max_f32_e32 %0, %1, %2":"=v"(r):"v"(a),"v"(b));return r;}
__device__ __forceinline__ float fadd_s(float a,float b){float r;asm("v_add_f32_e32 %0, %1, %2":"=v"(r):"v"(a),"v"(b));return r;}
__device__ __forceinline__ float fsub_s(float a,float b){float r;asm("v_sub_f32_e32 %0, %1, %2":"=v"(r):"v"(a),"v"(b));return r;}
typedef float f32x2_t __attribute__((ext_vector_type(2))); typedef float f32x4_t __attribute__((ext_vector_type(4))); typedef __bf16 bf16x2_t __attribute__((ext_vector_type(2)));
__device__ __forceinline__ unsigned cvtpk_s(float lo,float hi){f32x2_t v={lo,hi};bf16x2_t b=__builtin_convertvector(v,bf16x2_t);return __builtin_bit_cast(unsigned,b);}
#define WAIT_BAR(N) asm volatile("s_waitcnt vmcnt(" #N ") lgkmcnt(0)\n\ts_barrier":::"memory")

__device__ __forceinline__ void qkt(f32x16&p0,f32x16&p1,const char*Kslot,const bf16x8*qr,const f32x16&negm,int r32,int hi){
  const char*kb=Kslot+hi*1024+r32*16;
  #pragma unroll
  for(int d0=0;d0<4;++d0){
    const bf16x8 b0=*reinterpret_cast<const bf16x8*>(kb+d0*2048);
    const bf16x8 b1=*reinterpret_cast<const bf16x8*>(kb+d0*2048+512);
    if(d0==0){p0=__builtin_amdgcn_mfma_f32_32x32x16_bf16(b0,qr[0],negm,0,0,0);p1=__builtin_amdgcn_mfma_f32_32x32x16_bf16(b1,qr[0],negm,0,0,0);}
    else{p0=__builtin_amdgcn_mfma_f32_32x32x16_bf16(b0,qr[d0],p0,0,0,0);p1=__builtin_amdgcn_mfma_f32_32x32x16_bf16(b1,qr[d0],p1,0,0,0);}}
}
typedef __attribute__((address_space(3))) const char* lds_cptr;
typedef short v4i16_t __attribute__((ext_vector_type(4)));
__device__ __forceinline__ void kload8(bf16x8*kf,lds_cptr kp){
  kf[0]=*(const __attribute__((address_space(3))) bf16x8*)(kp);      kf[1]=*(const __attribute__((address_space(3))) bf16x8*)(kp+512);
  kf[2]=*(const __attribute__((address_space(3))) bf16x8*)(kp+2048); kf[3]=*(const __attribute__((address_space(3))) bf16x8*)(kp+2560);
  kf[4]=*(const __attribute__((address_space(3))) bf16x8*)(kp+4096); kf[5]=*(const __attribute__((address_space(3))) bf16x8*)(kp+4608);
  kf[6]=*(const __attribute__((address_space(3))) bf16x8*)(kp+6144); kf[7]=*(const __attribute__((address_space(3))) bf16x8*)(kp+6656);
}
__device__ __forceinline__ void kload2(bf16x8*kf,lds_cptr kp,int j){ kf[2*j]=*(const __attribute__((address_space(3))) bf16x8*)(kp+j*2048); kf[2*j+1]=*(const __attribute__((address_space(3))) bf16x8*)(kp+j*2048+512); }
__device__ __forceinline__ s16x4 vtr(lds_cptr p){ return __builtin_bit_cast(s16x4,__builtin_amdgcn_ds_read_tr16_b64_v4i16((__attribute__((address_space(3))) v4i16_t*)p)); }
__device__ __forceinline__ float rowmax(const f32x16&p0,const f32x16&p1){
  float a=max3f(p0[0],p0[1],p1[0]),b=max3f(p0[2],p0[3],p1[1]);a=max3f(a,p1[2],p1[3]);
  #pragma unroll
  for(int r=4;r<16;r+=4){a=max3f(a,p0[r],p0[r+1]);b=max3f(b,p0[r+2],p0[r+3]);a=max3f(a,p1[r],p1[r+1]);b=max3f(b,p1[r+2],p1[r+3]);}
  const float m=max2f(a,b);
  auto rr=__builtin_amdgcn_permlane32_swap(__float_as_uint(m),__float_as_uint(m),false,false);
  return max2f(__uint_as_float(rr[0]),__uint_as_float(rr[1]));
}
__device__ __forceinline__ void pv(f32x16*o,int vb,bf16x8 pa0,bf16x8 pa1,bf16x8 pa2,bf16x8 pa3){
  #pragma unroll
  for(int d0=0;d0<2;++d0){s16x4 lo[4],hi[4];
    #pragma unroll
    for(int ks=0;ks<4;++ks){
      asm volatile("ds_read_b64_tr_b16 %0,%1 offset:%c2":"=&v"(lo[ks]):"v"(vb),"i"(d0*4096+ks*1024):"memory");
      asm volatile("ds_read_b64_tr_b16 %0,%1 offset:%c2":"=&v"(hi[ks]):"v"(vb),"i"(d0*4096+ks*1024+512):"memory");}
    asm volatile("s_waitcnt lgkmcnt(0)":::"memory");SBAR();
    #define PK(k) (bf16x8){lo[k][0],lo[k][1],lo[k][2],lo[k][3],hi[k][0],hi[k][1],hi[k][2],hi[k][3]}
    o[d0]=__builtin_amdgcn_mfma_f32_32x32x16_bf16(pa0,PK(0),o[d0],0,0,0);
    o[d0]=__builtin_amdgcn_mfma_f32_32x32x16_bf16(pa1,PK(1),o[d0],0,0,0);
    o[d0]=__builtin_amdgcn_mfma_f32_32x32x16_bf16(pa2,PK(2),o[d0],0,0,0);
    o[d0]=__builtin_amdgcn_mfma_f32_32x32x16_bf16(pa3,PK(3),o[d0],0,0,0);
    #undef PK
  }
}

#ifndef ATTN_STORE16
#define ATTN_STORE16(p,v) (*(u32x4*)(p)=(v))
#endif
template<int THRL> __device__ __forceinline__ void attn_unit(int b,int h,int qb,const bf16*Q,const bf16*__restrict__ K,const bf16*__restrict__ V,bf16*O,const float*__restrict__ cf,const float Tskip,const int part,float*PART,unsigned*flag,char*shm){
  int tid_=threadIdx.x; asm volatile("":"+v"(tid_));
  const int tid=tid_,lane=tid&63,r32=lane&31,hi=lane>>5; const int wid=__builtin_amdgcn_readfirstlane(tid>>6);
  const long rowbase=(long)b*SEQ; const int q0=qb*QB;
  const bf16*Qw=Q+(rowbase+q0+wid*QBLK)*DM+h*D;
  const unsigned lds0=(unsigned)(uintptr_t)shm;
  float*wsf=(float*)(shm+LDS_WS)+wid*64;
  const unsigned kdst=lds0+LDS_K+wid*1024, vdst=lds0+LDS_V+wid*1024;
  #define DMA_K(t,slot) glds16(ksrc+(long)(t)*KVBLK*DM,(unsigned)__builtin_amdgcn_readfirstlane(kdst+(slot)))
  #define DMA_V(t,slot) glds16(vsrc+(long)(t)*KVBLK*DM,(unsigned)__builtin_amdgcn_readfirstlane(vdst+(slot)))
  const int vb0=(int)(lds0+LDS_V)+((lane>>4)&1)*32+(lane&3)*8+(4*hi+((lane&15)>>2))*64;
  const char*Kbase=shm+LDS_K; bf16x8 kf[8];
  const lds_cptr shm3=(lds_cptr)shm; const lds_cptr kp0=shm3+LDS_K+hi*1024+r32*16; const lds_cptr vp0=shm3+LDS_V+((lane>>4)&1)*32+(lane&3)*8+(4*hi+((lane&15)>>2))*64;
  typedef __attribute__((address_space(3))) float lds_f32; typedef __attribute__((address_space(3))) const f32x4_t* lds_cf4;
  const int NT0=(q0+QB)/KVBLK;
  int tb;
  { const float thr=cf[q0]+Tskip; const int t1=lane,t2=lane+64;
    const bool n1=(t1<NT0)&&(cf[64*t1+63]>thr), n2=(t2<NT0)&&(cf[64*t2+63]>thr);
    const int t0=(int)__popcll(__ballot(n1))+(int)__popcll(__ballot(n2));
    tb=t0&~1; if(tb>NT0-4)tb=NT0-4; tb=__builtin_amdgcn_readfirstlane(tb); }
  int NT=NT0-tb; bool band=true; const bool split=(PART!=nullptr)&&(NT>SPLIT_NT);
  if(PART!=nullptr){ if(!split){ if(part==1)return; } else { const int mid=(NT>>1)&~1; if(part==0){NT=mid;band=false;} else {tb+=mid;NT-=mid;} } }
  { lds_f32* ckw=(lds_f32*)((lds_cptr)shm+LDS_CK); int i0_=tb*KVBLK+tid; asm volatile("":"+v"(i0_)); _Pragma("nounroll") for(int i=i0_;i<q0+QB;i+=NW*64)ckw[i]=cf[i]; }
  const float cq=cf[q0+wid*QBLK+(lane&31)];
  asm volatile("s_waitcnt vmcnt(0) lgkmcnt(0)\n\ts_barrier":::"memory");
  const bf16*Kh=K+(rowbase+(long)tb*KVBLK)*DM+h*D,*Vh=V+(rowbase+(long)tb*KVBLK)*DM+h*D;
  const bf16*ksrc=Kh+(long)lane*DM+wid*8;
  const bf16*vsrc=Vh+(long)(16*(wid&3)+(lane>>2))*DM+(wid>>2)*32+(lane&3)*8;
  const lds_cptr ckl=(lds_cptr)shm+LDS_CK+256*tb+16*(lane>>5);
  #define CBIAS(P0,P1,t) do{ const lds_cptr cb_=ckl+256*(t); _Pragma("unroll") for(int g_=0;g_<4;++g_){ const f32x4_t a_=*(lds_cf4)(cb_+32*g_), b_=*(lds_cf4)(cb_+128+32*g_); \
      _Pragma("unroll") for(int i_=0;i_<4;++i_){ P0[4*g_+i_]-=(a_[i_]+mm); P1[4*g_+i_]-=(b_[i_]+mm); } } }while(0)
  f32x4_t cbA[4],cbB[4]; float clast;
  #define CBLD(t) do{ const lds_cptr cb_=ckl+256*(t); _Pragma("unroll") for(int g_=0;g_<4;++g_){ cbA[g_]=*(lds_cf4)(cb_+32*g_); cbB[g_]=*(lds_cf4)(cb_+128+32*g_); } \
      clast=*(const __attribute__((address_space(3))) float*)((lds_cptr)shm+LDS_CK+256*tb+256*(t)+252); }while(0)
  DMA_K(0,0);DMA_V(0,0);DMA_K(1,SLOTB);
  bf16x8 qr[4];
  #pragma unroll
  for(int d0=0;d0<4;++d0)qr[d0]=*reinterpret_cast<const bf16x8*>(&Qw[(long)r32*DM+d0*16+hi*8]);
  float mhat=0.f,l_reg=0.f;f32x16 o[2];o[0]=f32x16{};o[1]=f32x16{};float mm=-cq; const f32x16 negm=f32x16{};
  const int qrel=wid*QBLK+r32;
  #define CMASK(P0,P1,t) do{int jb_=(t)-(NT-4); if(band&&jb_>=0)cmask(P0,P1,jb_,qrel,hi);}while(0)
  bool resc=false;
  #define START(P0,P1) do{ const float rm=rowmax(P0,P1); resc=false; \
    { const float dl=rm; mhat=fadd_s(mhat,dl); \
      _Pragma("unroll") for(int r=0;r<16;++r){P0[r]=fsub_s(P0[r],dl);P1[r]=fsub_s(P1[r],dl);} \
      mm+=dl; } \
    _Pragma("unroll") for(int r=0;r<16;++r)P0[r]=__builtin_amdgcn_exp2f(P0[r]); }while(0)
  #define RESC() do{ if(resc){ asm volatile("s_waitcnt lgkmcnt(0)":::"memory"); \
      _Pragma("unroll") for(int d_=0;d_<2;++d_) _Pragma("unroll") for(int r=0;r<16;++r)o[d_][r]*=wsf[crow(r,hi)]; } }while(0)
  f32x16 pA0,pA1,pB0,pB1;
  int sl_prev=0,sl_cur=0,sl_next=SLOTB;
  #define ROT() do{sl_prev=sl_cur;sl_cur=sl_next;sl_next=(sl_next==(NSLOT-1)*SLOTB)?0:sl_next+SLOTB;}while(0)
  DMA_K(2,2*SLOTB);
  WAIT_BAR(3);
  qkt(pA0,pA1,Kbase,qr,negm,r32,hi);asm volatile("s_nop 15\n\ts_nop 7":"+v"(pA0),"+v"(pA1));CBIAS(pA0,pA1,0);CMASK(pA0,pA1,0);
  START(pA0,pA1);
  _Pragma("unroll") for(int r=0;r<16;++r)pA1[r]=__builtin_amdgcn_exp2f(pA1[r]);
  WAIT_BAR(0);
  DMA_K(3,0);DMA_V(1,SLOTB);
  ROT();
  kload8(kf,kp0+sl_cur);
  WAIT_BAR(2);
  s16x4 vlo[8],vhi[8]; u32x4 pw0,pw1,pw2,pw3;
  #define PKW(P,B) cvtpk_s(P[B],P[B+1])
  #define PAF(k) __builtin_bit_cast(bf16x8,pw##k)
  #define VFR(i) (bf16x8){vlo[i][0],vlo[i][1],vlo[i][2],vlo[i][3],vhi[i][0],vhi[i][1],vhi[i][2],vhi[i][3]}
  #define PIN(x) asm volatile("":"+v"(x))
  #define MX3(a,b,c) __builtin_fmaxf(__builtin_fmaxf((a),(b)),(c))
  #define GAPA(MF,A0,A1,A2,A3,W0,W1,PW) do{ MF; sacc+=A0; sacc+=A1; sacc+=A2; sacc+=A3; PIN(sacc); W0; W1; PIN(PW); SBAR(); }while(0)
  #define EX(v) __builtin_amdgcn_exp2f(v)
  #define GAPB(MF,X,B,CB) do{ MF; { const f32x4_t t_=(CB)+mm; X[B]=EX(X[B]-t_[0]); X[B+1]=EX(X[B+1]-t_[1]); X[B+2]=EX(X[B+2]-t_[2]); X[B+3]=EX(X[B+3]-t_[3]); } PIN(X); SBAR(); }while(0)
  #define VRD(i) do{ vlo[i]=vtr(vp_+(((i)>>2)*4096+((i)&3)*1024)); vhi[i]=vtr(vp_+(((i)>>2)*4096+((i)&3)*1024+512)); }while(0)
  #define KRD(G,j) do{ if(G){ kload2(kf,kp0+sl_next,j); SBAR(); } }while(0)
  #define STEP(C0,C1,P0,P1,t,GK,GV,GL) do{ SBAR(); \
    const lds_cptr vp_=vp0+sl_prev; \
    VRD(0); SBAR(); float sacc=(P0[0]+P0[1]); \
    GAPA(C0=__builtin_amdgcn_mfma_f32_32x32x16_bf16(kf[0],qr[0],negm,0,0,0), P0[2],P0[3],P0[4],P0[5],     pw0[0]=PKW(P0,0), pw0[1]=PKW(P0,2), pw0); \
    VRD(4); SBAR(); GAPA(C1=__builtin_amdgcn_mfma_f32_32x32x16_bf16(kf[1],qr[0],negm,0,0,0), P0[6],P0[7],P0[8],P0[9],     pw0[2]=PKW(P0,4), pw0[3]=PKW(P0,6), pw0); \
    VRD(1); SBAR(); GAPA(C0=__builtin_amdgcn_mfma_f32_32x32x16_bf16(kf[2],qr[1],C0,0,0,0),   P0[10],P0[11],P0[12],P0[13], pw1[0]=PKW(P0,8), pw1[1]=PKW(P0,10), pw1); \
    VRD(5); SBAR(); GAPA(C1=__builtin_amdgcn_mfma_f32_32x32x16_bf16(kf[3],qr[1],C1,0,0,0),   P0[14],P0[15],P1[0],P1[1],   pw1[2]=PKW(P0,12),pw1[3]=PKW(P0,14), pw1); \
    VRD(2); SBAR(); GAPA(C0=__builtin_amdgcn_mfma_f32_32x32x16_bf16(kf[4],qr[2],C0,0,0,0),   P1[2],P1[3],P1[4],P1[5],     pw2[0]=PKW(P1,0), pw2[1]=PKW(P1,2), pw2); \
    VRD(6); SBAR(); GAPA(C1=__builtin_amdgcn_mfma_f32_32x32x16_bf16(kf[5],qr[2],C1,0,0,0),   P1[6],P1[7],P1[8],P1[9],     pw2[2]=PKW(P1,4), pw2[3]=PKW(P1,6), pw2); \
    VRD(3); SBAR(); GAPA(C0=__builtin_amdgcn_mfma_f32_32x32x16_bf16(kf[6],qr[3],C0,0,0,0),   P1[10],P1[11],P1[12],P1[13], pw3[0]=PKW(P1,8), pw3[1]=PKW(P1,10), pw3); \
    VRD(7); SBAR(); GAPA(C1=__builtin_amdgcn_mfma_f32_32x32x16_bf16(kf[7],qr[3],C1,0,0,0),   P1[14],P1[15],0.f,0.f,       pw3[2]=PKW(P1,12),pw3[3]=PKW(P1,14), pw3); \
    l_reg+=sacc; \
    if(GK){DMA_K((t)+3,sl_cur);} if(GV){DMA_V((t)+1,sl_next);} \
    CBLD(t); CMASK(C0,C1,t); \
    { float a=MX3(C0[0],C0[1],C1[0]),b=MX3(C0[2],C0[3],C1[1]); a=MX3(a,C1[2],C1[3]); \
      _Pragma("unroll") for(int r=4;r<16;r+=4){a=MX3(a,C0[r],C0[r+1]);b=MX3(b,C0[r+2],C0[r+3]);a=MX3(a,C1[r],C1[r+1]);b=MX3(b,C1[r+2],C1[r+3]);} \
      float rm=__builtin_fmaxf(a,b); { auto rr=__builtin_amdgcn_permlane32_swap(__float_as_uint(rm),__float_as_uint(rm),false,false); rm=__builtin_fmaxf(__uint_as_float(rr[0]),__uint_as_float(rr[1])); } rm=rm-clast-mm; \
      resc=false; \
      if(__builtin_expect(__any(rm>(float)THRL),0)){ const float dl=__builtin_fmaxf(rm,0.f); mhat+=dl; \
        mm+=dl; \
        const float f=__builtin_amdgcn_exp2f(-dl); l_reg*=f; if(hi==0)wsf[r32]=f; resc=true; } } \
    SBAR(); \
    GAPB(o[0]=__builtin_amdgcn_mfma_f32_32x32x16_bf16(PAF(0),VFR(0),o[0],0,0,0), C0,0,cbA[0]); \
    GAPB(o[1]=__builtin_amdgcn_mfma_f32_32x32x16_bf16(PAF(0),VFR(4),o[1],0,0,0), C0,4,cbA[1]); \
    KRD(GL,0); GAPB(o[0]=__builtin_amdgcn_mfma_f32_32x32x16_bf16(PAF(1),VFR(1),o[0],0,0,0), C0,8,cbA[2]); \
    KRD(GL,1); GAPB(o[1]=__builtin_amdgcn_mfma_f32_32x32x16_bf16(PAF(1),VFR(5),o[1],0,0,0), C0,12,cbA[3]); \
    KRD(GL,2); GAPB(o[0]=__builtin_amdgcn_mfma_f32_32x32x16_bf16(PAF(2),VFR(2),o[0],0,0,0), C1,0,cbB[0]); \
    KRD(GL,3); GAPB(o[1]=__builtin_amdgcn_mfma_f32_32x32x16_bf16(PAF(2),VFR(6),o[1],0,0,0), C1,4,cbB[1]); \
    GAPB(o[0]=__builtin_amdgcn_mfma_f32_32x32x16_bf16(PAF(3),VFR(3),o[0],0,0,0), C1,8,cbB[2]); \
    GAPB(o[1]=__builtin_amdgcn_mfma_f32_32x32x16_bf16(PAF(3),VFR(7),o[1],0,0,0), C1,12,cbB[3]); \
    }while(0)
  int t=1;
  #undef CMASK
  #define CMASK(P0,P1,t) do{}while(0)
  for(;t+5<NT;t+=2){
    STEP(pB0,pB1,pA0,pA1,t,true,true,true);     WAIT_BAR(2); RESC(); ROT();
    STEP(pA0,pA1,pB0,pB1,t+1,true,true,true);   WAIT_BAR(2); RESC(); ROT();
  }
  #undef CMASK
  #define CMASK(P0,P1,t) do{int jb_=(t)-(NT-4); if(band&&jb_>=0)cmask(P0,P1,jb_,qrel,hi);}while(0)
  #define ENDW(tt) do{ if((tt)+3<NT){WAIT_BAR(2);} else if((tt)+2<NT){WAIT_BAR(1);} else {WAIT_BAR(0);} }while(0)
  for(;t+1<NT;t+=2){
    STEP(pB0,pB1,pA0,pA1,t,(t+3<NT),(t+1<NT),(t+1<NT));       ENDW(t);   RESC(); ROT();
    STEP(pA0,pA1,pB0,pB1,t+1,(t+4<NT),(t+2<NT),(t+2<NT));     ENDW(t+1); RESC(); ROT();
  }
  STEP(pB0,pB1,pA0,pA1,NT-1,false,false,false); RESC();
  { float sacc=pB0[0]+pB0[1]; _Pragma("unroll") for(int r=2;r<16;++r)sacc+=pB0[r]; _Pragma("unroll") for(int r=0;r<16;++r)sacc+=pB1[r]; l_reg+=sacc;
    pw0=(u32x4){PKW(pB0,0),PKW(pB0,2),PKW(pB0,4),PKW(pB0,6)};pw1=(u32x4){PKW(pB0,8),PKW(pB0,10),PKW(pB0,12),PKW(pB0,14)};pw2=(u32x4){PKW(pB1,0),PKW(pB1,2),PKW(pB1,4),PKW(pB1,6)};pw3=(u32x4){PKW(pB1,8),PKW(pB1,10),PKW(pB1,12),PKW(pB1,14)};
    SBAR(); pv(o,vb0+sl_cur,PAF(0),PAF(1),PAF(2),PAF(3)); }
  #undef PKW
  #undef PAF
  #undef VFR
  #undef PIN
  #undef MX3
  #undef GAPA
  #undef GAPB
  #undef EX
  #undef VRD
  #undef KRD
  #undef STEP
  #undef ENDW
  {auto rr=__builtin_amdgcn_permlane32_swap(__float_as_uint(l_reg),__float_as_uint(l_reg),false,false);l_reg=__uint_as_float(rr[0])+__uint_as_float(rr[1]);}
  if(hi==0)wsf[32+r32]=l_reg;asm volatile("s_waitcnt lgkmcnt(0)":::"memory");
  float rli[16];
  if(split){
    float*Pm=PART+(size_t)part*PART_F; const float*Po=PART+(size_t)(1-part)*PART_F;
    #pragma unroll
    for(int r=0;r<16;++r){
      #pragma unroll
      for(int d0=0;d0<2;++d0)Pm[(wid*QBLK+crow(r,hi))*64+d0*32+r32]=o[d0][r];}
    if(hi==0){Pm[QB*64+(wid*QBLK+r32)*2]=mm+cq;Pm[QB*64+(wid*QBLK+r32)*2+1]=l_reg;wsf[r32]=mm+cq;}
    asm volatile("s_waitcnt vmcnt(0) lgkmcnt(0)\n\ts_barrier":::"memory");
    if(tid==0){ __builtin_amdgcn_fence(__ATOMIC_RELEASE,"agent"); asm volatile("s_waitcnt vmcnt(0)":::"memory");
      *(volatile __attribute__((address_space(3))) unsigned*)((__attribute__((address_space(3))) char*)shm+LDS_OST)=__hip_atomic_fetch_add(flag,1u,__ATOMIC_RELAXED,__HIP_MEMORY_SCOPE_AGENT); }
    asm volatile("s_waitcnt vmcnt(0) lgkmcnt(0)\n\ts_barrier":::"memory");
    const unsigned old=*(volatile __attribute__((address_space(3))) unsigned*)((__attribute__((address_space(3))) char*)shm+LDS_OST);
    asm volatile("s_waitcnt lgkmcnt(0)\n\ts_barrier":::"memory");
    if(old==0u)return;
    __builtin_amdgcn_fence(__ATOMIC_ACQUIRE,"agent"); asm volatile("s_waitcnt vmcnt(0)":::"memory");
    #pragma unroll
    for(int r=0;r<16;++r){ const int row=crow(r,hi); const float mo=wsf[row],lo=wsf[32+row],mt=Po[QB*64+(wid*QBLK+row)*2],lt=Po[QB*64+(wid*QBLK+row)*2+1];
      const float m=__builtin_fmaxf(mo,mt),fo=__builtin_amdgcn_exp2f(mo-m),ft=__builtin_amdgcn_exp2f(mt-m),inv=__builtin_amdgcn_rcpf(lo*fo+lt*ft);
      #pragma unroll
      for(int d0=0;d0<2;++d0)o[d0][r]=(o[d0][r]*fo+Po[(wid*QBLK+row)*64+d0*32+r32]*ft)*inv;
      rli[r]=1.f; }
  } else {
  #pragma unroll
  for(int r=0;r<16;++r)rli[r]=__builtin_amdgcn_rcpf(wsf[32+crow(r,hi)]);
  }
  bf16*Ow=O+(rowbase+q0+wid*QBLK)*OPITCH+h*D;
  { bf16*stg=(bf16*)(shm+LDS_OST)+wid*2048;
    #pragma unroll
    for(int r=0;r<16;++r){const int orow=crow(r,hi);
      #pragma unroll
      for(int d0=0;d0<2;++d0)stg[orow*64+d0*32+r32]=__float2bfloat16(o[d0][r]*rli[r]);}
    asm volatile("s_waitcnt lgkmcnt(0)":::"memory");
    #pragma unroll
    for(int i=0;i<4;++i){const int row=i*8+(lane>>3),ch=lane&7; const u32x4 v=*(const u32x4*)(stg+row*64+ch*8); ATTN_STORE16(Ow+(long)row*OPITCH+ch*8,v);} }
  asm volatile("s_waitcnt lgkmcnt(0)\n\ts_barrier":::"memory");
  #undef CBIAS
  #undef CBLD
  #undef DMA_K
  #undef DMA_V
  #undef CMASK
  #undef START
  #undef RESC
  #undef ROT
}
constexpr int ATTN_LDS_BYTES=LDS_BYTES;
struct AttnTensors { const bf16* Q; const bf16* K; const bf16* V; bf16* O; const float* CF; const float* stat; };
struct AttnUnit { int bh; int qb; };
struct StaticOrder {
  int vcu;
  __device__ __forceinline__ explicit StaticOrder(int grid,int block):vcu((grid%8==0)?(block%8)*(grid/8)+block/8:block),G_(grid){}
  int G_;
  __device__ __forceinline__ bool next(int i,AttnUnit&u)const{ const int v=vcu+(i>>1)*G_; if(v>=256)return false; const int s=v&15; u.bh=v>>4; u.qb=(i&1)?31-s:s; return true; }
  __device__ __forceinline__ void a_ready(const AttnUnit&)const{}
  __device__ __forceinline__ void done(const AttnUnit&)const{}
};
struct QueueOrder {
  unsigned* ctr; __attribute__((address_space(3))) unsigned* slot;
  __device__ __forceinline__ bool next(int,AttnUnit&u)const{
    if(threadIdx.x==0)*slot=__hip_atomic_fetch_add(ctr,1u,__ATOMIC_RELAXED,__HIP_MEMORY_SCOPE_AGENT);
    asm volatile("s_waitcnt vmcnt(0) lgkmcnt(0)\n\ts_barrier":::"memory");
    const unsigned v=*(volatile __attribute__((address_space(3))) unsigned*)slot; const int vv=__builtin_amdgcn_readfirstlane((int)v);
    if(vv>=512)return false; u.qb=31-(vv>>4); u.bh=vv&15; return true; }
  __device__ __forceinline__ void a_ready(const AttnUnit&)const{}
  __device__ __forceinline__ void done(const AttnUnit&)const{}
};
template<class Sched,int THRL=8> __device__ __forceinline__ void attn_phase(char*lds,const AttnTensors&T,const Sched&S){
  AttnUnit u;
  for(int i=0;S.next(i,u);++i){ S.a_ready(u); const float Tsk=40.f+2.f*__builtin_sqrtf(T.stat[u.bh*2]*T.stat[u.bh*2+1])*1.01f+1.f;
    attn_unit<THRL>(u.bh/NHEAD,u.bh%NHEAD,u.qb,T.Q,T.K,T.V,T.O,T.CF+(long)u.bh*SEQ,Tsk,0,nullptr,nullptr,lds); S.done(u); }
}
#undef SBAR
#undef WAIT_BAR
}
#define GAS __attribute__((address_space(1)))
#define LAS __attribute__((address_space(3)))
typedef unsigned v4u __attribute__((ext_vector_type(4)));
typedef float f32x4 __attribute__((ext_vector_type(4)));
typedef short bf16x8 __attribute__((ext_vector_type(8)));
typedef GAS unsigned gu32;
typedef GAS unsigned long long gu64;
#define RLX_AGENT __ATOMIC_RELAXED, __HIP_MEMORY_SCOPE_AGENT
#define LDS_WAIT() asm volatile("s_waitcnt lgkmcnt(0)" ::: "memory")
#define VM_WAIT() asm volatile("s_waitcnt vmcnt(0)" ::: "memory")
__device__ __forceinline__ unsigned long long rt() { return __builtin_amdgcn_s_memrealtime(); }
__device__ __forceinline__ unsigned pk2(float lo, float hi) { return (unsigned)f2bf(lo) | ((unsigned)f2bf(hi) << 16); }

#define XB_TMO      128
#define XB_XCNT(j)  (256  + 64 * (j))
#define XB_XSUB(j)  (1280 + 64 * (j))
#define XB_XGEN(j)  (2304 + 64 * (j))
#define XB_TOP      3328
#define XB_TOPGEN   3392
#define XCD_BAR_WORDS 3456
#define XB_SPIN_CAP (1u << 18)

__device__ __forceinline__ unsigned xb_ld(unsigned* p)              { return __hip_atomic_load(p, __ATOMIC_RELAXED, __HIP_MEMORY_SCOPE_AGENT); }
__device__ __forceinline__ unsigned xb_add(unsigned* p, unsigned v) { return __hip_atomic_fetch_add(p, v, __ATOMIC_RELAXED, __HIP_MEMORY_SCOPE_AGENT); }
__device__ __forceinline__ unsigned xb_xcc_id() { return (unsigned)__builtin_amdgcn_s_getreg((3 << 11) | 20) & 0xFu; }
#define XB_SPIN(cond, bar) do { unsigned _sp = 0; while (cond) { __builtin_amdgcn_s_sleep(1); \
    if ((++_sp & 255u) == 0u) { if (xb_ld(&(bar)[XB_TMO])) break; if (_sp > XB_SPIN_CAP) { atomicAdd(&(bar)[XB_TMO], 1u); break; } } } } while (0)

struct XcdBarrier {
    unsigned* bar; unsigned x;
    volatile LAS unsigned* st;
};

__device__ __forceinline__ XcdBarrier xcd_barrier_post(unsigned* bar, volatile LAS unsigned* st) {
    XcdBarrier b; b.bar = bar; b.x = xb_xcc_id(); b.st = st;
    if (threadIdx.x == 0) (void)xb_add(&bar[XB_XCNT(b.x)], 1u);
    return b;
}
__device__ __forceinline__ void xcd_barrier_complete(unsigned* bar, unsigned x, unsigned& nloc, unsigned& nx) {
    const unsigned G = gridDim.x * gridDim.y * gridDim.z;
    unsigned sum, cnt, mine, sp = 0u;
    for (;;) {
        sum = 0u; cnt = 0u; mine = 0u;
#pragma unroll
        for (unsigned j = 0; j < 16; ++j) { const unsigned c = xb_ld(&bar[XB_XCNT(j)]); sum += c; cnt += (c > 0u) ? 1u : 0u; mine = (j == x) ? c : mine; }
        if (sum == G) break;
        __builtin_amdgcn_s_sleep(1);
        if ((++sp & 255u) == 0u) { if (xb_ld(&bar[XB_TMO])) break; if (sp > XB_SPIN_CAP) { atomicAdd(&bar[XB_TMO], 1u); break; } }
    }
    nloc = mine > 0u ? mine : 1u; nx = cnt > 0u ? cnt : 1u;
}

__device__ __forceinline__ void xcd_barrier(const XcdBarrier& b) {
    asm volatile("s_waitcnt vmcnt(0)" ::: "memory");
    __syncthreads();
    if (threadIdx.x == 0) {
        unsigned* bar = b.bar;
        __builtin_amdgcn_s_waitcnt(0);
        unsigned nloc = b.st[0], nx = b.st[1];
        if (nloc == 0u) { xcd_barrier_complete(bar, b.x, nloc, nx); b.st[0] = nloc; b.st[1] = nx; }
        const unsigned old = xb_add(&bar[XB_XSUB(b.x)], 1u);
        const unsigned gen = old / nloc;
        if (old + 1u == (gen + 1u) * nloc) {
            __builtin_amdgcn_fence(__ATOMIC_RELEASE, "agent");
            asm volatile("s_waitcnt vmcnt(0)" ::: "memory");
            const unsigned og = xb_add(&bar[XB_TOP], 1u);
            const unsigned tg = og / nx;
            if (og + 1u == (tg + 1u) * nx) xb_add(&bar[XB_TOPGEN], 1u);
            else XB_SPIN(xb_ld(&bar[XB_TOPGEN]) == tg, bar);
            __builtin_amdgcn_fence(__ATOMIC_ACQUIRE, "agent");
            xb_add(&bar[XB_XGEN(b.x)], 1u);
            asm volatile("s_waitcnt vmcnt(0)" ::: "memory");
        } else {
            XB_SPIN(xb_ld(&bar[XB_XGEN(b.x)]) == gen, bar);
            __builtin_amdgcn_fence(__ATOMIC_ACQUIRE, "agent");
            asm volatile("s_waitcnt vmcnt(0)" ::: "memory");
        }
    }
    __syncthreads();
}
constexpr int NWAVES = 8, NTHR = 512;
constexpr int RING_OFF = 0, RING_BYTES = 131072, LDSCTL_OFF = RING_BYTES, MISC_OFF = LDSCTL_OFF + 320, LDS_BYTES = 147456;
constexpr int CW_BAR = 4096;
constexpr size_t WS_WSM = 402 * MiB;
constexpr size_t WS_WIN = WS_WSM  , WS_SWIN = WS_WSM + 8 * MiB  , WS_WOUT = WS_WSM + 14 * MiB  , WS_WDGU = WS_WSM + 18 * MiB  , WS_SWDGU = WS_WSM + 24 * MiB  , WS_WDDN = WS_WSM + 29 * MiB  ;
constexpr size_t WS_SH = WS_H + 16 * MiB  , WS_SXG = WS_XG + 34 * MiB  ;
constexpr size_t WS_WMGU = WS_W  , WS_WMDN = 437 * MiB  ;
static_assert(WS_WDDN + 6 * MiB <= WS_WMDN && WS_WMGU + 56 * MiB <= WS_WSM && WS_WMDN + 28 * MiB <= WS_END, "ws");
struct MArgs { const float* in[20]; float* out; unsigned char* ws; int ph_lo, ph_hi; };
enum { I_X = 0, I_ATTN_NORM, I_W_IN, I_HGRN_LB, I_HGRN_NORM, I_MLSTM_CONV, I_MLSTM_BI, I_MLSTM_BF, I_MLSTM_NORM, I_FOX_BF, I_W_OUT, I_FFN_NORM, I_DGATE, I_DUP, I_DDOWN, I_ROUTER, I_MGATE, I_MUP, I_MDOWN, I_FINAL_NORM };

__device__ __forceinline__ void tr_item(const float* W, int ldw, int K, bf16_t* WT, LAS float* scr, int k0, int lane) {
#pragma unroll 32
    for (int i = 0; i < 32; ++i) { const int kk = 2 * i + (lane >> 5); scr[kk * 33 + (lane & 31)] = W[(size_t)(k0 + kk) * ldw + (lane & 31)]; }
    LDS_WAIT(); asm volatile("" ::: "memory");
    const int c = lane & 7;
#pragma unroll
    for (int j = 0; j < 4; ++j) { const int n = (lane >> 3) + 8 * j; const LAS float* s = scr + (8 * c) * 33 + n;
        v4u o; o.x = pk2(s[0 * 33], s[1 * 33]); o.y = pk2(s[2 * 33], s[3 * 33]); o.z = pk2(s[4 * 33], s[5 * 33]); o.w = pk2(s[6 * 33], s[7 * 33]);
        *(GAS v4u*)(WT + (size_t)n * K + k0 + 8 * c) = o; }
    LDS_WAIT(); asm volatile("" ::: "memory");
}
__device__ __forceinline__ int glu_row(int c, int up) { return (c >> 7) * 256 + (c & 127) + up * 128; }
constexpr int MOE_GU_ITEMS = 28672, MOE_ITEMS = 43008, MOE_FILL = 4, MOE_FILL_ITEMS = 128 * NWAVES * MOE_FILL;
__device__ __forceinline__ int moe_prefilled(int G) { return G == 256 ? 3 * MOE_FILL_ITEMS : 0; }
struct F8Item { const float* W; unsigned char* dst; int ldw, K; float sc; };
__device__ __forceinline__ F8Item moe_item(const MArgs& a, unsigned char* ws, int it) {
    const bool gu = it < MOE_GU_ITEMS; const int r0 = gu ? it : it - MOE_GU_ITEMS;
    const int e = gu ? r0 / 3584 : r0 / 1792; int r = gu ? r0 % 3584 : r0 % 1792; const int up = gu ? r / 1792 : 0; if (gu) r %= 1792;
    const int kb = gu ? r / 112 : r / 32, nb = gu ? r % 112 : r % 32, c = 32 * nb, k0 = 64 * kb;
    F8Item I; I.ldw = gu ? FE : D; I.K = gu ? D : FE; I.sc = gu ? pg8::F8_GSCALE : pg8::F8_WSCALE;
    I.W = (gu ? (up ? a.in[I_MUP] : a.in[I_MGATE]) + (size_t)e * D * FE : a.in[I_MDOWN] + (size_t)e * FE * D) + c + (size_t)k0 * I.ldw;
    I.dst = (gu ? (unsigned char*)(ws + WS_WMGU) + (size_t)e * 2 * FE * D + (size_t)glu_row(c, up) * D : (unsigned char*)(ws + WS_WMDN) + (size_t)e * D * FE + (size_t)c * FE) + k0;
    return I;
}
__device__ __forceinline__ void f8_load(float (&v)[32], const F8Item& I, int lane) {
    const float* p = I.W + (size_t)(lane >> 5) * I.ldw + (lane & 31);
#pragma unroll
    for (int i = 0; i < 32; ++i) v[i] = p[(size_t)(2 * i) * I.ldw];
}
__device__ __forceinline__ void f8_stage(const float (&v)[32], LAS float* scr, int lane) {
#pragma unroll
    for (int i = 0; i < 32; ++i) scr[(2 * i + (lane >> 5)) * 33 + (lane & 31)] = v[i];
}
__device__ __forceinline__ void f8_out(const F8Item& I, LAS float* scr, int lane) {
    LDS_WAIT(); asm volatile("" ::: "memory");
    const int c = lane & 7;
#pragma unroll
    for (int j = 0; j < 4; ++j) { const int n = (lane >> 3) + 8 * j; const LAS float* s = scr + (8 * c) * 33 + n; float h[8];
#pragma unroll
        for (int i = 0; i < 8; ++i) h[i] = __builtin_fminf(__builtin_fmaxf(s[i * 33] * I.sc, -448.f), 448.f);
        unsigned w0 = 0u, w1 = 0u; w0 = __builtin_amdgcn_cvt_pk_fp8_f32(h[0], h[1], w0, false); w0 = __builtin_amdgcn_cvt_pk_fp8_f32(h[2], h[3], w0, true);
        w1 = __builtin_amdgcn_cvt_pk_fp8_f32(h[4], h[5], w1, false); w1 = __builtin_amdgcn_cvt_pk_fp8_f32(h[6], h[7], w1, true);
        typedef unsigned u32x2_ __attribute__((ext_vector_type(2))); *(GAS u32x2_*)(I.dst + (size_t)n * I.K + 8 * c) = (u32x2_){w0, w1}; }
    LDS_WAIT(); asm volatile("" ::: "memory");
}
__device__ __forceinline__ void moe_conv_range(const MArgs& a, unsigned char* ws, LAS float* scr, int first, int step, int end, int lane) {
    float v[32]; int it = first; F8Item cur;
    if (it < end) { cur = moe_item(a, ws, it); f8_load(v, cur, lane); }
#pragma unroll 1
    for (; it < end; it += step) {
        f8_stage(v, scr, lane);
        F8Item nxt = cur; const int nx = it + step;
        if (nx < end) { nxt = moe_item(a, ws, nx); f8_load(v, nxt, lane); }
        f8_out(cur, scr, lane); cur = nxt;
    }
}
constexpr int MOE_FILL17 = 3;
__device__ __forceinline__ int moe_tail_idle(const int* cnt, int G) { int acc = 0;
#pragma unroll
    for (int e = 0; e < NE; ++e) acc += (cnt[e] + 255) >> 8;
    const int r = (acc * (2 * FE / 256)) % 256; return (G == 256 && r) ? 256 - r : 0; }
__device__ __forceinline__ void moe_fill(const MArgs& a, unsigned char* ws, LAS float* scr, int slot, int G, int bx, int wave, int lane) {
    if (G != 256 || bx < 128) return;
    const int first = slot * MOE_FILL_ITEMS + (bx - 128) * NWAVES + wave;
    moe_conv_range(a, ws, scr, first, 128 * NWAVES, first + MOE_FILL * 128 * NWAVES, lane);
}
struct RowIn { float4 v[4]; };
template <bool BF> __device__ __forceinline__ void mrow_load(RowIn& R, const void* src, int row, int lane) {
    if (BF) { const uint2* xr = (const uint2*)((const bf16_t*)src + (size_t)row * D) + lane;
#pragma unroll
        for (int j = 0; j < 4; ++j) { const uint2 w = xr[64 * j]; R.v[j] = make_float4(__uint_as_float(w.x << 16), __uint_as_float(w.x & 0xffff0000u), __uint_as_float(w.y << 16), __uint_as_float(w.y & 0xffff0000u)); } }
    else { const float4* xr = (const float4*)((const float*)src + (size_t)row * D) + lane;
#pragma unroll
        for (int j = 0; j < 4; ++j) R.v[j] = xr[64 * j]; } }
template <int MODE> __device__ __forceinline__ void mrow(const RowIn& R, signed char* H8, float* SH, const float* gain, const LAS float* tab, float* G, int row, int lane, float (&lg)[8]) {
    float4 v[4]; float ss = 0.f;
#pragma unroll
    for (int j = 0; j < 4; ++j) { v[j] = R.v[j]; ss += v[j].x * v[j].x + v[j].y * v[j].y + v[j].z * v[j].z + v[j].w * v[j].w; }
    ss = wave_sum(ss);
    const float r = rsqrtf(ss * (1.f / D) + EPS);
    float h[16];
#pragma unroll
    for (int j = 0; j < 4; ++j) { const float4 g = *((const float4*)gain + 64 * j + lane);
        h[4 * j + 0] = v[j].x * r * g.x; h[4 * j + 1] = v[j].y * r * g.y; h[4 * j + 2] = v[j].z * r * g.z; h[4 * j + 3] = v[j].w * r * g.w; }
    if (MODE == 2) {
#pragma unroll
      for (int j = 0; j < 4; ++j) { float q[4];
#pragma unroll
          for (int i = 0; i < 4; ++i) q[i] = __builtin_fminf(__builtin_fmaxf(h[4 * j + i] * pg8::F8_ASCALE, -448.f), 448.f);
          unsigned w = 0u; w = __builtin_amdgcn_cvt_pk_fp8_f32(q[0], q[1], w, false); w = __builtin_amdgcn_cvt_pk_fp8_f32(q[2], q[3], w, true);
          *((unsigned*)(H8 + (size_t)row * D) + 64 * j + lane) = w; }
    } else
    { float am = 0.f;
#pragma unroll
      for (int i = 0; i < 16; ++i) am = fmaxf(am, fabsf(h[i]));
      am = wave_max_nn(am);
      const float inv = am > 0.f ? 127.f / am : 0.f;
#pragma unroll
      for (int j = 0; j < 4; ++j) { const int q0 = (int)rintf(h[4 * j] * inv), q1 = (int)rintf(h[4 * j + 1] * inv), q2 = (int)rintf(h[4 * j + 2] * inv), q3 = (int)rintf(h[4 * j + 3] * inv);
          *((unsigned*)(H8 + (size_t)row * D) + 64 * j + lane) = (unsigned)(q0 & 255) | ((unsigned)(q1 & 255) << 8) | ((unsigned)(q2 & 255) << 16) | ((unsigned)(q3 & 255) << 24); }
      if (lane == 0) SH[row] = am > 0.f ? am * (1.f / 127.f) : 1.f; }
    if (MODE == 0) {
        float pa[16];
#pragma unroll
        for (int c = 0; c < 16; ++c) { float s = 0.f;
#pragma unroll
            for (int j = 0; j < 4; ++j) { const f32x4 w = *(const LAS f32x4*)(tab + c * 1024 + 256 * j + 4 * lane); s += h[4 * j] * w[0] + h[4 * j + 1] * w[1] + h[4 * j + 2] * w[2] + h[4 * j + 3] * w[3]; }
            pa[c] = s; }
#pragma unroll
        for (int c = 0; c < 8; ++c) { const bool up = (lane & 32) != 0; const float send = up ? pa[c] : pa[c + 8], keep = up ? pa[c + 8] : pa[c]; pa[c] = keep + __shfl_xor(send, 32); }
#pragma unroll
        for (int c = 0; c < 4; ++c) { const bool up = (lane & 16) != 0; const float send = up ? pa[c] : pa[c + 4], keep = up ? pa[c + 4] : pa[c]; pa[c] = keep + __shfl_xor(send, 16); }
#pragma unroll
        for (int c = 0; c < 2; ++c) { const bool up = (lane & 8) != 0; const float send = up ? pa[c] : pa[c + 2], keep = up ? pa[c + 2] : pa[c]; pa[c] = keep + __shfl_xor(send, 8); }
        { const bool up = (lane & 4) != 0; const float send = up ? pa[0] : pa[1], keep = up ? pa[1] : pa[0]; pa[0] = keep + __shfl_xor(send, 4); }
        pa[0] += __shfl_xor(pa[0], 2); pa[0] += __shfl_xor(pa[0], 1);
        if ((lane & 3) == 0) G[(size_t)row * GW + 8 * ((lane >> 5) & 1) + 4 * ((lane >> 4) & 1) + 2 * ((lane >> 3) & 1) + ((lane >> 2) & 1)] = pa[0];
    }
    if (MODE == 2) {
        float pa[8];
#pragma unroll
        for (int c = 0; c < 8; ++c) { float s = 0.f;
#pragma unroll
            for (int j = 0; j < 4; ++j) { const f32x4 w = *(const LAS f32x4*)(tab + c * 1024 + 256 * j + 4 * lane); s += h[4 * j] * w[0] + h[4 * j + 1] * w[1] + h[4 * j + 2] * w[2] + h[4 * j + 3] * w[3]; }
            pa[c] = s; }
#pragma unroll
        for (int c = 0; c < 4; ++c) { const bool up = (lane & 32) != 0; const float send = up ? pa[c] : pa[c + 4], keep = up ? pa[c + 4] : pa[c]; pa[c] = keep + __shfl_xor(send, 32); }
#pragma unroll
        for (int c = 0; c < 2; ++c) { const bool up = (lane & 16) != 0; const float send = up ? pa[c] : pa[c + 2], keep = up ? pa[c + 2] : pa[c]; pa[c] = keep + __shfl_xor(send, 16); }
        { const bool up = (lane & 8) != 0; const float send = up ? pa[0] : pa[1], keep = up ? pa[1] : pa[0]; pa[0] = keep + __shfl_xor(send, 8); }
        pa[0] += __shfl_xor(pa[0], 4); pa[0] += __shfl_xor(pa[0], 2); pa[0] += __shfl_xor(pa[0], 1);
        float v0 = -INFINITY, v1 = -INFINITY; int e0 = 0, e1 = 0;
#pragma unroll
        for (int c = 0; c < 8; ++c) { const float sv = __shfl(pa[0], 8 * c);
            if (sv > v0) { v1 = v0; e1 = e0; v0 = sv; e0 = c; } else if (sv > v1) { v1 = sv; e1 = c; } }
        lg[0] = v0; lg[1] = v1; lg[2] = __int_as_float(e0); lg[3] = __int_as_float(e1);
    }
}
__device__ __forceinline__ void load_gate_tab(LAS float* tab, const float* w_in, int tid) {
    for (int k = tid; k < D; k += NTHR) { const float4* w0 = (const float4*)(w_in + (size_t)k * DIN + 1792); const float4* w1 = (const float4*)(w_in + (size_t)k * DIN + 3592);
        const float4 a0 = w0[0], a1 = w0[1], b0 = w1[0], b1 = w1[1];
        tab[0 * 1024 + k] = a0.x; tab[1 * 1024 + k] = a0.y; tab[2 * 1024 + k] = a0.z; tab[3 * 1024 + k] = a0.w; tab[4 * 1024 + k] = a1.x; tab[5 * 1024 + k] = a1.y; tab[6 * 1024 + k] = a1.z; tab[7 * 1024 + k] = a1.w;
        tab[8 * 1024 + k] = b0.x; tab[9 * 1024 + k] = b0.y; tab[10 * 1024 + k] = b0.z; tab[11 * 1024 + k] = b0.w; tab[12 * 1024 + k] = b1.x; tab[13 * 1024 + k] = b1.y; tab[14 * 1024 + k] = b1.z; tab[15 * 1024 + k] = b1.w; }
}
__device__ __forceinline__ void load_router_tab(LAS float* tab, const float* router, int tid) {
    for (int k = tid; k < D; k += NTHR) { const float4* w0 = (const float4*)(router + (size_t)k * NE); const float4 a0 = w0[0], a1 = w0[1];
        tab[0 * 1024 + k] = a0.x; tab[1 * 1024 + k] = a0.y; tab[2 * 1024 + k] = a0.z; tab[3 * 1024 + k] = a0.w; tab[4 * 1024 + k] = a1.x; tab[5 * 1024 + k] = a1.y; tab[6 * 1024 + k] = a1.z; tab[7 * 1024 + k] = a1.w; }
}
struct Conv8Job { const float* W; int ldw; signed char* WT8; float* S; };
__device__ __forceinline__ void conv8_load(float (&v)[64], const Conv8Job& j, int tid, int wave) {
    const int lane = tid & 63, n = lane & 31, kp = lane >> 5;
#pragma unroll
    for (int i = 0; i < 64; ++i) v[i] = j.W[(size_t)(128 * wave + 2 * i + kp) * j.ldw + n];
}
__device__ __forceinline__ void conv8_stage(const float (&v)[64], LAS float* img, LAS float* pm, int tid, int wave) {
    const int lane = tid & 63, n = lane & 31, kp = lane >> 5; float m = 0.f;
#pragma unroll
    for (int i = 0; i < 64; ++i) { img[(128 * wave + 2 * i + kp) * 32 + n] = v[i]; m = fmaxf(m, fabsf(v[i])); }
    m = fmaxf(m, __shfl_xor(m, 32));
    if (lane < 32) pm[wave * 32 + lane] = m;
    __syncthreads();
}
__device__ __forceinline__ void conv8_quant(const Conv8Job& j, LAS float* img, LAS float* pm, int tid, int wave) {
    const int lane = tid & 63, no = lane >> 1, kh = 128 * wave + 64 * (lane & 1);
    float cm = 0.f;
#pragma unroll
    for (int w = 0; w < 8; ++w) cm = fmaxf(cm, pm[w * 32 + no]);
    const float inv = cm > 0.f ? 127.f / cm : 0.f;
    if (wave == 0 && (lane & 1) == 0) j.S[no] = cm > 0.f ? cm * (1.f / 127.f) : 1.f;
    const LAS float* sp = img + kh * 32 + no;
#pragma unroll
    for (int q = 0; q < 4; ++q) { unsigned wq[4];
#pragma unroll
        for (int jj = 0; jj < 4; ++jj) { const int kk = 16 * q + 4 * jj; const int q0 = (int)rintf(sp[kk * 32] * inv), q1 = (int)rintf(sp[(kk + 1) * 32] * inv), q2 = (int)rintf(sp[(kk + 2) * 32] * inv), q3 = (int)rintf(sp[(kk + 3) * 32] * inv);
            wq[jj] = (unsigned)(q0 & 255) | ((unsigned)(q1 & 255) << 8) | ((unsigned)(q2 & 255) << 16) | ((unsigned)(q3 & 255) << 24); }
        v4u o; o.x = wq[0]; o.y = wq[1]; o.z = wq[2]; o.w = wq[3];
        *(GAS v4u*)(j.WT8 + (size_t)no * 1024 + kh + 16 * q) = o; }
    __syncthreads();
}
namespace scan {
typedef short bf16x8 __attribute__((ext_vector_type(8)));
typedef float f32x4 __attribute__((ext_vector_type(4)));
typedef unsigned v2u __attribute__((ext_vector_type(2)));
constexpr int TS = 144, TB = 64 * TS;
constexpr int L_T0 = 0, L_T1 = TB, L_T2 = 2 * TB, L_T3 = 3 * TB, L_T4 = 4 * TB, L_T5 = 5 * TB, L_O = 6 * TB, OS = 68  , L_PART = L_O + 64 * OS * 4, L_VEC = L_PART + 8 * 64 * 4, L_END = L_VEC + 8 * 64 * 4;
static_assert(L_END <= RING_BYTES, "scan LDS");
constexpr size_t SC_LHG = 0, SC_LML = 16 * MiB, SC_DEC = 32 * MiB  , SC_NL = 32 * MiB + 256 * 1024  , SC_AMAX = 32 * MiB + 512 * 1024, SC_BEND = SC_AMAX + 4096, SC_MPREV = SC_BEND + 4096;

__device__ __forceinline__ float wave_incl_add(float v, int) {
    v += DPP_F(0.f, v, 0x111, 0xf); v += DPP_F(0.f, v, 0x112, 0xf); v += DPP_F(0.f, v, 0x114, 0xf); v += DPP_F(0.f, v, 0x118, 0xf);
    v += DPP_F(0.f, v, 0x142, 0xa); v += DPP_F(0.f, v, 0x143, 0xc);
    return v;
}
__device__ __forceinline__ float wave_incl_max(float v, int) {
    const float NI = -INFINITY;
    v = fmaxf(v, DPP_F(NI, v, 0x111, 0xf)); v = fmaxf(v, DPP_F(NI, v, 0x112, 0xf)); v = fmaxf(v, DPP_F(NI, v, 0x114, 0xf)); v = fmaxf(v, DPP_F(NI, v, 0x118, 0xf));
    v = fmaxf(v, DPP_F(NI, v, 0x142, 0xa)); v = fmaxf(v, DPP_F(NI, v, 0x143, 0xc));
    return v;
}
__device__ __forceinline__ float wave_max(float v) { return __int_as_float(__builtin_amdgcn_readlane(__float_as_int(wave_incl_max(v, 0)), 63)); }
__device__ __forceinline__ float lane_bcast(float v, int uniform_lane) { return __int_as_float(__builtin_amdgcn_readlane(__float_as_int(v), uniform_lane)); }
__device__ __forceinline__ f32x4 mma64(LAS const unsigned char* A, LAS const unsigned char* B, int m0, int n0, int lane, f32x4 acc) {
    const int r = lane & 15, kq = lane >> 4;
#pragma unroll
    for (int ks = 0; ks < 2; ++ks) {
        const bf16x8 a = *(LAS const bf16x8*)(A + (m0 + r) * TS + kq * 16 + ks * 64);
        const bf16x8 b = *(LAS const bf16x8*)(B + (n0 + r) * TS + kq * 16 + ks * 64);
        acc = __builtin_amdgcn_mfma_f32_16x16x32_bf16(a, b, acc, 0, 0, 0);
    }
    return acc;
}
__device__ __forceinline__ v4u pack8(const float (&v)[8]) { v4u w; w.x = pk2(v[0], v[1]); w.y = pk2(v[2], v[3]); w.z = pk2(v[4], v[5]); w.w = pk2(v[6], v[7]); return w; }
__device__ __forceinline__ v4u pack8h(const bf16_t (&v)[8]) { v4u w; w.x = v[0] | ((unsigned)v[1] << 16); w.y = v[2] | ((unsigned)v[3] << 16); w.z = v[4] | ((unsigned)v[5] << 16); w.w = v[6] | ((unsigned)v[7] << 16); return w; }
__device__ __forceinline__ void st16(LAS unsigned char* p, float v) { *(LAS bf16_t*)p = f2bf(v); }
__device__ __forceinline__ void load_state_tile(LAS unsigned char* T, const float* S, int tid) {
    const int v = tid >> 3, d0 = (tid & 7) * 8; const float4 x0 = *(const float4*)(S + v * 64 + d0), x1 = *(const float4*)(S + v * 64 + d0 + 4);
    v4u w; w.x = pk2(x0.x, x0.y); w.y = pk2(x0.z, x0.w); w.z = pk2(x1.x, x1.y); w.w = pk2(x1.z, x1.w);
    *(LAS v4u*)(T + v * TS + d0 * 2) = w;
}
typedef short s16x2 __attribute__((ext_vector_type(2)));
constexpr int IW = 4, TK = 64 / IW, CPT = 64 / IW, TPW = 16 / IW;
constexpr int HLDS = 6 * TB + 4096;
constexpr int H_O = L_T0, H_PART = 6 * TB, H_VEC = 6 * TB + 2048;
static_assert(2 * HLDS <= RING_BYTES && 64 * OS * 4 <= 2 * TB, "scan LDS (two halves)");
__device__ __forceinline__ void pack16w(LAS unsigned char* dst, const float (&v)[TK]) {
    v4u w0, w1; w0.x = pk2(v[0], v[1]); w0.y = pk2(v[2], v[3]); w0.z = pk2(v[4], v[5]); w0.w = pk2(v[6], v[7]); w1.x = pk2(v[8], v[9]); w1.y = pk2(v[10], v[11]); w1.z = pk2(v[12], v[13]); w1.w = pk2(v[14], v[15]);
    *(LAS v4u*)dst = w0; *(LAS v4u*)(dst + 16) = w1; }
__device__ __forceinline__ void pack16h(LAS unsigned char* dst, const s16x2 (&v)[TK / 2]) {
    v4u w0, w1; w0.x = __builtin_bit_cast(unsigned, v[0]); w0.y = __builtin_bit_cast(unsigned, v[1]); w0.z = __builtin_bit_cast(unsigned, v[2]); w0.w = __builtin_bit_cast(unsigned, v[3]);
    w1.x = __builtin_bit_cast(unsigned, v[4]); w1.y = __builtin_bit_cast(unsigned, v[5]); w1.z = __builtin_bit_cast(unsigned, v[6]); w1.w = __builtin_bit_cast(unsigned, v[7]);
    *(LAS v4u*)dst = w0; *(LAS v4u*)(dst + 16) = w1; }
__device__ __forceinline__ void local_state_mma_store(LAS unsigned char* Lh, bf16_t* LT, int tq, int lane) {
#pragma unroll
    for (int nn = 0; nn < TPW; ++nn) { const int ti = tq * TPW + nn, mt = ti >> 2, nt = ti & 3; f32x4 acc = {0.f, 0.f, 0.f, 0.f};
        acc = mma64(Lh + L_T0, Lh + L_T1, nt * 16, mt * 16, lane, acc);
        v2u w; w.x = pk2(acc[0], acc[1]); w.y = pk2(acc[2], acc[3]);
        *(v2u*)(LT + (mt * 16 + (lane & 15)) * 64 + nt * 16 + 4 * (lane >> 4)) = w; }
}
__device__ __forceinline__ float sigmoid_fast(float z) { return __builtin_amdgcn_rcpf(1.f + __builtin_amdgcn_exp2f(-1.4426950408889634f * z)); }
__device__ __forceinline__ float silu_fast(float z) { return z * sigmoid_fast(z); }
__device__ __forceinline__ void hgrn_gate(float lb, float z, float& sg, float& omsg, float& lf) {
    const float e = __builtin_amdgcn_exp2f(-1.4426950408889634f * fabsf(z)), ope = 1.f + e, r = __builtin_amdgcn_rcpf(ope), er = e * r; const bool pos = z >= 0.f;
    sg = pos ? r : er; omsg = pos ? er : r;
    lf = lb > 0.f ? __logf(lb + (1.f - lb) * sg) : (fminf(z, 0.f) - __logf(ope)); }
#define BFP(arr, i) bf2f((bf16_t)(arr)[(i) >> 1][(i) & 1])
struct HgIn { s16x2 fz[TK / 2], q[TK / 2], iv[TK / 2]; v4u gate[2]; v4u s[2]; };
template <bool DPH> __device__ __forceinline__ void hgrn_load(HgIn& R, const bf16_t* P, int b, int c, int h, const bf16_t* ST, int tl, int tq) {
    const int d = tl & 63, row0 = b * SEQ + c * 64; const bf16_t* pr = P + (size_t)(row0 + TK * tq) * PW + h * 64 + d;
#pragma unroll
    for (int i = 0; i < TK; ++i) { R.fz[i >> 1][i & 1] = (short)pr[(size_t)i * PW + P_HF]; R.iv[i >> 1][i & 1] = (short)pr[(size_t)i * PW + P_HI]; if (DPH) R.q[i >> 1][i & 1] = (short)pr[(size_t)i * PW + P_HQ]; }
    if (DPH) { const int t = tl / IW, v0 = (tl % IW) * CPT; const v4u* gp = (const v4u*)(P + (size_t)(row0 + t) * PW + P_HG + h * 64 + v0); R.gate[0] = gp[0]; R.gate[1] = gp[1];
        R.s[0] = *(const v4u*)(ST + t * 64 + v0); R.s[1] = *(const v4u*)(ST + t * 64 + v0 + 8); }
}
struct MlIn { s16x2 qr[(TK + 4) / 2], kr[(TK + 4) / 2], vv[TK / 2]; float ig, fg, np, mprev; v4u gate[2]; v4u s[2]; };
template <bool DPH> __device__ __forceinline__ void mlstm_load(MlIn& R, const bf16_t* P, const float* G, int b, int c, int h, const bf16_t* CT, const float* NP, const float* MP, int tl, int tq) {
    const int d = tl & 63, lane = tl & 63, row0 = b * SEQ + c * 64; const bool fz3 = (c == 0 && tq == 0);
    const bf16_t* pk = P + (size_t)(row0 + TK * tq) * PW + P_MK + h * 64 + d; const bf16_t* pq = P + (size_t)(row0 + TK * tq) * PW + P_MQ + h * 64 + d;
#pragma unroll
    for (int j = 0; j < TK + 3; ++j) { R.kr[j >> 1][j & 1] = (j < 3 && fz3) ? (short)0 : (short)pk[((long)j - 3) * PW]; if (DPH) R.qr[j >> 1][j & 1] = (j < 3 && fz3) ? (short)0 : (short)pq[((long)j - 3) * PW]; }
#pragma unroll
    for (int i = 0; i < TK; ++i) R.vv[i >> 1][i & 1] = (short)P[(size_t)(row0 + TK * tq + i) * PW + P_MV + h * 64 + d];
    R.ig = G[(size_t)(row0 + lane) * GW + h]; R.fg = G[(size_t)(row0 + lane) * GW + 4 + h];
    if (DPH) { const int t = tl / IW, v0 = (tl % IW) * CPT; const v4u* gp = (const v4u*)(P + (size_t)(row0 + t) * PW + P_MO + h * 64 + v0); R.gate[0] = gp[0]; R.gate[1] = gp[1];
        R.s[0] = *(const v4u*)(CT + t * 64 + v0); R.s[1] = *(const v4u*)(CT + t * 64 + v0 + 8);
        R.np = NP[lane]; R.mprev = MP[0]; }
}
__device__ __forceinline__ void store_state_tile(LAS unsigned char* T, const v4u (&x)[2], int tl) {
    const int v = tl / IW, d0 = (tl % IW) * CPT; *(LAS v4u*)(T + v * TS + d0 * 2) = x[0]; *(LAS v4u*)(T + v * TS + d0 * 2 + 16) = x[1];
}
__device__ __forceinline__ void conv_silu_r(const s16x2 (&raw)[(TK + 4) / 2], const float* w4  , float scale, float (&out)[TK]) {
    const float w0 = w4[0], w1 = w4[512], w2 = w4[1024], w3 = w4[1536];
#pragma unroll
    for (int i = 0; i < TK; ++i) out[i] = silu_fast(w0 * BFP(raw, i) + w1 * BFP(raw, i + 1) + w2 * BFP(raw, i + 2) + w3 * BFP(raw, i + 3)) * scale;
}
__device__ __forceinline__ void hgrn_b_item(LAS unsigned char* Lh, const HgIn& R, float lb, bf16_t* LT, float* DEC, int tl, int tq) {
    const int d = tl & 63;
    float bl[TK], kh[TK]; float run = 0.f;
#pragma unroll
    for (int i = 0; i < TK; ++i) { const float fz = BFP(R.fz, i);
        float sg, omsg, lf; hgrn_gate(lb, fz, sg, omsg, lf); kh[i] = (1.f - lb) * omsg; run += lf; bl[i] = run; }
    LAS float* part = (LAS float*)(Lh + H_PART);
    part[tq * 64 + d] = run; __syncthreads();
    float off = 0.f, btot = 0.f;
#pragma unroll
    for (int w = 0; w < IW; ++w) { const float pv = part[w * 64 + d]; btot += pv; if (w < tq) off += pv; }
#pragma unroll
    for (int i = 0; i < TK; ++i) kh[i] *= __expf(btot - (off + bl[i]));
    pack16w(Lh + L_T0 + d * TS + tq * (2 * TK), kh);
    pack16h(Lh + L_T1 + d * TS + tq * (2 * TK), R.iv);
    if (tq == 0) DEC[d] = __expf(btot);
    __syncthreads();
    local_state_mma_store(Lh, LT, tq, tl & 63);
    __syncthreads();
}
__device__ __forceinline__ void mlstm_gates(float ig, float fg, const float* b_i, const float* b_f, int h, int lane, float& bcum, float& a) {
    const float z = fg + b_f[h]; bcum = wave_incl_add(fminf(z, 0.f) - __logf(1.f + __builtin_amdgcn_exp2f(-1.4426950408889634f * fabsf(z))), lane); a = ig + b_i[h] - bcum;
}
__device__ __forceinline__ void mlstm_b_item(LAS unsigned char* Lh, const MlIn& R, const float* conv, const float* b_i, const float* b_f, int h, bf16_t* LT, float* NL, float* AMAX, float* BEND, int tl, int tq) {
    const int d = tl & 63, lane = tl & 63;
    float bcum, a; mlstm_gates(R.ig, R.fg, b_i, b_f, h, lane, bcum, a);
    const float A = wave_max(a), bend = lane_bcast(bcum, 63);
    float kh[TK]; conv_silu_r(R.kr, conv + 256 + h * 64 + d, 0.125f, kh);
    float nsum = 0.f;
#pragma unroll
    for (int i = 0; i < TK; ++i) { kh[i] *= __expf(lane_bcast(a, TK * tq + i) - A); nsum += bf2f(f2bf(kh[i])); }
    pack16w(Lh + L_T0 + d * TS + tq * (2 * TK), kh);
    pack16h(Lh + L_T1 + d * TS + tq * (2 * TK), R.vv);
    LAS float* part = (LAS float*)(Lh + H_PART); part[tq * 64 + d] = nsum;
    __syncthreads();
    if (tq == 0) { float s = 0.f;
#pragma unroll
        for (int w = 0; w < IW; ++w) s += part[w * 64 + d];
        NL[d] = s; if (lane == 0) { AMAX[0] = A; BEND[0] = bend; } }
    local_state_mma_store(Lh, LT, tq, lane);
    __syncthreads();
}
__device__ __forceinline__ void fox_cumsum_item(LAS unsigned char* L, const float* G, const float* fox_bf, float* CF, int bh, int tid, int wave) {
    const int b = bh >> 3, h = bh & 7, lane = tid & 63; const float bf = fox_bf[h];
    float loc[16]; float s = 0.f;
#pragma unroll
    for (int i = 0; i < 16; ++i) { s += log_sigmoidf_(G[((size_t)b * SEQ + tid * 16 + i) * GW + 8 + h] + bf); loc[i] = s; }
    const float incl = wave_incl_add(s, lane);
    LAS float* wt = (LAS float*)(L + L_PART);
    if (lane == 63) wt[wave] = incl;
    __syncthreads();
    float off = incl - s;
#pragma unroll
    for (int w = 0; w < 8; ++w) if (w < wave) off += wt[w];
#pragma unroll
    for (int i = 0; i < 16; ++i) CF[(size_t)bh * SEQ + tid * 16 + i] = (off + loc[i]) * LOG2E;
    __syncthreads();
}

template <bool DUMMY = false> __device__ __forceinline__ void scan_c_block(unsigned char* sc, int j, int tid) {
    constexpr size_t DOFF = DUMMY ? 104 * MiB / 4 : 0;
    constexpr int CB = 32;
    if (j < 128) {
        if (tid < 128) { const int chain = j >> 4, e = (j & 15) * 256 + 2 * tid, b = chain >> 2, h = chain & 3;
            unsigned* p = (unsigned*)(sc + SC_LHG) + (((size_t)(b * 128) * 4 + h) * 4096 + e) / 2; const float2* dp = (const float2*)((const float*)(sc + SC_DEC) + ((size_t)(b * 128) * 4 + h) * 64 + (e & 63));
            float S0 = 0.f, S1 = 0.f;
            for (int c0 = 0; c0 < 128; c0 += CB) { unsigned Lc[CB]; float2 dc[CB];
#pragma unroll
                for (int i = 0; i < CB; ++i) { Lc[i] = p[(size_t)(c0 + i) * 4 * 2048]; dc[i] = dp[(size_t)(c0 + i) * 4 * 32]; }
#pragma unroll
                for (int i = 0; i < CB; ++i) { const float o0 = S0, o1 = S1; S0 = dc[i].x * S0 + __uint_as_float(Lc[i] << 16); S1 = dc[i].y * S1 + __uint_as_float(Lc[i] & 0xffff0000u); Lc[i] = pk2(o0, o1); }
#pragma unroll
                for (int i = 0; i < CB; ++i) (p + DOFF)[(size_t)(c0 + i) * 4 * 2048] = Lc[i]; } }
    } else {
        const int jj = j - 128, chain = jj >> 4, part = jj & 15, b = chain >> 2, h = chain & 3; const size_t it0 = (size_t)(b * 128) * 4 + h;
        const float* am = (const float*)(sc + SC_AMAX) + it0; const float* be = (const float*)(sc + SC_BEND) + it0; float* mp = (float*)(sc + SC_MPREV) + it0;
        if (tid < 128) {
            unsigned* p = (unsigned*)(sc + SC_LML) + (it0 * 4096 + part * 256 + 2 * tid) / 2;
            const bool writer = (part == 0 && tid == 0);
            float S0 = 0.f, S1 = 0.f, m = 0.f;
            for (int c0 = 0; c0 < 128; c0 += CB) { unsigned Lc[CB]; float A[CB], bb[CB];
#pragma unroll
                for (int i = 0; i < CB; ++i) { Lc[i] = p[(size_t)(c0 + i) * 4 * 2048]; A[i] = am[(c0 + i) * 4]; bb[i] = be[(c0 + i) * 4]; }
#pragma unroll
                for (int i = 0; i < CB; ++i) { const float Mx = fmaxf(m, A[i]), o0 = S0, o1 = S1, f0 = __expf(m - Mx), f1 = __expf(A[i] - Mx);
                    S0 = f0 * S0 + f1 * __uint_as_float(Lc[i] << 16); S1 = f0 * S1 + f1 * __uint_as_float(Lc[i] & 0xffff0000u); Lc[i] = pk2(o0, o1); A[i] = m; m = bb[i] + Mx; }
#pragma unroll
                for (int i = 0; i < CB; ++i) { (p + DOFF)[(size_t)(c0 + i) * 4 * 2048] = Lc[i]; if (writer) (mp + DOFF)[(c0 + i) * 4] = A[i]; } }
        } else if (tid >= 256 && tid < 260) {
            float* p = (float*)(sc + SC_NL) + it0 * 64 + part * 4 + (tid - 256);
            float S = 0.f, m = 0.f;
            for (int c0 = 0; c0 < 128; c0 += CB) { float Lc[CB], A[CB], bb[CB];
#pragma unroll
                for (int i = 0; i < CB; ++i) { Lc[i] = p[(size_t)(c0 + i) * 4 * 64]; A[i] = am[(c0 + i) * 4]; bb[i] = be[(c0 + i) * 4]; }
#pragma unroll
                for (int i = 0; i < CB; ++i) { const float Mx = fmaxf(m, A[i]), So = S; S = __expf(m - Mx) * S + __expf(A[i] - Mx) * Lc[i]; Lc[i] = So; m = bb[i] + Mx; }
#pragma unroll
                for (int i = 0; i < CB; ++i) (p + DOFF)[(size_t)(c0 + i) * 4 * 64] = Lc[i]; }
        }
    }
}

template <bool SIG> __device__ __forceinline__ void head_epilogue(LAS unsigned char* Lh, float inv, const v4u (&gw)[2]  , const float* gain  , bf16_t* out  , int tl) {
    const int t = tl / IW, v0 = (tl % IW) * CPT; const LAS float* o = (const LAS float*)(Lh + H_O) + t * OS + v0;
    float x[CPT]; float ss = 0.f;
#pragma unroll
    for (int i = 0; i < CPT; ++i) { x[i] = o[i] * inv; ss += x[i] * x[i]; }
#pragma unroll
    for (int m = 1; m < IW; m <<= 1) ss += __shfl_xor(ss, m);
    const float r = rsqrtf(ss * (1.f / 64.f) + EPS);
    const unsigned gu[8] = {gw[0].x, gw[0].y, gw[0].z, gw[0].w, gw[1].x, gw[1].y, gw[1].z, gw[1].w};
    float y[CPT];
#pragma unroll
    for (int i = 0; i < CPT; ++i) { const float gz = bf2f((bf16_t)((gu[i >> 1] >> (16 * (i & 1))) & 0xffff)); y[i] = x[i] * r * gain[i] * (SIG ? sigmoid_fast(gz) : silu_fast(gz)); }
    v4u w0, w1; w0.x = pk2(y[0], y[1]); w0.y = pk2(y[2], y[3]); w0.z = pk2(y[4], y[5]); w0.w = pk2(y[6], y[7]); w1.x = pk2(y[8], y[9]); w1.y = pk2(y[10], y[11]); w1.z = pk2(y[12], y[13]); w1.w = pk2(y[14], y[15]);
    *(v4u*)out = w0; *((v4u*)out + 1) = w1;
}
__device__ __forceinline__ void store_o_tiles(LAS unsigned char* Lh, LAS const unsigned char* A1, LAS const unsigned char* B1, LAS const unsigned char* A2, LAS const unsigned char* B2, int tq, int lane) {
#pragma unroll
    for (int nn = 0; nn < TPW; ++nn) { const int ti = tq * TPW + nn, mt = ti >> 2, nt = ti & 3; f32x4 acc = {0.f, 0.f, 0.f, 0.f};
        acc = mma64(A1, B1, mt * 16, nt * 16, lane, acc); acc = mma64(A2, B2, mt * 16, nt * 16, lane, acc);
        LAS float* o = (LAS float*)(Lh + H_O);
#pragma unroll
        for (int r = 0; r < 4; ++r) o[(mt * 16 + 4 * (lane >> 4) + r) * OS + nt * 16 + (lane & 15)] = acc[r]; }
}
__device__ __forceinline__ void hgrn_d_item(LAS unsigned char* Lh, const HgIn& R, float lb, const float* gain  , bf16_t* out  , int tl, int tq) {
    const int d = tl & 63, lane = tl & 63;
    float bl[TK], kk[TK], q[TK]; float run = 0.f;
#pragma unroll
    for (int i = 0; i < TK; ++i) { const float fz = BFP(R.fz, i); q[i] = BFP(R.q, i);
        float sg, omsg, lf; hgrn_gate(lb, fz, sg, omsg, lf); kk[i] = (1.f - lb) * omsg; run += lf; bl[i] = run; }
    LAS float* part = (LAS float*)(Lh + H_PART);
    part[tq * 64 + d] = run;
    store_state_tile(Lh + L_T4, R.s, tl);
    pack16h(Lh + L_T3 + d * TS + tq * (2 * TK), R.iv);
    __syncthreads();
    float off = 0.f, bref = 0.f;
#pragma unroll
    for (int w = 0; w < IW; ++w) { const float pv = part[w * 64 + d]; if (w < IW / 2) bref += pv; if (w < tq) off += pv; }
#pragma unroll
    for (int i = 0; i < TK; ++i) { const float bb = off + bl[i]; const int t = TK * tq + i;
        st16(Lh + L_T0 + t * TS + d * 2, q[i] * __expf(bb - bref));
        st16(Lh + L_T1 + t * TS + d * 2, kk[i] * __expf(bref - bb));
        st16(Lh + L_T2 + t * TS + d * 2, q[i] * __expf(bb)); }
    __syncthreads();
#pragma unroll
    for (int nn = 0; nn < TPW; ++nn) { const int ti = tq * TPW + nn, mt = ti >> 2, nt = ti & 3; f32x4 acc = {0.f, 0.f, 0.f, 0.f};
        acc = mma64(Lh + L_T1, Lh + L_T0, mt * 16, nt * 16, lane, acc);
        const int s0 = mt * 16 + 4 * (lane >> 4), t = nt * 16 + (lane & 15);
        v2u w; w.x = pk2(s0 <= t ? acc[0] : 0.f, s0 + 1 <= t ? acc[1] : 0.f); w.y = pk2(s0 + 2 <= t ? acc[2] : 0.f, s0 + 3 <= t ? acc[3] : 0.f);
        *(LAS v2u*)(Lh + L_T5 + t * TS + s0 * 2) = w; }
    __syncthreads();
    store_o_tiles(Lh, Lh + L_T5, Lh + L_T3, Lh + L_T2, Lh + L_T4, tq, lane);
    __syncthreads();
    { const int t = tl / IW, v0 = (tl % IW) * CPT; head_epilogue<false>(Lh, 1.f, R.gate, gain + v0, out + (size_t)t * D + v0, tl); }
    __syncthreads();
}
__device__ __forceinline__ void mlstm_d_item(LAS unsigned char* Lh, const MlIn& R, const float* conv, const float* b_i, const float* b_f, const float* gain  , int h, bf16_t* out  , int tl, int tq) {
    const int d = tl & 63, lane = tl & 63; const float mprev = R.mprev;
    float bcum, a; mlstm_gates(R.ig, R.fg, b_i, b_f, h, lane, bcum, a);
    const float M = fmaxf(wave_incl_max(a, lane), mprev), sint = __expf(mprev - M);
    LAS float* vec = (LAS float*)(Lh + H_VEC);
    if (tq == 0) { vec[lane] = a; vec[64 + lane] = M; vec[128 + lane] = __expf(-bcum - M); vec[192 + lane] = R.np; }
    float qc[TK], kc[TK];
    conv_silu_r(R.qr, conv + h * 64 + d, 1.f, qc);
    conv_silu_r(R.kr, conv + 256 + h * 64 + d, 0.125f, kc);
#pragma unroll
    for (int i = 0; i < TK; ++i) { const int t = TK * tq + i;
        st16(Lh + L_T0 + t * TS + d * 2, qc[i]);
        st16(Lh + L_T1 + t * TS + d * 2, kc[i]);
        st16(Lh + L_T2 + t * TS + d * 2, qc[i] * lane_bcast(sint, t)); }
    pack16h(Lh + L_T3 + d * TS + tq * (2 * TK), R.vv);
    store_state_tile(Lh + L_T4, R.s, tl);
    __syncthreads();
#pragma unroll
    for (int nn = 0; nn < TPW; ++nn) { const int ti = tq * TPW + nn, mt = ti >> 2, nt = ti & 3; f32x4 acc = {0.f, 0.f, 0.f, 0.f};
        acc = mma64(Lh + L_T1, Lh + L_T0, mt * 16, nt * 16, lane, acc);
        const int s0 = mt * 16 + 4 * (lane >> 4), t = nt * 16 + (lane & 15); const float Mt = vec[64 + t];
        float wv[4];
#pragma unroll
        for (int r = 0; r < 4; ++r) wv[r] = (s0 + r <= t) ? acc[r] * __expf(vec[s0 + r] - Mt) : 0.f;
        v2u w; w.x = pk2(wv[0], wv[1]); w.y = pk2(wv[2], wv[3]); *(LAS v2u*)(Lh + L_T5 + t * TS + s0 * 2) = w; }
    __syncthreads();
    float inv;
    { const int t = tl / IW, c0 = (tl % IW) * CPT; float den = 0.f;
#pragma unroll
      for (int hh = 0; hh < 2; ++hh) { const v4u pw = *(LAS const v4u*)(Lh + L_T5 + t * TS + (c0 + 8 * hh) * 2), qw = *(LAS const v4u*)(Lh + L_T2 + t * TS + (c0 + 8 * hh) * 2);
          const unsigned pu[4] = {pw.x, pw.y, pw.z, pw.w}, qu[4] = {qw.x, qw.y, qw.z, qw.w};
#pragma unroll
          for (int i = 0; i < 8; ++i) den += bf2f((bf16_t)((pu[i >> 1] >> (16 * (i & 1))) & 0xffff)) + bf2f((bf16_t)((qu[i >> 1] >> (16 * (i & 1))) & 0xffff)) * vec[192 + c0 + 8 * hh + i]; }
#pragma unroll
      for (int m = 1; m < IW; m <<= 1) den += __shfl_xor(den, m);
      inv = __builtin_amdgcn_rcpf(fmaxf(fabsf(den), vec[128 + t])); }
    store_o_tiles(Lh, Lh + L_T5, Lh + L_T3, Lh + L_T2, Lh + L_T4, tq, lane);
    __syncthreads();
    { const int t = tl / IW, c0 = (tl % IW) * CPT; head_epilogue<true>(Lh, inv, R.gate, gain + c0, out + (size_t)t * D + c0, tl); }
    __syncthreads();
}
}
constexpr int N_PHASES = 21;
template <int PH, bool REP = false> __device__ __forceinline__ void run_phase(const MArgs& a, LAS unsigned char* L, const int tid, const int wave, const int G, const int bx, const int vcu) {
    const int lane = tid & 63, gw = vcu * NWAVES + wave, NGW = G * NWAVES;
    unsigned char* ws = a.ws; bf16_t* X = (bf16_t*)a.out;
    bf16_t* X2 = (bf16_t*)(ws + WS_X2); (void)X2;
    int* ctl = (int*)(ws + WS_CTL); int* cnt = ctl + CW_CNT;
    float* Gt = (float*)(ws + WS_G); float* CF = (float*)(ws + WS_CF); int4* tokinfo = (int4*)(ws + WS_TOKINFO); float2* tgate = (float2*)(ws + WS_TGATE); int* toklist = (int*)(ws + WS_TOKLIST);
    bf16_t* P = (bf16_t*)(ws + WS_P); bf16_t* HID = (bf16_t*)(ws + WS_HID); signed char* H = (signed char*)(ws + WS_H); float* SH = (float*)(ws + WS_SH); bf16_t* MIX = (bf16_t*)(ws + WS_MIX);
    signed char* XG = (signed char*)(ws + WS_XG); float* SXG = (float*)(ws + WS_SXG); bf16_t* Y = (bf16_t*)(ws + WS_XG);
    LAS float* scr = (LAS float*)(L + RING_OFF + wave * 16384);
    (void)ctl; (void)Gt; (void)CF; (void)tokinfo; (void)tgate; (void)toklist; (void)P; (void)HID; (void)H; (void)SH; (void)SXG; (void)MIX; (void)XG; (void)Y; (void)scr; (void)cnt; (void)lane; (void)gw; (void)NGW;
    constexpr int p = PH, l = p >= 10 ? 1 : 0, k = p == 0 ? -1 : (l ? p - 10 : p - 1);
    if constexpr (p == 0) {
            LAS float* img = (LAS float*)(L + RING_OFF); LAS float* pm = (LAS float*)(L + LDSCTL_OFF + 1024);
            { auto job = [&](int it) { Conv8Job j; int r = it;
                  if (r < 224) { const int ll = r / 112, nb = r % 112, sc = 32 * nb + (nb >= 56 ? 8 : 0);
                      j.W = a.in[I_W_IN] + (size_t)ll * D * DIN + sc; j.ldw = DIN; j.WT8 = (signed char*)(ws + WS_WIN) + (size_t)ll * PW * D + (size_t)32 * nb * D; j.S = (float*)(ws + WS_SWIN) + ll * PW + 32 * nb; }
                  else { r -= 224; const int up = r / 88, nb = r % 88, c = 32 * nb;
                      j.W = (up ? a.in[I_DUP] : a.in[I_DGATE]) + c; j.ldw = FF; j.WT8 = (signed char*)(ws + WS_WDGU) + (size_t)glu_row(c, up) * D; j.S = (float*)(ws + WS_SWDGU) + glu_row(c, up); }
                  return j; };
              float v[64]; int it = vcu; if (it < 400) conv8_load(v, job(it), tid, wave);
              for (; it < 400; it += G) { const Conv8Job j = job(it); conv8_stage(v, img, pm, tid, wave); if (it + G < 400) conv8_load(v, job(it + G), tid, wave); conv8_quant(j, img, pm, tid, wave); } }
            { LAS unsigned* slot = (LAS unsigned*)(L + LDSCTL_OFF); LAS float* tab = (LAS float*)(L + RING_OFF); bool tabbed = false;
              for (;;) {
                  __syncthreads();
                  if (tid == 0) *slot = __hip_atomic_fetch_add((unsigned*)ctl + CW_PQ + (REP ? 1 : 0), 1u, __ATOMIC_RELAXED, __HIP_MEMORY_SCOPE_AGENT);
                  __syncthreads();
                  const int t = __builtin_amdgcn_readfirstlane((int)*(volatile LAS unsigned*)slot);
                  if (t >= 560) break;
                  if (t < 304) { int r = 8 * t + wave;
                      if (r < 1024) { const int ll = r / 512; r %= 512; const int kb = r / 32, nb = r % 32;
                          tr_item(a.in[I_W_OUT] + (size_t)ll * D * D + 32 * nb, D, D, (bf16_t*)(ws + WS_WOUT) + (size_t)ll * D * D + (size_t)32 * nb * D, scr, 64 * kb, lane); }
                      else { r -= 1024; const int kb = r / 32, nb = r % 32; tr_item(a.in[I_DDOWN] + 32 * nb, D, FF, (bf16_t*)(ws + WS_WDDN) + (size_t)32 * nb * FF, scr, 64 * kb, lane); } }
                  else {
                      if (!tabbed) { __syncthreads(); load_gate_tab(tab, a.in[I_W_IN], tid); __syncthreads(); tabbed = true; }
                      float lg[8]; RowIn R, Rn; const int row0 = (t - 304) * 64 + wave * 8; mrow_load<false>(R, a.in[I_X], row0, lane);
#pragma unroll 1
                      for (int i = 0; i < 8; ++i) { if (i < 7) mrow_load<false>(Rn, a.in[I_X], row0 + i + 1, lane); asm volatile("" ::: "memory");
                          mrow<0>(R, H, SH, a.in[I_ATTN_NORM], tab, Gt, row0 + i, lane, lg); if (i < 7) R = Rn; } }
              } }
        } else if constexpr (k == 0) {
            { const int cb = (G >= 144) ? bx - 128 : bx; for (int bh = cb; bh >= 0 && bh < 16; bh += G) scan::fox_cumsum_item(L, Gt, a.in[I_FOX_BF] + l * 8, CF, bh, tid, wave); }
            pg8::GOrder S; S.so.init(NTOK, PW, G, bx); S.A = (const char*)H; S.B = (const char*)(ws + WS_WIN) + (size_t)l * PW * D; S.a_tile = (size_t)256 * D; S.b_tile = (size_t)256 * D; S.b_exp = 0;
            S.tb1 = S.tb2 = S.tb3 = S.tb4 = S.tb5 = S.tb6 = S.tb7 = 0x7fffffff;
            pg8::EpiBf8 E; E.O = P; E.ldc = PW; E.s_lo = P_FQ / 256; E.s_hi = P_FK / 256; E.scale = QSCALE; E.sA = SH; E.sB = (const float*)(ws + WS_SWIN) + l * PW; E.sc = (LAS float*)(L + LDSCTL_OFF + 4096);
            pg8::Gemm g{D / 2};
            pg8::gemm_phase<pg8::EpiBf8, pg8::GOrder, true, true, 1>(L + RING_OFF, g, S, E);
            if constexpr (!REP) moe_fill(a, ws, scr, l ? 2 : 0, G, bx, wave, lane);
        } else if constexpr (l == 1 && k == 9) {
            pg8::GOrderTail S; pg8::EpiBfPart E; int t[8]; int acc = 0;
#pragma unroll
            for (int e = 0; e < NE; ++e) { t[e] = acc; acc += (cnt[e] + 255) >> 8; }
            S.init(acc, D, G, bx); S.A = (const char*)HID; S.B = (const char*)(ws + WS_WMDN); S.a_tile = (size_t)256 * FE; S.b_tile = (size_t)256 * FE; S.b_exp = (size_t)D * FE;
            S.tb1 = t[1]; S.tb2 = t[2]; S.tb3 = t[3]; S.tb4 = t[4]; S.tb5 = t[5]; S.tb6 = t[6]; S.tb7 = t[7]; E.O = Y; E.ldc = D; E.scale = 1.f / (pg8::F8_HSCALE * pg8::F8_WSCALE);
            pg8::Gemm g{FE / 2};
            pg8::gemm_phase<pg8::EpiBfPart, pg8::GOrderTail, true, true, 2>(L + RING_OFF, g, S, E);
        } else if constexpr (k == 4 || (l == 0 && k == 7)) {
            pg8::GOrder S; S.so.init(NTOK, D, G, bx); S.b_exp = 0; S.tb1 = S.tb2 = S.tb3 = S.tb4 = S.tb5 = S.tb6 = S.tb7 = 0x7fffffff; int K;
            if constexpr (k == 4) { K = D; S.A = (const char*)MIX; S.B = (const char*)(ws + WS_WOUT) + (size_t)l * D * D * 2; }
            else { K = FF; S.A = (const char*)HID; S.B = (const char*)(ws + WS_WDDN); }
            S.a_tile = (size_t)256 * K * 2; S.b_tile = (size_t)256 * K * 2;
            pg8::Gemm g{K};
            if constexpr (k == 4 && l == 0) { pg8::EpiResid<true> E{a.in[I_X], X, D}; pg8::gemm_phase<pg8::EpiResid<true>, pg8::GOrder, true, true>(L + RING_OFF, g, S, E); }
            else { pg8::EpiResid<false> E{X, (k == 4 && l == 1) ? X2 : X, D}; pg8::gemm_phase<pg8::EpiResid<false>, pg8::GOrder, true, true>(L + RING_OFF, g, S, E); }
        } else if constexpr (l == 0 && k == 6) {
            pg8::GOrder S; pg8::EpiSwiglu8<false> E; S.a_tile = (size_t)256 * D; S.b_tile = (size_t)256 * D; E.O = HID; E.sc = (LAS float*)(L + LDSCTL_OFF + 4096);
            S.so.init(NTOK, 2 * FF, G, bx); S.A = (const char*)H; S.B = (const char*)(ws + WS_WDGU); S.b_exp = 0; S.tb1 = S.tb2 = S.tb3 = S.tb4 = S.tb5 = S.tb6 = S.tb7 = 0x7fffffff;
            E.ldc = FF; E.sA = SH; E.sB = (const float*)(ws + WS_SWDGU); E.sb_exp = 0;
            E.tb1 = S.tb1; E.tb2 = S.tb2; E.tb3 = S.tb3; E.tb4 = S.tb4; E.tb5 = S.tb5; E.tb6 = S.tb6; E.tb7 = S.tb7;
            pg8::Gemm g{D / 2};
            pg8::gemm_phase<pg8::EpiSwiglu8<false>, pg8::GOrder, true, true, 1>(L + RING_OFF, g, S, E);
            if constexpr (!REP) moe_fill(a, ws, scr, 1, G, bx, wave, lane);
        } else if constexpr (l == 1 && k == 7) {
            pg8::GOrder S; pg8::EpiSwigluF8 E; S.a_tile = (size_t)256 * D; S.b_tile = (size_t)256 * D; E.O = (unsigned char*)HID; E.ldc = FE;
            int t[8]; int acc = 0;
#pragma unroll
            for (int e = 0; e < NE; ++e) { t[e] = acc; acc += (cnt[e] + 255) >> 8; }
            S.so.init(acc * 256, 2 * FE, G, bx); S.A = (const char*)XG; S.B = (const char*)(ws + WS_WMGU); S.b_exp = (size_t)2 * FE * D;
            S.tb1 = t[1]; S.tb2 = t[2]; S.tb3 = t[3]; S.tb4 = t[4]; S.tb5 = t[5]; S.tb6 = t[6]; S.tb7 = t[7];
            pg8::Gemm g{D / 2};
#ifdef EXP_NULL_EPI
            if constexpr (REP) { pg8::EpiNull E0; E0.O = (unsigned char*)HID; E0.ldc = FE; pg8::gemm_phase<pg8::EpiNull, pg8::GOrder, true, true, 2>(L + RING_OFF, g, S, E0); } else
#endif
            pg8::gemm_phase<pg8::EpiSwigluF8, pg8::GOrder, true, true, 2>(L + RING_OFF, g, S, E);
            if constexpr (!REP) { const int ni = moe_tail_idle(cnt, G), ci = bx - (256 - ni);
                if (ni && ci >= 0) { const int first = MOE_ITEMS - ni * NWAVES * MOE_FILL17 + ci * NWAVES + wave; moe_conv_range(a, ws, scr, first, ni * NWAVES, MOE_ITEMS, lane); } }
        } else if constexpr (k == 5 && l == 0) {
            float lg[8];
            { RowIn R, Rn; int row = gw; if (row < NTOK) mrow_load<true>(R, X, row, lane);
              for (; row < NTOK; row += NGW) { const int nx = row + NGW; if (nx < NTOK) mrow_load<true>(Rn, X, nx, lane); asm volatile("" ::: "memory");
                  mrow<1>(R, H, SH, a.in[I_FFN_NORM], nullptr, nullptr, row, lane, lg); if (nx < NTOK) R = Rn; } }
        } else if constexpr (k == 8 && l == 0) {
            LAS float* tab = (LAS float*)(L + RING_OFF); load_gate_tab(tab, a.in[I_W_IN] + (size_t)D * DIN, tid); __syncthreads();
            float lg[8];
            { RowIn R, Rn; int row = gw; if (row < NTOK) mrow_load<true>(R, X, row, lane);
              for (; row < NTOK; row += NGW) { const int nx = row + NGW; if (nx < NTOK) mrow_load<true>(Rn, X, nx, lane); asm volatile("" ::: "memory");
                  mrow<0>(R, H, SH, a.in[I_ATTN_NORM] + D, tab, Gt, row, lane, lg); if (nx < NTOK) R = Rn; } }
        } else if constexpr (k == 5 && l == 1) {
            LAS int* sel_e = (LAS int*)(L + RING_OFF);
            LAS float* sel_g = (LAS float*)(L + RING_OFF + 512);
            LAS int* lcnt = (LAS int*)(L + RING_OFF + 1024);
            LAS float* tab = (LAS float*)(L + RING_OFF + 4096); load_router_tab(tab, a.in[I_ROUTER], tid); __syncthreads();
            for (int rb = bx; rb < NTOK / 64; rb += G) {
                if (tid < 16) lcnt[tid] = 0;
                RowIn R, Rn; mrow_load<true>(R, X2, rb * 64 + wave * 8, lane);
                for (int i = 0; i < 8; ++i) { const int rl = wave * 8 + i, row = rb * 64 + rl; float lg[8];
                    if (i < 7) mrow_load<true>(Rn, X2, row + 1, lane); asm volatile("" ::: "memory");
                    mrow<2>(R, H, SH, a.in[I_FFN_NORM] + D, tab, nullptr, row, lane, lg); if (i < 7) R = Rn;
                    if (lane == 0) { const float v0 = lg[0], v1 = lg[1]; const int e0 = __float_as_int(lg[2]), e1 = __float_as_int(lg[3]);
                        const float g1 = 1.f / (1.f + __expf(v0 - v1));
                        sel_e[2 * rl] = e0; sel_e[2 * rl + 1] = e1; sel_g[2 * rl] = 1.f - g1; sel_g[2 * rl + 1] = g1; } }
                __syncthreads();
                int e0 = 0, e1 = 0, r0 = 0, r1 = 0;
                if (tid < 64) { e0 = sel_e[2 * tid]; e1 = sel_e[2 * tid + 1]; r0 = __hip_atomic_fetch_add(lcnt + e0, 1, __ATOMIC_RELAXED, __HIP_MEMORY_SCOPE_WORKGROUP); r1 = __hip_atomic_fetch_add(lcnt + e1, 1, __ATOMIC_RELAXED, __HIP_MEMORY_SCOPE_WORKGROUP); }
                __syncthreads();
                if (tid < 8) lcnt[8 + tid] = atomicAdd(cnt + tid, (int)lcnt[tid]);
                __syncthreads();
                if (tid < 64) { const int row = rb * 64 + tid, s0 = lcnt[8 + e0] + r0, s1 = lcnt[8 + e1] + r1;
                    toklist[e0 * NTOK + s0] = row; toklist[e1 * NTOK + s1] = row; tokinfo[row] = make_int4(e0, s0, e1, s1); tgate[row] = make_float2(sel_g[2 * tid], sel_g[2 * tid + 1]); }
                __syncthreads();
            }
        } else if constexpr (k == 6 && l == 1) {
            { int base[NE]; int acc = 0;
#pragma unroll
              for (int e = 0; e < NE; ++e) { base[e] = acc; acc += (cnt[e] + 255) & ~255; }
              for (int r = gw; r < acc; r += NGW) { int e = 0, be = 0;
#pragma unroll
                  for (int c = 1; c < NE; ++c) if (r >= base[c]) { e = c; be = base[c]; }
                  const int s = r - be; v4u v0 = {0u, 0u, 0u, 0u}; float sv = 0.f;
                  if (s < cnt[e]) { const int tok = toklist[e * NTOK + s]; v0 = *((const v4u*)(H + (size_t)tok * D) + lane); sv = SH[tok]; }
                  *((v4u*)(XG + (size_t)r * D) + lane) = v0; if (lane == 0) SXG[r] = sv; } }
            moe_conv_range(a, ws, scr, moe_prefilled(G) + gw, NGW, MOE_ITEMS - moe_tail_idle(cnt, G) * NWAVES * MOE_FILL17, lane);
        } else if constexpr (k == 8 && l == 1) {
        } else if constexpr (l == 1 && k == 10) {
            int base[NE]; { int acc = 0;
#pragma unroll
              for (int e = 0; e < NE; ++e) { base[e] = acc; acc += (cnt[e] + 255) & ~255; } }
            constexpr int HALFR = NTOK; constexpr int rlo = 0;
            const bf16_t* Xs = X2;
            float* out = (float*)a.out;
            struct FA { uint2 v[4]; int4 ti; float2 tg; }; struct FB { uint2 y0[4], y1[4]; };
            auto loadA = [&](FA& A, int rr) { const uint2* xr = (const uint2*)(Xs + (size_t)rr * D) + lane;
#pragma unroll
                for (int j = 0; j < 4; ++j) A.v[j] = xr[64 * j];
                A.ti = tokinfo[rlo + rr]; A.tg = tgate[rlo + rr]; };
            auto ldrow = [&](uint2 (&y)[4], int r) {
                if ((r >> 8) < pg8::GOrderTail::MAIN_M) { const uint2* p = (const uint2*)(Y + (size_t)r * D) + lane;
#pragma unroll
                    for (int j = 0; j < 4; ++j) y[j] = p[64 * j]; }
                else { float s[16];
#pragma unroll
                    for (int i = 0; i < 16; ++i) s[i] = 0.f;
#pragma unroll 2
                    for (int kp = 0; kp < 8; ++kp) { const uint2* p = (const uint2*)(Y + (size_t)((pg8::EpiBfPart::YP_TILE0 + kp * 8 + (r >> 8) - pg8::GOrderTail::MAIN_M) * 256 + (r & 255)) * D) + lane;
#pragma unroll
                        for (int j = 0; j < 4; ++j) { const uint2 q = p[64 * j]; s[4 * j] += __uint_as_float(q.x << 16); s[4 * j + 1] += __uint_as_float(q.x & 0xffff0000u); s[4 * j + 2] += __uint_as_float(q.y << 16); s[4 * j + 3] += __uint_as_float(q.y & 0xffff0000u); } }
#pragma unroll
                    for (int j = 0; j < 4; ++j) { y[j].x = pk2(s[4 * j], s[4 * j + 1]); y[j].y = pk2(s[4 * j + 2], s[4 * j + 3]); } } };
            auto loadB = [&](FB& B, const FA& A) { int b0 = 0, b1 = 0;
#pragma unroll
                for (int c = 0; c < NE; ++c) { if (c == A.ti.x) b0 = base[c]; if (c == A.ti.z) b1 = base[c]; }
                ldrow(B.y0, b0 + A.ti.y); ldrow(B.y1, b1 + A.ti.w); };
            FA A0, A1, A2; FB B0, B1; int rr = gw;
            if (rr < HALFR) { loadA(A0, rr); if (rr + NGW < HALFR) loadA(A1, rr + NGW); loadB(B0, A0); }
            for (; rr < HALFR; rr += NGW) {
                const bool h1 = rr + NGW < HALFR, h2 = rr + 2 * NGW < HALFR;
                if (h2) loadA(A2, rr + 2 * NGW);
                if (h1) loadB(B1, A1);
                asm volatile("" ::: "memory");
                float4 v[4]; const float2 tg = A0.tg;
#pragma unroll
                for (int j = 0; j < 4; ++j) { const uint2 q = B0.y0[j], c = B0.y1[j], x = A0.v[j];
                    v[j].x = __uint_as_float(x.x << 16) + tg.x * bf2f((bf16_t)(q.x & 0xffff)) + tg.y * bf2f((bf16_t)(c.x & 0xffff)); v[j].y = __uint_as_float(x.x & 0xffff0000u) + tg.x * bf2f((bf16_t)(q.x >> 16)) + tg.y * bf2f((bf16_t)(c.x >> 16));
                    v[j].z = __uint_as_float(x.y << 16) + tg.x * bf2f((bf16_t)(q.y & 0xffff)) + tg.y * bf2f((bf16_t)(c.y & 0xffff)); v[j].w = __uint_as_float(x.y & 0xffff0000u) + tg.x * bf2f((bf16_t)(q.y >> 16)) + tg.y * bf2f((bf16_t)(c.y >> 16)); }
                float ss = 0.f;
#pragma unroll
                for (int j = 0; j < 4; ++j) ss += v[j].x * v[j].x + v[j].y * v[j].y + v[j].z * v[j].z + v[j].w * v[j].w;
                ss = wave_sum(ss); const float r = rsqrtf(ss * (1.f / D) + EPS);
                float4* xo = (float4*)(out + (size_t)(rlo + rr) * D) + lane;
#pragma unroll
                for (int j = 0; j < 4; ++j) { const float4 g = *((const float4*)a.in[I_FINAL_NORM] + 64 * j + lane); xo[64 * j] = make_float4(v[j].x * r * g.x, v[j].y * r * g.y, v[j].z * r * g.z, v[j].w * r * g.w); }
                if (h1) { A0 = A1; B0 = B1; } if (h2) A1 = A2;
            }
        } else {
            if constexpr (k == 1) {
                unsigned char* sc = ws + WS_SCAN; const int wv = wave;
#define ITEM_DECODE(it_) const int item = (it_) & 1023, h = item & 3, c = (item >> 2) & 127, b = item >> 9
#define HG_LB(h_) (l == 0 ? 0.f : 1.f / (1.f + __expf(a.in[I_HGRN_LB][(h_) * 64 + (tl & 63)] - a.in[I_HGRN_LB][256 + (h_) * 64 + (tl & 63)])))
                const int hf = wave >> 2, tq4 = wave & 3; LAS unsigned char* Lh = L + hf * scan::HLDS;
                { scan::HgIn R, Rn;
                  auto itemOf = [&](int pp) { const int it = bx + (2 * pp + hf) * G; return it < 1024 ? it : it - G; };
                  int pp = 0; if (bx < 1024) { ITEM_DECODE(itemOf(0)); scan::hgrn_load<false>(R, P, b, c, h, nullptr, tid & 255, tq4); }
                  for (; bx + 2 * pp * G < 1024; ++pp) { const bool nx = bx + 2 * (pp + 1) * G < 1024; int tl = tid & 255; asm volatile("" : "+v"(tl));
                      if (nx) { ITEM_DECODE(itemOf(pp + 1)); scan::hgrn_load<false>(Rn, P, b, c, h, nullptr, tl, tq4); }
                      asm volatile("" ::: "memory");
                      { ITEM_DECODE(itemOf(pp)); (void)b; (void)c; scan::hgrn_b_item(Lh, R, HG_LB(h), (bf16_t*)(sc + scan::SC_LHG) + (size_t)item * 4096, (float*)(sc + scan::SC_DEC) + item * 64, tl, tq4); }
                      if (nx) R = Rn; } }
                { scan::MlIn R, Rn; int base = bx; while (base < 1024) base += G;
                  auto itemOf = [&](int pp) { const int it = base + (2 * pp + hf) * G; return it < 2048 ? it : it - G; };
                  int pp = 0; if (base < 2048) { ITEM_DECODE(itemOf(0)); scan::mlstm_load<false>(R, P, Gt, b, c, h, nullptr, nullptr, nullptr, tid & 255, tq4); }
                  for (; base + 2 * pp * G < 2048; ++pp) { const bool nx = base + 2 * (pp + 1) * G < 2048; int tl = tid & 255; asm volatile("" : "+v"(tl));
                      if (nx) { ITEM_DECODE(itemOf(pp + 1)); scan::mlstm_load<false>(Rn, P, Gt, b, c, h, nullptr, nullptr, nullptr, tl, tq4); }
                      asm volatile("" ::: "memory");
                      { ITEM_DECODE(itemOf(pp)); (void)b; (void)c; scan::mlstm_b_item(Lh, R, a.in[I_MLSTM_CONV] + l * 2048, a.in[I_MLSTM_BI] + l * 4, a.in[I_MLSTM_BF] + l * 4, h, (bf16_t*)(sc + scan::SC_LML) + (size_t)item * 4096,
                                            (float*)(sc + scan::SC_NL) + item * 64, (float*)(sc + scan::SC_AMAX) + item, (float*)(sc + scan::SC_BEND) + item, tl, tq4); }
                      if (nx) R = Rn; } }
                { LAS unsigned* lst = (LAS unsigned*)(L + LDSCTL_OFF + 64);
                  if (tid < 48) lst[tid] = 0u; __syncthreads();
                  float mq0 = 0.f, mq1 = 0.f, mk0 = 0.f, mk1 = 0.f, md0 = 0.f, md1 = 0.f;
                  for (int row = gw; row < NTOK; row += NGW) {
                      const v4u wq = *((const v4u*)(P + (size_t)row * PW + P_FQ) + lane), wk = *((const v4u*)(P + (size_t)row * PW + P_FK) + lane);
                      float sq = 0.f, sk = 0.f, sd = 0.f;
#pragma unroll
                      for (int i = 0; i < 4; ++i) { const float q0 = bf2f((bf16_t)(wq[i] & 0xffff)), q1 = bf2f((bf16_t)(wq[i] >> 16)), k0 = bf2f((bf16_t)(wk[i] & 0xffff)), k1 = bf2f((bf16_t)(wk[i] >> 16));
                          sq += q0 * q0 + q1 * q1; sk += k0 * k0 + k1 * k1; sd += q0 * k0 + q1 * k1; }
                      sq += __shfl_xor(sq, 1); sq += __shfl_xor(sq, 2); sq += __shfl_xor(sq, 4); sk += __shfl_xor(sk, 1); sk += __shfl_xor(sk, 2); sk += __shfl_xor(sk, 4);
                      sd += __shfl_xor(sd, 1); sd += __shfl_xor(sd, 2); sd += __shfl_xor(sd, 4); sd = fmaxf(-sd, 0.f);
                      if (row < SEQ) { mq0 = fmaxf(mq0, sq); mk0 = fmaxf(mk0, sk); md0 = fmaxf(md0, sd); } else { mq1 = fmaxf(mq1, sq); mk1 = fmaxf(mk1, sk); md1 = fmaxf(md1, sd); } }
                  if ((lane & 7) == 0) { const int hh = lane >> 3;
                      __hip_atomic_fetch_max(lst + hh * 2, __float_as_uint(mq0), __ATOMIC_RELAXED, __HIP_MEMORY_SCOPE_WORKGROUP); __hip_atomic_fetch_max(lst + hh * 2 + 1, __float_as_uint(mk0), __ATOMIC_RELAXED, __HIP_MEMORY_SCOPE_WORKGROUP);
                      __hip_atomic_fetch_max(lst + 16 + hh * 2, __float_as_uint(mq1), __ATOMIC_RELAXED, __HIP_MEMORY_SCOPE_WORKGROUP); __hip_atomic_fetch_max(lst + 16 + hh * 2 + 1, __float_as_uint(mk1), __ATOMIC_RELAXED, __HIP_MEMORY_SCOPE_WORKGROUP);
                      __hip_atomic_fetch_max(lst + 32 + hh, __float_as_uint(md0), __ATOMIC_RELAXED, __HIP_MEMORY_SCOPE_WORKGROUP); __hip_atomic_fetch_max(lst + 40 + hh, __float_as_uint(md1), __ATOMIC_RELAXED, __HIP_MEMORY_SCOPE_WORKGROUP); }
                  __syncthreads();
                  if (tid < 32) __hip_atomic_fetch_max((unsigned*)ctl + CW_STAT + l * 32 + tid, lst[tid], __ATOMIC_RELAXED, __HIP_MEMORY_SCOPE_AGENT);
                  else if (tid < 48) __hip_atomic_fetch_max((unsigned*)ctl + CW_STAT3 + l * 16 + (tid - 32), lst[tid], __ATOMIC_RELAXED, __HIP_MEMORY_SCOPE_AGENT); }
            } else if constexpr (k == 2) {
                for (int j = bx; j < 256; j += G) scan::scan_c_block<REP>(ws + WS_SCAN, j, tid);
            } else if constexpr (k == 3) {
                static_assert(attn_body::ATTN_LDS_BYTES <= RING_BYTES, "attention LDS");
                unsigned char* sc = ws + WS_SCAN; const int wv = wave;
                const float* stat = (const float*)(ctl + CW_STAT + l * 32);
                LAS unsigned* slot = (LAS unsigned*)(L + LDSCTL_OFF);
                int v;
                for (;;) {
                    if (tid == 0) *slot = __hip_atomic_fetch_add((unsigned*)ctl + CW_QCTR + l + (REP ? 2 : 0), 1u, __ATOMIC_RELAXED, __HIP_MEMORY_SCOPE_AGENT);
                    __syncthreads();
                    v = __builtin_amdgcn_readfirstlane((int)*(volatile LAS unsigned*)slot);
                    if (v >= 736) break;
                    int qb, bh, part = 0; float* PART = nullptr;
                    if (v < 448) { qb = 31 - (v >> 5); bh = v & 15; part = (v >> 4) & 1; PART = (float*)(ws + WS_SCAN + (40 + 32 * l) * MiB) + (size_t)(bh * 14 + (qb - 18)) * 2 * attn_body::PART_F; }
                    else { const int u2 = v - 448; qb = 17 - (u2 >> 4); bh = u2 & 15; }
                    const float Tsk = 30.f + (__builtin_sqrtf(stat[bh * 2] * stat[bh * 2 + 1]) + ((const float*)(ctl + CW_STAT3 + l * 16))[bh]) * 1.01f + 1.f;
                    attn_body::attn_unit<8>(bh >> 3, bh & 7, qb, (const attn_body::bf16*)(P + P_FQ), (const attn_body::bf16*)(P + P_FK), (const attn_body::bf16*)(P + P_FV), (attn_body::bf16*)(MIX + 512), CF + (size_t)bh * SEQ, Tsk,
                                            part, PART, (unsigned*)ctl + CW_AFLAG + (l + (REP ? 2 : 0)) * 512 + bh * 32 + qb, (char*)L + RING_OFF);
                    __syncthreads();
                }
                int tid2 = tid; asm volatile("" : "+v"(tid2));
                while (v < 736 + 384 + 256) {
                    const int it0 = v < 1120 ? (v - 736) * 4 : 1536 + (v - 1120) * 2, nj = v < 1120 ? 2 : 1;
                    const int hf = wv >> 2, tq4 = wv & 3; LAS unsigned char* Lh = L + hf * scan::HLDS;
#pragma unroll 1
                    for (int j = 0; j < nj; ++j) { const int it = it0 + 2 * j + hf; int tl = tid2 & 255; asm volatile("" : "+v"(tl)); ITEM_DECODE(it);
                        if (it0 < 1024) { scan::HgIn R; scan::hgrn_load<true>(R, P, b, c, h, (const bf16_t*)(sc + scan::SC_LHG) + (size_t)item * 4096, tl, tq4);
                            const float lb = l == 0 ? 0.f : 1.f / (1.f + __expf(a.in[I_HGRN_LB][h * 64 + (tl & 63)] - a.in[I_HGRN_LB][256 + h * 64 + (tl & 63)]));
                            scan::hgrn_d_item(Lh, R, lb, a.in[I_HGRN_NORM] + l * 256 + h * 64, MIX + (size_t)(b * SEQ + c * 64) * D + h * 64, tl, tq4); }
                        else { scan::MlIn R; scan::mlstm_load<true>(R, P, Gt, b, c, h, (const bf16_t*)(sc + scan::SC_LML) + (size_t)item * 4096, (const float*)(sc + scan::SC_NL) + item * 64, (const float*)(sc + scan::SC_MPREV) + item, tl, tq4);
                            scan::mlstm_d_item(Lh, R, a.in[I_MLSTM_CONV] + l * 2048, a.in[I_MLSTM_BI] + l * 4, a.in[I_MLSTM_BF] + l * 4, a.in[I_MLSTM_NORM] + l * 256 + h * 64, h, MIX + (size_t)(b * SEQ + c * 64) * D + 256 + h * 64, tl, tq4); } }
                    __syncthreads();
                    if (tid2 == 0) *slot = __hip_atomic_fetch_add((unsigned*)ctl + CW_QCTR + l + (REP ? 2 : 0), 1u, __ATOMIC_RELAXED, __HIP_MEMORY_SCOPE_AGENT);
                    __syncthreads();
                    v = __builtin_amdgcn_readfirstlane((int)*(volatile LAS unsigned*)slot);
                }
            }

        }
}
__global__ void __launch_bounds__(NTHR, 2) mega(MArgs a) {
    extern __shared__ __attribute__((aligned(16))) unsigned char lds[];
    LAS unsigned char* L = (LAS unsigned char*)lds;
    volatile LAS unsigned* MISC = (volatile LAS unsigned*)(L + MISC_OFF);
    const int tid = threadIdx.x, wave = __builtin_amdgcn_readfirstlane(tid >> 6);
    const int G = gridDim.x, bx = blockIdx.x, vcu = (G % 8 == 0) ? (bx % 8) * (G / 8) + bx / 8 : bx;
    for (int u = tid; u < (LDS_BYTES - LDSCTL_OFF) / 4; u += NTHR) ((LAS unsigned*)(L + LDSCTL_OFF))[u] = 0u;
    __syncthreads();
    const int lo = a.ph_lo, hi = a.ph_hi;
    XcdBarrier bar; bar.bar = (unsigned*)(a.ws + WS_CTL) + CW_BAR; bar.x = 0; bar.st = nullptr;
    if (hi - lo > 1) bar = xcd_barrier_post((unsigned*)(a.ws + WS_CTL) + CW_BAR, MISC + 8);
#ifndef REPEAT_MASK
#define REPEAT_MASK 0u
#endif
#define PHASE(k) if (lo <= (k) && (k) < hi) { run_phase<k>(a, L, tid, wave, G, bx, vcu); if constexpr ((REPEAT_MASK >> (k)) & 1u) { xcd_barrier(bar); run_phase<k, true>(a, L, tid, wave, G, bx, vcu); } if ((k) + 1 < hi) xcd_barrier(bar); }
    PHASE(0) PHASE(1) PHASE(2) PHASE(3) PHASE(4) PHASE(5) PHASE(6) PHASE(7) PHASE(8) PHASE(9) PHASE(10)
    PHASE(11) PHASE(12) PHASE(13) PHASE(14) PHASE(15) PHASE(16) PHASE(17) PHASE(19) PHASE(20)
#undef PHASE
}
#ifndef MEGA_MASK
#define MEGA_MASK 0x1FFFFFu
#endif
#ifndef FUSE_RUNS
#define FUSE_RUNS 1
#endif
extern "C" void kernel_launch(void* const* d_in, const int* in_sizes, int n_in, void* d_out, int out_size, void* d_ws, size_t ws_size, hipStream_t stream) {
    static int grid = 0;
    if (grid == 0) {
        if (n_in != 20 || ws_size < WS_END || out_size != NTOK * D) { fprintf(stderr, "kernel_launch: unexpected n_in %d / ws %zu / out %d\n", n_in, ws_size, out_size); grid = -1; return; }
        int dev = 0, cus = 0, per_cu = 0;
        if (hipGetDevice(&dev) != hipSuccess || hipDeviceGetAttribute(&cus, hipDeviceAttributeMultiprocessorCount, dev) != hipSuccess) { grid = -1; return; }
        if (hipFuncSetAttribute((const void*)mega, hipFuncAttributeMaxDynamicSharedMemorySize, LDS_BYTES) != hipSuccess) { fprintf(stderr, "kernel_launch: hipFuncSetAttribute failed\n"); grid = -1; return; }
        if (hipOccupancyMaxActiveBlocksPerMultiprocessor(&per_cu, (const void*)mega, NTHR, LDS_BYTES) != hipSuccess || per_cu < 1) { fprintf(stderr, "kernel_launch: occupancy query says %d\n", per_cu); per_cu = 1; }
        (void)hipGetLastError();
        grid = cus;
        if (grid > 256) grid = 256;
    }
    if (grid < 0) return;
    const float* const* in = (const float* const*)d_in;
    unsigned char* ws = (unsigned char*)d_ws; float* X = (float*)d_out;
    (void)hipMemsetAsync(ws + WS_CTL, 0, CTL_BYTES, stream);
    MArgs ma; memset(&ma, 0, sizeof ma);
    for (int i = 0; i < 20; ++i) ma.in[i] = in[i];
    ma.out = X; ma.ws = ws;
    ma.ph_lo = 0; ma.ph_hi = N_PHASES;
    hipLaunchKernelGGL(mega, dim3(grid), dim3(NTHR), LDS_BYTES, stream, ma);
}
```

```cpp
#include <hip/hip_runtime.h>
#include <hip/hip_bf16.h>
#include <cstdint>
#include <cstdio>
#include <cstring>

namespace cfg {
constexpr int NTOK = 16384, D = 1024, SEQ = 8192, NB = 2, DIN = 3600, PW = 3584, GW = 16;
constexpr int FF = 2816, FE = 3584, NE = 8, MAXROWS = 34816;
constexpr float EPS = 1e-6f;
constexpr float LOG2E = 1.4426950408889634f;
constexpr float QSCALE = 0.125f * LOG2E;
constexpr int P_HQ = 0, P_HF = 256, P_HI = 512, P_HG = 768, P_MQ = 1024, P_MK = 1280, P_MV = 1536, P_MO = 1792, P_FQ = 2048, P_FK = 2560, P_FV = 3072;
constexpr size_t MiB = 1u << 20;
constexpr size_t WS_CTL = 0, CTL_BYTES = 1 * MiB;
constexpr size_t WS_G = 2 * MiB;
constexpr size_t WS_CF = 3 * MiB;
constexpr size_t WS_TOKINFO = 3 * MiB + 512 * 1024;
constexpr size_t WS_TGATE = 3 * MiB + 768 * 1024;
constexpr size_t WS_TOKLIST = 4 * MiB;
constexpr size_t WS_P = 8 * MiB;
constexpr size_t WS_SCAN = 120 * MiB;
constexpr size_t WS_HID = 8 * MiB;
constexpr size_t WS_H = 246 * MiB;
constexpr size_t WS_MIX = 278 * MiB;
constexpr size_t WS_XG = 278 * MiB;
constexpr size_t WS_W = 346 * MiB;
constexpr size_t WS_Y = 346 * MiB;
constexpr size_t WS_X2 = 130 * MiB;
constexpr size_t WS_PB = 164 * MiB;
constexpr size_t WS_END = 466 * MiB;
constexpr int CW_CNT = 64;
constexpr int CW_STAT = 128;
constexpr int CW_STAT3 = 192;
constexpr int CW_QCTR = 256;
constexpr int CW_PQ = 262;
constexpr int CW_TFLAG = 384;
constexpr int CW_AFLAG = 512;
}
using namespace cfg;
typedef unsigned short bf16_t;

__device__ __forceinline__ bf16_t f2bf(float f) { unsigned u = __builtin_bit_cast(unsigned, f); return (bf16_t)((u + 0x7fffu + ((u >> 16) & 1u)) >> 16); }
__device__ __forceinline__ float bf2f(bf16_t h) { return __builtin_bit_cast(float, (unsigned)h << 16); }
#define DPP_F(old_, v_, ctrl_, rmask_) __int_as_float(__builtin_amdgcn_update_dpp(__float_as_int(old_), __float_as_int(v_), ctrl_, rmask_, 0xf, false))
__device__ __forceinline__ float wave_sum(float v) {
    v += DPP_F(0.f, v, 0xB1, 0xf); v += DPP_F(0.f, v, 0x4E, 0xf); v += DPP_F(0.f, v, 0x141, 0xf); v += DPP_F(0.f, v, 0x140, 0xf);
    v += DPP_F(0.f, v, 0x142, 0xa); v += DPP_F(0.f, v, 0x143, 0xc);
    return __int_as_float(__builtin_amdgcn_readlane(__float_as_int(v), 63));
}
__device__ __forceinline__ float wave_max_nn(float v) {
    v = fmaxf(v, DPP_F(0.f, v, 0xB1, 0xf)); v = fmaxf(v, DPP_F(0.f, v, 0x4E, 0xf)); v = fmaxf(v, DPP_F(0.f, v, 0x141, 0xf)); v = fmaxf(v, DPP_F(0.f, v, 0x140, 0xf));
    v = fmaxf(v, DPP_F(0.f, v, 0x142, 0xa)); v = fmaxf(v, DPP_F(0.f, v, 0x143, 0xc));
    return __int_as_float(__builtin_amdgcn_readlane(__float_as_int(v), 63));
}
__device__ __forceinline__ float sigmoidf_(float z) { return 1.f / (1.f + __expf(-z)); }
__device__ __forceinline__ float siluf_(float z) { return z / (1.f + __expf(-z)); }
__device__ __forceinline__ float log_sigmoidf_(float z) { return fminf(z, 0.f) - log1pf(__expf(-fabsf(z))); }

__device__ __forceinline__ int moe_bases(const int* cnt, int* base) {
    int acc = 0;
#pragma unroll
    for (int e = 0; e < NE; ++e) { base[e] = acc; acc += (cnt[e] + 255) & ~255; }
    return acc;
}

namespace pg8 {
#define PG8_LAS __attribute__((address_space(3)))
typedef unsigned short bf16_t;
typedef short bf16x8 __attribute__((ext_vector_type(8)));
typedef float f32x4 __attribute__((ext_vector_type(4)));
typedef unsigned u32x4 __attribute__((ext_vector_type(4)));
constexpr int BM = 256, BK = 64, HALF = 128, HTB = HALF * BK * 2  , STAGE_BYTES = 8 * HTB, NXCD = 8, WGM = 8;

__host__ __device__ __forceinline__ int lds_byte(int r, int c) { const int st = (r >> 4) * 2 + (c >> 5), rr = r & 15, cc = c & 31, ob = rr * 64 + cc * 2; return st * 1024 + (ob ^ (((ob >> 9) & 1) << 5)); }
__host__ __device__ __forceinline__ void stage_rc(int b, int& R, int& C) { const int st = b / 1024, sb = b % 1024, swz = sb ^ (((sb >> 9) & 1) << 5); R = (st >> 1) * 16 + swz / 64; C = (st & 1) * 32 + (swz % 64) / 2; }
__host__ __device__ __forceinline__ int perm32(int rho) { const int n = rho >> 4, i = rho & 15; return 8 * (i >> 2) + 4 * n + (i & 3); }

struct Unit { int pm, pn, tq; };
struct Gemm { int K; };

struct StaticOrder {
    int nM, nN, nwg, G, c;
    __host__ __device__ void init(int M, int N, int G_, int c_) { nM = M / BM; nN = N / BM; nwg = nM * nN; G = G_; c = c_; }
    __host__ __device__ bool next(int i, Unit& u) const {
        const long L = (long)i * G + c; if (L >= nwg) return false;
        int wgid = (int)L; { const int q = nwg / NXCD, r = nwg % NXCD, xcd = wgid % NXCD, off = wgid / NXCD; wgid = (xcd < r ? xcd * (q + 1) : r * (q + 1) + (xcd - r) * q) + off; }
        const int nig = WGM * nN, gid = wgid / nig, fm = gid * WGM, gsz = (nM - fm) < WGM ? (nM - fm) : WGM;
        u.pm = fm + ((wgid % nig) % gsz); u.pn = (wgid % nig) / gsz; return true;
    }
    __device__ __forceinline__ void a_ready(const Unit&) const {}
    __device__ __forceinline__ void done(const Unit&) const {}
};

__device__ __forceinline__ unsigned cvt_pk_bf16(float lo, float hi) { unsigned r; asm volatile("v_cvt_pk_bf16_f32 %0, %1, %2" : "=v"(r) : "v"(lo), "v"(hi)); return r; }
typedef int i32x4 __attribute__((ext_vector_type(4)));
constexpr float F8_HSCALE = 4.f, F8_WSCALE = 64.f, F8_ASCALE = 16.f, F8_GSCALE = 32.f;
template <bool I8> struct AccT { typedef f32x4 type; };
template <> struct AccT<true> { typedef i32x4 type; };
__device__ __forceinline__ f32x4 mma_sel(bf16x8 b, bf16x8 a, f32x4 c) { return __builtin_amdgcn_mfma_f32_16x16x32_bf16(b, a, c, 0, 0, 0); }
__device__ __forceinline__ i32x4 mma_sel(bf16x8 b, bf16x8 a, i32x4 c) { return __builtin_amdgcn_mfma_i32_16x16x64_i8(__builtin_bit_cast(i32x4, b), __builtin_bit_cast(i32x4, a), c, 0, 0, 0); }
typedef int i32x8 __attribute__((ext_vector_type(8)));
struct Frag2 { bf16x8 k[2]; };
template <int MODE> struct Frag { typedef Frag2 type; };
template <> struct Frag<2> { typedef i32x8 type; };
template <int MODE> __device__ __forceinline__ typename Frag<MODE>::type ldfrag(PG8_LAS const unsigned char* p) {
    if constexpr (MODE == 2) { const i32x4 lo = *(const PG8_LAS i32x4*)p, hi = *(const PG8_LAS i32x4*)(p + 1024); return (i32x8){lo[0], lo[1], lo[2], lo[3], hi[0], hi[1], hi[2], hi[3]}; }
    else { Frag2 f; f.k[0] = *(const PG8_LAS bf16x8*)p; f.k[1] = *(const PG8_LAS bf16x8*)(p + 1024); return f; }
}
__device__ __forceinline__ void mma_step_(f32x4& acc, const Frag2& b, const Frag2& a) { acc = mma_sel(b.k[0], a.k[0], acc); acc = mma_sel(b.k[1], a.k[1], acc); }
__device__ __forceinline__ void mma_step_(i32x4& acc, const Frag2& b, const Frag2& a) { acc = mma_sel(b.k[0], a.k[0], acc); acc = mma_sel(b.k[1], a.k[1], acc); }
__device__ __forceinline__ void mma_step_(f32x4& acc, const i32x8& b, const i32x8& a) {
#if defined(__HIP_DEVICE_COMPILE__)
    const int scl = 0x7f7f7f7f;
    asm volatile("v_mfma_scale_f32_16x16x128_f8f6f4 %0, %1, %2, %0, %3, %3 op_sel_hi:[0,0,0]" : "+v"(acc) : "v"(b), "v"(a), "v"(scl));
#endif
}
template <int MODE, class ACC, class F> __device__ __forceinline__ void mma_step(ACC& acc, const F& b, const F& a) { mma_step_(acc, b, a); }
struct EpiBf {
    static constexpr bool PERM = true, AFTER_DRAIN = false;
    bf16_t* O; int ldc; int s_lo, s_hi; float scale;
    struct Pre {}; __device__ __forceinline__ void prefetch(Pre&, const Unit&, int, int, int, int, int) const {} __device__ __forceinline__ void commit(const Pre&, int, int, int, int, int) const {}
    __device__ __forceinline__ void operator()(const f32x4 (&acc)[2][2][4][2], const Unit& u, int wr, int wc, int fr_, int fq_, const Pre&, int) const {
        int fr = fr_, fq = fq_; asm volatile("" : "+v"(fr), "+v"(fq));
        const int row0 = u.pm * BM + wr * 64 + fr, col0 = u.pn * BM + wc * 32 + 8 * fq;
        const float sc = (u.pn >= s_lo && u.pn < s_hi) ? scale : 1.f;
#pragma unroll
        for (int ai = 0; ai < 2; ++ai)
#pragma unroll
            for (int m = 0; m < 4; ++m) { bf16_t* rowp = O + (size_t)(row0 + ai * HALF + m * 16) * ldc + col0;
#pragma unroll
                for (int bj = 0; bj < 2; ++bj) { const f32x4 v0 = acc[ai][bj][m][0] * sc, v1 = acc[ai][bj][m][1] * sc;
                    u32x4 w; w.x = cvt_pk_bf16(v0[0], v0[1]); w.y = cvt_pk_bf16(v0[2], v0[3]); w.z = cvt_pk_bf16(v1[0], v1[1]); w.w = cvt_pk_bf16(v1[2], v1[3]);
                    *(u32x4*)(rowp + bj * HALF) = w; } }
    }
};
__device__ __forceinline__ float silu_mul(float g, float u) { return g * __builtin_amdgcn_rcpf(1.f + __expf(-g)) * u; }
__device__ __forceinline__ float silu2_mul(float g2, float u2) { return g2 * __builtin_amdgcn_rcpf(1.f + __builtin_amdgcn_exp2f(-g2)) * u2; }
struct EpiSwiglu {
    static constexpr bool PERM = true, AFTER_DRAIN = false;
    bf16_t* O; int ldc;
    struct Pre {}; __device__ __forceinline__ void prefetch(Pre&, const Unit&, int, int, int, int, int) const {} __device__ __forceinline__ void commit(const Pre&, int, int, int, int, int) const {}
    __device__ __forceinline__ void operator()(const f32x4 (&acc)[2][2][4][2], const Unit& u, int wr, int wc, int fr, int fq, const Pre&, int) const {
        const int row0 = u.pm * BM + wr * 64 + fr, col0 = u.pn * HALF + wc * 32 + 8 * fq;
#pragma unroll
        for (int ai = 0; ai < 2; ++ai)
#pragma unroll
            for (int m = 0; m < 4; ++m) { bf16_t* rowp = O + (size_t)(row0 + ai * HALF + m * 16) * ldc + col0;
                const f32x4 g0 = acc[ai][0][m][0], g1 = acc[ai][0][m][1], u0 = acc[ai][1][m][0], u1 = acc[ai][1][m][1];
                u32x4 w; w.x = cvt_pk_bf16(silu_mul(g0[0], u0[0]), silu_mul(g0[1], u0[1])); w.y = cvt_pk_bf16(silu_mul(g0[2], u0[2]), silu_mul(g0[3], u0[3]));
                w.z = cvt_pk_bf16(silu_mul(g1[0], u1[0]), silu_mul(g1[1], u1[1])); w.w = cvt_pk_bf16(silu_mul(g1[2], u1[2]), silu_mul(g1[3], u1[3]));
                *(u32x4*)rowp = w; }
    }
};
struct EpiSwigluF8 {
    static constexpr bool PERM = true, AFTER_DRAIN = false;
    unsigned char* O; int ldc;
    struct Pre {}; __device__ __forceinline__ void prefetch(Pre&, const Unit&, int, int, int, int, int) const {} __device__ __forceinline__ void commit(const Pre&, int, int, int, int, int) const {}
    __device__ __forceinline__ void operator()(const f32x4 (&acc)[2][2][4][2], const Unit& u, int wr, int wc, int fr, int fq, const Pre&, int) const {
        const int row0 = u.pm * BM + wr * 64 + fr, col0 = u.pn * HALF + wc * 32 + 8 * fq;
        constexpr float CG = 1.4426950408889634f / (F8_ASCALE * F8_GSCALE), CU = F8_HSCALE * 0.6931471805599453f / (F8_ASCALE * F8_GSCALE);
#pragma unroll
        for (int ai = 0; ai < 2; ++ai)
#pragma unroll
            for (int m = 0; m < 4; ++m) { const int row = row0 + ai * HALF + m * 16;
                const f32x4 g0 = acc[ai][0][m][0] * CG, g1 = acc[ai][0][m][1] * CG, u0 = acc[ai][1][m][0] * CU, u1 = acc[ai][1][m][1] * CU;
                float h[8];
#pragma unroll
                for (int i = 0; i < 4; ++i) { h[i] = __builtin_fminf(__builtin_fmaxf(silu2_mul(g0[i], u0[i]), -448.f), 448.f); h[4 + i] = __builtin_fminf(__builtin_fmaxf(silu2_mul(g1[i], u1[i]), -448.f), 448.f); }
                unsigned w0 = 0u, w1 = 0u; w0 = __builtin_amdgcn_cvt_pk_fp8_f32(h[0], h[1], w0, false); w0 = __builtin_amdgcn_cvt_pk_fp8_f32(h[2], h[3], w0, true);
                w1 = __builtin_amdgcn_cvt_pk_fp8_f32(h[4], h[5], w1, false); w1 = __builtin_amdgcn_cvt_pk_fp8_f32(h[6], h[7], w1, true);
                typedef unsigned u32x2 __attribute__((ext_vector_type(2))); *(u32x2*)(O + (size_t)row * ldc + col0) = (u32x2){w0, w1}; }
    }
};
struct EpiNull {
    static constexpr bool PERM = true, AFTER_DRAIN = false;
    unsigned char* O; int ldc;
    struct Pre {}; __device__ __forceinline__ void prefetch(Pre&, const Unit&, int, int, int, int, int) const {} __device__ __forceinline__ void commit(const Pre&, int, int, int, int, int) const {}
    __device__ __forceinline__ void operator()(const f32x4 (&acc)[2][2][4][2], const Unit& u, int wr, int wc, int fr, int fq, const Pre&, int) const {
        f32x4 s = (f32x4){0.f, 0.f, 0.f, 0.f};
#pragma unroll
        for (int ai = 0; ai < 2; ++ai)
#pragma unroll
            for (int bj = 0; bj < 2; ++bj)
#pragma unroll
                for (int m = 0; m < 4; ++m)
#pragma unroll
                    for (int n = 0; n < 2; ++n) s += acc[ai][bj][m][n];
        if (s[0] + s[1] + s[2] + s[3] == 12345.678f) O[(size_t)(u.pm * BM + wr * 64 + fr) * ldc + u.pn * HALF + wc * 32 + 8 * fq] = 1;
    }
};
template <bool IN_F32> struct EpiResid {
    static constexpr bool PERM = true, AFTER_DRAIN = false;
    const void* Xin; bf16_t* X; int ldc;
    struct Pre {}; __device__ __forceinline__ void prefetch(Pre&, const Unit&, int, int, int, int, int) const {} __device__ __forceinline__ void commit(const Pre&, int, int, int, int, int) const {}
    __device__ __forceinline__ void operator()(const f32x4 (&acc)[2][2][4][2], const Unit& u, int wr, int wc, int fr, int fq, const Pre&, int) const {
        const int row0 = u.pm * BM + wr * 64 + fr, col0 = u.pn * BM + wc * 32 + 8 * fq;
#pragma unroll
        for (int ai = 0; ai < 2; ++ai)
#pragma unroll
            for (int m = 0; m < 4; ++m) { const size_t ro = (size_t)(row0 + ai * HALF + m * 16) * ldc + col0;
#pragma unroll
                for (int bj = 0; bj < 2; ++bj) { f32x4 x0, x1;
                    if (IN_F32) { const float* p = (const float*)Xin + ro + bj * HALF; x0 = *(const f32x4*)p; x1 = *(const f32x4*)(p + 4); }
                    else { const u32x4 w = *(const u32x4*)((const bf16_t*)Xin + ro + bj * HALF);
                        x0 = (f32x4){__builtin_bit_cast(float, w.x << 16), __builtin_bit_cast(float, w.x & 0xffff0000u), __builtin_bit_cast(float, w.y << 16), __builtin_bit_cast(float, w.y & 0xffff0000u)};
                        x1 = (f32x4){__builtin_bit_cast(float, w.z << 16), __builtin_bit_cast(float, w.z & 0xffff0000u), __builtin_bit_cast(float, w.w << 16), __builtin_bit_cast(float, w.w & 0xffff0000u)}; }
                    const f32x4 v0 = x0 + acc[ai][bj][m][0], v1 = x1 + acc[ai][bj][m][1];
                    u32x4 o; o.x = cvt_pk_bf16(v0[0], v0[1]); o.y = cvt_pk_bf16(v0[2], v0[3]); o.z = cvt_pk_bf16(v1[0], v1[1]); o.w = cvt_pk_bf16(v1[2], v1[3]);
                    *(u32x4*)(X + ro + bj * HALF) = o; }
                asm volatile("" ::: "memory"); }
    }
};
struct EpiBf8 {
    static constexpr bool PERM = true, AFTER_DRAIN = false;
    bf16_t* O; int ldc; int s_lo, s_hi; float scale; const float* sA; const float* sB; PG8_LAS float* sc;
    struct Pre {};
    __device__ __forceinline__ void prefetch(Pre&, const Unit& u, int wr, int wc, int fr, int fq, int ui) const {
        const int wid = wr * 4 + wc, lane = fq * 16 + fr; PG8_LAS float* d = sc + (ui & 1) * 512;
        if (wid < 2) { const float* src = (wid == 0 ? sA + u.pm * BM : sB + u.pn * BM) + 4 * lane;
            __builtin_amdgcn_global_load_lds((const unsigned*)src, (PG8_LAS unsigned*)(d + 256 * wid), 16, 0, 0); }
    }
    __device__ __forceinline__ void commit(const Pre&, int, int, int, int, int) const {}
    __device__ __forceinline__ void operator()(const i32x4 (&acc)[2][2][4][2], const Unit& u, int wr, int wc, int fr, int fq, const Pre&, int ui) const {
        const int row0 = u.pm * BM + wr * 64 + fr, col0 = u.pn * BM + wc * 32 + 8 * fq; const PG8_LAS float* d = sc + (ui & 1) * 512;
        const float sc0 = (u.pn >= s_lo && u.pn < s_hi) ? scale : 1.f;
        f32x4 cb[2][2];
#pragma unroll
        for (int bj = 0; bj < 2; ++bj)
#pragma unroll
            for (int n = 0; n < 2; ++n) cb[bj][n] = *(const PG8_LAS f32x4*)(d + 256 + wc * 32 + 8 * fq + bj * HALF + 4 * n) * sc0;
#pragma unroll
        for (int ai = 0; ai < 2; ++ai)
#pragma unroll
            for (int m = 0; m < 4; ++m) { const int row = row0 + ai * HALF + m * 16; const float ra = d[wr * 64 + fr + ai * HALF + m * 16]; bf16_t* rowp = O + (size_t)row * ldc + col0;
#pragma unroll
                for (int bj = 0; bj < 2; ++bj) { const f32x4 v0 = __builtin_convertvector(acc[ai][bj][m][0], f32x4) * cb[bj][0] * ra, v1 = __builtin_convertvector(acc[ai][bj][m][1], f32x4) * cb[bj][1] * ra;
                    u32x4 w; w.x = cvt_pk_bf16(v0[0], v0[1]); w.y = cvt_pk_bf16(v0[2], v0[3]); w.z = cvt_pk_bf16(v1[0], v1[1]); w.w = cvt_pk_bf16(v1[2], v1[3]);
                    *(u32x4*)(rowp + bj * HALF) = w; } }
    }
};
template <bool F8OUT> struct EpiSwiglu8 {
    static constexpr bool PERM = true, AFTER_DRAIN = false;
    bf16_t* O; int ldc; const float* sA; const float* sB; int sb_exp; int tb1, tb2, tb3, tb4, tb5, tb6, tb7; PG8_LAS float* sc;
    struct Pre {};
    __device__ __forceinline__ void prefetch(Pre&, const Unit& u, int wr, int wc, int fr, int fq, int ui) const {
        const int wid = wr * 4 + wc, lane = fq * 16 + fr; PG8_LAS float* d = sc + (ui & 1) * 512;
        const int e = (u.pm >= tb1) + (u.pm >= tb2) + (u.pm >= tb3) + (u.pm >= tb4) + (u.pm >= tb5) + (u.pm >= tb6) + (u.pm >= tb7);
        if (wid < 2) { const float* src = (wid == 0 ? sA + u.pm * BM : sB + (size_t)e * sb_exp + u.pn * BM) + 4 * lane;
            __builtin_amdgcn_global_load_lds((const unsigned*)src, (PG8_LAS unsigned*)(d + 256 * wid), 16, 0, 0); }
    }
    __device__ __forceinline__ void commit(const Pre&, int, int, int, int, int) const {}
    __device__ __forceinline__ void operator()(const i32x4 (&acc)[2][2][4][2], const Unit& u, int wr, int wc, int fr, int fq, const Pre&, int ui) const {
        const int row0 = u.pm * BM + wr * 64 + fr, col0 = u.pn * HALF + wc * 32 + 8 * fq; const PG8_LAS float* d = sc + (ui & 1) * 512;
        const PG8_LAS float* sb = d + 256 + wc * 32 + 8 * fq;
        constexpr float CG = 1.4426950408889634f, CU = (F8OUT ? F8_HSCALE : 1.f) * 0.6931471805599453f;
        const f32x4 sg0 = *(const PG8_LAS f32x4*)sb * CG, sg1 = *(const PG8_LAS f32x4*)(sb + 4) * CG, su0 = *(const PG8_LAS f32x4*)(sb + HALF) * CU, su1 = *(const PG8_LAS f32x4*)(sb + HALF + 4) * CU;
#pragma unroll
        for (int ai = 0; ai < 2; ++ai)
#pragma unroll
            for (int m = 0; m < 4; ++m) { const int row = row0 + ai * HALF + m * 16; const float ra = d[wr * 64 + fr + ai * HALF + m * 16];
                const f32x4 g0 = __builtin_convertvector(acc[ai][0][m][0], f32x4) * sg0 * ra, g1 = __builtin_convertvector(acc[ai][0][m][1], f32x4) * sg1 * ra;
                const f32x4 u0 = __builtin_convertvector(acc[ai][1][m][0], f32x4) * su0 * ra, u1 = __builtin_convertvector(acc[ai][1][m][1], f32x4) * su1 * ra;
                if constexpr (F8OUT) { float h[8];
#pragma unroll
                    for (int i = 0; i < 4; ++i) { h[i] = __builtin_fminf(__builtin_fmaxf(silu2_mul(g0[i], u0[i]), -448.f), 448.f); h[4 + i] = __builtin_fminf(__builtin_fmaxf(silu2_mul(g1[i], u1[i]), -448.f), 448.f); }
                    unsigned w0 = 0u, w1 = 0u; w0 = __builtin_amdgcn_cvt_pk_fp8_f32(h[0], h[1], w0, false); w0 = __builtin_amdgcn_cvt_pk_fp8_f32(h[2], h[3], w0, true);
                    w1 = __builtin_amdgcn_cvt_pk_fp8_f32(h[4], h[5], w1, false); w1 = __builtin_amdgcn_cvt_pk_fp8_f32(h[6], h[7], w1, true);
                    typedef unsigned u32x2 __attribute__((ext_vector_type(2))); *(u32x2*)((unsigned char*)O + (size_t)row * ldc + col0) = (u32x2){w0, w1}; }
                else { bf16_t* rowp = O + (size_t)row * ldc + col0;
                u32x4 w; w.x = cvt_pk_bf16(silu2_mul(g0[0], u0[0]), silu2_mul(g0[1], u0[1])); w.y = cvt_pk_bf16(silu2_mul(g0[2], u0[2]), silu2_mul(g0[3], u0[3]));
                w.z = cvt_pk_bf16(silu2_mul(g1[0], u1[0]), silu2_mul(g1[1], u1[1])); w.w = cvt_pk_bf16(silu2_mul(g1[2], u1[2]), silu2_mul(g1[3], u1[3]));
                *(u32x4*)rowp = w; } }
    }
};
struct GOrder {
    StaticOrder so; const char* A; const char* B; size_t a_tile, b_tile, b_exp; int tb1, tb2, tb3, tb4, tb5, tb6, tb7;
    __device__ __forceinline__ bool next(int i, Unit& u) const { return so.next(i, u); }
    __device__ __forceinline__ const char* a_base(const Unit& u) const { return A + (size_t)u.pm * a_tile; }
    __device__ __forceinline__ const char* b_base(const Unit& u) const {
        const int e = (u.pm >= tb1) + (u.pm >= tb2) + (u.pm >= tb3) + (u.pm >= tb4) + (u.pm >= tb5) + (u.pm >= tb6) + (u.pm >= tb7);
        return B + (size_t)e * b_exp + (size_t)u.pn * b_tile; }
    __device__ __forceinline__ int nt(const Unit&, int full) const { return full; }
    __device__ __forceinline__ void a_ready(const Unit&) const {}
    __device__ __forceinline__ void done(const Unit&) const {}
};
struct GOrderTail {
    static constexpr int MAIN_M = 128, NTF = 28;
    StaticOrder so; const char* A; const char* B; size_t a_tile, b_tile, b_exp; int tb1, tb2, tb3, tb4, tb5, tb6, tb7; int n_main, n_piece;
    __device__ __forceinline__ void init(int n_mtiles, int N, int G, int c) { so.init(MAIN_M * BM, N, G, c); n_main = c < so.nwg ? (so.nwg - c + G - 1) / G : 0; n_piece = (n_mtiles - MAIN_M) * 4 * 8; }
    __device__ __forceinline__ bool next(int i, Unit& u) const {
        const bool mainu = i < n_main; const int q = (i - n_main) * so.G + so.c, ut = q >> 3;
        Unit m; m.pm = 0; m.pn = 0; m.tq = -1; so.next(mainu ? i : 0, m);
        u.pm = mainu ? m.pm : MAIN_M + (ut >> 2); u.pn = mainu ? m.pn : (ut & 3); u.tq = mainu ? -1 : q;
        return mainu || q < n_piece; }
    __device__ __forceinline__ int nt(const Unit& u, int full) const { return u.tq < 0 ? full : ((u.tq & 7) < 6 ? 4 : 2); }
    __device__ __forceinline__ const char* a_base(const Unit& u) const { const int kp = u.tq & 7, k0 = u.tq < 0 ? 0 : (kp < 6 ? 4 * kp : 2 * kp + 12); return A + (size_t)u.pm * a_tile + (size_t)k0 * (BK * 2); }
    __device__ __forceinline__ const char* b_base(const Unit& u) const {
        const int e = (u.pm >= tb1) + (u.pm >= tb2) + (u.pm >= tb3) + (u.pm >= tb4) + (u.pm >= tb5) + (u.pm >= tb6) + (u.pm >= tb7);
        const int kp = u.tq & 7, k0 = u.tq < 0 ? 0 : (kp < 6 ? 4 * kp : 2 * kp + 12);
        return B + (size_t)e * b_exp + (size_t)u.pn * b_tile + (size_t)k0 * (BK * 2); }
    __device__ __forceinline__ void a_ready(const Unit&) const {}
    __device__ __forceinline__ void done(const Unit&) const {}
};
struct EpiBfPart {
    static constexpr bool PERM = true, AFTER_DRAIN = false; static constexpr int YP_TILE0 = 136;
    bf16_t* O; int ldc; float scale;
    struct Pre {}; __device__ __forceinline__ void prefetch(Pre&, const Unit&, int, int, int, int, int) const {} __device__ __forceinline__ void commit(const Pre&, int, int, int, int, int) const {}
    __device__ __forceinline__ void operator()(const f32x4 (&acc)[2][2][4][2], const Unit& u, int wr, int wc, int fr_, int fq_, const Pre&, int) const {
        int fr = fr_, fq = fq_; asm volatile("" : "+v"(fr), "+v"(fq));
        const int vt = u.tq < 0 ? u.pm : YP_TILE0 + (u.tq & 7) * 8 + (u.pm - GOrderTail::MAIN_M);
        const int row0 = vt * BM + wr * 64 + fr, col0 = u.pn * BM + wc * 32 + 8 * fq;
#pragma unroll
        for (int ai = 0; ai < 2; ++ai)
#pragma unroll
            for (int m = 0; m < 4; ++m) { bf16_t* rowp = O + (size_t)(row0 + ai * HALF + m * 16) * ldc + col0;
#pragma unroll
                for (int bj = 0; bj < 2; ++bj) { const f32x4 v0 = acc[ai][bj][m][0] * scale, v1 = acc[ai][bj][m][1] * scale;
                    u32x4 w; w.x = cvt_pk_bf16(v0[0], v0[1]); w.y = cvt_pk_bf16(v0[2], v0[3]); w.z = cvt_pk_bf16(v1[0], v1[1]); w.w = cvt_pk_bf16(v1[2], v1[3]);
                    *(u32x4*)(rowp + bj * HALF) = w; } }
    }
};
template <class Epi, class Sched, bool ALIGN_EPI = false, bool SP2 = false, int MODE = 0  , int XEXP = 0  >
__device__ __forceinline__ void gemm_phase(PG8_LAS unsigned char* lds, const Gemm g, const Sched& S, const Epi& E) {
    const int tid = threadIdx.x, wid = __builtin_amdgcn_readfirstlane(tid >> 6), lane = tid & 63, wr = wid >> 2, wc = wid & 3, fr = lane & 15, fq = lane >> 4;
    const int K = g.K, nt = K / BK;
    unsigned voffA[2], voffB[2];
#pragma unroll
    for (int i = 0; i < 2; ++i) { int R, C; stage_rc(tid * 16 + i * 8192, R, C); const int Rb = Epi::PERM ? ((R & ~31) + perm32(R & 31)) : R;
        voffA[i] = (unsigned)(R * K + C) * 2u; voffB[i] = (unsigned)(Rb * K + C) * 2u; }
    const size_t kstep = (size_t)(BK * 2);
    const size_t hstep = (size_t)HALF * K * 2;
        const unsigned ldsw = (unsigned)wid * 1024u;
    const int aoff = lds_byte(wr * 64 + fr, fq * 8), boff = lds_byte(wc * 32 + fr, fq * 8);
#define PG8_SA(b, h) (((b) * 2 + (h)) * HTB)
#define PG8_SB(b, h) ((4 + (b) * 2 + (h)) * HTB)
#define PG8_STAGE(bufoff, gbase, voff) do { if constexpr (XEXP != 2) _Pragma("unroll") for (int _i = 0; _i < 2; ++_i) \
        __builtin_amdgcn_global_load_lds((const unsigned*)((const char*)(gbase) + (voff)[_i]), (PG8_LAS unsigned*)(lds + (bufoff) + ldsw + _i * 8192), 16, 0, 0); } while (0)
#define PG8_LDA(dst, b, h) do { if constexpr (XEXP < 3) _Pragma("unroll") for (int m = 0; m < 4; ++m) dst[m] = ldfrag<MODE>(lds + PG8_SA(b, h) + aoff + m * 2048); } while (0)
#define PG8_LDB(dst, b, h) do { if constexpr (XEXP < 3) _Pragma("unroll") for (int n = 0; n < 2; ++n) dst[n] = ldfrag<MODE>(lds + PG8_SB(b, h) + boff + n * 2048); } while (0)
#define PG8_MMA(ai, bj, At, Bt) do { __builtin_amdgcn_s_setprio(1); _Pragma("unroll") for (int m = 0; m < 4; ++m) _Pragma("unroll") for (int n = 0; n < 2; ++n) \
        mma_step<MODE>(acc[ai][bj][m][n], Bt[n], At[m]); __builtin_amdgcn_s_setprio(0); } while (0)
#define PG8_WAIT_V(n) do { if constexpr (XEXP != 1) asm volatile("s_waitcnt vmcnt(" #n ")" ::: "memory"); } while (0)
#define PG8_WAIT_L(n) asm volatile("s_waitcnt lgkmcnt(" #n ")" ::: "memory")
#define PG8_BAR do { if constexpr (XEXP < 4) __builtin_amdgcn_s_barrier(); } while (0)
#define PG8_SCHED __builtin_amdgcn_sched_barrier(0)
    Unit cur, nxt; int ui = 0; typename Epi::Pre pre;
    if (!S.next(0, cur)) return;
    typename AccT<MODE == 1>::type acc[2][2][4][2];
#pragma unroll
    for (int a = 0; a < 2; ++a)
#pragma unroll
        for (int b = 0; b < 2; ++b)
#pragma unroll
            for (int m = 0; m < 4; ++m)
#pragma unroll
                for (int n = 0; n < 2; ++n) acc[a][b][m][n] = typename AccT<MODE == 1>::type{};
    typename Frag<MODE>::type At[4], B0[2], B1[2];
    const char* cA = S.a_base(cur); const char* cB = S.b_base(cur);
    S.a_ready(cur);
    if constexpr (SP2) {
        PG8_STAGE(PG8_SB(0, 0), cB, voffB); PG8_STAGE(PG8_SB(0, 1), cB + hstep, voffB); PG8_STAGE(PG8_SA(0, 0), cA, voffA); PG8_STAGE(PG8_SA(0, 1), cA + hstep, voffA);
        if (wr == 1) PG8_BAR;
        PG8_WAIT_V(2); PG8_BAR;
        PG8_STAGE(PG8_SB(1, 0), cB + kstep, voffB); PG8_STAGE(PG8_SA(1, 0), cA + kstep, voffA); PG8_STAGE(PG8_SB(1, 1), cB + hstep + kstep, voffB);
        PG8_WAIT_V(6); PG8_BAR;
    } else {
        PG8_STAGE(PG8_SB(0, 0), cB, voffB); PG8_STAGE(PG8_SA(0, 0), cA, voffA); PG8_STAGE(PG8_SB(0, 1), cB + hstep, voffB); PG8_STAGE(PG8_SA(0, 1), cA + hstep, voffA);
        if (wr == 1) PG8_BAR;
        PG8_WAIT_V(4); PG8_BAR;
        PG8_STAGE(PG8_SB(1, 0), cB + kstep, voffB); PG8_STAGE(PG8_SA(1, 0), cA + kstep, voffA); PG8_STAGE(PG8_SB(1, 1), cB + hstep + kstep, voffB);
        PG8_WAIT_V(6); PG8_BAR;
    }
    for (;;) {
        const bool has_next = S.next(ui + 1, nxt);
        const char* nA = has_next ? S.a_base(nxt) : cA; const char* nB = has_next ? S.b_base(nxt) : cB;
        const int ntc = S.nt(cur, nt);
        for (int t = 0; t < ntc; t += 2) {
            const bool last = (t == ntc - 2);
            const char* a1 = cA + (size_t)(t + 1) * kstep;
            const char* a2 = last ? nA : cA + (size_t)(t + 2) * kstep; const char* b2 = last ? nB : cB + (size_t)(t + 2) * kstep;
            const char* a3 = a2 + kstep; const char* b3 = b2 + kstep;
            if (last && has_next) S.a_ready(nxt);
            if (last) E.prefetch(pre, cur, wr, wc, fr, fq, ui);
            if constexpr (SP2) {
            PG8_LDB(B0, 0, 0); PG8_LDB(B1, 0, 1); PG8_SCHED; PG8_LDA(At, 0, 0); PG8_STAGE(PG8_SA(1, 1), a1 + hstep, voffA);
            PG8_WAIT_V(8); PG8_WAIT_L(0); PG8_BAR; PG8_MMA(0, 0, At, B0); PG8_MMA(0, 1, At, B1); PG8_BAR; PG8_SCHED;
            PG8_LDA(At, 0, 1); PG8_STAGE(PG8_SB(0, 0), b2, voffB); PG8_STAGE(PG8_SB(0, 1), b2 + hstep, voffB); PG8_STAGE(PG8_SA(0, 0), a2, voffA);
            PG8_WAIT_V(8); PG8_WAIT_L(0); PG8_BAR; PG8_MMA(1, 0, At, B0); PG8_MMA(1, 1, At, B1); PG8_BAR; PG8_SCHED;
            PG8_LDB(B0, 1, 0); PG8_LDB(B1, 1, 1); PG8_SCHED; PG8_LDA(At, 1, 0); PG8_STAGE(PG8_SA(0, 1), a2 + hstep, voffA);
            PG8_WAIT_V(8); PG8_WAIT_L(0); PG8_BAR; PG8_MMA(0, 0, At, B0); PG8_MMA(0, 1, At, B1); PG8_BAR; PG8_SCHED;
            PG8_LDA(At, 1, 1); PG8_STAGE(PG8_SB(1, 0), b3, voffB); PG8_STAGE(PG8_SB(1, 1), b3 + hstep, voffB); PG8_STAGE(PG8_SA(1, 0), a3, voffA);
            PG8_WAIT_V(8); PG8_WAIT_L(0); PG8_BAR; PG8_MMA(1, 0, At, B0); PG8_MMA(1, 1, At, B1); PG8_BAR; PG8_SCHED;
            } else {
            PG8_LDB(B0, 0, 0); PG8_SCHED; PG8_LDA(At, 0, 0); PG8_STAGE(PG8_SA(1, 1), a1 + hstep, voffA);
            PG8_WAIT_L(8); PG8_BAR; PG8_WAIT_L(0); PG8_MMA(0, 0, At, B0); PG8_BAR; PG8_SCHED;
            PG8_LDB(B1, 0, 1); PG8_STAGE(PG8_SB(0, 0), b2, voffB);
            PG8_BAR; PG8_WAIT_L(0); PG8_MMA(0, 1, At, B1); PG8_BAR;
            PG8_LDA(At, 0, 1); PG8_STAGE(PG8_SA(0, 0), a2, voffA);
            PG8_BAR; PG8_WAIT_L(0); PG8_MMA(1, 0, At, B0); PG8_BAR; PG8_SCHED;
            PG8_STAGE(PG8_SB(0, 1), b2 + hstep, voffB);
            PG8_WAIT_V(6); PG8_BAR; PG8_MMA(1, 1, At, B1); PG8_BAR;
            PG8_LDB(B0, 1, 0); PG8_SCHED; PG8_LDA(At, 1, 0); PG8_STAGE(PG8_SA(0, 1), a2 + hstep, voffA);
            PG8_WAIT_L(8); PG8_BAR; PG8_WAIT_L(0); PG8_MMA(0, 0, At, B0); PG8_BAR; PG8_SCHED;
            PG8_LDB(B1, 1, 1); PG8_STAGE(PG8_SB(1, 0), b3, voffB);
            PG8_BAR; PG8_WAIT_L(0); PG8_MMA(0, 1, At, B1); PG8_BAR;
            PG8_LDA(At, 1, 1); PG8_STAGE(PG8_SA(1, 0), a3, voffA);
            PG8_BAR; PG8_WAIT_L(0); PG8_MMA(1, 0, At, B0); PG8_BAR; PG8_SCHED;
            PG8_STAGE(PG8_SB(1, 1), b3 + hstep, voffB);
            PG8_WAIT_V(6); PG8_BAR; PG8_MMA(1, 1, At, B1); PG8_BAR;
            }
        }
        E.commit(pre, wr, wc, fr, fq, ui);
        if constexpr (ALIGN_EPI) { if (wr == 0) PG8_BAR; }
        if constexpr (MODE == 2) asm volatile("s_nop 15\n\ts_nop 7" ::: "memory");
        if constexpr (!Epi::AFTER_DRAIN) { E(acc, cur, wr, wc, fr, fq, pre, ui); S.done(cur); }
        if (!has_next) break;
#pragma unroll
        for (int a = 0; a < 2; ++a)
#pragma unroll
            for (int b = 0; b < 2; ++b)
#pragma unroll
                for (int m = 0; m < 4; ++m)
#pragma unroll
                    for (int n = 0; n < 2; ++n) acc[a][b][m][n] = typename AccT<MODE == 1>::type{};
        cur = nxt; cA = nA; cB = nB; ++ui;
        if constexpr (ALIGN_EPI) { if (wr == 1) PG8_BAR; }
    }
    PG8_WAIT_V(0);
    if constexpr (!ALIGN_EPI) { if (wr == 0) PG8_BAR; }
    PG8_BAR;
    if constexpr (Epi::AFTER_DRAIN) { E.fused(acc, cur, wr, wc, fr, fq, lds, wid, lane); S.done(cur); }
#undef PG8_SA
#undef PG8_SB
#undef PG8_STAGE
#undef PG8_LDA
#undef PG8_LDB
#undef PG8_MMA
#undef PG8_WAIT_V
#undef PG8_WAIT_L
#undef PG8_BAR
#undef PG8_SCHED
}
}
#include <hip/hip_bf16.h>
#include <cmath>
namespace attn_body {
using bf16=__hip_bfloat16;
using bf16x8=__attribute__((ext_vector_type(8)))short;
using s16x4=__attribute__((ext_vector_type(4)))short;
using f32x16=__attribute__((ext_vector_type(16)))float;
using u32x4=__attribute__((ext_vector_type(4)))unsigned;
constexpr int BATCH=2,NHEAD=8,SEQ=8192,D=64,DM=3584,OPITCH=1024;
constexpr int NW=8,QBLK=32,QB=QBLK*NW,KVBLK=64,NQB=SEQ/QB;
constexpr int ATTN_PITCH=DM, ATTN_UNIT_ROWS=QB;
__device__ __forceinline__ int crow(int r,int hi){return (r&3)+8*(r>>2)+4*hi;}
#define SBAR() __builtin_amdgcn_sched_barrier(0)
__device__ __forceinline__ void cmask(f32x16&p0,f32x16&p1,int jb,int qrel,int hi){
  const float NEG=-INFINITY; int kb=64*jb+4*hi;
  #pragma unroll
  for(int r=0;r<16;++r){int kv=kb+(r&3)+8*(r>>2); if(kv>qrel)p0[r]=NEG; if(kv+32>qrel)p1[r]=NEG;}
}

constexpr int NSLOT=3, SLOTB=8192, SPLIT_NT=72, PART_F=256*64+512;
constexpr int LDS_K=0, LDS_V=NSLOT*SLOTB, LDS_WS=2*NSLOT*SLOTB, LDS_OST=LDS_WS+NW*64*4, LDS_CK=LDS_OST+NW*4096, LDS_BYTES=LDS_CK+SEQ*4;
constexpr float C2=0.125f*1.4426950408889634f;
__device__ __forceinline__ void glds16(const void*gsrc,unsigned lds_dst){unsigned keep;
  asm volatile("s_mov_b32 %0, m0\n\ts_mov_b32 m0, %2\n\ts_nop 0\n\tglobal_load_lds_dwordx4 %1, off\n\ts_mov_b32 m0, %0":"=&s"(keep):"v"(gsrc),"s"(lds_dst):"memory");}
__device__ __forceinline__ float max3f(float a,float b,float c){float r;asm("v_max3_f32 %0, %1, %2, %3":"=v"(r):"v"(a),"v"(b),"v"(c));return r;}
__device__ __forceinline__ float max2f(float a,float b){float r;asm("v_max_f32_e32 %0, %1, %2":"=v"(r):"v"(a),"v"(b));return r;}
__device__ __forceinline__ float fadd_s(float a,float b){float r;asm("v_add_f32_e32 %0, %1, %2":"=v"(r):"v"(a),"v"(b));return r;}
__device__ __forceinline__ float fsub_s(float a,float b){float r;asm("v_sub_f32_e32 %0, %1, %2":"=v"(r):"v"(a),"v"(b));return r;}
typedef float f32x2_t __attribute__((ext_vector_type(2))); typedef float f32x4_t __attribute__((ext_vector_type(4))); typedef __bf16 bf16x2_t __attribute__((ext_vector_type(2)));
__device__ __forceinline__ unsigned cvtpk_s(float lo,float hi){f32x2_t v={lo,hi};bf16x2_t b=__builtin_convertvector(v,bf16x2_t);return __builtin_bit_cast(unsigned,b);}
#define WAIT_BAR(N) asm volatile("s_waitcnt vmcnt(" #N ") lgkmcnt(0)\n\ts_barrier":::"memory")

__device__ __forceinline__ void qkt(f32x16&p0,f32x16&p1,const char*Kslot,const bf16x8*qr,const f32x16&negm,int r32,int hi){
  const char*kb=Kslot+hi*1024+r32*16;
  #pragma unroll
  for(int d0=0;d0<4;++d0){
    const bf16x8 b0=*reinterpret_cast<const bf16x8*>(kb+d0*2048);
    const bf16x8 b1=*reinterpret_cast<const bf16x8*>(kb+d0*2048+512);
    if(d0==0){p0=__builtin_amdgcn_mfma_f32_32x32x16_bf16(b0,qr[0],negm,0,0,0);p1=__builtin_amdgcn_mfma_f32_32x32x16_bf16(b1,qr[0],negm,0,0,0);}
    else{p0=__builtin_amdgcn_mfma_f32_32x32x16_bf16(b0,qr[d0],p0,0,0,0);p1=__builtin_amdgcn_mfma_f32_32x32x16_bf16(b1,qr[d0],p1,0,0,0);}}
}
typedef __attribute__((address_space(3))) const char* lds_cptr;
typedef short v4i16_t __attribute__((ext_vector_type(4)));
__device__ __forceinline__ void kload8(bf16x8*kf,lds_cptr kp){
  kf[0]=*(const __attribute__((address_space(3))) bf16x8*)(kp);      kf[1]=*(const __attribute__((address_space(3))) bf16x8*)(kp+512);
  kf[2]=*(const __attribute__((address_space(3))) bf16x8*)(kp+2048); kf[3]=*(const __attribute__((address_space(3))) bf16x8*)(kp+2560);
  kf[4]=*(const __attribute__((address_space(3))) bf16x8*)(kp+4096); kf[5]=*(const __attribute__((address_space(3))) bf16x8*)(kp+4608);
  kf[6]=*(const __attribute__((address_space(3))) bf16x8*)(kp+6144); kf[7]=*(const __attribute__((address_space(3))) bf16x8*)(kp+6656);
}
__device__ __forceinline__ void kload2(bf16x8*kf,lds_cptr kp,int j){ kf[2*j]=*(const __attribute__((address_space(3))) bf16x8*)(kp+j*2048); kf[2*j+1]=*(const __attribute__((address_space(3))) bf16x8*)(kp+j*2048+512); }
__device__ __forceinline__ s16x4 vtr(lds_cptr p){ return __builtin_bit_cast(s16x4,__builtin_amdgcn_ds_read_tr16_b64_v4i16((__attribute__((address_space(3))) v4i16_t*)p)); }
__device__ __forceinline__ float rowmax(const f32x16&p0,const f32x16&p1){
  float a=max3f(p0[0],p0[1],p1[0]),b=max3f(p0[2],p0[3],p1[1]);a=max3f(a,p1[2],p1[3]);
  #pragma unroll
  for(int r=4;r<16;r+=4){a=max3f(a,p0[r],p0[r+1]);b=max3f(b,p0[r+2],p0[r+3]);a=max3f(a,p1[r],p1[r+1]);b=max3f(b,p1[r+2],p1[r+3]);}
  const float m=max2f(a,b);
  auto rr=__builtin_amdgcn_permlane32_swap(__float_as_uint(m),__float_as_uint(m),false,false);
  return max2f(__uint_as_float(rr[0]),__uint_as_float(rr[1]));
}
__device__ __forceinline__ void pv(f32x16*o,int vb,bf16x8 pa0,bf16x8 pa1,bf16x8 pa2,bf16x8 pa3){
  #pragma unroll
  for(int d0=0;d0<2;++d0){s16x4 lo[4],hi[4];
    #pragma unroll
    for(int ks=0;ks<4;++ks){
      asm volatile("ds_read_b64_tr_b16 %0,%1 offset:%c2":"=&v"(lo[ks]):"v"(vb),"i"(d0*4096+ks*1024):"memory");
      asm volatile("ds_read_b64_tr_b16 %0,%1 offset:%c2":"=&v"(hi[ks]):"v"(vb),"i"(d0*4096+ks*1024+512):"memory");}
    asm volatile("s_waitcnt lgkmcnt(0)":::"memory");SBAR();
    #define PK(k) (bf16x8){lo[k][0],lo[k][1],lo[k][2],lo[k][3],hi[k][0],hi[k][1],hi[k][2],hi[k][3]}
    o[d0]=__builtin_amdgcn_mfma_f32_32x32x16_bf16(pa0,PK(0),o[d0],0,0,0);
    o[d0]=__builtin_amdgcn_mfma_f32_32x32x16_bf16(pa1,PK(1),o[d0],0,0,0);
    o[d0]=__builtin_amdgcn_mfma_f32_32x32x16_bf16(pa2,PK(2),o[d0],0,0,0);
    o[d0]=__builtin_amdgcn_mfma_f32_32x32x16_bf16(pa3,PK(3),o[d0],0,0,0);
    #undef PK
  }
}

#ifndef ATTN_STORE16
#define ATTN_STORE16(p,v) (*(u32x4*)(p)=(v))
#endif
template<int THRL> __device__ __forceinline__ void attn_unit(int b,int h,int qb,const bf16*Q,const bf16*__restrict__ K,const bf16*__restrict__ V,bf16*O,const float*__restrict__ cf,const float Tskip,const int part,float*PART,unsigned*flag,char*shm){
  int tid_=threadIdx.x; asm volatile("":"+v"(tid_));
  const int tid=tid_,lane=tid&63,r32=lane&31,hi=lane>>5; const int wid=__builtin_amdgcn_readfirstlane(tid>>6);
  const long rowbase=(long)b*SEQ; const int q0=qb*QB;
  const bf16*Qw=Q+(rowbase+q0+wid*QBLK)*DM+h*D;
  const unsigned lds0=(unsigned)(uintptr_t)shm;
  float*wsf=(float*)(shm+LDS_WS)+wid*64;
  const unsigned kdst=lds0+LDS_K+wid*1024, vdst=lds0+LDS_V+wid*1024;
  #define DMA_K(t,slot) glds16(ksrc+(long)(t)*KVBLK*DM,(unsigned)__builtin_amdgcn_readfirstlane(kdst+(slot)))
  #define DMA_V(t,slot) glds16(vsrc+(long)(t)*KVBLK*DM,(unsigned)__builtin_amdgcn_readfirstlane(vdst+(slot)))
  const int vb0=(int)(lds0+LDS_V)+((lane>>4)&1)*32+(lane&3)*8+(4*hi+((lane&15)>>2))*64;
  const char*Kbase=shm+LDS_K; bf16x8 kf[8];
  const lds_cptr shm3=(lds_cptr)shm; const lds_cptr kp0=shm3+LDS_K+hi*1024+r32*16; const lds_cptr vp0=shm3+LDS_V+((lane>>4)&1)*32+(lane&3)*8+(4*hi+((lane&15)>>2))*64;
  typedef __attribute__((address_space(3))) float lds_f32; typedef __attribute__((address_space(3))) const f32x4_t* lds_cf4;
  const int NT0=(q0+QB)/KVBLK;
  int tb;
  { const float thr=cf[q0]+Tskip; const int t1=lane,t2=lane+64;
    const bool n1=(t1<NT0)&&(cf[64*t1+63]>thr), n2=(t2<NT0)&&(cf[64*t2+63]>thr);
    const int t0=(int)__popcll(__ballot(n1))+(int)__popcll(__ballot(n2));
    tb=t0&~1; if(tb>NT0-4)tb=NT0-4; tb=__builtin_amdgcn_readfirstlane(tb); }
  int NT=NT0-tb; bool band=true; const bool split=(PART!=nullptr)&&(NT>SPLIT_NT);
  if(PART!=nullptr){ if(!split){ if(part==1)return; } else { const int mid=(NT>>1)&~1; if(part==0){NT=mid;band=false;} else {tb+=mid;NT-=mid;} } }
  { lds_f32* ckw=(lds_f32*)((lds_cptr)shm+LDS_CK); int i0_=tb*KVBLK+tid; asm volatile("":"+v"(i0_)); _Pragma("nounroll") for(int i=i0_;i<q0+QB;i+=NW*64)ckw[i]=cf[i]; }
  const float cq=cf[q0+wid*QBLK+(lane&31)];
  asm volatile("s_waitcnt vmcnt(0) lgkmcnt(0)\n\ts_barrier":::"memory");
  const bf16*Kh=K+(rowbase+(long)tb*KVBLK)*DM+h*D,*Vh=V+(rowbase+(long)tb*KVBLK)*DM+h*D;
  const bf16*ksrc=Kh+(long)lane*DM+wid*8;
  const bf16*vsrc=Vh+(long)(16*(wid&3)+(lane>>2))*DM+(wid>>2)*32+(lane&3)*8;
  const lds_cptr ckl=(lds_cptr)shm+LDS_CK+256*tb+16*(lane>>5);
  #define CBIAS(P0,P1,t) do{ const lds_cptr cb_=ckl+256*(t); _Pragma("unroll") for(int g_=0;g_<4;++g_){ const f32x4_t a_=*(lds_cf4)(cb_+32*g_), b_=*(lds_cf4)(cb_+128+32*g_); \
      _Pragma("unroll") for(int i_=0;i_<4;++i_){ P0[4*g_+i_]-=(a_[i_]+mm); P1[4*g_+i_]-=(b_[i_]+mm); } } }while(0)
  f32x4_t cbA[4],cbB[4]; float clast;
  #define CBLD(t) do{ const lds_cptr cb_=ckl+256*(t); _Pragma("unroll") for(int g_=0;g_<4;++g_){ cbA[g_]=*(lds_cf4)(cb_+32*g_); cbB[g_]=*(lds_cf4)(cb_+128+32*g_); } \
      clast=*(const __attribute__((address_space(3))) float*)((lds_cptr)shm+LDS_CK+256*tb+256*(t)+252); }while(0)
  DMA_K(0,0);DMA_V(0,0);DMA_K(1,SLOTB);
  bf16x8 qr[4];
  #pragma unroll
  for(int d0=0;d0<4;++d0)qr[d0]=*reinterpret_cast<const bf16x8*>(&Qw[(long)r32*DM+d0*16+hi*8]);
  float mhat=0.f,l_reg=0.f;f32x16 o[2];o[0]=f32x16{};o[1]=f32x16{};float mm=-cq; const f32x16 negm=f32x16{};
  const int qrel=wid*QBLK+r32;
  #define CMASK(P0,P1,t) do{int jb_=(t)-(NT-4); if(band&&jb_>=0)cmask(P0,P1,jb_,qrel,hi);}while(0)
  bool resc=false;
  #define START(P0,P1) do{ const float rm=rowmax(P0,P1); resc=false; \
    { const float dl=rm; mhat=fadd_s(mhat,dl); \
      _Pragma("unroll") for(int r=0;r<16;++r){P0[r]=fsub_s(P0[r],dl);P1[r]=fsub_s(P1[r],dl);} \
      mm+=dl; } \
    _Pragma("unroll") for(int r=0;r<16;++r)P0[r]=__builtin_amdgcn_exp2f(P0[r]); }while(0)
  #define RESC() do{ if(resc){ asm volatile("s_waitcnt lgkmcnt(0)":::"memory"); \
      _Pragma("unroll") for(int d_=0;d_<2;++d_) _Pragma("unroll") for(int r=0;r<16;++r)o[d_][r]*=wsf[crow(r,hi)]; } }while(0)
  f32x16 pA0,pA1,pB0,pB1;
  int sl_prev=0,sl_cur=0,sl_next=SLOTB;
  #define ROT() do{sl_prev=sl_cur;sl_cur=sl_next;sl_next=(sl_next==(NSLOT-1)*SLOTB)?0:sl_next+SLOTB;}while(0)
  DMA_K(2,2*SLOTB);
  WAIT_BAR(3);
  qkt(pA0,pA1,Kbase,qr,negm,r32,hi);asm volatile("s_nop 15\n\ts_nop 7":"+v"(pA0),"+v"(pA1));CBIAS(pA0,pA1,0);CMASK(pA0,pA1,0);
  START(pA0,pA1);
  _Pragma("unroll") for(int r=0;r<16;++r)pA1[r]=__builtin_amdgcn_exp2f(pA1[r]);
  WAIT_BAR(0);
  DMA_K(3,0);DMA_V(1,SLOTB);
  ROT();
  kload8(kf,kp0+sl_cur);
  WAIT_BAR(2);
  s16x4 vlo[8],vhi[8]; u32x4 pw0,pw1,pw2,pw3;
  #define PKW(P,B) cvtpk_s(P[B],P[B+1])
  #define PAF(k) __builtin_bit_cast(bf16x8,pw##k)
  #define VFR(i) (bf16x8){vlo[i][0],vlo[i][1],vlo[i][2],vlo[i][3],vhi[i][0],vhi[i][1],vhi[i][2],vhi[i][3]}
  #define PIN(x) asm volatile("":"+v"(x))
  #define MX3(a,b,c) __builtin_fmaxf(__builtin_fmaxf((a),(b)),(c))
  #define GAPA(MF,A0,A1,A2,A3,W0,W1,PW) do{ MF; sacc+=A0; sacc+=A1; sacc+=A2; sacc+=A3; PIN(sacc); W0; W1; PIN(PW); SBAR(); }while(0)
  #define EX(v) __builtin_amdgcn_exp2f(v)
  #define GAPB(MF,X,B,CB) do{ MF; { const f32x4_t t_=(CB)+mm; X[B]=EX(X[B]-t_[0]); X[B+1]=EX(X[B+1]-t_[1]); X[B+2]=EX(X[B+2]-t_[2]); X[B+3]=EX(X[B+3]-t_[3]); } PIN(X); SBAR(); }while(0)
  #define VRD(i) do{ vlo[i]=vtr(vp_+(((i)>>2)*4096+((i)&3)*1024)); vhi[i]=vtr(vp_+(((i)>>2)*4096+((i)&3)*1024+512)); }while(0)
  #define KRD(G,j) do{ if(G){ kload2(kf,kp0+sl_next,j); SBAR(); } }while(0)
  #define STEP(C0,C1,P0,P1,t,GK,GV,GL) do{ SBAR(); \
    const lds_cptr vp_=vp0+sl_prev; \
    VRD(0); SBAR(); float sacc=(P0[0]+P0[1]); \
    GAPA(C0=__builtin_amdgcn_mfma_f32_32x32x16_bf16(kf[0],qr[0],negm,0,0,0), P0[2],P0[3],P0[4],P0[5],     pw0[0]=PKW(P0,0), pw0[1]=PKW(P0,2), pw0); \
    VRD(4); SBAR(); GAPA(C1=__builtin_amdgcn_mfma_f32_32x32x16_bf16(kf[1],qr[0],negm,0,0,0), P0[6],P0[7],P0[8],P0[9],     pw0[2]=PKW(P0,4), pw0[3]=PKW(P0,6), pw0); \
    VRD(1); SBAR(); GAPA(C0=__builtin_amdgcn_mfma_f32_32x32x16_bf16(kf[2],qr[1],C0,0,0,0),   P0[10],P0[11],P0[12],P0[13], pw1[0]=PKW(P0,8), pw1[1]=PKW(P0,10), pw1); \
    VRD(5); SBAR(); GAPA(C1=__builtin_amdgcn_mfma_f32_32x32x16_bf16(kf[3],qr[1],C1,0,0,0),   P0[14],P0[15],P1[0],P1[1],   pw1[2]=PKW(P0,12),pw1[3]=PKW(P0,14), pw1); \
    VRD(2); SBAR(); GAPA(C0=__builtin_amdgcn_mfma_f32_32x32x16_bf16(kf[4],qr[2],C0,0,0,0),   P1[2],P1[3],P1[4],P1[5],     pw2[0]=PKW(P1,0), pw2[1]=PKW(P1,2), pw2); \
    VRD(6); SBAR(); GAPA(C1=__builtin_amdgcn_mfma_f32_32x32x16_bf16(kf[5],qr[2],C1,0,0,0),   P1[6],P1[7],P1[8],P1[9],     pw2[2]=PKW(P1,4), pw2[3]=PKW(P1,6), pw2); \
    VRD(3); SBAR(); GAPA(C0=__builtin_amdgcn_mfma_f32_32x32x16_bf16(kf[6],qr[3],C0,0,0,0),   P1[10],P1[11],P1[12],P1[13], pw3[0]=PKW(P1,8), pw3[1]=PKW(P1,10), pw3); \
    VRD(7); SBAR(); GAPA(C1=__builtin_amdgcn_mfma_f32_32x32x16_bf16(kf[7],qr[3],C1,0,0,0),   P1[14],P1[15],0.f,0.f,       pw3[2]=PKW(P1,12),pw3[3]=PKW(P1,14), pw3); \
    l_reg+=sacc; \
    if(GK){DMA_K((t)+3,sl_cur);} if(GV){DMA_V((t)+1,sl_next);} \
    CBLD(t); CMASK(C0,C1,t); \
    { float a=MX3(C0[0],C0[1],C1[0]),b=MX3(C0[2],C0[3],C1[1]); a=MX3(a,C1[2],C1[3]); \
      _Pragma("unroll") for(int r=4;r<16;r+=4){a=MX3(a,C0[r],C0[r+1]);b=MX3(b,C0[r+2],C0[r+3]);a=MX3(a,C1[r],C1[r+1]);b=MX3(b,C1[r+2],C1[r+3]);} \
      float rm=__builtin_fmaxf(a,b); { auto rr=__builtin_amdgcn_permlane32_swap(__float_as_uint(rm),__float_as_uint(rm),false,false); rm=__builtin_fmaxf(__uint_as_float(rr[0]),__uint_as_float(rr[1])); } rm=rm-clast-mm; \
      resc=false; \
      if(__builtin_expect(__any(rm>(float)THRL),0)){ const float dl=__builtin_fmaxf(rm,0.f); mhat+=dl; \
        mm+=dl; \
        const float f=__builtin_amdgcn_exp2f(-dl); l_reg*=f; if(hi==0)wsf[r32]=f; resc=true; } } \
    SBAR(); \
    GAPB(o[0]=__builtin_amdgcn_mfma_f32_32x32x16_bf16(PAF(0),VFR(0),o[0],0,0,0), C0,0,cbA[0]); \
    GAPB(o[1]=__builtin_amdgcn_mfma_f32_32x32x16_bf16(PAF(0),VFR(4),o[1],0,0,0), C0,4,cbA[1]); \
    KRD(GL,0); GAPB(o[0]=__builtin_amdgcn_mfma_f32_32x32x16_bf16(PAF(1),VFR(1),o[0],0,0,0), C0,8,cbA[2]); \
    KRD(GL,1); GAPB(o[1]=__builtin_amdgcn_mfma_f32_32x32x16_bf16(PAF(1),VFR(5),o[1],0,0,0), C0,12,cbA[3]); \
    KRD(GL,2); GAPB(o[0]=__builtin_amdgcn_mfma_f32_32x32x16_bf16(PAF(2),VFR(2),o[0],0,0,0), C1,0,cbB[0]); \
    KRD(GL,3); GAPB(o[1]=__builtin_amdgcn_mfma_f32_32x32x16_bf16(PAF(2),VFR(6),o[1],0,0,0), C1,4,cbB[1]); \
    GAPB(o[0]=__builtin_amdgcn_mfma_f32_32x32x16_bf16(PAF(3),VFR(3),o[0],0,0,0), C1,8,cbB[2]); \
    GAPB(o[1]=__builtin_amdgcn_mfma_f32_32x32x16_bf16(PAF(3),VFR(7),o[1],0,0,0), C1,12,cbB[3]); \
    }while(0)
  int t=1;
  #undef CMASK
  #define CMASK(P0,P1,t) do{}while(0)
  for(;t+5<NT;t+=2){
    STEP(pB0,pB1,pA0,pA1,t,true,true,true);     WAIT_BAR(2); RESC(); ROT();
    STEP(pA0,pA1,pB0,pB1,t+1,true,true,true);   WAIT_BAR(2); RESC(); ROT();
  }
  #undef CMASK
  #define CMASK(P0,P1,t) do{int jb_=(t)-(NT-4); if(band&&jb_>=0)cmask(P0,P1,jb_,qrel,hi);}while(0)
  #define ENDW(tt) do{ if((tt)+3<NT){WAIT_BAR(2);} else if((tt)+2<NT){WAIT_BAR(1);} else {WAIT_BAR(0);} }while(0)
  for(;t+1<NT;t+=2){
    STEP(pB0,pB1,pA0,pA1,t,(t+3<NT),(t+1<NT),(t+1<NT));       ENDW(t);   RESC(); ROT();
    STEP(pA0,pA1,pB0,pB1,t+1,(t+4<NT),(t+2<NT),(t+2<NT));     ENDW(t+1); RESC(); ROT();
  }
  STEP(pB0,pB1,pA0,pA1,NT-1,false,false,false); RESC();
  { float sacc=pB0[0]+pB0[1]; _Pragma("unroll") for(int r=2;r<16;++r)sacc+=pB0[r]; _Pragma("unroll") for(int r=0;r<16;++r)sacc+=pB1[r]; l_reg+=sacc;
    pw0=(u32x4){PKW(pB0,0),PKW(pB0,2),PKW(pB0,4),PKW(pB0,6)};pw1=(u32x4){PKW(pB0,8),PKW(pB0,10),PKW(pB0,12),PKW(pB0,14)};pw2=(u32x4){PKW(pB1,0),PKW(pB1,2),PKW(pB1,4),PKW(pB1,6)};pw3=(u32x4){PKW(pB1,8),PKW(pB1,10),PKW(pB1,12),PKW(pB1,14)};
    SBAR(); pv(o,vb0+sl_cur,PAF(0),PAF(1),PAF(2),PAF(3)); }
  #undef PKW
  #undef PAF
  #undef VFR
  #undef PIN
  #undef MX3
  #undef GAPA
  #undef GAPB
  #undef EX
  #undef VRD
  #undef KRD
  #undef STEP
  #undef ENDW
  {auto rr=__builtin_amdgcn_permlane32_swap(__float_as_uint(l_reg),__float_as_uint(l_reg),false,false);l_reg=__uint_as_float(rr[0])+__uint_as_float(rr[1]);}
  if(hi==0)wsf[32+r32]=l_reg;asm volatile("s_waitcnt lgkmcnt(0)":::"memory");
  float rli[16];
  if(split){
    float*Pm=PART+(size_t)part*PART_F; const float*Po=PART+(size_t)(1-part)*PART_F;
    #pragma unroll
    for(int r=0;r<16;++r){
      #pragma unroll
      for(int d0=0;d0<2;++d0)Pm[(wid*QBLK+crow(r,hi))*64+d0*32+r32]=o[d0][r];}
    if(hi==0){Pm[QB*64+(wid*QBLK+r32)*2]=mm+cq;Pm[QB*64+(wid*QBLK+r32)*2+1]=l_reg;wsf[r32]=mm+cq;}
    asm volatile("s_waitcnt vmcnt(0) lgkmcnt(0)\n\ts_barrier":::"memory");
    if(tid==0){ __builtin_amdgcn_fence(__ATOMIC_RELEASE,"agent"); asm volatile("s_waitcnt vmcnt(0)":::"memory");
      *(volatile __attribute__((address_space(3))) unsigned*)((__attribute__((address_space(3))) char*)shm+LDS_OST)=__hip_atomic_fetch_add(flag,1u,__ATOMIC_RELAXED,__HIP_MEMORY_SCOPE_AGENT); }
    asm volatile("s_waitcnt vmcnt(0) lgkmcnt(0)\n\ts_barrier":::"memory");
    const unsigned old=*(volatile __attribute__((address_space(3))) unsigned*)((__attribute__((address_space(3))) char*)shm+LDS_OST);
    asm volatile("s_waitcnt lgkmcnt(0)\n\ts_barrier":::"memory");
    if(old==0u)return;
    __builtin_amdgcn_fence(__ATOMIC_ACQUIRE,"agent"); asm volatile("s_waitcnt vmcnt(0)":::"memory");
    #pragma unroll
    for(int r=0;r<16;++r){ const int row=crow(r,hi); const float mo=wsf[row],lo=wsf[32+row],mt=Po[QB*64+(wid*QBLK+row)*2],lt=Po[QB*64+(wid*QBLK+row)*2+1];
      const float m=__builtin_fmaxf(mo,mt),fo=__builtin_amdgcn_exp2f(mo-m),ft=__builtin_amdgcn_exp2f(mt-m),inv=__builtin_amdgcn_rcpf(lo*fo+lt*ft);
      #pragma unroll
      for(int d0=0;d0<2;++d0)o[d0][r]=(o[d0][r]*fo+Po[(wid*QBLK+row)*64+d0*32+r32]*ft)*inv;
      rli[r]=1.f; }
  } else {
  #pragma unroll
  for(int r=0;r<16;++r)rli[r]=__builtin_amdgcn_rcpf(wsf[32+crow(r,hi)]);
  }
  bf16*Ow=O+(rowbase+q0+wid*QBLK)*OPITCH+h*D;
  { bf16*stg=(bf16*)(shm+LDS_OST)+wid*2048;
    #pragma unroll
    for(int r=0;r<16;++r){const int orow=crow(r,hi);
      #pragma unroll
      for(int d0=0;d0<2;++d0)stg[orow*64+d0*32+r32]=__float2bfloat16(o[d0][r]*rli[r]);}
    asm volatile("s_waitcnt lgkmcnt(0)":::"memory");
    #pragma unroll
    for(int i=0;i<4;++i){const int row=i*8+(lane>>3),ch=lane&7; const u32x4 v=*(const u32x4*)(stg+row*64+ch*8); ATTN_STORE16(Ow+(long)row*OPITCH+ch*8,v);} }
  asm volatile("s_waitcnt lgkmcnt(0)\n\ts_barrier":::"memory");
  #undef CBIAS
  #undef CBLD
  #undef DMA_K
  #undef DMA_V
  #undef CMASK
  #undef START
  #undef RESC
  #undef ROT
}
constexpr int ATTN_LDS_BYTES=LDS_BYTES;
struct AttnTensors { const bf16* Q; const bf16* K; const bf16* V; bf16* O; const float* CF; const float* stat; };
struct AttnUnit { int bh; int qb; };
struct StaticOrder {
  int vcu;
  __device__ __forceinline__ explicit StaticOrder(int grid,int block):vcu((grid%8==0)?(block%8)*(grid/8)+block/8:block),G_(grid){}
  int G_;
  __device__ __forceinline__ bool next(int i,AttnUnit&u)const{ const int v=vcu+(i>>1)*G_; if(v>=256)return false; const int s=v&15; u.bh=v>>4; u.qb=(i&1)?31-s:s; return true; }
  __device__ __forceinline__ void a_ready(const AttnUnit&)const{}
  __device__ __forceinline__ void done(const AttnUnit&)const{}
};
struct QueueOrder {
  unsigned* ctr; __attribute__((address_space(3))) unsigned* slot;
  __device__ __forceinline__ bool next(int,AttnUnit&u)const{
    if(threadIdx.x==0)*slot=__hip_atomic_fetch_add(ctr,1u,__ATOMIC_RELAXED,__HIP_MEMORY_SCOPE_AGENT);
    asm volatile("s_waitcnt vmcnt(0) lgkmcnt(0)\n\ts_barrier":::"memory");
    const unsigned v=*(volatile __attribute__((address_space(3))) unsigned*)slot; const int vv=__builtin_amdgcn_readfirstlane((int)v);
    if(vv>=512)return false; u.qb=31-(vv>>4); u.bh=vv&15; return true; }
  __device__ __forceinline__ void a_ready(const AttnUnit&)const{}
  __device__ __forceinline__ void done(const AttnUnit&)const{}
};
template<class Sched,int THRL=8> __device__ __forceinline__ void attn_phase(char*lds,const AttnTensors&T,const Sched&S){
  AttnUnit u;
  for(int i=0;S.next(i,u);++i){ S.a_ready(u); const float Tsk=40.f+2.f*__builtin_sqrtf(T.stat[u.bh*2]*T.stat[u.bh*2+1])*1.01f+1.f;
    attn_unit<THRL>(u.bh/NHEAD,u.bh%NHEAD,u.qb,T.Q,T.K,T.V,T.O,T.CF+(long)u.bh*SEQ,Tsk,0,nullptr,nullptr,lds); S.done(u); }
}
#undef SBAR
#undef WAIT_BAR
}
#define GAS __attribute__((address_space(1)))
#define LAS __attribute__((address_space(3)))
typedef unsigned v4u __attribute__((ext_vector_type(4)));
typedef float f32x4 __attribute__((ext_vector_type(4)));
typedef short bf16x8 __attribute__((ext_vector_type(8)));
typedef GAS unsigned gu32;
typedef GAS unsigned long long gu64;
#define RLX_AGENT __ATOMIC_RELAXED, __HIP_MEMORY_SCOPE_AGENT
#define LDS_WAIT() asm volatile("s_waitcnt lgkmcnt(0)" ::: "memory")
#define VM_WAIT() asm volatile("s_waitcnt vmcnt(0)" ::: "memory")
__device__ __forceinline__ unsigned long long rt() { return __builtin_amdgcn_s_memrealtime(); }
__device__ __forceinline__ unsigned pk2(float lo, float hi) { return (unsigned)f2bf(lo) | ((unsigned)f2bf(hi) << 16); }

#define XB_TMO      128
#define XB_XCNT(j)  (256  + 64 * (j))
#define XB_XSUB(j)  (1280 + 64 * (j))
#define XB_XGEN(j)  (2304 + 64 * (j))
#define XB_TOP      3328
#define XB_TOPGEN   3392
#define XCD_BAR_WORDS 3456
#define XB_SPIN_CAP (1u << 18)

__device__ __forceinline__ unsigned xb_ld(unsigned* p)              { return __hip_atomic_load(p, __ATOMIC_RELAXED, __HIP_MEMORY_SCOPE_AGENT); }
__device__ __forceinline__ unsigned xb_add(unsigned* p, unsigned v) { return __hip_atomic_fetch_add(p, v, __ATOMIC_RELAXED, __HIP_MEMORY_SCOPE_AGENT); }
__device__ __forceinline__ unsigned xb_xcc_id() { return (unsigned)__builtin_amdgcn_s_getreg((3 << 11) | 20) & 0xFu; }
#define XB_SPIN(cond, bar) do { unsigned _sp = 0; while (cond) { __builtin_amdgcn_s_sleep(1); \
    if ((++_sp & 255u) == 0u) { if (xb_ld(&(bar)[XB_TMO])) break; if (_sp > XB_SPIN_CAP) { atomicAdd(&(bar)[XB_TMO], 1u); break; } } } } while (0)

struct XcdBarrier {
    unsigned* bar; unsigned x;
    volatile LAS unsigned* st;
};

__device__ __forceinline__ XcdBarrier xcd_barrier_post(unsigned* bar, volatile LAS unsigned* st) {
    XcdBarrier b; b.bar = bar; b.x = xb_xcc_id(); b.st = st;
    if (threadIdx.x == 0) (void)xb_add(&bar[XB_XCNT(b.x)], 1u);
    return b;
}
__device__ __forceinline__ void xcd_barrier_complete(unsigned* bar, unsigned x, unsigned& nloc, unsigned& nx) {
    const unsigned G = gridDim.x * gridDim.y * gridDim.z;
    unsigned sum, cnt, mine, sp = 0u;
    for (;;) {
        sum = 0u; cnt = 0u; mine = 0u;
#pragma unroll
        for (unsigned j = 0; j < 16; ++j) { const unsigned c = xb_ld(&bar[XB_XCNT(j)]); sum += c; cnt += (c > 0u) ? 1u : 0u; mine = (j == x) ? c : mine; }
        if (sum == G) break;
        __builtin_amdgcn_s_sleep(1);
        if ((++sp & 255u) == 0u) { if (xb_ld(&bar[XB_TMO])) break; if (sp > XB_SPIN_CAP) { atomicAdd(&bar[XB_TMO], 1u); break; } }
    }
    nloc = mine > 0u ? mine : 1u; nx = cnt > 0u ? cnt : 1u;
}

__device__ __forceinline__ void xcd_barrier(const XcdBarrier& b) {
    asm volatile("s_waitcnt vmcnt(0)" ::: "memory");
    __syncthreads();
    if (threadIdx.x == 0) {
        unsigned* bar = b.bar;
        __builtin_amdgcn_s_waitcnt(0);
        unsigned nloc = b.st[0], nx = b.st[1];
        if (nloc == 0u) { xcd_barrier_complete(bar, b.x, nloc, nx); b.st[0] = nloc; b.st[1] = nx; }
        const unsigned old = xb_add(&bar[XB_XSUB(b.x)], 1u);
        const unsigned gen = old / nloc;
        if (old + 1u == (gen + 1u) * nloc) {
            __builtin_amdgcn_fence(__ATOMIC_RELEASE, "agent");
            asm volatile("s_waitcnt vmcnt(0)" ::: "memory");
            const unsigned og = xb_add(&bar[XB_TOP], 1u);
            const unsigned tg = og / nx;
            if (og + 1u == (tg + 1u) * nx) xb_add(&bar[XB_TOPGEN], 1u);
            else XB_SPIN(xb_ld(&bar[XB_TOPGEN]) == tg, bar);
            __builtin_amdgcn_fence(__ATOMIC_ACQUIRE, "agent");
            xb_add(&bar[XB_XGEN(b.x)], 1u);
            asm volatile("s_waitcnt vmcnt(0)" ::: "memory");
        } else {
            XB_SPIN(xb_ld(&bar[XB_XGEN(b.x)]) == gen, bar);
            __builtin_amdgcn_fence(__ATOMIC_ACQUIRE, "agent");
            asm volatile("s_waitcnt vmcnt(0)" ::: "memory");
        }
    }
    __syncthreads();
}
constexpr int NWAVES = 8, NTHR = 512;
constexpr int RING_OFF = 0, RING_BYTES = 131072, LDSCTL_OFF = RING_BYTES, MISC_OFF = LDSCTL_OFF + 320, LDS_BYTES = 147456;
constexpr int CW_BAR = 4096;
constexpr size_t WS_WSM = 402 * MiB;
constexpr size_t WS_WIN = WS_WSM  , WS_SWIN = WS_WSM + 8 * MiB  , WS_WOUT = WS_WSM + 14 * MiB  , WS_WDGU = WS_WSM + 18 * MiB  , WS_SWDGU = WS_WSM + 24 * MiB  , WS_WDDN = WS_WSM + 29 * MiB  ;
constexpr size_t WS_SH = WS_H + 16 * MiB  , WS_SXG = WS_XG + 34 * MiB  ;
constexpr size_t WS_WMGU = WS_W  , WS_WMDN = 437 * MiB  ;
static_assert(WS_WDDN + 6 * MiB <= WS_WMDN && WS_WMGU + 56 * MiB <= WS_WSM && WS_WMDN + 28 * MiB <= WS_END, "ws");
struct MArgs { const float* in[20]; float* out; unsigned char* ws; int ph_lo, ph_hi; };
enum { I_X = 0, I_ATTN_NORM, I_W_IN, I_HGRN_LB, I_HGRN_NORM, I_MLSTM_CONV, I_MLSTM_BI, I_MLSTM_BF, I_MLSTM_NORM, I_FOX_BF, I_W_OUT, I_FFN_NORM, I_DGATE, I_DUP, I_DDOWN, I_ROUTER, I_MGATE, I_MUP, I_MDOWN, I_FINAL_NORM };

__device__ __forceinline__ void tr_item(const float* W, int ldw, int K, bf16_t* WT, LAS float* scr, int k0, int lane) {
#pragma unroll 32
    for (int i = 0; i < 32; ++i) { const int kk = 2 * i + (lane >> 5); scr[kk * 33 + (lane & 31)] = W[(size_t)(k0 + kk) * ldw + (lane & 31)]; }
    LDS_WAIT(); asm volatile("" ::: "memory");
    const int c = lane & 7;
#pragma unroll
    for (int j = 0; j < 4; ++j) { const int n = (lane >> 3) + 8 * j; const LAS float* s = scr + (8 * c) * 33 + n;
        v4u o; o.x = pk2(s[0 * 33], s[1 * 33]); o.y = pk2(s[2 * 33], s[3 * 33]); o.z = pk2(s[4 * 33], s[5 * 33]); o.w = pk2(s[6 * 33], s[7 * 33]);
        *(GAS v4u*)(WT + (size_t)n * K + k0 + 8 * c) = o; }
    LDS_WAIT(); asm volatile("" ::: "memory");
}
__device__ __forceinline__ int glu_row(int c, int up) { return (c >> 7) * 256 + (c & 127) + up * 128; }
constexpr int MOE_GU_ITEMS = 28672, MOE_ITEMS = 43008, MOE_FILL = 4;
__device__ __forceinline__ constexpr int moe_fill_blocks(int slot) { return slot == 1 ? 128 : 112; }
__device__ __forceinline__ constexpr int moe_fill_base(int slot) { return (slot > 0 ? moe_fill_blocks(0) : 0) * NWAVES * MOE_FILL + (slot > 1 ? moe_fill_blocks(1) : 0) * NWAVES * MOE_FILL; }
__device__ __forceinline__ int moe_prefilled(int G) { return G == 256 ? moe_fill_base(2) + moe_fill_blocks(2) * NWAVES * MOE_FILL : 0; }
struct F8Item { const float* W; unsigned char* dst; int ldw, K; float sc; };
__device__ __forceinline__ F8Item moe_item(const MArgs& a, unsigned char* ws, int it) {
    const bool gu = it < MOE_GU_ITEMS; const int r0 = gu ? it : it - MOE_GU_ITEMS;
    const int e = gu ? r0 / 3584 : r0 / 1792; int r = gu ? r0 % 3584 : r0 % 1792; const int up = gu ? r / 1792 : 0; if (gu) r %= 1792;
    const int kb = gu ? r / 112 : r / 32, nb = gu ? r % 112 : r % 32, c = 32 * nb, k0 = 64 * kb;
    F8Item I; I.ldw = gu ? FE : D; I.K = gu ? D : FE; I.sc = gu ? pg8::F8_GSCALE : pg8::F8_WSCALE;
    I.W = (gu ? (up ? a.in[I_MUP] : a.in[I_MGATE]) + (size_t)e * D * FE : a.in[I_MDOWN] + (size_t)e * FE * D) + c + (size_t)k0 * I.ldw;
    I.dst = (gu ? (unsigned char*)(ws + WS_WMGU) + (size_t)e * 2 * FE * D + (size_t)glu_row(c, up) * D : (unsigned char*)(ws + WS_WMDN) + (size_t)e * D * FE + (size_t)c * FE) + k0;
    return I;
}
__device__ __forceinline__ void f8_load(float (&v)[32], const F8Item& I, int lane) {
    const float* p = I.W + (size_t)(lane >> 5) * I.ldw + (lane & 31);
#pragma unroll
    for (int i = 0; i < 32; ++i) v[i] = p[(size_t)(2 * i) * I.ldw];
}
__device__ __forceinline__ void f8_stage(const float (&v)[32], LAS float* scr, int lane) {
#pragma unroll
    for (int i = 0; i < 32; ++i) scr[(2 * i + (lane >> 5)) * 33 + (lane & 31)] = v[i];
}
__device__ __forceinline__ void f8_out(const F8Item& I, LAS float* scr, int lane) {
    LDS_WAIT(); asm volatile("" ::: "memory");
    const int c = lane & 7;
#pragma unroll
    for (int j = 0; j < 4; ++j) { const int n = (lane >> 3) + 8 * j; const LAS float* s = scr + (8 * c) * 33 + n; float h[8];
#pragma unroll
        for (int i = 0; i < 8; ++i) h[i] = __builtin_fminf(__builtin_fmaxf(s[i * 33] * I.sc, -448.f), 448.f);
        unsigned w0 = 0u, w1 = 0u; w0 = __builtin_amdgcn_cvt_pk_fp8_f32(h[0], h[1], w0, false); w0 = __builtin_amdgcn_cvt_pk_fp8_f32(h[2], h[3], w0, true);
        w1 = __builtin_amdgcn_cvt_pk_fp8_f32(h[4], h[5], w1, false); w1 = __builtin_amdgcn_cvt_pk_fp8_f32(h[6], h[7], w1, true);
        typedef unsigned u32x2_ __attribute__((ext_vector_type(2))); *(GAS u32x2_*)(I.dst + (size_t)n * I.K + 8 * c) = (u32x2_){w0, w1}; }
    LDS_WAIT(); asm volatile("" ::: "memory");
}
__device__ __forceinline__ void moe_conv_range(const MArgs& a, unsigned char* ws, LAS float* scr, int first, int step, int end, int lane) {
    float v[32]; int it = first; F8Item cur;
    if (it < end) { cur = moe_item(a, ws, it); f8_load(v, cur, lane); }
#pragma unroll 1
    for (; it < end; it += step) {
        f8_stage(v, scr, lane);
        F8Item nxt = cur; const int nx = it + step;
        if (nx < end) { nxt = moe_item(a, ws, nx); f8_load(v, nxt, lane); }
        f8_out(cur, scr, lane); cur = nxt;
    }
}
constexpr int MOE_FILL17 = 3;
__device__ __forceinline__ int moe_tail_idle(const int* cnt, int G) { int acc = 0;
#pragma unroll
    for (int e = 0; e < NE; ++e) acc += (cnt[e] + 255) >> 8;
    const int r = (acc * (2 * FE / 256)) % 256; return (G == 256 && r) ? 256 - r : 0; }
__device__ __forceinline__ void moe_fill(const MArgs& a, unsigned char* ws, LAS float* scr, int slot, int G, int bx, int wave, int lane) {
    const int nb = moe_fill_blocks(slot), b0 = 256 - nb;
    if (G != 256 || bx < b0) return;
    const int first = moe_fill_base(slot) + (bx - b0) * NWAVES + wave;
    moe_conv_range(a, ws, scr, first, nb * NWAVES, first + MOE_FILL * nb * NWAVES, lane);
}
struct RowIn { float4 v[4]; };
template <bool BF> __device__ __forceinline__ void mrow_load(RowIn& R, const void* src, int row, int lane) {
    if (BF) { const uint2* xr = (const uint2*)((const bf16_t*)src + (size_t)row * D) + lane;
#pragma unroll
        for (int j = 0; j < 4; ++j) { const uint2 w = xr[64 * j]; R.v[j] = make_float4(__uint_as_float(w.x << 16), __uint_as_float(w.x & 0xffff0000u), __uint_as_float(w.y << 16), __uint_as_float(w.y & 0xffff0000u)); } }
    else { const float4* xr = (const float4*)((const float*)src + (size_t)row * D) + lane;
#pragma unroll
        for (int j = 0; j < 4; ++j) R.v[j] = xr[64 * j]; } }
template <int MODE> __device__ __forceinline__ void mrow(const RowIn& R, signed char* H8, float* SH, const float* gain, const LAS float* tab, float* G, int row, int lane, float (&lg)[8]) {
    float4 v[4]; float ss = 0.f;
#pragma unroll
    for (int j = 0; j < 4; ++j) { v[j] = R.v[j]; ss += v[j].x * v[j].x + v[j].y * v[j].y + v[j].z * v[j].z + v[j].w * v[j].w; }
    ss = wave_sum(ss);
    const float r = rsqrtf(ss * (1.f / D) + EPS);
    float h[16];
#pragma unroll
    for (int j = 0; j < 4; ++j) { const float4 g = *((const float4*)gain + 64 * j + lane);
        h[4 * j + 0] = v[j].x * r * g.x; h[4 * j + 1] = v[j].y * r * g.y; h[4 * j + 2] = v[j].z * r * g.z; h[4 * j + 3] = v[j].w * r * g.w; }
    if (MODE == 2) {
#pragma unroll
      for (int j = 0; j < 4; ++j) { float q[4];
#pragma unroll
          for (int i = 0; i < 4; ++i) q[i] = __builtin_fminf(__builtin_fmaxf(h[4 * j + i] * pg8::F8_ASCALE, -448.f), 448.f);
          unsigned w = 0u; w = __builtin_amdgcn_cvt_pk_fp8_f32(q[0], q[1], w, false); w = __builtin_amdgcn_cvt_pk_fp8_f32(q[2], q[3], w, true);
          *((unsigned*)(H8 + (size_t)row * D) + 64 * j + lane) = w; }
    } else
    { float am = 0.f;
#pragma unroll
      for (int i = 0; i < 16; ++i) am = fmaxf(am, fabsf(h[i]));
      am = wave_max_nn(am);
      const float inv = am > 0.f ? 127.f / am : 0.f;
#pragma unroll
      for (int j = 0; j < 4; ++j) { const int q0 = (int)rintf(h[4 * j] * inv), q1 = (int)rintf(h[4 * j + 1] * inv), q2 = (int)rintf(h[4 * j + 2] * inv), q3 = (int)rintf(h[4 * j + 3] * inv);
          *((unsigned*)(H8 + (size_t)row * D) + 64 * j + lane) = (unsigned)(q0 & 255) | ((unsigned)(q1 & 255) << 8) | ((unsigned)(q2 & 255) << 16) | ((unsigned)(q3 & 255) << 24); }
      if (lane == 0) SH[row] = am > 0.f ? am * (1.f / 127.f) : 1.f; }
    if (MODE == 0) {
        float pa[16];
#pragma unroll
        for (int c = 0; c < 16; ++c) { float s = 0.f;
#pragma unroll
            for (int j = 0; j < 4; ++j) { const f32x4 w = *(const LAS f32x4*)(tab + c * 1024 + 256 * j + 4 * lane); s += h[4 * j] * w[0] + h[4 * j + 1] * w[1] + h[4 * j + 2] * w[2] + h[4 * j + 3] * w[3]; }
            pa[c] = s; }
#pragma unroll
        for (int c = 0; c < 8; ++c) { const bool up = (lane & 32) != 0; const float send = up ? pa[c] : pa[c + 8], keep = up ? pa[c + 8] : pa[c]; pa[c] = keep + __shfl_xor(send, 32); }
#pragma unroll
        for (int c = 0; c < 4; ++c) { const bool up = (lane & 16) != 0; const float send = up ? pa[c] : pa[c + 4], keep = up ? pa[c + 4] : pa[c]; pa[c] = keep + __shfl_xor(send, 16); }
#pragma unroll
        for (int c = 0; c < 2; ++c) { const bool up = (lane & 8) != 0; const float send = up ? pa[c] : pa[c + 2], keep = up ? pa[c + 2] : pa[c]; pa[c] = keep + __shfl_xor(send, 8); }
        { const bool up = (lane & 4) != 0; const float send = up ? pa[0] : pa[1], keep = up ? pa[1] : pa[0]; pa[0] = keep + __shfl_xor(send, 4); }
        pa[0] += __shfl_xor(pa[0], 2); pa[0] += __shfl_xor(pa[0], 1);
        if ((lane & 3) == 0) G[(size_t)row * GW + 8 * ((lane >> 5) & 1) + 4 * ((lane >> 4) & 1) + 2 * ((lane >> 3) & 1) + ((lane >> 2) & 1)] = pa[0];
    }
    if (MODE == 2) {
        float pa[8];
#pragma unroll
        for (int c = 0; c < 8; ++c) { float s = 0.f;
#pragma unroll
            for (int j = 0; j < 4; ++j) { const f32x4 w = *(const LAS f32x4*)(tab + c * 1024 + 256 * j + 4 * lane); s += h[4 * j] * w[0] + h[4 * j + 1] * w[1] + h[4 * j + 2] * w[2] + h[4 * j + 3] * w[3]; }
            pa[c] = s; }
#pragma unroll
        for (int c = 0; c < 4; ++c) { const bool up = (lane & 32) != 0; const float send = up ? pa[c] : pa[c + 4], keep = up ? pa[c + 4] : pa[c]; pa[c] = keep + __shfl_xor(send, 32); }
#pragma unroll
        for (int c = 0; c < 2; ++c) { const bool up = (lane & 16) != 0; const float send = up ? pa[c] : pa[c + 2], keep = up ? pa[c + 2] : pa[c]; pa[c] = keep + __shfl_xor(send, 16); }
        { const bool up = (lane & 8) != 0; const float send = up ? pa[0] : pa[1], keep = up ? pa[1] : pa[0]; pa[0] = keep + __shfl_xor(send, 8); }
        pa[0] += __shfl_xor(pa[0], 4); pa[0] += __shfl_xor(pa[0], 2); pa[0] += __shfl_xor(pa[0], 1);
        float v0 = -INFINITY, v1 = -INFINITY; int e0 = 0, e1 = 0;
#pragma unroll
        for (int c = 0; c < 8; ++c) { const float sv = __shfl(pa[0], 8 * c);
            if (sv > v0) { v1 = v0; e1 = e0; v0 = sv; e0 = c; } else if (sv > v1) { v1 = sv; e1 = c; } }
        lg[0] = v0; lg[1] = v1; lg[2] = __int_as_float(e0); lg[3] = __int_as_float(e1);
    }
}
__device__ __forceinline__ void load_gate_tab(LAS float* tab, const float* w_in, int tid) {
    for (int k = tid; k < D; k += NTHR) { const float4* w0 = (const float4*)(w_in + (size_t)k * DIN + 1792); const float4* w1 = (const float4*)(w_in + (size_t)k * DIN + 3592);
        const float4 a0 = w0[0], a1 = w0[1], b0 = w1[0], b1 = w1[1];
        tab[0 * 1024 + k] = a0.x; tab[1 * 1024 + k] = a0.y; tab[2 * 1024 + k] = a0.z; tab[3 * 1024 + k] = a0.w; tab[4 * 1024 + k] = a1.x; tab[5 * 1024 + k] = a1.y; tab[6 * 1024 + k] = a1.z; tab[7 * 1024 + k] = a1.w;
        tab[8 * 1024 + k] = b0.x; tab[9 * 1024 + k] = b0.y; tab[10 * 1024 + k] = b0.z; tab[11 * 1024 + k] = b0.w; tab[12 * 1024 + k] = b1.x; tab[13 * 1024 + k] = b1.y; tab[14 * 1024 + k] = b1.z; tab[15 * 1024 + k] = b1.w; }
}
__device__ __forceinline__ void load_router_tab(LAS float* tab, const float* router, int tid) {
    for (int k = tid; k < D; k += NTHR) { const float4* w0 = (const float4*)(router + (size_t)k * NE); const float4 a0 = w0[0], a1 = w0[1];
        tab[0 * 1024 + k] = a0.x; tab[1 * 1024 + k] = a0.y; tab[2 * 1024 + k] = a0.z; tab[3 * 1024 + k] = a0.w; tab[4 * 1024 + k] = a1.x; tab[5 * 1024 + k] = a1.y; tab[6 * 1024 + k] = a1.z; tab[7 * 1024 + k] = a1.w; }
}
struct Conv8Job { const float* W; int ldw; signed char* WT8; float* S; };
__device__ __forceinline__ void conv8_load(float (&v)[64], const Conv8Job& j, int tid, int wave) {
    const int lane = tid & 63, n = lane & 31, kp = lane >> 5;
#pragma unroll
    for (int i = 0; i < 64; ++i) v[i] = j.W[(size_t)(128 * wave + 2 * i + kp) * j.ldw + n];
}
__device__ __forceinline__ void conv8_stage(const float (&v)[64], LAS float* img, LAS float* pm, int tid, int wave) {
    const int lane = tid & 63, n = lane & 31, kp = lane >> 5; float m = 0.f;
#pragma unroll
    for (int i = 0; i < 64; ++i) { img[(128 * wave + 2 * i + kp) * 32 + n] = v[i]; m = fmaxf(m, fabsf(v[i])); }
    m = fmaxf(m, __shfl_xor(m, 32));
    if (lane < 32) pm[wave * 32 + lane] = m;
    __syncthreads();
}
__device__ __forceinline__ void conv8_quant(const Conv8Job& j, LAS float* img, LAS float* pm, int tid, int wave) {
    const int lane = tid & 63, no = lane >> 1, kh = 128 * wave + 64 * (lane & 1);
    float cm = 0.f;
#pragma unroll
    for (int w = 0; w < 8; ++w) cm = fmaxf(cm, pm[w * 32 + no]);
    const float inv = cm > 0.f ? 127.f / cm : 0.f;
    if (wave == 0 && (lane & 1) == 0) j.S[no] = cm > 0.f ? cm * (1.f / 127.f) : 1.f;
    const LAS float* sp = img + kh * 32 + no;
#pragma unroll
    for (int q = 0; q < 4; ++q) { unsigned wq[4];
#pragma unroll
        for (int jj = 0; jj < 4; ++jj) { const int kk = 16 * q + 4 * jj; const int q0 = (int)rintf(sp[kk * 32] * inv), q1 = (int)rintf(sp[(kk + 1) * 32] * inv), q2 = (int)rintf(sp[(kk + 2) * 32] * inv), q3 = (int)rintf(sp[(kk + 3) * 32] * inv);
            wq[jj] = (unsigned)(q0 & 255) | ((unsigned)(q1 & 255) << 8) | ((unsigned)(q2 & 255) << 16) | ((unsigned)(q3 & 255) << 24); }
        v4u o; o.x = wq[0]; o.y = wq[1]; o.z = wq[2]; o.w = wq[3];
        *(GAS v4u*)(j.WT8 + (size_t)no * 1024 + kh + 16 * q) = o; }
    __syncthreads();
}
namespace scan {
typedef short bf16x8 __attribute__((ext_vector_type(8)));
typedef float f32x4 __attribute__((ext_vector_type(4)));
typedef unsigned v2u __attribute__((ext_vector_type(2)));
constexpr int TS = 144, TB = 64 * TS;
constexpr int L_T0 = 0, L_T1 = TB, L_T2 = 2 * TB, L_T3 = 3 * TB, L_T4 = 4 * TB, L_T5 = 5 * TB, L_O = 6 * TB, OS = 68  , L_PART = L_O + 64 * OS * 4, L_VEC = L_PART + 8 * 64 * 4, L_END = L_VEC + 8 * 64 * 4;
static_assert(L_END <= RING_BYTES, "scan LDS");
constexpr size_t SC_LHG = 0, SC_LML = 16 * MiB, SC_DEC = 32 * MiB  , SC_NL = 32 * MiB + 256 * 1024  , SC_AMAX = 32 * MiB + 512 * 1024, SC_BEND = SC_AMAX + 4096, SC_MPREV = SC_BEND + 4096;

__device__ __forceinline__ float wave_incl_add(float v, int) {
    v += DPP_F(0.f, v, 0x111, 0xf); v += DPP_F(0.f, v, 0x112, 0xf); v += DPP_F(0.f, v, 0x114, 0xf); v += DPP_F(0.f, v, 0x118, 0xf);
    v += DPP_F(0.f, v, 0x142, 0xa); v += DPP_F(0.f, v, 0x143, 0xc);
    return v;
}
__device__ __forceinline__ float wave_incl_max(float v, int) {
    const float NI = -INFINITY;
    v = fmaxf(v, DPP_F(NI, v, 0x111, 0xf)); v = fmaxf(v, DPP_F(NI, v, 0x112, 0xf)); v = fmaxf(v, DPP_F(NI, v, 0x114, 0xf)); v = fmaxf(v, DPP_F(NI, v, 0x118, 0xf));
    v = fmaxf(v, DPP_F(NI, v, 0x142, 0xa)); v = fmaxf(v, DPP_F(NI, v, 0x143, 0xc));
    return v;
}
__device__ __forceinline__ float wave_max(float v) { return __int_as_float(__builtin_amdgcn_readlane(__float_as_int(wave_incl_max(v, 0)), 63)); }
__device__ __forceinline__ float lane_bcast(float v, int uniform_lane) { return __int_as_float(__builtin_amdgcn_readlane(__float_as_int(v), uniform_lane)); }
__device__ __forceinline__ f32x4 mma64(LAS const unsigned char* A, LAS const unsigned char* B, int m0, int n0, int lane, f32x4 acc) {
    const int r = lane & 15, kq = lane >> 4;
#pragma unroll
    for (int ks = 0; ks < 2; ++ks) {
        const bf16x8 a = *(LAS const bf16x8*)(A + (m0 + r) * TS + kq * 16 + ks * 64);
        const bf16x8 b = *(LAS const bf16x8*)(B + (n0 + r) * TS + kq * 16 + ks * 64);
        acc = __builtin_amdgcn_mfma_f32_16x16x32_bf16(a, b, acc, 0, 0, 0);
    }
    return acc;
}
__device__ __forceinline__ v4u pack8(const float (&v)[8]) { v4u w; w.x = pk2(v[0], v[1]); w.y = pk2(v[2], v[3]); w.z = pk2(v[4], v[5]); w.w = pk2(v[6], v[7]); return w; }
__device__ __forceinline__ v4u pack8h(const bf16_t (&v)[8]) { v4u w; w.x = v[0] | ((unsigned)v[1] << 16); w.y = v[2] | ((unsigned)v[3] << 16); w.z = v[4] | ((unsigned)v[5] << 16); w.w = v[6] | ((unsigned)v[7] << 16); return w; }
__device__ __forceinline__ void st16(LAS unsigned char* p, float v) { *(LAS bf16_t*)p = f2bf(v); }
__device__ __forceinline__ void load_state_tile(LAS unsigned char* T, const float* S, int tid) {
    const int v = tid >> 3, d0 = (tid & 7) * 8; const float4 x0 = *(const float4*)(S + v * 64 + d0), x1 = *(const float4*)(S + v * 64 + d0 + 4);
    v4u w; w.x = pk2(x0.x, x0.y); w.y = pk2(x0.z, x0.w); w.z = pk2(x1.x, x1.y); w.w = pk2(x1.z, x1.w);
    *(LAS v4u*)(T + v * TS + d0 * 2) = w;
}
typedef short s16x2 __attribute__((ext_vector_type(2)));
constexpr int IW = 4, TK = 64 / IW, CPT = 64 / IW, TPW = 16 / IW;
constexpr int HLDS = 6 * TB + 4096;
constexpr int H_O = L_T0, H_PART = 6 * TB, H_VEC = 6 * TB + 2048;
static_assert(2 * HLDS <= RING_BYTES && 64 * OS * 4 <= 2 * TB, "scan LDS (two halves)");
__device__ __forceinline__ void pack16w(LAS unsigned char* dst, const float (&v)[TK]) {
    v4u w0, w1; w0.x = pk2(v[0], v[1]); w0.y = pk2(v[2], v[3]); w0.z = pk2(v[4], v[5]); w0.w = pk2(v[6], v[7]); w1.x = pk2(v[8], v[9]); w1.y = pk2(v[10], v[11]); w1.z = pk2(v[12], v[13]); w1.w = pk2(v[14], v[15]);
    *(LAS v4u*)dst = w0; *(LAS v4u*)(dst + 16) = w1; }
__device__ __forceinline__ void pack16h(LAS unsigned char* dst, const s16x2 (&v)[TK / 2]) {
    v4u w0, w1; w0.x = __builtin_bit_cast(unsigned, v[0]); w0.y = __builtin_bit_cast(unsigned, v[1]); w0.z = __builtin_bit_cast(unsigned, v[2]); w0.w = __builtin_bit_cast(unsigned, v[3]);
    w1.x = __builtin_bit_cast(unsigned, v[4]); w1.y = __builtin_bit_cast(unsigned, v[5]); w1.z = __builtin_bit_cast(unsigned, v[6]); w1.w = __builtin_bit_cast(unsigned, v[7]);
    *(LAS v4u*)dst = w0; *(LAS v4u*)(dst + 16) = w1; }
__device__ __forceinline__ void local_state_mma_store(LAS unsigned char* Lh, bf16_t* LT, int tq, int lane) {
#pragma unroll
    for (int nn = 0; nn < TPW; ++nn) { const int ti = tq * TPW + nn, mt = ti >> 2, nt = ti & 3; f32x4 acc = {0.f, 0.f, 0.f, 0.f};
        acc = mma64(Lh + L_T0, Lh + L_T1, nt * 16, mt * 16, lane, acc);
        v2u w; w.x = pk2(acc[0], acc[1]); w.y = pk2(acc[2], acc[3]);
        *(v2u*)(LT + (mt * 16 + (lane & 15)) * 64 + nt * 16 + 4 * (lane >> 4)) = w; }
}
__device__ __forceinline__ float sigmoid_fast(float z) { return __builtin_amdgcn_rcpf(1.f + __builtin_amdgcn_exp2f(-1.4426950408889634f * z)); }
__device__ __forceinline__ float silu_fast(float z) { return z * sigmoid_fast(z); }
__device__ __forceinline__ void hgrn_gate(float lb, float z, float& sg, float& omsg, float& lf) {
    const float e = __builtin_amdgcn_exp2f(-1.4426950408889634f * fabsf(z)), ope = 1.f + e, r = __builtin_amdgcn_rcpf(ope), er = e * r; const bool pos = z >= 0.f;
    sg = pos ? r : er; omsg = pos ? er : r;
    lf = lb > 0.f ? __logf(lb + (1.f - lb) * sg) : (fminf(z, 0.f) - __logf(ope)); }
#define BFP(arr, i) bf2f((bf16_t)(arr)[(i) >> 1][(i) & 1])
struct HgIn { s16x2 fz[TK / 2], q[TK / 2], iv[TK / 2]; v4u gate[2]; v4u s[2]; };
template <bool DPH> __device__ __forceinline__ void hgrn_load(HgIn& R, const bf16_t* P, int b, int c, int h, const bf16_t* ST, int tl, int tq) {
    const int d = tl & 63, row0 = b * SEQ + c * 64; const bf16_t* pr = P + (size_t)(row0 + TK * tq) * PW + h * 64 + d;
#pragma unroll
    for (int i = 0; i < TK; ++i) { R.fz[i >> 1][i & 1] = (short)pr[(size_t)i * PW + P_HF]; R.iv[i >> 1][i & 1] = (short)pr[(size_t)i * PW + P_HI]; if (DPH) R.q[i >> 1][i & 1] = (short)pr[(size_t)i * PW + P_HQ]; }
    if (DPH) { const int t = tl / IW, v0 = (tl % IW) * CPT; const v4u* gp = (const v4u*)(P + (size_t)(row0 + t) * PW + P_HG + h * 64 + v0); R.gate[0] = gp[0]; R.gate[1] = gp[1];
        R.s[0] = *(const v4u*)(ST + t * 64 + v0); R.s[1] = *(const v4u*)(ST + t * 64 + v0 + 8); }
}
struct MlIn { s16x2 qr[(TK + 4) / 2], kr[(TK + 4) / 2], vv[TK / 2]; float ig, fg, np, mprev; v4u gate[2]; v4u s[2]; };
template <bool DPH> __device__ __forceinline__ void mlstm_load(MlIn& R, const bf16_t* P, const float* G, int b, int c, int h, const bf16_t* CT, const float* NP, const float* MP, int tl, int tq) {
    const int d = tl & 63, lane = tl & 63, row0 = b * SEQ + c * 64; const bool fz3 = (c == 0 && tq == 0);
    const bf16_t* pk = P + (size_t)(row0 + TK * tq) * PW + P_MK + h * 64 + d; const bf16_t* pq = P + (size_t)(row0 + TK * tq) * PW + P_MQ + h * 64 + d;
#pragma unroll
    for (int j = 0; j < TK + 3; ++j) { R.kr[j >> 1][j & 1] = (j < 3 && fz3) ? (short)0 : (short)pk[((long)j - 3) * PW]; if (DPH) R.qr[j >> 1][j & 1] = (j < 3 && fz3) ? (short)0 : (short)pq[((long)j - 3) * PW]; }
#pragma unroll
    for (int i = 0; i < TK; ++i) R.vv[i >> 1][i & 1] = (short)P[(size_t)(row0 + TK * tq + i) * PW + P_MV + h * 64 + d];
    R.ig = G[(size_t)(row0 + lane) * GW + h]; R.fg = G[(size_t)(row0 + lane) * GW + 4 + h];
    if (DPH) { const int t = tl / IW, v0 = (tl % IW) * CPT; const v4u* gp = (const v4u*)(P + (size_t)(row0 + t) * PW + P_MO + h * 64 + v0); R.gate[0] = gp[0]; R.gate[1] = gp[1];
        R.s[0] = *(const v4u*)(CT + t * 64 + v0); R.s[1] = *(const v4u*)(CT + t * 64 + v0 + 8);
        R.np = NP[lane]; R.mprev = MP[0]; }
}
__device__ __forceinline__ void store_state_tile(LAS unsigned char* T, const v4u (&x)[2], int tl) {
    const int v = tl / IW, d0 = (tl % IW) * CPT; *(LAS v4u*)(T + v * TS + d0 * 2) = x[0]; *(LAS v4u*)(T + v * TS + d0 * 2 + 16) = x[1];
}
__device__ __forceinline__ void conv_silu_r(const s16x2 (&raw)[(TK + 4) / 2], const float* w4  , float scale, float (&out)[TK]) {
    const float w0 = w4[0], w1 = w4[512], w2 = w4[1024], w3 = w4[1536];
#pragma unroll
    for (int i = 0; i < TK; ++i) out[i] = silu_fast(w0 * BFP(raw, i) + w1 * BFP(raw, i + 1) + w2 * BFP(raw, i + 2) + w3 * BFP(raw, i + 3)) * scale;
}
__device__ __forceinline__ void hgrn_b_item(LAS unsigned char* Lh, const HgIn& R, float lb, bf16_t* LT, float* DEC, int tl, int tq) {
    const int d = tl & 63;
    float bl[TK], kh[TK]; float run = 0.f;
#pragma unroll
    for (int i = 0; i < TK; ++i) { const float fz = BFP(R.fz, i);
        float sg, omsg, lf; hgrn_gate(lb, fz, sg, omsg, lf); kh[i] = (1.f - lb) * omsg; run += lf; bl[i] = run; }
    LAS float* part = (LAS float*)(Lh + H_PART);
    part[tq * 64 + d] = run; __syncthreads();
    float off = 0.f, btot = 0.f;
#pragma unroll
    for (int w = 0; w < IW; ++w) { const float pv = part[w * 64 + d]; btot += pv; if (w < tq) off += pv; }
#pragma unroll
    for (int i = 0; i < TK; ++i) kh[i] *= __expf(btot - (off + bl[i]));
    pack16w(Lh + L_T0 + d * TS + tq * (2 * TK), kh);
    pack16h(Lh + L_T1 + d * TS + tq * (2 * TK), R.iv);
    if (tq == 0) DEC[d] = __expf(btot);
    __syncthreads();
    local_state_mma_store(Lh, LT, tq, tl & 63);
    __syncthreads();
}
__device__ __forceinline__ void mlstm_gates(float ig, float fg, const float* b_i, const float* b_f, int h, int lane, float& bcum, float& a) {
    const float z = fg + b_f[h]; bcum = wave_incl_add(fminf(z, 0.f) - __logf(1.f + __builtin_amdgcn_exp2f(-1.4426950408889634f * fabsf(z))), lane); a = ig + b_i[h] - bcum;
}
__device__ __forceinline__ void mlstm_b_item(LAS unsigned char* Lh, const MlIn& R, const float* conv, const float* b_i, const float* b_f, int h, bf16_t* LT, float* NL, float* AMAX, float* BEND, int tl, int tq) {
    const int d = tl & 63, lane = tl & 63;
    float bcum, a; mlstm_gates(R.ig, R.fg, b_i, b_f, h, lane, bcum, a);
    const float A = wave_max(a), bend = lane_bcast(bcum, 63);
    float kh[TK]; conv_silu_r(R.kr, conv + 256 + h * 64 + d, 0.125f, kh);
    float nsum = 0.f;
#pragma unroll
    for (int i = 0; i < TK; ++i) { kh[i] *= __expf(lane_bcast(a, TK * tq + i) - A); nsum += bf2f(f2bf(kh[i])); }
    pack16w(Lh + L_T0 + d * TS + tq * (2 * TK), kh);
    pack16h(Lh + L_T1 + d * TS + tq * (2 * TK), R.vv);
    LAS float* part = (LAS float*)(Lh + H_PART); part[tq * 64 + d] = nsum;
    __syncthreads();
    if (tq == 0) { float s = 0.f;
#pragma unroll
        for (int w = 0; w < IW; ++w) s += part[w * 64 + d];
        NL[d] = s; if (lane == 0) { AMAX[0] = A; BEND[0] = bend; } }
    local_state_mma_store(Lh, LT, tq, lane);
    __syncthreads();
}
__device__ __forceinline__ void fox_cumsum_item(LAS unsigned char* L, const float* G, const float* fox_bf, float* CF, int bh, int tid, int wave) {
    const int b = bh >> 3, h = bh & 7, lane = tid & 63; const float bf = fox_bf[h];
    float loc[16]; float s = 0.f;
#pragma unroll
    for (int i = 0; i < 16; ++i) { s += log_sigmoidf_(G[((size_t)b * SEQ + tid * 16 + i) * GW + 8 + h] + bf); loc[i] = s; }
    const float incl = wave_incl_add(s, lane);
    LAS float* wt = (LAS float*)(L + L_PART);
    if (lane == 63) wt[wave] = incl;
    __syncthreads();
    float off = incl - s;
#pragma unroll
    for (int w = 0; w < 8; ++w) if (w < wave) off += wt[w];
#pragma unroll
    for (int i = 0; i < 16; ++i) CF[(size_t)bh * SEQ + tid * 16 + i] = (off + loc[i]) * LOG2E;
    __syncthreads();
}

template <bool DUMMY = false> __device__ __forceinline__ void scan_c_block(unsigned char* sc, int j, int tid) {
    constexpr size_t DOFF = DUMMY ? 104 * MiB / 4 : 0;
    constexpr int CB = 32;
    if (j < 128) {
        if (tid < 128) { const int chain = j >> 4, e = (j & 15) * 256 + 2 * tid, b = chain >> 2, h = chain & 3;
            unsigned* p = (unsigned*)(sc + SC_LHG) + (((size_t)(b * 128) * 4 + h) * 4096 + e) / 2; const float2* dp = (const float2*)((const float*)(sc + SC_DEC) + ((size_t)(b * 128) * 4 + h) * 64 + (e & 63));
            float S0 = 0.f, S1 = 0.f;
            for (int c0 = 0; c0 < 128; c0 += CB) { unsigned Lc[CB]; float2 dc[CB];
#pragma unroll
                for (int i = 0; i < CB; ++i) { Lc[i] = p[(size_t)(c0 + i) * 4 * 2048]; dc[i] = dp[(size_t)(c0 + i) * 4 * 32]; }
#pragma unroll
                for (int i = 0; i < CB; ++i) { const float o0 = S0, o1 = S1; S0 = dc[i].x * S0 + __uint_as_float(Lc[i] << 16); S1 = dc[i].y * S1 + __uint_as_float(Lc[i] & 0xffff0000u); Lc[i] = pk2(o0, o1); }
#pragma unroll
                for (int i = 0; i < CB; ++i) (p + DOFF)[(size_t)(c0 + i) * 4 * 2048] = Lc[i]; } }
    } else {
        const int jj = j - 128, chain = jj >> 4, part = jj & 15, b = chain >> 2, h = chain & 3; const size_t it0 = (size_t)(b * 128) * 4 + h;
        const float* am = (const float*)(sc + SC_AMAX) + it0; const float* be = (const float*)(sc + SC_BEND) + it0; float* mp = (float*)(sc + SC_MPREV) + it0;
        if (tid < 128) {
            unsigned* p = (unsigned*)(sc + SC_LML) + (it0 * 4096 + part * 256 + 2 * tid) / 2;
            const bool writer = (part == 0 && tid == 0);
            float S0 = 0.f, S1 = 0.f, m = 0.f;
            for (int c0 = 0; c0 < 128; c0 += CB) { unsigned Lc[CB]; float A[CB], bb[CB];
#pragma unroll
                for (int i = 0; i < CB; ++i) { Lc[i] = p[(size_t)(c0 + i) * 4 * 2048]; A[i] = am[(c0 + i) * 4]; bb[i] = be[(c0 + i) * 4]; }
#pragma unroll
                for (int i = 0; i < CB; ++i) { const float Mx = fmaxf(m, A[i]), o0 = S0, o1 = S1, f0 = __expf(m - Mx), f1 = __expf(A[i] - Mx);
                    S0 = f0 * S0 + f1 * __uint_as_float(Lc[i] << 16); S1 = f0 * S1 + f1 * __uint_as_float(Lc[i] & 0xffff0000u); Lc[i] = pk2(o0, o1); A[i] = m; m = bb[i] + Mx; }
#pragma unroll
                for (int i = 0; i < CB; ++i) { (p + DOFF)[(size_t)(c0 + i) * 4 * 2048] = Lc[i]; if (writer) (mp + DOFF)[(c0 + i) * 4] = A[i]; } }
        } else if (tid >= 256 && tid < 260) {
            float* p = (float*)(sc + SC_NL) + it0 * 64 + part * 4 + (tid - 256);
            float S = 0.f, m = 0.f;
            for (int c0 = 0; c0 < 128; c0 += CB) { float Lc[CB], A[CB], bb[CB];
#pragma unroll
                for (int i = 0; i < CB; ++i) { Lc[i] = p[(size_t)(c0 + i) * 4 * 64]; A[i] = am[(c0 + i) * 4]; bb[i] = be[(c0 + i) * 4]; }
#pragma unroll
                for (int i = 0; i < CB; ++i) { const float Mx = fmaxf(m, A[i]), So = S; S = __expf(m - Mx) * S + __expf(A[i] - Mx) * Lc[i]; Lc[i] = So; m = bb[i] + Mx; }
#pragma unroll
                for (int i = 0; i < CB; ++i) (p + DOFF)[(size_t)(c0 + i) * 4 * 64] = Lc[i]; }
        }
    }
}

template <bool SIG> __device__ __forceinline__ void head_epilogue(LAS unsigned char* Lh, float inv, const v4u (&gw)[2]  , const float* gain  , bf16_t* out  , int tl) {
    const int t = tl / IW, v0 = (tl % IW) * CPT; const LAS float* o = (const LAS float*)(Lh + H_O) + t * OS + v0;
    float x[CPT]; float ss = 0.f;
#pragma unroll
    for (int i = 0; i < CPT; ++i) { x[i] = o[i] * inv; ss += x[i] * x[i]; }
#pragma unroll
    for (int m = 1; m < IW; m <<= 1) ss += __shfl_xor(ss, m);
    const float r = rsqrtf(ss * (1.f / 64.f) + EPS);
    const unsigned gu[8] = {gw[0].x, gw[0].y, gw[0].z, gw[0].w, gw[1].x, gw[1].y, gw[1].z, gw[1].w};
    float y[CPT];
#pragma unroll
    for (int i = 0; i < CPT; ++i) { const float gz = bf2f((bf16_t)((gu[i >> 1] >> (16 * (i & 1))) & 0xffff)); y[i] = x[i] * r * gain[i] * (SIG ? sigmoid_fast(gz) : silu_fast(gz)); }
    v4u w0, w1; w0.x = pk2(y[0], y[1]); w0.y = pk2(y[2], y[3]); w0.z = pk2(y[4], y[5]); w0.w = pk2(y[6], y[7]); w1.x = pk2(y[8], y[9]); w1.y = pk2(y[10], y[11]); w1.z = pk2(y[12], y[13]); w1.w = pk2(y[14], y[15]);
    *(v4u*)out = w0; *((v4u*)out + 1) = w1;
}
__device__ __forceinline__ void store_o_tiles(LAS unsigned char* Lh, LAS const unsigned char* A1, LAS const unsigned char* B1, LAS const unsigned char* A2, LAS const unsigned char* B2, int tq, int lane) {
#pragma unroll
    for (int nn = 0; nn < TPW; ++nn) { const int ti = tq * TPW + nn, mt = ti >> 2, nt = ti & 3; f32x4 acc = {0.f, 0.f, 0.f, 0.f};
        acc = mma64(A1, B1, mt * 16, nt * 16, lane, acc); acc = mma64(A2, B2, mt * 16, nt * 16, lane, acc);
        LAS float* o = (LAS float*)(Lh + H_O);
#pragma unroll
        for (int r = 0; r < 4; ++r) o[(mt * 16 + 4 * (lane >> 4) + r) * OS + nt * 16 + (lane & 15)] = acc[r]; }
}
__device__ __forceinline__ void hgrn_d_item(LAS unsigned char* Lh, const HgIn& R, float lb, const float* gain  , bf16_t* out  , int tl, int tq) {
    const int d = tl & 63, lane = tl & 63;
    float bl[TK], kk[TK], q[TK]; float run = 0.f;
#pragma unroll
    for (int i = 0; i < TK; ++i) { const float fz = BFP(R.fz, i); q[i] = BFP(R.q, i);
        float sg, omsg, lf; hgrn_gate(lb, fz, sg, omsg, lf); kk[i] = (1.f - lb) * omsg; run += lf; bl[i] = run; }
    LAS float* part = (LAS float*)(Lh + H_PART);
    part[tq * 64 + d] = run;
    store_state_tile(Lh + L_T4, R.s, tl);
    pack16h(Lh + L_T3 + d * TS + tq * (2 * TK), R.iv);
    __syncthreads();
    float off = 0.f, bref = 0.f;
#pragma unroll
    for (int w = 0; w < IW; ++w) { const float pv = part[w * 64 + d]; if (w < IW / 2) bref += pv; if (w < tq) off += pv; }
#pragma unroll
    for (int i = 0; i < TK; ++i) { const float bb = off + bl[i]; const int t = TK * tq + i;
        st16(Lh + L_T0 + t * TS + d * 2, q[i] * __expf(bb - bref));
        st16(Lh + L_T1 + t * TS + d * 2, kk[i] * __expf(bref - bb));
        st16(Lh + L_T2 + t * TS + d * 2, q[i] * __expf(bb)); }
    __syncthreads();
#pragma unroll
    for (int nn = 0; nn < TPW; ++nn) { const int ti = tq * TPW + nn, mt = ti >> 2, nt = ti & 3; f32x4 acc = {0.f, 0.f, 0.f, 0.f};
        acc = mma64(Lh + L_T1, Lh + L_T0, mt * 16, nt * 16, lane, acc);
        const int s0 = mt * 16 + 4 * (lane >> 4), t = nt * 16 + (lane & 15);
        v2u w; w.x = pk2(s0 <= t ? acc[0] : 0.f, s0 + 1 <= t ? acc[1] : 0.f); w.y = pk2(s0 + 2 <= t ? acc[2] : 0.f, s0 + 3 <= t ? acc[3] : 0.f);
        *(LAS v2u*)(Lh + L_T5 + t * TS + s0 * 2) = w; }
    __syncthreads();
    store_o_tiles(Lh, Lh + L_T5, Lh + L_T3, Lh + L_T2, Lh + L_T4, tq, lane);
    __syncthreads();
    { const int t = tl / IW, v0 = (tl % IW) * CPT; head_epilogue<false>(Lh, 1.f, R.gate, gain + v0, out + (size_t)t * D + v0, tl); }
    __syncthreads();
}
__device__ __forceinline__ void mlstm_d_item(LAS unsigned char* Lh, const MlIn& R, const float* conv, const float* b_i, const float* b_f, const float* gain  , int h, bf16_t* out  , int tl, int tq) {
    const int d = tl & 63, lane = tl & 63; const float mprev = R.mprev;
    float bcum, a; mlstm_gates(R.ig, R.fg, b_i, b_f, h, lane, bcum, a);
    const float M = fmaxf(wave_incl_max(a, lane), mprev), sint = __expf(mprev - M);
    LAS float* vec = (LAS float*)(Lh + H_VEC);
    if (tq == 0) { vec[lane] = a; vec[64 + lane] = M; vec[128 + lane] = __expf(-bcum - M); vec[192 + lane] = R.np; }
    float qc[TK], kc[TK];
    conv_silu_r(R.qr, conv + h * 64 + d, 1.f, qc);
    conv_silu_r(R.kr, conv + 256 + h * 64 + d, 0.125f, kc);
#pragma unroll
    for (int i = 0; i < TK; ++i) { const int t = TK * tq + i;
        st16(Lh + L_T0 + t * TS + d * 2, qc[i]);
        st16(Lh + L_T1 + t * TS + d * 2, kc[i]);
        st16(Lh + L_T2 + t * TS + d * 2, qc[i] * lane_bcast(sint, t)); }
    pack16h(Lh + L_T3 + d * TS + tq * (2 * TK), R.vv);
    store_state_tile(Lh + L_T4, R.s, tl);
    __syncthreads();
#pragma unroll
    for (int nn = 0; nn < TPW; ++nn) { const int ti = tq * TPW + nn, mt = ti >> 2, nt = ti & 3; f32x4 acc = {0.f, 0.f, 0.f, 0.f};
        acc = mma64(Lh + L_T1, Lh + L_T0, mt * 16, nt * 16, lane, acc);
        const int s0 = mt * 16 + 4 * (lane >> 4), t = nt * 16 + (lane & 15); const float Mt = vec[64 + t];
        float wv[4];
#pragma unroll
        for (int r = 0; r < 4; ++r) wv[r] = (s0 + r <= t) ? acc[r] * __expf(vec[s0 + r] - Mt) : 0.f;
        v2u w; w.x = pk2(wv[0], wv[1]); w.y = pk2(wv[2], wv[3]); *(LAS v2u*)(Lh + L_T5 + t * TS + s0 * 2) = w; }
    __syncthreads();
    float inv;
    { const int t = tl / IW, c0 = (tl % IW) * CPT; float den = 0.f;
#pragma unroll
      for (int hh = 0; hh < 2; ++hh) { const v4u pw = *(LAS const v4u*)(Lh + L_T5 + t * TS + (c0 + 8 * hh) * 2), qw = *(LAS const v4u*)(Lh + L_T2 + t * TS + (c0 + 8 * hh) * 2);
          const unsigned pu[4] = {pw.x, pw.y, pw.z, pw.w}, qu[4] = {qw.x, qw.y, qw.z, qw.w};
#pragma unroll
          for (int i = 0; i < 8; ++i) den += bf2f((bf16_t)((pu[i >> 1] >> (16 * (i & 1))) & 0xffff)) + bf2f((bf16_t)((qu[i >> 1] >> (16 * (i & 1))) & 0xffff)) * vec[192 + c0 + 8 * hh + i]; }
#pragma unroll
      for (int m = 1; m < IW; m <<= 1) den += __shfl_xor(den, m);
      inv = __builtin_amdgcn_rcpf(fmaxf(fabsf(den), vec[128 + t])); }
    store_o_tiles(Lh, Lh + L_T5, Lh + L_T3, Lh + L_T2, Lh + L_T4, tq, lane);
    __syncthreads();
    { const int t = tl / IW, c0 = (tl % IW) * CPT; head_epilogue<true>(Lh, inv, R.gate, gain + c0, out + (size_t)t * D + c0, tl); }
    __syncthreads();
}
}
constexpr int N_PHASES = 21;
template <int PH, bool REP = false> __device__ __forceinline__ void run_phase(const MArgs& a, LAS unsigned char* L, const int tid, const int wave, const int G, const int bx, const int vcu) {
    const int lane = tid & 63, gw = vcu * NWAVES + wave, NGW = G * NWAVES;
    unsigned char* ws = a.ws; bf16_t* X = (bf16_t*)a.out;
    bf16_t* X2 = (bf16_t*)(ws + WS_X2); (void)X2;
    int* ctl = (int*)(ws + WS_CTL); int* cnt = ctl + CW_CNT;
    float* Gt = (float*)(ws + WS_G); float* CF = (float*)(ws + WS_CF); int4* tokinfo = (int4*)(ws + WS_TOKINFO); float2* tgate = (float2*)(ws + WS_TGATE); int* toklist = (int*)(ws + WS_TOKLIST);
    bf16_t* P = (bf16_t*)(ws + WS_P); bf16_t* HID = (bf16_t*)(ws + WS_HID); signed char* H = (signed char*)(ws + WS_H); float* SH = (float*)(ws + WS_SH); bf16_t* MIX = (bf16_t*)(ws + WS_MIX);
    signed char* XG = (signed char*)(ws + WS_XG); float* SXG = (float*)(ws + WS_SXG); bf16_t* Y = (bf16_t*)(ws + WS_XG);
    LAS float* scr = (LAS float*)(L + RING_OFF + wave * 16384);
    (void)ctl; (void)Gt; (void)CF; (void)tokinfo; (void)tgate; (void)toklist; (void)P; (void)HID; (void)H; (void)SH; (void)SXG; (void)MIX; (void)XG; (void)Y; (void)scr; (void)cnt; (void)lane; (void)gw; (void)NGW;
    constexpr int p = PH, l = p >= 10 ? 1 : 0, k = p == 0 ? -1 : (l ? p - 10 : p - 1);
    if constexpr (p == 0) {
            LAS float* img = (LAS float*)(L + RING_OFF); LAS float* pm = (LAS float*)(L + LDSCTL_OFF + 1024);
            { auto job = [&](int it) { Conv8Job j; int r = it;
                  if (r < 224) { const int ll = r / 112, nb = r % 112, sc = 32 * nb + (nb >= 56 ? 8 : 0);
                      j.W = a.in[I_W_IN] + (size_t)ll * D * DIN + sc; j.ldw = DIN; j.WT8 = (signed char*)(ws + WS_WIN) + (size_t)ll * PW * D + (size_t)32 * nb * D; j.S = (float*)(ws + WS_SWIN) + ll * PW + 32 * nb; }
                  else { r -= 224; const int up = r / 88, nb = r % 88, c = 32 * nb;
                      j.W = (up ? a.in[I_DUP] : a.in[I_DGATE]) + c; j.ldw = FF; j.WT8 = (signed char*)(ws + WS_WDGU) + (size_t)glu_row(c, up) * D; j.S = (float*)(ws + WS_SWDGU) + glu_row(c, up); }
                  return j; };
              float v[64]; int it = vcu; if (it < 400) conv8_load(v, job(it), tid, wave);
              for (; it < 400; it += G) { const Conv8Job j = job(it); conv8_stage(v, img, pm, tid, wave); if (it + G < 400) conv8_load(v, job(it + G), tid, wave); conv8_quant(j, img, pm, tid, wave); } }
            { LAS unsigned* slot = (LAS unsigned*)(L + LDSCTL_OFF); LAS float* tab = (LAS float*)(L + RING_OFF); bool tabbed = false;
              for (;;) {
                  __syncthreads();
                  if (tid == 0) *slot = __hip_atomic_fetch_add((unsigned*)ctl + CW_PQ + (REP ? 1 : 0), 1u, __ATOMIC_RELAXED, __HIP_MEMORY_SCOPE_AGENT);
                  __syncthreads();
                  const int t = __builtin_amdgcn_readfirstlane((int)*(volatile LAS unsigned*)slot);
                  if (t >= 560) break;
                  if (t < 304) { int r = 8 * t + wave;
                      if (r < 1024) { const int ll = r / 512; r %= 512; const int kb = r / 32, nb = r % 32;
                          tr_item(a.in[I_W_OUT] + (size_t)ll * D * D + 32 * nb, D, D, (bf16_t*)(ws + WS_WOUT) + (size_t)ll * D * D + (size_t)32 * nb * D, scr, 64 * kb, lane); }
                      else { r -= 1024; const int kb = r / 32, nb = r % 32; tr_item(a.in[I_DDOWN] + 32 * nb, D, FF, (bf16_t*)(ws + WS_WDDN) + (size_t)32 * nb * FF, scr, 64 * kb, lane); } }
                  else {
                      if (!tabbed) { __syncthreads(); load_gate_tab(tab, a.in[I_W_IN], tid); __syncthreads(); tabbed = true; }
                      float lg[8]; RowIn R, Rn; const int row0 = (t - 304) * 64 + wave * 8; mrow_load<false>(R, a.in[I_X], row0, lane);
#pragma unroll 1
                      for (int i = 0; i < 8; ++i) { if (i < 7) mrow_load<false>(Rn, a.in[I_X], row0 + i + 1, lane); asm volatile("" ::: "memory");
                          mrow<0>(R, H, SH, a.in[I_ATTN_NORM], tab, Gt, row0 + i, lane, lg); if (i < 7) R = Rn; } }
              } }
        } else if constexpr (k == 0) {
            { const int cb = (G >= 144) ? bx - 128 : bx; for (int bh = cb; bh >= 0 && bh < 16; bh += G) scan::fox_cumsum_item(L, Gt, a.in[I_FOX_BF] + l * 8, CF, bh, tid, wave); }
            pg8::GOrder S; S.so.init(NTOK, PW, G, bx); S.A = (const char*)H; S.B = (const char*)(ws + WS_WIN) + (size_t)l * PW * D; S.a_tile = (size_t)256 * D; S.b_tile = (size_t)256 * D; S.b_exp = 0;
            S.tb1 = S.tb2 = S.tb3 = S.tb4 = S.tb5 = S.tb6 = S.tb7 = 0x7fffffff;
            pg8::EpiBf8 E; E.O = P; E.ldc = PW; E.s_lo = P_FQ / 256; E.s_hi = P_FK / 256; E.scale = QSCALE; E.sA = SH; E.sB = (const float*)(ws + WS_SWIN) + l * PW; E.sc = (LAS float*)(L + LDSCTL_OFF + 4096);
            pg8::Gemm g{D / 2};
            pg8::gemm_phase<pg8::EpiBf8, pg8::GOrder, true, true, 1>(L + RING_OFF, g, S, E);
            if constexpr (!REP) moe_fill(a, ws, scr, l ? 2 : 0, G, bx, wave, lane);
        } else if constexpr (l == 1 && k == 9) {
            pg8::GOrderTail S; pg8::EpiBfPart E; int t[8]; int acc = 0;
#pragma unroll
            for (int e = 0; e < NE; ++e) { t[e] = acc; acc += (cnt[e] + 255) >> 8; }
            S.init(acc, D, G, bx); S.A = (const char*)HID; S.B = (const char*)(ws + WS_WMDN); S.a_tile = (size_t)256 * FE; S.b_tile = (size_t)256 * FE; S.b_exp = (size_t)D * FE;
            S.tb1 = t[1]; S.tb2 = t[2]; S.tb3 = t[3]; S.tb4 = t[4]; S.tb5 = t[5]; S.tb6 = t[6]; S.tb7 = t[7]; E.O = Y; E.ldc = D; E.scale = 1.f / (pg8::F8_HSCALE * pg8::F8_WSCALE);
            pg8::Gemm g{FE / 2};
            pg8::gemm_phase<pg8::EpiBfPart, pg8::GOrderTail, true, true, 2>(L + RING_OFF, g, S, E);
        } else if constexpr (k == 4 || (l == 0 && k == 7)) {
            pg8::GOrder S; S.so.init(NTOK, D, G, bx); S.b_exp = 0; S.tb1 = S.tb2 = S.tb3 = S.tb4 = S.tb5 = S.tb6 = S.tb7 = 0x7fffffff; int K;
            if constexpr (k == 4) { K = D; S.A = (const char*)MIX; S.B = (const char*)(ws + WS_WOUT) + (size_t)l * D * D * 2; }
            else { K = FF; S.A = (const char*)HID; S.B = (const char*)(ws + WS_WDDN); }
            S.a_tile = (size_t)256 * K * 2; S.b_tile = (size_t)256 * K * 2;
            pg8::Gemm g{K};
            if constexpr (k == 4 && l == 0) { pg8::EpiResid<true> E{a.in[I_X], X, D}; pg8::gemm_phase<pg8::EpiResid<true>, pg8::GOrder, true, true>(L + RING_OFF, g, S, E); }
            else { pg8::EpiResid<false> E{X, (k == 4 && l == 1) ? X2 : X, D}; pg8::gemm_phase<pg8::EpiResid<false>, pg8::GOrder, true, true>(L + RING_OFF, g, S, E); }
        } else if constexpr (l == 0 && k == 6) {
            pg8::GOrder S; pg8::EpiSwiglu8<false> E; S.a_tile = (size_t)256 * D; S.b_tile = (size_t)256 * D; E.O = HID; E.sc = (LAS float*)(L + LDSCTL_OFF + 4096);
            S.so.init(NTOK, 2 * FF, G, bx); S.A = (const char*)H; S.B = (const char*)(ws + WS_WDGU); S.b_exp = 0; S.tb1 = S.tb2 = S.tb3 = S.tb4 = S.tb5 = S.tb6 = S.tb7 = 0x7fffffff;
            E.ldc = FF; E.sA = SH; E.sB = (const float*)(ws + WS_SWDGU); E.sb_exp = 0;
            E.tb1 = S.tb1; E.tb2 = S.tb2; E.tb3 = S.tb3; E.tb4 = S.tb4; E.tb5 = S.tb5; E.tb6 = S.tb6; E.tb7 = S.tb7;
            pg8::Gemm g{D / 2};
            pg8::gemm_phase<pg8::EpiSwiglu8<false>, pg8::GOrder, true, true, 1>(L + RING_OFF, g, S, E);
            if constexpr (!REP) moe_fill(a, ws, scr, 1, G, bx, wave, lane);
        } else if constexpr (l == 1 && k == 7) {
            pg8::GOrder S; pg8::EpiSwigluF8 E; S.a_tile = (size_t)256 * D; S.b_tile = (size_t)256 * D; E.O = (unsigned char*)HID; E.ldc = FE;
            int t[8]; int acc = 0;
#pragma unroll
            for (int e = 0; e < NE; ++e) { t[e] = acc; acc += (cnt[e] + 255) >> 8; }
            S.so.init(acc * 256, 2 * FE, G, bx); S.A = (const char*)XG; S.B = (const char*)(ws + WS_WMGU); S.b_exp = (size_t)2 * FE * D;
            S.tb1 = t[1]; S.tb2 = t[2]; S.tb3 = t[3]; S.tb4 = t[4]; S.tb5 = t[5]; S.tb6 = t[6]; S.tb7 = t[7];
            pg8::Gemm g{D / 2};
#ifdef EXP_NULL_EPI
            if constexpr (REP) { pg8::EpiNull E0; E0.O = (unsigned char*)HID; E0.ldc = FE; pg8::gemm_phase<pg8::EpiNull, pg8::GOrder, true, true, 2>(L + RING_OFF, g, S, E0); } else
#endif
            pg8::gemm_phase<pg8::EpiSwigluF8, pg8::GOrder, true, true, 2>(L + RING_OFF, g, S, E);
            if constexpr (!REP) { const int ni = moe_tail_idle(cnt, G), ci = bx - (256 - ni);
                if (ni && ci >= 0) { const int first = MOE_ITEMS - ni * NWAVES * MOE_FILL17 + ci * NWAVES + wave; moe_conv_range(a, ws, scr, first, ni * NWAVES, MOE_ITEMS, lane); } }
        } else if constexpr (k == 5 && l == 0) {
            float lg[8];
            { RowIn R, Rn; int row = gw; if (row < NTOK) mrow_load<true>(R, X, row, lane);
              for (; row < NTOK; row += NGW) { const int nx = row + NGW; if (nx < NTOK) mrow_load<true>(Rn, X, nx, lane); asm volatile("" ::: "memory");
                  mrow<1>(R, H, SH, a.in[I_FFN_NORM], nullptr, nullptr, row, lane, lg); if (nx < NTOK) R = Rn; } }
        } else if constexpr (k == 8 && l == 0) {
            LAS float* tab = (LAS float*)(L + RING_OFF); load_gate_tab(tab, a.in[I_W_IN] + (size_t)D * DIN, tid); __syncthreads();
            float lg[8];
            { RowIn R, Rn; int row = gw; if (row < NTOK) mrow_load<true>(R, X, row, lane);
              for (; row < NTOK; row += NGW) { const int nx = row + NGW; if (nx < NTOK) mrow_load<true>(Rn, X, nx, lane); asm volatile("" ::: "memory");
                  mrow<0>(R, H, SH, a.in[I_ATTN_NORM] + D, tab, Gt, row, lane, lg); if (nx < NTOK) R = Rn; } }
        } else if constexpr (k == 5 && l == 1) {
            LAS int* sel_e = (LAS int*)(L + RING_OFF);
            LAS float* sel_g = (LAS float*)(L + RING_OFF + 512);
            LAS int* lcnt = (LAS int*)(L + RING_OFF + 1024);
            LAS float* tab = (LAS float*)(L + RING_OFF + 4096); load_router_tab(tab, a.in[I_ROUTER], tid); __syncthreads();
            for (int rb = bx; rb < NTOK / 64; rb += G) {
                if (tid < 16) lcnt[tid] = 0;
                RowIn R, Rn; mrow_load<true>(R, X2, rb * 64 + wave * 8, lane);
                for (int i = 0; i < 8; ++i) { const int rl = wave * 8 + i, row = rb * 64 + rl; float lg[8];
                    if (i < 7) mrow_load<true>(Rn, X2, row + 1, lane); asm volatile("" ::: "memory");
                    mrow<2>(R, H, SH, a.in[I_FFN_NORM] + D, tab, nullptr, row, lane, lg); if (i < 7) R = Rn;
                    if (lane == 0) { const float v0 = lg[0], v1 = lg[1]; const int e0 = __float_as_int(lg[2]), e1 = __float_as_int(lg[3]);
                        const float g1 = 1.f / (1.f + __expf(v0 - v1));
                        sel_e[2 * rl] = e0; sel_e[2 * rl + 1] = e1; sel_g[2 * rl] = 1.f - g1; sel_g[2 * rl + 1] = g1; } }
                __syncthreads();
                int e0 = 0, e1 = 0, r0 = 0, r1 = 0;
                if (tid < 64) { e0 = sel_e[2 * tid]; e1 = sel_e[2 * tid + 1]; r0 = __hip_atomic_fetch_add(lcnt + e0, 1, __ATOMIC_RELAXED, __HIP_MEMORY_SCOPE_WORKGROUP); r1 = __hip_atomic_fetch_add(lcnt + e1, 1, __ATOMIC_RELAXED, __HIP_MEMORY_SCOPE_WORKGROUP); }
                __syncthreads();
                if (tid < 8) lcnt[8 + tid] = atomicAdd(cnt + tid, (int)lcnt[tid]);
                __syncthreads();
                if (tid < 64) { const int row = rb * 64 + tid, s0 = lcnt[8 + e0] + r0, s1 = lcnt[8 + e1] + r1;
                    toklist[e0 * NTOK + s0] = row; toklist[e1 * NTOK + s1] = row; tokinfo[row] = make_int4(e0, s0, e1, s1); tgate[row] = make_float2(sel_g[2 * tid], sel_g[2 * tid + 1]); }
                __syncthreads();
            }
        } else if constexpr (k == 6 && l == 1) {
            { int base[NE]; int acc = 0;
#pragma unroll
              for (int e = 0; e < NE; ++e) { base[e] = acc; acc += (cnt[e] + 255) & ~255; }
              for (int r = gw; r < acc; r += NGW) { int e = 0, be = 0;
#pragma unroll
                  for (int c = 1; c < NE; ++c) if (r >= base[c]) { e = c; be = base[c]; }
                  const int s = r - be; v4u v0 = {0u, 0u, 0u, 0u}; float sv = 0.f;
                  if (s < cnt[e]) { const int tok = toklist[e * NTOK + s]; v0 = *((const v4u*)(H + (size_t)tok * D) + lane); sv = SH[tok]; }
                  *((v4u*)(XG + (size_t)r * D) + lane) = v0; if (lane == 0) SXG[r] = sv; } }
            moe_conv_range(a, ws, scr, moe_prefilled(G) + gw, NGW, MOE_ITEMS - moe_tail_idle(cnt, G) * NWAVES * MOE_FILL17, lane);
        } else if constexpr (k == 8 && l == 1) {
        } else if constexpr (l == 1 && k == 10) {
            int base[NE]; { int acc = 0;
#pragma unroll
              for (int e = 0; e < NE; ++e) { base[e] = acc; acc += (cnt[e] + 255) & ~255; } }
            constexpr int HALFR = NTOK; constexpr int rlo = 0;
            const bf16_t* Xs = X2;
            float* out = (float*)a.out;
            struct FA { uint2 v[4]; int4 ti; float2 tg; }; struct FB { uint2 y0[4], y1[4]; };
            auto loadA = [&](FA& A, int rr) { const uint2* xr = (const uint2*)(Xs + (size_t)rr * D) + lane;
#pragma unroll
                for (int j = 0; j < 4; ++j) A.v[j] = xr[64 * j];
                A.ti = tokinfo[rlo + rr]; A.tg = tgate[rlo + rr]; };
            auto ldrow = [&](uint2 (&y)[4], int r) {
                if ((r >> 8) < pg8::GOrderTail::MAIN_M) { const uint2* p = (const uint2*)(Y + (size_t)r * D) + lane;
#pragma unroll
                    for (int j = 0; j < 4; ++j) y[j] = p[64 * j]; }
                else { float s[16];
#pragma unroll
                    for (int i = 0; i < 16; ++i) s[i] = 0.f;
#pragma unroll 2
                    for (int kp = 0; kp < 8; ++kp) { const uint2* p = (const uint2*)(Y + (size_t)((pg8::EpiBfPart::YP_TILE0 + kp * 8 + (r >> 8) - pg8::GOrderTail::MAIN_M) * 256 + (r & 255)) * D) + lane;
#pragma unroll
                        for (int j = 0; j < 4; ++j) { const uint2 q = p[64 * j]; s[4 * j] += __uint_as_float(q.x << 16); s[4 * j + 1] += __uint_as_float(q.x & 0xffff0000u); s[4 * j + 2] += __uint_as_float(q.y << 16); s[4 * j + 3] += __uint_as_float(q.y & 0xffff0000u); } }
#pragma unroll
                    for (int j = 0; j < 4; ++j) { y[j].x = pk2(s[4 * j], s[4 * j + 1]); y[j].y = pk2(s[4 * j + 2], s[4 * j + 3]); } } };
            auto loadB = [&](FB& B, const FA& A) { int b0 = 0, b1 = 0;
#pragma unroll
                for (int c = 0; c < NE; ++c) { if (c == A.ti.x) b0 = base[c]; if (c == A.ti.z) b1 = base[c]; }
                ldrow(B.y0, b0 + A.ti.y); ldrow(B.y1, b1 + A.ti.w); };
            FA A0, A1, A2; FB B0, B1; int rr = gw;
            if (rr < HALFR) { loadA(A0, rr); if (rr + NGW < HALFR) loadA(A1, rr + NGW); loadB(B0, A0); }
            for (; rr < HALFR; rr += NGW) {
                const bool h1 = rr + NGW < HALFR, h2 = rr + 2 * NGW < HALFR;
                if (h2) loadA(A2, rr + 2 * NGW);
                if (h1) loadB(B1, A1);
                asm volatile("" ::: "memory");
                float4 v[4]; const float2 tg = A0.tg;
#pragma unroll
                for (int j = 0; j < 4; ++j) { const uint2 q = B0.y0[j], c = B0.y1[j], x = A0.v[j];
                    v[j].x = __uint_as_float(x.x << 16) + tg.x * bf2f((bf16_t)(q.x & 0xffff)) + tg.y * bf2f((bf16_t)(c.x & 0xffff)); v[j].y = __uint_as_float(x.x & 0xffff0000u) + tg.x * bf2f((bf16_t)(q.x >> 16)) + tg.y * bf2f((bf16_t)(c.x >> 16));
                    v[j].z = __uint_as_float(x.y << 16) + tg.x * bf2f((bf16_t)(q.y & 0xffff)) + tg.y * bf2f((bf16_t)(c.y & 0xffff)); v[j].w = __uint_as_float(x.y & 0xffff0000u) + tg.x * bf2f((bf16_t)(q.y >> 16)) + tg.y * bf2f((bf16_t)(c.y >> 16)); }
                float ss = 0.f;
#pragma unroll
                for (int j = 0; j < 4; ++j) ss += v[j].x * v[j].x + v[j].y * v[j].y + v[j].z * v[j].z + v[j].w * v[j].w;
                ss = wave_sum(ss); const float r = rsqrtf(ss * (1.f / D) + EPS);
                float4* xo = (float4*)(out + (size_t)(rlo + rr) * D) + lane;
#pragma unroll
                for (int j = 0; j < 4; ++j) { const float4 g = *((const float4*)a.in[I_FINAL_NORM] + 64 * j + lane); xo[64 * j] = make_float4(v[j].x * r * g.x, v[j].y * r * g.y, v[j].z * r * g.z, v[j].w * r * g.w); }
                if (h1) { A0 = A1; B0 = B1; } if (h2) A1 = A2;
            }
        } else {
            if constexpr (k == 1) {
                unsigned char* sc = ws + WS_SCAN; const int wv = wave;
#define ITEM_DECODE(it_) const int item = (it_) & 1023, h = item & 3, c = (item >> 2) & 127, b = item >> 9
#define HG_LB(h_) (l == 0 ? 0.f : 1.f / (1.f + __expf(a.in[I_HGRN_LB][(h_) * 64 + (tl & 63)] - a.in[I_HGRN_LB][256 + (h_) * 64 + (tl & 63)])))
                const int hf = wave >> 2, tq4 = wave & 3; LAS unsigned char* Lh = L + hf * scan::HLDS;
                { scan::HgIn R, Rn;
                  auto itemOf = [&](int pp) { const int it = bx + (2 * pp + hf) * G; return it < 1024 ? it : it - G; };
                  int pp = 0; if (bx < 1024) { ITEM_DECODE(itemOf(0)); scan::hgrn_load<false>(R, P, b, c, h, nullptr, tid & 255, tq4); }
                  for (; bx + 2 * pp * G < 1024; ++pp) { const bool nx = bx + 2 * (pp + 1) * G < 1024; int tl = tid & 255; asm volatile("" : "+v"(tl));
                      if (nx) { ITEM_DECODE(itemOf(pp + 1)); scan::hgrn_load<false>(Rn, P, b, c, h, nullptr, tl, tq4); }
                      asm volatile("" ::: "memory");
                      { ITEM_DECODE(itemOf(pp)); (void)b; (void)c; scan::hgrn_b_item(Lh, R, HG_LB(h), (bf16_t*)(sc + scan::SC_LHG) + (size_t)item * 4096, (float*)(sc + scan::SC_DEC) + item * 64, tl, tq4); }
                      if (nx) R = Rn; } }
                { scan::MlIn R, Rn; int base = bx; while (base < 1024) base += G;
                  auto itemOf = [&](int pp) { const int it = base + (2 * pp + hf) * G; return it < 2048 ? it : it - G; };
                  int pp = 0; if (base < 2048) { ITEM_DECODE(itemOf(0)); scan::mlstm_load<false>(R, P, Gt, b, c, h, nullptr, nullptr, nullptr, tid & 255, tq4); }
                  for (; base + 2 * pp * G < 2048; ++pp) { const bool nx = base + 2 * (pp + 1) * G < 2048; int tl = tid & 255; asm volatile("" : "+v"(tl));
                      if (nx) { ITEM_DECODE(itemOf(pp + 1)); scan::mlstm_load<false>(Rn, P, Gt, b, c, h, nullptr, nullptr, nullptr, tl, tq4); }
                      asm volatile("" ::: "memory");
                      { ITEM_DECODE(itemOf(pp)); (void)b; (void)c; scan::mlstm_b_item(Lh, R, a.in[I_MLSTM_CONV] + l * 2048, a.in[I_MLSTM_BI] + l * 4, a.in[I_MLSTM_BF] + l * 4, h, (bf16_t*)(sc + scan::SC_LML) + (size_t)item * 4096,
                                            (float*)(sc + scan::SC_NL) + item * 64, (float*)(sc + scan::SC_AMAX) + item, (float*)(sc + scan::SC_BEND) + item, tl, tq4); }
                      if (nx) R = Rn; } }
                { LAS unsigned* lst = (LAS unsigned*)(L + LDSCTL_OFF + 64);
                  if (tid < 48) lst[tid] = 0u; __syncthreads();
                  float mq0 = 0.f, mq1 = 0.f, mk0 = 0.f, mk1 = 0.f, md0 = 0.f, md1 = 0.f;
                  for (int row = gw; row < NTOK; row += NGW) {
                      const v4u wq = *((const v4u*)(P + (size_t)row * PW + P_FQ) + lane), wk = *((const v4u*)(P + (size_t)row * PW + P_FK) + lane);
                      float sq = 0.f, sk = 0.f, sd = 0.f;
#pragma unroll
                      for (int i = 0; i < 4; ++i) { const float q0 = bf2f((bf16_t)(wq[i] & 0xffff)), q1 = bf2f((bf16_t)(wq[i] >> 16)), k0 = bf2f((bf16_t)(wk[i] & 0xffff)), k1 = bf2f((bf16_t)(wk[i] >> 16));
                          sq += q0 * q0 + q1 * q1; sk += k0 * k0 + k1 * k1; sd += q0 * k0 + q1 * k1; }
                      sq += __shfl_xor(sq, 1); sq += __shfl_xor(sq, 2); sq += __shfl_xor(sq, 4); sk += __shfl_xor(sk, 1); sk += __shfl_xor(sk, 2); sk += __shfl_xor(sk, 4);
                      sd += __shfl_xor(sd, 1); sd += __shfl_xor(sd, 2); sd += __shfl_xor(sd, 4); sd = fmaxf(-sd, 0.f);
                      if (row < SEQ) { mq0 = fmaxf(mq0, sq); mk0 = fmaxf(mk0, sk); md0 = fmaxf(md0, sd); } else { mq1 = fmaxf(mq1, sq); mk1 = fmaxf(mk1, sk); md1 = fmaxf(md1, sd); } }
                  if ((lane & 7) == 0) { const int hh = lane >> 3;
                      __hip_atomic_fetch_max(lst + hh * 2, __float_as_uint(mq0), __ATOMIC_RELAXED, __HIP_MEMORY_SCOPE_WORKGROUP); __hip_atomic_fetch_max(lst + hh * 2 + 1, __float_as_uint(mk0), __ATOMIC_RELAXED, __HIP_MEMORY_SCOPE_WORKGROUP);
                      __hip_atomic_fetch_max(lst + 16 + hh * 2, __float_as_uint(mq1), __ATOMIC_RELAXED, __HIP_MEMORY_SCOPE_WORKGROUP); __hip_atomic_fetch_max(lst + 16 + hh * 2 + 1, __float_as_uint(mk1), __ATOMIC_RELAXED, __HIP_MEMORY_SCOPE_WORKGROUP);
                      __hip_atomic_fetch_max(lst + 32 + hh, __float_as_uint(md0), __ATOMIC_RELAXED, __HIP_MEMORY_SCOPE_WORKGROUP); __hip_atomic_fetch_max(lst + 40 + hh, __float_as_uint(md1), __ATOMIC_RELAXED, __HIP_MEMORY_SCOPE_WORKGROUP); }
                  __syncthreads();
                  if (tid < 32) __hip_atomic_fetch_max((unsigned*)ctl + CW_STAT + l * 32 + tid, lst[tid], __ATOMIC_RELAXED, __HIP_MEMORY_SCOPE_AGENT);
                  else if (tid < 48) __hip_atomic_fetch_max((unsigned*)ctl + CW_STAT3 + l * 16 + (tid - 32), lst[tid], __ATOMIC_RELAXED, __HIP_MEMORY_SCOPE_AGENT); }
            } else if constexpr (k == 2) {
                for (int j = bx; j < 256; j += G) scan::scan_c_block<REP>(ws + WS_SCAN, j, tid);
            } else if constexpr (k == 3) {
                static_assert(attn_body::ATTN_LDS_BYTES <= RING_BYTES, "attention LDS");
                unsigned char* sc = ws + WS_SCAN; const int wv = wave;
                const float* stat = (const float*)(ctl + CW_STAT + l * 32);
                LAS unsigned* slot = (LAS unsigned*)(L + LDSCTL_OFF);
                int v;
                for (;;) {
                    if (tid == 0) *slot = __hip_atomic_fetch_add((unsigned*)ctl + CW_QCTR + l + (REP ? 2 : 0), 1u, __ATOMIC_RELAXED, __HIP_MEMORY_SCOPE_AGENT);
                    __syncthreads();
                    v = __builtin_amdgcn_readfirstlane((int)*(volatile LAS unsigned*)slot);
                    if (v >= 736) break;
                    int qb, bh, part = 0; float* PART = nullptr;
                    if (v < 448) { qb = 31 - (v >> 5); bh = v & 15; part = (v >> 4) & 1; PART = (float*)(ws + WS_SCAN + (40 + 32 * l) * MiB) + (size_t)(bh * 14 + (qb - 18)) * 2 * attn_body::PART_F; }
                    else { const int u2 = v - 448; qb = 17 - (u2 >> 4); bh = u2 & 15; }
                    const float Tsk = 30.f + (__builtin_sqrtf(stat[bh * 2] * stat[bh * 2 + 1]) + ((const float*)(ctl + CW_STAT3 + l * 16))[bh]) * 1.01f + 1.f;
                    attn_body::attn_unit<8>(bh >> 3, bh & 7, qb, (const attn_body::bf16*)(P + P_FQ), (const attn_body::bf16*)(P + P_FK), (const attn_body::bf16*)(P + P_FV), (attn_body::bf16*)(MIX + 512), CF + (size_t)bh * SEQ, Tsk,
                                            part, PART, (unsigned*)ctl + CW_AFLAG + (l + (REP ? 2 : 0)) * 512 + bh * 32 + qb, (char*)L + RING_OFF);
                    __syncthreads();
                }
                int tid2 = tid; asm volatile("" : "+v"(tid2));
                while (v < 736 + 384 + 256) {
                    const int it0 = v < 1120 ? (v - 736) * 4 : 1536 + (v - 1120) * 2, nj = v < 1120 ? 2 : 1;
                    const int hf = wv >> 2, tq4 = wv & 3; LAS unsigned char* Lh = L + hf * scan::HLDS;
#pragma unroll 1
                    for (int j = 0; j < nj; ++j) { const int it = it0 + 2 * j + hf; int tl = tid2 & 255; asm volatile("" : "+v"(tl)); ITEM_DECODE(it);
                        if (it0 < 1024) { scan::HgIn R; scan::hgrn_load<true>(R, P, b, c, h, (const bf16_t*)(sc + scan::SC_LHG) + (size_t)item * 4096, tl, tq4);
                            const float lb = l == 0 ? 0.f : 1.f / (1.f + __expf(a.in[I_HGRN_LB][h * 64 + (tl & 63)] - a.in[I_HGRN_LB][256 + h * 64 + (tl & 63)]));
                            scan::hgrn_d_item(Lh, R, lb, a.in[I_HGRN_NORM] + l * 256 + h * 64, MIX + (size_t)(b * SEQ + c * 64) * D + h * 64, tl, tq4); }
                        else { scan::MlIn R; scan::mlstm_load<true>(R, P, Gt, b, c, h, (const bf16_t*)(sc + scan::SC_LML) + (size_t)item * 4096, (const float*)(sc + scan::SC_NL) + item * 64, (const float*)(sc + scan::SC_MPREV) + item, tl, tq4);
                            scan::mlstm_d_item(Lh, R, a.in[I_MLSTM_CONV] + l * 2048, a.in[I_MLSTM_BI] + l * 4, a.in[I_MLSTM_BF] + l * 4, a.in[I_MLSTM_NORM] + l * 256 + h * 64, h, MIX + (size_t)(b * SEQ + c * 64) * D + 256 + h * 64, tl, tq4); } }
                    __syncthreads();
                    if (tid2 == 0) *slot = __hip_atomic_fetch_add((unsigned*)ctl + CW_QCTR + l + (REP ? 2 : 0), 1u, __ATOMIC_RELAXED, __HIP_MEMORY_SCOPE_AGENT);
                    __syncthreads();
                    v = __builtin_amdgcn_readfirstlane((int)*(volatile LAS unsigned*)slot);
                }
            }

        }
}
__global__ void __launch_bounds__(NTHR, 2) mega(MArgs a) {
    extern __shared__ __attribute__((aligned(16))) unsigned char lds[];
    LAS unsigned char* L = (LAS unsigned char*)lds;
    volatile LAS unsigned* MISC = (volatile LAS unsigned*)(L + MISC_OFF);
    const int tid = threadIdx.x, wave = __builtin_amdgcn_readfirstlane(tid >> 6);
    const int G = gridDim.x, bx = blockIdx.x, vcu = (G % 8 == 0) ? (bx % 8) * (G / 8) + bx / 8 : bx;
    for (int u = tid; u < (LDS_BYTES - LDSCTL_OFF) / 4; u += NTHR) ((LAS unsigned*)(L + LDSCTL_OFF))[u] = 0u;
    __syncthreads();
    const int lo = a.ph_lo, hi = a.ph_hi;
    XcdBarrier bar; bar.bar = (unsigned*)(a.ws + WS_CTL) + CW_BAR; bar.x = 0; bar.st = nullptr;
    if (hi - lo > 1) bar = xcd_barrier_post((unsigned*)(a.ws + WS_CTL) + CW_BAR, MISC + 8);
#ifndef REPEAT_MASK
#define REPEAT_MASK 0u
#endif
#define PHASE(k) if (lo <= (k) && (k) < hi) { run_phase<k>(a, L, tid, wave, G, bx, vcu); if constexpr ((REPEAT_MASK >> (k)) & 1u) { xcd_barrier(bar); run_phase<k, true>(a, L, tid, wave, G, bx, vcu); } if ((k) + 1 < hi) xcd_barrier(bar); }
    PHASE(0) PHASE(1) PHASE(2) PHASE(3) PHASE(4) PHASE(5) PHASE(6) PHASE(7) PHASE(8) PHASE(9) PHASE(10)
    PHASE(11) PHASE(12) PHASE(13) PHASE(14) PHASE(15) PHASE(16) PHASE(17) PHASE(19) PHASE(20)
#undef PHASE
}
#ifndef MEGA_MASK
#define MEGA_MASK 0x1FFFFFu
#endif
#ifndef FUSE_RUNS
#define FUSE_RUNS 1
#endif
extern "C" void kernel_launch(void* const* d_in, const int* in_sizes, int n_in, void* d_out, int out_size, void* d_ws, size_t ws_size, hipStream_t stream) {
    static int grid = 0;
    if (grid == 0) {
        if (n_in != 20 || ws_size < WS_END || out_size != NTOK * D) { fprintf(stderr, "kernel_launch: unexpected n_in %d / ws %zu / out %d\n", n_in, ws_size, out_size); grid = -1; return; }
        int dev = 0, cus = 0, per_cu = 0;
        if (hipGetDevice(&dev) != hipSuccess || hipDeviceGetAttribute(&cus, hipDeviceAttributeMultiprocessorCount, dev) != hipSuccess) { grid = -1; return; }
        if (hipFuncSetAttribute((const void*)mega, hipFuncAttributeMaxDynamicSharedMemorySize, LDS_BYTES) != hipSuccess) { fprintf(stderr, "kernel_launch: hipFuncSetAttribute failed\n"); grid = -1; return; }
        if (hipOccupancyMaxActiveBlocksPerMultiprocessor(&per_cu, (const void*)mega, NTHR, LDS_BYTES) != hipSuccess || per_cu < 1) { fprintf(stderr, "kernel_launch: occupancy query says %d\n", per_cu); per_cu = 1; }
        (void)hipGetLastError();
        grid = cus;
        if (grid > 256) grid = 256;
    }
    if (grid < 0) return;
    const float* const* in = (const float* const*)d_in;
    unsigned char* ws = (unsigned char*)d_ws; float* X = (float*)d_out;
    (void)hipMemsetAsync(ws + WS_CTL, 0, CTL_BYTES, stream);
    MArgs ma; memset(&ma, 0, sizeof ma);
    for (int i = 0; i < 20; ++i) ma.in[i] = in[i];
    ma.out = X; ma.ws = ws;
    ma.ph_lo = 0; ma.ph_hi = N_PHASES;
    hipLaunchKernelGGL(mega, dim3(grid), dim3(NTHR), LDS_BYTES, stream, ma);
}
```
